# Optimizing an MI355X kernel written in HIP

```python
import math
import jax, jax.numpy as jnp
from jax import lax
import numpy as np

D_MODEL = 1024
BATCH = 2
SEQ = 16384
DEPTH = 4

GRID_W = 64
CTX_LEN = 256
HEAD_DIM = 128
ATTN_HEADS = 4
ATTN_KV_HEADS = 2
DN_HEADS = 4
ATTN_Q_W = ATTN_HEADS * HEAD_DIM
ATTN_KV_W = ATTN_KV_HEADS * HEAD_DIM
DN_W = DN_HEADS * HEAD_DIM
MIX_WIDTH = ATTN_Q_W + DN_W
IN_SPLITS = (ATTN_Q_W, ATTN_KV_W, ATTN_KV_W, 3 * DN_W, DN_W, 2 * DN_HEADS, 2 * DN_HEADS)
IN_WIDTH = sum(IN_SPLITS)
ROPE_THETA = 10000.0
Q_BLOCK = 128
DN_CHUNK = 64
CONV_K = 5
PEER_HEADS = 8
PEER_QDIM = 256
PEER_HALF = PEER_QDIM // 2
N_KEYS = 128
N_EXPERTS = N_KEYS * N_KEYS
PEER_TOPK = 16
PEER_BLOCK = 128
EPS = 1e-6

kernel_name = 'hybrid_gqa_deltanet_peer_dit'


def rmsnorm(x, w):
    xf = x.astype(jnp.float32)
    y = xf * lax.rsqrt(jnp.mean(xf * xf, axis=-1, keepdims=True) + EPS)
    return (y * w.astype(jnp.float32)).astype(x.dtype)


def l2norm(x):
    return x * lax.rsqrt(jnp.sum(x * x, axis=-1, keepdims=True) + EPS)


def axial_rope_tables(n_tokens):
    rows = n_tokens // GRID_W
    row = jnp.repeat(jnp.arange(rows, dtype=jnp.float32), GRID_W)
    col = jnp.tile(jnp.arange(GRID_W, dtype=jnp.float32), rows)
    axis_dim = HEAD_DIM // 2
    inv_freq = ROPE_THETA ** (-jnp.arange(0, axis_dim, 2, dtype=jnp.float32) / axis_dim)
    ang_r = row[:, None] * inv_freq[None, :]
    ang_c = col[:, None] * inv_freq[None, :]
    ang = jnp.concatenate([ang_r, ang_r, ang_c, ang_c], axis=-1)
    return jnp.cos(ang), jnp.sin(ang)


def apply_axial_rope(x, cos, sin):
    B, T, H, Dh = x.shape
    xr = x.reshape(B, T, H, 2, 2, Dh // 4)
    rot = jnp.stack([-xr[..., 1, :], xr[..., 0, :]], axis=-2).reshape(B, T, H, Dh)
    return (x * cos[None, :, None, :] + rot * sin[None, :, None, :]).astype(x.dtype)


def split_in(p):
    offs = np.cumsum(IN_SPLITS)[:-1].tolist()
    return jnp.split(p, offs, axis=-1)


def attn_group(qa, ka, va, qn_w, kn_w, rope):
    B, T, _ = qa.shape
    q = rmsnorm(qa.reshape(B, T, ATTN_HEADS, HEAD_DIM), qn_w)
    k = rmsnorm(ka.reshape(B, T, ATTN_KV_HEADS, HEAD_DIM), kn_w)
    v = va.reshape(B, T, ATTN_KV_HEADS, HEAD_DIM)
    if rope is not None:
        q = apply_axial_rope(q, rope[0], rope[1])
        k = apply_axial_rope(k, rope[0], rope[1])
    return q, k, v


def latent_attention(q, k_lat, v_lat, k_ctx, v_ctx):
    B, T = q.shape[:2]
    G = ATTN_HEADS // ATTN_KV_HEADS
    scale = HEAD_DIM ** -0.5
    k_all = jnp.concatenate([k_lat, k_ctx], axis=1).transpose(0, 2, 1, 3)
    v_all = jnp.concatenate([v_lat, v_ctx], axis=1).transpose(0, 2, 1, 3)
    nb = T // Q_BLOCK
    qb = q.reshape(B, nb, Q_BLOCK, ATTN_KV_HEADS, G, HEAD_DIM).transpose(1, 0, 3, 4, 2, 5)

    def block(qi):
        s = jnp.einsum('bhgqd,bhkd->bhgqk', qi, k_all).astype(jnp.float32) * scale
        p = jax.nn.softmax(s, axis=-1).astype(v_all.dtype)
        return jnp.einsum('bhgqk,bhkd->bhgqd', p, v_all)

    o = lax.map(block, qb)
    return o.transpose(1, 0, 4, 2, 3, 5).reshape(B, T, ATTN_Q_W)


def context_attention(q, k, v):
    B, T = q.shape[:2]
    G = ATTN_HEADS // ATTN_KV_HEADS
    qg = q.reshape(B, T, ATTN_KV_HEADS, G, HEAD_DIM)
    s = jnp.einsum('bqhgd,bkhd->bhgqk', qg, k).astype(jnp.float32) * (HEAD_DIM ** -0.5)
    p = jax.nn.softmax(s, axis=-1).astype(v.dtype)
    o = jnp.einsum('bhgqk,bkhd->bqhgd', p, v)
    return o.reshape(B, T, ATTN_Q_W)


def centred_short_conv(x, w):
    pad = CONV_K // 2
    T = x.shape[1]
    xp = jnp.pad(x, ((0, 0), (pad, pad), (0, 0)))
    y = xp[:, 0:T] * w[0]
    for j in range(1, CONV_K):
        y = y + xp[:, j:j + T] * w[j]
    return jax.nn.silu(y)


def gated_delta_chunked(q, k, v, g, beta, S0):
    B, T, H, Dk = q.shape
    C = DN_CHUNK
    N = T // C
    qc, kc, vc = [t.reshape(B, N, C, H, -1).transpose(1, 0, 3, 2, 4) for t in (q, k, v)]
    gcum = jnp.cumsum(g.reshape(B, N, C, H).transpose(1, 0, 3, 2), axis=-1)
    bc = beta.reshape(B, N, C, H).transpose(1, 0, 3, 2)
    idx = jnp.arange(C)
    incl = idx[:, None] >= idx[None, :]
    strict = idx[:, None] > idx[None, :]
    decay = jnp.exp(jnp.where(incl, gcum[..., :, None] - gcum[..., None, :], -jnp.inf))
    kb = kc * bc[..., None]
    A = jnp.where(strict, jnp.einsum('nbhid,nbhjd->nbhij', kb, kc) * decay, 0.0)
    Tm = jnp.eye(C, dtype=jnp.float32) + A
    u = lax.linalg.triangular_solve(Tm, vc * bc[..., None], left_side=True, lower=True, unit_diagonal=True)
    w = lax.linalg.triangular_solve(Tm, kb * jnp.exp(gcum)[..., None], left_side=True, lower=True, unit_diagonal=True)
    qk = jnp.einsum('nbhid,nbhjd->nbhij', qc, kc) * decay

    def step(S, xs):
        q_i, k_i, u_i, w_i, g_i, qk_i = xs
        v_new = u_i - jnp.einsum('bhcd,bhde->bhce', w_i, S)
        o_i = (jnp.einsum('bhcd,bhde->bhce', q_i * jnp.exp(g_i)[..., None], S)
               + jnp.einsum('bhij,bhje->bhie', qk_i, v_new))
        g_last = g_i[..., -1:]
        S = (S * jnp.exp(g_last)[..., None]
             + jnp.einsum('bhcd,bhce->bhde', k_i * jnp.exp(g_last - g_i)[..., None], v_new))
        return S, o_i

    S_final, o = lax.scan(step, S0, (qc, kc, u, w, gcum, qk))
    o = o.transpose(1, 0, 3, 2, 4).reshape(B, T, H, v.shape[-1])
    return o, S_final


def dn_prepare(qkv, b_fb, a_fb, conv_w, A_log, dt_bias):
    B, T, _ = qkv.shape
    y = centred_short_conv(qkv, conv_w).astype(jnp.float32)
    q, k, v = jnp.split(y, 3, axis=-1)
    q = l2norm(q.reshape(B, T, DN_HEADS, HEAD_DIM)) * (HEAD_DIM ** -0.5)
    k = l2norm(k.reshape(B, T, DN_HEADS, HEAD_DIM))
    v = v.reshape(B, T, DN_HEADS, HEAD_DIM)
    a = a_fb.astype(jnp.float32).reshape(B, T, 2, DN_HEADS)
    g = -jnp.exp(A_log.astype(jnp.float32)) * jax.nn.softplus(a + dt_bias.astype(jnp.float32))
    beta = jax.nn.sigmoid(b_fb.astype(jnp.float32).reshape(B, T, 2, DN_HEADS))
    return q, k, v, g, beta


def dn_bidirectional(lat, ctx):
    q_l, k_l, v_l, g_l, b_l = lat
    q_c, k_c, v_c, g_c, b_c = ctx
    B = q_l.shape[0]
    S0 = jnp.zeros((B, DN_HEADS, HEAD_DIM, HEAD_DIM), jnp.float32)

    def flip(t):
        return jnp.flip(t, axis=1)

    o_cf, S_f = gated_delta_chunked(q_c, k_c, v_c, g_c[:, :, 0], b_c[:, :, 0], S0)
    o_lf, _ = gated_delta_chunked(q_l, k_l, v_l, g_l[:, :, 0], b_l[:, :, 0], S_f)
    o_cb, S_b = gated_delta_chunked(flip(q_c), flip(k_c), flip(v_c), flip(g_c[:, :, 1]), flip(b_c[:, :, 1]), S0)
    o_lb, _ = gated_delta_chunked(flip(q_l), flip(k_l), flip(v_l), flip(g_l[:, :, 1]), flip(b_l[:, :, 1]), S_b)
    return o_lf + flip(o_lb), o_cf + flip(o_cb)


def dn_output(o, gate, norm_w, dtype):
    B, T = o.shape[:2]
    y = rmsnorm(o, norm_w) * jax.nn.silu(gate.astype(jnp.float32).reshape(B, T, DN_HEADS, HEAD_DIM))
    return y.reshape(B, T, DN_W).astype(dtype)


def hybrid_mixer(h_lat, h_ctx, w_in, qn_w, kn_w, conv_w, A_log, dt_bias, dn_norm_w, w_out, rope, with_ctx):
    qa_l, ka_l, va_l, qkv_l, gate_l, b_l, a_l = split_in(h_lat @ w_in)
    qa_c, ka_c, va_c, qkv_c, gate_c, b_c, a_c = split_in(h_ctx @ w_in)
    q_l, k_l, v_l = attn_group(qa_l, ka_l, va_l, qn_w, kn_w, rope)
    q_c, k_c, v_c = attn_group(qa_c, ka_c, va_c, qn_w, kn_w, None)
    attn_lat = latent_attention(q_l, k_l, v_l, k_c, v_c)
    dn_lat, dn_ctx = dn_bidirectional(dn_prepare(qkv_l, b_l, a_l, conv_w, A_log, dt_bias),
                                      dn_prepare(qkv_c, b_c, a_c, conv_w, A_log, dt_bias))
    o_lat = jnp.concatenate([attn_lat, dn_output(dn_lat, gate_l, dn_norm_w, h_lat.dtype)], axis=-1) @ w_out
    if not with_ctx:
        return o_lat, None
    attn_ctx = context_attention(q_c, k_c, v_c)
    o_ctx = jnp.concatenate([attn_ctx, dn_output(dn_ctx, gate_c, dn_norm_w, h_ctx.dtype)], axis=-1) @ w_out
    return o_lat, o_ctx


def peer_ffn(h, wq, subkeys, u_tab, v_tab):
    B, T, D = h.shape
    tok = h.reshape(-1, PEER_BLOCK, D)

    def block(hb):
        q = (hb @ wq).reshape(PEER_BLOCK, PEER_HEADS, 2, PEER_HALF)
        s = jnp.einsum('thpd,hpkd->thpk', q, subkeys).astype(jnp.float32)
        sv, si = lax.top_k(s, PEER_TOPK)
        cand_s = (sv[..., 0, :, None] + sv[..., 1, None, :]).reshape(PEER_BLOCK, PEER_HEADS, PEER_TOPK * PEER_TOPK)
        cand_i = (si[..., 0, :, None] * N_KEYS + si[..., 1, None, :]).reshape(PEER_BLOCK, PEER_HEADS, PEER_TOPK * PEER_TOPK)
        top_s, pos = lax.top_k(cand_s, PEER_TOPK)
        expert = jnp.take_along_axis(cand_i, pos, axis=-1)
        gate = jax.nn.softmax(top_s, axis=-1)
        u = jnp.take(u_tab, expert, axis=0)
        act = jax.nn.gelu(jnp.einsum('thkd,td->thk', u, hb).astype(jnp.float32), approximate=False)
        vv = jnp.take(v_tab, expert, axis=0)
        return jnp.einsum('thk,thkd->td', (gate * act).astype(hb.dtype), vv)

    return lax.map(block, tok).reshape(B, T, D)


def setup_inputs(seed: int = 0) -> dict:
    key = jax.random.key(seed)
    ks = jax.random.split(key, 20)
    f32 = jnp.float32

    def nrm(k, shape, scale):
        return jax.random.normal(k, shape, f32) * scale

    dt = jnp.exp(jax.random.uniform(ks[13], (DEPTH, 2, DN_HEADS), f32, math.log(1e-3), math.log(1e-1)))
    return {
        'x': nrm(ks[0], (BATCH, SEQ, D_MODEL), 1.0),
        'c': nrm(ks[1], (BATCH, D_MODEL), 1.0),
        'ctx': nrm(ks[2], (BATCH, CTX_LEN, D_MODEL), 1.0),
        'c_ctx': nrm(ks[3], (D_MODEL,), 1.0),
        'ada_w': nrm(ks[4], (DEPTH, D_MODEL, 6 * D_MODEL), 0.5 * D_MODEL ** -0.5),
        'ada_b': nrm(ks[5], (DEPTH, 6 * D_MODEL), 0.02),
        'norm1_w': 1.0 + nrm(ks[6], (DEPTH, D_MODEL), 0.02),
        'norm2_w': 1.0 + nrm(ks[7], (DEPTH, D_MODEL), 0.02),
        'w_in': nrm(ks[8], (DEPTH, D_MODEL, IN_WIDTH), D_MODEL ** -0.5),
        'attn_qnorm_w': 1.0 + nrm(ks[9], (DEPTH, HEAD_DIM), 0.02),
        'attn_knorm_w': 1.0 + nrm(ks[10], (DEPTH, HEAD_DIM), 0.02),
        'dn_conv_w': nrm(ks[11], (DEPTH, CONV_K, 3 * DN_W), CONV_K ** -0.5),
        'dn_A_log': jnp.log(jax.random.uniform(ks[12], (DEPTH, 2, DN_HEADS), f32, 1.0, 16.0)),
        'dn_dt_bias': dt + jnp.log(-jnp.expm1(-dt)),
        'dn_norm_w': 1.0 + nrm(ks[14], (DEPTH, HEAD_DIM), 0.02),
        'w_out': nrm(ks[15], (DEPTH, MIX_WIDTH, D_MODEL), MIX_WIDTH ** -0.5),
        'peer_wq': nrm(ks[16], (DEPTH, D_MODEL, PEER_HEADS * PEER_QDIM), D_MODEL ** -0.5),
        'peer_subkeys': nrm(ks[17], (DEPTH, PEER_HEADS, 2, N_KEYS, PEER_HALF), PEER_HALF ** -0.5),
        'peer_u': nrm(ks[18], (DEPTH, N_EXPERTS, D_MODEL), D_MODEL ** -0.5),
        'peer_v': nrm(ks[19], (DEPTH, N_EXPERTS, D_MODEL), PEER_HEADS ** -0.5),
    }


def reference(x, c, ctx, c_ctx, ada_w, ada_b, norm1_w, norm2_w, w_in, attn_qnorm_w, attn_knorm_w,
              dn_conv_w, dn_A_log, dn_dt_bias, dn_norm_w, w_out, peer_wq, peer_subkeys, peer_u, peer_v):
    T = x.shape[1]
    rope = axial_rope_tables(T)
    for l in range(DEPTH):
        with_ctx = l < DEPTH - 1
        mod_lat = (jax.nn.silu(c) @ ada_w[l] + ada_b[l])[:, None, :]
        mod_ctx = (jax.nn.silu(c_ctx) @ ada_w[l] + ada_b[l])[None, None, :]
        sh1, sc1, g1, sh2, sc2, g2 = jnp.split(mod_lat, 6, axis=-1)
        csh1, csc1, cg1, csh2, csc2, cg2 = jnp.split(mod_ctx, 6, axis=-1)
        h_lat = rmsnorm(x, norm1_w[l]) * (1.0 + sc1) + sh1
        h_ctx = rmsnorm(ctx, norm1_w[l]) * (1.0 + csc1) + csh1
        o_lat, o_ctx = hybrid_mixer(h_lat, h_ctx, w_in[l], attn_qnorm_w[l], attn_knorm_w[l], dn_conv_w[l],
                                    dn_A_log[l], dn_dt_bias[l], dn_norm_w[l], w_out[l], rope, with_ctx)
        x = x + g1 * o_lat
        h2 = rmsnorm(x, norm2_w[l]) * (1.0 + sc2) + sh2
        x = x + g2 * peer_ffn(h2, peer_wq[l], peer_subkeys[l], peer_u[l], peer_v[l])
        if with_ctx:
            ctx = ctx + cg1 * o_ctx
            hc2 = rmsnorm(ctx, norm2_w[l]) * (1.0 + csc2) + csh2
            ctx = ctx + cg2 * peer_ffn(hc2, peer_wq[l], peer_subkeys[l], peer_u[l], peer_v[l])
    return x
```

```cpp
#include <hip/hip_runtime.h>
#include <cstdio>
#include <cstdint>

#define GAS __attribute__((address_space(1)))
#define LAS __attribute__((address_space(3)))
typedef unsigned short bf16_t;
typedef short bf16x8 __attribute__((ext_vector_type(8)));
typedef short s16x4 __attribute__((ext_vector_type(4)));
typedef float f32x4 __attribute__((ext_vector_type(4)));
typedef float f32x2 __attribute__((ext_vector_type(2)));
typedef float f32x16 __attribute__((ext_vector_type(16)));
typedef unsigned u32x4 __attribute__((ext_vector_type(4)));
typedef unsigned u32x2 __attribute__((ext_vector_type(2)));

constexpr int D = 1024, NB = 2, T = 16384, DEPTH = 4, CT = 256;
constexpr int ML = NB * T, MC = NB * CT, M = ML + MC;
constexpr int NIN = 3088, NP = 3072;
constexpr int KVLEN = T + CT;
constexpr int NEXP = 16384;
constexpr float EPS = 1e-6f;
constexpr int NPH_L = 11;
constexpr int NPHASE = 1 + DEPTH * NPH_L;

constexpr size_t MiB = 1u << 20;
constexpr size_t WS_CTL = 0, CTL_BYTES = 1 * MiB;
constexpr size_t WS_MOD = 1 * MiB;
constexpr size_t WS_ROPE = 2 * MiB;
constexpr size_t WS_WSK = 3 * MiB;
constexpr size_t WS_CTXX = 4 * MiB;
constexpr size_t WS_WINT = 8 * MiB;
constexpr size_t WS_WOUTT = 32 * MiB;
constexpr size_t WS_WQT = 40 * MiB;
constexpr size_t WS_SKB = 56 * MiB;
constexpr size_t WS_USC = 58 * MiB;
constexpr size_t WS_UB = 64 * MiB;
constexpr size_t WS_VB = 80 * MiB;
constexpr size_t TAB_SET = 32 * MiB;
constexpr size_t WS_H = 128 * MiB;
constexpr size_t WS_P = 193 * MiB;
constexpr size_t WS_QA = 388 * MiB;
constexpr size_t WS_KA = 421 * MiB;
constexpr size_t WS_VA = 438 * MiB;
constexpr size_t WS_CAT = 455 * MiB;
constexpr size_t WS_DQ = 520 * MiB;
constexpr size_t WS_DK = 553 * MiB;
constexpr size_t WS_DV = 586 * MiB;
constexpr size_t WS_OF = 619 * MiB;
constexpr size_t WS_OB = 684 * MiB;
constexpr size_t WS_GB = 749 * MiB;
constexpr size_t WS_BA = 752 * MiB;
constexpr size_t WS_PIDX = 755 * MiB;
constexpr size_t WS_PGATE = 772 * MiB;
constexpr size_t WS_REC = 789 * MiB;
constexpr size_t WS_END = 990 * MiB;
constexpr int NCH = 260;
constexpr int REC_K = 0, REC_KT = 16384, REC_Q = 32768, REC_V = 49152, REC_DIR = 65536, REC_DIRSZ = 17408, REC_BYTES = REC_DIR + 2 * REC_DIRSZ;
static_assert((size_t)NB * 4 * NCH * REC_BYTES + WS_REC <= WS_END, "rec region");

constexpr int LDS_BYTES = 163840;
constexpr int LDS_MISC = 163840 - 256;

__device__ __forceinline__ float bf2f(unsigned b) { return __uint_as_float(b << 16); }
__device__ __forceinline__ float bflo(unsigned w) { return __uint_as_float(w << 16); }
__device__ __forceinline__ float bfhi(unsigned w) { return __uint_as_float(w & 0xffff0000u); }
typedef __bf16 bf2v __attribute__((ext_vector_type(2)));
__device__ __forceinline__ unsigned pkbf(float lo, float hi) { unsigned r; asm("v_cvt_pk_bf16_f32 %0, %1, %2" : "=v"(r) : "v"(lo), "v"(hi)); return r; }
__device__ __forceinline__ unsigned pkbf_c(float lo, float hi) { f32x2 v = {lo, hi}; bf2v r = __builtin_convertvector(v, bf2v); return __builtin_bit_cast(unsigned, r); }
template <int K> __device__ __forceinline__ float lane_xor(float v) {
    const int b = __builtin_bit_cast(int, v);
    if constexpr (K == 1) return __builtin_bit_cast(float, __builtin_amdgcn_update_dpp(0, b, 0xB1, 0xF, 0xF, true));
    else if constexpr (K == 2) return __builtin_bit_cast(float, __builtin_amdgcn_update_dpp(0, b, 0x4E, 0xF, 0xF, true));
    else if constexpr (K == 32) { auto rr = __builtin_amdgcn_permlane32_swap((unsigned)b, (unsigned)b, false, false); unsigned ln_ = __builtin_amdgcn_mbcnt_hi(~0u, __builtin_amdgcn_mbcnt_lo(~0u, 0u)); asm volatile("" : "+v"(ln_));
        return __uint_as_float((ln_ & 32u) ? rr[0] : rr[1]); }
    else return __builtin_bit_cast(float, __builtin_amdgcn_ds_swizzle(b, 0x1F | (K << 10)));
}
__device__ __forceinline__ float wave_sum(float v) {
    v += lane_xor<1>(v); v += lane_xor<2>(v);
    v += __builtin_bit_cast(float, __builtin_amdgcn_update_dpp(0, __builtin_bit_cast(int, v), 0x124, 0xF, 0xF, true));
    v += __builtin_bit_cast(float, __builtin_amdgcn_update_dpp(0, __builtin_bit_cast(int, v), 0x128, 0xF, 0xF, true));
    v += lane_xor<16>(v);
    { auto rr = __builtin_amdgcn_permlane32_swap(__float_as_uint(v), __float_as_uint(v), false, false); v = __uint_as_float(rr[0]) + __uint_as_float(rr[1]); }
    return v;
}
__device__ __forceinline__ float wave_max(float v) {
    v = fmaxf(v, lane_xor<1>(v)); v = fmaxf(v, lane_xor<2>(v));
    v = fmaxf(v, __builtin_bit_cast(float, __builtin_amdgcn_update_dpp(0, __builtin_bit_cast(int, v), 0x124, 0xF, 0xF, true)));
    v = fmaxf(v, __builtin_bit_cast(float, __builtin_amdgcn_update_dpp(0, __builtin_bit_cast(int, v), 0x128, 0xF, 0xF, true)));
    v = fmaxf(v, lane_xor<16>(v));
    { auto rr = __builtin_amdgcn_permlane32_swap(__float_as_uint(v), __float_as_uint(v), false, false); v = fmaxf(__uint_as_float(rr[0]), __uint_as_float(rr[1])); }
    return v;
}
__device__ __forceinline__ float silu_f(float x) { return x / (1.f + __expf(-x)); }
#define LDS_WAIT() asm volatile("s_waitcnt lgkmcnt(0)" ::: "memory")

#define XB_TMO      128
#define XB_XCNT(j)  (256  + 64 * (j))
#define XB_XSUB(j)  (1280 + 64 * (j))
#define XB_XGEN(j)  (2304 + 64 * (j))
#define XB_TOP      3328
#define XB_TOPGEN   3392
#define XCD_BAR_WORDS 3456
#define XB_SPIN_CAP (1u << 22)
__device__ __forceinline__ unsigned xb_ld(unsigned* p)              { return __hip_atomic_load(p, __ATOMIC_RELAXED, __HIP_MEMORY_SCOPE_AGENT); }
__device__ __forceinline__ unsigned xb_add(unsigned* p, unsigned v) { return __hip_atomic_fetch_add(p, v, __ATOMIC_RELAXED, __HIP_MEMORY_SCOPE_AGENT); }
__device__ __forceinline__ unsigned xb_xcc_id() { return (unsigned)__builtin_amdgcn_s_getreg((3 << 11) | 20) & 0xFu; }
#define XB_SPIN(cond, bar) do { unsigned _sp = 0; while (cond) { __builtin_amdgcn_s_sleep(1); \
    if ((++_sp & 255u) == 0u) { if (xb_ld(&(bar)[XB_TMO])) break; if (_sp > XB_SPIN_CAP) { atomicAdd(&(bar)[XB_TMO], 1u); break; } } } } while (0)
struct XcdBarrier { unsigned* bar; unsigned x; volatile LAS unsigned* st; };
__device__ __forceinline__ XcdBarrier xcd_barrier_post(unsigned* bar, volatile LAS unsigned* st) {
    XcdBarrier b; b.bar = bar; b.x = xb_xcc_id(); b.st = st;
    if (threadIdx.x == 0) (void)xb_add(&bar[XB_XCNT(b.x)], 1u);
    return b;
}
__device__ __forceinline__ void xcd_barrier_complete(unsigned* bar, unsigned x, unsigned& nloc, unsigned& nx) {
    const unsigned G = gridDim.x * gridDim.y * gridDim.z;
    unsigned sum, cnt, mine, sp = 0u;
    for (;;) {
        sum = 0u; cnt = 0u; mine = 0u;
#pragma unroll
        for (unsigned j = 0; j < 16; ++j) { const unsigned c = xb_ld(&bar[XB_XCNT(j)]); sum += c; cnt += (c > 0u) ? 1u : 0u; mine = (j == x) ? c : mine; }
        if (sum == G) break;
        __builtin_amdgcn_s_sleep(1);
        if ((++sp & 255u) == 0u) { if (xb_ld(&bar[XB_TMO])) break; if (sp > XB_SPIN_CAP) { atomicAdd(&bar[XB_TMO], 1u); break; } }
    }
    nloc = mine > 0u ? mine : 1u; nx = cnt > 0u ? cnt : 1u;
}
__device__ __forceinline__ void xcd_barrier(const XcdBarrier& b) {
    asm volatile("s_waitcnt vmcnt(0)" ::: "memory");
    __syncthreads();
    if (threadIdx.x == 0) {
        unsigned* bar = b.bar; unsigned bx_ = b.x;
        asm volatile("" : "+s"(bar), "+s"(bx_));
        __builtin_amdgcn_s_waitcnt(0);
        unsigned nloc = b.st[0], nx = b.st[1];
        if (nloc == 0u) { xcd_barrier_complete(bar, bx_, nloc, nx); b.st[0] = nloc; b.st[1] = nx; }
        const unsigned old = xb_add(&bar[XB_XSUB(bx_)], 1u);
        const unsigned gen = old / nloc;
        if (old + 1u == (gen + 1u) * nloc) {
            __builtin_amdgcn_fence(__ATOMIC_RELEASE, "agent");
            asm volatile("s_waitcnt vmcnt(0)" ::: "memory");
            const unsigned og = xb_add(&bar[XB_TOP], 1u);
            const unsigned tg = og / nx;
            if (og + 1u == (tg + 1u) * nx) xb_add(&bar[XB_TOPGEN], 1u);
            else XB_SPIN(xb_ld(&bar[XB_TOPGEN]) == tg, bar);
            __builtin_amdgcn_fence(__ATOMIC_ACQUIRE, "agent");
            xb_add(&bar[XB_XGEN(bx_)], 1u);
            asm volatile("s_waitcnt vmcnt(0)" ::: "memory");
        } else {
            XB_SPIN(xb_ld(&bar[XB_XGEN(bx_)]) == gen, bar);
            __builtin_amdgcn_fence(__ATOMIC_ACQUIRE, "agent");
            asm volatile("s_waitcnt vmcnt(0)" ::: "memory");
        }
    }
    __syncthreads();
}

namespace pg8 {
constexpr int BM = 256, BK = 64, HALF = 128, HTB = HALF * BK * 2, STAGE_BYTES = 8 * HTB, NXCD = 8, WGM = 8;
__host__ __device__ __forceinline__ int lds_byte(int r, int c) { const int st = (r >> 4) * 2 + (c >> 5), rr = r & 15, cc = c & 31, ob = rr * 64 + cc * 2; return st * 1024 + (ob ^ (((ob >> 9) & 1) << 5)); }
__host__ __device__ __forceinline__ void stage_rc(int b, int& R, int& C) { const int st = b / 1024, sb = b % 1024, swz = sb ^ (((sb >> 9) & 1) << 5); R = (st >> 1) * 16 + swz / 64; C = (st & 1) * 32 + (swz % 64) / 2; }
__host__ __device__ __forceinline__ int perm32(int rho) { const int n = rho >> 4, i = rho & 15; return 8 * (i >> 2) + 4 * n + (i & 3); }
struct Unit { int pm, pn; };
struct Gemm { const bf16_t* A; const bf16_t* Bt; int M, N, K; };
struct StaticOrder {
    int nM, nN, nwg, G, c;
    __host__ __device__ void init(int M_, int N_, int G_, int c_) { nM = M_ / BM; nN = N_ / BM; nwg = nM * nN; G = G_; c = c_; }
    __host__ __device__ bool next(int i, Unit& u) const {
        const long L = (long)i * G + c; if (L >= nwg) return false;
        int wgid = (int)L; { const int q = nwg / NXCD, r = nwg % NXCD, xcd = wgid % NXCD, off = wgid / NXCD; wgid = (xcd < r ? xcd * (q + 1) : r * (q + 1) + (xcd - r) * q) + off; }
        const int nig = WGM * nN, gid = wgid / nig, fm = gid * WGM, gsz = (nM - fm) < WGM ? (nM - fm) : WGM;
        u.pm = fm + ((wgid % nig) % gsz); u.pn = (wgid % nig) / gsz; return true;
    }
    __device__ __forceinline__ void a_ready(const Unit&) const {}
    __device__ __forceinline__ void done(const Unit&) const {}
};
struct EpiBf16 {
    static constexpr bool PERM = true;
    bf16_t* O; int ldc;
    __device__ __forceinline__ void operator()(const f32x4 (&acc)[2][2][4][2], const Unit& u, int wr, int wc, int fr, int fq) const {
        const int row0 = u.pm * BM + wr * 64 + fr; const int col0 = u.pn * BM + wc * 32 + 8 * fq;
#pragma unroll
        for (int ai = 0; ai < 2; ++ai)
#pragma unroll
            for (int m = 0; m < 4; ++m) { bf16_t* rowp = O + (size_t)(row0 + ai * HALF + m * 16) * ldc + col0;
#pragma unroll
                for (int bj = 0; bj < 2; ++bj) { const f32x4 v0 = acc[ai][bj][m][0], v1 = acc[ai][bj][m][1];
                    u32x4 w; w.x = pkbf_c(v0[0], v0[1]); w.y = pkbf_c(v0[2], v0[3]); w.z = pkbf_c(v1[0], v1[1]); w.w = pkbf_c(v1[2], v1[3]);
                    *(u32x4*)(rowp + bj * HALF) = w; } }
    }
};
struct EpiRes {
    static constexpr bool PERM = false;
    const float* src_lat; const float* src_ctx; float* dst_lat; float* dst_ctx; const float* gate;
    __device__ __forceinline__ void operator()(const f32x4 (&acc)[2][2][4][2], const Unit& u, int wr, int wc, int fr, int fq) const {
        const bool isctx = u.pm >= (ML / BM);
        const float* src = isctx ? src_ctx + (size_t)(u.pm - ML / BM) * BM * D : src_lat + (size_t)u.pm * BM * D;
        float* dst = isctx ? dst_ctx + (size_t)(u.pm - ML / BM) * BM * D : dst_lat + (size_t)u.pm * BM * D;
        const int mrow = isctx ? 2 : (u.pm >= (T / BM) ? 1 : 0);
        const int row0 = wr * 64 + fr, col0 = u.pn * BM + wc * 32 + 4 * fq;
        f32x4 gv[2][2];
#pragma unroll
        for (int bj = 0; bj < 2; ++bj)
#pragma unroll
            for (int n = 0; n < 2; ++n) gv[bj][n] = *(const f32x4*)(gate + mrow * 6144 + col0 + bj * HALF + n * 16);
#pragma unroll
        for (int ai = 0; ai < 2; ++ai)
#pragma unroll
            for (int m = 0; m < 4; ++m) { const size_t off = (size_t)(row0 + ai * HALF + m * 16) * D + col0;
#pragma unroll
                for (int bj = 0; bj < 2; ++bj)
#pragma unroll
                    for (int n = 0; n < 2; ++n) { const f32x4 s = *(const f32x4*)(src + off + bj * HALF + n * 16);
                        *(f32x4*)(dst + off + bj * HALF + n * 16) = s + gv[bj][n] * acc[ai][bj][m][n]; } }
    }
};

template <class Epi, class Sched>
__device__ __forceinline__ void gemm_phase(LAS unsigned char* lds, const Gemm g, const Sched& S, const Epi& E) {
    int tid = threadIdx.x; asm volatile("" : "+v"(tid)); const int wid = __builtin_amdgcn_readfirstlane(tid >> 6), lane = tid & 63, wr = wid >> 2, wc = wid & 3, fr = lane & 15, fq = lane >> 4;
    const int K = g.K, nt = K / BK;
    unsigned voffA[2], voffB[2];
#pragma unroll
    for (int i = 0; i < 2; ++i) { int R, C; stage_rc(tid * 16 + i * 8192, R, C); const int Rb = Epi::PERM ? ((R & ~31) + perm32(R & 31)) : R;
        voffA[i] = (unsigned)(R * K + C) * 2u; voffB[i] = (unsigned)(Rb * K + C) * 2u; }
    const size_t kstep = (size_t)(BK * 2);
    const size_t hstep = (size_t)HALF * K * 2;
    const size_t tstep = 2 * hstep;
    const unsigned ldsw = (unsigned)wid * 1024u;
    const int aoff = lds_byte(wr * 64 + fr, fq * 8), boff = lds_byte(wc * 32 + fr, fq * 8);
#define PG8_SA(b, h) (((b) * 2 + (h)) * HTB)
#define PG8_SB(b, h) ((4 + (b) * 2 + (h)) * HTB)
#define PG8_STAGE(bufoff, gbase, voff) do { _Pragma("unroll") for (int _i = 0; _i < 2; ++_i) \
        __builtin_amdgcn_global_load_lds((const unsigned*)((const char*)(gbase) + (voff)[_i]), (LAS unsigned*)(lds + (bufoff) + ldsw + _i * 8192), 16, 0, 0); } while (0)
#define PG8_LDA(dst, b, h) do { _Pragma("unroll") for (int m = 0; m < 4; ++m) _Pragma("unroll") for (int k = 0; k < 2; ++k) dst[m][k] = *(const LAS bf16x8*)(lds + PG8_SA(b, h) + aoff + m * 2048 + k * 1024); } while (0)
#define PG8_LDB(dst, b, h) do { _Pragma("unroll") for (int n = 0; n < 2; ++n) _Pragma("unroll") for (int k = 0; k < 2; ++k) dst[n][k] = *(const LAS bf16x8*)(lds + PG8_SB(b, h) + boff + n * 2048 + k * 1024); } while (0)
#define PG8_MMA(ai, bj, At, Bt) do { __builtin_amdgcn_s_setprio(1); _Pragma("unroll") for (int m = 0; m < 4; ++m) _Pragma("unroll") for (int n = 0; n < 2; ++n) _Pragma("unroll") for (int k = 0; k < 2; ++k) \
        acc[ai][bj][m][n] = __builtin_amdgcn_mfma_f32_16x16x32_bf16(Bt[n][k], At[m][k], acc[ai][bj][m][n], 0, 0, 0); __builtin_amdgcn_s_setprio(0); } while (0)
#define PG8_WAIT_V(n) asm volatile("s_waitcnt vmcnt(" #n ")" ::: "memory")
#define PG8_WAIT_L(n) asm volatile("s_waitcnt lgkmcnt(" #n ")" ::: "memory")
#define PG8_BAR __builtin_amdgcn_s_barrier()
#define PG8_SCHED __builtin_amdgcn_sched_barrier(0)
    Unit cur, nxt; int ui = 0;
    if (!S.next(0, cur)) return;
    f32x4 acc[2][2][4][2];
#pragma unroll
    for (int a = 0; a < 2; ++a)
#pragma unroll
        for (int b = 0; b < 2; ++b)
#pragma unroll
            for (int m = 0; m < 4; ++m)
#pragma unroll
                for (int n = 0; n < 2; ++n) acc[a][b][m][n] = (f32x4){0.f, 0.f, 0.f, 0.f};
    bf16x8 At[4][2], B0[2][2], B1[2][2];
    const char* cA = (const char*)g.A + (size_t)cur.pm * tstep; const char* cB = (const char*)g.Bt + (size_t)cur.pn * tstep;
    S.a_ready(cur);
    PG8_STAGE(PG8_SB(0, 0), cB, voffB); PG8_STAGE(PG8_SA(0, 0), cA, voffA); PG8_STAGE(PG8_SB(0, 1), cB + hstep, voffB); PG8_STAGE(PG8_SA(0, 1), cA + hstep, voffA);
    if (wr == 1) PG8_BAR;
    PG8_WAIT_V(4); PG8_BAR;
    PG8_STAGE(PG8_SB(1, 0), cB + kstep, voffB); PG8_STAGE(PG8_SA(1, 0), cA + kstep, voffA); PG8_STAGE(PG8_SB(1, 1), cB + hstep + kstep, voffB);
    PG8_WAIT_V(6); PG8_BAR;
    for (;;) {
        const bool has_next = S.next(ui + 1, nxt);
        const char* nA = has_next ? (const char*)g.A + (size_t)nxt.pm * tstep : cA; const char* nB = has_next ? (const char*)g.Bt + (size_t)nxt.pn * tstep : cB;
        for (int t = 0; t < nt; t += 2) {
            const bool last = (t == nt - 2);
            const char* a1 = cA + (size_t)(t + 1) * kstep;
            const char* a2 = last ? nA : cA + (size_t)(t + 2) * kstep; const char* b2 = last ? nB : cB + (size_t)(t + 2) * kstep;
            const char* a3 = a2 + kstep; const char* b3 = b2 + kstep;
            if (last && has_next) S.a_ready(nxt);
            PG8_LDB(B0, 0, 0); PG8_SCHED; PG8_LDA(At, 0, 0); PG8_STAGE(PG8_SA(1, 1), a1 + hstep, voffA);
            PG8_WAIT_L(8); PG8_BAR; PG8_WAIT_L(0); PG8_MMA(0, 0, At, B0); PG8_BAR; PG8_SCHED;
            PG8_LDB(B1, 0, 1); PG8_STAGE(PG8_SB(0, 0), b2, voffB);
            PG8_BAR; PG8_WAIT_L(0); PG8_MMA(0, 1, At, B1); PG8_BAR;
            PG8_LDA(At, 0, 1); PG8_STAGE(PG8_SA(0, 0), a2, voffA);
            PG8_BAR; PG8_WAIT_L(0); PG8_MMA(1, 0, At, B0); PG8_BAR; PG8_SCHED;
            PG8_STAGE(PG8_SB(0, 1), b2 + hstep, voffB);
            PG8_WAIT_V(6); PG8_BAR; PG8_MMA(1, 1, At, B1); PG8_BAR;
            PG8_LDB(B0, 1, 0); PG8_SCHED; PG8_LDA(At, 1, 0); PG8_STAGE(PG8_SA(0, 1), a2 + hstep, voffA);
            PG8_WAIT_L(8); PG8_BAR; PG8_WAIT_L(0); PG8_MMA(0, 0, At, B0); PG8_BAR; PG8_SCHED;
            PG8_LDB(B1, 1, 1); PG8_STAGE(PG8_SB(1, 0), b3, voffB);
            PG8_BAR; PG8_WAIT_L(0); PG8_MMA(0, 1, At, B1); PG8_BAR;
            PG8_LDA(At, 1, 1); PG8_STAGE(PG8_SA(1, 0), a3, voffA);
            PG8_BAR; PG8_WAIT_L(0); PG8_MMA(1, 0, At, B0); PG8_BAR; PG8_SCHED;
            PG8_STAGE(PG8_SB(1, 1), b3 + hstep, voffB);
            PG8_WAIT_V(6); PG8_BAR; PG8_MMA(1, 1, At, B1); PG8_BAR;
        }
        E(acc, cur, wr, wc, fr, fq); S.done(cur);
        if (!has_next) break;
#pragma unroll
        for (int a = 0; a < 2; ++a)
#pragma unroll
            for (int b = 0; b < 2; ++b)
#pragma unroll
                for (int m = 0; m < 4; ++m)
#pragma unroll
                    for (int n = 0; n < 2; ++n) acc[a][b][m][n] = (f32x4){0.f, 0.f, 0.f, 0.f};
        cur = nxt; cA = nA; cB = nB; ++ui;
    }
    PG8_WAIT_V(0);
    if (wr == 0) PG8_BAR;
    PG8_BAR;
#undef PG8_SA
#undef PG8_SB
#undef PG8_STAGE
#undef PG8_LDA
#undef PG8_LDB
#undef PG8_MMA
#undef PG8_WAIT_V
#undef PG8_WAIT_L
#undef PG8_BAR
#undef PG8_SCHED
}
}

namespace att {
constexpr int HD = 128, NW = 8, QBLK = 32, KVBLK = 64;
constexpr float SCALE = 0.088388347648318440f;
constexpr float THR = 8.f;
constexpr int LDQ = 512, LDK = 256;
constexpr size_t SHM_V = KVBLK * HD * 2, SHM_K = KVBLK * HD * 2, SHM_ATTN = 2 * SHM_V + 2 * SHM_K + NW * 64 * 4;
#define KSWZ(row, colB) ((row) * 256 + ((colB) ^ (((row) & 7) << 4)))
#define SBAR() __builtin_amdgcn_sched_barrier(0)
__device__ __forceinline__ int crow(int r, int hi) { return (r & 3) + 8 * (r >> 2) + 4 * hi; }
__device__ __forceinline__ unsigned cvtpk(float lo, float hi) { unsigned r; asm volatile("v_cvt_pk_bf16_f32 %0, %1, %2" : "=v"(r) : "v"(lo), "v"(hi)); return r; }
__device__ __forceinline__ void partialSM(f32x16& p0, f32x16& p1, float mnC, bool shift) {
  if (__builtin_expect(shift, 0)) { for (int r = 0; r < 16; ++r) p0[r] += mnC; for (int r = 0; r < 16; ++r) p1[r] += mnC; }
  for (int r = 0; r < 16; ++r) p0[r] = __builtin_amdgcn_exp2f(p0[r]);
}
__device__ __forceinline__ void finishSM(f32x16& p0, f32x16& p1, float& l_reg, bf16x8& pa0, bf16x8& pa1, bf16x8& pa2, bf16x8& pa3) {
  for (int r = 0; r < 16; ++r) p1[r] = __builtin_amdgcn_exp2f(p1[r]);
  float ps = 0; for (int r = 0; r < 16; ++r) ps += p0[r]; for (int r = 0; r < 16; ++r) ps += p1[r];
  { auto rr = __builtin_amdgcn_permlane32_swap(__float_as_uint(ps), __float_as_uint(ps), false, false);
    ps = __uint_as_float(rr[0]) + __uint_as_float(rr[1]); }
  l_reg += ps;
#define PK4(P, BASE, OUT) do { unsigned a0 = cvtpk(P[BASE + 0], P[BASE + 1]), a1 = cvtpk(P[BASE + 2], P[BASE + 3]);   \
    unsigned b0 = cvtpk(P[BASE + 4], P[BASE + 5]), b1 = cvtpk(P[BASE + 6], P[BASE + 7]);                              \
    auto r0 = __builtin_amdgcn_permlane32_swap(a0, b0, false, false); auto r1 = __builtin_amdgcn_permlane32_swap(a1, b1, false, false); \
    u32x4 w = {r0[0], r1[0], r0[1], r1[1]}; OUT = *reinterpret_cast<bf16x8*>(&w); } while (0)
  PK4(p0, 0, pa0); PK4(p0, 8, pa1); PK4(p1, 0, pa2); PK4(p1, 8, pa3);
#undef PK4
}
__device__ __forceinline__ void qkt(f32x16& p0, f32x16& p1, const bf16_t* Ks, const bf16x8* qr, int r32, int hi) {
  p0 = f32x16{}; p1 = f32x16{};
  for (int d0 = 0; d0 < 8; ++d0) { int cb = (d0 * 16 + hi * 8) * 2;
    bf16x8 b0 = *reinterpret_cast<const bf16x8*>((const char*)Ks + KSWZ(r32, cb));
    bf16x8 b1 = *reinterpret_cast<const bf16x8*>((const char*)Ks + KSWZ(32 + r32, cb));
    p0 = __builtin_amdgcn_mfma_f32_32x32x16_bf16(b0, qr[d0], p0, 0, 0, 0);
    p1 = __builtin_amdgcn_mfma_f32_32x32x16_bf16(b1, qr[d0], p1, 0, 0, 0); }
}
__device__ __forceinline__ int v_st(int k, int c) { const int kk = (k & ~0xC) | ((k & 4) << 1) | ((k & 8) >> 1); return ((kk >> 3) * 4 + (c >> 5)) * 512 + ((kk & 7) * 32 + (c & 31)) * 2; }
__device__ __forceinline__ int v_rd_base(int lane) { return ((lane & 3) << 3) | (((lane >> 2) & 3) << 6) | (((lane >> 4) & 1) << 5) | (((lane >> 5) & 1) << 8); }
constexpr int v_rd_off(int d0, int ks, int half) { return d0 * 512 + ks * 4096 + half * 2048; }
template <int OFF> __device__ __forceinline__ s16x4 tr_read(int vb) {
  s16x4 r; asm volatile("ds_read_b64_tr_b16 %0, %1 offset:%2" : "=&v"(r) : "v"(vb), "i"(OFF) : "memory"); return r;
}
template <int D0> __device__ __forceinline__ void pv_one(f32x16& od, int vb, bf16x8 pa0, bf16x8 pa1, bf16x8 pa2, bf16x8 pa3) {
  const s16x4 l0 = tr_read<v_rd_off(D0, 0, 0)>(vb), h0 = tr_read<v_rd_off(D0, 0, 1)>(vb), l1 = tr_read<v_rd_off(D0, 1, 0)>(vb), h1 = tr_read<v_rd_off(D0, 1, 1)>(vb);
  const s16x4 l2 = tr_read<v_rd_off(D0, 2, 0)>(vb), h2 = tr_read<v_rd_off(D0, 2, 1)>(vb), l3 = tr_read<v_rd_off(D0, 3, 0)>(vb), h3 = tr_read<v_rd_off(D0, 3, 1)>(vb);
  asm volatile("s_waitcnt lgkmcnt(0)" ::: "memory"); SBAR();
#define PK(L, H) (bf16x8){L[0], L[1], L[2], L[3], H[0], H[1], H[2], H[3]}
  od = __builtin_amdgcn_mfma_f32_32x32x16_bf16(pa0, PK(l0, h0), od, 0, 0, 0);
  od = __builtin_amdgcn_mfma_f32_32x32x16_bf16(pa1, PK(l1, h1), od, 0, 0, 0);
  od = __builtin_amdgcn_mfma_f32_32x32x16_bf16(pa2, PK(l2, h2), od, 0, 0, 0);
  od = __builtin_amdgcn_mfma_f32_32x32x16_bf16(pa3, PK(l3, h3), od, 0, 0, 0);
#undef PK
}
__device__ __forceinline__ void pv_d0(f32x16* o, int vb, bf16x8 pa0, bf16x8 pa1, bf16x8 pa2, bf16x8 pa3) {
  pv_one<0>(o[0], vb, pa0, pa1, pa2, pa3); pv_one<1>(o[1], vb, pa0, pa1, pa2, pa3); pv_one<2>(o[2], vb, pa0, pa1, pa2, pa3); pv_one<3>(o[3], vb, pa0, pa1, pa2, pa3);
}
__device__ __forceinline__ void attn_dense_body(const bf16_t* __restrict__ Qb, const bf16_t* __restrict__ Kh, const bf16_t* __restrict__ Vh,
                                                bf16_t* __restrict__ Ob, int LDO, int seq, char* lds, float* __restrict__ lse, float braw) {
  int tid = threadIdx.x; asm volatile("" : "+v"(tid)); const int wid = tid >> 6, lane = tid & 63, r32 = lane & 31, hi = lane >> 5;
  bf16_t* V_lds = (bf16_t*)lds; bf16_t* K_lds = (bf16_t*)(lds + 2 * SHM_V);
  float* ws = (float*)(lds + 2 * SHM_V + 2 * SHM_K) + wid * 64; float* li_l = ws; float* al_l = ws + 32;
  float l_reg = 0; f32x16 o[4] = {}; bf16x8 qr[8];
  bool shift = braw * (SCALE * 1.4426950408889634f) > 64.f; { int sh_ = __builtin_amdgcn_readfirstlane((int)shift); asm volatile("" : "+s"(sh_)); shift = sh_ != 0; }
  const float mnC = __builtin_bit_cast(float, __builtin_amdgcn_readfirstlane(__builtin_bit_cast(int, shift ? -braw * (SCALE * 1.4426950408889634f) : 0.f)));
  const bf16_t* Qw = Qb + (long)(wid * QBLK + r32) * LDQ + hi * 8;
#pragma unroll
  for (int d0 = 0; d0 < 8; ++d0) qr[d0] = *reinterpret_cast<const bf16x8*>(Qw + d0 * 16);
  const int sr = tid >> 4, sc = (tid & 15) * 8, vst0 = v_st(sr, sc), vst1 = v_st(32 + sr, sc);
  const int vb0 = (int)(uintptr_t)V_lds + v_rd_base(lane);
  struct { bf16x8 vs0, vs1, ks0, ks1; } sr_[2];
#define SLOAD(i, k0) do { sr_[i].vs0 = *reinterpret_cast<const bf16x8*>(&Vh[(long)((k0) + sr) * LDK + sc]); sr_[i].vs1 = *reinterpret_cast<const bf16x8*>(&Vh[(long)((k0) + 32 + sr) * LDK + sc]); \
    sr_[i].ks0 = *reinterpret_cast<const bf16x8*>(&Kh[(long)((k0) + sr) * LDK + sc]); sr_[i].ks1 = *reinterpret_cast<const bf16x8*>(&Kh[(long)((k0) + 32 + sr) * LDK + sc]); } while (0)
#define SWRITE(b, i) do { *(bf16x8*)((char*)V_lds + (b) * SHM_V + vst0) = sr_[i].vs0;          \
    *(bf16x8*)((char*)V_lds + (b) * SHM_V + vst1) = sr_[i].vs1; int kc = sc * 2;               \
    *(bf16x8*)((char*)K_lds + (b) * SHM_K + KSWZ(sr, kc)) = sr_[i].ks0;                       \
    *(bf16x8*)((char*)K_lds + (b) * SHM_K + KSWZ(32 + sr, kc)) = sr_[i].ks1; } while (0)
#define SWAIT() asm volatile("s_waitcnt vmcnt(4)" ::: "memory")
#define RESC(a) do { if (__any((a) < 1.f)) { if (hi == 0) al_l[r32] = (a); asm volatile("s_waitcnt lgkmcnt(0)" ::: "memory"); \
    for (int d = 0; d < 4; ++d) for (int r = 0; r < 16; ++r) o[d][r] *= al_l[crow(r, hi)]; } } while (0)
  f32x16 pA0, pA1, pB0, pB1; bf16x8 pa0, pa1, pa2, pa3; const int NT = seq / KVBLK;
  constexpr int SE = 0, SO = 1;
  SLOAD(SE, 0); asm volatile("s_waitcnt vmcnt(0)" ::: "memory"); SWRITE(0, SE); __syncthreads();
  qkt(pA0, pA1, K_lds, qr, r32, hi); partialSM(pA0, pA1, mnC, shift);
  SLOAD(SO, KVBLK); SLOAD(SE, 2 * KVBLK);
  SWAIT(); SWRITE(1, SO); __syncthreads();
  for (int j = 1; j + 1 < NT; j += 2) {
    SBAR(); qkt(pB0, pB1, (bf16_t*)((char*)K_lds + SHM_K), qr, r32, hi);
    finishSM(pA0, pA1, l_reg, pa0, pa1, pa2, pa3); SBAR();
    SLOAD(SO, (j + 2) * KVBLK); SBAR();
    pv_d0(o, vb0, pa0, pa1, pa2, pa3); partialSM(pB0, pB1, mnC, shift);
    __syncthreads(); SWAIT(); SWRITE(0, SE);
    __syncthreads();
    SBAR(); qkt(pA0, pA1, K_lds, qr, r32, hi);
    finishSM(pB0, pB1, l_reg, pa0, pa1, pa2, pa3); SBAR();
    SLOAD(SE, (j + 3 < NT ? j + 3 : NT - 1) * KVBLK); SBAR();
    pv_d0(o, vb0 + (int)SHM_V, pa0, pa1, pa2, pa3); partialSM(pA0, pA1, mnC, shift);
    __syncthreads(); SWAIT(); SWRITE(1, SO);
    __syncthreads();
  }
  SBAR(); qkt(pB0, pB1, (bf16_t*)((char*)K_lds + SHM_K), qr, r32, hi);
  finishSM(pA0, pA1, l_reg, pa0, pa1, pa2, pa3); SBAR();
  pv_d0(o, vb0, pa0, pa1, pa2, pa3); partialSM(pB0, pB1, mnC, shift);
  __syncthreads();
  finishSM(pB0, pB1, l_reg, pa0, pa1, pa2, pa3); SBAR();
  pv_d0(o, vb0 + (int)SHM_V, pa0, pa1, pa2, pa3);
  if (hi == 0) { li_l[r32] = l_reg; if (lse) lse[(wid * QBLK + r32) * 4] = __logf(l_reg) - mnC * 0.69314718055994531f; }
  asm volatile("s_waitcnt lgkmcnt(0)" ::: "memory");
  float rli[16];
#pragma unroll
  for (int r = 0; r < 16; ++r) rli[r] = __builtin_amdgcn_rcpf(li_l[crow(r, hi)]);
  bf16_t* Ow = Ob + (long)(wid * QBLK) * LDO;
#pragma unroll
  for (int r = 0; r < 16; ++r) { int orow = crow(r, hi);
    for (int d0 = 0; d0 < 4; ++d0) Ow[(long)orow * LDO + d0 * 32 + r32] = (bf16_t)(pkbf(o[d0][r] * rli[r], 0.f) & 0xffffu); }
  __syncthreads();
#undef SLOAD
#undef SWRITE
#undef SWAIT
#undef RESC
}
}

struct Args { const float* in[20]; float* out; unsigned char* ws; int ph_lo, ph_hi; };
typedef const __attribute__((address_space(4))) Args* KArgs;
__device__ __forceinline__ KArgs get_args() { KArgs p = (KArgs)__builtin_amdgcn_kernarg_segment_ptr(); asm volatile("" : "+s"(p)); return p; }
__device__ __forceinline__ int fresh_tid() { int t = threadIdx.x; asm volatile("" : "+v"(t)); return t; }
__device__ __forceinline__ int fresh_bx() { int t = blockIdx.x; asm volatile("" : "+s"(t)); return t; }
__device__ __forceinline__ int fresh_g() { int t = gridDim.x; asm volatile("" : "+s"(t)); return t; }
enum { I_X = 0, I_C, I_CTX, I_CCTX, I_ADAW, I_ADAB, I_N1W, I_N2W, I_WIN, I_QNW, I_KNW, I_CONVW, I_ALOG, I_DTB, I_DNW, I_WOUT, I_WQ, I_SUBK, I_U, I_V };

__device__ __forceinline__ void convert_tables(const float* U, const float* V, unsigned char* ws, int l, int wvi, int nwv, int lane, int rw_end = 2 * NEXP) {
    const float* us = U + (size_t)l * NEXP * 1024; const float* vs = V + (size_t)l * NEXP * 1024;
    const int set = l & 1;
    float* scl = (float*)(ws + WS_USC) + set * 2 * NEXP;
    for (int rw = wvi; rw < rw_end; rw += nwv) {
        const bool isu = rw < NEXP; const int e = isu ? rw : rw - NEXP;
        const f32x4* sp = (const f32x4*)((isu ? us : vs) + (size_t)e * 1024 + 16 * lane);
        f32x4 x[4]; float mx = 0.f;
#pragma unroll
        for (int i = 0; i < 4; ++i) { x[i] = sp[i]; mx = fmaxf(mx, fmaxf(fmaxf(fabsf(x[i][0]), fabsf(x[i][1])), fmaxf(fabsf(x[i][2]), fabsf(x[i][3])))); }
        mx = wave_max(mx);
        const float sc = fmaxf(mx, 1e-30f) * (1.f / 127.f), inv = 1.f / sc;
        u32x4 o4;
#pragma unroll
        for (int i = 0; i < 4; ++i) { const unsigned b0 = (unsigned)(int)(rintf(x[i][0] * inv) + 128.f), b1 = (unsigned)(int)(rintf(x[i][1] * inv) + 128.f), b2 = (unsigned)(int)(rintf(x[i][2] * inv) + 128.f), b3 = (unsigned)(int)(rintf(x[i][3] * inv) + 128.f);
            o4[i] = b0 | (b1 << 8) | (b2 << 16) | (b3 << 24); }
        *(u32x4*)(ws + WS_UB + (size_t)set * TAB_SET + (size_t)e * 2048 + (isu ? 0 : 1024) + 16 * lane) = o4;
        if (lane == 0) scl[rw] = sc;
    }
}

__device__ __forceinline__ void transpose_item(const float* W, int ldw, int K, bf16_t* WT, LAS float* scr, int kb, int nb, int lane) {
    const int k0 = 64 * kb, n0 = 32 * nb;
#pragma unroll 8
    for (int i = 0; i < 32; ++i) { const int kk = 2 * i + (lane >> 5); scr[kk * 33 + (lane & 31)] = W[(size_t)(k0 + kk) * ldw + n0 + (lane & 31)]; }
    LDS_WAIT(); asm volatile("" ::: "memory");
    const int c = lane & 7;
#pragma unroll
    for (int j = 0; j < 4; ++j) { const int n = (lane >> 3) + 8 * j; const LAS float* s = scr + (8 * c) * 33 + n;
        u32x4 o; o.x = pkbf(s[0 * 33], s[1 * 33]); o.y = pkbf(s[2 * 33], s[3 * 33]); o.z = pkbf(s[4 * 33], s[5 * 33]); o.w = pkbf(s[6 * 33], s[7 * 33]);
        *(u32x4*)(WT + (size_t)(n0 + n) * K + k0 + 8 * c) = o; }
    LDS_WAIT(); asm volatile("" ::: "memory");
}
__device__ __forceinline__ void phase_prologue(LAS unsigned char* lds) {
    const KArgs ap = get_args();
#define a (*ap)

    const int tid = fresh_tid(), lane = tid & 63, wave = __builtin_amdgcn_readfirstlane(tid >> 6), G = fresh_g(), bx = fresh_bx();
    unsigned char* ws = a.ws;
    {
        LAS float* sc = (LAS float*)(lds + 70000);
        LAS float* part = (LAS float*)(lds + 70000 + 12288);
        for (int i = tid; i < 3 * 1024; i += 512) { const int r = i >> 10, k = i & 1023; const float v = r < 2 ? a.in[I_C][r * 1024 + k] : a.in[I_CCTX][k]; sc[i] = silu_f(v); }
        __syncthreads();
        float* mod = (float*)(ws + WS_MOD);
        for (int item = bx; item < DEPTH * 96; item += G) {
            const int l = item / 96, j0 = (item % 96) * 64;
            const float* wp = a.in[I_ADAW] + (size_t)l * 1024 * 6144 + (size_t)(wave * 128) * 6144 + j0 + lane;
            float a0 = 0.f, a1 = 0.f, a2 = 0.f;
#pragma unroll 8
            for (int kk = 0; kk < 128; ++kk) { const float w = wp[(size_t)kk * 6144]; const int k = wave * 128 + kk; a0 = fmaf(sc[k], w, a0); a1 = fmaf(sc[1024 + k], w, a1); a2 = fmaf(sc[2048 + k], w, a2); }
            part[(wave * 3 + 0) * 64 + lane] = a0; part[(wave * 3 + 1) * 64 + lane] = a1; part[(wave * 3 + 2) * 64 + lane] = a2;
            __syncthreads();
            if (tid < 192) { const int r = tid >> 6, jj = tid & 63; float s = a.in[I_ADAB][l * 6144 + j0 + jj];
#pragma unroll
                for (int w = 0; w < 8; ++w) s += part[(w * 3 + r) * 64 + jj];
                mod[(size_t)(l * 3 + r) * 6144 + j0 + jj] = s; }
            __syncthreads();
        }
    }
    {
        LAS float* scr = (LAS float*)(lds + wave * 8448);
        const int gw = bx * 8 + wave, NGW = G * 8;
        constexpr int I_IN = 16 * 96, I_OUT = 16 * 32, I_Q = 16 * 64, PER_L = I_IN + I_OUT + I_Q;
        for (int it = gw; it < DEPTH * PER_L; it += NGW) {
            const int l = it / PER_L; int r = it % PER_L;
            if (r < I_IN) { transpose_item(a.in[I_WIN] + (size_t)l * 1024 * NIN, NIN, 1024, (bf16_t*)(ws + WS_WINT) + (size_t)l * NP * 1024, scr, r / 96, r % 96, lane); continue; } r -= I_IN;
            if (r < I_OUT) { transpose_item(a.in[I_WOUT] + (size_t)l * 1024 * 1024, 1024, 1024, (bf16_t*)(ws + WS_WOUTT) + (size_t)l * 1024 * 1024, scr, r / 32, r % 32, lane); continue; } r -= I_OUT;
            transpose_item(a.in[I_WQ] + (size_t)l * 1024 * 2048, 2048, 1024, (bf16_t*)(ws + WS_WQT) + (size_t)l * 2048 * 1024, scr, r / 64, r % 64, lane);
        }
    }
    const size_t gt = (size_t)bx * 512 + tid, NT = (size_t)G * 512;
    for (size_t i = gt; i < (size_t)DEPTH * 16 * 1024; i += NT) { const int l = (int)(i >> 14), j = (int)((i >> 10) & 15), k = (int)(i & 1023);
        ((float*)(ws + WS_WSK))[i] = a.in[I_WIN][(size_t)l * 1024 * NIN + (size_t)k * NIN + NP + j]; }
    convert_tables(a.in[I_U], a.in[I_V], ws, 0, bx * 8 + wave, G * 8, lane);
    for (size_t i = gt; i < (size_t)DEPTH * 8 * 2 * 128 * 128 / 2; i += NT) { const f32x2 x = ((const f32x2*)a.in[I_SUBK])[i]; ((unsigned*)(ws + WS_SKB))[i] = pkbf(x[0], x[1]); }
    for (size_t i = gt; i < 8192; i += NT) { const int pos = (int)(i >> 5), fi = (int)(i & 31);
        const float inv = exp2f(-(float)fi * (13.287712379549449f / 32.f)); const float ang = (float)pos * inv;
        float rev = ang * 0.15915494309189535f; rev -= floorf(rev);
        ((float*)(ws + WS_ROPE))[i] = __builtin_amdgcn_cosf(rev); ((float*)(ws + WS_ROPE))[8192 + i] = __builtin_amdgcn_sinf(rev); }
}

template <bool SK>
__device__ __forceinline__ void phase_norm(int l, int which, LAS unsigned char* lds) {
    const KArgs ap = get_args();
#define a (*ap)

    const int tid = fresh_tid(), lane = tid & 63, wave = __builtin_amdgcn_readfirstlane(tid >> 6), G = fresh_g(), bx = fresh_bx();
    unsigned char* ws = a.ws;
    LAS float* wsk = (LAS float*)lds;
    if (SK) { const float* src = (const float*)(ws + WS_WSK) + (size_t)l * 16384; for (int i = tid; i < 16384 / 4; i += 512) ((LAS f32x4*)wsk)[i] = ((const f32x4*)src)[i]; __syncthreads(); }
    const int nrows = (which == 1 && l == DEPTH - 1) ? ML : M;
    const float* nw = a.in[which ? I_N2W : I_N1W] + l * 1024;
    const float* modl = (const float*)(ws + WS_MOD) + (size_t)l * 3 * 6144;
    const int shoff = which ? 3072 : 0, scoff = which ? 4096 : 1024;
    f32x4 nwv[4];
#pragma unroll
    for (int j = 0; j < 4; ++j) nwv[j] = *(const f32x4*)(nw + 4 * lane + 256 * j);
    for (int row = wave * G + bx; row < nrows; row += G * 8) {
        const float* src; int mrow;
        if (row < ML) { src = ((l == 0 && which == 0) ? a.in[I_X] : a.out) + (size_t)row * D; mrow = row >= T ? 1 : 0; }
        else { src = ((l == 0 && which == 0) ? a.in[I_CTX] : (const float*)(ws + WS_CTXX)) + (size_t)(row - ML) * D; mrow = 2; }
        const float* md = modl + mrow * 6144;
        f32x4 v[4]; float ss = 0.f;
#pragma unroll
        for (int j = 0; j < 4; ++j) { v[j] = *(const f32x4*)(src + 4 * lane + 256 * j); ss += (v[j][0] * v[j][0] + v[j][1] * v[j][1]) + (v[j][2] * v[j][2] + v[j][3] * v[j][3]); }
        const float rstd = rsqrtf(wave_sum(ss) * (1.f / D) + EPS);
        bf16_t* hrow = (bf16_t*)(ws + WS_H) + (size_t)row * D;
#pragma unroll
        for (int j = 0; j < 4; ++j) { const f32x4 sc = *(const f32x4*)(md + scoff + 4 * lane + 256 * j), sh = *(const f32x4*)(md + shoff + 4 * lane + 256 * j);
            v[j] = v[j] * rstd * nwv[j] * (sc + 1.f) + sh;
            u32x2 o; o.x = pkbf(v[j][0], v[j][1]); o.y = pkbf(v[j][2], v[j][3]); *(u32x2*)(hrow + 4 * lane + 256 * j) = o; }
        if (SK) {
            float p[16];
#pragma unroll
            for (int c = 0; c < 16; ++c) { float q = 0.f;
#pragma unroll
                for (int j = 0; j < 4; ++j) { const f32x4 w = *(const LAS f32x4*)(wsk + c * 1024 + 4 * lane + 256 * j); q += (v[j][0] * w[0] + v[j][1] * w[1]) + (v[j][2] * w[2] + v[j][3] * w[3]); }
                p[c] = q; }
            { const bool hb = (lane & 32) != 0;
#pragma unroll
              for (int c = 0; c < 8; ++c) { const float keep = hb ? p[c + 8] : p[c], send = hb ? p[c] : p[c + 8]; p[c] = keep + lane_xor<32>(send); } }
            { const bool hb = (lane & 16) != 0;
#pragma unroll
              for (int c = 0; c < 4; ++c) { const float keep = hb ? p[c + 4] : p[c], send = hb ? p[c] : p[c + 4]; p[c] = keep + lane_xor<16>(send); } }
            { const bool hb = (lane & 8) != 0;
#pragma unroll
              for (int c = 0; c < 2; ++c) { const float keep = hb ? p[c + 2] : p[c], send = hb ? p[c] : p[c + 2]; p[c] = keep + lane_xor<8>(send); } }
            { const bool hb = (lane & 4) != 0; const float keep = hb ? p[1] : p[0], send = hb ? p[0] : p[1]; p[0] = keep + lane_xor<4>(send); }
            p[0] += lane_xor<2>(p[0]); p[0] += lane_xor<1>(p[0]);
            if ((lane & 3) == 0) { const int c = ((lane >> 5) & 1) * 8 + ((lane >> 4) & 1) * 4 + ((lane >> 3) & 1) * 2 + ((lane >> 2) & 1); ((float*)(ws + WS_BA))[(size_t)row * 16 + c] = p[0]; }
        }
    }
    if (SK) __syncthreads();
}

__device__ __forceinline__ void phase_prep(int l, LAS unsigned char* lds) {
    const KArgs ap = get_args();
#define a (*ap)

    const int tid = fresh_tid(), lane = tid & 63, wave = __builtin_amdgcn_readfirstlane(tid >> 6), G = fresh_g(), bx = fresh_bx();
    unsigned char* ws = a.ws;
    const bf16_t* P = (const bf16_t*)(ws + WS_P);
    const float* ropec = (const float*)(ws + WS_ROPE); const float* ropes = ropec + 8192;
    const int sec = lane >> 5, fi = lane & 31;
    const float qw0 = a.in[I_QNW][l * 128 + sec * 64 + fi], qw1 = a.in[I_QNW][l * 128 + sec * 64 + 32 + fi];
    const float kw0 = a.in[I_KNW][l * 128 + sec * 64 + fi], kw1 = a.in[I_KNW][l * 128 + sec * 64 + 32 + fi];
    for (int row = wave * G + bx; row < M; row += G * 8) {
        const bool lat = row < ML;
        int b, tt, tlen; if (lat) { b = row >> 14; tt = row & (T - 1); tlen = T; } else { b = (row - ML) >> 8; tt = (row - ML) & (CT - 1); tlen = CT; }
        const bf16_t* prow = P + (size_t)row * NP;
        unsigned short xa[6][2];
#pragma unroll
        for (int hh = 0; hh < 6; ++hh) { const bf16_t* xp = prow + (hh < 4 ? hh * 128 : 512 + (hh - 4) * 128) + sec * 64 + fi; xa[hh][0] = xp[0]; xa[hh][1] = xp[32]; }
        const u32x2 vcp = *(const u32x2*)(prow + 768 + 4 * lane);
        float cs = 1.f, sn = 0.f;
        if (lat) { const int pos = sec ? (tt & 63) : (tt >> 6); cs = ropec[pos * 32 + fi]; sn = ropes[pos * 32 + fi]; }
        bf16_t* qo = (bf16_t*)(ws + WS_QA) + (size_t)row * 512;
        const size_t kvrow = (size_t)b * KVLEN + (lat ? tt : T + tt);
        bf16_t* ko = (bf16_t*)(ws + WS_KA) + kvrow * 256;
        bf16_t* vo = (bf16_t*)(ws + WS_VA) + kvrow * 256;
        float ssq[6];
#pragma unroll
        for (int hh = 0; hh < 6; ++hh) { const float x0 = bf2f(xa[hh][0]), x1 = bf2f(xa[hh][1]); ssq[hh] = x0 * x0 + x1 * x1; }
#pragma unroll
        for (int hh = 0; hh < 6; ++hh) ssq[hh] = wave_sum(ssq[hh]);
#pragma unroll
        for (int hh = 0; hh < 6; ++hh) {
            const float x0 = bf2f(xa[hh][0]), x1 = bf2f(xa[hh][1]);
            const float rs = rsqrtf(ssq[hh] * (1.f / 128.f) + EPS);
            const float y0 = x0 * rs * (hh < 4 ? qw0 : kw0), y1 = x1 * rs * (hh < 4 ? qw1 : kw1);
            const float qsc = hh < 4 ? 0.088388347648318440f * 1.4426950408889634f : 1.f;
            const float o0 = (y0 * cs - y1 * sn) * qsc, o1 = (y1 * cs + y0 * sn) * qsc;
            bf16_t* op = (hh < 4 ? qo + hh * 128 : ko + (hh - 4) * 128) + sec * 64 + fi;
            op[0] = (bf16_t)(pkbf(o0, 0.f) & 0xffffu); op[32] = (bf16_t)(pkbf(o1, 0.f) & 0xffffu);
        }
        *(u32x2*)(vo + 4 * lane) = vcp;
    }
    __syncthreads();
}

constexpr int ATT_PARTS = 4;
__device__ __forceinline__ void phase_attn(int l, unsigned char* lds_raw, volatile LAS unsigned* MISC, int rep) {
    const KArgs ap = get_args();
#define a (*ap)
    unsigned char* ws = a.ws;
    const bf16_t* QA = (const bf16_t*)(ws + WS_QA); const bf16_t* KA = (const bf16_t*)(ws + WS_KA); const bf16_t* VA = (const bf16_t*)(ws + WS_VA);
    bf16_t* CAT = (bf16_t*)(ws + WS_CAT); float* LSE = (float*)(ws + WS_BA);
    unsigned* ctr = (unsigned*)(ws + WS_CTL) + 8192 + 64 * l + 1024 * rep;
    const int natt = 2048 + (l < DEPTH - 1 ? 8 : 0);
    constexpr int CONV_ROWS = 64, NCONV = 2 * NEXP / CONV_ROWS;
    const int nunits = natt + (l + 1 < DEPTH ? NCONV : 0);
    float braw;
    { const int ln = threadIdx.x & 63; float mq = fmaxf(fabsf(a.in[I_QNW][l * 128 + ln]), fabsf(a.in[I_QNW][l * 128 + 64 + ln])), mk = fmaxf(fabsf(a.in[I_KNW][l * 128 + ln]), fabsf(a.in[I_KNW][l * 128 + 64 + ln]));
      mq = wave_max(mq); mk = wave_max(mk);
      braw = __builtin_bit_cast(float, __builtin_amdgcn_readfirstlane(__builtin_bit_cast(int, 128.f * mq * mk))); }
    if (threadIdx.x == 0) MISC[12] = __hip_atomic_fetch_add(ctr, 1u, __ATOMIC_RELAXED, __HIP_MEMORY_SCOPE_AGENT);
    __syncthreads();
    int u = (int)MISC[12], par = 0;
    for (; u < nunits; ) {
        if (threadIdx.x == 0) MISC[13 - par] = __hip_atomic_fetch_add(ctr, 1u, __ATOMIC_RELAXED, __HIP_MEMORY_SCOPE_AGENT);
        if (u >= natt) {
            const int rwb = (u - natt) * CONV_ROWS + (int)(threadIdx.x >> 6) * 8;
            convert_tables(a.in[I_U], a.in[I_V], ws, l + 1, rwb, 1, (int)(threadIdx.x & 63), rwb + 8);
            __syncthreads();
            u = (int)MISC[13 - par]; par ^= 1;
            continue;
        }
        size_t r0, kv0; int h, kvh, seq, ldo; bf16_t* ob; float* lse;
        if (u < 2048) { const int qb = u & 63, g = (u >> 6) & 1, part = (u >> 7) & 3, b = u >> 10; kvh = (u >> 9) & 1; h = kvh * 2 + g;
            const int t0 = (part >> 1) * 130 + (part & 1) * 64;
            r0 = (size_t)b * T + (size_t)qb * 256; kv0 = (size_t)b * KVLEN + (size_t)t0 * 64; seq = ((part & 1) ? 66 : 64) * 64;
            ob = part ? (bf16_t*)(ws + (part == 1 ? WS_DQ : part == 2 ? WS_DK : WS_DV)) + r0 * 512 + h * 128 : CAT + r0 * 1024 + h * 128; ldo = part ? 512 : 1024; lse = LSE + ((size_t)part * ML + r0) * 4 + h; }
        else { const int b = (u - 2048) >> 2; h = (u - 2048) & 3; kvh = h >> 1; r0 = (size_t)ML + (size_t)b * CT; kv0 = (size_t)b * KVLEN + T; seq = CT;
            ob = CAT + r0 * 1024 + h * 128; ldo = 1024; lse = nullptr; }
        att::attn_dense_body(QA + r0 * 512 + h * 128, KA + kv0 * 256 + kvh * 128, VA + kv0 * 256 + kvh * 128, ob, ldo, seq, (char*)lds_raw, lse, braw);
        u = (int)MISC[13 - par]; par ^= 1;
    }
#undef a
}

__device__ __forceinline__ int tokperm(int q, int hh, int jj) { return 16 * q + 8 * (jj >> 2) + 4 * hh + (jj & 3); }
__device__ __forceinline__ int crow16(int r, int hi) { return (r & 3) + 8 * (r >> 2) + 4 * hi; }
__device__ __forceinline__ int kperm16(int s_, int g, int jj) { return 32 * s_ + 16 * (jj >> 2) + 4 * g + (jj & 3); }
__device__ __forceinline__ int frag_off(int i, int j) {
    return (((i >> 4) * 2 + (j >> 5)) * 64 + ((i & 15) + 16 * ((j >> 2) & 3))) * 16 + (4 * ((j >> 4) & 1) + (j & 3)) * 2;
}
template <int MODE>
__device__ __forceinline__ void phase_dn_chunkprep(int l, LAS unsigned char* lds) {
    const KArgs ap = get_args();
#define a (*ap)
    const int tid = fresh_tid(), lane = tid & 63, wave = __builtin_amdgcn_readfirstlane(tid >> 6), G = fresh_g(), bx = fresh_bx();
    unsigned char* ws = a.ws;
    constexpr int KT_OFF = 0, QT_OFF = 17408, VT_OFF = 34816, GS_OFF = 52224, RS_OFF = 68864, AM_OFF = 85504, SC_OFF = 120320, IMG_OFF = 0;
    const int r = lane & 31, hh = lane >> 5;
    const bf16_t* DQ = (const bf16_t*)(ws + WS_DQ); const bf16_t* DK = (const bf16_t*)(ws + WS_DK); const bf16_t* DV = (const bf16_t*)(ws + WS_DV);
    const float* BA = (const float*)(ws + WS_BA);
    constexpr int NTASK = MODE ? NB * 4 * 4 : NB * 4 * (NCH - 4);
#define CP_TASKID(t_) (MODE ? ((t_) >> 2) * NCH + ((t_) & 3) : ((t_) >> 8) * NCH + 4 + ((t_) & 255))
    LAS float* gsc = (LAS float*)(lds + SC_OFF);
    LAS float* bsc = gsc + 128;
    LAS float* gcs = gsc + 256;
    constexpr int CW_OFF = 121856;
    LAS float* cwl = (LAS float*)(lds + CW_OFF);
    for (int i = tid; i < 5 * 1536; i += 512) cwl[i] = a.in[I_CONVW][(size_t)l * 5 * 1536 + i];
    __syncthreads();
    const bf16_t* P = (const bf16_t*)(ws + WS_P);
    u32x4 xin[3][5][2];
#define CP_LOADX(task_) do { const int cidx_ = (task_) % NCH, bh_ = (task_) / NCH, b_ = bh_ >> 2, h_ = bh_ & 3; \
        const int row0_ = cidx_ < 4 ? ML + b_ * CT + cidx_ * 64 : b_ * T + (cidx_ - 4) * 64, tt_ = (cidx_ < 4 ? cidx_ * 64 : (cidx_ - 4) * 64) + (tid >> 3), tlen_ = cidx_ < 4 ? CT : T; \
        _Pragma("unroll") for (int j = 0; j < 5; ++j) { const int t2 = tt_ + j - 2; const bool ok = t2 >= 0 && t2 < tlen_; \
            const bf16_t* xr = P + (size_t)(row0_ + (tid >> 3) + (ok ? j - 2 : 0)) * NP + 1024 + h_ * 128 + (tid & 7) * 16; \
            _Pragma("unroll") for (int m = 0; m < 3; ++m) { const u32x4 w0 = *(const u32x4*)(xr + m * 512), w1 = *(const u32x4*)(xr + m * 512 + 8); \
                xin[m][j][0] = ok ? w0 : (u32x4){0u, 0u, 0u, 0u}; xin[m][j][1] = ok ? w1 : (u32x4){0u, 0u, 0u, 0u}; } } } while (0)
    if (bx < NTASK) CP_LOADX(CP_TASKID(bx));
    for (int tk = bx; tk < NTASK; tk += G) {
        const int task = CP_TASKID(tk);
        const int cidx = task % NCH, bh = task / NCH, b = bh >> 2, h = bh & 3;
        const int row0 = cidx < 4 ? ML + b * CT + cidx * 64 : b * T + (cidx - 4) * 64;
        unsigned char* rec = ws + WS_REC + (size_t)task * REC_BYTES;
        {
            const int rr = tid >> 3, seg = tid & 7;
            if (tid < 128) { const int d = tid >> 6, i = tid & 63, dh = d * 4 + h;
                const float xb = BA[(size_t)(row0 + i) * 16 + dh], z = BA[(size_t)(row0 + i) * 16 + 8 + dh] + a.in[I_DTB][l * 8 + dh];
                bsc[tid] = 1.f / (1.f + __expf(-xb)); gsc[tid] = -__expf(a.in[I_ALOG][l * 8 + dh]) * (fmaxf(z, 0.f) + log1pf(__expf(-fabsf(z)))); }
#pragma unroll
            for (int m = 0; m < 3; ++m) {
                float y[16];
#pragma unroll
                for (int c = 0; c < 16; ++c) y[c] = 0.f;
#pragma unroll
                for (int j = 0; j < 5; ++j) { const LAS float* wp = cwl + j * 1536 + m * 512 + h * 128 + seg * 16;
#pragma unroll
                    for (int q4 = 0; q4 < 4; ++q4) { const f32x4 wv = *(const LAS f32x4*)(wp + 4 * q4); const unsigned u0 = xin[m][j][q4 >> 1][2 * (q4 & 1)], u1 = xin[m][j][q4 >> 1][2 * (q4 & 1) + 1];
                        y[4 * q4 + 0] = fmaf(bflo(u0), wv[0], y[4 * q4 + 0]); y[4 * q4 + 1] = fmaf(bfhi(u0), wv[1], y[4 * q4 + 1]); y[4 * q4 + 2] = fmaf(bflo(u1), wv[2], y[4 * q4 + 2]); y[4 * q4 + 3] = fmaf(bfhi(u1), wv[3], y[4 * q4 + 3]); } }
                float ss = 0.f;
#pragma unroll
                for (int c = 0; c < 16; ++c) { y[c] = silu_f(y[c]); ss = fmaf(y[c], y[c], ss); }
                if (m < 2) { ss += lane_xor<1>(ss); ss += lane_xor<2>(ss); ss += lane_xor<4>(ss);
                    float sc = rsqrtf(ss + EPS); if (m == 0) sc *= 0.088388347648318440f;
#pragma unroll
                    for (int c = 0; c < 16; ++c) y[c] *= sc; }
                u32x4 o0, o1; o0.x = pkbf(y[0], y[1]); o0.y = pkbf(y[2], y[3]); o0.z = pkbf(y[4], y[5]); o0.w = pkbf(y[6], y[7]); o1.x = pkbf(y[8], y[9]); o1.y = pkbf(y[10], y[11]); o1.z = pkbf(y[12], y[13]); o1.w = pkbf(y[14], y[15]);
                LAS unsigned char* dst = lds + (m == 0 ? QT_OFF : m == 1 ? KT_OFF : VT_OFF) + rr * 272 + seg * 32;
                *(LAS u32x4*)dst = o0; *(LAS u32x4*)(dst + 16) = o1;
            }
        }
        __syncthreads();
        {
            const int mat = wave >> 2, ti = (wave >> 1) & 1, tj = wave & 1;
            f32x16 acc = {};
#pragma unroll
            for (int ks = 0; ks < 8; ++ks) {
                const bf16x8 av = *(const LAS bf16x8*)(lds + (mat ? QT_OFF : KT_OFF) + (32 * ti + r) * 272 + (16 * ks + 8 * hh) * 2);
                const bf16x8 bv = *(const LAS bf16x8*)(lds + KT_OFF + (32 * tj + r) * 272 + (16 * ks + 8 * hh) * 2);
                acc = __builtin_amdgcn_mfma_f32_32x32x16_bf16(av, bv, acc, 0, 0, 0);
            }
            LAS float* dst = (LAS float*)(lds + (mat ? RS_OFF : GS_OFF));
#pragma unroll
            for (int i = 0; i < 16; ++i) dst[(32 * ti + crow16(i, hh)) * 65 + 32 * tj + r] = acc[i];
        }
        { const int r16 = lane & 15, g4 = lane >> 4;
#pragma unroll
        for (int t = 0; t < 2; ++t) { const int f = wave * 2 + t, mt = f >> 2, sk = f & 3;
            { const u32x2 lo = *(const LAS u32x2*)(lds + KT_OFF + (16 * mt + r16) * 272 + (32 * sk + 4 * g4) * 2), hi2 = *(const LAS u32x2*)(lds + KT_OFF + (16 * mt + r16) * 272 + (32 * sk + 16 + 4 * g4) * 2);
              *(u32x4*)(rec + REC_K + f * 1024 + lane * 16) = (u32x4){lo.x, lo.y, hi2.x, hi2.y}; }
            { const u32x2 lo = *(const LAS u32x2*)(lds + QT_OFF + (16 * mt + r16) * 272 + (32 * sk + 4 * g4) * 2), hi2 = *(const LAS u32x2*)(lds + QT_OFF + (16 * mt + r16) * 272 + (32 * sk + 16 + 4 * g4) * 2);
              *(u32x4*)(rec + REC_Q + f * 1024 + lane * 16) = (u32x4){lo.x, lo.y, hi2.x, hi2.y}; } }
#pragma unroll
        for (int t = 0; t < 2; ++t) { const int f = wave * 2 + t, mt = f >> 1, sk = f & 1;
            unsigned e[8];
#pragma unroll
            for (int jj = 0; jj < 8; ++jj) e[jj] = *(const LAS unsigned short*)(lds + KT_OFF + kperm16(sk, g4, jj) * 272 + (16 * mt + r16) * 2);
            *(u32x4*)(rec + REC_KT + f * 1024 + lane * 16) = (u32x4){e[0] | (e[1] << 16), e[2] | (e[3] << 16), e[4] | (e[5] << 16), e[6] | (e[7] << 16)}; }
        { const int sl = wave;
            unsigned e[16];
#pragma unroll
            for (int i = 0; i < 16; ++i) e[i] = *(const LAS unsigned short*)(lds + VT_OFF + (16 * (i >> 2) + 4 * g4 + (i & 3)) * 272 + (16 * sl + r16) * 2);
            u32x4* vp = (u32x4*)(rec + REC_V + sl * 2048 + lane * 32);
            vp[0] = (u32x4){e[0] | (e[1] << 16), e[2] | (e[3] << 16), e[4] | (e[5] << 16), e[6] | (e[7] << 16)};
            vp[1] = (u32x4){e[8] | (e[9] << 16), e[10] | (e[11] << 16), e[12] | (e[13] << 16), e[14] | (e[15] << 16)}; }
        }
        if (tk + G < NTASK) CP_LOADX(CP_TASKID(tk + G));
        if (wave < 2) { const int d = wave; float gv = gsc[d * 64 + (d ? 63 - lane : lane)];
            gv += __builtin_bit_cast(float, __builtin_amdgcn_update_dpp(0, __builtin_bit_cast(int, gv), 0x111, 0xF, 0xF, true));
            gv += __builtin_bit_cast(float, __builtin_amdgcn_update_dpp(0, __builtin_bit_cast(int, gv), 0x112, 0xF, 0xF, true));
            gv += __builtin_bit_cast(float, __builtin_amdgcn_update_dpp(0, __builtin_bit_cast(int, gv), 0x114, 0xF, 0xF, true));
            gv += __builtin_bit_cast(float, __builtin_amdgcn_update_dpp(0, __builtin_bit_cast(int, gv), 0x118, 0xF, 0xF, true));
            { const float t0 = __builtin_bit_cast(float, __builtin_amdgcn_readlane(__builtin_bit_cast(int, gv), 15)), t1 = __builtin_bit_cast(float, __builtin_amdgcn_readlane(__builtin_bit_cast(int, gv), 31)), t2 = __builtin_bit_cast(float, __builtin_amdgcn_readlane(__builtin_bit_cast(int, gv), 47));
              const int rw_ = lane >> 4; gv += (rw_ >= 1 ? t0 : 0.f) + (rw_ >= 2 ? t1 : 0.f) + (rw_ >= 3 ? t2 : 0.f); }
            gcs[d * 64 + lane] = gv; }
        __syncthreads();
        const LAS float* Gs = (const LAS float*)(lds + GS_OFF); const LAS float* Rs = (const LAS float*)(lds + RS_OFF);
#pragma unroll 4
        for (int t = 0; t < 16; ++t) { const int e = tid + 512 * t, d = e >> 12, jp = (e >> 6) & 63, ip = e & 63;
            const int in_ = d ? 63 - ip : ip, jn = d ? 63 - jp : jp;
            const float dec = __expf(fminf(gcs[d * 64 + ip] - gcs[d * 64 + jp], 0.f));
            const float av = (jp < ip) ? bsc[d * 64 + in_] * Gs[in_ * 65 + jn] * dec : 0.f;
            ((LAS float*)(lds + AM_OFF))[d * 4352 + jp * 68 + ip] = av;
            const float qk = (jp <= ip) ? Rs[in_ * 65 + jn] * dec : 0.f;
            *(LAS unsigned short*)(lds + IMG_OFF + d * 16384 + 8192 + frag_off(in_, jn)) = (unsigned short)(pkbf(qk, 0.f) & 0xffffu); }
        __syncthreads();
        if (wave < 2) { const int d = wave, c = lane, jn = d ? 63 - c : c; const float bj = bsc[d * 64 + jn];
            const LAS float* At = (const LAS float*)(lds + AM_OFF) + d * 4352;
            LAS float* Xm = (LAS float*)(lds + GS_OFF) + d * 4096 + c;
            const int fj = (jn >> 5) * 1024 + ((jn >> 2) & 3) * 256 + ((jn >> 4) & 1) * 8 + (jn & 3) * 2;
#pragma unroll 1
            for (int B = 0; B < 4; ++B) {
                float acc[16];
#pragma unroll
                for (int q = 0; q < 16; ++q) acc[q] = (16 * B + q == c) ? 1.f : 0.f;
#pragma unroll 4
                for (int j = 0; j < 16 * B; ++j) { const float xj = Xm[j * 64];
                    const f32x4 a0 = *(const LAS f32x4*)(At + j * 68 + 16 * B), a1 = *(const LAS f32x4*)(At + j * 68 + 16 * B + 4), a2 = *(const LAS f32x4*)(At + j * 68 + 16 * B + 8), a3 = *(const LAS f32x4*)(At + j * 68 + 16 * B + 12);
#pragma unroll
                    for (int q = 0; q < 4; ++q) { acc[q] = fmaf(-a0[q], xj, acc[q]); acc[4 + q] = fmaf(-a1[q], xj, acc[4 + q]); acc[8 + q] = fmaf(-a2[q], xj, acc[8 + q]); acc[12 + q] = fmaf(-a3[q], xj, acc[12 + q]); } }
#pragma unroll
                for (int r2 = 0; r2 < 15; ++r2) { const LAS float* ar = At + (16 * B + r2) * 68 + 16 * B; const float xr = acc[r2];
#pragma unroll
                    for (int q4 = (r2 + 1) / 4; q4 < 4; ++q4) { const f32x4 a4 = *(const LAS f32x4*)(ar + 4 * q4);
#pragma unroll
                        for (int q = 0; q < 4; ++q) if (4 * q4 + q > r2) acc[4 * q4 + q] = fmaf(-a4[q], xr, acc[4 * q4 + q]); } }
#pragma unroll
                for (int q = 0; q < 16; ++q) { const int i = 16 * B + q, in_ = d ? 63 - i : i; Xm[i * 64] = acc[q];
                    *(LAS unsigned short*)(lds + IMG_OFF + d * 16384 + (in_ >> 4) * 2048 + (in_ & 15) * 16 + fj) = (unsigned short)(pkbf(acc[q] * bj, 0.f) & 0xffffu); }
            }
        } else if (wave < 4) { const int d = wave - 2, ip = d ? 63 - lane : lane; const float gl = gcs[d * 64 + 63], gi = gcs[d * 64 + ip];
            float* sc = (float*)(rec + REC_DIR + d * REC_DIRSZ + 16384);
            sc[lane] = __expf(gi); sc[64 + lane] = __expf(gl - gi); if (lane == 0) sc[128] = __expf(gl); }
        __syncthreads();
#pragma unroll
        for (int t = 0; t < 4; ++t) { const int p = tid + 512 * t, d = p >> 10, off = (p & 1023) * 16;
            *(u32x4*)(rec + REC_DIR + d * REC_DIRSZ + off) = *(const LAS u32x4*)(lds + IMG_OFF + d * 16384 + off); }
        __syncthreads();
    }
#undef CP_LOADX
#undef CP_TASKID
#undef a
}

__device__ __forceinline__ bf16x8 pack44(const f32x4& lo, const f32x4& hi) {
    u32x4 p; p.x = pkbf_c(lo[0], lo[1]); p.y = pkbf_c(lo[2], lo[3]); p.z = pkbf_c(hi[0], hi[1]); p.w = pkbf_c(hi[2], hi[3]);
    return __builtin_bit_cast(bf16x8, p);
}
template <int VAR>
__device__ __forceinline__ void phase_dn_scan(int l, LAS unsigned char* lds) {
    const KArgs ap = get_args();
#define a (*ap)
    const int tid = fresh_tid(), lane = tid & 63, wave = __builtin_amdgcn_readfirstlane(tid >> 6), bx = fresh_bx();
    unsigned char* ws = a.ws;
    if (bx >= 32) return;
    const int chain = bx >> 1, half = bx & 1, b = chain >> 3, h = (chain >> 1) & 3, dir = chain & 1;
    const unsigned char* recb = ws + WS_REC + (size_t)((b * 4 + h) * NCH) * REC_BYTES;
    constexpr int BUFSZ = 74752;
#define CIDX(n) (dir ? ((n) < 4 ? 3 - (n) : 263 - (n)) : (n))
    if (wave >= 4) {
        const int sw = wave - 4;
#define DN_PIECE(i_) ((sw + 4 * (i_)) < 73 ? (sw + 4 * (i_)) : 72)
#define DN_SRC(rec_, p_) ((p_) < 48 ? (rec_) + (p_) * 1024 : (p_) < 65 ? (rec_) + REC_DIR + dir * REC_DIRSZ + ((p_) - 48) * 1024 : (rec_) + REC_V + half * 8192 + ((p_) - 65) * 1024)
#define DN_STAGE(n, bi) do { const unsigned char* rec_ = recb + (size_t)CIDX(n) * REC_BYTES; _Pragma("unroll") for (int i_ = 0; i_ < 19; ++i_) { const int p_ = DN_PIECE(i_); \
        __builtin_amdgcn_global_load_lds((const unsigned*)(DN_SRC(rec_, p_) + lane * 16), (LAS unsigned*)(lds + (bi) * BUFSZ + p_ * 1024), 16, 0, 0); } } while (0)
#define DN_SYNC() do { asm volatile("s_waitcnt vmcnt(0)" ::: "memory"); __builtin_amdgcn_s_barrier(); asm volatile("" ::: "memory"); } while (0)
        if (VAR != 3) DN_STAGE(0, 0);
        DN_SYNC();
        for (int n = 0; n < NCH; ++n) {
            if (VAR != 3 && n + 1 < NCH) DN_STAGE(n + 1, (n + 1) & 1);
            DN_SYNC();
        }
#undef DN_STAGE
#undef DN_PIECE
#undef DN_SRC
#undef DN_SYNC
    } else {
        const int sl = half * 4 + wave, c16 = lane & 15, g4 = lane >> 4;
        float* Og = (float*)(ws + (dir ? WS_OB : WS_OF)) + h * 128 + sl * 16 + c16;
        f32x4 S[8];
#pragma unroll
        for (int i = 0; i < 8; ++i) S[i] = (f32x4){0.f, 0.f, 0.f, 0.f};
        asm volatile("s_waitcnt lgkmcnt(0)" ::: "memory"); __builtin_amdgcn_s_barrier(); asm volatile("" ::: "memory");
        for (int n = 0; n < NCH; ++n) {
            if (VAR == 2) { asm volatile("s_waitcnt lgkmcnt(0)" ::: "memory"); __builtin_amdgcn_s_barrier(); asm volatile("" ::: "memory"); continue; }
            const LAS unsigned char* buf = lds + (n & 1) * BUFSZ;
            const int cidx = CIDX(n);
            const u32x4 vc0 = *(const LAS u32x4*)(buf + 66560 + wave * 2048 + lane * 32), vc1 = *(const LAS u32x4*)(buf + 66560 + wave * 2048 + lane * 32 + 16);
#define FR(off, f) (*(const LAS bf16x8*)(buf + (off) + (f) * 1024 + lane * 16))
#define MF(A, B, C) __builtin_amdgcn_mfma_f32_16x16x32_bf16((A), (B), (C), 0, 0, 0)
#define SB_() __builtin_amdgcn_sched_barrier(0)
            bf16x8 fa[8], fb[8];
            f32x4 eg[4], dl[4];
#pragma unroll
            for (int mt = 0; mt < 4; ++mt) { eg[mt] = *(const LAS f32x4*)(buf + 65536 + (16 * mt + 4 * g4) * 4); dl[mt] = *(const LAS f32x4*)(buf + 65536 + 256 + (16 * mt + 4 * g4) * 4); }
            const float egl = *(const LAS float*)(buf + 65536 + 512);
#define RD_KQ(dst, q) do { _Pragma("unroll") for (int mt = 0; mt < 4; ++mt) { dst[mt] = FR(0, mt * 4 + (q)); dst[4 + mt] = FR(32768, mt * 4 + (q)); } } while (0)
#define MM_KQ(src, q) do { _Pragma("unroll") for (int mt = 0; mt < 4; ++mt) { X[mt] = MF(src[mt], Sb[q], X[mt]); O[mt] = MF(src[4 + mt], Sb[q], O[mt]); } } while (0)
            f32x4 X[4], O[4], VN[4];
#pragma unroll
            for (int i = 0; i < 4; ++i) { X[i] = (f32x4){0.f, 0.f, 0.f, 0.f}; O[i] = (f32x4){0.f, 0.f, 0.f, 0.f}; VN[i] = (f32x4){0.f, 0.f, 0.f, 0.f}; }
            bf16x8 Sb[4];
#pragma unroll
            for (int q = 0; q < 4; ++q) Sb[q] = pack44(S[2 * q], S[2 * q + 1]);
            RD_KQ(fa, 0); SB_();
            RD_KQ(fb, 1); SB_(); MM_KQ(fa, 0); SB_();
            RD_KQ(fa, 2); SB_(); MM_KQ(fb, 1); SB_();
            RD_KQ(fb, 3); SB_(); MM_KQ(fa, 2); SB_();
#pragma unroll
            for (int i = 0; i < 8; ++i) fa[i] = FR(49152, i);
            SB_(); MM_KQ(fb, 3); SB_();
#pragma unroll
            for (int mt = 0; mt < 4; ++mt) { const unsigned w0 = (mt < 2 ? vc0 : vc1)[2 * (mt & 1)], w1 = (mt < 2 ? vc0 : vc1)[2 * (mt & 1) + 1];
                X[mt][0] = bflo(w0) - eg[mt][0] * X[mt][0]; X[mt][1] = bfhi(w0) - eg[mt][1] * X[mt][1]; X[mt][2] = bflo(w1) - eg[mt][2] * X[mt][2]; X[mt][3] = bfhi(w1) - eg[mt][3] * X[mt][3]; }
            const bf16x8 Yb0 = pack44(X[0], X[1]), Yb1 = pack44(X[2], X[3]);
            SB_();
#pragma unroll
            for (int i = 0; i < 8; ++i) fb[i] = FR(57344, i);
            SB_();
#pragma unroll
            for (int mt = 0; mt < 4; ++mt) { VN[mt] = MF(fa[mt * 2], Yb0, VN[mt]); VN[mt] = MF(fa[mt * 2 + 1], Yb1, VN[mt]); }
            SB_();
#pragma unroll
            for (int mt = 0; mt < 4; ++mt) O[mt] = O[mt] * eg[mt];
            const bf16x8 Vb0 = pack44(VN[0], VN[1]), Vb1 = pack44(VN[2], VN[3]);
            SB_();
#pragma unroll
            for (int i = 0; i < 8; ++i) fa[i] = FR(16384, i);
            SB_();
#pragma unroll
            for (int mt = 0; mt < 4; ++mt) { O[mt] = MF(fb[mt * 2], Vb0, O[mt]); O[mt] = MF(fb[mt * 2 + 1], Vb1, O[mt]); }
            SB_();
#pragma unroll
            for (int mt = 0; mt < 4; ++mt) VN[mt] = VN[mt] * dl[mt];
            const bf16x8 Vd0 = pack44(VN[0], VN[1]), Vd1 = pack44(VN[2], VN[3]);
#pragma unroll
            for (int i = 0; i < 8; ++i) S[i] = S[i] * egl;
            SB_();
#pragma unroll
            for (int i = 0; i < 8; ++i) fb[i] = FR(16384, 8 + i);
            SB_();
#pragma unroll
            for (int i = 0; i < 4; ++i) { S[i] = MF(fa[i * 2], Vd0, S[i]); S[i] = MF(fa[i * 2 + 1], Vd1, S[i]); }
            SB_();
#pragma unroll
            for (int i = 0; i < 4; ++i) { S[4 + i] = MF(fb[i * 2], Vd0, S[4 + i]); S[4 + i] = MF(fb[i * 2 + 1], Vd1, S[4 + i]); }
            SB_();
            {
                const int row0 = cidx < 4 ? ML + b * CT + cidx * 64 : b * T + (cidx - 4) * 64;
                float* op = Og + (size_t)(row0 + 4 * g4) * 512;
#pragma unroll
                for (int mt = 0; mt < 4; ++mt)
#pragma unroll
                    for (int t = 0; t < 4; ++t) { if (VAR != 1) op[(size_t)(16 * mt + t) * 512] = O[mt][t]; else asm volatile("" :: "v"(O[mt][t])); }
            }
#undef RD_KQ
#undef MM_KQ
#undef SB_
#undef FR
#undef MF
            asm volatile("s_waitcnt lgkmcnt(0)" ::: "memory"); __builtin_amdgcn_s_barrier(); asm volatile("" ::: "memory");
        }
    }
#undef CIDX
#undef a
}

__device__ __forceinline__ void phase_dn_out(int l) {
    const KArgs ap = get_args();
#define a (*ap)

    const int tid = fresh_tid(), lane = tid & 63, wave = __builtin_amdgcn_readfirstlane(tid >> 6), G = fresh_g(), bx = fresh_bx();
    unsigned char* ws = a.ws;
    const int nrows = (l == DEPTH - 1) ? ML : M;
    const float* OF = (const float*)(ws + WS_OF); const float* OB = (const float*)(ws + WS_OB);
    const bf16_t* P = (const bf16_t*)(ws + WS_P); bf16_t* CAT = (bf16_t*)(ws + WS_CAT);
    const f32x2 nw = *(const f32x2*)(a.in[I_DNW] + l * 128 + 2 * lane);
    const float* LSE = (const float*)(ws + WS_BA);
    for (int row = wave * G + bx; row < nrows; row += G * 8) {
        f32x2 of[4], ob[4]; unsigned gw[4];
#pragma unroll
        for (int hh = 0; hh < 4; ++hh) { of[hh] = *(const f32x2*)(OF + (size_t)row * 512 + hh * 128 + 2 * lane); ob[hh] = *(const f32x2*)(OB + (size_t)row * 512 + hh * 128 + 2 * lane);
            gw[hh] = *(const unsigned*)(P + (size_t)row * NP + 2560 + hh * 128 + 2 * lane); }
        u32x4 ap_[4]; float ls_[4];
#pragma unroll
        for (int p = 0; p < 4; ++p) { ap_[p] = (u32x4){0u, 0u, 0u, 0u}; ls_[p] = 0.f; }
        if (row < ML) {
            ap_[0] = *(const u32x4*)(CAT + (size_t)row * 1024 + 8 * lane); ap_[1] = *(const u32x4*)((const bf16_t*)(ws + WS_DQ) + (size_t)row * 512 + 8 * lane);
            ap_[2] = *(const u32x4*)((const bf16_t*)(ws + WS_DK) + (size_t)row * 512 + 8 * lane); ap_[3] = *(const u32x4*)((const bf16_t*)(ws + WS_DV) + (size_t)row * 512 + 8 * lane);
#pragma unroll
            for (int p = 0; p < 4; ++p) ls_[p] = LSE[((size_t)p * ML + row) * 4 + (lane >> 4)]; }
        float o0[4], o1[4], ssq[4];
#pragma unroll
        for (int hh = 0; hh < 4; ++hh) { o0[hh] = of[hh][0] + ob[hh][0]; o1[hh] = of[hh][1] + ob[hh][1]; ssq[hh] = o0[hh] * o0[hh] + o1[hh] * o1[hh]; }
#pragma unroll
        for (int hh = 0; hh < 4; ++hh) ssq[hh] = wave_sum(ssq[hh]);
#pragma unroll
        for (int hh = 0; hh < 4; ++hh) { const float rs = rsqrtf(ssq[hh] * (1.f / 128.f) + EPS); const float g0 = bflo(gw[hh]), g1 = bfhi(gw[hh]);
            *(unsigned*)(CAT + (size_t)row * 1024 + 512 + hh * 128 + 2 * lane) = pkbf(o0[hh] * rs * nw[0] * silu_f(g0), o1[hh] * rs * nw[1] * silu_f(g1)); }
        if (row < ML) { const float mx = fmaxf(fmaxf(ls_[0], ls_[1]), fmaxf(ls_[2], ls_[3]));
            float w_[4], wsum = 0.f;
#pragma unroll
            for (int p = 0; p < 4; ++p) { w_[p] = __expf(ls_[p] - mx); wsum += w_[p]; }
            const float inv = 1.f / wsum;
            u32x4 r;
#pragma unroll
            for (int i = 0; i < 4; ++i) { float lo = 0.f, hi2 = 0.f;
#pragma unroll
                for (int p = 0; p < 4; ++p) { lo = fmaf(w_[p], bflo(ap_[p][i]), lo); hi2 = fmaf(w_[p], bfhi(ap_[p][i]), hi2); }
                r[i] = pkbf(lo * inv, hi2 * inv); }
            *(u32x4*)(CAT + (size_t)row * 1024 + 8 * lane) = r; }
    }
#undef a
}

#define CE_DESC(a_, b_) do { const float hi_ = fmaxf(a_, b_), lo_ = fminf(a_, b_); a_ = hi_; b_ = lo_; } while (0)
__device__ __forceinline__ void bitonic_sort16_desc(float (&v)[16]) {
#pragma unroll
    for (int k = 2; k <= 16; k <<= 1)
#pragma unroll
        for (int j = k >> 1; j > 0; j >>= 1)
#pragma unroll
            for (int i = 0; i < 16; ++i) { const int p = i ^ j; if (p > i) { if ((i & k) == 0) CE_DESC(v[i], v[p]); else CE_DESC(v[p], v[i]); } }
}
__device__ __forceinline__ void merge_top16_desc(float (&lst)[16], const float (&nw)[16]) {
#pragma unroll
    for (int i = 0; i < 16; ++i) lst[i] = fmaxf(lst[i], nw[15 - i]);
#pragma unroll
    for (int j = 8; j > 0; j >>= 1)
#pragma unroll
        for (int i = 0; i < 16; ++i) { const int p = i ^ j; if (p > i) CE_DESC(lst[i], lst[p]); }
}
__device__ __forceinline__ void phase_peer_select(int l) {
    const KArgs ap = get_args();
#define a (*ap)
    const int tid = fresh_tid(), lane = tid & 63, wave = __builtin_amdgcn_readfirstlane(tid >> 6), G = fresh_g(), bx = fresh_bx();
    unsigned char* ws = a.ws;
    const int nrows = (l == DEPTH - 1) ? ML : M;
    const int ntask = (nrows / 32) * 4;
    const bf16_t* Q2 = (const bf16_t*)(ws + WS_P);
    const bf16_t* SKB = (const bf16_t*)(ws + WS_SKB) + (size_t)l * 8 * 2 * 128 * 128;
    int* PIDX = (int*)(ws + WS_PIDX); float* PGATE = (float*)(ws + WS_PGATE);
    const float NEG = -3.0e38f;
    const int r = lane & 31, hi = lane >> 5;
    for (int task = wave * G + bx; task < ntask; task += G * 8) {
        const int tg = task >> 2, hp = task & 3; const int row = tg * 32 + r;
        float mine0[16], mine1[16];
#pragma unroll
        for (int j = 0; j < 16; ++j) { mine0[j] = NEG; mine1[j] = NEG; }
        bf16x8 qA[8], kA[8], kB[8];
        float lst[16];
#define SEL_QPTR(it_) (Q2 + (size_t)row * 2048 + (2 * hp + ((it_) >> 1)) * 256 + ((it_) & 1) * 128 + 8 * hi)
#define SEL_KPTR(it_, t_) (SKB + (size_t)(((2 * hp + ((it_) >> 1)) * 2 + ((it_) & 1)) * 128 + 32 * (t_) + r) * 128 + 8 * hi)
#define SEL_LDQ(dst, it_) do { const bf16_t* qp_ = SEL_QPTR(it_); _Pragma("unroll") for (int ks = 0; ks < 8; ++ks) dst[ks] = *(const bf16x8*)(qp_ + 16 * ks); } while (0)
#define SEL_LDK(dst, it_, t_) do { const bf16_t* kp_ = SEL_KPTR(it_, t_); _Pragma("unroll") for (int ks = 0; ks < 8; ++ks) dst[ks] = *(const bf16x8*)(kp_ + 16 * ks); } while (0)
#define SEL_RANK(qv, kv, t_) do { f32x16 acc = {}; _Pragma("unroll") for (int ks = 0; ks < 8; ++ks) acc = __builtin_amdgcn_mfma_f32_32x32x16_bf16(kv[ks], qv[ks], acc, 0, 0, 0); \
            const unsigned kb = (unsigned)(32 * (t_) + 4 * hi); float nw_[16]; \
            _Pragma("unroll") for (int i = 0; i < 16; ++i) nw_[i] = __uint_as_float((__float_as_uint(acc[i]) & 0xffffff80u) | (kb + (unsigned)((i & 3) + 8 * (i >> 2)))); \
            bitonic_sort16_desc(nw_); merge_top16_desc(lst, nw_); } while (0)
#define SB_() __builtin_amdgcn_sched_barrier(0)
#pragma unroll
        for (int j = 0; j < 16; ++j) lst[j] = NEG;
        SEL_LDK(kA, 0, 0);
#pragma unroll 1
        for (int it = 0; it < 4; ++it) {
            const int itn = it < 3 ? it + 1 : 3;
            SEL_LDQ(qA, it); SEL_LDK(kB, it, 1); SB_(); SEL_RANK(qA, kA, 0); SB_();
            SEL_LDK(kA, it, 2); SB_();                  SEL_RANK(qA, kB, 1); SB_();
            SEL_LDK(kB, it, 3); SB_();                  SEL_RANK(qA, kA, 2); SB_();
            SEL_LDK(kA, itn, 0); SB_();                 SEL_RANK(qA, kB, 3); SB_();
            float oth[16];
#pragma unroll
            for (int j = 0; j < 16; ++j) { auto rr = __builtin_amdgcn_permlane32_swap(__float_as_uint(lst[j]), __float_as_uint(lst[j]), false, false); oth[j] = __uint_as_float(hi ? rr[0] : rr[1]); }
            merge_top16_desc(lst, oth);
            const bool k0 = ((it >> 1) == hi) && ((it & 1) == 0), k1 = ((it >> 1) == hi) && ((it & 1) == 1);
#pragma unroll
            for (int j = 0; j < 16; ++j) { mine0[j] = k0 ? lst[j] : mine0[j]; mine1[j] = k1 ? lst[j] : mine1[j]; lst[j] = NEG; }
        }
#undef SB_
#undef SEL_QPTR
#undef SEL_KPTR
#undef SEL_LDQ
#undef SEL_LDK
#undef SEL_RANK
        const int h = 2 * hp + hi;
        float ts[16];
#pragma unroll
        for (int j = 0; j < 16; ++j) ts[j] = NEG;
#pragma unroll
        for (int i = 0; i < 16; ++i)
#pragma unroll
            for (int j = 0; j < 16; ++j) if ((i + 1) * (j + 1) <= 16) {
                const unsigned b0 = __float_as_uint(mine0[i]), b1 = __float_as_uint(mine1[j]);
                const float c = __uint_as_float(b0 & 0xffffff80u) + __uint_as_float(b1 & 0xffffff80u);
                float x = __uint_as_float((__float_as_uint(c) & 0xffffc000u) | ((b0 & 127u) << 7) | (b1 & 127u));
#pragma unroll
                for (int t = 0; t < 16; ++t) { const float hv = fmaxf(ts[t], x); x = fminf(ts[t], x); ts[t] = hv; }
            }
        int te[16]; float ex[16], sum = 0.f;
        const float tmax = __uint_as_float(__float_as_uint(ts[0]) & 0xffffc000u);
#pragma unroll
        for (int t = 0; t < 16; ++t) { const unsigned bt = __float_as_uint(ts[t]); te[t] = (int)(bt & 0x3fffu); ex[t] = __expf(__uint_as_float(bt & 0xffffc000u) - tmax); sum += ex[t]; }
        const float inv = 1.f / sum;
        int* ip = PIDX + (size_t)row * 128 + h * 16; float* gp = PGATE + (size_t)row * 128 + h * 16;
#pragma unroll
        for (int t = 0; t < 16; t += 4) { *(u32x4*)(ip + t) = (u32x4){(unsigned)te[t], (unsigned)te[t + 1], (unsigned)te[t + 2], (unsigned)te[t + 3]}; *(f32x4*)(gp + t) = (f32x4){ex[t] * inv, ex[t + 1] * inv, ex[t + 2] * inv, ex[t + 3] * inv}; }
    }
#undef a
}

template <bool WR, int GV = 0>
__device__ __forceinline__ void phase_peer_gather(int l, LAS unsigned char* lds) {
    const KArgs ap = get_args();
#define a (*ap)
    const int tid = fresh_tid(), lane = tid & 63, wave = __builtin_amdgcn_readfirstlane(tid >> 6), G = fresh_g(), bx = fresh_bx();
    unsigned char* ws = a.ws;
    const int nrows = (l == DEPTH - 1) ? ML : M;
    const unsigned char* UB = ws + WS_UB + (size_t)(l & 1) * TAB_SET; const unsigned char* VB = UB + 1024;
    const float* USC = (const float*)(ws + WS_USC) + (l & 1) * 2 * NEXP; const float* VSC = USC + NEXP;
    const int* PIDX = (const int*)(ws + WS_PIDX); const float* PGATE = (const float*)(ws + WS_PGATE);
    const float* modl = (const float*)(ws + WS_MOD) + (size_t)l * 3 * 6144 + 5120;
    const bool fuse = WR && (l + 1 < DEPTH);
    LAS float* wsk = (LAS float*)lds;
    if (fuse) { const float* src = (const float*)(ws + WS_WSK) + (size_t)(l + 1) * 16384; for (int i = tid; i < 16384 / 4; i += 512) ((LAS f32x4*)wsk)[i] = ((const f32x4*)src)[i]; __syncthreads(); }
    const float* nw1 = a.in[I_N1W] + (l + 1 < DEPTH ? l + 1 : l) * 1024 + 16 * lane;
    const float* modn = (const float*)(ws + WS_MOD) + (size_t)(l + 1 < DEPTH ? l + 1 : l) * 3 * 6144;
    for (int row = wave * G + bx; row < nrows; row += G * 8) {
        float hv[16], out[16];
        { const u32x4* hp = (const u32x4*)((const bf16_t*)(ws + WS_H) + (size_t)row * D + 16 * lane); const u32x4 w0 = hp[0], w1 = hp[1];
          hv[0] = bflo(w0.x); hv[1] = bfhi(w0.x); hv[2] = bflo(w0.y); hv[3] = bfhi(w0.y); hv[4] = bflo(w0.z); hv[5] = bfhi(w0.z); hv[6] = bflo(w0.w); hv[7] = bfhi(w0.w);
          hv[8] = bflo(w1.x); hv[9] = bfhi(w1.x); hv[10] = bflo(w1.y); hv[11] = bfhi(w1.y); hv[12] = bflo(w1.z); hv[13] = bfhi(w1.z); hv[14] = bflo(w1.w); hv[15] = bfhi(w1.w); }
        float hs = 0.f;
#pragma unroll
        for (int i = 0; i < 16; ++i) { out[i] = 0.f; hs += hv[i]; }
        const float hsum128 = 128.f * wave_sum(hs);
        float wacc = 0.f;
        const int id0 = PIDX[(size_t)row * 128 + lane], id1 = PIDX[(size_t)row * 128 + 64 + lane];
        const float gt0 = PGATE[(size_t)row * 128 + lane], gt1 = PGATE[(size_t)row * 128 + 64 + lane];
        const float us0 = USC[id0], us1 = USC[id1], vs0 = VSC[id0], vs1 = VSC[id1];
        for (int e0 = 0; e0 < 128; e0 += 8) {
            u32x4 uw[8], vw[8]; float gte[8], use[8], vse[8];
#pragma unroll
            for (int j = 0; j < 8; ++j) { const int e = e0 + j; const int id = __builtin_amdgcn_readlane(e0 < 64 ? id0 : id1, e & 63);
                gte[j] = __builtin_bit_cast(float, __builtin_amdgcn_readlane(__builtin_bit_cast(int, e0 < 64 ? gt0 : gt1), e & 63));
                use[j] = __builtin_bit_cast(float, __builtin_amdgcn_readlane(__builtin_bit_cast(int, e0 < 64 ? us0 : us1), e & 63));
                vse[j] = __builtin_bit_cast(float, __builtin_amdgcn_readlane(__builtin_bit_cast(int, e0 < 64 ? vs0 : vs1), e & 63));
                uw[j] = *(const u32x4*)(UB + (size_t)id * 2048 + 16 * lane); vw[j] = *(const u32x4*)(VB + (size_t)id * 2048 + 16 * lane); }
#pragma unroll
            for (int j = 0; j < 8; ++j) {
                float d0 = 0.f, d1 = 0.f;
#pragma unroll
                for (int q = 0; q < 4; ++q) { const unsigned w = uw[j][q];
                    d0 = fmaf((float)(w & 255u), hv[4 * q + 0], d0); d1 = fmaf((float)((w >> 8) & 255u), hv[4 * q + 1], d1);
                    d0 = fmaf((float)((w >> 16) & 255u), hv[4 * q + 2], d0); d1 = fmaf((float)(w >> 24), hv[4 * q + 3], d1); }
                const float dsum = (wave_sum(d0 + d1) - hsum128) * use[j];
                const float act = 0.5f * dsum * (1.f + erff(dsum * 0.70710678118654752f));
                const float wgt = gte[j] * act * vse[j];
                wacc += wgt;
                if (GV == 1) { asm volatile("" :: "v"(vw[j])); out[0] += wgt; } else
#pragma unroll
                for (int q = 0; q < 4; ++q) { const unsigned w = vw[j][q];
                    out[4 * q + 0] = fmaf(wgt, (float)(w & 255u), out[4 * q + 0]); out[4 * q + 1] = fmaf(wgt, (float)((w >> 8) & 255u), out[4 * q + 1]);
                    out[4 * q + 2] = fmaf(wgt, (float)((w >> 16) & 255u), out[4 * q + 2]); out[4 * q + 3] = fmaf(wgt, (float)(w >> 24), out[4 * q + 3]); }
            }
        }
        const float corr = 128.f * wacc;
        float* xr; int mrow;
        if (row < ML) { xr = a.out + (size_t)row * D; mrow = row >= T ? 1 : 0; } else { xr = (float*)(ws + WS_CTXX) + (size_t)(row - ML) * D; mrow = 2; }
        const float* g2 = modl + mrow * 6144 + 16 * lane;
        f32x4 xn[4];
#pragma unroll
        for (int i = 0; i < 4; ++i) { const f32x4 x = *(const f32x4*)(xr + 16 * lane + 4 * i), g = *(const f32x4*)(g2 + 4 * i);
            xn[i] = x + g * (f32x4){out[4 * i] - corr, out[4 * i + 1] - corr, out[4 * i + 2] - corr, out[4 * i + 3] - corr};
            if (WR) *(f32x4*)(xr + 16 * lane + 4 * i) = xn[i]; else asm volatile("" :: "v"(xn[i])); }
        if (fuse) {
            float ss = 0.f;
#pragma unroll
            for (int i = 0; i < 4; ++i) ss += (xn[i][0] * xn[i][0] + xn[i][1] * xn[i][1]) + (xn[i][2] * xn[i][2] + xn[i][3] * xn[i][3]);
            const float rstd = rsqrtf(wave_sum(ss) * (1.f / D) + EPS);
            const float* md = modn + mrow * 6144 + 16 * lane;
            bf16_t* hrow = (bf16_t*)(ws + WS_H) + (size_t)row * D + 16 * lane;
#pragma unroll
            for (int i = 0; i < 4; ++i) { const f32x4 nwv = *(const f32x4*)(nw1 + 4 * i), sc = *(const f32x4*)(md + 1024 + 4 * i), sh = *(const f32x4*)(md + 4 * i);
                xn[i] = xn[i] * rstd * nwv * (sc + 1.f) + sh; }
            { u32x4 o0, o1; o0.x = pkbf(xn[0][0], xn[0][1]); o0.y = pkbf(xn[0][2], xn[0][3]); o0.z = pkbf(xn[1][0], xn[1][1]); o0.w = pkbf(xn[1][2], xn[1][3]);
              o1.x = pkbf(xn[2][0], xn[2][1]); o1.y = pkbf(xn[2][2], xn[2][3]); o1.z = pkbf(xn[3][0], xn[3][1]); o1.w = pkbf(xn[3][2], xn[3][3]);
              *(u32x4*)hrow = o0; *(u32x4*)(hrow + 8) = o1; }
            float p[16];
#pragma unroll
            for (int c = 0; c < 16; ++c) { float q = 0.f;
#pragma unroll
                for (int i = 0; i < 4; ++i) { const f32x4 w = *(const LAS f32x4*)(wsk + c * 1024 + 16 * lane + 4 * i); q += (xn[i][0] * w[0] + xn[i][1] * w[1]) + (xn[i][2] * w[2] + xn[i][3] * w[3]); }
                p[c] = q; }
            { const bool hb = (lane & 32) != 0;
#pragma unroll
              for (int c = 0; c < 8; ++c) { const float keep = hb ? p[c + 8] : p[c], send = hb ? p[c] : p[c + 8]; p[c] = keep + lane_xor<32>(send); } }
            { const bool hb = (lane & 16) != 0;
#pragma unroll
              for (int c = 0; c < 4; ++c) { const float keep = hb ? p[c + 4] : p[c], send = hb ? p[c] : p[c + 4]; p[c] = keep + lane_xor<16>(send); } }
            { const bool hb = (lane & 8) != 0;
#pragma unroll
              for (int c = 0; c < 2; ++c) { const float keep = hb ? p[c + 2] : p[c], send = hb ? p[c] : p[c + 2]; p[c] = keep + lane_xor<8>(send); } }
            { const bool hb = (lane & 4) != 0; const float keep = hb ? p[1] : p[0], send = hb ? p[0] : p[1]; p[0] = keep + lane_xor<4>(send); }
            p[0] += lane_xor<2>(p[0]); p[0] += lane_xor<1>(p[0]);
            if ((lane & 3) == 0) { const int c = ((lane >> 5) & 1) * 8 + ((lane >> 4) & 1) * 4 + ((lane >> 3) & 1) * 2 + ((lane >> 2) & 1); ((float*)(ws + WS_BA))[(size_t)row * 16 + c] = p[0]; }
        }
    }
    if (fuse) __syncthreads();
}
#undef a
__global__ void __launch_bounds__(512, 2) fwd(Args a) {
    extern __shared__ __attribute__((aligned(16))) unsigned char lds_raw[];
    LAS unsigned char* lds = (LAS unsigned char*)lds_raw;
    volatile LAS unsigned* MISC = (volatile LAS unsigned*)(lds + LDS_MISC);
    if (threadIdx.x < 16) MISC[threadIdx.x] = 0u;
    __syncthreads();
    XcdBarrier bar; bar.bar = (unsigned*)(a.ws + WS_CTL) + 4096; bar.x = 0; bar.st = MISC + 8;
    bar = xcd_barrier_post((unsigned*)(a.ws + WS_CTL) + 4096, MISC + 8);
#ifndef PHASE_MASK
#define PHASE_MASK 0x1FFF
#endif
#define EN(i) ((PHASE_MASK >> (i)) & 1)
#ifndef REP_MASK
#define REP_MASK 0
#endif
#define REPN(i) (1 + ((REP_MASK >> (i)) & 1))
#define IN(k) true
#define SEAM(k) do { XcdBarrier b_; b_.bar = (unsigned*)(get_args()->ws + WS_CTL) + 4096; b_.x = xb_xcc_id(); b_.st = (volatile LAS unsigned*)(lds + LDS_MISC) + 8; xcd_barrier(b_); } while (0)
    for (int rep_ = 0; rep_ < (REPN(0)); ++rep_) if (EN(0) && IN(0)) phase_prologue(lds);
    SEAM(0);
#pragma unroll 1
    for (int l_ = 0; l_ < DEPTH; ++l_) {
        int l = l_; asm volatile("" : "+s"(l));
        const int pb = 1 + l * NPH_L;
        const int mrows = (l == DEPTH - 1) ? ML : M;
        if (l == 0) { for (int rep_ = 0; rep_ < (REPN(1)); ++rep_) if (EN(1) && IN(pb + 0)) phase_norm<true>(l, 0, lds);
            SEAM(pb + 0); }
        for (int rep_ = 0; rep_ < (REPN(2)); ++rep_) if (EN(2) && IN(pb + 1)) { const KArgs ap = get_args(); unsigned char* ws = ap->ws; pg8::Gemm g{(const bf16_t*)(ws + WS_H), (const bf16_t*)(ws + WS_WINT) + (size_t)l * NP * 1024, M, NP, 1024}; pg8::StaticOrder S; S.init(M, NP, fresh_g(), fresh_bx());
            pg8::EpiBf16 E{(bf16_t*)(ws + WS_P), NP}; pg8::gemm_phase(lds, g, S, E); }
        SEAM(pb + 1);
        for (int rep_ = 0; rep_ < (REPN(3)); ++rep_) if (EN(3) && IN(pb + 2)) { phase_dn_chunkprep<1>(l, lds); phase_prep(l, lds); }
        for (int rep_ = 0; rep_ < (REPN(4)); ++rep_) if (EN(4) && IN(pb + 3)) phase_dn_chunkprep<0>(l, lds);
        SEAM(pb + 3);
        for (int rep_ = 0; rep_ < (REPN(5)); ++rep_) if (EN(5) && IN(pb + 4)) { phase_dn_scan<0>(l, lds); __syncthreads(); phase_attn(l, lds_raw, MISC, rep_); }
        SEAM(pb + 4);
        for (int rep_ = 0; rep_ < (REPN(7)); ++rep_) if (EN(7) && IN(pb + 5)) phase_dn_out(l);
        SEAM(pb + 5);
        if (EN(8) && IN(pb + 6)) { const KArgs ap = get_args(); unsigned char* ws = ap->ws; pg8::Gemm g{(const bf16_t*)(ws + WS_CAT), (const bf16_t*)(ws + WS_WOUTT) + (size_t)l * 1024 * 1024, mrows, 1024, 1024}; pg8::StaticOrder S; S.init(mrows, 1024, fresh_g(), fresh_bx());
            pg8::EpiRes E{l == 0 ? ap->in[I_X] : ap->out, l == 0 ? ap->in[I_CTX] : (const float*)(ws + WS_CTXX), ap->out, (float*)(ws + WS_CTXX), (const float*)(ws + WS_MOD) + (size_t)l * 3 * 6144 + 2048};
            pg8::gemm_phase(lds, g, S, E); }
        SEAM(pb + 6);
        for (int rep_ = 0; rep_ < (REPN(9)); ++rep_) if (EN(9) && IN(pb + 7)) phase_norm<false>(l, 1, lds);
        SEAM(pb + 7);
        for (int rep_ = 0; rep_ < (REPN(10)); ++rep_) if (EN(10) && IN(pb + 8)) { const KArgs ap = get_args(); unsigned char* ws = ap->ws; pg8::Gemm g{(const bf16_t*)(ws + WS_H), (const bf16_t*)(ws + WS_WQT) + (size_t)l * 2048 * 1024, mrows, 2048, 1024}; pg8::StaticOrder S; S.init(mrows, 2048, fresh_g(), fresh_bx());
            pg8::EpiBf16 E{(bf16_t*)(ws + WS_P), 2048}; pg8::gemm_phase(lds, g, S, E); }
        SEAM(pb + 8);
        for (int rep_ = 0; rep_ < (REPN(11)); ++rep_) if (EN(11) && IN(pb + 9)) phase_peer_select(l);
        SEAM(pb + 9);
        #ifdef GATHER_VAR
        if (EN(12) && IN(pb + 10)) phase_peer_gather<false, GATHER_VAR>(l, lds);
#endif
        if (REPN(12) > 1 && EN(12) && IN(pb + 10)) phase_peer_gather<false>(l, lds);
        if (EN(12) && IN(pb + 10)) phase_peer_gather<true>(l, lds);
        if (l + 1 < DEPTH) SEAM(pb + 10);
    }
#undef IN
#undef SEAM
}

#ifndef N_LAUNCH_MODE
#define N_LAUNCH_MODE 1
#endif
extern "C" void kernel_launch(void* const* d_in, const int* in_sizes, int n_in, void* d_out, int out_size, void* d_ws, size_t ws_size, hipStream_t stream) {
    static int grid = 0;
    if (grid == 0) {
        if (n_in != 20 || out_size != ML * D || ws_size < WS_END) { fprintf(stderr, "kernel_launch: unexpected shapes: n_in %d out %d ws %zu (need %zu)\n", n_in, out_size, ws_size, (size_t)WS_END); grid = -1; return; }
        int dev = 0, cus = 0, per_cu = 0;
        if (hipGetDevice(&dev) != hipSuccess || hipDeviceGetAttribute(&cus, hipDeviceAttributeMultiprocessorCount, dev) != hipSuccess) { grid = -1; return; }
        if (hipFuncSetAttribute((const void*)fwd, hipFuncAttributeMaxDynamicSharedMemorySize, LDS_BYTES) != hipSuccess) { fprintf(stderr, "kernel_launch: hipFuncSetAttribute failed\n"); grid = -1; return; }
        if (hipOccupancyMaxActiveBlocksPerMultiprocessor(&per_cu, (const void*)fwd, 512, LDS_BYTES) != hipSuccess || per_cu < 1) fprintf(stderr, "kernel_launch: occupancy query says %d\n", per_cu);
        (void)hipGetLastError();
        grid = cus;
    }
    if (grid < 0) return;
    (void)hipMemsetAsync((char*)d_ws + WS_CTL, 0, CTL_BYTES, stream);
    Args a{};
    for (int i = 0; i < 20; ++i) a.in[i] = (const float*)d_in[i];
    a.out = (float*)d_out; a.ws = (unsigned char*)d_ws;
    a.ph_lo = 0; a.ph_hi = NPHASE;
    hipLaunchKernelGGL(fwd, dim3(grid), dim3(512), LDS_BYTES, stream, a);
    const hipError_t le = hipPeekAtLastError();
    if (le != hipSuccess) fprintf(stderr, "kernel_launch: launch failed: %s\n", hipGetErrorName(le));
}
```

```cpp
#include <hip/hip_runtime.h>
#include <cstdio>
#include <cstdint>

#define GAS __attribute__((address_space(1)))
#define LAS __attribute__((address_space(3)))
typedef unsigned short bf16_t;
typedef short bf16x8 __attribute__((ext_vector_type(8)));
typedef short s16x4 __attribute__((ext_vector_type(4)));
typedef float f32x4 __attribute__((ext_vector_type(4)));
typedef float f32x2 __attribute__((ext_vector_type(2)));
typedef float f32x16 __attribute__((ext_vector_type(16)));
typedef unsigned u32x4 __attribute__((ext_vector_type(4)));
typedef unsigned u32x2 __attribute__((ext_vector_type(2)));
typedef int i32x4 __attribute__((ext_vector_type(4)));

constexpr int D = 1024, NB = 2, T = 16384, DEPTH = 4, CT = 256;
constexpr int ML = NB * T, MC = NB * CT, M = ML + MC;
constexpr int NIN = 3088, NP = 3072;
constexpr int KVLEN = T + CT;
constexpr int NEXP = 16384;
constexpr float EPS = 1e-6f;
constexpr int NPH_L = 11;
constexpr int NPHASE = 1 + DEPTH * NPH_L;

constexpr size_t MiB = 1u << 20;
constexpr size_t WS_CTL = 0, CTL_BYTES = 1 * MiB;
constexpr size_t WS_MOD = 1 * MiB;
constexpr size_t WS_ROPE = 2 * MiB;
constexpr size_t WS_WSK = 3 * MiB;
constexpr size_t WS_CTXX = 4 * MiB;
constexpr size_t WS_WINT = 8 * MiB;
constexpr size_t WS_WOUTT = 32 * MiB;
constexpr size_t WS_WQT = 40 * MiB;
constexpr size_t WS_SKB = 56 * MiB;
constexpr size_t WS_USC = 58 * MiB;
constexpr size_t WS_UB = 64 * MiB;
constexpr size_t WS_VB = 80 * MiB;
constexpr size_t TAB_SET = 32 * MiB;
constexpr size_t WS_H = 128 * MiB;
static_assert(WS_H + 2 * (size_t)M * 1024 <= 193 * MiB, "H + concat int8");
constexpr size_t WS_CATQ = WS_H + (size_t)M * 1024;
constexpr size_t WS_P = 193 * MiB;
constexpr size_t WS_QA = 388 * MiB;
constexpr size_t WS_KA = 421 * MiB;
constexpr size_t WS_VA = 438 * MiB;
constexpr size_t WS_CAT = 455 * MiB;
constexpr size_t WS_DQ = 520 * MiB;
constexpr size_t WS_DK = 553 * MiB;
constexpr size_t WS_DV = 586 * MiB;
constexpr size_t WS_OF = 619 * MiB;
constexpr size_t WS_OB = 684 * MiB;
constexpr size_t WS_GB = 749 * MiB;
constexpr size_t WS_BA = 752 * MiB;
constexpr size_t WS_PIDX = 755 * MiB;
constexpr size_t WS_PGATE = 772 * MiB;
constexpr size_t WS_REC = 789 * MiB;
constexpr size_t WS_END = 990 * MiB;
constexpr int CW_WMAX = 65536;
constexpr int NCH = 260;
constexpr int REC_K = 0, REC_KT = 16384, REC_Q = 32768, REC_V = 49152, REC_DIR = 65536, REC_DIRSZ = 17408, REC_BYTES = REC_DIR + 2 * REC_DIRSZ;
static_assert((size_t)NB * 4 * NCH * REC_BYTES + WS_REC <= WS_END, "rec region");

constexpr int LDS_BYTES = 163840;
constexpr int LDS_MISC = 163840 - 256;

__device__ __forceinline__ float bf2f(unsigned b) { return __uint_as_float(b << 16); }
__device__ __forceinline__ float bflo(unsigned w) { return __uint_as_float(w << 16); }
__device__ __forceinline__ float bfhi(unsigned w) { return __uint_as_float(w & 0xffff0000u); }
typedef __bf16 bf2v __attribute__((ext_vector_type(2)));
__device__ __forceinline__ unsigned pkbf(float lo, float hi) { unsigned r; asm("v_cvt_pk_bf16_f32 %0, %1, %2" : "=v"(r) : "v"(lo), "v"(hi)); return r; }
__device__ __forceinline__ unsigned pkbf_c(float lo, float hi) { f32x2 v = {lo, hi}; bf2v r = __builtin_convertvector(v, bf2v); return __builtin_bit_cast(unsigned, r); }
template <int K> __device__ __forceinline__ float lane_xor(float v) {
    const int b = __builtin_bit_cast(int, v);
    if constexpr (K == 1) return __builtin_bit_cast(float, __builtin_amdgcn_update_dpp(0, b, 0xB1, 0xF, 0xF, true));
    else if constexpr (K == 2) return __builtin_bit_cast(float, __builtin_amdgcn_update_dpp(0, b, 0x4E, 0xF, 0xF, true));
    else if constexpr (K == 32) { auto rr = __builtin_amdgcn_permlane32_swap((unsigned)b, (unsigned)b, false, false); unsigned ln_ = __builtin_amdgcn_mbcnt_hi(~0u, __builtin_amdgcn_mbcnt_lo(~0u, 0u)); asm volatile("" : "+v"(ln_));
        return __uint_as_float((ln_ & 32u) ? rr[0] : rr[1]); }
    else return __builtin_bit_cast(float, __builtin_amdgcn_ds_swizzle(b, 0x1F | (K << 10)));
}
__device__ __forceinline__ float wave_sum(float v) {
    v += lane_xor<1>(v); v += lane_xor<2>(v);
    v += __builtin_bit_cast(float, __builtin_amdgcn_update_dpp(0, __builtin_bit_cast(int, v), 0x124, 0xF, 0xF, true));
    v += __builtin_bit_cast(float, __builtin_amdgcn_update_dpp(0, __builtin_bit_cast(int, v), 0x128, 0xF, 0xF, true));
    v += lane_xor<16>(v);
    { auto rr = __builtin_amdgcn_permlane32_swap(__float_as_uint(v), __float_as_uint(v), false, false); v = __uint_as_float(rr[0]) + __uint_as_float(rr[1]); }
    return v;
}
__device__ __forceinline__ float wave_max(float v) {
    v = fmaxf(v, lane_xor<1>(v)); v = fmaxf(v, lane_xor<2>(v));
    v = fmaxf(v, __builtin_bit_cast(float, __builtin_amdgcn_update_dpp(0, __builtin_bit_cast(int, v), 0x124, 0xF, 0xF, true)));
    v = fmaxf(v, __builtin_bit_cast(float, __builtin_amdgcn_update_dpp(0, __builtin_bit_cast(int, v), 0x128, 0xF, 0xF, true)));
    v = fmaxf(v, lane_xor<16>(v));
    { auto rr = __builtin_amdgcn_permlane32_swap(__float_as_uint(v), __float_as_uint(v), false, false); v = fmaxf(__uint_as_float(rr[0]), __uint_as_float(rr[1])); }
    return v;
}
__device__ __forceinline__ float silu_f(float x) { return x / (1.f + __expf(-x)); }
#define LDS_WAIT() asm volatile("s_waitcnt lgkmcnt(0)" ::: "memory")

#define XB_TMO      128
#define XB_XCNT(j)  (256  + 64 * (j))
#define XB_XSUB(j)  (1280 + 64 * (j))
#define XB_XGEN(j)  (2304 + 64 * (j))
#define XB_TOP      3328
#define XB_TOPGEN   3392
#define XCD_BAR_WORDS 3456
#define XB_SPIN_CAP (1u << 22)
__device__ __forceinline__ unsigned xb_ld(unsigned* p)              { return __hip_atomic_load(p, __ATOMIC_RELAXED, __HIP_MEMORY_SCOPE_AGENT); }
__device__ __forceinline__ unsigned xb_add(unsigned* p, unsigned v) { return __hip_atomic_fetch_add(p, v, __ATOMIC_RELAXED, __HIP_MEMORY_SCOPE_AGENT); }
__device__ __forceinline__ unsigned xb_xcc_id() { return (unsigned)__builtin_amdgcn_s_getreg((3 << 11) | 20) & 0xFu; }
#define XB_SPIN(cond, bar) do { unsigned _sp = 0; while (cond) { __builtin_amdgcn_s_sleep(1); \
    if ((++_sp & 255u) == 0u) { if (xb_ld(&(bar)[XB_TMO])) break; if (_sp > XB_SPIN_CAP) { atomicAdd(&(bar)[XB_TMO], 1u); break; } } } } while (0)
struct XcdBarrier { unsigned* bar; unsigned x; volatile LAS unsigned* st; };
__device__ __forceinline__ XcdBarrier xcd_barrier_post(unsigned* bar, volatile LAS unsigned* st) {
    XcdBarrier b; b.bar = bar; b.x = xb_xcc_id(); b.st = st;
    if (threadIdx.x == 0) (void)xb_add(&bar[XB_XCNT(b.x)], 1u);
    return b;
}
__device__ __forceinline__ void xcd_barrier_complete(unsigned* bar, unsigned x, unsigned& nloc, unsigned& nx) {
    const unsigned G = gridDim.x * gridDim.y * gridDim.z;
    unsigned sum, cnt, mine, sp = 0u;
    for (;;) {
        sum = 0u; cnt = 0u; mine = 0u;
#pragma unroll
        for (unsigned j = 0; j < 16; ++j) { const unsigned c = xb_ld(&bar[XB_XCNT(j)]); sum += c; cnt += (c > 0u) ? 1u : 0u; mine = (j == x) ? c : mine; }
        if (sum == G) break;
        __builtin_amdgcn_s_sleep(1);
        if ((++sp & 255u) == 0u) { if (xb_ld(&bar[XB_TMO])) break; if (sp > XB_SPIN_CAP) { atomicAdd(&bar[XB_TMO], 1u); break; } }
    }
    nloc = mine > 0u ? mine : 1u; nx = cnt > 0u ? cnt : 1u;
}
__device__ __forceinline__ void xcd_barrier(const XcdBarrier& b) {
    asm volatile("s_waitcnt vmcnt(0)" ::: "memory");
    __syncthreads();
    if (threadIdx.x == 0) {
        unsigned* bar = b.bar; unsigned bx_ = b.x;
        asm volatile("" : "+s"(bar), "+s"(bx_));
        __builtin_amdgcn_s_waitcnt(0);
        unsigned nloc = b.st[0], nx = b.st[1];
        if (nloc == 0u) { xcd_barrier_complete(bar, bx_, nloc, nx); b.st[0] = nloc; b.st[1] = nx; }
        const unsigned old = xb_add(&bar[XB_XSUB(bx_)], 1u);
        const unsigned gen = old / nloc;
        if (old + 1u == (gen + 1u) * nloc) {
            __builtin_amdgcn_fence(__ATOMIC_RELEASE, "agent");
            asm volatile("s_waitcnt vmcnt(0)" ::: "memory");
            const unsigned og = xb_add(&bar[XB_TOP], 1u);
            const unsigned tg = og / nx;
            if (og + 1u == (tg + 1u) * nx) xb_add(&bar[XB_TOPGEN], 1u);
            else XB_SPIN(xb_ld(&bar[XB_TOPGEN]) == tg, bar);
            __builtin_amdgcn_fence(__ATOMIC_ACQUIRE, "agent");
            xb_add(&bar[XB_XGEN(bx_)], 1u);
            asm volatile("s_waitcnt vmcnt(0)" ::: "memory");
        } else {
            XB_SPIN(xb_ld(&bar[XB_XGEN(bx_)]) == gen, bar);
            __builtin_amdgcn_fence(__ATOMIC_ACQUIRE, "agent");
            asm volatile("s_waitcnt vmcnt(0)" ::: "memory");
        }
    }
    __syncthreads();
}

namespace pg8 {
constexpr int BM = 256, BK = 64, HALF = 128, HTB = HALF * BK * 2, STAGE_BYTES = 8 * HTB, NXCD = 8, WGM = 8;
__host__ __device__ __forceinline__ int lds_byte(int r, int c) { const int st = (r >> 4) * 2 + (c >> 5), rr = r & 15, cc = c & 31, ob = rr * 64 + cc * 2; return st * 1024 + (ob ^ (((ob >> 9) & 1) << 5)); }
__host__ __device__ __forceinline__ void stage_rc(int b, int& R, int& C) { const int st = b / 1024, sb = b % 1024, swz = sb ^ (((sb >> 9) & 1) << 5); R = (st >> 1) * 16 + swz / 64; C = (st & 1) * 32 + (swz % 64) / 2; }
__host__ __device__ __forceinline__ int perm32(int rho) { const int n = rho >> 4, i = rho & 15; return 8 * (i >> 2) + 4 * n + (i & 3); }
struct Unit { int pm, pn; };
struct Gemm { const bf16_t* A; const bf16_t* Bt; int M, N, K; };
struct StaticOrder {
    int nM, nN, nwg, G, c;
    __host__ __device__ void init(int M_, int N_, int G_, int c_) { nM = M_ / BM; nN = N_ / BM; nwg = nM * nN; G = G_; c = c_; }
    __host__ __device__ bool next(int i, Unit& u) const {
        const long L = (long)i * G + c; if (L >= nwg) return false;
        int wgid = (int)L; { const int q = nwg / NXCD, r = nwg % NXCD, xcd = wgid % NXCD, off = wgid / NXCD; wgid = (xcd < r ? xcd * (q + 1) : r * (q + 1) + (xcd - r) * q) + off; }
        const int nig = WGM * nN, gid = wgid / nig, fm = gid * WGM, gsz = (nM - fm) < WGM ? (nM - fm) : WGM;
        u.pm = fm + ((wgid % nig) % gsz); u.pn = (wgid % nig) / gsz; return true;
    }
    __device__ __forceinline__ void a_ready(const Unit&) const {}
    __device__ __forceinline__ void done(const Unit&) const {}
};
struct EpiBf16 {
    static constexpr bool PERM = true, I8 = false; typedef f32x4 acc_t;
    bf16_t* O; int ldc;
    __device__ __forceinline__ void operator()(const f32x4 (&acc)[2][2][4][2], const Unit& u, int wr, int wc, int fr, int fq) const {
        const int row0 = u.pm * BM + wr * 64 + fr; const int col0 = u.pn * BM + wc * 32 + 8 * fq;
#pragma unroll
        for (int ai = 0; ai < 2; ++ai)
#pragma unroll
            for (int m = 0; m < 4; ++m) { bf16_t* rowp = O + (size_t)(row0 + ai * HALF + m * 16) * ldc + col0;
#pragma unroll
                for (int bj = 0; bj < 2; ++bj) { const f32x4 v0 = acc[ai][bj][m][0], v1 = acc[ai][bj][m][1];
                    u32x4 w; w.x = pkbf_c(v0[0], v0[1]); w.y = pkbf_c(v0[2], v0[3]); w.z = pkbf_c(v1[0], v1[1]); w.w = pkbf_c(v1[2], v1[3]);
                    *(u32x4*)(rowp + bj * HALF) = w; } }
    }
};
struct EpiBf16I8 {
    static constexpr bool PERM = true, I8 = true; typedef i32x4 acc_t;
    bf16_t* O; int ldc; const float* sa; const float* wmax;
    __device__ __forceinline__ void operator()(const i32x4 (&acc)[2][2][4][2], const Unit& u, int wr, int wc, int fr, int fq) const {
        const int row0 = u.pm * BM + wr * 64 + fr; const int col0 = u.pn * BM + wc * 32 + 8 * fq;
        f32x4 sw[2][2];
#pragma unroll
        for (int bj = 0; bj < 2; ++bj)
#pragma unroll
            for (int n = 0; n < 2; ++n) sw[bj][n] = *(const f32x4*)(wmax + col0 + bj * HALF + 4 * n) * (1.f / 127.f);
#pragma unroll
        for (int ai = 0; ai < 2; ++ai)
#pragma unroll
            for (int m = 0; m < 4; ++m) { const int row = row0 + ai * HALF + m * 16; const float sr = sa[row]; bf16_t* rowp = O + (size_t)row * ldc + col0;
#pragma unroll
                for (int bj = 0; bj < 2; ++bj) { const i32x4 a0 = acc[ai][bj][m][0], a1 = acc[ai][bj][m][1];
                    const f32x4 v0 = (f32x4){(float)a0[0], (float)a0[1], (float)a0[2], (float)a0[3]} * sw[bj][0] * sr, v1 = (f32x4){(float)a1[0], (float)a1[1], (float)a1[2], (float)a1[3]} * sw[bj][1] * sr;
                    u32x4 w; w.x = pkbf(v0[0], v0[1]); w.y = pkbf(v0[2], v0[3]); w.z = pkbf(v1[0], v1[1]); w.w = pkbf(v1[2], v1[3]);
                    *(u32x4*)(rowp + bj * HALF) = w; } }
    }
};
struct EpiRes {
    static constexpr bool PERM = false, I8 = false; typedef f32x4 acc_t;
    const float* src_lat; const float* src_ctx; float* dst_lat; float* dst_ctx; const float* gate;
    __device__ __forceinline__ void operator()(const f32x4 (&acc)[2][2][4][2], const Unit& u, int wr, int wc, int fr, int fq) const {
        const bool isctx = u.pm >= (ML / BM);
        const float* src = isctx ? src_ctx + (size_t)(u.pm - ML / BM) * BM * D : src_lat + (size_t)u.pm * BM * D;
        float* dst = isctx ? dst_ctx + (size_t)(u.pm - ML / BM) * BM * D : dst_lat + (size_t)u.pm * BM * D;
        const int mrow = isctx ? 2 : (u.pm >= (T / BM) ? 1 : 0);
        const int row0 = wr * 64 + fr, col0 = u.pn * BM + wc * 32 + 4 * fq;
        f32x4 gv[2][2];
#pragma unroll
        for (int bj = 0; bj < 2; ++bj)
#pragma unroll
            for (int n = 0; n < 2; ++n) gv[bj][n] = *(const f32x4*)(gate + mrow * 6144 + col0 + bj * HALF + n * 16);
#pragma unroll
        for (int ai = 0; ai < 2; ++ai)
#pragma unroll
            for (int m = 0; m < 4; ++m) { const size_t off = (size_t)(row0 + ai * HALF + m * 16) * D + col0;
#pragma unroll
                for (int bj = 0; bj < 2; ++bj)
#pragma unroll
                    for (int n = 0; n < 2; ++n) { const f32x4 s = *(const f32x4*)(src + off + bj * HALF + n * 16);
                        *(f32x4*)(dst + off + bj * HALF + n * 16) = s + gv[bj][n] * acc[ai][bj][m][n]; } }
    }
};

struct EpiResI8 {
    static constexpr bool PERM = false, I8 = true; typedef i32x4 acc_t;
    const float* src_lat; const float* src_ctx; float* dst_lat; float* dst_ctx; const float* gate; const float* sa; const float* wmax;
    __device__ __forceinline__ void operator()(const i32x4 (&acc)[2][2][4][2], const Unit& u, int wr, int wc, int fr, int fq) const {
        const bool isctx = u.pm >= (ML / BM);
        const float* src = isctx ? src_ctx + (size_t)(u.pm - ML / BM) * BM * D : src_lat + (size_t)u.pm * BM * D;
        float* dst = isctx ? dst_ctx + (size_t)(u.pm - ML / BM) * BM * D : dst_lat + (size_t)u.pm * BM * D;
        const int mrow = isctx ? 2 : (u.pm >= (T / BM) ? 1 : 0);
        const int row0 = wr * 64 + fr, col0 = u.pn * BM + wc * 32 + 4 * fq;
        f32x4 gv[2][2];
#pragma unroll
        for (int bj = 0; bj < 2; ++bj)
#pragma unroll
            for (int n = 0; n < 2; ++n) gv[bj][n] = *(const f32x4*)(gate + mrow * 6144 + col0 + bj * HALF + n * 16) * *(const f32x4*)(wmax + col0 + bj * HALF + n * 16) * (1.f / 127.f);
#pragma unroll
        for (int ai = 0; ai < 2; ++ai)
#pragma unroll
            for (int m = 0; m < 4; ++m) { const int rl = row0 + ai * HALF + m * 16; const float sr = sa[u.pm * BM + rl]; const size_t off = (size_t)rl * D + col0;
#pragma unroll
                for (int bj = 0; bj < 2; ++bj)
#pragma unroll
                    for (int n = 0; n < 2; ++n) { const f32x4 sv = *(const f32x4*)(src + off + bj * HALF + n * 16); const i32x4 ac = acc[ai][bj][m][n];
                        *(f32x4*)(dst + off + bj * HALF + n * 16) = sv + gv[bj][n] * ((f32x4){(float)ac[0], (float)ac[1], (float)ac[2], (float)ac[3]} * sr); } }
    }
};
template <class Epi, class Sched>
__device__ __forceinline__ void gemm_phase(LAS unsigned char* lds, const Gemm g, const Sched& S, const Epi& E) {
    constexpr bool I8 = Epi::I8;
    typedef typename Epi::acc_t acc_t;
    int tid = threadIdx.x; asm volatile("" : "+v"(tid)); const int wid = __builtin_amdgcn_readfirstlane(tid >> 6), lane = tid & 63, wr = wid >> 2, wc = wid & 3, fr = lane & 15, fq = lane >> 4;
    const int K = g.K, nt = K / BK;
    unsigned voffA[2], voffB[2];
#pragma unroll
    for (int i = 0; i < 2; ++i) { int R, C; stage_rc(tid * 16 + i * 8192, R, C); const int Rb = Epi::PERM ? ((R & ~31) + perm32(R & 31)) : R;
        voffA[i] = (unsigned)(R * K + C) * 2u; voffB[i] = (unsigned)(Rb * K + C) * 2u; }
    const size_t kstep = (size_t)(BK * 2);
    const size_t hstep = (size_t)HALF * K * 2;
    const size_t tstep = 2 * hstep;
    const unsigned ldsw = (unsigned)wid * 1024u;
    const int aoff = lds_byte(wr * 64 + fr, fq * 8), boff = lds_byte(wc * 32 + fr, fq * 8);
#define PG8_SA(b, h) (((b) * 2 + (h)) * HTB)
#define PG8_SB(b, h) ((4 + (b) * 2 + (h)) * HTB)
#define PG8_STAGE(bufoff, gbase, voff) do { _Pragma("unroll") for (int _i = 0; _i < 2; ++_i) \
        __builtin_amdgcn_global_load_lds((const unsigned*)((const char*)(gbase) + (voff)[_i]), (LAS unsigned*)(lds + (bufoff) + ldsw + _i * 8192), 16, 0, 0); } while (0)
#define PG8_LDA(dst, b, h) do { _Pragma("unroll") for (int m = 0; m < 4; ++m) _Pragma("unroll") for (int k = 0; k < 2; ++k) dst[m][k] = *(const LAS bf16x8*)(lds + PG8_SA(b, h) + aoff + m * 2048 + k * 1024); } while (0)
#define PG8_LDB(dst, b, h) do { _Pragma("unroll") for (int n = 0; n < 2; ++n) _Pragma("unroll") for (int k = 0; k < 2; ++k) dst[n][k] = *(const LAS bf16x8*)(lds + PG8_SB(b, h) + boff + n * 2048 + k * 1024); } while (0)
#define PG8_MMA(ai, bj, At, Bt) do { __builtin_amdgcn_s_setprio(1); _Pragma("unroll") for (int m = 0; m < 4; ++m) _Pragma("unroll") for (int n = 0; n < 2; ++n) _Pragma("unroll") for (int k = 0; k < 2; ++k) \
        { if constexpr (I8) acc[ai][bj][m][n] = __builtin_bit_cast(acc_t, __builtin_amdgcn_mfma_i32_16x16x64_i8(__builtin_bit_cast(i32x4, Bt[n][k]), __builtin_bit_cast(i32x4, At[m][k]), __builtin_bit_cast(i32x4, acc[ai][bj][m][n]), 0, 0, 0)); \
          else acc[ai][bj][m][n] = __builtin_bit_cast(acc_t, __builtin_amdgcn_mfma_f32_16x16x32_bf16(Bt[n][k], At[m][k], __builtin_bit_cast(f32x4, acc[ai][bj][m][n]), 0, 0, 0)); } __builtin_amdgcn_s_setprio(0); } while (0)
#define PG8_WAIT_V(n) asm volatile("s_waitcnt vmcnt(" #n ")" ::: "memory")
#define PG8_WAIT_L(n) asm volatile("s_waitcnt lgkmcnt(" #n ")" ::: "memory")
#define PG8_BAR __builtin_amdgcn_s_barrier()
#define PG8_SCHED __builtin_amdgcn_sched_barrier(0)
    Unit cur, nxt; int ui = 0;
    if (!S.next(0, cur)) return;
    acc_t acc[2][2][4][2];
#pragma unroll
    for (int a = 0; a < 2; ++a)
#pragma unroll
        for (int b = 0; b < 2; ++b)
#pragma unroll
            for (int m = 0; m < 4; ++m)
#pragma unroll
                for (int n = 0; n < 2; ++n) acc[a][b][m][n] = acc_t{};
    bf16x8 At[4][2], B0[2][2], B1[2][2];
    const char* cA = (const char*)g.A + (size_t)cur.pm * tstep; const char* cB = (const char*)g.Bt + (size_t)cur.pn * tstep;
    S.a_ready(cur);
    PG8_STAGE(PG8_SB(0, 0), cB, voffB); PG8_STAGE(PG8_SA(0, 0), cA, voffA); PG8_STAGE(PG8_SB(0, 1), cB + hstep, voffB); PG8_STAGE(PG8_SA(0, 1), cA + hstep, voffA);
    if (wr == 1) PG8_BAR;
    PG8_WAIT_V(4); PG8_BAR;
    PG8_STAGE(PG8_SB(1, 0), cB + kstep, voffB); PG8_STAGE(PG8_SA(1, 0), cA + kstep, voffA); PG8_STAGE(PG8_SB(1, 1), cB + hstep + kstep, voffB);
    PG8_WAIT_V(6); PG8_BAR;
    for (;;) {
        const bool has_next = S.next(ui + 1, nxt);
        const char* nA = has_next ? (const char*)g.A + (size_t)nxt.pm * tstep : cA; const char* nB = has_next ? (const char*)g.Bt + (size_t)nxt.pn * tstep : cB;
        for (int t = 0; t < nt; t += 2) {
            const bool last = (t == nt - 2);
            const char* a1 = cA + (size_t)(t + 1) * kstep;
            const char* a2 = last ? nA : cA + (size_t)(t + 2) * kstep; const char* b2 = last ? nB : cB + (size_t)(t + 2) * kstep;
            const char* a3 = a2 + kstep; const char* b3 = b2 + kstep;
            if (last && has_next) S.a_ready(nxt);
            PG8_LDB(B0, 0, 0); PG8_SCHED; PG8_LDA(At, 0, 0); PG8_STAGE(PG8_SA(1, 1), a1 + hstep, voffA);
            PG8_WAIT_L(8); PG8_BAR; PG8_WAIT_L(0); PG8_MMA(0, 0, At, B0); PG8_BAR; PG8_SCHED;
            PG8_LDB(B1, 0, 1); PG8_STAGE(PG8_SB(0, 0), b2, voffB);
            PG8_BAR; PG8_WAIT_L(0); PG8_MMA(0, 1, At, B1); PG8_BAR;
            PG8_LDA(At, 0, 1); PG8_STAGE(PG8_SA(0, 0), a2, voffA);
            PG8_BAR; PG8_WAIT_L(0); PG8_MMA(1, 0, At, B0); PG8_BAR; PG8_SCHED;
            PG8_STAGE(PG8_SB(0, 1), b2 + hstep, voffB);
            PG8_WAIT_V(6); PG8_BAR; PG8_MMA(1, 1, At, B1); PG8_BAR;
            PG8_LDB(B0, 1, 0); PG8_SCHED; PG8_LDA(At, 1, 0); PG8_STAGE(PG8_SA(0, 1), a2 + hstep, voffA);
            PG8_WAIT_L(8); PG8_BAR; PG8_WAIT_L(0); PG8_MMA(0, 0, At, B0); PG8_BAR; PG8_SCHED;
            PG8_LDB(B1, 1, 1); PG8_STAGE(PG8_SB(1, 0), b3, voffB);
            PG8_BAR; PG8_WAIT_L(0); PG8_MMA(0, 1, At, B1); PG8_BAR;
            PG8_LDA(At, 1, 1); PG8_STAGE(PG8_SA(1, 0), a3, voffA);
            PG8_BAR; PG8_WAIT_L(0); PG8_MMA(1, 0, At, B0); PG8_BAR; PG8_SCHED;
            PG8_STAGE(PG8_SB(1, 1), b3 + hstep, voffB);
            PG8_WAIT_V(6); PG8_BAR; PG8_MMA(1, 1, At, B1); PG8_BAR;
        }
        E(acc, cur, wr, wc, fr, fq); S.done(cur);
        if (!has_next) break;
#pragma unroll
        for (int a = 0; a < 2; ++a)
#pragma unroll
            for (int b = 0; b < 2; ++b)
#pragma unroll
                for (int m = 0; m < 4; ++m)
#pragma unroll
                    for (int n = 0; n < 2; ++n) acc[a][b][m][n] = acc_t{};
        cur = nxt; cA = nA; cB = nB; ++ui;
    }
    PG8_WAIT_V(0);
    if (wr == 0) PG8_BAR;
    PG8_BAR;
#undef PG8_SA
#undef PG8_SB
#undef PG8_STAGE
#undef PG8_LDA
#undef PG8_LDB
#undef PG8_MMA
#undef PG8_WAIT_V
#undef PG8_WAIT_L
#undef PG8_BAR
#undef PG8_SCHED
}
}

namespace att {
constexpr int HD = 128, NW = 8, QBLK = 32, KVBLK = 64;
constexpr float SCALE = 0.088388347648318440f;
constexpr float THR = 8.f;
constexpr int LDQ = 512, LDK = 256;
constexpr size_t SHM_V = KVBLK * HD * 2, SHM_K = KVBLK * HD * 2, SHM_ATTN = 2 * SHM_V + 2 * SHM_K + NW * 64 * 4;
#define KSWZ(row, colB) ((row) * 256 + ((colB) ^ (((row) & 7) << 4)))
#define SBAR() __builtin_amdgcn_sched_barrier(0)
__device__ __forceinline__ int crow(int r, int hi) { return (r & 3) + 8 * (r >> 2) + 4 * hi; }
__device__ __forceinline__ unsigned cvtpk(float lo, float hi) { unsigned r; asm volatile("v_cvt_pk_bf16_f32 %0, %1, %2" : "=v"(r) : "v"(lo), "v"(hi)); return r; }
__device__ __forceinline__ void partialSM(f32x16& p0, f32x16& p1, float mnC, bool shift) {
  if (__builtin_expect(shift, 0)) { for (int r = 0; r < 16; ++r) p0[r] += mnC; for (int r = 0; r < 16; ++r) p1[r] += mnC; }
  for (int r = 0; r < 16; ++r) p0[r] = __builtin_amdgcn_exp2f(p0[r]);
}
__device__ __forceinline__ void finishSM(f32x16& p0, f32x16& p1, float& l_reg, bf16x8& pa0, bf16x8& pa1, bf16x8& pa2, bf16x8& pa3) {
  for (int r = 0; r < 16; ++r) p1[r] = __builtin_amdgcn_exp2f(p1[r]);
  float ps = 0; for (int r = 0; r < 16; ++r) ps += p0[r]; for (int r = 0; r < 16; ++r) ps += p1[r];
  { auto rr = __builtin_amdgcn_permlane32_swap(__float_as_uint(ps), __float_as_uint(ps), false, false);
    ps = __uint_as_float(rr[0]) + __uint_as_float(rr[1]); }
  l_reg += ps;
#define PK4(P, BASE, OUT) do { unsigned a0 = cvtpk(P[BASE + 0], P[BASE + 1]), a1 = cvtpk(P[BASE + 2], P[BASE + 3]);   \
    unsigned b0 = cvtpk(P[BASE + 4], P[BASE + 5]), b1 = cvtpk(P[BASE + 6], P[BASE + 7]);                              \
    auto r0 = __builtin_amdgcn_permlane32_swap(a0, b0, false, false); auto r1 = __builtin_amdgcn_permlane32_swap(a1, b1, false, false); \
    u32x4 w = {r0[0], r1[0], r0[1], r1[1]}; OUT = *reinterpret_cast<bf16x8*>(&w); } while (0)
  PK4(p0, 0, pa0); PK4(p0, 8, pa1); PK4(p1, 0, pa2); PK4(p1, 8, pa3);
#undef PK4
}
__device__ __forceinline__ void qkt(f32x16& p0, f32x16& p1, const bf16_t* Ks, const bf16x8* qr, int r32, int hi) {
  p0 = f32x16{}; p1 = f32x16{};
  for (int d0 = 0; d0 < 8; ++d0) { int cb = (d0 * 16 + hi * 8) * 2;
    bf16x8 b0 = *reinterpret_cast<const bf16x8*>((const char*)Ks + KSWZ(r32, cb));
    bf16x8 b1 = *reinterpret_cast<const bf16x8*>((const char*)Ks + KSWZ(32 + r32, cb));
    p0 = __builtin_amdgcn_mfma_f32_32x32x16_bf16(b0, qr[d0], p0, 0, 0, 0);
    p1 = __builtin_amdgcn_mfma_f32_32x32x16_bf16(b1, qr[d0], p1, 0, 0, 0); }
}
__device__ __forceinline__ int v_st(int k, int c) { const int kk = (k & ~0xC) | ((k & 4) << 1) | ((k & 8) >> 1); return ((kk >> 3) * 4 + (c >> 5)) * 512 + ((kk & 7) * 32 + (c & 31)) * 2; }
__device__ __forceinline__ int v_rd_base(int lane) { return ((lane & 3) << 3) | (((lane >> 2) & 3) << 6) | (((lane >> 4) & 1) << 5) | (((lane >> 5) & 1) << 8); }
constexpr int v_rd_off(int d0, int ks, int half) { return d0 * 512 + ks * 4096 + half * 2048; }
template <int OFF> __device__ __forceinline__ s16x4 tr_read(int vb) {
  s16x4 r; asm volatile("ds_read_b64_tr_b16 %0, %1 offset:%2" : "=&v"(r) : "v"(vb), "i"(OFF) : "memory"); return r;
}
template <int D0> __device__ __forceinline__ void pv_one(f32x16& od, int vb, bf16x8 pa0, bf16x8 pa1, bf16x8 pa2, bf16x8 pa3) {
  const s16x4 l0 = tr_read<v_rd_off(D0, 0, 0)>(vb), h0 = tr_read<v_rd_off(D0, 0, 1)>(vb), l1 = tr_read<v_rd_off(D0, 1, 0)>(vb), h1 = tr_read<v_rd_off(D0, 1, 1)>(vb);
  const s16x4 l2 = tr_read<v_rd_off(D0, 2, 0)>(vb), h2 = tr_read<v_rd_off(D0, 2, 1)>(vb), l3 = tr_read<v_rd_off(D0, 3, 0)>(vb), h3 = tr_read<v_rd_off(D0, 3, 1)>(vb);
  asm volatile("s_waitcnt lgkmcnt(0)" ::: "memory"); SBAR();
#define PK(L, H) (bf16x8){L[0], L[1], L[2], L[3], H[0], H[1], H[2], H[3]}
  od = __builtin_amdgcn_mfma_f32_32x32x16_bf16(pa0, PK(l0, h0), od, 0, 0, 0);
  od = __builtin_amdgcn_mfma_f32_32x32x16_bf16(pa1, PK(l1, h1), od, 0, 0, 0);
  od = __builtin_amdgcn_mfma_f32_32x32x16_bf16(pa2, PK(l2, h2), od, 0, 0, 0);
  od = __builtin_amdgcn_mfma_f32_32x32x16_bf16(pa3, PK(l3, h3), od, 0, 0, 0);
#undef PK
}
__device__ __forceinline__ void pv_d0(f32x16* o, int vb, bf16x8 pa0, bf16x8 pa1, bf16x8 pa2, bf16x8 pa3) {
  pv_one<0>(o[0], vb, pa0, pa1, pa2, pa3); pv_one<1>(o[1], vb, pa0, pa1, pa2, pa3); pv_one<2>(o[2], vb, pa0, pa1, pa2, pa3); pv_one<3>(o[3], vb, pa0, pa1, pa2, pa3);
}
__device__ __forceinline__ void attn_dense_body(const bf16_t* __restrict__ Qb, const bf16_t* __restrict__ Kh, const bf16_t* __restrict__ Vh,
                                                bf16_t* __restrict__ Ob, int LDO, int seq, char* lds, float* __restrict__ lse, float braw) {
  int tid = threadIdx.x; asm volatile("" : "+v"(tid)); const int wid = tid >> 6, lane = tid & 63, r32 = lane & 31, hi = lane >> 5;
  bf16_t* V_lds = (bf16_t*)lds; bf16_t* K_lds = (bf16_t*)(lds + 2 * SHM_V);
  float* ws = (float*)(lds + 2 * SHM_V + 2 * SHM_K) + wid * 64; float* li_l = ws; float* al_l = ws + 32;
  float l_reg = 0; f32x16 o[4] = {}; bf16x8 qr[8];
  bool shift = braw * (SCALE * 1.4426950408889634f) > 64.f; { int sh_ = __builtin_amdgcn_readfirstlane((int)shift); asm volatile("" : "+s"(sh_)); shift = sh_ != 0; }
  const float mnC = __builtin_bit_cast(float, __builtin_amdgcn_readfirstlane(__builtin_bit_cast(int, shift ? -braw * (SCALE * 1.4426950408889634f) : 0.f)));
  const bf16_t* Qw = Qb + (long)(wid * QBLK + r32) * LDQ + hi * 8;
#pragma unroll
  for (int d0 = 0; d0 < 8; ++d0) qr[d0] = *reinterpret_cast<const bf16x8*>(Qw + d0 * 16);
  const int sr = tid >> 4, sc = (tid & 15) * 8, vst0 = v_st(sr, sc), vst1 = v_st(32 + sr, sc);
  const int vb0 = (int)(uintptr_t)V_lds + v_rd_base(lane);
  struct { bf16x8 vs0, vs1, ks0, ks1; } sr_[2];
#define SLOAD(i, k0) do { sr_[i].vs0 = *reinterpret_cast<const bf16x8*>(&Vh[(long)((k0) + sr) * LDK + sc]); sr_[i].vs1 = *reinterpret_cast<const bf16x8*>(&Vh[(long)((k0) + 32 + sr) * LDK + sc]); \
    sr_[i].ks0 = *reinterpret_cast<const bf16x8*>(&Kh[(long)((k0) + sr) * LDK + sc]); sr_[i].ks1 = *reinterpret_cast<const bf16x8*>(&Kh[(long)((k0) + 32 + sr) * LDK + sc]); } while (0)
#define SWRITE(b, i) do { *(bf16x8*)((char*)V_lds + (b) * SHM_V + vst0) = sr_[i].vs0;          \
    *(bf16x8*)((char*)V_lds + (b) * SHM_V + vst1) = sr_[i].vs1; int kc = sc * 2;               \
    *(bf16x8*)((char*)K_lds + (b) * SHM_K + KSWZ(sr, kc)) = sr_[i].ks0;                       \
    *(bf16x8*)((char*)K_lds + (b) * SHM_K + KSWZ(32 + sr, kc)) = sr_[i].ks1; } while (0)
#define SWAIT() asm volatile("s_waitcnt vmcnt(4)" ::: "memory")
#define RESC(a) do { if (__any((a) < 1.f)) { if (hi == 0) al_l[r32] = (a); asm volatile("s_waitcnt lgkmcnt(0)" ::: "memory"); \
    for (int d = 0; d < 4; ++d) for (int r = 0; r < 16; ++r) o[d][r] *= al_l[crow(r, hi)]; } } while (0)
  f32x16 pA0, pA1, pB0, pB1; bf16x8 pa0, pa1, pa2, pa3; const int NT = seq / KVBLK;
  constexpr int SE = 0, SO = 1;
  SLOAD(SE, 0); asm volatile("s_waitcnt vmcnt(0)" ::: "memory"); SWRITE(0, SE); __syncthreads();
  qkt(pA0, pA1, K_lds, qr, r32, hi); partialSM(pA0, pA1, mnC, shift);
  SLOAD(SO, KVBLK); SLOAD(SE, 2 * KVBLK);
  SWAIT(); SWRITE(1, SO); __syncthreads();
  for (int j = 1; j + 1 < NT; j += 2) {
    SBAR(); qkt(pB0, pB1, (bf16_t*)((char*)K_lds + SHM_K), qr, r32, hi);
    finishSM(pA0, pA1, l_reg, pa0, pa1, pa2, pa3); SBAR();
    SLOAD(SO, (j + 2) * KVBLK); SBAR();
    pv_d0(o, vb0, pa0, pa1, pa2, pa3); partialSM(pB0, pB1, mnC, shift);
    __syncthreads(); SWAIT(); SWRITE(0, SE);
    __syncthreads();
    SBAR(); qkt(pA0, pA1, K_lds, qr, r32, hi);
    finishSM(pB0, pB1, l_reg, pa0, pa1, pa2, pa3); SBAR();
    SLOAD(SE, (j + 3 < NT ? j + 3 : NT - 1) * KVBLK); SBAR();
    pv_d0(o, vb0 + (int)SHM_V, pa0, pa1, pa2, pa3); partialSM(pA0, pA1, mnC, shift);
    __syncthreads(); SWAIT(); SWRITE(1, SO);
    __syncthreads();
  }
  SBAR(); qkt(pB0, pB1, (bf16_t*)((char*)K_lds + SHM_K), qr, r32, hi);
  finishSM(pA0, pA1, l_reg, pa0, pa1, pa2, pa3); SBAR();
  pv_d0(o, vb0, pa0, pa1, pa2, pa3); partialSM(pB0, pB1, mnC, shift);
  __syncthreads();
  finishSM(pB0, pB1, l_reg, pa0, pa1, pa2, pa3); SBAR();
  pv_d0(o, vb0 + (int)SHM_V, pa0, pa1, pa2, pa3);
  if (hi == 0) { li_l[r32] = l_reg; if (lse) lse[(wid * QBLK + r32) * 4] = __logf(l_reg) - mnC * 0.69314718055994531f; }
  asm volatile("s_waitcnt lgkmcnt(0)" ::: "memory");
  float rli[16];
#pragma unroll
  for (int r = 0; r < 16; ++r) rli[r] = __builtin_amdgcn_rcpf(li_l[crow(r, hi)]);
  bf16_t* Ow = Ob + (long)(wid * QBLK) * LDO;
#pragma unroll
  for (int r = 0; r < 16; ++r) { int orow = crow(r, hi);
    for (int d0 = 0; d0 < 4; ++d0) Ow[(long)orow * LDO + d0 * 32 + r32] = (bf16_t)(pkbf(o[d0][r] * rli[r], 0.f) & 0xffffu); }
  __syncthreads();
#undef SLOAD
#undef SWRITE
#undef SWAIT
#undef RESC
}
}

struct Args { const float* in[20]; float* out; unsigned char* ws; int ph_lo, ph_hi; };
typedef const __attribute__((address_space(4))) Args* KArgs;
__device__ __forceinline__ KArgs get_args() { KArgs p = (KArgs)__builtin_amdgcn_kernarg_segment_ptr(); asm volatile("" : "+s"(p)); return p; }
__device__ __forceinline__ int fresh_tid() { int t = threadIdx.x; asm volatile("" : "+v"(t)); return t; }
__device__ __forceinline__ int fresh_bx() { int t = blockIdx.x; asm volatile("" : "+s"(t)); return t; }
__device__ __forceinline__ int fresh_g() { int t = gridDim.x; asm volatile("" : "+s"(t)); return t; }
enum { I_X = 0, I_C, I_CTX, I_CCTX, I_ADAW, I_ADAB, I_N1W, I_N2W, I_WIN, I_QNW, I_KNW, I_CONVW, I_ALOG, I_DTB, I_DNW, I_WOUT, I_WQ, I_SUBK, I_U, I_V };

__device__ __forceinline__ void convert_tables(const float* U, const float* V, unsigned char* ws, int l, int wvi, int nwv, int lane, int rw_end = 2 * NEXP) {
    const float* us = U + (size_t)l * NEXP * 1024; const float* vs = V + (size_t)l * NEXP * 1024;
    const int set = l & 1;
    float* scl = (float*)(ws + WS_USC) + set * 2 * NEXP;
    for (int rw = wvi; rw < rw_end; rw += nwv) {
        const bool isu = rw < NEXP; const int e = isu ? rw : rw - NEXP;
        const f32x4* sp = (const f32x4*)((isu ? us : vs) + (size_t)e * 1024 + 16 * lane);
        f32x4 x[4]; float mx = 0.f;
#pragma unroll
        for (int i = 0; i < 4; ++i) { x[i] = sp[i]; mx = fmaxf(mx, fmaxf(fmaxf(fabsf(x[i][0]), fabsf(x[i][1])), fmaxf(fabsf(x[i][2]), fabsf(x[i][3])))); }
        mx = wave_max(mx);
        const float sc = fmaxf(mx, 1e-30f) * (1.f / 127.f), inv = 1.f / sc;
        u32x4 o4;
#pragma unroll
        for (int i = 0; i < 4; ++i) { const unsigned b0 = (unsigned)(int)(rintf(x[i][0] * inv) + 128.f), b1 = (unsigned)(int)(rintf(x[i][1] * inv) + 128.f), b2 = (unsigned)(int)(rintf(x[i][2] * inv) + 128.f), b3 = (unsigned)(int)(rintf(x[i][3] * inv) + 128.f);
            o4[i] = b0 | (b1 << 8) | (b2 << 16) | (b3 << 24); }
        *(u32x4*)(ws + WS_UB + (size_t)set * TAB_SET + (size_t)e * 2048 + (isu ? 0 : 1024) + 16 * lane) = o4;
        if (lane == 0) scl[rw] = sc;
    }
}

__device__ __forceinline__ void transpose_item(const float* W, int ldw, int K, bf16_t* WT, LAS float* scr, int kb, int nb, int lane) {
    const int k0 = 64 * kb, n0 = 32 * nb;
#pragma unroll 8
    for (int i = 0; i < 32; ++i) { const int kk = 2 * i + (lane >> 5); scr[kk * 33 + (lane & 31)] = W[(size_t)(k0 + kk) * ldw + n0 + (lane & 31)]; }
    LDS_WAIT(); asm volatile("" ::: "memory");
    const int c = lane & 7;
#pragma unroll
    for (int j = 0; j < 4; ++j) { const int n = (lane >> 3) + 8 * j; const LAS float* s = scr + (8 * c) * 33 + n;
        u32x4 o; o.x = pkbf(s[0 * 33], s[1 * 33]); o.y = pkbf(s[2 * 33], s[3 * 33]); o.z = pkbf(s[4 * 33], s[5 * 33]); o.w = pkbf(s[6 * 33], s[7 * 33]);
        *(u32x4*)(WT + (size_t)(n0 + n) * K + k0 + 8 * c) = o; }
    LDS_WAIT(); asm volatile("" ::: "memory");
}
__device__ __forceinline__ void phase_prologue(LAS unsigned char* lds) {
    const KArgs ap = get_args();
#define a (*ap)

    const int tid = fresh_tid(), lane = tid & 63, wave = __builtin_amdgcn_readfirstlane(tid >> 6), G = fresh_g(), bx = fresh_bx();
    unsigned char* ws = a.ws;
    {
        LAS float* sc = (LAS float*)(lds + 70000);
        LAS float* part = (LAS float*)(lds + 70000 + 12288);
        for (int i = tid; i < 3 * 1024; i += 512) { const int r = i >> 10, k = i & 1023; const float v = r < 2 ? a.in[I_C][r * 1024 + k] : a.in[I_CCTX][k]; sc[i] = silu_f(v); }
        __syncthreads();
        float* mod = (float*)(ws + WS_MOD);
        for (int item = bx; item < DEPTH * 96; item += G) {
            const int l = item / 96, j0 = (item % 96) * 64;
            const float* wp = a.in[I_ADAW] + (size_t)l * 1024 * 6144 + (size_t)(wave * 128) * 6144 + j0 + lane;
            float a0 = 0.f, a1 = 0.f, a2 = 0.f;
#pragma unroll 8
            for (int kk = 0; kk < 128; ++kk) { const float w = wp[(size_t)kk * 6144]; const int k = wave * 128 + kk; a0 = fmaf(sc[k], w, a0); a1 = fmaf(sc[1024 + k], w, a1); a2 = fmaf(sc[2048 + k], w, a2); }
            part[(wave * 3 + 0) * 64 + lane] = a0; part[(wave * 3 + 1) * 64 + lane] = a1; part[(wave * 3 + 2) * 64 + lane] = a2;
            __syncthreads();
            if (tid < 192) { const int r = tid >> 6, jj = tid & 63; float s = a.in[I_ADAB][l * 6144 + j0 + jj];
#pragma unroll
                for (int w = 0; w < 8; ++w) s += part[(w * 3 + r) * 64 + jj];
                mod[(size_t)(l * 3 + r) * 6144 + j0 + jj] = s; }
            __syncthreads();
        }
    }
    {
        const int gw = bx * 8 + wave, NGW = G * 8;
        unsigned* wmaxw = (unsigned*)(ws + WS_CTL) + CW_WMAX;
        constexpr int NB_IN = NP / 64, NB_OUT = 1024 / 64, NB_Q = 2048 / 64, PER_L2 = (NB_IN + NB_OUT + NB_Q) * 8;
        for (int it = gw; it < DEPTH * PER_L2; it += NGW) { const int l = it / PER_L2; int r = it % PER_L2; const int kc = r & 7; r >>= 3;
            const int mi = r < NB_IN ? 0 : r < NB_IN + NB_OUT ? 1 : 2; const int nb = mi == 0 ? r : mi == 1 ? r - NB_IN : r - NB_IN - NB_OUT; const int ldw = mi == 0 ? NIN : mi == 1 ? 1024 : 2048;
            const float* wp = (mi == 0 ? a.in[I_WIN] + (size_t)l * 1024 * NIN : mi == 1 ? a.in[I_WOUT] + (size_t)l * 1024 * 1024 : a.in[I_WQ] + (size_t)l * 1024 * 2048) + (size_t)(kc * 128) * ldw + nb * 64 + lane;
            float mx = 0.f;
#pragma unroll 8
            for (int kk = 0; kk < 128; ++kk) mx = fmaxf(mx, fabsf(wp[(size_t)kk * ldw]));
            atomicMax(wmaxw + (l * 3 + mi) * 3072 + nb * 64 + lane, __float_as_uint(mx)); }
    }
    const size_t gt = (size_t)bx * 512 + tid, NT = (size_t)G * 512;
    for (size_t i = gt; i < (size_t)DEPTH * 16 * 1024; i += NT) { const int l = (int)(i >> 14), j = (int)((i >> 10) & 15), k = (int)(i & 1023);
        ((float*)(ws + WS_WSK))[i] = a.in[I_WIN][(size_t)l * 1024 * NIN + (size_t)k * NIN + NP + j]; }
    convert_tables(a.in[I_U], a.in[I_V], ws, 0, bx * 8 + wave, G * 8, lane);
    for (size_t i = gt; i < (size_t)DEPTH * 8 * 2 * 128 * 128 / 2; i += NT) { const f32x2 x = ((const f32x2*)a.in[I_SUBK])[i]; ((unsigned*)(ws + WS_SKB))[i] = pkbf(x[0], x[1]); }
    for (size_t i = gt; i < 8192; i += NT) { const int pos = (int)(i >> 5), fi = (int)(i & 31);
        const float inv = exp2f(-(float)fi * (13.287712379549449f / 32.f)); const float ang = (float)pos * inv;
        float rev = ang * 0.15915494309189535f; rev -= floorf(rev);
        ((float*)(ws + WS_ROPE))[i] = __builtin_amdgcn_cosf(rev); ((float*)(ws + WS_ROPE))[8192 + i] = __builtin_amdgcn_sinf(rev); }
}


__device__ __forceinline__ void quant_transpose_item(const float* W, int ldw, signed char* WT, const unsigned* wmaxw, LAS float* scr, int kb, int nb, int lane) {
    const int k0 = 64 * kb, n0 = 32 * nb;
#pragma unroll 8
    for (int i = 0; i < 32; ++i) { const int kk = 2 * i + (lane >> 5); scr[kk * 33 + (lane & 31)] = W[(size_t)(k0 + kk) * ldw + n0 + (lane & 31)]; }
    LDS_WAIT(); asm volatile("" ::: "memory");
    const int n = lane >> 1, hf = lane & 1;
    const float mx = __uint_as_float(wmaxw[n0 + n]), inv = mx > 0.f ? 127.f / mx : 0.f;
    u32x4 o[2];
#pragma unroll
    for (int q = 0; q < 8; ++q) { unsigned w = 0u;
#pragma unroll
        for (int b = 0; b < 4; ++b) { const int kk = 32 * hf + 4 * q + b; w |= ((unsigned)(int)rintf(scr[kk * 33 + n] * inv) & 255u) << (8 * b); }
        o[q >> 2][q & 3] = w; }
    u32x4* dst = (u32x4*)(WT + (size_t)(n0 + n) * 1024 + k0 + 32 * hf);
    dst[0] = o[0]; dst[1] = o[1];
    LDS_WAIT(); asm volatile("" ::: "memory");
}
__device__ __forceinline__ void phase_quant_weights(LAS unsigned char* lds) {
    const KArgs ap = get_args();
#define a (*ap)
    const int tid = fresh_tid(), lane = tid & 63, wave = __builtin_amdgcn_readfirstlane(tid >> 6), G = fresh_g(), bx = fresh_bx();
    unsigned char* ws = a.ws;
    LAS float* scr = (LAS float*)(lds + 65536 + wave * 8448);
    const unsigned* wmaxw = (const unsigned*)(ws + WS_CTL) + CW_WMAX;
    constexpr int I_IN = 16 * 96, I_OUT = 16 * 32, I_Q = 16 * 64, PER_L = I_IN + I_OUT + I_Q;
    for (int it = bx * 8 + wave; it < DEPTH * PER_L; it += G * 8) { const int l = it / PER_L; int r = it % PER_L;
        if (r < I_IN) quant_transpose_item(a.in[I_WIN] + (size_t)l * 1024 * NIN, NIN, (signed char*)(ws + WS_WINT) + (size_t)l * NP * 1024, wmaxw + (l * 3 + 0) * 3072, scr, r / 96, r % 96, lane);
        else if (r < I_IN + I_OUT) { r -= I_IN; quant_transpose_item(a.in[I_WOUT] + (size_t)l * 1024 * 1024, 1024, (signed char*)(ws + WS_WOUTT) + (size_t)l * 1024 * 1024, wmaxw + (l * 3 + 1) * 3072, scr, r / 32, r % 32, lane); }
        else { r -= I_IN + I_OUT; quant_transpose_item(a.in[I_WQ] + (size_t)l * 1024 * 2048, 2048, (signed char*)(ws + WS_WQT) + (size_t)l * 2048 * 1024, wmaxw + (l * 3 + 2) * 3072, scr, r / 64, r % 64, lane); } }
#undef a
}

template <bool SK>
__device__ __forceinline__ void phase_norm(int l, int which, LAS unsigned char* lds) {
    const KArgs ap = get_args();
#define a (*ap)

    const int tid = fresh_tid(), lane = tid & 63, wave = __builtin_amdgcn_readfirstlane(tid >> 6), G = fresh_g(), bx = fresh_bx();
    unsigned char* ws = a.ws;
    LAS float* wsk = (LAS float*)lds;
    if (SK) { const float* src = (const float*)(ws + WS_WSK) + (size_t)l * 16384; for (int i = tid; i < 16384 / 4; i += 512) ((LAS f32x4*)wsk)[i] = ((const f32x4*)src)[i]; __syncthreads(); }
    const int nrows = (which == 1 && l == DEPTH - 1) ? ML : M;
    const float* nw = a.in[which ? I_N2W : I_N1W] + l * 1024;
    const float* modl = (const float*)(ws + WS_MOD) + (size_t)l * 3 * 6144;
    const int shoff = which ? 3072 : 0, scoff = which ? 4096 : 1024;
    f32x4 nwv[4];
#pragma unroll
    for (int j = 0; j < 4; ++j) nwv[j] = *(const f32x4*)(nw + 4 * lane + 256 * j);
    for (int row = wave * G + bx; row < nrows; row += G * 8) {
        const float* src; int mrow;
        if (row < ML) { src = ((l == 0 && which == 0) ? a.in[I_X] : a.out) + (size_t)row * D; mrow = row >= T ? 1 : 0; }
        else { src = ((l == 0 && which == 0) ? a.in[I_CTX] : (const float*)(ws + WS_CTXX)) + (size_t)(row - ML) * D; mrow = 2; }
        const float* md = modl + mrow * 6144;
        f32x4 v[4]; float ss = 0.f;
#pragma unroll
        for (int j = 0; j < 4; ++j) { v[j] = *(const f32x4*)(src + 4 * lane + 256 * j); ss += (v[j][0] * v[j][0] + v[j][1] * v[j][1]) + (v[j][2] * v[j][2] + v[j][3] * v[j][3]); }
        const float rstd = rsqrtf(wave_sum(ss) * (1.f / D) + EPS);
        signed char* hrow = (signed char*)(ws + WS_H) + (size_t)row * D;
        float hmx = 0.f;
#pragma unroll
        for (int j = 0; j < 4; ++j) { const f32x4 sc = *(const f32x4*)(md + scoff + 4 * lane + 256 * j), sh = *(const f32x4*)(md + shoff + 4 * lane + 256 * j);
            v[j] = v[j] * rstd * nwv[j] * (sc + 1.f) + sh; hmx = fmaxf(hmx, fmaxf(fmaxf(fabsf(v[j][0]), fabsf(v[j][1])), fmaxf(fabsf(v[j][2]), fabsf(v[j][3])))); }
        hmx = fmaxf(wave_max(hmx), 1e-30f);
        { const float hinv = 127.f / hmx;
#pragma unroll
          for (int j = 0; j < 4; ++j) *(unsigned*)(hrow + 4 * lane + 256 * j) = ((unsigned)(int)rintf(v[j][0] * hinv) & 255u) | (((unsigned)(int)rintf(v[j][1] * hinv) & 255u) << 8) | (((unsigned)(int)rintf(v[j][2] * hinv) & 255u) << 16) | (((unsigned)(int)rintf(v[j][3] * hinv) & 255u) << 24);
          if (lane == 0) ((float*)(ws + WS_GB))[row] = hmx * (1.f / 127.f); }
        if (SK) {
            float p[16];
#pragma unroll
            for (int c = 0; c < 16; ++c) { float q = 0.f;
#pragma unroll
                for (int j = 0; j < 4; ++j) { const f32x4 w = *(const LAS f32x4*)(wsk + c * 1024 + 4 * lane + 256 * j); q += (v[j][0] * w[0] + v[j][1] * w[1]) + (v[j][2] * w[2] + v[j][3] * w[3]); }
                p[c] = q; }
            { const bool hb = (lane & 32) != 0;
#pragma unroll
              for (int c = 0; c < 8; ++c) { const float keep = hb ? p[c + 8] : p[c], send = hb ? p[c] : p[c + 8]; p[c] = keep + lane_xor<32>(send); } }
            { const bool hb = (lane & 16) != 0;
#pragma unroll
              for (int c = 0; c < 4; ++c) { const float keep = hb ? p[c + 4] : p[c], send = hb ? p[c] : p[c + 4]; p[c] = keep + lane_xor<16>(send); } }
            { const bool hb = (lane & 8) != 0;
#pragma unroll
              for (int c = 0; c < 2; ++c) { const float keep = hb ? p[c + 2] : p[c], send = hb ? p[c] : p[c + 2]; p[c] = keep + lane_xor<8>(send); } }
            { const bool hb = (lane & 4) != 0; const float keep = hb ? p[1] : p[0], send = hb ? p[0] : p[1]; p[0] = keep + lane_xor<4>(send); }
            p[0] += lane_xor<2>(p[0]); p[0] += lane_xor<1>(p[0]);
            if ((lane & 3) == 0) { const int c = ((lane >> 5) & 1) * 8 + ((lane >> 4) & 1) * 4 + ((lane >> 3) & 1) * 2 + ((lane >> 2) & 1); ((float*)(ws + WS_BA))[(size_t)row * 16 + c] = p[0]; }
        }
    }
    if (SK) __syncthreads();
}

__device__ __forceinline__ void phase_prep(int l, LAS unsigned char* lds) {
    const KArgs ap = get_args();
#define a (*ap)

    const int tid = fresh_tid(), lane = tid & 63, wave = __builtin_amdgcn_readfirstlane(tid >> 6), G = fresh_g(), bx = fresh_bx();
    unsigned char* ws = a.ws;
    const bf16_t* P = (const bf16_t*)(ws + WS_P);
    const float* ropec = (const float*)(ws + WS_ROPE); const float* ropes = ropec + 8192;
    const int sec = lane >> 5, fi = lane & 31;
    const float qw0 = a.in[I_QNW][l * 128 + sec * 64 + fi], qw1 = a.in[I_QNW][l * 128 + sec * 64 + 32 + fi];
    const float kw0 = a.in[I_KNW][l * 128 + sec * 64 + fi], kw1 = a.in[I_KNW][l * 128 + sec * 64 + 32 + fi];
    for (int row = wave * G + bx; row < M; row += G * 8) {
        const bool lat = row < ML;
        int b, tt, tlen; if (lat) { b = row >> 14; tt = row & (T - 1); tlen = T; } else { b = (row - ML) >> 8; tt = (row - ML) & (CT - 1); tlen = CT; }
        const bf16_t* prow = P + (size_t)row * NP;
        unsigned short xa[6][2];
#pragma unroll
        for (int hh = 0; hh < 6; ++hh) { const bf16_t* xp = prow + (hh < 4 ? hh * 128 : 512 + (hh - 4) * 128) + sec * 64 + fi; xa[hh][0] = xp[0]; xa[hh][1] = xp[32]; }
        const u32x2 vcp = *(const u32x2*)(prow + 768 + 4 * lane);
        float cs = 1.f, sn = 0.f;
        if (lat) { const int pos = sec ? (tt & 63) : (tt >> 6); cs = ropec[pos * 32 + fi]; sn = ropes[pos * 32 + fi]; }
        bf16_t* qo = (bf16_t*)(ws + WS_QA) + (size_t)row * 512;
        const size_t kvrow = (size_t)b * KVLEN + (lat ? tt : T + tt);
        bf16_t* ko = (bf16_t*)(ws + WS_KA) + kvrow * 256;
        bf16_t* vo = (bf16_t*)(ws + WS_VA) + kvrow * 256;
        float ssq[6];
#pragma unroll
        for (int hh = 0; hh < 6; ++hh) { const float x0 = bf2f(xa[hh][0]), x1 = bf2f(xa[hh][1]); ssq[hh] = x0 * x0 + x1 * x1; }
#pragma unroll
        for (int hh = 0; hh < 6; ++hh) ssq[hh] = wave_sum(ssq[hh]);
#pragma unroll
        for (int hh = 0; hh < 6; ++hh) {
            const float x0 = bf2f(xa[hh][0]), x1 = bf2f(xa[hh][1]);
            const float rs = rsqrtf(ssq[hh] * (1.f / 128.f) + EPS);
            const float y0 = x0 * rs * (hh < 4 ? qw0 : kw0), y1 = x1 * rs * (hh < 4 ? qw1 : kw1);
            const float qsc = hh < 4 ? 0.088388347648318440f * 1.4426950408889634f : 1.f;
            const float o0 = (y0 * cs - y1 * sn) * qsc, o1 = (y1 * cs + y0 * sn) * qsc;
            bf16_t* op = (hh < 4 ? qo + hh * 128 : ko + (hh - 4) * 128) + sec * 64 + fi;
            op[0] = (bf16_t)(pkbf(o0, 0.f) & 0xffffu); op[32] = (bf16_t)(pkbf(o1, 0.f) & 0xffffu);
        }
        *(u32x2*)(vo + 4 * lane) = vcp;
    }
    __syncthreads();
}

constexpr int ATT_PARTS = 4;
__device__ __forceinline__ void phase_attn(int l, unsigned char* lds_raw, volatile LAS unsigned* MISC, int rep) {
    const KArgs ap = get_args();
#define a (*ap)
    unsigned char* ws = a.ws;
    const bf16_t* QA = (const bf16_t*)(ws + WS_QA); const bf16_t* KA = (const bf16_t*)(ws + WS_KA); const bf16_t* VA = (const bf16_t*)(ws + WS_VA);
    bf16_t* CAT = (bf16_t*)(ws + WS_CAT); float* LSE = (float*)(ws + WS_BA);
    unsigned* ctr = (unsigned*)(ws + WS_CTL) + 8192 + 64 * l + 1024 * rep;
    const int natt = 2048 + (l < DEPTH - 1 ? 8 : 0);
    constexpr int CONV_ROWS = 64, NCONV = 2 * NEXP / CONV_ROWS;
    const int nunits = natt + (l + 1 < DEPTH ? NCONV : 0);
    float braw;
    { const int ln = threadIdx.x & 63; float mq = fmaxf(fabsf(a.in[I_QNW][l * 128 + ln]), fabsf(a.in[I_QNW][l * 128 + 64 + ln])), mk = fmaxf(fabsf(a.in[I_KNW][l * 128 + ln]), fabsf(a.in[I_KNW][l * 128 + 64 + ln]));
      mq = wave_max(mq); mk = wave_max(mk);
      braw = __builtin_bit_cast(float, __builtin_amdgcn_readfirstlane(__builtin_bit_cast(int, 128.f * mq * mk))); }
    if (threadIdx.x == 0) MISC[12] = __hip_atomic_fetch_add(ctr, 1u, __ATOMIC_RELAXED, __HIP_MEMORY_SCOPE_AGENT);
    __syncthreads();
    int u = (int)MISC[12], par = 0;
    for (; u < nunits; ) {
        if (threadIdx.x == 0) MISC[13 - par] = __hip_atomic_fetch_add(ctr, 1u, __ATOMIC_RELAXED, __HIP_MEMORY_SCOPE_AGENT);
        if (u >= natt) {
            const int rwb = (u - natt) * CONV_ROWS + (int)(threadIdx.x >> 6) * 8;
            convert_tables(a.in[I_U], a.in[I_V], ws, l + 1, rwb, 1, (int)(threadIdx.x & 63), rwb + 8);
            __syncthreads();
            u = (int)MISC[13 - par]; par ^= 1;
            continue;
        }
        size_t r0, kv0; int h, kvh, seq, ldo; bf16_t* ob; float* lse;
        if (u < 2048) { const int qb = u & 63, g = (u >> 6) & 1, part = (u >> 7) & 3, b = u >> 10; kvh = (u >> 9) & 1; h = kvh * 2 + g;
            const int t0 = (part >> 1) * 130 + (part & 1) * 64;
            r0 = (size_t)b * T + (size_t)qb * 256; kv0 = (size_t)b * KVLEN + (size_t)t0 * 64; seq = ((part & 1) ? 66 : 64) * 64;
            ob = part ? (bf16_t*)(ws + (part == 1 ? WS_DQ : part == 2 ? WS_DK : WS_DV)) + r0 * 512 + h * 128 : CAT + r0 * 1024 + h * 128; ldo = part ? 512 : 1024; lse = LSE + ((size_t)part * ML + r0) * 4 + h; }
        else { const int b = (u - 2048) >> 2; h = (u - 2048) & 3; kvh = h >> 1; r0 = (size_t)ML + (size_t)b * CT; kv0 = (size_t)b * KVLEN + T; seq = CT;
            ob = CAT + r0 * 1024 + h * 128; ldo = 1024; lse = nullptr; }
        att::attn_dense_body(QA + r0 * 512 + h * 128, KA + kv0 * 256 + kvh * 128, VA + kv0 * 256 + kvh * 128, ob, ldo, seq, (char*)lds_raw, lse, braw);
        u = (int)MISC[13 - par]; par ^= 1;
    }
#undef a
}

__device__ __forceinline__ int tokperm(int q, int hh, int jj) { return 16 * q + 8 * (jj >> 2) + 4 * hh + (jj & 3); }
__device__ __forceinline__ int crow16(int r, int hi) { return (r & 3) + 8 * (r >> 2) + 4 * hi; }
__device__ __forceinline__ int kperm16(int s_, int g, int jj) { return 32 * s_ + 16 * (jj >> 2) + 4 * g + (jj & 3); }
__device__ __forceinline__ int frag_off(int i, int j) {
    return (((i >> 4) * 2 + (j >> 5)) * 64 + ((i & 15) + 16 * ((j >> 2) & 3))) * 16 + (4 * ((j >> 4) & 1) + (j & 3)) * 2;
}
template <int MODE>
__device__ __forceinline__ void phase_dn_chunkprep(int l, LAS unsigned char* lds) {
    const KArgs ap = get_args();
#define a (*ap)
    const int tid = fresh_tid(), lane = tid & 63, wave = __builtin_amdgcn_readfirstlane(tid >> 6), G = fresh_g(), bx = fresh_bx();
    unsigned char* ws = a.ws;
    constexpr int KT_OFF = 0, QT_OFF = 17408, VT_OFF = 34816, GS_OFF = 52224, RS_OFF = 68864, AM_OFF = 85504, SC_OFF = 120320, IMG_OFF = 0;
    const int r = lane & 31, hh = lane >> 5;
    const bf16_t* DQ = (const bf16_t*)(ws + WS_DQ); const bf16_t* DK = (const bf16_t*)(ws + WS_DK); const bf16_t* DV = (const bf16_t*)(ws + WS_DV);
    const float* BA = (const float*)(ws + WS_BA);
    constexpr int NTASK = MODE ? NB * 4 * 4 : NB * 4 * (NCH - 4);
#define CP_TASKID(t_) (MODE ? ((t_) >> 2) * NCH + ((t_) & 3) : ((t_) >> 8) * NCH + 4 + ((t_) & 255))
    LAS float* gsc = (LAS float*)(lds + SC_OFF);
    LAS float* bsc = gsc + 128;
    LAS float* gcs = gsc + 256;
    constexpr int CW_OFF = 121856;
    LAS float* cwl = (LAS float*)(lds + CW_OFF);
    for (int i = tid; i < 5 * 1536; i += 512) cwl[i] = a.in[I_CONVW][(size_t)l * 5 * 1536 + i];
    __syncthreads();
    const bf16_t* P = (const bf16_t*)(ws + WS_P);
    u32x4 xin[3][5][2];
#define CP_LOADX(task_) do { const int cidx_ = (task_) % NCH, bh_ = (task_) / NCH, b_ = bh_ >> 2, h_ = bh_ & 3; \
        const int row0_ = cidx_ < 4 ? ML + b_ * CT + cidx_ * 64 : b_ * T + (cidx_ - 4) * 64, tt_ = (cidx_ < 4 ? cidx_ * 64 : (cidx_ - 4) * 64) + (tid >> 3), tlen_ = cidx_ < 4 ? CT : T; \
        _Pragma("unroll") for (int j = 0; j < 5; ++j) { const int t2 = tt_ + j - 2; const bool ok = t2 >= 0 && t2 < tlen_; \
            const bf16_t* xr = P + (size_t)(row0_ + (tid >> 3) + (ok ? j - 2 : 0)) * NP + 1024 + h_ * 128 + (tid & 7) * 16; \
            _Pragma("unroll") for (int m = 0; m < 3; ++m) { const u32x4 w0 = *(const u32x4*)(xr + m * 512), w1 = *(const u32x4*)(xr + m * 512 + 8); \
                xin[m][j][0] = ok ? w0 : (u32x4){0u, 0u, 0u, 0u}; xin[m][j][1] = ok ? w1 : (u32x4){0u, 0u, 0u, 0u}; } } } while (0)
    if (bx < NTASK) CP_LOADX(CP_TASKID(bx));
    for (int tk = bx; tk < NTASK; tk += G) {
        const int task = CP_TASKID(tk);
        const int cidx = task % NCH, bh = task / NCH, b = bh >> 2, h = bh & 3;
        const int row0 = cidx < 4 ? ML + b * CT + cidx * 64 : b * T + (cidx - 4) * 64;
        unsigned char* rec = ws + WS_REC + (size_t)task * REC_BYTES;
        {
            const int rr = tid >> 3, seg = tid & 7;
            if (tid < 128) { const int d = tid >> 6, i = tid & 63, dh = d * 4 + h;
                const float xb = BA[(size_t)(row0 + i) * 16 + dh], z = BA[(size_t)(row0 + i) * 16 + 8 + dh] + a.in[I_DTB][l * 8 + dh];
                bsc[tid] = 1.f / (1.f + __expf(-xb)); gsc[tid] = -__expf(a.in[I_ALOG][l * 8 + dh]) * (fmaxf(z, 0.f) + log1pf(__expf(-fabsf(z)))); }
#pragma unroll
            for (int m = 0; m < 3; ++m) {
                float y[16];
#pragma unroll
                for (int c = 0; c < 16; ++c) y[c] = 0.f;
#pragma unroll
                for (int j = 0; j < 5; ++j) { const LAS float* wp = cwl + j * 1536 + m * 512 + h * 128 + seg * 16;
#pragma unroll
                    for (int q4 = 0; q4 < 4; ++q4) { const f32x4 wv = *(const LAS f32x4*)(wp + 4 * q4); const unsigned u0 = xin[m][j][q4 >> 1][2 * (q4 & 1)], u1 = xin[m][j][q4 >> 1][2 * (q4 & 1) + 1];
                        y[4 * q4 + 0] = fmaf(bflo(u0), wv[0], y[4 * q4 + 0]); y[4 * q4 + 1] = fmaf(bfhi(u0), wv[1], y[4 * q4 + 1]); y[4 * q4 + 2] = fmaf(bflo(u1), wv[2], y[4 * q4 + 2]); y[4 * q4 + 3] = fmaf(bfhi(u1), wv[3], y[4 * q4 + 3]); } }
                float ss = 0.f;
#pragma unroll
                for (int c = 0; c < 16; ++c) { y[c] = silu_f(y[c]); ss = fmaf(y[c], y[c], ss); }
                if (m < 2) { ss += lane_xor<1>(ss); ss += lane_xor<2>(ss); ss += lane_xor<4>(ss);
                    float sc = rsqrtf(ss + EPS); if (m == 0) sc *= 0.088388347648318440f;
#pragma unroll
                    for (int c = 0; c < 16; ++c) y[c] *= sc; }
                u32x4 o0, o1; o0.x = pkbf(y[0], y[1]); o0.y = pkbf(y[2], y[3]); o0.z = pkbf(y[4], y[5]); o0.w = pkbf(y[6], y[7]); o1.x = pkbf(y[8], y[9]); o1.y = pkbf(y[10], y[11]); o1.z = pkbf(y[12], y[13]); o1.w = pkbf(y[14], y[15]);
                LAS unsigned char* dst = lds + (m == 0 ? QT_OFF : m == 1 ? KT_OFF : VT_OFF) + rr * 272 + seg * 32;
                *(LAS u32x4*)dst = o0; *(LAS u32x4*)(dst + 16) = o1;
            }
        }
        __syncthreads();
        {
            const int mat = wave >> 2, ti = (wave >> 1) & 1, tj = wave & 1;
            f32x16 acc = {};
#pragma unroll
            for (int ks = 0; ks < 8; ++ks) {
                const bf16x8 av = *(const LAS bf16x8*)(lds + (mat ? QT_OFF : KT_OFF) + (32 * ti + r) * 272 + (16 * ks + 8 * hh) * 2);
                const bf16x8 bv = *(const LAS bf16x8*)(lds + KT_OFF + (32 * tj + r) * 272 + (16 * ks + 8 * hh) * 2);
                acc = __builtin_amdgcn_mfma_f32_32x32x16_bf16(av, bv, acc, 0, 0, 0);
            }
            LAS float* dst = (LAS float*)(lds + (mat ? RS_OFF : GS_OFF));
#pragma unroll
            for (int i = 0; i < 16; ++i) dst[(32 * ti + crow16(i, hh)) * 65 + 32 * tj + r] = acc[i];
        }
        { const int r16 = lane & 15, g4 = lane >> 4;
#pragma unroll
        for (int t = 0; t < 2; ++t) { const int f = wave * 2 + t, mt = f >> 2, sk = f & 3;
            { const u32x2 lo = *(const LAS u32x2*)(lds + KT_OFF + (16 * mt + r16) * 272 + (32 * sk + 4 * g4) * 2), hi2 = *(const LAS u32x2*)(lds + KT_OFF + (16 * mt + r16) * 272 + (32 * sk + 16 + 4 * g4) * 2);
              *(u32x4*)(rec + REC_K + f * 1024 + lane * 16) = (u32x4){lo.x, lo.y, hi2.x, hi2.y}; }
            { const u32x2 lo = *(const LAS u32x2*)(lds + QT_OFF + (16 * mt + r16) * 272 + (32 * sk + 4 * g4) * 2), hi2 = *(const LAS u32x2*)(lds + QT_OFF + (16 * mt + r16) * 272 + (32 * sk + 16 + 4 * g4) * 2);
              *(u32x4*)(rec + REC_Q + f * 1024 + lane * 16) = (u32x4){lo.x, lo.y, hi2.x, hi2.y}; } }
#pragma unroll
        for (int t = 0; t < 2; ++t) { const int f = wave * 2 + t, mt = f >> 1, sk = f & 1;
            unsigned e[8];
#pragma unroll
            for (int jj = 0; jj < 8; ++jj) e[jj] = *(const LAS unsigned short*)(lds + KT_OFF + kperm16(sk, g4, jj) * 272 + (16 * mt + r16) * 2);
            *(u32x4*)(rec + REC_KT + f * 1024 + lane * 16) = (u32x4){e[0] | (e[1] << 16), e[2] | (e[3] << 16), e[4] | (e[5] << 16), e[6] | (e[7] << 16)}; }
        { const int sl = wave;
            unsigned e[16];
#pragma unroll
            for (int i = 0; i < 16; ++i) e[i] = *(const LAS unsigned short*)(lds + VT_OFF + (16 * (i >> 2) + 4 * g4 + (i & 3)) * 272 + (16 * sl + r16) * 2);
            u32x4* vp = (u32x4*)(rec + REC_V + sl * 2048 + lane * 32);
            vp[0] = (u32x4){e[0] | (e[1] << 16), e[2] | (e[3] << 16), e[4] | (e[5] << 16), e[6] | (e[7] << 16)};
            vp[1] = (u32x4){e[8] | (e[9] << 16), e[10] | (e[11] << 16), e[12] | (e[13] << 16), e[14] | (e[15] << 16)}; }
        }
        if (tk + G < NTASK) CP_LOADX(CP_TASKID(tk + G));
        if (wave < 2) { const int d = wave; float gv = gsc[d * 64 + (d ? 63 - lane : lane)];
            gv += __builtin_bit_cast(float, __builtin_amdgcn_update_dpp(0, __builtin_bit_cast(int, gv), 0x111, 0xF, 0xF, true));
            gv += __builtin_bit_cast(float, __builtin_amdgcn_update_dpp(0, __builtin_bit_cast(int, gv), 0x112, 0xF, 0xF, true));
            gv += __builtin_bit_cast(float, __builtin_amdgcn_update_dpp(0, __builtin_bit_cast(int, gv), 0x114, 0xF, 0xF, true));
            gv += __builtin_bit_cast(float, __builtin_amdgcn_update_dpp(0, __builtin_bit_cast(int, gv), 0x118, 0xF, 0xF, true));
            { const float t0 = __builtin_bit_cast(float, __builtin_amdgcn_readlane(__builtin_bit_cast(int, gv), 15)), t1 = __builtin_bit_cast(float, __builtin_amdgcn_readlane(__builtin_bit_cast(int, gv), 31)), t2 = __builtin_bit_cast(float, __builtin_amdgcn_readlane(__builtin_bit_cast(int, gv), 47));
              const int rw_ = lane >> 4; gv += (rw_ >= 1 ? t0 : 0.f) + (rw_ >= 2 ? t1 : 0.f) + (rw_ >= 3 ? t2 : 0.f); }
            gcs[d * 64 + lane] = gv; }
        __syncthreads();
        const LAS float* Gs = (const LAS float*)(lds + GS_OFF); const LAS float* Rs = (const LAS float*)(lds + RS_OFF);
#pragma unroll 4
        for (int t = 0; t < 16; ++t) { const int e = tid + 512 * t, d = e >> 12, jp = (e >> 6) & 63, ip = e & 63;
            const int in_ = d ? 63 - ip : ip, jn = d ? 63 - jp : jp;
            const float dec = __expf(fminf(gcs[d * 64 + ip] - gcs[d * 64 + jp], 0.f));
            const float av = (jp < ip) ? bsc[d * 64 + in_] * Gs[in_ * 65 + jn] * dec : 0.f;
            ((LAS float*)(lds + AM_OFF))[d * 4352 + jp * 68 + ip] = av;
            const float qk = (jp <= ip) ? Rs[in_ * 65 + jn] * dec : 0.f;
            *(LAS unsigned short*)(lds + IMG_OFF + d * 16384 + 8192 + frag_off(in_, jn)) = (unsigned short)(pkbf(qk, 0.f) & 0xffffu); }
        __syncthreads();
        if (wave < 2) { const int d = wave, c = lane, jn = d ? 63 - c : c; const float bj = bsc[d * 64 + jn];
            const LAS float* At = (const LAS float*)(lds + AM_OFF) + d * 4352;
            LAS float* Xm = (LAS float*)(lds + GS_OFF) + d * 4096 + c;
            const int fj = (jn >> 5) * 1024 + ((jn >> 2) & 3) * 256 + ((jn >> 4) & 1) * 8 + (jn & 3) * 2;
#pragma unroll 1
            for (int B = 0; B < 4; ++B) {
                float acc[16];
#pragma unroll
                for (int q = 0; q < 16; ++q) acc[q] = (16 * B + q == c) ? 1.f : 0.f;
#pragma unroll 4
                for (int j = 0; j < 16 * B; ++j) { const float xj = Xm[j * 64];
                    const f32x4 a0 = *(const LAS f32x4*)(At + j * 68 + 16 * B), a1 = *(const LAS f32x4*)(At + j * 68 + 16 * B + 4), a2 = *(const LAS f32x4*)(At + j * 68 + 16 * B + 8), a3 = *(const LAS f32x4*)(At + j * 68 + 16 * B + 12);
#pragma unroll
                    for (int q = 0; q < 4; ++q) { acc[q] = fmaf(-a0[q], xj, acc[q]); acc[4 + q] = fmaf(-a1[q], xj, acc[4 + q]); acc[8 + q] = fmaf(-a2[q], xj, acc[8 + q]); acc[12 + q] = fmaf(-a3[q], xj, acc[12 + q]); } }
#pragma unroll
                for (int r2 = 0; r2 < 15; ++r2) { const LAS float* ar = At + (16 * B + r2) * 68 + 16 * B; const float xr = acc[r2];
#pragma unroll
                    for (int q4 = (r2 + 1) / 4; q4 < 4; ++q4) { const f32x4 a4 = *(const LAS f32x4*)(ar + 4 * q4);
#pragma unroll
                        for (int q = 0; q < 4; ++q) if (4 * q4 + q > r2) acc[4 * q4 + q] = fmaf(-a4[q], xr, acc[4 * q4 + q]); } }
#pragma unroll
                for (int q = 0; q < 16; ++q) { const int i = 16 * B + q, in_ = d ? 63 - i : i; Xm[i * 64] = acc[q];
                    *(LAS unsigned short*)(lds + IMG_OFF + d * 16384 + (in_ >> 4) * 2048 + (in_ & 15) * 16 + fj) = (unsigned short)(pkbf(acc[q] * bj, 0.f) & 0xffffu); }
            }
        } else if (wave < 4) { const int d = wave - 2, ip = d ? 63 - lane : lane; const float gl = gcs[d * 64 + 63], gi = gcs[d * 64 + ip];
            float* sc = (float*)(rec + REC_DIR + d * REC_DIRSZ + 16384);
            sc[lane] = __expf(gi); sc[64 + lane] = __expf(gl - gi); if (lane == 0) sc[128] = __expf(gl); }
        __syncthreads();
#pragma unroll
        for (int t = 0; t < 4; ++t) { const int p = tid + 512 * t, d = p >> 10, off = (p & 1023) * 16;
            *(u32x4*)(rec + REC_DIR + d * REC_DIRSZ + off) = *(const LAS u32x4*)(lds + IMG_OFF + d * 16384 + off); }
        __syncthreads();
    }
#undef CP_LOADX
#undef CP_TASKID
#undef a
}

__device__ __forceinline__ bf16x8 pack44(const f32x4& lo, const f32x4& hi) {
    u32x4 p; p.x = pkbf_c(lo[0], lo[1]); p.y = pkbf_c(lo[2], lo[3]); p.z = pkbf_c(hi[0], hi[1]); p.w = pkbf_c(hi[2], hi[3]);
    return __builtin_bit_cast(bf16x8, p);
}
template <int VAR>
__device__ __forceinline__ void phase_dn_scan(int l, LAS unsigned char* lds) {
    const KArgs ap = get_args();
#define a (*ap)
    const int tid = fresh_tid(), lane = tid & 63, wave = __builtin_amdgcn_readfirstlane(tid >> 6), bx = fresh_bx();
    unsigned char* ws = a.ws;
    if (bx >= 32) return;
    const int chain = bx >> 1, half = bx & 1, b = chain >> 3, h = (chain >> 1) & 3, dir = chain & 1;
    const unsigned char* recb = ws + WS_REC + (size_t)((b * 4 + h) * NCH) * REC_BYTES;
    constexpr int BUFSZ = 74752;
#define CIDX(n) (dir ? ((n) < 4 ? 3 - (n) : 263 - (n)) : (n))
    if (wave >= 4) {
        const int sw = wave - 4;
#define DN_PIECE(i_) ((sw + 4 * (i_)) < 73 ? (sw + 4 * (i_)) : 72)
#define DN_SRC(rec_, p_) ((p_) < 48 ? (rec_) + (p_) * 1024 : (p_) < 65 ? (rec_) + REC_DIR + dir * REC_DIRSZ + ((p_) - 48) * 1024 : (rec_) + REC_V + half * 8192 + ((p_) - 65) * 1024)
#define DN_STAGE(n, bi) do { const unsigned char* rec_ = recb + (size_t)CIDX(n) * REC_BYTES; _Pragma("unroll") for (int i_ = 0; i_ < 19; ++i_) { const int p_ = DN_PIECE(i_); \
        __builtin_amdgcn_global_load_lds((const unsigned*)(DN_SRC(rec_, p_) + lane * 16), (LAS unsigned*)(lds + (bi) * BUFSZ + p_ * 1024), 16, 0, 0); } } while (0)
#define DN_SYNC() do { asm volatile("s_waitcnt vmcnt(0)" ::: "memory"); __builtin_amdgcn_s_barrier(); asm volatile("" ::: "memory"); } while (0)
        if (VAR != 3) DN_STAGE(0, 0);
        DN_SYNC();
        for (int n = 0; n < NCH; ++n) {
            if (VAR != 3 && n + 1 < NCH) DN_STAGE(n + 1, (n + 1) & 1);
            DN_SYNC();
        }
#undef DN_STAGE
#undef DN_PIECE
#undef DN_SRC
#undef DN_SYNC
    } else {
        const int sl = half * 4 + wave, c16 = lane & 15, g4 = lane >> 4;
        float* Og = (float*)(ws + (dir ? WS_OB : WS_OF)) + h * 128 + sl * 16 + c16;
        f32x4 S[8];
#pragma unroll
        for (int i = 0; i < 8; ++i) S[i] = (f32x4){0.f, 0.f, 0.f, 0.f};
        asm volatile("s_waitcnt lgkmcnt(0)" ::: "memory"); __builtin_amdgcn_s_barrier(); asm volatile("" ::: "memory");
        for (int n = 0; n < NCH; ++n) {
            if (VAR == 2) { asm volatile("s_waitcnt lgkmcnt(0)" ::: "memory"); __builtin_amdgcn_s_barrier(); asm volatile("" ::: "memory"); continue; }
            const LAS unsigned char* buf = lds + (n & 1) * BUFSZ;
            const int cidx = CIDX(n);
            const u32x4 vc0 = *(const LAS u32x4*)(buf + 66560 + wave * 2048 + lane * 32), vc1 = *(const LAS u32x4*)(buf + 66560 + wave * 2048 + lane * 32 + 16);
#define FR(off, f) (*(const LAS bf16x8*)(buf + (off) + (f) * 1024 + lane * 16))
#define MF(A, B, C) __builtin_amdgcn_mfma_f32_16x16x32_bf16((A), (B), (C), 0, 0, 0)
#define SB_() __builtin_amdgcn_sched_barrier(0)
            bf16x8 fa[8], fb[8];
            f32x4 eg[4], dl[4];
#pragma unroll
            for (int mt = 0; mt < 4; ++mt) { eg[mt] = *(const LAS f32x4*)(buf + 65536 + (16 * mt + 4 * g4) * 4); dl[mt] = *(const LAS f32x4*)(buf + 65536 + 256 + (16 * mt + 4 * g4) * 4); }
            const float egl = *(const LAS float*)(buf + 65536 + 512);
#define RD_KQ(dst, q) do { _Pragma("unroll") for (int mt = 0; mt < 4; ++mt) { dst[mt] = FR(0, mt * 4 + (q)); dst[4 + mt] = FR(32768, mt * 4 + (q)); } } while (0)
#define MM_KQ(src, q) do { _Pragma("unroll") for (int mt = 0; mt < 4; ++mt) { X[mt] = MF(src[mt], Sb[q], X[mt]); O[mt] = MF(src[4 + mt], Sb[q], O[mt]); } } while (0)
            f32x4 X[4], O[4], VN[4];
#pragma unroll
            for (int i = 0; i < 4; ++i) { X[i] = (f32x4){0.f, 0.f, 0.f, 0.f}; O[i] = (f32x4){0.f, 0.f, 0.f, 0.f}; VN[i] = (f32x4){0.f, 0.f, 0.f, 0.f}; }
            bf16x8 Sb[4];
#pragma unroll
            for (int q = 0; q < 4; ++q) Sb[q] = pack44(S[2 * q], S[2 * q + 1]);
            RD_KQ(fa, 0); SB_();
            RD_KQ(fb, 1); SB_(); MM_KQ(fa, 0); SB_();
            RD_KQ(fa, 2); SB_(); MM_KQ(fb, 1); SB_();
            RD_KQ(fb, 3); SB_(); MM_KQ(fa, 2); SB_();
#pragma unroll
            for (int i = 0; i < 8; ++i) fa[i] = FR(49152, i);
            SB_(); MM_KQ(fb, 3); SB_();
#pragma unroll
            for (int mt = 0; mt < 4; ++mt) { const unsigned w0 = (mt < 2 ? vc0 : vc1)[2 * (mt & 1)], w1 = (mt < 2 ? vc0 : vc1)[2 * (mt & 1) + 1];
                X[mt][0] = bflo(w0) - eg[mt][0] * X[mt][0]; X[mt][1] = bfhi(w0) - eg[mt][1] * X[mt][1]; X[mt][2] = bflo(w1) - eg[mt][2] * X[mt][2]; X[mt][3] = bfhi(w1) - eg[mt][3] * X[mt][3]; }
            const bf16x8 Yb0 = pack44(X[0], X[1]), Yb1 = pack44(X[2], X[3]);
            SB_();
#pragma unroll
            for (int i = 0; i < 8; ++i) fb[i] = FR(57344, i);
            SB_();
#pragma unroll
            for (int mt = 0; mt < 4; ++mt) { VN[mt] = MF(fa[mt * 2], Yb0, VN[mt]); VN[mt] = MF(fa[mt * 2 + 1], Yb1, VN[mt]); }
            SB_();
#pragma unroll
            for (int mt = 0; mt < 4; ++mt) O[mt] = O[mt] * eg[mt];
            const bf16x8 Vb0 = pack44(VN[0], VN[1]), Vb1 = pack44(VN[2], VN[3]);
            SB_();
#pragma unroll
            for (int i = 0; i < 8; ++i) fa[i] = FR(16384, i);
            SB_();
#pragma unroll
            for (int mt = 0; mt < 4; ++mt) { O[mt] = MF(fb[mt * 2], Vb0, O[mt]); O[mt] = MF(fb[mt * 2 + 1], Vb1, O[mt]); }
            SB_();
#pragma unroll
            for (int mt = 0; mt < 4; ++mt) VN[mt] = VN[mt] * dl[mt];
            const bf16x8 Vd0 = pack44(VN[0], VN[1]), Vd1 = pack44(VN[2], VN[3]);
#pragma unroll
            for (int i = 0; i < 8; ++i) S[i] = S[i] * egl;
            SB_();
#pragma unroll
            for (int i = 0; i < 8; ++i) fb[i] = FR(16384, 8 + i);
            SB_();
#pragma unroll
            for (int i = 0; i < 4; ++i) { S[i] = MF(fa[i * 2], Vd0, S[i]); S[i] = MF(fa[i * 2 + 1], Vd1, S[i]); }
            SB_();
#pragma unroll
            for (int i = 0; i < 4; ++i) { S[4 + i] = MF(fb[i * 2], Vd0, S[4 + i]); S[4 + i] = MF(fb[i * 2 + 1], Vd1, S[4 + i]); }
            SB_();
            {
                const int row0 = cidx < 4 ? ML + b * CT + cidx * 64 : b * T + (cidx - 4) * 64;
                float* op = Og + (size_t)(row0 + 4 * g4) * 512;
#pragma unroll
                for (int mt = 0; mt < 4; ++mt)
#pragma unroll
                    for (int t = 0; t < 4; ++t) { if (VAR != 1) op[(size_t)(16 * mt + t) * 512] = O[mt][t]; else asm volatile("" :: "v"(O[mt][t])); }
            }
#undef RD_KQ
#undef MM_KQ
#undef SB_
#undef FR
#undef MF
            asm volatile("s_waitcnt lgkmcnt(0)" ::: "memory"); __builtin_amdgcn_s_barrier(); asm volatile("" ::: "memory");
        }
    }
#undef CIDX
#undef a
}

__device__ __forceinline__ void phase_dn_out(int l) {
    const KArgs ap = get_args();
#define a (*ap)

    const int tid = fresh_tid(), lane = tid & 63, wave = __builtin_amdgcn_readfirstlane(tid >> 6), G = fresh_g(), bx = fresh_bx();
    unsigned char* ws = a.ws;
    const int nrows = (l == DEPTH - 1) ? ML : M;
    const float* OF = (const float*)(ws + WS_OF); const float* OB = (const float*)(ws + WS_OB);
    const bf16_t* P = (const bf16_t*)(ws + WS_P); bf16_t* CAT = (bf16_t*)(ws + WS_CAT);
    const f32x2 nw = *(const f32x2*)(a.in[I_DNW] + l * 128 + 2 * lane);
    const float* LSE = (const float*)(ws + WS_BA);
    for (int row = wave * G + bx; row < nrows; row += G * 8) {
        f32x2 of[4], ob[4]; unsigned gw[4];
#pragma unroll
        for (int hh = 0; hh < 4; ++hh) { of[hh] = *(const f32x2*)(OF + (size_t)row * 512 + hh * 128 + 2 * lane); ob[hh] = *(const f32x2*)(OB + (size_t)row * 512 + hh * 128 + 2 * lane);
            gw[hh] = *(const unsigned*)(P + (size_t)row * NP + 2560 + hh * 128 + 2 * lane); }
        u32x4 ap_[4]; float ls_[4];
#pragma unroll
        for (int p = 0; p < 4; ++p) { ap_[p] = (u32x4){0u, 0u, 0u, 0u}; ls_[p] = 0.f; }
        if (row < ML) {
            ap_[0] = *(const u32x4*)(CAT + (size_t)row * 1024 + 8 * lane); ap_[1] = *(const u32x4*)((const bf16_t*)(ws + WS_DQ) + (size_t)row * 512 + 8 * lane);
            ap_[2] = *(const u32x4*)((const bf16_t*)(ws + WS_DK) + (size_t)row * 512 + 8 * lane); ap_[3] = *(const u32x4*)((const bf16_t*)(ws + WS_DV) + (size_t)row * 512 + 8 * lane);
#pragma unroll
            for (int p = 0; p < 4; ++p) ls_[p] = LSE[((size_t)p * ML + row) * 4 + (lane >> 4)]; }
        float o0[4], o1[4], ssq[4];
#pragma unroll
        for (int hh = 0; hh < 4; ++hh) { o0[hh] = of[hh][0] + ob[hh][0]; o1[hh] = of[hh][1] + ob[hh][1]; ssq[hh] = o0[hh] * o0[hh] + o1[hh] * o1[hh]; }
#pragma unroll
        for (int hh = 0; hh < 4; ++hh) ssq[hh] = wave_sum(ssq[hh]);
        float mxv = 0.f;
#pragma unroll
        for (int hh = 0; hh < 4; ++hh) { const float rs = rsqrtf(ssq[hh] * (1.f / 128.f) + EPS); const float g0 = bflo(gw[hh]), g1 = bfhi(gw[hh]);
            o0[hh] = o0[hh] * rs * nw[0] * silu_f(g0); o1[hh] = o1[hh] * rs * nw[1] * silu_f(g1); mxv = fmaxf(mxv, fmaxf(fabsf(o0[hh]), fabsf(o1[hh]))); }
        float av[8];
        if (row < ML) { const float mx = fmaxf(fmaxf(ls_[0], ls_[1]), fmaxf(ls_[2], ls_[3]));
            float w_[4], wsum = 0.f;
#pragma unroll
            for (int p = 0; p < 4; ++p) { w_[p] = __expf(ls_[p] - mx); wsum += w_[p]; }
            const float inv = 1.f / wsum;
#pragma unroll
            for (int i = 0; i < 4; ++i) { float lo = 0.f, hi2 = 0.f;
#pragma unroll
                for (int p = 0; p < 4; ++p) { lo = fmaf(w_[p], bflo(ap_[p][i]), lo); hi2 = fmaf(w_[p], bfhi(ap_[p][i]), hi2); }
                av[2 * i] = lo * inv; av[2 * i + 1] = hi2 * inv; } }
        else { const u32x4 cw_ = *(const u32x4*)(CAT + (size_t)row * 1024 + 8 * lane);
#pragma unroll
            for (int i = 0; i < 4; ++i) { av[2 * i] = bflo(cw_[i]); av[2 * i + 1] = bfhi(cw_[i]); } }
#pragma unroll
        for (int i = 0; i < 8; ++i) mxv = fmaxf(mxv, fabsf(av[i]));
        mxv = fmaxf(wave_max(mxv), 1e-30f);
        const float cinv = 127.f / mxv;
        signed char* crow = (signed char*)(ws + WS_CATQ) + (size_t)row * 1024;
#define Q8_(x) ((unsigned)(int)rintf((x) * cinv) & 255u)
        { u32x2 o; o.x = Q8_(av[0]) | (Q8_(av[1]) << 8) | (Q8_(av[2]) << 16) | (Q8_(av[3]) << 24); o.y = Q8_(av[4]) | (Q8_(av[5]) << 8) | (Q8_(av[6]) << 16) | (Q8_(av[7]) << 24); *(u32x2*)(crow + 8 * lane) = o; }
#pragma unroll
        for (int hh = 0; hh < 4; ++hh) *(unsigned short*)(crow + 512 + hh * 128 + 2 * lane) = (unsigned short)(Q8_(o0[hh]) | (Q8_(o1[hh]) << 8));
#undef Q8_
        if (lane == 0) ((float*)(ws + WS_GB))[(1u << 18) + row] = mxv * (1.f / 127.f);
    }
#undef a
}

#define CE_DESC(a_, b_) do { const float hi_ = fmaxf(a_, b_), lo_ = fminf(a_, b_); a_ = hi_; b_ = lo_; } while (0)
__device__ __forceinline__ void bitonic_sort16_desc(float (&v)[16]) {
#pragma unroll
    for (int k = 2; k <= 16; k <<= 1)
#pragma unroll
        for (int j = k >> 1; j > 0; j >>= 1)
#pragma unroll
            for (int i = 0; i < 16; ++i) { const int p = i ^ j; if (p > i) { if ((i & k) == 0) CE_DESC(v[i], v[p]); else CE_DESC(v[p], v[i]); } }
}
__device__ __forceinline__ void merge_top16_desc(float (&lst)[16], const float (&nw)[16]) {
#pragma unroll
    for (int i = 0; i < 16; ++i) lst[i] = fmaxf(lst[i], nw[15 - i]);
#pragma unroll
    for (int j = 8; j > 0; j >>= 1)
#pragma unroll
        for (int i = 0; i < 16; ++i) { const int p = i ^ j; if (p > i) CE_DESC(lst[i], lst[p]); }
}
__device__ __forceinline__ void phase_peer_select(int l) {
    const KArgs ap = get_args();
#define a (*ap)
    const int tid = fresh_tid(), lane = tid & 63, wave = __builtin_amdgcn_readfirstlane(tid >> 6), G = fresh_g(), bx = fresh_bx();
    unsigned char* ws = a.ws;
    const int nrows = (l == DEPTH - 1) ? ML : M;
    const int ntask = (nrows / 32) * 4;
    const bf16_t* Q2 = (const bf16_t*)(ws + WS_P);
    const bf16_t* SKB = (const bf16_t*)(ws + WS_SKB) + (size_t)l * 8 * 2 * 128 * 128;
    int* PIDX = (int*)(ws + WS_PIDX); float* PGATE = (float*)(ws + WS_PGATE);
    const float NEG = -3.0e38f;
    const int r = lane & 31, hi = lane >> 5;
    for (int task = wave * G + bx; task < ntask; task += G * 8) {
        const int tg = task >> 2, hp = task & 3; const int row = tg * 32 + r;
        float mine0[16], mine1[16];
#pragma unroll
        for (int j = 0; j < 16; ++j) { mine0[j] = NEG; mine1[j] = NEG; }
        bf16x8 qA[8], kA[8], kB[8];
        float lst[16];
#define SEL_QPTR(it_) (Q2 + (size_t)row * 2048 + (2 * hp + ((it_) >> 1)) * 256 + ((it_) & 1) * 128 + 8 * hi)
#define SEL_KPTR(it_, t_) (SKB + (size_t)(((2 * hp + ((it_) >> 1)) * 2 + ((it_) & 1)) * 128 + 32 * (t_) + r) * 128 + 8 * hi)
#define SEL_LDQ(dst, it_) do { const bf16_t* qp_ = SEL_QPTR(it_); _Pragma("unroll") for (int ks = 0; ks < 8; ++ks) dst[ks] = *(const bf16x8*)(qp_ + 16 * ks); } while (0)
#define SEL_LDK(dst, it_, t_) do { const bf16_t* kp_ = SEL_KPTR(it_, t_); _Pragma("unroll") for (int ks = 0; ks < 8; ++ks) dst[ks] = *(const bf16x8*)(kp_ + 16 * ks); } while (0)
#define SEL_RANK(qv, kv, t_) do { f32x16 acc = {}; _Pragma("unroll") for (int ks = 0; ks < 8; ++ks) acc = __builtin_amdgcn_mfma_f32_32x32x16_bf16(kv[ks], qv[ks], acc, 0, 0, 0); \
            const unsigned kb = (unsigned)(32 * (t_) + 4 * hi); float nw_[16]; \
            _Pragma("unroll") for (int i = 0; i < 16; ++i) nw_[i] = __uint_as_float((__float_as_uint(acc[i]) & 0xffffff80u) | (kb + (unsigned)((i & 3) + 8 * (i >> 2)))); \
            bitonic_sort16_desc(nw_); merge_top16_desc(lst, nw_); } while (0)
#define SB_() __builtin_amdgcn_sched_barrier(0)
#pragma unroll
        for (int j = 0; j < 16; ++j) lst[j] = NEG;
        SEL_LDK(kA, 0, 0);
#pragma unroll 1
        for (int it = 0; it < 4; ++it) {
            const int itn = it < 3 ? it + 1 : 3;
            SEL_LDQ(qA, it); SEL_LDK(kB, it, 1); SB_(); SEL_RANK(qA, kA, 0); SB_();
            SEL_LDK(kA, it, 2); SB_();                  SEL_RANK(qA, kB, 1); SB_();
            SEL_LDK(kB, it, 3); SB_();                  SEL_RANK(qA, kA, 2); SB_();
            SEL_LDK(kA, itn, 0); SB_();                 SEL_RANK(qA, kB, 3); SB_();
            float oth[16];
#pragma unroll
            for (int j = 0; j < 16; ++j) { auto rr = __builtin_amdgcn_permlane32_swap(__float_as_uint(lst[j]), __float_as_uint(lst[j]), false, false); oth[j] = __uint_as_float(hi ? rr[0] : rr[1]); }
            merge_top16_desc(lst, oth);
            const bool k0 = ((it >> 1) == hi) && ((it & 1) == 0), k1 = ((it >> 1) == hi) && ((it & 1) == 1);
#pragma unroll
            for (int j = 0; j < 16; ++j) { mine0[j] = k0 ? lst[j] : mine0[j]; mine1[j] = k1 ? lst[j] : mine1[j]; lst[j] = NEG; }
        }
#undef SB_
#undef SEL_QPTR
#undef SEL_KPTR
#undef SEL_LDQ
#undef SEL_LDK
#undef SEL_RANK
        const int h = 2 * hp + hi;
        float ts[16];
#pragma unroll
        for (int j = 0; j < 16; ++j) ts[j] = NEG;
#pragma unroll
        for (int i = 0; i < 16; ++i)
#pragma unroll
            for (int j = 0; j < 16; ++j) if ((i + 1) * (j + 1) <= 16) {
                const unsigned b0 = __float_as_uint(mine0[i]), b1 = __float_as_uint(mine1[j]);
                const float c = __uint_as_float(b0 & 0xffffff80u) + __uint_as_float(b1 & 0xffffff80u);
                float x = __uint_as_float((__float_as_uint(c) & 0xffffc000u) | ((b0 & 127u) << 7) | (b1 & 127u));
#pragma unroll
                for (int t = 0; t < 16; ++t) { const float hv = fmaxf(ts[t], x); x = fminf(ts[t], x); ts[t] = hv; }
            }
        int te[16]; float ex[16], sum = 0.f;
        const float tmax = __uint_as_float(__float_as_uint(ts[0]) & 0xffffc000u);
#pragma unroll
        for (int t = 0; t < 16; ++t) { const unsigned bt = __float_as_uint(ts[t]); te[t] = (int)(bt & 0x3fffu); ex[t] = __expf(__uint_as_float(bt & 0xffffc000u) - tmax); sum += ex[t]; }
        const float inv = 1.f / sum;
        int* ip = PIDX + (size_t)row * 128 + h * 16; float* gp = PGATE + (size_t)row * 128 + h * 16;
#pragma unroll
        for (int t = 0; t < 16; t += 4) { *(u32x4*)(ip + t) = (u32x4){(unsigned)te[t], (unsigned)te[t + 1], (unsigned)te[t + 2], (unsigned)te[t + 3]}; *(f32x4*)(gp + t) = (f32x4){ex[t] * inv, ex[t + 1] * inv, ex[t + 2] * inv, ex[t + 3] * inv}; }
    }
#undef a
}

template <bool WR, int GV = 0>
__device__ __forceinline__ void phase_peer_gather(int l, LAS unsigned char* lds) {
    const KArgs ap = get_args();
#define a (*ap)
    const int tid = fresh_tid(), lane = tid & 63, wave = __builtin_amdgcn_readfirstlane(tid >> 6), G = fresh_g(), bx = fresh_bx();
    unsigned char* ws = a.ws;
    const int nrows = (l == DEPTH - 1) ? ML : M;
    const unsigned char* UB = ws + WS_UB + (size_t)(l & 1) * TAB_SET; const unsigned char* VB = UB + 1024;
    const float* USC = (const float*)(ws + WS_USC) + (l & 1) * 2 * NEXP; const float* VSC = USC + NEXP;
    const int* PIDX = (const int*)(ws + WS_PIDX); const float* PGATE = (const float*)(ws + WS_PGATE);
    const float* modl = (const float*)(ws + WS_MOD) + (size_t)l * 3 * 6144 + 5120;
    const bool fuse = WR && (l + 1 < DEPTH);
    LAS float* wsk = (LAS float*)lds;
    if (fuse) { const float* src = (const float*)(ws + WS_WSK) + (size_t)(l + 1) * 16384; for (int i = tid; i < 16384 / 4; i += 512) ((LAS f32x4*)wsk)[i] = ((const f32x4*)src)[i]; __syncthreads(); }
    const float* nw1 = a.in[I_N1W] + (l + 1 < DEPTH ? l + 1 : l) * 1024 + 16 * lane;
    const float* modn = (const float*)(ws + WS_MOD) + (size_t)(l + 1 < DEPTH ? l + 1 : l) * 3 * 6144;
    for (int row = wave * G + bx; row < nrows; row += G * 8) {
        float hv[16], out[16];
        { const u32x4 hw = *(const u32x4*)((const signed char*)(ws + WS_H) + (size_t)row * D + 16 * lane); const float hsc = ((const float*)(ws + WS_GB))[row];
#pragma unroll
          for (int q = 0; q < 4; ++q) { const int w = (int)hw[q]; hv[4 * q + 0] = (float)((w << 24) >> 24) * hsc; hv[4 * q + 1] = (float)((w << 16) >> 24) * hsc; hv[4 * q + 2] = (float)((w << 8) >> 24) * hsc; hv[4 * q + 3] = (float)(w >> 24) * hsc; } }
        float hs = 0.f;
#pragma unroll
        for (int i = 0; i < 16; ++i) { out[i] = 0.f; hs += hv[i]; }
        const float hsum128 = 128.f * wave_sum(hs);
        float wacc = 0.f;
        const int id0 = PIDX[(size_t)row * 128 + lane], id1 = PIDX[(size_t)row * 128 + 64 + lane];
        const float gt0 = PGATE[(size_t)row * 128 + lane], gt1 = PGATE[(size_t)row * 128 + 64 + lane];
        const float us0 = USC[id0], us1 = USC[id1], vs0 = VSC[id0], vs1 = VSC[id1];
        for (int e0 = 0; e0 < 128; e0 += 8) {
            u32x4 uw[8], vw[8]; float gte[8], use[8], vse[8];
#pragma unroll
            for (int j = 0; j < 8; ++j) { const int e = e0 + j; const int id = __builtin_amdgcn_readlane(e0 < 64 ? id0 : id1, e & 63);
                gte[j] = __builtin_bit_cast(float, __builtin_amdgcn_readlane(__builtin_bit_cast(int, e0 < 64 ? gt0 : gt1), e & 63));
                use[j] = __builtin_bit_cast(float, __builtin_amdgcn_readlane(__builtin_bit_cast(int, e0 < 64 ? us0 : us1), e & 63));
                vse[j] = __builtin_bit_cast(float, __builtin_amdgcn_readlane(__builtin_bit_cast(int, e0 < 64 ? vs0 : vs1), e & 63));
                uw[j] = *(const u32x4*)(UB + (size_t)id * 2048 + 16 * lane); vw[j] = *(const u32x4*)(VB + (size_t)id * 2048 + 16 * lane); }
#pragma unroll
            for (int j = 0; j < 8; ++j) {
                float d0 = 0.f, d1 = 0.f;
#pragma unroll
                for (int q = 0; q < 4; ++q) { const unsigned w = uw[j][q];
                    d0 = fmaf((float)(w & 255u), hv[4 * q + 0], d0); d1 = fmaf((float)((w >> 8) & 255u), hv[4 * q + 1], d1);
                    d0 = fmaf((float)((w >> 16) & 255u), hv[4 * q + 2], d0); d1 = fmaf((float)(w >> 24), hv[4 * q + 3], d1); }
                const float dsum = (wave_sum(d0 + d1) - hsum128) * use[j];
                const float act = 0.5f * dsum * (1.f + erff(dsum * 0.70710678118654752f));
                const float wgt = gte[j] * act * vse[j];
                wacc += wgt;
                if (GV == 1) { asm volatile("" :: "v"(vw[j])); out[0] += wgt; } else
#pragma unroll
                for (int q = 0; q < 4; ++q) { const unsigned w = vw[j][q];
                    out[4 * q + 0] = fmaf(wgt, (float)(w & 255u), out[4 * q + 0]); out[4 * q + 1] = fmaf(wgt, (float)((w >> 8) & 255u), out[4 * q + 1]);
                    out[4 * q + 2] = fmaf(wgt, (float)((w >> 16) & 255u), out[4 * q + 2]); out[4 * q + 3] = fmaf(wgt, (float)(w >> 24), out[4 * q + 3]); }
            }
        }
        const float corr = 128.f * wacc;
        float* xr; int mrow;
        if (row < ML) { xr = a.out + (size_t)row * D; mrow = row >= T ? 1 : 0; } else { xr = (float*)(ws + WS_CTXX) + (size_t)(row - ML) * D; mrow = 2; }
        const float* g2 = modl + mrow * 6144 + 16 * lane;
        f32x4 xn[4];
#pragma unroll
        for (int i = 0; i < 4; ++i) { const f32x4 x = *(const f32x4*)(xr + 16 * lane + 4 * i), g = *(const f32x4*)(g2 + 4 * i);
            xn[i] = x + g * (f32x4){out[4 * i] - corr, out[4 * i + 1] - corr, out[4 * i + 2] - corr, out[4 * i + 3] - corr};
            if (WR) *(f32x4*)(xr + 16 * lane + 4 * i) = xn[i]; else asm volatile("" :: "v"(xn[i])); }
        if (fuse) {
            float ss = 0.f;
#pragma unroll
            for (int i = 0; i < 4; ++i) ss += (xn[i][0] * xn[i][0] + xn[i][1] * xn[i][1]) + (xn[i][2] * xn[i][2] + xn[i][3] * xn[i][3]);
            const float rstd = rsqrtf(wave_sum(ss) * (1.f / D) + EPS);
            const float* md = modn + mrow * 6144 + 16 * lane;
#pragma unroll
            for (int i = 0; i < 4; ++i) { const f32x4 nwv = *(const f32x4*)(nw1 + 4 * i), sc = *(const f32x4*)(md + 1024 + 4 * i), sh = *(const f32x4*)(md + 4 * i);
                xn[i] = xn[i] * rstd * nwv * (sc + 1.f) + sh; }
            { float hmx = 0.f;
#pragma unroll
              for (int i = 0; i < 4; ++i) hmx = fmaxf(hmx, fmaxf(fmaxf(fabsf(xn[i][0]), fabsf(xn[i][1])), fmaxf(fabsf(xn[i][2]), fabsf(xn[i][3]))));
              hmx = fmaxf(wave_max(hmx), 1e-30f); const float hinv = 127.f / hmx;
              u32x4 o;
#pragma unroll
              for (int i = 0; i < 4; ++i) o[i] = ((unsigned)(int)rintf(xn[i][0] * hinv) & 255u) | (((unsigned)(int)rintf(xn[i][1] * hinv) & 255u) << 8) | (((unsigned)(int)rintf(xn[i][2] * hinv) & 255u) << 16) | (((unsigned)(int)rintf(xn[i][3] * hinv) & 255u) << 24);
              *(u32x4*)((signed char*)(ws + WS_H) + (size_t)row * D + 16 * lane) = o;
              if (lane == 0) ((float*)(ws + WS_GB))[row] = hmx * (1.f / 127.f); }
            float p[16];
#pragma unroll
            for (int c = 0; c < 16; ++c) { float q = 0.f;
#pragma unroll
                for (int i = 0; i < 4; ++i) { const f32x4 w = *(const LAS f32x4*)(wsk + c * 1024 + 16 * lane + 4 * i); q += (xn[i][0] * w[0] + xn[i][1] * w[1]) + (xn[i][2] * w[2] + xn[i][3] * w[3]); }
                p[c] = q; }
            { const bool hb = (lane & 32) != 0;
#pragma unroll
              for (int c = 0; c < 8; ++c) { const float keep = hb ? p[c + 8] : p[c], send = hb ? p[c] : p[c + 8]; p[c] = keep + lane_xor<32>(send); } }
            { const bool hb = (lane & 16) != 0;
#pragma unroll
              for (int c = 0; c < 4; ++c) { const float keep = hb ? p[c + 4] : p[c], send = hb ? p[c] : p[c + 4]; p[c] = keep + lane_xor<16>(send); } }
            { const bool hb = (lane & 8) != 0;
#pragma unroll
              for (int c = 0; c < 2; ++c) { const float keep = hb ? p[c + 2] : p[c], send = hb ? p[c] : p[c + 2]; p[c] = keep + lane_xor<8>(send); } }
            { const bool hb = (lane & 4) != 0; const float keep = hb ? p[1] : p[0], send = hb ? p[0] : p[1]; p[0] = keep + lane_xor<4>(send); }
            p[0] += lane_xor<2>(p[0]); p[0] += lane_xor<1>(p[0]);
            if ((lane & 3) == 0) { const int c = ((lane >> 5) & 1) * 8 + ((lane >> 4) & 1) * 4 + ((lane >> 3) & 1) * 2 + ((lane >> 2) & 1); ((float*)(ws + WS_BA))[(size_t)row * 16 + c] = p[0]; }
        }
    }
    if (fuse) __syncthreads();
}
#undef a
__global__ void __launch_bounds__(512, 2) fwd(Args a) {
    extern __shared__ __attribute__((aligned(16))) unsigned char lds_raw[];
    LAS unsigned char* lds = (LAS unsigned char*)lds_raw;
    volatile LAS unsigned* MISC = (volatile LAS unsigned*)(lds + LDS_MISC);
    if (threadIdx.x < 16) MISC[threadIdx.x] = 0u;
    __syncthreads();
    XcdBarrier bar; bar.bar = (unsigned*)(a.ws + WS_CTL) + 4096; bar.x = 0; bar.st = MISC + 8;
    bar = xcd_barrier_post((unsigned*)(a.ws + WS_CTL) + 4096, MISC + 8);
#ifndef PHASE_MASK
#define PHASE_MASK 0x1FFF
#endif
#define EN(i) ((PHASE_MASK >> (i)) & 1)
#ifndef REP_MASK
#define REP_MASK 0
#endif
#define REPN(i) (1 + ((REP_MASK >> (i)) & 1))
#define IN(k) true
#define SEAM(k) do { XcdBarrier b_; b_.bar = (unsigned*)(get_args()->ws + WS_CTL) + 4096; b_.x = xb_xcc_id(); b_.st = (volatile LAS unsigned*)(lds + LDS_MISC) + 8; xcd_barrier(b_); } while (0)
    for (int rep_ = 0; rep_ < (REPN(0)); ++rep_) if (EN(0) && IN(0)) phase_prologue(lds);
    SEAM(0);
#pragma unroll 1
    for (int l_ = 0; l_ < DEPTH; ++l_) {
        int l = l_; asm volatile("" : "+s"(l));
        const int pb = 1 + l * NPH_L;
        const int mrows = (l == DEPTH - 1) ? ML : M;
        if (l == 0) { for (int rep_ = 0; rep_ < (REPN(1)); ++rep_) if (EN(1) && IN(pb + 0)) { phase_norm<true>(l, 0, lds); phase_quant_weights(lds); }
            SEAM(pb + 0); }
        for (int rep_ = 0; rep_ < (REPN(2)); ++rep_) if (EN(2) && IN(pb + 1)) { const KArgs ap = get_args(); unsigned char* ws = ap->ws; pg8::Gemm g{(const bf16_t*)(ws + WS_H), (const bf16_t*)((const signed char*)(ws + WS_WINT) + (size_t)l * NP * 1024), M, NP, 512}; pg8::StaticOrder S; S.init(M, NP, fresh_g(), fresh_bx());
            pg8::EpiBf16I8 E{(bf16_t*)(ws + WS_P), NP, (const float*)(ws + WS_GB), (const float*)(ws + WS_CTL) + CW_WMAX + (l * 3 + 0) * 3072}; pg8::gemm_phase(lds, g, S, E); }
        SEAM(pb + 1);
        for (int rep_ = 0; rep_ < (REPN(3)); ++rep_) if (EN(3) && IN(pb + 2)) { phase_dn_chunkprep<1>(l, lds); phase_prep(l, lds); }
        for (int rep_ = 0; rep_ < (REPN(4)); ++rep_) if (EN(4) && IN(pb + 3)) phase_dn_chunkprep<0>(l, lds);
        SEAM(pb + 3);
        for (int rep_ = 0; rep_ < (REPN(5)); ++rep_) if (EN(5) && IN(pb + 4)) { phase_dn_scan<0>(l, lds); __syncthreads(); phase_attn(l, lds_raw, MISC, rep_); }
        SEAM(pb + 4);
        for (int rep_ = 0; rep_ < (REPN(7)); ++rep_) if (EN(7) && IN(pb + 5)) phase_dn_out(l);
        SEAM(pb + 5);
        if (EN(8) && IN(pb + 6)) { const KArgs ap = get_args(); unsigned char* ws = ap->ws; pg8::Gemm g{(const bf16_t*)(ws + WS_CATQ), (const bf16_t*)((const signed char*)(ws + WS_WOUTT) + (size_t)l * 1024 * 1024), mrows, 1024, 512}; pg8::StaticOrder S; S.init(mrows, 1024, fresh_g(), fresh_bx());
            pg8::EpiResI8 E{l == 0 ? ap->in[I_X] : ap->out, l == 0 ? ap->in[I_CTX] : (const float*)(ws + WS_CTXX), ap->out, (float*)(ws + WS_CTXX), (const float*)(ws + WS_MOD) + (size_t)l * 3 * 6144 + 2048,
                              (const float*)(ws + WS_GB) + (1u << 18), (const float*)(ws + WS_CTL) + CW_WMAX + (l * 3 + 1) * 3072};
            pg8::gemm_phase(lds, g, S, E); }
        SEAM(pb + 6);
        for (int rep_ = 0; rep_ < (REPN(9)); ++rep_) if (EN(9) && IN(pb + 7)) phase_norm<false>(l, 1, lds);
        SEAM(pb + 7);
        for (int rep_ = 0; rep_ < (REPN(10)); ++rep_) if (EN(10) && IN(pb + 8)) { const KArgs ap = get_args(); unsigned char* ws = ap->ws; pg8::Gemm g{(const bf16_t*)(ws + WS_H), (const bf16_t*)((const signed char*)(ws + WS_WQT) + (size_t)l * 2048 * 1024), mrows, 2048, 512}; pg8::StaticOrder S; S.init(mrows, 2048, fresh_g(), fresh_bx());
            pg8::EpiBf16I8 E{(bf16_t*)(ws + WS_P), 2048, (const float*)(ws + WS_GB), (const float*)(ws + WS_CTL) + CW_WMAX + (l * 3 + 2) * 3072}; pg8::gemm_phase(lds, g, S, E); }
        SEAM(pb + 8);
        for (int rep_ = 0; rep_ < (REPN(11)); ++rep_) if (EN(11) && IN(pb + 9)) phase_peer_select(l);
        SEAM(pb + 9);
        #ifdef GATHER_VAR
        if (EN(12) && IN(pb + 10)) phase_peer_gather<false, GATHER_VAR>(l, lds);
#endif
        if (REPN(12) > 1 && EN(12) && IN(pb + 10)) phase_peer_gather<false>(l, lds);
        if (EN(12) && IN(pb + 10)) phase_peer_gather<true>(l, lds);
        if (l + 1 < DEPTH) SEAM(pb + 10);
    }
#undef IN
#undef SEAM
}

#ifndef N_LAUNCH_MODE
#define N_LAUNCH_MODE 1
#endif
extern "C" void kernel_launch(void* const* d_in, const int* in_sizes, int n_in, void* d_out, int out_size, void* d_ws, size_t ws_size, hipStream_t stream) {
    static int grid = 0;
    if (grid == 0) {
        if (n_in != 20 || out_size != ML * D || ws_size < WS_END) { fprintf(stderr, "kernel_launch: unexpected shapes: n_in %d out %d ws %zu (need %zu)\n", n_in, out_size, ws_size, (size_t)WS_END); grid = -1; return; }
        int dev = 0, cus = 0, per_cu = 0;
        if (hipGetDevice(&dev) != hipSuccess || hipDeviceGetAttribute(&cus, hipDeviceAttributeMultiprocessorCount, dev) != hipSuccess) { grid = -1; return; }
        if (hipFuncSetAttribute((const void*)fwd, hipFuncAttributeMaxDynamicSharedMemorySize, LDS_BYTES) != hipSuccess) { fprintf(stderr, "kernel_launch: hipFuncSetAttribute failed\n"); grid = -1; return; }
        if (hipOccupancyMaxActiveBlocksPerMultiprocessor(&per_cu, (const void*)fwd, 512, LDS_BYTES) != hipSuccess || per_cu < 1) fprintf(stderr, "kernel_launch: occupancy query says %d\n", per_cu);
        (void)hipGetLastError();
        grid = cus;
    }
    if (grid < 0) return;
    (void)hipMemsetAsync((char*)d_ws + WS_CTL, 0, CTL_BYTES, stream);
    Args a{};
    for (int i = 0; i < 20; ++i) a.in[i] = (const float*)d_in[i];
    a.out = (float*)d_out; a.ws = (unsigned char*)d_ws;
    a.ph_lo = 0; a.ph_hi = NPHASE;
    hipLaunchKernelGGL(fwd, dim3(grid), dim3(512), LDS_BYTES, stream, a);
    const hipError_t le = hipPeekAtLastError();
    if (le != hipSuccess) fprintf(stderr, "kernel_launch: launch failed: %s\n", hipGetErrorName(le));
}
```

```cpp
#include <hip/hip_runtime.h>
#include <cstdio>
#include <cstdint>

#define GAS __attribute__((address_space(1)))
#define LAS __attribute__((address_space(3)))
typedef unsigned short bf16_t;
typedef short bf16x8 __attribute__((ext_vector_type(8)));
typedef short s16x4 __attribute__((ext_vector_type(4)));
typedef float f32x4 __attribute__((ext_vector_type(4)));
typedef float f32x2 __attribute__((ext_vector_type(2)));
typedef float f32x16 __attribute__((ext_vector_type(16)));
typedef unsigned u32x4 __attribute__((ext_vector_type(4)));
typedef unsigned u32x2 __attribute__((ext_vector_type(2)));
typedef int i32x4 __attribute__((ext_vector_type(4)));

constexpr int D = 1024, NB = 2, T = 16384, DEPTH = 4, CT = 256;
constexpr int ML = NB * T, MC = NB * CT, M = ML + MC;
constexpr int NIN = 3088, NP = 3072;
constexpr int KVLEN = T + CT;
constexpr int NEXP = 16384;
constexpr float EPS = 1e-6f;
constexpr int NPH_L = 11;
constexpr int NPHASE = 1 + DEPTH * NPH_L;

constexpr size_t MiB = 1u << 20;
constexpr size_t WS_CTL = 0, CTL_BYTES = 1 * MiB;
constexpr size_t WS_MOD = 1 * MiB;
constexpr size_t WS_ROPE = 2 * MiB;
constexpr size_t WS_WSK = 3 * MiB;
constexpr size_t WS_CTXX = 4 * MiB;
constexpr size_t WS_WINT = 8 * MiB;
constexpr size_t WS_WOUTT = 32 * MiB;
constexpr size_t WS_WQT = 40 * MiB;
constexpr size_t WS_SKB = 56 * MiB;
constexpr size_t WS_USC = 58 * MiB;
constexpr size_t WS_UB = 64 * MiB;
constexpr size_t WS_VB = 80 * MiB;
constexpr size_t TAB_SET = 32 * MiB;
constexpr size_t WS_H = 128 * MiB;
static_assert(WS_H + 2 * (size_t)M * 1024 <= 193 * MiB, "H + concat int8");
constexpr size_t WS_CATQ = WS_H + (size_t)M * 1024;
constexpr size_t WS_P = 193 * MiB;
constexpr size_t WS_QA = 388 * MiB;
constexpr size_t WS_KA = 421 * MiB;
constexpr size_t WS_VA = 438 * MiB;
constexpr size_t WS_CAT = 455 * MiB;
constexpr size_t WS_DQ = 520 * MiB;
constexpr size_t WS_DK = 553 * MiB;
constexpr size_t WS_DV = 586 * MiB;
constexpr size_t WS_OF = 619 * MiB;
constexpr size_t WS_OB = 684 * MiB;
constexpr size_t WS_GB = 749 * MiB;
constexpr size_t WS_BA = 752 * MiB;
constexpr size_t WS_PIDX = 755 * MiB;
constexpr size_t WS_PGATE = 772 * MiB;
constexpr size_t WS_REC = 789 * MiB;
constexpr size_t WS_END = 990 * MiB;
constexpr int CW_WMAX = 65536;
constexpr int NCH = 260;
constexpr int REC_K = 0, REC_KT = 16384, REC_Q = 32768, REC_V = 49152, REC_DIR = 65536, REC_DIRSZ = 17408, REC_BYTES = REC_DIR + 2 * REC_DIRSZ;
static_assert((size_t)NB * 4 * NCH * REC_BYTES + WS_REC <= WS_END, "rec region");

constexpr int LDS_BYTES = 163840;
constexpr int LDS_MISC = 163840 - 256;

__device__ __forceinline__ float bf2f(unsigned b) { return __uint_as_float(b << 16); }
__device__ __forceinline__ float bflo(unsigned w) { return __uint_as_float(w << 16); }
__device__ __forceinline__ float bfhi(unsigned w) { return __uint_as_float(w & 0xffff0000u); }
typedef __bf16 bf2v __attribute__((ext_vector_type(2)));
__device__ __forceinline__ unsigned pkbf(float lo, float hi) { unsigned r; asm("v_cvt_pk_bf16_f32 %0, %1, %2" : "=v"(r) : "v"(lo), "v"(hi)); return r; }
__device__ __forceinline__ unsigned pkbf_c(float lo, float hi) { f32x2 v = {lo, hi}; bf2v r = __builtin_convertvector(v, bf2v); return __builtin_bit_cast(unsigned, r); }
template <int K> __device__ __forceinline__ float lane_xor(float v) {
    const int b = __builtin_bit_cast(int, v);
    if constexpr (K == 1) return __builtin_bit_cast(float, __builtin_amdgcn_update_dpp(0, b, 0xB1, 0xF, 0xF, true));
    else if constexpr (K == 2) return __builtin_bit_cast(float, __builtin_amdgcn_update_dpp(0, b, 0x4E, 0xF, 0xF, true));
    else if constexpr (K == 32) { auto rr = __builtin_amdgcn_permlane32_swap((unsigned)b, (unsigned)b, false, false); unsigned ln_ = __builtin_amdgcn_mbcnt_hi(~0u, __builtin_amdgcn_mbcnt_lo(~0u, 0u)); asm volatile("" : "+v"(ln_));
        return __uint_as_float((ln_ & 32u) ? rr[0] : rr[1]); }
    else return __builtin_bit_cast(float, __builtin_amdgcn_ds_swizzle(b, 0x1F | (K << 10)));
}
__device__ __forceinline__ float wave_sum(float v) {
    v += lane_xor<1>(v); v += lane_xor<2>(v);
    v += __builtin_bit_cast(float, __builtin_amdgcn_update_dpp(0, __builtin_bit_cast(int, v), 0x124, 0xF, 0xF, true));
    v += __builtin_bit_cast(float, __builtin_amdgcn_update_dpp(0, __builtin_bit_cast(int, v), 0x128, 0xF, 0xF, true));
    v += lane_xor<16>(v);
    { auto rr = __builtin_amdgcn_permlane32_swap(__float_as_uint(v), __float_as_uint(v), false, false); v = __uint_as_float(rr[0]) + __uint_as_float(rr[1]); }
    return v;
}
__device__ __forceinline__ float wave_max(float v) {
    v = fmaxf(v, lane_xor<1>(v)); v = fmaxf(v, lane_xor<2>(v));
    v = fmaxf(v, __builtin_bit_cast(float, __builtin_amdgcn_update_dpp(0, __builtin_bit_cast(int, v), 0x124, 0xF, 0xF, true)));
    v = fmaxf(v, __builtin_bit_cast(float, __builtin_amdgcn_update_dpp(0, __builtin_bit_cast(int, v), 0x128, 0xF, 0xF, true)));
    v = fmaxf(v, lane_xor<16>(v));
    { auto rr = __builtin_amdgcn_permlane32_swap(__float_as_uint(v), __float_as_uint(v), false, false); v = fmaxf(__uint_as_float(rr[0]), __uint_as_float(rr[1])); }
    return v;
}
__device__ __forceinline__ float silu_f(float x) { return x / (1.f + __expf(-x)); }
#define LDS_WAIT() asm volatile("s_waitcnt lgkmcnt(0)" ::: "memory")

#define XB_TMO      128
#define XB_XCNT(j)  (256  + 64 * (j))
#define XB_XSUB(j)  (1280 + 64 * (j))
#define XB_XGEN(j)  (2304 + 64 * (j))
#define XB_TOP      3328
#define XB_TOPGEN   3392
#define XCD_BAR_WORDS 3456
#define XB_SPIN_CAP (1u << 22)
__device__ __forceinline__ unsigned xb_ld(unsigned* p)              { return __hip_atomic_load(p, __ATOMIC_RELAXED, __HIP_MEMORY_SCOPE_AGENT); }
__device__ __forceinline__ unsigned xb_add(unsigned* p, unsigned v) { return __hip_atomic_fetch_add(p, v, __ATOMIC_RELAXED, __HIP_MEMORY_SCOPE_AGENT); }
__device__ __forceinline__ unsigned xb_xcc_id() { return (unsigned)__builtin_amdgcn_s_getreg((3 << 11) | 20) & 0xFu; }
#define XB_SPIN(cond, bar) do { unsigned _sp = 0; while (cond) { __builtin_amdgcn_s_sleep(1); \
    if ((++_sp & 255u) == 0u) { if (xb_ld(&(bar)[XB_TMO])) break; if (_sp > XB_SPIN_CAP) { atomicAdd(&(bar)[XB_TMO], 1u); break; } } } } while (0)
struct XcdBarrier { unsigned* bar; unsigned x; volatile LAS unsigned* st; };
__device__ __forceinline__ XcdBarrier xcd_barrier_post(unsigned* bar, volatile LAS unsigned* st) {
    XcdBarrier b; b.bar = bar; b.x = xb_xcc_id(); b.st = st;
    if (threadIdx.x == 0) (void)xb_add(&bar[XB_XCNT(b.x)], 1u);
    return b;
}
__device__ __forceinline__ void xcd_barrier_complete(unsigned* bar, unsigned x, unsigned& nloc, unsigned& nx) {
    const unsigned G = gridDim.x * gridDim.y * gridDim.z;
    unsigned sum, cnt, mine, sp = 0u;
    for (;;) {
        sum = 0u; cnt = 0u; mine = 0u;
#pragma unroll
        for (unsigned j = 0; j < 16; ++j) { const unsigned c = xb_ld(&bar[XB_XCNT(j)]); sum += c; cnt += (c > 0u) ? 1u : 0u; mine = (j == x) ? c : mine; }
        if (sum == G) break;
        __builtin_amdgcn_s_sleep(1);
        if ((++sp & 255u) == 0u) { if (xb_ld(&bar[XB_TMO])) break; if (sp > XB_SPIN_CAP) { atomicAdd(&bar[XB_TMO], 1u); break; } }
    }
    nloc = mine > 0u ? mine : 1u; nx = cnt > 0u ? cnt : 1u;
}
__device__ __forceinline__ void xcd_barrier(const XcdBarrier& b) {
    asm volatile("s_waitcnt vmcnt(0)" ::: "memory");
    __syncthreads();
    if (threadIdx.x == 0) {
        unsigned* bar = b.bar; unsigned bx_ = b.x;
        asm volatile("" : "+s"(bar), "+s"(bx_));
        __builtin_amdgcn_s_waitcnt(0);
        unsigned nloc = b.st[0], nx = b.st[1];
        if (nloc == 0u) { xcd_barrier_complete(bar, bx_, nloc, nx); b.st[0] = nloc; b.st[1] = nx; }
        const unsigned old = xb_add(&bar[XB_XSUB(bx_)], 1u);
        const unsigned gen = old / nloc;
        if (old + 1u == (gen + 1u) * nloc) {
            __builtin_amdgcn_fence(__ATOMIC_RELEASE, "agent");
            asm volatile("s_waitcnt vmcnt(0)" ::: "memory");
            const unsigned og = xb_add(&bar[XB_TOP], 1u);
            const unsigned tg = og / nx;
            if (og + 1u == (tg + 1u) * nx) xb_add(&bar[XB_TOPGEN], 1u);
            else XB_SPIN(xb_ld(&bar[XB_TOPGEN]) == tg, bar);
            __builtin_amdgcn_fence(__ATOMIC_ACQUIRE, "agent");
            xb_add(&bar[XB_XGEN(bx_)], 1u);
            asm volatile("s_waitcnt vmcnt(0)" ::: "memory");
        } else {
            XB_SPIN(xb_ld(&bar[XB_XGEN(bx_)]) == gen, bar);
            __builtin_amdgcn_fence(__ATOMIC_ACQUIRE, "agent");
            asm volatile("s_waitcnt vmcnt(0)" ::: "memory");
        }
    }
    __syncthreads();
}

namespace pg8 {
constexpr int BM = 256, BK = 64, HALF = 128, HTB = HALF * BK * 2, STAGE_BYTES = 8 * HTB, NXCD = 8, WGM = 8;
__host__ __device__ __forceinline__ int lds_byte(int r, int c) { const int st = (r >> 4) * 2 + (c >> 5), rr = r & 15, cc = c & 31, ob = rr * 64 + cc * 2; return st * 1024 + (ob ^ (((ob >> 9) & 1) << 5)); }
__host__ __device__ __forceinline__ void stage_rc(int b, int& R, int& C) { const int st = b / 1024, sb = b % 1024, swz = sb ^ (((sb >> 9) & 1) << 5); R = (st >> 1) * 16 + swz / 64; C = (st & 1) * 32 + (swz % 64) / 2; }
__host__ __device__ __forceinline__ int perm32(int rho) { const int n = rho >> 4, i = rho & 15; return 8 * (i >> 2) + 4 * n + (i & 3); }
struct Unit { int pm, pn; };
struct Gemm { const bf16_t* A; const bf16_t* Bt; int M, N, K; };
struct StaticOrder {
    int nM, nN, nwg, G, c;
    __host__ __device__ void init(int M_, int N_, int G_, int c_) { nM = M_ / BM; nN = N_ / BM; nwg = nM * nN; G = G_; c = c_; }
    __host__ __device__ bool next(int i, Unit& u) const {
        const long L = (long)i * G + c; if (L >= nwg) return false;
        int wgid = (int)L; { const int q = nwg / NXCD, r = nwg % NXCD, xcd = wgid % NXCD, off = wgid / NXCD; wgid = (xcd < r ? xcd * (q + 1) : r * (q + 1) + (xcd - r) * q) + off; }
        const int nig = WGM * nN, gid = wgid / nig, fm = gid * WGM, gsz = (nM - fm) < WGM ? (nM - fm) : WGM;
        u.pm = fm + ((wgid % nig) % gsz); u.pn = (wgid % nig) / gsz; return true;
    }
    __device__ __forceinline__ void a_ready(const Unit&) const {}
    __device__ __forceinline__ void done(const Unit&) const {}
};
struct EpiBf16 {
    static constexpr bool PERM = true, I8 = false; typedef f32x4 acc_t;
    bf16_t* O; int ldc;
    __device__ __forceinline__ void operator()(const f32x4 (&acc)[2][2][4][2], const Unit& u, int wr, int wc, int fr, int fq) const {
        const int row0 = u.pm * BM + wr * 64 + fr; const int col0 = u.pn * BM + wc * 32 + 8 * fq;
#pragma unroll
        for (int ai = 0; ai < 2; ++ai)
#pragma unroll
            for (int m = 0; m < 4; ++m) { bf16_t* rowp = O + (size_t)(row0 + ai * HALF + m * 16) * ldc + col0;
#pragma unroll
                for (int bj = 0; bj < 2; ++bj) { const f32x4 v0 = acc[ai][bj][m][0], v1 = acc[ai][bj][m][1];
                    u32x4 w; w.x = pkbf_c(v0[0], v0[1]); w.y = pkbf_c(v0[2], v0[3]); w.z = pkbf_c(v1[0], v1[1]); w.w = pkbf_c(v1[2], v1[3]);
                    *(u32x4*)(rowp + bj * HALF) = w; } }
    }
};
struct EpiBf16I8 {
    static constexpr bool PERM = true, I8 = true; typedef i32x4 acc_t;
    bf16_t* O; int ldc; const float* sa; const float* wmax;
    __device__ __forceinline__ void operator()(const i32x4 (&acc)[2][2][4][2], const Unit& u, int wr, int wc, int fr, int fq) const {
        const int row0 = u.pm * BM + wr * 64 + fr; const int col0 = u.pn * BM + wc * 32 + 8 * fq;
        f32x4 sw[2][2];
#pragma unroll
        for (int bj = 0; bj < 2; ++bj)
#pragma unroll
            for (int n = 0; n < 2; ++n) sw[bj][n] = *(const f32x4*)(wmax + col0 + bj * HALF + 4 * n) * (1.f / 127.f);
#pragma unroll
        for (int ai = 0; ai < 2; ++ai)
#pragma unroll
            for (int m = 0; m < 4; ++m) { const int row = row0 + ai * HALF + m * 16; const float sr = sa[row]; bf16_t* rowp = O + (size_t)row * ldc + col0;
#pragma unroll
                for (int bj = 0; bj < 2; ++bj) { const i32x4 a0 = acc[ai][bj][m][0], a1 = acc[ai][bj][m][1];
                    const f32x4 v0 = (f32x4){(float)a0[0], (float)a0[1], (float)a0[2], (float)a0[3]} * sw[bj][0] * sr, v1 = (f32x4){(float)a1[0], (float)a1[1], (float)a1[2], (float)a1[3]} * sw[bj][1] * sr;
                    u32x4 w; w.x = pkbf(v0[0], v0[1]); w.y = pkbf(v0[2], v0[3]); w.z = pkbf(v1[0], v1[1]); w.w = pkbf(v1[2], v1[3]);
                    *(u32x4*)(rowp + bj * HALF) = w; } }
    }
};
struct EpiRes {
    static constexpr bool PERM = false, I8 = false; typedef f32x4 acc_t;
    const float* src_lat; const float* src_ctx; float* dst_lat; float* dst_ctx; const float* gate;
    __device__ __forceinline__ void operator()(const f32x4 (&acc)[2][2][4][2], const Unit& u, int wr, int wc, int fr, int fq) const {
        const bool isctx = u.pm >= (ML / BM);
        const float* src = isctx ? src_ctx + (size_t)(u.pm - ML / BM) * BM * D : src_lat + (size_t)u.pm * BM * D;
        float* dst = isctx ? dst_ctx + (size_t)(u.pm - ML / BM) * BM * D : dst_lat + (size_t)u.pm * BM * D;
        const int mrow = isctx ? 2 : (u.pm >= (T / BM) ? 1 : 0);
        const int row0 = wr * 64 + fr, col0 = u.pn * BM + wc * 32 + 4 * fq;
        f32x4 gv[2][2];
#pragma unroll
        for (int bj = 0; bj < 2; ++bj)
#pragma unroll
            for (int n = 0; n < 2; ++n) gv[bj][n] = *(const f32x4*)(gate + mrow * 6144 + col0 + bj * HALF + n * 16);
#pragma unroll
        for (int ai = 0; ai < 2; ++ai)
#pragma unroll
            for (int m = 0; m < 4; ++m) { const size_t off = (size_t)(row0 + ai * HALF + m * 16) * D + col0;
#pragma unroll
                for (int bj = 0; bj < 2; ++bj)
#pragma unroll
                    for (int n = 0; n < 2; ++n) { const f32x4 s = *(const f32x4*)(src + off + bj * HALF + n * 16);
                        *(f32x4*)(dst + off + bj * HALF + n * 16) = s + gv[bj][n] * acc[ai][bj][m][n]; } }
    }
};

struct EpiResI8 {
    static constexpr bool PERM = false, I8 = true; typedef i32x4 acc_t;
    const float* src_lat; const float* src_ctx; float* dst_lat; float* dst_ctx; const float* gate; const float* sa; const float* wmax;
    __device__ __forceinline__ void operator()(const i32x4 (&acc)[2][2][4][2], const Unit& u, int wr, int wc, int fr, int fq) const {
        const bool isctx = u.pm >= (ML / BM);
        const float* src = isctx ? src_ctx + (size_t)(u.pm - ML / BM) * BM * D : src_lat + (size_t)u.pm * BM * D;
        float* dst = isctx ? dst_ctx + (size_t)(u.pm - ML / BM) * BM * D : dst_lat + (size_t)u.pm * BM * D;
        const int mrow = isctx ? 2 : (u.pm >= (T / BM) ? 1 : 0);
        const int row0 = wr * 64 + fr, col0 = u.pn * BM + wc * 32 + 4 * fq;
        f32x4 gv[2][2];
#pragma unroll
        for (int bj = 0; bj < 2; ++bj)
#pragma unroll
            for (int n = 0; n < 2; ++n) gv[bj][n] = *(const f32x4*)(gate + mrow * 6144 + col0 + bj * HALF + n * 16) * *(const f32x4*)(wmax + col0 + bj * HALF + n * 16) * (1.f / 127.f);
#pragma unroll
        for (int ai = 0; ai < 2; ++ai)
#pragma unroll
            for (int m = 0; m < 4; ++m) { const int rl = row0 + ai * HALF + m * 16; const float sr = sa[u.pm * BM + rl]; const size_t off = (size_t)rl * D + col0;
#pragma unroll
                for (int bj = 0; bj < 2; ++bj)
#pragma unroll
                    for (int n = 0; n < 2; ++n) { const f32x4 sv = *(const f32x4*)(src + off + bj * HALF + n * 16); const i32x4 ac = acc[ai][bj][m][n];
                        *(f32x4*)(dst + off + bj * HALF + n * 16) = sv + gv[bj][n] * ((f32x4){(float)ac[0], (float)ac[1], (float)ac[2], (float)ac[3]} * sr); } }
    }
};
template <class Epi, class Sched>
__device__ __forceinline__ void gemm_phase(LAS unsigned char* lds, const Gemm g, const Sched& S, const Epi& E) {
    constexpr bool I8 = Epi::I8;
    typedef typename Epi::acc_t acc_t;
    int tid = threadIdx.x; asm volatile("" : "+v"(tid)); const int wid = __builtin_amdgcn_readfirstlane(tid >> 6), lane = tid & 63, wr = wid >> 2, wc = wid & 3, fr = lane & 15, fq = lane >> 4;
    const int K = g.K, nt = K / BK;
    unsigned voffA[2], voffB[2];
#pragma unroll
    for (int i = 0; i < 2; ++i) { int R, C; stage_rc(tid * 16 + i * 8192, R, C); const int Rb = Epi::PERM ? ((R & ~31) + perm32(R & 31)) : R;
        voffA[i] = (unsigned)(R * K + C) * 2u; voffB[i] = (unsigned)(Rb * K + C) * 2u; }
    const size_t kstep = (size_t)(BK * 2);
    const size_t hstep = (size_t)HALF * K * 2;
    const size_t tstep = 2 * hstep;
    const unsigned ldsw = (unsigned)wid * 1024u;
    const int aoff = lds_byte(wr * 64 + fr, fq * 8), boff = lds_byte(wc * 32 + fr, fq * 8);
#define PG8_SA(b, h) (((b) * 2 + (h)) * HTB)
#define PG8_SB(b, h) ((4 + (b) * 2 + (h)) * HTB)
#define PG8_STAGE(bufoff, gbase, voff) do { _Pragma("unroll") for (int _i = 0; _i < 2; ++_i) \
        __builtin_amdgcn_global_load_lds((const unsigned*)((const char*)(gbase) + (voff)[_i]), (LAS unsigned*)(lds + (bufoff) + ldsw + _i * 8192), 16, 0, 0); } while (0)
#define PG8_LDA(dst, b, h) do { _Pragma("unroll") for (int m = 0; m < 4; ++m) _Pragma("unroll") for (int k = 0; k < 2; ++k) dst[m][k] = *(const LAS bf16x8*)(lds + PG8_SA(b, h) + aoff + m * 2048 + k * 1024); } while (0)
#define PG8_LDB(dst, b, h) do { _Pragma("unroll") for (int n = 0; n < 2; ++n) _Pragma("unroll") for (int k = 0; k < 2; ++k) dst[n][k] = *(const LAS bf16x8*)(lds + PG8_SB(b, h) + boff + n * 2048 + k * 1024); } while (0)
#define PG8_MMA(ai, bj, At, Bt) do { __builtin_amdgcn_s_setprio(1); _Pragma("unroll") for (int m = 0; m < 4; ++m) _Pragma("unroll") for (int n = 0; n < 2; ++n) _Pragma("unroll") for (int k = 0; k < 2; ++k) \
        { if constexpr (I8) acc[ai][bj][m][n] = __builtin_bit_cast(acc_t, __builtin_amdgcn_mfma_i32_16x16x64_i8(__builtin_bit_cast(i32x4, Bt[n][k]), __builtin_bit_cast(i32x4, At[m][k]), __builtin_bit_cast(i32x4, acc[ai][bj][m][n]), 0, 0, 0)); \
          else acc[ai][bj][m][n] = __builtin_bit_cast(acc_t, __builtin_amdgcn_mfma_f32_16x16x32_bf16(Bt[n][k], At[m][k], __builtin_bit_cast(f32x4, acc[ai][bj][m][n]), 0, 0, 0)); } __builtin_amdgcn_s_setprio(0); } while (0)
#define PG8_WAIT_V(n) asm volatile("s_waitcnt vmcnt(" #n ")" ::: "memory")
#define PG8_WAIT_L(n) asm volatile("s_waitcnt lgkmcnt(" #n ")" ::: "memory")
#define PG8_BAR __builtin_amdgcn_s_barrier()
#define PG8_SCHED __builtin_amdgcn_sched_barrier(0)
    Unit cur, nxt; int ui = 0;
    if (!S.next(0, cur)) return;
    acc_t acc[2][2][4][2];
#pragma unroll
    for (int a = 0; a < 2; ++a)
#pragma unroll
        for (int b = 0; b < 2; ++b)
#pragma unroll
            for (int m = 0; m < 4; ++m)
#pragma unroll
                for (int n = 0; n < 2; ++n) acc[a][b][m][n] = acc_t{};
    bf16x8 At[4][2], B0[2][2], B1[2][2];
    const char* cA = (const char*)g.A + (size_t)cur.pm * tstep; const char* cB = (const char*)g.Bt + (size_t)cur.pn * tstep;
    S.a_ready(cur);
    PG8_STAGE(PG8_SB(0, 0), cB, voffB); PG8_STAGE(PG8_SA(0, 0), cA, voffA); PG8_STAGE(PG8_SB(0, 1), cB + hstep, voffB); PG8_STAGE(PG8_SA(0, 1), cA + hstep, voffA);
    if (wr == 1) PG8_BAR;
    PG8_WAIT_V(4); PG8_BAR;
    PG8_STAGE(PG8_SB(1, 0), cB + kstep, voffB); PG8_STAGE(PG8_SA(1, 0), cA + kstep, voffA); PG8_STAGE(PG8_SB(1, 1), cB + hstep + kstep, voffB);
    PG8_WAIT_V(6); PG8_BAR;
    for (;;) {
        const bool has_next = S.next(ui + 1, nxt);
        const char* nA = has_next ? (const char*)g.A + (size_t)nxt.pm * tstep : cA; const char* nB = has_next ? (const char*)g.Bt + (size_t)nxt.pn * tstep : cB;
        for (int t = 0; t < nt; t += 2) {
            const bool last = (t == nt - 2);
            const char* a1 = cA + (size_t)(t + 1) * kstep;
            const char* a2 = last ? nA : cA + (size_t)(t + 2) * kstep; const char* b2 = last ? nB : cB + (size_t)(t + 2) * kstep;
            const char* a3 = a2 + kstep; const char* b3 = b2 + kstep;
            if (last && has_next) S.a_ready(nxt);
            PG8_LDB(B0, 0, 0); PG8_SCHED; PG8_LDA(At, 0, 0); PG8_STAGE(PG8_SA(1, 1), a1 + hstep, voffA);
            PG8_WAIT_L(8); PG8_BAR; PG8_WAIT_L(0); PG8_MMA(0, 0, At, B0); PG8_BAR; PG8_SCHED;
            PG8_LDB(B1, 0, 1); PG8_STAGE(PG8_SB(0, 0), b2, voffB);
            PG8_BAR; PG8_WAIT_L(0); PG8_MMA(0, 1, At, B1); PG8_BAR;
            PG8_LDA(At, 0, 1); PG8_STAGE(PG8_SA(0, 0), a2, voffA);
            PG8_BAR; PG8_WAIT_L(0); PG8_MMA(1, 0, At, B0); PG8_BAR; PG8_SCHED;
            PG8_STAGE(PG8_SB(0, 1), b2 + hstep, voffB);
            PG8_WAIT_V(6); PG8_BAR; PG8_MMA(1, 1, At, B1); PG8_BAR;
            PG8_LDB(B0, 1, 0); PG8_SCHED; PG8_LDA(At, 1, 0); PG8_STAGE(PG8_SA(0, 1), a2 + hstep, voffA);
            PG8_WAIT_L(8); PG8_BAR; PG8_WAIT_L(0); PG8_MMA(0, 0, At, B0); PG8_BAR; PG8_SCHED;
            PG8_LDB(B1, 1, 1); PG8_STAGE(PG8_SB(1, 0), b3, voffB);
            PG8_BAR; PG8_WAIT_L(0); PG8_MMA(0, 1, At, B1); PG8_BAR;
            PG8_LDA(At, 1, 1); PG8_STAGE(PG8_SA(1, 0), a3, voffA);
            PG8_BAR; PG8_WAIT_L(0); PG8_MMA(1, 0, At, B0); PG8_BAR; PG8_SCHED;
            PG8_STAGE(PG8_SB(1, 1), b3 + hstep, voffB);
            PG8_WAIT_V(6); PG8_BAR; PG8_MMA(1, 1, At, B1); PG8_BAR;
        }
        E(acc, cur, wr, wc, fr, fq); S.done(cur);
        if (!has_next) break;
#pragma unroll
        for (int a = 0; a < 2; ++a)
#pragma unroll
            for (int b = 0; b < 2; ++b)
#pragma unroll
                for (int m = 0; m < 4; ++m)
#pragma unroll
                    for (int n = 0; n < 2; ++n) acc[a][b][m][n] = acc_t{};
        cur = nxt; cA = nA; cB = nB; ++ui;
    }
    PG8_WAIT_V(0);
    if (wr == 0) PG8_BAR;
    PG8_BAR;
#undef PG8_SA
#undef PG8_SB
#undef PG8_STAGE
#undef PG8_LDA
#undef PG8_LDB
#undef PG8_MMA
#undef PG8_WAIT_V
#undef PG8_WAIT_L
#undef PG8_BAR
#undef PG8_SCHED
}
}

namespace att {
constexpr int HD = 128, NW = 8, QBLK = 32, KVBLK = 64;
constexpr float SCALE = 0.088388347648318440f;
constexpr float THR = 8.f;
constexpr int LDQ = 512, LDK = 256;
constexpr size_t SHM_V = KVBLK * HD * 2, SHM_K = KVBLK * HD * 2, SHM_ATTN = 2 * SHM_V + 2 * SHM_K + NW * 64 * 4;
#define KSWZ(row, colB) ((row) * 256 + ((colB) ^ (((row) & 7) << 4)))
#define SBAR() __builtin_amdgcn_sched_barrier(0)
__device__ __forceinline__ int crow(int r, int hi) { return (r & 3) + 8 * (r >> 2) + 4 * hi; }
__device__ __forceinline__ unsigned cvtpk(float lo, float hi) { unsigned r; asm volatile("v_cvt_pk_bf16_f32 %0, %1, %2" : "=v"(r) : "v"(lo), "v"(hi)); return r; }
__device__ __forceinline__ void partialSM(f32x16& p0, f32x16& p1, float mnC, bool shift) {
  if (__builtin_expect(shift, 0)) { for (int r = 0; r < 16; ++r) p0[r] += mnC; for (int r = 0; r < 16; ++r) p1[r] += mnC; }
  for (int r = 0; r < 16; ++r) p0[r] = __builtin_amdgcn_exp2f(p0[r]);
}
__device__ __forceinline__ void finishSM(f32x16& p0, f32x16& p1, float& l_reg, bf16x8& pa0, bf16x8& pa1, bf16x8& pa2, bf16x8& pa3) {
  for (int r = 0; r < 16; ++r) p1[r] = __builtin_amdgcn_exp2f(p1[r]);
  float ps = 0; for (int r = 0; r < 16; ++r) ps += p0[r]; for (int r = 0; r < 16; ++r) ps += p1[r];
  { auto rr = __builtin_amdgcn_permlane32_swap(__float_as_uint(ps), __float_as_uint(ps), false, false);
    ps = __uint_as_float(rr[0]) + __uint_as_float(rr[1]); }
  l_reg += ps;
#define PK4(P, BASE, OUT) do { unsigned a0 = cvtpk(P[BASE + 0], P[BASE + 1]), a1 = cvtpk(P[BASE + 2], P[BASE + 3]);   \
    unsigned b0 = cvtpk(P[BASE + 4], P[BASE + 5]), b1 = cvtpk(P[BASE + 6], P[BASE + 7]);                              \
    auto r0 = __builtin_amdgcn_permlane32_swap(a0, b0, false, false); auto r1 = __builtin_amdgcn_permlane32_swap(a1, b1, false, false); \
    u32x4 w = {r0[0], r1[0], r0[1], r1[1]}; OUT = *reinterpret_cast<bf16x8*>(&w); } while (0)
  PK4(p0, 0, pa0); PK4(p0, 8, pa1); PK4(p1, 0, pa2); PK4(p1, 8, pa3);
#undef PK4
}
typedef int i32x8 __attribute__((ext_vector_type(8)));
constexpr int K8_STRIDE = 144, K8_TILE = KVBLK * K8_STRIDE;
__device__ __forceinline__ void qkt(f32x16& p0, f32x16& p1, const unsigned char* Ks, const i32x8* qr, int r32, int hi) {
  p0 = f32x16{}; p1 = f32x16{};
#pragma unroll
  for (int ks = 0; ks < 2; ++ks) {
    const u32x4* a0 = (const u32x4*)(Ks + r32 * K8_STRIDE + 64 * ks + 32 * hi); const u32x4* a1 = (const u32x4*)(Ks + (32 + r32) * K8_STRIDE + 64 * ks + 32 * hi);
    const u32x4 x0 = a0[0], x1 = a0[1], y0 = a1[0], y1 = a1[1];
    const i32x8 k0 = {(int)x0.x, (int)x0.y, (int)x0.z, (int)x0.w, (int)x1.x, (int)x1.y, (int)x1.z, (int)x1.w}, k1 = {(int)y0.x, (int)y0.y, (int)y0.z, (int)y0.w, (int)y1.x, (int)y1.y, (int)y1.z, (int)y1.w};
    p0 = __builtin_amdgcn_mfma_scale_f32_32x32x64_f8f6f4(k0, qr[ks], p0, 0, 0, 0, 0x7F7F7F7F, 0, 0x7C7C7C7C);
    p1 = __builtin_amdgcn_mfma_scale_f32_32x32x64_f8f6f4(k1, qr[ks], p1, 0, 0, 0, 0x7F7F7F7F, 0, 0x7C7C7C7C); }
}
__device__ __forceinline__ int v_st(int k, int c) { const int kk = (k & ~0xC) | ((k & 4) << 1) | ((k & 8) >> 1); return ((kk >> 3) * 4 + (c >> 5)) * 512 + ((kk & 7) * 32 + (c & 31)) * 2; }
__device__ __forceinline__ int v_rd_base(int lane) { return ((lane & 3) << 3) | (((lane >> 2) & 3) << 6) | (((lane >> 4) & 1) << 5) | (((lane >> 5) & 1) << 8); }
constexpr int v_rd_off(int d0, int ks, int half) { return d0 * 512 + ks * 4096 + half * 2048; }
template <int OFF> __device__ __forceinline__ s16x4 tr_read(int vb) {
  s16x4 r; asm volatile("ds_read_b64_tr_b16 %0, %1 offset:%2" : "=&v"(r) : "v"(vb), "i"(OFF) : "memory"); return r;
}
template <int D0> __device__ __forceinline__ void pv_one(f32x16& od, int vb, bf16x8 pa0, bf16x8 pa1, bf16x8 pa2, bf16x8 pa3) {
  const s16x4 l0 = tr_read<v_rd_off(D0, 0, 0)>(vb), h0 = tr_read<v_rd_off(D0, 0, 1)>(vb), l1 = tr_read<v_rd_off(D0, 1, 0)>(vb), h1 = tr_read<v_rd_off(D0, 1, 1)>(vb);
  const s16x4 l2 = tr_read<v_rd_off(D0, 2, 0)>(vb), h2 = tr_read<v_rd_off(D0, 2, 1)>(vb), l3 = tr_read<v_rd_off(D0, 3, 0)>(vb), h3 = tr_read<v_rd_off(D0, 3, 1)>(vb);
  asm volatile("s_waitcnt lgkmcnt(0)" ::: "memory"); SBAR();
#define PK(L, H) (bf16x8){L[0], L[1], L[2], L[3], H[0], H[1], H[2], H[3]}
  od = __builtin_amdgcn_mfma_f32_32x32x16_bf16(pa0, PK(l0, h0), od, 0, 0, 0);
  od = __builtin_amdgcn_mfma_f32_32x32x16_bf16(pa1, PK(l1, h1), od, 0, 0, 0);
  od = __builtin_amdgcn_mfma_f32_32x32x16_bf16(pa2, PK(l2, h2), od, 0, 0, 0);
  od = __builtin_amdgcn_mfma_f32_32x32x16_bf16(pa3, PK(l3, h3), od, 0, 0, 0);
#undef PK
}
__device__ __forceinline__ void pv_d0(f32x16* o, int vb, bf16x8 pa0, bf16x8 pa1, bf16x8 pa2, bf16x8 pa3) {
  pv_one<0>(o[0], vb, pa0, pa1, pa2, pa3); pv_one<1>(o[1], vb, pa0, pa1, pa2, pa3); pv_one<2>(o[2], vb, pa0, pa1, pa2, pa3); pv_one<3>(o[3], vb, pa0, pa1, pa2, pa3);
}
__device__ __forceinline__ void attn_dense_body(const unsigned char* __restrict__ Qb, const unsigned char* __restrict__ Kh, const bf16_t* __restrict__ Vh,
                                                bf16_t* __restrict__ Ob, int LDO, int seq, char* lds, float* __restrict__ lse, float braw) {
  int tid = threadIdx.x; asm volatile("" : "+v"(tid)); const int wid = tid >> 6, lane = tid & 63, r32 = lane & 31, hi = lane >> 5;
  bf16_t* V_lds = (bf16_t*)lds; unsigned char* K_lds = (unsigned char*)(lds + 2 * SHM_V);
  float* ws = (float*)(lds + 2 * SHM_V + 2 * K8_TILE) + wid * 64; float* li_l = ws;
  float l_reg = 0; f32x16 o[4] = {}; i32x8 qr[2];
  bool shift = braw * (SCALE * 1.4426950408889634f) > 64.f; { int sh_ = __builtin_amdgcn_readfirstlane((int)shift); asm volatile("" : "+s"(sh_)); shift = sh_ != 0; }
  const float mnC = __builtin_bit_cast(float, __builtin_amdgcn_readfirstlane(__builtin_bit_cast(int, shift ? -braw * (SCALE * 1.4426950408889634f) : 0.f)));
  const unsigned char* Qw = Qb + (long)(wid * QBLK + r32) * LDQ + hi * 32;
#pragma unroll
  for (int ks = 0; ks < 2; ++ks) { const u32x4 x0 = *(const u32x4*)(Qw + 64 * ks), x1 = *(const u32x4*)(Qw + 64 * ks + 16);
    qr[ks] = (i32x8){(int)x0.x, (int)x0.y, (int)x0.z, (int)x0.w, (int)x1.x, (int)x1.y, (int)x1.z, (int)x1.w}; }
  const int krow = tid >> 3, kch = tid & 7;
  const int sr = tid >> 4, sc = (tid & 15) * 8, vst0 = v_st(sr, sc), vst1 = v_st(32 + sr, sc);
  const int vb0 = (int)(uintptr_t)V_lds + v_rd_base(lane);
  struct { bf16x8 vs0, vs1; u32x4 k8; } sr_[2];
#define SLOAD(i, k0) do { sr_[i].vs0 = *reinterpret_cast<const bf16x8*>(&Vh[(long)((k0) + sr) * LDK + sc]); sr_[i].vs1 = *reinterpret_cast<const bf16x8*>(&Vh[(long)((k0) + 32 + sr) * LDK + sc]); \
    sr_[i].k8 = *reinterpret_cast<const u32x4*>(Kh + (long)((k0) + krow) * LDK + kch * 16); } while (0)
#define SWRITE(b, i) do { *(bf16x8*)((char*)V_lds + (b) * SHM_V + vst0) = sr_[i].vs0;          \
    *(bf16x8*)((char*)V_lds + (b) * SHM_V + vst1) = sr_[i].vs1;               \
    *(u32x4*)(K_lds + (b) * K8_TILE + krow * K8_STRIDE + kch * 16) = sr_[i].k8; } while (0)
#define SWAIT() asm volatile("s_waitcnt vmcnt(3)" ::: "memory")
  f32x16 pA0, pA1, pB0, pB1; bf16x8 pa0, pa1, pa2, pa3; const int NT = seq / KVBLK;
  constexpr int SE = 0, SO = 1;
  SLOAD(SE, 0); asm volatile("s_waitcnt vmcnt(0)" ::: "memory"); SWRITE(0, SE); __syncthreads();
  qkt(pA0, pA1, K_lds, qr, r32, hi); partialSM(pA0, pA1, mnC, shift);
  SLOAD(SO, KVBLK); SLOAD(SE, 2 * KVBLK);
  SWAIT(); SWRITE(1, SO); __syncthreads();
  for (int j = 1; j + 1 < NT; j += 2) {
    SBAR(); qkt(pB0, pB1, K_lds + K8_TILE, qr, r32, hi);
    finishSM(pA0, pA1, l_reg, pa0, pa1, pa2, pa3); SBAR();
    SLOAD(SO, (j + 2) * KVBLK); SBAR();
    pv_d0(o, vb0, pa0, pa1, pa2, pa3); partialSM(pB0, pB1, mnC, shift);
    __syncthreads(); SWAIT(); SWRITE(0, SE);
    __syncthreads();
    SBAR(); qkt(pA0, pA1, K_lds, qr, r32, hi);
    finishSM(pB0, pB1, l_reg, pa0, pa1, pa2, pa3); SBAR();
    SLOAD(SE, (j + 3 < NT ? j + 3 : NT - 1) * KVBLK); SBAR();
    pv_d0(o, vb0 + (int)SHM_V, pa0, pa1, pa2, pa3); partialSM(pA0, pA1, mnC, shift);
    __syncthreads(); SWAIT(); SWRITE(1, SO);
    __syncthreads();
  }
  SBAR(); qkt(pB0, pB1, K_lds + K8_TILE, qr, r32, hi);
  finishSM(pA0, pA1, l_reg, pa0, pa1, pa2, pa3); SBAR();
  pv_d0(o, vb0, pa0, pa1, pa2, pa3); partialSM(pB0, pB1, mnC, shift);
  __syncthreads();
  finishSM(pB0, pB1, l_reg, pa0, pa1, pa2, pa3); SBAR();
  pv_d0(o, vb0 + (int)SHM_V, pa0, pa1, pa2, pa3);
  if (hi == 0) { li_l[r32] = l_reg; if (lse) lse[(wid * QBLK + r32) * 4] = __logf(l_reg) - mnC * 0.69314718055994531f; }
  asm volatile("s_waitcnt lgkmcnt(0)" ::: "memory");
  float rli[16];
#pragma unroll
  for (int r = 0; r < 16; ++r) rli[r] = __builtin_amdgcn_rcpf(li_l[crow(r, hi)]);
  bf16_t* Ow = Ob + (long)(wid * QBLK) * LDO;
#pragma unroll
  for (int r = 0; r < 16; ++r) { int orow = crow(r, hi);
    for (int d0 = 0; d0 < 4; ++d0) Ow[(long)orow * LDO + d0 * 32 + r32] = (bf16_t)(pkbf(o[d0][r] * rli[r], 0.f) & 0xffffu); }
  __syncthreads();
#undef SLOAD
#undef SWRITE
#undef SWAIT
}
}

struct Args { const float* in[20]; float* out; unsigned char* ws; int ph_lo, ph_hi; };
typedef const __attribute__((address_space(4))) Args* KArgs;
__device__ __forceinline__ KArgs get_args() { KArgs p = (KArgs)__builtin_amdgcn_kernarg_segment_ptr(); asm volatile("" : "+s"(p)); return p; }
__device__ __forceinline__ int fresh_tid() { int t = threadIdx.x; asm volatile("" : "+v"(t)); return t; }
__device__ __forceinline__ int fresh_bx() { int t = blockIdx.x; asm volatile("" : "+s"(t)); return t; }
__device__ __forceinline__ int fresh_g() { int t = gridDim.x; asm volatile("" : "+s"(t)); return t; }
enum { I_X = 0, I_C, I_CTX, I_CCTX, I_ADAW, I_ADAB, I_N1W, I_N2W, I_WIN, I_QNW, I_KNW, I_CONVW, I_ALOG, I_DTB, I_DNW, I_WOUT, I_WQ, I_SUBK, I_U, I_V };

__device__ __forceinline__ void convert_tables(const float* U, const float* V, unsigned char* ws, int l, int wvi, int nwv, int lane, int rw_end = 2 * NEXP) {
    const float* us = U + (size_t)l * NEXP * 1024; const float* vs = V + (size_t)l * NEXP * 1024;
    const int set = l & 1;
    float* scl = (float*)(ws + WS_USC) + set * 2 * NEXP;
    for (int rw = wvi; rw < rw_end; rw += nwv) {
        const bool isu = rw < NEXP; const int e = isu ? rw : rw - NEXP;
        const f32x4* sp = (const f32x4*)((isu ? us : vs) + (size_t)e * 1024 + 16 * lane);
        f32x4 x[4]; float mx = 0.f;
#pragma unroll
        for (int i = 0; i < 4; ++i) { x[i] = sp[i]; mx = fmaxf(mx, fmaxf(fmaxf(fabsf(x[i][0]), fabsf(x[i][1])), fmaxf(fabsf(x[i][2]), fabsf(x[i][3])))); }
        mx = wave_max(mx);
        const float sc = fmaxf(mx, 1e-30f) * (1.f / 127.f), inv = 1.f / sc;
        u32x4 o4;
#pragma unroll
        for (int i = 0; i < 4; ++i) { const unsigned b0 = (unsigned)(int)(rintf(x[i][0] * inv) + 128.f), b1 = (unsigned)(int)(rintf(x[i][1] * inv) + 128.f), b2 = (unsigned)(int)(rintf(x[i][2] * inv) + 128.f), b3 = (unsigned)(int)(rintf(x[i][3] * inv) + 128.f);
            o4[i] = b0 | (b1 << 8) | (b2 << 16) | (b3 << 24); }
        *(u32x4*)(ws + WS_UB + (size_t)set * TAB_SET + (size_t)e * 2048 + (isu ? 0 : 1024) + 16 * lane) = o4;
        if (lane == 0) scl[rw] = sc;
    }
}

__device__ __forceinline__ void transpose_item(const float* W, int ldw, int K, bf16_t* WT, LAS float* scr, int kb, int nb, int lane) {
    const int k0 = 64 * kb, n0 = 32 * nb;
#pragma unroll 8
    for (int i = 0; i < 32; ++i) { const int kk = 2 * i + (lane >> 5); scr[kk * 33 + (lane & 31)] = W[(size_t)(k0 + kk) * ldw + n0 + (lane & 31)]; }
    LDS_WAIT(); asm volatile("" ::: "memory");
    const int c = lane & 7;
#pragma unroll
    for (int j = 0; j < 4; ++j) { const int n = (lane >> 3) + 8 * j; const LAS float* s = scr + (8 * c) * 33 + n;
        u32x4 o; o.x = pkbf(s[0 * 33], s[1 * 33]); o.y = pkbf(s[2 * 33], s[3 * 33]); o.z = pkbf(s[4 * 33], s[5 * 33]); o.w = pkbf(s[6 * 33], s[7 * 33]);
        *(u32x4*)(WT + (size_t)(n0 + n) * K + k0 + 8 * c) = o; }
    LDS_WAIT(); asm volatile("" ::: "memory");
}
__device__ __forceinline__ void phase_prologue(LAS unsigned char* lds) {
    const KArgs ap = get_args();
#define a (*ap)

    const int tid = fresh_tid(), lane = tid & 63, wave = __builtin_amdgcn_readfirstlane(tid >> 6), G = fresh_g(), bx = fresh_bx();
    unsigned char* ws = a.ws;
    {
        LAS float* sc = (LAS float*)(lds + 70000);
        LAS float* part = (LAS float*)(lds + 70000 + 12288);
        for (int i = tid; i < 3 * 1024; i += 512) { const int r = i >> 10, k = i & 1023; const float v = r < 2 ? a.in[I_C][r * 1024 + k] : a.in[I_CCTX][k]; sc[i] = silu_f(v); }
        __syncthreads();
        float* mod = (float*)(ws + WS_MOD);
        for (int item = bx; item < DEPTH * 96; item += G) {
            const int l = item / 96, j0 = (item % 96) * 64;
            const float* wp = a.in[I_ADAW] + (size_t)l * 1024 * 6144 + (size_t)(wave * 128) * 6144 + j0 + lane;
            float a0 = 0.f, a1 = 0.f, a2 = 0.f;
#pragma unroll 8
            for (int kk = 0; kk < 128; ++kk) { const float w = wp[(size_t)kk * 6144]; const int k = wave * 128 + kk; a0 = fmaf(sc[k], w, a0); a1 = fmaf(sc[1024 + k], w, a1); a2 = fmaf(sc[2048 + k], w, a2); }
            part[(wave * 3 + 0) * 64 + lane] = a0; part[(wave * 3 + 1) * 64 + lane] = a1; part[(wave * 3 + 2) * 64 + lane] = a2;
            __syncthreads();
            if (tid < 192) { const int r = tid >> 6, jj = tid & 63; float s = a.in[I_ADAB][l * 6144 + j0 + jj];
#pragma unroll
                for (int w = 0; w < 8; ++w) s += part[(w * 3 + r) * 64 + jj];
                mod[(size_t)(l * 3 + r) * 6144 + j0 + jj] = s; }
            __syncthreads();
        }
    }
    {
        const int gw = bx * 8 + wave, NGW = G * 8;
        unsigned* wmaxw = (unsigned*)(ws + WS_CTL) + CW_WMAX;
        constexpr int NB_IN = NP / 64, NB_OUT = 1024 / 64, NB_Q = 2048 / 64, PER_L2 = (NB_IN + NB_OUT + NB_Q) * 8;
        for (int it = gw; it < DEPTH * PER_L2; it += NGW) { const int l = it / PER_L2; int r = it % PER_L2; const int kc = r & 7; r >>= 3;
            const int mi = r < NB_IN ? 0 : r < NB_IN + NB_OUT ? 1 : 2; const int nb = mi == 0 ? r : mi == 1 ? r - NB_IN : r - NB_IN - NB_OUT; const int ldw = mi == 0 ? NIN : mi == 1 ? 1024 : 2048;
            const float* wp = (mi == 0 ? a.in[I_WIN] + (size_t)l * 1024 * NIN : mi == 1 ? a.in[I_WOUT] + (size_t)l * 1024 * 1024 : a.in[I_WQ] + (size_t)l * 1024 * 2048) + (size_t)(kc * 128) * ldw + nb * 64 + lane;
            float mx = 0.f;
#pragma unroll 8
            for (int kk = 0; kk < 128; ++kk) mx = fmaxf(mx, fabsf(wp[(size_t)kk * ldw]));
            atomicMax(wmaxw + (l * 3 + mi) * 3072 + nb * 64 + lane, __float_as_uint(mx)); }
    }
    const size_t gt = (size_t)bx * 512 + tid, NT = (size_t)G * 512;
    for (size_t i = gt; i < (size_t)DEPTH * 16 * 1024; i += NT) { const int l = (int)(i >> 14), j = (int)((i >> 10) & 15), k = (int)(i & 1023);
        ((float*)(ws + WS_WSK))[i] = a.in[I_WIN][(size_t)l * 1024 * NIN + (size_t)k * NIN + NP + j]; }
    convert_tables(a.in[I_U], a.in[I_V], ws, 0, bx * 8 + wave, G * 8, lane);
    for (size_t i = gt; i < (size_t)DEPTH * 8 * 2 * 128 * 128 / 2; i += NT) { const f32x2 x = ((const f32x2*)a.in[I_SUBK])[i]; ((unsigned*)(ws + WS_SKB))[i] = pkbf(x[0], x[1]); }
    for (size_t i = gt; i < 8192; i += NT) { const int pos = (int)(i >> 5), fi = (int)(i & 31);
        const float inv = exp2f(-(float)fi * (13.287712379549449f / 32.f)); const float ang = (float)pos * inv;
        float rev = ang * 0.15915494309189535f; rev -= floorf(rev);
        ((float*)(ws + WS_ROPE))[i] = __builtin_amdgcn_cosf(rev); ((float*)(ws + WS_ROPE))[8192 + i] = __builtin_amdgcn_sinf(rev); }
}


__device__ __forceinline__ void quant_transpose_item(const float* W, int ldw, signed char* WT, const unsigned* wmaxw, LAS float* scr, int kb, int nb, int lane) {
    const int k0 = 64 * kb, n0 = 32 * nb;
#pragma unroll 8
    for (int i = 0; i < 32; ++i) { const int kk = 2 * i + (lane >> 5); scr[kk * 33 + (lane & 31)] = W[(size_t)(k0 + kk) * ldw + n0 + (lane & 31)]; }
    LDS_WAIT(); asm volatile("" ::: "memory");
    const int n = lane >> 1, hf = lane & 1;
    const float mx = __uint_as_float(wmaxw[n0 + n]), inv = mx > 0.f ? 127.f / mx : 0.f;
    u32x4 o[2];
#pragma unroll
    for (int q = 0; q < 8; ++q) { unsigned w = 0u;
#pragma unroll
        for (int b = 0; b < 4; ++b) { const int kk = 32 * hf + 4 * q + b; w |= ((unsigned)(int)rintf(scr[kk * 33 + n] * inv) & 255u) << (8 * b); }
        o[q >> 2][q & 3] = w; }
    u32x4* dst = (u32x4*)(WT + (size_t)(n0 + n) * 1024 + k0 + 32 * hf);
    dst[0] = o[0]; dst[1] = o[1];
    LDS_WAIT(); asm volatile("" ::: "memory");
}
__device__ __forceinline__ void phase_quant_weights(LAS unsigned char* lds) {
    const KArgs ap = get_args();
#define a (*ap)
    const int tid = fresh_tid(), lane = tid & 63, wave = __builtin_amdgcn_readfirstlane(tid >> 6), G = fresh_g(), bx = fresh_bx();
    unsigned char* ws = a.ws;
    LAS float* scr = (LAS float*)(lds + 65536 + wave * 8448);
    const unsigned* wmaxw = (const unsigned*)(ws + WS_CTL) + CW_WMAX;
    constexpr int I_IN = 16 * 96, I_OUT = 16 * 32, I_Q = 16 * 64, PER_L = I_IN + I_OUT + I_Q;
    for (int it = bx * 8 + wave; it < DEPTH * PER_L; it += G * 8) { const int l = it / PER_L; int r = it % PER_L;
        if (r < I_IN) quant_transpose_item(a.in[I_WIN] + (size_t)l * 1024 * NIN, NIN, (signed char*)(ws + WS_WINT) + (size_t)l * NP * 1024, wmaxw + (l * 3 + 0) * 3072, scr, r / 96, r % 96, lane);
        else if (r < I_IN + I_OUT) { r -= I_IN; quant_transpose_item(a.in[I_WOUT] + (size_t)l * 1024 * 1024, 1024, (signed char*)(ws + WS_WOUTT) + (size_t)l * 1024 * 1024, wmaxw + (l * 3 + 1) * 3072, scr, r / 32, r % 32, lane); }
        else { r -= I_IN + I_OUT; quant_transpose_item(a.in[I_WQ] + (size_t)l * 1024 * 2048, 2048, (signed char*)(ws + WS_WQT) + (size_t)l * 2048 * 1024, wmaxw + (l * 3 + 2) * 3072, scr, r / 64, r % 64, lane); } }
#undef a
}

template <bool SK>
__device__ __forceinline__ void phase_norm(int l, int which, LAS unsigned char* lds) {
    const KArgs ap = get_args();
#define a (*ap)

    const int tid = fresh_tid(), lane = tid & 63, wave = __builtin_amdgcn_readfirstlane(tid >> 6), G = fresh_g(), bx = fresh_bx();
    unsigned char* ws = a.ws;
    LAS float* wsk = (LAS float*)lds;
    if (SK) { const float* src = (const float*)(ws + WS_WSK) + (size_t)l * 16384; for (int i = tid; i < 16384 / 4; i += 512) ((LAS f32x4*)wsk)[i] = ((const f32x4*)src)[i]; __syncthreads(); }
    const int nrows = (which == 1 && l == DEPTH - 1) ? ML : M;
    const float* nw = a.in[which ? I_N2W : I_N1W] + l * 1024;
    const float* modl = (const float*)(ws + WS_MOD) + (size_t)l * 3 * 6144;
    const int shoff = which ? 3072 : 0, scoff = which ? 4096 : 1024;
    f32x4 nwv[4];
#pragma unroll
    for (int j = 0; j < 4; ++j) nwv[j] = *(const f32x4*)(nw + 4 * lane + 256 * j);
    for (int row = wave * G + bx; row < nrows; row += G * 8) {
        const float* src; int mrow;
        if (row < ML) { src = ((l == 0 && which == 0) ? a.in[I_X] : a.out) + (size_t)row * D; mrow = row >= T ? 1 : 0; }
        else { src = ((l == 0 && which == 0) ? a.in[I_CTX] : (const float*)(ws + WS_CTXX)) + (size_t)(row - ML) * D; mrow = 2; }
        const float* md = modl + mrow * 6144;
        f32x4 v[4]; float ss = 0.f;
#pragma unroll
        for (int j = 0; j < 4; ++j) { v[j] = *(const f32x4*)(src + 4 * lane + 256 * j); ss += (v[j][0] * v[j][0] + v[j][1] * v[j][1]) + (v[j][2] * v[j][2] + v[j][3] * v[j][3]); }
        const float rstd = rsqrtf(wave_sum(ss) * (1.f / D) + EPS);
        signed char* hrow = (signed char*)(ws + WS_H) + (size_t)row * D;
        float hmx = 0.f;
#pragma unroll
        for (int j = 0; j < 4; ++j) { const f32x4 sc = *(const f32x4*)(md + scoff + 4 * lane + 256 * j), sh = *(const f32x4*)(md + shoff + 4 * lane + 256 * j);
            v[j] = v[j] * rstd * nwv[j] * (sc + 1.f) + sh; hmx = fmaxf(hmx, fmaxf(fmaxf(fabsf(v[j][0]), fabsf(v[j][1])), fmaxf(fabsf(v[j][2]), fabsf(v[j][3])))); }
        hmx = fmaxf(wave_max(hmx), 1e-30f);
        { const float hinv = 127.f / hmx;
#pragma unroll
          for (int j = 0; j < 4; ++j) *(unsigned*)(hrow + 4 * lane + 256 * j) = ((unsigned)(int)rintf(v[j][0] * hinv) & 255u) | (((unsigned)(int)rintf(v[j][1] * hinv) & 255u) << 8) | (((unsigned)(int)rintf(v[j][2] * hinv) & 255u) << 16) | (((unsigned)(int)rintf(v[j][3] * hinv) & 255u) << 24);
          if (lane == 0) ((float*)(ws + WS_GB))[row] = hmx * (1.f / 127.f); }
        if (SK) {
            float p[16];
#pragma unroll
            for (int c = 0; c < 16; ++c) { float q = 0.f;
#pragma unroll
                for (int j = 0; j < 4; ++j) { const f32x4 w = *(const LAS f32x4*)(wsk + c * 1024 + 4 * lane + 256 * j); q += (v[j][0] * w[0] + v[j][1] * w[1]) + (v[j][2] * w[2] + v[j][3] * w[3]); }
                p[c] = q; }
            { const bool hb = (lane & 32) != 0;
#pragma unroll
              for (int c = 0; c < 8; ++c) { const float keep = hb ? p[c + 8] : p[c], send = hb ? p[c] : p[c + 8]; p[c] = keep + lane_xor<32>(send); } }
            { const bool hb = (lane & 16) != 0;
#pragma unroll
              for (int c = 0; c < 4; ++c) { const float keep = hb ? p[c + 4] : p[c], send = hb ? p[c] : p[c + 4]; p[c] = keep + lane_xor<16>(send); } }
            { const bool hb = (lane & 8) != 0;
#pragma unroll
              for (int c = 0; c < 2; ++c) { const float keep = hb ? p[c + 2] : p[c], send = hb ? p[c] : p[c + 2]; p[c] = keep + lane_xor<8>(send); } }
            { const bool hb = (lane & 4) != 0; const float keep = hb ? p[1] : p[0], send = hb ? p[0] : p[1]; p[0] = keep + lane_xor<4>(send); }
            p[0] += lane_xor<2>(p[0]); p[0] += lane_xor<1>(p[0]);
            if ((lane & 3) == 0) { const int c = ((lane >> 5) & 1) * 8 + ((lane >> 4) & 1) * 4 + ((lane >> 3) & 1) * 2 + ((lane >> 2) & 1); ((float*)(ws + WS_BA))[(size_t)row * 16 + c] = p[0]; }
        }
    }
    if (SK) __syncthreads();
}

__device__ __forceinline__ void phase_prep(int l, LAS unsigned char* lds) {
    const KArgs ap = get_args();
#define a (*ap)

    const int tid = fresh_tid(), lane = tid & 63, wave = __builtin_amdgcn_readfirstlane(tid >> 6), G = fresh_g(), bx = fresh_bx();
    unsigned char* ws = a.ws;
    const bf16_t* P = (const bf16_t*)(ws + WS_P);
    const float* ropec = (const float*)(ws + WS_ROPE); const float* ropes = ropec + 8192;
    const int sec = lane >> 5, fi = lane & 31;
    const float qw0 = a.in[I_QNW][l * 128 + sec * 64 + fi], qw1 = a.in[I_QNW][l * 128 + sec * 64 + 32 + fi];
    const float kw0 = a.in[I_KNW][l * 128 + sec * 64 + fi], kw1 = a.in[I_KNW][l * 128 + sec * 64 + 32 + fi];
    for (int row = wave * G + bx; row < M; row += G * 8) {
        const bool lat = row < ML;
        int b, tt, tlen; if (lat) { b = row >> 14; tt = row & (T - 1); tlen = T; } else { b = (row - ML) >> 8; tt = (row - ML) & (CT - 1); tlen = CT; }
        const bf16_t* prow = P + (size_t)row * NP;
        unsigned short xa[6][2];
#pragma unroll
        for (int hh = 0; hh < 6; ++hh) { const bf16_t* xp = prow + (hh < 4 ? hh * 128 : 512 + (hh - 4) * 128) + sec * 64 + fi; xa[hh][0] = xp[0]; xa[hh][1] = xp[32]; }
        const u32x2 vcp = *(const u32x2*)(prow + 768 + 4 * lane);
        float cs = 1.f, sn = 0.f;
        if (lat) { const int pos = sec ? (tt & 63) : (tt >> 6); cs = ropec[pos * 32 + fi]; sn = ropes[pos * 32 + fi]; }
        unsigned char* qo8 = ws + WS_QA + (size_t)row * 512;
        const size_t kvrow = (size_t)b * KVLEN + (lat ? tt : T + tt);
        unsigned char* ko8 = ws + WS_KA + kvrow * 256;
        bf16_t* vo = (bf16_t*)(ws + WS_VA) + kvrow * 256;
        float ssq[6];
#pragma unroll
        for (int hh = 0; hh < 6; ++hh) { const float x0 = bf2f(xa[hh][0]), x1 = bf2f(xa[hh][1]); ssq[hh] = x0 * x0 + x1 * x1; }
#pragma unroll
        for (int hh = 0; hh < 6; ++hh) ssq[hh] = wave_sum(ssq[hh]);
#pragma unroll
        for (int hh = 0; hh < 6; ++hh) {
            const float x0 = bf2f(xa[hh][0]), x1 = bf2f(xa[hh][1]);
            const float rs = rsqrtf(ssq[hh] * (1.f / 128.f) + EPS);
            const float y0 = x0 * rs * (hh < 4 ? qw0 : kw0), y1 = x1 * rs * (hh < 4 ? qw1 : kw1);
            const float qsc = hh < 4 ? 0.088388347648318440f * 1.4426950408889634f : 1.f;
            const float o0 = (y0 * cs - y1 * sn) * qsc, o1 = (y1 * cs + y0 * sn) * qsc;
            unsigned char* op8 = (hh < 4 ? qo8 + hh * 128 : ko8 + (hh - 4) * 128) + sec * 64 + fi;
            const float f8s = hh < 4 ? 8.f : 1.f;
            const int pk8 = __builtin_amdgcn_cvt_pk_fp8_f32(o0 * f8s, o1 * f8s, 0, false);
            op8[0] = (unsigned char)(pk8 & 255); op8[32] = (unsigned char)((pk8 >> 8) & 255);
        }
        *(u32x2*)(vo + 4 * lane) = vcp;
    }
    __syncthreads();
}

constexpr int ATT_PARTS = 4;
__device__ __forceinline__ void phase_attn(int l, unsigned char* lds_raw, volatile LAS unsigned* MISC, int rep) {
    const KArgs ap = get_args();
#define a (*ap)
    unsigned char* ws = a.ws;
    const unsigned char* QA = ws + WS_QA; const unsigned char* KA = ws + WS_KA; const bf16_t* VA = (const bf16_t*)(ws + WS_VA);
    bf16_t* CAT = (bf16_t*)(ws + WS_CAT); float* LSE = (float*)(ws + WS_BA);
    unsigned* ctr = (unsigned*)(ws + WS_CTL) + 8192 + 64 * l + 1024 * rep;
    const int natt = 2048 + (l < DEPTH - 1 ? 8 : 0);
    constexpr int CONV_ROWS = 64, NCONV = 2 * NEXP / CONV_ROWS;
    const int nunits = natt + (l + 1 < DEPTH ? NCONV : 0);
    float braw;
    { const int ln = threadIdx.x & 63; float mq = fmaxf(fabsf(a.in[I_QNW][l * 128 + ln]), fabsf(a.in[I_QNW][l * 128 + 64 + ln])), mk = fmaxf(fabsf(a.in[I_KNW][l * 128 + ln]), fabsf(a.in[I_KNW][l * 128 + 64 + ln]));
      mq = wave_max(mq); mk = wave_max(mk);
      braw = __builtin_bit_cast(float, __builtin_amdgcn_readfirstlane(__builtin_bit_cast(int, 128.f * mq * mk))); }
    if (threadIdx.x == 0) MISC[12] = __hip_atomic_fetch_add(ctr, 1u, __ATOMIC_RELAXED, __HIP_MEMORY_SCOPE_AGENT);
    __syncthreads();
    int u = (int)MISC[12], par = 0;
    for (; u < nunits; ) {
        if (threadIdx.x == 0) MISC[13 - par] = __hip_atomic_fetch_add(ctr, 1u, __ATOMIC_RELAXED, __HIP_MEMORY_SCOPE_AGENT);
        if (u >= natt) {
            const int rwb = (u - natt) * CONV_ROWS + (int)(threadIdx.x >> 6) * 8;
            convert_tables(a.in[I_U], a.in[I_V], ws, l + 1, rwb, 1, (int)(threadIdx.x & 63), rwb + 8);
            __syncthreads();
            u = (int)MISC[13 - par]; par ^= 1;
            continue;
        }
        size_t r0, kv0; int h, kvh, seq, ldo; bf16_t* ob; float* lse;
        if (u < 2048) { const int qb = u & 63, g = (u >> 6) & 1, part = (u >> 7) & 3, b = u >> 10; kvh = (u >> 9) & 1; h = kvh * 2 + g;
            const int t0 = (part >> 1) * 130 + (part & 1) * 64;
            r0 = (size_t)b * T + (size_t)qb * 256; kv0 = (size_t)b * KVLEN + (size_t)t0 * 64; seq = ((part & 1) ? 66 : 64) * 64;
            ob = part ? (bf16_t*)(ws + (part == 1 ? WS_DQ : part == 2 ? WS_DK : WS_DV)) + r0 * 512 + h * 128 : CAT + r0 * 1024 + h * 128; ldo = part ? 512 : 1024; lse = LSE + ((size_t)part * ML + r0) * 4 + h; }
        else { const int b = (u - 2048) >> 2; h = (u - 2048) & 3; kvh = h >> 1; r0 = (size_t)ML + (size_t)b * CT; kv0 = (size_t)b * KVLEN + T; seq = CT;
            ob = CAT + r0 * 1024 + h * 128; ldo = 1024; lse = nullptr; }
        att::attn_dense_body(QA + r0 * 512 + h * 128, KA + kv0 * 256 + kvh * 128, VA + kv0 * 256 + kvh * 128, ob, ldo, seq, (char*)lds_raw, lse, braw);
        u = (int)MISC[13 - par]; par ^= 1;
    }
#undef a
}

__device__ __forceinline__ int tokperm(int q, int hh, int jj) { return 16 * q + 8 * (jj >> 2) + 4 * hh + (jj & 3); }
__device__ __forceinline__ int crow16(int r, int hi) { return (r & 3) + 8 * (r >> 2) + 4 * hi; }
__device__ __forceinline__ int kperm16(int s_, int g, int jj) { return 32 * s_ + 16 * (jj >> 2) + 4 * g + (jj & 3); }
__device__ __forceinline__ int frag_off(int i, int j) {
    return (((i >> 4) * 2 + (j >> 5)) * 64 + ((i & 15) + 16 * ((j >> 2) & 3))) * 16 + (4 * ((j >> 4) & 1) + (j & 3)) * 2;
}
template <int MODE>
__device__ __forceinline__ void phase_dn_chunkprep(int l, LAS unsigned char* lds) {
    const KArgs ap = get_args();
#define a (*ap)
    const int tid = fresh_tid(), lane = tid & 63, wave = __builtin_amdgcn_readfirstlane(tid >> 6), G = fresh_g(), bx = fresh_bx();
    unsigned char* ws = a.ws;
    constexpr int KT_OFF = 0, QT_OFF = 17408, VT_OFF = 34816, GS_OFF = 52224, RS_OFF = 68864, AM_OFF = 85504, SC_OFF = 120320, IMG_OFF = 0;
    const int r = lane & 31, hh = lane >> 5;
    const bf16_t* DQ = (const bf16_t*)(ws + WS_DQ); const bf16_t* DK = (const bf16_t*)(ws + WS_DK); const bf16_t* DV = (const bf16_t*)(ws + WS_DV);
    const float* BA = (const float*)(ws + WS_BA);
    constexpr int NTASK = MODE ? NB * 4 * 4 : NB * 4 * (NCH - 4);
#define CP_TASKID(t_) (MODE ? ((t_) >> 2) * NCH + ((t_) & 3) : ((t_) >> 8) * NCH + 4 + ((t_) & 255))
    LAS float* gsc = (LAS float*)(lds + SC_OFF);
    LAS float* bsc = gsc + 128;
    LAS float* gcs = gsc + 256;
    constexpr int CW_OFF = 121856;
    LAS float* cwl = (LAS float*)(lds + CW_OFF);
    for (int i = tid; i < 5 * 1536; i += 512) cwl[i] = a.in[I_CONVW][(size_t)l * 5 * 1536 + i];
    __syncthreads();
    const bf16_t* P = (const bf16_t*)(ws + WS_P);
    u32x4 xin[3][5][2];
#define CP_LOADX(task_) do { const int cidx_ = (task_) % NCH, bh_ = (task_) / NCH, b_ = bh_ >> 2, h_ = bh_ & 3; \
        const int row0_ = cidx_ < 4 ? ML + b_ * CT + cidx_ * 64 : b_ * T + (cidx_ - 4) * 64, tt_ = (cidx_ < 4 ? cidx_ * 64 : (cidx_ - 4) * 64) + (tid >> 3), tlen_ = cidx_ < 4 ? CT : T; \
        _Pragma("unroll") for (int j = 0; j < 5; ++j) { const int t2 = tt_ + j - 2; const bool ok = t2 >= 0 && t2 < tlen_; \
            const bf16_t* xr = P + (size_t)(row0_ + (tid >> 3) + (ok ? j - 2 : 0)) * NP + 1024 + h_ * 128 + (tid & 7) * 16; \
            _Pragma("unroll") for (int m = 0; m < 3; ++m) { const u32x4 w0 = *(const u32x4*)(xr + m * 512), w1 = *(const u32x4*)(xr + m * 512 + 8); \
                xin[m][j][0] = ok ? w0 : (u32x4){0u, 0u, 0u, 0u}; xin[m][j][1] = ok ? w1 : (u32x4){0u, 0u, 0u, 0u}; } } } while (0)
    if (bx < NTASK) CP_LOADX(CP_TASKID(bx));
    for (int tk = bx; tk < NTASK; tk += G) {
        const int task = CP_TASKID(tk);
        const int cidx = task % NCH, bh = task / NCH, b = bh >> 2, h = bh & 3;
        const int row0 = cidx < 4 ? ML + b * CT + cidx * 64 : b * T + (cidx - 4) * 64;
        unsigned char* rec = ws + WS_REC + (size_t)task * REC_BYTES;
        {
            const int rr = tid >> 3, seg = tid & 7;
            if (tid < 128) { const int d = tid >> 6, i = tid & 63, dh = d * 4 + h;
                const float xb = BA[(size_t)(row0 + i) * 16 + dh], z = BA[(size_t)(row0 + i) * 16 + 8 + dh] + a.in[I_DTB][l * 8 + dh];
                bsc[tid] = 1.f / (1.f + __expf(-xb)); gsc[tid] = -__expf(a.in[I_ALOG][l * 8 + dh]) * (fmaxf(z, 0.f) + log1pf(__expf(-fabsf(z)))); }
#pragma unroll
            for (int m = 0; m < 3; ++m) {
                float y[16];
#pragma unroll
                for (int c = 0; c < 16; ++c) y[c] = 0.f;
#pragma unroll
                for (int j = 0; j < 5; ++j) { const LAS float* wp = cwl + j * 1536 + m * 512 + h * 128 + seg * 16;
#pragma unroll
                    for (int q4 = 0; q4 < 4; ++q4) { const f32x4 wv = *(const LAS f32x4*)(wp + 4 * q4); const unsigned u0 = xin[m][j][q4 >> 1][2 * (q4 & 1)], u1 = xin[m][j][q4 >> 1][2 * (q4 & 1) + 1];
                        y[4 * q4 + 0] = fmaf(bflo(u0), wv[0], y[4 * q4 + 0]); y[4 * q4 + 1] = fmaf(bfhi(u0), wv[1], y[4 * q4 + 1]); y[4 * q4 + 2] = fmaf(bflo(u1), wv[2], y[4 * q4 + 2]); y[4 * q4 + 3] = fmaf(bfhi(u1), wv[3], y[4 * q4 + 3]); } }
                float ss = 0.f;
#pragma unroll
                for (int c = 0; c < 16; ++c) { y[c] = silu_f(y[c]); ss = fmaf(y[c], y[c], ss); }
                if (m < 2) { ss += lane_xor<1>(ss); ss += lane_xor<2>(ss); ss += lane_xor<4>(ss);
                    float sc = rsqrtf(ss + EPS); if (m == 0) sc *= 0.088388347648318440f;
#pragma unroll
                    for (int c = 0; c < 16; ++c) y[c] *= sc; }
                u32x4 o0, o1; o0.x = pkbf(y[0], y[1]); o0.y = pkbf(y[2], y[3]); o0.z = pkbf(y[4], y[5]); o0.w = pkbf(y[6], y[7]); o1.x = pkbf(y[8], y[9]); o1.y = pkbf(y[10], y[11]); o1.z = pkbf(y[12], y[13]); o1.w = pkbf(y[14], y[15]);
                LAS unsigned char* dst = lds + (m == 0 ? QT_OFF : m == 1 ? KT_OFF : VT_OFF) + rr * 272 + seg * 32;
                *(LAS u32x4*)dst = o0; *(LAS u32x4*)(dst + 16) = o1;
            }
        }
        __syncthreads();
        {
            const int mat = wave >> 2, ti = (wave >> 1) & 1, tj = wave & 1;
            f32x16 acc = {};
#pragma unroll
            for (int ks = 0; ks < 8; ++ks) {
                const bf16x8 av = *(const LAS bf16x8*)(lds + (mat ? QT_OFF : KT_OFF) + (32 * ti + r) * 272 + (16 * ks + 8 * hh) * 2);
                const bf16x8 bv = *(const LAS bf16x8*)(lds + KT_OFF + (32 * tj + r) * 272 + (16 * ks + 8 * hh) * 2);
                acc = __builtin_amdgcn_mfma_f32_32x32x16_bf16(av, bv, acc, 0, 0, 0);
            }
            LAS float* dst = (LAS float*)(lds + (mat ? RS_OFF : GS_OFF));
#pragma unroll
            for (int i = 0; i < 16; ++i) dst[(32 * ti + crow16(i, hh)) * 65 + 32 * tj + r] = acc[i];
        }
        { const int r16 = lane & 15, g4 = lane >> 4;
#pragma unroll
        for (int t = 0; t < 2; ++t) { const int f = wave * 2 + t, mt = f >> 2, sk = f & 3;
            { const u32x2 lo = *(const LAS u32x2*)(lds + KT_OFF + (16 * mt + r16) * 272 + (32 * sk + 4 * g4) * 2), hi2 = *(const LAS u32x2*)(lds + KT_OFF + (16 * mt + r16) * 272 + (32 * sk + 16 + 4 * g4) * 2);
              *(u32x4*)(rec + REC_K + f * 1024 + lane * 16) = (u32x4){lo.x, lo.y, hi2.x, hi2.y}; }
            { const u32x2 lo = *(const LAS u32x2*)(lds + QT_OFF + (16 * mt + r16) * 272 + (32 * sk + 4 * g4) * 2), hi2 = *(const LAS u32x2*)(lds + QT_OFF + (16 * mt + r16) * 272 + (32 * sk + 16 + 4 * g4) * 2);
              *(u32x4*)(rec + REC_Q + f * 1024 + lane * 16) = (u32x4){lo.x, lo.y, hi2.x, hi2.y}; } }
#pragma unroll
        for (int t = 0; t < 2; ++t) { const int f = wave * 2 + t, mt = f >> 1, sk = f & 1;
            unsigned e[8];
#pragma unroll
            for (int jj = 0; jj < 8; ++jj) e[jj] = *(const LAS unsigned short*)(lds + KT_OFF + kperm16(sk, g4, jj) * 272 + (16 * mt + r16) * 2);
            *(u32x4*)(rec + REC_KT + f * 1024 + lane * 16) = (u32x4){e[0] | (e[1] << 16), e[2] | (e[3] << 16), e[4] | (e[5] << 16), e[6] | (e[7] << 16)}; }
        { const int sl = wave;
            unsigned e[16];
#pragma unroll
            for (int i = 0; i < 16; ++i) e[i] = *(const LAS unsigned short*)(lds + VT_OFF + (16 * (i >> 2) + 4 * g4 + (i & 3)) * 272 + (16 * sl + r16) * 2);
            u32x4* vp = (u32x4*)(rec + REC_V + sl * 2048 + lane * 32);
            vp[0] = (u32x4){e[0] | (e[1] << 16), e[2] | (e[3] << 16), e[4] | (e[5] << 16), e[6] | (e[7] << 16)};
            vp[1] = (u32x4){e[8] | (e[9] << 16), e[10] | (e[11] << 16), e[12] | (e[13] << 16), e[14] | (e[15] << 16)}; }
        }
        if (tk + G < NTASK) CP_LOADX(CP_TASKID(tk + G));
        if (wave < 2) { const int d = wave; float gv = gsc[d * 64 + (d ? 63 - lane : lane)];
            gv += __builtin_bit_cast(float, __builtin_amdgcn_update_dpp(0, __builtin_bit_cast(int, gv), 0x111, 0xF, 0xF, true));
            gv += __builtin_bit_cast(float, __builtin_amdgcn_update_dpp(0, __builtin_bit_cast(int, gv), 0x112, 0xF, 0xF, true));
            gv += __builtin_bit_cast(float, __builtin_amdgcn_update_dpp(0, __builtin_bit_cast(int, gv), 0x114, 0xF, 0xF, true));
            gv += __builtin_bit_cast(float, __builtin_amdgcn_update_dpp(0, __builtin_bit_cast(int, gv), 0x118, 0xF, 0xF, true));
            { const float t0 = __builtin_bit_cast(float, __builtin_amdgcn_readlane(__builtin_bit_cast(int, gv), 15)), t1 = __builtin_bit_cast(float, __builtin_amdgcn_readlane(__builtin_bit_cast(int, gv), 31)), t2 = __builtin_bit_cast(float, __builtin_amdgcn_readlane(__builtin_bit_cast(int, gv), 47));
              const int rw_ = lane >> 4; gv += (rw_ >= 1 ? t0 : 0.f) + (rw_ >= 2 ? t1 : 0.f) + (rw_ >= 3 ? t2 : 0.f); }
            gcs[d * 64 + lane] = gv; }
        __syncthreads();
        const LAS float* Gs = (const LAS float*)(lds + GS_OFF); const LAS float* Rs = (const LAS float*)(lds + RS_OFF);
#pragma unroll 4
        for (int t = 0; t < 16; ++t) { const int e = tid + 512 * t, d = e >> 12, jp = (e >> 6) & 63, ip = e & 63;
            const int in_ = d ? 63 - ip : ip, jn = d ? 63 - jp : jp;
            const float dec = __expf(fminf(gcs[d * 64 + ip] - gcs[d * 64 + jp], 0.f));
            const float av = (jp < ip) ? bsc[d * 64 + in_] * Gs[in_ * 65 + jn] * dec : 0.f;
            ((LAS float*)(lds + AM_OFF))[d * 4352 + jp * 68 + ip] = av;
            const float qk = (jp <= ip) ? Rs[in_ * 65 + jn] * dec : 0.f;
            *(LAS unsigned short*)(lds + IMG_OFF + d * 16384 + 8192 + frag_off(in_, jn)) = (unsigned short)(pkbf(qk, 0.f) & 0xffffu); }
        __syncthreads();
        if (wave < 2) { const int d = wave, c = lane, jn = d ? 63 - c : c; const float bj = bsc[d * 64 + jn];
            const LAS float* At = (const LAS float*)(lds + AM_OFF) + d * 4352;
            LAS float* Xm = (LAS float*)(lds + GS_OFF) + d * 4096 + c;
            const int fj = (jn >> 5) * 1024 + ((jn >> 2) & 3) * 256 + ((jn >> 4) & 1) * 8 + (jn & 3) * 2;
#pragma unroll 1
            for (int B = 0; B < 4; ++B) {
                float acc[16];
#pragma unroll
                for (int q = 0; q < 16; ++q) acc[q] = (16 * B + q == c) ? 1.f : 0.f;
#pragma unroll 4
                for (int j = 0; j < 16 * B; ++j) { const float xj = Xm[j * 64];
                    const f32x4 a0 = *(const LAS f32x4*)(At + j * 68 + 16 * B), a1 = *(const LAS f32x4*)(At + j * 68 + 16 * B + 4), a2 = *(const LAS f32x4*)(At + j * 68 + 16 * B + 8), a3 = *(const LAS f32x4*)(At + j * 68 + 16 * B + 12);
#pragma unroll
                    for (int q = 0; q < 4; ++q) { acc[q] = fmaf(-a0[q], xj, acc[q]); acc[4 + q] = fmaf(-a1[q], xj, acc[4 + q]); acc[8 + q] = fmaf(-a2[q], xj, acc[8 + q]); acc[12 + q] = fmaf(-a3[q], xj, acc[12 + q]); } }
#pragma unroll
                for (int r2 = 0; r2 < 15; ++r2) { const LAS float* ar = At + (16 * B + r2) * 68 + 16 * B; const float xr = acc[r2];
#pragma unroll
                    for (int q4 = (r2 + 1) / 4; q4 < 4; ++q4) { const f32x4 a4 = *(const LAS f32x4*)(ar + 4 * q4);
#pragma unroll
                        for (int q = 0; q < 4; ++q) if (4 * q4 + q > r2) acc[4 * q4 + q] = fmaf(-a4[q], xr, acc[4 * q4 + q]); } }
#pragma unroll
                for (int q = 0; q < 16; ++q) { const int i = 16 * B + q, in_ = d ? 63 - i : i; Xm[i * 64] = acc[q];
                    *(LAS unsigned short*)(lds + IMG_OFF + d * 16384 + (in_ >> 4) * 2048 + (in_ & 15) * 16 + fj) = (unsigned short)(pkbf(acc[q] * bj, 0.f) & 0xffffu); }
            }
        } else if (wave < 4) { const int d = wave - 2, ip = d ? 63 - lane : lane; const float gl = gcs[d * 64 + 63], gi = gcs[d * 64 + ip];
            float* sc = (float*)(rec + REC_DIR + d * REC_DIRSZ + 16384);
            sc[lane] = __expf(gi); sc[64 + lane] = __expf(gl - gi); if (lane == 0) sc[128] = __expf(gl); }
        __syncthreads();
#pragma unroll
        for (int t = 0; t < 4; ++t) { const int p = tid + 512 * t, d = p >> 10, off = (p & 1023) * 16;
            *(u32x4*)(rec + REC_DIR + d * REC_DIRSZ + off) = *(const LAS u32x4*)(lds + IMG_OFF + d * 16384 + off); }
        __syncthreads();
    }
#undef CP_LOADX
#undef CP_TASKID
#undef a
}

__device__ __forceinline__ bf16x8 pack44(const f32x4& lo, const f32x4& hi) {
    u32x4 p; p.x = pkbf_c(lo[0], lo[1]); p.y = pkbf_c(lo[2], lo[3]); p.z = pkbf_c(hi[0], hi[1]); p.w = pkbf_c(hi[2], hi[3]);
    return __builtin_bit_cast(bf16x8, p);
}
template <int VAR>
__device__ __forceinline__ void phase_dn_scan(int l, LAS unsigned char* lds) {
    const KArgs ap = get_args();
#define a (*ap)
    const int tid = fresh_tid(), lane = tid & 63, wave = __builtin_amdgcn_readfirstlane(tid >> 6), bx = fresh_bx();
    unsigned char* ws = a.ws;
    if (bx >= 32) return;
    const int chain = bx >> 1, half = bx & 1, b = chain >> 3, h = (chain >> 1) & 3, dir = chain & 1;
    const unsigned char* recb = ws + WS_REC + (size_t)((b * 4 + h) * NCH) * REC_BYTES;
    constexpr int BUFSZ = 74752;
#define CIDX(n) (dir ? ((n) < 4 ? 3 - (n) : 263 - (n)) : (n))
    if (wave >= 4) {
        const int sw = wave - 4;
#define DN_PIECE(i_) ((sw + 4 * (i_)) < 73 ? (sw + 4 * (i_)) : 72)
#define DN_SRC(rec_, p_) ((p_) < 48 ? (rec_) + (p_) * 1024 : (p_) < 65 ? (rec_) + REC_DIR + dir * REC_DIRSZ + ((p_) - 48) * 1024 : (rec_) + REC_V + half * 8192 + ((p_) - 65) * 1024)
#define DN_STAGE(n, bi) do { const unsigned char* rec_ = recb + (size_t)CIDX(n) * REC_BYTES; _Pragma("unroll") for (int i_ = 0; i_ < 19; ++i_) { const int p_ = DN_PIECE(i_); \
        __builtin_amdgcn_global_load_lds((const unsigned*)(DN_SRC(rec_, p_) + lane * 16), (LAS unsigned*)(lds + (bi) * BUFSZ + p_ * 1024), 16, 0, 0); } } while (0)
#define DN_SYNC() do { asm volatile("s_waitcnt vmcnt(0)" ::: "memory"); __builtin_amdgcn_s_barrier(); asm volatile("" ::: "memory"); } while (0)
        if (VAR != 3) DN_STAGE(0, 0);
        DN_SYNC();
        for (int n = 0; n < NCH; ++n) {
            if (VAR != 3 && n + 1 < NCH) DN_STAGE(n + 1, (n + 1) & 1);
            DN_SYNC();
        }
#undef DN_STAGE
#undef DN_PIECE
#undef DN_SRC
#undef DN_SYNC
    } else {
        const int sl = half * 4 + wave, c16 = lane & 15, g4 = lane >> 4;
        float* Og = (float*)(ws + (dir ? WS_OB : WS_OF)) + h * 128 + sl * 16 + c16;
        f32x4 S[8];
#pragma unroll
        for (int i = 0; i < 8; ++i) S[i] = (f32x4){0.f, 0.f, 0.f, 0.f};
        asm volatile("s_waitcnt lgkmcnt(0)" ::: "memory"); __builtin_amdgcn_s_barrier(); asm volatile("" ::: "memory");
        for (int n = 0; n < NCH; ++n) {
            if (VAR == 2) { asm volatile("s_waitcnt lgkmcnt(0)" ::: "memory"); __builtin_amdgcn_s_barrier(); asm volatile("" ::: "memory"); continue; }
            const LAS unsigned char* buf = lds + (n & 1) * BUFSZ;
            const int cidx = CIDX(n);
            const u32x4 vc0 = *(const LAS u32x4*)(buf + 66560 + wave * 2048 + lane * 32), vc1 = *(const LAS u32x4*)(buf + 66560 + wave * 2048 + lane * 32 + 16);
#define FR(off, f) (*(const LAS bf16x8*)(buf + (off) + (f) * 1024 + lane * 16))
#define MF(A, B, C) __builtin_amdgcn_mfma_f32_16x16x32_bf16((A), (B), (C), 0, 0, 0)
#define SB_() __builtin_amdgcn_sched_barrier(0)
            bf16x8 fa[8], fb[8];
            f32x4 eg[4], dl[4];
#pragma unroll
            for (int mt = 0; mt < 4; ++mt) { eg[mt] = *(const LAS f32x4*)(buf + 65536 + (16 * mt + 4 * g4) * 4); dl[mt] = *(const LAS f32x4*)(buf + 65536 + 256 + (16 * mt + 4 * g4) * 4); }
            const float egl = *(const LAS float*)(buf + 65536 + 512);
#define RD_KQ(dst, q) do { _Pragma("unroll") for (int mt = 0; mt < 4; ++mt) { dst[mt] = FR(0, mt * 4 + (q)); dst[4 + mt] = FR(32768, mt * 4 + (q)); } } while (0)
#define MM_KQ(src, q) do { _Pragma("unroll") for (int mt = 0; mt < 4; ++mt) { X[mt] = MF(src[mt], Sb[q], X[mt]); O[mt] = MF(src[4 + mt], Sb[q], O[mt]); } } while (0)
            f32x4 X[4], O[4], VN[4];
#pragma unroll
            for (int i = 0; i < 4; ++i) { X[i] = (f32x4){0.f, 0.f, 0.f, 0.f}; O[i] = (f32x4){0.f, 0.f, 0.f, 0.f}; VN[i] = (f32x4){0.f, 0.f, 0.f, 0.f}; }
            bf16x8 Sb[4];
#pragma unroll
            for (int q = 0; q < 4; ++q) Sb[q] = pack44(S[2 * q], S[2 * q + 1]);
            RD_KQ(fa, 0); SB_();
            RD_KQ(fb, 1); SB_(); MM_KQ(fa, 0); SB_();
            RD_KQ(fa, 2); SB_(); MM_KQ(fb, 1); SB_();
            RD_KQ(fb, 3); SB_(); MM_KQ(fa, 2); SB_();
#pragma unroll
            for (int i = 0; i < 8; ++i) fa[i] = FR(49152, i);
            SB_(); MM_KQ(fb, 3); SB_();
#pragma unroll
            for (int mt = 0; mt < 4; ++mt) { const unsigned w0 = (mt < 2 ? vc0 : vc1)[2 * (mt & 1)], w1 = (mt < 2 ? vc0 : vc1)[2 * (mt & 1) + 1];
                X[mt][0] = bflo(w0) - eg[mt][0] * X[mt][0]; X[mt][1] = bfhi(w0) - eg[mt][1] * X[mt][1]; X[mt][2] = bflo(w1) - eg[mt][2] * X[mt][2]; X[mt][3] = bfhi(w1) - eg[mt][3] * X[mt][3]; }
            const bf16x8 Yb0 = pack44(X[0], X[1]), Yb1 = pack44(X[2], X[3]);
            SB_();
#pragma unroll
            for (int i = 0; i < 8; ++i) fb[i] = FR(57344, i);
            SB_();
#pragma unroll
            for (int mt = 0; mt < 4; ++mt) { VN[mt] = MF(fa[mt * 2], Yb0, VN[mt]); VN[mt] = MF(fa[mt * 2 + 1], Yb1, VN[mt]); }
            SB_();
#pragma unroll
            for (int mt = 0; mt < 4; ++mt) O[mt] = O[mt] * eg[mt];
            const bf16x8 Vb0 = pack44(VN[0], VN[1]), Vb1 = pack44(VN[2], VN[3]);
            SB_();
#pragma unroll
            for (int i = 0; i < 8; ++i) fa[i] = FR(16384, i);
            SB_();
#pragma unroll
            for (int mt = 0; mt < 4; ++mt) { O[mt] = MF(fb[mt * 2], Vb0, O[mt]); O[mt] = MF(fb[mt * 2 + 1], Vb1, O[mt]); }
            SB_();
#pragma unroll
            for (int mt = 0; mt < 4; ++mt) VN[mt] = VN[mt] * dl[mt];
            const bf16x8 Vd0 = pack44(VN[0], VN[1]), Vd1 = pack44(VN[2], VN[3]);
#pragma unroll
            for (int i = 0; i < 8; ++i) S[i] = S[i] * egl;
            SB_();
#pragma unroll
            for (int i = 0; i < 8; ++i) fb[i] = FR(16384, 8 + i);
            SB_();
#pragma unroll
            for (int i = 0; i < 4; ++i) { S[i] = MF(fa[i * 2], Vd0, S[i]); S[i] = MF(fa[i * 2 + 1], Vd1, S[i]); }
            SB_();
#pragma unroll
            for (int i = 0; i < 4; ++i) { S[4 + i] = MF(fb[i * 2], Vd0, S[4 + i]); S[4 + i] = MF(fb[i * 2 + 1], Vd1, S[4 + i]); }
            SB_();
            {
                const int row0 = cidx < 4 ? ML + b * CT + cidx * 64 : b * T + (cidx - 4) * 64;
                float* op = Og + (size_t)(row0 + 4 * g4) * 512;
#pragma unroll
                for (int mt = 0; mt < 4; ++mt)
#pragma unroll
                    for (int t = 0; t < 4; ++t) { if (VAR != 1) op[(size_t)(16 * mt + t) * 512] = O[mt][t]; else asm volatile("" :: "v"(O[mt][t])); }
            }
#undef RD_KQ
#undef MM_KQ
#undef SB_
#undef FR
#undef MF
            asm volatile("s_waitcnt lgkmcnt(0)" ::: "memory"); __builtin_amdgcn_s_barrier(); asm volatile("" ::: "memory");
        }
    }
#undef CIDX
#undef a
}

__device__ __forceinline__ void phase_dn_out(int l) {
    const KArgs ap = get_args();
#define a (*ap)

    const int tid = fresh_tid(), lane = tid & 63, wave = __builtin_amdgcn_readfirstlane(tid >> 6), G = fresh_g(), bx = fresh_bx();
    unsigned char* ws = a.ws;
    const int nrows = (l == DEPTH - 1) ? ML : M;
    const float* OF = (const float*)(ws + WS_OF); const float* OB = (const float*)(ws + WS_OB);
    const bf16_t* P = (const bf16_t*)(ws + WS_P); bf16_t* CAT = (bf16_t*)(ws + WS_CAT);
    const f32x2 nw = *(const f32x2*)(a.in[I_DNW] + l * 128 + 2 * lane);
    const float* LSE = (const float*)(ws + WS_BA);
    for (int row = wave * G + bx; row < nrows; row += G * 8) {
        f32x2 of[4], ob[4]; unsigned gw[4];
#pragma unroll
        for (int hh = 0; hh < 4; ++hh) { of[hh] = *(const f32x2*)(OF + (size_t)row * 512 + hh * 128 + 2 * lane); ob[hh] = *(const f32x2*)(OB + (size_t)row * 512 + hh * 128 + 2 * lane);
            gw[hh] = *(const unsigned*)(P + (size_t)row * NP + 2560 + hh * 128 + 2 * lane); }
        u32x4 ap_[4]; float ls_[4];
#pragma unroll
        for (int p = 0; p < 4; ++p) { ap_[p] = (u32x4){0u, 0u, 0u, 0u}; ls_[p] = 0.f; }
        if (row < ML) {
            ap_[0] = *(const u32x4*)(CAT + (size_t)row * 1024 + 8 * lane); ap_[1] = *(const u32x4*)((const bf16_t*)(ws + WS_DQ) + (size_t)row * 512 + 8 * lane);
            ap_[2] = *(const u32x4*)((const bf16_t*)(ws + WS_DK) + (size_t)row * 512 + 8 * lane); ap_[3] = *(const u32x4*)((const bf16_t*)(ws + WS_DV) + (size_t)row * 512 + 8 * lane);
#pragma unroll
            for (int p = 0; p < 4; ++p) ls_[p] = LSE[((size_t)p * ML + row) * 4 + (lane >> 4)]; }
        float o0[4], o1[4], ssq[4];
#pragma unroll
        for (int hh = 0; hh < 4; ++hh) { o0[hh] = of[hh][0] + ob[hh][0]; o1[hh] = of[hh][1] + ob[hh][1]; ssq[hh] = o0[hh] * o0[hh] + o1[hh] * o1[hh]; }
#pragma unroll
        for (int hh = 0; hh < 4; ++hh) ssq[hh] = wave_sum(ssq[hh]);
        float mxv = 0.f;
#pragma unroll
        for (int hh = 0; hh < 4; ++hh) { const float rs = rsqrtf(ssq[hh] * (1.f / 128.f) + EPS); const float g0 = bflo(gw[hh]), g1 = bfhi(gw[hh]);
            o0[hh] = o0[hh] * rs * nw[0] * silu_f(g0); o1[hh] = o1[hh] * rs * nw[1] * silu_f(g1); mxv = fmaxf(mxv, fmaxf(fabsf(o0[hh]), fabsf(o1[hh]))); }
        float av[8];
        if (row < ML) { const float mx = fmaxf(fmaxf(ls_[0], ls_[1]), fmaxf(ls_[2], ls_[3]));
            float w_[4], wsum = 0.f;
#pragma unroll
            for (int p = 0; p < 4; ++p) { w_[p] = __expf(ls_[p] - mx); wsum += w_[p]; }
            const float inv = 1.f / wsum;
#pragma unroll
            for (int i = 0; i < 4; ++i) { float lo = 0.f, hi2 = 0.f;
#pragma unroll
                for (int p = 0; p < 4; ++p) { lo = fmaf(w_[p], bflo(ap_[p][i]), lo); hi2 = fmaf(w_[p], bfhi(ap_[p][i]), hi2); }
                av[2 * i] = lo * inv; av[2 * i + 1] = hi2 * inv; } }
        else { const u32x4 cw_ = *(const u32x4*)(CAT + (size_t)row * 1024 + 8 * lane);
#pragma unroll
            for (int i = 0; i < 4; ++i) { av[2 * i] = bflo(cw_[i]); av[2 * i + 1] = bfhi(cw_[i]); } }
#pragma unroll
        for (int i = 0; i < 8; ++i) mxv = fmaxf(mxv, fabsf(av[i]));
        mxv = fmaxf(wave_max(mxv), 1e-30f);
        const float cinv = 127.f / mxv;
        signed char* crow = (signed char*)(ws + WS_CATQ) + (size_t)row * 1024;
#define Q8_(x) ((unsigned)(int)rintf((x) * cinv) & 255u)
        { u32x2 o; o.x = Q8_(av[0]) | (Q8_(av[1]) << 8) | (Q8_(av[2]) << 16) | (Q8_(av[3]) << 24); o.y = Q8_(av[4]) | (Q8_(av[5]) << 8) | (Q8_(av[6]) << 16) | (Q8_(av[7]) << 24); *(u32x2*)(crow + 8 * lane) = o; }
#pragma unroll
        for (int hh = 0; hh < 4; ++hh) *(unsigned short*)(crow + 512 + hh * 128 + 2 * lane) = (unsigned short)(Q8_(o0[hh]) | (Q8_(o1[hh]) << 8));
#undef Q8_
        if (lane == 0) ((float*)(ws + WS_GB))[(1u << 18) + row] = mxv * (1.f / 127.f);
    }
#undef a
}

#define CE_DESC(a_, b_) do { const float hi_ = fmaxf(a_, b_), lo_ = fminf(a_, b_); a_ = hi_; b_ = lo_; } while (0)
__device__ __forceinline__ void bitonic_sort16_desc(float (&v)[16]) {
#pragma unroll
    for (int k = 2; k <= 16; k <<= 1)
#pragma unroll
        for (int j = k >> 1; j > 0; j >>= 1)
#pragma unroll
            for (int i = 0; i < 16; ++i) { const int p = i ^ j; if (p > i) { if ((i & k) == 0) CE_DESC(v[i], v[p]); else CE_DESC(v[p], v[i]); } }
}
__device__ __forceinline__ void merge_top16_desc(float (&lst)[16], const float (&nw)[16]) {
#pragma unroll
    for (int i = 0; i < 16; ++i) lst[i] = fmaxf(lst[i], nw[15 - i]);
#pragma unroll
    for (int j = 8; j > 0; j >>= 1)
#pragma unroll
        for (int i = 0; i < 16; ++i) { const int p = i ^ j; if (p > i) CE_DESC(lst[i], lst[p]); }
}
__device__ __forceinline__ void phase_peer_select(int l) {
    const KArgs ap = get_args();
#define a (*ap)
    const int tid = fresh_tid(), lane = tid & 63, wave = __builtin_amdgcn_readfirstlane(tid >> 6), G = fresh_g(), bx = fresh_bx();
    unsigned char* ws = a.ws;
    const int nrows = (l == DEPTH - 1) ? ML : M;
    const int ntask = (nrows / 32) * 4;
    const bf16_t* Q2 = (const bf16_t*)(ws + WS_P);
    const bf16_t* SKB = (const bf16_t*)(ws + WS_SKB) + (size_t)l * 8 * 2 * 128 * 128;
    int* PIDX = (int*)(ws + WS_PIDX); float* PGATE = (float*)(ws + WS_PGATE);
    const float NEG = -3.0e38f;
    const int r = lane & 31, hi = lane >> 5;
    for (int task = wave * G + bx; task < ntask; task += G * 8) {
        const int tg = task >> 2, hp = task & 3; const int row = tg * 32 + r;
        float mine0[16], mine1[16];
#pragma unroll
        for (int j = 0; j < 16; ++j) { mine0[j] = NEG; mine1[j] = NEG; }
        bf16x8 qA[8], kA[8];
        float lst[16];
#define SEL_QPTR(it_) (Q2 + (size_t)row * 2048 + (2 * hp + ((it_) >> 1)) * 256 + ((it_) & 1) * 128 + 8 * hi)
#define SEL_KPTR(it_, t_) (SKB + (size_t)(((2 * hp + ((it_) >> 1)) * 2 + ((it_) & 1)) * 128 + 32 * (t_) + r) * 128 + 8 * hi)
#define SEL_LDQ(dst, it_) do { const bf16_t* qp_ = SEL_QPTR(it_); _Pragma("unroll") for (int ks = 0; ks < 8; ++ks) dst[ks] = *(const bf16x8*)(qp_ + 16 * ks); } while (0)
#define SEL_LDK(dst, it_, t_) do { const bf16_t* kp_ = SEL_KPTR(it_, t_); _Pragma("unroll") for (int ks = 0; ks < 8; ++ks) dst[ks] = *(const bf16x8*)(kp_ + 16 * ks); } while (0)
#define SEL_RANK(qv, kv, t_) do { f32x16 acc = {}; _Pragma("unroll") for (int ks = 0; ks < 8; ++ks) acc = __builtin_amdgcn_mfma_f32_32x32x16_bf16(kv[ks], qv[ks], acc, 0, 0, 0); \
            const unsigned kb = (unsigned)(32 * (t_) + 4 * hi); float nw_[16]; \
            _Pragma("unroll") for (int i = 0; i < 16; ++i) nw_[i] = __uint_as_float((__float_as_uint(acc[i]) & 0xffffff80u) | (kb + (unsigned)((i & 3) + 8 * (i >> 2)))); \
            bitonic_sort16_desc(nw_); merge_top16_desc(lst, nw_); } while (0)
#define SB_() __builtin_amdgcn_sched_barrier(0)
#pragma unroll
        for (int j = 0; j < 16; ++j) lst[j] = NEG;
#pragma unroll 1
        for (int it = 0; it < 4; ++it) {
            SEL_LDQ(qA, it);
#pragma unroll 1
            for (int t = 0; t < 4; ++t) { SEL_LDK(kA, it, t); SEL_RANK(qA, kA, t); }
            float oth[16];
#pragma unroll
            for (int j = 0; j < 16; ++j) { auto rr = __builtin_amdgcn_permlane32_swap(__float_as_uint(lst[j]), __float_as_uint(lst[j]), false, false); oth[j] = __uint_as_float(hi ? rr[0] : rr[1]); }
            merge_top16_desc(lst, oth);
            const bool k0 = ((it >> 1) == hi) && ((it & 1) == 0), k1 = ((it >> 1) == hi) && ((it & 1) == 1);
#pragma unroll
            for (int j = 0; j < 16; ++j) { mine0[j] = k0 ? lst[j] : mine0[j]; mine1[j] = k1 ? lst[j] : mine1[j]; lst[j] = NEG; }
        }
#undef SB_
#undef SEL_QPTR
#undef SEL_KPTR
#undef SEL_LDQ
#undef SEL_LDK
#undef SEL_RANK
        const int h = 2 * hp + hi;
        float ts[16];
#pragma unroll
        for (int j = 0; j < 16; ++j) ts[j] = NEG;
#pragma unroll
        for (int i = 0; i < 16; ++i)
#pragma unroll
            for (int j = 0; j < 16; ++j) if ((i + 1) * (j + 1) <= 16) {
                const unsigned b0 = __float_as_uint(mine0[i]), b1 = __float_as_uint(mine1[j]);
                const float c = __uint_as_float(b0 & 0xffffff80u) + __uint_as_float(b1 & 0xffffff80u);
                float x = __uint_as_float((__float_as_uint(c) & 0xffffc000u) | ((b0 & 127u) << 7) | (b1 & 127u));
#pragma unroll
                for (int t = 0; t < 16; ++t) { const float hv = fmaxf(ts[t], x); x = fminf(ts[t], x); ts[t] = hv; }
            }
        int te[16]; float ex[16], sum = 0.f;
        const float tmax = __uint_as_float(__float_as_uint(ts[0]) & 0xffffc000u);
#pragma unroll
        for (int t = 0; t < 16; ++t) { const unsigned bt = __float_as_uint(ts[t]); te[t] = (int)(bt & 0x3fffu); ex[t] = __expf(__uint_as_float(bt & 0xffffc000u) - tmax); sum += ex[t]; }
        const float inv = 1.f / sum;
        int* ip = PIDX + (size_t)row * 128 + h * 16; float* gp = PGATE + (size_t)row * 128 + h * 16;
#pragma unroll
        for (int t = 0; t < 16; t += 4) { *(u32x4*)(ip + t) = (u32x4){(unsigned)te[t], (unsigned)te[t + 1], (unsigned)te[t + 2], (unsigned)te[t + 3]}; *(f32x4*)(gp + t) = (f32x4){ex[t] * inv, ex[t + 1] * inv, ex[t + 2] * inv, ex[t + 3] * inv}; }
    }
#undef a
}

template <bool WR, int GV = 0>
__device__ __forceinline__ void phase_peer_gather(int l, LAS unsigned char* lds) {
    const KArgs ap = get_args();
#define a (*ap)
    const int tid = fresh_tid(), lane = tid & 63, wave = __builtin_amdgcn_readfirstlane(tid >> 6), G = fresh_g(), bx = fresh_bx();
    unsigned char* ws = a.ws;
    const int nrows = (l == DEPTH - 1) ? ML : M;
    const unsigned char* UB = ws + WS_UB + (size_t)(l & 1) * TAB_SET; const unsigned char* VB = UB + 1024;
    const float* USC = (const float*)(ws + WS_USC) + (l & 1) * 2 * NEXP; const float* VSC = USC + NEXP;
    const int* PIDX = (const int*)(ws + WS_PIDX); const float* PGATE = (const float*)(ws + WS_PGATE);
    const float* modl = (const float*)(ws + WS_MOD) + (size_t)l * 3 * 6144 + 5120;
    const bool fuse = WR && (l + 1 < DEPTH);
    LAS float* wsk = (LAS float*)lds;
    if (fuse) { const float* src = (const float*)(ws + WS_WSK) + (size_t)(l + 1) * 16384; for (int i = tid; i < 16384 / 4; i += 512) ((LAS f32x4*)wsk)[i] = ((const f32x4*)src)[i]; __syncthreads(); }
    const float* nw1 = a.in[I_N1W] + (l + 1 < DEPTH ? l + 1 : l) * 1024 + 16 * lane;
    const float* modn = (const float*)(ws + WS_MOD) + (size_t)(l + 1 < DEPTH ? l + 1 : l) * 3 * 6144;
    for (int row = wave * G + bx; row < nrows; row += G * 8) {
        float hv[16], out[16];
        { const u32x4 hw = *(const u32x4*)((const signed char*)(ws + WS_H) + (size_t)row * D + 16 * lane); const float hsc = ((const float*)(ws + WS_GB))[row];
#pragma unroll
          for (int q = 0; q < 4; ++q) { const int w = (int)hw[q]; hv[4 * q + 0] = (float)((w << 24) >> 24) * hsc; hv[4 * q + 1] = (float)((w << 16) >> 24) * hsc; hv[4 * q + 2] = (float)((w << 8) >> 24) * hsc; hv[4 * q + 3] = (float)(w >> 24) * hsc; } }
        float hs = 0.f;
#pragma unroll
        for (int i = 0; i < 16; ++i) { out[i] = 0.f; hs += hv[i]; }
        const float hsum128 = 128.f * wave_sum(hs);
        float wacc = 0.f;
        const int id0 = PIDX[(size_t)row * 128 + lane], id1 = PIDX[(size_t)row * 128 + 64 + lane];
        const float gt0 = PGATE[(size_t)row * 128 + lane], gt1 = PGATE[(size_t)row * 128 + 64 + lane];
        const float us0 = USC[id0], us1 = USC[id1], vs0 = VSC[id0], vs1 = VSC[id1];
        for (int e0 = 0; e0 < 128; e0 += 8) {
            u32x4 uw[8], vw[8]; float gte[8], use[8], vse[8];
#pragma unroll
            for (int j = 0; j < 8; ++j) { const int e = e0 + j; const int id = __builtin_amdgcn_readlane(e0 < 64 ? id0 : id1, e & 63);
                gte[j] = __builtin_bit_cast(float, __builtin_amdgcn_readlane(__builtin_bit_cast(int, e0 < 64 ? gt0 : gt1), e & 63));
                use[j] = __builtin_bit_cast(float, __builtin_amdgcn_readlane(__builtin_bit_cast(int, e0 < 64 ? us0 : us1), e & 63));
                vse[j] = __builtin_bit_cast(float, __builtin_amdgcn_readlane(__builtin_bit_cast(int, e0 < 64 ? vs0 : vs1), e & 63));
                uw[j] = *(const u32x4*)(UB + (size_t)id * 2048 + 16 * lane); vw[j] = *(const u32x4*)(VB + (size_t)id * 2048 + 16 * lane); }
#pragma unroll
            for (int j = 0; j < 8; ++j) {
                float d0 = 0.f, d1 = 0.f;
#pragma unroll
                for (int q = 0; q < 4; ++q) { const unsigned w = uw[j][q];
                    d0 = fmaf((float)(w & 255u), hv[4 * q + 0], d0); d1 = fmaf((float)((w >> 8) & 255u), hv[4 * q + 1], d1);
                    d0 = fmaf((float)((w >> 16) & 255u), hv[4 * q + 2], d0); d1 = fmaf((float)(w >> 24), hv[4 * q + 3], d1); }
                const float dsum = (wave_sum(d0 + d1) - hsum128) * use[j];
                const float act = 0.5f * dsum * (1.f + erff(dsum * 0.70710678118654752f));
                const float wgt = gte[j] * act * vse[j];
                wacc += wgt;
                if (GV == 1) { asm volatile("" :: "v"(vw[j])); out[0] += wgt; } else
#pragma unroll
                for (int q = 0; q < 4; ++q) { const unsigned w = vw[j][q];
                    out[4 * q + 0] = fmaf(wgt, (float)(w & 255u), out[4 * q + 0]); out[4 * q + 1] = fmaf(wgt, (float)((w >> 8) & 255u), out[4 * q + 1]);
                    out[4 * q + 2] = fmaf(wgt, (float)((w >> 16) & 255u), out[4 * q + 2]); out[4 * q + 3] = fmaf(wgt, (float)(w >> 24), out[4 * q + 3]); }
            }
        }
        const float corr = 128.f * wacc;
        float* xr; int mrow;
        if (row < ML) { xr = a.out + (size_t)row * D; mrow = row >= T ? 1 : 0; } else { xr = (float*)(ws + WS_CTXX) + (size_t)(row - ML) * D; mrow = 2; }
        const float* g2 = modl + mrow * 6144 + 16 * lane;
        f32x4 xn[4];
#pragma unroll
        for (int i = 0; i < 4; ++i) { const f32x4 x = *(const f32x4*)(xr + 16 * lane + 4 * i), g = *(const f32x4*)(g2 + 4 * i);
            xn[i] = x + g * (f32x4){out[4 * i] - corr, out[4 * i + 1] - corr, out[4 * i + 2] - corr, out[4 * i + 3] - corr};
            if (WR) *(f32x4*)(xr + 16 * lane + 4 * i) = xn[i]; else asm volatile("" :: "v"(xn[i])); }
        if (fuse) {
            float ss = 0.f;
#pragma unroll
            for (int i = 0; i < 4; ++i) ss += (xn[i][0] * xn[i][0] + xn[i][1] * xn[i][1]) + (xn[i][2] * xn[i][2] + xn[i][3] * xn[i][3]);
            const float rstd = rsqrtf(wave_sum(ss) * (1.f / D) + EPS);
            const float* md = modn + mrow * 6144 + 16 * lane;
#pragma unroll
            for (int i = 0; i < 4; ++i) { const f32x4 nwv = *(const f32x4*)(nw1 + 4 * i), sc = *(const f32x4*)(md + 1024 + 4 * i), sh = *(const f32x4*)(md + 4 * i);
                xn[i] = xn[i] * rstd * nwv * (sc + 1.f) + sh; }
            { float hmx = 0.f;
#pragma unroll
              for (int i = 0; i < 4; ++i) hmx = fmaxf(hmx, fmaxf(fmaxf(fabsf(xn[i][0]), fabsf(xn[i][1])), fmaxf(fabsf(xn[i][2]), fabsf(xn[i][3]))));
              hmx = fmaxf(wave_max(hmx), 1e-30f); const float hinv = 127.f / hmx;
              u32x4 o;
#pragma unroll
              for (int i = 0; i < 4; ++i) o[i] = ((unsigned)(int)rintf(xn[i][0] * hinv) & 255u) | (((unsigned)(int)rintf(xn[i][1] * hinv) & 255u) << 8) | (((unsigned)(int)rintf(xn[i][2] * hinv) & 255u) << 16) | (((unsigned)(int)rintf(xn[i][3] * hinv) & 255u) << 24);
              *(u32x4*)((signed char*)(ws + WS_H) + (size_t)row * D + 16 * lane) = o;
              if (lane == 0) ((float*)(ws + WS_GB))[row] = hmx * (1.f / 127.f); }
            float p[16];
#pragma unroll
            for (int c = 0; c < 16; ++c) { float q = 0.f;
#pragma unroll
                for (int i = 0; i < 4; ++i) { const f32x4 w = *(const LAS f32x4*)(wsk + c * 1024 + 16 * lane + 4 * i); q += (xn[i][0] * w[0] + xn[i][1] * w[1]) + (xn[i][2] * w[2] + xn[i][3] * w[3]); }
                p[c] = q; }
            { const bool hb = (lane & 32) != 0;
#pragma unroll
              for (int c = 0; c < 8; ++c) { const float keep = hb ? p[c + 8] : p[c], send = hb ? p[c] : p[c + 8]; p[c] = keep + lane_xor<32>(send); } }
            { const bool hb = (lane & 16) != 0;
#pragma unroll
              for (int c = 0; c < 4; ++c) { const float keep = hb ? p[c + 4] : p[c], send = hb ? p[c] : p[c + 4]; p[c] = keep + lane_xor<16>(send); } }
            { const bool hb = (lane & 8) != 0;
#pragma unroll
              for (int c = 0; c < 2; ++c) { const float keep = hb ? p[c + 2] : p[c], send = hb ? p[c] : p[c + 2]; p[c] = keep + lane_xor<8>(send); } }
            { const bool hb = (lane & 4) != 0; const float keep = hb ? p[1] : p[0], send = hb ? p[0] : p[1]; p[0] = keep + lane_xor<4>(send); }
            p[0] += lane_xor<2>(p[0]); p[0] += lane_xor<1>(p[0]);
            if ((lane & 3) == 0) { const int c = ((lane >> 5) & 1) * 8 + ((lane >> 4) & 1) * 4 + ((lane >> 3) & 1) * 2 + ((lane >> 2) & 1); ((float*)(ws + WS_BA))[(size_t)row * 16 + c] = p[0]; }
        }
    }
    if (fuse) __syncthreads();
}
#undef a
__global__ void __launch_bounds__(512, 2) fwd(Args a) {
    extern __shared__ __attribute__((aligned(16))) unsigned char lds_raw[];
    LAS unsigned char* lds = (LAS unsigned char*)lds_raw;
    volatile LAS unsigned* MISC = (volatile LAS unsigned*)(lds + LDS_MISC);
    if (threadIdx.x < 16) MISC[threadIdx.x] = 0u;
    __syncthreads();
    XcdBarrier bar; bar.bar = (unsigned*)(a.ws + WS_CTL) + 4096; bar.x = 0; bar.st = MISC + 8;
    bar = xcd_barrier_post((unsigned*)(a.ws + WS_CTL) + 4096, MISC + 8);
#ifndef PHASE_MASK
#define PHASE_MASK 0x1FFF
#endif
#define EN(i) ((PHASE_MASK >> (i)) & 1)
#ifndef REP_MASK
#define REP_MASK 0
#endif
#define REPN(i) (1 + ((REP_MASK >> (i)) & 1))
#define IN(k) true
#define SEAM(k) do { XcdBarrier b_; b_.bar = (unsigned*)(get_args()->ws + WS_CTL) + 4096; b_.x = xb_xcc_id(); b_.st = (volatile LAS unsigned*)(lds + LDS_MISC) + 8; xcd_barrier(b_); } while (0)
    for (int rep_ = 0; rep_ < (REPN(0)); ++rep_) if (EN(0) && IN(0)) phase_prologue(lds);
    SEAM(0);
#pragma unroll 1
    for (int l_ = 0; l_ < DEPTH; ++l_) {
        int l = l_; asm volatile("" : "+s"(l));
        const int pb = 1 + l * NPH_L;
        const int mrows = (l == DEPTH - 1) ? ML : M;
        if (l == 0) { for (int rep_ = 0; rep_ < (REPN(1)); ++rep_) if (EN(1) && IN(pb + 0)) { phase_norm<true>(l, 0, lds); phase_quant_weights(lds); }
            SEAM(pb + 0); }
        for (int rep_ = 0; rep_ < (REPN(2)); ++rep_) if (EN(2) && IN(pb + 1)) { const KArgs ap = get_args(); unsigned char* ws = ap->ws; pg8::Gemm g{(const bf16_t*)(ws + WS_H), (const bf16_t*)((const signed char*)(ws + WS_WINT) + (size_t)l * NP * 1024), M, NP, 512}; pg8::StaticOrder S; S.init(M, NP, fresh_g(), fresh_bx());
            pg8::EpiBf16I8 E{(bf16_t*)(ws + WS_P), NP, (const float*)(ws + WS_GB), (const float*)(ws + WS_CTL) + CW_WMAX + (l * 3 + 0) * 3072}; pg8::gemm_phase(lds, g, S, E); }
        SEAM(pb + 1);
        for (int rep_ = 0; rep_ < (REPN(3)); ++rep_) if (EN(3) && IN(pb + 2)) { phase_dn_chunkprep<1>(l, lds); phase_prep(l, lds); }
        for (int rep_ = 0; rep_ < (REPN(4)); ++rep_) if (EN(4) && IN(pb + 3)) phase_dn_chunkprep<0>(l, lds);
        SEAM(pb + 3);
        for (int rep_ = 0; rep_ < (REPN(5)); ++rep_) if (EN(5) && IN(pb + 4)) { phase_dn_scan<0>(l, lds); __syncthreads(); phase_attn(l, lds_raw, MISC, rep_); }
        SEAM(pb + 4);
        for (int rep_ = 0; rep_ < (REPN(7)); ++rep_) if (EN(7) && IN(pb + 5)) phase_dn_out(l);
        SEAM(pb + 5);
        if (EN(8) && IN(pb + 6)) { const KArgs ap = get_args(); unsigned char* ws = ap->ws; pg8::Gemm g{(const bf16_t*)(ws + WS_CATQ), (const bf16_t*)((const signed char*)(ws + WS_WOUTT) + (size_t)l * 1024 * 1024), mrows, 1024, 512}; pg8::StaticOrder S; S.init(mrows, 1024, fresh_g(), fresh_bx());
            pg8::EpiResI8 E{l == 0 ? ap->in[I_X] : ap->out, l == 0 ? ap->in[I_CTX] : (const float*)(ws + WS_CTXX), ap->out, (float*)(ws + WS_CTXX), (const float*)(ws + WS_MOD) + (size_t)l * 3 * 6144 + 2048,
                              (const float*)(ws + WS_GB) + (1u << 18), (const float*)(ws + WS_CTL) + CW_WMAX + (l * 3 + 1) * 3072};
            pg8::gemm_phase(lds, g, S, E); }
        SEAM(pb + 6);
        for (int rep_ = 0; rep_ < (REPN(9)); ++rep_) if (EN(9) && IN(pb + 7)) phase_norm<false>(l, 1, lds);
        SEAM(pb + 7);
        for (int rep_ = 0; rep_ < (REPN(10)); ++rep_) if (EN(10) && IN(pb + 8)) { const KArgs ap = get_args(); unsigned char* ws = ap->ws; pg8::Gemm g{(const bf16_t*)(ws + WS_H), (const bf16_t*)((const signed char*)(ws + WS_WQT) + (size_t)l * 2048 * 1024), mrows, 2048, 512}; pg8::StaticOrder S; S.init(mrows, 2048, fresh_g(), fresh_bx());
            pg8::EpiBf16I8 E{(bf16_t*)(ws + WS_P), 2048, (const float*)(ws + WS_GB), (const float*)(ws + WS_CTL) + CW_WMAX + (l * 3 + 2) * 3072}; pg8::gemm_phase(lds, g, S, E); }
        SEAM(pb + 8);
        for (int rep_ = 0; rep_ < (REPN(11)); ++rep_) if (EN(11) && IN(pb + 9)) phase_peer_select(l);
        SEAM(pb + 9);
        #ifdef GATHER_VAR
        if (EN(12) && IN(pb + 10)) phase_peer_gather<false, GATHER_VAR>(l, lds);
#endif
        if (REPN(12) > 1 && EN(12) && IN(pb + 10)) phase_peer_gather<false>(l, lds);
        if (EN(12) && IN(pb + 10)) phase_peer_gather<true>(l, lds);
        if (l + 1 < DEPTH) SEAM(pb + 10);
    }
#undef IN
#undef SEAM
}

#ifndef N_LAUNCH_MODE
#define N_LAUNCH_MODE 1
#endif
extern "C" void kernel_launch(void* const* d_in, const int* in_sizes, int n_in, void* d_out, int out_size, void* d_ws, size_t ws_size, hipStream_t stream) {
    static int grid = 0;
    if (grid == 0) {
        if (n_in != 20 || out_size != ML * D || ws_size < WS_END) { fprintf(stderr, "kernel_launch: unexpected shapes: n_in %d out %d ws %zu (need %zu)\n", n_in, out_size, ws_size, (size_t)WS_END); grid = -1; return; }
        int dev = 0, cus = 0, per_cu = 0;
        if (hipGetDevice(&dev) != hipSuccess || hipDeviceGetAttribute(&cus, hipDeviceAttributeMultiprocessorCount, dev) != hipSuccess) { grid = -1; return; }
        if (hipFuncSetAttribute((const void*)fwd, hipFuncAttributeMaxDynamicSharedMemorySize, LDS_BYTES) != hipSuccess) { fprintf(stderr, "kernel_launch: hipFuncSetAttribute failed\n"); grid = -1; return; }
        if (hipOccupancyMaxActiveBlocksPerMultiprocessor(&per_cu, (const void*)fwd, 512, LDS_BYTES) != hipSuccess || per_cu < 1) fprintf(stderr, "kernel_launch: occupancy query says %d\n", per_cu);
        (void)hipGetLastError();
        grid = cus;
    }
    if (grid < 0) return;
    (void)hipMemsetAsync((char*)d_ws + WS_CTL, 0, CTL_BYTES, stream);
    Args a{};
    for (int i = 0; i < 20; ++i) a.in[i] = (const float*)d_in[i];
    a.out = (float*)d_out; a.ws = (unsigned char*)d_ws;
    a.ph_lo = 0; a.ph_hi = NPHASE;
    hipLaunchKernelGGL(fwd, dim3(grid), dim3(512), LDS_BYTES, stream, a);
    const hipError_t le = hipPeekAtLastError();
    if (le != hipSuccess) fprintf(stderr, "kernel_launch: launch failed: %s\n", hipGetErrorName(le));
}
```

```cpp
#include <hip/hip_runtime.h>
#include <cstdio>
#include <cstdint>

#define GAS __attribute__((address_space(1)))
#define LAS __attribute__((address_space(3)))
typedef unsigned short bf16_t;
typedef short bf16x8 __attribute__((ext_vector_type(8)));
typedef short s16x4 __attribute__((ext_vector_type(4)));
typedef float f32x4 __attribute__((ext_vector_type(4)));
typedef float f32x2 __attribute__((ext_vector_type(2)));
typedef float f32x16 __attribute__((ext_vector_type(16)));
typedef unsigned u32x4 __attribute__((ext_vector_type(4)));
typedef unsigned u32x2 __attribute__((ext_vector_type(2)));
typedef int i32x4 __attribute__((ext_vector_type(4)));

constexpr int D = 1024, NB = 2, T = 16384, DEPTH = 4, CT = 256;
constexpr int ML = NB * T, MC = NB * CT, M = ML + MC;
constexpr int NIN = 3088, NP = 3072;
constexpr int KVLEN = T + CT;
constexpr int NEXP = 16384;
constexpr float EPS = 1e-6f;
constexpr int NPH_L = 11;
constexpr int NPHASE = 1 + DEPTH * NPH_L;

constexpr size_t MiB = 1u << 20;
constexpr size_t WS_CTL = 0, CTL_BYTES = 1 * MiB;
constexpr size_t WS_MOD = 1 * MiB;
constexpr size_t WS_ROPE = 2 * MiB;
constexpr size_t WS_WSK = 3 * MiB;
constexpr size_t WS_CTXX = 4 * MiB;
constexpr size_t WS_WINT = 8 * MiB;
constexpr size_t WS_WOUTT = 32 * MiB;
constexpr size_t WS_WQT = 40 * MiB;
constexpr size_t WS_SKB = 56 * MiB;
constexpr size_t WS_USC = 58 * MiB;
constexpr size_t WS_UB = 64 * MiB;
constexpr size_t WS_VB = 80 * MiB;
constexpr size_t TAB_SET = 32 * MiB;
constexpr size_t WS_H = 128 * MiB;
static_assert(WS_H + 2 * (size_t)M * 1024 <= 193 * MiB, "H + concat int8");
constexpr size_t WS_CATQ = WS_H + (size_t)M * 1024;
constexpr size_t WS_P = 193 * MiB;
constexpr size_t WS_QA = 388 * MiB;
constexpr size_t WS_KA = 421 * MiB;
constexpr size_t WS_VA = 438 * MiB;
constexpr size_t WS_CAT = 455 * MiB;
constexpr size_t WS_DQ = 520 * MiB;
constexpr size_t WS_DK = 553 * MiB;
constexpr size_t WS_DV = 586 * MiB;
constexpr size_t WS_OF = 619 * MiB;
constexpr size_t WS_OB = 684 * MiB;
constexpr size_t WS_GB = 749 * MiB;
constexpr size_t WS_BA = 752 * MiB;
constexpr size_t WS_PIDX = 755 * MiB;
constexpr size_t WS_PGATE = 772 * MiB;
constexpr size_t WS_REC = 789 * MiB;
constexpr size_t WS_END = 990 * MiB;
constexpr int CW_WMAX = 65536;
constexpr int NCH = 260;
constexpr int REC_K = 0, REC_KT = 16384, REC_Q = 32768, REC_V = 49152, REC_DIR = 65536, REC_DIRSZ = 17408, REC_BYTES = REC_DIR + 2 * REC_DIRSZ;
static_assert((size_t)NB * 4 * NCH * REC_BYTES + WS_REC <= WS_END, "rec region");

constexpr int LDS_BYTES = 163840;
constexpr int LDS_MISC = 163840 - 256;

__device__ __forceinline__ float bf2f(unsigned b) { return __uint_as_float(b << 16); }
__device__ __forceinline__ float bflo(unsigned w) { return __uint_as_float(w << 16); }
__device__ __forceinline__ float bfhi(unsigned w) { return __uint_as_float(w & 0xffff0000u); }
typedef __bf16 bf2v __attribute__((ext_vector_type(2)));
__device__ __forceinline__ unsigned pkbf(float lo, float hi) { unsigned r; asm("v_cvt_pk_bf16_f32 %0, %1, %2" : "=v"(r) : "v"(lo), "v"(hi)); return r; }
__device__ __forceinline__ unsigned pkbf_c(float lo, float hi) { f32x2 v = {lo, hi}; bf2v r = __builtin_convertvector(v, bf2v); return __builtin_bit_cast(unsigned, r); }
template <int K> __device__ __forceinline__ float lane_xor(float v) {
    const int b = __builtin_bit_cast(int, v);
    if constexpr (K == 1) return __builtin_bit_cast(float, __builtin_amdgcn_update_dpp(0, b, 0xB1, 0xF, 0xF, true));
    else if constexpr (K == 2) return __builtin_bit_cast(float, __builtin_amdgcn_update_dpp(0, b, 0x4E, 0xF, 0xF, true));
    else if constexpr (K == 32) { auto rr = __builtin_amdgcn_permlane32_swap((unsigned)b, (unsigned)b, false, false); unsigned ln_ = __builtin_amdgcn_mbcnt_hi(~0u, __builtin_amdgcn_mbcnt_lo(~0u, 0u)); asm volatile("" : "+v"(ln_));
        return __uint_as_float((ln_ & 32u) ? rr[0] : rr[1]); }
    else return __builtin_bit_cast(float, __builtin_amdgcn_ds_swizzle(b, 0x1F | (K << 10)));
}
__device__ __forceinline__ float wave_sum(float v) {
    v += lane_xor<1>(v); v += lane_xor<2>(v);
    v += __builtin_bit_cast(float, __builtin_amdgcn_update_dpp(0, __builtin_bit_cast(int, v), 0x124, 0xF, 0xF, true));
    v += __builtin_bit_cast(float, __builtin_amdgcn_update_dpp(0, __builtin_bit_cast(int, v), 0x128, 0xF, 0xF, true));
    v += lane_xor<16>(v);
    { auto rr = __builtin_amdgcn_permlane32_swap(__float_as_uint(v), __float_as_uint(v), false, false); v = __uint_as_float(rr[0]) + __uint_as_float(rr[1]); }
    return v;
}
__device__ __forceinline__ float wave_max(float v) {
    v = fmaxf(v, lane_xor<1>(v)); v = fmaxf(v, lane_xor<2>(v));
    v = fmaxf(v, __builtin_bit_cast(float, __builtin_amdgcn_update_dpp(0, __builtin_bit_cast(int, v), 0x124, 0xF, 0xF, true)));
    v = fmaxf(v, __builtin_bit_cast(float, __builtin_amdgcn_update_dpp(0, __builtin_bit_cast(int, v), 0x128, 0xF, 0xF, true)));
    v = fmaxf(v, lane_xor<16>(v));
    { auto rr = __builtin_amdgcn_permlane32_swap(__float_as_uint(v), __float_as_uint(v), false, false); v = fmaxf(__uint_as_float(rr[0]), __uint_as_float(rr[1])); }
    return v;
}
__device__ __forceinline__ float silu_f(float x) { return x / (1.f + __expf(-x)); }
#define LDS_WAIT() asm volatile("s_waitcnt lgkmcnt(0)" ::: "memory")

#define XB_TMO      128
#define XB_XCNT(j)  (256  + 64 * (j))
#define XB_XSUB(j)  (1280 + 64 * (j))
#define XB_XGEN(j)  (2304 + 64 * (j))
#define XB_TOP      3328
#define XB_TOPGEN   3392
#define XCD_BAR_WORDS 3456
#define XB_SPIN_CAP (1u << 22)
__device__ __forceinline__ unsigned xb_ld(unsigned* p)              { return __hip_atomic_load(p, __ATOMIC_RELAXED, __HIP_MEMORY_SCOPE_AGENT); }
__device__ __forceinline__ unsigned xb_add(unsigned* p, unsigned v) { return __hip_atomic_fetch_add(p, v, __ATOMIC_RELAXED, __HIP_MEMORY_SCOPE_AGENT); }
__device__ __forceinline__ unsigned xb_xcc_id() { return (unsigned)__builtin_amdgcn_s_getreg((3 << 11) | 20) & 0xFu; }
#define XB_SPIN(cond, bar) do { unsigned _sp = 0; while (cond) { __builtin_amdgcn_s_sleep(1); \
    if ((++_sp & 255u) == 0u) { if (xb_ld(&(bar)[XB_TMO])) break; if (_sp > XB_SPIN_CAP) { atomicAdd(&(bar)[XB_TMO], 1u); break; } } } } while (0)
struct XcdBarrier { unsigned* bar; unsigned x; volatile LAS unsigned* st; };
__device__ __forceinline__ XcdBarrier xcd_barrier_post(unsigned* bar, volatile LAS unsigned* st) {
    XcdBarrier b; b.bar = bar; b.x = xb_xcc_id(); b.st = st;
    if (threadIdx.x == 0) (void)xb_add(&bar[XB_XCNT(b.x)], 1u);
    return b;
}
__device__ __forceinline__ void xcd_barrier_complete(unsigned* bar, unsigned x, unsigned& nloc, unsigned& nx) {
    const unsigned G = gridDim.x * gridDim.y * gridDim.z;
    unsigned sum, cnt, mine, sp = 0u;
    for (;;) {
        sum = 0u; cnt = 0u; mine = 0u;
#pragma unroll
        for (unsigned j = 0; j < 16; ++j) { const unsigned c = xb_ld(&bar[XB_XCNT(j)]); sum += c; cnt += (c > 0u) ? 1u : 0u; mine = (j == x) ? c : mine; }
        if (sum == G) break;
        __builtin_amdgcn_s_sleep(1);
        if ((++sp & 255u) == 0u) { if (xb_ld(&bar[XB_TMO])) break; if (sp > XB_SPIN_CAP) { atomicAdd(&bar[XB_TMO], 1u); break; } }
    }
    nloc = mine > 0u ? mine : 1u; nx = cnt > 0u ? cnt : 1u;
}
__device__ __forceinline__ void xcd_barrier(const XcdBarrier& b) {
    asm volatile("s_waitcnt vmcnt(0)" ::: "memory");
    __syncthreads();
    if (threadIdx.x == 0) {
        unsigned* bar = b.bar; unsigned bx_ = b.x;
        asm volatile("" : "+s"(bar), "+s"(bx_));
        __builtin_amdgcn_s_waitcnt(0);
        unsigned nloc = b.st[0], nx = b.st[1];
        if (nloc == 0u) { xcd_barrier_complete(bar, bx_, nloc, nx); b.st[0] = nloc; b.st[1] = nx; }
        const unsigned old = xb_add(&bar[XB_XSUB(bx_)], 1u);
        const unsigned gen = old / nloc;
        if (old + 1u == (gen + 1u) * nloc) {
            __builtin_amdgcn_fence(__ATOMIC_RELEASE, "agent");
            asm volatile("s_waitcnt vmcnt(0)" ::: "memory");
            const unsigned og = xb_add(&bar[XB_TOP], 1u);
            const unsigned tg = og / nx;
            if (og + 1u == (tg + 1u) * nx) xb_add(&bar[XB_TOPGEN], 1u);
            else XB_SPIN(xb_ld(&bar[XB_TOPGEN]) == tg, bar);
            __builtin_amdgcn_fence(__ATOMIC_ACQUIRE, "agent");
            xb_add(&bar[XB_XGEN(bx_)], 1u);
            asm volatile("s_waitcnt vmcnt(0)" ::: "memory");
        } else {
            XB_SPIN(xb_ld(&bar[XB_XGEN(bx_)]) == gen, bar);
            __builtin_amdgcn_fence(__ATOMIC_ACQUIRE, "agent");
            asm volatile("s_waitcnt vmcnt(0)" ::: "memory");
        }
    }
    __syncthreads();
}

namespace pg8 {
constexpr int BM = 256, BK = 64, HALF = 128, HTB = HALF * BK * 2, STAGE_BYTES = 8 * HTB, NXCD = 8, WGM = 8;
__host__ __device__ __forceinline__ int lds_byte(int r, int c) { const int st = (r >> 4) * 2 + (c >> 5), rr = r & 15, cc = c & 31, ob = rr * 64 + cc * 2; return st * 1024 + (ob ^ (((ob >> 9) & 1) << 5)); }
__host__ __device__ __forceinline__ void stage_rc(int b, int& R, int& C) { const int st = b / 1024, sb = b % 1024, swz = sb ^ (((sb >> 9) & 1) << 5); R = (st >> 1) * 16 + swz / 64; C = (st & 1) * 32 + (swz % 64) / 2; }
__host__ __device__ __forceinline__ int perm32(int rho) { const int n = rho >> 4, i = rho & 15; return 8 * (i >> 2) + 4 * n + (i & 3); }
struct Unit { int pm, pn; };
struct Gemm { const bf16_t* A; const bf16_t* Bt; int M, N, K; };
struct StaticOrder {
    int nM, nN, nwg, G, c;
    __host__ __device__ void init(int M_, int N_, int G_, int c_) { nM = M_ / BM; nN = N_ / BM; nwg = nM * nN; G = G_; c = c_; }
    __host__ __device__ bool next(int i, Unit& u) const {
        const long L = (long)i * G + c; if (L >= nwg) return false;
        int wgid = (int)L; { const int q = nwg / NXCD, r = nwg % NXCD, xcd = wgid % NXCD, off = wgid / NXCD; wgid = (xcd < r ? xcd * (q + 1) : r * (q + 1) + (xcd - r) * q) + off; }
        const int nig = WGM * nN, gid = wgid / nig, fm = gid * WGM, gsz = (nM - fm) < WGM ? (nM - fm) : WGM;
        u.pm = fm + ((wgid % nig) % gsz); u.pn = (wgid % nig) / gsz; return true;
    }
    __device__ __forceinline__ void a_ready(const Unit&) const {}
    __device__ __forceinline__ void done(const Unit&) const {}
};
struct EpiBf16 {
    static constexpr bool PERM = true, I8 = false; typedef f32x4 acc_t;
    bf16_t* O; int ldc;
    __device__ __forceinline__ void operator()(const f32x4 (&acc)[2][2][4][2], const Unit& u, int wr, int wc, int fr, int fq) const {
        const int row0 = u.pm * BM + wr * 64 + fr; const int col0 = u.pn * BM + wc * 32 + 8 * fq;
#pragma unroll
        for (int ai = 0; ai < 2; ++ai)
#pragma unroll
            for (int m = 0; m < 4; ++m) { bf16_t* rowp = O + (size_t)(row0 + ai * HALF + m * 16) * ldc + col0;
#pragma unroll
                for (int bj = 0; bj < 2; ++bj) { const f32x4 v0 = acc[ai][bj][m][0], v1 = acc[ai][bj][m][1];
                    u32x4 w; w.x = pkbf_c(v0[0], v0[1]); w.y = pkbf_c(v0[2], v0[3]); w.z = pkbf_c(v1[0], v1[1]); w.w = pkbf_c(v1[2], v1[3]);
                    *(u32x4*)(rowp + bj * HALF) = w; } }
    }
};
struct EpiBf16I8 {
    static constexpr bool PERM = true, I8 = true; typedef i32x4 acc_t;
    bf16_t* O; int ldc; const float* sa; const float* wmax;
    __device__ __forceinline__ void operator()(const i32x4 (&acc)[2][2][4][2], const Unit& u, int wr, int wc, int fr, int fq) const {
        const int row0 = u.pm * BM + wr * 64 + fr; const int col0 = u.pn * BM + wc * 32 + 8 * fq;
        f32x4 sw[2][2];
#pragma unroll
        for (int bj = 0; bj < 2; ++bj)
#pragma unroll
            for (int n = 0; n < 2; ++n) sw[bj][n] = *(const f32x4*)(wmax + col0 + bj * HALF + 4 * n) * (1.f / 127.f);
#pragma unroll
        for (int ai = 0; ai < 2; ++ai)
#pragma unroll
            for (int m = 0; m < 4; ++m) { const int row = row0 + ai * HALF + m * 16; const float sr = sa[row]; bf16_t* rowp = O + (size_t)row * ldc + col0;
#pragma unroll
                for (int bj = 0; bj < 2; ++bj) { const i32x4 a0 = acc[ai][bj][m][0], a1 = acc[ai][bj][m][1];
                    const f32x4 v0 = (f32x4){(float)a0[0], (float)a0[1], (float)a0[2], (float)a0[3]} * sw[bj][0] * sr, v1 = (f32x4){(float)a1[0], (float)a1[1], (float)a1[2], (float)a1[3]} * sw[bj][1] * sr;
                    u32x4 w; w.x = pkbf(v0[0], v0[1]); w.y = pkbf(v0[2], v0[3]); w.z = pkbf(v1[0], v1[1]); w.w = pkbf(v1[2], v1[3]);
                    *(u32x4*)(rowp + bj * HALF) = w; } }
    }
};
struct EpiRes {
    static constexpr bool PERM = false, I8 = false; typedef f32x4 acc_t;
    const float* src_lat; const float* src_ctx; float* dst_lat; float* dst_ctx; const float* gate;
    __device__ __forceinline__ void operator()(const f32x4 (&acc)[2][2][4][2], const Unit& u, int wr, int wc, int fr, int fq) const {
        const bool isctx = u.pm >= (ML / BM);
        const float* src = isctx ? src_ctx + (size_t)(u.pm - ML / BM) * BM * D : src_lat + (size_t)u.pm * BM * D;
        float* dst = isctx ? dst_ctx + (size_t)(u.pm - ML / BM) * BM * D : dst_lat + (size_t)u.pm * BM * D;
        const int mrow = isctx ? 2 : (u.pm >= (T / BM) ? 1 : 0);
        const int row0 = wr * 64 + fr, col0 = u.pn * BM + wc * 32 + 4 * fq;
        f32x4 gv[2][2];
#pragma unroll
        for (int bj = 0; bj < 2; ++bj)
#pragma unroll
            for (int n = 0; n < 2; ++n) gv[bj][n] = *(const f32x4*)(gate + mrow * 6144 + col0 + bj * HALF + n * 16);
#pragma unroll
        for (int ai = 0; ai < 2; ++ai)
#pragma unroll
            for (int m = 0; m < 4; ++m) { const size_t off = (size_t)(row0 + ai * HALF + m * 16) * D + col0;
#pragma unroll
                for (int bj = 0; bj < 2; ++bj)
#pragma unroll
                    for (int n = 0; n < 2; ++n) { const f32x4 s = *(const f32x4*)(src + off + bj * HALF + n * 16);
                        *(f32x4*)(dst + off + bj * HALF + n * 16) = s + gv[bj][n] * acc[ai][bj][m][n]; } }
    }
};

struct EpiResI8 {
    static constexpr bool PERM = false, I8 = true; typedef i32x4 acc_t;
    const float* src_lat; const float* src_ctx; float* dst_lat; float* dst_ctx; const float* gate; const float* sa; const float* wmax;
    __device__ __forceinline__ void operator()(const i32x4 (&acc)[2][2][4][2], const Unit& u, int wr, int wc, int fr, int fq) const {
        const bool isctx = u.pm >= (ML / BM);
        const float* src = isctx ? src_ctx + (size_t)(u.pm - ML / BM) * BM * D : src_lat + (size_t)u.pm * BM * D;
        float* dst = isctx ? dst_ctx + (size_t)(u.pm - ML / BM) * BM * D : dst_lat + (size_t)u.pm * BM * D;
        const int mrow = isctx ? 2 : (u.pm >= (T / BM) ? 1 : 0);
        const int row0 = wr * 64 + fr, col0 = u.pn * BM + wc * 32 + 4 * fq;
        f32x4 gv[2][2];
#pragma unroll
        for (int bj = 0; bj < 2; ++bj)
#pragma unroll
            for (int n = 0; n < 2; ++n) gv[bj][n] = *(const f32x4*)(gate + mrow * 6144 + col0 + bj * HALF + n * 16) * *(const f32x4*)(wmax + col0 + bj * HALF + n * 16) * (1.f / 127.f);
#pragma unroll
        for (int ai = 0; ai < 2; ++ai)
#pragma unroll
            for (int m = 0; m < 4; ++m) { const int rl = row0 + ai * HALF + m * 16; const float sr = sa[u.pm * BM + rl]; const size_t off = (size_t)rl * D + col0;
#pragma unroll
                for (int bj = 0; bj < 2; ++bj)
#pragma unroll
                    for (int n = 0; n < 2; ++n) { const f32x4 sv = *(const f32x4*)(src + off + bj * HALF + n * 16); const i32x4 ac = acc[ai][bj][m][n];
                        *(f32x4*)(dst + off + bj * HALF + n * 16) = sv + gv[bj][n] * ((f32x4){(float)ac[0], (float)ac[1], (float)ac[2], (float)ac[3]} * sr); } }
    }
};
template <class Epi, class Sched>
__device__ __forceinline__ void gemm_phase(LAS unsigned char* lds, const Gemm g, const Sched& S, const Epi& E) {
    constexpr bool I8 = Epi::I8;
    typedef typename Epi::acc_t acc_t;
    int tid = threadIdx.x; asm volatile("" : "+v"(tid)); const int wid = __builtin_amdgcn_readfirstlane(tid >> 6), lane = tid & 63, wr = wid >> 2, wc = wid & 3, fr = lane & 15, fq = lane >> 4;
    const int K = g.K, nt = K / BK;
    unsigned voffA[2], voffB[2];
#pragma unroll
    for (int i = 0; i < 2; ++i) { int R, C; stage_rc(tid * 16 + i * 8192, R, C); const int Rb = Epi::PERM ? ((R & ~31) + perm32(R & 31)) : R;
        voffA[i] = (unsigned)(R * K + C) * 2u; voffB[i] = (unsigned)(Rb * K + C) * 2u; }
    const size_t kstep = (size_t)(BK * 2);
    const size_t hstep = (size_t)HALF * K * 2;
    const size_t tstep = 2 * hstep;
    const unsigned ldsw = (unsigned)wid * 1024u;
    const int aoff = lds_byte(wr * 64 + fr, fq * 8), boff = lds_byte(wc * 32 + fr, fq * 8);
#define PG8_SA(b, h) (((b) * 2 + (h)) * HTB)
#define PG8_SB(b, h) ((4 + (b) * 2 + (h)) * HTB)
#define PG8_STAGE(bufoff, gbase, voff) do { _Pragma("unroll") for (int _i = 0; _i < 2; ++_i) \
        __builtin_amdgcn_global_load_lds((const unsigned*)((const char*)(gbase) + (voff)[_i]), (LAS unsigned*)(lds + (bufoff) + ldsw + _i * 8192), 16, 0, 0); } while (0)
#define PG8_LDA(dst, b, h) do { _Pragma("unroll") for (int m = 0; m < 4; ++m) _Pragma("unroll") for (int k = 0; k < 2; ++k) dst[m][k] = *(const LAS bf16x8*)(lds + PG8_SA(b, h) + aoff + m * 2048 + k * 1024); } while (0)
#define PG8_LDB(dst, b, h) do { _Pragma("unroll") for (int n = 0; n < 2; ++n) _Pragma("unroll") for (int k = 0; k < 2; ++k) dst[n][k] = *(const LAS bf16x8*)(lds + PG8_SB(b, h) + boff + n * 2048 + k * 1024); } while (0)
#define PG8_MMA(ai, bj, At, Bt) do { __builtin_amdgcn_s_setprio(1); _Pragma("unroll") for (int m = 0; m < 4; ++m) _Pragma("unroll") for (int n = 0; n < 2; ++n) _Pragma("unroll") for (int k = 0; k < 2; ++k) \
        { if constexpr (I8) acc[ai][bj][m][n] = __builtin_bit_cast(acc_t, __builtin_amdgcn_mfma_i32_16x16x64_i8(__builtin_bit_cast(i32x4, Bt[n][k]), __builtin_bit_cast(i32x4, At[m][k]), __builtin_bit_cast(i32x4, acc[ai][bj][m][n]), 0, 0, 0)); \
          else acc[ai][bj][m][n] = __builtin_bit_cast(acc_t, __builtin_amdgcn_mfma_f32_16x16x32_bf16(Bt[n][k], At[m][k], __builtin_bit_cast(f32x4, acc[ai][bj][m][n]), 0, 0, 0)); } __builtin_amdgcn_s_setprio(0); } while (0)
#define PG8_WAIT_V(n) asm volatile("s_waitcnt vmcnt(" #n ")" ::: "memory")
#define PG8_WAIT_L(n) asm volatile("s_waitcnt lgkmcnt(" #n ")" ::: "memory")
#define PG8_BAR __builtin_amdgcn_s_barrier()
#define PG8_SCHED __builtin_amdgcn_sched_barrier(0)
    Unit cur, nxt; int ui = 0;
    if (!S.next(0, cur)) return;
    acc_t acc[2][2][4][2];
#pragma unroll
    for (int a = 0; a < 2; ++a)
#pragma unroll
        for (int b = 0; b < 2; ++b)
#pragma unroll
            for (int m = 0; m < 4; ++m)
#pragma unroll
                for (int n = 0; n < 2; ++n) acc[a][b][m][n] = acc_t{};
    bf16x8 At[4][2], B0[2][2], B1[2][2];
    const char* cA = (const char*)g.A + (size_t)cur.pm * tstep; const char* cB = (const char*)g.Bt + (size_t)cur.pn * tstep;
    S.a_ready(cur);
    PG8_STAGE(PG8_SB(0, 0), cB, voffB); PG8_STAGE(PG8_SA(0, 0), cA, voffA); PG8_STAGE(PG8_SB(0, 1), cB + hstep, voffB); PG8_STAGE(PG8_SA(0, 1), cA + hstep, voffA);
    if (wr == 1) PG8_BAR;
    PG8_WAIT_V(4); PG8_BAR;
    PG8_STAGE(PG8_SB(1, 0), cB + kstep, voffB); PG8_STAGE(PG8_SA(1, 0), cA + kstep, voffA); PG8_STAGE(PG8_SB(1, 1), cB + hstep + kstep, voffB);
    PG8_WAIT_V(6); PG8_BAR;
    for (;;) {
        const bool has_next = S.next(ui + 1, nxt);
        const char* nA = has_next ? (const char*)g.A + (size_t)nxt.pm * tstep : cA; const char* nB = has_next ? (const char*)g.Bt + (size_t)nxt.pn * tstep : cB;
        for (int t = 0; t < nt; t += 2) {
            const bool last = (t == nt - 2);
            const char* a1 = cA + (size_t)(t + 1) * kstep;
            const char* a2 = last ? nA : cA + (size_t)(t + 2) * kstep; const char* b2 = last ? nB : cB + (size_t)(t + 2) * kstep;
            const char* a3 = a2 + kstep; const char* b3 = b2 + kstep;
            if (last && has_next) S.a_ready(nxt);
            PG8_LDB(B0, 0, 0); PG8_SCHED; PG8_LDA(At, 0, 0); PG8_STAGE(PG8_SA(1, 1), a1 + hstep, voffA);
            PG8_WAIT_L(8); PG8_BAR; PG8_WAIT_L(0); PG8_MMA(0, 0, At, B0); PG8_BAR; PG8_SCHED;
            PG8_LDB(B1, 0, 1); PG8_STAGE(PG8_SB(0, 0), b2, voffB);
            PG8_BAR; PG8_WAIT_L(0); PG8_MMA(0, 1, At, B1); PG8_BAR;
            PG8_LDA(At, 0, 1); PG8_STAGE(PG8_SA(0, 0), a2, voffA);
            PG8_BAR; PG8_WAIT_L(0); PG8_MMA(1, 0, At, B0); PG8_BAR; PG8_SCHED;
            PG8_STAGE(PG8_SB(0, 1), b2 + hstep, voffB);
            PG8_WAIT_V(6); PG8_BAR; PG8_MMA(1, 1, At, B1); PG8_BAR;
            PG8_LDB(B0, 1, 0); PG8_SCHED; PG8_LDA(At, 1, 0); PG8_STAGE(PG8_SA(0, 1), a2 + hstep, voffA);
            PG8_WAIT_L(8); PG8_BAR; PG8_WAIT_L(0); PG8_MMA(0, 0, At, B0); PG8_BAR; PG8_SCHED;
            PG8_LDB(B1, 1, 1); PG8_STAGE(PG8_SB(1, 0), b3, voffB);
            PG8_BAR; PG8_WAIT_L(0); PG8_MMA(0, 1, At, B1); PG8_BAR;
            PG8_LDA(At, 1, 1); PG8_STAGE(PG8_SA(1, 0), a3, voffA);
            PG8_BAR; PG8_WAIT_L(0); PG8_MMA(1, 0, At, B0); PG8_BAR; PG8_SCHED;
            PG8_STAGE(PG8_SB(1, 1), b3 + hstep, voffB);
            PG8_WAIT_V(6); PG8_BAR; PG8_MMA(1, 1, At, B1); PG8_BAR;
        }
        E(acc, cur, wr, wc, fr, fq); S.done(cur);
        if (!has_next) break;
#pragma unroll
        for (int a = 0; a < 2; ++a)
#pragma unroll
            for (int b = 0; b < 2; ++b)
#pragma unroll
                for (int m = 0; m < 4; ++m)
#pragma unroll
                    for (int n = 0; n < 2; ++n) acc[a][b][m][n] = acc_t{};
        cur = nxt; cA = nA; cB = nB; ++ui;
    }
    PG8_WAIT_V(0);
    if (wr == 0) PG8_BAR;
    PG8_BAR;
#undef PG8_SA
#undef PG8_SB
#undef PG8_STAGE
#undef PG8_LDA
#undef PG8_LDB
#undef PG8_MMA
#undef PG8_WAIT_V
#undef PG8_WAIT_L
#undef PG8_BAR
#undef PG8_SCHED
}
}

namespace att {
constexpr int HD = 128, NW = 8, QBLK = 32, KVBLK = 64;
constexpr float SCALE = 0.088388347648318440f;
constexpr float THR = 8.f;
constexpr int LDQ = 512, LDK = 256;
constexpr size_t SHM_V = KVBLK * HD * 2, SHM_K = KVBLK * HD * 2, SHM_ATTN = 2 * SHM_V + 2 * SHM_K + NW * 64 * 4;
#define KSWZ(row, colB) ((row) * 256 + ((colB) ^ (((row) & 7) << 4)))
#define SBAR() __builtin_amdgcn_sched_barrier(0)
__device__ __forceinline__ int crow(int r, int hi) { return (r & 3) + 8 * (r >> 2) + 4 * hi; }
__device__ __forceinline__ unsigned cvtpk(float lo, float hi) { unsigned r; asm volatile("v_cvt_pk_bf16_f32 %0, %1, %2" : "=v"(r) : "v"(lo), "v"(hi)); return r; }
__device__ __forceinline__ void partialSM(f32x16& p0, f32x16& p1) {
  for (int r = 0; r < 16; ++r) p0[r] = __builtin_amdgcn_exp2f(p0[r]);
}
typedef int i32x8 __attribute__((ext_vector_type(8)));
__device__ __forceinline__ void finishSM(f32x16& p0, f32x16& p1, float& l_reg, i32x8& pa) {
  for (int r = 0; r < 16; ++r) p1[r] = __builtin_amdgcn_exp2f(p1[r]);
  float ps = 0; for (int r = 0; r < 16; ++r) ps += p0[r]; for (int r = 0; r < 16; ++r) ps += p1[r];
  { auto rr = __builtin_amdgcn_permlane32_swap(__float_as_uint(ps), __float_as_uint(ps), false, false);
    ps = __uint_as_float(rr[0]) + __uint_as_float(rr[1]); }
  l_reg += ps;
#pragma unroll
  for (int q = 0; q < 4; ++q) { int w = __builtin_amdgcn_cvt_pk_bf8_f32(p0[4 * q], p0[4 * q + 1], 0, false); w = __builtin_amdgcn_cvt_pk_bf8_f32(p0[4 * q + 2], p0[4 * q + 3], w, true); pa[q] = w;
    int w2 = __builtin_amdgcn_cvt_pk_bf8_f32(p1[4 * q], p1[4 * q + 1], 0, false); w2 = __builtin_amdgcn_cvt_pk_bf8_f32(p1[4 * q + 2], p1[4 * q + 3], w2, true); pa[4 + q] = w2; }
}
constexpr int K8_STRIDE = 144, K8_TILE = KVBLK * K8_STRIDE;
__device__ __forceinline__ void qkt(f32x16& p0, f32x16& p1, const unsigned char* Ks, const i32x8* qr, int r32, int hi, const f32x16& cinit) {
  p0 = cinit; p1 = cinit;
#pragma unroll
  for (int ks = 0; ks < 2; ++ks) {
    const u32x4* a0 = (const u32x4*)(Ks + r32 * K8_STRIDE + 64 * ks + 32 * hi); const u32x4* a1 = (const u32x4*)(Ks + (32 + r32) * K8_STRIDE + 64 * ks + 32 * hi);
    const u32x4 x0 = a0[0], x1 = a0[1], y0 = a1[0], y1 = a1[1];
    const i32x8 k0 = {(int)x0.x, (int)x0.y, (int)x0.z, (int)x0.w, (int)x1.x, (int)x1.y, (int)x1.z, (int)x1.w}, k1 = {(int)y0.x, (int)y0.y, (int)y0.z, (int)y0.w, (int)y1.x, (int)y1.y, (int)y1.z, (int)y1.w};
    p0 = __builtin_amdgcn_mfma_scale_f32_32x32x64_f8f6f4(k0, qr[ks], p0, 0, 0, 0, 0x7F7F7F7F, 0, 0x7C7C7C7C);
    p1 = __builtin_amdgcn_mfma_scale_f32_32x32x64_f8f6f4(k1, qr[ks], p1, 0, 0, 0, 0x7F7F7F7F, 0, 0x7C7C7C7C); }
}
constexpr int V8_STRIDE = 80, V8_TILE = HD * V8_STRIDE;
__device__ __forceinline__ void pv_d0(f32x16* o, const unsigned char* Vs, const i32x8& pa, int r32, int hi) {
#pragma unroll
  for (int d0 = 0; d0 < 4; ++d0) { const u32x4* bp = (const u32x4*)(Vs + (32 * d0 + r32) * V8_STRIDE + 32 * hi); const u32x4 x0 = bp[0], x1 = bp[1];
    const i32x8 vb = {(int)x0.x, (int)x0.y, (int)x0.z, (int)x0.w, (int)x1.x, (int)x1.y, (int)x1.z, (int)x1.w};
    o[d0] = __builtin_amdgcn_mfma_scale_f32_32x32x64_f8f6f4(pa, vb, o[d0], 1  , 0  , 0, 0x7F7F7F7F, 0, 0x7F7F7F7F); }
}
__device__ __forceinline__ void attn_dense_body(const unsigned char* __restrict__ Qb, const unsigned char* __restrict__ Kh, const unsigned char* __restrict__ Vt,
                                                bf16_t* __restrict__ Ob, int LDO, int seq, char* lds, float* __restrict__ lse, float braw) {
  int tid = threadIdx.x; asm volatile("" : "+v"(tid)); const int wid = tid >> 6, lane = tid & 63, r32 = lane & 31, hi = lane >> 5;
  unsigned char* V_lds = (unsigned char*)lds; unsigned char* K_lds = (unsigned char*)(lds + 2 * V8_TILE);
  float* ws = (float*)(lds + 2 * V8_TILE + 2 * K8_TILE) + wid * 64; float* li_l = ws;
  float l_reg = 0; f32x16 o[4] = {}; i32x8 qr[2];
  const float mnC = __builtin_bit_cast(float, __builtin_amdgcn_readfirstlane(__builtin_bit_cast(int, -fmaxf(braw * (SCALE * 1.4426950408889634f) - 15.5f, 0.f))));
  f32x16 cinit;
#pragma unroll
  for (int r = 0; r < 16; ++r) cinit[r] = mnC;
  const unsigned char* Qw = Qb + (long)(wid * QBLK + r32) * LDQ + hi * 32;
#pragma unroll
  for (int ks = 0; ks < 2; ++ks) { const u32x4 x0 = *(const u32x4*)(Qw + 64 * ks), x1 = *(const u32x4*)(Qw + 64 * ks + 16);
    qr[ks] = (i32x8){(int)x0.x, (int)x0.y, (int)x0.z, (int)x0.w, (int)x1.x, (int)x1.y, (int)x1.z, (int)x1.w}; }
  const int krow = tid >> 3, kch = tid & 7;
  const int vrow = tid >> 2, vch = tid & 3;
  struct { u32x4 v8, k8; } sr_[2];
#define SLOAD(i, k0) do { sr_[i].v8 = *reinterpret_cast<const u32x4*>(Vt + (long)((k0) >> 6) * 8192 + tid * 16); \
    sr_[i].k8 = *reinterpret_cast<const u32x4*>(Kh + (long)((k0) + krow) * LDK + kch * 16); } while (0)
#define SWRITE(b, i) do { *(u32x4*)(V_lds + (b) * V8_TILE + vrow * V8_STRIDE + vch * 16) = sr_[i].v8; \
    *(u32x4*)(K_lds + (b) * K8_TILE + krow * K8_STRIDE + kch * 16) = sr_[i].k8; } while (0)
#define SWAIT() asm volatile("s_waitcnt vmcnt(2)" ::: "memory")
  f32x16 pA0, pA1, pB0, pB1; i32x8 pa; const int NT = seq / KVBLK;
  constexpr int SE = 0, SO = 1;
  SLOAD(SE, 0); asm volatile("s_waitcnt vmcnt(0)" ::: "memory"); SWRITE(0, SE); __syncthreads();
  qkt(pA0, pA1, K_lds, qr, r32, hi, cinit); partialSM(pA0, pA1);
  SLOAD(SO, KVBLK); SLOAD(SE, 2 * KVBLK);
  SWAIT(); SWRITE(1, SO); __syncthreads();
  for (int j = 1; j + 1 < NT; j += 2) {
    SBAR(); qkt(pB0, pB1, K_lds + K8_TILE, qr, r32, hi, cinit);
    finishSM(pA0, pA1, l_reg, pa); SBAR();
    SLOAD(SO, (j + 2) * KVBLK); SBAR();
    pv_d0(o, V_lds, pa, r32, hi); partialSM(pB0, pB1);
    __syncthreads(); SWAIT(); SWRITE(0, SE);
    __syncthreads();
    SBAR(); qkt(pA0, pA1, K_lds, qr, r32, hi, cinit);
    finishSM(pB0, pB1, l_reg, pa); SBAR();
    SLOAD(SE, (j + 3 < NT ? j + 3 : NT - 1) * KVBLK); SBAR();
    pv_d0(o, V_lds + V8_TILE, pa, r32, hi); partialSM(pA0, pA1);
    __syncthreads(); SWAIT(); SWRITE(1, SO);
    __syncthreads();
  }
  SBAR(); qkt(pB0, pB1, K_lds + K8_TILE, qr, r32, hi, cinit);
  finishSM(pA0, pA1, l_reg, pa); SBAR();
  pv_d0(o, V_lds, pa, r32, hi); partialSM(pB0, pB1);
  __syncthreads();
  finishSM(pB0, pB1, l_reg, pa); SBAR();
  pv_d0(o, V_lds + V8_TILE, pa, r32, hi);
  if (hi == 0) { li_l[r32] = l_reg; if (lse) lse[(wid * QBLK + r32) * 4] = __logf(l_reg) - mnC * 0.69314718055994531f; }
  asm volatile("s_waitcnt lgkmcnt(0)" ::: "memory");
  float rli[16];
#pragma unroll
  for (int r = 0; r < 16; ++r) rli[r] = __builtin_amdgcn_rcpf(li_l[crow(r, hi)]);
  bf16_t* Ow = Ob + (long)(wid * QBLK) * LDO;
#pragma unroll
  for (int r = 0; r < 16; ++r) { int orow = crow(r, hi);
    for (int d0 = 0; d0 < 4; ++d0) Ow[(long)orow * LDO + d0 * 32 + r32] = (bf16_t)(pkbf(o[d0][r] * rli[r], 0.f) & 0xffffu); }
  __syncthreads();
#undef SLOAD
#undef SWRITE
#undef SWAIT
}
}

struct Args { const float* in[20]; float* out; unsigned char* ws; int ph_lo, ph_hi; };
typedef const __attribute__((address_space(4))) Args* KArgs;
__device__ __forceinline__ KArgs get_args() { KArgs p = (KArgs)__builtin_amdgcn_kernarg_segment_ptr(); asm volatile("" : "+s"(p)); return p; }
__device__ __forceinline__ int fresh_tid() { int t = threadIdx.x; asm volatile("" : "+v"(t)); return t; }
__device__ __forceinline__ int fresh_bx() { int t = blockIdx.x; asm volatile("" : "+s"(t)); return t; }
__device__ __forceinline__ int fresh_g() { int t = gridDim.x; asm volatile("" : "+s"(t)); return t; }
enum { I_X = 0, I_C, I_CTX, I_CCTX, I_ADAW, I_ADAB, I_N1W, I_N2W, I_WIN, I_QNW, I_KNW, I_CONVW, I_ALOG, I_DTB, I_DNW, I_WOUT, I_WQ, I_SUBK, I_U, I_V };

__device__ __forceinline__ void convert_tables(const float* U, const float* V, unsigned char* ws, int l, int wvi, int nwv, int lane, int rw_end = 2 * NEXP) {
    const float* us = U + (size_t)l * NEXP * 1024; const float* vs = V + (size_t)l * NEXP * 1024;
    const int set = l & 1;
    float* scl = (float*)(ws + WS_USC) + set * 2 * NEXP;
    for (int rw = wvi; rw < rw_end; rw += nwv) {
        const bool isu = rw < NEXP; const int e = isu ? rw : rw - NEXP;
        const f32x4* sp = (const f32x4*)((isu ? us : vs) + (size_t)e * 1024 + 16 * lane);
        f32x4 x[4]; float mx = 0.f;
#pragma unroll
        for (int i = 0; i < 4; ++i) { x[i] = sp[i]; mx = fmaxf(mx, fmaxf(fmaxf(fabsf(x[i][0]), fabsf(x[i][1])), fmaxf(fabsf(x[i][2]), fabsf(x[i][3])))); }
        mx = wave_max(mx);
        const float sc = fmaxf(mx, 1e-30f) * (1.f / 127.f), inv = 1.f / sc;
        u32x4 o4;
#pragma unroll
        for (int i = 0; i < 4; ++i) { const unsigned b0 = (unsigned)(int)(rintf(x[i][0] * inv) + 128.f), b1 = (unsigned)(int)(rintf(x[i][1] * inv) + 128.f), b2 = (unsigned)(int)(rintf(x[i][2] * inv) + 128.f), b3 = (unsigned)(int)(rintf(x[i][3] * inv) + 128.f);
            o4[i] = b0 | (b1 << 8) | (b2 << 16) | (b3 << 24); }
        *(u32x4*)(ws + WS_UB + (size_t)set * TAB_SET + (size_t)e * 2048 + (isu ? 0 : 1024) + 16 * lane) = o4;
        if (lane == 0) scl[rw] = sc;
    }
}

__device__ __forceinline__ void transpose_item(const float* W, int ldw, int K, bf16_t* WT, LAS float* scr, int kb, int nb, int lane) {
    const int k0 = 64 * kb, n0 = 32 * nb;
#pragma unroll 8
    for (int i = 0; i < 32; ++i) { const int kk = 2 * i + (lane >> 5); scr[kk * 33 + (lane & 31)] = W[(size_t)(k0 + kk) * ldw + n0 + (lane & 31)]; }
    LDS_WAIT(); asm volatile("" ::: "memory");
    const int c = lane & 7;
#pragma unroll
    for (int j = 0; j < 4; ++j) { const int n = (lane >> 3) + 8 * j; const LAS float* s = scr + (8 * c) * 33 + n;
        u32x4 o; o.x = pkbf(s[0 * 33], s[1 * 33]); o.y = pkbf(s[2 * 33], s[3 * 33]); o.z = pkbf(s[4 * 33], s[5 * 33]); o.w = pkbf(s[6 * 33], s[7 * 33]);
        *(u32x4*)(WT + (size_t)(n0 + n) * K + k0 + 8 * c) = o; }
    LDS_WAIT(); asm volatile("" ::: "memory");
}
__device__ __forceinline__ void phase_prologue(LAS unsigned char* lds) {
    const KArgs ap = get_args();
#define a (*ap)

    const int tid = fresh_tid(), lane = tid & 63, wave = __builtin_amdgcn_readfirstlane(tid >> 6), G = fresh_g(), bx = fresh_bx();
    unsigned char* ws = a.ws;
    {
        LAS float* sc = (LAS float*)(lds + 70000);
        LAS float* part = (LAS float*)(lds + 70000 + 12288);
        for (int i = tid; i < 3 * 1024; i += 512) { const int r = i >> 10, k = i & 1023; const float v = r < 2 ? a.in[I_C][r * 1024 + k] : a.in[I_CCTX][k]; sc[i] = silu_f(v); }
        __syncthreads();
        float* mod = (float*)(ws + WS_MOD);
        for (int item = bx; item < DEPTH * 96; item += G) {
            const int l = item / 96, j0 = (item % 96) * 64;
            const float* wp = a.in[I_ADAW] + (size_t)l * 1024 * 6144 + (size_t)(wave * 128) * 6144 + j0 + lane;
            float a0 = 0.f, a1 = 0.f, a2 = 0.f;
#pragma unroll 8
            for (int kk = 0; kk < 128; ++kk) { const float w = wp[(size_t)kk * 6144]; const int k = wave * 128 + kk; a0 = fmaf(sc[k], w, a0); a1 = fmaf(sc[1024 + k], w, a1); a2 = fmaf(sc[2048 + k], w, a2); }
            part[(wave * 3 + 0) * 64 + lane] = a0; part[(wave * 3 + 1) * 64 + lane] = a1; part[(wave * 3 + 2) * 64 + lane] = a2;
            __syncthreads();
            if (tid < 192) { const int r = tid >> 6, jj = tid & 63; float s = a.in[I_ADAB][l * 6144 + j0 + jj];
#pragma unroll
                for (int w = 0; w < 8; ++w) s += part[(w * 3 + r) * 64 + jj];
                mod[(size_t)(l * 3 + r) * 6144 + j0 + jj] = s; }
            __syncthreads();
        }
    }
    {
        const int gw = bx * 8 + wave, NGW = G * 8;
        unsigned* wmaxw = (unsigned*)(ws + WS_CTL) + CW_WMAX;
        constexpr int NB_IN = NP / 64, NB_OUT = 1024 / 64, NB_Q = 2048 / 64, PER_L2 = (NB_IN + NB_OUT + NB_Q) * 8;
        for (int it = gw; it < DEPTH * PER_L2; it += NGW) { const int l = it / PER_L2; int r = it % PER_L2; const int kc = r & 7; r >>= 3;
            const int mi = r < NB_IN ? 0 : r < NB_IN + NB_OUT ? 1 : 2; const int nb = mi == 0 ? r : mi == 1 ? r - NB_IN : r - NB_IN - NB_OUT; const int ldw = mi == 0 ? NIN : mi == 1 ? 1024 : 2048;
            const float* wp = (mi == 0 ? a.in[I_WIN] + (size_t)l * 1024 * NIN : mi == 1 ? a.in[I_WOUT] + (size_t)l * 1024 * 1024 : a.in[I_WQ] + (size_t)l * 1024 * 2048) + (size_t)(kc * 128) * ldw + nb * 64 + lane;
            float mx = 0.f;
#pragma unroll 8
            for (int kk = 0; kk < 128; ++kk) mx = fmaxf(mx, fabsf(wp[(size_t)kk * ldw]));
            atomicMax(wmaxw + (l * 3 + mi) * 3072 + nb * 64 + lane, __float_as_uint(mx)); }
    }
    const size_t gt = (size_t)bx * 512 + tid, NT = (size_t)G * 512;
    for (size_t i = gt; i < (size_t)DEPTH * 16 * 1024; i += NT) { const int l = (int)(i >> 14), j = (int)((i >> 10) & 15), k = (int)(i & 1023);
        ((float*)(ws + WS_WSK))[i] = a.in[I_WIN][(size_t)l * 1024 * NIN + (size_t)k * NIN + NP + j]; }
    convert_tables(a.in[I_U], a.in[I_V], ws, 0, bx * 8 + wave, G * 8, lane);
    for (size_t i = gt; i < (size_t)DEPTH * 8 * 2 * 128 * 128 / 2; i += NT) { const f32x2 x = ((const f32x2*)a.in[I_SUBK])[i]; ((unsigned*)(ws + WS_SKB))[i] = pkbf(x[0], x[1]); }
    for (size_t i = gt; i < 8192; i += NT) { const int pos = (int)(i >> 5), fi = (int)(i & 31);
        const float inv = exp2f(-(float)fi * (13.287712379549449f / 32.f)); const float ang = (float)pos * inv;
        float rev = ang * 0.15915494309189535f; rev -= floorf(rev);
        ((float*)(ws + WS_ROPE))[i] = __builtin_amdgcn_cosf(rev); ((float*)(ws + WS_ROPE))[8192 + i] = __builtin_amdgcn_sinf(rev); }
}


__device__ __forceinline__ void quant_transpose_item(const float* W, int ldw, signed char* WT, const unsigned* wmaxw, LAS float* scr, int kb, int nb, int lane) {
    const int k0 = 64 * kb, n0 = 32 * nb;
#pragma unroll 8
    for (int i = 0; i < 32; ++i) { const int kk = 2 * i + (lane >> 5); scr[kk * 33 + (lane & 31)] = W[(size_t)(k0 + kk) * ldw + n0 + (lane & 31)]; }
    LDS_WAIT(); asm volatile("" ::: "memory");
    const int n = lane >> 1, hf = lane & 1;
    const float mx = __uint_as_float(wmaxw[n0 + n]), inv = mx > 0.f ? 127.f / mx : 0.f;
    u32x4 o[2];
#pragma unroll
    for (int q = 0; q < 8; ++q) { unsigned w = 0u;
#pragma unroll
        for (int b = 0; b < 4; ++b) { const int kk = 32 * hf + 4 * q + b; w |= ((unsigned)(int)rintf(scr[kk * 33 + n] * inv) & 255u) << (8 * b); }
        o[q >> 2][q & 3] = w; }
    u32x4* dst = (u32x4*)(WT + (size_t)(n0 + n) * 1024 + k0 + 32 * hf);
    dst[0] = o[0]; dst[1] = o[1];
    LDS_WAIT(); asm volatile("" ::: "memory");
}
__device__ __forceinline__ void phase_quant_weights(LAS unsigned char* lds) {
    const KArgs ap = get_args();
#define a (*ap)
    const int tid = fresh_tid(), lane = tid & 63, wave = __builtin_amdgcn_readfirstlane(tid >> 6), G = fresh_g(), bx = fresh_bx();
    unsigned char* ws = a.ws;
    LAS float* scr = (LAS float*)(lds + 65536 + wave * 8448);
    const unsigned* wmaxw = (const unsigned*)(ws + WS_CTL) + CW_WMAX;
    constexpr int I_IN = 16 * 96, I_OUT = 16 * 32, I_Q = 16 * 64, PER_L = I_IN + I_OUT + I_Q;
    for (int it = bx * 8 + wave; it < DEPTH * PER_L; it += G * 8) { const int l = it / PER_L; int r = it % PER_L;
        if (r < I_IN) quant_transpose_item(a.in[I_WIN] + (size_t)l * 1024 * NIN, NIN, (signed char*)(ws + WS_WINT) + (size_t)l * NP * 1024, wmaxw + (l * 3 + 0) * 3072, scr, r / 96, r % 96, lane);
        else if (r < I_IN + I_OUT) { r -= I_IN; quant_transpose_item(a.in[I_WOUT] + (size_t)l * 1024 * 1024, 1024, (signed char*)(ws + WS_WOUTT) + (size_t)l * 1024 * 1024, wmaxw + (l * 3 + 1) * 3072, scr, r / 32, r % 32, lane); }
        else { r -= I_IN + I_OUT; quant_transpose_item(a.in[I_WQ] + (size_t)l * 1024 * 2048, 2048, (signed char*)(ws + WS_WQT) + (size_t)l * 2048 * 1024, wmaxw + (l * 3 + 2) * 3072, scr, r / 64, r % 64, lane); } }
#undef a
}

template <bool SK>
__device__ __forceinline__ void phase_norm(int l, int which, LAS unsigned char* lds) {
    const KArgs ap = get_args();
#define a (*ap)

    const int tid = fresh_tid(), lane = tid & 63, wave = __builtin_amdgcn_readfirstlane(tid >> 6), G = fresh_g(), bx = fresh_bx();
    unsigned char* ws = a.ws;
    LAS float* wsk = (LAS float*)lds;
    if (SK) { const float* src = (const float*)(ws + WS_WSK) + (size_t)l * 16384; for (int i = tid; i < 16384 / 4; i += 512) ((LAS f32x4*)wsk)[i] = ((const f32x4*)src)[i]; __syncthreads(); }
    const int nrows = (which == 1 && l == DEPTH - 1) ? ML : M;
    const float* nw = a.in[which ? I_N2W : I_N1W] + l * 1024;
    const float* modl = (const float*)(ws + WS_MOD) + (size_t)l * 3 * 6144;
    const int shoff = which ? 3072 : 0, scoff = which ? 4096 : 1024;
    f32x4 nwv[4];
#pragma unroll
    for (int j = 0; j < 4; ++j) nwv[j] = *(const f32x4*)(nw + 4 * lane + 256 * j);
    for (int row = wave * G + bx; row < nrows; row += G * 8) {
        const float* src; int mrow;
        if (row < ML) { src = ((l == 0 && which == 0) ? a.in[I_X] : a.out) + (size_t)row * D; mrow = row >= T ? 1 : 0; }
        else { src = ((l == 0 && which == 0) ? a.in[I_CTX] : (const float*)(ws + WS_CTXX)) + (size_t)(row - ML) * D; mrow = 2; }
        const float* md = modl + mrow * 6144;
        f32x4 v[4]; float ss = 0.f;
#pragma unroll
        for (int j = 0; j < 4; ++j) { v[j] = *(const f32x4*)(src + 4 * lane + 256 * j); ss += (v[j][0] * v[j][0] + v[j][1] * v[j][1]) + (v[j][2] * v[j][2] + v[j][3] * v[j][3]); }
        const float rstd = rsqrtf(wave_sum(ss) * (1.f / D) + EPS);
        signed char* hrow = (signed char*)(ws + WS_H) + (size_t)row * D;
        float hmx = 0.f;
#pragma unroll
        for (int j = 0; j < 4; ++j) { const f32x4 sc = *(const f32x4*)(md + scoff + 4 * lane + 256 * j), sh = *(const f32x4*)(md + shoff + 4 * lane + 256 * j);
            v[j] = v[j] * rstd * nwv[j] * (sc + 1.f) + sh; hmx = fmaxf(hmx, fmaxf(fmaxf(fabsf(v[j][0]), fabsf(v[j][1])), fmaxf(fabsf(v[j][2]), fabsf(v[j][3])))); }
        hmx = fmaxf(wave_max(hmx), 1e-30f);
        { const float hinv = 127.f / hmx;
#pragma unroll
          for (int j = 0; j < 4; ++j) *(unsigned*)(hrow + 4 * lane + 256 * j) = ((unsigned)(int)rintf(v[j][0] * hinv) & 255u) | (((unsigned)(int)rintf(v[j][1] * hinv) & 255u) << 8) | (((unsigned)(int)rintf(v[j][2] * hinv) & 255u) << 16) | (((unsigned)(int)rintf(v[j][3] * hinv) & 255u) << 24);
          if (lane == 0) ((float*)(ws + WS_GB))[row] = hmx * (1.f / 127.f); }
        if (SK) {
            float p[16];
#pragma unroll
            for (int c = 0; c < 16; ++c) { float q = 0.f;
#pragma unroll
                for (int j = 0; j < 4; ++j) { const f32x4 w = *(const LAS f32x4*)(wsk + c * 1024 + 4 * lane + 256 * j); q += (v[j][0] * w[0] + v[j][1] * w[1]) + (v[j][2] * w[2] + v[j][3] * w[3]); }
                p[c] = q; }
            { const bool hb = (lane & 32) != 0;
#pragma unroll
              for (int c = 0; c < 8; ++c) { const float keep = hb ? p[c + 8] : p[c], send = hb ? p[c] : p[c + 8]; p[c] = keep + lane_xor<32>(send); } }
            { const bool hb = (lane & 16) != 0;
#pragma unroll
              for (int c = 0; c < 4; ++c) { const float keep = hb ? p[c + 4] : p[c], send = hb ? p[c] : p[c + 4]; p[c] = keep + lane_xor<16>(send); } }
            { const bool hb = (lane & 8) != 0;
#pragma unroll
              for (int c = 0; c < 2; ++c) { const float keep = hb ? p[c + 2] : p[c], send = hb ? p[c] : p[c + 2]; p[c] = keep + lane_xor<8>(send); } }
            { const bool hb = (lane & 4) != 0; const float keep = hb ? p[1] : p[0], send = hb ? p[0] : p[1]; p[0] = keep + lane_xor<4>(send); }
            p[0] += lane_xor<2>(p[0]); p[0] += lane_xor<1>(p[0]);
            if ((lane & 3) == 0) { const int c = ((lane >> 5) & 1) * 8 + ((lane >> 4) & 1) * 4 + ((lane >> 3) & 1) * 2 + ((lane >> 2) & 1); ((float*)(ws + WS_BA))[(size_t)row * 16 + c] = p[0]; }
        }
    }
    if (SK) __syncthreads();
}

__device__ __forceinline__ void phase_prep(int l, LAS unsigned char* lds) {
    const KArgs ap = get_args();
#define a (*ap)

    const int tid = fresh_tid(), lane = tid & 63, wave = __builtin_amdgcn_readfirstlane(tid >> 6), G = fresh_g(), bx = fresh_bx();
    unsigned char* ws = a.ws;
    const bf16_t* P = (const bf16_t*)(ws + WS_P);
    const float* ropec = (const float*)(ws + WS_ROPE); const float* ropes = ropec + 8192;
    const int sec = lane >> 5, fi = lane & 31;
    const float qw0 = a.in[I_QNW][l * 128 + sec * 64 + fi], qw1 = a.in[I_QNW][l * 128 + sec * 64 + 32 + fi];
    const float kw0 = a.in[I_KNW][l * 128 + sec * 64 + fi], kw1 = a.in[I_KNW][l * 128 + sec * 64 + 32 + fi];
    for (int row = wave * G + bx; row < M; row += G * 8) {
        const bool lat = row < ML;
        int b, tt, tlen; if (lat) { b = row >> 14; tt = row & (T - 1); tlen = T; } else { b = (row - ML) >> 8; tt = (row - ML) & (CT - 1); tlen = CT; }
        const bf16_t* prow = P + (size_t)row * NP;
        unsigned short xa[6][2];
#pragma unroll
        for (int hh = 0; hh < 6; ++hh) { const bf16_t* xp = prow + (hh < 4 ? hh * 128 : 512 + (hh - 4) * 128) + sec * 64 + fi; xa[hh][0] = xp[0]; xa[hh][1] = xp[32]; }
        const u32x2 vcp = *(const u32x2*)(prow + 768 + 4 * lane);
        float cs = 1.f, sn = 0.f;
        if (lat) { const int pos = sec ? (tt & 63) : (tt >> 6); cs = ropec[pos * 32 + fi]; sn = ropes[pos * 32 + fi]; }
        unsigned char* qo8 = ws + WS_QA + (size_t)row * 512;
        const size_t kvrow = (size_t)b * KVLEN + (lat ? tt : T + tt);
        unsigned char* ko8 = ws + WS_KA + kvrow * 256;
        float ssq[6];
#pragma unroll
        for (int hh = 0; hh < 6; ++hh) { const float x0 = bf2f(xa[hh][0]), x1 = bf2f(xa[hh][1]); ssq[hh] = x0 * x0 + x1 * x1; }
#pragma unroll
        for (int hh = 0; hh < 6; ++hh) ssq[hh] = wave_sum(ssq[hh]);
#pragma unroll
        for (int hh = 0; hh < 6; ++hh) {
            const float x0 = bf2f(xa[hh][0]), x1 = bf2f(xa[hh][1]);
            const float rs = rsqrtf(ssq[hh] * (1.f / 128.f) + EPS);
            const float y0 = x0 * rs * (hh < 4 ? qw0 : kw0), y1 = x1 * rs * (hh < 4 ? qw1 : kw1);
            const float qsc = hh < 4 ? 0.088388347648318440f * 1.4426950408889634f : 1.f;
            const float o0 = (y0 * cs - y1 * sn) * qsc, o1 = (y1 * cs + y0 * sn) * qsc;
            unsigned char* op8 = (hh < 4 ? qo8 + hh * 128 : ko8 + (hh - 4) * 128) + sec * 64 + fi;
            const float f8s = hh < 4 ? 8.f : 1.f;
            const int pk8 = __builtin_amdgcn_cvt_pk_fp8_f32(o0 * f8s, o1 * f8s, 0, false);
            op8[0] = (unsigned char)(pk8 & 255); op8[32] = (unsigned char)((pk8 >> 8) & 255);
        }
        { const int pos = lat ? tt : T + tt, tile = pos >> 6, k64 = pos & 63, k32 = k64 & 31;
          const int bytepos = 32 * ((k32 >> 2) & 1) + 16 * (k64 >> 5) + (k32 & 3) + 4 * (k32 >> 3);
          unsigned char* vt = ws + WS_VA + ((size_t)(b * 2) * (KVLEN / 64) + tile) * 8192 + bytepos;
          const unsigned short* vsrc = (const unsigned short*)&vcp;
          const int kvh_ = lane >> 5, d0 = (4 * lane) & 127;
          const int pk01 = __builtin_amdgcn_cvt_pk_fp8_f32(bf2f(vsrc[0]), bf2f(vsrc[1]), 0, false), pk23 = __builtin_amdgcn_cvt_pk_fp8_f32(bf2f(vsrc[2]), bf2f(vsrc[3]), 0, false);
          unsigned char* vt2 = vt + (size_t)kvh_ * (KVLEN / 64) * 8192 + (size_t)d0 * 64;
          vt2[0] = (unsigned char)(pk01 & 255); vt2[64] = (unsigned char)((pk01 >> 8) & 255); vt2[128] = (unsigned char)(pk23 & 255); vt2[192] = (unsigned char)((pk23 >> 8) & 255); }
    }
    __syncthreads();
}

constexpr int ATT_PARTS = 4;
__device__ __forceinline__ void phase_attn(int l, unsigned char* lds_raw, volatile LAS unsigned* MISC, int rep) {
    const KArgs ap = get_args();
#define a (*ap)
    unsigned char* ws = a.ws;
    const unsigned char* QA = ws + WS_QA; const unsigned char* KA = ws + WS_KA; const unsigned char* VT = ws + WS_VA;
    bf16_t* CAT = (bf16_t*)(ws + WS_CAT); float* LSE = (float*)(ws + WS_BA);
    unsigned* ctr = (unsigned*)(ws + WS_CTL) + 8192 + 64 * l + 1024 * rep;
    const int natt = 2048 + (l < DEPTH - 1 ? 8 : 0);
    constexpr int CONV_ROWS = 64, NCONV = 2 * NEXP / CONV_ROWS;
    const int nunits = natt + (l + 1 < DEPTH ? NCONV : 0);
    float braw;
    { const int ln = threadIdx.x & 63; float mq = fmaxf(fabsf(a.in[I_QNW][l * 128 + ln]), fabsf(a.in[I_QNW][l * 128 + 64 + ln])), mk = fmaxf(fabsf(a.in[I_KNW][l * 128 + ln]), fabsf(a.in[I_KNW][l * 128 + 64 + ln]));
      mq = wave_max(mq); mk = wave_max(mk);
      braw = __builtin_bit_cast(float, __builtin_amdgcn_readfirstlane(__builtin_bit_cast(int, 128.f * mq * mk))); }
    if (threadIdx.x == 0) MISC[12] = __hip_atomic_fetch_add(ctr, 1u, __ATOMIC_RELAXED, __HIP_MEMORY_SCOPE_AGENT);
    __syncthreads();
    int u = (int)MISC[12], par = 0;
    for (; u < nunits; ) {
        if (threadIdx.x == 0) MISC[13 - par] = __hip_atomic_fetch_add(ctr, 1u, __ATOMIC_RELAXED, __HIP_MEMORY_SCOPE_AGENT);
        if (u >= natt) {
            const int rwb = (u - natt) * CONV_ROWS + (int)(threadIdx.x >> 6) * 8;
            convert_tables(a.in[I_U], a.in[I_V], ws, l + 1, rwb, 1, (int)(threadIdx.x & 63), rwb + 8);
            __syncthreads();
            u = (int)MISC[13 - par]; par ^= 1;
            continue;
        }
        size_t r0, kv0; int h, kvh, seq, ldo; bf16_t* ob; float* lse;
        if (u < 2048) { const int qb = u & 63, g = (u >> 6) & 1, part = (u >> 7) & 3, b = u >> 10; kvh = (u >> 9) & 1; h = kvh * 2 + g;
            const int t0 = (part >> 1) * 130 + (part & 1) * 64;
            r0 = (size_t)b * T + (size_t)qb * 256; kv0 = (size_t)b * KVLEN + (size_t)t0 * 64; seq = ((part & 1) ? 66 : 64) * 64;
            ob = part ? (bf16_t*)(ws + (part == 1 ? WS_DQ : part == 2 ? WS_DK : WS_DV)) + r0 * 512 + h * 128 : CAT + r0 * 1024 + h * 128; ldo = part ? 512 : 1024; lse = LSE + ((size_t)part * ML + r0) * 4 + h; }
        else { const int b = (u - 2048) >> 2; h = (u - 2048) & 3; kvh = h >> 1; r0 = (size_t)ML + (size_t)b * CT; kv0 = (size_t)b * KVLEN + T; seq = CT;
            ob = CAT + r0 * 1024 + h * 128; ldo = 1024; lse = nullptr; }
        att::attn_dense_body(QA + r0 * 512 + h * 128, KA + kv0 * 256 + kvh * 128, VT + ((size_t)((kv0 / KVLEN) * 2 + kvh) * (KVLEN / 64) + (kv0 % KVLEN) / 64) * 8192, ob, ldo, seq, (char*)lds_raw, lse, braw);
        u = (int)MISC[13 - par]; par ^= 1;
    }
#undef a
}

__device__ __forceinline__ int tokperm(int q, int hh, int jj) { return 16 * q + 8 * (jj >> 2) + 4 * hh + (jj & 3); }
__device__ __forceinline__ int crow16(int r, int hi) { return (r & 3) + 8 * (r >> 2) + 4 * hi; }
__device__ __forceinline__ int kperm16(int s_, int g, int jj) { return 32 * s_ + 16 * (jj >> 2) + 4 * g + (jj & 3); }
__device__ __forceinline__ int frag_off(int i, int j) {
    return (((i >> 4) * 2 + (j >> 5)) * 64 + ((i & 15) + 16 * ((j >> 2) & 3))) * 16 + (4 * ((j >> 4) & 1) + (j & 3)) * 2;
}
template <int MODE>
__device__ __forceinline__ void phase_dn_chunkprep(int l, LAS unsigned char* lds) {
    const KArgs ap = get_args();
#define a (*ap)
    const int tid = fresh_tid(), lane = tid & 63, wave = __builtin_amdgcn_readfirstlane(tid >> 6), G = fresh_g(), bx = fresh_bx();
    unsigned char* ws = a.ws;
    constexpr int KT_OFF = 0, QT_OFF = 17408, VT_OFF = 34816, GS_OFF = 52224, RS_OFF = 68864, AM_OFF = 85504, SC_OFF = 120320, IMG_OFF = 0;
    const int r = lane & 31, hh = lane >> 5;
    const bf16_t* DQ = (const bf16_t*)(ws + WS_DQ); const bf16_t* DK = (const bf16_t*)(ws + WS_DK); const bf16_t* DV = (const bf16_t*)(ws + WS_DV);
    const float* BA = (const float*)(ws + WS_BA);
    constexpr int NTASK = MODE ? NB * 4 * 4 : NB * 4 * (NCH - 4);
#define CP_TASKID(t_) (MODE ? ((t_) >> 2) * NCH + ((t_) & 3) : ((t_) >> 8) * NCH + 4 + ((t_) & 255))
    LAS float* gsc = (LAS float*)(lds + SC_OFF);
    LAS float* bsc = gsc + 128;
    LAS float* gcs = gsc + 256;
    constexpr int CW_OFF = 121856;
    LAS float* cwl = (LAS float*)(lds + CW_OFF);
    for (int i = tid; i < 5 * 1536; i += 512) cwl[i] = a.in[I_CONVW][(size_t)l * 5 * 1536 + i];
    __syncthreads();
    const bf16_t* P = (const bf16_t*)(ws + WS_P);
    u32x4 xin[3][5][2];
#define CP_LOADX(task_) do { const int cidx_ = (task_) % NCH, bh_ = (task_) / NCH, b_ = bh_ >> 2, h_ = bh_ & 3; \
        const int row0_ = cidx_ < 4 ? ML + b_ * CT + cidx_ * 64 : b_ * T + (cidx_ - 4) * 64, tt_ = (cidx_ < 4 ? cidx_ * 64 : (cidx_ - 4) * 64) + (tid >> 3), tlen_ = cidx_ < 4 ? CT : T; \
        _Pragma("unroll") for (int j = 0; j < 5; ++j) { const int t2 = tt_ + j - 2; const bool ok = t2 >= 0 && t2 < tlen_; \
            const bf16_t* xr = P + (size_t)(row0_ + (tid >> 3) + (ok ? j - 2 : 0)) * NP + 1024 + h_ * 128 + (tid & 7) * 16; \
            _Pragma("unroll") for (int m = 0; m < 3; ++m) { const u32x4 w0 = *(const u32x4*)(xr + m * 512), w1 = *(const u32x4*)(xr + m * 512 + 8); \
                xin[m][j][0] = ok ? w0 : (u32x4){0u, 0u, 0u, 0u}; xin[m][j][1] = ok ? w1 : (u32x4){0u, 0u, 0u, 0u}; } } } while (0)
    if (bx < NTASK) CP_LOADX(CP_TASKID(bx));
    for (int tk = bx; tk < NTASK; tk += G) {
        const int task = CP_TASKID(tk);
        const int cidx = task % NCH, bh = task / NCH, b = bh >> 2, h = bh & 3;
        const int row0 = cidx < 4 ? ML + b * CT + cidx * 64 : b * T + (cidx - 4) * 64;
        unsigned char* rec = ws + WS_REC + (size_t)task * REC_BYTES;
        {
            const int rr = tid >> 3, seg = tid & 7;
            if (tid < 128) { const int d = tid >> 6, i = tid & 63, dh = d * 4 + h;
                const float xb = BA[(size_t)(row0 + i) * 16 + dh], z = BA[(size_t)(row0 + i) * 16 + 8 + dh] + a.in[I_DTB][l * 8 + dh];
                bsc[tid] = 1.f / (1.f + __expf(-xb)); gsc[tid] = -__expf(a.in[I_ALOG][l * 8 + dh]) * (fmaxf(z, 0.f) + log1pf(__expf(-fabsf(z)))); }
#pragma unroll
            for (int m = 0; m < 3; ++m) {
                float y[16];
#pragma unroll
                for (int c = 0; c < 16; ++c) y[c] = 0.f;
#pragma unroll
                for (int j = 0; j < 5; ++j) { const LAS float* wp = cwl + j * 1536 + m * 512 + h * 128 + seg * 16;
#pragma unroll
                    for (int q4 = 0; q4 < 4; ++q4) { const f32x4 wv = *(const LAS f32x4*)(wp + 4 * q4); const unsigned u0 = xin[m][j][q4 >> 1][2 * (q4 & 1)], u1 = xin[m][j][q4 >> 1][2 * (q4 & 1) + 1];
                        y[4 * q4 + 0] = fmaf(bflo(u0), wv[0], y[4 * q4 + 0]); y[4 * q4 + 1] = fmaf(bfhi(u0), wv[1], y[4 * q4 + 1]); y[4 * q4 + 2] = fmaf(bflo(u1), wv[2], y[4 * q4 + 2]); y[4 * q4 + 3] = fmaf(bfhi(u1), wv[3], y[4 * q4 + 3]); } }
                float ss = 0.f;
#pragma unroll
                for (int c = 0; c < 16; ++c) { y[c] = silu_f(y[c]); ss = fmaf(y[c], y[c], ss); }
                if (m < 2) { ss += lane_xor<1>(ss); ss += lane_xor<2>(ss); ss += lane_xor<4>(ss);
                    float sc = rsqrtf(ss + EPS); if (m == 0) sc *= 0.088388347648318440f;
#pragma unroll
                    for (int c = 0; c < 16; ++c) y[c] *= sc; }
                u32x4 o0, o1; o0.x = pkbf(y[0], y[1]); o0.y = pkbf(y[2], y[3]); o0.z = pkbf(y[4], y[5]); o0.w = pkbf(y[6], y[7]); o1.x = pkbf(y[8], y[9]); o1.y = pkbf(y[10], y[11]); o1.z = pkbf(y[12], y[13]); o1.w = pkbf(y[14], y[15]);
                LAS unsigned char* dst = lds + (m == 0 ? QT_OFF : m == 1 ? KT_OFF : VT_OFF) + rr * 272 + seg * 32;
                *(LAS u32x4*)dst = o0; *(LAS u32x4*)(dst + 16) = o1;
            }
        }
        __syncthreads();
        {
            const int mat = wave >> 2, ti = (wave >> 1) & 1, tj = wave & 1;
            f32x16 acc = {};
#pragma unroll
            for (int ks = 0; ks < 8; ++ks) {
                const bf16x8 av = *(const LAS bf16x8*)(lds + (mat ? QT_OFF : KT_OFF) + (32 * ti + r) * 272 + (16 * ks + 8 * hh) * 2);
                const bf16x8 bv = *(const LAS bf16x8*)(lds + KT_OFF + (32 * tj + r) * 272 + (16 * ks + 8 * hh) * 2);
                acc = __builtin_amdgcn_mfma_f32_32x32x16_bf16(av, bv, acc, 0, 0, 0);
            }
            LAS float* dst = (LAS float*)(lds + (mat ? RS_OFF : GS_OFF));
#pragma unroll
            for (int i = 0; i < 16; ++i) dst[(32 * ti + crow16(i, hh)) * 65 + 32 * tj + r] = acc[i];
        }
        { const int r16 = lane & 15, g4 = lane >> 4;
#pragma unroll
        for (int t = 0; t < 2; ++t) { const int f = wave * 2 + t, mt = f >> 2, sk = f & 3;
            { const u32x2 lo = *(const LAS u32x2*)(lds + KT_OFF + (16 * mt + r16) * 272 + (32 * sk + 4 * g4) * 2), hi2 = *(const LAS u32x2*)(lds + KT_OFF + (16 * mt + r16) * 272 + (32 * sk + 16 + 4 * g4) * 2);
              *(u32x4*)(rec + REC_K + f * 1024 + lane * 16) = (u32x4){lo.x, lo.y, hi2.x, hi2.y}; }
            { const u32x2 lo = *(const LAS u32x2*)(lds + QT_OFF + (16 * mt + r16) * 272 + (32 * sk + 4 * g4) * 2), hi2 = *(const LAS u32x2*)(lds + QT_OFF + (16 * mt + r16) * 272 + (32 * sk + 16 + 4 * g4) * 2);
              *(u32x4*)(rec + REC_Q + f * 1024 + lane * 16) = (u32x4){lo.x, lo.y, hi2.x, hi2.y}; } }
#pragma unroll
        for (int t = 0; t < 2; ++t) { const int f = wave * 2 + t, mt = f >> 1, sk = f & 1;
            unsigned e[8];
#pragma unroll
            for (int jj = 0; jj < 8; ++jj) e[jj] = *(const LAS unsigned short*)(lds + KT_OFF + kperm16(sk, g4, jj) * 272 + (16 * mt + r16) * 2);
            *(u32x4*)(rec + REC_KT + f * 1024 + lane * 16) = (u32x4){e[0] | (e[1] << 16), e[2] | (e[3] << 16), e[4] | (e[5] << 16), e[6] | (e[7] << 16)}; }
        { const int sl = wave;
            unsigned e[16];
#pragma unroll
            for (int i = 0; i < 16; ++i) e[i] = *(const LAS unsigned short*)(lds + VT_OFF + (16 * (i >> 2) + 4 * g4 + (i & 3)) * 272 + (16 * sl + r16) * 2);
            u32x4* vp = (u32x4*)(rec + REC_V + sl * 2048 + lane * 32);
            vp[0] = (u32x4){e[0] | (e[1] << 16), e[2] | (e[3] << 16), e[4] | (e[5] << 16), e[6] | (e[7] << 16)};
            vp[1] = (u32x4){e[8] | (e[9] << 16), e[10] | (e[11] << 16), e[12] | (e[13] << 16), e[14] | (e[15] << 16)}; }
        }
        if (tk + G < NTASK) CP_LOADX(CP_TASKID(tk + G));
        if (wave < 2) { const int d = wave; float gv = gsc[d * 64 + (d ? 63 - lane : lane)];
            gv += __builtin_bit_cast(float, __builtin_amdgcn_update_dpp(0, __builtin_bit_cast(int, gv), 0x111, 0xF, 0xF, true));
            gv += __builtin_bit_cast(float, __builtin_amdgcn_update_dpp(0, __builtin_bit_cast(int, gv), 0x112, 0xF, 0xF, true));
            gv += __builtin_bit_cast(float, __builtin_amdgcn_update_dpp(0, __builtin_bit_cast(int, gv), 0x114, 0xF, 0xF, true));
            gv += __builtin_bit_cast(float, __builtin_amdgcn_update_dpp(0, __builtin_bit_cast(int, gv), 0x118, 0xF, 0xF, true));
            { const float t0 = __builtin_bit_cast(float, __builtin_amdgcn_readlane(__builtin_bit_cast(int, gv), 15)), t1 = __builtin_bit_cast(float, __builtin_amdgcn_readlane(__builtin_bit_cast(int, gv), 31)), t2 = __builtin_bit_cast(float, __builtin_amdgcn_readlane(__builtin_bit_cast(int, gv), 47));
              const int rw_ = lane >> 4; gv += (rw_ >= 1 ? t0 : 0.f) + (rw_ >= 2 ? t1 : 0.f) + (rw_ >= 3 ? t2 : 0.f); }
            gcs[d * 64 + lane] = gv; }
        __syncthreads();
        const LAS float* Gs = (const LAS float*)(lds + GS_OFF); const LAS float* Rs = (const LAS float*)(lds + RS_OFF);
#pragma unroll 4
        for (int t = 0; t < 16; ++t) { const int e = tid + 512 * t, d = e >> 12, jp = (e >> 6) & 63, ip = e & 63;
            const int in_ = d ? 63 - ip : ip, jn = d ? 63 - jp : jp;
            const float dec = __expf(fminf(gcs[d * 64 + ip] - gcs[d * 64 + jp], 0.f));
            const float av = (jp < ip) ? bsc[d * 64 + in_] * Gs[in_ * 65 + jn] * dec : 0.f;
            ((LAS float*)(lds + AM_OFF))[d * 4352 + jp * 68 + ip] = av;
            const float qk = (jp <= ip) ? Rs[in_ * 65 + jn] * dec : 0.f;
            *(LAS unsigned short*)(lds + IMG_OFF + d * 16384 + 8192 + frag_off(in_, jn)) = (unsigned short)(pkbf(qk, 0.f) & 0xffffu); }
        __syncthreads();
        if (wave < 2) { const int d = wave, c = lane, jn = d ? 63 - c : c; const float bj = bsc[d * 64 + jn];
            const LAS float* At = (const LAS float*)(lds + AM_OFF) + d * 4352;
            LAS float* Xm = (LAS float*)(lds + GS_OFF) + d * 4096 + c;
            const int fj = (jn >> 5) * 1024 + ((jn >> 2) & 3) * 256 + ((jn >> 4) & 1) * 8 + (jn & 3) * 2;
#pragma unroll 1
            for (int B = 0; B < 4; ++B) {
                float acc[16];
#pragma unroll
                for (int q = 0; q < 16; ++q) acc[q] = (16 * B + q == c) ? 1.f : 0.f;
#pragma unroll 4
                for (int j = 0; j < 16 * B; ++j) { const float xj = Xm[j * 64];
                    const f32x4 a0 = *(const LAS f32x4*)(At + j * 68 + 16 * B), a1 = *(const LAS f32x4*)(At + j * 68 + 16 * B + 4), a2 = *(const LAS f32x4*)(At + j * 68 + 16 * B + 8), a3 = *(const LAS f32x4*)(At + j * 68 + 16 * B + 12);
#pragma unroll
                    for (int q = 0; q < 4; ++q) { acc[q] = fmaf(-a0[q], xj, acc[q]); acc[4 + q] = fmaf(-a1[q], xj, acc[4 + q]); acc[8 + q] = fmaf(-a2[q], xj, acc[8 + q]); acc[12 + q] = fmaf(-a3[q], xj, acc[12 + q]); } }
#pragma unroll
                for (int r2 = 0; r2 < 15; ++r2) { const LAS float* ar = At + (16 * B + r2) * 68 + 16 * B; const float xr = acc[r2];
#pragma unroll
                    for (int q4 = (r2 + 1) / 4; q4 < 4; ++q4) { const f32x4 a4 = *(const LAS f32x4*)(ar + 4 * q4);
#pragma unroll
                        for (int q = 0; q < 4; ++q) if (4 * q4 + q > r2) acc[4 * q4 + q] = fmaf(-a4[q], xr, acc[4 * q4 + q]); } }
#pragma unroll
                for (int q = 0; q < 16; ++q) { const int i = 16 * B + q, in_ = d ? 63 - i : i; Xm[i * 64] = acc[q];
                    *(LAS unsigned short*)(lds + IMG_OFF + d * 16384 + (in_ >> 4) * 2048 + (in_ & 15) * 16 + fj) = (unsigned short)(pkbf(acc[q] * bj, 0.f) & 0xffffu); }
            }
        } else if (wave < 4) { const int d = wave - 2, ip = d ? 63 - lane : lane; const float gl = gcs[d * 64 + 63], gi = gcs[d * 64 + ip];
            float* sc = (float*)(rec + REC_DIR + d * REC_DIRSZ + 16384);
            sc[lane] = __expf(gi); sc[64 + lane] = __expf(gl - gi); if (lane == 0) sc[128] = __expf(gl); }
        __syncthreads();
#pragma unroll
        for (int t = 0; t < 4; ++t) { const int p = tid + 512 * t, d = p >> 10, off = (p & 1023) * 16;
            *(u32x4*)(rec + REC_DIR + d * REC_DIRSZ + off) = *(const LAS u32x4*)(lds + IMG_OFF + d * 16384 + off); }
        __syncthreads();
    }
#undef CP_LOADX
#undef CP_TASKID
#undef a
}

__device__ __forceinline__ bf16x8 pack44(const f32x4& lo, const f32x4& hi) {
    u32x4 p; p.x = pkbf_c(lo[0], lo[1]); p.y = pkbf_c(lo[2], lo[3]); p.z = pkbf_c(hi[0], hi[1]); p.w = pkbf_c(hi[2], hi[3]);
    return __builtin_bit_cast(bf16x8, p);
}
template <int VAR>
__device__ __forceinline__ void phase_dn_scan(int l, LAS unsigned char* lds) {
    const KArgs ap = get_args();
#define a (*ap)
    const int tid = fresh_tid(), lane = tid & 63, wave = __builtin_amdgcn_readfirstlane(tid >> 6), bx = fresh_bx();
    unsigned char* ws = a.ws;
    if (bx >= 32) return;
    const int chain = bx >> 1, half = bx & 1, b = chain >> 3, h = (chain >> 1) & 3, dir = chain & 1;
    const unsigned char* recb = ws + WS_REC + (size_t)((b * 4 + h) * NCH) * REC_BYTES;
    constexpr int BUFSZ = 74752;
#define CIDX(n) (dir ? ((n) < 4 ? 3 - (n) : 263 - (n)) : (n))
    if (wave >= 4) {
        const int sw = wave - 4;
#define DN_PIECE(i_) ((sw + 4 * (i_)) < 73 ? (sw + 4 * (i_)) : 72)
#define DN_SRC(rec_, p_) ((p_) < 48 ? (rec_) + (p_) * 1024 : (p_) < 65 ? (rec_) + REC_DIR + dir * REC_DIRSZ + ((p_) - 48) * 1024 : (rec_) + REC_V + half * 8192 + ((p_) - 65) * 1024)
#define DN_STAGE(n, bi) do { const unsigned char* rec_ = recb + (size_t)CIDX(n) * REC_BYTES; _Pragma("unroll") for (int i_ = 0; i_ < 19; ++i_) { const int p_ = DN_PIECE(i_); \
        __builtin_amdgcn_global_load_lds((const unsigned*)(DN_SRC(rec_, p_) + lane * 16), (LAS unsigned*)(lds + (bi) * BUFSZ + p_ * 1024), 16, 0, 0); } } while (0)
#define DN_SYNC() do { asm volatile("s_waitcnt vmcnt(0)" ::: "memory"); __builtin_amdgcn_s_barrier(); asm volatile("" ::: "memory"); } while (0)
        if (VAR != 3) DN_STAGE(0, 0);
        DN_SYNC();
        for (int n = 0; n < NCH; ++n) {
            if (VAR != 3 && n + 1 < NCH) DN_STAGE(n + 1, (n + 1) & 1);
            DN_SYNC();
        }
#undef DN_STAGE
#undef DN_PIECE
#undef DN_SRC
#undef DN_SYNC
    } else {
        const int sl = half * 4 + wave, c16 = lane & 15, g4 = lane >> 4;
        float* Og = (float*)(ws + (dir ? WS_OB : WS_OF)) + h * 128 + sl * 16 + c16;
        f32x4 S[8];
#pragma unroll
        for (int i = 0; i < 8; ++i) S[i] = (f32x4){0.f, 0.f, 0.f, 0.f};
        asm volatile("s_waitcnt lgkmcnt(0)" ::: "memory"); __builtin_amdgcn_s_barrier(); asm volatile("" ::: "memory");
        for (int n = 0; n < NCH; ++n) {
            if (VAR == 2) { asm volatile("s_waitcnt lgkmcnt(0)" ::: "memory"); __builtin_amdgcn_s_barrier(); asm volatile("" ::: "memory"); continue; }
            const LAS unsigned char* buf = lds + (n & 1) * BUFSZ;
            const int cidx = CIDX(n);
            const u32x4 vc0 = *(const LAS u32x4*)(buf + 66560 + wave * 2048 + lane * 32), vc1 = *(const LAS u32x4*)(buf + 66560 + wave * 2048 + lane * 32 + 16);
#define FR(off, f) (*(const LAS bf16x8*)(buf + (off) + (f) * 1024 + lane * 16))
#define MF(A, B, C) __builtin_amdgcn_mfma_f32_16x16x32_bf16((A), (B), (C), 0, 0, 0)
#define SB_() __builtin_amdgcn_sched_barrier(0)
            bf16x8 fa[8], fb[8];
            f32x4 eg[4], dl[4];
#pragma unroll
            for (int mt = 0; mt < 4; ++mt) { eg[mt] = *(const LAS f32x4*)(buf + 65536 + (16 * mt + 4 * g4) * 4); dl[mt] = *(const LAS f32x4*)(buf + 65536 + 256 + (16 * mt + 4 * g4) * 4); }
            const float egl = *(const LAS float*)(buf + 65536 + 512);
#define RD_KQ(dst, q) do { _Pragma("unroll") for (int mt = 0; mt < 4; ++mt) { dst[mt] = FR(0, mt * 4 + (q)); dst[4 + mt] = FR(32768, mt * 4 + (q)); } } while (0)
#define MM_KQ(src, q) do { _Pragma("unroll") for (int mt = 0; mt < 4; ++mt) { X[mt] = MF(src[mt], Sb[q], X[mt]); O[mt] = MF(src[4 + mt], Sb[q], O[mt]); } } while (0)
            f32x4 X[4], O[4], VN[4];
#pragma unroll
            for (int i = 0; i < 4; ++i) { X[i] = (f32x4){0.f, 0.f, 0.f, 0.f}; O[i] = (f32x4){0.f, 0.f, 0.f, 0.f}; VN[i] = (f32x4){0.f, 0.f, 0.f, 0.f}; }
            bf16x8 Sb[4];
#pragma unroll
            for (int q = 0; q < 4; ++q) Sb[q] = pack44(S[2 * q], S[2 * q + 1]);
            RD_KQ(fa, 0); SB_();
            RD_KQ(fb, 1); SB_(); MM_KQ(fa, 0); SB_();
            RD_KQ(fa, 2); SB_(); MM_KQ(fb, 1); SB_();
            RD_KQ(fb, 3); SB_(); MM_KQ(fa, 2); SB_();
#pragma unroll
            for (int i = 0; i < 8; ++i) fa[i] = FR(49152, i);
            SB_(); MM_KQ(fb, 3); SB_();
#pragma unroll
            for (int mt = 0; mt < 4; ++mt) { const unsigned w0 = (mt < 2 ? vc0 : vc1)[2 * (mt & 1)], w1 = (mt < 2 ? vc0 : vc1)[2 * (mt & 1) + 1];
                X[mt][0] = bflo(w0) - eg[mt][0] * X[mt][0]; X[mt][1] = bfhi(w0) - eg[mt][1] * X[mt][1]; X[mt][2] = bflo(w1) - eg[mt][2] * X[mt][2]; X[mt][3] = bfhi(w1) - eg[mt][3] * X[mt][3]; }
            const bf16x8 Yb0 = pack44(X[0], X[1]), Yb1 = pack44(X[2], X[3]);
            SB_();
#pragma unroll
            for (int i = 0; i < 8; ++i) fb[i] = FR(57344, i);
            SB_();
#pragma unroll
            for (int mt = 0; mt < 4; ++mt) { VN[mt] = MF(fa[mt * 2], Yb0, VN[mt]); VN[mt] = MF(fa[mt * 2 + 1], Yb1, VN[mt]); }
            SB_();
#pragma unroll
            for (int mt = 0; mt < 4; ++mt) O[mt] = O[mt] * eg[mt];
            const bf16x8 Vb0 = pack44(VN[0], VN[1]), Vb1 = pack44(VN[2], VN[3]);
            SB_();
#pragma unroll
            for (int i = 0; i < 8; ++i) fa[i] = FR(16384, i);
            SB_();
#pragma unroll
            for (int mt = 0; mt < 4; ++mt) { O[mt] = MF(fb[mt * 2], Vb0, O[mt]); O[mt] = MF(fb[mt * 2 + 1], Vb1, O[mt]); }
            SB_();
#pragma unroll
            for (int mt = 0; mt < 4; ++mt) VN[mt] = VN[mt] * dl[mt];
            const bf16x8 Vd0 = pack44(VN[0], VN[1]), Vd1 = pack44(VN[2], VN[3]);
#pragma unroll
            for (int i = 0; i < 8; ++i) S[i] = S[i] * egl;
            SB_();
#pragma unroll
            for (int i = 0; i < 8; ++i) fb[i] = FR(16384, 8 + i);
            SB_();
#pragma unroll
            for (int i = 0; i < 4; ++i) { S[i] = MF(fa[i * 2], Vd0, S[i]); S[i] = MF(fa[i * 2 + 1], Vd1, S[i]); }
            SB_();
#pragma unroll
            for (int i = 0; i < 4; ++i) { S[4 + i] = MF(fb[i * 2], Vd0, S[4 + i]); S[4 + i] = MF(fb[i * 2 + 1], Vd1, S[4 + i]); }
            SB_();
            {
                const int row0 = cidx < 4 ? ML + b * CT + cidx * 64 : b * T + (cidx - 4) * 64;
                float* op = Og + (size_t)(row0 + 4 * g4) * 512;
#pragma unroll
                for (int mt = 0; mt < 4; ++mt)
#pragma unroll
                    for (int t = 0; t < 4; ++t) { if (VAR != 1) op[(size_t)(16 * mt + t) * 512] = O[mt][t]; else asm volatile("" :: "v"(O[mt][t])); }
            }
#undef RD_KQ
#undef MM_KQ
#undef SB_
#undef FR
#undef MF
            asm volatile("s_waitcnt lgkmcnt(0)" ::: "memory"); __builtin_amdgcn_s_barrier(); asm volatile("" ::: "memory");
        }
    }
#undef CIDX
#undef a
}

__device__ __forceinline__ void phase_dn_out(int l) {
    const KArgs ap = get_args();
#define a (*ap)

    const int tid = fresh_tid(), lane = tid & 63, wave = __builtin_amdgcn_readfirstlane(tid >> 6), G = fresh_g(), bx = fresh_bx();
    unsigned char* ws = a.ws;
    const int nrows = (l == DEPTH - 1) ? ML : M;
    const float* OF = (const float*)(ws + WS_OF); const float* OB = (const float*)(ws + WS_OB);
    const bf16_t* P = (const bf16_t*)(ws + WS_P); bf16_t* CAT = (bf16_t*)(ws + WS_CAT);
    const f32x2 nw = *(const f32x2*)(a.in[I_DNW] + l * 128 + 2 * lane);
    const float* LSE = (const float*)(ws + WS_BA);
    for (int row = wave * G + bx; row < nrows; row += G * 8) {
        f32x2 of[4], ob[4]; unsigned gw[4];
#pragma unroll
        for (int hh = 0; hh < 4; ++hh) { of[hh] = *(const f32x2*)(OF + (size_t)row * 512 + hh * 128 + 2 * lane); ob[hh] = *(const f32x2*)(OB + (size_t)row * 512 + hh * 128 + 2 * lane);
            gw[hh] = *(const unsigned*)(P + (size_t)row * NP + 2560 + hh * 128 + 2 * lane); }
        u32x4 ap_[4]; float ls_[4];
#pragma unroll
        for (int p = 0; p < 4; ++p) { ap_[p] = (u32x4){0u, 0u, 0u, 0u}; ls_[p] = 0.f; }
        if (row < ML) {
            ap_[0] = *(const u32x4*)(CAT + (size_t)row * 1024 + 8 * lane); ap_[1] = *(const u32x4*)((const bf16_t*)(ws + WS_DQ) + (size_t)row * 512 + 8 * lane);
            ap_[2] = *(const u32x4*)((const bf16_t*)(ws + WS_DK) + (size_t)row * 512 + 8 * lane); ap_[3] = *(const u32x4*)((const bf16_t*)(ws + WS_DV) + (size_t)row * 512 + 8 * lane);
#pragma unroll
            for (int p = 0; p < 4; ++p) ls_[p] = LSE[((size_t)p * ML + row) * 4 + (lane >> 4)]; }
        float o0[4], o1[4], ssq[4];
#pragma unroll
        for (int hh = 0; hh < 4; ++hh) { o0[hh] = of[hh][0] + ob[hh][0]; o1[hh] = of[hh][1] + ob[hh][1]; ssq[hh] = o0[hh] * o0[hh] + o1[hh] * o1[hh]; }
#pragma unroll
        for (int hh = 0; hh < 4; ++hh) ssq[hh] = wave_sum(ssq[hh]);
        float mxv = 0.f;
#pragma unroll
        for (int hh = 0; hh < 4; ++hh) { const float rs = rsqrtf(ssq[hh] * (1.f / 128.f) + EPS); const float g0 = bflo(gw[hh]), g1 = bfhi(gw[hh]);
            o0[hh] = o0[hh] * rs * nw[0] * silu_f(g0); o1[hh] = o1[hh] * rs * nw[1] * silu_f(g1); mxv = fmaxf(mxv, fmaxf(fabsf(o0[hh]), fabsf(o1[hh]))); }
        float av[8];
        if (row < ML) { const float mx = fmaxf(fmaxf(ls_[0], ls_[1]), fmaxf(ls_[2], ls_[3]));
            float w_[4], wsum = 0.f;
#pragma unroll
            for (int p = 0; p < 4; ++p) { w_[p] = __expf(ls_[p] - mx); wsum += w_[p]; }
            const float inv = 1.f / wsum;
#pragma unroll
            for (int i = 0; i < 4; ++i) { float lo = 0.f, hi2 = 0.f;
#pragma unroll
                for (int p = 0; p < 4; ++p) { lo = fmaf(w_[p], bflo(ap_[p][i]), lo); hi2 = fmaf(w_[p], bfhi(ap_[p][i]), hi2); }
                av[2 * i] = lo * inv; av[2 * i + 1] = hi2 * inv; } }
        else { const u32x4 cw_ = *(const u32x4*)(CAT + (size_t)row * 1024 + 8 * lane);
#pragma unroll
            for (int i = 0; i < 4; ++i) { av[2 * i] = bflo(cw_[i]); av[2 * i + 1] = bfhi(cw_[i]); } }
#pragma unroll
        for (int i = 0; i < 8; ++i) mxv = fmaxf(mxv, fabsf(av[i]));
        mxv = fmaxf(wave_max(mxv), 1e-30f);
        const float cinv = 127.f / mxv;
        signed char* crow = (signed char*)(ws + WS_CATQ) + (size_t)row * 1024;
#define Q8_(x) ((unsigned)(int)rintf((x) * cinv) & 255u)
        { u32x2 o; o.x = Q8_(av[0]) | (Q8_(av[1]) << 8) | (Q8_(av[2]) << 16) | (Q8_(av[3]) << 24); o.y = Q8_(av[4]) | (Q8_(av[5]) << 8) | (Q8_(av[6]) << 16) | (Q8_(av[7]) << 24); *(u32x2*)(crow + 8 * lane) = o; }
#pragma unroll
        for (int hh = 0; hh < 4; ++hh) *(unsigned short*)(crow + 512 + hh * 128 + 2 * lane) = (unsigned short)(Q8_(o0[hh]) | (Q8_(o1[hh]) << 8));
#undef Q8_
        if (lane == 0) ((float*)(ws + WS_GB))[(1u << 18) + row] = mxv * (1.f / 127.f);
    }
#undef a
}

#define CE_DESC(a_, b_) do { const float hi_ = fmaxf(a_, b_), lo_ = fminf(a_, b_); a_ = hi_; b_ = lo_; } while (0)
__device__ __forceinline__ void bitonic_sort16_desc(float (&v)[16]) {
#pragma unroll
    for (int k = 2; k <= 16; k <<= 1)
#pragma unroll
        for (int j = k >> 1; j > 0; j >>= 1)
#pragma unroll
            for (int i = 0; i < 16; ++i) { const int p = i ^ j; if (p > i) { if ((i & k) == 0) CE_DESC(v[i], v[p]); else CE_DESC(v[p], v[i]); } }
}
__device__ __forceinline__ void merge_top16_desc(float (&lst)[16], const float (&nw)[16]) {
#pragma unroll
    for (int i = 0; i < 16; ++i) lst[i] = fmaxf(lst[i], nw[15 - i]);
#pragma unroll
    for (int j = 8; j > 0; j >>= 1)
#pragma unroll
        for (int i = 0; i < 16; ++i) { const int p = i ^ j; if (p > i) CE_DESC(lst[i], lst[p]); }
}
__device__ __forceinline__ void phase_peer_select(int l) {
    const KArgs ap = get_args();
#define a (*ap)
    const int tid = fresh_tid(), lane = tid & 63, wave = __builtin_amdgcn_readfirstlane(tid >> 6), G = fresh_g(), bx = fresh_bx();
    unsigned char* ws = a.ws;
    const int nrows = (l == DEPTH - 1) ? ML : M;
    const int ntask = (nrows / 32) * 4;
    const bf16_t* Q2 = (const bf16_t*)(ws + WS_P);
    const bf16_t* SKB = (const bf16_t*)(ws + WS_SKB) + (size_t)l * 8 * 2 * 128 * 128;
    int* PIDX = (int*)(ws + WS_PIDX); float* PGATE = (float*)(ws + WS_PGATE);
    const float NEG = -3.0e38f;
    const int r = lane & 31, hi = lane >> 5;
    for (int task = wave * G + bx; task < ntask; task += G * 8) {
        const int tg = task >> 2, hp = task & 3; const int row = tg * 32 + r;
        float mine0[16], mine1[16];
#pragma unroll
        for (int j = 0; j < 16; ++j) { mine0[j] = NEG; mine1[j] = NEG; }
        bf16x8 qA[8], kA[8];
        float lst[16];
#define SEL_QPTR(it_) (Q2 + (size_t)row * 2048 + (2 * hp + ((it_) >> 1)) * 256 + ((it_) & 1) * 128 + 8 * hi)
#define SEL_KPTR(it_, t_) (SKB + (size_t)(((2 * hp + ((it_) >> 1)) * 2 + ((it_) & 1)) * 128 + 32 * (t_) + r) * 128 + 8 * hi)
#define SEL_LDQ(dst, it_) do { const bf16_t* qp_ = SEL_QPTR(it_); _Pragma("unroll") for (int ks = 0; ks < 8; ++ks) dst[ks] = *(const bf16x8*)(qp_ + 16 * ks); } while (0)
#define SEL_LDK(dst, it_, t_) do { const bf16_t* kp_ = SEL_KPTR(it_, t_); _Pragma("unroll") for (int ks = 0; ks < 8; ++ks) dst[ks] = *(const bf16x8*)(kp_ + 16 * ks); } while (0)
#define SEL_RANK(qv, kv, t_) do { f32x16 acc = {}; _Pragma("unroll") for (int ks = 0; ks < 8; ++ks) acc = __builtin_amdgcn_mfma_f32_32x32x16_bf16(kv[ks], qv[ks], acc, 0, 0, 0); \
            const unsigned kb = (unsigned)(32 * (t_) + 4 * hi); float nw_[16]; \
            _Pragma("unroll") for (int i = 0; i < 16; ++i) nw_[i] = __uint_as_float((__float_as_uint(acc[i]) & 0xffffff80u) | (kb + (unsigned)((i & 3) + 8 * (i >> 2)))); \
            bitonic_sort16_desc(nw_); merge_top16_desc(lst, nw_); } while (0)
#define SB_() __builtin_amdgcn_sched_barrier(0)
#pragma unroll
        for (int j = 0; j < 16; ++j) lst[j] = NEG;
#pragma unroll 1
        for (int it = 0; it < 4; ++it) {
            SEL_LDQ(qA, it);
#pragma unroll 1
            for (int t = 0; t < 4; ++t) { SEL_LDK(kA, it, t); SEL_RANK(qA, kA, t); }
            float oth[16];
#pragma unroll
            for (int j = 0; j < 16; ++j) { auto rr = __builtin_amdgcn_permlane32_swap(__float_as_uint(lst[j]), __float_as_uint(lst[j]), false, false); oth[j] = __uint_as_float(hi ? rr[0] : rr[1]); }
            merge_top16_desc(lst, oth);
            const bool k0 = ((it >> 1) == hi) && ((it & 1) == 0), k1 = ((it >> 1) == hi) && ((it & 1) == 1);
#pragma unroll
            for (int j = 0; j < 16; ++j) { mine0[j] = k0 ? lst[j] : mine0[j]; mine1[j] = k1 ? lst[j] : mine1[j]; lst[j] = NEG; }
        }
#undef SB_
#undef SEL_QPTR
#undef SEL_KPTR
#undef SEL_LDQ
#undef SEL_LDK
#undef SEL_RANK
        const int h = 2 * hp + hi;
        float ts[16];
#pragma unroll
        for (int j = 0; j < 16; ++j) ts[j] = NEG;
#pragma unroll
        for (int i = 0; i < 16; ++i)
#pragma unroll
            for (int j = 0; j < 16; ++j) if ((i + 1) * (j + 1) <= 16) {
                const unsigned b0 = __float_as_uint(mine0[i]), b1 = __float_as_uint(mine1[j]);
                const float c = __uint_as_float(b0 & 0xffffff80u) + __uint_as_float(b1 & 0xffffff80u);
                float x = __uint_as_float((__float_as_uint(c) & 0xffffc000u) | ((b0 & 127u) << 7) | (b1 & 127u));
#pragma unroll
                for (int t = 0; t < 16; ++t) { const float hv = fmaxf(ts[t], x); x = fminf(ts[t], x); ts[t] = hv; }
            }
        int te[16]; float ex[16], sum = 0.f;
        const float tmax = __uint_as_float(__float_as_uint(ts[0]) & 0xffffc000u);
#pragma unroll
        for (int t = 0; t < 16; ++t) { const unsigned bt = __float_as_uint(ts[t]); te[t] = (int)(bt & 0x3fffu); ex[t] = __expf(__uint_as_float(bt & 0xffffc000u) - tmax); sum += ex[t]; }
        const float inv = 1.f / sum;
        int* ip = PIDX + (size_t)row * 128 + h * 16; float* gp = PGATE + (size_t)row * 128 + h * 16;
#pragma unroll
        for (int t = 0; t < 16; t += 4) { *(u32x4*)(ip + t) = (u32x4){(unsigned)te[t], (unsigned)te[t + 1], (unsigned)te[t + 2], (unsigned)te[t + 3]}; *(f32x4*)(gp + t) = (f32x4){ex[t] * inv, ex[t + 1] * inv, ex[t + 2] * inv, ex[t + 3] * inv}; }
    }
#undef a
}

template <bool WR, int GV = 0>
__device__ __forceinline__ void phase_peer_gather(int l, LAS unsigned char* lds) {
    const KArgs ap = get_args();
#define a (*ap)
    const int tid = fresh_tid(), lane = tid & 63, wave = __builtin_amdgcn_readfirstlane(tid >> 6), G = fresh_g(), bx = fresh_bx();
    unsigned char* ws = a.ws;
    const int nrows = (l == DEPTH - 1) ? ML : M;
    const unsigned char* UB = ws + WS_UB + (size_t)(l & 1) * TAB_SET; const unsigned char* VB = UB + 1024;
    const float* USC = (const float*)(ws + WS_USC) + (l & 1) * 2 * NEXP; const float* VSC = USC + NEXP;
    const int* PIDX = (const int*)(ws + WS_PIDX); const float* PGATE = (const float*)(ws + WS_PGATE);
    const float* modl = (const float*)(ws + WS_MOD) + (size_t)l * 3 * 6144 + 5120;
    const bool fuse = WR && (l + 1 < DEPTH);
    LAS float* wsk = (LAS float*)lds;
    if (fuse) { const float* src = (const float*)(ws + WS_WSK) + (size_t)(l + 1) * 16384; for (int i = tid; i < 16384 / 4; i += 512) ((LAS f32x4*)wsk)[i] = ((const f32x4*)src)[i]; __syncthreads(); }
    const float* nw1 = a.in[I_N1W] + (l + 1 < DEPTH ? l + 1 : l) * 1024 + 16 * lane;
    const float* modn = (const float*)(ws + WS_MOD) + (size_t)(l + 1 < DEPTH ? l + 1 : l) * 3 * 6144;
    for (int row = wave * G + bx; row < nrows; row += G * 8) {
        float hv[16], out[16];
        { const u32x4 hw = *(const u32x4*)((const signed char*)(ws + WS_H) + (size_t)row * D + 16 * lane); const float hsc = ((const float*)(ws + WS_GB))[row];
#pragma unroll
          for (int q = 0; q < 4; ++q) { const int w = (int)hw[q]; hv[4 * q + 0] = (float)((w << 24) >> 24) * hsc; hv[4 * q + 1] = (float)((w << 16) >> 24) * hsc; hv[4 * q + 2] = (float)((w << 8) >> 24) * hsc; hv[4 * q + 3] = (float)(w >> 24) * hsc; } }
        float hs = 0.f;
#pragma unroll
        for (int i = 0; i < 16; ++i) { out[i] = 0.f; hs += hv[i]; }
        const float hsum128 = 128.f * wave_sum(hs);
        float wacc = 0.f;
        const int id0 = PIDX[(size_t)row * 128 + lane], id1 = PIDX[(size_t)row * 128 + 64 + lane];
        const float gt0 = PGATE[(size_t)row * 128 + lane], gt1 = PGATE[(size_t)row * 128 + 64 + lane];
        const float us0 = USC[id0], us1 = USC[id1], vs0 = VSC[id0], vs1 = VSC[id1];
        for (int e0 = 0; e0 < 128; e0 += 8) {
            u32x4 uw[8], vw[8]; float gte[8], use[8], vse[8];
#pragma unroll
            for (int j = 0; j < 8; ++j) { const int e = e0 + j; const int id = __builtin_amdgcn_readlane(e0 < 64 ? id0 : id1, e & 63);
                gte[j] = __builtin_bit_cast(float, __builtin_amdgcn_readlane(__builtin_bit_cast(int, e0 < 64 ? gt0 : gt1), e & 63));
                use[j] = __builtin_bit_cast(float, __builtin_amdgcn_readlane(__builtin_bit_cast(int, e0 < 64 ? us0 : us1), e & 63));
                vse[j] = __builtin_bit_cast(float, __builtin_amdgcn_readlane(__builtin_bit_cast(int, e0 < 64 ? vs0 : vs1), e & 63));
                uw[j] = *(const u32x4*)(UB + (size_t)id * 2048 + 16 * lane); vw[j] = *(const u32x4*)(VB + (size_t)id * 2048 + 16 * lane); }
#pragma unroll
            for (int j = 0; j < 8; ++j) {
                float d0 = 0.f, d1 = 0.f;
#pragma unroll
                for (int q = 0; q < 4; ++q) { const unsigned w = uw[j][q];
                    d0 = fmaf((float)(w & 255u), hv[4 * q + 0], d0); d1 = fmaf((float)((w >> 8) & 255u), hv[4 * q + 1], d1);
                    d0 = fmaf((float)((w >> 16) & 255u), hv[4 * q + 2], d0); d1 = fmaf((float)(w >> 24), hv[4 * q + 3], d1); }
                const float dsum = (wave_sum(d0 + d1) - hsum128) * use[j];
                const float act = 0.5f * dsum * (1.f + erff(dsum * 0.70710678118654752f));
                const float wgt = gte[j] * act * vse[j];
                wacc += wgt;
                if (GV == 1) { asm volatile("" :: "v"(vw[j])); out[0] += wgt; } else
#pragma unroll
                for (int q = 0; q < 4; ++q) { const unsigned w = vw[j][q];
                    out[4 * q + 0] = fmaf(wgt, (float)(w & 255u), out[4 * q + 0]); out[4 * q + 1] = fmaf(wgt, (float)((w >> 8) & 255u), out[4 * q + 1]);
                    out[4 * q + 2] = fmaf(wgt, (float)((w >> 16) & 255u), out[4 * q + 2]); out[4 * q + 3] = fmaf(wgt, (float)(w >> 24), out[4 * q + 3]); }
            }
        }
        const float corr = 128.f * wacc;
        float* xr; int mrow;
        if (row < ML) { xr = a.out + (size_t)row * D; mrow = row >= T ? 1 : 0; } else { xr = (float*)(ws + WS_CTXX) + (size_t)(row - ML) * D; mrow = 2; }
        const float* g2 = modl + mrow * 6144 + 16 * lane;
        f32x4 xn[4];
#pragma unroll
        for (int i = 0; i < 4; ++i) { const f32x4 x = *(const f32x4*)(xr + 16 * lane + 4 * i), g = *(const f32x4*)(g2 + 4 * i);
            xn[i] = x + g * (f32x4){out[4 * i] - corr, out[4 * i + 1] - corr, out[4 * i + 2] - corr, out[4 * i + 3] - corr};
            if (WR) *(f32x4*)(xr + 16 * lane + 4 * i) = xn[i]; else asm volatile("" :: "v"(xn[i])); }
        if (fuse) {
            float ss = 0.f;
#pragma unroll
            for (int i = 0; i < 4; ++i) ss += (xn[i][0] * xn[i][0] + xn[i][1] * xn[i][1]) + (xn[i][2] * xn[i][2] + xn[i][3] * xn[i][3]);
            const float rstd = rsqrtf(wave_sum(ss) * (1.f / D) + EPS);
            const float* md = modn + mrow * 6144 + 16 * lane;
#pragma unroll
            for (int i = 0; i < 4; ++i) { const f32x4 nwv = *(const f32x4*)(nw1 + 4 * i), sc = *(const f32x4*)(md + 1024 + 4 * i), sh = *(const f32x4*)(md + 4 * i);
                xn[i] = xn[i] * rstd * nwv * (sc + 1.f) + sh; }
            { float hmx = 0.f;
#pragma unroll
              for (int i = 0; i < 4; ++i) hmx = fmaxf(hmx, fmaxf(fmaxf(fabsf(xn[i][0]), fabsf(xn[i][1])), fmaxf(fabsf(xn[i][2]), fabsf(xn[i][3]))));
              hmx = fmaxf(wave_max(hmx), 1e-30f); const float hinv = 127.f / hmx;
              u32x4 o;
#pragma unroll
              for (int i = 0; i < 4; ++i) o[i] = ((unsigned)(int)rintf(xn[i][0] * hinv) & 255u) | (((unsigned)(int)rintf(xn[i][1] * hinv) & 255u) << 8) | (((unsigned)(int)rintf(xn[i][2] * hinv) & 255u) << 16) | (((unsigned)(int)rintf(xn[i][3] * hinv) & 255u) << 24);
              *(u32x4*)((signed char*)(ws + WS_H) + (size_t)row * D + 16 * lane) = o;
              if (lane == 0) ((float*)(ws + WS_GB))[row] = hmx * (1.f / 127.f); }
            float p[16];
#pragma unroll
            for (int c = 0; c < 16; ++c) { float q = 0.f;
#pragma unroll
                for (int i = 0; i < 4; ++i) { const f32x4 w = *(const LAS f32x4*)(wsk + c * 1024 + 16 * lane + 4 * i); q += (xn[i][0] * w[0] + xn[i][1] * w[1]) + (xn[i][2] * w[2] + xn[i][3] * w[3]); }
                p[c] = q; }
            { const bool hb = (lane & 32) != 0;
#pragma unroll
              for (int c = 0; c < 8; ++c) { const float keep = hb ? p[c + 8] : p[c], send = hb ? p[c] : p[c + 8]; p[c] = keep + lane_xor<32>(send); } }
            { const bool hb = (lane & 16) != 0;
#pragma unroll
              for (int c = 0; c < 4; ++c) { const float keep = hb ? p[c + 4] : p[c], send = hb ? p[c] : p[c + 4]; p[c] = keep + lane_xor<16>(send); } }
            { const bool hb = (lane & 8) != 0;
#pragma unroll
              for (int c = 0; c < 2; ++c) { const float keep = hb ? p[c + 2] : p[c], send = hb ? p[c] : p[c + 2]; p[c] = keep + lane_xor<8>(send); } }
            { const bool hb = (lane & 4) != 0; const float keep = hb ? p[1] : p[0], send = hb ? p[0] : p[1]; p[0] = keep + lane_xor<4>(send); }
            p[0] += lane_xor<2>(p[0]); p[0] += lane_xor<1>(p[0]);
            if ((lane & 3) == 0) { const int c = ((lane >> 5) & 1) * 8 + ((lane >> 4) & 1) * 4 + ((lane >> 3) & 1) * 2 + ((lane >> 2) & 1); ((float*)(ws + WS_BA))[(size_t)row * 16 + c] = p[0]; }
        }
    }
    if (fuse) __syncthreads();
}
#undef a
__global__ void __launch_bounds__(512, 2) fwd(Args a) {
    extern __shared__ __attribute__((aligned(16))) unsigned char lds_raw[];
    LAS unsigned char* lds = (LAS unsigned char*)lds_raw;
    volatile LAS unsigned* MISC = (volatile LAS unsigned*)(lds + LDS_MISC);
    if (threadIdx.x < 16) MISC[threadIdx.x] = 0u;
    __syncthreads();
    XcdBarrier bar; bar.bar = (unsigned*)(a.ws + WS_CTL) + 4096; bar.x = 0; bar.st = MISC + 8;
    bar = xcd_barrier_post((unsigned*)(a.ws + WS_CTL) + 4096, MISC + 8);
#ifndef PHASE_MASK
#define PHASE_MASK 0x1FFF
#endif
#define EN(i) ((PHASE_MASK >> (i)) & 1)
#ifndef REP_MASK
#define REP_MASK 0
#endif
#define REPN(i) (1 + ((REP_MASK >> (i)) & 1))
#define IN(k) true
#define SEAM(k) do { XcdBarrier b_; b_.bar = (unsigned*)(get_args()->ws + WS_CTL) + 4096; b_.x = xb_xcc_id(); b_.st = (volatile LAS unsigned*)(lds + LDS_MISC) + 8; xcd_barrier(b_); } while (0)
    for (int rep_ = 0; rep_ < (REPN(0)); ++rep_) if (EN(0) && IN(0)) phase_prologue(lds);
    SEAM(0);
#pragma unroll 1
    for (int l_ = 0; l_ < DEPTH; ++l_) {
        int l = l_; asm volatile("" : "+s"(l));
        const int pb = 1 + l * NPH_L;
        const int mrows = (l == DEPTH - 1) ? ML : M;
        if (l == 0) { for (int rep_ = 0; rep_ < (REPN(1)); ++rep_) if (EN(1) && IN(pb + 0)) { phase_norm<true>(l, 0, lds); phase_quant_weights(lds); }
            SEAM(pb + 0); }
        for (int rep_ = 0; rep_ < (REPN(2)); ++rep_) if (EN(2) && IN(pb + 1)) { const KArgs ap = get_args(); unsigned char* ws = ap->ws; pg8::Gemm g{(const bf16_t*)(ws + WS_H), (const bf16_t*)((const signed char*)(ws + WS_WINT) + (size_t)l * NP * 1024), M, NP, 512}; pg8::StaticOrder S; S.init(M, NP, fresh_g(), fresh_bx());
            pg8::EpiBf16I8 E{(bf16_t*)(ws + WS_P), NP, (const float*)(ws + WS_GB), (const float*)(ws + WS_CTL) + CW_WMAX + (l * 3 + 0) * 3072}; pg8::gemm_phase(lds, g, S, E); }
        SEAM(pb + 1);
        for (int rep_ = 0; rep_ < (REPN(3)); ++rep_) if (EN(3) && IN(pb + 2)) { phase_dn_chunkprep<1>(l, lds); phase_prep(l, lds); }
        for (int rep_ = 0; rep_ < (REPN(4)); ++rep_) if (EN(4) && IN(pb + 3)) phase_dn_chunkprep<0>(l, lds);
        SEAM(pb + 3);
        for (int rep_ = 0; rep_ < (REPN(5)); ++rep_) if (EN(5) && IN(pb + 4)) { phase_dn_scan<0>(l, lds); __syncthreads(); phase_attn(l, lds_raw, MISC, rep_); }
        SEAM(pb + 4);
        for (int rep_ = 0; rep_ < (REPN(7)); ++rep_) if (EN(7) && IN(pb + 5)) phase_dn_out(l);
        SEAM(pb + 5);
        if (EN(8) && IN(pb + 6)) { const KArgs ap = get_args(); unsigned char* ws = ap->ws; pg8::Gemm g{(const bf16_t*)(ws + WS_CATQ), (const bf16_t*)((const signed char*)(ws + WS_WOUTT) + (size_t)l * 1024 * 1024), mrows, 1024, 512}; pg8::StaticOrder S; S.init(mrows, 1024, fresh_g(), fresh_bx());
            pg8::EpiResI8 E{l == 0 ? ap->in[I_X] : ap->out, l == 0 ? ap->in[I_CTX] : (const float*)(ws + WS_CTXX), ap->out, (float*)(ws + WS_CTXX), (const float*)(ws + WS_MOD) + (size_t)l * 3 * 6144 + 2048,
                              (const float*)(ws + WS_GB) + (1u << 18), (const float*)(ws + WS_CTL) + CW_WMAX + (l * 3 + 1) * 3072};
            pg8::gemm_phase(lds, g, S, E); }
        SEAM(pb + 6);
        for (int rep_ = 0; rep_ < (REPN(9)); ++rep_) if (EN(9) && IN(pb + 7)) phase_norm<false>(l, 1, lds);
        SEAM(pb + 7);
        for (int rep_ = 0; rep_ < (REPN(10)); ++rep_) if (EN(10) && IN(pb + 8)) { const KArgs ap = get_args(); unsigned char* ws = ap->ws; pg8::Gemm g{(const bf16_t*)(ws + WS_H), (const bf16_t*)((const signed char*)(ws + WS_WQT) + (size_t)l * 2048 * 1024), mrows, 2048, 512}; pg8::StaticOrder S; S.init(mrows, 2048, fresh_g(), fresh_bx());
            pg8::EpiBf16I8 E{(bf16_t*)(ws + WS_P), 2048, (const float*)(ws + WS_GB), (const float*)(ws + WS_CTL) + CW_WMAX + (l * 3 + 2) * 3072}; pg8::gemm_phase(lds, g, S, E); }
        SEAM(pb + 8);
        for (int rep_ = 0; rep_ < (REPN(11)); ++rep_) if (EN(11) && IN(pb + 9)) phase_peer_select(l);
        SEAM(pb + 9);
        #ifdef GATHER_VAR
        if (EN(12) && IN(pb + 10)) phase_peer_gather<false, GATHER_VAR>(l, lds);
#endif
        if (REPN(12) > 1 && EN(12) && IN(pb + 10)) phase_peer_gather<false>(l, lds);
        if (EN(12) && IN(pb + 10)) phase_peer_gather<true>(l, lds);
        if (l + 1 < DEPTH) SEAM(pb + 10);
    }
#undef IN
#undef SEAM
}

#ifndef N_LAUNCH_MODE
#define N_LAUNCH_MODE 1
#endif
extern "C" void kernel_launch(void* const* d_in, const int* in_sizes, int n_in, void* d_out, int out_size, void* d_ws, size_t ws_size, hipStream_t stream) {
    static int grid = 0;
    if (grid == 0) {
        if (n_in != 20 || out_size != ML * D || ws_size < WS_END) { fprintf(stderr, "kernel_launch: unexpected shapes: n_in %d out %d ws %zu (need %zu)\n", n_in, out_size, ws_size, (size_t)WS_END); grid = -1; return; }
        int dev = 0, cus = 0, per_cu = 0;
        if (hipGetDevice(&dev) != hipSuccess || hipDeviceGetAttribute(&cus, hipDeviceAttributeMultiprocessorCount, dev) != hipSuccess) { grid = -1; return; }
        if (hipFuncSetAttribute((const void*)fwd, hipFuncAttributeMaxDynamicSharedMemorySize, LDS_BYTES) != hipSuccess) { fprintf(stderr, "kernel_launch: hipFuncSetAttribute failed\n"); grid = -1; return; }
        if (hipOccupancyMaxActiveBlocksPerMultiprocessor(&per_cu, (const void*)fwd, 512, LDS_BYTES) != hipSuccess || per_cu < 1) fprintf(stderr, "kernel_launch: occupancy query says %d\n", per_cu);
        (void)hipGetLastError();
        grid = cus;
    }
    if (grid < 0) return;
    (void)hipMemsetAsync((char*)d_ws + WS_CTL, 0, CTL_BYTES, stream);
    Args a{};
    for (int i = 0; i < 20; ++i) a.in[i] = (const float*)d_in[i];
    a.out = (float*)d_out; a.ws = (unsigned char*)d_ws;
    a.ph_lo = 0; a.ph_hi = NPHASE;
    hipLaunchKernelGGL(fwd, dim3(grid), dim3(512), LDS_BYTES, stream, a);
    const hipError_t le = hipPeekAtLastError();
    if (le != hipSuccess) fprintf(stderr, "kernel_launch: launch failed: %s\n", hipGetErrorName(le));
}
```

```cpp
#include <hip/hip_runtime.h>
#include <cstdio>
#include <cstdint>

#define GAS __attribute__((address_space(1)))
#define LAS __attribute__((address_space(3)))
typedef unsigned short bf16_t;
typedef short bf16x8 __attribute__((ext_vector_type(8)));
typedef short s16x4 __attribute__((ext_vector_type(4)));
typedef float f32x4 __attribute__((ext_vector_type(4)));
typedef float f32x2 __attribute__((ext_vector_type(2)));
typedef float f32x16 __attribute__((ext_vector_type(16)));
typedef unsigned u32x4 __attribute__((ext_vector_type(4)));
typedef unsigned u32x2 __attribute__((ext_vector_type(2)));
typedef int i32x4 __attribute__((ext_vector_type(4)));

constexpr int D = 1024, NB = 2, T = 16384, DEPTH = 4, CT = 256;
constexpr int ML = NB * T, MC = NB * CT, M = ML + MC;
constexpr int NIN = 3088, NP = 3072;
constexpr int KVLEN = T + CT;
constexpr int NEXP = 16384;
constexpr float EPS = 1e-6f;
constexpr int NPH_L = 11;
constexpr int NPHASE = 1 + DEPTH * NPH_L;

constexpr size_t MiB = 1u << 20;
constexpr size_t WS_CTL = 0, CTL_BYTES = 1 * MiB;
constexpr size_t WS_MOD = 1 * MiB;
constexpr size_t WS_ROPE = 2 * MiB;
constexpr size_t WS_WSK = 3 * MiB;
constexpr size_t WS_CTXX = 4 * MiB;
constexpr size_t WS_WINT = 8 * MiB;
constexpr size_t WS_WOUTT = 32 * MiB;
constexpr size_t WS_WQT = 40 * MiB;
constexpr size_t WS_SKB = 56 * MiB;
constexpr size_t WS_USC = 58 * MiB;
constexpr size_t WS_UB = 64 * MiB;
constexpr size_t WS_VB = 80 * MiB;
constexpr size_t TAB_SET = 32 * MiB;
constexpr size_t WS_H = 128 * MiB;
static_assert(WS_H + 2 * (size_t)M * 1024 <= 193 * MiB, "H + concat int8");
constexpr size_t WS_CATQ = WS_H + (size_t)M * 1024;
constexpr size_t WS_P = 193 * MiB;
constexpr size_t WS_QA = 388 * MiB;
constexpr size_t WS_KA = 421 * MiB;
constexpr size_t WS_VA = 438 * MiB;
constexpr size_t WS_CAT = 455 * MiB;
constexpr size_t WS_DQ = 520 * MiB;
constexpr size_t WS_DK = 553 * MiB;
constexpr size_t WS_DV = 586 * MiB;
constexpr size_t WS_OF = 619 * MiB;
constexpr size_t WS_OB = 684 * MiB;
constexpr size_t WS_GB = 749 * MiB;
constexpr size_t WS_BA = 752 * MiB;
constexpr size_t WS_PIDX = 755 * MiB;
constexpr size_t WS_PGATE = 772 * MiB;
constexpr size_t WS_REC = 789 * MiB;
constexpr size_t WS_END = 990 * MiB;
constexpr int CW_WMAX = 65536;
constexpr int NCH = 260;
constexpr int REC_K = 0, REC_KT = 16384, REC_Q = 32768, REC_V = 49152, REC_DIR = 65536, REC_DIRSZ = 17408, REC_BYTES = REC_DIR + 2 * REC_DIRSZ;
static_assert((size_t)NB * 4 * NCH * REC_BYTES + WS_REC <= WS_END, "rec region");

constexpr int LDS_BYTES = 163840;
constexpr int LDS_MISC = 163840 - 256;

__device__ __forceinline__ float bf2f(unsigned b) { return __uint_as_float(b << 16); }
__device__ __forceinline__ float bflo(unsigned w) { return __uint_as_float(w << 16); }
__device__ __forceinline__ float bfhi(unsigned w) { return __uint_as_float(w & 0xffff0000u); }
typedef __bf16 bf2v __attribute__((ext_vector_type(2)));
__device__ __forceinline__ unsigned pkbf(float lo, float hi) { unsigned r; asm("v_cvt_pk_bf16_f32 %0, %1, %2" : "=v"(r) : "v"(lo), "v"(hi)); return r; }
__device__ __forceinline__ unsigned pkbf_c(float lo, float hi) { f32x2 v = {lo, hi}; bf2v r = __builtin_convertvector(v, bf2v); return __builtin_bit_cast(unsigned, r); }
template <int K> __device__ __forceinline__ float lane_xor(float v) {
    const int b = __builtin_bit_cast(int, v);
    if constexpr (K == 1) return __builtin_bit_cast(float, __builtin_amdgcn_update_dpp(0, b, 0xB1, 0xF, 0xF, true));
    else if constexpr (K == 2) return __builtin_bit_cast(float, __builtin_amdgcn_update_dpp(0, b, 0x4E, 0xF, 0xF, true));
    else if constexpr (K == 32) { auto rr = __builtin_amdgcn_permlane32_swap((unsigned)b, (unsigned)b, false, false); unsigned ln_ = __builtin_amdgcn_mbcnt_hi(~0u, __builtin_amdgcn_mbcnt_lo(~0u, 0u)); asm volatile("" : "+v"(ln_));
        return __uint_as_float((ln_ & 32u) ? rr[0] : rr[1]); }
    else return __builtin_bit_cast(float, __builtin_amdgcn_ds_swizzle(b, 0x1F | (K << 10)));
}
__device__ __forceinline__ float wave_sum(float v) {
    v += lane_xor<1>(v); v += lane_xor<2>(v);
    v += __builtin_bit_cast(float, __builtin_amdgcn_update_dpp(0, __builtin_bit_cast(int, v), 0x124, 0xF, 0xF, true));
    v += __builtin_bit_cast(float, __builtin_amdgcn_update_dpp(0, __builtin_bit_cast(int, v), 0x128, 0xF, 0xF, true));
    v += lane_xor<16>(v);
    { auto rr = __builtin_amdgcn_permlane32_swap(__float_as_uint(v), __float_as_uint(v), false, false); v = __uint_as_float(rr[0]) + __uint_as_float(rr[1]); }
    return v;
}
__device__ __forceinline__ float wave_max(float v) {
    v = fmaxf(v, lane_xor<1>(v)); v = fmaxf(v, lane_xor<2>(v));
    v = fmaxf(v, __builtin_bit_cast(float, __builtin_amdgcn_update_dpp(0, __builtin_bit_cast(int, v), 0x124, 0xF, 0xF, true)));
    v = fmaxf(v, __builtin_bit_cast(float, __builtin_amdgcn_update_dpp(0, __builtin_bit_cast(int, v), 0x128, 0xF, 0xF, true)));
    v = fmaxf(v, lane_xor<16>(v));
    { auto rr = __builtin_amdgcn_permlane32_swap(__float_as_uint(v), __float_as_uint(v), false, false); v = fmaxf(__uint_as_float(rr[0]), __uint_as_float(rr[1])); }
    return v;
}
__device__ __forceinline__ float silu_f(float x) { return x / (1.f + __expf(-x)); }
#define LDS_WAIT() asm volatile("s_waitcnt lgkmcnt(0)" ::: "memory")

#define XB_TMO      128
#define XB_XCNT(j)  (256  + 64 * (j))
#define XB_XSUB(j)  (1280 + 64 * (j))
#define XB_XGEN(j)  (2304 + 64 * (j))
#define XB_TOP      3328
#define XB_TOPGEN   3392
#define XCD_BAR_WORDS 3456
#define XB_SPIN_CAP (1u << 22)
__device__ __forceinline__ unsigned xb_ld(unsigned* p)              { return __hip_atomic_load(p, __ATOMIC_RELAXED, __HIP_MEMORY_SCOPE_AGENT); }
__device__ __forceinline__ unsigned xb_add(unsigned* p, unsigned v) { return __hip_atomic_fetch_add(p, v, __ATOMIC_RELAXED, __HIP_MEMORY_SCOPE_AGENT); }
__device__ __forceinline__ unsigned xb_xcc_id() { return (unsigned)__builtin_amdgcn_s_getreg((3 << 11) | 20) & 0xFu; }
#define XB_SPIN(cond, bar) do { unsigned _sp = 0; while (cond) { __builtin_amdgcn_s_sleep(1); \
    if ((++_sp & 255u) == 0u) { if (xb_ld(&(bar)[XB_TMO])) break; if (_sp > XB_SPIN_CAP) { atomicAdd(&(bar)[XB_TMO], 1u); break; } } } } while (0)
struct XcdBarrier { unsigned* bar; unsigned x; volatile LAS unsigned* st; };
__device__ __forceinline__ XcdBarrier xcd_barrier_post(unsigned* bar, volatile LAS unsigned* st) {
    XcdBarrier b; b.bar = bar; b.x = xb_xcc_id(); b.st = st;
    if (threadIdx.x == 0) (void)xb_add(&bar[XB_XCNT(b.x)], 1u);
    return b;
}
__device__ __forceinline__ void xcd_barrier_complete(unsigned* bar, unsigned x, unsigned& nloc, unsigned& nx) {
    const unsigned G = gridDim.x * gridDim.y * gridDim.z;
    unsigned sum, cnt, mine, sp = 0u;
    for (;;) {
        sum = 0u; cnt = 0u; mine = 0u;
#pragma unroll
        for (unsigned j = 0; j < 16; ++j) { const unsigned c = xb_ld(&bar[XB_XCNT(j)]); sum += c; cnt += (c > 0u) ? 1u : 0u; mine = (j == x) ? c : mine; }
        if (sum == G) break;
        __builtin_amdgcn_s_sleep(1);
        if ((++sp & 255u) == 0u) { if (xb_ld(&bar[XB_TMO])) break; if (sp > XB_SPIN_CAP) { atomicAdd(&bar[XB_TMO], 1u); break; } }
    }
    nloc = mine > 0u ? mine : 1u; nx = cnt > 0u ? cnt : 1u;
}
__device__ __forceinline__ void xcd_barrier(const XcdBarrier& b) {
    asm volatile("s_waitcnt vmcnt(0)" ::: "memory");
    __syncthreads();
    if (threadIdx.x == 0) {
        unsigned* bar = b.bar; unsigned bx_ = b.x;
        asm volatile("" : "+s"(bar), "+s"(bx_));
        __builtin_amdgcn_s_waitcnt(0);
        unsigned nloc = b.st[0], nx = b.st[1];
        if (nloc == 0u) { xcd_barrier_complete(bar, bx_, nloc, nx); b.st[0] = nloc; b.st[1] = nx; }
        const unsigned old = xb_add(&bar[XB_XSUB(bx_)], 1u);
        const unsigned gen = old / nloc;
        if (old + 1u == (gen + 1u) * nloc) {
            __builtin_amdgcn_fence(__ATOMIC_RELEASE, "agent");
            asm volatile("s_waitcnt vmcnt(0)" ::: "memory");
            const unsigned og = xb_add(&bar[XB_TOP], 1u);
            const unsigned tg = og / nx;
            if (og + 1u == (tg + 1u) * nx) xb_add(&bar[XB_TOPGEN], 1u);
            else XB_SPIN(xb_ld(&bar[XB_TOPGEN]) == tg, bar);
            __builtin_amdgcn_fence(__ATOMIC_ACQUIRE, "agent");
            xb_add(&bar[XB_XGEN(bx_)], 1u);
            asm volatile("s_waitcnt vmcnt(0)" ::: "memory");
        } else {
            XB_SPIN(xb_ld(&bar[XB_XGEN(bx_)]) == gen, bar);
            __builtin_amdgcn_fence(__ATOMIC_ACQUIRE, "agent");
            asm volatile("s_waitcnt vmcnt(0)" ::: "memory");
        }
    }
    __syncthreads();
}

namespace pg8 {
constexpr int BM = 256, BK = 64, HALF = 128, HTB = HALF * BK * 2, STAGE_BYTES = 8 * HTB, NXCD = 8, WGM = 8;
__host__ __device__ __forceinline__ int lds_byte(int r, int c) { const int st = (r >> 4) * 2 + (c >> 5), rr = r & 15, cc = c & 31, ob = rr * 64 + cc * 2; return st * 1024 + (ob ^ (((ob >> 9) & 1) << 5)); }
__host__ __device__ __forceinline__ void stage_rc(int b, int& R, int& C) { const int st = b / 1024, sb = b % 1024, swz = sb ^ (((sb >> 9) & 1) << 5); R = (st >> 1) * 16 + swz / 64; C = (st & 1) * 32 + (swz % 64) / 2; }
__host__ __device__ __forceinline__ int perm32(int rho) { const int n = rho >> 4, i = rho & 15; return 8 * (i >> 2) + 4 * n + (i & 3); }
struct Unit { int pm, pn; };
struct Gemm { const bf16_t* A; const bf16_t* Bt; int M, N, K; };
struct StaticOrder {
    int nM, nN, nwg, G, c;
    __host__ __device__ void init(int M_, int N_, int G_, int c_) { nM = M_ / BM; nN = N_ / BM; nwg = nM * nN; G = G_; c = c_; }
    __host__ __device__ bool next(int i, Unit& u) const {
        const long L = (long)i * G + c; if (L >= nwg) return false;
        int wgid = (int)L; { const int q = nwg / NXCD, r = nwg % NXCD, xcd = wgid % NXCD, off = wgid / NXCD; wgid = (xcd < r ? xcd * (q + 1) : r * (q + 1) + (xcd - r) * q) + off; }
        const int nig = WGM * nN, gid = wgid / nig, fm = gid * WGM, gsz = (nM - fm) < WGM ? (nM - fm) : WGM;
        u.pm = fm + ((wgid % nig) % gsz); u.pn = (wgid % nig) / gsz; return true;
    }
    __device__ __forceinline__ void a_ready(const Unit&) const {}
    __device__ __forceinline__ void done(const Unit&) const {}
};
struct EpiBf16 {
    static constexpr bool PERM = true, I8 = false; typedef f32x4 acc_t;
    bf16_t* O; int ldc;
    __device__ __forceinline__ void operator()(const f32x4 (&acc)[2][2][4][2], const Unit& u, int wr, int wc, int fr, int fq) const {
        const int row0 = u.pm * BM + wr * 64 + fr; const int col0 = u.pn * BM + wc * 32 + 8 * fq;
#pragma unroll
        for (int ai = 0; ai < 2; ++ai)
#pragma unroll
            for (int m = 0; m < 4; ++m) { bf16_t* rowp = O + (size_t)(row0 + ai * HALF + m * 16) * ldc + col0;
#pragma unroll
                for (int bj = 0; bj < 2; ++bj) { const f32x4 v0 = acc[ai][bj][m][0], v1 = acc[ai][bj][m][1];
                    u32x4 w; w.x = pkbf_c(v0[0], v0[1]); w.y = pkbf_c(v0[2], v0[3]); w.z = pkbf_c(v1[0], v1[1]); w.w = pkbf_c(v1[2], v1[3]);
                    *(u32x4*)(rowp + bj * HALF) = w; } }
    }
};
struct EpiBf16I8 {
    static constexpr bool PERM = true, I8 = true; typedef i32x4 acc_t;
    bf16_t* O; int ldc; const float* sa; const float* wmax;
    __device__ __forceinline__ void operator()(const i32x4 (&acc)[2][2][4][2], const Unit& u, int wr, int wc, int fr, int fq) const {
        const int row0 = u.pm * BM + wr * 64 + fr; const int col0 = u.pn * BM + wc * 32 + 8 * fq;
        f32x4 sw[2][2];
#pragma unroll
        for (int bj = 0; bj < 2; ++bj)
#pragma unroll
            for (int n = 0; n < 2; ++n) sw[bj][n] = *(const f32x4*)(wmax + col0 + bj * HALF + 4 * n) * (1.f / 127.f);
#pragma unroll
        for (int ai = 0; ai < 2; ++ai)
#pragma unroll
            for (int m = 0; m < 4; ++m) { const int row = row0 + ai * HALF + m * 16; const float sr = sa[row]; bf16_t* rowp = O + (size_t)row * ldc + col0;
#pragma unroll
                for (int bj = 0; bj < 2; ++bj) { const i32x4 a0 = acc[ai][bj][m][0], a1 = acc[ai][bj][m][1];
                    const f32x4 v0 = (f32x4){(float)a0[0], (float)a0[1], (float)a0[2], (float)a0[3]} * sw[bj][0] * sr, v1 = (f32x4){(float)a1[0], (float)a1[1], (float)a1[2], (float)a1[3]} * sw[bj][1] * sr;
                    u32x4 w; w.x = pkbf(v0[0], v0[1]); w.y = pkbf(v0[2], v0[3]); w.z = pkbf(v1[0], v1[1]); w.w = pkbf(v1[2], v1[3]);
                    *(u32x4*)(rowp + bj * HALF) = w; } }
    }
};
struct EpiRes {
    static constexpr bool PERM = false, I8 = false; typedef f32x4 acc_t;
    const float* src_lat; const float* src_ctx; float* dst_lat; float* dst_ctx; const float* gate;
    __device__ __forceinline__ void operator()(const f32x4 (&acc)[2][2][4][2], const Unit& u, int wr, int wc, int fr, int fq) const {
        const bool isctx = u.pm >= (ML / BM);
        const float* src = isctx ? src_ctx + (size_t)(u.pm - ML / BM) * BM * D : src_lat + (size_t)u.pm * BM * D;
        float* dst = isctx ? dst_ctx + (size_t)(u.pm - ML / BM) * BM * D : dst_lat + (size_t)u.pm * BM * D;
        const int mrow = isctx ? 2 : (u.pm >= (T / BM) ? 1 : 0);
        const int row0 = wr * 64 + fr, col0 = u.pn * BM + wc * 32 + 4 * fq;
        f32x4 gv[2][2];
#pragma unroll
        for (int bj = 0; bj < 2; ++bj)
#pragma unroll
            for (int n = 0; n < 2; ++n) gv[bj][n] = *(const f32x4*)(gate + mrow * 6144 + col0 + bj * HALF + n * 16);
#pragma unroll
        for (int ai = 0; ai < 2; ++ai)
#pragma unroll
            for (int m = 0; m < 4; ++m) { const size_t off = (size_t)(row0 + ai * HALF + m * 16) * D + col0;
#pragma unroll
                for (int bj = 0; bj < 2; ++bj)
#pragma unroll
                    for (int n = 0; n < 2; ++n) { const f32x4 s = *(const f32x4*)(src + off + bj * HALF + n * 16);
                        *(f32x4*)(dst + off + bj * HALF + n * 16) = s + gv[bj][n] * acc[ai][bj][m][n]; } }
    }
};

struct EpiResI8 {
    static constexpr bool PERM = false, I8 = true; typedef i32x4 acc_t;
    const float* src_lat; const float* src_ctx; float* dst_lat; float* dst_ctx; const float* gate; const float* sa; const float* wmax;
    __device__ __forceinline__ void operator()(const i32x4 (&acc)[2][2][4][2], const Unit& u, int wr, int wc, int fr, int fq) const {
        const bool isctx = u.pm >= (ML / BM);
        const float* src = isctx ? src_ctx + (size_t)(u.pm - ML / BM) * BM * D : src_lat + (size_t)u.pm * BM * D;
        float* dst = isctx ? dst_ctx + (size_t)(u.pm - ML / BM) * BM * D : dst_lat + (size_t)u.pm * BM * D;
        const int mrow = isctx ? 2 : (u.pm >= (T / BM) ? 1 : 0);
        const int row0 = wr * 64 + fr, col0 = u.pn * BM + wc * 32 + 4 * fq;
        f32x4 gv[2][2];
#pragma unroll
        for (int bj = 0; bj < 2; ++bj)
#pragma unroll
            for (int n = 0; n < 2; ++n) gv[bj][n] = *(const f32x4*)(gate + mrow * 6144 + col0 + bj * HALF + n * 16) * *(const f32x4*)(wmax + col0 + bj * HALF + n * 16) * (1.f / 127.f);
#pragma unroll
        for (int ai = 0; ai < 2; ++ai)
#pragma unroll
            for (int m = 0; m < 4; ++m) { const int rl = row0 + ai * HALF + m * 16; const float sr = sa[u.pm * BM + rl]; const size_t off = (size_t)rl * D + col0;
#pragma unroll
                for (int bj = 0; bj < 2; ++bj)
#pragma unroll
                    for (int n = 0; n < 2; ++n) { const f32x4 sv = *(const f32x4*)(src + off + bj * HALF + n * 16); const i32x4 ac = acc[ai][bj][m][n];
                        *(f32x4*)(dst + off + bj * HALF + n * 16) = sv + gv[bj][n] * ((f32x4){(float)ac[0], (float)ac[1], (float)ac[2], (float)ac[3]} * sr); } }
    }
};
template <class Epi, class Sched>
__device__ __forceinline__ void gemm_phase(LAS unsigned char* lds, const Gemm g, const Sched& S, const Epi& E) {
    constexpr bool I8 = Epi::I8;
    typedef typename Epi::acc_t acc_t;
    int tid = threadIdx.x; asm volatile("" : "+v"(tid)); const int wid = __builtin_amdgcn_readfirstlane(tid >> 6), lane = tid & 63, wr = wid >> 2, wc = wid & 3, fr = lane & 15, fq = lane >> 4;
    const int K = g.K, nt = K / BK;
    unsigned voffA[2], voffB[2];
#pragma unroll
    for (int i = 0; i < 2; ++i) { int R, C; stage_rc(tid * 16 + i * 8192, R, C); const int Rb = Epi::PERM ? ((R & ~31) + perm32(R & 31)) : R;
        voffA[i] = (unsigned)(R * K + C) * 2u; voffB[i] = (unsigned)(Rb * K + C) * 2u; }
    const size_t kstep = (size_t)(BK * 2);
    const size_t hstep = (size_t)HALF * K * 2;
    const size_t tstep = 2 * hstep;
    const unsigned ldsw = (unsigned)wid * 1024u;
    const int aoff = lds_byte(wr * 64 + fr, fq * 8), boff = lds_byte(wc * 32 + fr, fq * 8);
#define PG8_SA(b, h) (((b) * 2 + (h)) * HTB)
#define PG8_SB(b, h) ((4 + (b) * 2 + (h)) * HTB)
#define PG8_STAGE(bufoff, gbase, voff) do { _Pragma("unroll") for (int _i = 0; _i < 2; ++_i) \
        __builtin_amdgcn_global_load_lds((const unsigned*)((const char*)(gbase) + (voff)[_i]), (LAS unsigned*)(lds + (bufoff) + ldsw + _i * 8192), 16, 0, 0); } while (0)
#define PG8_LDA(dst, b, h) do { _Pragma("unroll") for (int m = 0; m < 4; ++m) _Pragma("unroll") for (int k = 0; k < 2; ++k) dst[m][k] = *(const LAS bf16x8*)(lds + PG8_SA(b, h) + aoff + m * 2048 + k * 1024); } while (0)
#define PG8_LDB(dst, b, h) do { _Pragma("unroll") for (int n = 0; n < 2; ++n) _Pragma("unroll") for (int k = 0; k < 2; ++k) dst[n][k] = *(const LAS bf16x8*)(lds + PG8_SB(b, h) + boff + n * 2048 + k * 1024); } while (0)
#define PG8_MMA(ai, bj, At, Bt) do { __builtin_amdgcn_s_setprio(1); _Pragma("unroll") for (int m = 0; m < 4; ++m) _Pragma("unroll") for (int n = 0; n < 2; ++n) _Pragma("unroll") for (int k = 0; k < 2; ++k) \
        { if constexpr (I8) acc[ai][bj][m][n] = __builtin_bit_cast(acc_t, __builtin_amdgcn_mfma_i32_16x16x64_i8(__builtin_bit_cast(i32x4, Bt[n][k]), __builtin_bit_cast(i32x4, At[m][k]), __builtin_bit_cast(i32x4, acc[ai][bj][m][n]), 0, 0, 0)); \
          else acc[ai][bj][m][n] = __builtin_bit_cast(acc_t, __builtin_amdgcn_mfma_f32_16x16x32_bf16(Bt[n][k], At[m][k], __builtin_bit_cast(f32x4, acc[ai][bj][m][n]), 0, 0, 0)); } __builtin_amdgcn_s_setprio(0); } while (0)
#define PG8_WAIT_V(n) asm volatile("s_waitcnt vmcnt(" #n ")" ::: "memory")
#define PG8_WAIT_L(n) asm volatile("s_waitcnt lgkmcnt(" #n ")" ::: "memory")
#define PG8_BAR __builtin_amdgcn_s_barrier()
#define PG8_SCHED __builtin_amdgcn_sched_barrier(0)
    Unit cur, nxt; int ui = 0;
    if (!S.next(0, cur)) return;
    acc_t acc[2][2][4][2];
#pragma unroll
    for (int a = 0; a < 2; ++a)
#pragma unroll
        for (int b = 0; b < 2; ++b)
#pragma unroll
            for (int m = 0; m < 4; ++m)
#pragma unroll
                for (int n = 0; n < 2; ++n) acc[a][b][m][n] = acc_t{};
    bf16x8 At[4][2], B0[2][2], B1[2][2];
    const char* cA = (const char*)g.A + (size_t)cur.pm * tstep; const char* cB = (const char*)g.Bt + (size_t)cur.pn * tstep;
    S.a_ready(cur);
    PG8_STAGE(PG8_SB(0, 0), cB, voffB); PG8_STAGE(PG8_SA(0, 0), cA, voffA); PG8_STAGE(PG8_SB(0, 1), cB + hstep, voffB); PG8_STAGE(PG8_SA(0, 1), cA + hstep, voffA);
    if (wr == 1) PG8_BAR;
    PG8_WAIT_V(4); PG8_BAR;
    PG8_STAGE(PG8_SB(1, 0), cB + kstep, voffB); PG8_STAGE(PG8_SA(1, 0), cA + kstep, voffA); PG8_STAGE(PG8_SB(1, 1), cB + hstep + kstep, voffB);
    PG8_WAIT_V(6); PG8_BAR;
    for (;;) {
        const bool has_next = S.next(ui + 1, nxt);
        const char* nA = has_next ? (const char*)g.A + (size_t)nxt.pm * tstep : cA; const char* nB = has_next ? (const char*)g.Bt + (size_t)nxt.pn * tstep : cB;
        for (int t = 0; t < nt; t += 2) {
            const bool last = (t == nt - 2);
            const char* a1 = cA + (size_t)(t + 1) * kstep;
            const char* a2 = last ? nA : cA + (size_t)(t + 2) * kstep; const char* b2 = last ? nB : cB + (size_t)(t + 2) * kstep;
            const char* a3 = a2 + kstep; const char* b3 = b2 + kstep;
            if (last && has_next) S.a_ready(nxt);
            PG8_LDB(B0, 0, 0); PG8_SCHED; PG8_LDA(At, 0, 0); PG8_STAGE(PG8_SA(1, 1), a1 + hstep, voffA);
            PG8_WAIT_L(8); PG8_BAR; PG8_WAIT_L(0); PG8_MMA(0, 0, At, B0); PG8_BAR; PG8_SCHED;
            PG8_LDB(B1, 0, 1); PG8_STAGE(PG8_SB(0, 0), b2, voffB);
            PG8_BAR; PG8_WAIT_L(0); PG8_MMA(0, 1, At, B1); PG8_BAR;
            PG8_LDA(At, 0, 1); PG8_STAGE(PG8_SA(0, 0), a2, voffA);
            PG8_BAR; PG8_WAIT_L(0); PG8_MMA(1, 0, At, B0); PG8_BAR; PG8_SCHED;
            PG8_STAGE(PG8_SB(0, 1), b2 + hstep, voffB);
            PG8_WAIT_V(6); PG8_BAR; PG8_MMA(1, 1, At, B1); PG8_BAR;
            PG8_LDB(B0, 1, 0); PG8_SCHED; PG8_LDA(At, 1, 0); PG8_STAGE(PG8_SA(0, 1), a2 + hstep, voffA);
            PG8_WAIT_L(8); PG8_BAR; PG8_WAIT_L(0); PG8_MMA(0, 0, At, B0); PG8_BAR; PG8_SCHED;
            PG8_LDB(B1, 1, 1); PG8_STAGE(PG8_SB(1, 0), b3, voffB);
            PG8_BAR; PG8_WAIT_L(0); PG8_MMA(0, 1, At, B1); PG8_BAR;
            PG8_LDA(At, 1, 1); PG8_STAGE(PG8_SA(1, 0), a3, voffA);
            PG8_BAR; PG8_WAIT_L(0); PG8_MMA(1, 0, At, B0); PG8_BAR; PG8_SCHED;
            PG8_STAGE(PG8_SB(1, 1), b3 + hstep, voffB);
            PG8_WAIT_V(6); PG8_BAR; PG8_MMA(1, 1, At, B1); PG8_BAR;
        }
        E(acc, cur, wr, wc, fr, fq); S.done(cur);
        if (!has_next) break;
#pragma unroll
        for (int a = 0; a < 2; ++a)
#pragma unroll
            for (int b = 0; b < 2; ++b)
#pragma unroll
                for (int m = 0; m < 4; ++m)
#pragma unroll
                    for (int n = 0; n < 2; ++n) acc[a][b][m][n] = acc_t{};
        cur = nxt; cA = nA; cB = nB; ++ui;
    }
    PG8_WAIT_V(0);
    if (wr == 0) PG8_BAR;
    PG8_BAR;
#undef PG8_SA
#undef PG8_SB
#undef PG8_STAGE
#undef PG8_LDA
#undef PG8_LDB
#undef PG8_MMA
#undef PG8_WAIT_V
#undef PG8_WAIT_L
#undef PG8_BAR
#undef PG8_SCHED
}
}

namespace att {
constexpr int HD = 128, NW = 8, QBLK = 32, KVBLK = 64;
constexpr float SCALE = 0.088388347648318440f;
constexpr float THR = 8.f;
constexpr int LDQ = 512, LDK = 256;
constexpr size_t SHM_V = KVBLK * HD * 2, SHM_K = KVBLK * HD * 2, SHM_ATTN = 2 * SHM_V + 2 * SHM_K + NW * 64 * 4;
#define KSWZ(row, colB) ((row) * 256 + ((colB) ^ (((row) & 7) << 4)))
#define SBAR() __builtin_amdgcn_sched_barrier(0)
__device__ __forceinline__ int crow(int r, int hi) { return (r & 3) + 8 * (r >> 2) + 4 * hi; }
__device__ __forceinline__ unsigned cvtpk(float lo, float hi) { unsigned r; asm volatile("v_cvt_pk_bf16_f32 %0, %1, %2" : "=v"(r) : "v"(lo), "v"(hi)); return r; }
__device__ __forceinline__ void partialSM(f32x16& p0, f32x16& p1) {
  for (int r = 0; r < 16; ++r) p0[r] = __builtin_amdgcn_exp2f(p0[r]);
}
typedef int i32x8 __attribute__((ext_vector_type(8)));
__device__ __forceinline__ void finishSM(f32x16& p0, f32x16& p1, i32x8& pa) {
  for (int r = 0; r < 16; ++r) p1[r] = __builtin_amdgcn_exp2f(p1[r]);
#pragma unroll
  for (int q = 0; q < 4; ++q) { int w = __builtin_amdgcn_cvt_pk_bf8_f32(p0[4 * q], p0[4 * q + 1], 0, false); w = __builtin_amdgcn_cvt_pk_bf8_f32(p0[4 * q + 2], p0[4 * q + 3], w, true); pa[q] = w;
    int w2 = __builtin_amdgcn_cvt_pk_bf8_f32(p1[4 * q], p1[4 * q + 1], 0, false); w2 = __builtin_amdgcn_cvt_pk_bf8_f32(p1[4 * q + 2], p1[4 * q + 3], w2, true); pa[4 + q] = w2; }
}
constexpr int K8_STRIDE = 144, K8_TILE = KVBLK * K8_STRIDE;
__device__ __forceinline__ void qkt(f32x16& p0, f32x16& p1, const unsigned char* Ks, const i32x8* qr, int r32, int hi, const f32x16& cinit) {
  p0 = cinit; p1 = cinit;
#pragma unroll
  for (int ks = 0; ks < 2; ++ks) {
    const u32x4* a0 = (const u32x4*)(Ks + r32 * K8_STRIDE + 64 * ks + 32 * hi); const u32x4* a1 = (const u32x4*)(Ks + (32 + r32) * K8_STRIDE + 64 * ks + 32 * hi);
    const u32x4 x0 = a0[0], x1 = a0[1], y0 = a1[0], y1 = a1[1];
    const i32x8 k0 = {(int)x0.x, (int)x0.y, (int)x0.z, (int)x0.w, (int)x1.x, (int)x1.y, (int)x1.z, (int)x1.w}, k1 = {(int)y0.x, (int)y0.y, (int)y0.z, (int)y0.w, (int)y1.x, (int)y1.y, (int)y1.z, (int)y1.w};
    p0 = __builtin_amdgcn_mfma_scale_f32_32x32x64_f8f6f4(k0, qr[ks], p0, 0, 0, 0, 0x7F7F7F7F, 0, 0x7C7C7C7C);
    p1 = __builtin_amdgcn_mfma_scale_f32_32x32x64_f8f6f4(k1, qr[ks], p1, 0, 0, 0, 0x7F7F7F7F, 0, 0x7C7C7C7C); }
}
constexpr int V8_STRIDE = 80, V8_TILE = HD * V8_STRIDE;
__device__ __forceinline__ void pv_d0(f32x16* o, f32x16& ol, const unsigned char* Vs, const i32x8& pa, int r32, int hi) {
  { const i32x8 ones = {0x38383838, 0x38383838, 0x38383838, 0x38383838, 0x38383838, 0x38383838, 0x38383838, 0x38383838};
    ol = __builtin_amdgcn_mfma_scale_f32_32x32x64_f8f6f4(pa, ones, ol, 1, 0, 0, 0x7F7F7F7F, 0, 0x7F7F7F7F); }
#pragma unroll
  for (int d0 = 0; d0 < 4; ++d0) { const u32x4* bp = (const u32x4*)(Vs + (32 * d0 + r32) * V8_STRIDE + 32 * hi); const u32x4 x0 = bp[0], x1 = bp[1];
    const i32x8 vb = {(int)x0.x, (int)x0.y, (int)x0.z, (int)x0.w, (int)x1.x, (int)x1.y, (int)x1.z, (int)x1.w};
    o[d0] = __builtin_amdgcn_mfma_scale_f32_32x32x64_f8f6f4(pa, vb, o[d0], 1  , 0  , 0, 0x7F7F7F7F, 0, 0x7F7F7F7F); }
}
__device__ __forceinline__ void attn_dense_body(const unsigned char* __restrict__ Qb, const unsigned char* __restrict__ Kh, const unsigned char* __restrict__ Vt,
                                                bf16_t* __restrict__ Ob, int LDO, int seq, char* lds, float* __restrict__ lse, float braw) {
  int tid = threadIdx.x; asm volatile("" : "+v"(tid)); const int wid = tid >> 6, lane = tid & 63, r32 = lane & 31, hi = lane >> 5;
  unsigned char* V_lds = (unsigned char*)lds; unsigned char* K_lds = (unsigned char*)(lds + 2 * V8_TILE);
  f32x16 o[4] = {}, ol = {}; i32x8 qr[2];
  const float mnC = __builtin_bit_cast(float, __builtin_amdgcn_readfirstlane(__builtin_bit_cast(int, -fmaxf(braw * (SCALE * 1.4426950408889634f) - 15.5f, 0.f))));
  f32x16 cinit;
#pragma unroll
  for (int r = 0; r < 16; ++r) cinit[r] = mnC;
  const unsigned char* Qw = Qb + (long)(wid * QBLK + r32) * LDQ + hi * 32;
#pragma unroll
  for (int ks = 0; ks < 2; ++ks) { const u32x4 x0 = *(const u32x4*)(Qw + 64 * ks), x1 = *(const u32x4*)(Qw + 64 * ks + 16);
    qr[ks] = (i32x8){(int)x0.x, (int)x0.y, (int)x0.z, (int)x0.w, (int)x1.x, (int)x1.y, (int)x1.z, (int)x1.w}; }
  const int krow = tid >> 3, kch = tid & 7;
  const int vrow = tid >> 2, vch = tid & 3;
  struct { u32x4 v8, k8; } sr_[2];
#define SLOAD(i, k0) do { sr_[i].v8 = *reinterpret_cast<const u32x4*>(Vt + (long)((k0) >> 6) * 8192 + tid * 16); \
    sr_[i].k8 = *reinterpret_cast<const u32x4*>(Kh + (long)((k0) + krow) * LDK + kch * 16); } while (0)
#define SWRITE(b, i) do { *(u32x4*)(V_lds + (b) * V8_TILE + vrow * V8_STRIDE + vch * 16) = sr_[i].v8; \
    *(u32x4*)(K_lds + (b) * K8_TILE + krow * K8_STRIDE + kch * 16) = sr_[i].k8; } while (0)
#define SWAIT() asm volatile("s_waitcnt vmcnt(2)" ::: "memory")
  f32x16 pA0, pA1, pB0, pB1; i32x8 pa; const int NT = seq / KVBLK;
  constexpr int SE = 0, SO = 1;
  SLOAD(SE, 0); asm volatile("s_waitcnt vmcnt(0)" ::: "memory"); SWRITE(0, SE); __syncthreads();
  qkt(pA0, pA1, K_lds, qr, r32, hi, cinit); partialSM(pA0, pA1);
  SLOAD(SO, KVBLK); SLOAD(SE, 2 * KVBLK);
  SWAIT(); SWRITE(1, SO); __syncthreads();
  for (int j = 1; j + 1 < NT; j += 2) {
    SBAR(); qkt(pB0, pB1, K_lds + K8_TILE, qr, r32, hi, cinit);
    finishSM(pA0, pA1, pa); SBAR();
    SLOAD(SO, (j + 2) * KVBLK); SBAR();
    pv_d0(o, ol, V_lds, pa, r32, hi); partialSM(pB0, pB1);
    __syncthreads(); SWAIT(); SWRITE(0, SE);
    __syncthreads();
    SBAR(); qkt(pA0, pA1, K_lds, qr, r32, hi, cinit);
    finishSM(pB0, pB1, pa); SBAR();
    SLOAD(SE, (j + 3 < NT ? j + 3 : NT - 1) * KVBLK); SBAR();
    pv_d0(o, ol, V_lds + V8_TILE, pa, r32, hi); partialSM(pA0, pA1);
    __syncthreads(); SWAIT(); SWRITE(1, SO);
    __syncthreads();
  }
  SBAR(); qkt(pB0, pB1, K_lds + K8_TILE, qr, r32, hi, cinit);
  finishSM(pA0, pA1, pa); SBAR();
  pv_d0(o, ol, V_lds, pa, r32, hi); partialSM(pB0, pB1);
  __syncthreads();
  finishSM(pB0, pB1, pa); SBAR();
  pv_d0(o, ol, V_lds + V8_TILE, pa, r32, hi);
  if (lse && r32 == 0) {
#pragma unroll
    for (int r = 0; r < 16; ++r) lse[(wid * QBLK + crow(r, hi)) * 4] = __logf(ol[r]) - mnC * 0.69314718055994531f; }
  float rli[16];
#pragma unroll
  for (int r = 0; r < 16; ++r) rli[r] = __builtin_amdgcn_rcpf(ol[r]);
  bf16_t* Ow = Ob + (long)(wid * QBLK) * LDO;
#pragma unroll
  for (int r = 0; r < 16; ++r) { int orow = crow(r, hi);
    for (int d0 = 0; d0 < 4; ++d0) Ow[(long)orow * LDO + d0 * 32 + r32] = (bf16_t)(pkbf(o[d0][r] * rli[r], 0.f) & 0xffffu); }
  __syncthreads();
#undef SLOAD
#undef SWRITE
#undef SWAIT
}
}

struct Args { const float* in[20]; float* out; unsigned char* ws; int ph_lo, ph_hi; };
typedef const __attribute__((address_space(4))) Args* KArgs;
__device__ __forceinline__ KArgs get_args() { KArgs p = (KArgs)__builtin_amdgcn_kernarg_segment_ptr(); asm volatile("" : "+s"(p)); return p; }
__device__ __forceinline__ int fresh_tid() { int t = threadIdx.x; asm volatile("" : "+v"(t)); return t; }
__device__ __forceinline__ int fresh_bx() { int t = blockIdx.x; asm volatile("" : "+s"(t)); return t; }
__device__ __forceinline__ int fresh_g() { int t = gridDim.x; asm volatile("" : "+s"(t)); return t; }
enum { I_X = 0, I_C, I_CTX, I_CCTX, I_ADAW, I_ADAB, I_N1W, I_N2W, I_WIN, I_QNW, I_KNW, I_CONVW, I_ALOG, I_DTB, I_DNW, I_WOUT, I_WQ, I_SUBK, I_U, I_V };

__device__ __forceinline__ void convert_tables(const float* U, const float* V, unsigned char* ws, int l, int wvi, int nwv, int lane, int rw_end = 2 * NEXP) {
    const float* us = U + (size_t)l * NEXP * 1024; const float* vs = V + (size_t)l * NEXP * 1024;
    const int set = l & 1;
    float* scl = (float*)(ws + WS_USC) + set * 2 * NEXP;
    for (int rw = wvi; rw < rw_end; rw += nwv) {
        const bool isu = rw < NEXP; const int e = isu ? rw : rw - NEXP;
        const f32x4* sp = (const f32x4*)((isu ? us : vs) + (size_t)e * 1024 + 16 * lane);
        f32x4 x[4]; float mx = 0.f;
#pragma unroll
        for (int i = 0; i < 4; ++i) { x[i] = sp[i]; mx = fmaxf(mx, fmaxf(fmaxf(fabsf(x[i][0]), fabsf(x[i][1])), fmaxf(fabsf(x[i][2]), fabsf(x[i][3])))); }
        mx = wave_max(mx);
        const float sc = fmaxf(mx, 1e-30f) * (1.f / 127.f), inv = 1.f / sc;
        u32x4 o4;
#pragma unroll
        for (int i = 0; i < 4; ++i) { const unsigned b0 = (unsigned)(int)(rintf(x[i][0] * inv) + 128.f), b1 = (unsigned)(int)(rintf(x[i][1] * inv) + 128.f), b2 = (unsigned)(int)(rintf(x[i][2] * inv) + 128.f), b3 = (unsigned)(int)(rintf(x[i][3] * inv) + 128.f);
            o4[i] = b0 | (b1 << 8) | (b2 << 16) | (b3 << 24); }
        *(u32x4*)(ws + WS_UB + (size_t)set * TAB_SET + (size_t)e * 2048 + (isu ? 0 : 1024) + 16 * lane) = o4;
        if (lane == 0) scl[rw] = sc;
    }
}

__device__ __forceinline__ void transpose_item(const float* W, int ldw, int K, bf16_t* WT, LAS float* scr, int kb, int nb, int lane) {
    const int k0 = 64 * kb, n0 = 32 * nb;
#pragma unroll 8
    for (int i = 0; i < 32; ++i) { const int kk = 2 * i + (lane >> 5); scr[kk * 33 + (lane & 31)] = W[(size_t)(k0 + kk) * ldw + n0 + (lane & 31)]; }
    LDS_WAIT(); asm volatile("" ::: "memory");
    const int c = lane & 7;
#pragma unroll
    for (int j = 0; j < 4; ++j) { const int n = (lane >> 3) + 8 * j; const LAS float* s = scr + (8 * c) * 33 + n;
        u32x4 o; o.x = pkbf(s[0 * 33], s[1 * 33]); o.y = pkbf(s[2 * 33], s[3 * 33]); o.z = pkbf(s[4 * 33], s[5 * 33]); o.w = pkbf(s[6 * 33], s[7 * 33]);
        *(u32x4*)(WT + (size_t)(n0 + n) * K + k0 + 8 * c) = o; }
    LDS_WAIT(); asm volatile("" ::: "memory");
}
__device__ __forceinline__ void phase_prologue(LAS unsigned char* lds) {
    const KArgs ap = get_args();
#define a (*ap)

    const int tid = fresh_tid(), lane = tid & 63, wave = __builtin_amdgcn_readfirstlane(tid >> 6), G = fresh_g(), bx = fresh_bx();
    unsigned char* ws = a.ws;
    {
        LAS float* sc = (LAS float*)(lds + 70000);
        LAS float* part = (LAS float*)(lds + 70000 + 12288);
        for (int i = tid; i < 3 * 1024; i += 512) { const int r = i >> 10, k = i & 1023; const float v = r < 2 ? a.in[I_C][r * 1024 + k] : a.in[I_CCTX][k]; sc[i] = silu_f(v); }
        __syncthreads();
        float* mod = (float*)(ws + WS_MOD);
        for (int item = bx; item < DEPTH * 96; item += G) {
            const int l = item / 96, j0 = (item % 96) * 64;
            const float* wp = a.in[I_ADAW] + (size_t)l * 1024 * 6144 + (size_t)(wave * 128) * 6144 + j0 + lane;
            float a0 = 0.f, a1 = 0.f, a2 = 0.f;
#pragma unroll 8
            for (int kk = 0; kk < 128; ++kk) { const float w = wp[(size_t)kk * 6144]; const int k = wave * 128 + kk; a0 = fmaf(sc[k], w, a0); a1 = fmaf(sc[1024 + k], w, a1); a2 = fmaf(sc[2048 + k], w, a2); }
            part[(wave * 3 + 0) * 64 + lane] = a0; part[(wave * 3 + 1) * 64 + lane] = a1; part[(wave * 3 + 2) * 64 + lane] = a2;
            __syncthreads();
            if (tid < 192) { const int r = tid >> 6, jj = tid & 63; float s = a.in[I_ADAB][l * 6144 + j0 + jj];
#pragma unroll
                for (int w = 0; w < 8; ++w) s += part[(w * 3 + r) * 64 + jj];
                mod[(size_t)(l * 3 + r) * 6144 + j0 + jj] = s; }
            __syncthreads();
        }
    }
    {
        const int gw = bx * 8 + wave, NGW = G * 8;
        unsigned* wmaxw = (unsigned*)(ws + WS_CTL) + CW_WMAX;
        constexpr int NB_IN = NP / 64, NB_OUT = 1024 / 64, NB_Q = 2048 / 64, PER_L2 = (NB_IN + NB_OUT + NB_Q) * 8;
        for (int it = gw; it < DEPTH * PER_L2; it += NGW) { const int l = it / PER_L2; int r = it % PER_L2; const int kc = r & 7; r >>= 3;
            const int mi = r < NB_IN ? 0 : r < NB_IN + NB_OUT ? 1 : 2; const int nb = mi == 0 ? r : mi == 1 ? r - NB_IN : r - NB_IN - NB_OUT; const int ldw = mi == 0 ? NIN : mi == 1 ? 1024 : 2048;
            const float* wp = (mi == 0 ? a.in[I_WIN] + (size_t)l * 1024 * NIN : mi == 1 ? a.in[I_WOUT] + (size_t)l * 1024 * 1024 : a.in[I_WQ] + (size_t)l * 1024 * 2048) + (size_t)(kc * 128) * ldw + nb * 64 + lane;
            float mx = 0.f;
#pragma unroll 8
            for (int kk = 0; kk < 128; ++kk) mx = fmaxf(mx, fabsf(wp[(size_t)kk * ldw]));
            atomicMax(wmaxw + (l * 3 + mi) * 3072 + nb * 64 + lane, __float_as_uint(mx)); }
    }
    const size_t gt = (size_t)bx * 512 + tid, NT = (size_t)G * 512;
    for (size_t i = gt; i < (size_t)DEPTH * 16 * 1024; i += NT) { const int l = (int)(i >> 14), j = (int)((i >> 10) & 15), k = (int)(i & 1023);
        ((float*)(ws + WS_WSK))[i] = a.in[I_WIN][(size_t)l * 1024 * NIN + (size_t)k * NIN + NP + j]; }
    convert_tables(a.in[I_U], a.in[I_V], ws, 0, bx * 8 + wave, G * 8, lane);
    for (size_t i = gt; i < (size_t)DEPTH * 8 * 2 * 128 * 128 / 2; i += NT) { const f32x2 x = ((const f32x2*)a.in[I_SUBK])[i]; ((unsigned*)(ws + WS_SKB))[i] = pkbf(x[0], x[1]); }
    for (size_t i = gt; i < 8192; i += NT) { const int pos = (int)(i >> 5), fi = (int)(i & 31);
        const float inv = exp2f(-(float)fi * (13.287712379549449f / 32.f)); const float ang = (float)pos * inv;
        float rev = ang * 0.15915494309189535f; rev -= floorf(rev);
        ((float*)(ws + WS_ROPE))[i] = __builtin_amdgcn_cosf(rev); ((float*)(ws + WS_ROPE))[8192 + i] = __builtin_amdgcn_sinf(rev); }
}


__device__ __forceinline__ void quant_transpose_item(const float* W, int ldw, signed char* WT, const unsigned* wmaxw, LAS float* scr, int kb, int nb, int lane) {
    const int k0 = 64 * kb, n0 = 32 * nb;
#pragma unroll 8
    for (int i = 0; i < 32; ++i) { const int kk = 2 * i + (lane >> 5); scr[kk * 33 + (lane & 31)] = W[(size_t)(k0 + kk) * ldw + n0 + (lane & 31)]; }
    LDS_WAIT(); asm volatile("" ::: "memory");
    const int n = lane >> 1, hf = lane & 1;
    const float mx = __uint_as_float(wmaxw[n0 + n]), inv = mx > 0.f ? 127.f / mx : 0.f;
    u32x4 o[2];
#pragma unroll
    for (int q = 0; q < 8; ++q) { unsigned w = 0u;
#pragma unroll
        for (int b = 0; b < 4; ++b) { const int kk = 32 * hf + 4 * q + b; w |= ((unsigned)(int)rintf(scr[kk * 33 + n] * inv) & 255u) << (8 * b); }
        o[q >> 2][q & 3] = w; }
    u32x4* dst = (u32x4*)(WT + (size_t)(n0 + n) * 1024 + k0 + 32 * hf);
    dst[0] = o[0]; dst[1] = o[1];
    LDS_WAIT(); asm volatile("" ::: "memory");
}
__device__ __forceinline__ void phase_quant_weights(LAS unsigned char* lds) {
    const KArgs ap = get_args();
#define a (*ap)
    const int tid = fresh_tid(), lane = tid & 63, wave = __builtin_amdgcn_readfirstlane(tid >> 6), G = fresh_g(), bx = fresh_bx();
    unsigned char* ws = a.ws;
    LAS float* scr = (LAS float*)(lds + 65536 + wave * 8448);
    const unsigned* wmaxw = (const unsigned*)(ws + WS_CTL) + CW_WMAX;
    constexpr int I_IN = 16 * 96, I_OUT = 16 * 32, I_Q = 16 * 64, PER_L = I_IN + I_OUT + I_Q;
    for (int it = bx * 8 + wave; it < DEPTH * PER_L; it += G * 8) { const int l = it / PER_L; int r = it % PER_L;
        if (r < I_IN) quant_transpose_item(a.in[I_WIN] + (size_t)l * 1024 * NIN, NIN, (signed char*)(ws + WS_WINT) + (size_t)l * NP * 1024, wmaxw + (l * 3 + 0) * 3072, scr, r / 96, r % 96, lane);
        else if (r < I_IN + I_OUT) { r -= I_IN; quant_transpose_item(a.in[I_WOUT] + (size_t)l * 1024 * 1024, 1024, (signed char*)(ws + WS_WOUTT) + (size_t)l * 1024 * 1024, wmaxw + (l * 3 + 1) * 3072, scr, r / 32, r % 32, lane); }
        else { r -= I_IN + I_OUT; quant_transpose_item(a.in[I_WQ] + (size_t)l * 1024 * 2048, 2048, (signed char*)(ws + WS_WQT) + (size_t)l * 2048 * 1024, wmaxw + (l * 3 + 2) * 3072, scr, r / 64, r % 64, lane); } }
#undef a
}

template <bool SK>
__device__ __forceinline__ void phase_norm(int l, int which, LAS unsigned char* lds) {
    const KArgs ap = get_args();
#define a (*ap)

    const int tid = fresh_tid(), lane = tid & 63, wave = __builtin_amdgcn_readfirstlane(tid >> 6), G = fresh_g(), bx = fresh_bx();
    unsigned char* ws = a.ws;
    LAS float* wsk = (LAS float*)lds;
    if (SK) { const float* src = (const float*)(ws + WS_WSK) + (size_t)l * 16384; for (int i = tid; i < 16384 / 4; i += 512) ((LAS f32x4*)wsk)[i] = ((const f32x4*)src)[i]; __syncthreads(); }
    const int nrows = (which == 1 && l == DEPTH - 1) ? ML : M;
    const float* nw = a.in[which ? I_N2W : I_N1W] + l * 1024;
    const float* modl = (const float*)(ws + WS_MOD) + (size_t)l * 3 * 6144;
    const int shoff = which ? 3072 : 0, scoff = which ? 4096 : 1024;
    f32x4 nwv[4];
#pragma unroll
    for (int j = 0; j < 4; ++j) nwv[j] = *(const f32x4*)(nw + 4 * lane + 256 * j);
    for (int row = wave * G + bx; row < nrows; row += G * 8) {
        const float* src; int mrow;
        if (row < ML) { src = ((l == 0 && which == 0) ? a.in[I_X] : a.out) + (size_t)row * D; mrow = row >= T ? 1 : 0; }
        else { src = ((l == 0 && which == 0) ? a.in[I_CTX] : (const float*)(ws + WS_CTXX)) + (size_t)(row - ML) * D; mrow = 2; }
        const float* md = modl + mrow * 6144;
        f32x4 v[4]; float ss = 0.f;
#pragma unroll
        for (int j = 0; j < 4; ++j) { v[j] = *(const f32x4*)(src + 4 * lane + 256 * j); ss += (v[j][0] * v[j][0] + v[j][1] * v[j][1]) + (v[j][2] * v[j][2] + v[j][3] * v[j][3]); }
        const float rstd = rsqrtf(wave_sum(ss) * (1.f / D) + EPS);
        signed char* hrow = (signed char*)(ws + WS_H) + (size_t)row * D;
        float hmx = 0.f;
#pragma unroll
        for (int j = 0; j < 4; ++j) { const f32x4 sc = *(const f32x4*)(md + scoff + 4 * lane + 256 * j), sh = *(const f32x4*)(md + shoff + 4 * lane + 256 * j);
            v[j] = v[j] * rstd * nwv[j] * (sc + 1.f) + sh; hmx = fmaxf(hmx, fmaxf(fmaxf(fabsf(v[j][0]), fabsf(v[j][1])), fmaxf(fabsf(v[j][2]), fabsf(v[j][3])))); }
        hmx = fmaxf(wave_max(hmx), 1e-30f);
        { const float hinv = 127.f / hmx;
#pragma unroll
          for (int j = 0; j < 4; ++j) *(unsigned*)(hrow + 4 * lane + 256 * j) = ((unsigned)(int)rintf(v[j][0] * hinv) & 255u) | (((unsigned)(int)rintf(v[j][1] * hinv) & 255u) << 8) | (((unsigned)(int)rintf(v[j][2] * hinv) & 255u) << 16) | (((unsigned)(int)rintf(v[j][3] * hinv) & 255u) << 24);
          if (lane == 0) ((float*)(ws + WS_GB))[row] = hmx * (1.f / 127.f); }
        if (SK) {
            float p[16];
#pragma unroll
            for (int c = 0; c < 16; ++c) { float q = 0.f;
#pragma unroll
                for (int j = 0; j < 4; ++j) { const f32x4 w = *(const LAS f32x4*)(wsk + c * 1024 + 4 * lane + 256 * j); q += (v[j][0] * w[0] + v[j][1] * w[1]) + (v[j][2] * w[2] + v[j][3] * w[3]); }
                p[c] = q; }
            { const bool hb = (lane & 32) != 0;
#pragma unroll
              for (int c = 0; c < 8; ++c) { const float keep = hb ? p[c + 8] : p[c], send = hb ? p[c] : p[c + 8]; p[c] = keep + lane_xor<32>(send); } }
            { const bool hb = (lane & 16) != 0;
#pragma unroll
              for (int c = 0; c < 4; ++c) { const float keep = hb ? p[c + 4] : p[c], send = hb ? p[c] : p[c + 4]; p[c] = keep + lane_xor<16>(send); } }
            { const bool hb = (lane & 8) != 0;
#pragma unroll
              for (int c = 0; c < 2; ++c) { const float keep = hb ? p[c + 2] : p[c], send = hb ? p[c] : p[c + 2]; p[c] = keep + lane_xor<8>(send); } }
            { const bool hb = (lane & 4) != 0; const float keep = hb ? p[1] : p[0], send = hb ? p[0] : p[1]; p[0] = keep + lane_xor<4>(send); }
            p[0] += lane_xor<2>(p[0]); p[0] += lane_xor<1>(p[0]);
            if ((lane & 3) == 0) { const int c = ((lane >> 5) & 1) * 8 + ((lane >> 4) & 1) * 4 + ((lane >> 3) & 1) * 2 + ((lane >> 2) & 1); ((float*)(ws + WS_BA))[(size_t)row * 16 + c] = p[0]; }
        }
    }
    if (SK) __syncthreads();
}

__device__ __forceinline__ void phase_prep(int l, LAS unsigned char* lds) {
    const KArgs ap = get_args();
#define a (*ap)

    const int tid = fresh_tid(), lane = tid & 63, wave = __builtin_amdgcn_readfirstlane(tid >> 6), G = fresh_g(), bx = fresh_bx();
    unsigned char* ws = a.ws;
    const bf16_t* P = (const bf16_t*)(ws + WS_P);
    const float* ropec = (const float*)(ws + WS_ROPE); const float* ropes = ropec + 8192;
    const int sec = lane >> 5, fi = lane & 31;
    const float qw0 = a.in[I_QNW][l * 128 + sec * 64 + fi], qw1 = a.in[I_QNW][l * 128 + sec * 64 + 32 + fi];
    const float kw0 = a.in[I_KNW][l * 128 + sec * 64 + fi], kw1 = a.in[I_KNW][l * 128 + sec * 64 + 32 + fi];
    for (int row = wave * G + bx; row < M; row += G * 8) {
        const bool lat = row < ML;
        int b, tt, tlen; if (lat) { b = row >> 14; tt = row & (T - 1); tlen = T; } else { b = (row - ML) >> 8; tt = (row - ML) & (CT - 1); tlen = CT; }
        const bf16_t* prow = P + (size_t)row * NP;
        unsigned short xa[6][2];
#pragma unroll
        for (int hh = 0; hh < 6; ++hh) { const bf16_t* xp = prow + (hh < 4 ? hh * 128 : 512 + (hh - 4) * 128) + sec * 64 + fi; xa[hh][0] = xp[0]; xa[hh][1] = xp[32]; }
        const u32x2 vcp = *(const u32x2*)(prow + 768 + 4 * lane);
        float cs = 1.f, sn = 0.f;
        if (lat) { const int pos = sec ? (tt & 63) : (tt >> 6); cs = ropec[pos * 32 + fi]; sn = ropes[pos * 32 + fi]; }
        unsigned char* qo8 = ws + WS_QA + (size_t)row * 512;
        const size_t kvrow = (size_t)b * KVLEN + (lat ? tt : T + tt);
        unsigned char* ko8 = ws + WS_KA + kvrow * 256;
        float ssq[6];
#pragma unroll
        for (int hh = 0; hh < 6; ++hh) { const float x0 = bf2f(xa[hh][0]), x1 = bf2f(xa[hh][1]); ssq[hh] = x0 * x0 + x1 * x1; }
#pragma unroll
        for (int hh = 0; hh < 6; ++hh) ssq[hh] = wave_sum(ssq[hh]);
#pragma unroll
        for (int hh = 0; hh < 6; ++hh) {
            const float x0 = bf2f(xa[hh][0]), x1 = bf2f(xa[hh][1]);
            const float rs = rsqrtf(ssq[hh] * (1.f / 128.f) + EPS);
            const float y0 = x0 * rs * (hh < 4 ? qw0 : kw0), y1 = x1 * rs * (hh < 4 ? qw1 : kw1);
            const float qsc = hh < 4 ? 0.088388347648318440f * 1.4426950408889634f : 1.f;
            const float o0 = (y0 * cs - y1 * sn) * qsc, o1 = (y1 * cs + y0 * sn) * qsc;
            unsigned char* op8 = (hh < 4 ? qo8 + hh * 128 : ko8 + (hh - 4) * 128) + sec * 64 + fi;
            const float f8s = hh < 4 ? 8.f : 1.f;
            const int pk8 = __builtin_amdgcn_cvt_pk_fp8_f32(o0 * f8s, o1 * f8s, 0, false);
            op8[0] = (unsigned char)(pk8 & 255); op8[32] = (unsigned char)((pk8 >> 8) & 255);
        }
        { const int pos = lat ? tt : T + tt, tile = pos >> 6, k64 = pos & 63, k32 = k64 & 31;
          const int bytepos = 32 * ((k32 >> 2) & 1) + 16 * (k64 >> 5) + (k32 & 3) + 4 * (k32 >> 3);
          unsigned char* vt = ws + WS_VA + ((size_t)(b * 2) * (KVLEN / 64) + tile) * 8192 + bytepos;
          const unsigned short* vsrc = (const unsigned short*)&vcp;
          const int kvh_ = lane >> 5, d0 = (4 * lane) & 127;
          const int pk01 = __builtin_amdgcn_cvt_pk_fp8_f32(bf2f(vsrc[0]), bf2f(vsrc[1]), 0, false), pk23 = __builtin_amdgcn_cvt_pk_fp8_f32(bf2f(vsrc[2]), bf2f(vsrc[3]), 0, false);
          unsigned char* vt2 = vt + (size_t)kvh_ * (KVLEN / 64) * 8192 + (size_t)d0 * 64;
          vt2[0] = (unsigned char)(pk01 & 255); vt2[64] = (unsigned char)((pk01 >> 8) & 255); vt2[128] = (unsigned char)(pk23 & 255); vt2[192] = (unsigned char)((pk23 >> 8) & 255); }
    }
    __syncthreads();
}

constexpr int ATT_PARTS = 4;
__device__ __forceinline__ void phase_attn(int l, unsigned char* lds_raw, volatile LAS unsigned* MISC, int rep) {
    const KArgs ap = get_args();
#define a (*ap)
    unsigned char* ws = a.ws;
    const unsigned char* QA = ws + WS_QA; const unsigned char* KA = ws + WS_KA; const unsigned char* VT = ws + WS_VA;
    bf16_t* CAT = (bf16_t*)(ws + WS_CAT); float* LSE = (float*)(ws + WS_BA);
    unsigned* ctr = (unsigned*)(ws + WS_CTL) + 8192 + 64 * l + 1024 * rep;
    const int natt = 2048 + (l < DEPTH - 1 ? 8 : 0);
    constexpr int CONV_ROWS = 64, NCONV = 2 * NEXP / CONV_ROWS;
    const int nunits = natt + (l + 1 < DEPTH ? NCONV : 0);
    float braw;
    { const int ln = threadIdx.x & 63; float mq = fmaxf(fabsf(a.in[I_QNW][l * 128 + ln]), fabsf(a.in[I_QNW][l * 128 + 64 + ln])), mk = fmaxf(fabsf(a.in[I_KNW][l * 128 + ln]), fabsf(a.in[I_KNW][l * 128 + 64 + ln]));
      mq = wave_max(mq); mk = wave_max(mk);
      braw = __builtin_bit_cast(float, __builtin_amdgcn_readfirstlane(__builtin_bit_cast(int, 128.f * mq * mk))); }
    if (threadIdx.x == 0) MISC[12] = __hip_atomic_fetch_add(ctr, 1u, __ATOMIC_RELAXED, __HIP_MEMORY_SCOPE_AGENT);
    __syncthreads();
    int u = (int)MISC[12], par = 0;
    for (; u < nunits; ) {
        if (threadIdx.x == 0) MISC[13 - par] = __hip_atomic_fetch_add(ctr, 1u, __ATOMIC_RELAXED, __HIP_MEMORY_SCOPE_AGENT);
        if (u >= natt) {
            const int rwb = (u - natt) * CONV_ROWS + (int)(threadIdx.x >> 6) * 8;
            convert_tables(a.in[I_U], a.in[I_V], ws, l + 1, rwb, 1, (int)(threadIdx.x & 63), rwb + 8);
            __syncthreads();
            u = (int)MISC[13 - par]; par ^= 1;
            continue;
        }
        size_t r0, kv0; int h, kvh, seq, ldo; bf16_t* ob; float* lse;
        if (u < 2048) { const int qb = u & 63, g = (u >> 6) & 1, part = (u >> 7) & 3, b = u >> 10; kvh = (u >> 9) & 1; h = kvh * 2 + g;
            const int t0 = (part >> 1) * 130 + (part & 1) * 64;
            r0 = (size_t)b * T + (size_t)qb * 256; kv0 = (size_t)b * KVLEN + (size_t)t0 * 64; seq = ((part & 1) ? 66 : 64) * 64;
            ob = part ? (bf16_t*)(ws + (part == 1 ? WS_DQ : part == 2 ? WS_DK : WS_DV)) + r0 * 512 + h * 128 : CAT + r0 * 1024 + h * 128; ldo = part ? 512 : 1024; lse = LSE + ((size_t)part * ML + r0) * 4 + h; }
        else { const int b = (u - 2048) >> 2; h = (u - 2048) & 3; kvh = h >> 1; r0 = (size_t)ML + (size_t)b * CT; kv0 = (size_t)b * KVLEN + T; seq = CT;
            ob = CAT + r0 * 1024 + h * 128; ldo = 1024; lse = nullptr; }
        att::attn_dense_body(QA + r0 * 512 + h * 128, KA + kv0 * 256 + kvh * 128, VT + ((size_t)((kv0 / KVLEN) * 2 + kvh) * (KVLEN / 64) + (kv0 % KVLEN) / 64) * 8192, ob, ldo, seq, (char*)lds_raw, lse, braw);
        u = (int)MISC[13 - par]; par ^= 1;
    }
#undef a
}

__device__ __forceinline__ int tokperm(int q, int hh, int jj) { return 16 * q + 8 * (jj >> 2) + 4 * hh + (jj & 3); }
__device__ __forceinline__ int crow16(int r, int hi) { return (r & 3) + 8 * (r >> 2) + 4 * hi; }
__device__ __forceinline__ int kperm16(int s_, int g, int jj) { return 32 * s_ + 16 * (jj >> 2) + 4 * g + (jj & 3); }
__device__ __forceinline__ int frag_off(int i, int j) {
    return (((i >> 4) * 2 + (j >> 5)) * 64 + ((i & 15) + 16 * ((j >> 2) & 3))) * 16 + (4 * ((j >> 4) & 1) + (j & 3)) * 2;
}
template <int MODE>
__device__ __forceinline__ void phase_dn_chunkprep(int l, LAS unsigned char* lds) {
    const KArgs ap = get_args();
#define a (*ap)
    const int tid = fresh_tid(), lane = tid & 63, wave = __builtin_amdgcn_readfirstlane(tid >> 6), G = fresh_g(), bx = fresh_bx();
    unsigned char* ws = a.ws;
    constexpr int KT_OFF = 0, QT_OFF = 17408, VT_OFF = 34816, GS_OFF = 52224, RS_OFF = 68864, AM_OFF = 85504, SC_OFF = 120320, IMG_OFF = 0;
    const int r = lane & 31, hh = lane >> 5;
    const bf16_t* DQ = (const bf16_t*)(ws + WS_DQ); const bf16_t* DK = (const bf16_t*)(ws + WS_DK); const bf16_t* DV = (const bf16_t*)(ws + WS_DV);
    const float* BA = (const float*)(ws + WS_BA);
    constexpr int NTASK = MODE ? NB * 4 * 4 : NB * 4 * (NCH - 4);
#define CP_TASKID(t_) (MODE ? ((t_) >> 2) * NCH + ((t_) & 3) : ((t_) >> 8) * NCH + 4 + ((t_) & 255))
    LAS float* gsc = (LAS float*)(lds + SC_OFF);
    LAS float* bsc = gsc + 128;
    LAS float* gcs = gsc + 256;
    constexpr int CW_OFF = 121856;
    LAS float* cwl = (LAS float*)(lds + CW_OFF);
    for (int i = tid; i < 5 * 1536; i += 512) cwl[i] = a.in[I_CONVW][(size_t)l * 5 * 1536 + i];
    __syncthreads();
    const bf16_t* P = (const bf16_t*)(ws + WS_P);
    u32x4 xin[3][5][2];
#define CP_LOADX(task_) do { const int cidx_ = (task_) % NCH, bh_ = (task_) / NCH, b_ = bh_ >> 2, h_ = bh_ & 3; \
        const int row0_ = cidx_ < 4 ? ML + b_ * CT + cidx_ * 64 : b_ * T + (cidx_ - 4) * 64, tt_ = (cidx_ < 4 ? cidx_ * 64 : (cidx_ - 4) * 64) + (tid >> 3), tlen_ = cidx_ < 4 ? CT : T; \
        _Pragma("unroll") for (int j = 0; j < 5; ++j) { const int t2 = tt_ + j - 2; const bool ok = t2 >= 0 && t2 < tlen_; \
            const bf16_t* xr = P + (size_t)(row0_ + (tid >> 3) + (ok ? j - 2 : 0)) * NP + 1024 + h_ * 128 + (tid & 7) * 16; \
            _Pragma("unroll") for (int m = 0; m < 3; ++m) { const u32x4 w0 = *(const u32x4*)(xr + m * 512), w1 = *(const u32x4*)(xr + m * 512 + 8); \
                xin[m][j][0] = ok ? w0 : (u32x4){0u, 0u, 0u, 0u}; xin[m][j][1] = ok ? w1 : (u32x4){0u, 0u, 0u, 0u}; } } } while (0)
    if (bx < NTASK) CP_LOADX(CP_TASKID(bx));
    for (int tk = bx; tk < NTASK; tk += G) {
        const int task = CP_TASKID(tk);
        const int cidx = task % NCH, bh = task / NCH, b = bh >> 2, h = bh & 3;
        const int row0 = cidx < 4 ? ML + b * CT + cidx * 64 : b * T + (cidx - 4) * 64;
        unsigned char* rec = ws + WS_REC + (size_t)task * REC_BYTES;
        {
            const int rr = tid >> 3, seg = tid & 7;
            if (tid < 128) { const int d = tid >> 6, i = tid & 63, dh = d * 4 + h;
                const float xb = BA[(size_t)(row0 + i) * 16 + dh], z = BA[(size_t)(row0 + i) * 16 + 8 + dh] + a.in[I_DTB][l * 8 + dh];
                bsc[tid] = 1.f / (1.f + __expf(-xb)); gsc[tid] = -__expf(a.in[I_ALOG][l * 8 + dh]) * (fmaxf(z, 0.f) + log1pf(__expf(-fabsf(z)))); }
#pragma unroll
            for (int m = 0; m < 3; ++m) {
                float y[16];
#pragma unroll
                for (int c = 0; c < 16; ++c) y[c] = 0.f;
#pragma unroll
                for (int j = 0; j < 5; ++j) { const LAS float* wp = cwl + j * 1536 + m * 512 + h * 128 + seg * 16;
#pragma unroll
                    for (int q4 = 0; q4 < 4; ++q4) { const f32x4 wv = *(const LAS f32x4*)(wp + 4 * q4); const unsigned u0 = xin[m][j][q4 >> 1][2 * (q4 & 1)], u1 = xin[m][j][q4 >> 1][2 * (q4 & 1) + 1];
                        y[4 * q4 + 0] = fmaf(bflo(u0), wv[0], y[4 * q4 + 0]); y[4 * q4 + 1] = fmaf(bfhi(u0), wv[1], y[4 * q4 + 1]); y[4 * q4 + 2] = fmaf(bflo(u1), wv[2], y[4 * q4 + 2]); y[4 * q4 + 3] = fmaf(bfhi(u1), wv[3], y[4 * q4 + 3]); } }
                float ss = 0.f;
#pragma unroll
                for (int c = 0; c < 16; ++c) { y[c] = silu_f(y[c]); ss = fmaf(y[c], y[c], ss); }
                if (m < 2) { ss += lane_xor<1>(ss); ss += lane_xor<2>(ss); ss += lane_xor<4>(ss);
                    float sc = rsqrtf(ss + EPS); if (m == 0) sc *= 0.088388347648318440f;
#pragma unroll
                    for (int c = 0; c < 16; ++c) y[c] *= sc; }
                u32x4 o0, o1; o0.x = pkbf(y[0], y[1]); o0.y = pkbf(y[2], y[3]); o0.z = pkbf(y[4], y[5]); o0.w = pkbf(y[6], y[7]); o1.x = pkbf(y[8], y[9]); o1.y = pkbf(y[10], y[11]); o1.z = pkbf(y[12], y[13]); o1.w = pkbf(y[14], y[15]);
                LAS unsigned char* dst = lds + (m == 0 ? QT_OFF : m == 1 ? KT_OFF : VT_OFF) + rr * 272 + seg * 32;
                *(LAS u32x4*)dst = o0; *(LAS u32x4*)(dst + 16) = o1;
            }
        }
        __syncthreads();
        {
            const int mat = wave >> 2, ti = (wave >> 1) & 1, tj = wave & 1;
            f32x16 acc = {};
#pragma unroll
            for (int ks = 0; ks < 8; ++ks) {
                const bf16x8 av = *(const LAS bf16x8*)(lds + (mat ? QT_OFF : KT_OFF) + (32 * ti + r) * 272 + (16 * ks + 8 * hh) * 2);
                const bf16x8 bv = *(const LAS bf16x8*)(lds + KT_OFF + (32 * tj + r) * 272 + (16 * ks + 8 * hh) * 2);
                acc = __builtin_amdgcn_mfma_f32_32x32x16_bf16(av, bv, acc, 0, 0, 0);
            }
            LAS float* dst = (LAS float*)(lds + (mat ? RS_OFF : GS_OFF));
#pragma unroll
            for (int i = 0; i < 16; ++i) dst[(32 * ti + crow16(i, hh)) * 65 + 32 * tj + r] = acc[i];
        }
        { const int r16 = lane & 15, g4 = lane >> 4;
#pragma unroll
        for (int t = 0; t < 2; ++t) { const int f = wave * 2 + t, mt = f >> 2, sk = f & 3;
            { const u32x2 lo = *(const LAS u32x2*)(lds + KT_OFF + (16 * mt + r16) * 272 + (32 * sk + 4 * g4) * 2), hi2 = *(const LAS u32x2*)(lds + KT_OFF + (16 * mt + r16) * 272 + (32 * sk + 16 + 4 * g4) * 2);
              *(u32x4*)(rec + REC_K + f * 1024 + lane * 16) = (u32x4){lo.x, lo.y, hi2.x, hi2.y}; }
            { const u32x2 lo = *(const LAS u32x2*)(lds + QT_OFF + (16 * mt + r16) * 272 + (32 * sk + 4 * g4) * 2), hi2 = *(const LAS u32x2*)(lds + QT_OFF + (16 * mt + r16) * 272 + (32 * sk + 16 + 4 * g4) * 2);
              *(u32x4*)(rec + REC_Q + f * 1024 + lane * 16) = (u32x4){lo.x, lo.y, hi2.x, hi2.y}; } }
#pragma unroll
        for (int t = 0; t < 2; ++t) { const int f = wave * 2 + t, mt = f >> 1, sk = f & 1;
            unsigned e[8];
#pragma unroll
            for (int jj = 0; jj < 8; ++jj) e[jj] = *(const LAS unsigned short*)(lds + KT_OFF + kperm16(sk, g4, jj) * 272 + (16 * mt + r16) * 2);
            *(u32x4*)(rec + REC_KT + f * 1024 + lane * 16) = (u32x4){e[0] | (e[1] << 16), e[2] | (e[3] << 16), e[4] | (e[5] << 16), e[6] | (e[7] << 16)}; }
        { const int sl = wave;
            unsigned e[16];
#pragma unroll
            for (int i = 0; i < 16; ++i) e[i] = *(const LAS unsigned short*)(lds + VT_OFF + (16 * (i >> 2) + 4 * g4 + (i & 3)) * 272 + (16 * sl + r16) * 2);
            u32x4* vp = (u32x4*)(rec + REC_V + sl * 2048 + lane * 32);
            vp[0] = (u32x4){e[0] | (e[1] << 16), e[2] | (e[3] << 16), e[4] | (e[5] << 16), e[6] | (e[7] << 16)};
            vp[1] = (u32x4){e[8] | (e[9] << 16), e[10] | (e[11] << 16), e[12] | (e[13] << 16), e[14] | (e[15] << 16)}; }
        }
        if (tk + G < NTASK) CP_LOADX(CP_TASKID(tk + G));
        if (wave < 2) { const int d = wave; float gv = gsc[d * 64 + (d ? 63 - lane : lane)];
            gv += __builtin_bit_cast(float, __builtin_amdgcn_update_dpp(0, __builtin_bit_cast(int, gv), 0x111, 0xF, 0xF, true));
            gv += __builtin_bit_cast(float, __builtin_amdgcn_update_dpp(0, __builtin_bit_cast(int, gv), 0x112, 0xF, 0xF, true));
            gv += __builtin_bit_cast(float, __builtin_amdgcn_update_dpp(0, __builtin_bit_cast(int, gv), 0x114, 0xF, 0xF, true));
            gv += __builtin_bit_cast(float, __builtin_amdgcn_update_dpp(0, __builtin_bit_cast(int, gv), 0x118, 0xF, 0xF, true));
            { const float t0 = __builtin_bit_cast(float, __builtin_amdgcn_readlane(__builtin_bit_cast(int, gv), 15)), t1 = __builtin_bit_cast(float, __builtin_amdgcn_readlane(__builtin_bit_cast(int, gv), 31)), t2 = __builtin_bit_cast(float, __builtin_amdgcn_readlane(__builtin_bit_cast(int, gv), 47));
              const int rw_ = lane >> 4; gv += (rw_ >= 1 ? t0 : 0.f) + (rw_ >= 2 ? t1 : 0.f) + (rw_ >= 3 ? t2 : 0.f); }
            gcs[d * 64 + lane] = gv; }
        __syncthreads();
        const LAS float* Gs = (const LAS float*)(lds + GS_OFF); const LAS float* Rs = (const LAS float*)(lds + RS_OFF);
#pragma unroll 4
        for (int t = 0; t < 16; ++t) { const int e = tid + 512 * t, d = e >> 12, jp = (e >> 6) & 63, ip = e & 63;
            const int in_ = d ? 63 - ip : ip, jn = d ? 63 - jp : jp;
            const float dec = __expf(fminf(gcs[d * 64 + ip] - gcs[d * 64 + jp], 0.f));
            const float av = (jp < ip) ? bsc[d * 64 + in_] * Gs[in_ * 65 + jn] * dec : 0.f;
            ((LAS float*)(lds + AM_OFF))[d * 4352 + jp * 68 + ip] = av;
            const float qk = (jp <= ip) ? Rs[in_ * 65 + jn] * dec : 0.f;
            *(LAS unsigned short*)(lds + IMG_OFF + d * 16384 + 8192 + frag_off(in_, jn)) = (unsigned short)(pkbf(qk, 0.f) & 0xffffu); }
        __syncthreads();
        if (wave < 2) { const int d = wave, c = lane, jn = d ? 63 - c : c; const float bj = bsc[d * 64 + jn];
            const LAS float* At = (const LAS float*)(lds + AM_OFF) + d * 4352;
            LAS float* Xm = (LAS float*)(lds + GS_OFF) + d * 4096 + c;
            const int fj = (jn >> 5) * 1024 + ((jn >> 2) & 3) * 256 + ((jn >> 4) & 1) * 8 + (jn & 3) * 2;
#pragma unroll 1
            for (int B = 0; B < 4; ++B) {
                float acc[16];
#pragma unroll
                for (int q = 0; q < 16; ++q) acc[q] = (16 * B + q == c) ? 1.f : 0.f;
#pragma unroll 4
                for (int j = 0; j < 16 * B; ++j) { const float xj = Xm[j * 64];
                    const f32x4 a0 = *(const LAS f32x4*)(At + j * 68 + 16 * B), a1 = *(const LAS f32x4*)(At + j * 68 + 16 * B + 4), a2 = *(const LAS f32x4*)(At + j * 68 + 16 * B + 8), a3 = *(const LAS f32x4*)(At + j * 68 + 16 * B + 12);
#pragma unroll
                    for (int q = 0; q < 4; ++q) { acc[q] = fmaf(-a0[q], xj, acc[q]); acc[4 + q] = fmaf(-a1[q], xj, acc[4 + q]); acc[8 + q] = fmaf(-a2[q], xj, acc[8 + q]); acc[12 + q] = fmaf(-a3[q], xj, acc[12 + q]); } }
#pragma unroll
                for (int r2 = 0; r2 < 15; ++r2) { const LAS float* ar = At + (16 * B + r2) * 68 + 16 * B; const float xr = acc[r2];
#pragma unroll
                    for (int q4 = (r2 + 1) / 4; q4 < 4; ++q4) { const f32x4 a4 = *(const LAS f32x4*)(ar + 4 * q4);
#pragma unroll
                        for (int q = 0; q < 4; ++q) if (4 * q4 + q > r2) acc[4 * q4 + q] = fmaf(-a4[q], xr, acc[4 * q4 + q]); } }
#pragma unroll
                for (int q = 0; q < 16; ++q) { const int i = 16 * B + q, in_ = d ? 63 - i : i; Xm[i * 64] = acc[q];
                    *(LAS unsigned short*)(lds + IMG_OFF + d * 16384 + (in_ >> 4) * 2048 + (in_ & 15) * 16 + fj) = (unsigned short)(pkbf(acc[q] * bj, 0.f) & 0xffffu); }
            }
        } else if (wave < 4) { const int d = wave - 2, ip = d ? 63 - lane : lane; const float gl = gcs[d * 64 + 63], gi = gcs[d * 64 + ip];
            float* sc = (float*)(rec + REC_DIR + d * REC_DIRSZ + 16384);
            sc[lane] = __expf(gi); sc[64 + lane] = __expf(gl - gi); if (lane == 0) sc[128] = __expf(gl); }
        __syncthreads();
#pragma unroll
        for (int t = 0; t < 4; ++t) { const int p = tid + 512 * t, d = p >> 10, off = (p & 1023) * 16;
            *(u32x4*)(rec + REC_DIR + d * REC_DIRSZ + off) = *(const LAS u32x4*)(lds + IMG_OFF + d * 16384 + off); }
        __syncthreads();
    }
#undef CP_LOADX
#undef CP_TASKID
#undef a
}

__device__ __forceinline__ bf16x8 pack44(const f32x4& lo, const f32x4& hi) {
    u32x4 p; p.x = pkbf_c(lo[0], lo[1]); p.y = pkbf_c(lo[2], lo[3]); p.z = pkbf_c(hi[0], hi[1]); p.w = pkbf_c(hi[2], hi[3]);
    return __builtin_bit_cast(bf16x8, p);
}
template <int VAR>
__device__ __forceinline__ void phase_dn_scan(int l, LAS unsigned char* lds) {
    const KArgs ap = get_args();
#define a (*ap)
    const int tid = fresh_tid(), lane = tid & 63, wave = __builtin_amdgcn_readfirstlane(tid >> 6), bx = fresh_bx();
    unsigned char* ws = a.ws;
    if (bx >= 32) return;
    const int chain = bx >> 1, half = bx & 1, b = chain >> 3, h = (chain >> 1) & 3, dir = chain & 1;
    const unsigned char* recb = ws + WS_REC + (size_t)((b * 4 + h) * NCH) * REC_BYTES;
    constexpr int BUFSZ = 74752;
#define CIDX(n) (dir ? ((n) < 4 ? 3 - (n) : 263 - (n)) : (n))
    if (wave >= 4) {
        const int sw = wave - 4;
#define DN_PIECE(i_) ((sw + 4 * (i_)) < 73 ? (sw + 4 * (i_)) : 72)
#define DN_SRC(rec_, p_) ((p_) < 48 ? (rec_) + (p_) * 1024 : (p_) < 65 ? (rec_) + REC_DIR + dir * REC_DIRSZ + ((p_) - 48) * 1024 : (rec_) + REC_V + half * 8192 + ((p_) - 65) * 1024)
#define DN_STAGE(n, bi) do { const unsigned char* rec_ = recb + (size_t)CIDX(n) * REC_BYTES; _Pragma("unroll") for (int i_ = 0; i_ < 19; ++i_) { const int p_ = DN_PIECE(i_); \
        __builtin_amdgcn_global_load_lds((const unsigned*)(DN_SRC(rec_, p_) + lane * 16), (LAS unsigned*)(lds + (bi) * BUFSZ + p_ * 1024), 16, 0, 0); } } while (0)
#define DN_SYNC() do { asm volatile("s_waitcnt vmcnt(0)" ::: "memory"); __builtin_amdgcn_s_barrier(); asm volatile("" ::: "memory"); } while (0)
        if (VAR != 3) DN_STAGE(0, 0);
        DN_SYNC();
        for (int n = 0; n < NCH; ++n) {
            if (VAR != 3 && n + 1 < NCH) DN_STAGE(n + 1, (n + 1) & 1);
            DN_SYNC();
        }
#undef DN_STAGE
#undef DN_PIECE
#undef DN_SRC
#undef DN_SYNC
    } else {
        const int sl = half * 4 + wave, c16 = lane & 15, g4 = lane >> 4;
        float* Og = (float*)(ws + (dir ? WS_OB : WS_OF)) + h * 128 + sl * 16 + c16;
        f32x4 S[8];
#pragma unroll
        for (int i = 0; i < 8; ++i) S[i] = (f32x4){0.f, 0.f, 0.f, 0.f};
        asm volatile("s_waitcnt lgkmcnt(0)" ::: "memory"); __builtin_amdgcn_s_barrier(); asm volatile("" ::: "memory");
        for (int n = 0; n < NCH; ++n) {
            if (VAR == 2) { asm volatile("s_waitcnt lgkmcnt(0)" ::: "memory"); __builtin_amdgcn_s_barrier(); asm volatile("" ::: "memory"); continue; }
            const LAS unsigned char* buf = lds + (n & 1) * BUFSZ;
            const int cidx = CIDX(n);
            const u32x4 vc0 = *(const LAS u32x4*)(buf + 66560 + wave * 2048 + lane * 32), vc1 = *(const LAS u32x4*)(buf + 66560 + wave * 2048 + lane * 32 + 16);
#define FR(off, f) (*(const LAS bf16x8*)(buf + (off) + (f) * 1024 + lane * 16))
#define MF(A, B, C) __builtin_amdgcn_mfma_f32_16x16x32_bf16((A), (B), (C), 0, 0, 0)
#define SB_() __builtin_amdgcn_sched_barrier(0)
            bf16x8 fa[8], fb[8];
            f32x4 eg[4], dl[4];
#pragma unroll
            for (int mt = 0; mt < 4; ++mt) { eg[mt] = *(const LAS f32x4*)(buf + 65536 + (16 * mt + 4 * g4) * 4); dl[mt] = *(const LAS f32x4*)(buf + 65536 + 256 + (16 * mt + 4 * g4) * 4); }
            const float egl = *(const LAS float*)(buf + 65536 + 512);
#define RD_KQ(dst, q) do { _Pragma("unroll") for (int mt = 0; mt < 4; ++mt) { dst[mt] = FR(0, mt * 4 + (q)); dst[4 + mt] = FR(32768, mt * 4 + (q)); } } while (0)
#define MM_KQ(src, q) do { _Pragma("unroll") for (int mt = 0; mt < 4; ++mt) { X[mt] = MF(src[mt], Sb[q], X[mt]); O[mt] = MF(src[4 + mt], Sb[q], O[mt]); } } while (0)
            f32x4 X[4], O[4], VN[4];
#pragma unroll
            for (int i = 0; i < 4; ++i) { X[i] = (f32x4){0.f, 0.f, 0.f, 0.f}; O[i] = (f32x4){0.f, 0.f, 0.f, 0.f}; VN[i] = (f32x4){0.f, 0.f, 0.f, 0.f}; }
            bf16x8 Sb[4];
#pragma unroll
            for (int q = 0; q < 4; ++q) Sb[q] = pack44(S[2 * q], S[2 * q + 1]);
            RD_KQ(fa, 0); SB_();
            RD_KQ(fb, 1); SB_(); MM_KQ(fa, 0); SB_();
            RD_KQ(fa, 2); SB_(); MM_KQ(fb, 1); SB_();
            RD_KQ(fb, 3); SB_(); MM_KQ(fa, 2); SB_();
#pragma unroll
            for (int i = 0; i < 8; ++i) fa[i] = FR(49152, i);
            SB_(); MM_KQ(fb, 3); SB_();
#pragma unroll
            for (int mt = 0; mt < 4; ++mt) { const unsigned w0 = (mt < 2 ? vc0 : vc1)[2 * (mt & 1)], w1 = (mt < 2 ? vc0 : vc1)[2 * (mt & 1) + 1];
                X[mt][0] = bflo(w0) - eg[mt][0] * X[mt][0]; X[mt][1] = bfhi(w0) - eg[mt][1] * X[mt][1]; X[mt][2] = bflo(w1) - eg[mt][2] * X[mt][2]; X[mt][3] = bfhi(w1) - eg[mt][3] * X[mt][3]; }
            const bf16x8 Yb0 = pack44(X[0], X[1]), Yb1 = pack44(X[2], X[3]);
            SB_();
#pragma unroll
            for (int i = 0; i < 8; ++i) fb[i] = FR(57344, i);
            SB_();
#pragma unroll
            for (int mt = 0; mt < 4; ++mt) { VN[mt] = MF(fa[mt * 2], Yb0, VN[mt]); VN[mt] = MF(fa[mt * 2 + 1], Yb1, VN[mt]); }
            SB_();
#pragma unroll
            for (int mt = 0; mt < 4; ++mt) O[mt] = O[mt] * eg[mt];
            const bf16x8 Vb0 = pack44(VN[0], VN[1]), Vb1 = pack44(VN[2], VN[3]);
            SB_();
#pragma unroll
            for (int i = 0; i < 8; ++i) fa[i] = FR(16384, i);
            SB_();
#pragma unroll
            for (int mt = 0; mt < 4; ++mt) { O[mt] = MF(fb[mt * 2], Vb0, O[mt]); O[mt] = MF(fb[mt * 2 + 1], Vb1, O[mt]); }
            SB_();
#pragma unroll
            for (int mt = 0; mt < 4; ++mt) VN[mt] = VN[mt] * dl[mt];
            const bf16x8 Vd0 = pack44(VN[0], VN[1]), Vd1 = pack44(VN[2], VN[3]);
#pragma unroll
            for (int i = 0; i < 8; ++i) S[i] = S[i] * egl;
            SB_();
#pragma unroll
            for (int i = 0; i < 8; ++i) fb[i] = FR(16384, 8 + i);
            SB_();
#pragma unroll
            for (int i = 0; i < 4; ++i) { S[i] = MF(fa[i * 2], Vd0, S[i]); S[i] = MF(fa[i * 2 + 1], Vd1, S[i]); }
            SB_();
#pragma unroll
            for (int i = 0; i < 4; ++i) { S[4 + i] = MF(fb[i * 2], Vd0, S[4 + i]); S[4 + i] = MF(fb[i * 2 + 1], Vd1, S[4 + i]); }
            SB_();
            {
                const int row0 = cidx < 4 ? ML + b * CT + cidx * 64 : b * T + (cidx - 4) * 64;
                float* op = Og + (size_t)(row0 + 4 * g4) * 512;
#pragma unroll
                for (int mt = 0; mt < 4; ++mt)
#pragma unroll
                    for (int t = 0; t < 4; ++t) { if (VAR != 1) op[(size_t)(16 * mt + t) * 512] = O[mt][t]; else asm volatile("" :: "v"(O[mt][t])); }
            }
#undef RD_KQ
#undef MM_KQ
#undef SB_
#undef FR
#undef MF
            asm volatile("s_waitcnt lgkmcnt(0)" ::: "memory"); __builtin_amdgcn_s_barrier(); asm volatile("" ::: "memory");
        }
    }
#undef CIDX
#undef a
}

__device__ __forceinline__ void phase_dn_out(int l) {
    const KArgs ap = get_args();
#define a (*ap)

    const int tid = fresh_tid(), lane = tid & 63, wave = __builtin_amdgcn_readfirstlane(tid >> 6), G = fresh_g(), bx = fresh_bx();
    unsigned char* ws = a.ws;
    const int nrows = (l == DEPTH - 1) ? ML : M;
    const float* OF = (const float*)(ws + WS_OF); const float* OB = (const float*)(ws + WS_OB);
    const bf16_t* P = (const bf16_t*)(ws + WS_P); bf16_t* CAT = (bf16_t*)(ws + WS_CAT);
    const f32x2 nw = *(const f32x2*)(a.in[I_DNW] + l * 128 + 2 * lane);
    const float* LSE = (const float*)(ws + WS_BA);
    for (int row = wave * G + bx; row < nrows; row += G * 8) {
        f32x2 of[4], ob[4]; unsigned gw[4];
#pragma unroll
        for (int hh = 0; hh < 4; ++hh) { of[hh] = *(const f32x2*)(OF + (size_t)row * 512 + hh * 128 + 2 * lane); ob[hh] = *(const f32x2*)(OB + (size_t)row * 512 + hh * 128 + 2 * lane);
            gw[hh] = *(const unsigned*)(P + (size_t)row * NP + 2560 + hh * 128 + 2 * lane); }
        u32x4 ap_[4]; float ls_[4];
#pragma unroll
        for (int p = 0; p < 4; ++p) { ap_[p] = (u32x4){0u, 0u, 0u, 0u}; ls_[p] = 0.f; }
        if (row < ML) {
            ap_[0] = *(const u32x4*)(CAT + (size_t)row * 1024 + 8 * lane); ap_[1] = *(const u32x4*)((const bf16_t*)(ws + WS_DQ) + (size_t)row * 512 + 8 * lane);
            ap_[2] = *(const u32x4*)((const bf16_t*)(ws + WS_DK) + (size_t)row * 512 + 8 * lane); ap_[3] = *(const u32x4*)((const bf16_t*)(ws + WS_DV) + (size_t)row * 512 + 8 * lane);
#pragma unroll
            for (int p = 0; p < 4; ++p) ls_[p] = LSE[((size_t)p * ML + row) * 4 + (lane >> 4)]; }
        float o0[4], o1[4], ssq[4];
#pragma unroll
        for (int hh = 0; hh < 4; ++hh) { o0[hh] = of[hh][0] + ob[hh][0]; o1[hh] = of[hh][1] + ob[hh][1]; ssq[hh] = o0[hh] * o0[hh] + o1[hh] * o1[hh]; }
#pragma unroll
        for (int hh = 0; hh < 4; ++hh) ssq[hh] = wave_sum(ssq[hh]);
        float mxv = 0.f;
#pragma unroll
        for (int hh = 0; hh < 4; ++hh) { const float rs = rsqrtf(ssq[hh] * (1.f / 128.f) + EPS); const float g0 = bflo(gw[hh]), g1 = bfhi(gw[hh]);
            o0[hh] = o0[hh] * rs * nw[0] * silu_f(g0); o1[hh] = o1[hh] * rs * nw[1] * silu_f(g1); mxv = fmaxf(mxv, fmaxf(fabsf(o0[hh]), fabsf(o1[hh]))); }
        float av[8];
        if (row < ML) { const float mx = fmaxf(fmaxf(ls_[0], ls_[1]), fmaxf(ls_[2], ls_[3]));
            float w_[4], wsum = 0.f;
#pragma unroll
            for (int p = 0; p < 4; ++p) { w_[p] = __expf(ls_[p] - mx); wsum += w_[p]; }
            const float inv = 1.f / wsum;
#pragma unroll
            for (int i = 0; i < 4; ++i) { float lo = 0.f, hi2 = 0.f;
#pragma unroll
                for (int p = 0; p < 4; ++p) { lo = fmaf(w_[p], bflo(ap_[p][i]), lo); hi2 = fmaf(w_[p], bfhi(ap_[p][i]), hi2); }
                av[2 * i] = lo * inv; av[2 * i + 1] = hi2 * inv; } }
        else { const u32x4 cw_ = *(const u32x4*)(CAT + (size_t)row * 1024 + 8 * lane);
#pragma unroll
            for (int i = 0; i < 4; ++i) { av[2 * i] = bflo(cw_[i]); av[2 * i + 1] = bfhi(cw_[i]); } }
#pragma unroll
        for (int i = 0; i < 8; ++i) mxv = fmaxf(mxv, fabsf(av[i]));
        mxv = fmaxf(wave_max(mxv), 1e-30f);
        const float cinv = 127.f / mxv;
        signed char* crow = (signed char*)(ws + WS_CATQ) + (size_t)row * 1024;
#define Q8_(x) ((unsigned)(int)rintf((x) * cinv) & 255u)
        { u32x2 o; o.x = Q8_(av[0]) | (Q8_(av[1]) << 8) | (Q8_(av[2]) << 16) | (Q8_(av[3]) << 24); o.y = Q8_(av[4]) | (Q8_(av[5]) << 8) | (Q8_(av[6]) << 16) | (Q8_(av[7]) << 24); *(u32x2*)(crow + 8 * lane) = o; }
#pragma unroll
        for (int hh = 0; hh < 4; ++hh) *(unsigned short*)(crow + 512 + hh * 128 + 2 * lane) = (unsigned short)(Q8_(o0[hh]) | (Q8_(o1[hh]) << 8));
#undef Q8_
        if (lane == 0) ((float*)(ws + WS_GB))[(1u << 18) + row] = mxv * (1.f / 127.f);
    }
#undef a
}

#define CE_DESC(a_, b_) do { const float hi_ = fmaxf(a_, b_), lo_ = fminf(a_, b_); a_ = hi_; b_ = lo_; } while (0)
__device__ __forceinline__ void bitonic_sort16_desc(float (&v)[16]) {
#pragma unroll
    for (int k = 2; k <= 16; k <<= 1)
#pragma unroll
        for (int j = k >> 1; j > 0; j >>= 1)
#pragma unroll
            for (int i = 0; i < 16; ++i) { const int p = i ^ j; if (p > i) { if ((i & k) == 0) CE_DESC(v[i], v[p]); else CE_DESC(v[p], v[i]); } }
}
__device__ __forceinline__ void merge_top16_desc(float (&lst)[16], const float (&nw)[16]) {
#pragma unroll
    for (int i = 0; i < 16; ++i) lst[i] = fmaxf(lst[i], nw[15 - i]);
#pragma unroll
    for (int j = 8; j > 0; j >>= 1)
#pragma unroll
        for (int i = 0; i < 16; ++i) { const int p = i ^ j; if (p > i) CE_DESC(lst[i], lst[p]); }
}
__device__ __forceinline__ void phase_peer_select(int l) {
    const KArgs ap = get_args();
#define a (*ap)
    const int tid = fresh_tid(), lane = tid & 63, wave = __builtin_amdgcn_readfirstlane(tid >> 6), G = fresh_g(), bx = fresh_bx();
    unsigned char* ws = a.ws;
    const int nrows = (l == DEPTH - 1) ? ML : M;
    const int ntask = (nrows / 32) * 4;
    const bf16_t* Q2 = (const bf16_t*)(ws + WS_P);
    const bf16_t* SKB = (const bf16_t*)(ws + WS_SKB) + (size_t)l * 8 * 2 * 128 * 128;
    int* PIDX = (int*)(ws + WS_PIDX); float* PGATE = (float*)(ws + WS_PGATE);
    const float NEG = -3.0e38f;
    const int r = lane & 31, hi = lane >> 5;
    for (int task = wave * G + bx; task < ntask; task += G * 8) {
        const int tg = task >> 2, hp = task & 3; const int row = tg * 32 + r;
        float mine0[16], mine1[16];
#pragma unroll
        for (int j = 0; j < 16; ++j) { mine0[j] = NEG; mine1[j] = NEG; }
        bf16x8 qA[8], kA[8];
        float lst[16];
#define SEL_QPTR(it_) (Q2 + (size_t)row * 2048 + (2 * hp + ((it_) >> 1)) * 256 + ((it_) & 1) * 128 + 8 * hi)
#define SEL_KPTR(it_, t_) (SKB + (size_t)(((2 * hp + ((it_) >> 1)) * 2 + ((it_) & 1)) * 128 + 32 * (t_) + r) * 128 + 8 * hi)
#define SEL_LDQ(dst, it_) do { const bf16_t* qp_ = SEL_QPTR(it_); _Pragma("unroll") for (int ks = 0; ks < 8; ++ks) dst[ks] = *(const bf16x8*)(qp_ + 16 * ks); } while (0)
#define SEL_LDK(dst, it_, t_) do { const bf16_t* kp_ = SEL_KPTR(it_, t_); _Pragma("unroll") for (int ks = 0; ks < 8; ++ks) dst[ks] = *(const bf16x8*)(kp_ + 16 * ks); } while (0)
#define SEL_RANK(qv, kv, t_) do { f32x16 acc = {}; _Pragma("unroll") for (int ks = 0; ks < 8; ++ks) acc = __builtin_amdgcn_mfma_f32_32x32x16_bf16(kv[ks], qv[ks], acc, 0, 0, 0); \
            const unsigned kb = (unsigned)(32 * (t_) + 4 * hi); float nw_[16]; \
            _Pragma("unroll") for (int i = 0; i < 16; ++i) nw_[i] = __uint_as_float((__float_as_uint(acc[i]) & 0xffffff80u) | (kb + (unsigned)((i & 3) + 8 * (i >> 2)))); \
            bitonic_sort16_desc(nw_); merge_top16_desc(lst, nw_); } while (0)
#define SB_() __builtin_amdgcn_sched_barrier(0)
#pragma unroll
        for (int j = 0; j < 16; ++j) lst[j] = NEG;
#pragma unroll 1
        for (int it = 0; it < 4; ++it) {
            SEL_LDQ(qA, it);
#pragma unroll 1
            for (int t = 0; t < 4; ++t) { SEL_LDK(kA, it, t); SEL_RANK(qA, kA, t); }
            float oth[16];
#pragma unroll
            for (int j = 0; j < 16; ++j) { auto rr = __builtin_amdgcn_permlane32_swap(__float_as_uint(lst[j]), __float_as_uint(lst[j]), false, false); oth[j] = __uint_as_float(hi ? rr[0] : rr[1]); }
            merge_top16_desc(lst, oth);
            const bool k0 = ((it >> 1) == hi) && ((it & 1) == 0), k1 = ((it >> 1) == hi) && ((it & 1) == 1);
#pragma unroll
            for (int j = 0; j < 16; ++j) { mine0[j] = k0 ? lst[j] : mine0[j]; mine1[j] = k1 ? lst[j] : mine1[j]; lst[j] = NEG; }
        }
#undef SB_
#undef SEL_QPTR
#undef SEL_KPTR
#undef SEL_LDQ
#undef SEL_LDK
#undef SEL_RANK
        const int h = 2 * hp + hi;
        float ts[16];
#pragma unroll
        for (int j = 0; j < 16; ++j) ts[j] = NEG;
#pragma unroll
        for (int i = 0; i < 16; ++i)
#pragma unroll
            for (int j = 0; j < 16; ++j) if ((i + 1) * (j + 1) <= 16) {
                const unsigned b0 = __float_as_uint(mine0[i]), b1 = __float_as_uint(mine1[j]);
                const float c = __uint_as_float(b0 & 0xffffff80u) + __uint_as_float(b1 & 0xffffff80u);
                float x = __uint_as_float((__float_as_uint(c) & 0xffffc000u) | ((b0 & 127u) << 7) | (b1 & 127u));
#pragma unroll
                for (int t = 0; t < 16; ++t) { const float hv = fmaxf(ts[t], x); x = fminf(ts[t], x); ts[t] = hv; }
            }
        int te[16]; float ex[16], sum = 0.f;
        const float tmax = __uint_as_float(__float_as_uint(ts[0]) & 0xffffc000u);
#pragma unroll
        for (int t = 0; t < 16; ++t) { const unsigned bt = __float_as_uint(ts[t]); te[t] = (int)(bt & 0x3fffu); ex[t] = __expf(__uint_as_float(bt & 0xffffc000u) - tmax); sum += ex[t]; }
        const float inv = 1.f / sum;
        int* ip = PIDX + (size_t)row * 128 + h * 16; float* gp = PGATE + (size_t)row * 128 + h * 16;
#pragma unroll
        for (int t = 0; t < 16; t += 4) { *(u32x4*)(ip + t) = (u32x4){(unsigned)te[t], (unsigned)te[t + 1], (unsigned)te[t + 2], (unsigned)te[t + 3]}; *(f32x4*)(gp + t) = (f32x4){ex[t] * inv, ex[t + 1] * inv, ex[t + 2] * inv, ex[t + 3] * inv}; }
    }
#undef a
}

template <bool WR, int GV = 0>
__device__ __forceinline__ void phase_peer_gather(int l, LAS unsigned char* lds) {
    const KArgs ap = get_args();
#define a (*ap)
    const int tid = fresh_tid(), lane = tid & 63, wave = __builtin_amdgcn_readfirstlane(tid >> 6), G = fresh_g(), bx = fresh_bx();
    unsigned char* ws = a.ws;
    const int nrows = (l == DEPTH - 1) ? ML : M;
    const unsigned char* UB = ws + WS_UB + (size_t)(l & 1) * TAB_SET; const unsigned char* VB = UB + 1024;
    const float* USC = (const float*)(ws + WS_USC) + (l & 1) * 2 * NEXP; const float* VSC = USC + NEXP;
    const int* PIDX = (const int*)(ws + WS_PIDX); const float* PGATE = (const float*)(ws + WS_PGATE);
    const float* modl = (const float*)(ws + WS_MOD) + (size_t)l * 3 * 6144 + 5120;
    const bool fuse = WR && (l + 1 < DEPTH);
    LAS float* wsk = (LAS float*)lds;
    if (fuse) { const float* src = (const float*)(ws + WS_WSK) + (size_t)(l + 1) * 16384; for (int i = tid; i < 16384 / 4; i += 512) ((LAS f32x4*)wsk)[i] = ((const f32x4*)src)[i]; __syncthreads(); }
    const float* nw1 = a.in[I_N1W] + (l + 1 < DEPTH ? l + 1 : l) * 1024 + 16 * lane;
    const float* modn = (const float*)(ws + WS_MOD) + (size_t)(l + 1 < DEPTH ? l + 1 : l) * 3 * 6144;
    for (int row = wave * G + bx; row < nrows; row += G * 8) {
        float hv[16], out[16];
        { const u32x4 hw = *(const u32x4*)((const signed char*)(ws + WS_H) + (size_t)row * D + 16 * lane); const float hsc = ((const float*)(ws + WS_GB))[row];
#pragma unroll
          for (int q = 0; q < 4; ++q) { const int w = (int)hw[q]; hv[4 * q + 0] = (float)((w << 24) >> 24) * hsc; hv[4 * q + 1] = (float)((w << 16) >> 24) * hsc; hv[4 * q + 2] = (float)((w << 8) >> 24) * hsc; hv[4 * q + 3] = (float)(w >> 24) * hsc; } }
        float hs = 0.f;
#pragma unroll
        for (int i = 0; i < 16; ++i) { out[i] = 0.f; hs += hv[i]; }
        const float hsum128 = 128.f * wave_sum(hs);
        float wacc = 0.f;
        const int id0 = PIDX[(size_t)row * 128 + lane], id1 = PIDX[(size_t)row * 128 + 64 + lane];
        const float gt0 = PGATE[(size_t)row * 128 + lane], gt1 = PGATE[(size_t)row * 128 + 64 + lane];
        const float us0 = USC[id0], us1 = USC[id1], vs0 = VSC[id0], vs1 = VSC[id1];
        for (int e0 = 0; e0 < 128; e0 += 8) {
            u32x4 uw[8], vw[8]; float gte[8], use[8], vse[8];
#pragma unroll
            for (int j = 0; j < 8; ++j) { const int e = e0 + j; const int id = __builtin_amdgcn_readlane(e0 < 64 ? id0 : id1, e & 63);
                gte[j] = __builtin_bit_cast(float, __builtin_amdgcn_readlane(__builtin_bit_cast(int, e0 < 64 ? gt0 : gt1), e & 63));
                use[j] = __builtin_bit_cast(float, __builtin_amdgcn_readlane(__builtin_bit_cast(int, e0 < 64 ? us0 : us1), e & 63));
                vse[j] = __builtin_bit_cast(float, __builtin_amdgcn_readlane(__builtin_bit_cast(int, e0 < 64 ? vs0 : vs1), e & 63));
                uw[j] = *(const u32x4*)(UB + (size_t)id * 2048 + 16 * lane); vw[j] = *(const u32x4*)(VB + (size_t)id * 2048 + 16 * lane); }
#pragma unroll
            for (int j = 0; j < 8; ++j) {
                float d0 = 0.f, d1 = 0.f;
#pragma unroll
                for (int q = 0; q < 4; ++q) { const unsigned w = uw[j][q];
                    d0 = fmaf((float)(w & 255u), hv[4 * q + 0], d0); d1 = fmaf((float)((w >> 8) & 255u), hv[4 * q + 1], d1);
                    d0 = fmaf((float)((w >> 16) & 255u), hv[4 * q + 2], d0); d1 = fmaf((float)(w >> 24), hv[4 * q + 3], d1); }
                const float dsum = (wave_sum(d0 + d1) - hsum128) * use[j];
                const float act = 0.5f * dsum * (1.f + erff(dsum * 0.70710678118654752f));
                const float wgt = gte[j] * act * vse[j];
                wacc += wgt;
                if (GV == 1) { asm volatile("" :: "v"(vw[j])); out[0] += wgt; } else
#pragma unroll
                for (int q = 0; q < 4; ++q) { const unsigned w = vw[j][q];
                    out[4 * q + 0] = fmaf(wgt, (float)(w & 255u), out[4 * q + 0]); out[4 * q + 1] = fmaf(wgt, (float)((w >> 8) & 255u), out[4 * q + 1]);
                    out[4 * q + 2] = fmaf(wgt, (float)((w >> 16) & 255u), out[4 * q + 2]); out[4 * q + 3] = fmaf(wgt, (float)(w >> 24), out[4 * q + 3]); }
            }
        }
        const float corr = 128.f * wacc;
        float* xr; int mrow;
        if (row < ML) { xr = a.out + (size_t)row * D; mrow = row >= T ? 1 : 0; } else { xr = (float*)(ws + WS_CTXX) + (size_t)(row - ML) * D; mrow = 2; }
        const float* g2 = modl + mrow * 6144 + 16 * lane;
        f32x4 xn[4];
#pragma unroll
        for (int i = 0; i < 4; ++i) { const f32x4 x = *(const f32x4*)(xr + 16 * lane + 4 * i), g = *(const f32x4*)(g2 + 4 * i);
            xn[i] = x + g * (f32x4){out[4 * i] - corr, out[4 * i + 1] - corr, out[4 * i + 2] - corr, out[4 * i + 3] - corr};
            if (WR) *(f32x4*)(xr + 16 * lane + 4 * i) = xn[i]; else asm volatile("" :: "v"(xn[i])); }
        if (fuse) {
            float ss = 0.f;
#pragma unroll
            for (int i = 0; i < 4; ++i) ss += (xn[i][0] * xn[i][0] + xn[i][1] * xn[i][1]) + (xn[i][2] * xn[i][2] + xn[i][3] * xn[i][3]);
            const float rstd = rsqrtf(wave_sum(ss) * (1.f / D) + EPS);
            const float* md = modn + mrow * 6144 + 16 * lane;
#pragma unroll
            for (int i = 0; i < 4; ++i) { const f32x4 nwv = *(const f32x4*)(nw1 + 4 * i), sc = *(const f32x4*)(md + 1024 + 4 * i), sh = *(const f32x4*)(md + 4 * i);
                xn[i] = xn[i] * rstd * nwv * (sc + 1.f) + sh; }
            { float hmx = 0.f;
#pragma unroll
              for (int i = 0; i < 4; ++i) hmx = fmaxf(hmx, fmaxf(fmaxf(fabsf(xn[i][0]), fabsf(xn[i][1])), fmaxf(fabsf(xn[i][2]), fabsf(xn[i][3]))));
              hmx = fmaxf(wave_max(hmx), 1e-30f); const float hinv = 127.f / hmx;
              u32x4 o;
#pragma unroll
              for (int i = 0; i < 4; ++i) o[i] = ((unsigned)(int)rintf(xn[i][0] * hinv) & 255u) | (((unsigned)(int)rintf(xn[i][1] * hinv) & 255u) << 8) | (((unsigned)(int)rintf(xn[i][2] * hinv) & 255u) << 16) | (((unsigned)(int)rintf(xn[i][3] * hinv) & 255u) << 24);
              *(u32x4*)((signed char*)(ws + WS_H) + (size_t)row * D + 16 * lane) = o;
              if (lane == 0) ((float*)(ws + WS_GB))[row] = hmx * (1.f / 127.f); }
            float p[16];
#pragma unroll
            for (int c = 0; c < 16; ++c) { float q = 0.f;
#pragma unroll
                for (int i = 0; i < 4; ++i) { const f32x4 w = *(const LAS f32x4*)(wsk + c * 1024 + 16 * lane + 4 * i); q += (xn[i][0] * w[0] + xn[i][1] * w[1]) + (xn[i][2] * w[2] + xn[i][3] * w[3]); }
                p[c] = q; }
            { const bool hb = (lane & 32) != 0;
#pragma unroll
              for (int c = 0; c < 8; ++c) { const float keep = hb ? p[c + 8] : p[c], send = hb ? p[c] : p[c + 8]; p[c] = keep + lane_xor<32>(send); } }
            { const bool hb = (lane & 16) != 0;
#pragma unroll
              for (int c = 0; c < 4; ++c) { const float keep = hb ? p[c + 4] : p[c], send = hb ? p[c] : p[c + 4]; p[c] = keep + lane_xor<16>(send); } }
            { const bool hb = (lane & 8) != 0;
#pragma unroll
              for (int c = 0; c < 2; ++c) { const float keep = hb ? p[c + 2] : p[c], send = hb ? p[c] : p[c + 2]; p[c] = keep + lane_xor<8>(send); } }
            { const bool hb = (lane & 4) != 0; const float keep = hb ? p[1] : p[0], send = hb ? p[0] : p[1]; p[0] = keep + lane_xor<4>(send); }
            p[0] += lane_xor<2>(p[0]); p[0] += lane_xor<1>(p[0]);
            if ((lane & 3) == 0) { const int c = ((lane >> 5) & 1) * 8 + ((lane >> 4) & 1) * 4 + ((lane >> 3) & 1) * 2 + ((lane >> 2) & 1); ((float*)(ws + WS_BA))[(size_t)row * 16 + c] = p[0]; }
        }
    }
    if (fuse) __syncthreads();
}
#undef a
__global__ void __launch_bounds__(512, 2) fwd(Args a) {
    extern __shared__ __attribute__((aligned(16))) unsigned char lds_raw[];
    LAS unsigned char* lds = (LAS unsigned char*)lds_raw;
    volatile LAS unsigned* MISC = (volatile LAS unsigned*)(lds + LDS_MISC);
    if (threadIdx.x < 16) MISC[threadIdx.x] = 0u;
    __syncthreads();
    XcdBarrier bar; bar.bar = (unsigned*)(a.ws + WS_CTL) + 4096; bar.x = 0; bar.st = MISC + 8;
    bar = xcd_barrier_post((unsigned*)(a.ws + WS_CTL) + 4096, MISC + 8);
#ifndef PHASE_MASK
#define PHASE_MASK 0x1FFF
#endif
#define EN(i) ((PHASE_MASK >> (i)) & 1)
#ifndef REP_MASK
#define REP_MASK 0
#endif
#define REPN(i) (1 + ((REP_MASK >> (i)) & 1))
#define IN(k) true
#define SEAM(k) do { XcdBarrier b_; b_.bar = (unsigned*)(get_args()->ws + WS_CTL) + 4096; b_.x = xb_xcc_id(); b_.st = (volatile LAS unsigned*)(lds + LDS_MISC) + 8; xcd_barrier(b_); } while (0)
    for (int rep_ = 0; rep_ < (REPN(0)); ++rep_) if (EN(0) && IN(0)) phase_prologue(lds);
    SEAM(0);
#pragma unroll 1
    for (int l_ = 0; l_ < DEPTH; ++l_) {
        int l = l_; asm volatile("" : "+s"(l));
        const int pb = 1 + l * NPH_L;
        const int mrows = (l == DEPTH - 1) ? ML : M;
        if (l == 0) { for (int rep_ = 0; rep_ < (REPN(1)); ++rep_) if (EN(1) && IN(pb + 0)) { phase_norm<true>(l, 0, lds); phase_quant_weights(lds); }
            SEAM(pb + 0); }
        for (int rep_ = 0; rep_ < (REPN(2)); ++rep_) if (EN(2) && IN(pb + 1)) { const KArgs ap = get_args(); unsigned char* ws = ap->ws; pg8::Gemm g{(const bf16_t*)(ws + WS_H), (const bf16_t*)((const signed char*)(ws + WS_WINT) + (size_t)l * NP * 1024), M, NP, 512}; pg8::StaticOrder S; S.init(M, NP, fresh_g(), fresh_bx());
            pg8::EpiBf16I8 E{(bf16_t*)(ws + WS_P), NP, (const float*)(ws + WS_GB), (const float*)(ws + WS_CTL) + CW_WMAX + (l * 3 + 0) * 3072}; pg8::gemm_phase(lds, g, S, E); }
        SEAM(pb + 1);
        for (int rep_ = 0; rep_ < (REPN(3)); ++rep_) if (EN(3) && IN(pb + 2)) { phase_dn_chunkprep<1>(l, lds); phase_prep(l, lds); }
        for (int rep_ = 0; rep_ < (REPN(4)); ++rep_) if (EN(4) && IN(pb + 3)) phase_dn_chunkprep<0>(l, lds);
        SEAM(pb + 3);
        for (int rep_ = 0; rep_ < (REPN(5)); ++rep_) if (EN(5) && IN(pb + 4)) { phase_dn_scan<0>(l, lds); __syncthreads(); phase_attn(l, lds_raw, MISC, rep_); }
        SEAM(pb + 4);
        for (int rep_ = 0; rep_ < (REPN(7)); ++rep_) if (EN(7) && IN(pb + 5)) phase_dn_out(l);
        SEAM(pb + 5);
        if (EN(8) && IN(pb + 6)) { const KArgs ap = get_args(); unsigned char* ws = ap->ws; pg8::Gemm g{(const bf16_t*)(ws + WS_CATQ), (const bf16_t*)((const signed char*)(ws + WS_WOUTT) + (size_t)l * 1024 * 1024), mrows, 1024, 512}; pg8::StaticOrder S; S.init(mrows, 1024, fresh_g(), fresh_bx());
            pg8::EpiResI8 E{l == 0 ? ap->in[I_X] : ap->out, l == 0 ? ap->in[I_CTX] : (const float*)(ws + WS_CTXX), ap->out, (float*)(ws + WS_CTXX), (const float*)(ws + WS_MOD) + (size_t)l * 3 * 6144 + 2048,
                              (const float*)(ws + WS_GB) + (1u << 18), (const float*)(ws + WS_CTL) + CW_WMAX + (l * 3 + 1) * 3072};
            pg8::gemm_phase(lds, g, S, E); }
        SEAM(pb + 6);
        for (int rep_ = 0; rep_ < (REPN(9)); ++rep_) if (EN(9) && IN(pb + 7)) phase_norm<false>(l, 1, lds);
        SEAM(pb + 7);
        for (int rep_ = 0; rep_ < (REPN(10)); ++rep_) if (EN(10) && IN(pb + 8)) { const KArgs ap = get_args(); unsigned char* ws = ap->ws; pg8::Gemm g{(const bf16_t*)(ws + WS_H), (const bf16_t*)((const signed char*)(ws + WS_WQT) + (size_t)l * 2048 * 1024), mrows, 2048, 512}; pg8::StaticOrder S; S.init(mrows, 2048, fresh_g(), fresh_bx());
            pg8::EpiBf16I8 E{(bf16_t*)(ws + WS_P), 2048, (const float*)(ws + WS_GB), (const float*)(ws + WS_CTL) + CW_WMAX + (l * 3 + 2) * 3072}; pg8::gemm_phase(lds, g, S, E); }
        SEAM(pb + 8);
        for (int rep_ = 0; rep_ < (REPN(11)); ++rep_) if (EN(11) && IN(pb + 9)) phase_peer_select(l);
        SEAM(pb + 9);
        #ifdef GATHER_VAR
        if (EN(12) && IN(pb + 10)) phase_peer_gather<false, GATHER_VAR>(l, lds);
#endif
        if (REPN(12) > 1 && EN(12) && IN(pb + 10)) phase_peer_gather<false>(l, lds);
        if (EN(12) && IN(pb + 10)) phase_peer_gather<true>(l, lds);
        if (l + 1 < DEPTH) SEAM(pb + 10);
    }
#undef IN
#undef SEAM
}

#ifndef N_LAUNCH_MODE
#define N_LAUNCH_MODE 1
#endif
extern "C" void kernel_launch(void* const* d_in, const int* in_sizes, int n_in, void* d_out, int out_size, void* d_ws, size_t ws_size, hipStream_t stream) {
    static int grid = 0;
    if (grid == 0) {
        if (n_in != 20 || out_size != ML * D || ws_size < WS_END) { fprintf(stderr, "kernel_launch: unexpected shapes: n_in %d out %d ws %zu (need %zu)\n", n_in, out_size, ws_size, (size_t)WS_END); grid = -1; return; }
        int dev = 0, cus = 0, per_cu = 0;
        if (hipGetDevice(&dev) != hipSuccess || hipDeviceGetAttribute(&cus, hipDeviceAttributeMultiprocessorCount, dev) != hipSuccess) { grid = -1; return; }
        if (hipFuncSetAttribute((const void*)fwd, hipFuncAttributeMaxDynamicSharedMemorySize, LDS_BYTES) != hipSuccess) { fprintf(stderr, "kernel_launch: hipFuncSetAttribute failed\n"); grid = -1; return; }
        if (hipOccupancyMaxActiveBlocksPerMultiprocessor(&per_cu, (const void*)fwd, 512, LDS_BYTES) != hipSuccess || per_cu < 1) fprintf(stderr, "kernel_launch: occupancy query says %d\n", per_cu);
        (void)hipGetLastError();
        grid = cus;
    }
    if (grid < 0) return;
    (void)hipMemsetAsync((char*)d_ws + WS_CTL, 0, CTL_BYTES, stream);
    Args a{};
    for (int i = 0; i < 20; ++i) a.in[i] = (const float*)d_in[i];
    a.out = (float*)d_out; a.ws = (unsigned char*)d_ws;
    a.ph_lo = 0; a.ph_hi = NPHASE;
    hipLaunchKernelGGL(fwd, dim3(grid), dim3(512), LDS_BYTES, stream, a);
    const hipError_t le = hipPeekAtLastError();
    if (le != hipSuccess) fprintf(stderr, "kernel_launch: launch failed: %s\n", hipGetErrorName(le));
}
```

```cpp
#include <hip/hip_runtime.h>
#ifndef GATHER_PART
#define GATHER_PART 1
#endif
#include <cstdio>
#include <cstdint>

#define GAS __attribute__((address_space(1)))
#define LAS __attribute__((address_space(3)))
typedef unsigned short bf16_t;
typedef short bf16x8 __attribute__((ext_vector_type(8)));
typedef short s16x4 __attribute__((ext_vector_type(4)));
typedef float f32x4 __attribute__((ext_vector_type(4)));
typedef float f32x2 __attribute__((ext_vector_type(2)));
typedef float f32x16 __attribute__((ext_vector_type(16)));
typedef unsigned u32x4 __attribute__((ext_vector_type(4)));
typedef unsigned u32x2 __attribute__((ext_vector_type(2)));
typedef int i32x4 __attribute__((ext_vector_type(4)));

constexpr int D = 1024, NB = 2, T = 16384, DEPTH = 4, CT = 256;
constexpr int ML = NB * T, MC = NB * CT, M = ML + MC;
constexpr int NIN = 3088, NP = 3072;
constexpr int KVLEN = T + CT;
constexpr int NEXP = 16384;
constexpr float EPS = 1e-6f;
constexpr int NPH_L = 11;
constexpr int NPHASE = 1 + DEPTH * NPH_L;

constexpr size_t MiB = 1u << 20;
constexpr size_t WS_CTL = 0, CTL_BYTES = 1 * MiB;
constexpr size_t WS_MOD = 1 * MiB;
constexpr size_t WS_ROPE = 2 * MiB;
constexpr size_t WS_WSK = 3 * MiB;
constexpr size_t WS_CTXX = 4 * MiB;
constexpr size_t WS_WINT = 8 * MiB;
constexpr size_t WS_WOUTT = 32 * MiB;
constexpr size_t WS_WQT = 40 * MiB;
constexpr size_t WS_SKB = 56 * MiB;
constexpr size_t WS_USC = 58 * MiB;
constexpr size_t WS_UB = 64 * MiB;
constexpr size_t WS_VB = 80 * MiB;
constexpr size_t TAB_SET = 32 * MiB;
constexpr size_t WS_H = 128 * MiB;
static_assert(WS_H + 2 * (size_t)M * 1024 <= 193 * MiB, "H + concat int8");
constexpr size_t WS_CATQ = WS_H + (size_t)M * 1024;
constexpr size_t WS_P = 193 * MiB;
constexpr size_t WS_QA = 388 * MiB;
constexpr size_t WS_KA = 421 * MiB;
constexpr size_t WS_VA = 438 * MiB;
constexpr size_t WS_CAT = 455 * MiB;
constexpr size_t WS_DQ = 520 * MiB;
constexpr size_t WS_DK = 553 * MiB;
constexpr size_t WS_DV = 586 * MiB;
constexpr size_t WS_OF = 619 * MiB;
constexpr size_t WS_OB = 684 * MiB;
constexpr size_t WS_GB = 749 * MiB;
constexpr size_t WS_BA = 752 * MiB;
constexpr size_t WS_PIDX = 755 * MiB;
constexpr size_t WS_PGATE = 772 * MiB;
constexpr size_t WS_REC = 789 * MiB;
constexpr size_t WS_END = 990 * MiB;
constexpr int CW_WMAX = 65536;
constexpr int NCH = 260;
constexpr int REC_K = 0, REC_KT = 16384, REC_Q = 32768, REC_V = 49152, REC_DIR = 65536, REC_DIRSZ = 17408, REC_BYTES = REC_DIR + 2 * REC_DIRSZ;
static_assert((size_t)NB * 4 * NCH * REC_BYTES + WS_REC <= WS_END, "rec region");

constexpr int LDS_BYTES = 163840;
constexpr int LDS_MISC = 163840 - 256;

__device__ __forceinline__ float bf2f(unsigned b) { return __uint_as_float(b << 16); }
__device__ __forceinline__ float bflo(unsigned w) { return __uint_as_float(w << 16); }
__device__ __forceinline__ float bfhi(unsigned w) { return __uint_as_float(w & 0xffff0000u); }
typedef __bf16 bf2v __attribute__((ext_vector_type(2)));
__device__ __forceinline__ unsigned pkbf(float lo, float hi) { unsigned r; asm("v_cvt_pk_bf16_f32 %0, %1, %2" : "=v"(r) : "v"(lo), "v"(hi)); return r; }
__device__ __forceinline__ unsigned pkbf_c(float lo, float hi) { f32x2 v = {lo, hi}; bf2v r = __builtin_convertvector(v, bf2v); return __builtin_bit_cast(unsigned, r); }
template <int K> __device__ __forceinline__ float lane_xor(float v) {
    const int b = __builtin_bit_cast(int, v);
    if constexpr (K == 1) return __builtin_bit_cast(float, __builtin_amdgcn_update_dpp(0, b, 0xB1, 0xF, 0xF, true));
    else if constexpr (K == 2) return __builtin_bit_cast(float, __builtin_amdgcn_update_dpp(0, b, 0x4E, 0xF, 0xF, true));
    else if constexpr (K == 32) { auto rr = __builtin_amdgcn_permlane32_swap((unsigned)b, (unsigned)b, false, false); unsigned ln_ = __builtin_amdgcn_mbcnt_hi(~0u, __builtin_amdgcn_mbcnt_lo(~0u, 0u)); asm volatile("" : "+v"(ln_));
        return __uint_as_float((ln_ & 32u) ? rr[0] : rr[1]); }
    else return __builtin_bit_cast(float, __builtin_amdgcn_ds_swizzle(b, 0x1F | (K << 10)));
}
__device__ __forceinline__ float wave_sum(float v) {
    v += lane_xor<1>(v); v += lane_xor<2>(v);
    v += __builtin_bit_cast(float, __builtin_amdgcn_update_dpp(0, __builtin_bit_cast(int, v), 0x124, 0xF, 0xF, true));
    v += __builtin_bit_cast(float, __builtin_amdgcn_update_dpp(0, __builtin_bit_cast(int, v), 0x128, 0xF, 0xF, true));
    v += lane_xor<16>(v);
    { auto rr = __builtin_amdgcn_permlane32_swap(__float_as_uint(v), __float_as_uint(v), false, false); v = __uint_as_float(rr[0]) + __uint_as_float(rr[1]); }
    return v;
}
__device__ __forceinline__ float wave_max(float v) {
    v = fmaxf(v, lane_xor<1>(v)); v = fmaxf(v, lane_xor<2>(v));
    v = fmaxf(v, __builtin_bit_cast(float, __builtin_amdgcn_update_dpp(0, __builtin_bit_cast(int, v), 0x124, 0xF, 0xF, true)));
    v = fmaxf(v, __builtin_bit_cast(float, __builtin_amdgcn_update_dpp(0, __builtin_bit_cast(int, v), 0x128, 0xF, 0xF, true)));
    v = fmaxf(v, lane_xor<16>(v));
    { auto rr = __builtin_amdgcn_permlane32_swap(__float_as_uint(v), __float_as_uint(v), false, false); v = fmaxf(__uint_as_float(rr[0]), __uint_as_float(rr[1])); }
    return v;
}
__device__ __forceinline__ float silu_f(float x) { return x / (1.f + __expf(-x)); }
#define LDS_WAIT() asm volatile("s_waitcnt lgkmcnt(0)" ::: "memory")

#define XB_TMO      128
#define XB_XCNT(j)  (256  + 64 * (j))
#define XB_XSUB(j)  (1280 + 64 * (j))
#define XB_XGEN(j)  (2304 + 64 * (j))
#define XB_TOP      3328
#define XB_TOPGEN   3392
#define XCD_BAR_WORDS 3456
#define XB_SPIN_CAP (1u << 22)
__device__ __forceinline__ unsigned xb_ld(unsigned* p)              { return __hip_atomic_load(p, __ATOMIC_RELAXED, __HIP_MEMORY_SCOPE_AGENT); }
__device__ __forceinline__ unsigned xb_add(unsigned* p, unsigned v) { return __hip_atomic_fetch_add(p, v, __ATOMIC_RELAXED, __HIP_MEMORY_SCOPE_AGENT); }
__device__ __forceinline__ unsigned xb_xcc_id() { return (unsigned)__builtin_amdgcn_s_getreg((3 << 11) | 20) & 0xFu; }
#define XB_SPIN(cond, bar) do { unsigned _sp = 0; while (cond) { __builtin_amdgcn_s_sleep(1); \
    if ((++_sp & 255u) == 0u) { if (xb_ld(&(bar)[XB_TMO])) break; if (_sp > XB_SPIN_CAP) { atomicAdd(&(bar)[XB_TMO], 1u); break; } } } } while (0)
struct XcdBarrier { unsigned* bar; unsigned x; volatile LAS unsigned* st; };
__device__ __forceinline__ XcdBarrier xcd_barrier_post(unsigned* bar, volatile LAS unsigned* st) {
    XcdBarrier b; b.bar = bar; b.x = xb_xcc_id(); b.st = st;
    if (threadIdx.x == 0) (void)xb_add(&bar[XB_XCNT(b.x)], 1u);
    return b;
}
__device__ __forceinline__ void xcd_barrier_complete(unsigned* bar, unsigned x, unsigned& nloc, unsigned& nx) {
    const unsigned G = gridDim.x * gridDim.y * gridDim.z;
    unsigned sum, cnt, mine, sp = 0u;
    for (;;) {
        sum = 0u; cnt = 0u; mine = 0u;
#pragma unroll
        for (unsigned j = 0; j < 16; ++j) { const unsigned c = xb_ld(&bar[XB_XCNT(j)]); sum += c; cnt += (c > 0u) ? 1u : 0u; mine = (j == x) ? c : mine; }
        if (sum == G) break;
        __builtin_amdgcn_s_sleep(1);
        if ((++sp & 255u) == 0u) { if (xb_ld(&bar[XB_TMO])) break; if (sp > XB_SPIN_CAP) { atomicAdd(&bar[XB_TMO], 1u); break; } }
    }
    nloc = mine > 0u ? mine : 1u; nx = cnt > 0u ? cnt : 1u;
}
__device__ __forceinline__ void xcd_barrier(const XcdBarrier& b) {
    asm volatile("s_waitcnt vmcnt(0)" ::: "memory");
    __syncthreads();
    if (threadIdx.x == 0) {
        unsigned* bar = b.bar; unsigned bx_ = b.x;
        asm volatile("" : "+s"(bar), "+s"(bx_));
        __builtin_amdgcn_s_waitcnt(0);
        unsigned nloc = b.st[0], nx = b.st[1];
        if (nloc == 0u) { xcd_barrier_complete(bar, bx_, nloc, nx); b.st[0] = nloc; b.st[1] = nx; }
        const unsigned old = xb_add(&bar[XB_XSUB(bx_)], 1u);
        const unsigned gen = old / nloc;
        if (old + 1u == (gen + 1u) * nloc) {
            __builtin_amdgcn_fence(__ATOMIC_RELEASE, "agent");
            asm volatile("s_waitcnt vmcnt(0)" ::: "memory");
            const unsigned og = xb_add(&bar[XB_TOP], 1u);
            const unsigned tg = og / nx;
            if (og + 1u == (tg + 1u) * nx) xb_add(&bar[XB_TOPGEN], 1u);
            else XB_SPIN(xb_ld(&bar[XB_TOPGEN]) == tg, bar);
            __builtin_amdgcn_fence(__ATOMIC_ACQUIRE, "agent");
            xb_add(&bar[XB_XGEN(bx_)], 1u);
            asm volatile("s_waitcnt vmcnt(0)" ::: "memory");
        } else {
            XB_SPIN(xb_ld(&bar[XB_XGEN(bx_)]) == gen, bar);
            __builtin_amdgcn_fence(__ATOMIC_ACQUIRE, "agent");
            asm volatile("s_waitcnt vmcnt(0)" ::: "memory");
        }
    }
    __syncthreads();
}

namespace pg8 {
constexpr int BM = 256, BK = 64, HALF = 128, HTB = HALF * BK * 2, STAGE_BYTES = 8 * HTB, NXCD = 8, WGM = 8;
__host__ __device__ __forceinline__ int lds_byte(int r, int c) { const int st = (r >> 4) * 2 + (c >> 5), rr = r & 15, cc = c & 31, ob = rr * 64 + cc * 2; return st * 1024 + (ob ^ (((ob >> 9) & 1) << 5)); }
__host__ __device__ __forceinline__ void stage_rc(int b, int& R, int& C) { const int st = b / 1024, sb = b % 1024, swz = sb ^ (((sb >> 9) & 1) << 5); R = (st >> 1) * 16 + swz / 64; C = (st & 1) * 32 + (swz % 64) / 2; }
__host__ __device__ __forceinline__ int perm32(int rho) { const int n = rho >> 4, i = rho & 15; return 8 * (i >> 2) + 4 * n + (i & 3); }
struct Unit { int pm, pn; };
struct Gemm { const bf16_t* A; const bf16_t* Bt; int M, N, K; };
struct StaticOrder {
    int nM, nN, nwg, G, c;
    __host__ __device__ void init(int M_, int N_, int G_, int c_) { nM = M_ / BM; nN = N_ / BM; nwg = nM * nN; G = G_; c = c_; }
    __host__ __device__ bool next(int i, Unit& u) const {
        const long L = (long)i * G + c; if (L >= nwg) return false;
        int wgid = (int)L; { const int q = nwg / NXCD, r = nwg % NXCD, xcd = wgid % NXCD, off = wgid / NXCD; wgid = (xcd < r ? xcd * (q + 1) : r * (q + 1) + (xcd - r) * q) + off; }
        const int nig = WGM * nN, gid = wgid / nig, fm = gid * WGM, gsz = (nM - fm) < WGM ? (nM - fm) : WGM;
        u.pm = fm + ((wgid % nig) % gsz); u.pn = (wgid % nig) / gsz; return true;
    }
    __device__ __forceinline__ void a_ready(const Unit&) const {}
    __device__ __forceinline__ void done(const Unit&) const {}
};
struct EpiBf16 {
    static constexpr bool PERM = true, I8 = false; typedef f32x4 acc_t;
    bf16_t* O; int ldc;
    __device__ __forceinline__ void operator()(const f32x4 (&acc)[2][2][4][2], const Unit& u, int wr, int wc, int fr, int fq) const {
        const int row0 = u.pm * BM + wr * 64 + fr; const int col0 = u.pn * BM + wc * 32 + 8 * fq;
#pragma unroll
        for (int ai = 0; ai < 2; ++ai)
#pragma unroll
            for (int m = 0; m < 4; ++m) { bf16_t* rowp = O + (size_t)(row0 + ai * HALF + m * 16) * ldc + col0;
#pragma unroll
                for (int bj = 0; bj < 2; ++bj) { const f32x4 v0 = acc[ai][bj][m][0], v1 = acc[ai][bj][m][1];
                    u32x4 w; w.x = pkbf_c(v0[0], v0[1]); w.y = pkbf_c(v0[2], v0[3]); w.z = pkbf_c(v1[0], v1[1]); w.w = pkbf_c(v1[2], v1[3]);
                    *(u32x4*)(rowp + bj * HALF) = w; } }
    }
};
struct EpiBf16I8 {
    static constexpr bool PERM = true, I8 = true; typedef i32x4 acc_t;
    bf16_t* O; int ldc; const float* sa; const float* wmax;
    __device__ __forceinline__ void operator()(const i32x4 (&acc)[2][2][4][2], const Unit& u, int wr, int wc, int fr, int fq) const {
        const int row0 = u.pm * BM + wr * 64 + fr; const int col0 = u.pn * BM + wc * 32 + 8 * fq;
        f32x4 sw[2][2];
#pragma unroll
        for (int bj = 0; bj < 2; ++bj)
#pragma unroll
            for (int n = 0; n < 2; ++n) sw[bj][n] = *(const f32x4*)(wmax + col0 + bj * HALF + 4 * n) * (1.f / 127.f);
#pragma unroll
        for (int ai = 0; ai < 2; ++ai)
#pragma unroll
            for (int m = 0; m < 4; ++m) { const int row = row0 + ai * HALF + m * 16; const float sr = sa[row]; bf16_t* rowp = O + (size_t)row * ldc + col0;
#pragma unroll
                for (int bj = 0; bj < 2; ++bj) { const i32x4 a0 = acc[ai][bj][m][0], a1 = acc[ai][bj][m][1];
                    const f32x4 v0 = (f32x4){(float)a0[0], (float)a0[1], (float)a0[2], (float)a0[3]} * sw[bj][0] * sr, v1 = (f32x4){(float)a1[0], (float)a1[1], (float)a1[2], (float)a1[3]} * sw[bj][1] * sr;
                    u32x4 w; w.x = pkbf(v0[0], v0[1]); w.y = pkbf(v0[2], v0[3]); w.z = pkbf(v1[0], v1[1]); w.w = pkbf(v1[2], v1[3]);
                    *(u32x4*)(rowp + bj * HALF) = w; } }
    }
};
struct EpiRes {
    static constexpr bool PERM = false, I8 = false; typedef f32x4 acc_t;
    const float* src_lat; const float* src_ctx; float* dst_lat; float* dst_ctx; const float* gate;
    __device__ __forceinline__ void operator()(const f32x4 (&acc)[2][2][4][2], const Unit& u, int wr, int wc, int fr, int fq) const {
        const bool isctx = u.pm >= (ML / BM);
        const float* src = isctx ? src_ctx + (size_t)(u.pm - ML / BM) * BM * D : src_lat + (size_t)u.pm * BM * D;
        float* dst = isctx ? dst_ctx + (size_t)(u.pm - ML / BM) * BM * D : dst_lat + (size_t)u.pm * BM * D;
        const int mrow = isctx ? 2 : (u.pm >= (T / BM) ? 1 : 0);
        const int row0 = wr * 64 + fr, col0 = u.pn * BM + wc * 32 + 4 * fq;
        f32x4 gv[2][2];
#pragma unroll
        for (int bj = 0; bj < 2; ++bj)
#pragma unroll
            for (int n = 0; n < 2; ++n) gv[bj][n] = *(const f32x4*)(gate + mrow * 6144 + col0 + bj * HALF + n * 16);
#pragma unroll
        for (int ai = 0; ai < 2; ++ai)
#pragma unroll
            for (int m = 0; m < 4; ++m) { const size_t off = (size_t)(row0 + ai * HALF + m * 16) * D + col0;
#pragma unroll
                for (int bj = 0; bj < 2; ++bj)
#pragma unroll
                    for (int n = 0; n < 2; ++n) { const f32x4 s = *(const f32x4*)(src + off + bj * HALF + n * 16);
                        *(f32x4*)(dst + off + bj * HALF + n * 16) = s + gv[bj][n] * acc[ai][bj][m][n]; } }
    }
};

struct EpiResI8 {
    static constexpr bool PERM = false, I8 = true; typedef i32x4 acc_t;
    const float* src_lat; const float* src_ctx; float* dst_lat; float* dst_ctx; const float* gate; const float* sa; const float* wmax;
    __device__ __forceinline__ void operator()(const i32x4 (&acc)[2][2][4][2], const Unit& u, int wr, int wc, int fr, int fq) const {
        const bool isctx = u.pm >= (ML / BM);
        const float* src = isctx ? src_ctx + (size_t)(u.pm - ML / BM) * BM * D : src_lat + (size_t)u.pm * BM * D;
        float* dst = isctx ? dst_ctx + (size_t)(u.pm - ML / BM) * BM * D : dst_lat + (size_t)u.pm * BM * D;
        const int mrow = isctx ? 2 : (u.pm >= (T / BM) ? 1 : 0);
        const int row0 = wr * 64 + fr, col0 = u.pn * BM + wc * 32 + 4 * fq;
        f32x4 gv[2][2];
#pragma unroll
        for (int bj = 0; bj < 2; ++bj)
#pragma unroll
            for (int n = 0; n < 2; ++n) gv[bj][n] = *(const f32x4*)(gate + mrow * 6144 + col0 + bj * HALF + n * 16) * *(const f32x4*)(wmax + col0 + bj * HALF + n * 16) * (1.f / 127.f);
#pragma unroll
        for (int ai = 0; ai < 2; ++ai)
#pragma unroll
            for (int m = 0; m < 4; ++m) { const int rl = row0 + ai * HALF + m * 16; const float sr = sa[u.pm * BM + rl]; const size_t off = (size_t)rl * D + col0;
#pragma unroll
                for (int bj = 0; bj < 2; ++bj)
#pragma unroll
                    for (int n = 0; n < 2; ++n) { const f32x4 sv = *(const f32x4*)(src + off + bj * HALF + n * 16); const i32x4 ac = acc[ai][bj][m][n];
                        *(f32x4*)(dst + off + bj * HALF + n * 16) = sv + gv[bj][n] * ((f32x4){(float)ac[0], (float)ac[1], (float)ac[2], (float)ac[3]} * sr); } }
    }
};
template <class Epi, class Sched>
__device__ __forceinline__ void gemm_phase(LAS unsigned char* lds, const Gemm g, const Sched& S, const Epi& E) {
    constexpr bool I8 = Epi::I8;
    typedef typename Epi::acc_t acc_t;
    int tid = threadIdx.x; asm volatile("" : "+v"(tid)); const int wid = __builtin_amdgcn_readfirstlane(tid >> 6), lane = tid & 63, wr = wid >> 2, wc = wid & 3, fr = lane & 15, fq = lane >> 4;
    const int K = g.K, nt = K / BK;
    unsigned voffA[2], voffB[2];
#pragma unroll
    for (int i = 0; i < 2; ++i) { int R, C; stage_rc(tid * 16 + i * 8192, R, C); const int Rb = Epi::PERM ? ((R & ~31) + perm32(R & 31)) : R;
        voffA[i] = (unsigned)(R * K + C) * 2u; voffB[i] = (unsigned)(Rb * K + C) * 2u; }
    const size_t kstep = (size_t)(BK * 2);
    const size_t hstep = (size_t)HALF * K * 2;
    const size_t tstep = 2 * hstep;
    const unsigned ldsw = (unsigned)wid * 1024u;
    const int aoff = lds_byte(wr * 64 + fr, fq * 8), boff = lds_byte(wc * 32 + fr, fq * 8);
#define PG8_SA(b, h) (((b) * 2 + (h)) * HTB)
#define PG8_SB(b, h) ((4 + (b) * 2 + (h)) * HTB)
#define PG8_STAGE(bufoff, gbase, voff) do { _Pragma("unroll") for (int _i = 0; _i < 2; ++_i) \
        __builtin_amdgcn_global_load_lds((const unsigned*)((const char*)(gbase) + (voff)[_i]), (LAS unsigned*)(lds + (bufoff) + ldsw + _i * 8192), 16, 0, 0); } while (0)
#define PG8_LDA(dst, b, h) do { _Pragma("unroll") for (int m = 0; m < 4; ++m) _Pragma("unroll") for (int k = 0; k < 2; ++k) dst[m][k] = *(const LAS bf16x8*)(lds + PG8_SA(b, h) + aoff + m * 2048 + k * 1024); } while (0)
#define PG8_LDB(dst, b, h) do { _Pragma("unroll") for (int n = 0; n < 2; ++n) _Pragma("unroll") for (int k = 0; k < 2; ++k) dst[n][k] = *(const LAS bf16x8*)(lds + PG8_SB(b, h) + boff + n * 2048 + k * 1024); } while (0)
#define PG8_MMA(ai, bj, At, Bt) do { __builtin_amdgcn_s_setprio(1); _Pragma("unroll") for (int m = 0; m < 4; ++m) _Pragma("unroll") for (int n = 0; n < 2; ++n) _Pragma("unroll") for (int k = 0; k < 2; ++k) \
        { if constexpr (I8) acc[ai][bj][m][n] = __builtin_bit_cast(acc_t, __builtin_amdgcn_mfma_i32_16x16x64_i8(__builtin_bit_cast(i32x4, Bt[n][k]), __builtin_bit_cast(i32x4, At[m][k]), __builtin_bit_cast(i32x4, acc[ai][bj][m][n]), 0, 0, 0)); \
          else acc[ai][bj][m][n] = __builtin_bit_cast(acc_t, __builtin_amdgcn_mfma_f32_16x16x32_bf16(Bt[n][k], At[m][k], __builtin_bit_cast(f32x4, acc[ai][bj][m][n]), 0, 0, 0)); } __builtin_amdgcn_s_setprio(0); } while (0)
#define PG8_WAIT_V(n) asm volatile("s_waitcnt vmcnt(" #n ")" ::: "memory")
#define PG8_WAIT_L(n) asm volatile("s_waitcnt lgkmcnt(" #n ")" ::: "memory")
#define PG8_BAR __builtin_amdgcn_s_barrier()
#define PG8_SCHED __builtin_amdgcn_sched_barrier(0)
    Unit cur, nxt; int ui = 0;
    if (!S.next(0, cur)) return;
    acc_t acc[2][2][4][2];
#pragma unroll
    for (int a = 0; a < 2; ++a)
#pragma unroll
        for (int b = 0; b < 2; ++b)
#pragma unroll
            for (int m = 0; m < 4; ++m)
#pragma unroll
                for (int n = 0; n < 2; ++n) acc[a][b][m][n] = acc_t{};
    bf16x8 At[4][2], B0[2][2], B1[2][2];
    const char* cA = (const char*)g.A + (size_t)cur.pm * tstep; const char* cB = (const char*)g.Bt + (size_t)cur.pn * tstep;
    S.a_ready(cur);
    PG8_STAGE(PG8_SB(0, 0), cB, voffB); PG8_STAGE(PG8_SA(0, 0), cA, voffA); PG8_STAGE(PG8_SB(0, 1), cB + hstep, voffB); PG8_STAGE(PG8_SA(0, 1), cA + hstep, voffA);
    if (wr == 1) PG8_BAR;
    PG8_WAIT_V(4); PG8_BAR;
    PG8_STAGE(PG8_SB(1, 0), cB + kstep, voffB); PG8_STAGE(PG8_SA(1, 0), cA + kstep, voffA); PG8_STAGE(PG8_SB(1, 1), cB + hstep + kstep, voffB);
    PG8_WAIT_V(6); PG8_BAR;
    for (;;) {
        const bool has_next = S.next(ui + 1, nxt);
        const char* nA = has_next ? (const char*)g.A + (size_t)nxt.pm * tstep : cA; const char* nB = has_next ? (const char*)g.Bt + (size_t)nxt.pn * tstep : cB;
        for (int t = 0; t < nt; t += 2) {
            const bool last = (t == nt - 2);
            const char* a1 = cA + (size_t)(t + 1) * kstep;
            const char* a2 = last ? nA : cA + (size_t)(t + 2) * kstep; const char* b2 = last ? nB : cB + (size_t)(t + 2) * kstep;
            const char* a3 = a2 + kstep; const char* b3 = b2 + kstep;
            if (last && has_next) S.a_ready(nxt);
            PG8_LDB(B0, 0, 0); PG8_SCHED; PG8_LDA(At, 0, 0); PG8_STAGE(PG8_SA(1, 1), a1 + hstep, voffA);
            PG8_WAIT_L(8); PG8_BAR; PG8_WAIT_L(0); PG8_MMA(0, 0, At, B0); PG8_BAR; PG8_SCHED;
            PG8_LDB(B1, 0, 1); PG8_STAGE(PG8_SB(0, 0), b2, voffB);
            PG8_BAR; PG8_WAIT_L(0); PG8_MMA(0, 1, At, B1); PG8_BAR;
            PG8_LDA(At, 0, 1); PG8_STAGE(PG8_SA(0, 0), a2, voffA);
            PG8_BAR; PG8_WAIT_L(0); PG8_MMA(1, 0, At, B0); PG8_BAR; PG8_SCHED;
            PG8_STAGE(PG8_SB(0, 1), b2 + hstep, voffB);
            PG8_WAIT_V(6); PG8_BAR; PG8_MMA(1, 1, At, B1); PG8_BAR;
            PG8_LDB(B0, 1, 0); PG8_SCHED; PG8_LDA(At, 1, 0); PG8_STAGE(PG8_SA(0, 1), a2 + hstep, voffA);
            PG8_WAIT_L(8); PG8_BAR; PG8_WAIT_L(0); PG8_MMA(0, 0, At, B0); PG8_BAR; PG8_SCHED;
            PG8_LDB(B1, 1, 1); PG8_STAGE(PG8_SB(1, 0), b3, voffB);
            PG8_BAR; PG8_WAIT_L(0); PG8_MMA(0, 1, At, B1); PG8_BAR;
            PG8_LDA(At, 1, 1); PG8_STAGE(PG8_SA(1, 0), a3, voffA);
            PG8_BAR; PG8_WAIT_L(0); PG8_MMA(1, 0, At, B0); PG8_BAR; PG8_SCHED;
            PG8_STAGE(PG8_SB(1, 1), b3 + hstep, voffB);
            PG8_WAIT_V(6); PG8_BAR; PG8_MMA(1, 1, At, B1); PG8_BAR;
        }
        E(acc, cur, wr, wc, fr, fq); S.done(cur);
        if (!has_next) break;
#pragma unroll
        for (int a = 0; a < 2; ++a)
#pragma unroll
            for (int b = 0; b < 2; ++b)
#pragma unroll
                for (int m = 0; m < 4; ++m)
#pragma unroll
                    for (int n = 0; n < 2; ++n) acc[a][b][m][n] = acc_t{};
        cur = nxt; cA = nA; cB = nB; ++ui;
    }
    PG8_WAIT_V(0);
    if (wr == 0) PG8_BAR;
    PG8_BAR;
#undef PG8_SA
#undef PG8_SB
#undef PG8_STAGE
#undef PG8_LDA
#undef PG8_LDB
#undef PG8_MMA
#undef PG8_WAIT_V
#undef PG8_WAIT_L
#undef PG8_BAR
#undef PG8_SCHED
}
}

namespace att {
constexpr int HD = 128, NW = 8, QBLK = 32, KVBLK = 64;
constexpr float SCALE = 0.088388347648318440f;
constexpr float THR = 8.f;
constexpr int LDQ = 512, LDK = 256;
constexpr size_t SHM_V = KVBLK * HD * 2, SHM_K = KVBLK * HD * 2, SHM_ATTN = 2 * SHM_V + 2 * SHM_K + NW * 64 * 4;
#define KSWZ(row, colB) ((row) * 256 + ((colB) ^ (((row) & 7) << 4)))
#define SBAR() __builtin_amdgcn_sched_barrier(0)
__device__ __forceinline__ int crow(int r, int hi) { return (r & 3) + 8 * (r >> 2) + 4 * hi; }
__device__ __forceinline__ unsigned cvtpk(float lo, float hi) { unsigned r; asm volatile("v_cvt_pk_bf16_f32 %0, %1, %2" : "=v"(r) : "v"(lo), "v"(hi)); return r; }
__device__ __forceinline__ void partialSM(f32x16& p0, f32x16& p1) {
  for (int r = 0; r < 16; ++r) p0[r] = __builtin_amdgcn_exp2f(p0[r]);
}
typedef int i32x8 __attribute__((ext_vector_type(8)));
__device__ __forceinline__ void finishSM(f32x16& p0, f32x16& p1, i32x8& pa) {
  for (int r = 0; r < 16; ++r) p1[r] = __builtin_amdgcn_exp2f(p1[r]);
#pragma unroll
  for (int q = 0; q < 4; ++q) { int w = __builtin_amdgcn_cvt_pk_bf8_f32(p0[4 * q], p0[4 * q + 1], 0, false); w = __builtin_amdgcn_cvt_pk_bf8_f32(p0[4 * q + 2], p0[4 * q + 3], w, true); pa[q] = w;
    int w2 = __builtin_amdgcn_cvt_pk_bf8_f32(p1[4 * q], p1[4 * q + 1], 0, false); w2 = __builtin_amdgcn_cvt_pk_bf8_f32(p1[4 * q + 2], p1[4 * q + 3], w2, true); pa[4 + q] = w2; }
}
constexpr int K8_STRIDE = 144, K8_TILE = KVBLK * K8_STRIDE;
__device__ __forceinline__ void qkt(f32x16& p0, f32x16& p1, const unsigned char* Ks, const i32x8* qr, int r32, int hi, const f32x16& cinit) {
  p0 = cinit; p1 = cinit;
#pragma unroll
  for (int ks = 0; ks < 2; ++ks) {
    const u32x4* a0 = (const u32x4*)(Ks + r32 * K8_STRIDE + 64 * ks + 32 * hi); const u32x4* a1 = (const u32x4*)(Ks + (32 + r32) * K8_STRIDE + 64 * ks + 32 * hi);
    const u32x4 x0 = a0[0], x1 = a0[1], y0 = a1[0], y1 = a1[1];
    const i32x8 k0 = {(int)x0.x, (int)x0.y, (int)x0.z, (int)x0.w, (int)x1.x, (int)x1.y, (int)x1.z, (int)x1.w}, k1 = {(int)y0.x, (int)y0.y, (int)y0.z, (int)y0.w, (int)y1.x, (int)y1.y, (int)y1.z, (int)y1.w};
    p0 = __builtin_amdgcn_mfma_scale_f32_32x32x64_f8f6f4(k0, qr[ks], p0, 0, 0, 0, 0x7F7F7F7F, 0, 0x7C7C7C7C);
    p1 = __builtin_amdgcn_mfma_scale_f32_32x32x64_f8f6f4(k1, qr[ks], p1, 0, 0, 0, 0x7F7F7F7F, 0, 0x7C7C7C7C); }
}
constexpr int V8_STRIDE = 80, V8_TILE = HD * V8_STRIDE;
__device__ __forceinline__ void pv_d0(f32x16* o, f32x16& ol, const unsigned char* Vs, const i32x8& pa, int r32, int hi) {
  { const i32x8 ones = {0x38383838, 0x38383838, 0x38383838, 0x38383838, 0x38383838, 0x38383838, 0x38383838, 0x38383838};
    ol = __builtin_amdgcn_mfma_scale_f32_32x32x64_f8f6f4(pa, ones, ol, 1, 0, 0, 0x7F7F7F7F, 0, 0x7F7F7F7F); }
#pragma unroll
  for (int d0 = 0; d0 < 4; ++d0) { const u32x4* bp = (const u32x4*)(Vs + (32 * d0 + r32) * V8_STRIDE + 32 * hi); const u32x4 x0 = bp[0], x1 = bp[1];
    const i32x8 vb = {(int)x0.x, (int)x0.y, (int)x0.z, (int)x0.w, (int)x1.x, (int)x1.y, (int)x1.z, (int)x1.w};
    o[d0] = __builtin_amdgcn_mfma_scale_f32_32x32x64_f8f6f4(pa, vb, o[d0], 1  , 0  , 0, 0x7F7F7F7F, 0, 0x7F7F7F7F); }
}
__device__ __forceinline__ void attn_dense_body(const unsigned char* __restrict__ Qb, const unsigned char* __restrict__ Kh, const unsigned char* __restrict__ Vt,
                                                bf16_t* __restrict__ Ob, int LDO, int seq, char* lds, float* __restrict__ lse, float braw) {
  int tid = threadIdx.x; asm volatile("" : "+v"(tid)); const int wid = tid >> 6, lane = tid & 63, r32 = lane & 31, hi = lane >> 5;
  unsigned char* V_lds = (unsigned char*)lds; unsigned char* K_lds = (unsigned char*)(lds + 2 * V8_TILE);
  f32x16 o[4] = {}, ol = {}; i32x8 qr[2];
  const float mnC = __builtin_bit_cast(float, __builtin_amdgcn_readfirstlane(__builtin_bit_cast(int, -fmaxf(braw * (SCALE * 1.4426950408889634f) - 15.5f, 0.f))));
  f32x16 cinit;
#pragma unroll
  for (int r = 0; r < 16; ++r) cinit[r] = mnC;
  const unsigned char* Qw = Qb + (long)(wid * QBLK + r32) * LDQ + hi * 32;
#pragma unroll
  for (int ks = 0; ks < 2; ++ks) { const u32x4 x0 = *(const u32x4*)(Qw + 64 * ks), x1 = *(const u32x4*)(Qw + 64 * ks + 16);
    qr[ks] = (i32x8){(int)x0.x, (int)x0.y, (int)x0.z, (int)x0.w, (int)x1.x, (int)x1.y, (int)x1.z, (int)x1.w}; }
  const int krow = tid >> 3, kch = tid & 7;
  const int vrow = tid >> 2, vch = tid & 3;
  struct { u32x4 v8, k8; } sr_[2];
#define SLOAD(i, k0) do { sr_[i].v8 = *reinterpret_cast<const u32x4*>(Vt + (long)((k0) >> 6) * 8192 + tid * 16); \
    sr_[i].k8 = *reinterpret_cast<const u32x4*>(Kh + (long)((k0) + krow) * LDK + kch * 16); } while (0)
#define SWRITE(b, i) do { *(u32x4*)(V_lds + (b) * V8_TILE + vrow * V8_STRIDE + vch * 16) = sr_[i].v8; \
    *(u32x4*)(K_lds + (b) * K8_TILE + krow * K8_STRIDE + kch * 16) = sr_[i].k8; } while (0)
#define SWAIT() asm volatile("s_waitcnt vmcnt(2)" ::: "memory")
  f32x16 pA0, pA1, pB0, pB1; i32x8 pa; const int NT = seq / KVBLK;
  constexpr int SE = 0, SO = 1;
  SLOAD(SE, 0); asm volatile("s_waitcnt vmcnt(0)" ::: "memory"); SWRITE(0, SE); __syncthreads();
  qkt(pA0, pA1, K_lds, qr, r32, hi, cinit); partialSM(pA0, pA1);
  SLOAD(SO, KVBLK); SLOAD(SE, 2 * KVBLK);
  SWAIT(); SWRITE(1, SO); __syncthreads();
  for (int j = 1; j + 1 < NT; j += 2) {
    SBAR(); qkt(pB0, pB1, K_lds + K8_TILE, qr, r32, hi, cinit);
    finishSM(pA0, pA1, pa); SBAR();
    SLOAD(SO, (j + 2) * KVBLK); SBAR();
    pv_d0(o, ol, V_lds, pa, r32, hi); partialSM(pB0, pB1);
    __syncthreads(); SWAIT(); SWRITE(0, SE);
    __syncthreads();
    SBAR(); qkt(pA0, pA1, K_lds, qr, r32, hi, cinit);
    finishSM(pB0, pB1, pa); SBAR();
    SLOAD(SE, (j + 3 < NT ? j + 3 : NT - 1) * KVBLK); SBAR();
    pv_d0(o, ol, V_lds + V8_TILE, pa, r32, hi); partialSM(pA0, pA1);
    __syncthreads(); SWAIT(); SWRITE(1, SO);
    __syncthreads();
  }
  SBAR(); qkt(pB0, pB1, K_lds + K8_TILE, qr, r32, hi, cinit);
  finishSM(pA0, pA1, pa); SBAR();
  pv_d0(o, ol, V_lds, pa, r32, hi); partialSM(pB0, pB1);
  __syncthreads();
  finishSM(pB0, pB1, pa); SBAR();
  pv_d0(o, ol, V_lds + V8_TILE, pa, r32, hi);
  if (lse && r32 == 0) {
#pragma unroll
    for (int r = 0; r < 16; ++r) lse[(wid * QBLK + crow(r, hi)) * 4] = __logf(ol[r]) - mnC * 0.69314718055994531f; }
  float rli[16];
#pragma unroll
  for (int r = 0; r < 16; ++r) rli[r] = __builtin_amdgcn_rcpf(ol[r]);
  bf16_t* Ow = Ob + (long)(wid * QBLK) * LDO;
#pragma unroll
  for (int r = 0; r < 16; ++r) { int orow = crow(r, hi);
    for (int d0 = 0; d0 < 4; ++d0) Ow[(long)orow * LDO + d0 * 32 + r32] = (bf16_t)(pkbf(o[d0][r] * rli[r], 0.f) & 0xffffu); }
  __syncthreads();
#undef SLOAD
#undef SWRITE
#undef SWAIT
}
}

struct Args { const float* in[20]; float* out; unsigned char* ws; int ph_lo, ph_hi; };
typedef const __attribute__((address_space(4))) Args* KArgs;
__device__ __forceinline__ KArgs get_args() { KArgs p = (KArgs)__builtin_amdgcn_kernarg_segment_ptr(); asm volatile("" : "+s"(p)); return p; }
__device__ __forceinline__ int fresh_tid() { int t = threadIdx.x; asm volatile("" : "+v"(t)); return t; }
__device__ __forceinline__ int fresh_bx() { int t = blockIdx.x; asm volatile("" : "+s"(t)); return t; }
__device__ __forceinline__ int fresh_g() { int t = gridDim.x; asm volatile("" : "+s"(t)); return t; }
enum { I_X = 0, I_C, I_CTX, I_CCTX, I_ADAW, I_ADAB, I_N1W, I_N2W, I_WIN, I_QNW, I_KNW, I_CONVW, I_ALOG, I_DTB, I_DNW, I_WOUT, I_WQ, I_SUBK, I_U, I_V };

__device__ __forceinline__ void convert_tables(const float* U, const float* V, unsigned char* ws, int l, int wvi, int nwv, int lane, int rw_end = 2 * NEXP) {
    const float* us = U + (size_t)l * NEXP * 1024; const float* vs = V + (size_t)l * NEXP * 1024;
    const int set = l & 1;
    float* scl = (float*)(ws + WS_USC) + set * 2 * NEXP;
    for (int rw = wvi; rw < rw_end; rw += nwv) {
        const bool isu = rw < NEXP; const int e = isu ? rw : rw - NEXP;
        const f32x4* sp = (const f32x4*)((isu ? us : vs) + (size_t)e * 1024 + 16 * lane);
        f32x4 x[4]; float mx = 0.f;
#pragma unroll
        for (int i = 0; i < 4; ++i) { x[i] = sp[i]; mx = fmaxf(mx, fmaxf(fmaxf(fabsf(x[i][0]), fabsf(x[i][1])), fmaxf(fabsf(x[i][2]), fabsf(x[i][3])))); }
        mx = wave_max(mx);
        const float sc = fmaxf(mx, 1e-30f) * (1.f / 127.f), inv = 1.f / sc;
        u32x4 o4;
        const float ofs = (GATHER_PART && isu) ? 0.f : 128.f;
#pragma unroll
        for (int i = 0; i < 4; ++i) { const unsigned b0 = (unsigned)(int)(rintf(x[i][0] * inv) + ofs) & 255u, b1 = (unsigned)(int)(rintf(x[i][1] * inv) + ofs) & 255u, b2 = (unsigned)(int)(rintf(x[i][2] * inv) + ofs) & 255u, b3 = (unsigned)(int)(rintf(x[i][3] * inv) + ofs) & 255u;
            o4[i] = b0 | (b1 << 8) | (b2 << 16) | (b3 << 24); }
        *(u32x4*)(ws + WS_UB + (size_t)set * TAB_SET + (size_t)e * 2048 + (isu ? 0 : 1024) + 16 * lane) = o4;
        if (lane == 0) { if (GATHER_PART) scl[2 * e + (isu ? 0 : 1)] = sc; else scl[rw] = sc; }
    }
}

__device__ __forceinline__ void transpose_item(const float* W, int ldw, int K, bf16_t* WT, LAS float* scr, int kb, int nb, int lane) {
    const int k0 = 64 * kb, n0 = 32 * nb;
#pragma unroll 8
    for (int i = 0; i < 32; ++i) { const int kk = 2 * i + (lane >> 5); scr[kk * 33 + (lane & 31)] = W[(size_t)(k0 + kk) * ldw + n0 + (lane & 31)]; }
    LDS_WAIT(); asm volatile("" ::: "memory");
    const int c = lane & 7;
#pragma unroll
    for (int j = 0; j < 4; ++j) { const int n = (lane >> 3) + 8 * j; const LAS float* s = scr + (8 * c) * 33 + n;
        u32x4 o; o.x = pkbf(s[0 * 33], s[1 * 33]); o.y = pkbf(s[2 * 33], s[3 * 33]); o.z = pkbf(s[4 * 33], s[5 * 33]); o.w = pkbf(s[6 * 33], s[7 * 33]);
        *(u32x4*)(WT + (size_t)(n0 + n) * K + k0 + 8 * c) = o; }
    LDS_WAIT(); asm volatile("" ::: "memory");
}
__device__ __forceinline__ void phase_prologue(LAS unsigned char* lds) {
    const KArgs ap = get_args();
#define a (*ap)

    const int tid = fresh_tid(), lane = tid & 63, wave = __builtin_amdgcn_readfirstlane(tid >> 6), G = fresh_g(), bx = fresh_bx();
    unsigned char* ws = a.ws;
    {
        LAS float* sc = (LAS float*)(lds + 70000);
        LAS float* part = (LAS float*)(lds + 70000 + 12288);
        for (int i = tid; i < 3 * 1024; i += 512) { const int r = i >> 10, k = i & 1023; const float v = r < 2 ? a.in[I_C][r * 1024 + k] : a.in[I_CCTX][k]; sc[i] = silu_f(v); }
        __syncthreads();
        float* mod = (float*)(ws + WS_MOD);
        for (int item = bx; item < DEPTH * 96; item += G) {
            const int l = item / 96, j0 = (item % 96) * 64;
            const float* wp = a.in[I_ADAW] + (size_t)l * 1024 * 6144 + (size_t)(wave * 128) * 6144 + j0 + lane;
            float a0 = 0.f, a1 = 0.f, a2 = 0.f;
#pragma unroll 8
            for (int kk = 0; kk < 128; ++kk) { const float w = wp[(size_t)kk * 6144]; const int k = wave * 128 + kk; a0 = fmaf(sc[k], w, a0); a1 = fmaf(sc[1024 + k], w, a1); a2 = fmaf(sc[2048 + k], w, a2); }
            part[(wave * 3 + 0) * 64 + lane] = a0; part[(wave * 3 + 1) * 64 + lane] = a1; part[(wave * 3 + 2) * 64 + lane] = a2;
            __syncthreads();
            if (tid < 192) { const int r = tid >> 6, jj = tid & 63; float s = a.in[I_ADAB][l * 6144 + j0 + jj];
#pragma unroll
                for (int w = 0; w < 8; ++w) s += part[(w * 3 + r) * 64 + jj];
                mod[(size_t)(l * 3 + r) * 6144 + j0 + jj] = s; }
            __syncthreads();
        }
    }
    {
        const int gw = bx * 8 + wave, NGW = G * 8;
        unsigned* wmaxw = (unsigned*)(ws + WS_CTL) + CW_WMAX;
        constexpr int NB_IN = NP / 64, NB_OUT = 1024 / 64, NB_Q = 2048 / 64, PER_L2 = (NB_IN + NB_OUT + NB_Q) * 8;
        for (int it = gw; it < DEPTH * PER_L2; it += NGW) { const int l = it / PER_L2; int r = it % PER_L2; const int kc = r & 7; r >>= 3;
            const int mi = r < NB_IN ? 0 : r < NB_IN + NB_OUT ? 1 : 2; const int nb = mi == 0 ? r : mi == 1 ? r - NB_IN : r - NB_IN - NB_OUT; const int ldw = mi == 0 ? NIN : mi == 1 ? 1024 : 2048;
            const float* wp = (mi == 0 ? a.in[I_WIN] + (size_t)l * 1024 * NIN : mi == 1 ? a.in[I_WOUT] + (size_t)l * 1024 * 1024 : a.in[I_WQ] + (size_t)l * 1024 * 2048) + (size_t)(kc * 128) * ldw + nb * 64 + lane;
            float mx = 0.f;
#pragma unroll 8
            for (int kk = 0; kk < 128; ++kk) mx = fmaxf(mx, fabsf(wp[(size_t)kk * ldw]));
            atomicMax(wmaxw + (l * 3 + mi) * 3072 + nb * 64 + lane, __float_as_uint(mx)); }
    }
    const size_t gt = (size_t)bx * 512 + tid, NT = (size_t)G * 512;
    for (size_t i = gt; i < (size_t)DEPTH * 16 * 1024; i += NT) { const int l = (int)(i >> 14), j = (int)((i >> 10) & 15), k = (int)(i & 1023);
        ((float*)(ws + WS_WSK))[i] = a.in[I_WIN][(size_t)l * 1024 * NIN + (size_t)k * NIN + NP + j]; }
    convert_tables(a.in[I_U], a.in[I_V], ws, 0, bx * 8 + wave, G * 8, lane);
    for (size_t i = gt; i < (size_t)DEPTH * 8 * 2 * 128 * 128 / 2; i += NT) { const f32x2 x = ((const f32x2*)a.in[I_SUBK])[i]; ((unsigned*)(ws + WS_SKB))[i] = pkbf(x[0], x[1]); }
    for (size_t i = gt; i < 8192; i += NT) { const int pos = (int)(i >> 5), fi = (int)(i & 31);
        const float inv = exp2f(-(float)fi * (13.287712379549449f / 32.f)); const float ang = (float)pos * inv;
        float rev = ang * 0.15915494309189535f; rev -= floorf(rev);
        ((float*)(ws + WS_ROPE))[i] = __builtin_amdgcn_cosf(rev); ((float*)(ws + WS_ROPE))[8192 + i] = __builtin_amdgcn_sinf(rev); }
}


__device__ __forceinline__ void quant_transpose_item(const float* W, int ldw, signed char* WT, const unsigned* wmaxw, LAS float* scr, int kb, int nb, int lane) {
    const int k0 = 64 * kb, n0 = 32 * nb;
#pragma unroll 8
    for (int i = 0; i < 32; ++i) { const int kk = 2 * i + (lane >> 5); scr[kk * 33 + (lane & 31)] = W[(size_t)(k0 + kk) * ldw + n0 + (lane & 31)]; }
    LDS_WAIT(); asm volatile("" ::: "memory");
    const int n = lane >> 1, hf = lane & 1;
    const float mx = __uint_as_float(wmaxw[n0 + n]), inv = mx > 0.f ? 127.f / mx : 0.f;
    u32x4 o[2];
#pragma unroll
    for (int q = 0; q < 8; ++q) { unsigned w = 0u;
#pragma unroll
        for (int b = 0; b < 4; ++b) { const int kk = 32 * hf + 4 * q + b; w |= ((unsigned)(int)rintf(scr[kk * 33 + n] * inv) & 255u) << (8 * b); }
        o[q >> 2][q & 3] = w; }
    u32x4* dst = (u32x4*)(WT + (size_t)(n0 + n) * 1024 + k0 + 32 * hf);
    dst[0] = o[0]; dst[1] = o[1];
    LDS_WAIT(); asm volatile("" ::: "memory");
}
__device__ __forceinline__ void phase_quant_weights(LAS unsigned char* lds) {
    const KArgs ap = get_args();
#define a (*ap)
    const int tid = fresh_tid(), lane = tid & 63, wave = __builtin_amdgcn_readfirstlane(tid >> 6), G = fresh_g(), bx = fresh_bx();
    unsigned char* ws = a.ws;
    LAS float* scr = (LAS float*)(lds + 65536 + wave * 8448);
    const unsigned* wmaxw = (const unsigned*)(ws + WS_CTL) + CW_WMAX;
    constexpr int I_IN = 16 * 96, I_OUT = 16 * 32, I_Q = 16 * 64, PER_L = I_IN + I_OUT + I_Q;
    for (int it = bx * 8 + wave; it < DEPTH * PER_L; it += G * 8) { const int l = it / PER_L; int r = it % PER_L;
        if (r < I_IN) quant_transpose_item(a.in[I_WIN] + (size_t)l * 1024 * NIN, NIN, (signed char*)(ws + WS_WINT) + (size_t)l * NP * 1024, wmaxw + (l * 3 + 0) * 3072, scr, r / 96, r % 96, lane);
        else if (r < I_IN + I_OUT) { r -= I_IN; quant_transpose_item(a.in[I_WOUT] + (size_t)l * 1024 * 1024, 1024, (signed char*)(ws + WS_WOUTT) + (size_t)l * 1024 * 1024, wmaxw + (l * 3 + 1) * 3072, scr, r / 32, r % 32, lane); }
        else { r -= I_IN + I_OUT; quant_transpose_item(a.in[I_WQ] + (size_t)l * 1024 * 2048, 2048, (signed char*)(ws + WS_WQT) + (size_t)l * 2048 * 1024, wmaxw + (l * 3 + 2) * 3072, scr, r / 64, r % 64, lane); } }
#undef a
}

template <bool SK>
__device__ __forceinline__ void phase_norm(int l, int which, LAS unsigned char* lds) {
    const KArgs ap = get_args();
#define a (*ap)

    const int tid = fresh_tid(), lane = tid & 63, wave = __builtin_amdgcn_readfirstlane(tid >> 6), G = fresh_g(), bx = fresh_bx();
    unsigned char* ws = a.ws;
    LAS float* wsk = (LAS float*)lds;
    if (SK) { const float* src = (const float*)(ws + WS_WSK) + (size_t)l * 16384; for (int i = tid; i < 16384 / 4; i += 512) ((LAS f32x4*)wsk)[i] = ((const f32x4*)src)[i]; __syncthreads(); }
    const int nrows = (which == 1 && l == DEPTH - 1) ? ML : M;
    const float* nw = a.in[which ? I_N2W : I_N1W] + l * 1024;
    const float* modl = (const float*)(ws + WS_MOD) + (size_t)l * 3 * 6144;
    const int shoff = which ? 3072 : 0, scoff = which ? 4096 : 1024;
    f32x4 nwv[4];
#pragma unroll
    for (int j = 0; j < 4; ++j) nwv[j] = *(const f32x4*)(nw + 4 * lane + 256 * j);
    for (int row = wave * G + bx; row < nrows; row += G * 8) {
        const float* src; int mrow;
        if (row < ML) { src = ((l == 0 && which == 0) ? a.in[I_X] : a.out) + (size_t)row * D; mrow = row >= T ? 1 : 0; }
        else { src = ((l == 0 && which == 0) ? a.in[I_CTX] : (const float*)(ws + WS_CTXX)) + (size_t)(row - ML) * D; mrow = 2; }
        const float* md = modl + mrow * 6144;
        f32x4 v[4]; float ss = 0.f;
#pragma unroll
        for (int j = 0; j < 4; ++j) { v[j] = *(const f32x4*)(src + 4 * lane + 256 * j); ss += (v[j][0] * v[j][0] + v[j][1] * v[j][1]) + (v[j][2] * v[j][2] + v[j][3] * v[j][3]); }
        const float rstd = rsqrtf(wave_sum(ss) * (1.f / D) + EPS);
        signed char* hrow = (signed char*)(ws + WS_H) + (size_t)row * D;
        float hmx = 0.f;
#pragma unroll
        for (int j = 0; j < 4; ++j) { const f32x4 sc = *(const f32x4*)(md + scoff + 4 * lane + 256 * j), sh = *(const f32x4*)(md + shoff + 4 * lane + 256 * j);
            v[j] = v[j] * rstd * nwv[j] * (sc + 1.f) + sh; hmx = fmaxf(hmx, fmaxf(fmaxf(fabsf(v[j][0]), fabsf(v[j][1])), fmaxf(fabsf(v[j][2]), fabsf(v[j][3])))); }
        hmx = fmaxf(wave_max(hmx), 1e-30f);
        { const float hinv = 127.f / hmx;
#pragma unroll
          for (int j = 0; j < 4; ++j) *(unsigned*)(hrow + 4 * lane + 256 * j) = ((unsigned)(int)rintf(v[j][0] * hinv) & 255u) | (((unsigned)(int)rintf(v[j][1] * hinv) & 255u) << 8) | (((unsigned)(int)rintf(v[j][2] * hinv) & 255u) << 16) | (((unsigned)(int)rintf(v[j][3] * hinv) & 255u) << 24);
          if (lane == 0) ((float*)(ws + WS_GB))[row] = hmx * (1.f / 127.f); }
        if (SK) {
            float p[16];
#pragma unroll
            for (int c = 0; c < 16; ++c) { float q = 0.f;
#pragma unroll
                for (int j = 0; j < 4; ++j) { const f32x4 w = *(const LAS f32x4*)(wsk + c * 1024 + 4 * lane + 256 * j); q += (v[j][0] * w[0] + v[j][1] * w[1]) + (v[j][2] * w[2] + v[j][3] * w[3]); }
                p[c] = q; }
            { const bool hb = (lane & 32) != 0;
#pragma unroll
              for (int c = 0; c < 8; ++c) { const float keep = hb ? p[c + 8] : p[c], send = hb ? p[c] : p[c + 8]; p[c] = keep + lane_xor<32>(send); } }
            { const bool hb = (lane & 16) != 0;
#pragma unroll
              for (int c = 0; c < 4; ++c) { const float keep = hb ? p[c + 4] : p[c], send = hb ? p[c] : p[c + 4]; p[c] = keep + lane_xor<16>(send); } }
            { const bool hb = (lane & 8) != 0;
#pragma unroll
              for (int c = 0; c < 2; ++c) { const float keep = hb ? p[c + 2] : p[c], send = hb ? p[c] : p[c + 2]; p[c] = keep + lane_xor<8>(send); } }
            { const bool hb = (lane & 4) != 0; const float keep = hb ? p[1] : p[0], send = hb ? p[0] : p[1]; p[0] = keep + lane_xor<4>(send); }
            p[0] += lane_xor<2>(p[0]); p[0] += lane_xor<1>(p[0]);
            if ((lane & 3) == 0) { const int c = ((lane >> 5) & 1) * 8 + ((lane >> 4) & 1) * 4 + ((lane >> 3) & 1) * 2 + ((lane >> 2) & 1); ((float*)(ws + WS_BA))[(size_t)row * 16 + c] = p[0]; }
        }
    }
    if (SK) __syncthreads();
}

__device__ __forceinline__ void phase_prep(int l, LAS unsigned char* lds) {
    const KArgs ap = get_args();
#define a (*ap)

    const int tid = fresh_tid(), lane = tid & 63, wave = __builtin_amdgcn_readfirstlane(tid >> 6), G = fresh_g(), bx = fresh_bx();
    unsigned char* ws = a.ws;
    const bf16_t* P = (const bf16_t*)(ws + WS_P);
    const float* ropec = (const float*)(ws + WS_ROPE); const float* ropes = ropec + 8192;
    const int sec = lane >> 5, fi = lane & 31;
    const float qw0 = a.in[I_QNW][l * 128 + sec * 64 + fi], qw1 = a.in[I_QNW][l * 128 + sec * 64 + 32 + fi];
    const float kw0 = a.in[I_KNW][l * 128 + sec * 64 + fi], kw1 = a.in[I_KNW][l * 128 + sec * 64 + 32 + fi];
    for (int row = wave * G + bx; row < M; row += G * 8) {
        const bool lat = row < ML;
        int b, tt, tlen; if (lat) { b = row >> 14; tt = row & (T - 1); tlen = T; } else { b = (row - ML) >> 8; tt = (row - ML) & (CT - 1); tlen = CT; }
        const bf16_t* prow = P + (size_t)row * NP;
        unsigned short xa[6][2];
#pragma unroll
        for (int hh = 0; hh < 6; ++hh) { const bf16_t* xp = prow + (hh < 4 ? hh * 128 : 512 + (hh - 4) * 128) + sec * 64 + fi; xa[hh][0] = xp[0]; xa[hh][1] = xp[32]; }
        const u32x2 vcp = *(const u32x2*)(prow + 768 + 4 * lane);
        float cs = 1.f, sn = 0.f;
        if (lat) { const int pos = sec ? (tt & 63) : (tt >> 6); cs = ropec[pos * 32 + fi]; sn = ropes[pos * 32 + fi]; }
        unsigned char* qo8 = ws + WS_QA + (size_t)row * 512;
        const size_t kvrow = (size_t)b * KVLEN + (lat ? tt : T + tt);
        unsigned char* ko8 = ws + WS_KA + kvrow * 256;
        float ssq[6];
#pragma unroll
        for (int hh = 0; hh < 6; ++hh) { const float x0 = bf2f(xa[hh][0]), x1 = bf2f(xa[hh][1]); ssq[hh] = x0 * x0 + x1 * x1; }
#pragma unroll
        for (int hh = 0; hh < 6; ++hh) ssq[hh] = wave_sum(ssq[hh]);
#pragma unroll
        for (int hh = 0; hh < 6; ++hh) {
            const float x0 = bf2f(xa[hh][0]), x1 = bf2f(xa[hh][1]);
            const float rs = rsqrtf(ssq[hh] * (1.f / 128.f) + EPS);
            const float y0 = x0 * rs * (hh < 4 ? qw0 : kw0), y1 = x1 * rs * (hh < 4 ? qw1 : kw1);
            const float qsc = hh < 4 ? 0.088388347648318440f * 1.4426950408889634f : 1.f;
            const float o0 = (y0 * cs - y1 * sn) * qsc, o1 = (y1 * cs + y0 * sn) * qsc;
            unsigned char* op8 = (hh < 4 ? qo8 + hh * 128 : ko8 + (hh - 4) * 128) + sec * 64 + fi;
            const float f8s = hh < 4 ? 8.f : 1.f;
            const int pk8 = __builtin_amdgcn_cvt_pk_fp8_f32(o0 * f8s, o1 * f8s, 0, false);
            op8[0] = (unsigned char)(pk8 & 255); op8[32] = (unsigned char)((pk8 >> 8) & 255);
        }
        { const int pos = lat ? tt : T + tt, tile = pos >> 6, k64 = pos & 63, k32 = k64 & 31;
          const int bytepos = 32 * ((k32 >> 2) & 1) + 16 * (k64 >> 5) + (k32 & 3) + 4 * (k32 >> 3);
          unsigned char* vt = ws + WS_VA + ((size_t)(b * 2) * (KVLEN / 64) + tile) * 8192 + bytepos;
          const unsigned short* vsrc = (const unsigned short*)&vcp;
          const int kvh_ = lane >> 5, d0 = (4 * lane) & 127;
          const int pk01 = __builtin_amdgcn_cvt_pk_fp8_f32(bf2f(vsrc[0]), bf2f(vsrc[1]), 0, false), pk23 = __builtin_amdgcn_cvt_pk_fp8_f32(bf2f(vsrc[2]), bf2f(vsrc[3]), 0, false);
          unsigned char* vt2 = vt + (size_t)kvh_ * (KVLEN / 64) * 8192 + (size_t)d0 * 64;
          vt2[0] = (unsigned char)(pk01 & 255); vt2[64] = (unsigned char)((pk01 >> 8) & 255); vt2[128] = (unsigned char)(pk23 & 255); vt2[192] = (unsigned char)((pk23 >> 8) & 255); }
    }
    __syncthreads();
}

constexpr int ATT_PARTS = 4;
__device__ __forceinline__ void phase_attn(int l, unsigned char* lds_raw, volatile LAS unsigned* MISC, int rep) {
    const KArgs ap = get_args();
#define a (*ap)
    unsigned char* ws = a.ws;
    const unsigned char* QA = ws + WS_QA; const unsigned char* KA = ws + WS_KA; const unsigned char* VT = ws + WS_VA;
    bf16_t* CAT = (bf16_t*)(ws + WS_CAT); float* LSE = (float*)(ws + WS_BA);
    unsigned* ctr = (unsigned*)(ws + WS_CTL) + 8192 + 64 * l + 1024 * rep;
    const int natt = 2048 + (l < DEPTH - 1 ? 8 : 0);
    constexpr int CONV_ROWS = 64, NCONV = 2 * NEXP / CONV_ROWS;
    const int nunits = natt + (l + 1 < DEPTH ? NCONV : 0);
    float braw;
    { const int ln = threadIdx.x & 63; float mq = fmaxf(fabsf(a.in[I_QNW][l * 128 + ln]), fabsf(a.in[I_QNW][l * 128 + 64 + ln])), mk = fmaxf(fabsf(a.in[I_KNW][l * 128 + ln]), fabsf(a.in[I_KNW][l * 128 + 64 + ln]));
      mq = wave_max(mq); mk = wave_max(mk);
      braw = __builtin_bit_cast(float, __builtin_amdgcn_readfirstlane(__builtin_bit_cast(int, 128.f * mq * mk))); }
    if (threadIdx.x == 0) MISC[12] = __hip_atomic_fetch_add(ctr, 1u, __ATOMIC_RELAXED, __HIP_MEMORY_SCOPE_AGENT);
    __syncthreads();
    int u = (int)MISC[12], par = 0;
    for (; u < nunits; ) {
        if (threadIdx.x == 0) MISC[13 - par] = __hip_atomic_fetch_add(ctr, 1u, __ATOMIC_RELAXED, __HIP_MEMORY_SCOPE_AGENT);
        if (u >= natt) {
            const int rwb = (u - natt) * CONV_ROWS + (int)(threadIdx.x >> 6) * 8;
            convert_tables(a.in[I_U], a.in[I_V], ws, l + 1, rwb, 1, (int)(threadIdx.x & 63), rwb + 8);
            __syncthreads();
            u = (int)MISC[13 - par]; par ^= 1;
            continue;
        }
        size_t r0, kv0; int h, kvh, seq, ldo; bf16_t* ob; float* lse;
        if (u < 2048) { const int qb = u & 63, g = (u >> 6) & 1, part = (u >> 7) & 3, b = u >> 10; kvh = (u >> 9) & 1; h = kvh * 2 + g;
            const int t0 = (part >> 1) * 130 + (part & 1) * 64;
            r0 = (size_t)b * T + (size_t)qb * 256; kv0 = (size_t)b * KVLEN + (size_t)t0 * 64; seq = ((part & 1) ? 66 : 64) * 64;
            ob = part ? (bf16_t*)(ws + (part == 1 ? WS_DQ : part == 2 ? WS_DK : WS_DV)) + r0 * 512 + h * 128 : CAT + r0 * 1024 + h * 128; ldo = part ? 512 : 1024; lse = LSE + ((size_t)part * ML + r0) * 4 + h; }
        else { const int b = (u - 2048) >> 2; h = (u - 2048) & 3; kvh = h >> 1; r0 = (size_t)ML + (size_t)b * CT; kv0 = (size_t)b * KVLEN + T; seq = CT;
            ob = CAT + r0 * 1024 + h * 128; ldo = 1024; lse = nullptr; }
        att::attn_dense_body(QA + r0 * 512 + h * 128, KA + kv0 * 256 + kvh * 128, VT + ((size_t)((kv0 / KVLEN) * 2 + kvh) * (KVLEN / 64) + (kv0 % KVLEN) / 64) * 8192, ob, ldo, seq, (char*)lds_raw, lse, braw);
        u = (int)MISC[13 - par]; par ^= 1;
    }
#undef a
}

__device__ __forceinline__ int tokperm(int q, int hh, int jj) { return 16 * q + 8 * (jj >> 2) + 4 * hh + (jj & 3); }
__device__ __forceinline__ int crow16(int r, int hi) { return (r & 3) + 8 * (r >> 2) + 4 * hi; }
__device__ __forceinline__ int kperm16(int s_, int g, int jj) { return 32 * s_ + 16 * (jj >> 2) + 4 * g + (jj & 3); }
__device__ __forceinline__ int frag_off(int i, int j) {
    return (((i >> 4) * 2 + (j >> 5)) * 64 + ((i & 15) + 16 * ((j >> 2) & 3))) * 16 + (4 * ((j >> 4) & 1) + (j & 3)) * 2;
}
template <int MODE>
__device__ __forceinline__ void phase_dn_chunkprep(int l, LAS unsigned char* lds) {
    const KArgs ap = get_args();
#define a (*ap)
    const int tid = fresh_tid(), lane = tid & 63, wave = __builtin_amdgcn_readfirstlane(tid >> 6), G = fresh_g(), bx = fresh_bx();
    unsigned char* ws = a.ws;
    constexpr int KT_OFF = 0, QT_OFF = 17408, VT_OFF = 34816, GS_OFF = 52224, RS_OFF = 68864, AM_OFF = 85504, SC_OFF = 120320, IMG_OFF = 0;
    const int r = lane & 31, hh = lane >> 5;
    const bf16_t* DQ = (const bf16_t*)(ws + WS_DQ); const bf16_t* DK = (const bf16_t*)(ws + WS_DK); const bf16_t* DV = (const bf16_t*)(ws + WS_DV);
    const float* BA = (const float*)(ws + WS_BA);
    constexpr int NTASK = MODE ? NB * 4 * 4 : NB * 4 * (NCH - 4);
#define CP_TASKID(t_) (MODE ? ((t_) >> 2) * NCH + ((t_) & 3) : ((t_) >> 8) * NCH + 4 + ((t_) & 255))
    LAS float* gsc = (LAS float*)(lds + SC_OFF);
    LAS float* bsc = gsc + 128;
    LAS float* gcs = gsc + 256;
    constexpr int CW_OFF = 121856;
    LAS float* cwl = (LAS float*)(lds + CW_OFF);
    for (int i = tid; i < 5 * 1536; i += 512) cwl[i] = a.in[I_CONVW][(size_t)l * 5 * 1536 + i];
    __syncthreads();
    const bf16_t* P = (const bf16_t*)(ws + WS_P);
    u32x4 xin[3][5][2];
#define CP_LOADX(task_) do { const int cidx_ = (task_) % NCH, bh_ = (task_) / NCH, b_ = bh_ >> 2, h_ = bh_ & 3; \
        const int row0_ = cidx_ < 4 ? ML + b_ * CT + cidx_ * 64 : b_ * T + (cidx_ - 4) * 64, tt_ = (cidx_ < 4 ? cidx_ * 64 : (cidx_ - 4) * 64) + (tid >> 3), tlen_ = cidx_ < 4 ? CT : T; \
        _Pragma("unroll") for (int j = 0; j < 5; ++j) { const int t2 = tt_ + j - 2; const bool ok = t2 >= 0 && t2 < tlen_; \
            const bf16_t* xr = P + (size_t)(row0_ + (tid >> 3) + (ok ? j - 2 : 0)) * NP + 1024 + h_ * 128 + (tid & 7) * 16; \
            _Pragma("unroll") for (int m = 0; m < 3; ++m) { const u32x4 w0 = *(const u32x4*)(xr + m * 512), w1 = *(const u32x4*)(xr + m * 512 + 8); \
                xin[m][j][0] = ok ? w0 : (u32x4){0u, 0u, 0u, 0u}; xin[m][j][1] = ok ? w1 : (u32x4){0u, 0u, 0u, 0u}; } } } while (0)
    if (bx < NTASK) CP_LOADX(CP_TASKID(bx));
    for (int tk = bx; tk < NTASK; tk += G) {
        const int task = CP_TASKID(tk);
        const int cidx = task % NCH, bh = task / NCH, b = bh >> 2, h = bh & 3;
        const int row0 = cidx < 4 ? ML + b * CT + cidx * 64 : b * T + (cidx - 4) * 64;
        unsigned char* rec = ws + WS_REC + (size_t)task * REC_BYTES;
        {
            const int rr = tid >> 3, seg = tid & 7;
            if (tid < 128) { const int d = tid >> 6, i = tid & 63, dh = d * 4 + h;
                const float xb = BA[(size_t)(row0 + i) * 16 + dh], z = BA[(size_t)(row0 + i) * 16 + 8 + dh] + a.in[I_DTB][l * 8 + dh];
                bsc[tid] = 1.f / (1.f + __expf(-xb)); gsc[tid] = -__expf(a.in[I_ALOG][l * 8 + dh]) * (fmaxf(z, 0.f) + log1pf(__expf(-fabsf(z)))); }
#pragma unroll
            for (int m = 0; m < 3; ++m) {
                float y[16];
#pragma unroll
                for (int c = 0; c < 16; ++c) y[c] = 0.f;
#pragma unroll
                for (int j = 0; j < 5; ++j) { const LAS float* wp = cwl + j * 1536 + m * 512 + h * 128 + seg * 16;
#pragma unroll
                    for (int q4 = 0; q4 < 4; ++q4) { const f32x4 wv = *(const LAS f32x4*)(wp + 4 * q4); const unsigned u0 = xin[m][j][q4 >> 1][2 * (q4 & 1)], u1 = xin[m][j][q4 >> 1][2 * (q4 & 1) + 1];
                        y[4 * q4 + 0] = fmaf(bflo(u0), wv[0], y[4 * q4 + 0]); y[4 * q4 + 1] = fmaf(bfhi(u0), wv[1], y[4 * q4 + 1]); y[4 * q4 + 2] = fmaf(bflo(u1), wv[2], y[4 * q4 + 2]); y[4 * q4 + 3] = fmaf(bfhi(u1), wv[3], y[4 * q4 + 3]); } }
                float ss = 0.f;
#pragma unroll
                for (int c = 0; c < 16; ++c) { y[c] = silu_f(y[c]); ss = fmaf(y[c], y[c], ss); }
                if (m < 2) { ss += lane_xor<1>(ss); ss += lane_xor<2>(ss); ss += lane_xor<4>(ss);
                    float sc = rsqrtf(ss + EPS); if (m == 0) sc *= 0.088388347648318440f;
#pragma unroll
                    for (int c = 0; c < 16; ++c) y[c] *= sc; }
                u32x4 o0, o1; o0.x = pkbf(y[0], y[1]); o0.y = pkbf(y[2], y[3]); o0.z = pkbf(y[4], y[5]); o0.w = pkbf(y[6], y[7]); o1.x = pkbf(y[8], y[9]); o1.y = pkbf(y[10], y[11]); o1.z = pkbf(y[12], y[13]); o1.w = pkbf(y[14], y[15]);
                LAS unsigned char* dst = lds + (m == 0 ? QT_OFF : m == 1 ? KT_OFF : VT_OFF) + rr * 272 + seg * 32;
                *(LAS u32x4*)dst = o0; *(LAS u32x4*)(dst + 16) = o1;
            }
        }
        __syncthreads();
        {
            const int mat = wave >> 2, ti = (wave >> 1) & 1, tj = wave & 1;
            f32x16 acc = {};
#pragma unroll
            for (int ks = 0; ks < 8; ++ks) {
                const bf16x8 av = *(const LAS bf16x8*)(lds + (mat ? QT_OFF : KT_OFF) + (32 * ti + r) * 272 + (16 * ks + 8 * hh) * 2);
                const bf16x8 bv = *(const LAS bf16x8*)(lds + KT_OFF + (32 * tj + r) * 272 + (16 * ks + 8 * hh) * 2);
                acc = __builtin_amdgcn_mfma_f32_32x32x16_bf16(av, bv, acc, 0, 0, 0);
            }
            LAS float* dst = (LAS float*)(lds + (mat ? RS_OFF : GS_OFF));
#pragma unroll
            for (int i = 0; i < 16; ++i) dst[(32 * ti + crow16(i, hh)) * 65 + 32 * tj + r] = acc[i];
        }
        { const int r16 = lane & 15, g4 = lane >> 4;
#pragma unroll
        for (int t = 0; t < 2; ++t) { const int f = wave * 2 + t, mt = f >> 2, sk = f & 3;
            { const u32x2 lo = *(const LAS u32x2*)(lds + KT_OFF + (16 * mt + r16) * 272 + (32 * sk + 4 * g4) * 2), hi2 = *(const LAS u32x2*)(lds + KT_OFF + (16 * mt + r16) * 272 + (32 * sk + 16 + 4 * g4) * 2);
              *(u32x4*)(rec + REC_K + f * 1024 + lane * 16) = (u32x4){lo.x, lo.y, hi2.x, hi2.y}; }
            { const u32x2 lo = *(const LAS u32x2*)(lds + QT_OFF + (16 * mt + r16) * 272 + (32 * sk + 4 * g4) * 2), hi2 = *(const LAS u32x2*)(lds + QT_OFF + (16 * mt + r16) * 272 + (32 * sk + 16 + 4 * g4) * 2);
              *(u32x4*)(rec + REC_Q + f * 1024 + lane * 16) = (u32x4){lo.x, lo.y, hi2.x, hi2.y}; } }
#pragma unroll
        for (int t = 0; t < 2; ++t) { const int f = wave * 2 + t, mt = f >> 1, sk = f & 1;
            unsigned e[8];
#pragma unroll
            for (int jj = 0; jj < 8; ++jj) e[jj] = *(const LAS unsigned short*)(lds + KT_OFF + kperm16(sk, g4, jj) * 272 + (16 * mt + r16) * 2);
            *(u32x4*)(rec + REC_KT + f * 1024 + lane * 16) = (u32x4){e[0] | (e[1] << 16), e[2] | (e[3] << 16), e[4] | (e[5] << 16), e[6] | (e[7] << 16)}; }
        { const int sl = wave;
            unsigned e[16];
#pragma unroll
            for (int i = 0; i < 16; ++i) e[i] = *(const LAS unsigned short*)(lds + VT_OFF + (16 * (i >> 2) + 4 * g4 + (i & 3)) * 272 + (16 * sl + r16) * 2);
            u32x4* vp = (u32x4*)(rec + REC_V + sl * 2048 + lane * 32);
            vp[0] = (u32x4){e[0] | (e[1] << 16), e[2] | (e[3] << 16), e[4] | (e[5] << 16), e[6] | (e[7] << 16)};
            vp[1] = (u32x4){e[8] | (e[9] << 16), e[10] | (e[11] << 16), e[12] | (e[13] << 16), e[14] | (e[15] << 16)}; }
        }
        if (tk + G < NTASK) CP_LOADX(CP_TASKID(tk + G));
        if (wave < 2) { const int d = wave; float gv = gsc[d * 64 + (d ? 63 - lane : lane)];
            gv += __builtin_bit_cast(float, __builtin_amdgcn_update_dpp(0, __builtin_bit_cast(int, gv), 0x111, 0xF, 0xF, true));
            gv += __builtin_bit_cast(float, __builtin_amdgcn_update_dpp(0, __builtin_bit_cast(int, gv), 0x112, 0xF, 0xF, true));
            gv += __builtin_bit_cast(float, __builtin_amdgcn_update_dpp(0, __builtin_bit_cast(int, gv), 0x114, 0xF, 0xF, true));
            gv += __builtin_bit_cast(float, __builtin_amdgcn_update_dpp(0, __builtin_bit_cast(int, gv), 0x118, 0xF, 0xF, true));
            { const float t0 = __builtin_bit_cast(float, __builtin_amdgcn_readlane(__builtin_bit_cast(int, gv), 15)), t1 = __builtin_bit_cast(float, __builtin_amdgcn_readlane(__builtin_bit_cast(int, gv), 31)), t2 = __builtin_bit_cast(float, __builtin_amdgcn_readlane(__builtin_bit_cast(int, gv), 47));
              const int rw_ = lane >> 4; gv += (rw_ >= 1 ? t0 : 0.f) + (rw_ >= 2 ? t1 : 0.f) + (rw_ >= 3 ? t2 : 0.f); }
            gcs[d * 64 + lane] = gv; }
        __syncthreads();
        const LAS float* Gs = (const LAS float*)(lds + GS_OFF); const LAS float* Rs = (const LAS float*)(lds + RS_OFF);
#pragma unroll 4
        for (int t = 0; t < 16; ++t) { const int e = tid + 512 * t, d = e >> 12, jp = (e >> 6) & 63, ip = e & 63;
            const int in_ = d ? 63 - ip : ip, jn = d ? 63 - jp : jp;
            const float dec = __expf(fminf(gcs[d * 64 + ip] - gcs[d * 64 + jp], 0.f));
            const float av = (jp < ip) ? bsc[d * 64 + in_] * Gs[in_ * 65 + jn] * dec : 0.f;
            ((LAS float*)(lds + AM_OFF))[d * 4352 + jp * 68 + ip] = av;
            const float qk = (jp <= ip) ? Rs[in_ * 65 + jn] * dec : 0.f;
            *(LAS unsigned short*)(lds + IMG_OFF + d * 16384 + 8192 + frag_off(in_, jn)) = (unsigned short)(pkbf(qk, 0.f) & 0xffffu); }
        __syncthreads();
        if (wave < 2) { const int d = wave, c = lane, jn = d ? 63 - c : c; const float bj = bsc[d * 64 + jn];
            const LAS float* At = (const LAS float*)(lds + AM_OFF) + d * 4352;
            LAS float* Xm = (LAS float*)(lds + GS_OFF) + d * 4096 + c;
            const int fj = (jn >> 5) * 1024 + ((jn >> 2) & 3) * 256 + ((jn >> 4) & 1) * 8 + (jn & 3) * 2;
#pragma unroll 1
            for (int B = 0; B < 4; ++B) {
                float acc[16];
#pragma unroll
                for (int q = 0; q < 16; ++q) acc[q] = (16 * B + q == c) ? 1.f : 0.f;
#pragma unroll 4
                for (int j = 0; j < 16 * B; ++j) { const float xj = Xm[j * 64];
                    const f32x4 a0 = *(const LAS f32x4*)(At + j * 68 + 16 * B), a1 = *(const LAS f32x4*)(At + j * 68 + 16 * B + 4), a2 = *(const LAS f32x4*)(At + j * 68 + 16 * B + 8), a3 = *(const LAS f32x4*)(At + j * 68 + 16 * B + 12);
#pragma unroll
                    for (int q = 0; q < 4; ++q) { acc[q] = fmaf(-a0[q], xj, acc[q]); acc[4 + q] = fmaf(-a1[q], xj, acc[4 + q]); acc[8 + q] = fmaf(-a2[q], xj, acc[8 + q]); acc[12 + q] = fmaf(-a3[q], xj, acc[12 + q]); } }
#pragma unroll
                for (int r2 = 0; r2 < 15; ++r2) { const LAS float* ar = At + (16 * B + r2) * 68 + 16 * B; const float xr = acc[r2];
#pragma unroll
                    for (int q4 = (r2 + 1) / 4; q4 < 4; ++q4) { const f32x4 a4 = *(const LAS f32x4*)(ar + 4 * q4);
#pragma unroll
                        for (int q = 0; q < 4; ++q) if (4 * q4 + q > r2) acc[4 * q4 + q] = fmaf(-a4[q], xr, acc[4 * q4 + q]); } }
#pragma unroll
                for (int q = 0; q < 16; ++q) { const int i = 16 * B + q, in_ = d ? 63 - i : i; Xm[i * 64] = acc[q];
                    *(LAS unsigned short*)(lds + IMG_OFF + d * 16384 + (in_ >> 4) * 2048 + (in_ & 15) * 16 + fj) = (unsigned short)(pkbf(acc[q] * bj, 0.f) & 0xffffu); }
            }
        } else if (wave < 4) { const int d = wave - 2, ip = d ? 63 - lane : lane; const float gl = gcs[d * 64 + 63], gi = gcs[d * 64 + ip];
            float* sc = (float*)(rec + REC_DIR + d * REC_DIRSZ + 16384);
            sc[lane] = __expf(gi); sc[64 + lane] = __expf(gl - gi); if (lane == 0) sc[128] = __expf(gl); }
        __syncthreads();
#pragma unroll
        for (int t = 0; t < 4; ++t) { const int p = tid + 512 * t, d = p >> 10, off = (p & 1023) * 16;
            *(u32x4*)(rec + REC_DIR + d * REC_DIRSZ + off) = *(const LAS u32x4*)(lds + IMG_OFF + d * 16384 + off); }
        __syncthreads();
    }
#undef CP_LOADX
#undef CP_TASKID
#undef a
}

__device__ __forceinline__ bf16x8 pack44(const f32x4& lo, const f32x4& hi) {
    u32x4 p; p.x = pkbf_c(lo[0], lo[1]); p.y = pkbf_c(lo[2], lo[3]); p.z = pkbf_c(hi[0], hi[1]); p.w = pkbf_c(hi[2], hi[3]);
    return __builtin_bit_cast(bf16x8, p);
}
template <int VAR>
__device__ __forceinline__ void phase_dn_scan(int l, LAS unsigned char* lds) {
    const KArgs ap = get_args();
#define a (*ap)
    const int tid = fresh_tid(), lane = tid & 63, wave = __builtin_amdgcn_readfirstlane(tid >> 6), bx = fresh_bx();
    unsigned char* ws = a.ws;
    if (bx >= 32) return;
    const int chain = bx >> 1, half = bx & 1, b = chain >> 3, h = (chain >> 1) & 3, dir = chain & 1;
    const unsigned char* recb = ws + WS_REC + (size_t)((b * 4 + h) * NCH) * REC_BYTES;
    constexpr int BUFSZ = 74752;
#define CIDX(n) (dir ? ((n) < 4 ? 3 - (n) : 263 - (n)) : (n))
    if (wave >= 4) {
        const int sw = wave - 4;
#define DN_PIECE(i_) ((sw + 4 * (i_)) < 73 ? (sw + 4 * (i_)) : 72)
#define DN_SRC(rec_, p_) ((p_) < 48 ? (rec_) + (p_) * 1024 : (p_) < 65 ? (rec_) + REC_DIR + dir * REC_DIRSZ + ((p_) - 48) * 1024 : (rec_) + REC_V + half * 8192 + ((p_) - 65) * 1024)
#define DN_STAGE(n, bi) do { const unsigned char* rec_ = recb + (size_t)CIDX(n) * REC_BYTES; _Pragma("unroll") for (int i_ = 0; i_ < 19; ++i_) { const int p_ = DN_PIECE(i_); \
        __builtin_amdgcn_global_load_lds((const unsigned*)(DN_SRC(rec_, p_) + lane * 16), (LAS unsigned*)(lds + (bi) * BUFSZ + p_ * 1024), 16, 0, 0); } } while (0)
#define DN_SYNC() do { asm volatile("s_waitcnt vmcnt(0)" ::: "memory"); __builtin_amdgcn_s_barrier(); asm volatile("" ::: "memory"); } while (0)
        if (VAR != 3) DN_STAGE(0, 0);
        DN_SYNC();
        for (int n = 0; n < NCH; ++n) {
            if (VAR != 3 && n + 1 < NCH) DN_STAGE(n + 1, (n + 1) & 1);
            DN_SYNC();
        }
#undef DN_STAGE
#undef DN_PIECE
#undef DN_SRC
#undef DN_SYNC
    } else {
        const int sl = half * 4 + wave, c16 = lane & 15, g4 = lane >> 4;
        float* Og = (float*)(ws + (dir ? WS_OB : WS_OF)) + h * 128 + sl * 16 + c16;
        f32x4 S[8];
#pragma unroll
        for (int i = 0; i < 8; ++i) S[i] = (f32x4){0.f, 0.f, 0.f, 0.f};
        asm volatile("s_waitcnt lgkmcnt(0)" ::: "memory"); __builtin_amdgcn_s_barrier(); asm volatile("" ::: "memory");
        for (int n = 0; n < NCH; ++n) {
            if (VAR == 2) { asm volatile("s_waitcnt lgkmcnt(0)" ::: "memory"); __builtin_amdgcn_s_barrier(); asm volatile("" ::: "memory"); continue; }
            const LAS unsigned char* buf = lds + (n & 1) * BUFSZ;
            const int cidx = CIDX(n);
            const u32x4 vc0 = *(const LAS u32x4*)(buf + 66560 + wave * 2048 + lane * 32), vc1 = *(const LAS u32x4*)(buf + 66560 + wave * 2048 + lane * 32 + 16);
#define FR(off, f) (*(const LAS bf16x8*)(buf + (off) + (f) * 1024 + lane * 16))
#define MF(A, B, C) __builtin_amdgcn_mfma_f32_16x16x32_bf16((A), (B), (C), 0, 0, 0)
#define SB_() __builtin_amdgcn_sched_barrier(0)
            bf16x8 fa[8], fb[8];
            f32x4 eg[4], dl[4];
#pragma unroll
            for (int mt = 0; mt < 4; ++mt) { eg[mt] = *(const LAS f32x4*)(buf + 65536 + (16 * mt + 4 * g4) * 4); dl[mt] = *(const LAS f32x4*)(buf + 65536 + 256 + (16 * mt + 4 * g4) * 4); }
            const float egl = *(const LAS float*)(buf + 65536 + 512);
#define RD_KQ(dst, q) do { _Pragma("unroll") for (int mt = 0; mt < 4; ++mt) { dst[mt] = FR(0, mt * 4 + (q)); dst[4 + mt] = FR(32768, mt * 4 + (q)); } } while (0)
#define MM_KQ(src, q) do { _Pragma("unroll") for (int mt = 0; mt < 4; ++mt) { X[mt] = MF(src[mt], Sb[q], X[mt]); O[mt] = MF(src[4 + mt], Sb[q], O[mt]); } } while (0)
            f32x4 X[4], O[4], VN[4];
#pragma unroll
            for (int i = 0; i < 4; ++i) { X[i] = (f32x4){0.f, 0.f, 0.f, 0.f}; O[i] = (f32x4){0.f, 0.f, 0.f, 0.f}; VN[i] = (f32x4){0.f, 0.f, 0.f, 0.f}; }
            bf16x8 Sb[4];
#pragma unroll
            for (int q = 0; q < 4; ++q) Sb[q] = pack44(S[2 * q], S[2 * q + 1]);
            RD_KQ(fa, 0); SB_();
            RD_KQ(fb, 1); SB_(); MM_KQ(fa, 0); SB_();
            RD_KQ(fa, 2); SB_(); MM_KQ(fb, 1); SB_();
            RD_KQ(fb, 3); SB_(); MM_KQ(fa, 2); SB_();
#pragma unroll
            for (int i = 0; i < 8; ++i) fa[i] = FR(49152, i);
            SB_(); MM_KQ(fb, 3); SB_();
#pragma unroll
            for (int mt = 0; mt < 4; ++mt) { const unsigned w0 = (mt < 2 ? vc0 : vc1)[2 * (mt & 1)], w1 = (mt < 2 ? vc0 : vc1)[2 * (mt & 1) + 1];
                X[mt][0] = bflo(w0) - eg[mt][0] * X[mt][0]; X[mt][1] = bfhi(w0) - eg[mt][1] * X[mt][1]; X[mt][2] = bflo(w1) - eg[mt][2] * X[mt][2]; X[mt][3] = bfhi(w1) - eg[mt][3] * X[mt][3]; }
            const bf16x8 Yb0 = pack44(X[0], X[1]), Yb1 = pack44(X[2], X[3]);
            SB_();
#pragma unroll
            for (int i = 0; i < 8; ++i) fb[i] = FR(57344, i);
            SB_();
#pragma unroll
            for (int mt = 0; mt < 4; ++mt) { VN[mt] = MF(fa[mt * 2], Yb0, VN[mt]); VN[mt] = MF(fa[mt * 2 + 1], Yb1, VN[mt]); }
            SB_();
#pragma unroll
            for (int mt = 0; mt < 4; ++mt) O[mt] = O[mt] * eg[mt];
            const bf16x8 Vb0 = pack44(VN[0], VN[1]), Vb1 = pack44(VN[2], VN[3]);
            SB_();
#pragma unroll
            for (int i = 0; i < 8; ++i) fa[i] = FR(16384, i);
            SB_();
#pragma unroll
            for (int mt = 0; mt < 4; ++mt) { O[mt] = MF(fb[mt * 2], Vb0, O[mt]); O[mt] = MF(fb[mt * 2 + 1], Vb1, O[mt]); }
            SB_();
#pragma unroll
            for (int mt = 0; mt < 4; ++mt) VN[mt] = VN[mt] * dl[mt];
            const bf16x8 Vd0 = pack44(VN[0], VN[1]), Vd1 = pack44(VN[2], VN[3]);
#pragma unroll
            for (int i = 0; i < 8; ++i) S[i] = S[i] * egl;
            SB_();
#pragma unroll
            for (int i = 0; i < 8; ++i) fb[i] = FR(16384, 8 + i);
            SB_();
#pragma unroll
            for (int i = 0; i < 4; ++i) { S[i] = MF(fa[i * 2], Vd0, S[i]); S[i] = MF(fa[i * 2 + 1], Vd1, S[i]); }
            SB_();
#pragma unroll
            for (int i = 0; i < 4; ++i) { S[4 + i] = MF(fb[i * 2], Vd0, S[4 + i]); S[4 + i] = MF(fb[i * 2 + 1], Vd1, S[4 + i]); }
            SB_();
            {
                const int row0 = cidx < 4 ? ML + b * CT + cidx * 64 : b * T + (cidx - 4) * 64;
                float* op = Og + (size_t)(row0 + 4 * g4) * 512;
#pragma unroll
                for (int mt = 0; mt < 4; ++mt)
#pragma unroll
                    for (int t = 0; t < 4; ++t) { if (VAR != 1) op[(size_t)(16 * mt + t) * 512] = O[mt][t]; else asm volatile("" :: "v"(O[mt][t])); }
            }
#undef RD_KQ
#undef MM_KQ
#undef SB_
#undef FR
#undef MF
            asm volatile("s_waitcnt lgkmcnt(0)" ::: "memory"); __builtin_amdgcn_s_barrier(); asm volatile("" ::: "memory");
        }
    }
#undef CIDX
#undef a
}

__device__ __forceinline__ void phase_dn_out(int l) {
    const KArgs ap = get_args();
#define a (*ap)

    const int tid = fresh_tid(), lane = tid & 63, wave = __builtin_amdgcn_readfirstlane(tid >> 6), G = fresh_g(), bx = fresh_bx();
    unsigned char* ws = a.ws;
    const int nrows = (l == DEPTH - 1) ? ML : M;
    const float* OF = (const float*)(ws + WS_OF); const float* OB = (const float*)(ws + WS_OB);
    const bf16_t* P = (const bf16_t*)(ws + WS_P); bf16_t* CAT = (bf16_t*)(ws + WS_CAT);
    const f32x2 nw = *(const f32x2*)(a.in[I_DNW] + l * 128 + 2 * lane);
    const float* LSE = (const float*)(ws + WS_BA);
    for (int row = wave * G + bx; row < nrows; row += G * 8) {
        f32x2 of[4], ob[4]; unsigned gw[4];
#pragma unroll
        for (int hh = 0; hh < 4; ++hh) { of[hh] = *(const f32x2*)(OF + (size_t)row * 512 + hh * 128 + 2 * lane); ob[hh] = *(const f32x2*)(OB + (size_t)row * 512 + hh * 128 + 2 * lane);
            gw[hh] = *(const unsigned*)(P + (size_t)row * NP + 2560 + hh * 128 + 2 * lane); }
        u32x4 ap_[4]; float ls_[4];
#pragma unroll
        for (int p = 0; p < 4; ++p) { ap_[p] = (u32x4){0u, 0u, 0u, 0u}; ls_[p] = 0.f; }
        if (row < ML) {
            ap_[0] = *(const u32x4*)(CAT + (size_t)row * 1024 + 8 * lane); ap_[1] = *(const u32x4*)((const bf16_t*)(ws + WS_DQ) + (size_t)row * 512 + 8 * lane);
            ap_[2] = *(const u32x4*)((const bf16_t*)(ws + WS_DK) + (size_t)row * 512 + 8 * lane); ap_[3] = *(const u32x4*)((const bf16_t*)(ws + WS_DV) + (size_t)row * 512 + 8 * lane);
#pragma unroll
            for (int p = 0; p < 4; ++p) ls_[p] = LSE[((size_t)p * ML + row) * 4 + (lane >> 4)]; }
        float o0[4], o1[4], ssq[4];
#pragma unroll
        for (int hh = 0; hh < 4; ++hh) { o0[hh] = of[hh][0] + ob[hh][0]; o1[hh] = of[hh][1] + ob[hh][1]; ssq[hh] = o0[hh] * o0[hh] + o1[hh] * o1[hh]; }
#pragma unroll
        for (int hh = 0; hh < 4; ++hh) ssq[hh] = wave_sum(ssq[hh]);
        float mxv = 0.f;
#pragma unroll
        for (int hh = 0; hh < 4; ++hh) { const float rs = rsqrtf(ssq[hh] * (1.f / 128.f) + EPS); const float g0 = bflo(gw[hh]), g1 = bfhi(gw[hh]);
            o0[hh] = o0[hh] * rs * nw[0] * silu_f(g0); o1[hh] = o1[hh] * rs * nw[1] * silu_f(g1); mxv = fmaxf(mxv, fmaxf(fabsf(o0[hh]), fabsf(o1[hh]))); }
        float av[8];
        if (row < ML) { const float mx = fmaxf(fmaxf(ls_[0], ls_[1]), fmaxf(ls_[2], ls_[3]));
            float w_[4], wsum = 0.f;
#pragma unroll
            for (int p = 0; p < 4; ++p) { w_[p] = __expf(ls_[p] - mx); wsum += w_[p]; }
            const float inv = 1.f / wsum;
#pragma unroll
            for (int i = 0; i < 4; ++i) { float lo = 0.f, hi2 = 0.f;
#pragma unroll
                for (int p = 0; p < 4; ++p) { lo = fmaf(w_[p], bflo(ap_[p][i]), lo); hi2 = fmaf(w_[p], bfhi(ap_[p][i]), hi2); }
                av[2 * i] = lo * inv; av[2 * i + 1] = hi2 * inv; } }
        else { const u32x4 cw_ = *(const u32x4*)(CAT + (size_t)row * 1024 + 8 * lane);
#pragma unroll
            for (int i = 0; i < 4; ++i) { av[2 * i] = bflo(cw_[i]); av[2 * i + 1] = bfhi(cw_[i]); } }
#pragma unroll
        for (int i = 0; i < 8; ++i) mxv = fmaxf(mxv, fabsf(av[i]));
        mxv = fmaxf(wave_max(mxv), 1e-30f);
        const float cinv = 127.f / mxv;
        signed char* crow = (signed char*)(ws + WS_CATQ) + (size_t)row * 1024;
#define Q8_(x) ((unsigned)(int)rintf((x) * cinv) & 255u)
        { u32x2 o; o.x = Q8_(av[0]) | (Q8_(av[1]) << 8) | (Q8_(av[2]) << 16) | (Q8_(av[3]) << 24); o.y = Q8_(av[4]) | (Q8_(av[5]) << 8) | (Q8_(av[6]) << 16) | (Q8_(av[7]) << 24); *(u32x2*)(crow + 8 * lane) = o; }
#pragma unroll
        for (int hh = 0; hh < 4; ++hh) *(unsigned short*)(crow + 512 + hh * 128 + 2 * lane) = (unsigned short)(Q8_(o0[hh]) | (Q8_(o1[hh]) << 8));
#undef Q8_
        if (lane == 0) ((float*)(ws + WS_GB))[(1u << 18) + row] = mxv * (1.f / 127.f);
    }
#undef a
}

#define CE_DESC(a_, b_) do { const float hi_ = fmaxf(a_, b_), lo_ = fminf(a_, b_); a_ = hi_; b_ = lo_; } while (0)
__device__ __forceinline__ void bitonic_sort16_desc(float (&v)[16]) {
#pragma unroll
    for (int k = 2; k <= 16; k <<= 1)
#pragma unroll
        for (int j = k >> 1; j > 0; j >>= 1)
#pragma unroll
            for (int i = 0; i < 16; ++i) { const int p = i ^ j; if (p > i) { if ((i & k) == 0) CE_DESC(v[i], v[p]); else CE_DESC(v[p], v[i]); } }
}
__device__ __forceinline__ void merge_top16_desc(float (&lst)[16], const float (&nw)[16]) {
#pragma unroll
    for (int i = 0; i < 16; ++i) lst[i] = fmaxf(lst[i], nw[15 - i]);
#pragma unroll
    for (int j = 8; j > 0; j >>= 1)
#pragma unroll
        for (int i = 0; i < 16; ++i) { const int p = i ^ j; if (p > i) CE_DESC(lst[i], lst[p]); }
}
__device__ __forceinline__ void phase_peer_select(int l) {
    const KArgs ap = get_args();
#define a (*ap)
    const int tid = fresh_tid(), lane = tid & 63, wave = __builtin_amdgcn_readfirstlane(tid >> 6), G = fresh_g(), bx = fresh_bx();
    unsigned char* ws = a.ws;
    const int nrows = (l == DEPTH - 1) ? ML : M;
    const int ntask = (nrows / 32) * 4;
    const bf16_t* Q2 = (const bf16_t*)(ws + WS_P);
    const bf16_t* SKB = (const bf16_t*)(ws + WS_SKB) + (size_t)l * 8 * 2 * 128 * 128;
    int* PIDX = (int*)(ws + WS_PIDX); float* PGATE = (float*)(ws + WS_PGATE);
    const float NEG = -3.0e38f;
    const int r = lane & 31, hi = lane >> 5;
    for (int task = wave * G + bx; task < ntask; task += G * 8) {
        const int tg = task >> 2, hp = task & 3; const int row = tg * 32 + r;
        float mine0[16], mine1[16];
#pragma unroll
        for (int j = 0; j < 16; ++j) { mine0[j] = NEG; mine1[j] = NEG; }
        bf16x8 qA[8], kA[8];
        float lst[16];
#define SEL_QPTR(it_) (Q2 + (size_t)row * 2048 + (2 * hp + ((it_) >> 1)) * 256 + ((it_) & 1) * 128 + 8 * hi)
#define SEL_KPTR(it_, t_) (SKB + (size_t)(((2 * hp + ((it_) >> 1)) * 2 + ((it_) & 1)) * 128 + 32 * (t_) + r) * 128 + 8 * hi)
#define SEL_LDQ(dst, it_) do { const bf16_t* qp_ = SEL_QPTR(it_); _Pragma("unroll") for (int ks = 0; ks < 8; ++ks) dst[ks] = *(const bf16x8*)(qp_ + 16 * ks); } while (0)
#define SEL_LDK(dst, it_, t_) do { const bf16_t* kp_ = SEL_KPTR(it_, t_); _Pragma("unroll") for (int ks = 0; ks < 8; ++ks) dst[ks] = *(const bf16x8*)(kp_ + 16 * ks); } while (0)
#define SEL_RANK(qv, kv, t_) do { f32x16 acc = {}; _Pragma("unroll") for (int ks = 0; ks < 8; ++ks) acc = __builtin_amdgcn_mfma_f32_32x32x16_bf16(kv[ks], qv[ks], acc, 0, 0, 0); \
            const unsigned kb = (unsigned)(32 * (t_) + 4 * hi); float nw_[16]; \
            _Pragma("unroll") for (int i = 0; i < 16; ++i) nw_[i] = __uint_as_float((__float_as_uint(acc[i]) & 0xffffff80u) | (kb + (unsigned)((i & 3) + 8 * (i >> 2)))); \
            bitonic_sort16_desc(nw_); merge_top16_desc(lst, nw_); } while (0)
#define SB_() __builtin_amdgcn_sched_barrier(0)
#pragma unroll
        for (int j = 0; j < 16; ++j) lst[j] = NEG;
#pragma unroll 1
        for (int it = 0; it < 4; ++it) {
            SEL_LDQ(qA, it);
#pragma unroll 1
            for (int t = 0; t < 4; ++t) { SEL_LDK(kA, it, t); SEL_RANK(qA, kA, t); }
            float oth[16];
#pragma unroll
            for (int j = 0; j < 16; ++j) { auto rr = __builtin_amdgcn_permlane32_swap(__float_as_uint(lst[j]), __float_as_uint(lst[j]), false, false); oth[j] = __uint_as_float(hi ? rr[0] : rr[1]); }
            merge_top16_desc(lst, oth);
            const bool k0 = ((it >> 1) == hi) && ((it & 1) == 0), k1 = ((it >> 1) == hi) && ((it & 1) == 1);
#pragma unroll
            for (int j = 0; j < 16; ++j) { mine0[j] = k0 ? lst[j] : mine0[j]; mine1[j] = k1 ? lst[j] : mine1[j]; lst[j] = NEG; }
        }
#undef SB_
#undef SEL_QPTR
#undef SEL_KPTR
#undef SEL_LDQ
#undef SEL_LDK
#undef SEL_RANK
        const int h = 2 * hp + hi;
        float ts[16];
#pragma unroll
        for (int j = 0; j < 16; ++j) ts[j] = NEG;
#pragma unroll
        for (int i = 0; i < 16; ++i)
#pragma unroll
            for (int j = 0; j < 16; ++j) if ((i + 1) * (j + 1) <= 16) {
                const unsigned b0 = __float_as_uint(mine0[i]), b1 = __float_as_uint(mine1[j]);
                const float c = __uint_as_float(b0 & 0xffffff80u) + __uint_as_float(b1 & 0xffffff80u);
                float x = __uint_as_float((__float_as_uint(c) & 0xffffc000u) | ((b0 & 127u) << 7) | (b1 & 127u));
#pragma unroll
                for (int t = 0; t < 16; ++t) { const float hv = fmaxf(ts[t], x); x = fminf(ts[t], x); ts[t] = hv; }
            }
        int te[16]; float ex[16], sum = 0.f;
        const float tmax = __uint_as_float(__float_as_uint(ts[0]) & 0xffffc000u);
#pragma unroll
        for (int t = 0; t < 16; ++t) { const unsigned bt = __float_as_uint(ts[t]); te[t] = (int)(bt & 0x3fffu); ex[t] = __expf(__uint_as_float(bt & 0xffffc000u) - tmax); sum += ex[t]; }
        const float inv = 1.f / sum;
        int* ip = PIDX + (size_t)row * 128 + h * 16; float* gp = PGATE + (size_t)row * 128 + h * 16;
#pragma unroll
        for (int t = 0; t < 16; t += 4) { *(u32x4*)(ip + t) = (u32x4){(unsigned)te[t], (unsigned)te[t + 1], (unsigned)te[t + 2], (unsigned)te[t + 3]}; *(f32x4*)(gp + t) = (f32x4){ex[t] * inv, ex[t + 1] * inv, ex[t + 2] * inv, ex[t + 3] * inv}; }
    }
#undef a
}

template <bool WR, int GV = 0>
__device__ __forceinline__ void phase_peer_gather(int l, LAS unsigned char* lds) {
    const KArgs ap = get_args();
#define a (*ap)
    const int tid = fresh_tid(), lane = tid & 63, wave = __builtin_amdgcn_readfirstlane(tid >> 6), G = fresh_g(), bx = fresh_bx();
    unsigned char* ws = a.ws;
    const int nrows = (l == DEPTH - 1) ? ML : M;
    const unsigned char* UB = ws + WS_UB + (size_t)(l & 1) * TAB_SET; const unsigned char* VB = UB + 1024;
    const float* USC = (const float*)(ws + WS_USC) + (l & 1) * 2 * NEXP; const float* VSC = USC + NEXP;
    const int* PIDX = (const int*)(ws + WS_PIDX); const float* PGATE = (const float*)(ws + WS_PGATE);
    const float* modl = (const float*)(ws + WS_MOD) + (size_t)l * 3 * 6144 + 5120;
    const bool fuse = WR && (l + 1 < DEPTH);
    LAS float* wsk = (LAS float*)lds;
    if (fuse) { const float* src = (const float*)(ws + WS_WSK) + (size_t)(l + 1) * 16384; for (int i = tid; i < 16384 / 4; i += 512) ((LAS f32x4*)wsk)[i] = ((const f32x4*)src)[i]; __syncthreads(); }
    const float* nw1 = a.in[I_N1W] + (l + 1 < DEPTH ? l + 1 : l) * 1024 + 16 * lane;
    const float* modn = (const float*)(ws + WS_MOD) + (size_t)(l + 1 < DEPTH ? l + 1 : l) * 3 * 6144;
    for (int row = wave * G + bx; row < nrows; row += G * 8) {
        float hv[16], out[16];
        { const u32x4 hw = *(const u32x4*)((const signed char*)(ws + WS_H) + (size_t)row * D + 16 * lane); const float hsc = ((const float*)(ws + WS_GB))[row];
#pragma unroll
          for (int q = 0; q < 4; ++q) { const int w = (int)hw[q]; hv[4 * q + 0] = (float)((w << 24) >> 24) * hsc; hv[4 * q + 1] = (float)((w << 16) >> 24) * hsc; hv[4 * q + 2] = (float)((w << 8) >> 24) * hsc; hv[4 * q + 3] = (float)(w >> 24) * hsc; } }
        float hs = 0.f;
#pragma unroll
        for (int i = 0; i < 16; ++i) { out[i] = 0.f; hs += hv[i]; }
        const float hsum128 = 128.f * wave_sum(hs);
        float wacc = 0.f;
        const int id0 = PIDX[(size_t)row * 128 + lane], id1 = PIDX[(size_t)row * 128 + 64 + lane];
        const float gt0 = PGATE[(size_t)row * 128 + lane], gt1 = PGATE[(size_t)row * 128 + 64 + lane];
        const float us0 = USC[id0], us1 = USC[id1], vs0 = VSC[id0], vs1 = VSC[id1];
        for (int e0 = 0; e0 < 128; e0 += 8) {
            u32x4 uw[8], vw[8]; float gte[8], use[8], vse[8];
#pragma unroll
            for (int j = 0; j < 8; ++j) { const int e = e0 + j; const int id = __builtin_amdgcn_readlane(e0 < 64 ? id0 : id1, e & 63);
                gte[j] = __builtin_bit_cast(float, __builtin_amdgcn_readlane(__builtin_bit_cast(int, e0 < 64 ? gt0 : gt1), e & 63));
                use[j] = __builtin_bit_cast(float, __builtin_amdgcn_readlane(__builtin_bit_cast(int, e0 < 64 ? us0 : us1), e & 63));
                vse[j] = __builtin_bit_cast(float, __builtin_amdgcn_readlane(__builtin_bit_cast(int, e0 < 64 ? vs0 : vs1), e & 63));
                uw[j] = *(const u32x4*)(UB + (size_t)id * 2048 + 16 * lane); vw[j] = *(const u32x4*)(VB + (size_t)id * 2048 + 16 * lane); }
#pragma unroll
            for (int j = 0; j < 8; ++j) {
                float d0 = 0.f, d1 = 0.f;
#pragma unroll
                for (int q = 0; q < 4; ++q) { const unsigned w = uw[j][q];
                    d0 = fmaf((float)(w & 255u), hv[4 * q + 0], d0); d1 = fmaf((float)((w >> 8) & 255u), hv[4 * q + 1], d1);
                    d0 = fmaf((float)((w >> 16) & 255u), hv[4 * q + 2], d0); d1 = fmaf((float)(w >> 24), hv[4 * q + 3], d1); }
                const float dsum = (wave_sum(d0 + d1) - hsum128) * use[j];
                const float act = 0.5f * dsum * (1.f + erff(dsum * 0.70710678118654752f));
                const float wgt = gte[j] * act * vse[j];
                wacc += wgt;
                if (GV == 1) { asm volatile("" :: "v"(vw[j])); out[0] += wgt; } else
#pragma unroll
                for (int q = 0; q < 4; ++q) { const unsigned w = vw[j][q];
                    out[4 * q + 0] = fmaf(wgt, (float)(w & 255u), out[4 * q + 0]); out[4 * q + 1] = fmaf(wgt, (float)((w >> 8) & 255u), out[4 * q + 1]);
                    out[4 * q + 2] = fmaf(wgt, (float)((w >> 16) & 255u), out[4 * q + 2]); out[4 * q + 3] = fmaf(wgt, (float)(w >> 24), out[4 * q + 3]); }
            }
        }
        const float corr = 128.f * wacc;
        float* xr; int mrow;
        if (row < ML) { xr = a.out + (size_t)row * D; mrow = row >= T ? 1 : 0; } else { xr = (float*)(ws + WS_CTXX) + (size_t)(row - ML) * D; mrow = 2; }
        const float* g2 = modl + mrow * 6144 + 16 * lane;
        f32x4 xn[4];
#pragma unroll
        for (int i = 0; i < 4; ++i) { const f32x4 x = *(const f32x4*)(xr + 16 * lane + 4 * i), g = *(const f32x4*)(g2 + 4 * i);
            xn[i] = x + g * (f32x4){out[4 * i] - corr, out[4 * i + 1] - corr, out[4 * i + 2] - corr, out[4 * i + 3] - corr};
            if (WR) *(f32x4*)(xr + 16 * lane + 4 * i) = xn[i]; else asm volatile("" :: "v"(xn[i])); }
        if (fuse) {
            float ss = 0.f;
#pragma unroll
            for (int i = 0; i < 4; ++i) ss += (xn[i][0] * xn[i][0] + xn[i][1] * xn[i][1]) + (xn[i][2] * xn[i][2] + xn[i][3] * xn[i][3]);
            const float rstd = rsqrtf(wave_sum(ss) * (1.f / D) + EPS);
            const float* md = modn + mrow * 6144 + 16 * lane;
#pragma unroll
            for (int i = 0; i < 4; ++i) { const f32x4 nwv = *(const f32x4*)(nw1 + 4 * i), sc = *(const f32x4*)(md + 1024 + 4 * i), sh = *(const f32x4*)(md + 4 * i);
                xn[i] = xn[i] * rstd * nwv * (sc + 1.f) + sh; }
            { float hmx = 0.f;
#pragma unroll
              for (int i = 0; i < 4; ++i) hmx = fmaxf(hmx, fmaxf(fmaxf(fabsf(xn[i][0]), fabsf(xn[i][1])), fmaxf(fabsf(xn[i][2]), fabsf(xn[i][3]))));
              hmx = fmaxf(wave_max(hmx), 1e-30f); const float hinv = 127.f / hmx;
              u32x4 o;
#pragma unroll
              for (int i = 0; i < 4; ++i) o[i] = ((unsigned)(int)rintf(xn[i][0] * hinv) & 255u) | (((unsigned)(int)rintf(xn[i][1] * hinv) & 255u) << 8) | (((unsigned)(int)rintf(xn[i][2] * hinv) & 255u) << 16) | (((unsigned)(int)rintf(xn[i][3] * hinv) & 255u) << 24);
              *(u32x4*)((signed char*)(ws + WS_H) + (size_t)row * D + 16 * lane) = o;
              if (lane == 0) ((float*)(ws + WS_GB))[row] = hmx * (1.f / 127.f); }
            float p[16];
#pragma unroll
            for (int c = 0; c < 16; ++c) { float q = 0.f;
#pragma unroll
                for (int i = 0; i < 4; ++i) { const f32x4 w = *(const LAS f32x4*)(wsk + c * 1024 + 16 * lane + 4 * i); q += (xn[i][0] * w[0] + xn[i][1] * w[1]) + (xn[i][2] * w[2] + xn[i][3] * w[3]); }
                p[c] = q; }
            { const bool hb = (lane & 32) != 0;
#pragma unroll
              for (int c = 0; c < 8; ++c) { const float keep = hb ? p[c + 8] : p[c], send = hb ? p[c] : p[c + 8]; p[c] = keep + lane_xor<32>(send); } }
            { const bool hb = (lane & 16) != 0;
#pragma unroll
              for (int c = 0; c < 4; ++c) { const float keep = hb ? p[c + 4] : p[c], send = hb ? p[c] : p[c + 4]; p[c] = keep + lane_xor<16>(send); } }
            { const bool hb = (lane & 8) != 0;
#pragma unroll
              for (int c = 0; c < 2; ++c) { const float keep = hb ? p[c + 2] : p[c], send = hb ? p[c] : p[c + 2]; p[c] = keep + lane_xor<8>(send); } }
            { const bool hb = (lane & 4) != 0; const float keep = hb ? p[1] : p[0], send = hb ? p[0] : p[1]; p[0] = keep + lane_xor<4>(send); }
            p[0] += lane_xor<2>(p[0]); p[0] += lane_xor<1>(p[0]);
            if ((lane & 3) == 0) { const int c = ((lane >> 5) & 1) * 8 + ((lane >> 4) & 1) * 4 + ((lane >> 3) & 1) * 2 + ((lane >> 2) & 1); ((float*)(ws + WS_BA))[(size_t)row * 16 + c] = p[0]; }
        }
    }
    if (fuse) __syncthreads();
}
#undef a
constexpr size_t WS_PART = WS_P;
static_assert(WS_PART + 8 * (size_t)M * 1024 * 2 <= WS_GB, "partials region");
constexpr int GP_ITEM = 8;
__device__ __forceinline__ void phase_peer_gpart(int l, LAS unsigned char* lds) {
    const KArgs ap = get_args();
#define a (*ap)
    const int tid = fresh_tid(), lane = tid & 63, wave = __builtin_amdgcn_readfirstlane(tid >> 6);
    unsigned char* ws = a.ws;
    const int nrows = (l == DEPTH - 1) ? ML : M;
    const int nitem = nrows / GP_ITEM;
    const unsigned char* UB = ws + WS_UB + (size_t)(l & 1) * TAB_SET; const unsigned char* VB = UB + 1024;
    const f32x2* SC2 = (const f32x2*)(ws + WS_USC) + (size_t)(l & 1) * NEXP;
    const int* PIDX = (const int*)(ws + WS_PIDX); const float* PGATE = (const float*)(ws + WS_PGATE);
    LAS u32x4* lst = (LAS u32x4*)lds + wave * 128;
    const int eidx = ((lane >> 5) & 1) * 4 + ((lane >> 4) & 1) * 2 + ((lane >> 3) & 1);
    const int x = (int)(xb_xcc_id() & 7u);
#pragma unroll 1
    for (int pp = 0; pp < 8; ++pp) {
        const int p = (x + pp) & 7;
        unsigned* ctr = (unsigned*)(ws + WS_CTL) + 16384 + (l * 8 + p) * 64;
        unsigned* part = (unsigned*)(ws + WS_PART + (size_t)p * M * 2048);
        unsigned tk = 0; if (lane == 0) tk = __hip_atomic_fetch_add(ctr, 1u, __ATOMIC_RELAXED, __HIP_MEMORY_SCOPE_AGENT);
        int it = __builtin_amdgcn_readfirstlane((int)tk);
#pragma unroll 1
        while (it < nitem) {
            unsigned tn = 0; if (lane == 0) tn = __hip_atomic_fetch_add(ctr, 1u, __ATOMIC_RELAXED, __HIP_MEMORY_SCOPE_AGENT);
#pragma unroll 1
            for (int i = 0; i < GP_ITEM; ++i) {
                const int row = it * GP_ITEM + i;
                const int id0 = PIDX[(size_t)row * 128 + lane], id1 = PIDX[(size_t)row * 128 + 64 + lane];
                const float gt0 = PGATE[(size_t)row * 128 + lane], gt1 = PGATE[(size_t)row * 128 + 64 + lane];
                const u32x4 hw = *(const u32x4*)((const signed char*)(ws + WS_H) + (size_t)row * D + 16 * lane); const float hsc = ((const float*)(ws + WS_GB))[row];
                const bool s0 = (id0 >> 11) == p, s1 = (id1 >> 11) == p;
                const unsigned long long m0 = __ballot(s0), m1 = __ballot(s1);
                const int c0 = __builtin_popcountll(m0), c = __builtin_amdgcn_readfirstlane(c0 + __builtin_popcountll(m1));
                const int r0 = (int)__builtin_amdgcn_mbcnt_hi((unsigned)(m0 >> 32), __builtin_amdgcn_mbcnt_lo((unsigned)m0, 0u));
                const int r1 = c0 + (int)__builtin_amdgcn_mbcnt_hi((unsigned)(m1 >> 32), __builtin_amdgcn_mbcnt_lo((unsigned)m1, 0u));
                if (s0) { const f32x2 sc = SC2[id0]; lst[r0] = (u32x4){(unsigned)id0, __float_as_uint(gt0 * sc[1]), __float_as_uint(sc[0]), 0u}; }
                if (s1) { const f32x2 sc = SC2[id1]; lst[r1] = (u32x4){(unsigned)id1, __float_as_uint(gt1 * sc[1]), __float_as_uint(sc[0]), 0u}; }
                f32x2 o2[8];
#pragma unroll
                for (int k = 0; k < 8; ++k) o2[k] = (f32x2){0.f, 0.f};
                float wacc = 0.f;
#pragma unroll 1
                for (int e = 0; e < c; e += 8) {
                    u32x4 uw[8], vw[8];
#pragma unroll
                    for (int j = 0; j < 8; ++j) { const int sl = min(e + j, c - 1);
                        const int id = __builtin_amdgcn_readfirstlane((int)lst[sl][0]);
                        uw[j] = *(const u32x4*)(UB + (size_t)id * 2048 + 16 * lane); vw[j] = *(const u32x4*)(VB + (size_t)id * 2048 + 16 * lane); }
                    const int ms = e + eidx; const u32x4 en = lst[min(ms, c - 1)];
                    float pd[8];
#pragma unroll
                    for (int j = 0; j < 8; ++j) { int d = 0;
#pragma unroll
                        for (int q = 0; q < 4; ++q) d = __builtin_amdgcn_sdot4((int)uw[j][q], (int)hw[q], d, false);
                        pd[j] = (float)d; }
                    { const bool hb = (lane & 32) != 0;
#pragma unroll
                      for (int j = 0; j < 4; ++j) { const float keep = hb ? pd[j + 4] : pd[j], send = hb ? pd[j] : pd[j + 4]; pd[j] = keep + lane_xor<32>(send); } }
                    { const bool hb = (lane & 16) != 0;
#pragma unroll
                      for (int j = 0; j < 2; ++j) { const float keep = hb ? pd[j + 2] : pd[j], send = hb ? pd[j] : pd[j + 2]; pd[j] = keep + lane_xor<16>(send); } }
                    { const bool hb = (lane & 8) != 0; const float keep = hb ? pd[1] : pd[0], send = hb ? pd[0] : pd[1]; pd[0] = keep + lane_xor<8>(send); }
                    pd[0] += lane_xor<4>(pd[0]); pd[0] += lane_xor<2>(pd[0]); pd[0] += lane_xor<1>(pd[0]);
                    const float dsum = pd[0] * (__uint_as_float(en[2]) * hsc);
                    const float act = 0.5f * dsum * (1.f + erff(dsum * 0.70710678118654752f));
                    const float wgt = ms < c ? __uint_as_float(en[1]) * act : 0.f;
                    wacc += wgt;
#pragma unroll
                    for (int j = 0; j < 8; ++j) {
                        const float wj = __builtin_bit_cast(float, __builtin_amdgcn_readlane(__builtin_bit_cast(int, wgt), 32 * ((j >> 2) & 1) + 16 * ((j >> 1) & 1) + 8 * (j & 1)));
                        const f32x2 ww = {wj, wj};
#pragma unroll
                        for (int q = 0; q < 4; ++q) { const unsigned w = vw[j][q];
                            const f32x2 v01 = {(float)(w & 255u), (float)((w >> 8) & 255u)}, v23 = {(float)((w >> 16) & 255u), (float)(w >> 24)};
                            o2[2 * q] = __builtin_elementwise_fma(ww, v01, o2[2 * q]); o2[2 * q + 1] = __builtin_elementwise_fma(ww, v23, o2[2 * q + 1]); }
                    }
                }
                const float corr = 16.f * wave_sum(wacc);
                u32x4 w0, w1;
#pragma unroll
                for (int k = 0; k < 4; ++k) { w0[k] = pkbf_c(o2[k][0] - corr, o2[k][1] - corr); w1[k] = pkbf_c(o2[4 + k][0] - corr, o2[4 + k][1] - corr); }
                unsigned* dst = part + (size_t)row * 512 + 8 * lane;
                __builtin_nontemporal_store(w0, (u32x4*)dst); __builtin_nontemporal_store(w1, (u32x4*)(dst + 4));
            }
            it = __builtin_amdgcn_readfirstlane((int)tn);
        }
    }
#undef a
}

__device__ __forceinline__ void phase_peer_combine(int l, LAS unsigned char* lds) {
    const KArgs ap = get_args();
#define a (*ap)
    const int tid = fresh_tid(), lane = tid & 63, wave = __builtin_amdgcn_readfirstlane(tid >> 6), G = fresh_g(), bx = fresh_bx();
    unsigned char* ws = a.ws;
    const int nrows = (l == DEPTH - 1) ? ML : M;
    const float* modl = (const float*)(ws + WS_MOD) + (size_t)l * 3 * 6144 + 5120;
    const bool fuse = (l + 1 < DEPTH);
    LAS float* wsk = (LAS float*)lds;
    if (fuse) { const float* src = (const float*)(ws + WS_WSK) + (size_t)(l + 1) * 16384; for (int i = tid; i < 16384 / 4; i += 512) ((LAS f32x4*)wsk)[i] = ((const f32x4*)src)[i]; __syncthreads(); }
    const float* nw1 = a.in[I_N1W] + (l + 1 < DEPTH ? l + 1 : l) * 1024 + 16 * lane;
    const float* modn = (const float*)(ws + WS_MOD) + (size_t)(l + 1 < DEPTH ? l + 1 : l) * 3 * 6144;
    for (int row = wave * G + bx; row < nrows; row += G * 8) {
        float out[16];
#pragma unroll
        for (int i = 0; i < 16; ++i) out[i] = 0.f;
#pragma unroll
        for (int p = 0; p < 8; ++p) { const unsigned* src = (const unsigned*)(ws + WS_PART + (size_t)p * M * 2048) + (size_t)row * 512 + 8 * lane;
            const u32x4 w0 = __builtin_nontemporal_load((const u32x4*)src), w1 = __builtin_nontemporal_load((const u32x4*)(src + 4));
#pragma unroll
            for (int k = 0; k < 4; ++k) { out[2 * k] += bflo(w0[k]); out[2 * k + 1] += bfhi(w0[k]); out[8 + 2 * k] += bflo(w1[k]); out[8 + 2 * k + 1] += bfhi(w1[k]); } }
        float* xr; int mrow;
        if (row < ML) { xr = a.out + (size_t)row * D; mrow = row >= T ? 1 : 0; } else { xr = (float*)(ws + WS_CTXX) + (size_t)(row - ML) * D; mrow = 2; }
        const float* g2 = modl + mrow * 6144 + 16 * lane;
        f32x4 xn[4];
#pragma unroll
        for (int i = 0; i < 4; ++i) { const f32x4 x = *(const f32x4*)(xr + 16 * lane + 4 * i), g = *(const f32x4*)(g2 + 4 * i);
            xn[i] = x + g * (f32x4){out[4 * i], out[4 * i + 1], out[4 * i + 2], out[4 * i + 3]};
            *(f32x4*)(xr + 16 * lane + 4 * i) = xn[i]; }
        if (fuse) {
            float ss = 0.f;
#pragma unroll
            for (int i = 0; i < 4; ++i) ss += (xn[i][0] * xn[i][0] + xn[i][1] * xn[i][1]) + (xn[i][2] * xn[i][2] + xn[i][3] * xn[i][3]);
            const float rstd = rsqrtf(wave_sum(ss) * (1.f / D) + EPS);
            const float* md = modn + mrow * 6144 + 16 * lane;
#pragma unroll
            for (int i = 0; i < 4; ++i) { const f32x4 nwv = *(const f32x4*)(nw1 + 4 * i), sc = *(const f32x4*)(md + 1024 + 4 * i), sh = *(const f32x4*)(md + 4 * i);
                xn[i] = xn[i] * rstd * nwv * (sc + 1.f) + sh; }
            { float hmx = 0.f;
#pragma unroll
              for (int i = 0; i < 4; ++i) hmx = fmaxf(hmx, fmaxf(fmaxf(fabsf(xn[i][0]), fabsf(xn[i][1])), fmaxf(fabsf(xn[i][2]), fabsf(xn[i][3]))));
              hmx = fmaxf(wave_max(hmx), 1e-30f); const float hinv = 127.f / hmx;
              u32x4 o;
#pragma unroll
              for (int i = 0; i < 4; ++i) o[i] = ((unsigned)(int)rintf(xn[i][0] * hinv) & 255u) | (((unsigned)(int)rintf(xn[i][1] * hinv) & 255u) << 8) | (((unsigned)(int)rintf(xn[i][2] * hinv) & 255u) << 16) | (((unsigned)(int)rintf(xn[i][3] * hinv) & 255u) << 24);
              *(u32x4*)((signed char*)(ws + WS_H) + (size_t)row * D + 16 * lane) = o;
              if (lane == 0) ((float*)(ws + WS_GB))[row] = hmx * (1.f / 127.f); }
            float p[16];
#pragma unroll
            for (int c = 0; c < 16; ++c) { float q = 0.f;
#pragma unroll
                for (int i = 0; i < 4; ++i) { const f32x4 w = *(const LAS f32x4*)(wsk + c * 1024 + 16 * lane + 4 * i); q += (xn[i][0] * w[0] + xn[i][1] * w[1]) + (xn[i][2] * w[2] + xn[i][3] * w[3]); }
                p[c] = q; }
            { const bool hb = (lane & 32) != 0;
#pragma unroll
              for (int c = 0; c < 8; ++c) { const float keep = hb ? p[c + 8] : p[c], send = hb ? p[c] : p[c + 8]; p[c] = keep + lane_xor<32>(send); } }
            { const bool hb = (lane & 16) != 0;
#pragma unroll
              for (int c = 0; c < 4; ++c) { const float keep = hb ? p[c + 4] : p[c], send = hb ? p[c] : p[c + 4]; p[c] = keep + lane_xor<16>(send); } }
            { const bool hb = (lane & 8) != 0;
#pragma unroll
              for (int c = 0; c < 2; ++c) { const float keep = hb ? p[c + 2] : p[c], send = hb ? p[c] : p[c + 2]; p[c] = keep + lane_xor<8>(send); } }
            { const bool hb = (lane & 4) != 0; const float keep = hb ? p[1] : p[0], send = hb ? p[0] : p[1]; p[0] = keep + lane_xor<4>(send); }
            p[0] += lane_xor<2>(p[0]); p[0] += lane_xor<1>(p[0]);
            if ((lane & 3) == 0) { const int c = ((lane >> 5) & 1) * 8 + ((lane >> 4) & 1) * 4 + ((lane >> 3) & 1) * 2 + ((lane >> 2) & 1); ((float*)(ws + WS_BA))[(size_t)row * 16 + c] = p[0]; }
        }
    }
    if (fuse) __syncthreads();
#undef a
}
__global__ void __launch_bounds__(512, 2) fwd(Args a) {
    extern __shared__ __attribute__((aligned(16))) unsigned char lds_raw[];
    LAS unsigned char* lds = (LAS unsigned char*)lds_raw;
    volatile LAS unsigned* MISC = (volatile LAS unsigned*)(lds + LDS_MISC);
    if (threadIdx.x < 16) MISC[threadIdx.x] = 0u;
    __syncthreads();
    XcdBarrier bar; bar.bar = (unsigned*)(a.ws + WS_CTL) + 4096; bar.x = 0; bar.st = MISC + 8;
    bar = xcd_barrier_post((unsigned*)(a.ws + WS_CTL) + 4096, MISC + 8);
#ifndef PHASE_MASK
#define PHASE_MASK 0x1FFF
#endif
#define EN(i) ((PHASE_MASK >> (i)) & 1)
#ifndef REP_MASK
#define REP_MASK 0
#endif
#define REPN(i) (1 + ((REP_MASK >> (i)) & 1))
#define IN(k) true
#define SEAM(k) do { XcdBarrier b_; b_.bar = (unsigned*)(get_args()->ws + WS_CTL) + 4096; b_.x = xb_xcc_id(); b_.st = (volatile LAS unsigned*)(lds + LDS_MISC) + 8; xcd_barrier(b_); } while (0)
    for (int rep_ = 0; rep_ < (REPN(0)); ++rep_) if (EN(0) && IN(0)) phase_prologue(lds);
    SEAM(0);
#pragma unroll 1
    for (int l_ = 0; l_ < DEPTH; ++l_) {
        int l = l_; asm volatile("" : "+s"(l));
        const int pb = 1 + l * NPH_L;
        const int mrows = (l == DEPTH - 1) ? ML : M;
        if (l == 0) { for (int rep_ = 0; rep_ < (REPN(1)); ++rep_) if (EN(1) && IN(pb + 0)) { phase_norm<true>(l, 0, lds); phase_quant_weights(lds); }
            SEAM(pb + 0); }
        for (int rep_ = 0; rep_ < (REPN(2)); ++rep_) if (EN(2) && IN(pb + 1)) { const KArgs ap = get_args(); unsigned char* ws = ap->ws; pg8::Gemm g{(const bf16_t*)(ws + WS_H), (const bf16_t*)((const signed char*)(ws + WS_WINT) + (size_t)l * NP * 1024), M, NP, 512}; pg8::StaticOrder S; S.init(M, NP, fresh_g(), fresh_bx());
            pg8::EpiBf16I8 E{(bf16_t*)(ws + WS_P), NP, (const float*)(ws + WS_GB), (const float*)(ws + WS_CTL) + CW_WMAX + (l * 3 + 0) * 3072}; pg8::gemm_phase(lds, g, S, E); }
        SEAM(pb + 1);
        for (int rep_ = 0; rep_ < (REPN(3)); ++rep_) if (EN(3) && IN(pb + 2)) { phase_dn_chunkprep<1>(l, lds); phase_prep(l, lds); }
        for (int rep_ = 0; rep_ < (REPN(4)); ++rep_) if (EN(4) && IN(pb + 3)) phase_dn_chunkprep<0>(l, lds);
        SEAM(pb + 3);
        for (int rep_ = 0; rep_ < (REPN(5)); ++rep_) if (EN(5) && IN(pb + 4)) { phase_dn_scan<0>(l, lds); __syncthreads(); phase_attn(l, lds_raw, MISC, rep_); }
        SEAM(pb + 4);
        for (int rep_ = 0; rep_ < (REPN(7)); ++rep_) if (EN(7) && IN(pb + 5)) phase_dn_out(l);
        SEAM(pb + 5);
        if (EN(8) && IN(pb + 6)) { const KArgs ap = get_args(); unsigned char* ws = ap->ws; pg8::Gemm g{(const bf16_t*)(ws + WS_CATQ), (const bf16_t*)((const signed char*)(ws + WS_WOUTT) + (size_t)l * 1024 * 1024), mrows, 1024, 512}; pg8::StaticOrder S; S.init(mrows, 1024, fresh_g(), fresh_bx());
            pg8::EpiResI8 E{l == 0 ? ap->in[I_X] : ap->out, l == 0 ? ap->in[I_CTX] : (const float*)(ws + WS_CTXX), ap->out, (float*)(ws + WS_CTXX), (const float*)(ws + WS_MOD) + (size_t)l * 3 * 6144 + 2048,
                              (const float*)(ws + WS_GB) + (1u << 18), (const float*)(ws + WS_CTL) + CW_WMAX + (l * 3 + 1) * 3072};
            pg8::gemm_phase(lds, g, S, E); }
        SEAM(pb + 6);
        for (int rep_ = 0; rep_ < (REPN(9)); ++rep_) if (EN(9) && IN(pb + 7)) phase_norm<false>(l, 1, lds);
        SEAM(pb + 7);
        for (int rep_ = 0; rep_ < (REPN(10)); ++rep_) if (EN(10) && IN(pb + 8)) { const KArgs ap = get_args(); unsigned char* ws = ap->ws; pg8::Gemm g{(const bf16_t*)(ws + WS_H), (const bf16_t*)((const signed char*)(ws + WS_WQT) + (size_t)l * 2048 * 1024), mrows, 2048, 512}; pg8::StaticOrder S; S.init(mrows, 2048, fresh_g(), fresh_bx());
            pg8::EpiBf16I8 E{(bf16_t*)(ws + WS_P), 2048, (const float*)(ws + WS_GB), (const float*)(ws + WS_CTL) + CW_WMAX + (l * 3 + 2) * 3072}; pg8::gemm_phase(lds, g, S, E); }
        SEAM(pb + 8);
        for (int rep_ = 0; rep_ < (REPN(11)); ++rep_) if (EN(11) && IN(pb + 9)) phase_peer_select(l);
        SEAM(pb + 9);
        #ifdef GATHER_VAR
        if (EN(12) && IN(pb + 10)) phase_peer_gather<false, GATHER_VAR>(l, lds);
#endif
#if GATHER_PART
        if (EN(12) && IN(pb + 10)) phase_peer_gpart(l, lds);
        SEAM(pb + 10);
        if (EN(12) && IN(pb + 10)) phase_peer_combine(l, lds);
#else
        if (REPN(12) > 1 && EN(12) && IN(pb + 10)) phase_peer_gather<false>(l, lds);
        if (EN(12) && IN(pb + 10)) phase_peer_gather<true>(l, lds);
#endif
        if (l + 1 < DEPTH) SEAM(pb + 10);
    }
#undef IN
#undef SEAM
}

#ifndef N_LAUNCH_MODE
#define N_LAUNCH_MODE 1
#endif
extern "C" void kernel_launch(void* const* d_in, const int* in_sizes, int n_in, void* d_out, int out_size, void* d_ws, size_t ws_size, hipStream_t stream) {
    static int grid = 0;
    if (grid == 0) {
        if (n_in != 20 || out_size != ML * D || ws_size < WS_END) { fprintf(stderr, "kernel_launch: unexpected shapes: n_in %d out %d ws %zu (need %zu)\n", n_in, out_size, ws_size, (size_t)WS_END); grid = -1; return; }
        int dev = 0, cus = 0, per_cu = 0;
        if (hipGetDevice(&dev) != hipSuccess || hipDeviceGetAttribute(&cus, hipDeviceAttributeMultiprocessorCount, dev) != hipSuccess) { grid = -1; return; }
        if (hipFuncSetAttribute((const void*)fwd, hipFuncAttributeMaxDynamicSharedMemorySize, LDS_BYTES) != hipSuccess) { fprintf(stderr, "kernel_launch: hipFuncSetAttribute failed\n"); grid = -1; return; }
        if (hipOccupancyMaxActiveBlocksPerMultiprocessor(&per_cu, (const void*)fwd, 512, LDS_BYTES) != hipSuccess || per_cu < 1) fprintf(stderr, "kernel_launch: occupancy query says %d\n", per_cu);
        (void)hipGetLastError();
        grid = cus;
    }
    if (grid < 0) return;
    (void)hipMemsetAsync((char*)d_ws + WS_CTL, 0, CTL_BYTES, stream);
    Args a{};
    for (int i = 0; i < 20; ++i) a.in[i] = (const float*)d_in[i];
    a.out = (float*)d_out; a.ws = (unsigned char*)d_ws;
    a.ph_lo = 0; a.ph_hi = NPHASE;
    hipLaunchKernelGGL(fwd, dim3(grid), dim3(512), LDS_BYTES, stream, a);
    const hipError_t le = hipPeekAtLastError();
    if (le != hipSuccess) fprintf(stderr, "kernel_launch: launch failed: %s\n", hipGetErrorName(le));
}
```

```cpp
#include <hip/hip_runtime.h>
#ifndef GATHER_PART
#define GATHER_PART 2
#endif
#include <cstdio>
#include <cstdint>

#define GAS __attribute__((address_space(1)))
#define LAS __attribute__((address_space(3)))
typedef unsigned short bf16_t;
typedef short bf16x8 __attribute__((ext_vector_type(8)));
typedef short s16x4 __attribute__((ext_vector_type(4)));
typedef float f32x4 __attribute__((ext_vector_type(4)));
typedef float f32x2 __attribute__((ext_vector_type(2)));
typedef float f32x16 __attribute__((ext_vector_type(16)));
typedef unsigned u32x4 __attribute__((ext_vector_type(4)));
typedef unsigned u32x2 __attribute__((ext_vector_type(2)));
typedef int i32x4 __attribute__((ext_vector_type(4)));

constexpr int D = 1024, NB = 2, T = 16384, DEPTH = 4, CT = 256;
constexpr int ML = NB * T, MC = NB * CT, M = ML + MC;
constexpr int NIN = 3088, NP = 3072;
constexpr int KVLEN = T + CT;
constexpr int NEXP = 16384;
constexpr float EPS = 1e-6f;
constexpr int NPH_L = 11;
constexpr int NPHASE = 1 + DEPTH * NPH_L;

constexpr size_t MiB = 1u << 20;
constexpr size_t WS_CTL = 0, CTL_BYTES = 1 * MiB;
constexpr size_t WS_MOD = 1 * MiB;
constexpr size_t WS_ROPE = 2 * MiB;
constexpr size_t WS_WSK = 3 * MiB;
constexpr size_t WS_CTXX = 4 * MiB;
constexpr size_t WS_WINT = 8 * MiB;
constexpr size_t WS_WOUTT = 32 * MiB;
constexpr size_t WS_WQT = 40 * MiB;
constexpr size_t WS_SKB = 56 * MiB;
constexpr size_t WS_USC = 58 * MiB;
constexpr size_t WS_UB = 64 * MiB;
constexpr size_t WS_VB = 80 * MiB;
constexpr size_t TAB_SET = 32 * MiB;
constexpr size_t WS_H = 128 * MiB;
static_assert(WS_H + 2 * (size_t)M * 1024 <= 193 * MiB, "H + concat int8");
constexpr size_t WS_CATQ = WS_H + (size_t)M * 1024;
constexpr size_t WS_P = 193 * MiB;
constexpr size_t WS_QA = 388 * MiB;
constexpr size_t WS_KA = 421 * MiB;
constexpr size_t WS_VA = 438 * MiB;
constexpr size_t WS_CAT = 455 * MiB;
constexpr size_t WS_DQ = 520 * MiB;
constexpr size_t WS_DK = 553 * MiB;
constexpr size_t WS_DV = 586 * MiB;
constexpr size_t WS_OF = 619 * MiB;
constexpr size_t WS_OB = 684 * MiB;
constexpr size_t WS_GB = 749 * MiB;
constexpr size_t WS_BA = 752 * MiB;
constexpr size_t WS_PIDX = 755 * MiB;
constexpr size_t WS_PGATE = 772 * MiB;
constexpr size_t WS_REC = 789 * MiB;
constexpr size_t WS_END = 990 * MiB;
constexpr int CW_WMAX = 65536;
constexpr int NCH = 260;
constexpr int REC_K = 0, REC_KT = 16384, REC_Q = 32768, REC_V = 49152, REC_DIR = 65536, REC_DIRSZ = 17408, REC_BYTES = REC_DIR + 2 * REC_DIRSZ;
static_assert((size_t)NB * 4 * NCH * REC_BYTES + WS_REC <= WS_END, "rec region");

constexpr int LDS_BYTES = 163840;
constexpr int LDS_MISC = 163840 - 256;

__device__ __forceinline__ float bf2f(unsigned b) { return __uint_as_float(b << 16); }
__device__ __forceinline__ float bflo(unsigned w) { return __uint_as_float(w << 16); }
__device__ __forceinline__ float bfhi(unsigned w) { return __uint_as_float(w & 0xffff0000u); }
typedef __bf16 bf2v __attribute__((ext_vector_type(2)));
__device__ __forceinline__ unsigned pkbf(float lo, float hi) { unsigned r; asm("v_cvt_pk_bf16_f32 %0, %1, %2" : "=v"(r) : "v"(lo), "v"(hi)); return r; }
__device__ __forceinline__ unsigned pkbf_c(float lo, float hi) { f32x2 v = {lo, hi}; bf2v r = __builtin_convertvector(v, bf2v); return __builtin_bit_cast(unsigned, r); }
template <int K> __device__ __forceinline__ float lane_xor(float v) {
    const int b = __builtin_bit_cast(int, v);
    if constexpr (K == 1) return __builtin_bit_cast(float, __builtin_amdgcn_update_dpp(0, b, 0xB1, 0xF, 0xF, true));
    else if constexpr (K == 2) return __builtin_bit_cast(float, __builtin_amdgcn_update_dpp(0, b, 0x4E, 0xF, 0xF, true));
    else if constexpr (K == 32) { auto rr = __builtin_amdgcn_permlane32_swap((unsigned)b, (unsigned)b, false, false); unsigned ln_ = __builtin_amdgcn_mbcnt_hi(~0u, __builtin_amdgcn_mbcnt_lo(~0u, 0u)); asm volatile("" : "+v"(ln_));
        return __uint_as_float((ln_ & 32u) ? rr[0] : rr[1]); }
    else return __builtin_bit_cast(float, __builtin_amdgcn_ds_swizzle(b, 0x1F | (K << 10)));
}
__device__ __forceinline__ float wave_sum(float v) {
    v += lane_xor<1>(v); v += lane_xor<2>(v);
    v += __builtin_bit_cast(float, __builtin_amdgcn_update_dpp(0, __builtin_bit_cast(int, v), 0x124, 0xF, 0xF, true));
    v += __builtin_bit_cast(float, __builtin_amdgcn_update_dpp(0, __builtin_bit_cast(int, v), 0x128, 0xF, 0xF, true));
    v += lane_xor<16>(v);
    { auto rr = __builtin_amdgcn_permlane32_swap(__float_as_uint(v), __float_as_uint(v), false, false); v = __uint_as_float(rr[0]) + __uint_as_float(rr[1]); }
    return v;
}
__device__ __forceinline__ float wave_max(float v) {
    v = fmaxf(v, lane_xor<1>(v)); v = fmaxf(v, lane_xor<2>(v));
    v = fmaxf(v, __builtin_bit_cast(float, __builtin_amdgcn_update_dpp(0, __builtin_bit_cast(int, v), 0x124, 0xF, 0xF, true)));
    v = fmaxf(v, __builtin_bit_cast(float, __builtin_amdgcn_update_dpp(0, __builtin_bit_cast(int, v), 0x128, 0xF, 0xF, true)));
    v = fmaxf(v, lane_xor<16>(v));
    { auto rr = __builtin_amdgcn_permlane32_swap(__float_as_uint(v), __float_as_uint(v), false, false); v = fmaxf(__uint_as_float(rr[0]), __uint_as_float(rr[1])); }
    return v;
}
__device__ __forceinline__ float silu_f(float x) { return x / (1.f + __expf(-x)); }
#define LDS_WAIT() asm volatile("s_waitcnt lgkmcnt(0)" ::: "memory")

#define XB_TMO      128
#define XB_XCNT(j)  (256  + 64 * (j))
#define XB_XSUB(j)  (1280 + 64 * (j))
#define XB_XGEN(j)  (2304 + 64 * (j))
#define XB_TOP      3328
#define XB_TOPGEN   3392
#define XCD_BAR_WORDS 3456
#define XB_SPIN_CAP (1u << 22)
__device__ __forceinline__ unsigned xb_ld(unsigned* p)              { return __hip_atomic_load(p, __ATOMIC_RELAXED, __HIP_MEMORY_SCOPE_AGENT); }
__device__ __forceinline__ unsigned xb_add(unsigned* p, unsigned v) { return __hip_atomic_fetch_add(p, v, __ATOMIC_RELAXED, __HIP_MEMORY_SCOPE_AGENT); }
__device__ __forceinline__ unsigned xb_xcc_id() { return (unsigned)__builtin_amdgcn_s_getreg((3 << 11) | 20) & 0xFu; }
#define XB_SPIN(cond, bar) do { unsigned _sp = 0; while (cond) { __builtin_amdgcn_s_sleep(1); \
    if ((++_sp & 255u) == 0u) { if (xb_ld(&(bar)[XB_TMO])) break; if (_sp > XB_SPIN_CAP) { atomicAdd(&(bar)[XB_TMO], 1u); break; } } } } while (0)
struct XcdBarrier { unsigned* bar; unsigned x; volatile LAS unsigned* st; };
__device__ __forceinline__ XcdBarrier xcd_barrier_post(unsigned* bar, volatile LAS unsigned* st) {
    XcdBarrier b; b.bar = bar; b.x = xb_xcc_id(); b.st = st;
    if (threadIdx.x == 0) (void)xb_add(&bar[XB_XCNT(b.x)], 1u);
    return b;
}
__device__ __forceinline__ void xcd_barrier_complete(unsigned* bar, unsigned x, unsigned& nloc, unsigned& nx) {
    const unsigned G = gridDim.x * gridDim.y * gridDim.z;
    unsigned sum, cnt, mine, sp = 0u;
    for (;;) {
        sum = 0u; cnt = 0u; mine = 0u;
#pragma unroll
        for (unsigned j = 0; j < 16; ++j) { const unsigned c = xb_ld(&bar[XB_XCNT(j)]); sum += c; cnt += (c > 0u) ? 1u : 0u; mine = (j == x) ? c : mine; }
        if (sum == G) break;
        __builtin_amdgcn_s_sleep(1);
        if ((++sp & 255u) == 0u) { if (xb_ld(&bar[XB_TMO])) break; if (sp > XB_SPIN_CAP) { atomicAdd(&bar[XB_TMO], 1u); break; } }
    }
    nloc = mine > 0u ? mine : 1u; nx = cnt > 0u ? cnt : 1u;
}
__device__ __forceinline__ void xcd_barrier(const XcdBarrier& b) {
    asm volatile("s_waitcnt vmcnt(0)" ::: "memory");
    __syncthreads();
    if (threadIdx.x == 0) {
        unsigned* bar = b.bar; unsigned bx_ = b.x;
        asm volatile("" : "+s"(bar), "+s"(bx_));
        __builtin_amdgcn_s_waitcnt(0);
        unsigned nloc = b.st[0], nx = b.st[1];
        if (nloc == 0u) { xcd_barrier_complete(bar, bx_, nloc, nx); b.st[0] = nloc; b.st[1] = nx; }
        const unsigned old = xb_add(&bar[XB_XSUB(bx_)], 1u);
        const unsigned gen = old / nloc;
        if (old + 1u == (gen + 1u) * nloc) {
            __builtin_amdgcn_fence(__ATOMIC_RELEASE, "agent");
            asm volatile("s_waitcnt vmcnt(0)" ::: "memory");
            const unsigned og = xb_add(&bar[XB_TOP], 1u);
            const unsigned tg = og / nx;
            if (og + 1u == (tg + 1u) * nx) xb_add(&bar[XB_TOPGEN], 1u);
            else XB_SPIN(xb_ld(&bar[XB_TOPGEN]) == tg, bar);
            __builtin_amdgcn_fence(__ATOMIC_ACQUIRE, "agent");
            xb_add(&bar[XB_XGEN(bx_)], 1u);
            asm volatile("s_waitcnt vmcnt(0)" ::: "memory");
        } else {
            XB_SPIN(xb_ld(&bar[XB_XGEN(bx_)]) == gen, bar);
            __builtin_amdgcn_fence(__ATOMIC_ACQUIRE, "agent");
            asm volatile("s_waitcnt vmcnt(0)" ::: "memory");
        }
    }
    __syncthreads();
}

namespace pg8 {
constexpr int BM = 256, BK = 64, HALF = 128, HTB = HALF * BK * 2, STAGE_BYTES = 8 * HTB, NXCD = 8, WGM = 8;
__host__ __device__ __forceinline__ int lds_byte(int r, int c) { const int st = (r >> 4) * 2 + (c >> 5), rr = r & 15, cc = c & 31, ob = rr * 64 + cc * 2; return st * 1024 + (ob ^ (((ob >> 9) & 1) << 5)); }
__host__ __device__ __forceinline__ void stage_rc(int b, int& R, int& C) { const int st = b / 1024, sb = b % 1024, swz = sb ^ (((sb >> 9) & 1) << 5); R = (st >> 1) * 16 + swz / 64; C = (st & 1) * 32 + (swz % 64) / 2; }
__host__ __device__ __forceinline__ int perm32(int rho) { const int n = rho >> 4, i = rho & 15; return 8 * (i >> 2) + 4 * n + (i & 3); }
struct Unit { int pm, pn; };
struct Gemm { const bf16_t* A; const bf16_t* Bt; int M, N, K; };
struct StaticOrder {
    int nM, nN, nwg, G, c;
    __host__ __device__ void init(int M_, int N_, int G_, int c_) { nM = M_ / BM; nN = N_ / BM; nwg = nM * nN; G = G_; c = c_; }
    __host__ __device__ bool next(int i, Unit& u) const {
        const long L = (long)i * G + c; if (L >= nwg) return false;
        int wgid = (int)L; { const int q = nwg / NXCD, r = nwg % NXCD, xcd = wgid % NXCD, off = wgid / NXCD; wgid = (xcd < r ? xcd * (q + 1) : r * (q + 1) + (xcd - r) * q) + off; }
        const int nig = WGM * nN, gid = wgid / nig, fm = gid * WGM, gsz = (nM - fm) < WGM ? (nM - fm) : WGM;
        u.pm = fm + ((wgid % nig) % gsz); u.pn = (wgid % nig) / gsz; return true;
    }
    __device__ __forceinline__ void a_ready(const Unit&) const {}
    __device__ __forceinline__ void done(const Unit&) const {}
};
struct EpiBf16 {
    static constexpr bool PERM = true, I8 = false; typedef f32x4 acc_t;
    bf16_t* O; int ldc;
    __device__ __forceinline__ void operator()(const f32x4 (&acc)[2][2][4][2], const Unit& u, int wr, int wc, int fr, int fq) const {
        const int row0 = u.pm * BM + wr * 64 + fr; const int col0 = u.pn * BM + wc * 32 + 8 * fq;
#pragma unroll
        for (int ai = 0; ai < 2; ++ai)
#pragma unroll
            for (int m = 0; m < 4; ++m) { bf16_t* rowp = O + (size_t)(row0 + ai * HALF + m * 16) * ldc + col0;
#pragma unroll
                for (int bj = 0; bj < 2; ++bj) { const f32x4 v0 = acc[ai][bj][m][0], v1 = acc[ai][bj][m][1];
                    u32x4 w; w.x = pkbf_c(v0[0], v0[1]); w.y = pkbf_c(v0[2], v0[3]); w.z = pkbf_c(v1[0], v1[1]); w.w = pkbf_c(v1[2], v1[3]);
                    *(u32x4*)(rowp + bj * HALF) = w; } }
    }
};
struct EpiBf16I8 {
    static constexpr bool PERM = true, I8 = true; typedef i32x4 acc_t;
    bf16_t* O; int ldc; const float* sa; const float* wmax;
    __device__ __forceinline__ void operator()(const i32x4 (&acc)[2][2][4][2], const Unit& u, int wr, int wc, int fr, int fq) const {
        const int row0 = u.pm * BM + wr * 64 + fr; const int col0 = u.pn * BM + wc * 32 + 8 * fq;
        f32x4 sw[2][2];
#pragma unroll
        for (int bj = 0; bj < 2; ++bj)
#pragma unroll
            for (int n = 0; n < 2; ++n) sw[bj][n] = *(const f32x4*)(wmax + col0 + bj * HALF + 4 * n) * (1.f / 127.f);
#pragma unroll
        for (int ai = 0; ai < 2; ++ai)
#pragma unroll
            for (int m = 0; m < 4; ++m) { const int row = row0 + ai * HALF + m * 16; const float sr = sa[row]; bf16_t* rowp = O + (size_t)row * ldc + col0;
#pragma unroll
                for (int bj = 0; bj < 2; ++bj) { const i32x4 a0 = acc[ai][bj][m][0], a1 = acc[ai][bj][m][1];
                    const f32x4 v0 = (f32x4){(float)a0[0], (float)a0[1], (float)a0[2], (float)a0[3]} * sw[bj][0] * sr, v1 = (f32x4){(float)a1[0], (float)a1[1], (float)a1[2], (float)a1[3]} * sw[bj][1] * sr;
                    u32x4 w; w.x = pkbf(v0[0], v0[1]); w.y = pkbf(v0[2], v0[3]); w.z = pkbf(v1[0], v1[1]); w.w = pkbf(v1[2], v1[3]);
                    *(u32x4*)(rowp + bj * HALF) = w; } }
    }
};
struct EpiRes {
    static constexpr bool PERM = false, I8 = false; typedef f32x4 acc_t;
    const float* src_lat; const float* src_ctx; float* dst_lat; float* dst_ctx; const float* gate;
    __device__ __forceinline__ void operator()(const f32x4 (&acc)[2][2][4][2], const Unit& u, int wr, int wc, int fr, int fq) const {
        const bool isctx = u.pm >= (ML / BM);
        const float* src = isctx ? src_ctx + (size_t)(u.pm - ML / BM) * BM * D : src_lat + (size_t)u.pm * BM * D;
        float* dst = isctx ? dst_ctx + (size_t)(u.pm - ML / BM) * BM * D : dst_lat + (size_t)u.pm * BM * D;
        const int mrow = isctx ? 2 : (u.pm >= (T / BM) ? 1 : 0);
        const int row0 = wr * 64 + fr, col0 = u.pn * BM + wc * 32 + 4 * fq;
        f32x4 gv[2][2];
#pragma unroll
        for (int bj = 0; bj < 2; ++bj)
#pragma unroll
            for (int n = 0; n < 2; ++n) gv[bj][n] = *(const f32x4*)(gate + mrow * 6144 + col0 + bj * HALF + n * 16);
#pragma unroll
        for (int ai = 0; ai < 2; ++ai)
#pragma unroll
            for (int m = 0; m < 4; ++m) { const size_t off = (size_t)(row0 + ai * HALF + m * 16) * D + col0;
#pragma unroll
                for (int bj = 0; bj < 2; ++bj)
#pragma unroll
                    for (int n = 0; n < 2; ++n) { const f32x4 s = *(const f32x4*)(src + off + bj * HALF + n * 16);
                        *(f32x4*)(dst + off + bj * HALF + n * 16) = s + gv[bj][n] * acc[ai][bj][m][n]; } }
    }
};

struct EpiResI8 {
    static constexpr bool PERM = false, I8 = true; typedef i32x4 acc_t;
    const float* src_lat; const float* src_ctx; float* dst_lat; float* dst_ctx; const float* gate; const float* sa; const float* wmax;
    __device__ __forceinline__ void operator()(const i32x4 (&acc)[2][2][4][2], const Unit& u, int wr, int wc, int fr, int fq) const {
        const bool isctx = u.pm >= (ML / BM);
        const float* src = isctx ? src_ctx + (size_t)(u.pm - ML / BM) * BM * D : src_lat + (size_t)u.pm * BM * D;
        float* dst = isctx ? dst_ctx + (size_t)(u.pm - ML / BM) * BM * D : dst_lat + (size_t)u.pm * BM * D;
        const int mrow = isctx ? 2 : (u.pm >= (T / BM) ? 1 : 0);
        const int row0 = wr * 64 + fr, col0 = u.pn * BM + wc * 32 + 4 * fq;
        f32x4 gv[2][2];
#pragma unroll
        for (int bj = 0; bj < 2; ++bj)
#pragma unroll
            for (int n = 0; n < 2; ++n) gv[bj][n] = *(const f32x4*)(gate + mrow * 6144 + col0 + bj * HALF + n * 16) * *(const f32x4*)(wmax + col0 + bj * HALF + n * 16) * (1.f / 127.f);
#pragma unroll
        for (int ai = 0; ai < 2; ++ai)
#pragma unroll
            for (int m = 0; m < 4; ++m) { const int rl = row0 + ai * HALF + m * 16; const float sr = sa[u.pm * BM + rl]; const size_t off = (size_t)rl * D + col0;
#pragma unroll
                for (int bj = 0; bj < 2; ++bj)
#pragma unroll
                    for (int n = 0; n < 2; ++n) { const f32x4 sv = *(const f32x4*)(src + off + bj * HALF + n * 16); const i32x4 ac = acc[ai][bj][m][n];
                        *(f32x4*)(dst + off + bj * HALF + n * 16) = sv + gv[bj][n] * ((f32x4){(float)ac[0], (float)ac[1], (float)ac[2], (float)ac[3]} * sr); } }
    }
};
template <class Epi, class Sched>
__device__ __forceinline__ void gemm_phase(LAS unsigned char* lds, const Gemm g, const Sched& S, const Epi& E) {
    constexpr bool I8 = Epi::I8;
    typedef typename Epi::acc_t acc_t;
    int tid = threadIdx.x; asm volatile("" : "+v"(tid)); const int wid = __builtin_amdgcn_readfirstlane(tid >> 6), lane = tid & 63, wr = wid >> 2, wc = wid & 3, fr = lane & 15, fq = lane >> 4;
    const int K = g.K, nt = K / BK;
    unsigned voffA[2], voffB[2];
#pragma unroll
    for (int i = 0; i < 2; ++i) { int R, C; stage_rc(tid * 16 + i * 8192, R, C); const int Rb = Epi::PERM ? ((R & ~31) + perm32(R & 31)) : R;
        voffA[i] = (unsigned)(R * K + C) * 2u; voffB[i] = (unsigned)(Rb * K + C) * 2u; }
    const size_t kstep = (size_t)(BK * 2);
    const size_t hstep = (size_t)HALF * K * 2;
    const size_t tstep = 2 * hstep;
    const unsigned ldsw = (unsigned)wid * 1024u;
    const int aoff = lds_byte(wr * 64 + fr, fq * 8), boff = lds_byte(wc * 32 + fr, fq * 8);
#define PG8_SA(b, h) (((b) * 2 + (h)) * HTB)
#define PG8_SB(b, h) ((4 + (b) * 2 + (h)) * HTB)
#define PG8_STAGE(bufoff, gbase, voff) do { _Pragma("unroll") for (int _i = 0; _i < 2; ++_i) \
        __builtin_amdgcn_global_load_lds((const unsigned*)((const char*)(gbase) + (voff)[_i]), (LAS unsigned*)(lds + (bufoff) + ldsw + _i * 8192), 16, 0, 0); } while (0)
#define PG8_LDA(dst, b, h) do { _Pragma("unroll") for (int m = 0; m < 4; ++m) _Pragma("unroll") for (int k = 0; k < 2; ++k) dst[m][k] = *(const LAS bf16x8*)(lds + PG8_SA(b, h) + aoff + m * 2048 + k * 1024); } while (0)
#define PG8_LDB(dst, b, h) do { _Pragma("unroll") for (int n = 0; n < 2; ++n) _Pragma("unroll") for (int k = 0; k < 2; ++k) dst[n][k] = *(const LAS bf16x8*)(lds + PG8_SB(b, h) + boff + n * 2048 + k * 1024); } while (0)
#define PG8_MMA(ai, bj, At, Bt) do { __builtin_amdgcn_s_setprio(1); _Pragma("unroll") for (int m = 0; m < 4; ++m) _Pragma("unroll") for (int n = 0; n < 2; ++n) _Pragma("unroll") for (int k = 0; k < 2; ++k) \
        { if constexpr (I8) acc[ai][bj][m][n] = __builtin_bit_cast(acc_t, __builtin_amdgcn_mfma_i32_16x16x64_i8(__builtin_bit_cast(i32x4, Bt[n][k]), __builtin_bit_cast(i32x4, At[m][k]), __builtin_bit_cast(i32x4, acc[ai][bj][m][n]), 0, 0, 0)); \
          else acc[ai][bj][m][n] = __builtin_bit_cast(acc_t, __builtin_amdgcn_mfma_f32_16x16x32_bf16(Bt[n][k], At[m][k], __builtin_bit_cast(f32x4, acc[ai][bj][m][n]), 0, 0, 0)); } __builtin_amdgcn_s_setprio(0); } while (0)
#define PG8_WAIT_V(n) asm volatile("s_waitcnt vmcnt(" #n ")" ::: "memory")
#define PG8_WAIT_L(n) asm volatile("s_waitcnt lgkmcnt(" #n ")" ::: "memory")
#define PG8_BAR __builtin_amdgcn_s_barrier()
#define PG8_SCHED __builtin_amdgcn_sched_barrier(0)
    Unit cur, nxt; int ui = 0;
    if (!S.next(0, cur)) return;
    acc_t acc[2][2][4][2];
#pragma unroll
    for (int a = 0; a < 2; ++a)
#pragma unroll
        for (int b = 0; b < 2; ++b)
#pragma unroll
            for (int m = 0; m < 4; ++m)
#pragma unroll
                for (int n = 0; n < 2; ++n) acc[a][b][m][n] = acc_t{};
    bf16x8 At[4][2], B0[2][2], B1[2][2];
    const char* cA = (const char*)g.A + (size_t)cur.pm * tstep; const char* cB = (const char*)g.Bt + (size_t)cur.pn * tstep;
    S.a_ready(cur);
    PG8_STAGE(PG8_SB(0, 0), cB, voffB); PG8_STAGE(PG8_SA(0, 0), cA, voffA); PG8_STAGE(PG8_SB(0, 1), cB + hstep, voffB); PG8_STAGE(PG8_SA(0, 1), cA + hstep, voffA);
    if (wr == 1) PG8_BAR;
    PG8_WAIT_V(4); PG8_BAR;
    PG8_STAGE(PG8_SB(1, 0), cB + kstep, voffB); PG8_STAGE(PG8_SA(1, 0), cA + kstep, voffA); PG8_STAGE(PG8_SB(1, 1), cB + hstep + kstep, voffB);
    PG8_WAIT_V(6); PG8_BAR;
    for (;;) {
        const bool has_next = S.next(ui + 1, nxt);
        const char* nA = has_next ? (const char*)g.A + (size_t)nxt.pm * tstep : cA; const char* nB = has_next ? (const char*)g.Bt + (size_t)nxt.pn * tstep : cB;
        for (int t = 0; t < nt; t += 2) {
            const bool last = (t == nt - 2);
            const char* a1 = cA + (size_t)(t + 1) * kstep;
            const char* a2 = last ? nA : cA + (size_t)(t + 2) * kstep; const char* b2 = last ? nB : cB + (size_t)(t + 2) * kstep;
            const char* a3 = a2 + kstep; const char* b3 = b2 + kstep;
            if (last && has_next) S.a_ready(nxt);
            PG8_LDB(B0, 0, 0); PG8_SCHED; PG8_LDA(At, 0, 0); PG8_STAGE(PG8_SA(1, 1), a1 + hstep, voffA);
            PG8_WAIT_L(8); PG8_BAR; PG8_WAIT_L(0); PG8_MMA(0, 0, At, B0); PG8_BAR; PG8_SCHED;
            PG8_LDB(B1, 0, 1); PG8_STAGE(PG8_SB(0, 0), b2, voffB);
            PG8_BAR; PG8_WAIT_L(0); PG8_MMA(0, 1, At, B1); PG8_BAR;
            PG8_LDA(At, 0, 1); PG8_STAGE(PG8_SA(0, 0), a2, voffA);
            PG8_BAR; PG8_WAIT_L(0); PG8_MMA(1, 0, At, B0); PG8_BAR; PG8_SCHED;
            PG8_STAGE(PG8_SB(0, 1), b2 + hstep, voffB);
            PG8_WAIT_V(6); PG8_BAR; PG8_MMA(1, 1, At, B1); PG8_BAR;
            PG8_LDB(B0, 1, 0); PG8_SCHED; PG8_LDA(At, 1, 0); PG8_STAGE(PG8_SA(0, 1), a2 + hstep, voffA);
            PG8_WAIT_L(8); PG8_BAR; PG8_WAIT_L(0); PG8_MMA(0, 0, At, B0); PG8_BAR; PG8_SCHED;
            PG8_LDB(B1, 1, 1); PG8_STAGE(PG8_SB(1, 0), b3, voffB);
            PG8_BAR; PG8_WAIT_L(0); PG8_MMA(0, 1, At, B1); PG8_BAR;
            PG8_LDA(At, 1, 1); PG8_STAGE(PG8_SA(1, 0), a3, voffA);
            PG8_BAR; PG8_WAIT_L(0); PG8_MMA(1, 0, At, B0); PG8_BAR; PG8_SCHED;
            PG8_STAGE(PG8_SB(1, 1), b3 + hstep, voffB);
            PG8_WAIT_V(6); PG8_BAR; PG8_MMA(1, 1, At, B1); PG8_BAR;
        }
        E(acc, cur, wr, wc, fr, fq); S.done(cur);
        if (!has_next) break;
#pragma unroll
        for (int a = 0; a < 2; ++a)
#pragma unroll
            for (int b = 0; b < 2; ++b)
#pragma unroll
                for (int m = 0; m < 4; ++m)
#pragma unroll
                    for (int n = 0; n < 2; ++n) acc[a][b][m][n] = acc_t{};
        cur = nxt; cA = nA; cB = nB; ++ui;
    }
    PG8_WAIT_V(0);
    if (wr == 0) PG8_BAR;
    PG8_BAR;
#undef PG8_SA
#undef PG8_SB
#undef PG8_STAGE
#undef PG8_LDA
#undef PG8_LDB
#undef PG8_MMA
#undef PG8_WAIT_V
#undef PG8_WAIT_L
#undef PG8_BAR
#undef PG8_SCHED
}
}

namespace att {
constexpr int HD = 128, NW = 8, QBLK = 32, KVBLK = 64;
constexpr float SCALE = 0.088388347648318440f;
constexpr float THR = 8.f;
constexpr int LDQ = 512, LDK = 256;
constexpr size_t SHM_V = KVBLK * HD * 2, SHM_K = KVBLK * HD * 2, SHM_ATTN = 2 * SHM_V + 2 * SHM_K + NW * 64 * 4;
#define KSWZ(row, colB) ((row) * 256 + ((colB) ^ (((row) & 7) << 4)))
#define SBAR() __builtin_amdgcn_sched_barrier(0)
__device__ __forceinline__ int crow(int r, int hi) { return (r & 3) + 8 * (r >> 2) + 4 * hi; }
__device__ __forceinline__ unsigned cvtpk(float lo, float hi) { unsigned r; asm volatile("v_cvt_pk_bf16_f32 %0, %1, %2" : "=v"(r) : "v"(lo), "v"(hi)); return r; }
__device__ __forceinline__ void partialSM(f32x16& p0, f32x16& p1) {
  for (int r = 0; r < 16; ++r) p0[r] = __builtin_amdgcn_exp2f(p0[r]);
}
typedef int i32x8 __attribute__((ext_vector_type(8)));
__device__ __forceinline__ void finishSM(f32x16& p0, f32x16& p1, i32x8& pa) {
  for (int r = 0; r < 16; ++r) p1[r] = __builtin_amdgcn_exp2f(p1[r]);
#pragma unroll
  for (int q = 0; q < 4; ++q) { int w = __builtin_amdgcn_cvt_pk_bf8_f32(p0[4 * q], p0[4 * q + 1], 0, false); w = __builtin_amdgcn_cvt_pk_bf8_f32(p0[4 * q + 2], p0[4 * q + 3], w, true); pa[q] = w;
    int w2 = __builtin_amdgcn_cvt_pk_bf8_f32(p1[4 * q], p1[4 * q + 1], 0, false); w2 = __builtin_amdgcn_cvt_pk_bf8_f32(p1[4 * q + 2], p1[4 * q + 3], w2, true); pa[4 + q] = w2; }
}
constexpr int K8_STRIDE = 144, K8_TILE = KVBLK * K8_STRIDE;
__device__ __forceinline__ void qkt(f32x16& p0, f32x16& p1, const unsigned char* Ks, const i32x8* qr, int r32, int hi, const f32x16& cinit) {
  p0 = cinit; p1 = cinit;
#pragma unroll
  for (int ks = 0; ks < 2; ++ks) {
    const u32x4* a0 = (const u32x4*)(Ks + r32 * K8_STRIDE + 64 * ks + 32 * hi); const u32x4* a1 = (const u32x4*)(Ks + (32 + r32) * K8_STRIDE + 64 * ks + 32 * hi);
    const u32x4 x0 = a0[0], x1 = a0[1], y0 = a1[0], y1 = a1[1];
    const i32x8 k0 = {(int)x0.x, (int)x0.y, (int)x0.z, (int)x0.w, (int)x1.x, (int)x1.y, (int)x1.z, (int)x1.w}, k1 = {(int)y0.x, (int)y0.y, (int)y0.z, (int)y0.w, (int)y1.x, (int)y1.y, (int)y1.z, (int)y1.w};
    p0 = __builtin_amdgcn_mfma_scale_f32_32x32x64_f8f6f4(k0, qr[ks], p0, 0, 0, 0, 0x7F7F7F7F, 0, 0x7C7C7C7C);
    p1 = __builtin_amdgcn_mfma_scale_f32_32x32x64_f8f6f4(k1, qr[ks], p1, 0, 0, 0, 0x7F7F7F7F, 0, 0x7C7C7C7C); }
}
constexpr int V8_STRIDE = 80, V8_TILE = HD * V8_STRIDE;
__device__ __forceinline__ void pv_d0(f32x16* o, f32x16& ol, const unsigned char* Vs, const i32x8& pa, int r32, int hi) {
  { const i32x8 ones = {0x38383838, 0x38383838, 0x38383838, 0x38383838, 0x38383838, 0x38383838, 0x38383838, 0x38383838};
    ol = __builtin_amdgcn_mfma_scale_f32_32x32x64_f8f6f4(pa, ones, ol, 1, 0, 0, 0x7F7F7F7F, 0, 0x7F7F7F7F); }
#pragma unroll
  for (int d0 = 0; d0 < 4; ++d0) { const u32x4* bp = (const u32x4*)(Vs + (32 * d0 + r32) * V8_STRIDE + 32 * hi); const u32x4 x0 = bp[0], x1 = bp[1];
    const i32x8 vb = {(int)x0.x, (int)x0.y, (int)x0.z, (int)x0.w, (int)x1.x, (int)x1.y, (int)x1.z, (int)x1.w};
    o[d0] = __builtin_amdgcn_mfma_scale_f32_32x32x64_f8f6f4(pa, vb, o[d0], 1  , 0  , 0, 0x7F7F7F7F, 0, 0x7F7F7F7F); }
}
__device__ __forceinline__ void attn_dense_body(const unsigned char* __restrict__ Qb, const unsigned char* __restrict__ Kh, const unsigned char* __restrict__ Vt,
                                                bf16_t* __restrict__ Ob, int LDO, int seq, char* lds, float* __restrict__ lse, float braw) {
  int tid = threadIdx.x; asm volatile("" : "+v"(tid)); const int wid = tid >> 6, lane = tid & 63, r32 = lane & 31, hi = lane >> 5;
  unsigned char* V_lds = (unsigned char*)lds; unsigned char* K_lds = (unsigned char*)(lds + 2 * V8_TILE);
  f32x16 o[4] = {}, ol = {}; i32x8 qr[2];
  const float mnC = __builtin_bit_cast(float, __builtin_amdgcn_readfirstlane(__builtin_bit_cast(int, -fmaxf(braw * (SCALE * 1.4426950408889634f) - 15.5f, 0.f))));
  f32x16 cinit;
#pragma unroll
  for (int r = 0; r < 16; ++r) cinit[r] = mnC;
  const unsigned char* Qw = Qb + (long)(wid * QBLK + r32) * LDQ + hi * 32;
#pragma unroll
  for (int ks = 0; ks < 2; ++ks) { const u32x4 x0 = *(const u32x4*)(Qw + 64 * ks), x1 = *(const u32x4*)(Qw + 64 * ks + 16);
    qr[ks] = (i32x8){(int)x0.x, (int)x0.y, (int)x0.z, (int)x0.w, (int)x1.x, (int)x1.y, (int)x1.z, (int)x1.w}; }
  const int krow = tid >> 3, kch = tid & 7;
  const int vrow = tid >> 2, vch = tid & 3;
  struct { u32x4 v8, k8; } sr_[2];
#define SLOAD(i, k0) do { sr_[i].v8 = *reinterpret_cast<const u32x4*>(Vt + (long)((k0) >> 6) * 8192 + tid * 16); \
    sr_[i].k8 = *reinterpret_cast<const u32x4*>(Kh + (long)((k0) + krow) * LDK + kch * 16); } while (0)
#define SWRITE(b, i) do { *(u32x4*)(V_lds + (b) * V8_TILE + vrow * V8_STRIDE + vch * 16) = sr_[i].v8; \
    *(u32x4*)(K_lds + (b) * K8_TILE + krow * K8_STRIDE + kch * 16) = sr_[i].k8; } while (0)
#define SWAIT() asm volatile("s_waitcnt vmcnt(2)" ::: "memory")
  f32x16 pA0, pA1, pB0, pB1; i32x8 pa; const int NT = seq / KVBLK;
  constexpr int SE = 0, SO = 1;
  SLOAD(SE, 0); asm volatile("s_waitcnt vmcnt(0)" ::: "memory"); SWRITE(0, SE); __syncthreads();
  qkt(pA0, pA1, K_lds, qr, r32, hi, cinit); partialSM(pA0, pA1);
  SLOAD(SO, KVBLK); SLOAD(SE, 2 * KVBLK);
  SWAIT(); SWRITE(1, SO); __syncthreads();
  for (int j = 1; j + 1 < NT; j += 2) {
    SBAR(); qkt(pB0, pB1, K_lds + K8_TILE, qr, r32, hi, cinit);
    finishSM(pA0, pA1, pa); SBAR();
    SLOAD(SO, (j + 2) * KVBLK); SBAR();
    pv_d0(o, ol, V_lds, pa, r32, hi); partialSM(pB0, pB1);
    __syncthreads(); SWAIT(); SWRITE(0, SE);
    __syncthreads();
    SBAR(); qkt(pA0, pA1, K_lds, qr, r32, hi, cinit);
    finishSM(pB0, pB1, pa); SBAR();
    SLOAD(SE, (j + 3 < NT ? j + 3 : NT - 1) * KVBLK); SBAR();
    pv_d0(o, ol, V_lds + V8_TILE, pa, r32, hi); partialSM(pA0, pA1);
    __syncthreads(); SWAIT(); SWRITE(1, SO);
    __syncthreads();
  }
  SBAR(); qkt(pB0, pB1, K_lds + K8_TILE, qr, r32, hi, cinit);
  finishSM(pA0, pA1, pa); SBAR();
  pv_d0(o, ol, V_lds, pa, r32, hi); partialSM(pB0, pB1);
  __syncthreads();
  finishSM(pB0, pB1, pa); SBAR();
  pv_d0(o, ol, V_lds + V8_TILE, pa, r32, hi);
  if (lse && r32 == 0) {
#pragma unroll
    for (int r = 0; r < 16; ++r) lse[(wid * QBLK + crow(r, hi)) * 4] = __logf(ol[r]) - mnC * 0.69314718055994531f; }
  float rli[16];
#pragma unroll
  for (int r = 0; r < 16; ++r) rli[r] = __builtin_amdgcn_rcpf(ol[r]);
  bf16_t* Ow = Ob + (long)(wid * QBLK) * LDO;
#pragma unroll
  for (int r = 0; r < 16; ++r) { int orow = crow(r, hi);
    for (int d0 = 0; d0 < 4; ++d0) Ow[(long)orow * LDO + d0 * 32 + r32] = (bf16_t)(pkbf(o[d0][r] * rli[r], 0.f) & 0xffffu); }
  __syncthreads();
#undef SLOAD
#undef SWRITE
#undef SWAIT
}
}

struct Args { const float* in[20]; float* out; unsigned char* ws; int ph_lo, ph_hi; };
typedef const __attribute__((address_space(4))) Args* KArgs;
__device__ __forceinline__ KArgs get_args() { KArgs p = (KArgs)__builtin_amdgcn_kernarg_segment_ptr(); asm volatile("" : "+s"(p)); return p; }
__device__ __forceinline__ int fresh_tid() { int t = threadIdx.x; asm volatile("" : "+v"(t)); return t; }
__device__ __forceinline__ int fresh_bx() { int t = blockIdx.x; asm volatile("" : "+s"(t)); return t; }
__device__ __forceinline__ int fresh_g() { int t = gridDim.x; asm volatile("" : "+s"(t)); return t; }
enum { I_X = 0, I_C, I_CTX, I_CCTX, I_ADAW, I_ADAB, I_N1W, I_N2W, I_WIN, I_QNW, I_KNW, I_CONVW, I_ALOG, I_DTB, I_DNW, I_WOUT, I_WQ, I_SUBK, I_U, I_V };

__device__ __forceinline__ void convert_tables(const float* U, const float* V, unsigned char* ws, int l, int wvi, int nwv, int lane, int rw_end = 2 * NEXP) {
    const float* us = U + (size_t)l * NEXP * 1024; const float* vs = V + (size_t)l * NEXP * 1024;
    const int set = l & 1;
    float* scl = (float*)(ws + WS_USC) + set * 2 * NEXP;
    for (int rw = wvi; rw < rw_end; rw += nwv) {
        const bool isu = rw < NEXP; const int e = isu ? rw : rw - NEXP;
        const f32x4* sp = (const f32x4*)((isu ? us : vs) + (size_t)e * 1024 + 16 * lane);
        f32x4 x[4]; float mx = 0.f;
#pragma unroll
        for (int i = 0; i < 4; ++i) { x[i] = sp[i]; mx = fmaxf(mx, fmaxf(fmaxf(fabsf(x[i][0]), fabsf(x[i][1])), fmaxf(fabsf(x[i][2]), fabsf(x[i][3])))); }
        mx = wave_max(mx);
        const float sc = fmaxf(mx, 1e-30f) * (1.f / 127.f), inv = 1.f / sc;
        u32x4 o4;
        const float ofs = (GATHER_PART && isu) ? 0.f : 128.f;
#pragma unroll
        for (int i = 0; i < 4; ++i) { const unsigned b0 = (unsigned)(int)(rintf(x[i][0] * inv) + ofs) & 255u, b1 = (unsigned)(int)(rintf(x[i][1] * inv) + ofs) & 255u, b2 = (unsigned)(int)(rintf(x[i][2] * inv) + ofs) & 255u, b3 = (unsigned)(int)(rintf(x[i][3] * inv) + ofs) & 255u;
            o4[i] = b0 | (b1 << 8) | (b2 << 16) | (b3 << 24); }
        if (GATHER_PART == 2) *(u32x4*)(ws + WS_UB + (size_t)set * TAB_SET + (isu ? 0 : (size_t)NEXP * 1024) + ((size_t)(lane >> 3) * NEXP + e) * 128 + 16 * (lane & 7)) = o4;
        else *(u32x4*)(ws + WS_UB + (size_t)set * TAB_SET + (size_t)e * 2048 + (isu ? 0 : 1024) + 16 * lane) = o4;
        if (lane == 0) { if (GATHER_PART) scl[2 * e + (isu ? 0 : 1)] = sc; else scl[rw] = sc; }
    }
}

__device__ __forceinline__ void transpose_item(const float* W, int ldw, int K, bf16_t* WT, LAS float* scr, int kb, int nb, int lane) {
    const int k0 = 64 * kb, n0 = 32 * nb;
#pragma unroll 8
    for (int i = 0; i < 32; ++i) { const int kk = 2 * i + (lane >> 5); scr[kk * 33 + (lane & 31)] = W[(size_t)(k0 + kk) * ldw + n0 + (lane & 31)]; }
    LDS_WAIT(); asm volatile("" ::: "memory");
    const int c = lane & 7;
#pragma unroll
    for (int j = 0; j < 4; ++j) { const int n = (lane >> 3) + 8 * j; const LAS float* s = scr + (8 * c) * 33 + n;
        u32x4 o; o.x = pkbf(s[0 * 33], s[1 * 33]); o.y = pkbf(s[2 * 33], s[3 * 33]); o.z = pkbf(s[4 * 33], s[5 * 33]); o.w = pkbf(s[6 * 33], s[7 * 33]);
        *(u32x4*)(WT + (size_t)(n0 + n) * K + k0 + 8 * c) = o; }
    LDS_WAIT(); asm volatile("" ::: "memory");
}
__device__ __forceinline__ void phase_prologue(LAS unsigned char* lds) {
    const KArgs ap = get_args();
#define a (*ap)

    const int tid = fresh_tid(), lane = tid & 63, wave = __builtin_amdgcn_readfirstlane(tid >> 6), G = fresh_g(), bx = fresh_bx();
    unsigned char* ws = a.ws;
    {
        LAS float* sc = (LAS float*)(lds + 70000);
        LAS float* part = (LAS float*)(lds + 70000 + 12288);
        for (int i = tid; i < 3 * 1024; i += 512) { const int r = i >> 10, k = i & 1023; const float v = r < 2 ? a.in[I_C][r * 1024 + k] : a.in[I_CCTX][k]; sc[i] = silu_f(v); }
        __syncthreads();
        float* mod = (float*)(ws + WS_MOD);
        for (int item = bx; item < DEPTH * 96; item += G) {
            const int l = item / 96, j0 = (item % 96) * 64;
            const float* wp = a.in[I_ADAW] + (size_t)l * 1024 * 6144 + (size_t)(wave * 128) * 6144 + j0 + lane;
            float a0 = 0.f, a1 = 0.f, a2 = 0.f;
#pragma unroll 8
            for (int kk = 0; kk < 128; ++kk) { const float w = wp[(size_t)kk * 6144]; const int k = wave * 128 + kk; a0 = fmaf(sc[k], w, a0); a1 = fmaf(sc[1024 + k], w, a1); a2 = fmaf(sc[2048 + k], w, a2); }
            part[(wave * 3 + 0) * 64 + lane] = a0; part[(wave * 3 + 1) * 64 + lane] = a1; part[(wave * 3 + 2) * 64 + lane] = a2;
            __syncthreads();
            if (tid < 192) { const int r = tid >> 6, jj = tid & 63; float s = a.in[I_ADAB][l * 6144 + j0 + jj];
#pragma unroll
                for (int w = 0; w < 8; ++w) s += part[(w * 3 + r) * 64 + jj];
                mod[(size_t)(l * 3 + r) * 6144 + j0 + jj] = s; }
            __syncthreads();
        }
    }
    {
        const int gw = bx * 8 + wave, NGW = G * 8;
        unsigned* wmaxw = (unsigned*)(ws + WS_CTL) + CW_WMAX;
        constexpr int NB_IN = NP / 64, NB_OUT = 1024 / 64, NB_Q = 2048 / 64, PER_L2 = (NB_IN + NB_OUT + NB_Q) * 8;
        for (int it = gw; it < DEPTH * PER_L2; it += NGW) { const int l = it / PER_L2; int r = it % PER_L2; const int kc = r & 7; r >>= 3;
            const int mi = r < NB_IN ? 0 : r < NB_IN + NB_OUT ? 1 : 2; const int nb = mi == 0 ? r : mi == 1 ? r - NB_IN : r - NB_IN - NB_OUT; const int ldw = mi == 0 ? NIN : mi == 1 ? 1024 : 2048;
            const float* wp = (mi == 0 ? a.in[I_WIN] + (size_t)l * 1024 * NIN : mi == 1 ? a.in[I_WOUT] + (size_t)l * 1024 * 1024 : a.in[I_WQ] + (size_t)l * 1024 * 2048) + (size_t)(kc * 128) * ldw + nb * 64 + lane;
            float mx = 0.f;
#pragma unroll 8
            for (int kk = 0; kk < 128; ++kk) mx = fmaxf(mx, fabsf(wp[(size_t)kk * ldw]));
            atomicMax(wmaxw + (l * 3 + mi) * 3072 + nb * 64 + lane, __float_as_uint(mx)); }
    }
    const size_t gt = (size_t)bx * 512 + tid, NT = (size_t)G * 512;
    for (size_t i = gt; i < (size_t)DEPTH * 16 * 1024; i += NT) { const int l = (int)(i >> 14), j = (int)((i >> 10) & 15), k = (int)(i & 1023);
        ((float*)(ws + WS_WSK))[i] = a.in[I_WIN][(size_t)l * 1024 * NIN + (size_t)k * NIN + NP + j]; }
    convert_tables(a.in[I_U], a.in[I_V], ws, 0, bx * 8 + wave, G * 8, lane);
    for (size_t i = gt; i < (size_t)DEPTH * 8 * 2 * 128 * 128 / 2; i += NT) { const f32x2 x = ((const f32x2*)a.in[I_SUBK])[i]; ((unsigned*)(ws + WS_SKB))[i] = pkbf(x[0], x[1]); }
    for (size_t i = gt; i < 8192; i += NT) { const int pos = (int)(i >> 5), fi = (int)(i & 31);
        const float inv = exp2f(-(float)fi * (13.287712379549449f / 32.f)); const float ang = (float)pos * inv;
        float rev = ang * 0.15915494309189535f; rev -= floorf(rev);
        ((float*)(ws + WS_ROPE))[i] = __builtin_amdgcn_cosf(rev); ((float*)(ws + WS_ROPE))[8192 + i] = __builtin_amdgcn_sinf(rev); }
}


__device__ __forceinline__ void quant_transpose_item(const float* W, int ldw, signed char* WT, const unsigned* wmaxw, LAS float* scr, int kb, int nb, int lane) {
    const int k0 = 64 * kb, n0 = 32 * nb;
#pragma unroll 8
    for (int i = 0; i < 32; ++i) { const int kk = 2 * i + (lane >> 5); scr[kk * 33 + (lane & 31)] = W[(size_t)(k0 + kk) * ldw + n0 + (lane & 31)]; }
    LDS_WAIT(); asm volatile("" ::: "memory");
    const int n = lane >> 1, hf = lane & 1;
    const float mx = __uint_as_float(wmaxw[n0 + n]), inv = mx > 0.f ? 127.f / mx : 0.f;
    u32x4 o[2];
#pragma unroll
    for (int q = 0; q < 8; ++q) { unsigned w = 0u;
#pragma unroll
        for (int b = 0; b < 4; ++b) { const int kk = 32 * hf + 4 * q + b; w |= ((unsigned)(int)rintf(scr[kk * 33 + n] * inv) & 255u) << (8 * b); }
        o[q >> 2][q & 3] = w; }
    u32x4* dst = (u32x4*)(WT + (size_t)(n0 + n) * 1024 + k0 + 32 * hf);
    dst[0] = o[0]; dst[1] = o[1];
    LDS_WAIT(); asm volatile("" ::: "memory");
}
__device__ __forceinline__ void phase_quant_weights(LAS unsigned char* lds) {
    const KArgs ap = get_args();
#define a (*ap)
    const int tid = fresh_tid(), lane = tid & 63, wave = __builtin_amdgcn_readfirstlane(tid >> 6), G = fresh_g(), bx = fresh_bx();
    unsigned char* ws = a.ws;
    LAS float* scr = (LAS float*)(lds + 65536 + wave * 8448);
    const unsigned* wmaxw = (const unsigned*)(ws + WS_CTL) + CW_WMAX;
    constexpr int I_IN = 16 * 96, I_OUT = 16 * 32, I_Q = 16 * 64, PER_L = I_IN + I_OUT + I_Q;
    for (int it = bx * 8 + wave; it < DEPTH * PER_L; it += G * 8) { const int l = it / PER_L; int r = it % PER_L;
        if (r < I_IN) quant_transpose_item(a.in[I_WIN] + (size_t)l * 1024 * NIN, NIN, (signed char*)(ws + WS_WINT) + (size_t)l * NP * 1024, wmaxw + (l * 3 + 0) * 3072, scr, r / 96, r % 96, lane);
        else if (r < I_IN + I_OUT) { r -= I_IN; quant_transpose_item(a.in[I_WOUT] + (size_t)l * 1024 * 1024, 1024, (signed char*)(ws + WS_WOUTT) + (size_t)l * 1024 * 1024, wmaxw + (l * 3 + 1) * 3072, scr, r / 32, r % 32, lane); }
        else { r -= I_IN + I_OUT; quant_transpose_item(a.in[I_WQ] + (size_t)l * 1024 * 2048, 2048, (signed char*)(ws + WS_WQT) + (size_t)l * 2048 * 1024, wmaxw + (l * 3 + 2) * 3072, scr, r / 64, r % 64, lane); } }
#undef a
}

template <bool SK>
__device__ __forceinline__ void phase_norm(int l, int which, LAS unsigned char* lds) {
    const KArgs ap = get_args();
#define a (*ap)

    const int tid = fresh_tid(), lane = tid & 63, wave = __builtin_amdgcn_readfirstlane(tid >> 6), G = fresh_g(), bx = fresh_bx();
    unsigned char* ws = a.ws;
    LAS float* wsk = (LAS float*)lds;
    if (SK) { const float* src = (const float*)(ws + WS_WSK) + (size_t)l * 16384; for (int i = tid; i < 16384 / 4; i += 512) ((LAS f32x4*)wsk)[i] = ((const f32x4*)src)[i]; __syncthreads(); }
    const int nrows = (which == 1 && l == DEPTH - 1) ? ML : M;
    const float* nw = a.in[which ? I_N2W : I_N1W] + l * 1024;
    const float* modl = (const float*)(ws + WS_MOD) + (size_t)l * 3 * 6144;
    const int shoff = which ? 3072 : 0, scoff = which ? 4096 : 1024;
    f32x4 nwv[4];
#pragma unroll
    for (int j = 0; j < 4; ++j) nwv[j] = *(const f32x4*)(nw + 4 * lane + 256 * j);
    for (int row = wave * G + bx; row < nrows; row += G * 8) {
        const float* src; int mrow;
        if (row < ML) { src = ((l == 0 && which == 0) ? a.in[I_X] : a.out) + (size_t)row * D; mrow = row >= T ? 1 : 0; }
        else { src = ((l == 0 && which == 0) ? a.in[I_CTX] : (const float*)(ws + WS_CTXX)) + (size_t)(row - ML) * D; mrow = 2; }
        const float* md = modl + mrow * 6144;
        f32x4 v[4]; float ss = 0.f;
#pragma unroll
        for (int j = 0; j < 4; ++j) { v[j] = *(const f32x4*)(src + 4 * lane + 256 * j); ss += (v[j][0] * v[j][0] + v[j][1] * v[j][1]) + (v[j][2] * v[j][2] + v[j][3] * v[j][3]); }
        const float rstd = rsqrtf(wave_sum(ss) * (1.f / D) + EPS);
        signed char* hrow = (signed char*)(ws + WS_H) + (size_t)row * D;
        float hmx = 0.f;
#pragma unroll
        for (int j = 0; j < 4; ++j) { const f32x4 sc = *(const f32x4*)(md + scoff + 4 * lane + 256 * j), sh = *(const f32x4*)(md + shoff + 4 * lane + 256 * j);
            v[j] = v[j] * rstd * nwv[j] * (sc + 1.f) + sh; hmx = fmaxf(hmx, fmaxf(fmaxf(fabsf(v[j][0]), fabsf(v[j][1])), fmaxf(fabsf(v[j][2]), fabsf(v[j][3])))); }
        hmx = fmaxf(wave_max(hmx), 1e-30f);
        { const float hinv = 127.f / hmx;
#pragma unroll
          for (int j = 0; j < 4; ++j) *(unsigned*)(hrow + 4 * lane + 256 * j) = ((unsigned)(int)rintf(v[j][0] * hinv) & 255u) | (((unsigned)(int)rintf(v[j][1] * hinv) & 255u) << 8) | (((unsigned)(int)rintf(v[j][2] * hinv) & 255u) << 16) | (((unsigned)(int)rintf(v[j][3] * hinv) & 255u) << 24);
          if (lane == 0) ((float*)(ws + WS_GB))[row] = hmx * (1.f / 127.f); }
        if (SK) {
            float p[16];
#pragma unroll
            for (int c = 0; c < 16; ++c) { float q = 0.f;
#pragma unroll
                for (int j = 0; j < 4; ++j) { const f32x4 w = *(const LAS f32x4*)(wsk + c * 1024 + 4 * lane + 256 * j); q += (v[j][0] * w[0] + v[j][1] * w[1]) + (v[j][2] * w[2] + v[j][3] * w[3]); }
                p[c] = q; }
            { const bool hb = (lane & 32) != 0;
#pragma unroll
              for (int c = 0; c < 8; ++c) { const float keep = hb ? p[c + 8] : p[c], send = hb ? p[c] : p[c + 8]; p[c] = keep + lane_xor<32>(send); } }
            { const bool hb = (lane & 16) != 0;
#pragma unroll
              for (int c = 0; c < 4; ++c) { const float keep = hb ? p[c + 4] : p[c], send = hb ? p[c] : p[c + 4]; p[c] = keep + lane_xor<16>(send); } }
            { const bool hb = (lane & 8) != 0;
#pragma unroll
              for (int c = 0; c < 2; ++c) { const float keep = hb ? p[c + 2] : p[c], send = hb ? p[c] : p[c + 2]; p[c] = keep + lane_xor<8>(send); } }
            { const bool hb = (lane & 4) != 0; const float keep = hb ? p[1] : p[0], send = hb ? p[0] : p[1]; p[0] = keep + lane_xor<4>(send); }
            p[0] += lane_xor<2>(p[0]); p[0] += lane_xor<1>(p[0]);
            if ((lane & 3) == 0) { const int c = ((lane >> 5) & 1) * 8 + ((lane >> 4) & 1) * 4 + ((lane >> 3) & 1) * 2 + ((lane >> 2) & 1); ((float*)(ws + WS_BA))[(size_t)row * 16 + c] = p[0]; }
        }
    }
    if (SK) __syncthreads();
}

__device__ __forceinline__ void phase_prep(int l, LAS unsigned char* lds) {
    const KArgs ap = get_args();
#define a (*ap)

    const int tid = fresh_tid(), lane = tid & 63, wave = __builtin_amdgcn_readfirstlane(tid >> 6), G = fresh_g(), bx = fresh_bx();
    unsigned char* ws = a.ws;
    const bf16_t* P = (const bf16_t*)(ws + WS_P);
    const float* ropec = (const float*)(ws + WS_ROPE); const float* ropes = ropec + 8192;
    const int sec = lane >> 5, fi = lane & 31;
    const float qw0 = a.in[I_QNW][l * 128 + sec * 64 + fi], qw1 = a.in[I_QNW][l * 128 + sec * 64 + 32 + fi];
    const float kw0 = a.in[I_KNW][l * 128 + sec * 64 + fi], kw1 = a.in[I_KNW][l * 128 + sec * 64 + 32 + fi];
    for (int row = wave * G + bx; row < M; row += G * 8) {
        const bool lat = row < ML;
        int b, tt, tlen; if (lat) { b = row >> 14; tt = row & (T - 1); tlen = T; } else { b = (row - ML) >> 8; tt = (row - ML) & (CT - 1); tlen = CT; }
        const bf16_t* prow = P + (size_t)row * NP;
        unsigned short xa[6][2];
#pragma unroll
        for (int hh = 0; hh < 6; ++hh) { const bf16_t* xp = prow + (hh < 4 ? hh * 128 : 512 + (hh - 4) * 128) + sec * 64 + fi; xa[hh][0] = xp[0]; xa[hh][1] = xp[32]; }
        const u32x2 vcp = *(const u32x2*)(prow + 768 + 4 * lane);
        float cs = 1.f, sn = 0.f;
        if (lat) { const int pos = sec ? (tt & 63) : (tt >> 6); cs = ropec[pos * 32 + fi]; sn = ropes[pos * 32 + fi]; }
        unsigned char* qo8 = ws + WS_QA + (size_t)row * 512;
        const size_t kvrow = (size_t)b * KVLEN + (lat ? tt : T + tt);
        unsigned char* ko8 = ws + WS_KA + kvrow * 256;
        float ssq[6];
#pragma unroll
        for (int hh = 0; hh < 6; ++hh) { const float x0 = bf2f(xa[hh][0]), x1 = bf2f(xa[hh][1]); ssq[hh] = x0 * x0 + x1 * x1; }
#pragma unroll
        for (int hh = 0; hh < 6; ++hh) ssq[hh] = wave_sum(ssq[hh]);
#pragma unroll
        for (int hh = 0; hh < 6; ++hh) {
            const float x0 = bf2f(xa[hh][0]), x1 = bf2f(xa[hh][1]);
            const float rs = rsqrtf(ssq[hh] * (1.f / 128.f) + EPS);
            const float y0 = x0 * rs * (hh < 4 ? qw0 : kw0), y1 = x1 * rs * (hh < 4 ? qw1 : kw1);
            const float qsc = hh < 4 ? 0.088388347648318440f * 1.4426950408889634f : 1.f;
            const float o0 = (y0 * cs - y1 * sn) * qsc, o1 = (y1 * cs + y0 * sn) * qsc;
            unsigned char* op8 = (hh < 4 ? qo8 + hh * 128 : ko8 + (hh - 4) * 128) + sec * 64 + fi;
            const float f8s = hh < 4 ? 8.f : 1.f;
            const int pk8 = __builtin_amdgcn_cvt_pk_fp8_f32(o0 * f8s, o1 * f8s, 0, false);
            op8[0] = (unsigned char)(pk8 & 255); op8[32] = (unsigned char)((pk8 >> 8) & 255);
        }
        { const int pos = lat ? tt : T + tt, tile = pos >> 6, k64 = pos & 63, k32 = k64 & 31;
          const int bytepos = 32 * ((k32 >> 2) & 1) + 16 * (k64 >> 5) + (k32 & 3) + 4 * (k32 >> 3);
          unsigned char* vt = ws + WS_VA + ((size_t)(b * 2) * (KVLEN / 64) + tile) * 8192 + bytepos;
          const unsigned short* vsrc = (const unsigned short*)&vcp;
          const int kvh_ = lane >> 5, d0 = (4 * lane) & 127;
          const int pk01 = __builtin_amdgcn_cvt_pk_fp8_f32(bf2f(vsrc[0]), bf2f(vsrc[1]), 0, false), pk23 = __builtin_amdgcn_cvt_pk_fp8_f32(bf2f(vsrc[2]), bf2f(vsrc[3]), 0, false);
          unsigned char* vt2 = vt + (size_t)kvh_ * (KVLEN / 64) * 8192 + (size_t)d0 * 64;
          vt2[0] = (unsigned char)(pk01 & 255); vt2[64] = (unsigned char)((pk01 >> 8) & 255); vt2[128] = (unsigned char)(pk23 & 255); vt2[192] = (unsigned char)((pk23 >> 8) & 255); }
    }
    __syncthreads();
}

constexpr int ATT_PARTS = 4;
__device__ __forceinline__ void phase_attn(int l, unsigned char* lds_raw, volatile LAS unsigned* MISC, int rep) {
    const KArgs ap = get_args();
#define a (*ap)
    unsigned char* ws = a.ws;
    const unsigned char* QA = ws + WS_QA; const unsigned char* KA = ws + WS_KA; const unsigned char* VT = ws + WS_VA;
    bf16_t* CAT = (bf16_t*)(ws + WS_CAT); float* LSE = (float*)(ws + WS_BA);
    unsigned* ctr = (unsigned*)(ws + WS_CTL) + 8192 + 64 * l + 1024 * rep;
    const int natt = 2048 + (l < DEPTH - 1 ? 8 : 0);
    constexpr int CONV_ROWS = 64, NCONV = 2 * NEXP / CONV_ROWS;
    const int nunits = natt + (l + 1 < DEPTH ? NCONV : 0);
    float braw;
    { const int ln = threadIdx.x & 63; float mq = fmaxf(fabsf(a.in[I_QNW][l * 128 + ln]), fabsf(a.in[I_QNW][l * 128 + 64 + ln])), mk = fmaxf(fabsf(a.in[I_KNW][l * 128 + ln]), fabsf(a.in[I_KNW][l * 128 + 64 + ln]));
      mq = wave_max(mq); mk = wave_max(mk);
      braw = __builtin_bit_cast(float, __builtin_amdgcn_readfirstlane(__builtin_bit_cast(int, 128.f * mq * mk))); }
    if (threadIdx.x == 0) MISC[12] = __hip_atomic_fetch_add(ctr, 1u, __ATOMIC_RELAXED, __HIP_MEMORY_SCOPE_AGENT);
    __syncthreads();
    int u = (int)MISC[12], par = 0;
    for (; u < nunits; ) {
        if (threadIdx.x == 0) MISC[13 - par] = __hip_atomic_fetch_add(ctr, 1u, __ATOMIC_RELAXED, __HIP_MEMORY_SCOPE_AGENT);
        if (u >= natt) {
            const int rwb = (u - natt) * CONV_ROWS + (int)(threadIdx.x >> 6) * 8;
            convert_tables(a.in[I_U], a.in[I_V], ws, l + 1, rwb, 1, (int)(threadIdx.x & 63), rwb + 8);
            __syncthreads();
            u = (int)MISC[13 - par]; par ^= 1;
            continue;
        }
        size_t r0, kv0; int h, kvh, seq, ldo; bf16_t* ob; float* lse;
        if (u < 2048) { const int qb = u & 63, g = (u >> 6) & 1, part = (u >> 7) & 3, b = u >> 10; kvh = (u >> 9) & 1; h = kvh * 2 + g;
            const int t0 = (part >> 1) * 130 + (part & 1) * 64;
            r0 = (size_t)b * T + (size_t)qb * 256; kv0 = (size_t)b * KVLEN + (size_t)t0 * 64; seq = ((part & 1) ? 66 : 64) * 64;
            ob = part ? (bf16_t*)(ws + (part == 1 ? WS_DQ : part == 2 ? WS_DK : WS_DV)) + r0 * 512 + h * 128 : CAT + r0 * 1024 + h * 128; ldo = part ? 512 : 1024; lse = LSE + ((size_t)part * ML + r0) * 4 + h; }
        else { const int b = (u - 2048) >> 2; h = (u - 2048) & 3; kvh = h >> 1; r0 = (size_t)ML + (size_t)b * CT; kv0 = (size_t)b * KVLEN + T; seq = CT;
            ob = CAT + r0 * 1024 + h * 128; ldo = 1024; lse = nullptr; }
        att::attn_dense_body(QA + r0 * 512 + h * 128, KA + kv0 * 256 + kvh * 128, VT + ((size_t)((kv0 / KVLEN) * 2 + kvh) * (KVLEN / 64) + (kv0 % KVLEN) / 64) * 8192, ob, ldo, seq, (char*)lds_raw, lse, braw);
        u = (int)MISC[13 - par]; par ^= 1;
    }
#undef a
}

__device__ __forceinline__ int tokperm(int q, int hh, int jj) { return 16 * q + 8 * (jj >> 2) + 4 * hh + (jj & 3); }
__device__ __forceinline__ int crow16(int r, int hi) { return (r & 3) + 8 * (r >> 2) + 4 * hi; }
__device__ __forceinline__ int kperm16(int s_, int g, int jj) { return 32 * s_ + 16 * (jj >> 2) + 4 * g + (jj & 3); }
__device__ __forceinline__ int frag_off(int i, int j) {
    return (((i >> 4) * 2 + (j >> 5)) * 64 + ((i & 15) + 16 * ((j >> 2) & 3))) * 16 + (4 * ((j >> 4) & 1) + (j & 3)) * 2;
}
template <int MODE>
__device__ __forceinline__ void phase_dn_chunkprep(int l, LAS unsigned char* lds) {
    const KArgs ap = get_args();
#define a (*ap)
    const int tid = fresh_tid(), lane = tid & 63, wave = __builtin_amdgcn_readfirstlane(tid >> 6), G = fresh_g(), bx = fresh_bx();
    unsigned char* ws = a.ws;
    constexpr int KT_OFF = 0, QT_OFF = 17408, VT_OFF = 34816, GS_OFF = 52224, RS_OFF = 68864, AM_OFF = 85504, SC_OFF = 120320, IMG_OFF = 0;
    const int r = lane & 31, hh = lane >> 5;
    const bf16_t* DQ = (const bf16_t*)(ws + WS_DQ); const bf16_t* DK = (const bf16_t*)(ws + WS_DK); const bf16_t* DV = (const bf16_t*)(ws + WS_DV);
    const float* BA = (const float*)(ws + WS_BA);
    constexpr int NTASK = MODE ? NB * 4 * 4 : NB * 4 * (NCH - 4);
#define CP_TASKID(t_) (MODE ? ((t_) >> 2) * NCH + ((t_) & 3) : ((t_) >> 8) * NCH + 4 + ((t_) & 255))
    LAS float* gsc = (LAS float*)(lds + SC_OFF);
    LAS float* bsc = gsc + 128;
    LAS float* gcs = gsc + 256;
    constexpr int CW_OFF = 121856;
    LAS float* cwl = (LAS float*)(lds + CW_OFF);
    for (int i = tid; i < 5 * 1536; i += 512) cwl[i] = a.in[I_CONVW][(size_t)l * 5 * 1536 + i];
    __syncthreads();
    const bf16_t* P = (const bf16_t*)(ws + WS_P);
    u32x4 xin[3][5][2];
#define CP_LOADX(task_) do { const int cidx_ = (task_) % NCH, bh_ = (task_) / NCH, b_ = bh_ >> 2, h_ = bh_ & 3; \
        const int row0_ = cidx_ < 4 ? ML + b_ * CT + cidx_ * 64 : b_ * T + (cidx_ - 4) * 64, tt_ = (cidx_ < 4 ? cidx_ * 64 : (cidx_ - 4) * 64) + (tid >> 3), tlen_ = cidx_ < 4 ? CT : T; \
        _Pragma("unroll") for (int j = 0; j < 5; ++j) { const int t2 = tt_ + j - 2; const bool ok = t2 >= 0 && t2 < tlen_; \
            const bf16_t* xr = P + (size_t)(row0_ + (tid >> 3) + (ok ? j - 2 : 0)) * NP + 1024 + h_ * 128 + (tid & 7) * 16; \
            _Pragma("unroll") for (int m = 0; m < 3; ++m) { const u32x4 w0 = *(const u32x4*)(xr + m * 512), w1 = *(const u32x4*)(xr + m * 512 + 8); \
                xin[m][j][0] = ok ? w0 : (u32x4){0u, 0u, 0u, 0u}; xin[m][j][1] = ok ? w1 : (u32x4){0u, 0u, 0u, 0u}; } } } while (0)
    if (bx < NTASK) CP_LOADX(CP_TASKID(bx));
    for (int tk = bx; tk < NTASK; tk += G) {
        const int task = CP_TASKID(tk);
        const int cidx = task % NCH, bh = task / NCH, b = bh >> 2, h = bh & 3;
        const int row0 = cidx < 4 ? ML + b * CT + cidx * 64 : b * T + (cidx - 4) * 64;
        unsigned char* rec = ws + WS_REC + (size_t)task * REC_BYTES;
        {
            const int rr = tid >> 3, seg = tid & 7;
            if (tid < 128) { const int d = tid >> 6, i = tid & 63, dh = d * 4 + h;
                const float xb = BA[(size_t)(row0 + i) * 16 + dh], z = BA[(size_t)(row0 + i) * 16 + 8 + dh] + a.in[I_DTB][l * 8 + dh];
                bsc[tid] = 1.f / (1.f + __expf(-xb)); gsc[tid] = -__expf(a.in[I_ALOG][l * 8 + dh]) * (fmaxf(z, 0.f) + log1pf(__expf(-fabsf(z)))); }
#pragma unroll
            for (int m = 0; m < 3; ++m) {
                float y[16];
#pragma unroll
                for (int c = 0; c < 16; ++c) y[c] = 0.f;
#pragma unroll
                for (int j = 0; j < 5; ++j) { const LAS float* wp = cwl + j * 1536 + m * 512 + h * 128 + seg * 16;
#pragma unroll
                    for (int q4 = 0; q4 < 4; ++q4) { const f32x4 wv = *(const LAS f32x4*)(wp + 4 * q4); const unsigned u0 = xin[m][j][q4 >> 1][2 * (q4 & 1)], u1 = xin[m][j][q4 >> 1][2 * (q4 & 1) + 1];
                        y[4 * q4 + 0] = fmaf(bflo(u0), wv[0], y[4 * q4 + 0]); y[4 * q4 + 1] = fmaf(bfhi(u0), wv[1], y[4 * q4 + 1]); y[4 * q4 + 2] = fmaf(bflo(u1), wv[2], y[4 * q4 + 2]); y[4 * q4 + 3] = fmaf(bfhi(u1), wv[3], y[4 * q4 + 3]); } }
                float ss = 0.f;
#pragma unroll
                for (int c = 0; c < 16; ++c) { y[c] = silu_f(y[c]); ss = fmaf(y[c], y[c], ss); }
                if (m < 2) { ss += lane_xor<1>(ss); ss += lane_xor<2>(ss); ss += lane_xor<4>(ss);
                    float sc = rsqrtf(ss + EPS); if (m == 0) sc *= 0.088388347648318440f;
#pragma unroll
                    for (int c = 0; c < 16; ++c) y[c] *= sc; }
                u32x4 o0, o1; o0.x = pkbf(y[0], y[1]); o0.y = pkbf(y[2], y[3]); o0.z = pkbf(y[4], y[5]); o0.w = pkbf(y[6], y[7]); o1.x = pkbf(y[8], y[9]); o1.y = pkbf(y[10], y[11]); o1.z = pkbf(y[12], y[13]); o1.w = pkbf(y[14], y[15]);
                LAS unsigned char* dst = lds + (m == 0 ? QT_OFF : m == 1 ? KT_OFF : VT_OFF) + rr * 272 + seg * 32;
                *(LAS u32x4*)dst = o0; *(LAS u32x4*)(dst + 16) = o1;
            }
        }
        __syncthreads();
        {
            const int mat = wave >> 2, ti = (wave >> 1) & 1, tj = wave & 1;
            f32x16 acc = {};
#pragma unroll
            for (int ks = 0; ks < 8; ++ks) {
                const bf16x8 av = *(const LAS bf16x8*)(lds + (mat ? QT_OFF : KT_OFF) + (32 * ti + r) * 272 + (16 * ks + 8 * hh) * 2);
                const bf16x8 bv = *(const LAS bf16x8*)(lds + KT_OFF + (32 * tj + r) * 272 + (16 * ks + 8 * hh) * 2);
                acc = __builtin_amdgcn_mfma_f32_32x32x16_bf16(av, bv, acc, 0, 0, 0);
            }
            LAS float* dst = (LAS float*)(lds + (mat ? RS_OFF : GS_OFF));
#pragma unroll
            for (int i = 0; i < 16; ++i) dst[(32 * ti + crow16(i, hh)) * 65 + 32 * tj + r] = acc[i];
        }
        { const int r16 = lane & 15, g4 = lane >> 4;
#pragma unroll
        for (int t = 0; t < 2; ++t) { const int f = wave * 2 + t, mt = f >> 2, sk = f & 3;
            { const u32x2 lo = *(const LAS u32x2*)(lds + KT_OFF + (16 * mt + r16) * 272 + (32 * sk + 4 * g4) * 2), hi2 = *(const LAS u32x2*)(lds + KT_OFF + (16 * mt + r16) * 272 + (32 * sk + 16 + 4 * g4) * 2);
              *(u32x4*)(rec + REC_K + f * 1024 + lane * 16) = (u32x4){lo.x, lo.y, hi2.x, hi2.y}; }
            { const u32x2 lo = *(const LAS u32x2*)(lds + QT_OFF + (16 * mt + r16) * 272 + (32 * sk + 4 * g4) * 2), hi2 = *(const LAS u32x2*)(lds + QT_OFF + (16 * mt + r16) * 272 + (32 * sk + 16 + 4 * g4) * 2);
              *(u32x4*)(rec + REC_Q + f * 1024 + lane * 16) = (u32x4){lo.x, lo.y, hi2.x, hi2.y}; } }
#pragma unroll
        for (int t = 0; t < 2; ++t) { const int f = wave * 2 + t, mt = f >> 1, sk = f & 1;
            unsigned e[8];
#pragma unroll
            for (int jj = 0; jj < 8; ++jj) e[jj] = *(const LAS unsigned short*)(lds + KT_OFF + kperm16(sk, g4, jj) * 272 + (16 * mt + r16) * 2);
            *(u32x4*)(rec + REC_KT + f * 1024 + lane * 16) = (u32x4){e[0] | (e[1] << 16), e[2] | (e[3] << 16), e[4] | (e[5] << 16), e[6] | (e[7] << 16)}; }
        { const int sl = wave;
            unsigned e[16];
#pragma unroll
            for (int i = 0; i < 16; ++i) e[i] = *(const LAS unsigned short*)(lds + VT_OFF + (16 * (i >> 2) + 4 * g4 + (i & 3)) * 272 + (16 * sl + r16) * 2);
            u32x4* vp = (u32x4*)(rec + REC_V + sl * 2048 + lane * 32);
            vp[0] = (u32x4){e[0] | (e[1] << 16), e[2] | (e[3] << 16), e[4] | (e[5] << 16), e[6] | (e[7] << 16)};
            vp[1] = (u32x4){e[8] | (e[9] << 16), e[10] | (e[11] << 16), e[12] | (e[13] << 16), e[14] | (e[15] << 16)}; }
        }
        if (tk + G < NTASK) CP_LOADX(CP_TASKID(tk + G));
        if (wave < 2) { const int d = wave; float gv = gsc[d * 64 + (d ? 63 - lane : lane)];
            gv += __builtin_bit_cast(float, __builtin_amdgcn_update_dpp(0, __builtin_bit_cast(int, gv), 0x111, 0xF, 0xF, true));
            gv += __builtin_bit_cast(float, __builtin_amdgcn_update_dpp(0, __builtin_bit_cast(int, gv), 0x112, 0xF, 0xF, true));
            gv += __builtin_bit_cast(float, __builtin_amdgcn_update_dpp(0, __builtin_bit_cast(int, gv), 0x114, 0xF, 0xF, true));
            gv += __builtin_bit_cast(float, __builtin_amdgcn_update_dpp(0, __builtin_bit_cast(int, gv), 0x118, 0xF, 0xF, true));
            { const float t0 = __builtin_bit_cast(float, __builtin_amdgcn_readlane(__builtin_bit_cast(int, gv), 15)), t1 = __builtin_bit_cast(float, __builtin_amdgcn_readlane(__builtin_bit_cast(int, gv), 31)), t2 = __builtin_bit_cast(float, __builtin_amdgcn_readlane(__builtin_bit_cast(int, gv), 47));
              const int rw_ = lane >> 4; gv += (rw_ >= 1 ? t0 : 0.f) + (rw_ >= 2 ? t1 : 0.f) + (rw_ >= 3 ? t2 : 0.f); }
            gcs[d * 64 + lane] = gv; }
        __syncthreads();
        const LAS float* Gs = (const LAS float*)(lds + GS_OFF); const LAS float* Rs = (const LAS float*)(lds + RS_OFF);
#pragma unroll 4
        for (int t = 0; t < 16; ++t) { const int e = tid + 512 * t, d = e >> 12, jp = (e >> 6) & 63, ip = e & 63;
            const int in_ = d ? 63 - ip : ip, jn = d ? 63 - jp : jp;
            const float dec = __expf(fminf(gcs[d * 64 + ip] - gcs[d * 64 + jp], 0.f));
            const float av = (jp < ip) ? bsc[d * 64 + in_] * Gs[in_ * 65 + jn] * dec : 0.f;
            ((LAS float*)(lds + AM_OFF))[d * 4352 + jp * 68 + ip] = av;
            const float qk = (jp <= ip) ? Rs[in_ * 65 + jn] * dec : 0.f;
            *(LAS unsigned short*)(lds + IMG_OFF + d * 16384 + 8192 + frag_off(in_, jn)) = (unsigned short)(pkbf(qk, 0.f) & 0xffffu); }
        __syncthreads();
        if (wave < 2) { const int d = wave, c = lane, jn = d ? 63 - c : c; const float bj = bsc[d * 64 + jn];
            const LAS float* At = (const LAS float*)(lds + AM_OFF) + d * 4352;
            LAS float* Xm = (LAS float*)(lds + GS_OFF) + d * 4096 + c;
            const int fj = (jn >> 5) * 1024 + ((jn >> 2) & 3) * 256 + ((jn >> 4) & 1) * 8 + (jn & 3) * 2;
#pragma unroll 1
            for (int B = 0; B < 4; ++B) {
                float acc[16];
#pragma unroll
                for (int q = 0; q < 16; ++q) acc[q] = (16 * B + q == c) ? 1.f : 0.f;
#pragma unroll 4
                for (int j = 0; j < 16 * B; ++j) { const float xj = Xm[j * 64];
                    const f32x4 a0 = *(const LAS f32x4*)(At + j * 68 + 16 * B), a1 = *(const LAS f32x4*)(At + j * 68 + 16 * B + 4), a2 = *(const LAS f32x4*)(At + j * 68 + 16 * B + 8), a3 = *(const LAS f32x4*)(At + j * 68 + 16 * B + 12);
#pragma unroll
                    for (int q = 0; q < 4; ++q) { acc[q] = fmaf(-a0[q], xj, acc[q]); acc[4 + q] = fmaf(-a1[q], xj, acc[4 + q]); acc[8 + q] = fmaf(-a2[q], xj, acc[8 + q]); acc[12 + q] = fmaf(-a3[q], xj, acc[12 + q]); } }
#pragma unroll
                for (int r2 = 0; r2 < 15; ++r2) { const LAS float* ar = At + (16 * B + r2) * 68 + 16 * B; const float xr = acc[r2];
#pragma unroll
                    for (int q4 = (r2 + 1) / 4; q4 < 4; ++q4) { const f32x4 a4 = *(const LAS f32x4*)(ar + 4 * q4);
#pragma unroll
                        for (int q = 0; q < 4; ++q) if (4 * q4 + q > r2) acc[4 * q4 + q] = fmaf(-a4[q], xr, acc[4 * q4 + q]); } }
#pragma unroll
                for (int q = 0; q < 16; ++q) { const int i = 16 * B + q, in_ = d ? 63 - i : i; Xm[i * 64] = acc[q];
                    *(LAS unsigned short*)(lds + IMG_OFF + d * 16384 + (in_ >> 4) * 2048 + (in_ & 15) * 16 + fj) = (unsigned short)(pkbf(acc[q] * bj, 0.f) & 0xffffu); }
            }
        } else if (wave < 4) { const int d = wave - 2, ip = d ? 63 - lane : lane; const float gl = gcs[d * 64 + 63], gi = gcs[d * 64 + ip];
            float* sc = (float*)(rec + REC_DIR + d * REC_DIRSZ + 16384);
            sc[lane] = __expf(gi); sc[64 + lane] = __expf(gl - gi); if (lane == 0) sc[128] = __expf(gl); }
        __syncthreads();
#pragma unroll
        for (int t = 0; t < 4; ++t) { const int p = tid + 512 * t, d = p >> 10, off = (p & 1023) * 16;
            *(u32x4*)(rec + REC_DIR + d * REC_DIRSZ + off) = *(const LAS u32x4*)(lds + IMG_OFF + d * 16384 + off); }
        __syncthreads();
    }
#undef CP_LOADX
#undef CP_TASKID
#undef a
}

__device__ __forceinline__ bf16x8 pack44(const f32x4& lo, const f32x4& hi) {
    u32x4 p; p.x = pkbf_c(lo[0], lo[1]); p.y = pkbf_c(lo[2], lo[3]); p.z = pkbf_c(hi[0], hi[1]); p.w = pkbf_c(hi[2], hi[3]);
    return __builtin_bit_cast(bf16x8, p);
}
template <int VAR>
__device__ __forceinline__ void phase_dn_scan(int l, LAS unsigned char* lds) {
    const KArgs ap = get_args();
#define a (*ap)
    const int tid = fresh_tid(), lane = tid & 63, wave = __builtin_amdgcn_readfirstlane(tid >> 6), bx = fresh_bx();
    unsigned char* ws = a.ws;
    if (bx >= 32) return;
    const int chain = bx >> 1, half = bx & 1, b = chain >> 3, h = (chain >> 1) & 3, dir = chain & 1;
    const unsigned char* recb = ws + WS_REC + (size_t)((b * 4 + h) * NCH) * REC_BYTES;
    constexpr int BUFSZ = 74752;
#define CIDX(n) (dir ? ((n) < 4 ? 3 - (n) : 263 - (n)) : (n))
    if (wave >= 4) {
        const int sw = wave - 4;
#define DN_PIECE(i_) ((sw + 4 * (i_)) < 73 ? (sw + 4 * (i_)) : 72)
#define DN_SRC(rec_, p_) ((p_) < 48 ? (rec_) + (p_) * 1024 : (p_) < 65 ? (rec_) + REC_DIR + dir * REC_DIRSZ + ((p_) - 48) * 1024 : (rec_) + REC_V + half * 8192 + ((p_) - 65) * 1024)
#define DN_STAGE(n, bi) do { const unsigned char* rec_ = recb + (size_t)CIDX(n) * REC_BYTES; _Pragma("unroll") for (int i_ = 0; i_ < 19; ++i_) { const int p_ = DN_PIECE(i_); \
        __builtin_amdgcn_global_load_lds((const unsigned*)(DN_SRC(rec_, p_) + lane * 16), (LAS unsigned*)(lds + (bi) * BUFSZ + p_ * 1024), 16, 0, 0); } } while (0)
#define DN_SYNC() do { asm volatile("s_waitcnt vmcnt(0)" ::: "memory"); __builtin_amdgcn_s_barrier(); asm volatile("" ::: "memory"); } while (0)
        if (VAR != 3) DN_STAGE(0, 0);
        DN_SYNC();
        for (int n = 0; n < NCH; ++n) {
            if (VAR != 3 && n + 1 < NCH) DN_STAGE(n + 1, (n + 1) & 1);
            DN_SYNC();
        }
#undef DN_STAGE
#undef DN_PIECE
#undef DN_SRC
#undef DN_SYNC
    } else {
        const int sl = half * 4 + wave, c16 = lane & 15, g4 = lane >> 4;
        float* Og = (float*)(ws + (dir ? WS_OB : WS_OF)) + h * 128 + sl * 16 + c16;
        f32x4 S[8];
#pragma unroll
        for (int i = 0; i < 8; ++i) S[i] = (f32x4){0.f, 0.f, 0.f, 0.f};
        asm volatile("s_waitcnt lgkmcnt(0)" ::: "memory"); __builtin_amdgcn_s_barrier(); asm volatile("" ::: "memory");
        for (int n = 0; n < NCH; ++n) {
            if (VAR == 2) { asm volatile("s_waitcnt lgkmcnt(0)" ::: "memory"); __builtin_amdgcn_s_barrier(); asm volatile("" ::: "memory"); continue; }
            const LAS unsigned char* buf = lds + (n & 1) * BUFSZ;
            const int cidx = CIDX(n);
            const u32x4 vc0 = *(const LAS u32x4*)(buf + 66560 + wave * 2048 + lane * 32), vc1 = *(const LAS u32x4*)(buf + 66560 + wave * 2048 + lane * 32 + 16);
#define FR(off, f) (*(const LAS bf16x8*)(buf + (off) + (f) * 1024 + lane * 16))
#define MF(A, B, C) __builtin_amdgcn_mfma_f32_16x16x32_bf16((A), (B), (C), 0, 0, 0)
#define SB_() __builtin_amdgcn_sched_barrier(0)
            bf16x8 fa[8], fb[8];
            f32x4 eg[4], dl[4];
#pragma unroll
            for (int mt = 0; mt < 4; ++mt) { eg[mt] = *(const LAS f32x4*)(buf + 65536 + (16 * mt + 4 * g4) * 4); dl[mt] = *(const LAS f32x4*)(buf + 65536 + 256 + (16 * mt + 4 * g4) * 4); }
            const float egl = *(const LAS float*)(buf + 65536 + 512);
#define RD_KQ(dst, q) do { _Pragma("unroll") for (int mt = 0; mt < 4; ++mt) { dst[mt] = FR(0, mt * 4 + (q)); dst[4 + mt] = FR(32768, mt * 4 + (q)); } } while (0)
#define MM_KQ(src, q) do { _Pragma("unroll") for (int mt = 0; mt < 4; ++mt) { X[mt] = MF(src[mt], Sb[q], X[mt]); O[mt] = MF(src[4 + mt], Sb[q], O[mt]); } } while (0)
            f32x4 X[4], O[4], VN[4];
#pragma unroll
            for (int i = 0; i < 4; ++i) { X[i] = (f32x4){0.f, 0.f, 0.f, 0.f}; O[i] = (f32x4){0.f, 0.f, 0.f, 0.f}; VN[i] = (f32x4){0.f, 0.f, 0.f, 0.f}; }
            bf16x8 Sb[4];
#pragma unroll
            for (int q = 0; q < 4; ++q) Sb[q] = pack44(S[2 * q], S[2 * q + 1]);
            RD_KQ(fa, 0); SB_();
            RD_KQ(fb, 1); SB_(); MM_KQ(fa, 0); SB_();
            RD_KQ(fa, 2); SB_(); MM_KQ(fb, 1); SB_();
            RD_KQ(fb, 3); SB_(); MM_KQ(fa, 2); SB_();
#pragma unroll
            for (int i = 0; i < 8; ++i) fa[i] = FR(49152, i);
            SB_(); MM_KQ(fb, 3); SB_();
#pragma unroll
            for (int mt = 0; mt < 4; ++mt) { const unsigned w0 = (mt < 2 ? vc0 : vc1)[2 * (mt & 1)], w1 = (mt < 2 ? vc0 : vc1)[2 * (mt & 1) + 1];
                X[mt][0] = bflo(w0) - eg[mt][0] * X[mt][0]; X[mt][1] = bfhi(w0) - eg[mt][1] * X[mt][1]; X[mt][2] = bflo(w1) - eg[mt][2] * X[mt][2]; X[mt][3] = bfhi(w1) - eg[mt][3] * X[mt][3]; }
            const bf16x8 Yb0 = pack44(X[0], X[1]), Yb1 = pack44(X[2], X[3]);
            SB_();
#pragma unroll
            for (int i = 0; i < 8; ++i) fb[i] = FR(57344, i);
            SB_();
#pragma unroll
            for (int mt = 0; mt < 4; ++mt) { VN[mt] = MF(fa[mt * 2], Yb0, VN[mt]); VN[mt] = MF(fa[mt * 2 + 1], Yb1, VN[mt]); }
            SB_();
#pragma unroll
            for (int mt = 0; mt < 4; ++mt) O[mt] = O[mt] * eg[mt];
            const bf16x8 Vb0 = pack44(VN[0], VN[1]), Vb1 = pack44(VN[2], VN[3]);
            SB_();
#pragma unroll
            for (int i = 0; i < 8; ++i) fa[i] = FR(16384, i);
            SB_();
#pragma unroll
            for (int mt = 0; mt < 4; ++mt) { O[mt] = MF(fb[mt * 2], Vb0, O[mt]); O[mt] = MF(fb[mt * 2 + 1], Vb1, O[mt]); }
            SB_();
#pragma unroll
            for (int mt = 0; mt < 4; ++mt) VN[mt] = VN[mt] * dl[mt];
            const bf16x8 Vd0 = pack44(VN[0], VN[1]), Vd1 = pack44(VN[2], VN[3]);
#pragma unroll
            for (int i = 0; i < 8; ++i) S[i] = S[i] * egl;
            SB_();
#pragma unroll
            for (int i = 0; i < 8; ++i) fb[i] = FR(16384, 8 + i);
            SB_();
#pragma unroll
            for (int i = 0; i < 4; ++i) { S[i] = MF(fa[i * 2], Vd0, S[i]); S[i] = MF(fa[i * 2 + 1], Vd1, S[i]); }
            SB_();
#pragma unroll
            for (int i = 0; i < 4; ++i) { S[4 + i] = MF(fb[i * 2], Vd0, S[4 + i]); S[4 + i] = MF(fb[i * 2 + 1], Vd1, S[4 + i]); }
            SB_();
            {
                const int row0 = cidx < 4 ? ML + b * CT + cidx * 64 : b * T + (cidx - 4) * 64;
                float* op = Og + (size_t)(row0 + 4 * g4) * 512;
#pragma unroll
                for (int mt = 0; mt < 4; ++mt)
#pragma unroll
                    for (int t = 0; t < 4; ++t) { if (VAR != 1) op[(size_t)(16 * mt + t) * 512] = O[mt][t]; else asm volatile("" :: "v"(O[mt][t])); }
            }
#undef RD_KQ
#undef MM_KQ
#undef SB_
#undef FR
#undef MF
            asm volatile("s_waitcnt lgkmcnt(0)" ::: "memory"); __builtin_amdgcn_s_barrier(); asm volatile("" ::: "memory");
        }
    }
#undef CIDX
#undef a
}

__device__ __forceinline__ void phase_dn_out(int l) {
    const KArgs ap = get_args();
#define a (*ap)

    const int tid = fresh_tid(), lane = tid & 63, wave = __builtin_amdgcn_readfirstlane(tid >> 6), G = fresh_g(), bx = fresh_bx();
    unsigned char* ws = a.ws;
    const int nrows = (l == DEPTH - 1) ? ML : M;
    const float* OF = (const float*)(ws + WS_OF); const float* OB = (const float*)(ws + WS_OB);
    const bf16_t* P = (const bf16_t*)(ws + WS_P); bf16_t* CAT = (bf16_t*)(ws + WS_CAT);
    const f32x2 nw = *(const f32x2*)(a.in[I_DNW] + l * 128 + 2 * lane);
    const float* LSE = (const float*)(ws + WS_BA);
    for (int row = wave * G + bx; row < nrows; row += G * 8) {
        f32x2 of[4], ob[4]; unsigned gw[4];
#pragma unroll
        for (int hh = 0; hh < 4; ++hh) { of[hh] = *(const f32x2*)(OF + (size_t)row * 512 + hh * 128 + 2 * lane); ob[hh] = *(const f32x2*)(OB + (size_t)row * 512 + hh * 128 + 2 * lane);
            gw[hh] = *(const unsigned*)(P + (size_t)row * NP + 2560 + hh * 128 + 2 * lane); }
        u32x4 ap_[4]; float ls_[4];
#pragma unroll
        for (int p = 0; p < 4; ++p) { ap_[p] = (u32x4){0u, 0u, 0u, 0u}; ls_[p] = 0.f; }
        if (row < ML) {
            ap_[0] = *(const u32x4*)(CAT + (size_t)row * 1024 + 8 * lane); ap_[1] = *(const u32x4*)((const bf16_t*)(ws + WS_DQ) + (size_t)row * 512 + 8 * lane);
            ap_[2] = *(const u32x4*)((const bf16_t*)(ws + WS_DK) + (size_t)row * 512 + 8 * lane); ap_[3] = *(const u32x4*)((const bf16_t*)(ws + WS_DV) + (size_t)row * 512 + 8 * lane);
#pragma unroll
            for (int p = 0; p < 4; ++p) ls_[p] = LSE[((size_t)p * ML + row) * 4 + (lane >> 4)]; }
        float o0[4], o1[4], ssq[4];
#pragma unroll
        for (int hh = 0; hh < 4; ++hh) { o0[hh] = of[hh][0] + ob[hh][0]; o1[hh] = of[hh][1] + ob[hh][1]; ssq[hh] = o0[hh] * o0[hh] + o1[hh] * o1[hh]; }
#pragma unroll
        for (int hh = 0; hh < 4; ++hh) ssq[hh] = wave_sum(ssq[hh]);
        float mxv = 0.f;
#pragma unroll
        for (int hh = 0; hh < 4; ++hh) { const float rs = rsqrtf(ssq[hh] * (1.f / 128.f) + EPS); const float g0 = bflo(gw[hh]), g1 = bfhi(gw[hh]);
            o0[hh] = o0[hh] * rs * nw[0] * silu_f(g0); o1[hh] = o1[hh] * rs * nw[1] * silu_f(g1); mxv = fmaxf(mxv, fmaxf(fabsf(o0[hh]), fabsf(o1[hh]))); }
        float av[8];
        if (row < ML) { const float mx = fmaxf(fmaxf(ls_[0], ls_[1]), fmaxf(ls_[2], ls_[3]));
            float w_[4], wsum = 0.f;
#pragma unroll
            for (int p = 0; p < 4; ++p) { w_[p] = __expf(ls_[p] - mx); wsum += w_[p]; }
            const float inv = 1.f / wsum;
#pragma unroll
            for (int i = 0; i < 4; ++i) { float lo = 0.f, hi2 = 0.f;
#pragma unroll
                for (int p = 0; p < 4; ++p) { lo = fmaf(w_[p], bflo(ap_[p][i]), lo); hi2 = fmaf(w_[p], bfhi(ap_[p][i]), hi2); }
                av[2 * i] = lo * inv; av[2 * i + 1] = hi2 * inv; } }
        else { const u32x4 cw_ = *(const u32x4*)(CAT + (size_t)row * 1024 + 8 * lane);
#pragma unroll
            for (int i = 0; i < 4; ++i) { av[2 * i] = bflo(cw_[i]); av[2 * i + 1] = bfhi(cw_[i]); } }
#pragma unroll
        for (int i = 0; i < 8; ++i) mxv = fmaxf(mxv, fabsf(av[i]));
        mxv = fmaxf(wave_max(mxv), 1e-30f);
        const float cinv = 127.f / mxv;
        signed char* crow = (signed char*)(ws + WS_CATQ) + (size_t)row * 1024;
#define Q8_(x) ((unsigned)(int)rintf((x) * cinv) & 255u)
        { u32x2 o; o.x = Q8_(av[0]) | (Q8_(av[1]) << 8) | (Q8_(av[2]) << 16) | (Q8_(av[3]) << 24); o.y = Q8_(av[4]) | (Q8_(av[5]) << 8) | (Q8_(av[6]) << 16) | (Q8_(av[7]) << 24); *(u32x2*)(crow + 8 * lane) = o; }
#pragma unroll
        for (int hh = 0; hh < 4; ++hh) *(unsigned short*)(crow + 512 + hh * 128 + 2 * lane) = (unsigned short)(Q8_(o0[hh]) | (Q8_(o1[hh]) << 8));
#undef Q8_
        if (lane == 0) ((float*)(ws + WS_GB))[(1u << 18) + row] = mxv * (1.f / 127.f);
    }
#undef a
}

#define CE_DESC(a_, b_) do { const float hi_ = fmaxf(a_, b_), lo_ = fminf(a_, b_); a_ = hi_; b_ = lo_; } while (0)
__device__ __forceinline__ void bitonic_sort16_desc(float (&v)[16]) {
#pragma unroll
    for (int k = 2; k <= 16; k <<= 1)
#pragma unroll
        for (int j = k >> 1; j > 0; j >>= 1)
#pragma unroll
            for (int i = 0; i < 16; ++i) { const int p = i ^ j; if (p > i) { if ((i & k) == 0) CE_DESC(v[i], v[p]); else CE_DESC(v[p], v[i]); } }
}
__device__ __forceinline__ void merge_top16_desc(float (&lst)[16], const float (&nw)[16]) {
#pragma unroll
    for (int i = 0; i < 16; ++i) lst[i] = fmaxf(lst[i], nw[15 - i]);
#pragma unroll
    for (int j = 8; j > 0; j >>= 1)
#pragma unroll
        for (int i = 0; i < 16; ++i) { const int p = i ^ j; if (p > i) CE_DESC(lst[i], lst[p]); }
}
__device__ __forceinline__ void phase_peer_select(int l) {
    const KArgs ap = get_args();
#define a (*ap)
    const int tid = fresh_tid(), lane = tid & 63, wave = __builtin_amdgcn_readfirstlane(tid >> 6), G = fresh_g(), bx = fresh_bx();
    unsigned char* ws = a.ws;
    const int nrows = (l == DEPTH - 1) ? ML : M;
    const int ntask = (nrows / 32) * 4;
    const bf16_t* Q2 = (const bf16_t*)(ws + WS_P);
    const bf16_t* SKB = (const bf16_t*)(ws + WS_SKB) + (size_t)l * 8 * 2 * 128 * 128;
    int* PIDX = (int*)(ws + WS_PIDX); float* PGATE = (float*)(ws + WS_PGATE);
    const float NEG = -3.0e38f;
    const int r = lane & 31, hi = lane >> 5;
    for (int task = wave * G + bx; task < ntask; task += G * 8) {
        const int tg = task >> 2, hp = task & 3; const int row = tg * 32 + r;
        float mine0[16], mine1[16];
#pragma unroll
        for (int j = 0; j < 16; ++j) { mine0[j] = NEG; mine1[j] = NEG; }
        bf16x8 qA[8], kA[8];
        float lst[16];
#define SEL_QPTR(it_) (Q2 + (size_t)row * 2048 + (2 * hp + ((it_) >> 1)) * 256 + ((it_) & 1) * 128 + 8 * hi)
#define SEL_KPTR(it_, t_) (SKB + (size_t)(((2 * hp + ((it_) >> 1)) * 2 + ((it_) & 1)) * 128 + 32 * (t_) + r) * 128 + 8 * hi)
#define SEL_LDQ(dst, it_) do { const bf16_t* qp_ = SEL_QPTR(it_); _Pragma("unroll") for (int ks = 0; ks < 8; ++ks) dst[ks] = *(const bf16x8*)(qp_ + 16 * ks); } while (0)
#define SEL_LDK(dst, it_, t_) do { const bf16_t* kp_ = SEL_KPTR(it_, t_); _Pragma("unroll") for (int ks = 0; ks < 8; ++ks) dst[ks] = *(const bf16x8*)(kp_ + 16 * ks); } while (0)
#define SEL_RANK(qv, kv, t_) do { f32x16 acc = {}; _Pragma("unroll") for (int ks = 0; ks < 8; ++ks) acc = __builtin_amdgcn_mfma_f32_32x32x16_bf16(kv[ks], qv[ks], acc, 0, 0, 0); \
            const unsigned kb = (unsigned)(32 * (t_) + 4 * hi); float nw_[16]; \
            _Pragma("unroll") for (int i = 0; i < 16; ++i) nw_[i] = __uint_as_float((__float_as_uint(acc[i]) & 0xffffff80u) | (kb + (unsigned)((i & 3) + 8 * (i >> 2)))); \
            bitonic_sort16_desc(nw_); merge_top16_desc(lst, nw_); } while (0)
#define SB_() __builtin_amdgcn_sched_barrier(0)
#pragma unroll
        for (int j = 0; j < 16; ++j) lst[j] = NEG;
#pragma unroll 1
        for (int it = 0; it < 4; ++it) {
            SEL_LDQ(qA, it);
#pragma unroll 1
            for (int t = 0; t < 4; ++t) { SEL_LDK(kA, it, t); SEL_RANK(qA, kA, t); }
            float oth[16];
#pragma unroll
            for (int j = 0; j < 16; ++j) { auto rr = __builtin_amdgcn_permlane32_swap(__float_as_uint(lst[j]), __float_as_uint(lst[j]), false, false); oth[j] = __uint_as_float(hi ? rr[0] : rr[1]); }
            merge_top16_desc(lst, oth);
            const bool k0 = ((it >> 1) == hi) && ((it & 1) == 0), k1 = ((it >> 1) == hi) && ((it & 1) == 1);
#pragma unroll
            for (int j = 0; j < 16; ++j) { mine0[j] = k0 ? lst[j] : mine0[j]; mine1[j] = k1 ? lst[j] : mine1[j]; lst[j] = NEG; }
        }
#undef SB_
#undef SEL_QPTR
#undef SEL_KPTR
#undef SEL_LDQ
#undef SEL_LDK
#undef SEL_RANK
        const int h = 2 * hp + hi;
        float ts[16];
#pragma unroll
        for (int j = 0; j < 16; ++j) ts[j] = NEG;
#pragma unroll
        for (int i = 0; i < 16; ++i)
#pragma unroll
            for (int j = 0; j < 16; ++j) if ((i + 1) * (j + 1) <= 16) {
                const unsigned b0 = __float_as_uint(mine0[i]), b1 = __float_as_uint(mine1[j]);
                const float c = __uint_as_float(b0 & 0xffffff80u) + __uint_as_float(b1 & 0xffffff80u);
                float x = __uint_as_float((__float_as_uint(c) & 0xffffc000u) | ((b0 & 127u) << 7) | (b1 & 127u));
#pragma unroll
                for (int t = 0; t < 16; ++t) { const float hv = fmaxf(ts[t], x); x = fminf(ts[t], x); ts[t] = hv; }
            }
        int te[16]; float ex[16], sum = 0.f;
        const float tmax = __uint_as_float(__float_as_uint(ts[0]) & 0xffffc000u);
#pragma unroll
        for (int t = 0; t < 16; ++t) { const unsigned bt = __float_as_uint(ts[t]); te[t] = (int)(bt & 0x3fffu); ex[t] = __expf(__uint_as_float(bt & 0xffffc000u) - tmax); sum += ex[t]; }
        const float inv = 1.f / sum;
        int* ip = PIDX + (size_t)row * 128 + h * 16; float* gp = PGATE + (size_t)row * 128 + h * 16;
#pragma unroll
        for (int t = 0; t < 16; t += 4) { *(u32x4*)(ip + t) = (u32x4){(unsigned)te[t], (unsigned)te[t + 1], (unsigned)te[t + 2], (unsigned)te[t + 3]}; *(f32x4*)(gp + t) = (f32x4){ex[t] * inv, ex[t + 1] * inv, ex[t + 2] * inv, ex[t + 3] * inv}; }
    }
#undef a
}

template <bool WR, int GV = 0>
__device__ __forceinline__ void phase_peer_gather(int l, LAS unsigned char* lds) {
    const KArgs ap = get_args();
#define a (*ap)
    const int tid = fresh_tid(), lane = tid & 63, wave = __builtin_amdgcn_readfirstlane(tid >> 6), G = fresh_g(), bx = fresh_bx();
    unsigned char* ws = a.ws;
    const int nrows = (l == DEPTH - 1) ? ML : M;
    const unsigned char* UB = ws + WS_UB + (size_t)(l & 1) * TAB_SET; const unsigned char* VB = UB + 1024;
    const float* USC = (const float*)(ws + WS_USC) + (l & 1) * 2 * NEXP; const float* VSC = USC + NEXP;
    const int* PIDX = (const int*)(ws + WS_PIDX); const float* PGATE = (const float*)(ws + WS_PGATE);
    const float* modl = (const float*)(ws + WS_MOD) + (size_t)l * 3 * 6144 + 5120;
    const bool fuse = WR && (l + 1 < DEPTH);
    LAS float* wsk = (LAS float*)lds;
    if (fuse) { const float* src = (const float*)(ws + WS_WSK) + (size_t)(l + 1) * 16384; for (int i = tid; i < 16384 / 4; i += 512) ((LAS f32x4*)wsk)[i] = ((const f32x4*)src)[i]; __syncthreads(); }
    const float* nw1 = a.in[I_N1W] + (l + 1 < DEPTH ? l + 1 : l) * 1024 + 16 * lane;
    const float* modn = (const float*)(ws + WS_MOD) + (size_t)(l + 1 < DEPTH ? l + 1 : l) * 3 * 6144;
    for (int row = wave * G + bx; row < nrows; row += G * 8) {
        float hv[16], out[16];
        { const u32x4 hw = *(const u32x4*)((const signed char*)(ws + WS_H) + (size_t)row * D + 16 * lane); const float hsc = ((const float*)(ws + WS_GB))[row];
#pragma unroll
          for (int q = 0; q < 4; ++q) { const int w = (int)hw[q]; hv[4 * q + 0] = (float)((w << 24) >> 24) * hsc; hv[4 * q + 1] = (float)((w << 16) >> 24) * hsc; hv[4 * q + 2] = (float)((w << 8) >> 24) * hsc; hv[4 * q + 3] = (float)(w >> 24) * hsc; } }
        float hs = 0.f;
#pragma unroll
        for (int i = 0; i < 16; ++i) { out[i] = 0.f; hs += hv[i]; }
        const float hsum128 = 128.f * wave_sum(hs);
        float wacc = 0.f;
        const int id0 = PIDX[(size_t)row * 128 + lane], id1 = PIDX[(size_t)row * 128 + 64 + lane];
        const float gt0 = PGATE[(size_t)row * 128 + lane], gt1 = PGATE[(size_t)row * 128 + 64 + lane];
        const float us0 = USC[id0], us1 = USC[id1], vs0 = VSC[id0], vs1 = VSC[id1];
        for (int e0 = 0; e0 < 128; e0 += 8) {
            u32x4 uw[8], vw[8]; float gte[8], use[8], vse[8];
#pragma unroll
            for (int j = 0; j < 8; ++j) { const int e = e0 + j; const int id = __builtin_amdgcn_readlane(e0 < 64 ? id0 : id1, e & 63);
                gte[j] = __builtin_bit_cast(float, __builtin_amdgcn_readlane(__builtin_bit_cast(int, e0 < 64 ? gt0 : gt1), e & 63));
                use[j] = __builtin_bit_cast(float, __builtin_amdgcn_readlane(__builtin_bit_cast(int, e0 < 64 ? us0 : us1), e & 63));
                vse[j] = __builtin_bit_cast(float, __builtin_amdgcn_readlane(__builtin_bit_cast(int, e0 < 64 ? vs0 : vs1), e & 63));
                uw[j] = *(const u32x4*)(UB + (size_t)id * 2048 + 16 * lane); vw[j] = *(const u32x4*)(VB + (size_t)id * 2048 + 16 * lane); }
#pragma unroll
            for (int j = 0; j < 8; ++j) {
                float d0 = 0.f, d1 = 0.f;
#pragma unroll
                for (int q = 0; q < 4; ++q) { const unsigned w = uw[j][q];
                    d0 = fmaf((float)(w & 255u), hv[4 * q + 0], d0); d1 = fmaf((float)((w >> 8) & 255u), hv[4 * q + 1], d1);
                    d0 = fmaf((float)((w >> 16) & 255u), hv[4 * q + 2], d0); d1 = fmaf((float)(w >> 24), hv[4 * q + 3], d1); }
                const float dsum = (wave_sum(d0 + d1) - hsum128) * use[j];
                const float act = 0.5f * dsum * (1.f + erff(dsum * 0.70710678118654752f));
                const float wgt = gte[j] * act * vse[j];
                wacc += wgt;
                if (GV == 1) { asm volatile("" :: "v"(vw[j])); out[0] += wgt; } else
#pragma unroll
                for (int q = 0; q < 4; ++q) { const unsigned w = vw[j][q];
                    out[4 * q + 0] = fmaf(wgt, (float)(w & 255u), out[4 * q + 0]); out[4 * q + 1] = fmaf(wgt, (float)((w >> 8) & 255u), out[4 * q + 1]);
                    out[4 * q + 2] = fmaf(wgt, (float)((w >> 16) & 255u), out[4 * q + 2]); out[4 * q + 3] = fmaf(wgt, (float)(w >> 24), out[4 * q + 3]); }
            }
        }
        const float corr = 128.f * wacc;
        float* xr; int mrow;
        if (row < ML) { xr = a.out + (size_t)row * D; mrow = row >= T ? 1 : 0; } else { xr = (float*)(ws + WS_CTXX) + (size_t)(row - ML) * D; mrow = 2; }
        const float* g2 = modl + mrow * 6144 + 16 * lane;
        f32x4 xn[4];
#pragma unroll
        for (int i = 0; i < 4; ++i) { const f32x4 x = *(const f32x4*)(xr + 16 * lane + 4 * i), g = *(const f32x4*)(g2 + 4 * i);
            xn[i] = x + g * (f32x4){out[4 * i] - corr, out[4 * i + 1] - corr, out[4 * i + 2] - corr, out[4 * i + 3] - corr};
            if (WR) *(f32x4*)(xr + 16 * lane + 4 * i) = xn[i]; else asm volatile("" :: "v"(xn[i])); }
        if (fuse) {
            float ss = 0.f;
#pragma unroll
            for (int i = 0; i < 4; ++i) ss += (xn[i][0] * xn[i][0] + xn[i][1] * xn[i][1]) + (xn[i][2] * xn[i][2] + xn[i][3] * xn[i][3]);
            const float rstd = rsqrtf(wave_sum(ss) * (1.f / D) + EPS);
            const float* md = modn + mrow * 6144 + 16 * lane;
#pragma unroll
            for (int i = 0; i < 4; ++i) { const f32x4 nwv = *(const f32x4*)(nw1 + 4 * i), sc = *(const f32x4*)(md + 1024 + 4 * i), sh = *(const f32x4*)(md + 4 * i);
                xn[i] = xn[i] * rstd * nwv * (sc + 1.f) + sh; }
            { float hmx = 0.f;
#pragma unroll
              for (int i = 0; i < 4; ++i) hmx = fmaxf(hmx, fmaxf(fmaxf(fabsf(xn[i][0]), fabsf(xn[i][1])), fmaxf(fabsf(xn[i][2]), fabsf(xn[i][3]))));
              hmx = fmaxf(wave_max(hmx), 1e-30f); const float hinv = 127.f / hmx;
              u32x4 o;
#pragma unroll
              for (int i = 0; i < 4; ++i) o[i] = ((unsigned)(int)rintf(xn[i][0] * hinv) & 255u) | (((unsigned)(int)rintf(xn[i][1] * hinv) & 255u) << 8) | (((unsigned)(int)rintf(xn[i][2] * hinv) & 255u) << 16) | (((unsigned)(int)rintf(xn[i][3] * hinv) & 255u) << 24);
              *(u32x4*)((signed char*)(ws + WS_H) + (size_t)row * D + 16 * lane) = o;
              if (lane == 0) ((float*)(ws + WS_GB))[row] = hmx * (1.f / 127.f); }
            float p[16];
#pragma unroll
            for (int c = 0; c < 16; ++c) { float q = 0.f;
#pragma unroll
                for (int i = 0; i < 4; ++i) { const f32x4 w = *(const LAS f32x4*)(wsk + c * 1024 + 16 * lane + 4 * i); q += (xn[i][0] * w[0] + xn[i][1] * w[1]) + (xn[i][2] * w[2] + xn[i][3] * w[3]); }
                p[c] = q; }
            { const bool hb = (lane & 32) != 0;
#pragma unroll
              for (int c = 0; c < 8; ++c) { const float keep = hb ? p[c + 8] : p[c], send = hb ? p[c] : p[c + 8]; p[c] = keep + lane_xor<32>(send); } }
            { const bool hb = (lane & 16) != 0;
#pragma unroll
              for (int c = 0; c < 4; ++c) { const float keep = hb ? p[c + 4] : p[c], send = hb ? p[c] : p[c + 4]; p[c] = keep + lane_xor<16>(send); } }
            { const bool hb = (lane & 8) != 0;
#pragma unroll
              for (int c = 0; c < 2; ++c) { const float keep = hb ? p[c + 2] : p[c], send = hb ? p[c] : p[c + 2]; p[c] = keep + lane_xor<8>(send); } }
            { const bool hb = (lane & 4) != 0; const float keep = hb ? p[1] : p[0], send = hb ? p[0] : p[1]; p[0] = keep + lane_xor<4>(send); }
            p[0] += lane_xor<2>(p[0]); p[0] += lane_xor<1>(p[0]);
            if ((lane & 3) == 0) { const int c = ((lane >> 5) & 1) * 8 + ((lane >> 4) & 1) * 4 + ((lane >> 3) & 1) * 2 + ((lane >> 2) & 1); ((float*)(ws + WS_BA))[(size_t)row * 16 + c] = p[0]; }
        }
    }
    if (fuse) __syncthreads();
}
#undef a
constexpr size_t WS_PART = WS_P;
static_assert(WS_PART + 8 * (size_t)M * 1024 * 2 <= WS_GB, "partials region");
constexpr int GP_ITEM = 16;
struct GpMeta { int id0, id1; float gt0, gt1; u32x4 hw; float hsc; };
__device__ __forceinline__ void phase_peer_gpart(int l, LAS unsigned char* lds) {
    const KArgs ap = get_args();
#define a (*ap)
    const int tid = fresh_tid(), lane = tid & 63, wave = __builtin_amdgcn_readfirstlane(tid >> 6);
    unsigned char* ws = a.ws;
    const int nrows = (l == DEPTH - 1) ? ML : M;
    const int nitem = nrows / GP_ITEM;
    const unsigned char* UB = ws + WS_UB + (size_t)(l & 1) * TAB_SET; const unsigned char* VB = UB + 1024;
    const f32x2* SC2 = (const f32x2*)(ws + WS_USC) + (size_t)(l & 1) * NEXP;
    const int* PIDX = (const int*)(ws + WS_PIDX); const float* PGATE = (const float*)(ws + WS_PGATE);
    LAS u32x4* lst0 = (LAS u32x4*)lds + wave * 256;
    const int eidx = ((lane >> 5) & 1) * 4 + ((lane >> 4) & 1) * 2 + ((lane >> 3) & 1);
    const int x = (int)(xb_xcc_id() & 7u);
#define GP_LOAD_META(m_, row_) do { const int rw_ = (row_); (m_).id0 = PIDX[(size_t)rw_ * 128 + lane]; (m_).id1 = PIDX[(size_t)rw_ * 128 + 64 + lane]; (m_).gt0 = PGATE[(size_t)rw_ * 128 + lane]; (m_).gt1 = PGATE[(size_t)rw_ * 128 + 64 + lane]; \
        (m_).hw = *(const u32x4*)((const signed char*)(ws + WS_H) + (size_t)rw_ * D + 16 * lane); (m_).hsc = ((const float*)(ws + WS_GB))[rw_]; } while (0)
#define GP_LOAD_SC(sa_, sb_, m_) do { sa_ = (f32x2){0.f, 0.f}; sb_ = (f32x2){0.f, 0.f}; if (((m_).id0 >> 11) == p) sa_ = SC2[(m_).id0]; if (((m_).id1 >> 11) == p) sb_ = SC2[(m_).id1]; } while (0)
#define GP_BUILD(cnt_, m_, sa_, sb_, buf_) do { const bool s0_ = ((m_).id0 >> 11) == p, s1_ = ((m_).id1 >> 11) == p; const unsigned long long m0_ = __ballot(s0_), m1_ = __ballot(s1_); \
        const int c0_ = __builtin_popcountll(m0_); cnt_ = __builtin_amdgcn_readfirstlane(c0_ + __builtin_popcountll(m1_)); \
        const int r0_ = (int)__builtin_amdgcn_mbcnt_hi((unsigned)(m0_ >> 32), __builtin_amdgcn_mbcnt_lo((unsigned)m0_, 0u)); \
        const int r1_ = c0_ + (int)__builtin_amdgcn_mbcnt_hi((unsigned)(m1_ >> 32), __builtin_amdgcn_mbcnt_lo((unsigned)m1_, 0u)); \
        LAS u32x4* lb_ = lst0 + (buf_) * 128; \
        if (s0_) lb_[r0_] = (u32x4){(unsigned)(m_).id0, __float_as_uint((m_).gt0 * sa_[1]), __float_as_uint(sa_[0]), 0u}; \
        if (s1_) lb_[r1_] = (u32x4){(unsigned)(m_).id1, __float_as_uint((m_).gt1 * sb_[1]), __float_as_uint(sb_[0]), 0u}; } while (0)
#pragma unroll 1
    for (int pp = 0; pp < 8; ++pp) {
        const int p = (x + pp) & 7;
        unsigned* ctr = (unsigned*)(ws + WS_CTL) + 16384 + (l * 8 + p) * 64;
        unsigned* part = (unsigned*)(ws + WS_PART + (size_t)p * M * 2048);
        unsigned tk = 0; if (lane == 0) tk = __hip_atomic_fetch_add(ctr, 1u, __ATOMIC_RELAXED, __HIP_MEMORY_SCOPE_AGENT);
        int it = __builtin_amdgcn_readfirstlane((int)tk);
#pragma unroll 1
        while (it < nitem) {
            unsigned tn = 0; if (lane == 0) tn = __hip_atomic_fetch_add(ctr, 1u, __ATOMIC_RELAXED, __HIP_MEMORY_SCOPE_AGENT);
            const int row0 = it * GP_ITEM, rowl = row0 + GP_ITEM - 1;
            GpMeta m1, m2, m3; f32x2 sa1, sb1, sa2, sb2; int c_cur, c_nxt; u32x4 hw_cur; float hsc_cur;
            GP_LOAD_META(m1, row0); GP_LOAD_META(m2, min(row0 + 1, rowl)); GP_LOAD_META(m3, min(row0 + 2, rowl));
            GP_LOAD_SC(sa1, sb1, m1);
            GP_BUILD(c_cur, m1, sa1, sb1, 0); hw_cur = m1.hw; hsc_cur = m1.hsc;
            GP_LOAD_SC(sa1, sb1, m2);
            m1 = m2; m2 = m3;
            GP_LOAD_META(m3, min(row0 + 3, rowl));
#pragma unroll 1
            for (int i = 0; i < GP_ITEM; ++i) {
                const int row = row0 + i;
                GP_BUILD(c_nxt, m1, sa1, sb1, (i + 1) & 1);
                const u32x4 hw_nxt = m1.hw; const float hsc_nxt = m1.hsc;
                GP_LOAD_SC(sa2, sb2, m2);
                m1 = m2; sa1 = sa2; sb1 = sb2; m2 = m3;
                GP_LOAD_META(m3, min(row + 4, rowl));
                LAS u32x4* lst = lst0 + (i & 1) * 128;
                const int c = c_cur; const u32x4 hw = hw_cur; const float hsc = hsc_cur;
                f32x2 o2[8];
#pragma unroll
                for (int k = 0; k < 8; ++k) o2[k] = (f32x2){0.f, 0.f};
                float wacc = 0.f;
#pragma unroll 1
                for (int e = 0; e < c; e += 8) {
                    u32x4 uw[8], vw[8];
#pragma unroll
                    for (int j = 0; j < 8; ++j) { const int sl = min(e + j, c - 1);
                        const int id = __builtin_amdgcn_readfirstlane((int)lst[sl][0]);
                        uw[j] = *(const u32x4*)(UB + (size_t)id * 2048 + 16 * lane); vw[j] = *(const u32x4*)(VB + (size_t)id * 2048 + 16 * lane); }
                    const int ms = e + eidx; const u32x4 en = lst[min(ms, c - 1)];
                    float pd[8];
#pragma unroll
                    for (int j = 0; j < 8; ++j) { int d = 0;
#pragma unroll
                        for (int q = 0; q < 4; ++q) d = __builtin_amdgcn_sdot4((int)uw[j][q], (int)hw[q], d, false);
                        pd[j] = (float)d; }
                    { const bool hb = (lane & 32) != 0;
#pragma unroll
                      for (int j = 0; j < 4; ++j) { const float keep = hb ? pd[j + 4] : pd[j], send = hb ? pd[j] : pd[j + 4]; pd[j] = keep + lane_xor<32>(send); } }
                    { const bool hb = (lane & 16) != 0;
#pragma unroll
                      for (int j = 0; j < 2; ++j) { const float keep = hb ? pd[j + 2] : pd[j], send = hb ? pd[j] : pd[j + 2]; pd[j] = keep + lane_xor<16>(send); } }
                    { const bool hb = (lane & 8) != 0; const float keep = hb ? pd[1] : pd[0], send = hb ? pd[0] : pd[1]; pd[0] = keep + lane_xor<8>(send); }
                    pd[0] += lane_xor<4>(pd[0]); pd[0] += lane_xor<2>(pd[0]); pd[0] += lane_xor<1>(pd[0]);
                    const float dsum = pd[0] * (__uint_as_float(en[2]) * hsc);
                    const float act = 0.5f * dsum * (1.f + erff(dsum * 0.70710678118654752f));
                    const float wgt = ms < c ? __uint_as_float(en[1]) * act : 0.f;
                    wacc += wgt;
#pragma unroll
                    for (int j = 0; j < 8; ++j) {
                        const float wj = __builtin_bit_cast(float, __builtin_amdgcn_readlane(__builtin_bit_cast(int, wgt), 32 * ((j >> 2) & 1) + 16 * ((j >> 1) & 1) + 8 * (j & 1)));
                        const f32x2 ww = {wj, wj};
#pragma unroll
                        for (int q = 0; q < 4; ++q) { const unsigned w = vw[j][q];
                            const f32x2 v01 = {(float)(w & 255u), (float)((w >> 8) & 255u)}, v23 = {(float)((w >> 16) & 255u), (float)(w >> 24)};
                            o2[2 * q] = __builtin_elementwise_fma(ww, v01, o2[2 * q]); o2[2 * q + 1] = __builtin_elementwise_fma(ww, v23, o2[2 * q + 1]); }
                    }
                }
                const float corr = 16.f * wave_sum(wacc);
                u32x4 w0, w1;
#pragma unroll
                for (int k = 0; k < 4; ++k) { w0[k] = pkbf_c(o2[k][0] - corr, o2[k][1] - corr); w1[k] = pkbf_c(o2[4 + k][0] - corr, o2[4 + k][1] - corr); }
                unsigned* dst = part + (size_t)row * 512 + 8 * lane;
                __builtin_nontemporal_store(w0, (u32x4*)dst); __builtin_nontemporal_store(w1, (u32x4*)(dst + 4));
                c_cur = c_nxt; hw_cur = hw_nxt; hsc_cur = hsc_nxt;
            }
            it = __builtin_amdgcn_readfirstlane((int)tn);
        }
    }
#undef GP_LOAD_META
#undef GP_LOAD_SC
#undef GP_BUILD
#undef a
}

__device__ __forceinline__ void phase_peer_combine(int l, LAS unsigned char* lds) {
    const KArgs ap = get_args();
#define a (*ap)
    const int tid = fresh_tid(), lane = tid & 63, wave = __builtin_amdgcn_readfirstlane(tid >> 6), G = fresh_g(), bx = fresh_bx();
    unsigned char* ws = a.ws;
    const int nrows = (l == DEPTH - 1) ? ML : M;
    const float* modl = (const float*)(ws + WS_MOD) + (size_t)l * 3 * 6144 + 5120;
    const bool fuse = (l + 1 < DEPTH);
    LAS float* wsk = (LAS float*)lds;
    if (fuse) { const float* src = (const float*)(ws + WS_WSK) + (size_t)(l + 1) * 16384; for (int i = tid; i < 16384 / 4; i += 512) ((LAS f32x4*)wsk)[i] = ((const f32x4*)src)[i]; __syncthreads(); }
    const float* nw1 = a.in[I_N1W] + (l + 1 < DEPTH ? l + 1 : l) * 1024 + 16 * lane;
    const float* modn = (const float*)(ws + WS_MOD) + (size_t)(l + 1 < DEPTH ? l + 1 : l) * 3 * 6144;
    for (int row = wave * G + bx; row < nrows; row += G * 8) {
        float out[16];
#pragma unroll
        for (int i = 0; i < 16; ++i) out[i] = 0.f;
#pragma unroll
        for (int p = 0; p < 8; ++p) { const unsigned* src = (const unsigned*)(ws + WS_PART + (size_t)p * M * 2048) + (size_t)row * 512 + 8 * lane;
            const u32x4 w0 = __builtin_nontemporal_load((const u32x4*)src), w1 = __builtin_nontemporal_load((const u32x4*)(src + 4));
#pragma unroll
            for (int k = 0; k < 4; ++k) { out[2 * k] += bflo(w0[k]); out[2 * k + 1] += bfhi(w0[k]); out[8 + 2 * k] += bflo(w1[k]); out[8 + 2 * k + 1] += bfhi(w1[k]); } }
        float* xr; int mrow;
        if (row < ML) { xr = a.out + (size_t)row * D; mrow = row >= T ? 1 : 0; } else { xr = (float*)(ws + WS_CTXX) + (size_t)(row - ML) * D; mrow = 2; }
        const float* g2 = modl + mrow * 6144 + 16 * lane;
        f32x4 xn[4];
#pragma unroll
        for (int i = 0; i < 4; ++i) { const f32x4 x = *(const f32x4*)(xr + 16 * lane + 4 * i), g = *(const f32x4*)(g2 + 4 * i);
            xn[i] = x + g * (f32x4){out[4 * i], out[4 * i + 1], out[4 * i + 2], out[4 * i + 3]};
            *(f32x4*)(xr + 16 * lane + 4 * i) = xn[i]; }
        if (fuse) {
            float ss = 0.f;
#pragma unroll
            for (int i = 0; i < 4; ++i) ss += (xn[i][0] * xn[i][0] + xn[i][1] * xn[i][1]) + (xn[i][2] * xn[i][2] + xn[i][3] * xn[i][3]);
            const float rstd = rsqrtf(wave_sum(ss) * (1.f / D) + EPS);
            const float* md = modn + mrow * 6144 + 16 * lane;
#pragma unroll
            for (int i = 0; i < 4; ++i) { const f32x4 nwv = *(const f32x4*)(nw1 + 4 * i), sc = *(const f32x4*)(md + 1024 + 4 * i), sh = *(const f32x4*)(md + 4 * i);
                xn[i] = xn[i] * rstd * nwv * (sc + 1.f) + sh; }
            { float hmx = 0.f;
#pragma unroll
              for (int i = 0; i < 4; ++i) hmx = fmaxf(hmx, fmaxf(fmaxf(fabsf(xn[i][0]), fabsf(xn[i][1])), fmaxf(fabsf(xn[i][2]), fabsf(xn[i][3]))));
              hmx = fmaxf(wave_max(hmx), 1e-30f); const float hinv = 127.f / hmx;
              u32x4 o;
#pragma unroll
              for (int i = 0; i < 4; ++i) o[i] = ((unsigned)(int)rintf(xn[i][0] * hinv) & 255u) | (((unsigned)(int)rintf(xn[i][1] * hinv) & 255u) << 8) | (((unsigned)(int)rintf(xn[i][2] * hinv) & 255u) << 16) | (((unsigned)(int)rintf(xn[i][3] * hinv) & 255u) << 24);
              *(u32x4*)((signed char*)(ws + WS_H) + (size_t)row * D + 16 * lane) = o;
              if (lane == 0) ((float*)(ws + WS_GB))[row] = hmx * (1.f / 127.f); }
            float p[16];
#pragma unroll
            for (int c = 0; c < 16; ++c) { float q = 0.f;
#pragma unroll
                for (int i = 0; i < 4; ++i) { const f32x4 w = *(const LAS f32x4*)(wsk + c * 1024 + 16 * lane + 4 * i); q += (xn[i][0] * w[0] + xn[i][1] * w[1]) + (xn[i][2] * w[2] + xn[i][3] * w[3]); }
                p[c] = q; }
            { const bool hb = (lane & 32) != 0;
#pragma unroll
              for (int c = 0; c < 8; ++c) { const float keep = hb ? p[c + 8] : p[c], send = hb ? p[c] : p[c + 8]; p[c] = keep + lane_xor<32>(send); } }
            { const bool hb = (lane & 16) != 0;
#pragma unroll
              for (int c = 0; c < 4; ++c) { const float keep = hb ? p[c + 4] : p[c], send = hb ? p[c] : p[c + 4]; p[c] = keep + lane_xor<16>(send); } }
            { const bool hb = (lane & 8) != 0;
#pragma unroll
              for (int c = 0; c < 2; ++c) { const float keep = hb ? p[c + 2] : p[c], send = hb ? p[c] : p[c + 2]; p[c] = keep + lane_xor<8>(send); } }
            { const bool hb = (lane & 4) != 0; const float keep = hb ? p[1] : p[0], send = hb ? p[0] : p[1]; p[0] = keep + lane_xor<4>(send); }
            p[0] += lane_xor<2>(p[0]); p[0] += lane_xor<1>(p[0]);
            if ((lane & 3) == 0) { const int c = ((lane >> 5) & 1) * 8 + ((lane >> 4) & 1) * 4 + ((lane >> 3) & 1) * 2 + ((lane >> 2) & 1); ((float*)(ws + WS_BA))[(size_t)row * 16 + c] = p[0]; }
        }
    }
    if (fuse) __syncthreads();
#undef a
}
constexpr size_t WS_PD = WS_REC;
constexpr size_t WS_PW = WS_REC + 8 * (size_t)M * 128 * 4;
constexpr size_t WS_PC = WS_PW + (size_t)M * 128 * 4;
static_assert(WS_PC + (size_t)M * 4 <= WS_END, "sliced gather scratch");
constexpr int GS_ITEM = 8;
template <int PH>
__device__ __forceinline__ void phase_peer_slice(int l, int cslot) {
    const KArgs ap = get_args();
#define a (*ap)
    const int tid = fresh_tid(), lane = tid & 63;
    unsigned char* ws = a.ws;
    const int nrows = (l == DEPTH - 1) ? ML : M;
    const int nitem = nrows / GS_ITEM;
    const unsigned char* TAB = ws + WS_UB + (size_t)(l & 1) * TAB_SET + (PH ? (size_t)NEXP * 1024 : 0);
    const int* PIDX = (const int*)(ws + WS_PIDX);
    const float* PW = (const float*)(ws + WS_PW); const float* PC = (const float*)(ws + WS_PC);
    const float* modl = (const float*)(ws + WS_MOD) + (size_t)l * 3 * 6144 + 5120;
    const int g = lane >> 3, i8 = lane & 7;
    const int x = (int)(xb_xcc_id() & 7u);
#pragma unroll 1
    for (int pp = 0; pp < 8; ++pp) {
        const int p = (x + pp) & 7;
        unsigned* ctr = (unsigned*)(ws + WS_CTL) + 16384 + ((l * 2 + PH) * 8 + p) * 64 + cslot * 8192;
        const unsigned char* tb = TAB + (size_t)p * NEXP * 128 + 16 * i8;
        unsigned tk = 0; if (lane == 0) tk = __hip_atomic_fetch_add(ctr, 1u, __ATOMIC_RELAXED, __HIP_MEMORY_SCOPE_AGENT);
        int it = __builtin_amdgcn_readfirstlane((int)tk);
#pragma unroll 1
        while (it < nitem) {
            unsigned tn = 0; if (lane == 0) tn = __hip_atomic_fetch_add(ctr, 1u, __ATOMIC_RELAXED, __HIP_MEMORY_SCOPE_AGENT);
            const int row0 = it * GS_ITEM, rowl = row0 + GS_ITEM - 1;
            u32x4 idc[4], idn[4], ra[8], rb[8]; f32x4 wc[4], wn[4]; u32x4 hc, hn;
#define GS_META(ids_, wts_, h_, row_) do { const int rw_ = (row_); const u32x4* ip_ = (const u32x4*)(PIDX + (size_t)rw_ * 128 + 16 * g); _Pragma("unroll") for (int q_ = 0; q_ < 4; ++q_) ids_[q_] = ip_[q_]; \
                if (PH) { const f32x4* wp_ = (const f32x4*)(PW + (size_t)rw_ * 128 + 16 * g); _Pragma("unroll") for (int q_ = 0; q_ < 4; ++q_) wts_[q_] = wp_[q_]; } \
                else h_ = *(const u32x4*)((const signed char*)(ws + WS_H) + (size_t)rw_ * D + 128 * p + 16 * i8); } while (0)
#define GS_ROWS(dst_, ids_, hf_) do { _Pragma("unroll") for (int k_ = 0; k_ < 8; ++k_) dst_[k_] = *(const u32x4*)(tb + (size_t)ids_[2 * (hf_) + (k_ >> 2)][k_ & 3] * 128); } while (0)
            GS_META(idc, wc, hc, row0);
            GS_ROWS(ra, idc, 0);
            GS_META(idn, wn, hn, min(row0 + 1, rowl));
#pragma unroll 1
            for (int i = 0; i < GS_ITEM; ++i) {
                const int row = row0 + i;
                GS_ROWS(rb, idc, 1);
                if (PH == 0) {
                    int d[16];
#pragma unroll
                    for (int k = 0; k < 8; ++k) { int s_ = 0;
#pragma unroll
                        for (int q = 0; q < 4; ++q) s_ = __builtin_amdgcn_sdot4((int)ra[k][q], (int)hc[q], s_, false);
                        d[k] = s_; }
                    GS_ROWS(ra, idn, 0);
#pragma unroll
                    for (int k = 0; k < 8; ++k) { int s_ = 0;
#pragma unroll
                        for (int q = 0; q < 4; ++q) s_ = __builtin_amdgcn_sdot4((int)rb[k][q], (int)hc[q], s_, false);
                        d[8 + k] = s_; }
#define GS_IX(v_, K_) __builtin_bit_cast(int, lane_xor<K_>(__builtin_bit_cast(float, v_)))
                    { const bool hb = (lane & 4) != 0;
#pragma unroll
                      for (int j = 0; j < 8; ++j) { const int keep = hb ? d[j + 8] : d[j], send = hb ? d[j] : d[j + 8]; d[j] = keep + GS_IX(send, 4); } }
                    { const bool hb = (lane & 2) != 0;
#pragma unroll
                      for (int j = 0; j < 4; ++j) { const int keep = hb ? d[j + 4] : d[j], send = hb ? d[j] : d[j + 4]; d[j] = keep + GS_IX(send, 2); } }
                    { const bool hb = (lane & 1) != 0;
#pragma unroll
                      for (int j = 0; j < 2; ++j) { const int keep = hb ? d[j + 2] : d[j], send = hb ? d[j] : d[j + 2]; d[j] = keep + GS_IX(send, 1); } }
#undef GS_IX
                    u32x2 o = {(unsigned)d[0], (unsigned)d[1]};
                    __builtin_nontemporal_store(o, (u32x2*)((int*)(ws + WS_PD) + ((size_t)p * M + row) * 128 + 2 * lane));
                } else {
                    f32x2 o2[8];
#pragma unroll
                    for (int k = 0; k < 8; ++k) o2[k] = (f32x2){0.f, 0.f};
#define GS_FMA(rr_, hf_) do { _Pragma("unroll") for (int k_ = 0; k_ < 8; ++k_) { const float wk_ = wc[2 * (hf_) + (k_ >> 2)][k_ & 3]; const f32x2 ww_ = {wk_, wk_}; \
                        _Pragma("unroll") for (int q_ = 0; q_ < 4; ++q_) { const unsigned w_ = rr_[k_][q_]; \
                            const f32x2 v01_ = {(float)(w_ & 255u), (float)((w_ >> 8) & 255u)}, v23_ = {(float)((w_ >> 16) & 255u), (float)(w_ >> 24)}; \
                            o2[2 * q_] = __builtin_elementwise_fma(ww_, v01_, o2[2 * q_]); o2[2 * q_ + 1] = __builtin_elementwise_fma(ww_, v23_, o2[2 * q_ + 1]); } } } while (0)
                    GS_FMA(ra, 0);
                    GS_ROWS(ra, idn, 0);
                    GS_FMA(rb, 1);
#undef GS_FMA
                    float o[16];
#pragma unroll
                    for (int k = 0; k < 8; ++k) { o[2 * k] = o2[k][0]; o[2 * k + 1] = o2[k][1]; }
                    { const bool hb = (lane & 32) != 0;
#pragma unroll
                      for (int j = 0; j < 8; ++j) { const float keep = hb ? o[j + 8] : o[j], send = hb ? o[j] : o[j + 8]; o[j] = keep + lane_xor<32>(send); } }
                    { const bool hb = (lane & 16) != 0;
#pragma unroll
                      for (int j = 0; j < 4; ++j) { const float keep = hb ? o[j + 4] : o[j], send = hb ? o[j] : o[j + 4]; o[j] = keep + lane_xor<16>(send); } }
                    { const bool hb = (lane & 8) != 0;
#pragma unroll
                      for (int j = 0; j < 2; ++j) { const float keep = hb ? o[j + 2] : o[j], send = hb ? o[j] : o[j + 2]; o[j] = keep + lane_xor<8>(send); } }
                    const float corr = PC[row];
                    float* xr; int mrow;
                    if (row < ML) { xr = a.out + (size_t)row * D; mrow = row >= T ? 1 : 0; } else { xr = (float*)(ws + WS_CTXX) + (size_t)(row - ML) * D; mrow = 2; }
                    const int col = 128 * p + 16 * i8 + 2 * g;
                    const f32x2 g2 = *(const f32x2*)(modl + mrow * 6144 + col), xo = *(const f32x2*)(xr + col);
                    *(f32x2*)(xr + col) = (f32x2){xo[0] + g2[0] * (o[0] - corr), xo[1] + g2[1] * (o[1] - corr)};
                }
#pragma unroll
                for (int q = 0; q < 4; ++q) { idc[q] = idn[q]; if (PH) wc[q] = wn[q]; }
                if (!PH) hc = hn;
                GS_META(idn, wn, hn, min(row + 2, rowl));
            }
#undef GS_META
#undef GS_ROWS
            it = __builtin_amdgcn_readfirstlane((int)tn);
        }
    }
#undef a
}
__device__ __forceinline__ void phase_peer_weights(int l) {
    const KArgs ap = get_args();
#define a (*ap)
    const int tid = fresh_tid(), lane = tid & 63, wave = __builtin_amdgcn_readfirstlane(tid >> 6), G = fresh_g(), bx = fresh_bx();
    unsigned char* ws = a.ws;
    const int nrows = (l == DEPTH - 1) ? ML : M;
    const f32x2* SC2 = (const f32x2*)(ws + WS_USC) + (size_t)(l & 1) * NEXP;
    const int* PIDX = (const int*)(ws + WS_PIDX); const float* PGATE = (const float*)(ws + WS_PGATE);
    for (int row = wave * G + bx; row < nrows; row += G * 8) {
        const u32x2 id = *(const u32x2*)(PIDX + (size_t)row * 128 + 2 * lane); const f32x2 gt = *(const f32x2*)(PGATE + (size_t)row * 128 + 2 * lane);
        const float hsc = ((const float*)(ws + WS_GB))[row];
        int d0 = 0, d1 = 0;
#pragma unroll
        for (int p = 0; p < 8; ++p) { const u32x2 v = __builtin_nontemporal_load((const u32x2*)((const int*)(ws + WS_PD) + ((size_t)p * M + row) * 128 + 2 * lane)); d0 += (int)v[0]; d1 += (int)v[1]; }
        const f32x2 s0 = SC2[id[0]], s1 = SC2[id[1]];
        const float x0 = (float)d0 * (s0[0] * hsc), x1 = (float)d1 * (s1[0] * hsc);
        const float w0 = gt[0] * s0[1] * (0.5f * x0 * (1.f + erff(x0 * 0.70710678118654752f))), w1 = gt[1] * s1[1] * (0.5f * x1 * (1.f + erff(x1 * 0.70710678118654752f)));
        *(f32x2*)((float*)(ws + WS_PW) + (size_t)row * 128 + 2 * lane) = (f32x2){w0, w1};
        const float tot = wave_sum(w0 + w1);
        if (lane == 0) ((float*)(ws + WS_PC))[row] = 128.f * tot;
    }
#undef a
}

__global__ void __launch_bounds__(512, 2) fwd(Args a) {
    extern __shared__ __attribute__((aligned(16))) unsigned char lds_raw[];
    LAS unsigned char* lds = (LAS unsigned char*)lds_raw;
    volatile LAS unsigned* MISC = (volatile LAS unsigned*)(lds + LDS_MISC);
    if (threadIdx.x < 16) MISC[threadIdx.x] = 0u;
    __syncthreads();
    XcdBarrier bar; bar.bar = (unsigned*)(a.ws + WS_CTL) + 4096; bar.x = 0; bar.st = MISC + 8;
    bar = xcd_barrier_post((unsigned*)(a.ws + WS_CTL) + 4096, MISC + 8);
#ifndef PHASE_MASK
#define PHASE_MASK 0x1FFF
#endif
#define EN(i) ((PHASE_MASK >> (i)) & 1)
#ifndef REP_MASK
#define REP_MASK 0
#endif
#define REPN(i) (1 + ((REP_MASK >> (i)) & 1))
#define IN(k) true
#define SEAM(k) do { XcdBarrier b_; b_.bar = (unsigned*)(get_args()->ws + WS_CTL) + 4096; b_.x = xb_xcc_id(); b_.st = (volatile LAS unsigned*)(lds + LDS_MISC) + 8; xcd_barrier(b_); } while (0)
    for (int rep_ = 0; rep_ < (REPN(0)); ++rep_) if (EN(0) && IN(0)) phase_prologue(lds);
    SEAM(0);
#pragma unroll 1
    for (int l_ = 0; l_ < DEPTH; ++l_) {
        int l = l_; asm volatile("" : "+s"(l));
        const int pb = 1 + l * NPH_L;
        const int mrows = (l == DEPTH - 1) ? ML : M;
        if (l == 0) { for (int rep_ = 0; rep_ < (REPN(1)); ++rep_) if (EN(1) && IN(pb + 0)) { phase_norm<true>(l, 0, lds); phase_quant_weights(lds); }
            SEAM(pb + 0); }
        for (int rep_ = 0; rep_ < (REPN(2)); ++rep_) if (EN(2) && IN(pb + 1)) { const KArgs ap = get_args(); unsigned char* ws = ap->ws; pg8::Gemm g{(const bf16_t*)(ws + WS_H), (const bf16_t*)((const signed char*)(ws + WS_WINT) + (size_t)l * NP * 1024), M, NP, 512}; pg8::StaticOrder S; S.init(M, NP, fresh_g(), fresh_bx());
            pg8::EpiBf16I8 E{(bf16_t*)(ws + WS_P), NP, (const float*)(ws + WS_GB), (const float*)(ws + WS_CTL) + CW_WMAX + (l * 3 + 0) * 3072}; pg8::gemm_phase(lds, g, S, E); }
        SEAM(pb + 1);
        for (int rep_ = 0; rep_ < (REPN(3)); ++rep_) if (EN(3) && IN(pb + 2)) { phase_dn_chunkprep<1>(l, lds); phase_prep(l, lds); }
        for (int rep_ = 0; rep_ < (REPN(4)); ++rep_) if (EN(4) && IN(pb + 3)) phase_dn_chunkprep<0>(l, lds);
        SEAM(pb + 3);
        for (int rep_ = 0; rep_ < (REPN(5)); ++rep_) if (EN(5) && IN(pb + 4)) { phase_dn_scan<0>(l, lds); __syncthreads(); phase_attn(l, lds_raw, MISC, rep_); }
        SEAM(pb + 4);
        for (int rep_ = 0; rep_ < (REPN(7)); ++rep_) if (EN(7) && IN(pb + 5)) phase_dn_out(l);
        SEAM(pb + 5);
        if (EN(8) && IN(pb + 6)) { const KArgs ap = get_args(); unsigned char* ws = ap->ws; pg8::Gemm g{(const bf16_t*)(ws + WS_CATQ), (const bf16_t*)((const signed char*)(ws + WS_WOUTT) + (size_t)l * 1024 * 1024), mrows, 1024, 512}; pg8::StaticOrder S; S.init(mrows, 1024, fresh_g(), fresh_bx());
            pg8::EpiResI8 E{l == 0 ? ap->in[I_X] : ap->out, l == 0 ? ap->in[I_CTX] : (const float*)(ws + WS_CTXX), ap->out, (float*)(ws + WS_CTXX), (const float*)(ws + WS_MOD) + (size_t)l * 3 * 6144 + 2048,
                              (const float*)(ws + WS_GB) + (1u << 18), (const float*)(ws + WS_CTL) + CW_WMAX + (l * 3 + 1) * 3072};
            pg8::gemm_phase(lds, g, S, E); }
        SEAM(pb + 6);
        for (int rep_ = 0; rep_ < (REPN(9)); ++rep_) if (EN(9) && IN(pb + 7)) phase_norm<false>(l, 1, lds);
        SEAM(pb + 7);
        for (int rep_ = 0; rep_ < (REPN(10)); ++rep_) if (EN(10) && IN(pb + 8)) { const KArgs ap = get_args(); unsigned char* ws = ap->ws; pg8::Gemm g{(const bf16_t*)(ws + WS_H), (const bf16_t*)((const signed char*)(ws + WS_WQT) + (size_t)l * 2048 * 1024), mrows, 2048, 512}; pg8::StaticOrder S; S.init(mrows, 2048, fresh_g(), fresh_bx());
            pg8::EpiBf16I8 E{(bf16_t*)(ws + WS_P), 2048, (const float*)(ws + WS_GB), (const float*)(ws + WS_CTL) + CW_WMAX + (l * 3 + 2) * 3072}; pg8::gemm_phase(lds, g, S, E); }
        SEAM(pb + 8);
        for (int rep_ = 0; rep_ < (REPN(11)); ++rep_) if (EN(11) && IN(pb + 9)) phase_peer_select(l);
        SEAM(pb + 9);
        #ifdef GATHER_VAR
        if (EN(12) && IN(pb + 10)) phase_peer_gather<false, GATHER_VAR>(l, lds);
#endif
#if GATHER_PART == 2
        if (EN(12) && IN(pb + 10)) phase_peer_slice<0>(l, 0);
        SEAM(pb + 10);
        if (EN(12) && IN(pb + 10)) phase_peer_weights(l);
        SEAM(pb + 10);
        if (EN(12) && IN(pb + 10)) phase_peer_slice<1>(l, 0);
        if (l + 1 < DEPTH) { SEAM(pb + 10); if (EN(12) && IN(pb + 10)) phase_norm<true>(l + 1, 0, lds); }
#elif GATHER_PART
        if (EN(12) && IN(pb + 10)) phase_peer_gpart(l, lds);
        SEAM(pb + 10);
        if (EN(12) && IN(pb + 10)) phase_peer_combine(l, lds);
#else
        if (REPN(12) > 1 && EN(12) && IN(pb + 10)) phase_peer_gather<false>(l, lds);
        if (EN(12) && IN(pb + 10)) phase_peer_gather<true>(l, lds);
#endif
        if (l + 1 < DEPTH) SEAM(pb + 10);
    }
#undef IN
#undef SEAM
}

#ifndef N_LAUNCH_MODE
#define N_LAUNCH_MODE 1
#endif
extern "C" void kernel_launch(void* const* d_in, const int* in_sizes, int n_in, void* d_out, int out_size, void* d_ws, size_t ws_size, hipStream_t stream) {
    static int grid = 0;
    if (grid == 0) {
        if (n_in != 20 || out_size != ML * D || ws_size < WS_END) { fprintf(stderr, "kernel_launch: unexpected shapes: n_in %d out %d ws %zu (need %zu)\n", n_in, out_size, ws_size, (size_t)WS_END); grid = -1; return; }
        int dev = 0, cus = 0, per_cu = 0;
        if (hipGetDevice(&dev) != hipSuccess || hipDeviceGetAttribute(&cus, hipDeviceAttributeMultiprocessorCount, dev) != hipSuccess) { grid = -1; return; }
        if (hipFuncSetAttribute((const void*)fwd, hipFuncAttributeMaxDynamicSharedMemorySize, LDS_BYTES) != hipSuccess) { fprintf(stderr, "kernel_launch: hipFuncSetAttribute failed\n"); grid = -1; return; }
        if (hipOccupancyMaxActiveBlocksPerMultiprocessor(&per_cu, (const void*)fwd, 512, LDS_BYTES) != hipSuccess || per_cu < 1) fprintf(stderr, "kernel_launch: occupancy query says %d\n", per_cu);
        (void)hipGetLastError();
        grid = cus;
    }
    if (grid < 0) return;
    (void)hipMemsetAsync((char*)d_ws + WS_CTL, 0, CTL_BYTES, stream);
    Args a{};
    for (int i = 0; i < 20; ++i) a.in[i] = (const float*)d_in[i];
    a.out = (float*)d_out; a.ws = (unsigned char*)d_ws;
    a.ph_lo = 0; a.ph_hi = NPHASE;
    hipLaunchKernelGGL(fwd, dim3(grid), dim3(512), LDS_BYTES, stream, a);
    const hipError_t le = hipPeekAtLastError();
    if (le != hipSuccess) fprintf(stderr, "kernel_launch: launch failed: %s\n", hipGetErrorName(le));
}
```

```cpp
#include <hip/hip_runtime.h>
#ifndef GATHER_PART
#define GATHER_PART 2
#endif
#include <cstdio>
#include <cstdint>

#define GAS __attribute__((address_space(1)))
#define LAS __attribute__((address_space(3)))
typedef unsigned short bf16_t;
typedef short bf16x8 __attribute__((ext_vector_type(8)));
typedef short s16x4 __attribute__((ext_vector_type(4)));
typedef float f32x4 __attribute__((ext_vector_type(4)));
typedef float f32x2 __attribute__((ext_vector_type(2)));
typedef float f32x16 __attribute__((ext_vector_type(16)));
typedef unsigned u32x4 __attribute__((ext_vector_type(4)));
typedef unsigned u32x2 __attribute__((ext_vector_type(2)));
typedef int i32x4 __attribute__((ext_vector_type(4)));

constexpr int D = 1024, NB = 2, T = 16384, DEPTH = 4, CT = 256;
constexpr int ML = NB * T, MC = NB * CT, M = ML + MC;
constexpr int NIN = 3088, NP = 3072;
constexpr int KVLEN = T + CT;
constexpr int NEXP = 16384;
constexpr float EPS = 1e-6f;
constexpr int NPH_L = 11;
constexpr int NPHASE = 1 + DEPTH * NPH_L;

constexpr size_t MiB = 1u << 20;
constexpr size_t WS_CTL = 0, CTL_BYTES = 1 * MiB;
constexpr size_t WS_MOD = 1 * MiB;
constexpr size_t WS_ROPE = 2 * MiB;
constexpr size_t WS_WSK = 3 * MiB;
constexpr size_t WS_CTXX = 4 * MiB;
constexpr size_t WS_WINT = 8 * MiB;
constexpr size_t WS_WOUTT = 32 * MiB;
constexpr size_t WS_WQT = 40 * MiB;
constexpr size_t WS_SKB = 56 * MiB;
constexpr size_t WS_USC = 58 * MiB;
constexpr size_t WS_UB = 64 * MiB;
constexpr size_t WS_VB = 80 * MiB;
constexpr size_t TAB_SET = 32 * MiB;
constexpr size_t WS_H = 128 * MiB;
static_assert(WS_H + 2 * (size_t)M * 1024 <= 193 * MiB, "H + concat int8");
constexpr size_t WS_CATQ = WS_H + (size_t)M * 1024;
constexpr size_t WS_P = 193 * MiB;
constexpr size_t WS_QA = 388 * MiB;
constexpr size_t WS_KA = 421 * MiB;
constexpr size_t WS_VA = 438 * MiB;
constexpr size_t WS_CAT = 455 * MiB;
constexpr size_t WS_DQ = 520 * MiB;
constexpr size_t WS_DK = 553 * MiB;
constexpr size_t WS_DV = 586 * MiB;
constexpr size_t WS_OF = 619 * MiB;
constexpr size_t WS_OB = 684 * MiB;
constexpr size_t WS_GB = 749 * MiB;
constexpr size_t WS_BA = 752 * MiB;
constexpr size_t WS_PIDX = 755 * MiB;
constexpr size_t WS_PGATE = 772 * MiB;
constexpr size_t WS_REC = 789 * MiB;
constexpr size_t WS_END = 990 * MiB;
constexpr int CW_WMAX = 65536;
constexpr int NCH = 260;
constexpr int REC_K = 0, REC_KT = 16384, REC_Q = 32768, REC_V = 49152, REC_DIR = 65536, REC_DIRSZ = 17408, REC_BYTES = REC_DIR + 2 * REC_DIRSZ;
static_assert((size_t)NB * 4 * NCH * REC_BYTES + WS_REC <= WS_END, "rec region");

constexpr int LDS_BYTES = 163840;
constexpr int LDS_MISC = 163840 - 256;

__device__ __forceinline__ float bf2f(unsigned b) { return __uint_as_float(b << 16); }
__device__ __forceinline__ float bflo(unsigned w) { return __uint_as_float(w << 16); }
__device__ __forceinline__ float bfhi(unsigned w) { return __uint_as_float(w & 0xffff0000u); }
typedef __bf16 bf2v __attribute__((ext_vector_type(2)));
__device__ __forceinline__ unsigned pkbf(float lo, float hi) { unsigned r; asm("v_cvt_pk_bf16_f32 %0, %1, %2" : "=v"(r) : "v"(lo), "v"(hi)); return r; }
__device__ __forceinline__ unsigned pkbf_c(float lo, float hi) { f32x2 v = {lo, hi}; bf2v r = __builtin_convertvector(v, bf2v); return __builtin_bit_cast(unsigned, r); }
template <int K> __device__ __forceinline__ float lane_xor(float v) {
    const int b = __builtin_bit_cast(int, v);
    if constexpr (K == 1) return __builtin_bit_cast(float, __builtin_amdgcn_update_dpp(0, b, 0xB1, 0xF, 0xF, true));
    else if constexpr (K == 2) return __builtin_bit_cast(float, __builtin_amdgcn_update_dpp(0, b, 0x4E, 0xF, 0xF, true));
    else if constexpr (K == 32) { auto rr = __builtin_amdgcn_permlane32_swap((unsigned)b, (unsigned)b, false, false); unsigned ln_ = __builtin_amdgcn_mbcnt_hi(~0u, __builtin_amdgcn_mbcnt_lo(~0u, 0u)); asm volatile("" : "+v"(ln_));
        return __uint_as_float((ln_ & 32u) ? rr[0] : rr[1]); }
    else return __builtin_bit_cast(float, __builtin_amdgcn_ds_swizzle(b, 0x1F | (K << 10)));
}
__device__ __forceinline__ float wave_sum(float v) {
    v += lane_xor<1>(v); v += lane_xor<2>(v);
    v += __builtin_bit_cast(float, __builtin_amdgcn_update_dpp(0, __builtin_bit_cast(int, v), 0x124, 0xF, 0xF, true));
    v += __builtin_bit_cast(float, __builtin_amdgcn_update_dpp(0, __builtin_bit_cast(int, v), 0x128, 0xF, 0xF, true));
    v += lane_xor<16>(v);
    { auto rr = __builtin_amdgcn_permlane32_swap(__float_as_uint(v), __float_as_uint(v), false, false); v = __uint_as_float(rr[0]) + __uint_as_float(rr[1]); }
    return v;
}
__device__ __forceinline__ float wave_max(float v) {
    v = fmaxf(v, lane_xor<1>(v)); v = fmaxf(v, lane_xor<2>(v));
    v = fmaxf(v, __builtin_bit_cast(float, __builtin_amdgcn_update_dpp(0, __builtin_bit_cast(int, v), 0x124, 0xF, 0xF, true)));
    v = fmaxf(v, __builtin_bit_cast(float, __builtin_amdgcn_update_dpp(0, __builtin_bit_cast(int, v), 0x128, 0xF, 0xF, true)));
    v = fmaxf(v, lane_xor<16>(v));
    { auto rr = __builtin_amdgcn_permlane32_swap(__float_as_uint(v), __float_as_uint(v), false, false); v = fmaxf(__uint_as_float(rr[0]), __uint_as_float(rr[1])); }
    return v;
}
__device__ __forceinline__ float silu_f(float x) { return x / (1.f + __expf(-x)); }
#define LDS_WAIT() asm volatile("s_waitcnt lgkmcnt(0)" ::: "memory")

#define XB_TMO      128
#define XB_XCNT(j)  (256  + 64 * (j))
#define XB_XSUB(j)  (1280 + 64 * (j))
#define XB_XGEN(j)  (2304 + 64 * (j))
#define XB_TOP      3328
#define XB_TOPGEN   3392
#define XCD_BAR_WORDS 3456
#define XB_SPIN_CAP (1u << 22)
__device__ __forceinline__ unsigned xb_ld(unsigned* p)              { return __hip_atomic_load(p, __ATOMIC_RELAXED, __HIP_MEMORY_SCOPE_AGENT); }
__device__ __forceinline__ unsigned xb_add(unsigned* p, unsigned v) { return __hip_atomic_fetch_add(p, v, __ATOMIC_RELAXED, __HIP_MEMORY_SCOPE_AGENT); }
__device__ __forceinline__ unsigned xb_xcc_id() { return (unsigned)__builtin_amdgcn_s_getreg((3 << 11) | 20) & 0xFu; }
#define XB_SPIN(cond, bar) do { unsigned _sp = 0; while (cond) { __builtin_amdgcn_s_sleep(1); \
    if ((++_sp & 255u) == 0u) { if (xb_ld(&(bar)[XB_TMO])) break; if (_sp > XB_SPIN_CAP) { atomicAdd(&(bar)[XB_TMO], 1u); break; } } } } while (0)
struct XcdBarrier { unsigned* bar; unsigned x; volatile LAS unsigned* st; };
__device__ __forceinline__ XcdBarrier xcd_barrier_post(unsigned* bar, volatile LAS unsigned* st) {
    XcdBarrier b; b.bar = bar; b.x = xb_xcc_id(); b.st = st;
    if (threadIdx.x == 0) (void)xb_add(&bar[XB_XCNT(b.x)], 1u);
    return b;
}
__device__ __forceinline__ void xcd_barrier_complete(unsigned* bar, unsigned x, unsigned& nloc, unsigned& nx) {
    const unsigned G = gridDim.x * gridDim.y * gridDim.z;
    unsigned sum, cnt, mine, sp = 0u;
    for (;;) {
        sum = 0u; cnt = 0u; mine = 0u;
#pragma unroll
        for (unsigned j = 0; j < 16; ++j) { const unsigned c = xb_ld(&bar[XB_XCNT(j)]); sum += c; cnt += (c > 0u) ? 1u : 0u; mine = (j == x) ? c : mine; }
        if (sum == G) break;
        __builtin_amdgcn_s_sleep(1);
        if ((++sp & 255u) == 0u) { if (xb_ld(&bar[XB_TMO])) break; if (sp > XB_SPIN_CAP) { atomicAdd(&bar[XB_TMO], 1u); break; } }
    }
    nloc = mine > 0u ? mine : 1u; nx = cnt > 0u ? cnt : 1u;
}
__device__ __forceinline__ void xcd_barrier(const XcdBarrier& b) {
    asm volatile("s_waitcnt vmcnt(0)" ::: "memory");
    __syncthreads();
    if (threadIdx.x == 0) {
        unsigned* bar = b.bar; unsigned bx_ = b.x;
        asm volatile("" : "+s"(bar), "+s"(bx_));
        __builtin_amdgcn_s_waitcnt(0);
        unsigned nloc = b.st[0], nx = b.st[1];
        if (nloc == 0u) { xcd_barrier_complete(bar, bx_, nloc, nx); b.st[0] = nloc; b.st[1] = nx; }
        const unsigned old = xb_add(&bar[XB_XSUB(bx_)], 1u);
        const unsigned gen = old / nloc;
        if (old + 1u == (gen + 1u) * nloc) {
            __builtin_amdgcn_fence(__ATOMIC_RELEASE, "agent");
            asm volatile("s_waitcnt vmcnt(0)" ::: "memory");
            const unsigned og = xb_add(&bar[XB_TOP], 1u);
            const unsigned tg = og / nx;
            if (og + 1u == (tg + 1u) * nx) xb_add(&bar[XB_TOPGEN], 1u);
            else XB_SPIN(xb_ld(&bar[XB_TOPGEN]) == tg, bar);
            __builtin_amdgcn_fence(__ATOMIC_ACQUIRE, "agent");
            xb_add(&bar[XB_XGEN(bx_)], 1u);
            asm volatile("s_waitcnt vmcnt(0)" ::: "memory");
        } else {
            XB_SPIN(xb_ld(&bar[XB_XGEN(bx_)]) == gen, bar);
            __builtin_amdgcn_fence(__ATOMIC_ACQUIRE, "agent");
            asm volatile("s_waitcnt vmcnt(0)" ::: "memory");
        }
    }
    __syncthreads();
}

namespace pg8 {
constexpr int BM = 256, BK = 64, HALF = 128, HTB = HALF * BK * 2, STAGE_BYTES = 8 * HTB, NXCD = 8, WGM = 8;
__host__ __device__ __forceinline__ int lds_byte(int r, int c) { const int st = (r >> 4) * 2 + (c >> 5), rr = r & 15, cc = c & 31, ob = rr * 64 + cc * 2; return st * 1024 + (ob ^ (((ob >> 9) & 1) << 5)); }
__host__ __device__ __forceinline__ void stage_rc(int b, int& R, int& C) { const int st = b / 1024, sb = b % 1024, swz = sb ^ (((sb >> 9) & 1) << 5); R = (st >> 1) * 16 + swz / 64; C = (st & 1) * 32 + (swz % 64) / 2; }
__host__ __device__ __forceinline__ int perm32(int rho) { const int n = rho >> 4, i = rho & 15; return 8 * (i >> 2) + 4 * n + (i & 3); }
struct Unit { int pm, pn; };
struct Gemm { const bf16_t* A; const bf16_t* Bt; int M, N, K; };
struct StaticOrder {
    int nM, nN, nwg, G, c;
    __host__ __device__ void init(int M_, int N_, int G_, int c_) { nM = M_ / BM; nN = N_ / BM; nwg = nM * nN; G = G_; c = c_; }
    __host__ __device__ bool next(int i, Unit& u) const {
        const long L = (long)i * G + c; if (L >= nwg) return false;
        int wgid = (int)L; { const int q = nwg / NXCD, r = nwg % NXCD, xcd = wgid % NXCD, off = wgid / NXCD; wgid = (xcd < r ? xcd * (q + 1) : r * (q + 1) + (xcd - r) * q) + off; }
        const int nig = WGM * nN, gid = wgid / nig, fm = gid * WGM, gsz = (nM - fm) < WGM ? (nM - fm) : WGM;
        u.pm = fm + ((wgid % nig) % gsz); u.pn = (wgid % nig) / gsz; return true;
    }
    __device__ __forceinline__ void a_ready(const Unit&) const {}
    __device__ __forceinline__ void done(const Unit&) const {}
};
struct EpiBf16 {
    static constexpr bool PERM = true, I8 = false; typedef f32x4 acc_t;
    bf16_t* O; int ldc;
    __device__ __forceinline__ void operator()(const f32x4 (&acc)[2][2][4][2], const Unit& u, int wr, int wc, int fr, int fq) const {
        const int row0 = u.pm * BM + wr * 64 + fr; const int col0 = u.pn * BM + wc * 32 + 8 * fq;
#pragma unroll
        for (int ai = 0; ai < 2; ++ai)
#pragma unroll
            for (int m = 0; m < 4; ++m) { bf16_t* rowp = O + (size_t)(row0 + ai * HALF + m * 16) * ldc + col0;
#pragma unroll
                for (int bj = 0; bj < 2; ++bj) { const f32x4 v0 = acc[ai][bj][m][0], v1 = acc[ai][bj][m][1];
                    u32x4 w; w.x = pkbf_c(v0[0], v0[1]); w.y = pkbf_c(v0[2], v0[3]); w.z = pkbf_c(v1[0], v1[1]); w.w = pkbf_c(v1[2], v1[3]);
                    *(u32x4*)(rowp + bj * HALF) = w; } }
    }
};
struct EpiBf16I8 {
    static constexpr bool PERM = true, I8 = true; typedef i32x4 acc_t;
    bf16_t* O; int ldc; const float* sa; const float* wmax;
    __device__ __forceinline__ void operator()(const i32x4 (&acc)[2][2][4][2], const Unit& u, int wr, int wc, int fr, int fq) const {
        const int row0 = u.pm * BM + wr * 64 + fr; const int col0 = u.pn * BM + wc * 32 + 8 * fq;
        f32x4 sw[2][2];
#pragma unroll
        for (int bj = 0; bj < 2; ++bj)
#pragma unroll
            for (int n = 0; n < 2; ++n) sw[bj][n] = *(const f32x4*)(wmax + col0 + bj * HALF + 4 * n) * (1.f / 127.f);
#pragma unroll
        for (int ai = 0; ai < 2; ++ai)
#pragma unroll
            for (int m = 0; m < 4; ++m) { const int row = row0 + ai * HALF + m * 16; const float sr = sa[row]; bf16_t* rowp = O + (size_t)row * ldc + col0;
#pragma unroll
                for (int bj = 0; bj < 2; ++bj) { const i32x4 a0 = acc[ai][bj][m][0], a1 = acc[ai][bj][m][1];
                    const f32x4 v0 = (f32x4){(float)a0[0], (float)a0[1], (float)a0[2], (float)a0[3]} * sw[bj][0] * sr, v1 = (f32x4){(float)a1[0], (float)a1[1], (float)a1[2], (float)a1[3]} * sw[bj][1] * sr;
                    u32x4 w; w.x = pkbf(v0[0], v0[1]); w.y = pkbf(v0[2], v0[3]); w.z = pkbf(v1[0], v1[1]); w.w = pkbf(v1[2], v1[3]);
                    *(u32x4*)(rowp + bj * HALF) = w; } }
    }
};
struct EpiRes {
    static constexpr bool PERM = false, I8 = false; typedef f32x4 acc_t;
    const float* src_lat; const float* src_ctx; float* dst_lat; float* dst_ctx; const float* gate;
    __device__ __forceinline__ void operator()(const f32x4 (&acc)[2][2][4][2], const Unit& u, int wr, int wc, int fr, int fq) const {
        const bool isctx = u.pm >= (ML / BM);
        const float* src = isctx ? src_ctx + (size_t)(u.pm - ML / BM) * BM * D : src_lat + (size_t)u.pm * BM * D;
        float* dst = isctx ? dst_ctx + (size_t)(u.pm - ML / BM) * BM * D : dst_lat + (size_t)u.pm * BM * D;
        const int mrow = isctx ? 2 : (u.pm >= (T / BM) ? 1 : 0);
        const int row0 = wr * 64 + fr, col0 = u.pn * BM + wc * 32 + 4 * fq;
        f32x4 gv[2][2];
#pragma unroll
        for (int bj = 0; bj < 2; ++bj)
#pragma unroll
            for (int n = 0; n < 2; ++n) gv[bj][n] = *(const f32x4*)(gate + mrow * 6144 + col0 + bj * HALF + n * 16);
#pragma unroll
        for (int ai = 0; ai < 2; ++ai)
#pragma unroll
            for (int m = 0; m < 4; ++m) { const size_t off = (size_t)(row0 + ai * HALF + m * 16) * D + col0;
#pragma unroll
                for (int bj = 0; bj < 2; ++bj)
#pragma unroll
                    for (int n = 0; n < 2; ++n) { const f32x4 s = *(const f32x4*)(src + off + bj * HALF + n * 16);
                        *(f32x4*)(dst + off + bj * HALF + n * 16) = s + gv[bj][n] * acc[ai][bj][m][n]; } }
    }
};

struct EpiResI8 {
    static constexpr bool PERM = false, I8 = true; typedef i32x4 acc_t;
    const float* src_lat; const float* src_ctx; float* dst_lat; float* dst_ctx; const float* gate; const float* sa; const float* wmax;
    __device__ __forceinline__ void operator()(const i32x4 (&acc)[2][2][4][2], const Unit& u, int wr, int wc, int fr, int fq) const {
        const bool isctx = u.pm >= (ML / BM);
        const float* src = isctx ? src_ctx + (size_t)(u.pm - ML / BM) * BM * D : src_lat + (size_t)u.pm * BM * D;
        float* dst = isctx ? dst_ctx + (size_t)(u.pm - ML / BM) * BM * D : dst_lat + (size_t)u.pm * BM * D;
        const int mrow = isctx ? 2 : (u.pm >= (T / BM) ? 1 : 0);
        const int row0 = wr * 64 + fr, col0 = u.pn * BM + wc * 32 + 4 * fq;
        f32x4 gv[2][2];
#pragma unroll
        for (int bj = 0; bj < 2; ++bj)
#pragma unroll
            for (int n = 0; n < 2; ++n) gv[bj][n] = *(const f32x4*)(gate + mrow * 6144 + col0 + bj * HALF + n * 16) * *(const f32x4*)(wmax + col0 + bj * HALF + n * 16) * (1.f / 127.f);
#pragma unroll
        for (int ai = 0; ai < 2; ++ai)
#pragma unroll
            for (int m = 0; m < 4; ++m) { const int rl = row0 + ai * HALF + m * 16; const float sr = sa[u.pm * BM + rl]; const size_t off = (size_t)rl * D + col0;
#pragma unroll
                for (int bj = 0; bj < 2; ++bj)
#pragma unroll
                    for (int n = 0; n < 2; ++n) { const f32x4 sv = *(const f32x4*)(src + off + bj * HALF + n * 16); const i32x4 ac = acc[ai][bj][m][n];
                        *(f32x4*)(dst + off + bj * HALF + n * 16) = sv + gv[bj][n] * ((f32x4){(float)ac[0], (float)ac[1], (float)ac[2], (float)ac[3]} * sr); } }
    }
};
template <class Epi, class Sched>
__device__ __forceinline__ void gemm_phase(LAS unsigned char* lds, const Gemm g, const Sched& S, const Epi& E) {
    constexpr bool I8 = Epi::I8;
    typedef typename Epi::acc_t acc_t;
    int tid = threadIdx.x; asm volatile("" : "+v"(tid)); const int wid = __builtin_amdgcn_readfirstlane(tid >> 6), lane = tid & 63, wr = wid >> 2, wc = wid & 3, fr = lane & 15, fq = lane >> 4;
    const int K = g.K, nt = K / BK;
    unsigned voffA[2], voffB[2];
#pragma unroll
    for (int i = 0; i < 2; ++i) { int R, C; stage_rc(tid * 16 + i * 8192, R, C); const int Rb = Epi::PERM ? ((R & ~31) + perm32(R & 31)) : R;
        voffA[i] = (unsigned)(R * K + C) * 2u; voffB[i] = (unsigned)(Rb * K + C) * 2u; }
    const size_t kstep = (size_t)(BK * 2);
    const size_t hstep = (size_t)HALF * K * 2;
    const size_t tstep = 2 * hstep;
    const unsigned ldsw = (unsigned)wid * 1024u;
    const int aoff = lds_byte(wr * 64 + fr, fq * 8), boff = lds_byte(wc * 32 + fr, fq * 8);
#define PG8_SA(b, h) (((b) * 2 + (h)) * HTB)
#define PG8_SB(b, h) ((4 + (b) * 2 + (h)) * HTB)
#define PG8_STAGE(bufoff, gbase, voff) do { _Pragma("unroll") for (int _i = 0; _i < 2; ++_i) \
        __builtin_amdgcn_global_load_lds((const unsigned*)((const char*)(gbase) + (voff)[_i]), (LAS unsigned*)(lds + (bufoff) + ldsw + _i * 8192), 16, 0, 0); } while (0)
#define PG8_LDA(dst, b, h) do { _Pragma("unroll") for (int m = 0; m < 4; ++m) _Pragma("unroll") for (int k = 0; k < 2; ++k) dst[m][k] = *(const LAS bf16x8*)(lds + PG8_SA(b, h) + aoff + m * 2048 + k * 1024); } while (0)
#define PG8_LDB(dst, b, h) do { _Pragma("unroll") for (int n = 0; n < 2; ++n) _Pragma("unroll") for (int k = 0; k < 2; ++k) dst[n][k] = *(const LAS bf16x8*)(lds + PG8_SB(b, h) + boff + n * 2048 + k * 1024); } while (0)
#define PG8_MMA(ai, bj, At, Bt) do { __builtin_amdgcn_s_setprio(1); _Pragma("unroll") for (int m = 0; m < 4; ++m) _Pragma("unroll") for (int n = 0; n < 2; ++n) _Pragma("unroll") for (int k = 0; k < 2; ++k) \
        { if constexpr (I8) acc[ai][bj][m][n] = __builtin_bit_cast(acc_t, __builtin_amdgcn_mfma_i32_16x16x64_i8(__builtin_bit_cast(i32x4, Bt[n][k]), __builtin_bit_cast(i32x4, At[m][k]), __builtin_bit_cast(i32x4, acc[ai][bj][m][n]), 0, 0, 0)); \
          else acc[ai][bj][m][n] = __builtin_bit_cast(acc_t, __builtin_amdgcn_mfma_f32_16x16x32_bf16(Bt[n][k], At[m][k], __builtin_bit_cast(f32x4, acc[ai][bj][m][n]), 0, 0, 0)); } __builtin_amdgcn_s_setprio(0); } while (0)
#define PG8_WAIT_V(n) asm volatile("s_waitcnt vmcnt(" #n ")" ::: "memory")
#define PG8_WAIT_L(n) asm volatile("s_waitcnt lgkmcnt(" #n ")" ::: "memory")
#define PG8_BAR __builtin_amdgcn_s_barrier()
#define PG8_SCHED __builtin_amdgcn_sched_barrier(0)
    Unit cur, nxt; int ui = 0;
    if (!S.next(0, cur)) return;
    acc_t acc[2][2][4][2];
#pragma unroll
    for (int a = 0; a < 2; ++a)
#pragma unroll
        for (int b = 0; b < 2; ++b)
#pragma unroll
            for (int m = 0; m < 4; ++m)
#pragma unroll
                for (int n = 0; n < 2; ++n) acc[a][b][m][n] = acc_t{};
    bf16x8 At[4][2], B0[2][2], B1[2][2];
    const char* cA = (const char*)g.A + (size_t)cur.pm * tstep; const char* cB = (const char*)g.Bt + (size_t)cur.pn * tstep;
    S.a_ready(cur);
    PG8_STAGE(PG8_SB(0, 0), cB, voffB); PG8_STAGE(PG8_SA(0, 0), cA, voffA); PG8_STAGE(PG8_SB(0, 1), cB + hstep, voffB); PG8_STAGE(PG8_SA(0, 1), cA + hstep, voffA);
    if (wr == 1) PG8_BAR;
    PG8_WAIT_V(4); PG8_BAR;
    PG8_STAGE(PG8_SB(1, 0), cB + kstep, voffB); PG8_STAGE(PG8_SA(1, 0), cA + kstep, voffA); PG8_STAGE(PG8_SB(1, 1), cB + hstep + kstep, voffB);
    PG8_WAIT_V(6); PG8_BAR;
    for (;;) {
        const bool has_next = S.next(ui + 1, nxt);
        const char* nA = has_next ? (const char*)g.A + (size_t)nxt.pm * tstep : cA; const char* nB = has_next ? (const char*)g.Bt + (size_t)nxt.pn * tstep : cB;
        for (int t = 0; t < nt; t += 2) {
            const bool last = (t == nt - 2);
            const char* a1 = cA + (size_t)(t + 1) * kstep;
            const char* a2 = last ? nA : cA + (size_t)(t + 2) * kstep; const char* b2 = last ? nB : cB + (size_t)(t + 2) * kstep;
            const char* a3 = a2 + kstep; const char* b3 = b2 + kstep;
            if (last && has_next) S.a_ready(nxt);
            PG8_LDB(B0, 0, 0); PG8_SCHED; PG8_LDA(At, 0, 0); PG8_STAGE(PG8_SA(1, 1), a1 + hstep, voffA);
            PG8_WAIT_L(8); PG8_BAR; PG8_WAIT_L(0); PG8_MMA(0, 0, At, B0); PG8_BAR; PG8_SCHED;
            PG8_LDB(B1, 0, 1); PG8_STAGE(PG8_SB(0, 0), b2, voffB);
            PG8_BAR; PG8_WAIT_L(0); PG8_MMA(0, 1, At, B1); PG8_BAR;
            PG8_LDA(At, 0, 1); PG8_STAGE(PG8_SA(0, 0), a2, voffA);
            PG8_BAR; PG8_WAIT_L(0); PG8_MMA(1, 0, At, B0); PG8_BAR; PG8_SCHED;
            PG8_STAGE(PG8_SB(0, 1), b2 + hstep, voffB);
            PG8_WAIT_V(6); PG8_BAR; PG8_MMA(1, 1, At, B1); PG8_BAR;
            PG8_LDB(B0, 1, 0); PG8_SCHED; PG8_LDA(At, 1, 0); PG8_STAGE(PG8_SA(0, 1), a2 + hstep, voffA);
            PG8_WAIT_L(8); PG8_BAR; PG8_WAIT_L(0); PG8_MMA(0, 0, At, B0); PG8_BAR; PG8_SCHED;
            PG8_LDB(B1, 1, 1); PG8_STAGE(PG8_SB(1, 0), b3, voffB);
            PG8_BAR; PG8_WAIT_L(0); PG8_MMA(0, 1, At, B1); PG8_BAR;
            PG8_LDA(At, 1, 1); PG8_STAGE(PG8_SA(1, 0), a3, voffA);
            PG8_BAR; PG8_WAIT_L(0); PG8_MMA(1, 0, At, B0); PG8_BAR; PG8_SCHED;
            PG8_STAGE(PG8_SB(1, 1), b3 + hstep, voffB);
            PG8_WAIT_V(6); PG8_BAR; PG8_MMA(1, 1, At, B1); PG8_BAR;
        }
        E(acc, cur, wr, wc, fr, fq); S.done(cur);
        if (!has_next) break;
#pragma unroll
        for (int a = 0; a < 2; ++a)
#pragma unroll
            for (int b = 0; b < 2; ++b)
#pragma unroll
                for (int m = 0; m < 4; ++m)
#pragma unroll
                    for (int n = 0; n < 2; ++n) acc[a][b][m][n] = acc_t{};
        cur = nxt; cA = nA; cB = nB; ++ui;
    }
    PG8_WAIT_V(0);
    if (wr == 0) PG8_BAR;
    PG8_BAR;
#undef PG8_SA
#undef PG8_SB
#undef PG8_STAGE
#undef PG8_LDA
#undef PG8_LDB
#undef PG8_MMA
#undef PG8_WAIT_V
#undef PG8_WAIT_L
#undef PG8_BAR
#undef PG8_SCHED
}
}

namespace att {
constexpr int HD = 128, NW = 8, QBLK = 32, KVBLK = 64;
constexpr float SCALE = 0.088388347648318440f;
constexpr float THR = 8.f;
constexpr int LDQ = 512, LDK = 256;
constexpr size_t SHM_V = KVBLK * HD * 2, SHM_K = KVBLK * HD * 2, SHM_ATTN = 2 * SHM_V + 2 * SHM_K + NW * 64 * 4;
#define KSWZ(row, colB) ((row) * 256 + ((colB) ^ (((row) & 7) << 4)))
#define SBAR() __builtin_amdgcn_sched_barrier(0)
__device__ __forceinline__ int crow(int r, int hi) { return (r & 3) + 8 * (r >> 2) + 4 * hi; }
__device__ __forceinline__ unsigned cvtpk(float lo, float hi) { unsigned r; asm volatile("v_cvt_pk_bf16_f32 %0, %1, %2" : "=v"(r) : "v"(lo), "v"(hi)); return r; }
__device__ __forceinline__ void partialSM(f32x16& p0, f32x16& p1) {
  for (int r = 0; r < 16; ++r) p0[r] = __builtin_amdgcn_exp2f(p0[r]);
}
typedef int i32x8 __attribute__((ext_vector_type(8)));
__device__ __forceinline__ void finishSM(f32x16& p0, f32x16& p1, i32x8& pa) {
  for (int r = 0; r < 16; ++r) p1[r] = __builtin_amdgcn_exp2f(p1[r]);
#pragma unroll
  for (int q = 0; q < 4; ++q) { int w = __builtin_amdgcn_cvt_pk_bf8_f32(p0[4 * q], p0[4 * q + 1], 0, false); w = __builtin_amdgcn_cvt_pk_bf8_f32(p0[4 * q + 2], p0[4 * q + 3], w, true); pa[q] = w;
    int w2 = __builtin_amdgcn_cvt_pk_bf8_f32(p1[4 * q], p1[4 * q + 1], 0, false); w2 = __builtin_amdgcn_cvt_pk_bf8_f32(p1[4 * q + 2], p1[4 * q + 3], w2, true); pa[4 + q] = w2; }
}
constexpr int K8_STRIDE = 144, K8_TILE = KVBLK * K8_STRIDE;
__device__ __forceinline__ void qkt(f32x16& p0, f32x16& p1, const unsigned char* Ks, const i32x8* qr, int r32, int hi, const f32x16& cinit) {
  p0 = cinit; p1 = cinit;
#pragma unroll
  for (int ks = 0; ks < 2; ++ks) {
    const u32x4* a0 = (const u32x4*)(Ks + r32 * K8_STRIDE + 64 * ks + 32 * hi); const u32x4* a1 = (const u32x4*)(Ks + (32 + r32) * K8_STRIDE + 64 * ks + 32 * hi);
    const u32x4 x0 = a0[0], x1 = a0[1], y0 = a1[0], y1 = a1[1];
    const i32x8 k0 = {(int)x0.x, (int)x0.y, (int)x0.z, (int)x0.w, (int)x1.x, (int)x1.y, (int)x1.z, (int)x1.w}, k1 = {(int)y0.x, (int)y0.y, (int)y0.z, (int)y0.w, (int)y1.x, (int)y1.y, (int)y1.z, (int)y1.w};
    p0 = __builtin_amdgcn_mfma_scale_f32_32x32x64_f8f6f4(k0, qr[ks], p0, 0, 0, 0, 0x7F7F7F7F, 0, 0x7C7C7C7C);
    p1 = __builtin_amdgcn_mfma_scale_f32_32x32x64_f8f6f4(k1, qr[ks], p1, 0, 0, 0, 0x7F7F7F7F, 0, 0x7C7C7C7C); }
}
constexpr int V8_STRIDE = 80, V8_TILE = HD * V8_STRIDE;
__device__ __forceinline__ void pv_d0(f32x16* o, f32x16& ol, const unsigned char* Vs, const i32x8& pa, int r32, int hi) {
  { const i32x8 ones = {0x38383838, 0x38383838, 0x38383838, 0x38383838, 0x38383838, 0x38383838, 0x38383838, 0x38383838};
    ol = __builtin_amdgcn_mfma_scale_f32_32x32x64_f8f6f4(pa, ones, ol, 1, 0, 0, 0x7F7F7F7F, 0, 0x7F7F7F7F); }
#pragma unroll
  for (int d0 = 0; d0 < 4; ++d0) { const u32x4* bp = (const u32x4*)(Vs + (32 * d0 + r32) * V8_STRIDE + 32 * hi); const u32x4 x0 = bp[0], x1 = bp[1];
    const i32x8 vb = {(int)x0.x, (int)x0.y, (int)x0.z, (int)x0.w, (int)x1.x, (int)x1.y, (int)x1.z, (int)x1.w};
    o[d0] = __builtin_amdgcn_mfma_scale_f32_32x32x64_f8f6f4(pa, vb, o[d0], 1  , 0  , 0, 0x7F7F7F7F, 0, 0x7F7F7F7F); }
}
__device__ __forceinline__ void attn_dense_body(const unsigned char* __restrict__ Qb, const unsigned char* __restrict__ Kh, const unsigned char* __restrict__ Vt,
                                                bf16_t* __restrict__ Ob, int LDO, int seq, char* lds, float* __restrict__ lse, float braw) {
  int tid = threadIdx.x; asm volatile("" : "+v"(tid)); const int wid = tid >> 6, lane = tid & 63, r32 = lane & 31, hi = lane >> 5;
  unsigned char* V_lds = (unsigned char*)lds; unsigned char* K_lds = (unsigned char*)(lds + 2 * V8_TILE);
  f32x16 o[4] = {}, ol = {}; i32x8 qr[2];
  const float mnC = __builtin_bit_cast(float, __builtin_amdgcn_readfirstlane(__builtin_bit_cast(int, -fmaxf(braw * (SCALE * 1.4426950408889634f) - 15.5f, 0.f))));
  f32x16 cinit;
#pragma unroll
  for (int r = 0; r < 16; ++r) cinit[r] = mnC;
  const unsigned char* Qw = Qb + (long)(wid * QBLK + r32) * LDQ + hi * 32;
#pragma unroll
  for (int ks = 0; ks < 2; ++ks) { const u32x4 x0 = *(const u32x4*)(Qw + 64 * ks), x1 = *(const u32x4*)(Qw + 64 * ks + 16);
    qr[ks] = (i32x8){(int)x0.x, (int)x0.y, (int)x0.z, (int)x0.w, (int)x1.x, (int)x1.y, (int)x1.z, (int)x1.w}; }
  const int krow = tid >> 3, kch = tid & 7;
  const int vrow = tid >> 2, vch = tid & 3;
  struct { u32x4 v8, k8; } sr_[2];
#define SLOAD(i, k0) do { sr_[i].v8 = *reinterpret_cast<const u32x4*>(Vt + (long)((k0) >> 6) * 8192 + tid * 16); \
    sr_[i].k8 = *reinterpret_cast<const u32x4*>(Kh + (long)((k0) + krow) * LDK + kch * 16); } while (0)
#define SWRITE(b, i) do { *(u32x4*)(V_lds + (b) * V8_TILE + vrow * V8_STRIDE + vch * 16) = sr_[i].v8; \
    *(u32x4*)(K_lds + (b) * K8_TILE + krow * K8_STRIDE + kch * 16) = sr_[i].k8; } while (0)
#define SWAIT() asm volatile("s_waitcnt vmcnt(2)" ::: "memory")
  f32x16 pA0, pA1, pB0, pB1; i32x8 pa; const int NT = seq / KVBLK;
  constexpr int SE = 0, SO = 1;
  SLOAD(SE, 0); asm volatile("s_waitcnt vmcnt(0)" ::: "memory"); SWRITE(0, SE); __syncthreads();
  qkt(pA0, pA1, K_lds, qr, r32, hi, cinit); partialSM(pA0, pA1);
  SLOAD(SO, KVBLK); SLOAD(SE, 2 * KVBLK);
  SWAIT(); SWRITE(1, SO); __syncthreads();
  for (int j = 1; j + 1 < NT; j += 2) {
    SBAR(); qkt(pB0, pB1, K_lds + K8_TILE, qr, r32, hi, cinit);
    finishSM(pA0, pA1, pa); SBAR();
    SLOAD(SO, (j + 2) * KVBLK); SBAR();
    pv_d0(o, ol, V_lds, pa, r32, hi); partialSM(pB0, pB1);
    __syncthreads(); SWAIT(); SWRITE(0, SE);
    __syncthreads();
    SBAR(); qkt(pA0, pA1, K_lds, qr, r32, hi, cinit);
    finishSM(pB0, pB1, pa); SBAR();
    SLOAD(SE, (j + 3 < NT ? j + 3 : NT - 1) * KVBLK); SBAR();
    pv_d0(o, ol, V_lds + V8_TILE, pa, r32, hi); partialSM(pA0, pA1);
    __syncthreads(); SWAIT(); SWRITE(1, SO);
    __syncthreads();
  }
  SBAR(); qkt(pB0, pB1, K_lds + K8_TILE, qr, r32, hi, cinit);
  finishSM(pA0, pA1, pa); SBAR();
  pv_d0(o, ol, V_lds, pa, r32, hi); partialSM(pB0, pB1);
  __syncthreads();
  finishSM(pB0, pB1, pa); SBAR();
  pv_d0(o, ol, V_lds + V8_TILE, pa, r32, hi);
  if (lse && r32 == 0) {
#pragma unroll
    for (int r = 0; r < 16; ++r) lse[(wid * QBLK + crow(r, hi)) * 4] = __logf(ol[r]) - mnC * 0.69314718055994531f; }
  float rli[16];
#pragma unroll
  for (int r = 0; r < 16; ++r) rli[r] = __builtin_amdgcn_rcpf(ol[r]);
  bf16_t* Ow = Ob + (long)(wid * QBLK) * LDO;
#pragma unroll
  for (int r = 0; r < 16; ++r) { int orow = crow(r, hi);
    for (int d0 = 0; d0 < 4; ++d0) Ow[(long)orow * LDO + d0 * 32 + r32] = (bf16_t)(pkbf(o[d0][r] * rli[r], 0.f) & 0xffffu); }
  __syncthreads();
#undef SLOAD
#undef SWRITE
#undef SWAIT
}
}

struct Args { const float* in[20]; float* out; unsigned char* ws; int ph_lo, ph_hi; };
typedef const __attribute__((address_space(4))) Args* KArgs;
__device__ __forceinline__ KArgs get_args() { KArgs p = (KArgs)__builtin_amdgcn_kernarg_segment_ptr(); asm volatile("" : "+s"(p)); return p; }
__device__ __forceinline__ int fresh_tid() { int t = threadIdx.x; asm volatile("" : "+v"(t)); return t; }
__device__ __forceinline__ int fresh_bx() { int t = blockIdx.x; asm volatile("" : "+s"(t)); return t; }
__device__ __forceinline__ int fresh_g() { int t = gridDim.x; asm volatile("" : "+s"(t)); return t; }
enum { I_X = 0, I_C, I_CTX, I_CCTX, I_ADAW, I_ADAB, I_N1W, I_N2W, I_WIN, I_QNW, I_KNW, I_CONVW, I_ALOG, I_DTB, I_DNW, I_WOUT, I_WQ, I_SUBK, I_U, I_V };

__device__ __forceinline__ void convert_tables(const float* U, const float* V, unsigned char* ws, int l, int wvi, int nwv, int lane, int rw_end = 2 * NEXP) {
    const float* us = U + (size_t)l * NEXP * 1024; const float* vs = V + (size_t)l * NEXP * 1024;
    const int set = l & 1;
    float* scl = (float*)(ws + WS_USC) + set * 2 * NEXP;
    for (int rw = wvi; rw < rw_end; rw += nwv) {
        const bool isu = rw < NEXP; const int e = isu ? rw : rw - NEXP;
        const f32x4* sp = (const f32x4*)((isu ? us : vs) + (size_t)e * 1024 + 16 * lane);
        f32x4 x[4]; float mx = 0.f;
#pragma unroll
        for (int i = 0; i < 4; ++i) { x[i] = sp[i]; mx = fmaxf(mx, fmaxf(fmaxf(fabsf(x[i][0]), fabsf(x[i][1])), fmaxf(fabsf(x[i][2]), fabsf(x[i][3])))); }
        mx = wave_max(mx);
        const float sc = fmaxf(mx, 1e-30f) * (1.f / 127.f), inv = 1.f / sc;
        u32x4 o4;
        const float ofs = ((GATHER_PART && isu) || GATHER_PART == 2) ? 0.f : 128.f;
#pragma unroll
        for (int i = 0; i < 4; ++i) { const unsigned b0 = (unsigned)(int)(rintf(x[i][0] * inv) + ofs) & 255u, b1 = (unsigned)(int)(rintf(x[i][1] * inv) + ofs) & 255u, b2 = (unsigned)(int)(rintf(x[i][2] * inv) + ofs) & 255u, b3 = (unsigned)(int)(rintf(x[i][3] * inv) + ofs) & 255u;
            o4[i] = b0 | (b1 << 8) | (b2 << 16) | (b3 << 24); }
        if (GATHER_PART == 2) *(u32x4*)(ws + WS_UB + (size_t)set * TAB_SET + (isu ? 0 : (size_t)NEXP * 1024) + ((size_t)(lane >> 3) * NEXP + e) * 128 + 16 * (lane & 7)) = o4;
        else *(u32x4*)(ws + WS_UB + (size_t)set * TAB_SET + (size_t)e * 2048 + (isu ? 0 : 1024) + 16 * lane) = o4;
        if (lane == 0) { if (GATHER_PART) scl[2 * e + (isu ? 0 : 1)] = sc; else scl[rw] = sc; }
    }
}

__device__ __forceinline__ void transpose_item(const float* W, int ldw, int K, bf16_t* WT, LAS float* scr, int kb, int nb, int lane) {
    const int k0 = 64 * kb, n0 = 32 * nb;
#pragma unroll 8
    for (int i = 0; i < 32; ++i) { const int kk = 2 * i + (lane >> 5); scr[kk * 33 + (lane & 31)] = W[(size_t)(k0 + kk) * ldw + n0 + (lane & 31)]; }
    LDS_WAIT(); asm volatile("" ::: "memory");
    const int c = lane & 7;
#pragma unroll
    for (int j = 0; j < 4; ++j) { const int n = (lane >> 3) + 8 * j; const LAS float* s = scr + (8 * c) * 33 + n;
        u32x4 o; o.x = pkbf(s[0 * 33], s[1 * 33]); o.y = pkbf(s[2 * 33], s[3 * 33]); o.z = pkbf(s[4 * 33], s[5 * 33]); o.w = pkbf(s[6 * 33], s[7 * 33]);
        *(u32x4*)(WT + (size_t)(n0 + n) * K + k0 + 8 * c) = o; }
    LDS_WAIT(); asm volatile("" ::: "memory");
}
__device__ __forceinline__ void phase_prologue(LAS unsigned char* lds) {
    const KArgs ap = get_args();
#define a (*ap)

    const int tid = fresh_tid(), lane = tid & 63, wave = __builtin_amdgcn_readfirstlane(tid >> 6), G = fresh_g(), bx = fresh_bx();
    unsigned char* ws = a.ws;
    {
        LAS float* sc = (LAS float*)(lds + 70000);
        LAS float* part = (LAS float*)(lds + 70000 + 12288);
        for (int i = tid; i < 3 * 1024; i += 512) { const int r = i >> 10, k = i & 1023; const float v = r < 2 ? a.in[I_C][r * 1024 + k] : a.in[I_CCTX][k]; sc[i] = silu_f(v); }
        __syncthreads();
        float* mod = (float*)(ws + WS_MOD);
        for (int item = bx; item < DEPTH * 96; item += G) {
            const int l = item / 96, j0 = (item % 96) * 64;
            const float* wp = a.in[I_ADAW] + (size_t)l * 1024 * 6144 + (size_t)(wave * 128) * 6144 + j0 + lane;
            float a0 = 0.f, a1 = 0.f, a2 = 0.f;
#pragma unroll 8
            for (int kk = 0; kk < 128; ++kk) { const float w = wp[(size_t)kk * 6144]; const int k = wave * 128 + kk; a0 = fmaf(sc[k], w, a0); a1 = fmaf(sc[1024 + k], w, a1); a2 = fmaf(sc[2048 + k], w, a2); }
            part[(wave * 3 + 0) * 64 + lane] = a0; part[(wave * 3 + 1) * 64 + lane] = a1; part[(wave * 3 + 2) * 64 + lane] = a2;
            __syncthreads();
            if (tid < 192) { const int r = tid >> 6, jj = tid & 63; float s = a.in[I_ADAB][l * 6144 + j0 + jj];
#pragma unroll
                for (int w = 0; w < 8; ++w) s += part[(w * 3 + r) * 64 + jj];
                mod[(size_t)(l * 3 + r) * 6144 + j0 + jj] = s; }
            __syncthreads();
        }
    }
    {
        const int gw = bx * 8 + wave, NGW = G * 8;
        unsigned* wmaxw = (unsigned*)(ws + WS_CTL) + CW_WMAX;
        constexpr int NB_IN = NP / 64, NB_OUT = 1024 / 64, NB_Q = 2048 / 64, PER_L2 = (NB_IN + NB_OUT + NB_Q) * 8;
        for (int it = gw; it < DEPTH * PER_L2; it += NGW) { const int l = it / PER_L2; int r = it % PER_L2; const int kc = r & 7; r >>= 3;
            const int mi = r < NB_IN ? 0 : r < NB_IN + NB_OUT ? 1 : 2; const int nb = mi == 0 ? r : mi == 1 ? r - NB_IN : r - NB_IN - NB_OUT; const int ldw = mi == 0 ? NIN : mi == 1 ? 1024 : 2048;
            const float* wp = (mi == 0 ? a.in[I_WIN] + (size_t)l * 1024 * NIN : mi == 1 ? a.in[I_WOUT] + (size_t)l * 1024 * 1024 : a.in[I_WQ] + (size_t)l * 1024 * 2048) + (size_t)(kc * 128) * ldw + nb * 64 + lane;
            float mx = 0.f;
#pragma unroll 8
            for (int kk = 0; kk < 128; ++kk) mx = fmaxf(mx, fabsf(wp[(size_t)kk * ldw]));
            atomicMax(wmaxw + (l * 3 + mi) * 3072 + nb * 64 + lane, __float_as_uint(mx)); }
    }
    const size_t gt = (size_t)bx * 512 + tid, NT = (size_t)G * 512;
    for (size_t i = gt; i < (size_t)DEPTH * 16 * 1024; i += NT) { const int l = (int)(i >> 14), j = (int)((i >> 10) & 15), k = (int)(i & 1023);
        ((float*)(ws + WS_WSK))[i] = a.in[I_WIN][(size_t)l * 1024 * NIN + (size_t)k * NIN + NP + j]; }
    convert_tables(a.in[I_U], a.in[I_V], ws, 0, bx * 8 + wave, G * 8, lane);
    for (size_t i = gt; i < (size_t)DEPTH * 8 * 2 * 128 * 128 / 2; i += NT) { const f32x2 x = ((const f32x2*)a.in[I_SUBK])[i]; ((unsigned*)(ws + WS_SKB))[i] = pkbf(x[0], x[1]); }
    for (size_t i = gt; i < 8192; i += NT) { const int pos = (int)(i >> 5), fi = (int)(i & 31);
        const float inv = exp2f(-(float)fi * (13.287712379549449f / 32.f)); const float ang = (float)pos * inv;
        float rev = ang * 0.15915494309189535f; rev -= floorf(rev);
        ((float*)(ws + WS_ROPE))[i] = __builtin_amdgcn_cosf(rev); ((float*)(ws + WS_ROPE))[8192 + i] = __builtin_amdgcn_sinf(rev); }
}


__device__ __forceinline__ void quant_transpose_item(const float* W, int ldw, signed char* WT, const unsigned* wmaxw, LAS float* scr, int kb, int nb, int lane) {
    const int k0 = 64 * kb, n0 = 32 * nb;
#pragma unroll 8
    for (int i = 0; i < 32; ++i) { const int kk = 2 * i + (lane >> 5); scr[kk * 33 + (lane & 31)] = W[(size_t)(k0 + kk) * ldw + n0 + (lane & 31)]; }
    LDS_WAIT(); asm volatile("" ::: "memory");
    const int n = lane >> 1, hf = lane & 1;
    const float mx = __uint_as_float(wmaxw[n0 + n]), inv = mx > 0.f ? 127.f / mx : 0.f;
    u32x4 o[2];
#pragma unroll
    for (int q = 0; q < 8; ++q) { unsigned w = 0u;
#pragma unroll
        for (int b = 0; b < 4; ++b) { const int kk = 32 * hf + 4 * q + b; w |= ((unsigned)(int)rintf(scr[kk * 33 + n] * inv) & 255u) << (8 * b); }
        o[q >> 2][q & 3] = w; }
    u32x4* dst = (u32x4*)(WT + (size_t)(n0 + n) * 1024 + k0 + 32 * hf);
    dst[0] = o[0]; dst[1] = o[1];
    LDS_WAIT(); asm volatile("" ::: "memory");
}
__device__ __forceinline__ void phase_quant_weights(LAS unsigned char* lds) {
    const KArgs ap = get_args();
#define a (*ap)
    const int tid = fresh_tid(), lane = tid & 63, wave = __builtin_amdgcn_readfirstlane(tid >> 6), G = fresh_g(), bx = fresh_bx();
    unsigned char* ws = a.ws;
    LAS float* scr = (LAS float*)(lds + 65536 + wave * 8448);
    const unsigned* wmaxw = (const unsigned*)(ws + WS_CTL) + CW_WMAX;
    constexpr int I_IN = 16 * 96, I_OUT = 16 * 32, I_Q = 16 * 64, PER_L = I_IN + I_OUT + I_Q;
    for (int it = bx * 8 + wave; it < DEPTH * PER_L; it += G * 8) { const int l = it / PER_L; int r = it % PER_L;
        if (r < I_IN) quant_transpose_item(a.in[I_WIN] + (size_t)l * 1024 * NIN, NIN, (signed char*)(ws + WS_WINT) + (size_t)l * NP * 1024, wmaxw + (l * 3 + 0) * 3072, scr, r / 96, r % 96, lane);
        else if (r < I_IN + I_OUT) { r -= I_IN; quant_transpose_item(a.in[I_WOUT] + (size_t)l * 1024 * 1024, 1024, (signed char*)(ws + WS_WOUTT) + (size_t)l * 1024 * 1024, wmaxw + (l * 3 + 1) * 3072, scr, r / 32, r % 32, lane); }
        else { r -= I_IN + I_OUT; quant_transpose_item(a.in[I_WQ] + (size_t)l * 1024 * 2048, 2048, (signed char*)(ws + WS_WQT) + (size_t)l * 2048 * 1024, wmaxw + (l * 3 + 2) * 3072, scr, r / 64, r % 64, lane); } }
#undef a
}

template <bool SK>
__device__ __forceinline__ void phase_norm(int l, int which, LAS unsigned char* lds) {
    const KArgs ap = get_args();
#define a (*ap)

    const int tid = fresh_tid(), lane = tid & 63, wave = __builtin_amdgcn_readfirstlane(tid >> 6), G = fresh_g(), bx = fresh_bx();
    unsigned char* ws = a.ws;
    LAS float* wsk = (LAS float*)lds;
    if (SK) { const float* src = (const float*)(ws + WS_WSK) + (size_t)l * 16384; for (int i = tid; i < 16384 / 4; i += 512) ((LAS f32x4*)wsk)[i] = ((const f32x4*)src)[i]; __syncthreads(); }
    const int nrows = (which == 1 && l == DEPTH - 1) ? ML : M;
    const float* nw = a.in[which ? I_N2W : I_N1W] + l * 1024;
    const float* modl = (const float*)(ws + WS_MOD) + (size_t)l * 3 * 6144;
    const int shoff = which ? 3072 : 0, scoff = which ? 4096 : 1024;
    f32x4 nwv[4];
#pragma unroll
    for (int j = 0; j < 4; ++j) nwv[j] = *(const f32x4*)(nw + 4 * lane + 256 * j);
    for (int row = wave * G + bx; row < nrows; row += G * 8) {
        const float* src; int mrow;
        if (row < ML) { src = ((l == 0 && which == 0) ? a.in[I_X] : a.out) + (size_t)row * D; mrow = row >= T ? 1 : 0; }
        else { src = ((l == 0 && which == 0) ? a.in[I_CTX] : (const float*)(ws + WS_CTXX)) + (size_t)(row - ML) * D; mrow = 2; }
        const float* md = modl + mrow * 6144;
        f32x4 v[4]; float ss = 0.f;
#pragma unroll
        for (int j = 0; j < 4; ++j) { v[j] = *(const f32x4*)(src + 4 * lane + 256 * j); ss += (v[j][0] * v[j][0] + v[j][1] * v[j][1]) + (v[j][2] * v[j][2] + v[j][3] * v[j][3]); }
        const float rstd = rsqrtf(wave_sum(ss) * (1.f / D) + EPS);
        signed char* hrow = (signed char*)(ws + WS_H) + (size_t)row * D;
        float hmx = 0.f;
#pragma unroll
        for (int j = 0; j < 4; ++j) { const f32x4 sc = *(const f32x4*)(md + scoff + 4 * lane + 256 * j), sh = *(const f32x4*)(md + shoff + 4 * lane + 256 * j);
            v[j] = v[j] * rstd * nwv[j] * (sc + 1.f) + sh; hmx = fmaxf(hmx, fmaxf(fmaxf(fabsf(v[j][0]), fabsf(v[j][1])), fmaxf(fabsf(v[j][2]), fabsf(v[j][3])))); }
        hmx = fmaxf(wave_max(hmx), 1e-30f);
        { const float hinv = 127.f / hmx;
#pragma unroll
          for (int j = 0; j < 4; ++j) *(unsigned*)(hrow + 4 * lane + 256 * j) = ((unsigned)(int)rintf(v[j][0] * hinv) & 255u) | (((unsigned)(int)rintf(v[j][1] * hinv) & 255u) << 8) | (((unsigned)(int)rintf(v[j][2] * hinv) & 255u) << 16) | (((unsigned)(int)rintf(v[j][3] * hinv) & 255u) << 24);
          if (lane == 0) ((float*)(ws + WS_GB))[row] = hmx * (1.f / 127.f); }
        if (SK) {
            float p[16];
#pragma unroll
            for (int c = 0; c < 16; ++c) { float q = 0.f;
#pragma unroll
                for (int j = 0; j < 4; ++j) { const f32x4 w = *(const LAS f32x4*)(wsk + c * 1024 + 4 * lane + 256 * j); q += (v[j][0] * w[0] + v[j][1] * w[1]) + (v[j][2] * w[2] + v[j][3] * w[3]); }
                p[c] = q; }
            { const bool hb = (lane & 32) != 0;
#pragma unroll
              for (int c = 0; c < 8; ++c) { const float keep = hb ? p[c + 8] : p[c], send = hb ? p[c] : p[c + 8]; p[c] = keep + lane_xor<32>(send); } }
            { const bool hb = (lane & 16) != 0;
#pragma unroll
              for (int c = 0; c < 4; ++c) { const float keep = hb ? p[c + 4] : p[c], send = hb ? p[c] : p[c + 4]; p[c] = keep + lane_xor<16>(send); } }
            { const bool hb = (lane & 8) != 0;
#pragma unroll
              for (int c = 0; c < 2; ++c) { const float keep = hb ? p[c + 2] : p[c], send = hb ? p[c] : p[c + 2]; p[c] = keep + lane_xor<8>(send); } }
            { const bool hb = (lane & 4) != 0; const float keep = hb ? p[1] : p[0], send = hb ? p[0] : p[1]; p[0] = keep + lane_xor<4>(send); }
            p[0] += lane_xor<2>(p[0]); p[0] += lane_xor<1>(p[0]);
            if ((lane & 3) == 0) { const int c = ((lane >> 5) & 1) * 8 + ((lane >> 4) & 1) * 4 + ((lane >> 3) & 1) * 2 + ((lane >> 2) & 1); ((float*)(ws + WS_BA))[(size_t)row * 16 + c] = p[0]; }
        }
    }
    if (SK) __syncthreads();
}

__device__ __forceinline__ void phase_prep(int l, LAS unsigned char* lds) {
    const KArgs ap = get_args();
#define a (*ap)

    const int tid = fresh_tid(), lane = tid & 63, wave = __builtin_amdgcn_readfirstlane(tid >> 6), G = fresh_g(), bx = fresh_bx();
    unsigned char* ws = a.ws;
    const bf16_t* P = (const bf16_t*)(ws + WS_P);
    const float* ropec = (const float*)(ws + WS_ROPE); const float* ropes = ropec + 8192;
    const int sec = lane >> 5, fi = lane & 31;
    const float qw0 = a.in[I_QNW][l * 128 + sec * 64 + fi], qw1 = a.in[I_QNW][l * 128 + sec * 64 + 32 + fi];
    const float kw0 = a.in[I_KNW][l * 128 + sec * 64 + fi], kw1 = a.in[I_KNW][l * 128 + sec * 64 + 32 + fi];
    for (int row = wave * G + bx; row < M; row += G * 8) {
        const bool lat = row < ML;
        int b, tt, tlen; if (lat) { b = row >> 14; tt = row & (T - 1); tlen = T; } else { b = (row - ML) >> 8; tt = (row - ML) & (CT - 1); tlen = CT; }
        const bf16_t* prow = P + (size_t)row * NP;
        unsigned short xa[6][2];
#pragma unroll
        for (int hh = 0; hh < 6; ++hh) { const bf16_t* xp = prow + (hh < 4 ? hh * 128 : 512 + (hh - 4) * 128) + sec * 64 + fi; xa[hh][0] = xp[0]; xa[hh][1] = xp[32]; }
        const u32x2 vcp = *(const u32x2*)(prow + 768 + 4 * lane);
        float cs = 1.f, sn = 0.f;
        if (lat) { const int pos = sec ? (tt & 63) : (tt >> 6); cs = ropec[pos * 32 + fi]; sn = ropes[pos * 32 + fi]; }
        unsigned char* qo8 = ws + WS_QA + (size_t)row * 512;
        const size_t kvrow = (size_t)b * KVLEN + (lat ? tt : T + tt);
        unsigned char* ko8 = ws + WS_KA + kvrow * 256;
        float ssq[6];
#pragma unroll
        for (int hh = 0; hh < 6; ++hh) { const float x0 = bf2f(xa[hh][0]), x1 = bf2f(xa[hh][1]); ssq[hh] = x0 * x0 + x1 * x1; }
#pragma unroll
        for (int hh = 0; hh < 6; ++hh) ssq[hh] = wave_sum(ssq[hh]);
#pragma unroll
        for (int hh = 0; hh < 6; ++hh) {
            const float x0 = bf2f(xa[hh][0]), x1 = bf2f(xa[hh][1]);
            const float rs = rsqrtf(ssq[hh] * (1.f / 128.f) + EPS);
            const float y0 = x0 * rs * (hh < 4 ? qw0 : kw0), y1 = x1 * rs * (hh < 4 ? qw1 : kw1);
            const float qsc = hh < 4 ? 0.088388347648318440f * 1.4426950408889634f : 1.f;
            const float o0 = (y0 * cs - y1 * sn) * qsc, o1 = (y1 * cs + y0 * sn) * qsc;
            unsigned char* op8 = (hh < 4 ? qo8 + hh * 128 : ko8 + (hh - 4) * 128) + sec * 64 + fi;
            const float f8s = hh < 4 ? 8.f : 1.f;
            const int pk8 = __builtin_amdgcn_cvt_pk_fp8_f32(o0 * f8s, o1 * f8s, 0, false);
            op8[0] = (unsigned char)(pk8 & 255); op8[32] = (unsigned char)((pk8 >> 8) & 255);
        }
        { const int pos = lat ? tt : T + tt, tile = pos >> 6, k64 = pos & 63, k32 = k64 & 31;
          const int bytepos = 32 * ((k32 >> 2) & 1) + 16 * (k64 >> 5) + (k32 & 3) + 4 * (k32 >> 3);
          unsigned char* vt = ws + WS_VA + ((size_t)(b * 2) * (KVLEN / 64) + tile) * 8192 + bytepos;
          const unsigned short* vsrc = (const unsigned short*)&vcp;
          const int kvh_ = lane >> 5, d0 = (4 * lane) & 127;
          const int pk01 = __builtin_amdgcn_cvt_pk_fp8_f32(bf2f(vsrc[0]), bf2f(vsrc[1]), 0, false), pk23 = __builtin_amdgcn_cvt_pk_fp8_f32(bf2f(vsrc[2]), bf2f(vsrc[3]), 0, false);
          unsigned char* vt2 = vt + (size_t)kvh_ * (KVLEN / 64) * 8192 + (size_t)d0 * 64;
          vt2[0] = (unsigned char)(pk01 & 255); vt2[64] = (unsigned char)((pk01 >> 8) & 255); vt2[128] = (unsigned char)(pk23 & 255); vt2[192] = (unsigned char)((pk23 >> 8) & 255); }
    }
    __syncthreads();
}

constexpr int ATT_PARTS = 4;
__device__ __forceinline__ void phase_attn(int l, unsigned char* lds_raw, volatile LAS unsigned* MISC, int rep) {
    const KArgs ap = get_args();
#define a (*ap)
    unsigned char* ws = a.ws;
    const unsigned char* QA = ws + WS_QA; const unsigned char* KA = ws + WS_KA; const unsigned char* VT = ws + WS_VA;
    bf16_t* CAT = (bf16_t*)(ws + WS_CAT); float* LSE = (float*)(ws + WS_BA);
    unsigned* ctr = (unsigned*)(ws + WS_CTL) + 8192 + 64 * l + 1024 * rep;
    const int natt = 2048 + (l < DEPTH - 1 ? 8 : 0);
    constexpr int CONV_ROWS = 64, NCONV = 2 * NEXP / CONV_ROWS;
    const int nunits = natt + (l + 1 < DEPTH ? NCONV : 0);
    float braw;
    { const int ln = threadIdx.x & 63; float mq = fmaxf(fabsf(a.in[I_QNW][l * 128 + ln]), fabsf(a.in[I_QNW][l * 128 + 64 + ln])), mk = fmaxf(fabsf(a.in[I_KNW][l * 128 + ln]), fabsf(a.in[I_KNW][l * 128 + 64 + ln]));
      mq = wave_max(mq); mk = wave_max(mk);
      braw = __builtin_bit_cast(float, __builtin_amdgcn_readfirstlane(__builtin_bit_cast(int, 128.f * mq * mk))); }
    if (threadIdx.x == 0) MISC[12] = __hip_atomic_fetch_add(ctr, 1u, __ATOMIC_RELAXED, __HIP_MEMORY_SCOPE_AGENT);
    __syncthreads();
    int u = (int)MISC[12], par = 0;
    for (; u < nunits; ) {
        if (threadIdx.x == 0) MISC[13 - par] = __hip_atomic_fetch_add(ctr, 1u, __ATOMIC_RELAXED, __HIP_MEMORY_SCOPE_AGENT);
        if (u >= natt) {
            const int rwb = (u - natt) * CONV_ROWS + (int)(threadIdx.x >> 6) * 8;
            convert_tables(a.in[I_U], a.in[I_V], ws, l + 1, rwb, 1, (int)(threadIdx.x & 63), rwb + 8);
            __syncthreads();
            u = (int)MISC[13 - par]; par ^= 1;
            continue;
        }
        size_t r0, kv0; int h, kvh, seq, ldo; bf16_t* ob; float* lse;
        if (u < 2048) { const int qb = u & 63, g = (u >> 6) & 1, part = (u >> 7) & 3, b = u >> 10; kvh = (u >> 9) & 1; h = kvh * 2 + g;
            const int t0 = (part >> 1) * 130 + (part & 1) * 64;
            r0 = (size_t)b * T + (size_t)qb * 256; kv0 = (size_t)b * KVLEN + (size_t)t0 * 64; seq = ((part & 1) ? 66 : 64) * 64;
            ob = part ? (bf16_t*)(ws + (part == 1 ? WS_DQ : part == 2 ? WS_DK : WS_DV)) + r0 * 512 + h * 128 : CAT + r0 * 1024 + h * 128; ldo = part ? 512 : 1024; lse = LSE + ((size_t)part * ML + r0) * 4 + h; }
        else { const int b = (u - 2048) >> 2; h = (u - 2048) & 3; kvh = h >> 1; r0 = (size_t)ML + (size_t)b * CT; kv0 = (size_t)b * KVLEN + T; seq = CT;
            ob = CAT + r0 * 1024 + h * 128; ldo = 1024; lse = nullptr; }
        att::attn_dense_body(QA + r0 * 512 + h * 128, KA + kv0 * 256 + kvh * 128, VT + ((size_t)((kv0 / KVLEN) * 2 + kvh) * (KVLEN / 64) + (kv0 % KVLEN) / 64) * 8192, ob, ldo, seq, (char*)lds_raw, lse, braw);
        u = (int)MISC[13 - par]; par ^= 1;
    }
#undef a
}

__device__ __forceinline__ int tokperm(int q, int hh, int jj) { return 16 * q + 8 * (jj >> 2) + 4 * hh + (jj & 3); }
__device__ __forceinline__ int crow16(int r, int hi) { return (r & 3) + 8 * (r >> 2) + 4 * hi; }
__device__ __forceinline__ int kperm16(int s_, int g, int jj) { return 32 * s_ + 16 * (jj >> 2) + 4 * g + (jj & 3); }
__device__ __forceinline__ int frag_off(int i, int j) {
    return (((i >> 4) * 2 + (j >> 5)) * 64 + ((i & 15) + 16 * ((j >> 2) & 3))) * 16 + (4 * ((j >> 4) & 1) + (j & 3)) * 2;
}
template <int MODE>
__device__ __forceinline__ void phase_dn_chunkprep(int l, LAS unsigned char* lds) {
    const KArgs ap = get_args();
#define a (*ap)
    const int tid = fresh_tid(), lane = tid & 63, wave = __builtin_amdgcn_readfirstlane(tid >> 6), G = fresh_g(), bx = fresh_bx();
    unsigned char* ws = a.ws;
    constexpr int KT_OFF = 0, QT_OFF = 17408, VT_OFF = 34816, GS_OFF = 52224, RS_OFF = 68864, AM_OFF = 85504, SC_OFF = 120320, IMG_OFF = 0;
    const int r = lane & 31, hh = lane >> 5;
    const bf16_t* DQ = (const bf16_t*)(ws + WS_DQ); const bf16_t* DK = (const bf16_t*)(ws + WS_DK); const bf16_t* DV = (const bf16_t*)(ws + WS_DV);
    const float* BA = (const float*)(ws + WS_BA);
    constexpr int NTASK = MODE ? NB * 4 * 4 : NB * 4 * (NCH - 4);
#define CP_TASKID(t_) (MODE ? ((t_) >> 2) * NCH + ((t_) & 3) : ((t_) >> 8) * NCH + 4 + ((t_) & 255))
    LAS float* gsc = (LAS float*)(lds + SC_OFF);
    LAS float* bsc = gsc + 128;
    LAS float* gcs = gsc + 256;
    constexpr int CW_OFF = 121856;
    LAS float* cwl = (LAS float*)(lds + CW_OFF);
    for (int i = tid; i < 5 * 1536; i += 512) cwl[i] = a.in[I_CONVW][(size_t)l * 5 * 1536 + i];
    __syncthreads();
    const bf16_t* P = (const bf16_t*)(ws + WS_P);
    u32x4 xin[3][5][2];
#define CP_LOADX(task_) do { const int cidx_ = (task_) % NCH, bh_ = (task_) / NCH, b_ = bh_ >> 2, h_ = bh_ & 3; \
        const int row0_ = cidx_ < 4 ? ML + b_ * CT + cidx_ * 64 : b_ * T + (cidx_ - 4) * 64, tt_ = (cidx_ < 4 ? cidx_ * 64 : (cidx_ - 4) * 64) + (tid >> 3), tlen_ = cidx_ < 4 ? CT : T; \
        _Pragma("unroll") for (int j = 0; j < 5; ++j) { const int t2 = tt_ + j - 2; const bool ok = t2 >= 0 && t2 < tlen_; \
            const bf16_t* xr = P + (size_t)(row0_ + (tid >> 3) + (ok ? j - 2 : 0)) * NP + 1024 + h_ * 128 + (tid & 7) * 16; \
            _Pragma("unroll") for (int m = 0; m < 3; ++m) { const u32x4 w0 = *(const u32x4*)(xr + m * 512), w1 = *(const u32x4*)(xr + m * 512 + 8); \
                xin[m][j][0] = ok ? w0 : (u32x4){0u, 0u, 0u, 0u}; xin[m][j][1] = ok ? w1 : (u32x4){0u, 0u, 0u, 0u}; } } } while (0)
    if (bx < NTASK) CP_LOADX(CP_TASKID(bx));
    for (int tk = bx; tk < NTASK; tk += G) {
        const int task = CP_TASKID(tk);
        const int cidx = task % NCH, bh = task / NCH, b = bh >> 2, h = bh & 3;
        const int row0 = cidx < 4 ? ML + b * CT + cidx * 64 : b * T + (cidx - 4) * 64;
        unsigned char* rec = ws + WS_REC + (size_t)task * REC_BYTES;
        {
            const int rr = tid >> 3, seg = tid & 7;
            if (tid < 128) { const int d = tid >> 6, i = tid & 63, dh = d * 4 + h;
                const float xb = BA[(size_t)(row0 + i) * 16 + dh], z = BA[(size_t)(row0 + i) * 16 + 8 + dh] + a.in[I_DTB][l * 8 + dh];
                bsc[tid] = 1.f / (1.f + __expf(-xb)); gsc[tid] = -__expf(a.in[I_ALOG][l * 8 + dh]) * (fmaxf(z, 0.f) + log1pf(__expf(-fabsf(z)))); }
#pragma unroll
            for (int m = 0; m < 3; ++m) {
                float y[16];
#pragma unroll
                for (int c = 0; c < 16; ++c) y[c] = 0.f;
#pragma unroll
                for (int j = 0; j < 5; ++j) { const LAS float* wp = cwl + j * 1536 + m * 512 + h * 128 + seg * 16;
#pragma unroll
                    for (int q4 = 0; q4 < 4; ++q4) { const f32x4 wv = *(const LAS f32x4*)(wp + 4 * q4); const unsigned u0 = xin[m][j][q4 >> 1][2 * (q4 & 1)], u1 = xin[m][j][q4 >> 1][2 * (q4 & 1) + 1];
                        y[4 * q4 + 0] = fmaf(bflo(u0), wv[0], y[4 * q4 + 0]); y[4 * q4 + 1] = fmaf(bfhi(u0), wv[1], y[4 * q4 + 1]); y[4 * q4 + 2] = fmaf(bflo(u1), wv[2], y[4 * q4 + 2]); y[4 * q4 + 3] = fmaf(bfhi(u1), wv[3], y[4 * q4 + 3]); } }
                float ss = 0.f;
#pragma unroll
                for (int c = 0; c < 16; ++c) { y[c] = silu_f(y[c]); ss = fmaf(y[c], y[c], ss); }
                if (m < 2) { ss += lane_xor<1>(ss); ss += lane_xor<2>(ss); ss += lane_xor<4>(ss);
                    float sc = rsqrtf(ss + EPS); if (m == 0) sc *= 0.088388347648318440f;
#pragma unroll
                    for (int c = 0; c < 16; ++c) y[c] *= sc; }
                u32x4 o0, o1; o0.x = pkbf(y[0], y[1]); o0.y = pkbf(y[2], y[3]); o0.z = pkbf(y[4], y[5]); o0.w = pkbf(y[6], y[7]); o1.x = pkbf(y[8], y[9]); o1.y = pkbf(y[10], y[11]); o1.z = pkbf(y[12], y[13]); o1.w = pkbf(y[14], y[15]);
                LAS unsigned char* dst = lds + (m == 0 ? QT_OFF : m == 1 ? KT_OFF : VT_OFF) + rr * 272 + seg * 32;
                *(LAS u32x4*)dst = o0; *(LAS u32x4*)(dst + 16) = o1;
            }
        }
        __syncthreads();
        {
            const int mat = wave >> 2, ti = (wave >> 1) & 1, tj = wave & 1;
            f32x16 acc = {};
#pragma unroll
            for (int ks = 0; ks < 8; ++ks) {
                const bf16x8 av = *(const LAS bf16x8*)(lds + (mat ? QT_OFF : KT_OFF) + (32 * ti + r) * 272 + (16 * ks + 8 * hh) * 2);
                const bf16x8 bv = *(const LAS bf16x8*)(lds + KT_OFF + (32 * tj + r) * 272 + (16 * ks + 8 * hh) * 2);
                acc = __builtin_amdgcn_mfma_f32_32x32x16_bf16(av, bv, acc, 0, 0, 0);
            }
            LAS float* dst = (LAS float*)(lds + (mat ? RS_OFF : GS_OFF));
#pragma unroll
            for (int i = 0; i < 16; ++i) dst[(32 * ti + crow16(i, hh)) * 65 + 32 * tj + r] = acc[i];
        }
        { const int r16 = lane & 15, g4 = lane >> 4;
#pragma unroll
        for (int t = 0; t < 2; ++t) { const int f = wave * 2 + t, mt = f >> 2, sk = f & 3;
            { const u32x2 lo = *(const LAS u32x2*)(lds + KT_OFF + (16 * mt + r16) * 272 + (32 * sk + 4 * g4) * 2), hi2 = *(const LAS u32x2*)(lds + KT_OFF + (16 * mt + r16) * 272 + (32 * sk + 16 + 4 * g4) * 2);
              *(u32x4*)(rec + REC_K + f * 1024 + lane * 16) = (u32x4){lo.x, lo.y, hi2.x, hi2.y}; }
            { const u32x2 lo = *(const LAS u32x2*)(lds + QT_OFF + (16 * mt + r16) * 272 + (32 * sk + 4 * g4) * 2), hi2 = *(const LAS u32x2*)(lds + QT_OFF + (16 * mt + r16) * 272 + (32 * sk + 16 + 4 * g4) * 2);
              *(u32x4*)(rec + REC_Q + f * 1024 + lane * 16) = (u32x4){lo.x, lo.y, hi2.x, hi2.y}; } }
#pragma unroll
        for (int t = 0; t < 2; ++t) { const int f = wave * 2 + t, mt = f >> 1, sk = f & 1;
            unsigned e[8];
#pragma unroll
            for (int jj = 0; jj < 8; ++jj) e[jj] = *(const LAS unsigned short*)(lds + KT_OFF + kperm16(sk, g4, jj) * 272 + (16 * mt + r16) * 2);
            *(u32x4*)(rec + REC_KT + f * 1024 + lane * 16) = (u32x4){e[0] | (e[1] << 16), e[2] | (e[3] << 16), e[4] | (e[5] << 16), e[6] | (e[7] << 16)}; }
        { const int sl = wave;
            unsigned e[16];
#pragma unroll
            for (int i = 0; i < 16; ++i) e[i] = *(const LAS unsigned short*)(lds + VT_OFF + (16 * (i >> 2) + 4 * g4 + (i & 3)) * 272 + (16 * sl + r16) * 2);
            u32x4* vp = (u32x4*)(rec + REC_V + sl * 2048 + lane * 32);
            vp[0] = (u32x4){e[0] | (e[1] << 16), e[2] | (e[3] << 16), e[4] | (e[5] << 16), e[6] | (e[7] << 16)};
            vp[1] = (u32x4){e[8] | (e[9] << 16), e[10] | (e[11] << 16), e[12] | (e[13] << 16), e[14] | (e[15] << 16)}; }
        }
        if (tk + G < NTASK) CP_LOADX(CP_TASKID(tk + G));
        if (wave < 2) { const int d = wave; float gv = gsc[d * 64 + (d ? 63 - lane : lane)];
            gv += __builtin_bit_cast(float, __builtin_amdgcn_update_dpp(0, __builtin_bit_cast(int, gv), 0x111, 0xF, 0xF, true));
            gv += __builtin_bit_cast(float, __builtin_amdgcn_update_dpp(0, __builtin_bit_cast(int, gv), 0x112, 0xF, 0xF, true));
            gv += __builtin_bit_cast(float, __builtin_amdgcn_update_dpp(0, __builtin_bit_cast(int, gv), 0x114, 0xF, 0xF, true));
            gv += __builtin_bit_cast(float, __builtin_amdgcn_update_dpp(0, __builtin_bit_cast(int, gv), 0x118, 0xF, 0xF, true));
            { const float t0 = __builtin_bit_cast(float, __builtin_amdgcn_readlane(__builtin_bit_cast(int, gv), 15)), t1 = __builtin_bit_cast(float, __builtin_amdgcn_readlane(__builtin_bit_cast(int, gv), 31)), t2 = __builtin_bit_cast(float, __builtin_amdgcn_readlane(__builtin_bit_cast(int, gv), 47));
              const int rw_ = lane >> 4; gv += (rw_ >= 1 ? t0 : 0.f) + (rw_ >= 2 ? t1 : 0.f) + (rw_ >= 3 ? t2 : 0.f); }
            gcs[d * 64 + lane] = gv; }
        __syncthreads();
        const LAS float* Gs = (const LAS float*)(lds + GS_OFF); const LAS float* Rs = (const LAS float*)(lds + RS_OFF);
#pragma unroll 4
        for (int t = 0; t < 16; ++t) { const int e = tid + 512 * t, d = e >> 12, jp = (e >> 6) & 63, ip = e & 63;
            const int in_ = d ? 63 - ip : ip, jn = d ? 63 - jp : jp;
            const float dec = __expf(fminf(gcs[d * 64 + ip] - gcs[d * 64 + jp], 0.f));
            const float av = (jp < ip) ? bsc[d * 64 + in_] * Gs[in_ * 65 + jn] * dec : 0.f;
            ((LAS float*)(lds + AM_OFF))[d * 4352 + jp * 68 + ip] = av;
            const float qk = (jp <= ip) ? Rs[in_ * 65 + jn] * dec : 0.f;
            *(LAS unsigned short*)(lds + IMG_OFF + d * 16384 + 8192 + frag_off(in_, jn)) = (unsigned short)(pkbf(qk, 0.f) & 0xffffu); }
        __syncthreads();
        if (wave < 2) { const int d = wave, c = lane, jn = d ? 63 - c : c; const float bj = bsc[d * 64 + jn];
            const LAS float* At = (const LAS float*)(lds + AM_OFF) + d * 4352;
            LAS float* Xm = (LAS float*)(lds + GS_OFF) + d * 4096 + c;
            const int fj = (jn >> 5) * 1024 + ((jn >> 2) & 3) * 256 + ((jn >> 4) & 1) * 8 + (jn & 3) * 2;
#pragma unroll 1
            for (int B = 0; B < 4; ++B) {
                float acc[16];
#pragma unroll
                for (int q = 0; q < 16; ++q) acc[q] = (16 * B + q == c) ? 1.f : 0.f;
#pragma unroll 4
                for (int j = 0; j < 16 * B; ++j) { const float xj = Xm[j * 64];
                    const f32x4 a0 = *(const LAS f32x4*)(At + j * 68 + 16 * B), a1 = *(const LAS f32x4*)(At + j * 68 + 16 * B + 4), a2 = *(const LAS f32x4*)(At + j * 68 + 16 * B + 8), a3 = *(const LAS f32x4*)(At + j * 68 + 16 * B + 12);
#pragma unroll
                    for (int q = 0; q < 4; ++q) { acc[q] = fmaf(-a0[q], xj, acc[q]); acc[4 + q] = fmaf(-a1[q], xj, acc[4 + q]); acc[8 + q] = fmaf(-a2[q], xj, acc[8 + q]); acc[12 + q] = fmaf(-a3[q], xj, acc[12 + q]); } }
#pragma unroll
                for (int r2 = 0; r2 < 15; ++r2) { const LAS float* ar = At + (16 * B + r2) * 68 + 16 * B; const float xr = acc[r2];
#pragma unroll
                    for (int q4 = (r2 + 1) / 4; q4 < 4; ++q4) { const f32x4 a4 = *(const LAS f32x4*)(ar + 4 * q4);
#pragma unroll
                        for (int q = 0; q < 4; ++q) if (4 * q4 + q > r2) acc[4 * q4 + q] = fmaf(-a4[q], xr, acc[4 * q4 + q]); } }
#pragma unroll
                for (int q = 0; q < 16; ++q) { const int i = 16 * B + q, in_ = d ? 63 - i : i; Xm[i * 64] = acc[q];
                    *(LAS unsigned short*)(lds + IMG_OFF + d * 16384 + (in_ >> 4) * 2048 + (in_ & 15) * 16 + fj) = (unsigned short)(pkbf(acc[q] * bj, 0.f) & 0xffffu); }
            }
        } else if (wave < 4) { const int d = wave - 2, ip = d ? 63 - lane : lane; const float gl = gcs[d * 64 + 63], gi = gcs[d * 64 + ip];
            float* sc = (float*)(rec + REC_DIR + d * REC_DIRSZ + 16384);
            sc[lane] = __expf(gi); sc[64 + lane] = __expf(gl - gi); if (lane == 0) sc[128] = __expf(gl); }
        __syncthreads();
#pragma unroll
        for (int t = 0; t < 4; ++t) { const int p = tid + 512 * t, d = p >> 10, off = (p & 1023) * 16;
            *(u32x4*)(rec + REC_DIR + d * REC_DIRSZ + off) = *(const LAS u32x4*)(lds + IMG_OFF + d * 16384 + off); }
        __syncthreads();
    }
#undef CP_LOADX
#undef CP_TASKID
#undef a
}

__device__ __forceinline__ bf16x8 pack44(const f32x4& lo, const f32x4& hi) {
    u32x4 p; p.x = pkbf_c(lo[0], lo[1]); p.y = pkbf_c(lo[2], lo[3]); p.z = pkbf_c(hi[0], hi[1]); p.w = pkbf_c(hi[2], hi[3]);
    return __builtin_bit_cast(bf16x8, p);
}
template <int VAR>
__device__ __forceinline__ void phase_dn_scan(int l, LAS unsigned char* lds) {
    const KArgs ap = get_args();
#define a (*ap)
    const int tid = fresh_tid(), lane = tid & 63, wave = __builtin_amdgcn_readfirstlane(tid >> 6), bx = fresh_bx();
    unsigned char* ws = a.ws;
    if (bx >= 32) return;
    const int chain = bx >> 1, half = bx & 1, b = chain >> 3, h = (chain >> 1) & 3, dir = chain & 1;
    const unsigned char* recb = ws + WS_REC + (size_t)((b * 4 + h) * NCH) * REC_BYTES;
    constexpr int BUFSZ = 74752;
#define CIDX(n) (dir ? ((n) < 4 ? 3 - (n) : 263 - (n)) : (n))
    if (wave >= 4) {
        const int sw = wave - 4;
#define DN_PIECE(i_) ((sw + 4 * (i_)) < 73 ? (sw + 4 * (i_)) : 72)
#define DN_SRC(rec_, p_) ((p_) < 48 ? (rec_) + (p_) * 1024 : (p_) < 65 ? (rec_) + REC_DIR + dir * REC_DIRSZ + ((p_) - 48) * 1024 : (rec_) + REC_V + half * 8192 + ((p_) - 65) * 1024)
#define DN_STAGE(n, bi) do { const unsigned char* rec_ = recb + (size_t)CIDX(n) * REC_BYTES; _Pragma("unroll") for (int i_ = 0; i_ < 19; ++i_) { const int p_ = DN_PIECE(i_); \
        __builtin_amdgcn_global_load_lds((const unsigned*)(DN_SRC(rec_, p_) + lane * 16), (LAS unsigned*)(lds + (bi) * BUFSZ + p_ * 1024), 16, 0, 0); } } while (0)
#define DN_SYNC() do { asm volatile("s_waitcnt vmcnt(0)" ::: "memory"); __builtin_amdgcn_s_barrier(); asm volatile("" ::: "memory"); } while (0)
        if (VAR != 3) DN_STAGE(0, 0);
        DN_SYNC();
        for (int n = 0; n < NCH; ++n) {
            if (VAR != 3 && n + 1 < NCH) DN_STAGE(n + 1, (n + 1) & 1);
            DN_SYNC();
        }
#undef DN_STAGE
#undef DN_PIECE
#undef DN_SRC
#undef DN_SYNC
    } else {
        const int sl = half * 4 + wave, c16 = lane & 15, g4 = lane >> 4;
        float* Og = (float*)(ws + (dir ? WS_OB : WS_OF)) + h * 128 + sl * 16 + c16;
        f32x4 S[8];
#pragma unroll
        for (int i = 0; i < 8; ++i) S[i] = (f32x4){0.f, 0.f, 0.f, 0.f};
        asm volatile("s_waitcnt lgkmcnt(0)" ::: "memory"); __builtin_amdgcn_s_barrier(); asm volatile("" ::: "memory");
        for (int n = 0; n < NCH; ++n) {
            if (VAR == 2) { asm volatile("s_waitcnt lgkmcnt(0)" ::: "memory"); __builtin_amdgcn_s_barrier(); asm volatile("" ::: "memory"); continue; }
            const LAS unsigned char* buf = lds + (n & 1) * BUFSZ;
            const int cidx = CIDX(n);
            const u32x4 vc0 = *(const LAS u32x4*)(buf + 66560 + wave * 2048 + lane * 32), vc1 = *(const LAS u32x4*)(buf + 66560 + wave * 2048 + lane * 32 + 16);
#define FR(off, f) (*(const LAS bf16x8*)(buf + (off) + (f) * 1024 + lane * 16))
#define MF(A, B, C) __builtin_amdgcn_mfma_f32_16x16x32_bf16((A), (B), (C), 0, 0, 0)
#define SB_() __builtin_amdgcn_sched_barrier(0)
            bf16x8 fa[8], fb[8];
            f32x4 eg[4], dl[4];
#pragma unroll
            for (int mt = 0; mt < 4; ++mt) { eg[mt] = *(const LAS f32x4*)(buf + 65536 + (16 * mt + 4 * g4) * 4); dl[mt] = *(const LAS f32x4*)(buf + 65536 + 256 + (16 * mt + 4 * g4) * 4); }
            const float egl = *(const LAS float*)(buf + 65536 + 512);
#define RD_KQ(dst, q) do { _Pragma("unroll") for (int mt = 0; mt < 4; ++mt) { dst[mt] = FR(0, mt * 4 + (q)); dst[4 + mt] = FR(32768, mt * 4 + (q)); } } while (0)
#define MM_KQ(src, q) do { _Pragma("unroll") for (int mt = 0; mt < 4; ++mt) { X[mt] = MF(src[mt], Sb[q], X[mt]); O[mt] = MF(src[4 + mt], Sb[q], O[mt]); } } while (0)
            f32x4 X[4], O[4], VN[4];
#pragma unroll
            for (int i = 0; i < 4; ++i) { X[i] = (f32x4){0.f, 0.f, 0.f, 0.f}; O[i] = (f32x4){0.f, 0.f, 0.f, 0.f}; VN[i] = (f32x4){0.f, 0.f, 0.f, 0.f}; }
            bf16x8 Sb[4];
#pragma unroll
            for (int q = 0; q < 4; ++q) Sb[q] = pack44(S[2 * q], S[2 * q + 1]);
            RD_KQ(fa, 0); SB_();
            RD_KQ(fb, 1); SB_(); MM_KQ(fa, 0); SB_();
            RD_KQ(fa, 2); SB_(); MM_KQ(fb, 1); SB_();
            RD_KQ(fb, 3); SB_(); MM_KQ(fa, 2); SB_();
#pragma unroll
            for (int i = 0; i < 8; ++i) fa[i] = FR(49152, i);
            SB_(); MM_KQ(fb, 3); SB_();
#pragma unroll
            for (int mt = 0; mt < 4; ++mt) { const unsigned w0 = (mt < 2 ? vc0 : vc1)[2 * (mt & 1)], w1 = (mt < 2 ? vc0 : vc1)[2 * (mt & 1) + 1];
                X[mt][0] = bflo(w0) - eg[mt][0] * X[mt][0]; X[mt][1] = bfhi(w0) - eg[mt][1] * X[mt][1]; X[mt][2] = bflo(w1) - eg[mt][2] * X[mt][2]; X[mt][3] = bfhi(w1) - eg[mt][3] * X[mt][3]; }
            const bf16x8 Yb0 = pack44(X[0], X[1]), Yb1 = pack44(X[2], X[3]);
            SB_();
#pragma unroll
            for (int i = 0; i < 8; ++i) fb[i] = FR(57344, i);
            SB_();
#pragma unroll
            for (int mt = 0; mt < 4; ++mt) { VN[mt] = MF(fa[mt * 2], Yb0, VN[mt]); VN[mt] = MF(fa[mt * 2 + 1], Yb1, VN[mt]); }
            SB_();
#pragma unroll
            for (int mt = 0; mt < 4; ++mt) O[mt] = O[mt] * eg[mt];
            const bf16x8 Vb0 = pack44(VN[0], VN[1]), Vb1 = pack44(VN[2], VN[3]);
            SB_();
#pragma unroll
            for (int i = 0; i < 8; ++i) fa[i] = FR(16384, i);
            SB_();
#pragma unroll
            for (int mt = 0; mt < 4; ++mt) { O[mt] = MF(fb[mt * 2], Vb0, O[mt]); O[mt] = MF(fb[mt * 2 + 1], Vb1, O[mt]); }
            SB_();
#pragma unroll
            for (int mt = 0; mt < 4; ++mt) VN[mt] = VN[mt] * dl[mt];
            const bf16x8 Vd0 = pack44(VN[0], VN[1]), Vd1 = pack44(VN[2], VN[3]);
#pragma unroll
            for (int i = 0; i < 8; ++i) S[i] = S[i] * egl;
            SB_();
#pragma unroll
            for (int i = 0; i < 8; ++i) fb[i] = FR(16384, 8 + i);
            SB_();
#pragma unroll
            for (int i = 0; i < 4; ++i) { S[i] = MF(fa[i * 2], Vd0, S[i]); S[i] = MF(fa[i * 2 + 1], Vd1, S[i]); }
            SB_();
#pragma unroll
            for (int i = 0; i < 4; ++i) { S[4 + i] = MF(fb[i * 2], Vd0, S[4 + i]); S[4 + i] = MF(fb[i * 2 + 1], Vd1, S[4 + i]); }
            SB_();
            {
                const int row0 = cidx < 4 ? ML + b * CT + cidx * 64 : b * T + (cidx - 4) * 64;
                float* op = Og + (size_t)(row0 + 4 * g4) * 512;
#pragma unroll
                for (int mt = 0; mt < 4; ++mt)
#pragma unroll
                    for (int t = 0; t < 4; ++t) { if (VAR != 1) op[(size_t)(16 * mt + t) * 512] = O[mt][t]; else asm volatile("" :: "v"(O[mt][t])); }
            }
#undef RD_KQ
#undef MM_KQ
#undef SB_
#undef FR
#undef MF
            asm volatile("s_waitcnt lgkmcnt(0)" ::: "memory"); __builtin_amdgcn_s_barrier(); asm volatile("" ::: "memory");
        }
    }
#undef CIDX
#undef a
}

__device__ __forceinline__ void phase_dn_out(int l) {
    const KArgs ap = get_args();
#define a (*ap)

    const int tid = fresh_tid(), lane = tid & 63, wave = __builtin_amdgcn_readfirstlane(tid >> 6), G = fresh_g(), bx = fresh_bx();
    unsigned char* ws = a.ws;
    const int nrows = (l == DEPTH - 1) ? ML : M;
    const float* OF = (const float*)(ws + WS_OF); const float* OB = (const float*)(ws + WS_OB);
    const bf16_t* P = (const bf16_t*)(ws + WS_P); bf16_t* CAT = (bf16_t*)(ws + WS_CAT);
    const f32x2 nw = *(const f32x2*)(a.in[I_DNW] + l * 128 + 2 * lane);
    const float* LSE = (const float*)(ws + WS_BA);
    for (int row = wave * G + bx; row < nrows; row += G * 8) {
        f32x2 of[4], ob[4]; unsigned gw[4];
#pragma unroll
        for (int hh = 0; hh < 4; ++hh) { of[hh] = *(const f32x2*)(OF + (size_t)row * 512 + hh * 128 + 2 * lane); ob[hh] = *(const f32x2*)(OB + (size_t)row * 512 + hh * 128 + 2 * lane);
            gw[hh] = *(const unsigned*)(P + (size_t)row * NP + 2560 + hh * 128 + 2 * lane); }
        u32x4 ap_[4]; float ls_[4];
#pragma unroll
        for (int p = 0; p < 4; ++p) { ap_[p] = (u32x4){0u, 0u, 0u, 0u}; ls_[p] = 0.f; }
        if (row < ML) {
            ap_[0] = *(const u32x4*)(CAT + (size_t)row * 1024 + 8 * lane); ap_[1] = *(const u32x4*)((const bf16_t*)(ws + WS_DQ) + (size_t)row * 512 + 8 * lane);
            ap_[2] = *(const u32x4*)((const bf16_t*)(ws + WS_DK) + (size_t)row * 512 + 8 * lane); ap_[3] = *(const u32x4*)((const bf16_t*)(ws + WS_DV) + (size_t)row * 512 + 8 * lane);
#pragma unroll
            for (int p = 0; p < 4; ++p) ls_[p] = LSE[((size_t)p * ML + row) * 4 + (lane >> 4)]; }
        float o0[4], o1[4], ssq[4];
#pragma unroll
        for (int hh = 0; hh < 4; ++hh) { o0[hh] = of[hh][0] + ob[hh][0]; o1[hh] = of[hh][1] + ob[hh][1]; ssq[hh] = o0[hh] * o0[hh] + o1[hh] * o1[hh]; }
#pragma unroll
        for (int hh = 0; hh < 4; ++hh) ssq[hh] = wave_sum(ssq[hh]);
        float mxv = 0.f;
#pragma unroll
        for (int hh = 0; hh < 4; ++hh) { const float rs = rsqrtf(ssq[hh] * (1.f / 128.f) + EPS); const float g0 = bflo(gw[hh]), g1 = bfhi(gw[hh]);
            o0[hh] = o0[hh] * rs * nw[0] * silu_f(g0); o1[hh] = o1[hh] * rs * nw[1] * silu_f(g1); mxv = fmaxf(mxv, fmaxf(fabsf(o0[hh]), fabsf(o1[hh]))); }
        float av[8];
        if (row < ML) { const float mx = fmaxf(fmaxf(ls_[0], ls_[1]), fmaxf(ls_[2], ls_[3]));
            float w_[4], wsum = 0.f;
#pragma unroll
            for (int p = 0; p < 4; ++p) { w_[p] = __expf(ls_[p] - mx); wsum += w_[p]; }
            const float inv = 1.f / wsum;
#pragma unroll
            for (int i = 0; i < 4; ++i) { float lo = 0.f, hi2 = 0.f;
#pragma unroll
                for (int p = 0; p < 4; ++p) { lo = fmaf(w_[p], bflo(ap_[p][i]), lo); hi2 = fmaf(w_[p], bfhi(ap_[p][i]), hi2); }
                av[2 * i] = lo * inv; av[2 * i + 1] = hi2 * inv; } }
        else { const u32x4 cw_ = *(const u32x4*)(CAT + (size_t)row * 1024 + 8 * lane);
#pragma unroll
            for (int i = 0; i < 4; ++i) { av[2 * i] = bflo(cw_[i]); av[2 * i + 1] = bfhi(cw_[i]); } }
#pragma unroll
        for (int i = 0; i < 8; ++i) mxv = fmaxf(mxv, fabsf(av[i]));
        mxv = fmaxf(wave_max(mxv), 1e-30f);
        const float cinv = 127.f / mxv;
        signed char* crow = (signed char*)(ws + WS_CATQ) + (size_t)row * 1024;
#define Q8_(x) ((unsigned)(int)rintf((x) * cinv) & 255u)
        { u32x2 o; o.x = Q8_(av[0]) | (Q8_(av[1]) << 8) | (Q8_(av[2]) << 16) | (Q8_(av[3]) << 24); o.y = Q8_(av[4]) | (Q8_(av[5]) << 8) | (Q8_(av[6]) << 16) | (Q8_(av[7]) << 24); *(u32x2*)(crow + 8 * lane) = o; }
#pragma unroll
        for (int hh = 0; hh < 4; ++hh) *(unsigned short*)(crow + 512 + hh * 128 + 2 * lane) = (unsigned short)(Q8_(o0[hh]) | (Q8_(o1[hh]) << 8));
#undef Q8_
        if (lane == 0) ((float*)(ws + WS_GB))[(1u << 18) + row] = mxv * (1.f / 127.f);
    }
#undef a
}

#define CE_DESC(a_, b_) do { const float hi_ = fmaxf(a_, b_), lo_ = fminf(a_, b_); a_ = hi_; b_ = lo_; } while (0)
__device__ __forceinline__ void bitonic_sort16_desc(float (&v)[16]) {
#pragma unroll
    for (int k = 2; k <= 16; k <<= 1)
#pragma unroll
        for (int j = k >> 1; j > 0; j >>= 1)
#pragma unroll
            for (int i = 0; i < 16; ++i) { const int p = i ^ j; if (p > i) { if ((i & k) == 0) CE_DESC(v[i], v[p]); else CE_DESC(v[p], v[i]); } }
}
__device__ __forceinline__ void merge_top16_desc(float (&lst)[16], const float (&nw)[16]) {
#pragma unroll
    for (int i = 0; i < 16; ++i) lst[i] = fmaxf(lst[i], nw[15 - i]);
#pragma unroll
    for (int j = 8; j > 0; j >>= 1)
#pragma unroll
        for (int i = 0; i < 16; ++i) { const int p = i ^ j; if (p > i) CE_DESC(lst[i], lst[p]); }
}
__device__ __forceinline__ void phase_peer_select(int l) {
    const KArgs ap = get_args();
#define a (*ap)
    const int tid = fresh_tid(), lane = tid & 63, wave = __builtin_amdgcn_readfirstlane(tid >> 6), G = fresh_g(), bx = fresh_bx();
    unsigned char* ws = a.ws;
    const int nrows = (l == DEPTH - 1) ? ML : M;
    const int ntask = (nrows / 32) * 4;
    const bf16_t* Q2 = (const bf16_t*)(ws + WS_P);
    const bf16_t* SKB = (const bf16_t*)(ws + WS_SKB) + (size_t)l * 8 * 2 * 128 * 128;
    int* PIDX = (int*)(ws + WS_PIDX); float* PGATE = (float*)(ws + WS_PGATE);
    const float NEG = -3.0e38f;
    const int r = lane & 31, hi = lane >> 5;
    for (int task = wave * G + bx; task < ntask; task += G * 8) {
        const int tg = task >> 2, hp = task & 3; const int row = tg * 32 + r;
        float mine0[16], mine1[16];
#pragma unroll
        for (int j = 0; j < 16; ++j) { mine0[j] = NEG; mine1[j] = NEG; }
        bf16x8 qA[8], kA[8];
        float lst[16];
#define SEL_QPTR(it_) (Q2 + (size_t)row * 2048 + (2 * hp + ((it_) >> 1)) * 256 + ((it_) & 1) * 128 + 8 * hi)
#define SEL_KPTR(it_, t_) (SKB + (size_t)(((2 * hp + ((it_) >> 1)) * 2 + ((it_) & 1)) * 128 + 32 * (t_) + r) * 128 + 8 * hi)
#define SEL_LDQ(dst, it_) do { const bf16_t* qp_ = SEL_QPTR(it_); _Pragma("unroll") for (int ks = 0; ks < 8; ++ks) dst[ks] = *(const bf16x8*)(qp_ + 16 * ks); } while (0)
#define SEL_LDK(dst, it_, t_) do { const bf16_t* kp_ = SEL_KPTR(it_, t_); _Pragma("unroll") for (int ks = 0; ks < 8; ++ks) dst[ks] = *(const bf16x8*)(kp_ + 16 * ks); } while (0)
#define SEL_RANK(qv, kv, t_) do { f32x16 acc = {}; _Pragma("unroll") for (int ks = 0; ks < 8; ++ks) acc = __builtin_amdgcn_mfma_f32_32x32x16_bf16(kv[ks], qv[ks], acc, 0, 0, 0); \
            const unsigned kb = (unsigned)(32 * (t_) + 4 * hi); float nw_[16]; \
            _Pragma("unroll") for (int i = 0; i < 16; ++i) nw_[i] = __uint_as_float((__float_as_uint(acc[i]) & 0xffffff80u) | (kb + (unsigned)((i & 3) + 8 * (i >> 2)))); \
            bitonic_sort16_desc(nw_); merge_top16_desc(lst, nw_); } while (0)
#define SB_() __builtin_amdgcn_sched_barrier(0)
#pragma unroll
        for (int j = 0; j < 16; ++j) lst[j] = NEG;
#pragma unroll 1
        for (int it = 0; it < 4; ++it) {
            SEL_LDQ(qA, it);
#pragma unroll 1
            for (int t = 0; t < 4; ++t) { SEL_LDK(kA, it, t); SEL_RANK(qA, kA, t); }
            float oth[16];
#pragma unroll
            for (int j = 0; j < 16; ++j) { auto rr = __builtin_amdgcn_permlane32_swap(__float_as_uint(lst[j]), __float_as_uint(lst[j]), false, false); oth[j] = __uint_as_float(hi ? rr[0] : rr[1]); }
            merge_top16_desc(lst, oth);
            const bool k0 = ((it >> 1) == hi) && ((it & 1) == 0), k1 = ((it >> 1) == hi) && ((it & 1) == 1);
#pragma unroll
            for (int j = 0; j < 16; ++j) { mine0[j] = k0 ? lst[j] : mine0[j]; mine1[j] = k1 ? lst[j] : mine1[j]; lst[j] = NEG; }
        }
#undef SB_
#undef SEL_QPTR
#undef SEL_KPTR
#undef SEL_LDQ
#undef SEL_LDK
#undef SEL_RANK
        const int h = 2 * hp + hi;
        float ts[16];
#pragma unroll
        for (int j = 0; j < 16; ++j) ts[j] = NEG;
#pragma unroll
        for (int i = 0; i < 16; ++i)
#pragma unroll
            for (int j = 0; j < 16; ++j) if ((i + 1) * (j + 1) <= 16) {
                const unsigned b0 = __float_as_uint(mine0[i]), b1 = __float_as_uint(mine1[j]);
                const float c = __uint_as_float(b0 & 0xffffff80u) + __uint_as_float(b1 & 0xffffff80u);
                float x = __uint_as_float((__float_as_uint(c) & 0xffffc000u) | ((b0 & 127u) << 7) | (b1 & 127u));
#pragma unroll
                for (int t = 0; t < 16; ++t) { const float hv = fmaxf(ts[t], x); x = fminf(ts[t], x); ts[t] = hv; }
            }
        int te[16]; float ex[16], sum = 0.f;
        const float tmax = __uint_as_float(__float_as_uint(ts[0]) & 0xffffc000u);
#pragma unroll
        for (int t = 0; t < 16; ++t) { const unsigned bt = __float_as_uint(ts[t]); te[t] = (int)(bt & 0x3fffu); ex[t] = __expf(__uint_as_float(bt & 0xffffc000u) - tmax); sum += ex[t]; }
        const float inv = 1.f / sum;
        int* ip = PIDX + (size_t)row * 128 + h * 16; float* gp = PGATE + (size_t)row * 128 + h * 16;
#pragma unroll
        for (int t = 0; t < 16; t += 4) { *(u32x4*)(ip + t) = (u32x4){(unsigned)te[t], (unsigned)te[t + 1], (unsigned)te[t + 2], (unsigned)te[t + 3]}; *(f32x4*)(gp + t) = (f32x4){ex[t] * inv, ex[t + 1] * inv, ex[t + 2] * inv, ex[t + 3] * inv}; }
    }
#undef a
}

template <bool WR, int GV = 0>
__device__ __forceinline__ void phase_peer_gather(int l, LAS unsigned char* lds) {
    const KArgs ap = get_args();
#define a (*ap)
    const int tid = fresh_tid(), lane = tid & 63, wave = __builtin_amdgcn_readfirstlane(tid >> 6), G = fresh_g(), bx = fresh_bx();
    unsigned char* ws = a.ws;
    const int nrows = (l == DEPTH - 1) ? ML : M;
    const unsigned char* UB = ws + WS_UB + (size_t)(l & 1) * TAB_SET; const unsigned char* VB = UB + 1024;
    const float* USC = (const float*)(ws + WS_USC) + (l & 1) * 2 * NEXP; const float* VSC = USC + NEXP;
    const int* PIDX = (const int*)(ws + WS_PIDX); const float* PGATE = (const float*)(ws + WS_PGATE);
    const float* modl = (const float*)(ws + WS_MOD) + (size_t)l * 3 * 6144 + 5120;
    const bool fuse = WR && (l + 1 < DEPTH);
    LAS float* wsk = (LAS float*)lds;
    if (fuse) { const float* src = (const float*)(ws + WS_WSK) + (size_t)(l + 1) * 16384; for (int i = tid; i < 16384 / 4; i += 512) ((LAS f32x4*)wsk)[i] = ((const f32x4*)src)[i]; __syncthreads(); }
    const float* nw1 = a.in[I_N1W] + (l + 1 < DEPTH ? l + 1 : l) * 1024 + 16 * lane;
    const float* modn = (const float*)(ws + WS_MOD) + (size_t)(l + 1 < DEPTH ? l + 1 : l) * 3 * 6144;
    for (int row = wave * G + bx; row < nrows; row += G * 8) {
        float hv[16], out[16];
        { const u32x4 hw = *(const u32x4*)((const signed char*)(ws + WS_H) + (size_t)row * D + 16 * lane); const float hsc = ((const float*)(ws + WS_GB))[row];
#pragma unroll
          for (int q = 0; q < 4; ++q) { const int w = (int)hw[q]; hv[4 * q + 0] = (float)((w << 24) >> 24) * hsc; hv[4 * q + 1] = (float)((w << 16) >> 24) * hsc; hv[4 * q + 2] = (float)((w << 8) >> 24) * hsc; hv[4 * q + 3] = (float)(w >> 24) * hsc; } }
        float hs = 0.f;
#pragma unroll
        for (int i = 0; i < 16; ++i) { out[i] = 0.f; hs += hv[i]; }
        const float hsum128 = 128.f * wave_sum(hs);
        float wacc = 0.f;
        const int id0 = PIDX[(size_t)row * 128 + lane], id1 = PIDX[(size_t)row * 128 + 64 + lane];
        const float gt0 = PGATE[(size_t)row * 128 + lane], gt1 = PGATE[(size_t)row * 128 + 64 + lane];
        const float us0 = USC[id0], us1 = USC[id1], vs0 = VSC[id0], vs1 = VSC[id1];
        for (int e0 = 0; e0 < 128; e0 += 8) {
            u32x4 uw[8], vw[8]; float gte[8], use[8], vse[8];
#pragma unroll
            for (int j = 0; j < 8; ++j) { const int e = e0 + j; const int id = __builtin_amdgcn_readlane(e0 < 64 ? id0 : id1, e & 63);
                gte[j] = __builtin_bit_cast(float, __builtin_amdgcn_readlane(__builtin_bit_cast(int, e0 < 64 ? gt0 : gt1), e & 63));
                use[j] = __builtin_bit_cast(float, __builtin_amdgcn_readlane(__builtin_bit_cast(int, e0 < 64 ? us0 : us1), e & 63));
                vse[j] = __builtin_bit_cast(float, __builtin_amdgcn_readlane(__builtin_bit_cast(int, e0 < 64 ? vs0 : vs1), e & 63));
                uw[j] = *(const u32x4*)(UB + (size_t)id * 2048 + 16 * lane); vw[j] = *(const u32x4*)(VB + (size_t)id * 2048 + 16 * lane); }
#pragma unroll
            for (int j = 0; j < 8; ++j) {
                float d0 = 0.f, d1 = 0.f;
#pragma unroll
                for (int q = 0; q < 4; ++q) { const unsigned w = uw[j][q];
                    d0 = fmaf((float)(w & 255u), hv[4 * q + 0], d0); d1 = fmaf((float)((w >> 8) & 255u), hv[4 * q + 1], d1);
                    d0 = fmaf((float)((w >> 16) & 255u), hv[4 * q + 2], d0); d1 = fmaf((float)(w >> 24), hv[4 * q + 3], d1); }
                const float dsum = (wave_sum(d0 + d1) - hsum128) * use[j];
                const float act = 0.5f * dsum * (1.f + erff(dsum * 0.70710678118654752f));
                const float wgt = gte[j] * act * vse[j];
                wacc += wgt;
                if (GV == 1) { asm volatile("" :: "v"(vw[j])); out[0] += wgt; } else
#pragma unroll
                for (int q = 0; q < 4; ++q) { const unsigned w = vw[j][q];
                    out[4 * q + 0] = fmaf(wgt, (float)(w & 255u), out[4 * q + 0]); out[4 * q + 1] = fmaf(wgt, (float)((w >> 8) & 255u), out[4 * q + 1]);
                    out[4 * q + 2] = fmaf(wgt, (float)((w >> 16) & 255u), out[4 * q + 2]); out[4 * q + 3] = fmaf(wgt, (float)(w >> 24), out[4 * q + 3]); }
            }
        }
        const float corr = 128.f * wacc;
        float* xr; int mrow;
        if (row < ML) { xr = a.out + (size_t)row * D; mrow = row >= T ? 1 : 0; } else { xr = (float*)(ws + WS_CTXX) + (size_t)(row - ML) * D; mrow = 2; }
        const float* g2 = modl + mrow * 6144 + 16 * lane;
        f32x4 xn[4];
#pragma unroll
        for (int i = 0; i < 4; ++i) { const f32x4 x = *(const f32x4*)(xr + 16 * lane + 4 * i), g = *(const f32x4*)(g2 + 4 * i);
            xn[i] = x + g * (f32x4){out[4 * i] - corr, out[4 * i + 1] - corr, out[4 * i + 2] - corr, out[4 * i + 3] - corr};
            if (WR) *(f32x4*)(xr + 16 * lane + 4 * i) = xn[i]; else asm volatile("" :: "v"(xn[i])); }
        if (fuse) {
            float ss = 0.f;
#pragma unroll
            for (int i = 0; i < 4; ++i) ss += (xn[i][0] * xn[i][0] + xn[i][1] * xn[i][1]) + (xn[i][2] * xn[i][2] + xn[i][3] * xn[i][3]);
            const float rstd = rsqrtf(wave_sum(ss) * (1.f / D) + EPS);
            const float* md = modn + mrow * 6144 + 16 * lane;
#pragma unroll
            for (int i = 0; i < 4; ++i) { const f32x4 nwv = *(const f32x4*)(nw1 + 4 * i), sc = *(const f32x4*)(md + 1024 + 4 * i), sh = *(const f32x4*)(md + 4 * i);
                xn[i] = xn[i] * rstd * nwv * (sc + 1.f) + sh; }
            { float hmx = 0.f;
#pragma unroll
              for (int i = 0; i < 4; ++i) hmx = fmaxf(hmx, fmaxf(fmaxf(fabsf(xn[i][0]), fabsf(xn[i][1])), fmaxf(fabsf(xn[i][2]), fabsf(xn[i][3]))));
              hmx = fmaxf(wave_max(hmx), 1e-30f); const float hinv = 127.f / hmx;
              u32x4 o;
#pragma unroll
              for (int i = 0; i < 4; ++i) o[i] = ((unsigned)(int)rintf(xn[i][0] * hinv) & 255u) | (((unsigned)(int)rintf(xn[i][1] * hinv) & 255u) << 8) | (((unsigned)(int)rintf(xn[i][2] * hinv) & 255u) << 16) | (((unsigned)(int)rintf(xn[i][3] * hinv) & 255u) << 24);
              *(u32x4*)((signed char*)(ws + WS_H) + (size_t)row * D + 16 * lane) = o;
              if (lane == 0) ((float*)(ws + WS_GB))[row] = hmx * (1.f / 127.f); }
            float p[16];
#pragma unroll
            for (int c = 0; c < 16; ++c) { float q = 0.f;
#pragma unroll
                for (int i = 0; i < 4; ++i) { const f32x4 w = *(const LAS f32x4*)(wsk + c * 1024 + 16 * lane + 4 * i); q += (xn[i][0] * w[0] + xn[i][1] * w[1]) + (xn[i][2] * w[2] + xn[i][3] * w[3]); }
                p[c] = q; }
            { const bool hb = (lane & 32) != 0;
#pragma unroll
              for (int c = 0; c < 8; ++c) { const float keep = hb ? p[c + 8] : p[c], send = hb ? p[c] : p[c + 8]; p[c] = keep + lane_xor<32>(send); } }
            { const bool hb = (lane & 16) != 0;
#pragma unroll
              for (int c = 0; c < 4; ++c) { const float keep = hb ? p[c + 4] : p[c], send = hb ? p[c] : p[c + 4]; p[c] = keep + lane_xor<16>(send); } }
            { const bool hb = (lane & 8) != 0;
#pragma unroll
              for (int c = 0; c < 2; ++c) { const float keep = hb ? p[c + 2] : p[c], send = hb ? p[c] : p[c + 2]; p[c] = keep + lane_xor<8>(send); } }
            { const bool hb = (lane & 4) != 0; const float keep = hb ? p[1] : p[0], send = hb ? p[0] : p[1]; p[0] = keep + lane_xor<4>(send); }
            p[0] += lane_xor<2>(p[0]); p[0] += lane_xor<1>(p[0]);
            if ((lane & 3) == 0) { const int c = ((lane >> 5) & 1) * 8 + ((lane >> 4) & 1) * 4 + ((lane >> 3) & 1) * 2 + ((lane >> 2) & 1); ((float*)(ws + WS_BA))[(size_t)row * 16 + c] = p[0]; }
        }
    }
    if (fuse) __syncthreads();
}
#undef a
constexpr size_t WS_PART = WS_P;
static_assert(WS_PART + 8 * (size_t)M * 1024 * 2 <= WS_GB, "partials region");
constexpr int GP_ITEM = 16;
struct GpMeta { int id0, id1; float gt0, gt1; u32x4 hw; float hsc; };
__device__ __forceinline__ void phase_peer_gpart(int l, LAS unsigned char* lds) {
    const KArgs ap = get_args();
#define a (*ap)
    const int tid = fresh_tid(), lane = tid & 63, wave = __builtin_amdgcn_readfirstlane(tid >> 6);
    unsigned char* ws = a.ws;
    const int nrows = (l == DEPTH - 1) ? ML : M;
    const int nitem = nrows / GP_ITEM;
    const unsigned char* UB = ws + WS_UB + (size_t)(l & 1) * TAB_SET; const unsigned char* VB = UB + 1024;
    const f32x2* SC2 = (const f32x2*)(ws + WS_USC) + (size_t)(l & 1) * NEXP;
    const int* PIDX = (const int*)(ws + WS_PIDX); const float* PGATE = (const float*)(ws + WS_PGATE);
    LAS u32x4* lst0 = (LAS u32x4*)lds + wave * 256;
    const int eidx = ((lane >> 5) & 1) * 4 + ((lane >> 4) & 1) * 2 + ((lane >> 3) & 1);
    const int x = (int)(xb_xcc_id() & 7u);
#define GP_LOAD_META(m_, row_) do { const int rw_ = (row_); (m_).id0 = PIDX[(size_t)rw_ * 128 + lane]; (m_).id1 = PIDX[(size_t)rw_ * 128 + 64 + lane]; (m_).gt0 = PGATE[(size_t)rw_ * 128 + lane]; (m_).gt1 = PGATE[(size_t)rw_ * 128 + 64 + lane]; \
        (m_).hw = *(const u32x4*)((const signed char*)(ws + WS_H) + (size_t)rw_ * D + 16 * lane); (m_).hsc = ((const float*)(ws + WS_GB))[rw_]; } while (0)
#define GP_LOAD_SC(sa_, sb_, m_) do { sa_ = (f32x2){0.f, 0.f}; sb_ = (f32x2){0.f, 0.f}; if (((m_).id0 >> 11) == p) sa_ = SC2[(m_).id0]; if (((m_).id1 >> 11) == p) sb_ = SC2[(m_).id1]; } while (0)
#define GP_BUILD(cnt_, m_, sa_, sb_, buf_) do { const bool s0_ = ((m_).id0 >> 11) == p, s1_ = ((m_).id1 >> 11) == p; const unsigned long long m0_ = __ballot(s0_), m1_ = __ballot(s1_); \
        const int c0_ = __builtin_popcountll(m0_); cnt_ = __builtin_amdgcn_readfirstlane(c0_ + __builtin_popcountll(m1_)); \
        const int r0_ = (int)__builtin_amdgcn_mbcnt_hi((unsigned)(m0_ >> 32), __builtin_amdgcn_mbcnt_lo((unsigned)m0_, 0u)); \
        const int r1_ = c0_ + (int)__builtin_amdgcn_mbcnt_hi((unsigned)(m1_ >> 32), __builtin_amdgcn_mbcnt_lo((unsigned)m1_, 0u)); \
        LAS u32x4* lb_ = lst0 + (buf_) * 128; \
        if (s0_) lb_[r0_] = (u32x4){(unsigned)(m_).id0, __float_as_uint((m_).gt0 * sa_[1]), __float_as_uint(sa_[0]), 0u}; \
        if (s1_) lb_[r1_] = (u32x4){(unsigned)(m_).id1, __float_as_uint((m_).gt1 * sb_[1]), __float_as_uint(sb_[0]), 0u}; } while (0)
#pragma unroll 1
    for (int pp = 0; pp < 8; ++pp) {
        const int p = (x + pp) & 7;
        unsigned* ctr = (unsigned*)(ws + WS_CTL) + 16384 + (l * 8 + p) * 64;
        unsigned* part = (unsigned*)(ws + WS_PART + (size_t)p * M * 2048);
        unsigned tk = 0; if (lane == 0) tk = __hip_atomic_fetch_add(ctr, 1u, __ATOMIC_RELAXED, __HIP_MEMORY_SCOPE_AGENT);
        int it = __builtin_amdgcn_readfirstlane((int)tk);
#pragma unroll 1
        while (it < nitem) {
            unsigned tn = 0; if (lane == 0) tn = __hip_atomic_fetch_add(ctr, 1u, __ATOMIC_RELAXED, __HIP_MEMORY_SCOPE_AGENT);
            const int row0 = it * GP_ITEM, rowl = row0 + GP_ITEM - 1;
            GpMeta m1, m2, m3; f32x2 sa1, sb1, sa2, sb2; int c_cur, c_nxt; u32x4 hw_cur; float hsc_cur;
            GP_LOAD_META(m1, row0); GP_LOAD_META(m2, min(row0 + 1, rowl)); GP_LOAD_META(m3, min(row0 + 2, rowl));
            GP_LOAD_SC(sa1, sb1, m1);
            GP_BUILD(c_cur, m1, sa1, sb1, 0); hw_cur = m1.hw; hsc_cur = m1.hsc;
            GP_LOAD_SC(sa1, sb1, m2);
            m1 = m2; m2 = m3;
            GP_LOAD_META(m3, min(row0 + 3, rowl));
#pragma unroll 1
            for (int i = 0; i < GP_ITEM; ++i) {
                const int row = row0 + i;
                GP_BUILD(c_nxt, m1, sa1, sb1, (i + 1) & 1);
                const u32x4 hw_nxt = m1.hw; const float hsc_nxt = m1.hsc;
                GP_LOAD_SC(sa2, sb2, m2);
                m1 = m2; sa1 = sa2; sb1 = sb2; m2 = m3;
                GP_LOAD_META(m3, min(row + 4, rowl));
                LAS u32x4* lst = lst0 + (i & 1) * 128;
                const int c = c_cur; const u32x4 hw = hw_cur; const float hsc = hsc_cur;
                f32x2 o2[8];
#pragma unroll
                for (int k = 0; k < 8; ++k) o2[k] = (f32x2){0.f, 0.f};
                float wacc = 0.f;
#pragma unroll 1
                for (int e = 0; e < c; e += 8) {
                    u32x4 uw[8], vw[8];
#pragma unroll
                    for (int j = 0; j < 8; ++j) { const int sl = min(e + j, c - 1);
                        const int id = __builtin_amdgcn_readfirstlane((int)lst[sl][0]);
                        uw[j] = *(const u32x4*)(UB + (size_t)id * 2048 + 16 * lane); vw[j] = *(const u32x4*)(VB + (size_t)id * 2048 + 16 * lane); }
                    const int ms = e + eidx; const u32x4 en = lst[min(ms, c - 1)];
                    float pd[8];
#pragma unroll
                    for (int j = 0; j < 8; ++j) { int d = 0;
#pragma unroll
                        for (int q = 0; q < 4; ++q) d = __builtin_amdgcn_sdot4((int)uw[j][q], (int)hw[q], d, false);
                        pd[j] = (float)d; }
                    { const bool hb = (lane & 32) != 0;
#pragma unroll
                      for (int j = 0; j < 4; ++j) { const float keep = hb ? pd[j + 4] : pd[j], send = hb ? pd[j] : pd[j + 4]; pd[j] = keep + lane_xor<32>(send); } }
                    { const bool hb = (lane & 16) != 0;
#pragma unroll
                      for (int j = 0; j < 2; ++j) { const float keep = hb ? pd[j + 2] : pd[j], send = hb ? pd[j] : pd[j + 2]; pd[j] = keep + lane_xor<16>(send); } }
                    { const bool hb = (lane & 8) != 0; const float keep = hb ? pd[1] : pd[0], send = hb ? pd[0] : pd[1]; pd[0] = keep + lane_xor<8>(send); }
                    pd[0] += lane_xor<4>(pd[0]); pd[0] += lane_xor<2>(pd[0]); pd[0] += lane_xor<1>(pd[0]);
                    const float dsum = pd[0] * (__uint_as_float(en[2]) * hsc);
                    const float act = 0.5f * dsum * (1.f + erff(dsum * 0.70710678118654752f));
                    const float wgt = ms < c ? __uint_as_float(en[1]) * act : 0.f;
                    wacc += wgt;
#pragma unroll
                    for (int j = 0; j < 8; ++j) {
                        const float wj = __builtin_bit_cast(float, __builtin_amdgcn_readlane(__builtin_bit_cast(int, wgt), 32 * ((j >> 2) & 1) + 16 * ((j >> 1) & 1) + 8 * (j & 1)));
                        const f32x2 ww = {wj, wj};
#pragma unroll
                        for (int q = 0; q < 4; ++q) { const unsigned w = vw[j][q];
                            const f32x2 v01 = {(float)(w & 255u), (float)((w >> 8) & 255u)}, v23 = {(float)((w >> 16) & 255u), (float)(w >> 24)};
                            o2[2 * q] = __builtin_elementwise_fma(ww, v01, o2[2 * q]); o2[2 * q + 1] = __builtin_elementwise_fma(ww, v23, o2[2 * q + 1]); }
                    }
                }
                const float corr = 16.f * wave_sum(wacc);
                u32x4 w0, w1;
#pragma unroll
                for (int k = 0; k < 4; ++k) { w0[k] = pkbf_c(o2[k][0] - corr, o2[k][1] - corr); w1[k] = pkbf_c(o2[4 + k][0] - corr, o2[4 + k][1] - corr); }
                unsigned* dst = part + (size_t)row * 512 + 8 * lane;
                __builtin_nontemporal_store(w0, (u32x4*)dst); __builtin_nontemporal_store(w1, (u32x4*)(dst + 4));
                c_cur = c_nxt; hw_cur = hw_nxt; hsc_cur = hsc_nxt;
            }
            it = __builtin_amdgcn_readfirstlane((int)tn);
        }
    }
#undef GP_LOAD_META
#undef GP_LOAD_SC
#undef GP_BUILD
#undef a
}

__device__ __forceinline__ void phase_peer_combine(int l, LAS unsigned char* lds) {
    const KArgs ap = get_args();
#define a (*ap)
    const int tid = fresh_tid(), lane = tid & 63, wave = __builtin_amdgcn_readfirstlane(tid >> 6), G = fresh_g(), bx = fresh_bx();
    unsigned char* ws = a.ws;
    const int nrows = (l == DEPTH - 1) ? ML : M;
    const float* modl = (const float*)(ws + WS_MOD) + (size_t)l * 3 * 6144 + 5120;
    const bool fuse = (l + 1 < DEPTH);
    LAS float* wsk = (LAS float*)lds;
    if (fuse) { const float* src = (const float*)(ws + WS_WSK) + (size_t)(l + 1) * 16384; for (int i = tid; i < 16384 / 4; i += 512) ((LAS f32x4*)wsk)[i] = ((const f32x4*)src)[i]; __syncthreads(); }
    const float* nw1 = a.in[I_N1W] + (l + 1 < DEPTH ? l + 1 : l) * 1024 + 16 * lane;
    const float* modn = (const float*)(ws + WS_MOD) + (size_t)(l + 1 < DEPTH ? l + 1 : l) * 3 * 6144;
    for (int row = wave * G + bx; row < nrows; row += G * 8) {
        float out[16];
#pragma unroll
        for (int i = 0; i < 16; ++i) out[i] = 0.f;
#pragma unroll
        for (int p = 0; p < 8; ++p) { const unsigned* src = (const unsigned*)(ws + WS_PART + (size_t)p * M * 2048) + (size_t)row * 512 + 8 * lane;
            const u32x4 w0 = __builtin_nontemporal_load((const u32x4*)src), w1 = __builtin_nontemporal_load((const u32x4*)(src + 4));
#pragma unroll
            for (int k = 0; k < 4; ++k) { out[2 * k] += bflo(w0[k]); out[2 * k + 1] += bfhi(w0[k]); out[8 + 2 * k] += bflo(w1[k]); out[8 + 2 * k + 1] += bfhi(w1[k]); } }
        float* xr; int mrow;
        if (row < ML) { xr = a.out + (size_t)row * D; mrow = row >= T ? 1 : 0; } else { xr = (float*)(ws + WS_CTXX) + (size_t)(row - ML) * D; mrow = 2; }
        const float* g2 = modl + mrow * 6144 + 16 * lane;
        f32x4 xn[4];
#pragma unroll
        for (int i = 0; i < 4; ++i) { const f32x4 x = *(const f32x4*)(xr + 16 * lane + 4 * i), g = *(const f32x4*)(g2 + 4 * i);
            xn[i] = x + g * (f32x4){out[4 * i], out[4 * i + 1], out[4 * i + 2], out[4 * i + 3]};
            *(f32x4*)(xr + 16 * lane + 4 * i) = xn[i]; }
        if (fuse) {
            float ss = 0.f;
#pragma unroll
            for (int i = 0; i < 4; ++i) ss += (xn[i][0] * xn[i][0] + xn[i][1] * xn[i][1]) + (xn[i][2] * xn[i][2] + xn[i][3] * xn[i][3]);
            const float rstd = rsqrtf(wave_sum(ss) * (1.f / D) + EPS);
            const float* md = modn + mrow * 6144 + 16 * lane;
#pragma unroll
            for (int i = 0; i < 4; ++i) { const f32x4 nwv = *(const f32x4*)(nw1 + 4 * i), sc = *(const f32x4*)(md + 1024 + 4 * i), sh = *(const f32x4*)(md + 4 * i);
                xn[i] = xn[i] * rstd * nwv * (sc + 1.f) + sh; }
            { float hmx = 0.f;
#pragma unroll
              for (int i = 0; i < 4; ++i) hmx = fmaxf(hmx, fmaxf(fmaxf(fabsf(xn[i][0]), fabsf(xn[i][1])), fmaxf(fabsf(xn[i][2]), fabsf(xn[i][3]))));
              hmx = fmaxf(wave_max(hmx), 1e-30f); const float hinv = 127.f / hmx;
              u32x4 o;
#pragma unroll
              for (int i = 0; i < 4; ++i) o[i] = ((unsigned)(int)rintf(xn[i][0] * hinv) & 255u) | (((unsigned)(int)rintf(xn[i][1] * hinv) & 255u) << 8) | (((unsigned)(int)rintf(xn[i][2] * hinv) & 255u) << 16) | (((unsigned)(int)rintf(xn[i][3] * hinv) & 255u) << 24);
              *(u32x4*)((signed char*)(ws + WS_H) + (size_t)row * D + 16 * lane) = o;
              if (lane == 0) ((float*)(ws + WS_GB))[row] = hmx * (1.f / 127.f); }
            float p[16];
#pragma unroll
            for (int c = 0; c < 16; ++c) { float q = 0.f;
#pragma unroll
                for (int i = 0; i < 4; ++i) { const f32x4 w = *(const LAS f32x4*)(wsk + c * 1024 + 16 * lane + 4 * i); q += (xn[i][0] * w[0] + xn[i][1] * w[1]) + (xn[i][2] * w[2] + xn[i][3] * w[3]); }
                p[c] = q; }
            { const bool hb = (lane & 32) != 0;
#pragma unroll
              for (int c = 0; c < 8; ++c) { const float keep = hb ? p[c + 8] : p[c], send = hb ? p[c] : p[c + 8]; p[c] = keep + lane_xor<32>(send); } }
            { const bool hb = (lane & 16) != 0;
#pragma unroll
              for (int c = 0; c < 4; ++c) { const float keep = hb ? p[c + 4] : p[c], send = hb ? p[c] : p[c + 4]; p[c] = keep + lane_xor<16>(send); } }
            { const bool hb = (lane & 8) != 0;
#pragma unroll
              for (int c = 0; c < 2; ++c) { const float keep = hb ? p[c + 2] : p[c], send = hb ? p[c] : p[c + 2]; p[c] = keep + lane_xor<8>(send); } }
            { const bool hb = (lane & 4) != 0; const float keep = hb ? p[1] : p[0], send = hb ? p[0] : p[1]; p[0] = keep + lane_xor<4>(send); }
            p[0] += lane_xor<2>(p[0]); p[0] += lane_xor<1>(p[0]);
            if ((lane & 3) == 0) { const int c = ((lane >> 5) & 1) * 8 + ((lane >> 4) & 1) * 4 + ((lane >> 3) & 1) * 2 + ((lane >> 2) & 1); ((float*)(ws + WS_BA))[(size_t)row * 16 + c] = p[0]; }
        }
    }
    if (fuse) __syncthreads();
#undef a
}
constexpr size_t WS_PD = WS_REC;
constexpr size_t WS_PW = WS_REC + 8 * (size_t)M * 128 * 4;
constexpr size_t WS_PC = WS_PW + (size_t)M * 128;
static_assert(WS_PC + (size_t)M * 8 * 4 <= WS_END, "sliced gather scratch");
constexpr int GS_ITEM = 8;
template <int PH>
__device__ __forceinline__ void phase_peer_slice(int l, int cslot) {
    const KArgs ap = get_args();
#define a (*ap)
    const int tid = fresh_tid(), lane = tid & 63;
    unsigned char* ws = a.ws;
    const int nrows = (l == DEPTH - 1) ? ML : M;
    const int nitem = nrows / GS_ITEM;
    const unsigned char* TAB = ws + WS_UB + (size_t)(l & 1) * TAB_SET + (PH ? (size_t)NEXP * 1024 : 0);
    const int* PIDX = (const int*)(ws + WS_PIDX);
    const unsigned char* PW = ws + WS_PW; const float* PC = (const float*)(ws + WS_PC);
    const float* modl = (const float*)(ws + WS_MOD) + (size_t)l * 3 * 6144 + 5120;
    const int g = lane >> 3, i8 = lane & 7;
    const int x = (int)(xb_xcc_id() & 7u);
#pragma unroll 1
    for (int pp = 0; pp < 8; ++pp) {
        const int p = (x + pp) & 7;
        unsigned* ctr = (unsigned*)(ws + WS_CTL) + 16384 + ((l * 2 + PH) * 8 + p) * 64 + cslot * 8192;
        const unsigned char* tb = TAB + (size_t)p * NEXP * 128 + 16 * i8;
        unsigned tk = 0; if (lane == 0) tk = __hip_atomic_fetch_add(ctr, 1u, __ATOMIC_RELAXED, __HIP_MEMORY_SCOPE_AGENT);
        int it = __builtin_amdgcn_readfirstlane((int)tk);
#pragma unroll 1
        while (it < nitem) {
            unsigned tn = 0; if (lane == 0) tn = __hip_atomic_fetch_add(ctr, 1u, __ATOMIC_RELAXED, __HIP_MEMORY_SCOPE_AGENT);
            const int row0 = it * GS_ITEM, rowl = row0 + GS_ITEM - 1;
            u32x4 idc[4], idn[4], ra[8], rb[8]; u32x4 wc, wn; float sc_c, sc_n; u32x4 hc, hn;
#define GS_META(ids_, wts_, wsc_, h_, row_) do { const int rw_ = (row_); const u32x4* ip_ = (const u32x4*)(PIDX + (size_t)rw_ * 128 + 16 * g); _Pragma("unroll") for (int q_ = 0; q_ < 4; ++q_) ids_[q_] = ip_[q_]; \
                if (PH) { wts_ = *(const u32x4*)(PW + (size_t)rw_ * 128 + 16 * g); wsc_ = PC[(size_t)rw_ * 8 + g]; } \
                else h_ = *(const u32x4*)((const signed char*)(ws + WS_H) + (size_t)rw_ * D + 128 * p + 16 * i8); } while (0)
#define GS_ROWS(dst_, ids_, hf_) do { _Pragma("unroll") for (int k_ = 0; k_ < 8; ++k_) dst_[k_] = *(const u32x4*)(tb + (size_t)ids_[2 * (hf_) + (k_ >> 2)][k_ & 3] * 128); } while (0)
            GS_META(idc, wc, sc_c, hc, row0);
            GS_ROWS(ra, idc, 0);
            GS_META(idn, wn, sc_n, hn, min(row0 + 1, rowl));
#pragma unroll 1
            for (int i = 0; i < GS_ITEM; ++i) {
                const int row = row0 + i;
                GS_ROWS(rb, idc, 1);
                if (PH == 0) {
                    int d[16];
#pragma unroll
                    for (int k = 0; k < 8; ++k) { int s_ = 0;
#pragma unroll
                        for (int q = 0; q < 4; ++q) s_ = __builtin_amdgcn_sdot4((int)ra[k][q], (int)hc[q], s_, false);
                        d[k] = s_; }
                    GS_ROWS(ra, idn, 0);
#pragma unroll
                    for (int k = 0; k < 8; ++k) { int s_ = 0;
#pragma unroll
                        for (int q = 0; q < 4; ++q) s_ = __builtin_amdgcn_sdot4((int)rb[k][q], (int)hc[q], s_, false);
                        d[8 + k] = s_; }
#define GS_IX(v_, K_) __builtin_bit_cast(int, lane_xor<K_>(__builtin_bit_cast(float, v_)))
                    { const bool hb = (lane & 4) != 0;
#pragma unroll
                      for (int j = 0; j < 8; ++j) { const int keep = hb ? d[j + 8] : d[j], send = hb ? d[j] : d[j + 8]; d[j] = keep + GS_IX(send, 4); } }
                    { const bool hb = (lane & 2) != 0;
#pragma unroll
                      for (int j = 0; j < 4; ++j) { const int keep = hb ? d[j + 4] : d[j], send = hb ? d[j] : d[j + 4]; d[j] = keep + GS_IX(send, 2); } }
                    { const bool hb = (lane & 1) != 0;
#pragma unroll
                      for (int j = 0; j < 2; ++j) { const int keep = hb ? d[j + 2] : d[j], send = hb ? d[j] : d[j + 2]; d[j] = keep + GS_IX(send, 1); } }
#undef GS_IX
                    u32x2 o = {(unsigned)d[0], (unsigned)d[1]};
                    __builtin_nontemporal_store(o, (u32x2*)((int*)(ws + WS_PD) + ((size_t)p * M + row) * 128 + 2 * lane));
                } else {
                    int oi[16];
#pragma unroll
                    for (int k = 0; k < 16; ++k) oi[k] = 0;
#define GS_QUAD(rr_, qd_, wd_) do { _Pragma("unroll") for (int q_ = 0; q_ < 4; ++q_) { \
                        const unsigned r0_ = rr_[4 * (qd_) + 0][q_], r1_ = rr_[4 * (qd_) + 1][q_], r2_ = rr_[4 * (qd_) + 2][q_], r3_ = rr_[4 * (qd_) + 3][q_]; \
                        const unsigned t0_ = __builtin_amdgcn_perm(r1_, r0_, 0x05010400u), t1_ = __builtin_amdgcn_perm(r1_, r0_, 0x07030602u), t2_ = __builtin_amdgcn_perm(r3_, r2_, 0x05010400u), t3_ = __builtin_amdgcn_perm(r3_, r2_, 0x07030602u); \
                        oi[4 * q_ + 0] = __builtin_amdgcn_sdot4((int)__builtin_amdgcn_perm(t2_, t0_, 0x05040100u), (int)(wd_), oi[4 * q_ + 0], false); \
                        oi[4 * q_ + 1] = __builtin_amdgcn_sdot4((int)__builtin_amdgcn_perm(t2_, t0_, 0x07060302u), (int)(wd_), oi[4 * q_ + 1], false); \
                        oi[4 * q_ + 2] = __builtin_amdgcn_sdot4((int)__builtin_amdgcn_perm(t3_, t1_, 0x05040100u), (int)(wd_), oi[4 * q_ + 2], false); \
                        oi[4 * q_ + 3] = __builtin_amdgcn_sdot4((int)__builtin_amdgcn_perm(t3_, t1_, 0x07060302u), (int)(wd_), oi[4 * q_ + 3], false); } } while (0)
                    GS_QUAD(ra, 0, wc[0]); GS_QUAD(ra, 1, wc[1]);
                    GS_ROWS(ra, idn, 0);
                    GS_QUAD(rb, 0, wc[2]); GS_QUAD(rb, 1, wc[3]);
#undef GS_QUAD
                    float o[16];
#pragma unroll
                    for (int k = 0; k < 16; ++k) o[k] = (float)oi[k] * sc_c;
                    { const bool hb = (lane & 32) != 0;
#pragma unroll
                      for (int j = 0; j < 8; ++j) { const float keep = hb ? o[j + 8] : o[j], send = hb ? o[j] : o[j + 8]; o[j] = keep + lane_xor<32>(send); } }
                    { const bool hb = (lane & 16) != 0;
#pragma unroll
                      for (int j = 0; j < 4; ++j) { const float keep = hb ? o[j + 4] : o[j], send = hb ? o[j] : o[j + 4]; o[j] = keep + lane_xor<16>(send); } }
                    { const bool hb = (lane & 8) != 0;
#pragma unroll
                      for (int j = 0; j < 2; ++j) { const float keep = hb ? o[j + 2] : o[j], send = hb ? o[j] : o[j + 2]; o[j] = keep + lane_xor<8>(send); } }
                    const float corr = 0.f;
                    float* xr; int mrow;
                    if (row < ML) { xr = a.out + (size_t)row * D; mrow = row >= T ? 1 : 0; } else { xr = (float*)(ws + WS_CTXX) + (size_t)(row - ML) * D; mrow = 2; }
                    const int col = 128 * p + 16 * i8 + 2 * g;
                    const f32x2 g2 = *(const f32x2*)(modl + mrow * 6144 + col), xo = *(const f32x2*)(xr + col);
                    *(f32x2*)(xr + col) = (f32x2){xo[0] + g2[0] * (o[0] - corr), xo[1] + g2[1] * (o[1] - corr)};
                }
#pragma unroll
                for (int q = 0; q < 4; ++q) idc[q] = idn[q];
                if (PH) { wc = wn; sc_c = sc_n; } else hc = hn;
                GS_META(idn, wn, sc_n, hn, min(row + 2, rowl));
            }
#undef GS_META
#undef GS_ROWS
            it = __builtin_amdgcn_readfirstlane((int)tn);
        }
    }
#undef a
}
__device__ __forceinline__ void phase_peer_weights(int l) {
    const KArgs ap = get_args();
#define a (*ap)
    const int tid = fresh_tid(), lane = tid & 63, wave = __builtin_amdgcn_readfirstlane(tid >> 6), G = fresh_g(), bx = fresh_bx();
    unsigned char* ws = a.ws;
    const int nrows = (l == DEPTH - 1) ? ML : M;
    const f32x2* SC2 = (const f32x2*)(ws + WS_USC) + (size_t)(l & 1) * NEXP;
    const int* PIDX = (const int*)(ws + WS_PIDX); const float* PGATE = (const float*)(ws + WS_PGATE);
    for (int row = wave * G + bx; row < nrows; row += G * 8) {
        const u32x2 id = *(const u32x2*)(PIDX + (size_t)row * 128 + 2 * lane); const f32x2 gt = *(const f32x2*)(PGATE + (size_t)row * 128 + 2 * lane);
        const float hsc = ((const float*)(ws + WS_GB))[row];
        int d0 = 0, d1 = 0;
#pragma unroll
        for (int p = 0; p < 8; ++p) { const u32x2 v = __builtin_nontemporal_load((const u32x2*)((const int*)(ws + WS_PD) + ((size_t)p * M + row) * 128 + 2 * lane)); d0 += (int)v[0]; d1 += (int)v[1]; }
        const f32x2 s0 = SC2[id[0]], s1 = SC2[id[1]];
        const float x0 = (float)d0 * (s0[0] * hsc), x1 = (float)d1 * (s1[0] * hsc);
        const float w0 = gt[0] * s0[1] * (0.5f * x0 * (1.f + erff(x0 * 0.70710678118654752f))), w1 = gt[1] * s1[1] * (0.5f * x1 * (1.f + erff(x1 * 0.70710678118654752f)));
        float mx = fmaxf(fabsf(w0), fabsf(w1));
        mx = fmaxf(mx, lane_xor<1>(mx)); mx = fmaxf(mx, lane_xor<2>(mx)); mx = fmaxf(mx, lane_xor<4>(mx));
        mx = fmaxf(mx, 1e-30f); const float inv = 127.f / mx;
        *(unsigned short*)(ws + WS_PW + (size_t)row * 128 + 2 * lane) = (unsigned short)(((unsigned)(int)rintf(w0 * inv) & 255u) | (((unsigned)(int)rintf(w1 * inv) & 255u) << 8));
        if ((lane & 7) == 0) ((float*)(ws + WS_PC))[(size_t)row * 8 + (lane >> 3)] = mx * (1.f / 127.f);
    }
#undef a
}

__global__ void __launch_bounds__(512, 2) fwd(Args a) {
    extern __shared__ __attribute__((aligned(16))) unsigned char lds_raw[];
    LAS unsigned char* lds = (LAS unsigned char*)lds_raw;
    volatile LAS unsigned* MISC = (volatile LAS unsigned*)(lds + LDS_MISC);
    if (threadIdx.x < 16) MISC[threadIdx.x] = 0u;
    __syncthreads();
    XcdBarrier bar; bar.bar = (unsigned*)(a.ws + WS_CTL) + 4096; bar.x = 0; bar.st = MISC + 8;
    bar = xcd_barrier_post((unsigned*)(a.ws + WS_CTL) + 4096, MISC + 8);
#ifndef PHASE_MASK
#define PHASE_MASK 0x1FFF
#endif
#define EN(i) ((PHASE_MASK >> (i)) & 1)
#ifndef REP_MASK
#define REP_MASK 0
#endif
#define REPN(i) (1 + ((REP_MASK >> (i)) & 1))
#define IN(k) true
#define SEAM(k) do { XcdBarrier b_; b_.bar = (unsigned*)(get_args()->ws + WS_CTL) + 4096; b_.x = xb_xcc_id(); b_.st = (volatile LAS unsigned*)(lds + LDS_MISC) + 8; xcd_barrier(b_); } while (0)
    for (int rep_ = 0; rep_ < (REPN(0)); ++rep_) if (EN(0) && IN(0)) phase_prologue(lds);
    SEAM(0);
#pragma unroll 1
    for (int l_ = 0; l_ < DEPTH; ++l_) {
        int l = l_; asm volatile("" : "+s"(l));
        const int pb = 1 + l * NPH_L;
        const int mrows = (l == DEPTH - 1) ? ML : M;
        if (l == 0) { for (int rep_ = 0; rep_ < (REPN(1)); ++rep_) if (EN(1) && IN(pb + 0)) { phase_norm<true>(l, 0, lds); phase_quant_weights(lds); }
            SEAM(pb + 0); }
        for (int rep_ = 0; rep_ < (REPN(2)); ++rep_) if (EN(2) && IN(pb + 1)) { const KArgs ap = get_args(); unsigned char* ws = ap->ws; pg8::Gemm g{(const bf16_t*)(ws + WS_H), (const bf16_t*)((const signed char*)(ws + WS_WINT) + (size_t)l * NP * 1024), M, NP, 512}; pg8::StaticOrder S; S.init(M, NP, fresh_g(), fresh_bx());
            pg8::EpiBf16I8 E{(bf16_t*)(ws + WS_P), NP, (const float*)(ws + WS_GB), (const float*)(ws + WS_CTL) + CW_WMAX + (l * 3 + 0) * 3072}; pg8::gemm_phase(lds, g, S, E); }
        SEAM(pb + 1);
        for (int rep_ = 0; rep_ < (REPN(3)); ++rep_) if (EN(3) && IN(pb + 2)) { phase_dn_chunkprep<1>(l, lds); phase_prep(l, lds); }
        for (int rep_ = 0; rep_ < (REPN(4)); ++rep_) if (EN(4) && IN(pb + 3)) phase_dn_chunkprep<0>(l, lds);
        SEAM(pb + 3);
        for (int rep_ = 0; rep_ < (REPN(5)); ++rep_) if (EN(5) && IN(pb + 4)) { phase_dn_scan<0>(l, lds); __syncthreads(); phase_attn(l, lds_raw, MISC, rep_); }
        SEAM(pb + 4);
        for (int rep_ = 0; rep_ < (REPN(7)); ++rep_) if (EN(7) && IN(pb + 5)) phase_dn_out(l);
        SEAM(pb + 5);
        if (EN(8) && IN(pb + 6)) { const KArgs ap = get_args(); unsigned char* ws = ap->ws; pg8::Gemm g{(const bf16_t*)(ws + WS_CATQ), (const bf16_t*)((const signed char*)(ws + WS_WOUTT) + (size_t)l * 1024 * 1024), mrows, 1024, 512}; pg8::StaticOrder S; S.init(mrows, 1024, fresh_g(), fresh_bx());
            pg8::EpiResI8 E{l == 0 ? ap->in[I_X] : ap->out, l == 0 ? ap->in[I_CTX] : (const float*)(ws + WS_CTXX), ap->out, (float*)(ws + WS_CTXX), (const float*)(ws + WS_MOD) + (size_t)l * 3 * 6144 + 2048,
                              (const float*)(ws + WS_GB) + (1u << 18), (const float*)(ws + WS_CTL) + CW_WMAX + (l * 3 + 1) * 3072};
            pg8::gemm_phase(lds, g, S, E); }
        SEAM(pb + 6);
        for (int rep_ = 0; rep_ < (REPN(9)); ++rep_) if (EN(9) && IN(pb + 7)) phase_norm<false>(l, 1, lds);
        SEAM(pb + 7);
        for (int rep_ = 0; rep_ < (REPN(10)); ++rep_) if (EN(10) && IN(pb + 8)) { const KArgs ap = get_args(); unsigned char* ws = ap->ws; pg8::Gemm g{(const bf16_t*)(ws + WS_H), (const bf16_t*)((const signed char*)(ws + WS_WQT) + (size_t)l * 2048 * 1024), mrows, 2048, 512}; pg8::StaticOrder S; S.init(mrows, 2048, fresh_g(), fresh_bx());
            pg8::EpiBf16I8 E{(bf16_t*)(ws + WS_P), 2048, (const float*)(ws + WS_GB), (const float*)(ws + WS_CTL) + CW_WMAX + (l * 3 + 2) * 3072}; pg8::gemm_phase(lds, g, S, E); }
        SEAM(pb + 8);
        for (int rep_ = 0; rep_ < (REPN(11)); ++rep_) if (EN(11) && IN(pb + 9)) phase_peer_select(l);
        SEAM(pb + 9);
        #ifdef GATHER_VAR
        if (EN(12) && IN(pb + 10)) phase_peer_gather<false, GATHER_VAR>(l, lds);
#endif
#if GATHER_PART == 2
        if (EN(12) && IN(pb + 10)) phase_peer_slice<0>(l, 0);
        SEAM(pb + 10);
        if (EN(12) && IN(pb + 10)) phase_peer_weights(l);
        SEAM(pb + 10);
        if (EN(12) && IN(pb + 10)) phase_peer_slice<1>(l, 0);
        if (l + 1 < DEPTH) { SEAM(pb + 10); if (EN(12) && IN(pb + 10)) phase_norm<true>(l + 1, 0, lds); }
#elif GATHER_PART
        if (EN(12) && IN(pb + 10)) phase_peer_gpart(l, lds);
        SEAM(pb + 10);
        if (EN(12) && IN(pb + 10)) phase_peer_combine(l, lds);
#else
        if (REPN(12) > 1 && EN(12) && IN(pb + 10)) phase_peer_gather<false>(l, lds);
        if (EN(12) && IN(pb + 10)) phase_peer_gather<true>(l, lds);
#endif
        if (l + 1 < DEPTH) SEAM(pb + 10);
    }
#undef IN
#undef SEAM
}

#ifndef N_LAUNCH_MODE
#define N_LAUNCH_MODE 1
#endif
extern "C" void kernel_launch(void* const* d_in, const int* in_sizes, int n_in, void* d_out, int out_size, void* d_ws, size_t ws_size, hipStream_t stream) {
    static int grid = 0;
    if (grid == 0) {
        if (n_in != 20 || out_size != ML * D || ws_size < WS_END) { fprintf(stderr, "kernel_launch: unexpected shapes: n_in %d out %d ws %zu (need %zu)\n", n_in, out_size, ws_size, (size_t)WS_END); grid = -1; return; }
        int dev = 0, cus = 0, per_cu = 0;
        if (hipGetDevice(&dev) != hipSuccess || hipDeviceGetAttribute(&cus, hipDeviceAttributeMultiprocessorCount, dev) != hipSuccess) { grid = -1; return; }
        if (hipFuncSetAttribute((const void*)fwd, hipFuncAttributeMaxDynamicSharedMemorySize, LDS_BYTES) != hipSuccess) { fprintf(stderr, "kernel_launch: hipFuncSetAttribute failed\n"); grid = -1; return; }
        if (hipOccupancyMaxActiveBlocksPerMultiprocessor(&per_cu, (const void*)fwd, 512, LDS_BYTES) != hipSuccess || per_cu < 1) fprintf(stderr, "kernel_launch: occupancy query says %d\n", per_cu);
        (void)hipGetLastError();
        grid = cus;
    }
    if (grid < 0) return;
    (void)hipMemsetAsync((char*)d_ws + WS_CTL, 0, CTL_BYTES, stream);
    Args a{};
    for (int i = 0; i < 20; ++i) a.in[i] = (const float*)d_in[i];
    a.out = (float*)d_out; a.ws = (unsigned char*)d_ws;
    a.ph_lo = 0; a.ph_hi = NPHASE;
    hipLaunchKernelGGL(fwd, dim3(grid), dim3(512), LDS_BYTES, stream, a);
    const hipError_t le = hipPeekAtLastError();
    if (le != hipSuccess) fprintf(stderr, "kernel_launch: launch failed: %s\n", hipGetErrorName(le));
}
```

```cpp
#include <hip/hip_runtime.h>
#ifndef GATHER_PART
#define GATHER_PART 2
#endif
#include <cstdio>
#include <cstdint>

#define GAS __attribute__((address_space(1)))
#define LAS __attribute__((address_space(3)))
typedef unsigned short bf16_t;
typedef short bf16x8 __attribute__((ext_vector_type(8)));
typedef short s16x4 __attribute__((ext_vector_type(4)));
typedef float f32x4 __attribute__((ext_vector_type(4)));
typedef float f32x2 __attribute__((ext_vector_type(2)));
typedef float f32x16 __attribute__((ext_vector_type(16)));
typedef unsigned u32x4 __attribute__((ext_vector_type(4)));
typedef unsigned u32x2 __attribute__((ext_vector_type(2)));
typedef int i32x4 __attribute__((ext_vector_type(4)));

constexpr int D = 1024, NB = 2, T = 16384, DEPTH = 4, CT = 256;
constexpr int ML = NB * T, MC = NB * CT, M = ML + MC;
constexpr int NIN = 3088, NP = 3072;
constexpr int KVLEN = T + CT;
constexpr int NEXP = 16384;
constexpr float EPS = 1e-6f;
constexpr int NPH_L = 11;
constexpr int NPHASE = 1 + DEPTH * NPH_L;

constexpr size_t MiB = 1u << 20;
constexpr size_t WS_CTL = 0, CTL_BYTES = 1 * MiB;
constexpr size_t WS_MOD = 1 * MiB;
constexpr size_t WS_ROPE = 2 * MiB;
constexpr size_t WS_WSK = 3 * MiB;
constexpr size_t WS_CTXX = 4 * MiB;
constexpr size_t WS_WINT = 8 * MiB;
constexpr size_t WS_WOUTT = 32 * MiB;
constexpr size_t WS_WQT = 40 * MiB;
constexpr size_t WS_SKB = 56 * MiB;
constexpr size_t WS_USC = 58 * MiB;
constexpr size_t WS_UB = 64 * MiB;
constexpr size_t WS_VB = 80 * MiB;
constexpr size_t TAB_SET = 32 * MiB;
constexpr size_t WS_H = 128 * MiB;
static_assert(WS_H + 2 * (size_t)M * 1024 <= 193 * MiB, "H + concat int8");
constexpr size_t WS_CATQ = WS_H + (size_t)M * 1024;
constexpr size_t WS_P = 193 * MiB;
constexpr size_t WS_QA = 388 * MiB;
constexpr size_t WS_KA = 421 * MiB;
constexpr size_t WS_VA = 438 * MiB;
constexpr size_t WS_CAT = 455 * MiB;
constexpr size_t WS_DQ = 520 * MiB;
constexpr size_t WS_DK = 553 * MiB;
constexpr size_t WS_DV = 586 * MiB;
constexpr size_t WS_OF = 619 * MiB;
constexpr size_t WS_OB = 684 * MiB;
constexpr size_t WS_GB = 749 * MiB;
constexpr size_t WS_BA = 752 * MiB;
constexpr size_t WS_PIDX = 755 * MiB;
constexpr size_t WS_PGATE = 772 * MiB;
constexpr size_t WS_REC = 789 * MiB;
constexpr size_t WS_END = 990 * MiB;
constexpr int CW_WMAX = 65536;
constexpr int NCH = 260;
constexpr int REC_K = 0, REC_KT = 16384, REC_Q = 32768, REC_V = 49152, REC_DIR = 65536, REC_DIRSZ = 17408, REC_BYTES = REC_DIR + 2 * REC_DIRSZ;
static_assert((size_t)NB * 4 * NCH * REC_BYTES + WS_REC <= WS_END, "rec region");

constexpr int LDS_BYTES = 163840;
constexpr int LDS_MISC = 163840 - 256;

__device__ __forceinline__ float bf2f(unsigned b) { return __uint_as_float(b << 16); }
__device__ __forceinline__ float bflo(unsigned w) { return __uint_as_float(w << 16); }
__device__ __forceinline__ float bfhi(unsigned w) { return __uint_as_float(w & 0xffff0000u); }
typedef __bf16 bf2v __attribute__((ext_vector_type(2)));
__device__ __forceinline__ unsigned pkbf(float lo, float hi) { unsigned r; asm("v_cvt_pk_bf16_f32 %0, %1, %2" : "=v"(r) : "v"(lo), "v"(hi)); return r; }
__device__ __forceinline__ unsigned pkbf_c(float lo, float hi) { f32x2 v = {lo, hi}; bf2v r = __builtin_convertvector(v, bf2v); return __builtin_bit_cast(unsigned, r); }
template <int K> __device__ __forceinline__ float lane_xor(float v) {
    const int b = __builtin_bit_cast(int, v);
    if constexpr (K == 1) return __builtin_bit_cast(float, __builtin_amdgcn_update_dpp(0, b, 0xB1, 0xF, 0xF, true));
    else if constexpr (K == 2) return __builtin_bit_cast(float, __builtin_amdgcn_update_dpp(0, b, 0x4E, 0xF, 0xF, true));
    else if constexpr (K == 32) { auto rr = __builtin_amdgcn_permlane32_swap((unsigned)b, (unsigned)b, false, false); unsigned ln_ = __builtin_amdgcn_mbcnt_hi(~0u, __builtin_amdgcn_mbcnt_lo(~0u, 0u)); asm volatile("" : "+v"(ln_));
        return __uint_as_float((ln_ & 32u) ? rr[0] : rr[1]); }
    else return __builtin_bit_cast(float, __builtin_amdgcn_ds_swizzle(b, 0x1F | (K << 10)));
}
__device__ __forceinline__ float wave_sum(float v) {
    v += lane_xor<1>(v); v += lane_xor<2>(v);
    v += __builtin_bit_cast(float, __builtin_amdgcn_update_dpp(0, __builtin_bit_cast(int, v), 0x124, 0xF, 0xF, true));
    v += __builtin_bit_cast(float, __builtin_amdgcn_update_dpp(0, __builtin_bit_cast(int, v), 0x128, 0xF, 0xF, true));
    v += lane_xor<16>(v);
    { auto rr = __builtin_amdgcn_permlane32_swap(__float_as_uint(v), __float_as_uint(v), false, false); v = __uint_as_float(rr[0]) + __uint_as_float(rr[1]); }
    return v;
}
__device__ __forceinline__ float wave_max(float v) {
    v = fmaxf(v, lane_xor<1>(v)); v = fmaxf(v, lane_xor<2>(v));
    v = fmaxf(v, __builtin_bit_cast(float, __builtin_amdgcn_update_dpp(0, __builtin_bit_cast(int, v), 0x124, 0xF, 0xF, true)));
    v = fmaxf(v, __builtin_bit_cast(float, __builtin_amdgcn_update_dpp(0, __builtin_bit_cast(int, v), 0x128, 0xF, 0xF, true)));
    v = fmaxf(v, lane_xor<16>(v));
    { auto rr = __builtin_amdgcn_permlane32_swap(__float_as_uint(v), __float_as_uint(v), false, false); v = fmaxf(__uint_as_float(rr[0]), __uint_as_float(rr[1])); }
    return v;
}
__device__ __forceinline__ float silu_f(float x) { return x / (1.f + __expf(-x)); }
#define LDS_WAIT() asm volatile("s_waitcnt lgkmcnt(0)" ::: "memory")

#define XB_TMO      128
#define XB_XCNT(j)  (256  + 64 * (j))
#define XB_XSUB(j)  (1280 + 64 * (j))
#define XB_XGEN(j)  (2304 + 64 * (j))
#define XB_TOP      3328
#define XB_TOPGEN   3392
#define XCD_BAR_WORDS 3456
#define XB_SPIN_CAP (1u << 22)
__device__ __forceinline__ unsigned xb_ld(unsigned* p)              { return __hip_atomic_load(p, __ATOMIC_RELAXED, __HIP_MEMORY_SCOPE_AGENT); }
__device__ __forceinline__ unsigned xb_add(unsigned* p, unsigned v) { return __hip_atomic_fetch_add(p, v, __ATOMIC_RELAXED, __HIP_MEMORY_SCOPE_AGENT); }
__device__ __forceinline__ unsigned xb_xcc_id() { return (unsigned)__builtin_amdgcn_s_getreg((3 << 11) | 20) & 0xFu; }
#define XB_SPIN(cond, bar) do { unsigned _sp = 0; while (cond) { __builtin_amdgcn_s_sleep(1); \
    if ((++_sp & 255u) == 0u) { if (xb_ld(&(bar)[XB_TMO])) break; if (_sp > XB_SPIN_CAP) { atomicAdd(&(bar)[XB_TMO], 1u); break; } } } } while (0)
struct XcdBarrier { unsigned* bar; unsigned x; volatile LAS unsigned* st; };
__device__ __forceinline__ XcdBarrier xcd_barrier_post(unsigned* bar, volatile LAS unsigned* st) {
    XcdBarrier b; b.bar = bar; b.x = xb_xcc_id(); b.st = st;
    if (threadIdx.x == 0) (void)xb_add(&bar[XB_XCNT(b.x)], 1u);
    return b;
}
__device__ __forceinline__ void xcd_barrier_complete(unsigned* bar, unsigned x, unsigned& nloc, unsigned& nx) {
    const unsigned G = gridDim.x * gridDim.y * gridDim.z;
    unsigned sum, cnt, mine, sp = 0u;
    for (;;) {
        sum = 0u; cnt = 0u; mine = 0u;
#pragma unroll
        for (unsigned j = 0; j < 16; ++j) { const unsigned c = xb_ld(&bar[XB_XCNT(j)]); sum += c; cnt += (c > 0u) ? 1u : 0u; mine = (j == x) ? c : mine; }
        if (sum == G) break;
        __builtin_amdgcn_s_sleep(1);
        if ((++sp & 255u) == 0u) { if (xb_ld(&bar[XB_TMO])) break; if (sp > XB_SPIN_CAP) { atomicAdd(&bar[XB_TMO], 1u); break; } }
    }
    nloc = mine > 0u ? mine : 1u; nx = cnt > 0u ? cnt : 1u;
}
__device__ __forceinline__ void xcd_barrier(const XcdBarrier& b) {
    asm volatile("s_waitcnt vmcnt(0)" ::: "memory");
    __syncthreads();
    if (threadIdx.x == 0) {
        unsigned* bar = b.bar; unsigned bx_ = b.x;
        asm volatile("" : "+s"(bar), "+s"(bx_));
        __builtin_amdgcn_s_waitcnt(0);
        unsigned nloc = b.st[0], nx = b.st[1];
        if (nloc == 0u) { xcd_barrier_complete(bar, bx_, nloc, nx); b.st[0] = nloc; b.st[1] = nx; }
        const unsigned old = xb_add(&bar[XB_XSUB(bx_)], 1u);
        const unsigned gen = old / nloc;
        if (old + 1u == (gen + 1u) * nloc) {
            __builtin_amdgcn_fence(__ATOMIC_RELEASE, "agent");
            asm volatile("s_waitcnt vmcnt(0)" ::: "memory");
            const unsigned og = xb_add(&bar[XB_TOP], 1u);
            const unsigned tg = og / nx;
            if (og + 1u == (tg + 1u) * nx) xb_add(&bar[XB_TOPGEN], 1u);
            else XB_SPIN(xb_ld(&bar[XB_TOPGEN]) == tg, bar);
            __builtin_amdgcn_fence(__ATOMIC_ACQUIRE, "agent");
            xb_add(&bar[XB_XGEN(bx_)], 1u);
            asm volatile("s_waitcnt vmcnt(0)" ::: "memory");
        } else {
            XB_SPIN(xb_ld(&bar[XB_XGEN(bx_)]) == gen, bar);
            __builtin_amdgcn_fence(__ATOMIC_ACQUIRE, "agent");
            asm volatile("s_waitcnt vmcnt(0)" ::: "memory");
        }
    }
    __syncthreads();
}

namespace pg8 {
constexpr int BM = 256, BK = 64, HALF = 128, HTB = HALF * BK * 2, STAGE_BYTES = 8 * HTB, NXCD = 8, WGM = 8;
__host__ __device__ __forceinline__ int lds_byte(int r, int c) { const int st = (r >> 4) * 2 + (c >> 5), rr = r & 15, cc = c & 31, ob = rr * 64 + cc * 2; return st * 1024 + (ob ^ (((ob >> 9) & 1) << 5)); }
__host__ __device__ __forceinline__ void stage_rc(int b, int& R, int& C) { const int st = b / 1024, sb = b % 1024, swz = sb ^ (((sb >> 9) & 1) << 5); R = (st >> 1) * 16 + swz / 64; C = (st & 1) * 32 + (swz % 64) / 2; }
__host__ __device__ __forceinline__ int perm32(int rho) { const int n = rho >> 4, i = rho & 15; return 8 * (i >> 2) + 4 * n + (i & 3); }
struct Unit { int pm, pn; };
struct Gemm { const bf16_t* A; const bf16_t* Bt; int M, N, K; };
struct StaticOrder {
    int nM, nN, nwg, G, c;
    __host__ __device__ void init(int M_, int N_, int G_, int c_) { nM = M_ / BM; nN = N_ / BM; nwg = nM * nN; G = G_; c = c_; }
    __host__ __device__ bool next(int i, Unit& u) const {
        const long L = (long)i * G + c; if (L >= nwg) return false;
        int wgid = (int)L; { const int q = nwg / NXCD, r = nwg % NXCD, xcd = wgid % NXCD, off = wgid / NXCD; wgid = (xcd < r ? xcd * (q + 1) : r * (q + 1) + (xcd - r) * q) + off; }
        const int nig = WGM * nN, gid = wgid / nig, fm = gid * WGM, gsz = (nM - fm) < WGM ? (nM - fm) : WGM;
        u.pm = fm + ((wgid % nig) % gsz); u.pn = (wgid % nig) / gsz; return true;
    }
    __device__ __forceinline__ void a_ready(const Unit&) const {}
    __device__ __forceinline__ void done(const Unit&) const {}
};
struct EpiBf16 {
    static constexpr bool PERM = true, I8 = false; typedef f32x4 acc_t;
    bf16_t* O; int ldc;
    __device__ __forceinline__ void operator()(const f32x4 (&acc)[2][2][4][2], const Unit& u, int wr, int wc, int fr, int fq) const {
        const int row0 = u.pm * BM + wr * 64 + fr; const int col0 = u.pn * BM + wc * 32 + 8 * fq;
#pragma unroll
        for (int ai = 0; ai < 2; ++ai)
#pragma unroll
            for (int m = 0; m < 4; ++m) { bf16_t* rowp = O + (size_t)(row0 + ai * HALF + m * 16) * ldc + col0;
#pragma unroll
                for (int bj = 0; bj < 2; ++bj) { const f32x4 v0 = acc[ai][bj][m][0], v1 = acc[ai][bj][m][1];
                    u32x4 w; w.x = pkbf_c(v0[0], v0[1]); w.y = pkbf_c(v0[2], v0[3]); w.z = pkbf_c(v1[0], v1[1]); w.w = pkbf_c(v1[2], v1[3]);
                    *(u32x4*)(rowp + bj * HALF) = w; } }
    }
};
struct EpiBf16I8 {
    static constexpr bool PERM = true, I8 = true; typedef i32x4 acc_t;
    bf16_t* O; int ldc; const float* sa; const float* wmax;
    __device__ __forceinline__ void operator()(const i32x4 (&acc)[2][2][4][2], const Unit& u, int wr, int wc, int fr, int fq) const {
        const int row0 = u.pm * BM + wr * 64 + fr; const int col0 = u.pn * BM + wc * 32 + 8 * fq;
        f32x4 sw[2][2];
#pragma unroll
        for (int bj = 0; bj < 2; ++bj)
#pragma unroll
            for (int n = 0; n < 2; ++n) sw[bj][n] = *(const f32x4*)(wmax + col0 + bj * HALF + 4 * n) * (1.f / 127.f);
#pragma unroll
        for (int ai = 0; ai < 2; ++ai)
#pragma unroll
            for (int m = 0; m < 4; ++m) { const int row = row0 + ai * HALF + m * 16; const float sr = sa[row]; bf16_t* rowp = O + (size_t)row * ldc + col0;
#pragma unroll
                for (int bj = 0; bj < 2; ++bj) { const i32x4 a0 = acc[ai][bj][m][0], a1 = acc[ai][bj][m][1];
                    const f32x4 v0 = (f32x4){(float)a0[0], (float)a0[1], (float)a0[2], (float)a0[3]} * sw[bj][0] * sr, v1 = (f32x4){(float)a1[0], (float)a1[1], (float)a1[2], (float)a1[3]} * sw[bj][1] * sr;
                    u32x4 w; w.x = pkbf(v0[0], v0[1]); w.y = pkbf(v0[2], v0[3]); w.z = pkbf(v1[0], v1[1]); w.w = pkbf(v1[2], v1[3]);
                    *(u32x4*)(rowp + bj * HALF) = w; } }
    }
};
struct EpiRes {
    static constexpr bool PERM = false, I8 = false; typedef f32x4 acc_t;
    const float* src_lat; const float* src_ctx; float* dst_lat; float* dst_ctx; const float* gate;
    __device__ __forceinline__ void operator()(const f32x4 (&acc)[2][2][4][2], const Unit& u, int wr, int wc, int fr, int fq) const {
        const bool isctx = u.pm >= (ML / BM);
        const float* src = isctx ? src_ctx + (size_t)(u.pm - ML / BM) * BM * D : src_lat + (size_t)u.pm * BM * D;
        float* dst = isctx ? dst_ctx + (size_t)(u.pm - ML / BM) * BM * D : dst_lat + (size_t)u.pm * BM * D;
        const int mrow = isctx ? 2 : (u.pm >= (T / BM) ? 1 : 0);
        const int row0 = wr * 64 + fr, col0 = u.pn * BM + wc * 32 + 4 * fq;
        f32x4 gv[2][2];
#pragma unroll
        for (int bj = 0; bj < 2; ++bj)
#pragma unroll
            for (int n = 0; n < 2; ++n) gv[bj][n] = *(const f32x4*)(gate + mrow * 6144 + col0 + bj * HALF + n * 16);
#pragma unroll
        for (int ai = 0; ai < 2; ++ai)
#pragma unroll
            for (int m = 0; m < 4; ++m) { const size_t off = (size_t)(row0 + ai * HALF + m * 16) * D + col0;
#pragma unroll
                for (int bj = 0; bj < 2; ++bj)
#pragma unroll
                    for (int n = 0; n < 2; ++n) { const f32x4 s = *(const f32x4*)(src + off + bj * HALF + n * 16);
                        *(f32x4*)(dst + off + bj * HALF + n * 16) = s + gv[bj][n] * acc[ai][bj][m][n]; } }
    }
};

struct EpiResI8 {
    static constexpr bool PERM = false, I8 = true; typedef i32x4 acc_t;
    const float* src_lat; const float* src_ctx; float* dst_lat; float* dst_ctx; const float* gate; const float* sa; const float* wmax;
    __device__ __forceinline__ void operator()(const i32x4 (&acc)[2][2][4][2], const Unit& u, int wr, int wc, int fr, int fq) const {
        const bool isctx = u.pm >= (ML / BM);
        const float* src = isctx ? src_ctx + (size_t)(u.pm - ML / BM) * BM * D : src_lat + (size_t)u.pm * BM * D;
        float* dst = isctx ? dst_ctx + (size_t)(u.pm - ML / BM) * BM * D : dst_lat + (size_t)u.pm * BM * D;
        const int mrow = isctx ? 2 : (u.pm >= (T / BM) ? 1 : 0);
        const int row0 = wr * 64 + fr, col0 = u.pn * BM + wc * 32 + 4 * fq;
        f32x4 gv[2][2];
#pragma unroll
        for (int bj = 0; bj < 2; ++bj)
#pragma unroll
            for (int n = 0; n < 2; ++n) gv[bj][n] = *(const f32x4*)(gate + mrow * 6144 + col0 + bj * HALF + n * 16) * *(const f32x4*)(wmax + col0 + bj * HALF + n * 16) * (1.f / 127.f);
#pragma unroll
        for (int ai = 0; ai < 2; ++ai)
#pragma unroll
            for (int m = 0; m < 4; ++m) { const int rl = row0 + ai * HALF + m * 16; const float sr = sa[u.pm * BM + rl]; const size_t off = (size_t)rl * D + col0;
#pragma unroll
                for (int bj = 0; bj < 2; ++bj)
#pragma unroll
                    for (int n = 0; n < 2; ++n) { const f32x4 sv = *(const f32x4*)(src + off + bj * HALF + n * 16); const i32x4 ac = acc[ai][bj][m][n];
                        *(f32x4*)(dst + off + bj * HALF + n * 16) = sv + gv[bj][n] * ((f32x4){(float)ac[0], (float)ac[1], (float)ac[2], (float)ac[3]} * sr); } }
    }
};
template <class Epi, class Sched>
__device__ __forceinline__ void gemm_phase(LAS unsigned char* lds, const Gemm g, const Sched& S, const Epi& E) {
    constexpr bool I8 = Epi::I8;
    typedef typename Epi::acc_t acc_t;
    int tid = threadIdx.x; asm volatile("" : "+v"(tid)); const int wid = __builtin_amdgcn_readfirstlane(tid >> 6), lane = tid & 63, wr = wid >> 2, wc = wid & 3, fr = lane & 15, fq = lane >> 4;
    const int K = g.K, nt = K / BK;
    unsigned voffA[2], voffB[2];
#pragma unroll
    for (int i = 0; i < 2; ++i) { int R, C; stage_rc(tid * 16 + i * 8192, R, C); const int Rb = Epi::PERM ? ((R & ~31) + perm32(R & 31)) : R;
        voffA[i] = (unsigned)(R * K + C) * 2u; voffB[i] = (unsigned)(Rb * K + C) * 2u; }
    const size_t kstep = (size_t)(BK * 2);
    const size_t hstep = (size_t)HALF * K * 2;
    const size_t tstep = 2 * hstep;
    const unsigned ldsw = (unsigned)wid * 1024u;
    const int aoff = lds_byte(wr * 64 + fr, fq * 8), boff = lds_byte(wc * 32 + fr, fq * 8);
#define PG8_SA(b, h) (((b) * 2 + (h)) * HTB)
#define PG8_SB(b, h) ((4 + (b) * 2 + (h)) * HTB)
#define PG8_STAGE(bufoff, gbase, voff) do { _Pragma("unroll") for (int _i = 0; _i < 2; ++_i) \
        __builtin_amdgcn_global_load_lds((const unsigned*)((const char*)(gbase) + (voff)[_i]), (LAS unsigned*)(lds + (bufoff) + ldsw + _i * 8192), 16, 0, 0); } while (0)
#define PG8_LDA(dst, b, h) do { _Pragma("unroll") for (int m = 0; m < 4; ++m) _Pragma("unroll") for (int k = 0; k < 2; ++k) dst[m][k] = *(const LAS bf16x8*)(lds + PG8_SA(b, h) + aoff + m * 2048 + k * 1024); } while (0)
#define PG8_LDB(dst, b, h) do { _Pragma("unroll") for (int n = 0; n < 2; ++n) _Pragma("unroll") for (int k = 0; k < 2; ++k) dst[n][k] = *(const LAS bf16x8*)(lds + PG8_SB(b, h) + boff + n * 2048 + k * 1024); } while (0)
#define PG8_MMA(ai, bj, At, Bt) do { __builtin_amdgcn_s_setprio(1); _Pragma("unroll") for (int m = 0; m < 4; ++m) _Pragma("unroll") for (int n = 0; n < 2; ++n) _Pragma("unroll") for (int k = 0; k < 2; ++k) \
        { if constexpr (I8) acc[ai][bj][m][n] = __builtin_bit_cast(acc_t, __builtin_amdgcn_mfma_i32_16x16x64_i8(__builtin_bit_cast(i32x4, Bt[n][k]), __builtin_bit_cast(i32x4, At[m][k]), __builtin_bit_cast(i32x4, acc[ai][bj][m][n]), 0, 0, 0)); \
          else acc[ai][bj][m][n] = __builtin_bit_cast(acc_t, __builtin_amdgcn_mfma_f32_16x16x32_bf16(Bt[n][k], At[m][k], __builtin_bit_cast(f32x4, acc[ai][bj][m][n]), 0, 0, 0)); } __builtin_amdgcn_s_setprio(0); } while (0)
#define PG8_WAIT_V(n) asm volatile("s_waitcnt vmcnt(" #n ")" ::: "memory")
#define PG8_WAIT_L(n) asm volatile("s_waitcnt lgkmcnt(" #n ")" ::: "memory")
#define PG8_BAR __builtin_amdgcn_s_barrier()
#define PG8_SCHED __builtin_amdgcn_sched_barrier(0)
    Unit cur, nxt; int ui = 0;
    if (!S.next(0, cur)) return;
    acc_t acc[2][2][4][2];
#pragma unroll
    for (int a = 0; a < 2; ++a)
#pragma unroll
        for (int b = 0; b < 2; ++b)
#pragma unroll
            for (int m = 0; m < 4; ++m)
#pragma unroll
                for (int n = 0; n < 2; ++n) acc[a][b][m][n] = acc_t{};
    bf16x8 At[4][2], B0[2][2], B1[2][2];
    const char* cA = (const char*)g.A + (size_t)cur.pm * tstep; const char* cB = (const char*)g.Bt + (size_t)cur.pn * tstep;
    S.a_ready(cur);
    PG8_STAGE(PG8_SB(0, 0), cB, voffB); PG8_STAGE(PG8_SA(0, 0), cA, voffA); PG8_STAGE(PG8_SB(0, 1), cB + hstep, voffB); PG8_STAGE(PG8_SA(0, 1), cA + hstep, voffA);
    if (wr == 1) PG8_BAR;
    PG8_WAIT_V(4); PG8_BAR;
    PG8_STAGE(PG8_SB(1, 0), cB + kstep, voffB); PG8_STAGE(PG8_SA(1, 0), cA + kstep, voffA); PG8_STAGE(PG8_SB(1, 1), cB + hstep + kstep, voffB);
    PG8_WAIT_V(6); PG8_BAR;
    for (;;) {
        const bool has_next = S.next(ui + 1, nxt);
        const char* nA = has_next ? (const char*)g.A + (size_t)nxt.pm * tstep : cA; const char* nB = has_next ? (const char*)g.Bt + (size_t)nxt.pn * tstep : cB;
        for (int t = 0; t < nt; t += 2) {
            const bool last = (t == nt - 2);
            const char* a1 = cA + (size_t)(t + 1) * kstep;
            const char* a2 = last ? nA : cA + (size_t)(t + 2) * kstep; const char* b2 = last ? nB : cB + (size_t)(t + 2) * kstep;
            const char* a3 = a2 + kstep; const char* b3 = b2 + kstep;
            if (last && has_next) S.a_ready(nxt);
            PG8_LDB(B0, 0, 0); PG8_SCHED; PG8_LDA(At, 0, 0); PG8_STAGE(PG8_SA(1, 1), a1 + hstep, voffA);
            PG8_WAIT_L(8); PG8_BAR; PG8_WAIT_L(0); PG8_MMA(0, 0, At, B0); PG8_BAR; PG8_SCHED;
            PG8_LDB(B1, 0, 1); PG8_STAGE(PG8_SB(0, 0), b2, voffB);
            PG8_BAR; PG8_WAIT_L(0); PG8_MMA(0, 1, At, B1); PG8_BAR;
            PG8_LDA(At, 0, 1); PG8_STAGE(PG8_SA(0, 0), a2, voffA);
            PG8_BAR; PG8_WAIT_L(0); PG8_MMA(1, 0, At, B0); PG8_BAR; PG8_SCHED;
            PG8_STAGE(PG8_SB(0, 1), b2 + hstep, voffB);
            PG8_WAIT_V(6); PG8_BAR; PG8_MMA(1, 1, At, B1); PG8_BAR;
            PG8_LDB(B0, 1, 0); PG8_SCHED; PG8_LDA(At, 1, 0); PG8_STAGE(PG8_SA(0, 1), a2 + hstep, voffA);
            PG8_WAIT_L(8); PG8_BAR; PG8_WAIT_L(0); PG8_MMA(0, 0, At, B0); PG8_BAR; PG8_SCHED;
            PG8_LDB(B1, 1, 1); PG8_STAGE(PG8_SB(1, 0), b3, voffB);
            PG8_BAR; PG8_WAIT_L(0); PG8_MMA(0, 1, At, B1); PG8_BAR;
            PG8_LDA(At, 1, 1); PG8_STAGE(PG8_SA(1, 0), a3, voffA);
            PG8_BAR; PG8_WAIT_L(0); PG8_MMA(1, 0, At, B0); PG8_BAR; PG8_SCHED;
            PG8_STAGE(PG8_SB(1, 1), b3 + hstep, voffB);
            PG8_WAIT_V(6); PG8_BAR; PG8_MMA(1, 1, At, B1); PG8_BAR;
        }
        E(acc, cur, wr, wc, fr, fq); S.done(cur);
        if (!has_next) break;
#pragma unroll
        for (int a = 0; a < 2; ++a)
#pragma unroll
            for (int b = 0; b < 2; ++b)
#pragma unroll
                for (int m = 0; m < 4; ++m)
#pragma unroll
                    for (int n = 0; n < 2; ++n) acc[a][b][m][n] = acc_t{};
        cur = nxt; cA = nA; cB = nB; ++ui;
    }
    PG8_WAIT_V(0);
    if (wr == 0) PG8_BAR;
    PG8_BAR;
#undef PG8_SA
#undef PG8_SB
#undef PG8_STAGE
#undef PG8_LDA
#undef PG8_LDB
#undef PG8_MMA
#undef PG8_WAIT_V
#undef PG8_WAIT_L
#undef PG8_BAR
#undef PG8_SCHED
}
}

namespace att {
constexpr int HD = 128, NW = 8, QBLK = 32, KVBLK = 64;
constexpr float SCALE = 0.088388347648318440f;
constexpr float THR = 8.f;
constexpr int LDQ = 512, LDK = 256;
constexpr size_t SHM_V = KVBLK * HD * 2, SHM_K = KVBLK * HD * 2, SHM_ATTN = 2 * SHM_V + 2 * SHM_K + NW * 64 * 4;
#define KSWZ(row, colB) ((row) * 256 + ((colB) ^ (((row) & 7) << 4)))
#define SBAR() __builtin_amdgcn_sched_barrier(0)
__device__ __forceinline__ int crow(int r, int hi) { return (r & 3) + 8 * (r >> 2) + 4 * hi; }
__device__ __forceinline__ unsigned cvtpk(float lo, float hi) { unsigned r; asm volatile("v_cvt_pk_bf16_f32 %0, %1, %2" : "=v"(r) : "v"(lo), "v"(hi)); return r; }
__device__ __forceinline__ void partialSM(f32x16& p0, f32x16& p1) {
  for (int r = 0; r < 16; ++r) p0[r] = __builtin_amdgcn_exp2f(p0[r]);
}
typedef int i32x8 __attribute__((ext_vector_type(8)));
__device__ __forceinline__ void finishSM(f32x16& p0, f32x16& p1, i32x8& pa) {
  for (int r = 0; r < 16; ++r) p1[r] = __builtin_amdgcn_exp2f(p1[r]);
#pragma unroll
  for (int q = 0; q < 4; ++q) { int w = __builtin_amdgcn_cvt_pk_bf8_f32(p0[4 * q], p0[4 * q + 1], 0, false); w = __builtin_amdgcn_cvt_pk_bf8_f32(p0[4 * q + 2], p0[4 * q + 3], w, true); pa[q] = w;
    int w2 = __builtin_amdgcn_cvt_pk_bf8_f32(p1[4 * q], p1[4 * q + 1], 0, false); w2 = __builtin_amdgcn_cvt_pk_bf8_f32(p1[4 * q + 2], p1[4 * q + 3], w2, true); pa[4 + q] = w2; }
}
constexpr int K8_STRIDE = 144, K8_TILE = KVBLK * K8_STRIDE;
__device__ __forceinline__ void qkt(f32x16& p0, f32x16& p1, const unsigned char* Ks, const i32x8* qr, int r32, int hi, const f32x16& cinit) {
  p0 = cinit; p1 = cinit;
#pragma unroll
  for (int ks = 0; ks < 2; ++ks) {
    const u32x4* a0 = (const u32x4*)(Ks + r32 * K8_STRIDE + 64 * ks + 32 * hi); const u32x4* a1 = (const u32x4*)(Ks + (32 + r32) * K8_STRIDE + 64 * ks + 32 * hi);
    const u32x4 x0 = a0[0], x1 = a0[1], y0 = a1[0], y1 = a1[1];
    const i32x8 k0 = {(int)x0.x, (int)x0.y, (int)x0.z, (int)x0.w, (int)x1.x, (int)x1.y, (int)x1.z, (int)x1.w}, k1 = {(int)y0.x, (int)y0.y, (int)y0.z, (int)y0.w, (int)y1.x, (int)y1.y, (int)y1.z, (int)y1.w};
    p0 = __builtin_amdgcn_mfma_scale_f32_32x32x64_f8f6f4(k0, qr[ks], p0, 0, 0, 0, 0x7F7F7F7F, 0, 0x7C7C7C7C);
    p1 = __builtin_amdgcn_mfma_scale_f32_32x32x64_f8f6f4(k1, qr[ks], p1, 0, 0, 0, 0x7F7F7F7F, 0, 0x7C7C7C7C); }
}
constexpr int V8_STRIDE = 80, V8_TILE = HD * V8_STRIDE;
__device__ __forceinline__ void pv_d0(f32x16* o, f32x16& ol, const unsigned char* Vs, const i32x8& pa, int r32, int hi) {
  { const i32x8 ones = {0x38383838, 0x38383838, 0x38383838, 0x38383838, 0x38383838, 0x38383838, 0x38383838, 0x38383838};
    ol = __builtin_amdgcn_mfma_scale_f32_32x32x64_f8f6f4(pa, ones, ol, 1, 0, 0, 0x7F7F7F7F, 0, 0x7F7F7F7F); }
#pragma unroll
  for (int d0 = 0; d0 < 4; ++d0) { const u32x4* bp = (const u32x4*)(Vs + (32 * d0 + r32) * V8_STRIDE + 32 * hi); const u32x4 x0 = bp[0], x1 = bp[1];
    const i32x8 vb = {(int)x0.x, (int)x0.y, (int)x0.z, (int)x0.w, (int)x1.x, (int)x1.y, (int)x1.z, (int)x1.w};
    o[d0] = __builtin_amdgcn_mfma_scale_f32_32x32x64_f8f6f4(pa, vb, o[d0], 1  , 0  , 0, 0x7F7F7F7F, 0, 0x7F7F7F7F); }
}
__device__ __forceinline__ void attn_dense_body(const unsigned char* __restrict__ Qb, const unsigned char* __restrict__ Kh, const unsigned char* __restrict__ Vt,
                                                bf16_t* __restrict__ Ob, int LDO, int seq, char* lds, float* __restrict__ lse, float braw) {
  int tid = threadIdx.x; asm volatile("" : "+v"(tid)); const int wid = tid >> 6, lane = tid & 63, r32 = lane & 31, hi = lane >> 5;
  unsigned char* V_lds = (unsigned char*)lds; unsigned char* K_lds = (unsigned char*)(lds + 2 * V8_TILE);
  f32x16 o[4] = {}, ol = {}; i32x8 qr[2];
  const float mnC = __builtin_bit_cast(float, __builtin_amdgcn_readfirstlane(__builtin_bit_cast(int, -fmaxf(braw * (SCALE * 1.4426950408889634f) - 15.5f, 0.f))));
  f32x16 cinit;
#pragma unroll
  for (int r = 0; r < 16; ++r) cinit[r] = mnC;
  const unsigned char* Qw = Qb + (long)(wid * QBLK + r32) * LDQ + hi * 32;
#pragma unroll
  for (int ks = 0; ks < 2; ++ks) { const u32x4 x0 = *(const u32x4*)(Qw + 64 * ks), x1 = *(const u32x4*)(Qw + 64 * ks + 16);
    qr[ks] = (i32x8){(int)x0.x, (int)x0.y, (int)x0.z, (int)x0.w, (int)x1.x, (int)x1.y, (int)x1.z, (int)x1.w}; }
  const int krow = tid >> 3, kch = tid & 7;
  const int vrow = tid >> 2, vch = tid & 3;
  struct { u32x4 v8, k8; } sr_[2];
#define SLOAD(i, k0) do { sr_[i].v8 = *reinterpret_cast<const u32x4*>(Vt + (long)((k0) >> 6) * 8192 + tid * 16); \
    sr_[i].k8 = *reinterpret_cast<const u32x4*>(Kh + (long)((k0) + krow) * LDK + kch * 16); } while (0)
#define SWRITE(b, i) do { *(u32x4*)(V_lds + (b) * V8_TILE + vrow * V8_STRIDE + vch * 16) = sr_[i].v8; \
    *(u32x4*)(K_lds + (b) * K8_TILE + krow * K8_STRIDE + kch * 16) = sr_[i].k8; } while (0)
#define SWAIT() asm volatile("s_waitcnt vmcnt(2)" ::: "memory")
  f32x16 pA0, pA1, pB0, pB1; i32x8 pa; const int NT = seq / KVBLK;
  constexpr int SE = 0, SO = 1;
  SLOAD(SE, 0); asm volatile("s_waitcnt vmcnt(0)" ::: "memory"); SWRITE(0, SE); __syncthreads();
  qkt(pA0, pA1, K_lds, qr, r32, hi, cinit); partialSM(pA0, pA1);
  SLOAD(SO, KVBLK); SLOAD(SE, 2 * KVBLK);
  SWAIT(); SWRITE(1, SO); __syncthreads();
  for (int j = 1; j + 1 < NT; j += 2) {
    SBAR(); qkt(pB0, pB1, K_lds + K8_TILE, qr, r32, hi, cinit);
    finishSM(pA0, pA1, pa); SBAR();
    SLOAD(SO, (j + 2) * KVBLK); SBAR();
    pv_d0(o, ol, V_lds, pa, r32, hi); partialSM(pB0, pB1);
    __syncthreads(); SWAIT(); SWRITE(0, SE);
    __syncthreads();
    SBAR(); qkt(pA0, pA1, K_lds, qr, r32, hi, cinit);
    finishSM(pB0, pB1, pa); SBAR();
    SLOAD(SE, (j + 3 < NT ? j + 3 : NT - 1) * KVBLK); SBAR();
    pv_d0(o, ol, V_lds + V8_TILE, pa, r32, hi); partialSM(pA0, pA1);
    __syncthreads(); SWAIT(); SWRITE(1, SO);
    __syncthreads();
  }
  SBAR(); qkt(pB0, pB1, K_lds + K8_TILE, qr, r32, hi, cinit);
  finishSM(pA0, pA1, pa); SBAR();
  pv_d0(o, ol, V_lds, pa, r32, hi); partialSM(pB0, pB1);
  __syncthreads();
  finishSM(pB0, pB1, pa); SBAR();
  pv_d0(o, ol, V_lds + V8_TILE, pa, r32, hi);
  if (lse && r32 == 0) {
#pragma unroll
    for (int r = 0; r < 16; ++r) lse[(wid * QBLK + crow(r, hi)) * 4] = __logf(ol[r]) - mnC * 0.69314718055994531f; }
  float rli[16];
#pragma unroll
  for (int r = 0; r < 16; ++r) rli[r] = __builtin_amdgcn_rcpf(ol[r]);
  bf16_t* Ow = Ob + (long)(wid * QBLK) * LDO;
#pragma unroll
  for (int r = 0; r < 16; ++r) { int orow = crow(r, hi);
    for (int d0 = 0; d0 < 4; ++d0) Ow[(long)orow * LDO + d0 * 32 + r32] = (bf16_t)(pkbf(o[d0][r] * rli[r], 0.f) & 0xffffu); }
  __syncthreads();
#undef SLOAD
#undef SWRITE
#undef SWAIT
}
}

struct Args { const float* in[20]; float* out; unsigned char* ws; int ph_lo, ph_hi; };
typedef const __attribute__((address_space(4))) Args* KArgs;
__device__ __forceinline__ KArgs get_args() { KArgs p = (KArgs)__builtin_amdgcn_kernarg_segment_ptr(); asm volatile("" : "+s"(p)); return p; }
__device__ __forceinline__ int fresh_tid() { int t = threadIdx.x; asm volatile("" : "+v"(t)); return t; }
__device__ __forceinline__ int fresh_bx() { int t = blockIdx.x; asm volatile("" : "+s"(t)); return t; }
__device__ __forceinline__ int fresh_g() { int t = gridDim.x; asm volatile("" : "+s"(t)); return t; }
enum { I_X = 0, I_C, I_CTX, I_CCTX, I_ADAW, I_ADAB, I_N1W, I_N2W, I_WIN, I_QNW, I_KNW, I_CONVW, I_ALOG, I_DTB, I_DNW, I_WOUT, I_WQ, I_SUBK, I_U, I_V };

__device__ __forceinline__ void convert_tables(const float* U, const float* V, unsigned char* ws, int l, int wvi, int nwv, int lane, int rw_end = 2 * NEXP) {
    const float* us = U + (size_t)l * NEXP * 1024; const float* vs = V + (size_t)l * NEXP * 1024;
    const int set = l & 1;
    float* scl = (float*)(ws + WS_USC) + set * 2 * NEXP;
    for (int rw = wvi; rw < rw_end; rw += nwv) {
        const bool isu = rw < NEXP; const int e = isu ? rw : rw - NEXP;
        const f32x4* sp = (const f32x4*)((isu ? us : vs) + (size_t)e * 1024 + 16 * lane);
        f32x4 x[4]; float mx = 0.f;
#pragma unroll
        for (int i = 0; i < 4; ++i) { x[i] = sp[i]; mx = fmaxf(mx, fmaxf(fmaxf(fabsf(x[i][0]), fabsf(x[i][1])), fmaxf(fabsf(x[i][2]), fabsf(x[i][3])))); }
        mx = wave_max(mx);
        const float sc = fmaxf(mx, 1e-30f) * (1.f / 127.f), inv = 1.f / sc;
        u32x4 o4;
        const float ofs = ((GATHER_PART && isu) || GATHER_PART == 2) ? 0.f : 128.f;
#pragma unroll
        for (int i = 0; i < 4; ++i) { const unsigned b0 = (unsigned)(int)(rintf(x[i][0] * inv) + ofs) & 255u, b1 = (unsigned)(int)(rintf(x[i][1] * inv) + ofs) & 255u, b2 = (unsigned)(int)(rintf(x[i][2] * inv) + ofs) & 255u, b3 = (unsigned)(int)(rintf(x[i][3] * inv) + ofs) & 255u;
            o4[i] = b0 | (b1 << 8) | (b2 << 16) | (b3 << 24); }
        if (GATHER_PART == 2) *(u32x4*)(ws + WS_UB + (size_t)set * TAB_SET + (isu ? 0 : (size_t)NEXP * 1024) + ((size_t)(lane >> 3) * NEXP + e) * 128 + 16 * (lane & 7)) = o4;
        else *(u32x4*)(ws + WS_UB + (size_t)set * TAB_SET + (size_t)e * 2048 + (isu ? 0 : 1024) + 16 * lane) = o4;
        if (lane == 0) { if (GATHER_PART) scl[2 * e + (isu ? 0 : 1)] = sc; else scl[rw] = sc; }
    }
}

__device__ __forceinline__ void transpose_item(const float* W, int ldw, int K, bf16_t* WT, LAS float* scr, int kb, int nb, int lane) {
    const int k0 = 64 * kb, n0 = 32 * nb;
#pragma unroll 8
    for (int i = 0; i < 32; ++i) { const int kk = 2 * i + (lane >> 5); scr[kk * 33 + (lane & 31)] = W[(size_t)(k0 + kk) * ldw + n0 + (lane & 31)]; }
    LDS_WAIT(); asm volatile("" ::: "memory");
    const int c = lane & 7;
#pragma unroll
    for (int j = 0; j < 4; ++j) { const int n = (lane >> 3) + 8 * j; const LAS float* s = scr + (8 * c) * 33 + n;
        u32x4 o; o.x = pkbf(s[0 * 33], s[1 * 33]); o.y = pkbf(s[2 * 33], s[3 * 33]); o.z = pkbf(s[4 * 33], s[5 * 33]); o.w = pkbf(s[6 * 33], s[7 * 33]);
        *(u32x4*)(WT + (size_t)(n0 + n) * K + k0 + 8 * c) = o; }
    LDS_WAIT(); asm volatile("" ::: "memory");
}
__device__ __forceinline__ void phase_prologue(LAS unsigned char* lds) {
    const KArgs ap = get_args();
#define a (*ap)

    const int tid = fresh_tid(), lane = tid & 63, wave = __builtin_amdgcn_readfirstlane(tid >> 6), G = fresh_g(), bx = fresh_bx();
    unsigned char* ws = a.ws;
    {
        LAS float* sc = (LAS float*)(lds + 70000);
        LAS float* part = (LAS float*)(lds + 70000 + 12288);
        for (int i = tid; i < 3 * 1024; i += 512) { const int r = i >> 10, k = i & 1023; const float v = r < 2 ? a.in[I_C][r * 1024 + k] : a.in[I_CCTX][k]; sc[i] = silu_f(v); }
        __syncthreads();
        float* mod = (float*)(ws + WS_MOD);
        for (int item = bx; item < DEPTH * 96; item += G) {
            const int l = item / 96, j0 = (item % 96) * 64;
            const float* wp = a.in[I_ADAW] + (size_t)l * 1024 * 6144 + (size_t)(wave * 128) * 6144 + j0 + lane;
            float a0 = 0.f, a1 = 0.f, a2 = 0.f;
#pragma unroll 8
            for (int kk = 0; kk < 128; ++kk) { const float w = wp[(size_t)kk * 6144]; const int k = wave * 128 + kk; a0 = fmaf(sc[k], w, a0); a1 = fmaf(sc[1024 + k], w, a1); a2 = fmaf(sc[2048 + k], w, a2); }
            part[(wave * 3 + 0) * 64 + lane] = a0; part[(wave * 3 + 1) * 64 + lane] = a1; part[(wave * 3 + 2) * 64 + lane] = a2;
            __syncthreads();
            if (tid < 192) { const int r = tid >> 6, jj = tid & 63; float s = a.in[I_ADAB][l * 6144 + j0 + jj];
#pragma unroll
                for (int w = 0; w < 8; ++w) s += part[(w * 3 + r) * 64 + jj];
                mod[(size_t)(l * 3 + r) * 6144 + j0 + jj] = s; }
            __syncthreads();
        }
    }
    {
        const int gw = bx * 8 + wave, NGW = G * 8;
        unsigned* wmaxw = (unsigned*)(ws + WS_CTL) + CW_WMAX;
        constexpr int NB_IN = NP / 64, NB_OUT = 1024 / 64, NB_Q = 2048 / 64, PER_L2 = (NB_IN + NB_OUT + NB_Q) * 8;
        for (int it = gw; it < DEPTH * PER_L2; it += NGW) { const int l = it / PER_L2; int r = it % PER_L2; const int kc = r & 7; r >>= 3;
            const int mi = r < NB_IN ? 0 : r < NB_IN + NB_OUT ? 1 : 2; const int nb = mi == 0 ? r : mi == 1 ? r - NB_IN : r - NB_IN - NB_OUT; const int ldw = mi == 0 ? NIN : mi == 1 ? 1024 : 2048;
            const float* wp = (mi == 0 ? a.in[I_WIN] + (size_t)l * 1024 * NIN : mi == 1 ? a.in[I_WOUT] + (size_t)l * 1024 * 1024 : a.in[I_WQ] + (size_t)l * 1024 * 2048) + (size_t)(kc * 128) * ldw + nb * 64 + lane;
            float mx = 0.f;
#pragma unroll 8
            for (int kk = 0; kk < 128; ++kk) mx = fmaxf(mx, fabsf(wp[(size_t)kk * ldw]));
            atomicMax(wmaxw + (l * 3 + mi) * 3072 + nb * 64 + lane, __float_as_uint(mx)); }
    }
    const size_t gt = (size_t)bx * 512 + tid, NT = (size_t)G * 512;
    for (size_t i = gt; i < (size_t)DEPTH * 16 * 1024; i += NT) { const int l = (int)(i >> 14), j = (int)((i >> 10) & 15), k = (int)(i & 1023);
        ((float*)(ws + WS_WSK))[i] = a.in[I_WIN][(size_t)l * 1024 * NIN + (size_t)k * NIN + NP + j]; }
    convert_tables(a.in[I_U], a.in[I_V], ws, 0, bx * 8 + wave, G * 8, lane);
    for (size_t i = gt; i < (size_t)DEPTH * 8 * 2 * 128 * 128 / 2; i += NT) { const f32x2 x = ((const f32x2*)a.in[I_SUBK])[i]; ((unsigned*)(ws + WS_SKB))[i] = pkbf(x[0], x[1]); }
    for (size_t i = gt; i < 8192; i += NT) { const int pos = (int)(i >> 5), fi = (int)(i & 31);
        const float inv = exp2f(-(float)fi * (13.287712379549449f / 32.f)); const float ang = (float)pos * inv;
        float rev = ang * 0.15915494309189535f; rev -= floorf(rev);
        ((float*)(ws + WS_ROPE))[i] = __builtin_amdgcn_cosf(rev); ((float*)(ws + WS_ROPE))[8192 + i] = __builtin_amdgcn_sinf(rev); }
}


__device__ __forceinline__ void quant_transpose_item(const float* W, int ldw, signed char* WT, const unsigned* wmaxw, LAS float* scr, int kb, int nb, int lane) {
    const int k0 = 64 * kb, n0 = 32 * nb;
#pragma unroll 8
    for (int i = 0; i < 32; ++i) { const int kk = 2 * i + (lane >> 5); scr[kk * 33 + (lane & 31)] = W[(size_t)(k0 + kk) * ldw + n0 + (lane & 31)]; }
    LDS_WAIT(); asm volatile("" ::: "memory");
    const int n = lane >> 1, hf = lane & 1;
    const float mx = __uint_as_float(wmaxw[n0 + n]), inv = mx > 0.f ? 127.f / mx : 0.f;
    u32x4 o[2];
#pragma unroll
    for (int q = 0; q < 8; ++q) { unsigned w = 0u;
#pragma unroll
        for (int b = 0; b < 4; ++b) { const int kk = 32 * hf + 4 * q + b; w |= ((unsigned)(int)rintf(scr[kk * 33 + n] * inv) & 255u) << (8 * b); }
        o[q >> 2][q & 3] = w; }
    u32x4* dst = (u32x4*)(WT + (size_t)(n0 + n) * 1024 + k0 + 32 * hf);
    dst[0] = o[0]; dst[1] = o[1];
    LDS_WAIT(); asm volatile("" ::: "memory");
}
__device__ __forceinline__ void phase_quant_weights(LAS unsigned char* lds) {
    const KArgs ap = get_args();
#define a (*ap)
    const int tid = fresh_tid(), lane = tid & 63, wave = __builtin_amdgcn_readfirstlane(tid >> 6), G = fresh_g(), bx = fresh_bx();
    unsigned char* ws = a.ws;
    LAS float* scr = (LAS float*)(lds + 65536 + wave * 8448);
    const unsigned* wmaxw = (const unsigned*)(ws + WS_CTL) + CW_WMAX;
    constexpr int I_IN = 16 * 96, I_OUT = 16 * 32, I_Q = 16 * 64, PER_L = I_IN + I_OUT + I_Q;
    for (int it = bx * 8 + wave; it < DEPTH * PER_L; it += G * 8) { const int l = it / PER_L; int r = it % PER_L;
        if (r < I_IN) quant_transpose_item(a.in[I_WIN] + (size_t)l * 1024 * NIN, NIN, (signed char*)(ws + WS_WINT) + (size_t)l * NP * 1024, wmaxw + (l * 3 + 0) * 3072, scr, r / 96, r % 96, lane);
        else if (r < I_IN + I_OUT) { r -= I_IN; quant_transpose_item(a.in[I_WOUT] + (size_t)l * 1024 * 1024, 1024, (signed char*)(ws + WS_WOUTT) + (size_t)l * 1024 * 1024, wmaxw + (l * 3 + 1) * 3072, scr, r / 32, r % 32, lane); }
        else { r -= I_IN + I_OUT; quant_transpose_item(a.in[I_WQ] + (size_t)l * 1024 * 2048, 2048, (signed char*)(ws + WS_WQT) + (size_t)l * 2048 * 1024, wmaxw + (l * 3 + 2) * 3072, scr, r / 64, r % 64, lane); } }
#undef a
}

template <bool SK>
__device__ __forceinline__ void phase_norm(int l, int which, LAS unsigned char* lds) {
    const KArgs ap = get_args();
#define a (*ap)

    const int tid = fresh_tid(), lane = tid & 63, wave = __builtin_amdgcn_readfirstlane(tid >> 6), G = fresh_g(), bx = fresh_bx();
    unsigned char* ws = a.ws;
    LAS float* wsk = (LAS float*)lds;
    if (SK) { const float* src = (const float*)(ws + WS_WSK) + (size_t)l * 16384; for (int i = tid; i < 16384 / 4; i += 512) ((LAS f32x4*)wsk)[i] = ((const f32x4*)src)[i]; __syncthreads(); }
    const int nrows = (which == 1 && l == DEPTH - 1) ? ML : M;
    const float* nw = a.in[which ? I_N2W : I_N1W] + l * 1024;
    const float* modl = (const float*)(ws + WS_MOD) + (size_t)l * 3 * 6144;
    const int shoff = which ? 3072 : 0, scoff = which ? 4096 : 1024;
    f32x4 nwv[4];
#pragma unroll
    for (int j = 0; j < 4; ++j) nwv[j] = *(const f32x4*)(nw + 4 * lane + 256 * j);
    for (int row = wave * G + bx; row < nrows; row += G * 8) {
        const float* src; int mrow;
        if (row < ML) { src = ((l == 0 && which == 0) ? a.in[I_X] : a.out) + (size_t)row * D; mrow = row >= T ? 1 : 0; }
        else { src = ((l == 0 && which == 0) ? a.in[I_CTX] : (const float*)(ws + WS_CTXX)) + (size_t)(row - ML) * D; mrow = 2; }
        const float* md = modl + mrow * 6144;
        f32x4 v[4]; float ss = 0.f;
#pragma unroll
        for (int j = 0; j < 4; ++j) { v[j] = *(const f32x4*)(src + 4 * lane + 256 * j); ss += (v[j][0] * v[j][0] + v[j][1] * v[j][1]) + (v[j][2] * v[j][2] + v[j][3] * v[j][3]); }
        const float rstd = rsqrtf(wave_sum(ss) * (1.f / D) + EPS);
        signed char* hrow = (signed char*)(ws + WS_H) + (size_t)row * D;
        float hmx = 0.f;
#pragma unroll
        for (int j = 0; j < 4; ++j) { const f32x4 sc = *(const f32x4*)(md + scoff + 4 * lane + 256 * j), sh = *(const f32x4*)(md + shoff + 4 * lane + 256 * j);
            v[j] = v[j] * rstd * nwv[j] * (sc + 1.f) + sh; hmx = fmaxf(hmx, fmaxf(fmaxf(fabsf(v[j][0]), fabsf(v[j][1])), fmaxf(fabsf(v[j][2]), fabsf(v[j][3])))); }
        hmx = fmaxf(wave_max(hmx), 1e-30f);
        { const float hinv = 127.f / hmx;
#pragma unroll
          for (int j = 0; j < 4; ++j) *(unsigned*)(hrow + 4 * lane + 256 * j) = ((unsigned)(int)rintf(v[j][0] * hinv) & 255u) | (((unsigned)(int)rintf(v[j][1] * hinv) & 255u) << 8) | (((unsigned)(int)rintf(v[j][2] * hinv) & 255u) << 16) | (((unsigned)(int)rintf(v[j][3] * hinv) & 255u) << 24);
          if (lane == 0) ((float*)(ws + WS_GB))[row] = hmx * (1.f / 127.f); }
        if (SK) {
            float p[16];
#pragma unroll
            for (int c = 0; c < 16; ++c) { float q = 0.f;
#pragma unroll
                for (int j = 0; j < 4; ++j) { const f32x4 w = *(const LAS f32x4*)(wsk + c * 1024 + 4 * lane + 256 * j); q += (v[j][0] * w[0] + v[j][1] * w[1]) + (v[j][2] * w[2] + v[j][3] * w[3]); }
                p[c] = q; }
            { const bool hb = (lane & 32) != 0;
#pragma unroll
              for (int c = 0; c < 8; ++c) { const float keep = hb ? p[c + 8] : p[c], send = hb ? p[c] : p[c + 8]; p[c] = keep + lane_xor<32>(send); } }
            { const bool hb = (lane & 16) != 0;
#pragma unroll
              for (int c = 0; c < 4; ++c) { const float keep = hb ? p[c + 4] : p[c], send = hb ? p[c] : p[c + 4]; p[c] = keep + lane_xor<16>(send); } }
            { const bool hb = (lane & 8) != 0;
#pragma unroll
              for (int c = 0; c < 2; ++c) { const float keep = hb ? p[c + 2] : p[c], send = hb ? p[c] : p[c + 2]; p[c] = keep + lane_xor<8>(send); } }
            { const bool hb = (lane & 4) != 0; const float keep = hb ? p[1] : p[0], send = hb ? p[0] : p[1]; p[0] = keep + lane_xor<4>(send); }
            p[0] += lane_xor<2>(p[0]); p[0] += lane_xor<1>(p[0]);
            if ((lane & 3) == 0) { const int c = ((lane >> 5) & 1) * 8 + ((lane >> 4) & 1) * 4 + ((lane >> 3) & 1) * 2 + ((lane >> 2) & 1); ((float*)(ws + WS_BA))[(size_t)row * 16 + c] = p[0]; }
        }
    }
    if (SK) __syncthreads();
}

__device__ __forceinline__ void phase_prep(int l, LAS unsigned char* lds) {
    const KArgs ap = get_args();
#define a (*ap)

    const int tid = fresh_tid(), lane = tid & 63, wave = __builtin_amdgcn_readfirstlane(tid >> 6), G = fresh_g(), bx = fresh_bx();
    unsigned char* ws = a.ws;
    const bf16_t* P = (const bf16_t*)(ws + WS_P);
    const float* ropec = (const float*)(ws + WS_ROPE); const float* ropes = ropec + 8192;
    const int sec = lane >> 5, fi = lane & 31;
    const float qw0 = a.in[I_QNW][l * 128 + sec * 64 + fi], qw1 = a.in[I_QNW][l * 128 + sec * 64 + 32 + fi];
    const float kw0 = a.in[I_KNW][l * 128 + sec * 64 + fi], kw1 = a.in[I_KNW][l * 128 + sec * 64 + 32 + fi];
    for (int row = wave * G + bx; row < M; row += G * 8) {
        const bool lat = row < ML;
        int b, tt, tlen; if (lat) { b = row >> 14; tt = row & (T - 1); tlen = T; } else { b = (row - ML) >> 8; tt = (row - ML) & (CT - 1); tlen = CT; }
        const bf16_t* prow = P + (size_t)row * NP;
        unsigned short xa[6][2];
#pragma unroll
        for (int hh = 0; hh < 6; ++hh) { const bf16_t* xp = prow + (hh < 4 ? hh * 128 : 512 + (hh - 4) * 128) + sec * 64 + fi; xa[hh][0] = xp[0]; xa[hh][1] = xp[32]; }
        const u32x2 vcp = *(const u32x2*)(prow + 768 + 4 * lane);
        float cs = 1.f, sn = 0.f;
        if (lat) { const int pos = sec ? (tt & 63) : (tt >> 6); cs = ropec[pos * 32 + fi]; sn = ropes[pos * 32 + fi]; }
        unsigned char* qo8 = ws + WS_QA + (size_t)row * 512;
        const size_t kvrow = (size_t)b * KVLEN + (lat ? tt : T + tt);
        unsigned char* ko8 = ws + WS_KA + kvrow * 256;
        float ssq[6];
#pragma unroll
        for (int hh = 0; hh < 6; ++hh) { const float x0 = bf2f(xa[hh][0]), x1 = bf2f(xa[hh][1]); ssq[hh] = x0 * x0 + x1 * x1; }
#pragma unroll
        for (int hh = 0; hh < 6; ++hh) ssq[hh] = wave_sum(ssq[hh]);
#pragma unroll
        for (int hh = 0; hh < 6; ++hh) {
            const float x0 = bf2f(xa[hh][0]), x1 = bf2f(xa[hh][1]);
            const float rs = rsqrtf(ssq[hh] * (1.f / 128.f) + EPS);
            const float y0 = x0 * rs * (hh < 4 ? qw0 : kw0), y1 = x1 * rs * (hh < 4 ? qw1 : kw1);
            const float qsc = hh < 4 ? 0.088388347648318440f * 1.4426950408889634f : 1.f;
            const float o0 = (y0 * cs - y1 * sn) * qsc, o1 = (y1 * cs + y0 * sn) * qsc;
            unsigned char* op8 = (hh < 4 ? qo8 + hh * 128 : ko8 + (hh - 4) * 128) + sec * 64 + fi;
            const float f8s = hh < 4 ? 8.f : 1.f;
            const int pk8 = __builtin_amdgcn_cvt_pk_fp8_f32(o0 * f8s, o1 * f8s, 0, false);
            op8[0] = (unsigned char)(pk8 & 255); op8[32] = (unsigned char)((pk8 >> 8) & 255);
        }
        { const int pos = lat ? tt : T + tt, tile = pos >> 6, k64 = pos & 63, k32 = k64 & 31;
          const int bytepos = 32 * ((k32 >> 2) & 1) + 16 * (k64 >> 5) + (k32 & 3) + 4 * (k32 >> 3);
          unsigned char* vt = ws + WS_VA + ((size_t)(b * 2) * (KVLEN / 64) + tile) * 8192 + bytepos;
          const unsigned short* vsrc = (const unsigned short*)&vcp;
          const int kvh_ = lane >> 5, d0 = (4 * lane) & 127;
          const int pk01 = __builtin_amdgcn_cvt_pk_fp8_f32(bf2f(vsrc[0]), bf2f(vsrc[1]), 0, false), pk23 = __builtin_amdgcn_cvt_pk_fp8_f32(bf2f(vsrc[2]), bf2f(vsrc[3]), 0, false);
          unsigned char* vt2 = vt + (size_t)kvh_ * (KVLEN / 64) * 8192 + (size_t)d0 * 64;
          vt2[0] = (unsigned char)(pk01 & 255); vt2[64] = (unsigned char)((pk01 >> 8) & 255); vt2[128] = (unsigned char)(pk23 & 255); vt2[192] = (unsigned char)((pk23 >> 8) & 255); }
    }
    __syncthreads();
}

constexpr int ATT_PARTS = 4;
__device__ __forceinline__ void phase_attn(int l, unsigned char* lds_raw, volatile LAS unsigned* MISC, int rep) {
    const KArgs ap = get_args();
#define a (*ap)
    unsigned char* ws = a.ws;
    const unsigned char* QA = ws + WS_QA; const unsigned char* KA = ws + WS_KA; const unsigned char* VT = ws + WS_VA;
    bf16_t* CAT = (bf16_t*)(ws + WS_CAT); float* LSE = (float*)(ws + WS_BA);
    unsigned* ctr = (unsigned*)(ws + WS_CTL) + 8192 + 64 * l + 1024 * rep;
    const int natt = 2048 + (l < DEPTH - 1 ? 8 : 0);
    constexpr int CONV_ROWS = 64, NCONV = 2 * NEXP / CONV_ROWS;
    const int nunits = natt + (l + 1 < DEPTH ? NCONV : 0);
    float braw;
    { const int ln = threadIdx.x & 63; float mq = fmaxf(fabsf(a.in[I_QNW][l * 128 + ln]), fabsf(a.in[I_QNW][l * 128 + 64 + ln])), mk = fmaxf(fabsf(a.in[I_KNW][l * 128 + ln]), fabsf(a.in[I_KNW][l * 128 + 64 + ln]));
      mq = wave_max(mq); mk = wave_max(mk);
      braw = __builtin_bit_cast(float, __builtin_amdgcn_readfirstlane(__builtin_bit_cast(int, 128.f * mq * mk))); }
    if (threadIdx.x == 0) MISC[12] = __hip_atomic_fetch_add(ctr, 1u, __ATOMIC_RELAXED, __HIP_MEMORY_SCOPE_AGENT);
    __syncthreads();
    int u = (int)MISC[12], par = 0;
    for (; u < nunits; ) {
        if (threadIdx.x == 0) MISC[13 - par] = __hip_atomic_fetch_add(ctr, 1u, __ATOMIC_RELAXED, __HIP_MEMORY_SCOPE_AGENT);
        if (u >= natt) {
            const int rwb = (u - natt) * CONV_ROWS + (int)(threadIdx.x >> 6) * 8;
            convert_tables(a.in[I_U], a.in[I_V], ws, l + 1, rwb, 1, (int)(threadIdx.x & 63), rwb + 8);
            __syncthreads();
            u = (int)MISC[13 - par]; par ^= 1;
            continue;
        }
        size_t r0, kv0; int h, kvh, seq, ldo; bf16_t* ob; float* lse;
        if (u < 2048) { const int qb = u & 63, g = (u >> 6) & 1, part = (u >> 7) & 3, b = u >> 10; kvh = (u >> 9) & 1; h = kvh * 2 + g;
            const int t0 = (part >> 1) * 130 + (part & 1) * 64;
            r0 = (size_t)b * T + (size_t)qb * 256; kv0 = (size_t)b * KVLEN + (size_t)t0 * 64; seq = ((part & 1) ? 66 : 64) * 64;
            ob = part ? (bf16_t*)(ws + (part == 1 ? WS_DQ : part == 2 ? WS_DK : WS_DV)) + r0 * 512 + h * 128 : CAT + r0 * 1024 + h * 128; ldo = part ? 512 : 1024; lse = LSE + ((size_t)part * ML + r0) * 4 + h; }
        else { const int b = (u - 2048) >> 2; h = (u - 2048) & 3; kvh = h >> 1; r0 = (size_t)ML + (size_t)b * CT; kv0 = (size_t)b * KVLEN + T; seq = CT;
            ob = CAT + r0 * 1024 + h * 128; ldo = 1024; lse = nullptr; }
        att::attn_dense_body(QA + r0 * 512 + h * 128, KA + kv0 * 256 + kvh * 128, VT + ((size_t)((kv0 / KVLEN) * 2 + kvh) * (KVLEN / 64) + (kv0 % KVLEN) / 64) * 8192, ob, ldo, seq, (char*)lds_raw, lse, braw);
        u = (int)MISC[13 - par]; par ^= 1;
    }
#undef a
}

__device__ __forceinline__ int tokperm(int q, int hh, int jj) { return 16 * q + 8 * (jj >> 2) + 4 * hh + (jj & 3); }
__device__ __forceinline__ int crow16(int r, int hi) { return (r & 3) + 8 * (r >> 2) + 4 * hi; }
__device__ __forceinline__ int kperm16(int s_, int g, int jj) { return 32 * s_ + 16 * (jj >> 2) + 4 * g + (jj & 3); }
__device__ __forceinline__ int frag_off(int i, int j) {
    return (((i >> 4) * 2 + (j >> 5)) * 64 + ((i & 15) + 16 * ((j >> 2) & 3))) * 16 + (4 * ((j >> 4) & 1) + (j & 3)) * 2;
}
template <int MODE>
__device__ __forceinline__ void phase_dn_chunkprep(int l, LAS unsigned char* lds) {
    const KArgs ap = get_args();
#define a (*ap)
    const int tid = fresh_tid(), lane = tid & 63, wave = __builtin_amdgcn_readfirstlane(tid >> 6), G = fresh_g(), bx = fresh_bx();
    unsigned char* ws = a.ws;
    constexpr int KT_OFF = 0, QT_OFF = 17408, VT_OFF = 34816, GS_OFF = 52224, RS_OFF = 68864, AM_OFF = 85504, SC_OFF = 120320, IMG_OFF = 0;
    const int r = lane & 31, hh = lane >> 5;
    const bf16_t* DQ = (const bf16_t*)(ws + WS_DQ); const bf16_t* DK = (const bf16_t*)(ws + WS_DK); const bf16_t* DV = (const bf16_t*)(ws + WS_DV);
    const float* BA = (const float*)(ws + WS_BA);
    constexpr int NTASK = MODE ? NB * 4 * 4 : NB * 4 * (NCH - 4);
#define CP_TASKID(t_) (MODE ? ((t_) >> 2) * NCH + ((t_) & 3) : ((t_) >> 8) * NCH + 4 + ((t_) & 255))
    LAS float* gsc = (LAS float*)(lds + SC_OFF);
    LAS float* bsc = gsc + 128;
    LAS float* gcs = gsc + 256;
    constexpr int CW_OFF = 121856;
    LAS float* cwl = (LAS float*)(lds + CW_OFF);
    for (int i = tid; i < 5 * 1536; i += 512) cwl[i] = a.in[I_CONVW][(size_t)l * 5 * 1536 + i];
    __syncthreads();
    const bf16_t* P = (const bf16_t*)(ws + WS_P);
    u32x4 xin[3][5][2];
#define CP_LOADX(task_) do { const int cidx_ = (task_) % NCH, bh_ = (task_) / NCH, b_ = bh_ >> 2, h_ = bh_ & 3; \
        const int row0_ = cidx_ < 4 ? ML + b_ * CT + cidx_ * 64 : b_ * T + (cidx_ - 4) * 64, tt_ = (cidx_ < 4 ? cidx_ * 64 : (cidx_ - 4) * 64) + (tid >> 3), tlen_ = cidx_ < 4 ? CT : T; \
        _Pragma("unroll") for (int j = 0; j < 5; ++j) { const int t2 = tt_ + j - 2; const bool ok = t2 >= 0 && t2 < tlen_; \
            const bf16_t* xr = P + (size_t)(row0_ + (tid >> 3) + (ok ? j - 2 : 0)) * NP + 1024 + h_ * 128 + (tid & 7) * 16; \
            _Pragma("unroll") for (int m = 0; m < 3; ++m) { const u32x4 w0 = *(const u32x4*)(xr + m * 512), w1 = *(const u32x4*)(xr + m * 512 + 8); \
                xin[m][j][0] = ok ? w0 : (u32x4){0u, 0u, 0u, 0u}; xin[m][j][1] = ok ? w1 : (u32x4){0u, 0u, 0u, 0u}; } } } while (0)
    if (bx < NTASK) CP_LOADX(CP_TASKID(bx));
    for (int tk = bx; tk < NTASK; tk += G) {
        const int task = CP_TASKID(tk);
        const int cidx = task % NCH, bh = task / NCH, b = bh >> 2, h = bh & 3;
        const int row0 = cidx < 4 ? ML + b * CT + cidx * 64 : b * T + (cidx - 4) * 64;
        unsigned char* rec = ws + WS_REC + (size_t)task * REC_BYTES;
        {
            const int rr = tid >> 3, seg = tid & 7;
            if (tid < 128) { const int d = tid >> 6, i = tid & 63, dh = d * 4 + h;
                const float xb = BA[(size_t)(row0 + i) * 16 + dh], z = BA[(size_t)(row0 + i) * 16 + 8 + dh] + a.in[I_DTB][l * 8 + dh];
                bsc[tid] = 1.f / (1.f + __expf(-xb)); gsc[tid] = -__expf(a.in[I_ALOG][l * 8 + dh]) * (fmaxf(z, 0.f) + log1pf(__expf(-fabsf(z)))); }
#pragma unroll
            for (int m = 0; m < 3; ++m) {
                float y[16];
#pragma unroll
                for (int c = 0; c < 16; ++c) y[c] = 0.f;
#pragma unroll
                for (int j = 0; j < 5; ++j) { const LAS float* wp = cwl + j * 1536 + m * 512 + h * 128 + seg * 16;
#pragma unroll
                    for (int q4 = 0; q4 < 4; ++q4) { const f32x4 wv = *(const LAS f32x4*)(wp + 4 * q4); const unsigned u0 = xin[m][j][q4 >> 1][2 * (q4 & 1)], u1 = xin[m][j][q4 >> 1][2 * (q4 & 1) + 1];
                        y[4 * q4 + 0] = fmaf(bflo(u0), wv[0], y[4 * q4 + 0]); y[4 * q4 + 1] = fmaf(bfhi(u0), wv[1], y[4 * q4 + 1]); y[4 * q4 + 2] = fmaf(bflo(u1), wv[2], y[4 * q4 + 2]); y[4 * q4 + 3] = fmaf(bfhi(u1), wv[3], y[4 * q4 + 3]); } }
                float ss = 0.f;
#pragma unroll
                for (int c = 0; c < 16; ++c) { y[c] = silu_f(y[c]); ss = fmaf(y[c], y[c], ss); }
                if (m < 2) { ss += lane_xor<1>(ss); ss += lane_xor<2>(ss); ss += lane_xor<4>(ss);
                    float sc = rsqrtf(ss + EPS); if (m == 0) sc *= 0.088388347648318440f;
#pragma unroll
                    for (int c = 0; c < 16; ++c) y[c] *= sc; }
                u32x4 o0, o1; o0.x = pkbf(y[0], y[1]); o0.y = pkbf(y[2], y[3]); o0.z = pkbf(y[4], y[5]); o0.w = pkbf(y[6], y[7]); o1.x = pkbf(y[8], y[9]); o1.y = pkbf(y[10], y[11]); o1.z = pkbf(y[12], y[13]); o1.w = pkbf(y[14], y[15]);
                LAS unsigned char* dst = lds + (m == 0 ? QT_OFF : m == 1 ? KT_OFF : VT_OFF) + rr * 272 + seg * 32;
                *(LAS u32x4*)dst = o0; *(LAS u32x4*)(dst + 16) = o1;
            }
        }
        __syncthreads();
        {
            const int mat = wave >> 2, ti = (wave >> 1) & 1, tj = wave & 1;
            f32x16 acc = {};
#pragma unroll
            for (int ks = 0; ks < 8; ++ks) {
                const bf16x8 av = *(const LAS bf16x8*)(lds + (mat ? QT_OFF : KT_OFF) + (32 * ti + r) * 272 + (16 * ks + 8 * hh) * 2);
                const bf16x8 bv = *(const LAS bf16x8*)(lds + KT_OFF + (32 * tj + r) * 272 + (16 * ks + 8 * hh) * 2);
                acc = __builtin_amdgcn_mfma_f32_32x32x16_bf16(av, bv, acc, 0, 0, 0);
            }
            LAS float* dst = (LAS float*)(lds + (mat ? RS_OFF : GS_OFF));
#pragma unroll
            for (int i = 0; i < 16; ++i) dst[(32 * ti + crow16(i, hh)) * 65 + 32 * tj + r] = acc[i];
        }
        { const int r16 = lane & 15, g4 = lane >> 4;
#pragma unroll
        for (int t = 0; t < 2; ++t) { const int f = wave * 2 + t, mt = f >> 2, sk = f & 3;
            { const u32x2 lo = *(const LAS u32x2*)(lds + KT_OFF + (16 * mt + r16) * 272 + (32 * sk + 4 * g4) * 2), hi2 = *(const LAS u32x2*)(lds + KT_OFF + (16 * mt + r16) * 272 + (32 * sk + 16 + 4 * g4) * 2);
              *(u32x4*)(rec + REC_K + f * 1024 + lane * 16) = (u32x4){lo.x, lo.y, hi2.x, hi2.y}; }
            { const u32x2 lo = *(const LAS u32x2*)(lds + QT_OFF + (16 * mt + r16) * 272 + (32 * sk + 4 * g4) * 2), hi2 = *(const LAS u32x2*)(lds + QT_OFF + (16 * mt + r16) * 272 + (32 * sk + 16 + 4 * g4) * 2);
              *(u32x4*)(rec + REC_Q + f * 1024 + lane * 16) = (u32x4){lo.x, lo.y, hi2.x, hi2.y}; } }
#pragma unroll
        for (int t = 0; t < 2; ++t) { const int f = wave * 2 + t, mt = f >> 1, sk = f & 1;
            unsigned e[8];
#pragma unroll
            for (int jj = 0; jj < 8; ++jj) e[jj] = *(const LAS unsigned short*)(lds + KT_OFF + kperm16(sk, g4, jj) * 272 + (16 * mt + r16) * 2);
            *(u32x4*)(rec + REC_KT + f * 1024 + lane * 16) = (u32x4){e[0] | (e[1] << 16), e[2] | (e[3] << 16), e[4] | (e[5] << 16), e[6] | (e[7] << 16)}; }
        { const int sl = wave;
            unsigned e[16];
#pragma unroll
            for (int i = 0; i < 16; ++i) e[i] = *(const LAS unsigned short*)(lds + VT_OFF + (16 * (i >> 2) + 4 * g4 + (i & 3)) * 272 + (16 * sl + r16) * 2);
            u32x4* vp = (u32x4*)(rec + REC_V + sl * 2048 + lane * 32);
            vp[0] = (u32x4){e[0] | (e[1] << 16), e[2] | (e[3] << 16), e[4] | (e[5] << 16), e[6] | (e[7] << 16)};
            vp[1] = (u32x4){e[8] | (e[9] << 16), e[10] | (e[11] << 16), e[12] | (e[13] << 16), e[14] | (e[15] << 16)}; }
        }
        if (tk + G < NTASK) CP_LOADX(CP_TASKID(tk + G));
        if (wave < 2) { const int d = wave; float gv = gsc[d * 64 + (d ? 63 - lane : lane)];
            gv += __builtin_bit_cast(float, __builtin_amdgcn_update_dpp(0, __builtin_bit_cast(int, gv), 0x111, 0xF, 0xF, true));
            gv += __builtin_bit_cast(float, __builtin_amdgcn_update_dpp(0, __builtin_bit_cast(int, gv), 0x112, 0xF, 0xF, true));
            gv += __builtin_bit_cast(float, __builtin_amdgcn_update_dpp(0, __builtin_bit_cast(int, gv), 0x114, 0xF, 0xF, true));
            gv += __builtin_bit_cast(float, __builtin_amdgcn_update_dpp(0, __builtin_bit_cast(int, gv), 0x118, 0xF, 0xF, true));
            { const float t0 = __builtin_bit_cast(float, __builtin_amdgcn_readlane(__builtin_bit_cast(int, gv), 15)), t1 = __builtin_bit_cast(float, __builtin_amdgcn_readlane(__builtin_bit_cast(int, gv), 31)), t2 = __builtin_bit_cast(float, __builtin_amdgcn_readlane(__builtin_bit_cast(int, gv), 47));
              const int rw_ = lane >> 4; gv += (rw_ >= 1 ? t0 : 0.f) + (rw_ >= 2 ? t1 : 0.f) + (rw_ >= 3 ? t2 : 0.f); }
            gcs[d * 64 + lane] = gv; }
        __syncthreads();
        const LAS float* Gs = (const LAS float*)(lds + GS_OFF); const LAS float* Rs = (const LAS float*)(lds + RS_OFF);
#pragma unroll 4
        for (int t = 0; t < 16; ++t) { const int e = tid + 512 * t, d = e >> 12, jp = (e >> 6) & 63, ip = e & 63;
            const int in_ = d ? 63 - ip : ip, jn = d ? 63 - jp : jp;
            const float dec = __expf(fminf(gcs[d * 64 + ip] - gcs[d * 64 + jp], 0.f));
            const float av = (jp < ip) ? bsc[d * 64 + in_] * Gs[in_ * 65 + jn] * dec : 0.f;
            ((LAS float*)(lds + AM_OFF))[d * 4352 + jp * 68 + ip] = av;
            const float qk = (jp <= ip) ? Rs[in_ * 65 + jn] * dec : 0.f;
            *(LAS unsigned short*)(lds + IMG_OFF + d * 16384 + 8192 + frag_off(in_, jn)) = (unsigned short)(pkbf(qk, 0.f) & 0xffffu); }
        __syncthreads();
        if (wave < 2) { const int d = wave, c = lane, jn = d ? 63 - c : c; const float bj = bsc[d * 64 + jn];
            const LAS float* At = (const LAS float*)(lds + AM_OFF) + d * 4352;
            LAS float* Xm = (LAS float*)(lds + GS_OFF) + d * 4096 + c;
            const int fj = (jn >> 5) * 1024 + ((jn >> 2) & 3) * 256 + ((jn >> 4) & 1) * 8 + (jn & 3) * 2;
#pragma unroll 1
            for (int B = 0; B < 4; ++B) {
                float acc[16];
#pragma unroll
                for (int q = 0; q < 16; ++q) acc[q] = (16 * B + q == c) ? 1.f : 0.f;
#pragma unroll 4
                for (int j = 0; j < 16 * B; ++j) { const float xj = Xm[j * 64];
                    const f32x4 a0 = *(const LAS f32x4*)(At + j * 68 + 16 * B), a1 = *(const LAS f32x4*)(At + j * 68 + 16 * B + 4), a2 = *(const LAS f32x4*)(At + j * 68 + 16 * B + 8), a3 = *(const LAS f32x4*)(At + j * 68 + 16 * B + 12);
#pragma unroll
                    for (int q = 0; q < 4; ++q) { acc[q] = fmaf(-a0[q], xj, acc[q]); acc[4 + q] = fmaf(-a1[q], xj, acc[4 + q]); acc[8 + q] = fmaf(-a2[q], xj, acc[8 + q]); acc[12 + q] = fmaf(-a3[q], xj, acc[12 + q]); } }
#pragma unroll
                for (int r2 = 0; r2 < 15; ++r2) { const LAS float* ar = At + (16 * B + r2) * 68 + 16 * B; const float xr = acc[r2];
#pragma unroll
                    for (int q4 = (r2 + 1) / 4; q4 < 4; ++q4) { const f32x4 a4 = *(const LAS f32x4*)(ar + 4 * q4);
#pragma unroll
                        for (int q = 0; q < 4; ++q) if (4 * q4 + q > r2) acc[4 * q4 + q] = fmaf(-a4[q], xr, acc[4 * q4 + q]); } }
#pragma unroll
                for (int q = 0; q < 16; ++q) { const int i = 16 * B + q, in_ = d ? 63 - i : i; Xm[i * 64] = acc[q];
                    *(LAS unsigned short*)(lds + IMG_OFF + d * 16384 + (in_ >> 4) * 2048 + (in_ & 15) * 16 + fj) = (unsigned short)(pkbf(acc[q] * bj, 0.f) & 0xffffu); }
            }
        } else if (wave < 4) { const int d = wave - 2, ip = d ? 63 - lane : lane; const float gl = gcs[d * 64 + 63], gi = gcs[d * 64 + ip];
            float* sc = (float*)(rec + REC_DIR + d * REC_DIRSZ + 16384);
            sc[lane] = __expf(gi); sc[64 + lane] = __expf(gl - gi); if (lane == 0) sc[128] = __expf(gl); }
        __syncthreads();
#pragma unroll
        for (int t = 0; t < 4; ++t) { const int p = tid + 512 * t, d = p >> 10, off = (p & 1023) * 16;
            *(u32x4*)(rec + REC_DIR + d * REC_DIRSZ + off) = *(const LAS u32x4*)(lds + IMG_OFF + d * 16384 + off); }
        __syncthreads();
    }
#undef CP_LOADX
#undef CP_TASKID
#undef a
}

__device__ __forceinline__ bf16x8 pack44(const f32x4& lo, const f32x4& hi) {
    u32x4 p; p.x = pkbf_c(lo[0], lo[1]); p.y = pkbf_c(lo[2], lo[3]); p.z = pkbf_c(hi[0], hi[1]); p.w = pkbf_c(hi[2], hi[3]);
    return __builtin_bit_cast(bf16x8, p);
}
template <int VAR>
__device__ __forceinline__ void phase_dn_scan(int l, LAS unsigned char* lds) {
    const KArgs ap = get_args();
#define a (*ap)
    const int tid = fresh_tid(), lane = tid & 63, wave = __builtin_amdgcn_readfirstlane(tid >> 6), bx = fresh_bx();
    unsigned char* ws = a.ws;
    if (bx >= 32) return;
    const int chain = bx >> 1, half = bx & 1, b = chain >> 3, h = (chain >> 1) & 3, dir = chain & 1;
    const unsigned char* recb = ws + WS_REC + (size_t)((b * 4 + h) * NCH) * REC_BYTES;
    constexpr int BUFSZ = 74752;
#define CIDX(n) (dir ? ((n) < 4 ? 3 - (n) : 263 - (n)) : (n))
    if (wave >= 4) {
        const int sw = wave - 4;
#define DN_PIECE(i_) ((sw + 4 * (i_)) < 73 ? (sw + 4 * (i_)) : 72)
#define DN_SRC(rec_, p_) ((p_) < 48 ? (rec_) + (p_) * 1024 : (p_) < 65 ? (rec_) + REC_DIR + dir * REC_DIRSZ + ((p_) - 48) * 1024 : (rec_) + REC_V + half * 8192 + ((p_) - 65) * 1024)
#define DN_STAGE(n, bi) do { const unsigned char* rec_ = recb + (size_t)CIDX(n) * REC_BYTES; _Pragma("unroll") for (int i_ = 0; i_ < 19; ++i_) { const int p_ = DN_PIECE(i_); \
        __builtin_amdgcn_global_load_lds((const unsigned*)(DN_SRC(rec_, p_) + lane * 16), (LAS unsigned*)(lds + (bi) * BUFSZ + p_ * 1024), 16, 0, 0); } } while (0)
#define DN_SYNC() do { asm volatile("s_waitcnt vmcnt(0)" ::: "memory"); __builtin_amdgcn_s_barrier(); asm volatile("" ::: "memory"); } while (0)
        if (VAR != 3) DN_STAGE(0, 0);
        DN_SYNC();
        for (int n = 0; n < NCH; ++n) {
            if (VAR != 3 && n + 1 < NCH) DN_STAGE(n + 1, (n + 1) & 1);
            DN_SYNC();
        }
#undef DN_STAGE
#undef DN_PIECE
#undef DN_SRC
#undef DN_SYNC
    } else {
        const int sl = half * 4 + wave, c16 = lane & 15, g4 = lane >> 4;
        float* Og = (float*)(ws + (dir ? WS_OB : WS_OF)) + h * 128 + sl * 16 + c16;
        f32x4 S[8];
#pragma unroll
        for (int i = 0; i < 8; ++i) S[i] = (f32x4){0.f, 0.f, 0.f, 0.f};
        asm volatile("s_waitcnt lgkmcnt(0)" ::: "memory"); __builtin_amdgcn_s_barrier(); asm volatile("" ::: "memory");
        for (int n = 0; n < NCH; ++n) {
            if (VAR == 2) { asm volatile("s_waitcnt lgkmcnt(0)" ::: "memory"); __builtin_amdgcn_s_barrier(); asm volatile("" ::: "memory"); continue; }
            const LAS unsigned char* buf = lds + (n & 1) * BUFSZ;
            const int cidx = CIDX(n);
            const u32x4 vc0 = *(const LAS u32x4*)(buf + 66560 + wave * 2048 + lane * 32), vc1 = *(const LAS u32x4*)(buf + 66560 + wave * 2048 + lane * 32 + 16);
#define FR(off, f) (*(const LAS bf16x8*)(buf + (off) + (f) * 1024 + lane * 16))
#define MF(A, B, C) __builtin_amdgcn_mfma_f32_16x16x32_bf16((A), (B), (C), 0, 0, 0)
#define SB_() __builtin_amdgcn_sched_barrier(0)
            bf16x8 fa[8], fb[8];
            f32x4 eg[4], dl[4];
#pragma unroll
            for (int mt = 0; mt < 4; ++mt) { eg[mt] = *(const LAS f32x4*)(buf + 65536 + (16 * mt + 4 * g4) * 4); dl[mt] = *(const LAS f32x4*)(buf + 65536 + 256 + (16 * mt + 4 * g4) * 4); }
            const float egl = *(const LAS float*)(buf + 65536 + 512);
#define RD_KQ(dst, q) do { _Pragma("unroll") for (int mt = 0; mt < 4; ++mt) { dst[mt] = FR(0, mt * 4 + (q)); dst[4 + mt] = FR(32768, mt * 4 + (q)); } } while (0)
#define MM_KQ(src, q) do { _Pragma("unroll") for (int mt = 0; mt < 4; ++mt) { X[mt] = MF(src[mt], Sb[q], X[mt]); O[mt] = MF(src[4 + mt], Sb[q], O[mt]); } } while (0)
            f32x4 X[4], O[4], VN[4];
#pragma unroll
            for (int i = 0; i < 4; ++i) { X[i] = (f32x4){0.f, 0.f, 0.f, 0.f}; O[i] = (f32x4){0.f, 0.f, 0.f, 0.f}; VN[i] = (f32x4){0.f, 0.f, 0.f, 0.f}; }
            bf16x8 Sb[4];
#pragma unroll
            for (int q = 0; q < 4; ++q) Sb[q] = pack44(S[2 * q], S[2 * q + 1]);
            RD_KQ(fa, 0); SB_();
            RD_KQ(fb, 1); SB_(); MM_KQ(fa, 0); SB_();
            RD_KQ(fa, 2); SB_(); MM_KQ(fb, 1); SB_();
            RD_KQ(fb, 3); SB_(); MM_KQ(fa, 2); SB_();
#pragma unroll
            for (int i = 0; i < 8; ++i) fa[i] = FR(49152, i);
            SB_(); MM_KQ(fb, 3); SB_();
#pragma unroll
            for (int mt = 0; mt < 4; ++mt) { const unsigned w0 = (mt < 2 ? vc0 : vc1)[2 * (mt & 1)], w1 = (mt < 2 ? vc0 : vc1)[2 * (mt & 1) + 1];
                X[mt][0] = bflo(w0) - eg[mt][0] * X[mt][0]; X[mt][1] = bfhi(w0) - eg[mt][1] * X[mt][1]; X[mt][2] = bflo(w1) - eg[mt][2] * X[mt][2]; X[mt][3] = bfhi(w1) - eg[mt][3] * X[mt][3]; }
            const bf16x8 Yb0 = pack44(X[0], X[1]), Yb1 = pack44(X[2], X[3]);
            SB_();
#pragma unroll
            for (int i = 0; i < 8; ++i) fb[i] = FR(57344, i);
            SB_();
#pragma unroll
            for (int mt = 0; mt < 4; ++mt) { VN[mt] = MF(fa[mt * 2], Yb0, VN[mt]); VN[mt] = MF(fa[mt * 2 + 1], Yb1, VN[mt]); }
            SB_();
#pragma unroll
            for (int mt = 0; mt < 4; ++mt) O[mt] = O[mt] * eg[mt];
            const bf16x8 Vb0 = pack44(VN[0], VN[1]), Vb1 = pack44(VN[2], VN[3]);
            SB_();
#pragma unroll
            for (int i = 0; i < 8; ++i) fa[i] = FR(16384, i);
            SB_();
#pragma unroll
            for (int mt = 0; mt < 4; ++mt) { O[mt] = MF(fb[mt * 2], Vb0, O[mt]); O[mt] = MF(fb[mt * 2 + 1], Vb1, O[mt]); }
            SB_();
#pragma unroll
            for (int mt = 0; mt < 4; ++mt) VN[mt] = VN[mt] * dl[mt];
            const bf16x8 Vd0 = pack44(VN[0], VN[1]), Vd1 = pack44(VN[2], VN[3]);
#pragma unroll
            for (int i = 0; i < 8; ++i) S[i] = S[i] * egl;
            SB_();
#pragma unroll
            for (int i = 0; i < 8; ++i) fb[i] = FR(16384, 8 + i);
            SB_();
#pragma unroll
            for (int i = 0; i < 4; ++i) { S[i] = MF(fa[i * 2], Vd0, S[i]); S[i] = MF(fa[i * 2 + 1], Vd1, S[i]); }
            SB_();
#pragma unroll
            for (int i = 0; i < 4; ++i) { S[4 + i] = MF(fb[i * 2], Vd0, S[4 + i]); S[4 + i] = MF(fb[i * 2 + 1], Vd1, S[4 + i]); }
            SB_();
            {
                const int row0 = cidx < 4 ? ML + b * CT + cidx * 64 : b * T + (cidx - 4) * 64;
                float* op = Og + (size_t)(row0 + 4 * g4) * 512;
#pragma unroll
                for (int mt = 0; mt < 4; ++mt)
#pragma unroll
                    for (int t = 0; t < 4; ++t) { if (VAR != 1) op[(size_t)(16 * mt + t) * 512] = O[mt][t]; else asm volatile("" :: "v"(O[mt][t])); }
            }
#undef RD_KQ
#undef MM_KQ
#undef SB_
#undef FR
#undef MF
            asm volatile("s_waitcnt lgkmcnt(0)" ::: "memory"); __builtin_amdgcn_s_barrier(); asm volatile("" ::: "memory");
        }
    }
#undef CIDX
#undef a
}

__device__ __forceinline__ void phase_dn_out(int l) {
    const KArgs ap = get_args();
#define a (*ap)

    const int tid = fresh_tid(), lane = tid & 63, wave = __builtin_amdgcn_readfirstlane(tid >> 6), G = fresh_g(), bx = fresh_bx();
    unsigned char* ws = a.ws;
    const int nrows = (l == DEPTH - 1) ? ML : M;
    const float* OF = (const float*)(ws + WS_OF); const float* OB = (const float*)(ws + WS_OB);
    const bf16_t* P = (const bf16_t*)(ws + WS_P); bf16_t* CAT = (bf16_t*)(ws + WS_CAT);
    const f32x2 nw = *(const f32x2*)(a.in[I_DNW] + l * 128 + 2 * lane);
    const float* LSE = (const float*)(ws + WS_BA);
    for (int row = wave * G + bx; row < nrows; row += G * 8) {
        f32x2 of[4], ob[4]; unsigned gw[4];
#pragma unroll
        for (int hh = 0; hh < 4; ++hh) { of[hh] = *(const f32x2*)(OF + (size_t)row * 512 + hh * 128 + 2 * lane); ob[hh] = *(const f32x2*)(OB + (size_t)row * 512 + hh * 128 + 2 * lane);
            gw[hh] = *(const unsigned*)(P + (size_t)row * NP + 2560 + hh * 128 + 2 * lane); }
        u32x4 ap_[4]; float ls_[4];
#pragma unroll
        for (int p = 0; p < 4; ++p) { ap_[p] = (u32x4){0u, 0u, 0u, 0u}; ls_[p] = 0.f; }
        if (row < ML) {
            ap_[0] = *(const u32x4*)(CAT + (size_t)row * 1024 + 8 * lane); ap_[1] = *(const u32x4*)((const bf16_t*)(ws + WS_DQ) + (size_t)row * 512 + 8 * lane);
            ap_[2] = *(const u32x4*)((const bf16_t*)(ws + WS_DK) + (size_t)row * 512 + 8 * lane); ap_[3] = *(const u32x4*)((const bf16_t*)(ws + WS_DV) + (size_t)row * 512 + 8 * lane);
#pragma unroll
            for (int p = 0; p < 4; ++p) ls_[p] = LSE[((size_t)p * ML + row) * 4 + (lane >> 4)]; }
        float o0[4], o1[4], ssq[4];
#pragma unroll
        for (int hh = 0; hh < 4; ++hh) { o0[hh] = of[hh][0] + ob[hh][0]; o1[hh] = of[hh][1] + ob[hh][1]; ssq[hh] = o0[hh] * o0[hh] + o1[hh] * o1[hh]; }
#pragma unroll
        for (int hh = 0; hh < 4; ++hh) ssq[hh] = wave_sum(ssq[hh]);
        float mxv = 0.f;
#pragma unroll
        for (int hh = 0; hh < 4; ++hh) { const float rs = rsqrtf(ssq[hh] * (1.f / 128.f) + EPS); const float g0 = bflo(gw[hh]), g1 = bfhi(gw[hh]);
            o0[hh] = o0[hh] * rs * nw[0] * silu_f(g0); o1[hh] = o1[hh] * rs * nw[1] * silu_f(g1); mxv = fmaxf(mxv, fmaxf(fabsf(o0[hh]), fabsf(o1[hh]))); }
        float av[8];
        if (row < ML) { const float mx = fmaxf(fmaxf(ls_[0], ls_[1]), fmaxf(ls_[2], ls_[3]));
            float w_[4], wsum = 0.f;
#pragma unroll
            for (int p = 0; p < 4; ++p) { w_[p] = __expf(ls_[p] - mx); wsum += w_[p]; }
            const float inv = 1.f / wsum;
#pragma unroll
            for (int i = 0; i < 4; ++i) { float lo = 0.f, hi2 = 0.f;
#pragma unroll
                for (int p = 0; p < 4; ++p) { lo = fmaf(w_[p], bflo(ap_[p][i]), lo); hi2 = fmaf(w_[p], bfhi(ap_[p][i]), hi2); }
                av[2 * i] = lo * inv; av[2 * i + 1] = hi2 * inv; } }
        else { const u32x4 cw_ = *(const u32x4*)(CAT + (size_t)row * 1024 + 8 * lane);
#pragma unroll
            for (int i = 0; i < 4; ++i) { av[2 * i] = bflo(cw_[i]); av[2 * i + 1] = bfhi(cw_[i]); } }
#pragma unroll
        for (int i = 0; i < 8; ++i) mxv = fmaxf(mxv, fabsf(av[i]));
        mxv = fmaxf(wave_max(mxv), 1e-30f);
        const float cinv = 127.f / mxv;
        signed char* crow = (signed char*)(ws + WS_CATQ) + (size_t)row * 1024;
#define Q8_(x) ((unsigned)(int)rintf((x) * cinv) & 255u)
        { u32x2 o; o.x = Q8_(av[0]) | (Q8_(av[1]) << 8) | (Q8_(av[2]) << 16) | (Q8_(av[3]) << 24); o.y = Q8_(av[4]) | (Q8_(av[5]) << 8) | (Q8_(av[6]) << 16) | (Q8_(av[7]) << 24); *(u32x2*)(crow + 8 * lane) = o; }
#pragma unroll
        for (int hh = 0; hh < 4; ++hh) *(unsigned short*)(crow + 512 + hh * 128 + 2 * lane) = (unsigned short)(Q8_(o0[hh]) | (Q8_(o1[hh]) << 8));
#undef Q8_
        if (lane == 0) ((float*)(ws + WS_GB))[(1u << 18) + row] = mxv * (1.f / 127.f);
    }
#undef a
}

#define CE_DESC(a_, b_) do { const float hi_ = fmaxf(a_, b_), lo_ = fminf(a_, b_); a_ = hi_; b_ = lo_; } while (0)
__device__ __forceinline__ void bitonic_sort16_desc(float (&v)[16]) {
#pragma unroll
    for (int k = 2; k <= 16; k <<= 1)
#pragma unroll
        for (int j = k >> 1; j > 0; j >>= 1)
#pragma unroll
            for (int i = 0; i < 16; ++i) { const int p = i ^ j; if (p > i) { if ((i & k) == 0) CE_DESC(v[i], v[p]); else CE_DESC(v[p], v[i]); } }
}
__device__ __forceinline__ void merge_top16_desc(float (&lst)[16], const float (&nw)[16]) {
#pragma unroll
    for (int i = 0; i < 16; ++i) lst[i] = fmaxf(lst[i], nw[15 - i]);
#pragma unroll
    for (int j = 8; j > 0; j >>= 1)
#pragma unroll
        for (int i = 0; i < 16; ++i) { const int p = i ^ j; if (p > i) CE_DESC(lst[i], lst[p]); }
}
__device__ __forceinline__ void phase_peer_select(int l) {
    const KArgs ap = get_args();
#define a (*ap)
    const int tid = fresh_tid(), lane = tid & 63, wave = __builtin_amdgcn_readfirstlane(tid >> 6), G = fresh_g(), bx = fresh_bx();
    unsigned char* ws = a.ws;
    const int nrows = (l == DEPTH - 1) ? ML : M;
    const int ntask = (nrows / 32) * 4;
    const bf16_t* Q2 = (const bf16_t*)(ws + WS_P);
    const bf16_t* SKB = (const bf16_t*)(ws + WS_SKB) + (size_t)l * 8 * 2 * 128 * 128;
    int* PIDX = (int*)(ws + WS_PIDX); float* PGATE = (float*)(ws + WS_PGATE);
    const float NEG = -3.0e38f;
    const int r = lane & 31, hi = lane >> 5;
    for (int task = wave * G + bx; task < ntask; task += G * 8) {
        const int tg = task >> 2, hp = task & 3; const int row = tg * 32 + r;
        float mine0[16], mine1[16];
#pragma unroll
        for (int j = 0; j < 16; ++j) { mine0[j] = NEG; mine1[j] = NEG; }
        bf16x8 qA[8], kA[8];
        float lst[16];
#define SEL_QPTR(it_) (Q2 + (size_t)row * 2048 + (2 * hp + ((it_) >> 1)) * 256 + ((it_) & 1) * 128 + 8 * hi)
#define SEL_KPTR(it_, t_) (SKB + (size_t)(((2 * hp + ((it_) >> 1)) * 2 + ((it_) & 1)) * 128 + 32 * (t_) + r) * 128 + 8 * hi)
#define SEL_LDQ(dst, it_) do { const bf16_t* qp_ = SEL_QPTR(it_); _Pragma("unroll") for (int ks = 0; ks < 8; ++ks) dst[ks] = *(const bf16x8*)(qp_ + 16 * ks); } while (0)
#define SEL_LDK(dst, it_, t_) do { const bf16_t* kp_ = SEL_KPTR(it_, t_); _Pragma("unroll") for (int ks = 0; ks < 8; ++ks) dst[ks] = *(const bf16x8*)(kp_ + 16 * ks); } while (0)
#define SEL_RANK(qv, kv, t_) do { f32x16 acc = {}; _Pragma("unroll") for (int ks = 0; ks < 8; ++ks) acc = __builtin_amdgcn_mfma_f32_32x32x16_bf16(kv[ks], qv[ks], acc, 0, 0, 0); \
            const unsigned kb = (unsigned)(32 * (t_) + 4 * hi); float nw_[16]; \
            _Pragma("unroll") for (int i = 0; i < 16; ++i) nw_[i] = __uint_as_float((__float_as_uint(acc[i]) & 0xffffff80u) | (kb + (unsigned)((i & 3) + 8 * (i >> 2)))); \
            bitonic_sort16_desc(nw_); merge_top16_desc(lst, nw_); } while (0)
#define SB_() __builtin_amdgcn_sched_barrier(0)
#pragma unroll
        for (int j = 0; j < 16; ++j) lst[j] = NEG;
#pragma unroll 1
        for (int it = 0; it < 4; ++it) {
            SEL_LDQ(qA, it);
#pragma unroll 1
            for (int t = 0; t < 4; ++t) { SEL_LDK(kA, it, t); SEL_RANK(qA, kA, t); }
            float oth[16];
#pragma unroll
            for (int j = 0; j < 16; ++j) { auto rr = __builtin_amdgcn_permlane32_swap(__float_as_uint(lst[j]), __float_as_uint(lst[j]), false, false); oth[j] = __uint_as_float(hi ? rr[0] : rr[1]); }
            merge_top16_desc(lst, oth);
            const bool k0 = ((it >> 1) == hi) && ((it & 1) == 0), k1 = ((it >> 1) == hi) && ((it & 1) == 1);
#pragma unroll
            for (int j = 0; j < 16; ++j) { mine0[j] = k0 ? lst[j] : mine0[j]; mine1[j] = k1 ? lst[j] : mine1[j]; lst[j] = NEG; }
        }
#undef SB_
#undef SEL_QPTR
#undef SEL_KPTR
#undef SEL_LDQ
#undef SEL_LDK
#undef SEL_RANK
        const int h = 2 * hp + hi;
        float ts[16];
#pragma unroll
        for (int j = 0; j < 16; ++j) ts[j] = NEG;
#pragma unroll
        for (int i = 0; i < 16; ++i)
#pragma unroll
            for (int j = 0; j < 16; ++j) if ((i + 1) * (j + 1) <= 16) {
                const unsigned b0 = __float_as_uint(mine0[i]), b1 = __float_as_uint(mine1[j]);
                const float c = __uint_as_float(b0 & 0xffffff80u) + __uint_as_float(b1 & 0xffffff80u);
                float x = __uint_as_float((__float_as_uint(c) & 0xffffc000u) | ((b0 & 127u) << 7) | (b1 & 127u));
#pragma unroll
                for (int t = 0; t < 16; ++t) { const float hv = fmaxf(ts[t], x); x = fminf(ts[t], x); ts[t] = hv; }
            }
        int te[16]; float ex[16], sum = 0.f;
        const float tmax = __uint_as_float(__float_as_uint(ts[0]) & 0xffffc000u);
#pragma unroll
        for (int t = 0; t < 16; ++t) { const unsigned bt = __float_as_uint(ts[t]); te[t] = (int)(bt & 0x3fffu); ex[t] = __expf(__uint_as_float(bt & 0xffffc000u) - tmax); sum += ex[t]; }
        const float inv = 1.f / sum;
        int* ip = PIDX + (size_t)row * 128 + h * 16; float* gp = PGATE + (size_t)row * 128 + h * 16;
#pragma unroll
        for (int t = 0; t < 16; t += 4) { *(u32x4*)(ip + t) = (u32x4){(unsigned)te[t], (unsigned)te[t + 1], (unsigned)te[t + 2], (unsigned)te[t + 3]}; *(f32x4*)(gp + t) = (f32x4){ex[t] * inv, ex[t + 1] * inv, ex[t + 2] * inv, ex[t + 3] * inv}; }
    }
#undef a
}

template <bool WR, int GV = 0>
__device__ __forceinline__ void phase_peer_gather(int l, LAS unsigned char* lds) {
    const KArgs ap = get_args();
#define a (*ap)
    const int tid = fresh_tid(), lane = tid & 63, wave = __builtin_amdgcn_readfirstlane(tid >> 6), G = fresh_g(), bx = fresh_bx();
    unsigned char* ws = a.ws;
    const int nrows = (l == DEPTH - 1) ? ML : M;
    const unsigned char* UB = ws + WS_UB + (size_t)(l & 1) * TAB_SET; const unsigned char* VB = UB + 1024;
    const float* USC = (const float*)(ws + WS_USC) + (l & 1) * 2 * NEXP; const float* VSC = USC + NEXP;
    const int* PIDX = (const int*)(ws + WS_PIDX); const float* PGATE = (const float*)(ws + WS_PGATE);
    const float* modl = (const float*)(ws + WS_MOD) + (size_t)l * 3 * 6144 + 5120;
    const bool fuse = WR && (l + 1 < DEPTH);
    LAS float* wsk = (LAS float*)lds;
    if (fuse) { const float* src = (const float*)(ws + WS_WSK) + (size_t)(l + 1) * 16384; for (int i = tid; i < 16384 / 4; i += 512) ((LAS f32x4*)wsk)[i] = ((const f32x4*)src)[i]; __syncthreads(); }
    const float* nw1 = a.in[I_N1W] + (l + 1 < DEPTH ? l + 1 : l) * 1024 + 16 * lane;
    const float* modn = (const float*)(ws + WS_MOD) + (size_t)(l + 1 < DEPTH ? l + 1 : l) * 3 * 6144;
    for (int row = wave * G + bx; row < nrows; row += G * 8) {
        float hv[16], out[16];
        { const u32x4 hw = *(const u32x4*)((const signed char*)(ws + WS_H) + (size_t)row * D + 16 * lane); const float hsc = ((const float*)(ws + WS_GB))[row];
#pragma unroll
          for (int q = 0; q < 4; ++q) { const int w = (int)hw[q]; hv[4 * q + 0] = (float)((w << 24) >> 24) * hsc; hv[4 * q + 1] = (float)((w << 16) >> 24) * hsc; hv[4 * q + 2] = (float)((w << 8) >> 24) * hsc; hv[4 * q + 3] = (float)(w >> 24) * hsc; } }
        float hs = 0.f;
#pragma unroll
        for (int i = 0; i < 16; ++i) { out[i] = 0.f; hs += hv[i]; }
        const float hsum128 = 128.f * wave_sum(hs);
        float wacc = 0.f;
        const int id0 = PIDX[(size_t)row * 128 + lane], id1 = PIDX[(size_t)row * 128 + 64 + lane];
        const float gt0 = PGATE[(size_t)row * 128 + lane], gt1 = PGATE[(size_t)row * 128 + 64 + lane];
        const float us0 = USC[id0], us1 = USC[id1], vs0 = VSC[id0], vs1 = VSC[id1];
        for (int e0 = 0; e0 < 128; e0 += 8) {
            u32x4 uw[8], vw[8]; float gte[8], use[8], vse[8];
#pragma unroll
            for (int j = 0; j < 8; ++j) { const int e = e0 + j; const int id = __builtin_amdgcn_readlane(e0 < 64 ? id0 : id1, e & 63);
                gte[j] = __builtin_bit_cast(float, __builtin_amdgcn_readlane(__builtin_bit_cast(int, e0 < 64 ? gt0 : gt1), e & 63));
                use[j] = __builtin_bit_cast(float, __builtin_amdgcn_readlane(__builtin_bit_cast(int, e0 < 64 ? us0 : us1), e & 63));
                vse[j] = __builtin_bit_cast(float, __builtin_amdgcn_readlane(__builtin_bit_cast(int, e0 < 64 ? vs0 : vs1), e & 63));
                uw[j] = *(const u32x4*)(UB + (size_t)id * 2048 + 16 * lane); vw[j] = *(const u32x4*)(VB + (size_t)id * 2048 + 16 * lane); }
#pragma unroll
            for (int j = 0; j < 8; ++j) {
                float d0 = 0.f, d1 = 0.f;
#pragma unroll
                for (int q = 0; q < 4; ++q) { const unsigned w = uw[j][q];
                    d0 = fmaf((float)(w & 255u), hv[4 * q + 0], d0); d1 = fmaf((float)((w >> 8) & 255u), hv[4 * q + 1], d1);
                    d0 = fmaf((float)((w >> 16) & 255u), hv[4 * q + 2], d0); d1 = fmaf((float)(w >> 24), hv[4 * q + 3], d1); }
                const float dsum = (wave_sum(d0 + d1) - hsum128) * use[j];
                const float act = 0.5f * dsum * (1.f + erff(dsum * 0.70710678118654752f));
                const float wgt = gte[j] * act * vse[j];
                wacc += wgt;
                if (GV == 1) { asm volatile("" :: "v"(vw[j])); out[0] += wgt; } else
#pragma unroll
                for (int q = 0; q < 4; ++q) { const unsigned w = vw[j][q];
                    out[4 * q + 0] = fmaf(wgt, (float)(w & 255u), out[4 * q + 0]); out[4 * q + 1] = fmaf(wgt, (float)((w >> 8) & 255u), out[4 * q + 1]);
                    out[4 * q + 2] = fmaf(wgt, (float)((w >> 16) & 255u), out[4 * q + 2]); out[4 * q + 3] = fmaf(wgt, (float)(w >> 24), out[4 * q + 3]); }
            }
        }
        const float corr = 128.f * wacc;
        float* xr; int mrow;
        if (row < ML) { xr = a.out + (size_t)row * D; mrow = row >= T ? 1 : 0; } else { xr = (float*)(ws + WS_CTXX) + (size_t)(row - ML) * D; mrow = 2; }
        const float* g2 = modl + mrow * 6144 + 16 * lane;
        f32x4 xn[4];
#pragma unroll
        for (int i = 0; i < 4; ++i) { const f32x4 x = *(const f32x4*)(xr + 16 * lane + 4 * i), g = *(const f32x4*)(g2 + 4 * i);
            xn[i] = x + g * (f32x4){out[4 * i] - corr, out[4 * i + 1] - corr, out[4 * i + 2] - corr, out[4 * i + 3] - corr};
            if (WR) *(f32x4*)(xr + 16 * lane + 4 * i) = xn[i]; else asm volatile("" :: "v"(xn[i])); }
        if (fuse) {
            float ss = 0.f;
#pragma unroll
            for (int i = 0; i < 4; ++i) ss += (xn[i][0] * xn[i][0] + xn[i][1] * xn[i][1]) + (xn[i][2] * xn[i][2] + xn[i][3] * xn[i][3]);
            const float rstd = rsqrtf(wave_sum(ss) * (1.f / D) + EPS);
            const float* md = modn + mrow * 6144 + 16 * lane;
#pragma unroll
            for (int i = 0; i < 4; ++i) { const f32x4 nwv = *(const f32x4*)(nw1 + 4 * i), sc = *(const f32x4*)(md + 1024 + 4 * i), sh = *(const f32x4*)(md + 4 * i);
                xn[i] = xn[i] * rstd * nwv * (sc + 1.f) + sh; }
            { float hmx = 0.f;
#pragma unroll
              for (int i = 0; i < 4; ++i) hmx = fmaxf(hmx, fmaxf(fmaxf(fabsf(xn[i][0]), fabsf(xn[i][1])), fmaxf(fabsf(xn[i][2]), fabsf(xn[i][3]))));
              hmx = fmaxf(wave_max(hmx), 1e-30f); const float hinv = 127.f / hmx;
              u32x4 o;
#pragma unroll
              for (int i = 0; i < 4; ++i) o[i] = ((unsigned)(int)rintf(xn[i][0] * hinv) & 255u) | (((unsigned)(int)rintf(xn[i][1] * hinv) & 255u) << 8) | (((unsigned)(int)rintf(xn[i][2] * hinv) & 255u) << 16) | (((unsigned)(int)rintf(xn[i][3] * hinv) & 255u) << 24);
              *(u32x4*)((signed char*)(ws + WS_H) + (size_t)row * D + 16 * lane) = o;
              if (lane == 0) ((float*)(ws + WS_GB))[row] = hmx * (1.f / 127.f); }
            float p[16];
#pragma unroll
            for (int c = 0; c < 16; ++c) { float q = 0.f;
#pragma unroll
                for (int i = 0; i < 4; ++i) { const f32x4 w = *(const LAS f32x4*)(wsk + c * 1024 + 16 * lane + 4 * i); q += (xn[i][0] * w[0] + xn[i][1] * w[1]) + (xn[i][2] * w[2] + xn[i][3] * w[3]); }
                p[c] = q; }
            { const bool hb = (lane & 32) != 0;
#pragma unroll
              for (int c = 0; c < 8; ++c) { const float keep = hb ? p[c + 8] : p[c], send = hb ? p[c] : p[c + 8]; p[c] = keep + lane_xor<32>(send); } }
            { const bool hb = (lane & 16) != 0;
#pragma unroll
              for (int c = 0; c < 4; ++c) { const float keep = hb ? p[c + 4] : p[c], send = hb ? p[c] : p[c + 4]; p[c] = keep + lane_xor<16>(send); } }
            { const bool hb = (lane & 8) != 0;
#pragma unroll
              for (int c = 0; c < 2; ++c) { const float keep = hb ? p[c + 2] : p[c], send = hb ? p[c] : p[c + 2]; p[c] = keep + lane_xor<8>(send); } }
            { const bool hb = (lane & 4) != 0; const float keep = hb ? p[1] : p[0], send = hb ? p[0] : p[1]; p[0] = keep + lane_xor<4>(send); }
            p[0] += lane_xor<2>(p[0]); p[0] += lane_xor<1>(p[0]);
            if ((lane & 3) == 0) { const int c = ((lane >> 5) & 1) * 8 + ((lane >> 4) & 1) * 4 + ((lane >> 3) & 1) * 2 + ((lane >> 2) & 1); ((float*)(ws + WS_BA))[(size_t)row * 16 + c] = p[0]; }
        }
    }
    if (fuse) __syncthreads();
}
#undef a
constexpr size_t WS_PART = WS_P;
static_assert(WS_PART + 8 * (size_t)M * 1024 * 2 <= WS_GB, "partials region");
constexpr int GP_ITEM = 16;
struct GpMeta { int id0, id1; float gt0, gt1; u32x4 hw; float hsc; };
__device__ __forceinline__ void phase_peer_gpart(int l, LAS unsigned char* lds) {
    const KArgs ap = get_args();
#define a (*ap)
    const int tid = fresh_tid(), lane = tid & 63, wave = __builtin_amdgcn_readfirstlane(tid >> 6);
    unsigned char* ws = a.ws;
    const int nrows = (l == DEPTH - 1) ? ML : M;
    const int nitem = nrows / GP_ITEM;
    const unsigned char* UB = ws + WS_UB + (size_t)(l & 1) * TAB_SET; const unsigned char* VB = UB + 1024;
    const f32x2* SC2 = (const f32x2*)(ws + WS_USC) + (size_t)(l & 1) * NEXP;
    const int* PIDX = (const int*)(ws + WS_PIDX); const float* PGATE = (const float*)(ws + WS_PGATE);
    LAS u32x4* lst0 = (LAS u32x4*)lds + wave * 256;
    const int eidx = ((lane >> 5) & 1) * 4 + ((lane >> 4) & 1) * 2 + ((lane >> 3) & 1);
    const int x = (int)(xb_xcc_id() & 7u);
#define GP_LOAD_META(m_, row_) do { const int rw_ = (row_); (m_).id0 = PIDX[(size_t)rw_ * 128 + lane]; (m_).id1 = PIDX[(size_t)rw_ * 128 + 64 + lane]; (m_).gt0 = PGATE[(size_t)rw_ * 128 + lane]; (m_).gt1 = PGATE[(size_t)rw_ * 128 + 64 + lane]; \
        (m_).hw = *(const u32x4*)((const signed char*)(ws + WS_H) + (size_t)rw_ * D + 16 * lane); (m_).hsc = ((const float*)(ws + WS_GB))[rw_]; } while (0)
#define GP_LOAD_SC(sa_, sb_, m_) do { sa_ = (f32x2){0.f, 0.f}; sb_ = (f32x2){0.f, 0.f}; if (((m_).id0 >> 11) == p) sa_ = SC2[(m_).id0]; if (((m_).id1 >> 11) == p) sb_ = SC2[(m_).id1]; } while (0)
#define GP_BUILD(cnt_, m_, sa_, sb_, buf_) do { const bool s0_ = ((m_).id0 >> 11) == p, s1_ = ((m_).id1 >> 11) == p; const unsigned long long m0_ = __ballot(s0_), m1_ = __ballot(s1_); \
        const int c0_ = __builtin_popcountll(m0_); cnt_ = __builtin_amdgcn_readfirstlane(c0_ + __builtin_popcountll(m1_)); \
        const int r0_ = (int)__builtin_amdgcn_mbcnt_hi((unsigned)(m0_ >> 32), __builtin_amdgcn_mbcnt_lo((unsigned)m0_, 0u)); \
        const int r1_ = c0_ + (int)__builtin_amdgcn_mbcnt_hi((unsigned)(m1_ >> 32), __builtin_amdgcn_mbcnt_lo((unsigned)m1_, 0u)); \
        LAS u32x4* lb_ = lst0 + (buf_) * 128; \
        if (s0_) lb_[r0_] = (u32x4){(unsigned)(m_).id0, __float_as_uint((m_).gt0 * sa_[1]), __float_as_uint(sa_[0]), 0u}; \
        if (s1_) lb_[r1_] = (u32x4){(unsigned)(m_).id1, __float_as_uint((m_).gt1 * sb_[1]), __float_as_uint(sb_[0]), 0u}; } while (0)
#pragma unroll 1
    for (int pp = 0; pp < 8; ++pp) {
        const int p = (x + pp) & 7;
        unsigned* ctr = (unsigned*)(ws + WS_CTL) + 16384 + (l * 8 + p) * 64;
        unsigned* part = (unsigned*)(ws + WS_PART + (size_t)p * M * 2048);
        unsigned tk = 0; if (lane == 0) tk = __hip_atomic_fetch_add(ctr, 1u, __ATOMIC_RELAXED, __HIP_MEMORY_SCOPE_AGENT);
        int it = __builtin_amdgcn_readfirstlane((int)tk);
#pragma unroll 1
        while (it < nitem) {
            unsigned tn = 0; if (lane == 0) tn = __hip_atomic_fetch_add(ctr, 1u, __ATOMIC_RELAXED, __HIP_MEMORY_SCOPE_AGENT);
            const int row0 = it * GP_ITEM, rowl = row0 + GP_ITEM - 1;
            GpMeta m1, m2, m3; f32x2 sa1, sb1, sa2, sb2; int c_cur, c_nxt; u32x4 hw_cur; float hsc_cur;
            GP_LOAD_META(m1, row0); GP_LOAD_META(m2, min(row0 + 1, rowl)); GP_LOAD_META(m3, min(row0 + 2, rowl));
            GP_LOAD_SC(sa1, sb1, m1);
            GP_BUILD(c_cur, m1, sa1, sb1, 0); hw_cur = m1.hw; hsc_cur = m1.hsc;
            GP_LOAD_SC(sa1, sb1, m2);
            m1 = m2; m2 = m3;
            GP_LOAD_META(m3, min(row0 + 3, rowl));
#pragma unroll 1
            for (int i = 0; i < GP_ITEM; ++i) {
                const int row = row0 + i;
                GP_BUILD(c_nxt, m1, sa1, sb1, (i + 1) & 1);
                const u32x4 hw_nxt = m1.hw; const float hsc_nxt = m1.hsc;
                GP_LOAD_SC(sa2, sb2, m2);
                m1 = m2; sa1 = sa2; sb1 = sb2; m2 = m3;
                GP_LOAD_META(m3, min(row + 4, rowl));
                LAS u32x4* lst = lst0 + (i & 1) * 128;
                const int c = c_cur; const u32x4 hw = hw_cur; const float hsc = hsc_cur;
                f32x2 o2[8];
#pragma unroll
                for (int k = 0; k < 8; ++k) o2[k] = (f32x2){0.f, 0.f};
                float wacc = 0.f;
#pragma unroll 1
                for (int e = 0; e < c; e += 8) {
                    u32x4 uw[8], vw[8];
#pragma unroll
                    for (int j = 0; j < 8; ++j) { const int sl = min(e + j, c - 1);
                        const int id = __builtin_amdgcn_readfirstlane((int)lst[sl][0]);
                        uw[j] = *(const u32x4*)(UB + (size_t)id * 2048 + 16 * lane); vw[j] = *(const u32x4*)(VB + (size_t)id * 2048 + 16 * lane); }
                    const int ms = e + eidx; const u32x4 en = lst[min(ms, c - 1)];
                    float pd[8];
#pragma unroll
                    for (int j = 0; j < 8; ++j) { int d = 0;
#pragma unroll
                        for (int q = 0; q < 4; ++q) d = __builtin_amdgcn_sdot4((int)uw[j][q], (int)hw[q], d, false);
                        pd[j] = (float)d; }
                    { const bool hb = (lane & 32) != 0;
#pragma unroll
                      for (int j = 0; j < 4; ++j) { const float keep = hb ? pd[j + 4] : pd[j], send = hb ? pd[j] : pd[j + 4]; pd[j] = keep + lane_xor<32>(send); } }
                    { const bool hb = (lane & 16) != 0;
#pragma unroll
                      for (int j = 0; j < 2; ++j) { const float keep = hb ? pd[j + 2] : pd[j], send = hb ? pd[j] : pd[j + 2]; pd[j] = keep + lane_xor<16>(send); } }
                    { const bool hb = (lane & 8) != 0; const float keep = hb ? pd[1] : pd[0], send = hb ? pd[0] : pd[1]; pd[0] = keep + lane_xor<8>(send); }
                    pd[0] += lane_xor<4>(pd[0]); pd[0] += lane_xor<2>(pd[0]); pd[0] += lane_xor<1>(pd[0]);
                    const float dsum = pd[0] * (__uint_as_float(en[2]) * hsc);
                    const float act = 0.5f * dsum * (1.f + erff(dsum * 0.70710678118654752f));
                    const float wgt = ms < c ? __uint_as_float(en[1]) * act : 0.f;
                    wacc += wgt;
#pragma unroll
                    for (int j = 0; j < 8; ++j) {
                        const float wj = __builtin_bit_cast(float, __builtin_amdgcn_readlane(__builtin_bit_cast(int, wgt), 32 * ((j >> 2) & 1) + 16 * ((j >> 1) & 1) + 8 * (j & 1)));
                        const f32x2 ww = {wj, wj};
#pragma unroll
                        for (int q = 0; q < 4; ++q) { const unsigned w = vw[j][q];
                            const f32x2 v01 = {(float)(w & 255u), (float)((w >> 8) & 255u)}, v23 = {(float)((w >> 16) & 255u), (float)(w >> 24)};
                            o2[2 * q] = __builtin_elementwise_fma(ww, v01, o2[2 * q]); o2[2 * q + 1] = __builtin_elementwise_fma(ww, v23, o2[2 * q + 1]); }
                    }
                }
                const float corr = 16.f * wave_sum(wacc);
                u32x4 w0, w1;
#pragma unroll
                for (int k = 0; k < 4; ++k) { w0[k] = pkbf_c(o2[k][0] - corr, o2[k][1] - corr); w1[k] = pkbf_c(o2[4 + k][0] - corr, o2[4 + k][1] - corr); }
                unsigned* dst = part + (size_t)row * 512 + 8 * lane;
                __builtin_nontemporal_store(w0, (u32x4*)dst); __builtin_nontemporal_store(w1, (u32x4*)(dst + 4));
                c_cur = c_nxt; hw_cur = hw_nxt; hsc_cur = hsc_nxt;
            }
            it = __builtin_amdgcn_readfirstlane((int)tn);
        }
    }
#undef GP_LOAD_META
#undef GP_LOAD_SC
#undef GP_BUILD
#undef a
}

__device__ __forceinline__ void phase_peer_combine(int l, LAS unsigned char* lds) {
    const KArgs ap = get_args();
#define a (*ap)
    const int tid = fresh_tid(), lane = tid & 63, wave = __builtin_amdgcn_readfirstlane(tid >> 6), G = fresh_g(), bx = fresh_bx();
    unsigned char* ws = a.ws;
    const int nrows = (l == DEPTH - 1) ? ML : M;
    const float* modl = (const float*)(ws + WS_MOD) + (size_t)l * 3 * 6144 + 5120;
    const bool fuse = (l + 1 < DEPTH);
    LAS float* wsk = (LAS float*)lds;
    if (fuse) { const float* src = (const float*)(ws + WS_WSK) + (size_t)(l + 1) * 16384; for (int i = tid; i < 16384 / 4; i += 512) ((LAS f32x4*)wsk)[i] = ((const f32x4*)src)[i]; __syncthreads(); }
    const float* nw1 = a.in[I_N1W] + (l + 1 < DEPTH ? l + 1 : l) * 1024 + 16 * lane;
    const float* modn = (const float*)(ws + WS_MOD) + (size_t)(l + 1 < DEPTH ? l + 1 : l) * 3 * 6144;
    for (int row = wave * G + bx; row < nrows; row += G * 8) {
        float out[16];
#pragma unroll
        for (int i = 0; i < 16; ++i) out[i] = 0.f;
#pragma unroll
        for (int p = 0; p < 8; ++p) { const unsigned* src = (const unsigned*)(ws + WS_PART + (size_t)p * M * 2048) + (size_t)row * 512 + 8 * lane;
            const u32x4 w0 = __builtin_nontemporal_load((const u32x4*)src), w1 = __builtin_nontemporal_load((const u32x4*)(src + 4));
#pragma unroll
            for (int k = 0; k < 4; ++k) { out[2 * k] += bflo(w0[k]); out[2 * k + 1] += bfhi(w0[k]); out[8 + 2 * k] += bflo(w1[k]); out[8 + 2 * k + 1] += bfhi(w1[k]); } }
        float* xr; int mrow;
        if (row < ML) { xr = a.out + (size_t)row * D; mrow = row >= T ? 1 : 0; } else { xr = (float*)(ws + WS_CTXX) + (size_t)(row - ML) * D; mrow = 2; }
        const float* g2 = modl + mrow * 6144 + 16 * lane;
        f32x4 xn[4];
#pragma unroll
        for (int i = 0; i < 4; ++i) { const f32x4 x = *(const f32x4*)(xr + 16 * lane + 4 * i), g = *(const f32x4*)(g2 + 4 * i);
            xn[i] = x + g * (f32x4){out[4 * i], out[4 * i + 1], out[4 * i + 2], out[4 * i + 3]};
            *(f32x4*)(xr + 16 * lane + 4 * i) = xn[i]; }
        if (fuse) {
            float ss = 0.f;
#pragma unroll
            for (int i = 0; i < 4; ++i) ss += (xn[i][0] * xn[i][0] + xn[i][1] * xn[i][1]) + (xn[i][2] * xn[i][2] + xn[i][3] * xn[i][3]);
            const float rstd = rsqrtf(wave_sum(ss) * (1.f / D) + EPS);
            const float* md = modn + mrow * 6144 + 16 * lane;
#pragma unroll
            for (int i = 0; i < 4; ++i) { const f32x4 nwv = *(const f32x4*)(nw1 + 4 * i), sc = *(const f32x4*)(md + 1024 + 4 * i), sh = *(const f32x4*)(md + 4 * i);
                xn[i] = xn[i] * rstd * nwv * (sc + 1.f) + sh; }
            { float hmx = 0.f;
#pragma unroll
              for (int i = 0; i < 4; ++i) hmx = fmaxf(hmx, fmaxf(fmaxf(fabsf(xn[i][0]), fabsf(xn[i][1])), fmaxf(fabsf(xn[i][2]), fabsf(xn[i][3]))));
              hmx = fmaxf(wave_max(hmx), 1e-30f); const float hinv = 127.f / hmx;
              u32x4 o;
#pragma unroll
              for (int i = 0; i < 4; ++i) o[i] = ((unsigned)(int)rintf(xn[i][0] * hinv) & 255u) | (((unsigned)(int)rintf(xn[i][1] * hinv) & 255u) << 8) | (((unsigned)(int)rintf(xn[i][2] * hinv) & 255u) << 16) | (((unsigned)(int)rintf(xn[i][3] * hinv) & 255u) << 24);
              *(u32x4*)((signed char*)(ws + WS_H) + (size_t)row * D + 16 * lane) = o;
              if (lane == 0) ((float*)(ws + WS_GB))[row] = hmx * (1.f / 127.f); }
            float p[16];
#pragma unroll
            for (int c = 0; c < 16; ++c) { float q = 0.f;
#pragma unroll
                for (int i = 0; i < 4; ++i) { const f32x4 w = *(const LAS f32x4*)(wsk + c * 1024 + 16 * lane + 4 * i); q += (xn[i][0] * w[0] + xn[i][1] * w[1]) + (xn[i][2] * w[2] + xn[i][3] * w[3]); }
                p[c] = q; }
            { const bool hb = (lane & 32) != 0;
#pragma unroll
              for (int c = 0; c < 8; ++c) { const float keep = hb ? p[c + 8] : p[c], send = hb ? p[c] : p[c + 8]; p[c] = keep + lane_xor<32>(send); } }
            { const bool hb = (lane & 16) != 0;
#pragma unroll
              for (int c = 0; c < 4; ++c) { const float keep = hb ? p[c + 4] : p[c], send = hb ? p[c] : p[c + 4]; p[c] = keep + lane_xor<16>(send); } }
            { const bool hb = (lane & 8) != 0;
#pragma unroll
              for (int c = 0; c < 2; ++c) { const float keep = hb ? p[c + 2] : p[c], send = hb ? p[c] : p[c + 2]; p[c] = keep + lane_xor<8>(send); } }
            { const bool hb = (lane & 4) != 0; const float keep = hb ? p[1] : p[0], send = hb ? p[0] : p[1]; p[0] = keep + lane_xor<4>(send); }
            p[0] += lane_xor<2>(p[0]); p[0] += lane_xor<1>(p[0]);
            if ((lane & 3) == 0) { const int c = ((lane >> 5) & 1) * 8 + ((lane >> 4) & 1) * 4 + ((lane >> 3) & 1) * 2 + ((lane >> 2) & 1); ((float*)(ws + WS_BA))[(size_t)row * 16 + c] = p[0]; }
        }
    }
    if (fuse) __syncthreads();
#undef a
}
constexpr size_t WS_PD = WS_REC;
constexpr size_t WS_PW = WS_REC + 8 * (size_t)M * 128 * 4;
constexpr size_t WS_PC = WS_PW + (size_t)M * 128;
static_assert(WS_PC + (size_t)M * 8 * 4 <= WS_END, "sliced gather scratch");
constexpr int GS_ITEM = 8;
template <int PH>
__device__ __forceinline__ void phase_peer_slice(int l, int cslot) {
    const KArgs ap = get_args();
#define a (*ap)
    const int tid = fresh_tid(), lane = tid & 63;
    unsigned char* ws = a.ws;
    const int nrows = (l == DEPTH - 1) ? ML : M;
    const int nitem = nrows / GS_ITEM;
    const unsigned char* TAB = ws + WS_UB + (size_t)(l & 1) * TAB_SET + (PH ? (size_t)NEXP * 1024 : 0);
    const int* PIDX = (const int*)(ws + WS_PIDX);
    const unsigned char* PW = ws + WS_PW; const float* PC = (const float*)(ws + WS_PC);
    const float* modl = (const float*)(ws + WS_MOD) + (size_t)l * 3 * 6144 + 5120;
    const int g = lane >> 3, i8 = lane & 7;
    const int x = (int)(xb_xcc_id() & 7u);
#pragma unroll 1
    for (int pp = 0; pp < 8; ++pp) {
        const int p = (x + pp) & 7;
        unsigned* ctr = (unsigned*)(ws + WS_CTL) + 16384 + ((l * 2 + PH) * 8 + p) * 64 + cslot * 8192;
        const unsigned char* tb = TAB + (size_t)p * NEXP * 128 + 16 * i8;
        unsigned tk = 0; if (lane == 0) tk = __hip_atomic_fetch_add(ctr, 1u, __ATOMIC_RELAXED, __HIP_MEMORY_SCOPE_AGENT);
        int it = __builtin_amdgcn_readfirstlane((int)tk);
        if (it < nitem) {
            unsigned tn = 0; if (lane == 0) tn = __hip_atomic_fetch_add(ctr, 1u, __ATOMIC_RELAXED, __HIP_MEMORY_SCOPE_AGENT);
            const int row0 = it * GS_ITEM;
            u32x4 idc[4], idn[4], ra[8], rb[8]; u32x4 wc, wn; float sc_c, sc_n; u32x4 hc, hn;
#define GS_META(ids_, wts_, wsc_, h_, row_) do { const int rw_ = (row_); const u32x4* ip_ = (const u32x4*)(PIDX + (size_t)rw_ * 128 + 16 * g); _Pragma("unroll") for (int q_ = 0; q_ < 4; ++q_) ids_[q_] = ip_[q_]; \
                if (PH) { wts_ = *(const u32x4*)(PW + (size_t)rw_ * 128 + 16 * g); wsc_ = PC[(size_t)rw_ * 8 + g]; } \
                else h_ = *(const u32x4*)((const signed char*)(ws + WS_H) + (size_t)rw_ * D + 128 * p + 16 * i8); } while (0)
#define GS_ROWS(dst_, ids_, hf_) do { _Pragma("unroll") for (int k_ = 0; k_ < 8; ++k_) dst_[k_] = *(const u32x4*)(tb + (size_t)ids_[2 * (hf_) + (k_ >> 2)][k_ & 3] * 128); } while (0)
            GS_META(idc, wc, sc_c, hc, row0);
            GS_ROWS(ra, idc, 0);
            GS_META(idn, wn, sc_n, hn, row0 + 1);
            int i = 0, tnv = 0x7fffffff;
#pragma unroll 1
            for (;;) {
                if (i == GS_ITEM - 2) tnv = __builtin_amdgcn_readfirstlane((int)tn);
                const int row = it * GS_ITEM + i;
                const int r2 = (i + 2 < GS_ITEM) ? row + 2 : (tnv < nitem ? tnv * GS_ITEM + (i + 2 - GS_ITEM) : row);
                GS_ROWS(rb, idc, 1);
                if (PH == 0) {
                    int d[16];
#pragma unroll
                    for (int k = 0; k < 8; ++k) { int s_ = 0;
#pragma unroll
                        for (int q = 0; q < 4; ++q) s_ = __builtin_amdgcn_sdot4((int)ra[k][q], (int)hc[q], s_, false);
                        d[k] = s_; }
                    GS_ROWS(ra, idn, 0);
#pragma unroll
                    for (int k = 0; k < 8; ++k) { int s_ = 0;
#pragma unroll
                        for (int q = 0; q < 4; ++q) s_ = __builtin_amdgcn_sdot4((int)rb[k][q], (int)hc[q], s_, false);
                        d[8 + k] = s_; }
#define GS_IX(v_, K_) __builtin_bit_cast(int, lane_xor<K_>(__builtin_bit_cast(float, v_)))
                    { const bool hb = (lane & 4) != 0;
#pragma unroll
                      for (int j = 0; j < 8; ++j) { const int keep = hb ? d[j + 8] : d[j], send = hb ? d[j] : d[j + 8]; d[j] = keep + GS_IX(send, 4); } }
                    { const bool hb = (lane & 2) != 0;
#pragma unroll
                      for (int j = 0; j < 4; ++j) { const int keep = hb ? d[j + 4] : d[j], send = hb ? d[j] : d[j + 4]; d[j] = keep + GS_IX(send, 2); } }
                    { const bool hb = (lane & 1) != 0;
#pragma unroll
                      for (int j = 0; j < 2; ++j) { const int keep = hb ? d[j + 2] : d[j], send = hb ? d[j] : d[j + 2]; d[j] = keep + GS_IX(send, 1); } }
#undef GS_IX
                    u32x2 o = {(unsigned)d[0], (unsigned)d[1]};
                    __builtin_nontemporal_store(o, (u32x2*)((int*)(ws + WS_PD) + ((size_t)p * M + row) * 128 + 2 * lane));
                } else {
                    int oi[16];
#pragma unroll
                    for (int k = 0; k < 16; ++k) oi[k] = 0;
#define GS_QUAD(rr_, qd_, wd_) do { _Pragma("unroll") for (int q_ = 0; q_ < 4; ++q_) { \
                        const unsigned r0_ = rr_[4 * (qd_) + 0][q_], r1_ = rr_[4 * (qd_) + 1][q_], r2_ = rr_[4 * (qd_) + 2][q_], r3_ = rr_[4 * (qd_) + 3][q_]; \
                        const unsigned t0_ = __builtin_amdgcn_perm(r1_, r0_, 0x05010400u), t1_ = __builtin_amdgcn_perm(r1_, r0_, 0x07030602u), t2_ = __builtin_amdgcn_perm(r3_, r2_, 0x05010400u), t3_ = __builtin_amdgcn_perm(r3_, r2_, 0x07030602u); \
                        oi[4 * q_ + 0] = __builtin_amdgcn_sdot4((int)__builtin_amdgcn_perm(t2_, t0_, 0x05040100u), (int)(wd_), oi[4 * q_ + 0], false); \
                        oi[4 * q_ + 1] = __builtin_amdgcn_sdot4((int)__builtin_amdgcn_perm(t2_, t0_, 0x07060302u), (int)(wd_), oi[4 * q_ + 1], false); \
                        oi[4 * q_ + 2] = __builtin_amdgcn_sdot4((int)__builtin_amdgcn_perm(t3_, t1_, 0x05040100u), (int)(wd_), oi[4 * q_ + 2], false); \
                        oi[4 * q_ + 3] = __builtin_amdgcn_sdot4((int)__builtin_amdgcn_perm(t3_, t1_, 0x07060302u), (int)(wd_), oi[4 * q_ + 3], false); } } while (0)
                    GS_QUAD(ra, 0, wc[0]); GS_QUAD(ra, 1, wc[1]);
                    GS_ROWS(ra, idn, 0);
                    GS_QUAD(rb, 0, wc[2]); GS_QUAD(rb, 1, wc[3]);
#undef GS_QUAD
                    float o[16];
#pragma unroll
                    for (int k = 0; k < 16; ++k) o[k] = (float)oi[k] * sc_c;
                    { const bool hb = (lane & 32) != 0;
#pragma unroll
                      for (int j = 0; j < 8; ++j) { const float keep = hb ? o[j + 8] : o[j], send = hb ? o[j] : o[j + 8]; o[j] = keep + lane_xor<32>(send); } }
                    { const bool hb = (lane & 16) != 0;
#pragma unroll
                      for (int j = 0; j < 4; ++j) { const float keep = hb ? o[j + 4] : o[j], send = hb ? o[j] : o[j + 4]; o[j] = keep + lane_xor<16>(send); } }
                    { const bool hb = (lane & 8) != 0;
#pragma unroll
                      for (int j = 0; j < 2; ++j) { const float keep = hb ? o[j + 2] : o[j], send = hb ? o[j] : o[j + 2]; o[j] = keep + lane_xor<8>(send); } }
                    const float corr = 0.f;
                    float* xr; int mrow;
                    if (row < ML) { xr = a.out + (size_t)row * D; mrow = row >= T ? 1 : 0; } else { xr = (float*)(ws + WS_CTXX) + (size_t)(row - ML) * D; mrow = 2; }
                    const int col = 128 * p + 16 * i8 + 2 * g;
                    const f32x2 g2 = *(const f32x2*)(modl + mrow * 6144 + col), xo = *(const f32x2*)(xr + col);
                    *(f32x2*)(xr + col) = (f32x2){xo[0] + g2[0] * (o[0] - corr), xo[1] + g2[1] * (o[1] - corr)};
                }
#pragma unroll
                for (int q = 0; q < 4; ++q) idc[q] = idn[q];
                if (PH) { wc = wn; sc_c = sc_n; } else hc = hn;
                GS_META(idn, wn, sc_n, hn, r2);
                if (++i == GS_ITEM) {
                    if (tnv >= nitem) break;
                    it = tnv; i = 0; tnv = 0x7fffffff;
                    if (lane == 0) tn = __hip_atomic_fetch_add(ctr, 1u, __ATOMIC_RELAXED, __HIP_MEMORY_SCOPE_AGENT);
                }
            }
#undef GS_META
#undef GS_ROWS
        }
    }
#undef a
}
__device__ __forceinline__ void phase_peer_weights(int l) {
    const KArgs ap = get_args();
#define a (*ap)
    const int tid = fresh_tid(), lane = tid & 63, wave = __builtin_amdgcn_readfirstlane(tid >> 6), G = fresh_g(), bx = fresh_bx();
    unsigned char* ws = a.ws;
    const int nrows = (l == DEPTH - 1) ? ML : M;
    const f32x2* SC2 = (const f32x2*)(ws + WS_USC) + (size_t)(l & 1) * NEXP;
    const int* PIDX = (const int*)(ws + WS_PIDX); const float* PGATE = (const float*)(ws + WS_PGATE);
    for (int row = wave * G + bx; row < nrows; row += G * 8) {
        const u32x2 id = *(const u32x2*)(PIDX + (size_t)row * 128 + 2 * lane); const f32x2 gt = *(const f32x2*)(PGATE + (size_t)row * 128 + 2 * lane);
        const float hsc = ((const float*)(ws + WS_GB))[row];
        int d0 = 0, d1 = 0;
#pragma unroll
        for (int p = 0; p < 8; ++p) { const u32x2 v = __builtin_nontemporal_load((const u32x2*)((const int*)(ws + WS_PD) + ((size_t)p * M + row) * 128 + 2 * lane)); d0 += (int)v[0]; d1 += (int)v[1]; }
        const f32x2 s0 = SC2[id[0]], s1 = SC2[id[1]];
        const float x0 = (float)d0 * (s0[0] * hsc), x1 = (float)d1 * (s1[0] * hsc);
        const float w0 = gt[0] * s0[1] * (0.5f * x0 * (1.f + erff(x0 * 0.70710678118654752f))), w1 = gt[1] * s1[1] * (0.5f * x1 * (1.f + erff(x1 * 0.70710678118654752f)));
        float mx = fmaxf(fabsf(w0), fabsf(w1));
        mx = fmaxf(mx, lane_xor<1>(mx)); mx = fmaxf(mx, lane_xor<2>(mx)); mx = fmaxf(mx, lane_xor<4>(mx));
        mx = fmaxf(mx, 1e-30f); const float inv = 127.f / mx;
        *(unsigned short*)(ws + WS_PW + (size_t)row * 128 + 2 * lane) = (unsigned short)(((unsigned)(int)rintf(w0 * inv) & 255u) | (((unsigned)(int)rintf(w1 * inv) & 255u) << 8));
        if ((lane & 7) == 0) ((float*)(ws + WS_PC))[(size_t)row * 8 + (lane >> 3)] = mx * (1.f / 127.f);
    }
#undef a
}

__global__ void __launch_bounds__(512, 2) fwd(Args a) {
    extern __shared__ __attribute__((aligned(16))) unsigned char lds_raw[];
    LAS unsigned char* lds = (LAS unsigned char*)lds_raw;
    volatile LAS unsigned* MISC = (volatile LAS unsigned*)(lds + LDS_MISC);
    if (threadIdx.x < 16) MISC[threadIdx.x] = 0u;
    __syncthreads();
    XcdBarrier bar; bar.bar = (unsigned*)(a.ws + WS_CTL) + 4096; bar.x = 0; bar.st = MISC + 8;
    bar = xcd_barrier_post((unsigned*)(a.ws + WS_CTL) + 4096, MISC + 8);
#ifndef PHASE_MASK
#define PHASE_MASK 0x1FFF
#endif
#define EN(i) ((PHASE_MASK >> (i)) & 1)
#ifndef REP_MASK
#define REP_MASK 0
#endif
#define REPN(i) (1 + ((REP_MASK >> (i)) & 1))
#define IN(k) true
#define SEAM(k) do { XcdBarrier b_; b_.bar = (unsigned*)(get_args()->ws + WS_CTL) + 4096; b_.x = xb_xcc_id(); b_.st = (volatile LAS unsigned*)(lds + LDS_MISC) + 8; xcd_barrier(b_); } while (0)
    for (int rep_ = 0; rep_ < (REPN(0)); ++rep_) if (EN(0) && IN(0)) phase_prologue(lds);
    SEAM(0);
#pragma unroll 1
    for (int l_ = 0; l_ < DEPTH; ++l_) {
        int l = l_; asm volatile("" : "+s"(l));
        const int pb = 1 + l * NPH_L;
        const int mrows = (l == DEPTH - 1) ? ML : M;
        if (l == 0) { for (int rep_ = 0; rep_ < (REPN(1)); ++rep_) if (EN(1) && IN(pb + 0)) { phase_norm<true>(l, 0, lds); phase_quant_weights(lds); }
            SEAM(pb + 0); }
        for (int rep_ = 0; rep_ < (REPN(2)); ++rep_) if (EN(2) && IN(pb + 1)) { const KArgs ap = get_args(); unsigned char* ws = ap->ws; pg8::Gemm g{(const bf16_t*)(ws + WS_H), (const bf16_t*)((const signed char*)(ws + WS_WINT) + (size_t)l * NP * 1024), M, NP, 512}; pg8::StaticOrder S; S.init(M, NP, fresh_g(), fresh_bx());
            pg8::EpiBf16I8 E{(bf16_t*)(ws + WS_P), NP, (const float*)(ws + WS_GB), (const float*)(ws + WS_CTL) + CW_WMAX + (l * 3 + 0) * 3072}; pg8::gemm_phase(lds, g, S, E); }
        SEAM(pb + 1);
        for (int rep_ = 0; rep_ < (REPN(3)); ++rep_) if (EN(3) && IN(pb + 2)) { phase_dn_chunkprep<1>(l, lds); phase_prep(l, lds); }
        for (int rep_ = 0; rep_ < (REPN(4)); ++rep_) if (EN(4) && IN(pb + 3)) phase_dn_chunkprep<0>(l, lds);
        SEAM(pb + 3);
        for (int rep_ = 0; rep_ < (REPN(5)); ++rep_) if (EN(5) && IN(pb + 4)) { phase_dn_scan<0>(l, lds); __syncthreads(); phase_attn(l, lds_raw, MISC, rep_); }
        SEAM(pb + 4);
        for (int rep_ = 0; rep_ < (REPN(7)); ++rep_) if (EN(7) && IN(pb + 5)) phase_dn_out(l);
        SEAM(pb + 5);
        if (EN(8) && IN(pb + 6)) { const KArgs ap = get_args(); unsigned char* ws = ap->ws; pg8::Gemm g{(const bf16_t*)(ws + WS_CATQ), (const bf16_t*)((const signed char*)(ws + WS_WOUTT) + (size_t)l * 1024 * 1024), mrows, 1024, 512}; pg8::StaticOrder S; S.init(mrows, 1024, fresh_g(), fresh_bx());
            pg8::EpiResI8 E{l == 0 ? ap->in[I_X] : ap->out, l == 0 ? ap->in[I_CTX] : (const float*)(ws + WS_CTXX), ap->out, (float*)(ws + WS_CTXX), (const float*)(ws + WS_MOD) + (size_t)l * 3 * 6144 + 2048,
                              (const float*)(ws + WS_GB) + (1u << 18), (const float*)(ws + WS_CTL) + CW_WMAX + (l * 3 + 1) * 3072};
            pg8::gemm_phase(lds, g, S, E); }
        SEAM(pb + 6);
        for (int rep_ = 0; rep_ < (REPN(9)); ++rep_) if (EN(9) && IN(pb + 7)) phase_norm<false>(l, 1, lds);
        SEAM(pb + 7);
        for (int rep_ = 0; rep_ < (REPN(10)); ++rep_) if (EN(10) && IN(pb + 8)) { const KArgs ap = get_args(); unsigned char* ws = ap->ws; pg8::Gemm g{(const bf16_t*)(ws + WS_H), (const bf16_t*)((const signed char*)(ws + WS_WQT) + (size_t)l * 2048 * 1024), mrows, 2048, 512}; pg8::StaticOrder S; S.init(mrows, 2048, fresh_g(), fresh_bx());
            pg8::EpiBf16I8 E{(bf16_t*)(ws + WS_P), 2048, (const float*)(ws + WS_GB), (const float*)(ws + WS_CTL) + CW_WMAX + (l * 3 + 2) * 3072}; pg8::gemm_phase(lds, g, S, E); }
        SEAM(pb + 8);
        for (int rep_ = 0; rep_ < (REPN(11)); ++rep_) if (EN(11) && IN(pb + 9)) phase_peer_select(l);
        SEAM(pb + 9);
        #ifdef GATHER_VAR
        if (EN(12) && IN(pb + 10)) phase_peer_gather<false, GATHER_VAR>(l, lds);
#endif
#if GATHER_PART == 2
        if (EN(12) && IN(pb + 10)) phase_peer_slice<0>(l, 0);
        SEAM(pb + 10);
        if (EN(12) && IN(pb + 10)) phase_peer_weights(l);
        SEAM(pb + 10);
        if (EN(12) && IN(pb + 10)) phase_peer_slice<1>(l, 0);
        if (l + 1 < DEPTH) { SEAM(pb + 10); if (EN(12) && IN(pb + 10)) phase_norm<true>(l + 1, 0, lds); }
#elif GATHER_PART
        if (EN(12) && IN(pb + 10)) phase_peer_gpart(l, lds);
        SEAM(pb + 10);
        if (EN(12) && IN(pb + 10)) phase_peer_combine(l, lds);
#else
        if (REPN(12) > 1 && EN(12) && IN(pb + 10)) phase_peer_gather<false>(l, lds);
        if (EN(12) && IN(pb + 10)) phase_peer_gather<true>(l, lds);
#endif
        if (l + 1 < DEPTH) SEAM(pb + 10);
    }
#undef IN
#undef SEAM
}

#ifndef N_LAUNCH_MODE
#define N_LAUNCH_MODE 1
#endif
extern "C" void kernel_launch(void* const* d_in, const int* in_sizes, int n_in, void* d_out, int out_size, void* d_ws, size_t ws_size, hipStream_t stream) {
    static int grid = 0;
    if (grid == 0) {
        if (n_in != 20 || out_size != ML * D || ws_size < WS_END) { fprintf(stderr, "kernel_launch: unexpected shapes: n_in %d out %d ws %zu (need %zu)\n", n_in, out_size, ws_size, (size_t)WS_END); grid = -1; return; }
        int dev = 0, cus = 0, per_cu = 0;
        if (hipGetDevice(&dev) != hipSuccess || hipDeviceGetAttribute(&cus, hipDeviceAttributeMultiprocessorCount, dev) != hipSuccess) { grid = -1; return; }
        if (hipFuncSetAttribute((const void*)fwd, hipFuncAttributeMaxDynamicSharedMemorySize, LDS_BYTES) != hipSuccess) { fprintf(stderr, "kernel_launch: hipFuncSetAttribute failed\n"); grid = -1; return; }
        if (hipOccupancyMaxActiveBlocksPerMultiprocessor(&per_cu, (const void*)fwd, 512, LDS_BYTES) != hipSuccess || per_cu < 1) fprintf(stderr, "kernel_launch: occupancy query says %d\n", per_cu);
        (void)hipGetLastError();
        grid = cus;
    }
    if (grid < 0) return;
    (void)hipMemsetAsync((char*)d_ws + WS_CTL, 0, CTL_BYTES, stream);
    Args a{};
    for (int i = 0; i < 20; ++i) a.in[i] = (const float*)d_in[i];
    a.out = (float*)d_out; a.ws = (unsigned char*)d_ws;
    a.ph_lo = 0; a.ph_hi = NPHASE;
    hipLaunchKernelGGL(fwd, dim3(grid), dim3(512), LDS_BYTES, stream, a);
    const hipError_t le = hipPeekAtLastError();
    if (le != hipSuccess) fprintf(stderr, "kernel_launch: launch failed: %s\n", hipGetErrorName(le));
}
```

```cpp
#include <hip/hip_runtime.h>
#ifndef GATHER_PART
#define GATHER_PART 2
#endif
#include <cstdio>
#include <cstdint>

#define GAS __attribute__((address_space(1)))
#define LAS __attribute__((address_space(3)))
typedef unsigned short bf16_t;
typedef short bf16x8 __attribute__((ext_vector_type(8)));
typedef short s16x4 __attribute__((ext_vector_type(4)));
typedef float f32x4 __attribute__((ext_vector_type(4)));
typedef float f32x2 __attribute__((ext_vector_type(2)));
typedef float f32x16 __attribute__((ext_vector_type(16)));
typedef unsigned u32x4 __attribute__((ext_vector_type(4)));
typedef unsigned u32x2 __attribute__((ext_vector_type(2)));
typedef int i32x4 __attribute__((ext_vector_type(4)));

constexpr int D = 1024, NB = 2, T = 16384, DEPTH = 4, CT = 256;
constexpr int ML = NB * T, MC = NB * CT, M = ML + MC;
constexpr int NIN = 3088, NP = 3072;
constexpr int KVLEN = T + CT;
constexpr int NEXP = 16384;
constexpr float EPS = 1e-6f;
constexpr int NPH_L = 11;
constexpr int NPHASE = 1 + DEPTH * NPH_L;

constexpr size_t MiB = 1u << 20;
constexpr size_t WS_CTL = 0, CTL_BYTES = 1 * MiB;
constexpr size_t WS_MOD = 1 * MiB;
constexpr size_t WS_ROPE = 2 * MiB;
constexpr size_t WS_WSK = 3 * MiB;
constexpr size_t WS_CTXX = 4 * MiB;
constexpr size_t WS_WINT = 8 * MiB;
constexpr size_t WS_WOUTT = 32 * MiB;
constexpr size_t WS_WQT = 40 * MiB;
constexpr size_t WS_SKB = 56 * MiB;
constexpr size_t WS_USC = 58 * MiB;
constexpr size_t WS_UB = 64 * MiB;
constexpr size_t WS_VB = 80 * MiB;
constexpr size_t TAB_SET = 32 * MiB;
constexpr size_t WS_H = 128 * MiB;
static_assert(WS_H + 2 * (size_t)M * 1024 <= 193 * MiB, "H + concat int8");
constexpr size_t WS_CATQ = WS_H + (size_t)M * 1024;
constexpr size_t WS_P = 193 * MiB;
constexpr size_t WS_QA = 388 * MiB;
constexpr size_t WS_KA = 421 * MiB;
constexpr size_t WS_VA = 438 * MiB;
constexpr size_t WS_CAT = 455 * MiB;
constexpr size_t WS_DQ = 520 * MiB;
constexpr size_t WS_DK = 553 * MiB;
constexpr size_t WS_DV = 586 * MiB;
constexpr size_t WS_OF = 619 * MiB;
constexpr size_t WS_OB = 684 * MiB;
constexpr size_t WS_GB = 749 * MiB;
constexpr size_t WS_BA = 752 * MiB;
constexpr size_t WS_PIDX = 755 * MiB;
constexpr size_t WS_PGATE = 772 * MiB;
constexpr size_t WS_REC = 789 * MiB;
constexpr size_t WS_END = 990 * MiB;
constexpr int CW_WMAX = 65536;
constexpr int NCH = 260;
constexpr int REC_K = 0, REC_KT = 16384, REC_Q = 32768, REC_V = 49152, REC_DIR = 65536, REC_DIRSZ = 17408, REC_BYTES = REC_DIR + 2 * REC_DIRSZ;
static_assert((size_t)NB * 4 * NCH * REC_BYTES + WS_REC <= WS_END, "rec region");

constexpr int LDS_BYTES = 163840;
constexpr int LDS_MISC = 163840 - 256;

__device__ __forceinline__ float bf2f(unsigned b) { return __uint_as_float(b << 16); }
__device__ __forceinline__ float bflo(unsigned w) { return __uint_as_float(w << 16); }
__device__ __forceinline__ float bfhi(unsigned w) { return __uint_as_float(w & 0xffff0000u); }
typedef __bf16 bf2v __attribute__((ext_vector_type(2)));
__device__ __forceinline__ unsigned pkbf(float lo, float hi) { unsigned r; asm("v_cvt_pk_bf16_f32 %0, %1, %2" : "=v"(r) : "v"(lo), "v"(hi)); return r; }
__device__ __forceinline__ unsigned pkbf_c(float lo, float hi) { f32x2 v = {lo, hi}; bf2v r = __builtin_convertvector(v, bf2v); return __builtin_bit_cast(unsigned, r); }
template <int K> __device__ __forceinline__ float lane_xor(float v) {
    const int b = __builtin_bit_cast(int, v);
    if constexpr (K == 1) return __builtin_bit_cast(float, __builtin_amdgcn_update_dpp(0, b, 0xB1, 0xF, 0xF, true));
    else if constexpr (K == 2) return __builtin_bit_cast(float, __builtin_amdgcn_update_dpp(0, b, 0x4E, 0xF, 0xF, true));
    else if constexpr (K == 32) { auto rr = __builtin_amdgcn_permlane32_swap((unsigned)b, (unsigned)b, false, false); unsigned ln_ = __builtin_amdgcn_mbcnt_hi(~0u, __builtin_amdgcn_mbcnt_lo(~0u, 0u)); asm volatile("" : "+v"(ln_));
        return __uint_as_float((ln_ & 32u) ? rr[0] : rr[1]); }
    else return __builtin_bit_cast(float, __builtin_amdgcn_ds_swizzle(b, 0x1F | (K << 10)));
}
__device__ __forceinline__ float wave_sum(float v) {
    v += lane_xor<1>(v); v += lane_xor<2>(v);
    v += __builtin_bit_cast(float, __builtin_amdgcn_update_dpp(0, __builtin_bit_cast(int, v), 0x124, 0xF, 0xF, true));
    v += __builtin_bit_cast(float, __builtin_amdgcn_update_dpp(0, __builtin_bit_cast(int, v), 0x128, 0xF, 0xF, true));
    v += lane_xor<16>(v);
    { auto rr = __builtin_amdgcn_permlane32_swap(__float_as_uint(v), __float_as_uint(v), false, false); v = __uint_as_float(rr[0]) + __uint_as_float(rr[1]); }
    return v;
}
__device__ __forceinline__ float wave_max(float v) {
    v = fmaxf(v, lane_xor<1>(v)); v = fmaxf(v, lane_xor<2>(v));
    v = fmaxf(v, __builtin_bit_cast(float, __builtin_amdgcn_update_dpp(0, __builtin_bit_cast(int, v), 0x124, 0xF, 0xF, true)));
    v = fmaxf(v, __builtin_bit_cast(float, __builtin_amdgcn_update_dpp(0, __builtin_bit_cast(int, v), 0x128, 0xF, 0xF, true)));
    v = fmaxf(v, lane_xor<16>(v));
    { auto rr = __builtin_amdgcn_permlane32_swap(__float_as_uint(v), __float_as_uint(v), false, false); v = fmaxf(__uint_as_float(rr[0]), __uint_as_float(rr[1])); }
    return v;
}
__device__ __forceinline__ float silu_f(float x) { return x / (1.f + __expf(-x)); }
#define LDS_WAIT() asm volatile("s_waitcnt lgkmcnt(0)" ::: "memory")

#define XB_TMO      128
#define XB_XCNT(j)  (256  + 64 * (j))
#define XB_XSUB(j)  (1280 + 64 * (j))
#define XB_XGEN(j)  (2304 + 64 * (j))
#define XB_TOP      3328
#define XB_TOPGEN   3392
#define XCD_BAR_WORDS 3456
#define XB_SPIN_CAP (1u << 22)
__device__ __forceinline__ unsigned xb_ld(unsigned* p)              { return __hip_atomic_load(p, __ATOMIC_RELAXED, __HIP_MEMORY_SCOPE_AGENT); }
__device__ __forceinline__ unsigned xb_add(unsigned* p, unsigned v) { return __hip_atomic_fetch_add(p, v, __ATOMIC_RELAXED, __HIP_MEMORY_SCOPE_AGENT); }
__device__ __forceinline__ unsigned xb_xcc_id() { return (unsigned)__builtin_amdgcn_s_getreg((3 << 11) | 20) & 0xFu; }
#define XB_SPIN(cond, bar) do { unsigned _sp = 0; while (cond) { __builtin_amdgcn_s_sleep(1); \
    if ((++_sp & 255u) == 0u) { if (xb_ld(&(bar)[XB_TMO])) break; if (_sp > XB_SPIN_CAP) { atomicAdd(&(bar)[XB_TMO], 1u); break; } } } } while (0)
struct XcdBarrier { unsigned* bar; unsigned x; volatile LAS unsigned* st; };
__device__ __forceinline__ XcdBarrier xcd_barrier_post(unsigned* bar, volatile LAS unsigned* st) {
    XcdBarrier b; b.bar = bar; b.x = xb_xcc_id(); b.st = st;
    if (threadIdx.x == 0) (void)xb_add(&bar[XB_XCNT(b.x)], 1u);
    return b;
}
__device__ __forceinline__ void xcd_barrier_complete(unsigned* bar, unsigned x, unsigned& nloc, unsigned& nx) {
    const unsigned G = gridDim.x * gridDim.y * gridDim.z;
    unsigned sum, cnt, mine, sp = 0u;
    for (;;) {
        sum = 0u; cnt = 0u; mine = 0u;
#pragma unroll
        for (unsigned j = 0; j < 16; ++j) { const unsigned c = xb_ld(&bar[XB_XCNT(j)]); sum += c; cnt += (c > 0u) ? 1u : 0u; mine = (j == x) ? c : mine; }
        if (sum == G) break;
        __builtin_amdgcn_s_sleep(1);
        if ((++sp & 255u) == 0u) { if (xb_ld(&bar[XB_TMO])) break; if (sp > XB_SPIN_CAP) { atomicAdd(&bar[XB_TMO], 1u); break; } }
    }
    nloc = mine > 0u ? mine : 1u; nx = cnt > 0u ? cnt : 1u;
}
__device__ __forceinline__ void xcd_barrier(const XcdBarrier& b) {
    asm volatile("s_waitcnt vmcnt(0)" ::: "memory");
    __syncthreads();
    if (threadIdx.x == 0) {
        unsigned* bar = b.bar; unsigned bx_ = b.x;
        asm volatile("" : "+s"(bar), "+s"(bx_));
        __builtin_amdgcn_s_waitcnt(0);
        unsigned nloc = b.st[0], nx = b.st[1];
        if (nloc == 0u) { xcd_barrier_complete(bar, bx_, nloc, nx); b.st[0] = nloc; b.st[1] = nx; }
        const unsigned old = xb_add(&bar[XB_XSUB(bx_)], 1u);
        const unsigned gen = old / nloc;
        if (old + 1u == (gen + 1u) * nloc) {
            __builtin_amdgcn_fence(__ATOMIC_RELEASE, "agent");
            asm volatile("s_waitcnt vmcnt(0)" ::: "memory");
            const unsigned og = xb_add(&bar[XB_TOP], 1u);
            const unsigned tg = og / nx;
            if (og + 1u == (tg + 1u) * nx) xb_add(&bar[XB_TOPGEN], 1u);
            else XB_SPIN(xb_ld(&bar[XB_TOPGEN]) == tg, bar);
            __builtin_amdgcn_fence(__ATOMIC_ACQUIRE, "agent");
            xb_add(&bar[XB_XGEN(bx_)], 1u);
            asm volatile("s_waitcnt vmcnt(0)" ::: "memory");
        } else {
            XB_SPIN(xb_ld(&bar[XB_XGEN(bx_)]) == gen, bar);
            __builtin_amdgcn_fence(__ATOMIC_ACQUIRE, "agent");
            asm volatile("s_waitcnt vmcnt(0)" ::: "memory");
        }
    }
    __syncthreads();
}

namespace pg8 {
constexpr int BM = 256, BK = 64, HALF = 128, HTB = HALF * BK * 2, STAGE_BYTES = 8 * HTB, NXCD = 8, WGM = 8;
__host__ __device__ __forceinline__ int lds_byte(int r, int c) { const int st = (r >> 4) * 2 + (c >> 5), rr = r & 15, cc = c & 31, ob = rr * 64 + cc * 2; return st * 1024 + (ob ^ (((ob >> 9) & 1) << 5)); }
__host__ __device__ __forceinline__ void stage_rc(int b, int& R, int& C) { const int st = b / 1024, sb = b % 1024, swz = sb ^ (((sb >> 9) & 1) << 5); R = (st >> 1) * 16 + swz / 64; C = (st & 1) * 32 + (swz % 64) / 2; }
__host__ __device__ __forceinline__ int perm32(int rho) { const int n = rho >> 4, i = rho & 15; return 8 * (i >> 2) + 4 * n + (i & 3); }
struct Unit { int pm, pn; };
struct Gemm { const bf16_t* A; const bf16_t* Bt; int M, N, K; };
struct StaticOrder {
    int nM, nN, nwg, G, c;
    __host__ __device__ void init(int M_, int N_, int G_, int c_) { nM = M_ / BM; nN = N_ / BM; nwg = nM * nN; G = G_; c = c_; }
    __host__ __device__ bool next(int i, Unit& u) const {
        const long L = (long)i * G + c; if (L >= nwg) return false;
        int wgid = (int)L; { const int q = nwg / NXCD, r = nwg % NXCD, xcd = wgid % NXCD, off = wgid / NXCD; wgid = (xcd < r ? xcd * (q + 1) : r * (q + 1) + (xcd - r) * q) + off; }
        const int nig = WGM * nN, gid = wgid / nig, fm = gid * WGM, gsz = (nM - fm) < WGM ? (nM - fm) : WGM;
        u.pm = fm + ((wgid % nig) % gsz); u.pn = (wgid % nig) / gsz; return true;
    }
    __device__ __forceinline__ void a_ready(const Unit&) const {}
    __device__ __forceinline__ void done(const Unit&) const {}
};
struct EpiBf16 {
    static constexpr bool PERM = true, I8 = false; typedef f32x4 acc_t;
    bf16_t* O; int ldc;
    __device__ __forceinline__ void operator()(const f32x4 (&acc)[2][2][4][2], const Unit& u, int wr, int wc, int fr, int fq) const {
        const int row0 = u.pm * BM + wr * 64 + fr; const int col0 = u.pn * BM + wc * 32 + 8 * fq;
#pragma unroll
        for (int ai = 0; ai < 2; ++ai)
#pragma unroll
            for (int m = 0; m < 4; ++m) { bf16_t* rowp = O + (size_t)(row0 + ai * HALF + m * 16) * ldc + col0;
#pragma unroll
                for (int bj = 0; bj < 2; ++bj) { const f32x4 v0 = acc[ai][bj][m][0], v1 = acc[ai][bj][m][1];
                    u32x4 w; w.x = pkbf_c(v0[0], v0[1]); w.y = pkbf_c(v0[2], v0[3]); w.z = pkbf_c(v1[0], v1[1]); w.w = pkbf_c(v1[2], v1[3]);
                    *(u32x4*)(rowp + bj * HALF) = w; } }
    }
};
struct EpiBf16I8 {
    static constexpr bool PERM = true, I8 = true; typedef i32x4 acc_t;
    bf16_t* O; int ldc; const float* sa; const float* wmax;
    __device__ __forceinline__ void operator()(const i32x4 (&acc)[2][2][4][2], const Unit& u, int wr, int wc, int fr, int fq) const {
        const int row0 = u.pm * BM + wr * 64 + fr; const int col0 = u.pn * BM + wc * 32 + 8 * fq;
        f32x4 sw[2][2];
#pragma unroll
        for (int bj = 0; bj < 2; ++bj)
#pragma unroll
            for (int n = 0; n < 2; ++n) sw[bj][n] = *(const f32x4*)(wmax + col0 + bj * HALF + 4 * n) * (1.f / 127.f);
#pragma unroll
        for (int ai = 0; ai < 2; ++ai)
#pragma unroll
            for (int m = 0; m < 4; ++m) { const int row = row0 + ai * HALF + m * 16; const float sr = sa[row]; bf16_t* rowp = O + (size_t)row * ldc + col0;
#pragma unroll
                for (int bj = 0; bj < 2; ++bj) { const i32x4 a0 = acc[ai][bj][m][0], a1 = acc[ai][bj][m][1];
                    const f32x4 v0 = (f32x4){(float)a0[0], (float)a0[1], (float)a0[2], (float)a0[3]} * sw[bj][0] * sr, v1 = (f32x4){(float)a1[0], (float)a1[1], (float)a1[2], (float)a1[3]} * sw[bj][1] * sr;
                    u32x4 w; w.x = pkbf(v0[0], v0[1]); w.y = pkbf(v0[2], v0[3]); w.z = pkbf(v1[0], v1[1]); w.w = pkbf(v1[2], v1[3]);
                    *(u32x4*)(rowp + bj * HALF) = w; } }
    }
};
struct EpiRes {
    static constexpr bool PERM = false, I8 = false; typedef f32x4 acc_t;
    const float* src_lat; const float* src_ctx; float* dst_lat; float* dst_ctx; const float* gate;
    __device__ __forceinline__ void operator()(const f32x4 (&acc)[2][2][4][2], const Unit& u, int wr, int wc, int fr, int fq) const {
        const bool isctx = u.pm >= (ML / BM);
        const float* src = isctx ? src_ctx + (size_t)(u.pm - ML / BM) * BM * D : src_lat + (size_t)u.pm * BM * D;
        float* dst = isctx ? dst_ctx + (size_t)(u.pm - ML / BM) * BM * D : dst_lat + (size_t)u.pm * BM * D;
        const int mrow = isctx ? 2 : (u.pm >= (T / BM) ? 1 : 0);
        const int row0 = wr * 64 + fr, col0 = u.pn * BM + wc * 32 + 4 * fq;
        f32x4 gv[2][2];
#pragma unroll
        for (int bj = 0; bj < 2; ++bj)
#pragma unroll
            for (int n = 0; n < 2; ++n) gv[bj][n] = *(const f32x4*)(gate + mrow * 6144 + col0 + bj * HALF + n * 16);
#pragma unroll
        for (int ai = 0; ai < 2; ++ai)
#pragma unroll
            for (int m = 0; m < 4; ++m) { const size_t off = (size_t)(row0 + ai * HALF + m * 16) * D + col0;
#pragma unroll
                for (int bj = 0; bj < 2; ++bj)
#pragma unroll
                    for (int n = 0; n < 2; ++n) { const f32x4 s = *(const f32x4*)(src + off + bj * HALF + n * 16);
                        *(f32x4*)(dst + off + bj * HALF + n * 16) = s + gv[bj][n] * acc[ai][bj][m][n]; } }
    }
};

struct EpiResI8 {
    static constexpr bool PERM = false, I8 = true; typedef i32x4 acc_t;
    const float* src_lat; const float* src_ctx; float* dst_lat; float* dst_ctx; const float* gate; const float* sa; const float* wmax;
    __device__ __forceinline__ void operator()(const i32x4 (&acc)[2][2][4][2], const Unit& u, int wr, int wc, int fr, int fq) const {
        const bool isctx = u.pm >= (ML / BM);
        const float* src = isctx ? src_ctx + (size_t)(u.pm - ML / BM) * BM * D : src_lat + (size_t)u.pm * BM * D;
        float* dst = isctx ? dst_ctx + (size_t)(u.pm - ML / BM) * BM * D : dst_lat + (size_t)u.pm * BM * D;
        const int mrow = isctx ? 2 : (u.pm >= (T / BM) ? 1 : 0);
        const int row0 = wr * 64 + fr, col0 = u.pn * BM + wc * 32 + 4 * fq;
        f32x4 gv[2][2];
#pragma unroll
        for (int bj = 0; bj < 2; ++bj)
#pragma unroll
            for (int n = 0; n < 2; ++n) gv[bj][n] = *(const f32x4*)(gate + mrow * 6144 + col0 + bj * HALF + n * 16) * *(const f32x4*)(wmax + col0 + bj * HALF + n * 16) * (1.f / 127.f);
#pragma unroll
        for (int ai = 0; ai < 2; ++ai)
#pragma unroll
            for (int m = 0; m < 4; ++m) { const int rl = row0 + ai * HALF + m * 16; const float sr = sa[u.pm * BM + rl]; const size_t off = (size_t)rl * D + col0;
#pragma unroll
                for (int bj = 0; bj < 2; ++bj)
#pragma unroll
                    for (int n = 0; n < 2; ++n) { const f32x4 sv = *(const f32x4*)(src + off + bj * HALF + n * 16); const i32x4 ac = acc[ai][bj][m][n];
                        *(f32x4*)(dst + off + bj * HALF + n * 16) = sv + gv[bj][n] * ((f32x4){(float)ac[0], (float)ac[1], (float)ac[2], (float)ac[3]} * sr); } }
    }
};
template <class Epi, class Sched>
__device__ __forceinline__ void gemm_phase(LAS unsigned char* lds, const Gemm g, const Sched& S, const Epi& E) {
    constexpr bool I8 = Epi::I8;
    typedef typename Epi::acc_t acc_t;
    int tid = threadIdx.x; asm volatile("" : "+v"(tid)); const int wid = __builtin_amdgcn_readfirstlane(tid >> 6), lane = tid & 63, wr = wid >> 2, wc = wid & 3, fr = lane & 15, fq = lane >> 4;
    const int K = g.K, nt = K / BK;
    unsigned voffA[2], voffB[2];
#pragma unroll
    for (int i = 0; i < 2; ++i) { int R, C; stage_rc(tid * 16 + i * 8192, R, C); const int Rb = Epi::PERM ? ((R & ~31) + perm32(R & 31)) : R;
        voffA[i] = (unsigned)(R * K + C) * 2u; voffB[i] = (unsigned)(Rb * K + C) * 2u; }
    const size_t kstep = (size_t)(BK * 2);
    const size_t hstep = (size_t)HALF * K * 2;
    const size_t tstep = 2 * hstep;
    const unsigned ldsw = (unsigned)wid * 1024u;
    const int aoff = lds_byte(wr * 64 + fr, fq * 8), boff = lds_byte(wc * 32 + fr, fq * 8);
#define PG8_SA(b, h) (((b) * 2 + (h)) * HTB)
#define PG8_SB(b, h) ((4 + (b) * 2 + (h)) * HTB)
#define PG8_STAGE(bufoff, gbase, voff) do { _Pragma("unroll") for (int _i = 0; _i < 2; ++_i) \
        __builtin_amdgcn_global_load_lds((const unsigned*)((const char*)(gbase) + (voff)[_i]), (LAS unsigned*)(lds + (bufoff) + ldsw + _i * 8192), 16, 0, 0); } while (0)
#define PG8_LDA(dst, b, h) do { _Pragma("unroll") for (int m = 0; m < 4; ++m) _Pragma("unroll") for (int k = 0; k < 2; ++k) dst[m][k] = *(const LAS bf16x8*)(lds + PG8_SA(b, h) + aoff + m * 2048 + k * 1024); } while (0)
#define PG8_LDB(dst, b, h) do { _Pragma("unroll") for (int n = 0; n < 2; ++n) _Pragma("unroll") for (int k = 0; k < 2; ++k) dst[n][k] = *(const LAS bf16x8*)(lds + PG8_SB(b, h) + boff + n * 2048 + k * 1024); } while (0)
#define PG8_MMA(ai, bj, At, Bt) do { __builtin_amdgcn_s_setprio(1); _Pragma("unroll") for (int m = 0; m < 4; ++m) _Pragma("unroll") for (int n = 0; n < 2; ++n) _Pragma("unroll") for (int k = 0; k < 2; ++k) \
        { if constexpr (I8) acc[ai][bj][m][n] = __builtin_bit_cast(acc_t, __builtin_amdgcn_mfma_i32_16x16x64_i8(__builtin_bit_cast(i32x4, Bt[n][k]), __builtin_bit_cast(i32x4, At[m][k]), __builtin_bit_cast(i32x4, acc[ai][bj][m][n]), 0, 0, 0)); \
          else acc[ai][bj][m][n] = __builtin_bit_cast(acc_t, __builtin_amdgcn_mfma_f32_16x16x32_bf16(Bt[n][k], At[m][k], __builtin_bit_cast(f32x4, acc[ai][bj][m][n]), 0, 0, 0)); } __builtin_amdgcn_s_setprio(0); } while (0)
#define PG8_WAIT_V(n) asm volatile("s_waitcnt vmcnt(" #n ")" ::: "memory")
#define PG8_WAIT_L(n) asm volatile("s_waitcnt lgkmcnt(" #n ")" ::: "memory")
#define PG8_BAR __builtin_amdgcn_s_barrier()
#define PG8_SCHED __builtin_amdgcn_sched_barrier(0)
    Unit cur, nxt; int ui = 0;
    if (!S.next(0, cur)) return;
    acc_t acc[2][2][4][2];
#pragma unroll
    for (int a = 0; a < 2; ++a)
#pragma unroll
        for (int b = 0; b < 2; ++b)
#pragma unroll
            for (int m = 0; m < 4; ++m)
#pragma unroll
                for (int n = 0; n < 2; ++n) acc[a][b][m][n] = acc_t{};
    bf16x8 At[4][2], B0[2][2], B1[2][2];
    const char* cA = (const char*)g.A + (size_t)cur.pm * tstep; const char* cB = (const char*)g.Bt + (size_t)cur.pn * tstep;
    S.a_ready(cur);
    PG8_STAGE(PG8_SB(0, 0), cB, voffB); PG8_STAGE(PG8_SA(0, 0), cA, voffA); PG8_STAGE(PG8_SB(0, 1), cB + hstep, voffB); PG8_STAGE(PG8_SA(0, 1), cA + hstep, voffA);
    if (wr == 1) PG8_BAR;
    PG8_WAIT_V(4); PG8_BAR;
    PG8_STAGE(PG8_SB(1, 0), cB + kstep, voffB); PG8_STAGE(PG8_SA(1, 0), cA + kstep, voffA); PG8_STAGE(PG8_SB(1, 1), cB + hstep + kstep, voffB);
    PG8_WAIT_V(6); PG8_BAR;
    for (;;) {
        const bool has_next = S.next(ui + 1, nxt);
        const char* nA = has_next ? (const char*)g.A + (size_t)nxt.pm * tstep : cA; const char* nB = has_next ? (const char*)g.Bt + (size_t)nxt.pn * tstep : cB;
        for (int t = 0; t < nt; t += 2) {
            const bool last = (t == nt - 2);
            const char* a1 = cA + (size_t)(t + 1) * kstep;
            const char* a2 = last ? nA : cA + (size_t)(t + 2) * kstep; const char* b2 = last ? nB : cB + (size_t)(t + 2) * kstep;
            const char* a3 = a2 + kstep; const char* b3 = b2 + kstep;
            if (last && has_next) S.a_ready(nxt);
            PG8_LDB(B0, 0, 0); PG8_SCHED; PG8_LDA(At, 0, 0); PG8_STAGE(PG8_SA(1, 1), a1 + hstep, voffA);
            PG8_WAIT_L(8); PG8_BAR; PG8_WAIT_L(0); PG8_MMA(0, 0, At, B0); PG8_BAR; PG8_SCHED;
            PG8_LDB(B1, 0, 1); PG8_STAGE(PG8_SB(0, 0), b2, voffB);
            PG8_BAR; PG8_WAIT_L(0); PG8_MMA(0, 1, At, B1); PG8_BAR;
            PG8_LDA(At, 0, 1); PG8_STAGE(PG8_SA(0, 0), a2, voffA);
            PG8_BAR; PG8_WAIT_L(0); PG8_MMA(1, 0, At, B0); PG8_BAR; PG8_SCHED;
            PG8_STAGE(PG8_SB(0, 1), b2 + hstep, voffB);
            PG8_WAIT_V(6); PG8_BAR; PG8_MMA(1, 1, At, B1); PG8_BAR;
            PG8_LDB(B0, 1, 0); PG8_SCHED; PG8_LDA(At, 1, 0); PG8_STAGE(PG8_SA(0, 1), a2 + hstep, voffA);
            PG8_WAIT_L(8); PG8_BAR; PG8_WAIT_L(0); PG8_MMA(0, 0, At, B0); PG8_BAR; PG8_SCHED;
            PG8_LDB(B1, 1, 1); PG8_STAGE(PG8_SB(1, 0), b3, voffB);
            PG8_BAR; PG8_WAIT_L(0); PG8_MMA(0, 1, At, B1); PG8_BAR;
            PG8_LDA(At, 1, 1); PG8_STAGE(PG8_SA(1, 0), a3, voffA);
            PG8_BAR; PG8_WAIT_L(0); PG8_MMA(1, 0, At, B0); PG8_BAR; PG8_SCHED;
            PG8_STAGE(PG8_SB(1, 1), b3 + hstep, voffB);
            PG8_WAIT_V(6); PG8_BAR; PG8_MMA(1, 1, At, B1); PG8_BAR;
        }
        E(acc, cur, wr, wc, fr, fq); S.done(cur);
        if (!has_next) break;
#pragma unroll
        for (int a = 0; a < 2; ++a)
#pragma unroll
            for (int b = 0; b < 2; ++b)
#pragma unroll
                for (int m = 0; m < 4; ++m)
#pragma unroll
                    for (int n = 0; n < 2; ++n) acc[a][b][m][n] = acc_t{};
        cur = nxt; cA = nA; cB = nB; ++ui;
    }
    PG8_WAIT_V(0);
    if (wr == 0) PG8_BAR;
    PG8_BAR;
#undef PG8_SA
#undef PG8_SB
#undef PG8_STAGE
#undef PG8_LDA
#undef PG8_LDB
#undef PG8_MMA
#undef PG8_WAIT_V
#undef PG8_WAIT_L
#undef PG8_BAR
#undef PG8_SCHED
}
}

namespace att {
constexpr int HD = 128, NW = 8, QBLK = 32, KVBLK = 64;
constexpr float SCALE = 0.088388347648318440f;
constexpr float THR = 8.f;
constexpr int LDQ = 512, LDK = 256;
constexpr size_t SHM_V = KVBLK * HD * 2, SHM_K = KVBLK * HD * 2, SHM_ATTN = 2 * SHM_V + 2 * SHM_K + NW * 64 * 4;
#define KSWZ(row, colB) ((row) * 256 + ((colB) ^ (((row) & 7) << 4)))
#define SBAR() __builtin_amdgcn_sched_barrier(0)
__device__ __forceinline__ int crow(int r, int hi) { return (r & 3) + 8 * (r >> 2) + 4 * hi; }
__device__ __forceinline__ unsigned cvtpk(float lo, float hi) { unsigned r; asm volatile("v_cvt_pk_bf16_f32 %0, %1, %2" : "=v"(r) : "v"(lo), "v"(hi)); return r; }
__device__ __forceinline__ void partialSM(f32x16& p0, f32x16& p1) {
  for (int r = 0; r < 16; ++r) p0[r] = __builtin_amdgcn_exp2f(p0[r]);
}
typedef int i32x8 __attribute__((ext_vector_type(8)));
__device__ __forceinline__ void finishSM(f32x16& p0, f32x16& p1, i32x8& pa) {
  for (int r = 0; r < 16; ++r) p1[r] = __builtin_amdgcn_exp2f(p1[r]);
#pragma unroll
  for (int q = 0; q < 4; ++q) { int w = __builtin_amdgcn_cvt_pk_bf8_f32(p0[4 * q], p0[4 * q + 1], 0, false); w = __builtin_amdgcn_cvt_pk_bf8_f32(p0[4 * q + 2], p0[4 * q + 3], w, true); pa[q] = w;
    int w2 = __builtin_amdgcn_cvt_pk_bf8_f32(p1[4 * q], p1[4 * q + 1], 0, false); w2 = __builtin_amdgcn_cvt_pk_bf8_f32(p1[4 * q + 2], p1[4 * q + 3], w2, true); pa[4 + q] = w2; }
}
constexpr int K8_STRIDE = 144, K8_TILE = KVBLK * K8_STRIDE;
__device__ __forceinline__ void qkt(f32x16& p0, f32x16& p1, const unsigned char* Ks, const i32x8* qr, int r32, int hi, const f32x16& cinit) {
  p0 = cinit; p1 = cinit;
#pragma unroll
  for (int ks = 0; ks < 2; ++ks) {
    const u32x4* a0 = (const u32x4*)(Ks + r32 * K8_STRIDE + 64 * ks + 32 * hi); const u32x4* a1 = (const u32x4*)(Ks + (32 + r32) * K8_STRIDE + 64 * ks + 32 * hi);
    const u32x4 x0 = a0[0], x1 = a0[1], y0 = a1[0], y1 = a1[1];
    const i32x8 k0 = {(int)x0.x, (int)x0.y, (int)x0.z, (int)x0.w, (int)x1.x, (int)x1.y, (int)x1.z, (int)x1.w}, k1 = {(int)y0.x, (int)y0.y, (int)y0.z, (int)y0.w, (int)y1.x, (int)y1.y, (int)y1.z, (int)y1.w};
    p0 = __builtin_amdgcn_mfma_scale_f32_32x32x64_f8f6f4(k0, qr[ks], p0, 0, 0, 0, 0x7F7F7F7F, 0, 0x7C7C7C7C);
    p1 = __builtin_amdgcn_mfma_scale_f32_32x32x64_f8f6f4(k1, qr[ks], p1, 0, 0, 0, 0x7F7F7F7F, 0, 0x7C7C7C7C); }
}
constexpr int V8_STRIDE = 80, V8_TILE = HD * V8_STRIDE;
__device__ __forceinline__ void pv_d0(f32x16* o, f32x16& ol, const unsigned char* Vs, const i32x8& pa, int r32, int hi) {
  { const i32x8 ones = {0x38383838, 0x38383838, 0x38383838, 0x38383838, 0x38383838, 0x38383838, 0x38383838, 0x38383838};
    ol = __builtin_amdgcn_mfma_scale_f32_32x32x64_f8f6f4(pa, ones, ol, 1, 0, 0, 0x7F7F7F7F, 0, 0x7F7F7F7F); }
#pragma unroll
  for (int d0 = 0; d0 < 4; ++d0) { const u32x4* bp = (const u32x4*)(Vs + (32 * d0 + r32) * V8_STRIDE + 32 * hi); const u32x4 x0 = bp[0], x1 = bp[1];
    const i32x8 vb = {(int)x0.x, (int)x0.y, (int)x0.z, (int)x0.w, (int)x1.x, (int)x1.y, (int)x1.z, (int)x1.w};
    o[d0] = __builtin_amdgcn_mfma_scale_f32_32x32x64_f8f6f4(pa, vb, o[d0], 1  , 0  , 0, 0x7F7F7F7F, 0, 0x7F7F7F7F); }
}
__device__ __forceinline__ void attn_dense_body(const unsigned char* __restrict__ Qb, const unsigned char* __restrict__ Kh, const unsigned char* __restrict__ Vt,
                                                bf16_t* __restrict__ Ob, int LDO, int seq, char* lds, float* __restrict__ lse, float braw) {
  int tid = threadIdx.x; asm volatile("" : "+v"(tid)); const int wid = tid >> 6, lane = tid & 63, r32 = lane & 31, hi = lane >> 5;
  unsigned char* V_lds = (unsigned char*)lds; unsigned char* K_lds = (unsigned char*)(lds + 3 * V8_TILE);
  f32x16 o[4] = {}, ol = {}; i32x8 qr[2];
  const float mnC = __builtin_bit_cast(float, __builtin_amdgcn_readfirstlane(__builtin_bit_cast(int, -fmaxf(braw * (SCALE * 1.4426950408889634f) - 15.5f, 0.f))));
  f32x16 cinit;
#pragma unroll
  for (int r = 0; r < 16; ++r) cinit[r] = mnC;
  const unsigned char* Qw = Qb + (long)(wid * QBLK + r32) * LDQ + hi * 32;
#pragma unroll
  for (int ks = 0; ks < 2; ++ks) { const u32x4 x0 = *(const u32x4*)(Qw + 64 * ks), x1 = *(const u32x4*)(Qw + 64 * ks + 16);
    qr[ks] = (i32x8){(int)x0.x, (int)x0.y, (int)x0.z, (int)x0.w, (int)x1.x, (int)x1.y, (int)x1.z, (int)x1.w}; }
  const int krow = tid >> 3, kch = tid & 7;
  const int vrow = tid >> 2, vch = tid & 3;
  struct { u32x4 v8, k8; } sr_[2];
#define SLOAD(i, k0) do { sr_[i].v8 = *reinterpret_cast<const u32x4*>(Vt + (long)((k0) >> 6) * 8192 + tid * 16); \
    sr_[i].k8 = *reinterpret_cast<const u32x4*>(Kh + (long)((k0) + krow) * LDK + kch * 16); } while (0)
#define SWRITE(b, i) do { *(u32x4*)(V_lds + (b) * V8_TILE + vrow * V8_STRIDE + vch * 16) = sr_[i].v8; \
    *(u32x4*)(K_lds + (b) * K8_TILE + krow * K8_STRIDE + kch * 16) = sr_[i].k8; } while (0)
#define SWAIT() asm volatile("s_waitcnt vmcnt(2)" ::: "memory")
  f32x16 pA0, pA1, pB0, pB1; i32x8 pa; const int NT = seq / KVBLK;
  constexpr int SE = 0, SO = 1;
  SLOAD(SE, 0); asm volatile("s_waitcnt vmcnt(0)" ::: "memory"); SWRITE(0, SE);
  SLOAD(SO, KVBLK); SLOAD(SE, 2 * KVBLK);
  __syncthreads();
  qkt(pA0, pA1, K_lds, qr, r32, hi, cinit); partialSM(pA0, pA1);
  SWAIT(); SWRITE(1, SO); SLOAD(SO, 3 * KVBLK);
  __syncthreads();
  int s0 = 0, s1 = 1, s2 = 2;
  for (int j = 1; j + 1 < NT; j += 2) {
    SBAR(); qkt(pB0, pB1, K_lds + s1 * K8_TILE, qr, r32, hi, cinit);
    finishSM(pA0, pA1, pa); SBAR();
    pv_d0(o, ol, V_lds + s0 * V8_TILE, pa, r32, hi); partialSM(pB0, pB1);
    SBAR(); SWAIT(); SWRITE(s2, SE); SLOAD(SE, (j + 3 < NT ? j + 3 : NT - 1) * KVBLK);
    __syncthreads();
    SBAR(); qkt(pA0, pA1, K_lds + s2 * K8_TILE, qr, r32, hi, cinit);
    finishSM(pB0, pB1, pa); SBAR();
    pv_d0(o, ol, V_lds + s1 * V8_TILE, pa, r32, hi); partialSM(pA0, pA1);
    SBAR(); SWAIT(); SWRITE(s0, SO); SLOAD(SO, (j + 4 < NT ? j + 4 : NT - 1) * KVBLK);
    __syncthreads();
    { const int t_ = s0; s0 = s2; s2 = s1; s1 = t_; }
  }
  SBAR(); qkt(pB0, pB1, K_lds + s1 * K8_TILE, qr, r32, hi, cinit);
  finishSM(pA0, pA1, pa); SBAR();
  pv_d0(o, ol, V_lds + s0 * V8_TILE, pa, r32, hi); partialSM(pB0, pB1);
  finishSM(pB0, pB1, pa); SBAR();
  pv_d0(o, ol, V_lds + s1 * V8_TILE, pa, r32, hi);
  asm volatile("s_waitcnt vmcnt(0)" ::: "memory");
  if (lse && r32 == 0) {
#pragma unroll
    for (int r = 0; r < 16; ++r) lse[(wid * QBLK + crow(r, hi)) * 4] = __logf(ol[r]) - mnC * 0.69314718055994531f; }
  float rli[16];
#pragma unroll
  for (int r = 0; r < 16; ++r) rli[r] = __builtin_amdgcn_rcpf(ol[r]);
  bf16_t* Ow = Ob + (long)(wid * QBLK) * LDO;
#pragma unroll
  for (int r = 0; r < 16; ++r) { int orow = crow(r, hi);
    for (int d0 = 0; d0 < 4; ++d0) Ow[(long)orow * LDO + d0 * 32 + r32] = (bf16_t)(pkbf(o[d0][r] * rli[r], 0.f) & 0xffffu); }
  __syncthreads();
#undef SLOAD
#undef SWRITE
#undef SWAIT
}
}

struct Args { const float* in[20]; float* out; unsigned char* ws; int ph_lo, ph_hi; };
typedef const __attribute__((address_space(4))) Args* KArgs;
__device__ __forceinline__ KArgs get_args() { KArgs p = (KArgs)__builtin_amdgcn_kernarg_segment_ptr(); asm volatile("" : "+s"(p)); return p; }
__device__ __forceinline__ int fresh_tid() { int t = threadIdx.x; asm volatile("" : "+v"(t)); return t; }
__device__ __forceinline__ int fresh_bx() { int t = blockIdx.x; asm volatile("" : "+s"(t)); return t; }
__device__ __forceinline__ int fresh_g() { int t = gridDim.x; asm volatile("" : "+s"(t)); return t; }
enum { I_X = 0, I_C, I_CTX, I_CCTX, I_ADAW, I_ADAB, I_N1W, I_N2W, I_WIN, I_QNW, I_KNW, I_CONVW, I_ALOG, I_DTB, I_DNW, I_WOUT, I_WQ, I_SUBK, I_U, I_V };

__device__ __forceinline__ void convert_tables(const float* U, const float* V, unsigned char* ws, int l, int wvi, int nwv, int lane, int rw_end = 2 * NEXP) {
    const float* us = U + (size_t)l * NEXP * 1024; const float* vs = V + (size_t)l * NEXP * 1024;
    const int set = l & 1;
    float* scl = (float*)(ws + WS_USC) + set * 2 * NEXP;
    for (int rw = wvi; rw < rw_end; rw += nwv) {
        const bool isu = rw < NEXP; const int e = isu ? rw : rw - NEXP;
        const f32x4* sp = (const f32x4*)((isu ? us : vs) + (size_t)e * 1024 + 16 * lane);
        f32x4 x[4]; float mx = 0.f;
#pragma unroll
        for (int i = 0; i < 4; ++i) { x[i] = sp[i]; mx = fmaxf(mx, fmaxf(fmaxf(fabsf(x[i][0]), fabsf(x[i][1])), fmaxf(fabsf(x[i][2]), fabsf(x[i][3])))); }
        mx = wave_max(mx);
        const float sc = fmaxf(mx, 1e-30f) * (1.f / 127.f), inv = 1.f / sc;
        u32x4 o4;
        const float ofs = ((GATHER_PART && isu) || GATHER_PART == 2) ? 0.f : 128.f;
#pragma unroll
        for (int i = 0; i < 4; ++i) { const unsigned b0 = (unsigned)(int)(rintf(x[i][0] * inv) + ofs) & 255u, b1 = (unsigned)(int)(rintf(x[i][1] * inv) + ofs) & 255u, b2 = (unsigned)(int)(rintf(x[i][2] * inv) + ofs) & 255u, b3 = (unsigned)(int)(rintf(x[i][3] * inv) + ofs) & 255u;
            o4[i] = b0 | (b1 << 8) | (b2 << 16) | (b3 << 24); }
        if (GATHER_PART == 2) *(u32x4*)(ws + WS_UB + (size_t)set * TAB_SET + (isu ? 0 : (size_t)NEXP * 1024) + ((size_t)(lane >> 3) * NEXP + e) * 128 + 16 * (lane & 7)) = o4;
        else *(u32x4*)(ws + WS_UB + (size_t)set * TAB_SET + (size_t)e * 2048 + (isu ? 0 : 1024) + 16 * lane) = o4;
        if (lane == 0) { if (GATHER_PART) scl[2 * e + (isu ? 0 : 1)] = sc; else scl[rw] = sc; }
    }
}

__device__ __forceinline__ void transpose_item(const float* W, int ldw, int K, bf16_t* WT, LAS float* scr, int kb, int nb, int lane) {
    const int k0 = 64 * kb, n0 = 32 * nb;
#pragma unroll 8
    for (int i = 0; i < 32; ++i) { const int kk = 2 * i + (lane >> 5); scr[kk * 33 + (lane & 31)] = W[(size_t)(k0 + kk) * ldw + n0 + (lane & 31)]; }
    LDS_WAIT(); asm volatile("" ::: "memory");
    const int c = lane & 7;
#pragma unroll
    for (int j = 0; j < 4; ++j) { const int n = (lane >> 3) + 8 * j; const LAS float* s = scr + (8 * c) * 33 + n;
        u32x4 o; o.x = pkbf(s[0 * 33], s[1 * 33]); o.y = pkbf(s[2 * 33], s[3 * 33]); o.z = pkbf(s[4 * 33], s[5 * 33]); o.w = pkbf(s[6 * 33], s[7 * 33]);
        *(u32x4*)(WT + (size_t)(n0 + n) * K + k0 + 8 * c) = o; }
    LDS_WAIT(); asm volatile("" ::: "memory");
}
__device__ __forceinline__ void phase_prologue(LAS unsigned char* lds) {
    const KArgs ap = get_args();
#define a (*ap)

    const int tid = fresh_tid(), lane = tid & 63, wave = __builtin_amdgcn_readfirstlane(tid >> 6), G = fresh_g(), bx = fresh_bx();
    unsigned char* ws = a.ws;
    {
        LAS float* sc = (LAS float*)(lds + 70000);
        LAS float* part = (LAS float*)(lds + 70000 + 12288);
        for (int i = tid; i < 3 * 1024; i += 512) { const int r = i >> 10, k = i & 1023; const float v = r < 2 ? a.in[I_C][r * 1024 + k] : a.in[I_CCTX][k]; sc[i] = silu_f(v); }
        __syncthreads();
        float* mod = (float*)(ws + WS_MOD);
        for (int item = bx; item < DEPTH * 96; item += G) {
            const int l = item / 96, j0 = (item % 96) * 64;
            const float* wp = a.in[I_ADAW] + (size_t)l * 1024 * 6144 + (size_t)(wave * 128) * 6144 + j0 + lane;
            float a0 = 0.f, a1 = 0.f, a2 = 0.f;
#pragma unroll 8
            for (int kk = 0; kk < 128; ++kk) { const float w = wp[(size_t)kk * 6144]; const int k = wave * 128 + kk; a0 = fmaf(sc[k], w, a0); a1 = fmaf(sc[1024 + k], w, a1); a2 = fmaf(sc[2048 + k], w, a2); }
            part[(wave * 3 + 0) * 64 + lane] = a0; part[(wave * 3 + 1) * 64 + lane] = a1; part[(wave * 3 + 2) * 64 + lane] = a2;
            __syncthreads();
            if (tid < 192) { const int r = tid >> 6, jj = tid & 63; float s = a.in[I_ADAB][l * 6144 + j0 + jj];
#pragma unroll
                for (int w = 0; w < 8; ++w) s += part[(w * 3 + r) * 64 + jj];
                mod[(size_t)(l * 3 + r) * 6144 + j0 + jj] = s; }
            __syncthreads();
        }
    }
    {
        const int gw = bx * 8 + wave, NGW = G * 8;
        unsigned* wmaxw = (unsigned*)(ws + WS_CTL) + CW_WMAX;
        constexpr int NB_IN = NP / 64, NB_OUT = 1024 / 64, NB_Q = 2048 / 64, PER_L2 = (NB_IN + NB_OUT + NB_Q) * 8;
        for (int it = gw; it < DEPTH * PER_L2; it += NGW) { const int l = it / PER_L2; int r = it % PER_L2; const int kc = r & 7; r >>= 3;
            const int mi = r < NB_IN ? 0 : r < NB_IN + NB_OUT ? 1 : 2; const int nb = mi == 0 ? r : mi == 1 ? r - NB_IN : r - NB_IN - NB_OUT; const int ldw = mi == 0 ? NIN : mi == 1 ? 1024 : 2048;
            const float* wp = (mi == 0 ? a.in[I_WIN] + (size_t)l * 1024 * NIN : mi == 1 ? a.in[I_WOUT] + (size_t)l * 1024 * 1024 : a.in[I_WQ] + (size_t)l * 1024 * 2048) + (size_t)(kc * 128) * ldw + nb * 64 + lane;
            float mx = 0.f;
#pragma unroll 8
            for (int kk = 0; kk < 128; ++kk) mx = fmaxf(mx, fabsf(wp[(size_t)kk * ldw]));
            atomicMax(wmaxw + (l * 3 + mi) * 3072 + nb * 64 + lane, __float_as_uint(mx)); }
    }
    const size_t gt = (size_t)bx * 512 + tid, NT = (size_t)G * 512;
    for (size_t i = gt; i < (size_t)DEPTH * 16 * 1024; i += NT) { const int l = (int)(i >> 14), j = (int)((i >> 10) & 15), k = (int)(i & 1023);
        ((float*)(ws + WS_WSK))[i] = a.in[I_WIN][(size_t)l * 1024 * NIN + (size_t)k * NIN + NP + j]; }
    convert_tables(a.in[I_U], a.in[I_V], ws, 0, bx * 8 + wave, G * 8, lane);
    for (size_t i = gt; i < (size_t)DEPTH * 8 * 2 * 128 * 128 / 2; i += NT) { const f32x2 x = ((const f32x2*)a.in[I_SUBK])[i]; ((unsigned*)(ws + WS_SKB))[i] = pkbf(x[0], x[1]); }
    for (size_t i = gt; i < 8192; i += NT) { const int pos = (int)(i >> 5), fi = (int)(i & 31);
        const float inv = exp2f(-(float)fi * (13.287712379549449f / 32.f)); const float ang = (float)pos * inv;
        float rev = ang * 0.15915494309189535f; rev -= floorf(rev);
        ((float*)(ws + WS_ROPE))[i] = __builtin_amdgcn_cosf(rev); ((float*)(ws + WS_ROPE))[8192 + i] = __builtin_amdgcn_sinf(rev); }
}


__device__ __forceinline__ void quant_transpose_item(const float* W, int ldw, signed char* WT, const unsigned* wmaxw, LAS float* scr, int kb, int nb, int lane) {
    const int k0 = 64 * kb, n0 = 32 * nb;
#pragma unroll 8
    for (int i = 0; i < 32; ++i) { const int kk = 2 * i + (lane >> 5); scr[kk * 33 + (lane & 31)] = W[(size_t)(k0 + kk) * ldw + n0 + (lane & 31)]; }
    LDS_WAIT(); asm volatile("" ::: "memory");
    const int n = lane >> 1, hf = lane & 1;
    const float mx = __uint_as_float(wmaxw[n0 + n]), inv = mx > 0.f ? 127.f / mx : 0.f;
    u32x4 o[2];
#pragma unroll
    for (int q = 0; q < 8; ++q) { unsigned w = 0u;
#pragma unroll
        for (int b = 0; b < 4; ++b) { const int kk = 32 * hf + 4 * q + b; w |= ((unsigned)(int)rintf(scr[kk * 33 + n] * inv) & 255u) << (8 * b); }
        o[q >> 2][q & 3] = w; }
    u32x4* dst = (u32x4*)(WT + (size_t)(n0 + n) * 1024 + k0 + 32 * hf);
    dst[0] = o[0]; dst[1] = o[1];
    LDS_WAIT(); asm volatile("" ::: "memory");
}
__device__ __forceinline__ void phase_quant_weights(LAS unsigned char* lds) {
    const KArgs ap = get_args();
#define a (*ap)
    const int tid = fresh_tid(), lane = tid & 63, wave = __builtin_amdgcn_readfirstlane(tid >> 6), G = fresh_g(), bx = fresh_bx();
    unsigned char* ws = a.ws;
    LAS float* scr = (LAS float*)(lds + 65536 + wave * 8448);
    const unsigned* wmaxw = (const unsigned*)(ws + WS_CTL) + CW_WMAX;
    constexpr int I_IN = 16 * 96, I_OUT = 16 * 32, I_Q = 16 * 64, PER_L = I_IN + I_OUT + I_Q;
    for (int it = bx * 8 + wave; it < DEPTH * PER_L; it += G * 8) { const int l = it / PER_L; int r = it % PER_L;
        if (r < I_IN) quant_transpose_item(a.in[I_WIN] + (size_t)l * 1024 * NIN, NIN, (signed char*)(ws + WS_WINT) + (size_t)l * NP * 1024, wmaxw + (l * 3 + 0) * 3072, scr, r / 96, r % 96, lane);
        else if (r < I_IN + I_OUT) { r -= I_IN; quant_transpose_item(a.in[I_WOUT] + (size_t)l * 1024 * 1024, 1024, (signed char*)(ws + WS_WOUTT) + (size_t)l * 1024 * 1024, wmaxw + (l * 3 + 1) * 3072, scr, r / 32, r % 32, lane); }
        else { r -= I_IN + I_OUT; quant_transpose_item(a.in[I_WQ] + (size_t)l * 1024 * 2048, 2048, (signed char*)(ws + WS_WQT) + (size_t)l * 2048 * 1024, wmaxw + (l * 3 + 2) * 3072, scr, r / 64, r % 64, lane); } }
#undef a
}

template <bool SK>
__device__ __forceinline__ void phase_norm(int l, int which, LAS unsigned char* lds) {
    const KArgs ap = get_args();
#define a (*ap)

    const int tid = fresh_tid(), lane = tid & 63, wave = __builtin_amdgcn_readfirstlane(tid >> 6), G = fresh_g(), bx = fresh_bx();
    unsigned char* ws = a.ws;
    LAS float* wsk = (LAS float*)lds;
    if (SK) { const float* src = (const float*)(ws + WS_WSK) + (size_t)l * 16384; for (int i = tid; i < 16384 / 4; i += 512) ((LAS f32x4*)wsk)[i] = ((const f32x4*)src)[i]; __syncthreads(); }
    const int nrows = (which == 1 && l == DEPTH - 1) ? ML : M;
    const float* nw = a.in[which ? I_N2W : I_N1W] + l * 1024;
    const float* modl = (const float*)(ws + WS_MOD) + (size_t)l * 3 * 6144;
    const int shoff = which ? 3072 : 0, scoff = which ? 4096 : 1024;
    f32x4 nwv[4];
#pragma unroll
    for (int j = 0; j < 4; ++j) nwv[j] = *(const f32x4*)(nw + 4 * lane + 256 * j);
    for (int row = wave * G + bx; row < nrows; row += G * 8) {
        const float* src; int mrow;
        if (row < ML) { src = ((l == 0 && which == 0) ? a.in[I_X] : a.out) + (size_t)row * D; mrow = row >= T ? 1 : 0; }
        else { src = ((l == 0 && which == 0) ? a.in[I_CTX] : (const float*)(ws + WS_CTXX)) + (size_t)(row - ML) * D; mrow = 2; }
        const float* md = modl + mrow * 6144;
        f32x4 v[4]; float ss = 0.f;
#pragma unroll
        for (int j = 0; j < 4; ++j) { v[j] = *(const f32x4*)(src + 4 * lane + 256 * j); ss += (v[j][0] * v[j][0] + v[j][1] * v[j][1]) + (v[j][2] * v[j][2] + v[j][3] * v[j][3]); }
        const float rstd = rsqrtf(wave_sum(ss) * (1.f / D) + EPS);
        signed char* hrow = (signed char*)(ws + WS_H) + (size_t)row * D;
        float hmx = 0.f;
#pragma unroll
        for (int j = 0; j < 4; ++j) { const f32x4 sc = *(const f32x4*)(md + scoff + 4 * lane + 256 * j), sh = *(const f32x4*)(md + shoff + 4 * lane + 256 * j);
            v[j] = v[j] * rstd * nwv[j] * (sc + 1.f) + sh; hmx = fmaxf(hmx, fmaxf(fmaxf(fabsf(v[j][0]), fabsf(v[j][1])), fmaxf(fabsf(v[j][2]), fabsf(v[j][3])))); }
        hmx = fmaxf(wave_max(hmx), 1e-30f);
        { const float hinv = 127.f / hmx;
#pragma unroll
          for (int j = 0; j < 4; ++j) *(unsigned*)(hrow + 4 * lane + 256 * j) = ((unsigned)(int)rintf(v[j][0] * hinv) & 255u) | (((unsigned)(int)rintf(v[j][1] * hinv) & 255u) << 8) | (((unsigned)(int)rintf(v[j][2] * hinv) & 255u) << 16) | (((unsigned)(int)rintf(v[j][3] * hinv) & 255u) << 24);
          if (lane == 0) ((float*)(ws + WS_GB))[row] = hmx * (1.f / 127.f); }
        if (SK) {
            float p[16];
#pragma unroll
            for (int c = 0; c < 16; ++c) { float q = 0.f;
#pragma unroll
                for (int j = 0; j < 4; ++j) { const f32x4 w = *(const LAS f32x4*)(wsk + c * 1024 + 4 * lane + 256 * j); q += (v[j][0] * w[0] + v[j][1] * w[1]) + (v[j][2] * w[2] + v[j][3] * w[3]); }
                p[c] = q; }
            { const bool hb = (lane & 32) != 0;
#pragma unroll
              for (int c = 0; c < 8; ++c) { const float keep = hb ? p[c + 8] : p[c], send = hb ? p[c] : p[c + 8]; p[c] = keep + lane_xor<32>(send); } }
            { const bool hb = (lane & 16) != 0;
#pragma unroll
              for (int c = 0; c < 4; ++c) { const float keep = hb ? p[c + 4] : p[c], send = hb ? p[c] : p[c + 4]; p[c] = keep + lane_xor<16>(send); } }
            { const bool hb = (lane & 8) != 0;
#pragma unroll
              for (int c = 0; c < 2; ++c) { const float keep = hb ? p[c + 2] : p[c], send = hb ? p[c] : p[c + 2]; p[c] = keep + lane_xor<8>(send); } }
            { const bool hb = (lane & 4) != 0; const float keep = hb ? p[1] : p[0], send = hb ? p[0] : p[1]; p[0] = keep + lane_xor<4>(send); }
            p[0] += lane_xor<2>(p[0]); p[0] += lane_xor<1>(p[0]);
            if ((lane & 3) == 0) { const int c = ((lane >> 5) & 1) * 8 + ((lane >> 4) & 1) * 4 + ((lane >> 3) & 1) * 2 + ((lane >> 2) & 1); ((float*)(ws + WS_BA))[(size_t)row * 16 + c] = p[0]; }
        }
    }
    if (SK) __syncthreads();
}

__device__ __forceinline__ void phase_prep(int l, LAS unsigned char* lds) {
    const KArgs ap = get_args();
#define a (*ap)

    const int tid = fresh_tid(), lane = tid & 63, wave = __builtin_amdgcn_readfirstlane(tid >> 6), G = fresh_g(), bx = fresh_bx();
    unsigned char* ws = a.ws;
    const bf16_t* P = (const bf16_t*)(ws + WS_P);
    const float* ropec = (const float*)(ws + WS_ROPE); const float* ropes = ropec + 8192;
    const int sec = lane >> 5, fi = lane & 31;
    const float qw0 = a.in[I_QNW][l * 128 + sec * 64 + fi], qw1 = a.in[I_QNW][l * 128 + sec * 64 + 32 + fi];
    const float kw0 = a.in[I_KNW][l * 128 + sec * 64 + fi], kw1 = a.in[I_KNW][l * 128 + sec * 64 + 32 + fi];
    for (int row = wave * G + bx; row < M; row += G * 8) {
        const bool lat = row < ML;
        int b, tt, tlen; if (lat) { b = row >> 14; tt = row & (T - 1); tlen = T; } else { b = (row - ML) >> 8; tt = (row - ML) & (CT - 1); tlen = CT; }
        const bf16_t* prow = P + (size_t)row * NP;
        unsigned short xa[6][2];
#pragma unroll
        for (int hh = 0; hh < 6; ++hh) { const bf16_t* xp = prow + (hh < 4 ? hh * 128 : 512 + (hh - 4) * 128) + sec * 64 + fi; xa[hh][0] = xp[0]; xa[hh][1] = xp[32]; }
        const u32x2 vcp = *(const u32x2*)(prow + 768 + 4 * lane);
        float cs = 1.f, sn = 0.f;
        if (lat) { const int pos = sec ? (tt & 63) : (tt >> 6); cs = ropec[pos * 32 + fi]; sn = ropes[pos * 32 + fi]; }
        unsigned char* qo8 = ws + WS_QA + (size_t)row * 512;
        const size_t kvrow = (size_t)b * KVLEN + (lat ? tt : T + tt);
        unsigned char* ko8 = ws + WS_KA + kvrow * 256;
        float ssq[6];
#pragma unroll
        for (int hh = 0; hh < 6; ++hh) { const float x0 = bf2f(xa[hh][0]), x1 = bf2f(xa[hh][1]); ssq[hh] = x0 * x0 + x1 * x1; }
#pragma unroll
        for (int hh = 0; hh < 6; ++hh) ssq[hh] = wave_sum(ssq[hh]);
#pragma unroll
        for (int hh = 0; hh < 6; ++hh) {
            const float x0 = bf2f(xa[hh][0]), x1 = bf2f(xa[hh][1]);
            const float rs = rsqrtf(ssq[hh] * (1.f / 128.f) + EPS);
            const float y0 = x0 * rs * (hh < 4 ? qw0 : kw0), y1 = x1 * rs * (hh < 4 ? qw1 : kw1);
            const float qsc = hh < 4 ? 0.088388347648318440f * 1.4426950408889634f : 1.f;
            const float o0 = (y0 * cs - y1 * sn) * qsc, o1 = (y1 * cs + y0 * sn) * qsc;
            unsigned char* op8 = (hh < 4 ? qo8 + hh * 128 : ko8 + (hh - 4) * 128) + sec * 64 + fi;
            const float f8s = hh < 4 ? 8.f : 1.f;
            const int pk8 = __builtin_amdgcn_cvt_pk_fp8_f32(o0 * f8s, o1 * f8s, 0, false);
            op8[0] = (unsigned char)(pk8 & 255); op8[32] = (unsigned char)((pk8 >> 8) & 255);
        }
        { const int pos = lat ? tt : T + tt, tile = pos >> 6, k64 = pos & 63, k32 = k64 & 31;
          const int bytepos = 32 * ((k32 >> 2) & 1) + 16 * (k64 >> 5) + (k32 & 3) + 4 * (k32 >> 3);
          unsigned char* vt = ws + WS_VA + ((size_t)(b * 2) * (KVLEN / 64) + tile) * 8192 + bytepos;
          const unsigned short* vsrc = (const unsigned short*)&vcp;
          const int kvh_ = lane >> 5, d0 = (4 * lane) & 127;
          const int pk01 = __builtin_amdgcn_cvt_pk_fp8_f32(bf2f(vsrc[0]), bf2f(vsrc[1]), 0, false), pk23 = __builtin_amdgcn_cvt_pk_fp8_f32(bf2f(vsrc[2]), bf2f(vsrc[3]), 0, false);
          unsigned char* vt2 = vt + (size_t)kvh_ * (KVLEN / 64) * 8192 + (size_t)d0 * 64;
          vt2[0] = (unsigned char)(pk01 & 255); vt2[64] = (unsigned char)((pk01 >> 8) & 255); vt2[128] = (unsigned char)(pk23 & 255); vt2[192] = (unsigned char)((pk23 >> 8) & 255); }
    }
    __syncthreads();
}

constexpr int ATT_PARTS = 4;
__device__ __forceinline__ void phase_attn(int l, unsigned char* lds_raw, volatile LAS unsigned* MISC, int rep) {
    const KArgs ap = get_args();
#define a (*ap)
    unsigned char* ws = a.ws;
    const unsigned char* QA = ws + WS_QA; const unsigned char* KA = ws + WS_KA; const unsigned char* VT = ws + WS_VA;
    bf16_t* CAT = (bf16_t*)(ws + WS_CAT); float* LSE = (float*)(ws + WS_BA);
    unsigned* ctr = (unsigned*)(ws + WS_CTL) + 8192 + 64 * l + 1024 * rep;
    const int natt = 2048 + (l < DEPTH - 1 ? 8 : 0);
    constexpr int CONV_ROWS = 64, NCONV = 2 * NEXP / CONV_ROWS;
    const int nunits = natt + (l + 1 < DEPTH ? NCONV : 0);
    float braw;
    { const int ln = threadIdx.x & 63; float mq = fmaxf(fabsf(a.in[I_QNW][l * 128 + ln]), fabsf(a.in[I_QNW][l * 128 + 64 + ln])), mk = fmaxf(fabsf(a.in[I_KNW][l * 128 + ln]), fabsf(a.in[I_KNW][l * 128 + 64 + ln]));
      mq = wave_max(mq); mk = wave_max(mk);
      braw = __builtin_bit_cast(float, __builtin_amdgcn_readfirstlane(__builtin_bit_cast(int, 128.f * mq * mk))); }
    if (threadIdx.x == 0) MISC[12] = __hip_atomic_fetch_add(ctr, 1u, __ATOMIC_RELAXED, __HIP_MEMORY_SCOPE_AGENT);
    __syncthreads();
    int u = (int)MISC[12], par = 0;
    for (; u < nunits; ) {
        if (threadIdx.x == 0) MISC[13 - par] = __hip_atomic_fetch_add(ctr, 1u, __ATOMIC_RELAXED, __HIP_MEMORY_SCOPE_AGENT);
        if (u >= natt) {
            const int tq_ = fresh_tid();
            const int rwb = (u - natt) * CONV_ROWS + __builtin_amdgcn_readfirstlane(tq_ >> 6) * 8;
            convert_tables(a.in[I_U], a.in[I_V], ws, l + 1, rwb, 1, tq_ & 63, rwb + 8);
            __syncthreads();
            u = (int)MISC[13 - par]; par ^= 1;
            continue;
        }
        size_t r0, kv0; int h, kvh, seq, ldo; bf16_t* ob; float* lse;
        if (u < 2048) { const int qb = u & 63, g = (u >> 6) & 1, part = (u >> 7) & 3, b = u >> 10; kvh = (u >> 9) & 1; h = kvh * 2 + g;
            const int t0 = (part >> 1) * 130 + (part & 1) * 64;
            r0 = (size_t)b * T + (size_t)qb * 256; kv0 = (size_t)b * KVLEN + (size_t)t0 * 64; seq = ((part & 1) ? 66 : 64) * 64;
            ob = part ? (bf16_t*)(ws + (part == 1 ? WS_DQ : part == 2 ? WS_DK : WS_DV)) + r0 * 512 + h * 128 : CAT + r0 * 1024 + h * 128; ldo = part ? 512 : 1024; lse = LSE + ((size_t)part * ML + r0) * 4 + h; }
        else { const int b = (u - 2048) >> 2; h = (u - 2048) & 3; kvh = h >> 1; r0 = (size_t)ML + (size_t)b * CT; kv0 = (size_t)b * KVLEN + T; seq = CT;
            ob = CAT + r0 * 1024 + h * 128; ldo = 1024; lse = nullptr; }
        att::attn_dense_body(QA + r0 * 512 + h * 128, KA + kv0 * 256 + kvh * 128, VT + ((size_t)((kv0 / KVLEN) * 2 + kvh) * (KVLEN / 64) + (kv0 % KVLEN) / 64) * 8192, ob, ldo, seq, (char*)lds_raw, lse, braw);
        u = (int)MISC[13 - par]; par ^= 1;
    }
#undef a
}

__device__ __forceinline__ int tokperm(int q, int hh, int jj) { return 16 * q + 8 * (jj >> 2) + 4 * hh + (jj & 3); }
__device__ __forceinline__ int crow16(int r, int hi) { return (r & 3) + 8 * (r >> 2) + 4 * hi; }
__device__ __forceinline__ int kperm16(int s_, int g, int jj) { return 32 * s_ + 16 * (jj >> 2) + 4 * g + (jj & 3); }
__device__ __forceinline__ int frag_off(int i, int j) {
    return (((i >> 4) * 2 + (j >> 5)) * 64 + ((i & 15) + 16 * ((j >> 2) & 3))) * 16 + (4 * ((j >> 4) & 1) + (j & 3)) * 2;
}
template <int MODE>
__device__ __forceinline__ void phase_dn_chunkprep(int l, LAS unsigned char* lds) {
    const KArgs ap = get_args();
#define a (*ap)
    const int tid = fresh_tid(), lane = tid & 63, wave = __builtin_amdgcn_readfirstlane(tid >> 6), G = fresh_g(), bx = fresh_bx();
    unsigned char* ws = a.ws;
    constexpr int KT_OFF = 0, QT_OFF = 17408, VT_OFF = 34816, GS_OFF = 52224, RS_OFF = 68864, AM_OFF = 85504, SC_OFF = 120320, IMG_OFF = 0;
    const int r = lane & 31, hh = lane >> 5;
    const bf16_t* DQ = (const bf16_t*)(ws + WS_DQ); const bf16_t* DK = (const bf16_t*)(ws + WS_DK); const bf16_t* DV = (const bf16_t*)(ws + WS_DV);
    const float* BA = (const float*)(ws + WS_BA);
    constexpr int NTASK = MODE ? NB * 4 * 4 : NB * 4 * (NCH - 4);
#define CP_TASKID(t_) (MODE ? ((t_) >> 2) * NCH + ((t_) & 3) : ((t_) >> 8) * NCH + 4 + ((t_) & 255))
    LAS float* gsc = (LAS float*)(lds + SC_OFF);
    LAS float* bsc = gsc + 128;
    LAS float* gcs = gsc + 256;
    constexpr int CW_OFF = 121856, DI_OFF = CW_OFF + 5 * 1536 * 4;
    static_assert(DI_OFF + 8192 <= LDS_MISC, "chunkprep LDS");
    LAS float* cwl = (LAS float*)(lds + CW_OFF);
    for (int i = tid; i < 5 * 1536; i += 512) cwl[i] = a.in[I_CONVW][(size_t)l * 5 * 1536 + i];
    __syncthreads();
    const bf16_t* P = (const bf16_t*)(ws + WS_P);
    u32x4 xin[3][5][2];
#define CP_LOADX(task_) do { const int cidx_ = (task_) % NCH, bh_ = (task_) / NCH, b_ = bh_ >> 2, h_ = bh_ & 3; \
        const int row0_ = cidx_ < 4 ? ML + b_ * CT + cidx_ * 64 : b_ * T + (cidx_ - 4) * 64, tt_ = (cidx_ < 4 ? cidx_ * 64 : (cidx_ - 4) * 64) + (tid >> 3), tlen_ = cidx_ < 4 ? CT : T; \
        _Pragma("unroll") for (int j = 0; j < 5; ++j) { const int t2 = tt_ + j - 2; const bool ok = t2 >= 0 && t2 < tlen_; \
            const bf16_t* xr = P + (size_t)(row0_ + (tid >> 3) + (ok ? j - 2 : 0)) * NP + 1024 + h_ * 128 + (tid & 7) * 16; \
            _Pragma("unroll") for (int m = 0; m < 3; ++m) { const u32x4 w0 = *(const u32x4*)(xr + m * 512), w1 = *(const u32x4*)(xr + m * 512 + 8); \
                xin[m][j][0] = ok ? w0 : (u32x4){0u, 0u, 0u, 0u}; xin[m][j][1] = ok ? w1 : (u32x4){0u, 0u, 0u, 0u}; } } } while (0)
    if (bx < NTASK) CP_LOADX(CP_TASKID(bx));
    for (int tk = bx; tk < NTASK; tk += G) {
        const int task = CP_TASKID(tk);
        const int cidx = task % NCH, bh = task / NCH, b = bh >> 2, h = bh & 3;
        const int row0 = cidx < 4 ? ML + b * CT + cidx * 64 : b * T + (cidx - 4) * 64;
        unsigned char* rec = ws + WS_REC + (size_t)task * REC_BYTES;
        {
            const int rr = tid >> 3, seg = tid & 7;
            if (tid < 128) { const int d = tid >> 6, i = tid & 63, dh = d * 4 + h;
                const float xb = BA[(size_t)(row0 + i) * 16 + dh], z = BA[(size_t)(row0 + i) * 16 + 8 + dh] + a.in[I_DTB][l * 8 + dh];
                bsc[tid] = 1.f / (1.f + __expf(-xb)); gsc[tid] = -__expf(a.in[I_ALOG][l * 8 + dh]) * (fmaxf(z, 0.f) + log1pf(__expf(-fabsf(z)))); }
#pragma unroll
            for (int m = 0; m < 3; ++m) {
                float y[16];
#pragma unroll
                for (int c = 0; c < 16; ++c) y[c] = 0.f;
#pragma unroll
                for (int j = 0; j < 5; ++j) { const LAS float* wp = cwl + j * 1536 + m * 512 + h * 128 + seg * 16;
#pragma unroll
                    for (int q4 = 0; q4 < 4; ++q4) { const f32x4 wv = *(const LAS f32x4*)(wp + 4 * q4); const unsigned u0 = xin[m][j][q4 >> 1][2 * (q4 & 1)], u1 = xin[m][j][q4 >> 1][2 * (q4 & 1) + 1];
                        y[4 * q4 + 0] = fmaf(bflo(u0), wv[0], y[4 * q4 + 0]); y[4 * q4 + 1] = fmaf(bfhi(u0), wv[1], y[4 * q4 + 1]); y[4 * q4 + 2] = fmaf(bflo(u1), wv[2], y[4 * q4 + 2]); y[4 * q4 + 3] = fmaf(bfhi(u1), wv[3], y[4 * q4 + 3]); } }
                float ss = 0.f;
#pragma unroll
                for (int c = 0; c < 16; ++c) { y[c] = silu_f(y[c]); ss = fmaf(y[c], y[c], ss); }
                if (m < 2) { ss += lane_xor<1>(ss); ss += lane_xor<2>(ss); ss += lane_xor<4>(ss);
                    float sc = rsqrtf(ss + EPS); if (m == 0) sc *= 0.088388347648318440f;
#pragma unroll
                    for (int c = 0; c < 16; ++c) y[c] *= sc; }
                u32x4 o0, o1; o0.x = pkbf(y[0], y[1]); o0.y = pkbf(y[2], y[3]); o0.z = pkbf(y[4], y[5]); o0.w = pkbf(y[6], y[7]); o1.x = pkbf(y[8], y[9]); o1.y = pkbf(y[10], y[11]); o1.z = pkbf(y[12], y[13]); o1.w = pkbf(y[14], y[15]);
                LAS unsigned char* dst = lds + (m == 0 ? QT_OFF : m == 1 ? KT_OFF : VT_OFF) + rr * 272 + seg * 32;
                *(LAS u32x4*)dst = o0; *(LAS u32x4*)(dst + 16) = o1;
            }
        }
        __syncthreads();
        {
            const int mat = wave >> 2, ti = (wave >> 1) & 1, tj = wave & 1;
            f32x16 acc = {};
#pragma unroll
            for (int ks = 0; ks < 8; ++ks) {
                const bf16x8 av = *(const LAS bf16x8*)(lds + (mat ? QT_OFF : KT_OFF) + (32 * ti + r) * 272 + (16 * ks + 8 * hh) * 2);
                const bf16x8 bv = *(const LAS bf16x8*)(lds + KT_OFF + (32 * tj + r) * 272 + (16 * ks + 8 * hh) * 2);
                acc = __builtin_amdgcn_mfma_f32_32x32x16_bf16(av, bv, acc, 0, 0, 0);
            }
            LAS float* dst = (LAS float*)(lds + (mat ? RS_OFF : GS_OFF));
#pragma unroll
            for (int i = 0; i < 16; ++i) dst[(32 * ti + crow16(i, hh)) * 65 + 32 * tj + r] = acc[i];
        }
        { const int r16 = lane & 15, g4 = lane >> 4;
#pragma unroll
        for (int t = 0; t < 2; ++t) { const int f = wave * 2 + t, mt = f >> 2, sk = f & 3;
            { const u32x2 lo = *(const LAS u32x2*)(lds + KT_OFF + (16 * mt + r16) * 272 + (32 * sk + 4 * g4) * 2), hi2 = *(const LAS u32x2*)(lds + KT_OFF + (16 * mt + r16) * 272 + (32 * sk + 16 + 4 * g4) * 2);
              *(u32x4*)(rec + REC_K + f * 1024 + lane * 16) = (u32x4){lo.x, lo.y, hi2.x, hi2.y}; }
            { const u32x2 lo = *(const LAS u32x2*)(lds + QT_OFF + (16 * mt + r16) * 272 + (32 * sk + 4 * g4) * 2), hi2 = *(const LAS u32x2*)(lds + QT_OFF + (16 * mt + r16) * 272 + (32 * sk + 16 + 4 * g4) * 2);
              *(u32x4*)(rec + REC_Q + f * 1024 + lane * 16) = (u32x4){lo.x, lo.y, hi2.x, hi2.y}; } }
#pragma unroll
        for (int t = 0; t < 2; ++t) { const int f = wave * 2 + t, mt = f >> 1, sk = f & 1;
            unsigned e[8];
#pragma unroll
            for (int jj = 0; jj < 8; ++jj) e[jj] = *(const LAS unsigned short*)(lds + KT_OFF + kperm16(sk, g4, jj) * 272 + (16 * mt + r16) * 2);
            *(u32x4*)(rec + REC_KT + f * 1024 + lane * 16) = (u32x4){e[0] | (e[1] << 16), e[2] | (e[3] << 16), e[4] | (e[5] << 16), e[6] | (e[7] << 16)}; }
        { const int sl = wave;
            unsigned e[16];
#pragma unroll
            for (int i = 0; i < 16; ++i) e[i] = *(const LAS unsigned short*)(lds + VT_OFF + (16 * (i >> 2) + 4 * g4 + (i & 3)) * 272 + (16 * sl + r16) * 2);
            u32x4* vp = (u32x4*)(rec + REC_V + sl * 2048 + lane * 32);
            vp[0] = (u32x4){e[0] | (e[1] << 16), e[2] | (e[3] << 16), e[4] | (e[5] << 16), e[6] | (e[7] << 16)};
            vp[1] = (u32x4){e[8] | (e[9] << 16), e[10] | (e[11] << 16), e[12] | (e[13] << 16), e[14] | (e[15] << 16)}; }
        }
        if (wave < 2) { const int d = wave; float gv = gsc[d * 64 + (d ? 63 - lane : lane)];
            gv += __builtin_bit_cast(float, __builtin_amdgcn_update_dpp(0, __builtin_bit_cast(int, gv), 0x111, 0xF, 0xF, true));
            gv += __builtin_bit_cast(float, __builtin_amdgcn_update_dpp(0, __builtin_bit_cast(int, gv), 0x112, 0xF, 0xF, true));
            gv += __builtin_bit_cast(float, __builtin_amdgcn_update_dpp(0, __builtin_bit_cast(int, gv), 0x114, 0xF, 0xF, true));
            gv += __builtin_bit_cast(float, __builtin_amdgcn_update_dpp(0, __builtin_bit_cast(int, gv), 0x118, 0xF, 0xF, true));
            { const float t0 = __builtin_bit_cast(float, __builtin_amdgcn_readlane(__builtin_bit_cast(int, gv), 15)), t1 = __builtin_bit_cast(float, __builtin_amdgcn_readlane(__builtin_bit_cast(int, gv), 31)), t2 = __builtin_bit_cast(float, __builtin_amdgcn_readlane(__builtin_bit_cast(int, gv), 47));
              const int rw_ = lane >> 4; gv += (rw_ >= 1 ? t0 : 0.f) + (rw_ >= 2 ? t1 : 0.f) + (rw_ >= 3 ? t2 : 0.f); }
            gcs[d * 64 + lane] = gv; }
        __syncthreads();
        const LAS float* Gs = (const LAS float*)(lds + GS_OFF); const LAS float* Rs = (const LAS float*)(lds + RS_OFF);
#pragma unroll 4
        for (int t = 0; t < 16; ++t) { const int e = tid + 512 * t, d = e >> 12, jp = (e >> 6) & 63, ip = e & 63;
            const int in_ = d ? 63 - ip : ip, jn = d ? 63 - jp : jp;
            const float dec = __expf(fminf(gcs[d * 64 + ip] - gcs[d * 64 + jp], 0.f));
            const float av = (jp < ip) ? bsc[d * 64 + in_] * Gs[in_ * 65 + jn] * dec : 0.f;
            ((LAS float*)(lds + AM_OFF))[d * 4352 + jp * 68 + ip] = av;
            const float qk = (jp <= ip) ? Rs[in_ * 65 + jn] * dec : 0.f;
            *(LAS unsigned short*)(lds + IMG_OFF + d * 16384 + 8192 + frag_off(in_, jn)) = (unsigned short)(pkbf(qk, 0.f) & 0xffffu); }
        __syncthreads();
        { int ln_ = lane; asm volatile("" : "+v"(ln_));
          const int d = wave >> 2, nt = wave & 3, n16 = ln_ & 15, g4 = ln_ >> 4;
          const LAS float* At = (const LAS float*)(lds + AM_OFF) + d * 4352;
          LAS float* Xd = (LAS float*)(lds + GS_OFF) + d * 4096;
          LAS float* Dinv = (LAS float*)(lds + DI_OFF) + d * 1024;
          { float x[16];
#pragma unroll
            for (int q = 0; q < 16; ++q) x[q] = (q == n16) ? 1.f : 0.f;
#pragma unroll
            for (int r2 = 0; r2 < 15; ++r2) { const LAS float* ar = At + (16 * nt + r2) * 68 + 16 * nt; const float xr = x[r2];
#pragma unroll
                for (int q4 = (r2 + 1) / 4; q4 < 4; ++q4) { const f32x4 a4 = *(const LAS f32x4*)(ar + 4 * q4);
#pragma unroll
                    for (int q = 0; q < 4; ++q) if (4 * q4 + q > r2) x[4 * q4 + q] = fmaf(-a4[q], xr, x[4 * q4 + q]); } }
            if (ln_ < 16) {
#pragma unroll
                for (int q = 0; q < 16; ++q) Dinv[nt * 256 + q * 16 + n16] = x[q]; } }
          if (wave == 2 || wave == 3) { const int d2 = wave - 2, ip = d2 ? 63 - lane : lane; const float gl = gcs[d2 * 64 + 63], gi = gcs[d2 * 64 + ip];
            float* sc = (float*)(rec + REC_DIR + d2 * REC_DIRSZ + 16384);
            sc[lane] = __expf(gi); sc[64 + lane] = __expf(gl - gi); if (lane == 0) sc[128] = __expf(gl); }
          __syncthreads();
          const int c = 16 * nt + n16, jn = d ? 63 - c : c; const float bj = bsc[d * 64 + jn];
          const int fj = (jn >> 5) * 1024 + ((jn >> 2) & 3) * 256 + ((jn >> 4) & 1) * 8 + (jn & 3) * 2;
#pragma unroll 1
          for (int B = 0; B < 4; ++B) {
            f32x4 y = {0.f, 0.f, 0.f, 0.f};
            if (nt <= B) {
                f32x4 acc;
#pragma unroll
                for (int r2 = 0; r2 < 4; ++r2) acc[r2] = (nt == B && 4 * g4 + r2 == n16) ? 1.f : 0.f;
#pragma unroll 2
                for (int j0 = 0; j0 < 16 * B; j0 += 4) { const float av = -At[(j0 + g4) * 68 + 16 * B + n16], bv = Xd[(j0 + g4) * 64 + c];
                    acc = __builtin_amdgcn_mfma_f32_16x16x4f32(av, bv, acc, 0, 0, 0); }
#pragma unroll
                for (int r2 = 0; r2 < 4; ++r2) Xd[(16 * B + 4 * g4 + r2) * 64 + c] = acc[r2];
#pragma unroll
                for (int s4 = 0; s4 < 4; ++s4) { const float av = Dinv[B * 256 + n16 * 16 + 4 * s4 + g4], bv = Xd[(16 * B + 4 * s4 + g4) * 64 + c];
                    y = __builtin_amdgcn_mfma_f32_16x16x4f32(av, bv, y, 0, 0, 0); }
            }
#pragma unroll
            for (int r2 = 0; r2 < 4; ++r2) { const int i = 16 * B + 4 * g4 + r2, in_ = d ? 63 - i : i; Xd[i * 64 + c] = y[r2];
                *(LAS unsigned short*)(lds + IMG_OFF + d * 16384 + (in_ >> 4) * 2048 + (in_ & 15) * 16 + fj) = (unsigned short)(pkbf_c(y[r2] * bj, 0.f) & 0xffffu); }
            __syncthreads();
          }
        }
        if (tk + G < NTASK) CP_LOADX(CP_TASKID(tk + G));
#pragma unroll
        for (int t = 0; t < 4; ++t) { const int p = tid + 512 * t, d = p >> 10, off = (p & 1023) * 16;
            *(u32x4*)(rec + REC_DIR + d * REC_DIRSZ + off) = *(const LAS u32x4*)(lds + IMG_OFF + d * 16384 + off); }
        __syncthreads();
    }
#undef CP_LOADX
#undef CP_TASKID
#undef a
}

__device__ __forceinline__ bf16x8 pack44(const f32x4& lo, const f32x4& hi) {
    u32x4 p; p.x = pkbf_c(lo[0], lo[1]); p.y = pkbf_c(lo[2], lo[3]); p.z = pkbf_c(hi[0], hi[1]); p.w = pkbf_c(hi[2], hi[3]);
    return __builtin_bit_cast(bf16x8, p);
}
template <int VAR>
__device__ __forceinline__ void phase_dn_scan(int l, LAS unsigned char* lds) {
    const KArgs ap = get_args();
#define a (*ap)
    const int tid = fresh_tid(), lane = tid & 63, wave = __builtin_amdgcn_readfirstlane(tid >> 6), bx = fresh_bx();
    unsigned char* ws = a.ws;
    if (bx >= 32) return;
    const int chain = bx >> 1, half = bx & 1, b = chain >> 3, h = (chain >> 1) & 3, dir = chain & 1;
    const unsigned char* recb = ws + WS_REC + (size_t)((b * 4 + h) * NCH) * REC_BYTES;
    constexpr int BUFSZ = 74752;
#define CIDX(n) (dir ? ((n) < 4 ? 3 - (n) : 263 - (n)) : (n))
    if (wave >= 4) {
        const int sw = wave - 4;
#define DN_PIECE(i_) ((sw + 4 * (i_)) < 73 ? (sw + 4 * (i_)) : 72)
#define DN_SRC(rec_, p_) ((p_) < 48 ? (rec_) + (p_) * 1024 : (p_) < 65 ? (rec_) + REC_DIR + dir * REC_DIRSZ + ((p_) - 48) * 1024 : (rec_) + REC_V + half * 8192 + ((p_) - 65) * 1024)
#define DN_STAGE(n, bi) do { const unsigned char* rec_ = recb + (size_t)CIDX(n) * REC_BYTES; _Pragma("unroll") for (int i_ = 0; i_ < 19; ++i_) { const int p_ = DN_PIECE(i_); \
        __builtin_amdgcn_global_load_lds((const unsigned*)(DN_SRC(rec_, p_) + lane * 16), (LAS unsigned*)(lds + (bi) * BUFSZ + p_ * 1024), 16, 0, 0); } } while (0)
#define DN_SYNC() do { asm volatile("s_waitcnt vmcnt(0)" ::: "memory"); __builtin_amdgcn_s_barrier(); asm volatile("" ::: "memory"); } while (0)
        if (VAR != 3) DN_STAGE(0, 0);
        DN_SYNC();
        for (int n = 0; n < NCH; ++n) {
            if (VAR != 3 && n + 1 < NCH) DN_STAGE(n + 1, (n + 1) & 1);
            DN_SYNC();
        }
#undef DN_STAGE
#undef DN_PIECE
#undef DN_SRC
#undef DN_SYNC
    } else {
        const int sl = half * 4 + wave, c16 = lane & 15, g4 = lane >> 4;
        float* Og = (float*)(ws + (dir ? WS_OB : WS_OF)) + h * 128 + sl * 16 + c16;
        f32x4 S[8];
#pragma unroll
        for (int i = 0; i < 8; ++i) S[i] = (f32x4){0.f, 0.f, 0.f, 0.f};
        asm volatile("s_waitcnt lgkmcnt(0)" ::: "memory"); __builtin_amdgcn_s_barrier(); asm volatile("" ::: "memory");
        for (int n = 0; n < NCH; ++n) {
            if (VAR == 2) { asm volatile("s_waitcnt lgkmcnt(0)" ::: "memory"); __builtin_amdgcn_s_barrier(); asm volatile("" ::: "memory"); continue; }
            const LAS unsigned char* buf = lds + (n & 1) * BUFSZ;
            const int cidx = CIDX(n);
            const u32x4 vc0 = *(const LAS u32x4*)(buf + 66560 + wave * 2048 + lane * 32), vc1 = *(const LAS u32x4*)(buf + 66560 + wave * 2048 + lane * 32 + 16);
#define FR(off, f) (*(const LAS bf16x8*)(buf + (off) + (f) * 1024 + lane * 16))
#define MF(A, B, C) __builtin_amdgcn_mfma_f32_16x16x32_bf16((A), (B), (C), 0, 0, 0)
#define SB_() __builtin_amdgcn_sched_barrier(0)
            bf16x8 fa[8], fb[8];
            f32x4 eg[4], dl[4];
#pragma unroll
            for (int mt = 0; mt < 4; ++mt) { eg[mt] = *(const LAS f32x4*)(buf + 65536 + (16 * mt + 4 * g4) * 4); dl[mt] = *(const LAS f32x4*)(buf + 65536 + 256 + (16 * mt + 4 * g4) * 4); }
            const float egl = *(const LAS float*)(buf + 65536 + 512);
#define RD_KQ(dst, q) do { _Pragma("unroll") for (int mt = 0; mt < 4; ++mt) { dst[mt] = FR(0, mt * 4 + (q)); dst[4 + mt] = FR(32768, mt * 4 + (q)); } } while (0)
#define MM_KQ(src, q) do { _Pragma("unroll") for (int mt = 0; mt < 4; ++mt) { X[mt] = MF(src[mt], Sb[q], X[mt]); O[mt] = MF(src[4 + mt], Sb[q], O[mt]); } } while (0)
            f32x4 X[4], O[4], VN[4];
#pragma unroll
            for (int i = 0; i < 4; ++i) { X[i] = (f32x4){0.f, 0.f, 0.f, 0.f}; O[i] = (f32x4){0.f, 0.f, 0.f, 0.f}; VN[i] = (f32x4){0.f, 0.f, 0.f, 0.f}; }
            bf16x8 Sb[4];
#pragma unroll
            for (int q = 0; q < 4; ++q) Sb[q] = pack44(S[2 * q], S[2 * q + 1]);
            RD_KQ(fa, 0); SB_();
            RD_KQ(fb, 1); SB_(); MM_KQ(fa, 0); SB_();
            RD_KQ(fa, 2); SB_(); MM_KQ(fb, 1); SB_();
            RD_KQ(fb, 3); SB_(); MM_KQ(fa, 2); SB_();
#pragma unroll
            for (int i = 0; i < 8; ++i) fa[i] = FR(49152, i);
            SB_(); MM_KQ(fb, 3); SB_();
#pragma unroll
            for (int mt = 0; mt < 4; ++mt) { const unsigned w0 = (mt < 2 ? vc0 : vc1)[2 * (mt & 1)], w1 = (mt < 2 ? vc0 : vc1)[2 * (mt & 1) + 1];
                X[mt][0] = bflo(w0) - eg[mt][0] * X[mt][0]; X[mt][1] = bfhi(w0) - eg[mt][1] * X[mt][1]; X[mt][2] = bflo(w1) - eg[mt][2] * X[mt][2]; X[mt][3] = bfhi(w1) - eg[mt][3] * X[mt][3]; }
            const bf16x8 Yb0 = pack44(X[0], X[1]), Yb1 = pack44(X[2], X[3]);
            SB_();
#pragma unroll
            for (int i = 0; i < 8; ++i) fb[i] = FR(57344, i);
            SB_();
#pragma unroll
            for (int mt = 0; mt < 4; ++mt) { VN[mt] = MF(fa[mt * 2], Yb0, VN[mt]); VN[mt] = MF(fa[mt * 2 + 1], Yb1, VN[mt]); }
            SB_();
#pragma unroll
            for (int mt = 0; mt < 4; ++mt) O[mt] = O[mt] * eg[mt];
            const bf16x8 Vb0 = pack44(VN[0], VN[1]), Vb1 = pack44(VN[2], VN[3]);
            SB_();
#pragma unroll
            for (int i = 0; i < 8; ++i) fa[i] = FR(16384, i);
            SB_();
#pragma unroll
            for (int mt = 0; mt < 4; ++mt) { O[mt] = MF(fb[mt * 2], Vb0, O[mt]); O[mt] = MF(fb[mt * 2 + 1], Vb1, O[mt]); }
            SB_();
#pragma unroll
            for (int mt = 0; mt < 4; ++mt) VN[mt] = VN[mt] * dl[mt];
            const bf16x8 Vd0 = pack44(VN[0], VN[1]), Vd1 = pack44(VN[2], VN[3]);
#pragma unroll
            for (int i = 0; i < 8; ++i) S[i] = S[i] * egl;
            SB_();
#pragma unroll
            for (int i = 0; i < 8; ++i) fb[i] = FR(16384, 8 + i);
            SB_();
#pragma unroll
            for (int i = 0; i < 4; ++i) { S[i] = MF(fa[i * 2], Vd0, S[i]); S[i] = MF(fa[i * 2 + 1], Vd1, S[i]); }
            SB_();
#pragma unroll
            for (int i = 0; i < 4; ++i) { S[4 + i] = MF(fb[i * 2], Vd0, S[4 + i]); S[4 + i] = MF(fb[i * 2 + 1], Vd1, S[4 + i]); }
            SB_();
            {
                const int row0 = cidx < 4 ? ML + b * CT + cidx * 64 : b * T + (cidx - 4) * 64;
                float* op = Og + (size_t)(row0 + 4 * g4) * 512;
#pragma unroll
                for (int mt = 0; mt < 4; ++mt)
#pragma unroll
                    for (int t = 0; t < 4; ++t) { if (VAR != 1) op[(size_t)(16 * mt + t) * 512] = O[mt][t]; else asm volatile("" :: "v"(O[mt][t])); }
            }
#undef RD_KQ
#undef MM_KQ
#undef SB_
#undef FR
#undef MF
            asm volatile("s_waitcnt lgkmcnt(0)" ::: "memory"); __builtin_amdgcn_s_barrier(); asm volatile("" ::: "memory");
        }
    }
#undef CIDX
#undef a
}

__device__ __forceinline__ void phase_dn_out(int l) {
    const KArgs ap = get_args();
#define a (*ap)

    const int tid = fresh_tid(), lane = tid & 63, wave = __builtin_amdgcn_readfirstlane(tid >> 6), G = fresh_g(), bx = fresh_bx();
    unsigned char* ws = a.ws;
    const int nrows = (l == DEPTH - 1) ? ML : M;
    const float* OF = (const float*)(ws + WS_OF); const float* OB = (const float*)(ws + WS_OB);
    const bf16_t* P = (const bf16_t*)(ws + WS_P); bf16_t* CAT = (bf16_t*)(ws + WS_CAT);
    const f32x2 nw = *(const f32x2*)(a.in[I_DNW] + l * 128 + 2 * lane);
    const float* LSE = (const float*)(ws + WS_BA);
    for (int row = wave * G + bx; row < nrows; row += G * 8) {
        f32x2 of[4], ob[4]; unsigned gw[4];
#pragma unroll
        for (int hh = 0; hh < 4; ++hh) { of[hh] = *(const f32x2*)(OF + (size_t)row * 512 + hh * 128 + 2 * lane); ob[hh] = *(const f32x2*)(OB + (size_t)row * 512 + hh * 128 + 2 * lane);
            gw[hh] = *(const unsigned*)(P + (size_t)row * NP + 2560 + hh * 128 + 2 * lane); }
        u32x4 ap_[4]; float ls_[4];
#pragma unroll
        for (int p = 0; p < 4; ++p) { ap_[p] = (u32x4){0u, 0u, 0u, 0u}; ls_[p] = 0.f; }
        if (row < ML) {
            ap_[0] = *(const u32x4*)(CAT + (size_t)row * 1024 + 8 * lane); ap_[1] = *(const u32x4*)((const bf16_t*)(ws + WS_DQ) + (size_t)row * 512 + 8 * lane);
            ap_[2] = *(const u32x4*)((const bf16_t*)(ws + WS_DK) + (size_t)row * 512 + 8 * lane); ap_[3] = *(const u32x4*)((const bf16_t*)(ws + WS_DV) + (size_t)row * 512 + 8 * lane);
#pragma unroll
            for (int p = 0; p < 4; ++p) ls_[p] = LSE[((size_t)p * ML + row) * 4 + (lane >> 4)]; }
        float o0[4], o1[4], ssq[4];
#pragma unroll
        for (int hh = 0; hh < 4; ++hh) { o0[hh] = of[hh][0] + ob[hh][0]; o1[hh] = of[hh][1] + ob[hh][1]; ssq[hh] = o0[hh] * o0[hh] + o1[hh] * o1[hh]; }
#pragma unroll
        for (int hh = 0; hh < 4; ++hh) ssq[hh] = wave_sum(ssq[hh]);
        float mxv = 0.f;
#pragma unroll
        for (int hh = 0; hh < 4; ++hh) { const float rs = rsqrtf(ssq[hh] * (1.f / 128.f) + EPS); const float g0 = bflo(gw[hh]), g1 = bfhi(gw[hh]);
            o0[hh] = o0[hh] * rs * nw[0] * silu_f(g0); o1[hh] = o1[hh] * rs * nw[1] * silu_f(g1); mxv = fmaxf(mxv, fmaxf(fabsf(o0[hh]), fabsf(o1[hh]))); }
        float av[8];
        if (row < ML) { const float mx = fmaxf(fmaxf(ls_[0], ls_[1]), fmaxf(ls_[2], ls_[3]));
            float w_[4], wsum = 0.f;
#pragma unroll
            for (int p = 0; p < 4; ++p) { w_[p] = __expf(ls_[p] - mx); wsum += w_[p]; }
            const float inv = 1.f / wsum;
#pragma unroll
            for (int i = 0; i < 4; ++i) { float lo = 0.f, hi2 = 0.f;
#pragma unroll
                for (int p = 0; p < 4; ++p) { lo = fmaf(w_[p], bflo(ap_[p][i]), lo); hi2 = fmaf(w_[p], bfhi(ap_[p][i]), hi2); }
                av[2 * i] = lo * inv; av[2 * i + 1] = hi2 * inv; } }
        else { const u32x4 cw_ = *(const u32x4*)(CAT + (size_t)row * 1024 + 8 * lane);
#pragma unroll
            for (int i = 0; i < 4; ++i) { av[2 * i] = bflo(cw_[i]); av[2 * i + 1] = bfhi(cw_[i]); } }
#pragma unroll
        for (int i = 0; i < 8; ++i) mxv = fmaxf(mxv, fabsf(av[i]));
        mxv = fmaxf(wave_max(mxv), 1e-30f);
        const float cinv = 127.f / mxv;
        signed char* crow = (signed char*)(ws + WS_CATQ) + (size_t)row * 1024;
#define Q8_(x) ((unsigned)(int)rintf((x) * cinv) & 255u)
        { u32x2 o; o.x = Q8_(av[0]) | (Q8_(av[1]) << 8) | (Q8_(av[2]) << 16) | (Q8_(av[3]) << 24); o.y = Q8_(av[4]) | (Q8_(av[5]) << 8) | (Q8_(av[6]) << 16) | (Q8_(av[7]) << 24); *(u32x2*)(crow + 8 * lane) = o; }
#pragma unroll
        for (int hh = 0; hh < 4; ++hh) *(unsigned short*)(crow + 512 + hh * 128 + 2 * lane) = (unsigned short)(Q8_(o0[hh]) | (Q8_(o1[hh]) << 8));
#undef Q8_
        if (lane == 0) ((float*)(ws + WS_GB))[(1u << 18) + row] = mxv * (1.f / 127.f);
    }
#undef a
}

#define CE_DESC(a_, b_) do { const float hi_ = fmaxf(a_, b_), lo_ = fminf(a_, b_); a_ = hi_; b_ = lo_; } while (0)
__device__ __forceinline__ void bitonic_sort16_desc(float (&v)[16]) {
#pragma unroll
    for (int k = 2; k <= 16; k <<= 1)
#pragma unroll
        for (int j = k >> 1; j > 0; j >>= 1)
#pragma unroll
            for (int i = 0; i < 16; ++i) { const int p = i ^ j; if (p > i) { if ((i & k) == 0) CE_DESC(v[i], v[p]); else CE_DESC(v[p], v[i]); } }
}
__device__ __forceinline__ void merge_top16_desc(float (&lst)[16], const float (&nw)[16]) {
#pragma unroll
    for (int i = 0; i < 16; ++i) lst[i] = fmaxf(lst[i], nw[15 - i]);
#pragma unroll
    for (int j = 8; j > 0; j >>= 1)
#pragma unroll
        for (int i = 0; i < 16; ++i) { const int p = i ^ j; if (p > i) CE_DESC(lst[i], lst[p]); }
}
__device__ __forceinline__ void phase_peer_select(int l) {
    const KArgs ap = get_args();
#define a (*ap)
    const int tid = fresh_tid(), lane = tid & 63, wave = __builtin_amdgcn_readfirstlane(tid >> 6), G = fresh_g(), bx = fresh_bx();
    unsigned char* ws = a.ws;
    const int nrows = (l == DEPTH - 1) ? ML : M;
    const int ntask = (nrows / 32) * 4;
    const bf16_t* Q2 = (const bf16_t*)(ws + WS_P);
    const bf16_t* SKB = (const bf16_t*)(ws + WS_SKB) + (size_t)l * 8 * 2 * 128 * 128;
    int* PIDX = (int*)(ws + WS_PIDX); float* PGATE = (float*)(ws + WS_PGATE);
    const float NEG = -3.0e38f;
    const int r = lane & 31, hi = lane >> 5;
    for (int task = wave * G + bx; task < ntask; task += G * 8) {
        const int tg = task >> 2, hp = task & 3; const int row = tg * 32 + r;
        float mine0[16], mine1[16];
#pragma unroll
        for (int j = 0; j < 16; ++j) { mine0[j] = NEG; mine1[j] = NEG; }
        bf16x8 qA[8], kA[8];
        float lst[16];
#define SEL_QPTR(it_) (Q2 + (size_t)row * 2048 + (2 * hp + ((it_) >> 1)) * 256 + ((it_) & 1) * 128 + 8 * hi)
#define SEL_KPTR(it_, t_) (SKB + (size_t)(((2 * hp + ((it_) >> 1)) * 2 + ((it_) & 1)) * 128 + 32 * (t_) + r) * 128 + 8 * hi)
#define SEL_LDQ(dst, it_) do { const bf16_t* qp_ = SEL_QPTR(it_); _Pragma("unroll") for (int ks = 0; ks < 8; ++ks) dst[ks] = *(const bf16x8*)(qp_ + 16 * ks); } while (0)
#define SEL_LDK(dst, it_, t_) do { const bf16_t* kp_ = SEL_KPTR(it_, t_); _Pragma("unroll") for (int ks = 0; ks < 8; ++ks) dst[ks] = *(const bf16x8*)(kp_ + 16 * ks); } while (0)
#define SEL_RANK(qv, kv, t_) do { f32x16 acc = {}; _Pragma("unroll") for (int ks = 0; ks < 8; ++ks) acc = __builtin_amdgcn_mfma_f32_32x32x16_bf16(kv[ks], qv[ks], acc, 0, 0, 0); \
            const unsigned kb = (unsigned)(32 * (t_) + 4 * hi); float nw_[16]; \
            _Pragma("unroll") for (int i = 0; i < 16; ++i) nw_[i] = __uint_as_float((__float_as_uint(acc[i]) & 0xffffff80u) | (kb + (unsigned)((i & 3) + 8 * (i >> 2)))); \
            bitonic_sort16_desc(nw_); merge_top16_desc(lst, nw_); } while (0)
#define SB_() __builtin_amdgcn_sched_barrier(0)
#pragma unroll
        for (int j = 0; j < 16; ++j) lst[j] = NEG;
#pragma unroll 1
        for (int it = 0; it < 4; ++it) {
            SEL_LDQ(qA, it);
#pragma unroll 1
            for (int t = 0; t < 4; ++t) { SEL_LDK(kA, it, t); SEL_RANK(qA, kA, t); }
            float oth[16];
#pragma unroll
            for (int j = 0; j < 16; ++j) { auto rr = __builtin_amdgcn_permlane32_swap(__float_as_uint(lst[j]), __float_as_uint(lst[j]), false, false); oth[j] = __uint_as_float(hi ? rr[0] : rr[1]); }
            merge_top16_desc(lst, oth);
            const bool k0 = ((it >> 1) == hi) && ((it & 1) == 0), k1 = ((it >> 1) == hi) && ((it & 1) == 1);
#pragma unroll
            for (int j = 0; j < 16; ++j) { mine0[j] = k0 ? lst[j] : mine0[j]; mine1[j] = k1 ? lst[j] : mine1[j]; lst[j] = NEG; }
        }
#undef SB_
#undef SEL_QPTR
#undef SEL_KPTR
#undef SEL_LDQ
#undef SEL_LDK
#undef SEL_RANK
        const int h = 2 * hp + hi;
        float ts[16];
#pragma unroll
        for (int j = 0; j < 16; ++j) ts[j] = NEG;
#pragma unroll
        for (int i = 0; i < 16; ++i)
#pragma unroll
            for (int j = 0; j < 16; ++j) if ((i + 1) * (j + 1) <= 16) {
                const unsigned b0 = __float_as_uint(mine0[i]), b1 = __float_as_uint(mine1[j]);
                const float c = __uint_as_float(b0 & 0xffffff80u) + __uint_as_float(b1 & 0xffffff80u);
                float x = __uint_as_float((__float_as_uint(c) & 0xffffc000u) | ((b0 & 127u) << 7) | (b1 & 127u));
#pragma unroll
                for (int t = 0; t < 16; ++t) { const float hv = fmaxf(ts[t], x); x = fminf(ts[t], x); ts[t] = hv; }
            }
        int te[16]; float ex[16], sum = 0.f;
        const float tmax = __uint_as_float(__float_as_uint(ts[0]) & 0xffffc000u);
#pragma unroll
        for (int t = 0; t < 16; ++t) { const unsigned bt = __float_as_uint(ts[t]); te[t] = (int)(bt & 0x3fffu); ex[t] = __expf(__uint_as_float(bt & 0xffffc000u) - tmax); sum += ex[t]; }
        const float inv = 1.f / sum;
        int* ip = PIDX + (size_t)row * 128 + h * 16; float* gp = PGATE + (size_t)row * 128 + h * 16;
#pragma unroll
        for (int t = 0; t < 16; t += 4) { *(u32x4*)(ip + t) = (u32x4){(unsigned)te[t], (unsigned)te[t + 1], (unsigned)te[t + 2], (unsigned)te[t + 3]}; *(f32x4*)(gp + t) = (f32x4){ex[t] * inv, ex[t + 1] * inv, ex[t + 2] * inv, ex[t + 3] * inv}; }
    }
#undef a
}

template <bool WR, int GV = 0>
__device__ __forceinline__ void phase_peer_gather(int l, LAS unsigned char* lds) {
    const KArgs ap = get_args();
#define a (*ap)
    const int tid = fresh_tid(), lane = tid & 63, wave = __builtin_amdgcn_readfirstlane(tid >> 6), G = fresh_g(), bx = fresh_bx();
    unsigned char* ws = a.ws;
    const int nrows = (l == DEPTH - 1) ? ML : M;
    const unsigned char* UB = ws + WS_UB + (size_t)(l & 1) * TAB_SET; const unsigned char* VB = UB + 1024;
    const float* USC = (const float*)(ws + WS_USC) + (l & 1) * 2 * NEXP; const float* VSC = USC + NEXP;
    const int* PIDX = (const int*)(ws + WS_PIDX); const float* PGATE = (const float*)(ws + WS_PGATE);
    const float* modl = (const float*)(ws + WS_MOD) + (size_t)l * 3 * 6144 + 5120;
    const bool fuse = WR && (l + 1 < DEPTH);
    LAS float* wsk = (LAS float*)lds;
    if (fuse) { const float* src = (const float*)(ws + WS_WSK) + (size_t)(l + 1) * 16384; for (int i = tid; i < 16384 / 4; i += 512) ((LAS f32x4*)wsk)[i] = ((const f32x4*)src)[i]; __syncthreads(); }
    const float* nw1 = a.in[I_N1W] + (l + 1 < DEPTH ? l + 1 : l) * 1024 + 16 * lane;
    const float* modn = (const float*)(ws + WS_MOD) + (size_t)(l + 1 < DEPTH ? l + 1 : l) * 3 * 6144;
    for (int row = wave * G + bx; row < nrows; row += G * 8) {
        float hv[16], out[16];
        { const u32x4 hw = *(const u32x4*)((const signed char*)(ws + WS_H) + (size_t)row * D + 16 * lane); const float hsc = ((const float*)(ws + WS_GB))[row];
#pragma unroll
          for (int q = 0; q < 4; ++q) { const int w = (int)hw[q]; hv[4 * q + 0] = (float)((w << 24) >> 24) * hsc; hv[4 * q + 1] = (float)((w << 16) >> 24) * hsc; hv[4 * q + 2] = (float)((w << 8) >> 24) * hsc; hv[4 * q + 3] = (float)(w >> 24) * hsc; } }
        float hs = 0.f;
#pragma unroll
        for (int i = 0; i < 16; ++i) { out[i] = 0.f; hs += hv[i]; }
        const float hsum128 = 128.f * wave_sum(hs);
        float wacc = 0.f;
        const int id0 = PIDX[(size_t)row * 128 + lane], id1 = PIDX[(size_t)row * 128 + 64 + lane];
        const float gt0 = PGATE[(size_t)row * 128 + lane], gt1 = PGATE[(size_t)row * 128 + 64 + lane];
        const float us0 = USC[id0], us1 = USC[id1], vs0 = VSC[id0], vs1 = VSC[id1];
        for (int e0 = 0; e0 < 128; e0 += 8) {
            u32x4 uw[8], vw[8]; float gte[8], use[8], vse[8];
#pragma unroll
            for (int j = 0; j < 8; ++j) { const int e = e0 + j; const int id = __builtin_amdgcn_readlane(e0 < 64 ? id0 : id1, e & 63);
                gte[j] = __builtin_bit_cast(float, __builtin_amdgcn_readlane(__builtin_bit_cast(int, e0 < 64 ? gt0 : gt1), e & 63));
                use[j] = __builtin_bit_cast(float, __builtin_amdgcn_readlane(__builtin_bit_cast(int, e0 < 64 ? us0 : us1), e & 63));
                vse[j] = __builtin_bit_cast(float, __builtin_amdgcn_readlane(__builtin_bit_cast(int, e0 < 64 ? vs0 : vs1), e & 63));
                uw[j] = *(const u32x4*)(UB + (size_t)id * 2048 + 16 * lane); vw[j] = *(const u32x4*)(VB + (size_t)id * 2048 + 16 * lane); }
#pragma unroll
            for (int j = 0; j < 8; ++j) {
                float d0 = 0.f, d1 = 0.f;
#pragma unroll
                for (int q = 0; q < 4; ++q) { const unsigned w = uw[j][q];
                    d0 = fmaf((float)(w & 255u), hv[4 * q + 0], d0); d1 = fmaf((float)((w >> 8) & 255u), hv[4 * q + 1], d1);
                    d0 = fmaf((float)((w >> 16) & 255u), hv[4 * q + 2], d0); d1 = fmaf((float)(w >> 24), hv[4 * q + 3], d1); }
                const float dsum = (wave_sum(d0 + d1) - hsum128) * use[j];
                const float act = 0.5f * dsum * (1.f + erff(dsum * 0.70710678118654752f));
                const float wgt = gte[j] * act * vse[j];
                wacc += wgt;
                if (GV == 1) { asm volatile("" :: "v"(vw[j])); out[0] += wgt; } else
#pragma unroll
                for (int q = 0; q < 4; ++q) { const unsigned w = vw[j][q];
                    out[4 * q + 0] = fmaf(wgt, (float)(w & 255u), out[4 * q + 0]); out[4 * q + 1] = fmaf(wgt, (float)((w >> 8) & 255u), out[4 * q + 1]);
                    out[4 * q + 2] = fmaf(wgt, (float)((w >> 16) & 255u), out[4 * q + 2]); out[4 * q + 3] = fmaf(wgt, (float)(w >> 24), out[4 * q + 3]); }
            }
        }
        const float corr = 128.f * wacc;
        float* xr; int mrow;
        if (row < ML) { xr = a.out + (size_t)row * D; mrow = row >= T ? 1 : 0; } else { xr = (float*)(ws + WS_CTXX) + (size_t)(row - ML) * D; mrow = 2; }
        const float* g2 = modl + mrow * 6144 + 16 * lane;
        f32x4 xn[4];
#pragma unroll
        for (int i = 0; i < 4; ++i) { const f32x4 x = *(const f32x4*)(xr + 16 * lane + 4 * i), g = *(const f32x4*)(g2 + 4 * i);
            xn[i] = x + g * (f32x4){out[4 * i] - corr, out[4 * i + 1] - corr, out[4 * i + 2] - corr, out[4 * i + 3] - corr};
            if (WR) *(f32x4*)(xr + 16 * lane + 4 * i) = xn[i]; else asm volatile("" :: "v"(xn[i])); }
        if (fuse) {
            float ss = 0.f;
#pragma unroll
            for (int i = 0; i < 4; ++i) ss += (xn[i][0] * xn[i][0] + xn[i][1] * xn[i][1]) + (xn[i][2] * xn[i][2] + xn[i][3] * xn[i][3]);
            const float rstd = rsqrtf(wave_sum(ss) * (1.f / D) + EPS);
            const float* md = modn + mrow * 6144 + 16 * lane;
#pragma unroll
            for (int i = 0; i < 4; ++i) { const f32x4 nwv = *(const f32x4*)(nw1 + 4 * i), sc = *(const f32x4*)(md + 1024 + 4 * i), sh = *(const f32x4*)(md + 4 * i);
                xn[i] = xn[i] * rstd * nwv * (sc + 1.f) + sh; }
            { float hmx = 0.f;
#pragma unroll
              for (int i = 0; i < 4; ++i) hmx = fmaxf(hmx, fmaxf(fmaxf(fabsf(xn[i][0]), fabsf(xn[i][1])), fmaxf(fabsf(xn[i][2]), fabsf(xn[i][3]))));
              hmx = fmaxf(wave_max(hmx), 1e-30f); const float hinv = 127.f / hmx;
              u32x4 o;
#pragma unroll
              for (int i = 0; i < 4; ++i) o[i] = ((unsigned)(int)rintf(xn[i][0] * hinv) & 255u) | (((unsigned)(int)rintf(xn[i][1] * hinv) & 255u) << 8) | (((unsigned)(int)rintf(xn[i][2] * hinv) & 255u) << 16) | (((unsigned)(int)rintf(xn[i][3] * hinv) & 255u) << 24);
              *(u32x4*)((signed char*)(ws + WS_H) + (size_t)row * D + 16 * lane) = o;
              if (lane == 0) ((float*)(ws + WS_GB))[row] = hmx * (1.f / 127.f); }
            float p[16];
#pragma unroll
            for (int c = 0; c < 16; ++c) { float q = 0.f;
#pragma unroll
                for (int i = 0; i < 4; ++i) { const f32x4 w = *(const LAS f32x4*)(wsk + c * 1024 + 16 * lane + 4 * i); q += (xn[i][0] * w[0] + xn[i][1] * w[1]) + (xn[i][2] * w[2] + xn[i][3] * w[3]); }
                p[c] = q; }
            { const bool hb = (lane & 32) != 0;
#pragma unroll
              for (int c = 0; c < 8; ++c) { const float keep = hb ? p[c + 8] : p[c], send = hb ? p[c] : p[c + 8]; p[c] = keep + lane_xor<32>(send); } }
            { const bool hb = (lane & 16) != 0;
#pragma unroll
              for (int c = 0; c < 4; ++c) { const float keep = hb ? p[c + 4] : p[c], send = hb ? p[c] : p[c + 4]; p[c] = keep + lane_xor<16>(send); } }
            { const bool hb = (lane & 8) != 0;
#pragma unroll
              for (int c = 0; c < 2; ++c) { const float keep = hb ? p[c + 2] : p[c], send = hb ? p[c] : p[c + 2]; p[c] = keep + lane_xor<8>(send); } }
            { const bool hb = (lane & 4) != 0; const float keep = hb ? p[1] : p[0], send = hb ? p[0] : p[1]; p[0] = keep + lane_xor<4>(send); }
            p[0] += lane_xor<2>(p[0]); p[0] += lane_xor<1>(p[0]);
            if ((lane & 3) == 0) { const int c = ((lane >> 5) & 1) * 8 + ((lane >> 4) & 1) * 4 + ((lane >> 3) & 1) * 2 + ((lane >> 2) & 1); ((float*)(ws + WS_BA))[(size_t)row * 16 + c] = p[0]; }
        }
    }
    if (fuse) __syncthreads();
}
#undef a
constexpr size_t WS_PART = WS_P;
static_assert(WS_PART + 8 * (size_t)M * 1024 * 2 <= WS_GB, "partials region");
constexpr int GP_ITEM = 16;
struct GpMeta { int id0, id1; float gt0, gt1; u32x4 hw; float hsc; };
__device__ __forceinline__ void phase_peer_gpart(int l, LAS unsigned char* lds) {
    const KArgs ap = get_args();
#define a (*ap)
    const int tid = fresh_tid(), lane = tid & 63, wave = __builtin_amdgcn_readfirstlane(tid >> 6);
    unsigned char* ws = a.ws;
    const int nrows = (l == DEPTH - 1) ? ML : M;
    const int nitem = nrows / GP_ITEM;
    const unsigned char* UB = ws + WS_UB + (size_t)(l & 1) * TAB_SET; const unsigned char* VB = UB + 1024;
    const f32x2* SC2 = (const f32x2*)(ws + WS_USC) + (size_t)(l & 1) * NEXP;
    const int* PIDX = (const int*)(ws + WS_PIDX); const float* PGATE = (const float*)(ws + WS_PGATE);
    LAS u32x4* lst0 = (LAS u32x4*)lds + wave * 256;
    const int eidx = ((lane >> 5) & 1) * 4 + ((lane >> 4) & 1) * 2 + ((lane >> 3) & 1);
    const int x = (int)(xb_xcc_id() & 7u);
#define GP_LOAD_META(m_, row_) do { const int rw_ = (row_); (m_).id0 = PIDX[(size_t)rw_ * 128 + lane]; (m_).id1 = PIDX[(size_t)rw_ * 128 + 64 + lane]; (m_).gt0 = PGATE[(size_t)rw_ * 128 + lane]; (m_).gt1 = PGATE[(size_t)rw_ * 128 + 64 + lane]; \
        (m_).hw = *(const u32x4*)((const signed char*)(ws + WS_H) + (size_t)rw_ * D + 16 * lane); (m_).hsc = ((const float*)(ws + WS_GB))[rw_]; } while (0)
#define GP_LOAD_SC(sa_, sb_, m_) do { sa_ = (f32x2){0.f, 0.f}; sb_ = (f32x2){0.f, 0.f}; if (((m_).id0 >> 11) == p) sa_ = SC2[(m_).id0]; if (((m_).id1 >> 11) == p) sb_ = SC2[(m_).id1]; } while (0)
#define GP_BUILD(cnt_, m_, sa_, sb_, buf_) do { const bool s0_ = ((m_).id0 >> 11) == p, s1_ = ((m_).id1 >> 11) == p; const unsigned long long m0_ = __ballot(s0_), m1_ = __ballot(s1_); \
        const int c0_ = __builtin_popcountll(m0_); cnt_ = __builtin_amdgcn_readfirstlane(c0_ + __builtin_popcountll(m1_)); \
        const int r0_ = (int)__builtin_amdgcn_mbcnt_hi((unsigned)(m0_ >> 32), __builtin_amdgcn_mbcnt_lo((unsigned)m0_, 0u)); \
        const int r1_ = c0_ + (int)__builtin_amdgcn_mbcnt_hi((unsigned)(m1_ >> 32), __builtin_amdgcn_mbcnt_lo((unsigned)m1_, 0u)); \
        LAS u32x4* lb_ = lst0 + (buf_) * 128; \
        if (s0_) lb_[r0_] = (u32x4){(unsigned)(m_).id0, __float_as_uint((m_).gt0 * sa_[1]), __float_as_uint(sa_[0]), 0u}; \
        if (s1_) lb_[r1_] = (u32x4){(unsigned)(m_).id1, __float_as_uint((m_).gt1 * sb_[1]), __float_as_uint(sb_[0]), 0u}; } while (0)
#pragma unroll 1
    for (int pp = 0; pp < 8; ++pp) {
        const int p = (x + pp) & 7;
        unsigned* ctr = (unsigned*)(ws + WS_CTL) + 16384 + (l * 8 + p) * 64;
        unsigned* part = (unsigned*)(ws + WS_PART + (size_t)p * M * 2048);
        unsigned tk = 0; if (lane == 0) tk = __hip_atomic_fetch_add(ctr, 1u, __ATOMIC_RELAXED, __HIP_MEMORY_SCOPE_AGENT);
        int it = __builtin_amdgcn_readfirstlane((int)tk);
#pragma unroll 1
        while (it < nitem) {
            unsigned tn = 0; if (lane == 0) tn = __hip_atomic_fetch_add(ctr, 1u, __ATOMIC_RELAXED, __HIP_MEMORY_SCOPE_AGENT);
            const int row0 = it * GP_ITEM, rowl = row0 + GP_ITEM - 1;
            GpMeta m1, m2, m3; f32x2 sa1, sb1, sa2, sb2; int c_cur, c_nxt; u32x4 hw_cur; float hsc_cur;
            GP_LOAD_META(m1, row0); GP_LOAD_META(m2, min(row0 + 1, rowl)); GP_LOAD_META(m3, min(row0 + 2, rowl));
            GP_LOAD_SC(sa1, sb1, m1);
            GP_BUILD(c_cur, m1, sa1, sb1, 0); hw_cur = m1.hw; hsc_cur = m1.hsc;
            GP_LOAD_SC(sa1, sb1, m2);
            m1 = m2; m2 = m3;
            GP_LOAD_META(m3, min(row0 + 3, rowl));
#pragma unroll 1
            for (int i = 0; i < GP_ITEM; ++i) {
                const int row = row0 + i;
                GP_BUILD(c_nxt, m1, sa1, sb1, (i + 1) & 1);
                const u32x4 hw_nxt = m1.hw; const float hsc_nxt = m1.hsc;
                GP_LOAD_SC(sa2, sb2, m2);
                m1 = m2; sa1 = sa2; sb1 = sb2; m2 = m3;
                GP_LOAD_META(m3, min(row + 4, rowl));
                LAS u32x4* lst = lst0 + (i & 1) * 128;
                const int c = c_cur; const u32x4 hw = hw_cur; const float hsc = hsc_cur;
                f32x2 o2[8];
#pragma unroll
                for (int k = 0; k < 8; ++k) o2[k] = (f32x2){0.f, 0.f};
                float wacc = 0.f;
#pragma unroll 1
                for (int e = 0; e < c; e += 8) {
                    u32x4 uw[8], vw[8];
#pragma unroll
                    for (int j = 0; j < 8; ++j) { const int sl = min(e + j, c - 1);
                        const int id = __builtin_amdgcn_readfirstlane((int)lst[sl][0]);
                        uw[j] = *(const u32x4*)(UB + (size_t)id * 2048 + 16 * lane); vw[j] = *(const u32x4*)(VB + (size_t)id * 2048 + 16 * lane); }
                    const int ms = e + eidx; const u32x4 en = lst[min(ms, c - 1)];
                    float pd[8];
#pragma unroll
                    for (int j = 0; j < 8; ++j) { int d = 0;
#pragma unroll
                        for (int q = 0; q < 4; ++q) d = __builtin_amdgcn_sdot4((int)uw[j][q], (int)hw[q], d, false);
                        pd[j] = (float)d; }
                    { const bool hb = (lane & 32) != 0;
#pragma unroll
                      for (int j = 0; j < 4; ++j) { const float keep = hb ? pd[j + 4] : pd[j], send = hb ? pd[j] : pd[j + 4]; pd[j] = keep + lane_xor<32>(send); } }
                    { const bool hb = (lane & 16) != 0;
#pragma unroll
                      for (int j = 0; j < 2; ++j) { const float keep = hb ? pd[j + 2] : pd[j], send = hb ? pd[j] : pd[j + 2]; pd[j] = keep + lane_xor<16>(send); } }
                    { const bool hb = (lane & 8) != 0; const float keep = hb ? pd[1] : pd[0], send = hb ? pd[0] : pd[1]; pd[0] = keep + lane_xor<8>(send); }
                    pd[0] += lane_xor<4>(pd[0]); pd[0] += lane_xor<2>(pd[0]); pd[0] += lane_xor<1>(pd[0]);
                    const float dsum = pd[0] * (__uint_as_float(en[2]) * hsc);
                    const float act = 0.5f * dsum * (1.f + erff(dsum * 0.70710678118654752f));
                    const float wgt = ms < c ? __uint_as_float(en[1]) * act : 0.f;
                    wacc += wgt;
#pragma unroll
                    for (int j = 0; j < 8; ++j) {
                        const float wj = __builtin_bit_cast(float, __builtin_amdgcn_readlane(__builtin_bit_cast(int, wgt), 32 * ((j >> 2) & 1) + 16 * ((j >> 1) & 1) + 8 * (j & 1)));
                        const f32x2 ww = {wj, wj};
#pragma unroll
                        for (int q = 0; q < 4; ++q) { const unsigned w = vw[j][q];
                            const f32x2 v01 = {(float)(w & 255u), (float)((w >> 8) & 255u)}, v23 = {(float)((w >> 16) & 255u), (float)(w >> 24)};
                            o2[2 * q] = __builtin_elementwise_fma(ww, v01, o2[2 * q]); o2[2 * q + 1] = __builtin_elementwise_fma(ww, v23, o2[2 * q + 1]); }
                    }
                }
                const float corr = 16.f * wave_sum(wacc);
                u32x4 w0, w1;
#pragma unroll
                for (int k = 0; k < 4; ++k) { w0[k] = pkbf_c(o2[k][0] - corr, o2[k][1] - corr); w1[k] = pkbf_c(o2[4 + k][0] - corr, o2[4 + k][1] - corr); }
                unsigned* dst = part + (size_t)row * 512 + 8 * lane;
                __builtin_nontemporal_store(w0, (u32x4*)dst); __builtin_nontemporal_store(w1, (u32x4*)(dst + 4));
                c_cur = c_nxt; hw_cur = hw_nxt; hsc_cur = hsc_nxt;
            }
            it = __builtin_amdgcn_readfirstlane((int)tn);
        }
    }
#undef GP_LOAD_META
#undef GP_LOAD_SC
#undef GP_BUILD
#undef a
}

__device__ __forceinline__ void phase_peer_combine(int l, LAS unsigned char* lds) {
    const KArgs ap = get_args();
#define a (*ap)
    const int tid = fresh_tid(), lane = tid & 63, wave = __builtin_amdgcn_readfirstlane(tid >> 6), G = fresh_g(), bx = fresh_bx();
    unsigned char* ws = a.ws;
    const int nrows = (l == DEPTH - 1) ? ML : M;
    const float* modl = (const float*)(ws + WS_MOD) + (size_t)l * 3 * 6144 + 5120;
    const bool fuse = (l + 1 < DEPTH);
    LAS float* wsk = (LAS float*)lds;
    if (fuse) { const float* src = (const float*)(ws + WS_WSK) + (size_t)(l + 1) * 16384; for (int i = tid; i < 16384 / 4; i += 512) ((LAS f32x4*)wsk)[i] = ((const f32x4*)src)[i]; __syncthreads(); }
    const float* nw1 = a.in[I_N1W] + (l + 1 < DEPTH ? l + 1 : l) * 1024 + 16 * lane;
    const float* modn = (const float*)(ws + WS_MOD) + (size_t)(l + 1 < DEPTH ? l + 1 : l) * 3 * 6144;
    for (int row = wave * G + bx; row < nrows; row += G * 8) {
        float out[16];
#pragma unroll
        for (int i = 0; i < 16; ++i) out[i] = 0.f;
#pragma unroll
        for (int p = 0; p < 8; ++p) { const unsigned* src = (const unsigned*)(ws + WS_PART + (size_t)p * M * 2048) + (size_t)row * 512 + 8 * lane;
            const u32x4 w0 = __builtin_nontemporal_load((const u32x4*)src), w1 = __builtin_nontemporal_load((const u32x4*)(src + 4));
#pragma unroll
            for (int k = 0; k < 4; ++k) { out[2 * k] += bflo(w0[k]); out[2 * k + 1] += bfhi(w0[k]); out[8 + 2 * k] += bflo(w1[k]); out[8 + 2 * k + 1] += bfhi(w1[k]); } }
        float* xr; int mrow;
        if (row < ML) { xr = a.out + (size_t)row * D; mrow = row >= T ? 1 : 0; } else { xr = (float*)(ws + WS_CTXX) + (size_t)(row - ML) * D; mrow = 2; }
        const float* g2 = modl + mrow * 6144 + 16 * lane;
        f32x4 xn[4];
#pragma unroll
        for (int i = 0; i < 4; ++i) { const f32x4 x = *(const f32x4*)(xr + 16 * lane + 4 * i), g = *(const f32x4*)(g2 + 4 * i);
            xn[i] = x + g * (f32x4){out[4 * i], out[4 * i + 1], out[4 * i + 2], out[4 * i + 3]};
            *(f32x4*)(xr + 16 * lane + 4 * i) = xn[i]; }
        if (fuse) {
            float ss = 0.f;
#pragma unroll
            for (int i = 0; i < 4; ++i) ss += (xn[i][0] * xn[i][0] + xn[i][1] * xn[i][1]) + (xn[i][2] * xn[i][2] + xn[i][3] * xn[i][3]);
            const float rstd = rsqrtf(wave_sum(ss) * (1.f / D) + EPS);
            const float* md = modn + mrow * 6144 + 16 * lane;
#pragma unroll
            for (int i = 0; i < 4; ++i) { const f32x4 nwv = *(const f32x4*)(nw1 + 4 * i), sc = *(const f32x4*)(md + 1024 + 4 * i), sh = *(const f32x4*)(md + 4 * i);
                xn[i] = xn[i] * rstd * nwv * (sc + 1.f) + sh; }
            { float hmx = 0.f;
#pragma unroll
              for (int i = 0; i < 4; ++i) hmx = fmaxf(hmx, fmaxf(fmaxf(fabsf(xn[i][0]), fabsf(xn[i][1])), fmaxf(fabsf(xn[i][2]), fabsf(xn[i][3]))));
              hmx = fmaxf(wave_max(hmx), 1e-30f); const float hinv = 127.f / hmx;
              u32x4 o;
#pragma unroll
              for (int i = 0; i < 4; ++i) o[i] = ((unsigned)(int)rintf(xn[i][0] * hinv) & 255u) | (((unsigned)(int)rintf(xn[i][1] * hinv) & 255u) << 8) | (((unsigned)(int)rintf(xn[i][2] * hinv) & 255u) << 16) | (((unsigned)(int)rintf(xn[i][3] * hinv) & 255u) << 24);
              *(u32x4*)((signed char*)(ws + WS_H) + (size_t)row * D + 16 * lane) = o;
              if (lane == 0) ((float*)(ws + WS_GB))[row] = hmx * (1.f / 127.f); }
            float p[16];
#pragma unroll
            for (int c = 0; c < 16; ++c) { float q = 0.f;
#pragma unroll
                for (int i = 0; i < 4; ++i) { const f32x4 w = *(const LAS f32x4*)(wsk + c * 1024 + 16 * lane + 4 * i); q += (xn[i][0] * w[0] + xn[i][1] * w[1]) + (xn[i][2] * w[2] + xn[i][3] * w[3]); }
                p[c] = q; }
            { const bool hb = (lane & 32) != 0;
#pragma unroll
              for (int c = 0; c < 8; ++c) { const float keep = hb ? p[c + 8] : p[c], send = hb ? p[c] : p[c + 8]; p[c] = keep + lane_xor<32>(send); } }
            { const bool hb = (lane & 16) != 0;
#pragma unroll
              for (int c = 0; c < 4; ++c) { const float keep = hb ? p[c + 4] : p[c], send = hb ? p[c] : p[c + 4]; p[c] = keep + lane_xor<16>(send); } }
            { const bool hb = (lane & 8) != 0;
#pragma unroll
              for (int c = 0; c < 2; ++c) { const float keep = hb ? p[c + 2] : p[c], send = hb ? p[c] : p[c + 2]; p[c] = keep + lane_xor<8>(send); } }
            { const bool hb = (lane & 4) != 0; const float keep = hb ? p[1] : p[0], send = hb ? p[0] : p[1]; p[0] = keep + lane_xor<4>(send); }
            p[0] += lane_xor<2>(p[0]); p[0] += lane_xor<1>(p[0]);
            if ((lane & 3) == 0) { const int c = ((lane >> 5) & 1) * 8 + ((lane >> 4) & 1) * 4 + ((lane >> 3) & 1) * 2 + ((lane >> 2) & 1); ((float*)(ws + WS_BA))[(size_t)row * 16 + c] = p[0]; }
        }
    }
    if (fuse) __syncthreads();
#undef a
}
constexpr size_t WS_PD = WS_REC;
constexpr size_t WS_PW = WS_REC + 8 * (size_t)M * 128 * 4;
constexpr size_t WS_PC = WS_PW + (size_t)M * 128;
static_assert(WS_PC + (size_t)M * 8 * 4 <= WS_END, "sliced gather scratch");
constexpr int GS_ITEM = 8;
template <int PH>
__device__ __forceinline__ void phase_peer_slice(int l, int cslot) {
    const KArgs ap = get_args();
#define a (*ap)
    const int tid = fresh_tid(), lane = tid & 63;
    unsigned char* ws = a.ws;
    const int nrows = (l == DEPTH - 1) ? ML : M;
    const int nitem = nrows / GS_ITEM;
    const unsigned char* TAB = ws + WS_UB + (size_t)(l & 1) * TAB_SET + (PH ? (size_t)NEXP * 1024 : 0);
    const int* PIDX = (const int*)(ws + WS_PIDX);
    const unsigned char* PW = ws + WS_PW; const float* PC = (const float*)(ws + WS_PC);
    const float* modl = (const float*)(ws + WS_MOD) + (size_t)l * 3 * 6144 + 5120;
    const int g = lane >> 3, i8 = lane & 7;
    const int x = (int)(xb_xcc_id() & 7u);
#pragma unroll 1
    for (int pp = 0; pp < 8; ++pp) {
        const int p = (x + pp) & 7;
        unsigned* ctr = (unsigned*)(ws + WS_CTL) + 16384 + ((l * 2 + PH) * 8 + p) * 64 + cslot * 8192;
        const unsigned char* tb = TAB + (size_t)p * NEXP * 128 + 16 * i8;
        unsigned tk = 0; if (lane == 0) tk = __hip_atomic_fetch_add(ctr, 1u, __ATOMIC_RELAXED, __HIP_MEMORY_SCOPE_AGENT);
        int it = __builtin_amdgcn_readfirstlane((int)tk);
        if (it < nitem) {
            unsigned tn = 0; if (lane == 0) tn = __hip_atomic_fetch_add(ctr, 1u, __ATOMIC_RELAXED, __HIP_MEMORY_SCOPE_AGENT);
            const int row0 = it * GS_ITEM;
            u32x4 idc[4], idn[4], ra[8], rb[8]; u32x4 wc, wn; float sc_c, sc_n; u32x4 hc, hn;
#define GS_META(ids_, wts_, wsc_, h_, row_) do { const int rw_ = (row_); const u32x4* ip_ = (const u32x4*)(PIDX + (size_t)rw_ * 128 + 16 * g); _Pragma("unroll") for (int q_ = 0; q_ < 4; ++q_) ids_[q_] = ip_[q_]; \
                if (PH) { wts_ = *(const u32x4*)(PW + (size_t)rw_ * 128 + 16 * g); wsc_ = PC[(size_t)rw_ * 8 + g]; } \
                else h_ = *(const u32x4*)((const signed char*)(ws + WS_H) + (size_t)rw_ * D + 128 * p + 16 * i8); } while (0)
#define GS_ROWS(dst_, ids_, hf_) do { _Pragma("unroll") for (int k_ = 0; k_ < 8; ++k_) dst_[k_] = *(const u32x4*)(tb + (size_t)ids_[2 * (hf_) + (k_ >> 2)][k_ & 3] * 128); } while (0)
            GS_META(idc, wc, sc_c, hc, row0);
            GS_ROWS(ra, idc, 0);
            GS_META(idn, wn, sc_n, hn, row0 + 1);
            int i = 0, tnv = 0x7fffffff;
#pragma unroll 1
            for (;;) {
                if (i == GS_ITEM - 2) tnv = __builtin_amdgcn_readfirstlane((int)tn);
                const int row = it * GS_ITEM + i;
                const int r2 = (i + 2 < GS_ITEM) ? row + 2 : (tnv < nitem ? tnv * GS_ITEM + (i + 2 - GS_ITEM) : row);
                GS_ROWS(rb, idc, 1);
                if (PH == 0) {
                    int d[16];
#pragma unroll
                    for (int k = 0; k < 8; ++k) { int s_ = 0;
#pragma unroll
                        for (int q = 0; q < 4; ++q) s_ = __builtin_amdgcn_sdot4((int)ra[k][q], (int)hc[q], s_, false);
                        d[k] = s_; }
                    GS_ROWS(ra, idn, 0);
#pragma unroll
                    for (int k = 0; k < 8; ++k) { int s_ = 0;
#pragma unroll
                        for (int q = 0; q < 4; ++q) s_ = __builtin_amdgcn_sdot4((int)rb[k][q], (int)hc[q], s_, false);
                        d[8 + k] = s_; }
#define GS_IX(v_, K_) __builtin_bit_cast(int, lane_xor<K_>(__builtin_bit_cast(float, v_)))
                    { const bool hb = (lane & 4) != 0;
#pragma unroll
                      for (int j = 0; j < 8; ++j) { const int keep = hb ? d[j + 8] : d[j], send = hb ? d[j] : d[j + 8]; d[j] = keep + GS_IX(send, 4); } }
                    { const bool hb = (lane & 2) != 0;
#pragma unroll
                      for (int j = 0; j < 4; ++j) { const int keep = hb ? d[j + 4] : d[j], send = hb ? d[j] : d[j + 4]; d[j] = keep + GS_IX(send, 2); } }
                    { const bool hb = (lane & 1) != 0;
#pragma unroll
                      for (int j = 0; j < 2; ++j) { const int keep = hb ? d[j + 2] : d[j], send = hb ? d[j] : d[j + 2]; d[j] = keep + GS_IX(send, 1); } }
#undef GS_IX
                    u32x2 o = {(unsigned)d[0], (unsigned)d[1]};
                    __builtin_nontemporal_store(o, (u32x2*)((int*)(ws + WS_PD) + ((size_t)p * M + row) * 128 + 2 * lane));
                } else {
                    int oi[16];
#pragma unroll
                    for (int k = 0; k < 16; ++k) oi[k] = 0;
#define GS_QUAD(rr_, qd_, wd_) do { _Pragma("unroll") for (int q_ = 0; q_ < 4; ++q_) { \
                        const unsigned r0_ = rr_[4 * (qd_) + 0][q_], r1_ = rr_[4 * (qd_) + 1][q_], r2_ = rr_[4 * (qd_) + 2][q_], r3_ = rr_[4 * (qd_) + 3][q_]; \
                        const unsigned t0_ = __builtin_amdgcn_perm(r1_, r0_, 0x05010400u), t1_ = __builtin_amdgcn_perm(r1_, r0_, 0x07030602u), t2_ = __builtin_amdgcn_perm(r3_, r2_, 0x05010400u), t3_ = __builtin_amdgcn_perm(r3_, r2_, 0x07030602u); \
                        oi[4 * q_ + 0] = __builtin_amdgcn_sdot4((int)__builtin_amdgcn_perm(t2_, t0_, 0x05040100u), (int)(wd_), oi[4 * q_ + 0], false); \
                        oi[4 * q_ + 1] = __builtin_amdgcn_sdot4((int)__builtin_amdgcn_perm(t2_, t0_, 0x07060302u), (int)(wd_), oi[4 * q_ + 1], false); \
                        oi[4 * q_ + 2] = __builtin_amdgcn_sdot4((int)__builtin_amdgcn_perm(t3_, t1_, 0x05040100u), (int)(wd_), oi[4 * q_ + 2], false); \
                        oi[4 * q_ + 3] = __builtin_amdgcn_sdot4((int)__builtin_amdgcn_perm(t3_, t1_, 0x07060302u), (int)(wd_), oi[4 * q_ + 3], false); } } while (0)
                    GS_QUAD(ra, 0, wc[0]); GS_QUAD(ra, 1, wc[1]);
                    GS_ROWS(ra, idn, 0);
                    GS_QUAD(rb, 0, wc[2]); GS_QUAD(rb, 1, wc[3]);
#undef GS_QUAD
                    float o[16];
#pragma unroll
                    for (int k = 0; k < 16; ++k) o[k] = (float)oi[k] * sc_c;
                    { const bool hb = (lane & 32) != 0;
#pragma unroll
                      for (int j = 0; j < 8; ++j) { const float keep = hb ? o[j + 8] : o[j], send = hb ? o[j] : o[j + 8]; o[j] = keep + lane_xor<32>(send); } }
                    { const bool hb = (lane & 16) != 0;
#pragma unroll
                      for (int j = 0; j < 4; ++j) { const float keep = hb ? o[j + 4] : o[j], send = hb ? o[j] : o[j + 4]; o[j] = keep + lane_xor<16>(send); } }
                    { const bool hb = (lane & 8) != 0;
#pragma unroll
                      for (int j = 0; j < 2; ++j) { const float keep = hb ? o[j + 2] : o[j], send = hb ? o[j] : o[j + 2]; o[j] = keep + lane_xor<8>(send); } }
                    const float corr = 0.f;
                    float* xr; int mrow;
                    if (row < ML) { xr = a.out + (size_t)row * D; mrow = row >= T ? 1 : 0; } else { xr = (float*)(ws + WS_CTXX) + (size_t)(row - ML) * D; mrow = 2; }
                    const int col = 128 * p + 16 * i8 + 2 * g;
                    const f32x2 g2 = *(const f32x2*)(modl + mrow * 6144 + col), xo = *(const f32x2*)(xr + col);
                    *(f32x2*)(xr + col) = (f32x2){xo[0] + g2[0] * (o[0] - corr), xo[1] + g2[1] * (o[1] - corr)};
                }
#pragma unroll
                for (int q = 0; q < 4; ++q) idc[q] = idn[q];
                if (PH) { wc = wn; sc_c = sc_n; } else hc = hn;
                GS_META(idn, wn, sc_n, hn, r2);
                if (++i == GS_ITEM) {
                    if (tnv >= nitem) break;
                    it = tnv; i = 0; tnv = 0x7fffffff;
                    if (lane == 0) tn = __hip_atomic_fetch_add(ctr, 1u, __ATOMIC_RELAXED, __HIP_MEMORY_SCOPE_AGENT);
                }
            }
#undef GS_META
#undef GS_ROWS
        }
    }
#undef a
}
__device__ __forceinline__ void phase_peer_weights(int l) {
    const KArgs ap = get_args();
#define a (*ap)
    const int tid = fresh_tid(), lane = tid & 63, wave = __builtin_amdgcn_readfirstlane(tid >> 6), G = fresh_g(), bx = fresh_bx();
    unsigned char* ws = a.ws;
    const int nrows = (l == DEPTH - 1) ? ML : M;
    const f32x2* SC2 = (const f32x2*)(ws + WS_USC) + (size_t)(l & 1) * NEXP;
    const int* PIDX = (const int*)(ws + WS_PIDX); const float* PGATE = (const float*)(ws + WS_PGATE);
    for (int row = wave * G + bx; row < nrows; row += G * 8) {
        const u32x2 id = *(const u32x2*)(PIDX + (size_t)row * 128 + 2 * lane); const f32x2 gt = *(const f32x2*)(PGATE + (size_t)row * 128 + 2 * lane);
        const float hsc = ((const float*)(ws + WS_GB))[row];
        int d0 = 0, d1 = 0;
#pragma unroll
        for (int p = 0; p < 8; ++p) { const u32x2 v = __builtin_nontemporal_load((const u32x2*)((const int*)(ws + WS_PD) + ((size_t)p * M + row) * 128 + 2 * lane)); d0 += (int)v[0]; d1 += (int)v[1]; }
        const f32x2 s0 = SC2[id[0]], s1 = SC2[id[1]];
        const float x0 = (float)d0 * (s0[0] * hsc), x1 = (float)d1 * (s1[0] * hsc);
        const float w0 = gt[0] * s0[1] * (0.5f * x0 * (1.f + erff(x0 * 0.70710678118654752f))), w1 = gt[1] * s1[1] * (0.5f * x1 * (1.f + erff(x1 * 0.70710678118654752f)));
        float mx = fmaxf(fabsf(w0), fabsf(w1));
        mx = fmaxf(mx, lane_xor<1>(mx)); mx = fmaxf(mx, lane_xor<2>(mx)); mx = fmaxf(mx, lane_xor<4>(mx));
        mx = fmaxf(mx, 1e-30f); const float inv = 127.f / mx;
        *(unsigned short*)(ws + WS_PW + (size_t)row * 128 + 2 * lane) = (unsigned short)(((unsigned)(int)rintf(w0 * inv) & 255u) | (((unsigned)(int)rintf(w1 * inv) & 255u) << 8));
        if ((lane & 7) == 0) ((float*)(ws + WS_PC))[(size_t)row * 8 + (lane >> 3)] = mx * (1.f / 127.f);
    }
#undef a
}

__global__ void __launch_bounds__(512, 2) fwd(Args a) {
    extern __shared__ __attribute__((aligned(16))) unsigned char lds_raw[];
    LAS unsigned char* lds = (LAS unsigned char*)lds_raw;
    volatile LAS unsigned* MISC = (volatile LAS unsigned*)(lds + LDS_MISC);
    if (threadIdx.x < 16) MISC[threadIdx.x] = 0u;
    __syncthreads();
    XcdBarrier bar; bar.bar = (unsigned*)(a.ws + WS_CTL) + 4096; bar.x = 0; bar.st = MISC + 8;
    bar = xcd_barrier_post((unsigned*)(a.ws + WS_CTL) + 4096, MISC + 8);
#ifndef PHASE_MASK
#define PHASE_MASK 0x1FFF
#endif
#define EN(i) ((PHASE_MASK >> (i)) & 1)
#ifndef REP_MASK
#define REP_MASK 0
#endif
#define REPN(i) (1 + ((REP_MASK >> (i)) & 1))
#define IN(k) true
#define SEAM(k) do { XcdBarrier b_; b_.bar = (unsigned*)(get_args()->ws + WS_CTL) + 4096; b_.x = xb_xcc_id(); b_.st = (volatile LAS unsigned*)(lds + LDS_MISC) + 8; xcd_barrier(b_); } while (0)
    for (int rep_ = 0; rep_ < (REPN(0)); ++rep_) if (EN(0) && IN(0)) phase_prologue(lds);
    SEAM(0);
#pragma unroll 1
    for (int l_ = 0; l_ < DEPTH; ++l_) {
        int l = l_; asm volatile("" : "+s"(l));
        const int pb = 1 + l * NPH_L;
        const int mrows = (l == DEPTH - 1) ? ML : M;
        if (l == 0) { for (int rep_ = 0; rep_ < (REPN(1)); ++rep_) if (EN(1) && IN(pb + 0)) { phase_norm<true>(l, 0, lds); phase_quant_weights(lds); }
            SEAM(pb + 0); }
        for (int rep_ = 0; rep_ < (REPN(2)); ++rep_) if (EN(2) && IN(pb + 1)) { const KArgs ap = get_args(); unsigned char* ws = ap->ws; pg8::Gemm g{(const bf16_t*)(ws + WS_H), (const bf16_t*)((const signed char*)(ws + WS_WINT) + (size_t)l * NP * 1024), M, NP, 512}; pg8::StaticOrder S; S.init(M, NP, fresh_g(), fresh_bx());
            pg8::EpiBf16I8 E{(bf16_t*)(ws + WS_P), NP, (const float*)(ws + WS_GB), (const float*)(ws + WS_CTL) + CW_WMAX + (l * 3 + 0) * 3072}; pg8::gemm_phase(lds, g, S, E); }
        SEAM(pb + 1);
        for (int rep_ = 0; rep_ < (REPN(3)); ++rep_) if (EN(3) && IN(pb + 2)) { phase_dn_chunkprep<1>(l, lds); phase_prep(l, lds); }
        for (int rep_ = 0; rep_ < (REPN(4)); ++rep_) if (EN(4) && IN(pb + 3)) phase_dn_chunkprep<0>(l, lds);
        SEAM(pb + 3);
        for (int rep_ = 0; rep_ < (REPN(5)); ++rep_) if (EN(5) && IN(pb + 4)) { phase_dn_scan<0>(l, lds); __syncthreads(); phase_attn(l, lds_raw, MISC, rep_); }
        SEAM(pb + 4);
        for (int rep_ = 0; rep_ < (REPN(7)); ++rep_) if (EN(7) && IN(pb + 5)) phase_dn_out(l);
        SEAM(pb + 5);
        if (EN(8) && IN(pb + 6)) { const KArgs ap = get_args(); unsigned char* ws = ap->ws; pg8::Gemm g{(const bf16_t*)(ws + WS_CATQ), (const bf16_t*)((const signed char*)(ws + WS_WOUTT) + (size_t)l * 1024 * 1024), mrows, 1024, 512}; pg8::StaticOrder S; S.init(mrows, 1024, fresh_g(), fresh_bx());
            pg8::EpiResI8 E{l == 0 ? ap->in[I_X] : ap->out, l == 0 ? ap->in[I_CTX] : (const float*)(ws + WS_CTXX), ap->out, (float*)(ws + WS_CTXX), (const float*)(ws + WS_MOD) + (size_t)l * 3 * 6144 + 2048,
                              (const float*)(ws + WS_GB) + (1u << 18), (const float*)(ws + WS_CTL) + CW_WMAX + (l * 3 + 1) * 3072};
            pg8::gemm_phase(lds, g, S, E); }
        SEAM(pb + 6);
        for (int rep_ = 0; rep_ < (REPN(9)); ++rep_) if (EN(9) && IN(pb + 7)) phase_norm<false>(l, 1, lds);
        SEAM(pb + 7);
        for (int rep_ = 0; rep_ < (REPN(10)); ++rep_) if (EN(10) && IN(pb + 8)) { const KArgs ap = get_args(); unsigned char* ws = ap->ws; pg8::Gemm g{(const bf16_t*)(ws + WS_H), (const bf16_t*)((const signed char*)(ws + WS_WQT) + (size_t)l * 2048 * 1024), mrows, 2048, 512}; pg8::StaticOrder S; S.init(mrows, 2048, fresh_g(), fresh_bx());
            pg8::EpiBf16I8 E{(bf16_t*)(ws + WS_P), 2048, (const float*)(ws + WS_GB), (const float*)(ws + WS_CTL) + CW_WMAX + (l * 3 + 2) * 3072}; pg8::gemm_phase(lds, g, S, E); }
        SEAM(pb + 8);
        for (int rep_ = 0; rep_ < (REPN(11)); ++rep_) if (EN(11) && IN(pb + 9)) phase_peer_select(l);
        SEAM(pb + 9);
        #ifdef GATHER_VAR
        if (EN(12) && IN(pb + 10)) phase_peer_gather<false, GATHER_VAR>(l, lds);
#endif
#if GATHER_PART == 2
        if (EN(12) && IN(pb + 10)) phase_peer_slice<0>(l, 0);
        SEAM(pb + 10);
        if (EN(12) && IN(pb + 10)) phase_peer_weights(l);
        SEAM(pb + 10);
        if (EN(12) && IN(pb + 10)) phase_peer_slice<1>(l, 0);
        if (l + 1 < DEPTH) { SEAM(pb + 10); if (EN(12) && IN(pb + 10)) phase_norm<true>(l + 1, 0, lds); }
#elif GATHER_PART
        if (EN(12) && IN(pb + 10)) phase_peer_gpart(l, lds);
        SEAM(pb + 10);
        if (EN(12) && IN(pb + 10)) phase_peer_combine(l, lds);
#else
        if (REPN(12) > 1 && EN(12) && IN(pb + 10)) phase_peer_gather<false>(l, lds);
        if (EN(12) && IN(pb + 10)) phase_peer_gather<true>(l, lds);
#endif
        if (l + 1 < DEPTH) SEAM(pb + 10);
    }
#undef IN
#undef SEAM
}

#ifndef N_LAUNCH_MODE
#define N_LAUNCH_MODE 1
#endif
extern "C" void kernel_launch(void* const* d_in, const int* in_sizes, int n_in, void* d_out, int out_size, void* d_ws, size_t ws_size, hipStream_t stream) {
    static int grid = 0;
    if (grid == 0) {
        if (n_in != 20 || out_size != ML * D || ws_size < WS_END) { fprintf(stderr, "kernel_launch: unexpected shapes: n_in %d out %d ws %zu (need %zu)\n", n_in, out_size, ws_size, (size_t)WS_END); grid = -1; return; }
        int dev = 0, cus = 0, per_cu = 0;
        if (hipGetDevice(&dev) != hipSuccess || hipDeviceGetAttribute(&cus, hipDeviceAttributeMultiprocessorCount, dev) != hipSuccess) { grid = -1; return; }
        if (hipFuncSetAttribute((const void*)fwd, hipFuncAttributeMaxDynamicSharedMemorySize, LDS_BYTES) != hipSuccess) { fprintf(stderr, "kernel_launch: hipFuncSetAttribute failed\n"); grid = -1; return; }
        if (hipOccupancyMaxActiveBlocksPerMultiprocessor(&per_cu, (const void*)fwd, 512, LDS_BYTES) != hipSuccess || per_cu < 1) fprintf(stderr, "kernel_launch: occupancy query says %d\n", per_cu);
        (void)hipGetLastError();
        grid = cus;
    }
    if (grid < 0) return;
    (void)hipMemsetAsync((char*)d_ws + WS_CTL, 0, CTL_BYTES, stream);
    Args a{};
    for (int i = 0; i < 20; ++i) a.in[i] = (const float*)d_in[i];
    a.out = (float*)d_out; a.ws = (unsigned char*)d_ws;
    a.ph_lo = 0; a.ph_hi = NPHASE;
    hipLaunchKernelGGL(fwd, dim3(grid), dim3(512), LDS_BYTES, stream, a);
    const hipError_t le = hipPeekAtLastError();
    if (le != hipSuccess) fprintf(stderr, "kernel_launch: launch failed: %s\n", hipGetErrorName(le));
}
```

```cpp
#include <hip/hip_runtime.h>
#ifndef GATHER_PART
#define GATHER_PART 2
#endif
#include <cstdio>
#include <cstdint>

#define GAS __attribute__((address_space(1)))
#define LAS __attribute__((address_space(3)))
typedef unsigned short bf16_t;
typedef short bf16x8 __attribute__((ext_vector_type(8)));
typedef short s16x4 __attribute__((ext_vector_type(4)));
typedef float f32x4 __attribute__((ext_vector_type(4)));
typedef float f32x2 __attribute__((ext_vector_type(2)));
typedef float f32x16 __attribute__((ext_vector_type(16)));
typedef unsigned u32x4 __attribute__((ext_vector_type(4)));
typedef unsigned u32x2 __attribute__((ext_vector_type(2)));
typedef int i32x4 __attribute__((ext_vector_type(4)));

constexpr int D = 1024, NB = 2, T = 16384, DEPTH = 4, CT = 256;
constexpr int ML = NB * T, MC = NB * CT, M = ML + MC;
constexpr int NIN = 3088, NP = 3072;
constexpr int KVLEN = T + CT;
constexpr int NEXP = 16384;
constexpr float EPS = 1e-6f;
constexpr int NPH_L = 11;
constexpr int NPHASE = 1 + DEPTH * NPH_L;

constexpr size_t MiB = 1u << 20;
constexpr size_t WS_CTL = 0, CTL_BYTES = 1 * MiB;
constexpr size_t WS_MOD = 1 * MiB;
constexpr size_t WS_ROPE = 2 * MiB;
constexpr size_t WS_WSK = 3 * MiB;
constexpr size_t WS_CTXX = 4 * MiB;
constexpr size_t WS_WINT = 8 * MiB;
constexpr size_t WS_WOUTT = 32 * MiB;
constexpr size_t WS_WQT = 40 * MiB;
constexpr size_t WS_SKB = 56 * MiB;
constexpr size_t WS_USC = 58 * MiB;
constexpr size_t WS_UB = 64 * MiB;
constexpr size_t WS_VB = 80 * MiB;
constexpr size_t TAB_SET = 32 * MiB;
constexpr size_t WS_H = 128 * MiB;
static_assert(WS_H + 2 * (size_t)M * 1024 <= 193 * MiB, "H + concat int8");
constexpr size_t WS_CATQ = WS_H + (size_t)M * 1024;
constexpr size_t WS_P = 193 * MiB;
constexpr size_t WS_QA = 388 * MiB;
constexpr size_t WS_KA = 421 * MiB;
constexpr size_t WS_VA = 438 * MiB;
constexpr size_t WS_CAT = 455 * MiB;
constexpr size_t WS_DQ = 520 * MiB;
constexpr size_t WS_DK = 553 * MiB;
constexpr size_t WS_DV = 586 * MiB;
constexpr size_t WS_OF = 619 * MiB;
constexpr size_t WS_OB = 684 * MiB;
constexpr size_t WS_GB = 749 * MiB;
constexpr size_t WS_BA = 752 * MiB;
constexpr size_t WS_PIDX = 755 * MiB;
constexpr size_t WS_PGATE = 772 * MiB;
constexpr size_t WS_REC = 789 * MiB;
constexpr size_t WS_END = 990 * MiB;
constexpr int CW_WMAX = 65536;
constexpr int NCH = 260;
constexpr int REC_K = 0, REC_KT = 16384, REC_Q = 32768, REC_V = 49152, REC_DIR = 65536, REC_DIRSZ = 17408, REC_BYTES = REC_DIR + 2 * REC_DIRSZ;
static_assert((size_t)NB * 4 * NCH * REC_BYTES + WS_REC <= WS_END, "rec region");

constexpr int LDS_BYTES = 163840;
constexpr int LDS_MISC = 163840 - 256;

__device__ __forceinline__ float bf2f(unsigned b) { return __uint_as_float(b << 16); }
__device__ __forceinline__ float bflo(unsigned w) { return __uint_as_float(w << 16); }
__device__ __forceinline__ float bfhi(unsigned w) { return __uint_as_float(w & 0xffff0000u); }
typedef __bf16 bf2v __attribute__((ext_vector_type(2)));
__device__ __forceinline__ unsigned pkbf(float lo, float hi) { unsigned r; asm("v_cvt_pk_bf16_f32 %0, %1, %2" : "=v"(r) : "v"(lo), "v"(hi)); return r; }
__device__ __forceinline__ unsigned pkbf_c(float lo, float hi) { f32x2 v = {lo, hi}; bf2v r = __builtin_convertvector(v, bf2v); return __builtin_bit_cast(unsigned, r); }
template <int K> __device__ __forceinline__ float lane_xor(float v) {
    const int b = __builtin_bit_cast(int, v);
    if constexpr (K == 1) return __builtin_bit_cast(float, __builtin_amdgcn_update_dpp(0, b, 0xB1, 0xF, 0xF, true));
    else if constexpr (K == 2) return __builtin_bit_cast(float, __builtin_amdgcn_update_dpp(0, b, 0x4E, 0xF, 0xF, true));
    else if constexpr (K == 32) { auto rr = __builtin_amdgcn_permlane32_swap((unsigned)b, (unsigned)b, false, false); unsigned ln_ = __builtin_amdgcn_mbcnt_hi(~0u, __builtin_amdgcn_mbcnt_lo(~0u, 0u)); asm volatile("" : "+v"(ln_));
        return __uint_as_float((ln_ & 32u) ? rr[0] : rr[1]); }
    else return __builtin_bit_cast(float, __builtin_amdgcn_ds_swizzle(b, 0x1F | (K << 10)));
}
__device__ __forceinline__ float wave_sum(float v) {
    v += lane_xor<1>(v); v += lane_xor<2>(v);
    v += __builtin_bit_cast(float, __builtin_amdgcn_update_dpp(0, __builtin_bit_cast(int, v), 0x124, 0xF, 0xF, true));
    v += __builtin_bit_cast(float, __builtin_amdgcn_update_dpp(0, __builtin_bit_cast(int, v), 0x128, 0xF, 0xF, true));
    v += lane_xor<16>(v);
    { auto rr = __builtin_amdgcn_permlane32_swap(__float_as_uint(v), __float_as_uint(v), false, false); v = __uint_as_float(rr[0]) + __uint_as_float(rr[1]); }
    return v;
}
__device__ __forceinline__ float wave_max(float v) {
    v = fmaxf(v, lane_xor<1>(v)); v = fmaxf(v, lane_xor<2>(v));
    v = fmaxf(v, __builtin_bit_cast(float, __builtin_amdgcn_update_dpp(0, __builtin_bit_cast(int, v), 0x124, 0xF, 0xF, true)));
    v = fmaxf(v, __builtin_bit_cast(float, __builtin_amdgcn_update_dpp(0, __builtin_bit_cast(int, v), 0x128, 0xF, 0xF, true)));
    v = fmaxf(v, lane_xor<16>(v));
    { auto rr = __builtin_amdgcn_permlane32_swap(__float_as_uint(v), __float_as_uint(v), false, false); v = fmaxf(__uint_as_float(rr[0]), __uint_as_float(rr[1])); }
    return v;
}
__device__ __forceinline__ float silu_f(float x) { return x / (1.f + __expf(-x)); }
#define LDS_WAIT() asm volatile("s_waitcnt lgkmcnt(0)" ::: "memory")

#define XB_TMO      128
#define XB_XCNT(j)  (256  + 64 * (j))
#define XB_XSUB(j)  (1280 + 64 * (j))
#define XB_XGEN(j)  (2304 + 64 * (j))
#define XB_TOP      3328
#define XB_TOPGEN   3392
#define XCD_BAR_WORDS 3456
#define XB_SPIN_CAP (1u << 22)
__device__ __forceinline__ unsigned xb_ld(unsigned* p)              { return __hip_atomic_load(p, __ATOMIC_RELAXED, __HIP_MEMORY_SCOPE_AGENT); }
__device__ __forceinline__ unsigned xb_add(unsigned* p, unsigned v) { return __hip_atomic_fetch_add(p, v, __ATOMIC_RELAXED, __HIP_MEMORY_SCOPE_AGENT); }
__device__ __forceinline__ unsigned xb_xcc_id() { return (unsigned)__builtin_amdgcn_s_getreg((3 << 11) | 20) & 0xFu; }
#define XB_SPIN(cond, bar) do { unsigned _sp = 0; while (cond) { __builtin_amdgcn_s_sleep(1); \
    if ((++_sp & 255u) == 0u) { if (xb_ld(&(bar)[XB_TMO])) break; if (_sp > XB_SPIN_CAP) { atomicAdd(&(bar)[XB_TMO], 1u); break; } } } } while (0)
struct XcdBarrier { unsigned* bar; unsigned x; volatile LAS unsigned* st; };
__device__ __forceinline__ XcdBarrier xcd_barrier_post(unsigned* bar, volatile LAS unsigned* st) {
    XcdBarrier b; b.bar = bar; b.x = xb_xcc_id(); b.st = st;
    if (threadIdx.x == 0) (void)xb_add(&bar[XB_XCNT(b.x)], 1u);
    return b;
}
__device__ __forceinline__ void xcd_barrier_complete(unsigned* bar, unsigned x, unsigned& nloc, unsigned& nx) {
    const unsigned G = gridDim.x * gridDim.y * gridDim.z;
    unsigned sum, cnt, mine, sp = 0u;
    for (;;) {
        sum = 0u; cnt = 0u; mine = 0u;
#pragma unroll
        for (unsigned j = 0; j < 16; ++j) { const unsigned c = xb_ld(&bar[XB_XCNT(j)]); sum += c; cnt += (c > 0u) ? 1u : 0u; mine = (j == x) ? c : mine; }
        if (sum == G) break;
        __builtin_amdgcn_s_sleep(1);
        if ((++sp & 255u) == 0u) { if (xb_ld(&bar[XB_TMO])) break; if (sp > XB_SPIN_CAP) { atomicAdd(&bar[XB_TMO], 1u); break; } }
    }
    nloc = mine > 0u ? mine : 1u; nx = cnt > 0u ? cnt : 1u;
}
__device__ __forceinline__ void xcd_barrier(const XcdBarrier& b) {
    asm volatile("s_waitcnt vmcnt(0)" ::: "memory");
    __syncthreads();
    if (threadIdx.x == 0) {
        unsigned* bar = b.bar; unsigned bx_ = b.x;
        asm volatile("" : "+s"(bar), "+s"(bx_));
        __builtin_amdgcn_s_waitcnt(0);
        unsigned nloc = b.st[0], nx = b.st[1];
        if (nloc == 0u) { xcd_barrier_complete(bar, bx_, nloc, nx); b.st[0] = nloc; b.st[1] = nx; }
        const unsigned old = xb_add(&bar[XB_XSUB(bx_)], 1u);
        const unsigned gen = old / nloc;
        if (old + 1u == (gen + 1u) * nloc) {
            __builtin_amdgcn_fence(__ATOMIC_RELEASE, "agent");
            asm volatile("s_waitcnt vmcnt(0)" ::: "memory");
            const unsigned og = xb_add(&bar[XB_TOP], 1u);
            const unsigned tg = og / nx;
            if (og + 1u == (tg + 1u) * nx) xb_add(&bar[XB_TOPGEN], 1u);
            else XB_SPIN(xb_ld(&bar[XB_TOPGEN]) == tg, bar);
            __builtin_amdgcn_fence(__ATOMIC_ACQUIRE, "agent");
            xb_add(&bar[XB_XGEN(bx_)], 1u);
            asm volatile("s_waitcnt vmcnt(0)" ::: "memory");
        } else {
            XB_SPIN(xb_ld(&bar[XB_XGEN(bx_)]) == gen, bar);
            __builtin_amdgcn_fence(__ATOMIC_ACQUIRE, "agent");
            asm volatile("s_waitcnt vmcnt(0)" ::: "memory");
        }
    }
    __syncthreads();
}

namespace pg8 {
constexpr int BM = 256, BK = 64, HALF = 128, HTB = HALF * BK * 2, STAGE_BYTES = 8 * HTB, NXCD = 8, WGM = 8;
__host__ __device__ __forceinline__ int lds_byte(int r, int c) { const int st = (r >> 4) * 2 + (c >> 5), rr = r & 15, cc = c & 31, ob = rr * 64 + cc * 2; return st * 1024 + (ob ^ (((ob >> 9) & 1) << 5)); }
__host__ __device__ __forceinline__ void stage_rc(int b, int& R, int& C) { const int st = b / 1024, sb = b % 1024, swz = sb ^ (((sb >> 9) & 1) << 5); R = (st >> 1) * 16 + swz / 64; C = (st & 1) * 32 + (swz % 64) / 2; }
__host__ __device__ __forceinline__ int perm32(int rho) { const int n = rho >> 4, i = rho & 15; return 8 * (i >> 2) + 4 * n + (i & 3); }
struct Unit { int pm, pn; };
struct Gemm { const bf16_t* A; const bf16_t* Bt; int M, N, K; };
struct StaticOrder {
    int nM, nN, nwg, G, c;
    __host__ __device__ void init(int M_, int N_, int G_, int c_) { nM = M_ / BM; nN = N_ / BM; nwg = nM * nN; G = G_; c = c_; }
    __host__ __device__ bool next(int i, Unit& u) const {
        const long L = (long)i * G + c; if (L >= nwg) return false;
        int wgid = (int)L; { const int q = nwg / NXCD, r = nwg % NXCD, xcd = wgid % NXCD, off = wgid / NXCD; wgid = (xcd < r ? xcd * (q + 1) : r * (q + 1) + (xcd - r) * q) + off; }
        const int nig = WGM * nN, gid = wgid / nig, fm = gid * WGM, gsz = (nM - fm) < WGM ? (nM - fm) : WGM;
        u.pm = fm + ((wgid % nig) % gsz); u.pn = (wgid % nig) / gsz; return true;
    }
    __device__ __forceinline__ void a_ready(const Unit&) const {}
    __device__ __forceinline__ void done(const Unit&) const {}
};
struct EpiBf16 {
    static constexpr bool PERM = true, I8 = false; typedef f32x4 acc_t;
    bf16_t* O; int ldc;
    __device__ __forceinline__ void operator()(const f32x4 (&acc)[2][2][4][2], const Unit& u, int wr, int wc, int fr, int fq) const {
        const int row0 = u.pm * BM + wr * 64 + fr; const int col0 = u.pn * BM + wc * 32 + 8 * fq;
#pragma unroll
        for (int ai = 0; ai < 2; ++ai)
#pragma unroll
            for (int m = 0; m < 4; ++m) { bf16_t* rowp = O + (size_t)(row0 + ai * HALF + m * 16) * ldc + col0;
#pragma unroll
                for (int bj = 0; bj < 2; ++bj) { const f32x4 v0 = acc[ai][bj][m][0], v1 = acc[ai][bj][m][1];
                    u32x4 w; w.x = pkbf_c(v0[0], v0[1]); w.y = pkbf_c(v0[2], v0[3]); w.z = pkbf_c(v1[0], v1[1]); w.w = pkbf_c(v1[2], v1[3]);
                    *(u32x4*)(rowp + bj * HALF) = w; } }
    }
};
struct EpiBf16I8 {
    static constexpr bool PERM = true, I8 = true; typedef i32x4 acc_t;
    bf16_t* O; int ldc; const float* sa; const float* wmax;
    __device__ __forceinline__ void operator()(const i32x4 (&acc)[2][2][4][2], const Unit& u, int wr, int wc, int fr, int fq) const {
        const int row0 = u.pm * BM + wr * 64 + fr; const int col0 = u.pn * BM + wc * 32 + 8 * fq;
        f32x4 sw[2][2];
#pragma unroll
        for (int bj = 0; bj < 2; ++bj)
#pragma unroll
            for (int n = 0; n < 2; ++n) sw[bj][n] = *(const f32x4*)(wmax + col0 + bj * HALF + 4 * n) * (1.f / 127.f);
#pragma unroll
        for (int ai = 0; ai < 2; ++ai)
#pragma unroll
            for (int m = 0; m < 4; ++m) { const int row = row0 + ai * HALF + m * 16; const float sr = sa[row]; bf16_t* rowp = O + (size_t)row * ldc + col0;
#pragma unroll
                for (int bj = 0; bj < 2; ++bj) { const i32x4 a0 = acc[ai][bj][m][0], a1 = acc[ai][bj][m][1];
                    const f32x4 v0 = (f32x4){(float)a0[0], (float)a0[1], (float)a0[2], (float)a0[3]} * sw[bj][0] * sr, v1 = (f32x4){(float)a1[0], (float)a1[1], (float)a1[2], (float)a1[3]} * sw[bj][1] * sr;
                    u32x4 w; w.x = pkbf(v0[0], v0[1]); w.y = pkbf(v0[2], v0[3]); w.z = pkbf(v1[0], v1[1]); w.w = pkbf(v1[2], v1[3]);
                    *(u32x4*)(rowp + bj * HALF) = w; } }
    }
};
struct EpiRes {
    static constexpr bool PERM = false, I8 = false; typedef f32x4 acc_t;
    const float* src_lat; const float* src_ctx; float* dst_lat; float* dst_ctx; const float* gate;
    __device__ __forceinline__ void operator()(const f32x4 (&acc)[2][2][4][2], const Unit& u, int wr, int wc, int fr, int fq) const {
        const bool isctx = u.pm >= (ML / BM);
        const float* src = isctx ? src_ctx + (size_t)(u.pm - ML / BM) * BM * D : src_lat + (size_t)u.pm * BM * D;
        float* dst = isctx ? dst_ctx + (size_t)(u.pm - ML / BM) * BM * D : dst_lat + (size_t)u.pm * BM * D;
        const int mrow = isctx ? 2 : (u.pm >= (T / BM) ? 1 : 0);
        const int row0 = wr * 64 + fr, col0 = u.pn * BM + wc * 32 + 4 * fq;
        f32x4 gv[2][2];
#pragma unroll
        for (int bj = 0; bj < 2; ++bj)
#pragma unroll
            for (int n = 0; n < 2; ++n) gv[bj][n] = *(const f32x4*)(gate + mrow * 6144 + col0 + bj * HALF + n * 16);
#pragma unroll
        for (int ai = 0; ai < 2; ++ai)
#pragma unroll
            for (int m = 0; m < 4; ++m) { const size_t off = (size_t)(row0 + ai * HALF + m * 16) * D + col0;
#pragma unroll
                for (int bj = 0; bj < 2; ++bj)
#pragma unroll
                    for (int n = 0; n < 2; ++n) { const f32x4 s = *(const f32x4*)(src + off + bj * HALF + n * 16);
                        *(f32x4*)(dst + off + bj * HALF + n * 16) = s + gv[bj][n] * acc[ai][bj][m][n]; } }
    }
};

struct EpiResI8 {
    static constexpr bool PERM = false, I8 = true; typedef i32x4 acc_t;
    const float* src_lat; const float* src_ctx; float* dst_lat; float* dst_ctx; const float* gate; const float* sa; const float* wmax;
    __device__ __forceinline__ void operator()(const i32x4 (&acc)[2][2][4][2], const Unit& u, int wr, int wc, int fr, int fq) const {
        const bool isctx = u.pm >= (ML / BM);
        const float* src = isctx ? src_ctx + (size_t)(u.pm - ML / BM) * BM * D : src_lat + (size_t)u.pm * BM * D;
        float* dst = isctx ? dst_ctx + (size_t)(u.pm - ML / BM) * BM * D : dst_lat + (size_t)u.pm * BM * D;
        const int mrow = isctx ? 2 : (u.pm >= (T / BM) ? 1 : 0);
        const int row0 = wr * 64 + fr, col0 = u.pn * BM + wc * 32 + 4 * fq;
        f32x4 gv[2][2];
#pragma unroll
        for (int bj = 0; bj < 2; ++bj)
#pragma unroll
            for (int n = 0; n < 2; ++n) gv[bj][n] = *(const f32x4*)(gate + mrow * 6144 + col0 + bj * HALF + n * 16) * *(const f32x4*)(wmax + col0 + bj * HALF + n * 16) * (1.f / 127.f);
#pragma unroll
        for (int ai = 0; ai < 2; ++ai)
#pragma unroll
            for (int m = 0; m < 4; ++m) { const int rl = row0 + ai * HALF + m * 16; const float sr = sa[u.pm * BM + rl]; const size_t off = (size_t)rl * D + col0;
#pragma unroll
                for (int bj = 0; bj < 2; ++bj)
#pragma unroll
                    for (int n = 0; n < 2; ++n) { const f32x4 sv = *(const f32x4*)(src + off + bj * HALF + n * 16); const i32x4 ac = acc[ai][bj][m][n];
                        *(f32x4*)(dst + off + bj * HALF + n * 16) = sv + gv[bj][n] * ((f32x4){(float)ac[0], (float)ac[1], (float)ac[2], (float)ac[3]} * sr); } }
    }
};
template <class Epi, class Sched>
__device__ __forceinline__ void gemm_phase(LAS unsigned char* lds, const Gemm g, const Sched& S, const Epi& E) {
    constexpr bool I8 = Epi::I8;
    typedef typename Epi::acc_t acc_t;
    int tid = threadIdx.x; asm volatile("" : "+v"(tid)); const int wid = __builtin_amdgcn_readfirstlane(tid >> 6), lane = tid & 63, wr = wid >> 2, wc = wid & 3, fr = lane & 15, fq = lane >> 4;
    const int K = g.K, nt = K / BK;
    unsigned voffA[2], voffB[2];
#pragma unroll
    for (int i = 0; i < 2; ++i) { int R, C; stage_rc(tid * 16 + i * 8192, R, C); const int Rb = Epi::PERM ? ((R & ~31) + perm32(R & 31)) : R;
        voffA[i] = (unsigned)(R * K + C) * 2u; voffB[i] = (unsigned)(Rb * K + C) * 2u; }
    const size_t kstep = (size_t)(BK * 2);
    const size_t hstep = (size_t)HALF * K * 2;
    const size_t tstep = 2 * hstep;
    const unsigned ldsw = (unsigned)wid * 1024u;
    const int aoff = lds_byte(wr * 64 + fr, fq * 8), boff = lds_byte(wc * 32 + fr, fq * 8);
#define PG8_SA(b, h) (((b) * 2 + (h)) * HTB)
#define PG8_SB(b, h) ((4 + (b) * 2 + (h)) * HTB)
#define PG8_STAGE(bufoff, gbase, voff) do { _Pragma("unroll") for (int _i = 0; _i < 2; ++_i) \
        __builtin_amdgcn_global_load_lds((const unsigned*)((const char*)(gbase) + (voff)[_i]), (LAS unsigned*)(lds + (bufoff) + ldsw + _i * 8192), 16, 0, 0); } while (0)
#define PG8_LDA(dst, b, h) do { _Pragma("unroll") for (int m = 0; m < 4; ++m) _Pragma("unroll") for (int k = 0; k < 2; ++k) dst[m][k] = *(const LAS bf16x8*)(lds + PG8_SA(b, h) + aoff + m * 2048 + k * 1024); } while (0)
#define PG8_LDB(dst, b, h) do { _Pragma("unroll") for (int n = 0; n < 2; ++n) _Pragma("unroll") for (int k = 0; k < 2; ++k) dst[n][k] = *(const LAS bf16x8*)(lds + PG8_SB(b, h) + boff + n * 2048 + k * 1024); } while (0)
#define PG8_MMA(ai, bj, At, Bt) do { __builtin_amdgcn_s_setprio(1); _Pragma("unroll") for (int m = 0; m < 4; ++m) _Pragma("unroll") for (int n = 0; n < 2; ++n) _Pragma("unroll") for (int k = 0; k < 2; ++k) \
        { if constexpr (I8) acc[ai][bj][m][n] = __builtin_bit_cast(acc_t, __builtin_amdgcn_mfma_i32_16x16x64_i8(__builtin_bit_cast(i32x4, Bt[n][k]), __builtin_bit_cast(i32x4, At[m][k]), __builtin_bit_cast(i32x4, acc[ai][bj][m][n]), 0, 0, 0)); \
          else acc[ai][bj][m][n] = __builtin_bit_cast(acc_t, __builtin_amdgcn_mfma_f32_16x16x32_bf16(Bt[n][k], At[m][k], __builtin_bit_cast(f32x4, acc[ai][bj][m][n]), 0, 0, 0)); } __builtin_amdgcn_s_setprio(0); } while (0)
#define PG8_WAIT_V(n) asm volatile("s_waitcnt vmcnt(" #n ")" ::: "memory")
#define PG8_WAIT_L(n) asm volatile("s_waitcnt lgkmcnt(" #n ")" ::: "memory")
#define PG8_BAR __builtin_amdgcn_s_barrier()
#define PG8_SCHED __builtin_amdgcn_sched_barrier(0)
    Unit cur, nxt; int ui = 0;
    if (!S.next(0, cur)) return;
    acc_t acc[2][2][4][2];
#pragma unroll
    for (int a = 0; a < 2; ++a)
#pragma unroll
        for (int b = 0; b < 2; ++b)
#pragma unroll
            for (int m = 0; m < 4; ++m)
#pragma unroll
                for (int n = 0; n < 2; ++n) acc[a][b][m][n] = acc_t{};
    bf16x8 At[4][2], B0[2][2], B1[2][2];
    const char* cA = (const char*)g.A + (size_t)cur.pm * tstep; const char* cB = (const char*)g.Bt + (size_t)cur.pn * tstep;
    S.a_ready(cur);
    PG8_STAGE(PG8_SB(0, 0), cB, voffB); PG8_STAGE(PG8_SA(0, 0), cA, voffA); PG8_STAGE(PG8_SB(0, 1), cB + hstep, voffB); PG8_STAGE(PG8_SA(0, 1), cA + hstep, voffA);
    if (wr == 1) PG8_BAR;
    PG8_WAIT_V(4); PG8_BAR;
    PG8_STAGE(PG8_SB(1, 0), cB + kstep, voffB); PG8_STAGE(PG8_SA(1, 0), cA + kstep, voffA); PG8_STAGE(PG8_SB(1, 1), cB + hstep + kstep, voffB);
    PG8_WAIT_V(6); PG8_BAR;
    for (;;) {
        const bool has_next = S.next(ui + 1, nxt);
        const char* nA = has_next ? (const char*)g.A + (size_t)nxt.pm * tstep : cA; const char* nB = has_next ? (const char*)g.Bt + (size_t)nxt.pn * tstep : cB;
        for (int t = 0; t < nt; t += 2) {
            const bool last = (t == nt - 2);
            const char* a1 = cA + (size_t)(t + 1) * kstep;
            const char* a2 = last ? nA : cA + (size_t)(t + 2) * kstep; const char* b2 = last ? nB : cB + (size_t)(t + 2) * kstep;
            const char* a3 = a2 + kstep; const char* b3 = b2 + kstep;
            if (last && has_next) S.a_ready(nxt);
            PG8_LDB(B0, 0, 0); PG8_SCHED; PG8_LDA(At, 0, 0); PG8_STAGE(PG8_SA(1, 1), a1 + hstep, voffA);
            PG8_WAIT_L(8); PG8_BAR; PG8_WAIT_L(0); PG8_MMA(0, 0, At, B0); PG8_BAR; PG8_SCHED;
            PG8_LDB(B1, 0, 1); PG8_STAGE(PG8_SB(0, 0), b2, voffB);
            PG8_BAR; PG8_WAIT_L(0); PG8_MMA(0, 1, At, B1); PG8_BAR;
            PG8_LDA(At, 0, 1); PG8_STAGE(PG8_SA(0, 0), a2, voffA);
            PG8_BAR; PG8_WAIT_L(0); PG8_MMA(1, 0, At, B0); PG8_BAR; PG8_SCHED;
            PG8_STAGE(PG8_SB(0, 1), b2 + hstep, voffB);
            PG8_WAIT_V(6); PG8_BAR; PG8_MMA(1, 1, At, B1); PG8_BAR;
            PG8_LDB(B0, 1, 0); PG8_SCHED; PG8_LDA(At, 1, 0); PG8_STAGE(PG8_SA(0, 1), a2 + hstep, voffA);
            PG8_WAIT_L(8); PG8_BAR; PG8_WAIT_L(0); PG8_MMA(0, 0, At, B0); PG8_BAR; PG8_SCHED;
            PG8_LDB(B1, 1, 1); PG8_STAGE(PG8_SB(1, 0), b3, voffB);
            PG8_BAR; PG8_WAIT_L(0); PG8_MMA(0, 1, At, B1); PG8_BAR;
            PG8_LDA(At, 1, 1); PG8_STAGE(PG8_SA(1, 0), a3, voffA);
            PG8_BAR; PG8_WAIT_L(0); PG8_MMA(1, 0, At, B0); PG8_BAR; PG8_SCHED;
            PG8_STAGE(PG8_SB(1, 1), b3 + hstep, voffB);
            PG8_WAIT_V(6); PG8_BAR; PG8_MMA(1, 1, At, B1); PG8_BAR;
        }
        E(acc, cur, wr, wc, fr, fq); S.done(cur);
        if (!has_next) break;
#pragma unroll
        for (int a = 0; a < 2; ++a)
#pragma unroll
            for (int b = 0; b < 2; ++b)
#pragma unroll
                for (int m = 0; m < 4; ++m)
#pragma unroll
                    for (int n = 0; n < 2; ++n) acc[a][b][m][n] = acc_t{};
        cur = nxt; cA = nA; cB = nB; ++ui;
    }
    PG8_WAIT_V(0);
    if (wr == 0) PG8_BAR;
    PG8_BAR;
#undef PG8_SA
#undef PG8_SB
#undef PG8_STAGE
#undef PG8_LDA
#undef PG8_LDB
#undef PG8_MMA
#undef PG8_WAIT_V
#undef PG8_WAIT_L
#undef PG8_BAR
#undef PG8_SCHED
}
}

namespace att {
constexpr int HD = 128, NW = 8, QBLK = 32, KVBLK = 64;
constexpr float SCALE = 0.088388347648318440f;
constexpr float THR = 8.f;
constexpr int LDQ = 512, LDK = 256;
constexpr size_t SHM_V = KVBLK * HD * 2, SHM_K = KVBLK * HD * 2, SHM_ATTN = 2 * SHM_V + 2 * SHM_K + NW * 64 * 4;
#define KSWZ(row, colB) ((row) * 256 + ((colB) ^ (((row) & 7) << 4)))
#define SBAR() __builtin_amdgcn_sched_barrier(0)
__device__ __forceinline__ int crow(int r, int hi) { return (r & 3) + 8 * (r >> 2) + 4 * hi; }
__device__ __forceinline__ unsigned cvtpk(float lo, float hi) { unsigned r; asm volatile("v_cvt_pk_bf16_f32 %0, %1, %2" : "=v"(r) : "v"(lo), "v"(hi)); return r; }
__device__ __forceinline__ void partialSM(f32x16& p0, f32x16& p1) {
  for (int r = 0; r < 16; ++r) p0[r] = __builtin_amdgcn_exp2f(p0[r]);
}
typedef int i32x8 __attribute__((ext_vector_type(8)));
__device__ __forceinline__ void finishSM(f32x16& p0, f32x16& p1, i32x8& pa) {
  for (int r = 0; r < 16; ++r) p1[r] = __builtin_amdgcn_exp2f(p1[r]);
#pragma unroll
  for (int q = 0; q < 4; ++q) { int w = __builtin_amdgcn_cvt_pk_bf8_f32(p0[4 * q], p0[4 * q + 1], 0, false); w = __builtin_amdgcn_cvt_pk_bf8_f32(p0[4 * q + 2], p0[4 * q + 3], w, true); pa[q] = w;
    int w2 = __builtin_amdgcn_cvt_pk_bf8_f32(p1[4 * q], p1[4 * q + 1], 0, false); w2 = __builtin_amdgcn_cvt_pk_bf8_f32(p1[4 * q + 2], p1[4 * q + 3], w2, true); pa[4 + q] = w2; }
}
constexpr int K8_STRIDE = 144, K8_TILE = KVBLK * K8_STRIDE;
__device__ __forceinline__ void qkt(f32x16& p0, f32x16& p1, const unsigned char* Ks, const i32x8* qr, int r32, int hi, const f32x16& cinit) {
  p0 = cinit; p1 = cinit;
#pragma unroll
  for (int ks = 0; ks < 2; ++ks) {
    const u32x4* a0 = (const u32x4*)(Ks + r32 * K8_STRIDE + 64 * ks + 32 * hi); const u32x4* a1 = (const u32x4*)(Ks + (32 + r32) * K8_STRIDE + 64 * ks + 32 * hi);
    const u32x4 x0 = a0[0], x1 = a0[1], y0 = a1[0], y1 = a1[1];
    const i32x8 k0 = {(int)x0.x, (int)x0.y, (int)x0.z, (int)x0.w, (int)x1.x, (int)x1.y, (int)x1.z, (int)x1.w}, k1 = {(int)y0.x, (int)y0.y, (int)y0.z, (int)y0.w, (int)y1.x, (int)y1.y, (int)y1.z, (int)y1.w};
    p0 = __builtin_amdgcn_mfma_scale_f32_32x32x64_f8f6f4(k0, qr[ks], p0, 0, 0, 0, 0x7F7F7F7F, 0, 0x7C7C7C7C);
    p1 = __builtin_amdgcn_mfma_scale_f32_32x32x64_f8f6f4(k1, qr[ks], p1, 0, 0, 0, 0x7F7F7F7F, 0, 0x7C7C7C7C); }
}
constexpr int V8_STRIDE = 80, V8_TILE = HD * V8_STRIDE;
__device__ __forceinline__ void pv_d0(f32x16* o, f32x16& ol, const unsigned char* Vs, const i32x8& pa, int r32, int hi) {
  { const i32x8 ones = {0x38383838, 0x38383838, 0x38383838, 0x38383838, 0x38383838, 0x38383838, 0x38383838, 0x38383838};
    ol = __builtin_amdgcn_mfma_scale_f32_32x32x64_f8f6f4(pa, ones, ol, 1, 0, 0, 0x7F7F7F7F, 0, 0x7F7F7F7F); }
#pragma unroll
  for (int d0 = 0; d0 < 4; ++d0) { const u32x4* bp = (const u32x4*)(Vs + (32 * d0 + r32) * V8_STRIDE + 32 * hi); const u32x4 x0 = bp[0], x1 = bp[1];
    const i32x8 vb = {(int)x0.x, (int)x0.y, (int)x0.z, (int)x0.w, (int)x1.x, (int)x1.y, (int)x1.z, (int)x1.w};
    o[d0] = __builtin_amdgcn_mfma_scale_f32_32x32x64_f8f6f4(pa, vb, o[d0], 1  , 0  , 0, 0x7F7F7F7F, 0, 0x7F7F7F7F); }
}
__device__ __forceinline__ void attn_dense_body(const unsigned char* __restrict__ Qb, const unsigned char* __restrict__ Kh, const unsigned char* __restrict__ Vt,
                                                bf16_t* __restrict__ Ob, int LDO, int seq, char* lds, float* __restrict__ lse, float braw) {
  int tid = threadIdx.x; asm volatile("" : "+v"(tid)); const int wid = tid >> 6, lane = tid & 63, r32 = lane & 31, hi = lane >> 5;
  unsigned char* V_lds = (unsigned char*)lds; unsigned char* K_lds = (unsigned char*)(lds + 3 * V8_TILE);
  f32x16 o[4] = {}, ol = {}; i32x8 qr[2];
  const float mnC = __builtin_bit_cast(float, __builtin_amdgcn_readfirstlane(__builtin_bit_cast(int, -fmaxf(braw * (SCALE * 1.4426950408889634f) - 15.5f, 0.f))));
  f32x16 cinit;
#pragma unroll
  for (int r = 0; r < 16; ++r) cinit[r] = mnC;
  const unsigned char* Qw = Qb + (long)(wid * QBLK + r32) * LDQ + hi * 32;
#pragma unroll
  for (int ks = 0; ks < 2; ++ks) { const u32x4 x0 = *(const u32x4*)(Qw + 64 * ks), x1 = *(const u32x4*)(Qw + 64 * ks + 16);
    qr[ks] = (i32x8){(int)x0.x, (int)x0.y, (int)x0.z, (int)x0.w, (int)x1.x, (int)x1.y, (int)x1.z, (int)x1.w}; }
  const int krow = tid >> 3, kch = tid & 7;
  const int vrow = tid >> 2, vch = tid & 3;
  struct { u32x4 v8, k8; } sr_[2];
#define SLOAD(i, k0) do { sr_[i].v8 = *reinterpret_cast<const u32x4*>(Vt + (long)((k0) >> 6) * 8192 + tid * 16); \
    sr_[i].k8 = *reinterpret_cast<const u32x4*>(Kh + (long)((k0) + krow) * LDK + kch * 16); } while (0)
#define SWRITE(b, i) do { *(u32x4*)(V_lds + (b) * V8_TILE + vrow * V8_STRIDE + vch * 16) = sr_[i].v8; \
    *(u32x4*)(K_lds + (b) * K8_TILE + krow * K8_STRIDE + kch * 16) = sr_[i].k8; } while (0)
#define SWAIT() asm volatile("s_waitcnt vmcnt(2)" ::: "memory")
  f32x16 pA0, pA1, pB0, pB1; i32x8 pa; const int NT = seq / KVBLK;
  constexpr int SE = 0, SO = 1;
  SLOAD(SE, 0); asm volatile("s_waitcnt vmcnt(0)" ::: "memory"); SWRITE(0, SE);
  SLOAD(SO, KVBLK); SLOAD(SE, 2 * KVBLK);
  __syncthreads();
  qkt(pA0, pA1, K_lds, qr, r32, hi, cinit); partialSM(pA0, pA1);
  SWAIT(); SWRITE(1, SO); SLOAD(SO, 3 * KVBLK);
  __syncthreads();
  int s0 = 0, s1 = 1, s2 = 2;
  for (int j = 1; j + 1 < NT; j += 2) {
    SBAR(); qkt(pB0, pB1, K_lds + s1 * K8_TILE, qr, r32, hi, cinit);
    finishSM(pA0, pA1, pa); SBAR();
    pv_d0(o, ol, V_lds + s0 * V8_TILE, pa, r32, hi); partialSM(pB0, pB1);
    SBAR(); SWAIT(); SWRITE(s2, SE); SLOAD(SE, (j + 3 < NT ? j + 3 : NT - 1) * KVBLK);
    __syncthreads();
    SBAR(); qkt(pA0, pA1, K_lds + s2 * K8_TILE, qr, r32, hi, cinit);
    finishSM(pB0, pB1, pa); SBAR();
    pv_d0(o, ol, V_lds + s1 * V8_TILE, pa, r32, hi); partialSM(pA0, pA1);
    SBAR(); SWAIT(); SWRITE(s0, SO); SLOAD(SO, (j + 4 < NT ? j + 4 : NT - 1) * KVBLK);
    __syncthreads();
    { const int t_ = s0; s0 = s2; s2 = s1; s1 = t_; }
  }
  SBAR(); qkt(pB0, pB1, K_lds + s1 * K8_TILE, qr, r32, hi, cinit);
  finishSM(pA0, pA1, pa); SBAR();
  pv_d0(o, ol, V_lds + s0 * V8_TILE, pa, r32, hi); partialSM(pB0, pB1);
  finishSM(pB0, pB1, pa); SBAR();
  pv_d0(o, ol, V_lds + s1 * V8_TILE, pa, r32, hi);
  asm volatile("s_waitcnt vmcnt(0)" ::: "memory");
  if (lse && r32 == 0) {
#pragma unroll
    for (int r = 0; r < 16; ++r) lse[(wid * QBLK + crow(r, hi)) * 4] = __logf(ol[r]) - mnC * 0.69314718055994531f; }
  float rli[16];
#pragma unroll
  for (int r = 0; r < 16; ++r) rli[r] = __builtin_amdgcn_rcpf(ol[r]);
  bf16_t* Ow = Ob + (long)(wid * QBLK) * LDO;
#pragma unroll
  for (int r = 0; r < 16; ++r) { int orow = crow(r, hi);
    for (int d0 = 0; d0 < 4; ++d0) Ow[(long)orow * LDO + d0 * 32 + r32] = (bf16_t)(pkbf(o[d0][r] * rli[r], 0.f) & 0xffffu); }
  __syncthreads();
#undef SLOAD
#undef SWRITE
#undef SWAIT
}
}

struct Args { const float* in[20]; float* out; unsigned char* ws; int ph_lo, ph_hi; };
typedef const __attribute__((address_space(4))) Args* KArgs;
__device__ __forceinline__ KArgs get_args() { KArgs p = (KArgs)__builtin_amdgcn_kernarg_segment_ptr(); asm volatile("" : "+s"(p)); return p; }
__device__ __forceinline__ int fresh_tid() { int t = threadIdx.x; asm volatile("" : "+v"(t)); return t; }
__device__ __forceinline__ int fresh_bx() { int t = blockIdx.x; asm volatile("" : "+s"(t)); return t; }
__device__ __forceinline__ int fresh_g() { int t = gridDim.x; asm volatile("" : "+s"(t)); return t; }
enum { I_X = 0, I_C, I_CTX, I_CCTX, I_ADAW, I_ADAB, I_N1W, I_N2W, I_WIN, I_QNW, I_KNW, I_CONVW, I_ALOG, I_DTB, I_DNW, I_WOUT, I_WQ, I_SUBK, I_U, I_V };

__device__ __forceinline__ void convert_tables(const float* U, const float* V, unsigned char* ws, int l, int wvi, int nwv, int lane, int rw_end = 2 * NEXP) {
    const float* us = U + (size_t)l * NEXP * 1024; const float* vs = V + (size_t)l * NEXP * 1024;
    const int set = l & 1;
    float* scl = (float*)(ws + WS_USC) + set * 2 * NEXP;
    for (int rw = wvi; rw < rw_end; rw += nwv) {
        const bool isu = rw < NEXP; const int e = isu ? rw : rw - NEXP;
        const f32x4* sp = (const f32x4*)((isu ? us : vs) + (size_t)e * 1024 + 16 * lane);
        f32x4 x[4]; float mx = 0.f;
#pragma unroll
        for (int i = 0; i < 4; ++i) { x[i] = sp[i]; mx = fmaxf(mx, fmaxf(fmaxf(fabsf(x[i][0]), fabsf(x[i][1])), fmaxf(fabsf(x[i][2]), fabsf(x[i][3])))); }
        mx = wave_max(mx);
        const float sc = fmaxf(mx, 1e-30f) * (1.f / 127.f), inv = 1.f / sc;
        u32x4 o4;
        const float ofs = ((GATHER_PART && isu) || GATHER_PART == 2) ? 0.f : 128.f;
#pragma unroll
        for (int i = 0; i < 4; ++i) { const unsigned b0 = (unsigned)(int)(rintf(x[i][0] * inv) + ofs) & 255u, b1 = (unsigned)(int)(rintf(x[i][1] * inv) + ofs) & 255u, b2 = (unsigned)(int)(rintf(x[i][2] * inv) + ofs) & 255u, b3 = (unsigned)(int)(rintf(x[i][3] * inv) + ofs) & 255u;
            o4[i] = b0 | (b1 << 8) | (b2 << 16) | (b3 << 24); }
        if (GATHER_PART == 2) *(u32x4*)(ws + WS_UB + (size_t)set * TAB_SET + (isu ? 0 : (size_t)NEXP * 1024) + ((size_t)(lane >> 3) * NEXP + e) * 128 + 16 * (lane & 7)) = o4;
        else *(u32x4*)(ws + WS_UB + (size_t)set * TAB_SET + (size_t)e * 2048 + (isu ? 0 : 1024) + 16 * lane) = o4;
        if (lane == 0) { if (GATHER_PART) scl[2 * e + (isu ? 0 : 1)] = sc; else scl[rw] = sc; }
    }
}

__device__ __forceinline__ void transpose_item(const float* W, int ldw, int K, bf16_t* WT, LAS float* scr, int kb, int nb, int lane) {
    const int k0 = 64 * kb, n0 = 32 * nb;
#pragma unroll 8
    for (int i = 0; i < 32; ++i) { const int kk = 2 * i + (lane >> 5); scr[kk * 33 + (lane & 31)] = W[(size_t)(k0 + kk) * ldw + n0 + (lane & 31)]; }
    LDS_WAIT(); asm volatile("" ::: "memory");
    const int c = lane & 7;
#pragma unroll
    for (int j = 0; j < 4; ++j) { const int n = (lane >> 3) + 8 * j; const LAS float* s = scr + (8 * c) * 33 + n;
        u32x4 o; o.x = pkbf(s[0 * 33], s[1 * 33]); o.y = pkbf(s[2 * 33], s[3 * 33]); o.z = pkbf(s[4 * 33], s[5 * 33]); o.w = pkbf(s[6 * 33], s[7 * 33]);
        *(u32x4*)(WT + (size_t)(n0 + n) * K + k0 + 8 * c) = o; }
    LDS_WAIT(); asm volatile("" ::: "memory");
}
__device__ __forceinline__ void phase_prologue(LAS unsigned char* lds) {
    const KArgs ap = get_args();
#define a (*ap)

    const int tid = fresh_tid(), lane = tid & 63, wave = __builtin_amdgcn_readfirstlane(tid >> 6), G = fresh_g(), bx = fresh_bx();
    unsigned char* ws = a.ws;
    {
        LAS float* sc = (LAS float*)(lds + 70000);
        LAS float* part = (LAS float*)(lds + 70000 + 12288);
        for (int i = tid; i < 3 * 1024; i += 512) { const int r = i >> 10, k = i & 1023; const float v = r < 2 ? a.in[I_C][r * 1024 + k] : a.in[I_CCTX][k]; sc[i] = silu_f(v); }
        __syncthreads();
        float* mod = (float*)(ws + WS_MOD);
        for (int item = bx; item < DEPTH * 96; item += G) {
            const int l = item / 96, j0 = (item % 96) * 64;
            const float* wp = a.in[I_ADAW] + (size_t)l * 1024 * 6144 + (size_t)(wave * 128) * 6144 + j0 + lane;
            float a0 = 0.f, a1 = 0.f, a2 = 0.f;
#pragma unroll 8
            for (int kk = 0; kk < 128; ++kk) { const float w = wp[(size_t)kk * 6144]; const int k = wave * 128 + kk; a0 = fmaf(sc[k], w, a0); a1 = fmaf(sc[1024 + k], w, a1); a2 = fmaf(sc[2048 + k], w, a2); }
            part[(wave * 3 + 0) * 64 + lane] = a0; part[(wave * 3 + 1) * 64 + lane] = a1; part[(wave * 3 + 2) * 64 + lane] = a2;
            __syncthreads();
            if (tid < 192) { const int r = tid >> 6, jj = tid & 63; float s = a.in[I_ADAB][l * 6144 + j0 + jj];
#pragma unroll
                for (int w = 0; w < 8; ++w) s += part[(w * 3 + r) * 64 + jj];
                mod[(size_t)(l * 3 + r) * 6144 + j0 + jj] = s; }
            __syncthreads();
        }
    }
    {
        const int gw = bx * 8 + wave, NGW = G * 8;
        unsigned* wmaxw = (unsigned*)(ws + WS_CTL) + CW_WMAX;
        constexpr int NB_IN = NP / 64, NB_OUT = 1024 / 64, NB_Q = 2048 / 64, PER_L2 = (NB_IN + NB_OUT + NB_Q) * 8;
        for (int it = gw; it < DEPTH * PER_L2; it += NGW) { const int l = it / PER_L2; int r = it % PER_L2; const int kc = r & 7; r >>= 3;
            const int mi = r < NB_IN ? 0 : r < NB_IN + NB_OUT ? 1 : 2; const int nb = mi == 0 ? r : mi == 1 ? r - NB_IN : r - NB_IN - NB_OUT; const int ldw = mi == 0 ? NIN : mi == 1 ? 1024 : 2048;
            const float* wp = (mi == 0 ? a.in[I_WIN] + (size_t)l * 1024 * NIN : mi == 1 ? a.in[I_WOUT] + (size_t)l * 1024 * 1024 : a.in[I_WQ] + (size_t)l * 1024 * 2048) + (size_t)(kc * 128) * ldw + nb * 64 + lane;
            float mx = 0.f;
#pragma unroll 8
            for (int kk = 0; kk < 128; ++kk) mx = fmaxf(mx, fabsf(wp[(size_t)kk * ldw]));
            atomicMax(wmaxw + (l * 3 + mi) * 3072 + nb * 64 + lane, __float_as_uint(mx)); }
    }
    const size_t gt = (size_t)bx * 512 + tid, NT = (size_t)G * 512;
    for (size_t i = gt; i < (size_t)DEPTH * 16 * 1024; i += NT) { const int l = (int)(i >> 14), j = (int)((i >> 10) & 15), k = (int)(i & 1023);
        ((float*)(ws + WS_WSK))[i] = a.in[I_WIN][(size_t)l * 1024 * NIN + (size_t)k * NIN + NP + j]; }
    convert_tables(a.in[I_U], a.in[I_V], ws, 0, bx * 8 + wave, G * 8, lane);
    for (size_t i = gt; i < (size_t)DEPTH * 8 * 2 * 128 * 128 / 2; i += NT) { const f32x2 x = ((const f32x2*)a.in[I_SUBK])[i]; ((unsigned*)(ws + WS_SKB))[i] = pkbf(x[0], x[1]); }
    for (size_t i = gt; i < 8192; i += NT) { const int pos = (int)(i >> 5), fi = (int)(i & 31);
        const float inv = exp2f(-(float)fi * (13.287712379549449f / 32.f)); const float ang = (float)pos * inv;
        float rev = ang * 0.15915494309189535f; rev -= floorf(rev);
        ((float*)(ws + WS_ROPE))[i] = __builtin_amdgcn_cosf(rev); ((float*)(ws + WS_ROPE))[8192 + i] = __builtin_amdgcn_sinf(rev); }
}


__device__ __forceinline__ void quant_transpose_item(const float* W, int ldw, signed char* WT, const unsigned* wmaxw, LAS float* scr, int kb, int nb, int lane) {
    const int k0 = 64 * kb, n0 = 32 * nb;
#pragma unroll 8
    for (int i = 0; i < 32; ++i) { const int kk = 2 * i + (lane >> 5); scr[kk * 33 + (lane & 31)] = W[(size_t)(k0 + kk) * ldw + n0 + (lane & 31)]; }
    LDS_WAIT(); asm volatile("" ::: "memory");
    const int n = lane >> 1, hf = lane & 1;
    const float mx = __uint_as_float(wmaxw[n0 + n]), inv = mx > 0.f ? 127.f / mx : 0.f;
    u32x4 o[2];
#pragma unroll
    for (int q = 0; q < 8; ++q) { unsigned w = 0u;
#pragma unroll
        for (int b = 0; b < 4; ++b) { const int kk = 32 * hf + 4 * q + b; w |= ((unsigned)(int)rintf(scr[kk * 33 + n] * inv) & 255u) << (8 * b); }
        o[q >> 2][q & 3] = w; }
    u32x4* dst = (u32x4*)(WT + (size_t)(n0 + n) * 1024 + k0 + 32 * hf);
    dst[0] = o[0]; dst[1] = o[1];
    LDS_WAIT(); asm volatile("" ::: "memory");
}
__device__ __forceinline__ void phase_quant_weights(LAS unsigned char* lds) {
    const KArgs ap = get_args();
#define a (*ap)
    const int tid = fresh_tid(), lane = tid & 63, wave = __builtin_amdgcn_readfirstlane(tid >> 6), G = fresh_g(), bx = fresh_bx();
    unsigned char* ws = a.ws;
    LAS float* scr = (LAS float*)(lds + 65536 + wave * 8448);
    const unsigned* wmaxw = (const unsigned*)(ws + WS_CTL) + CW_WMAX;
    constexpr int I_IN = 16 * 96, I_OUT = 16 * 32, I_Q = 16 * 64, PER_L = I_IN + I_OUT + I_Q;
    for (int it = bx * 8 + wave; it < DEPTH * PER_L; it += G * 8) { const int l = it / PER_L; int r = it % PER_L;
        if (r < I_IN) quant_transpose_item(a.in[I_WIN] + (size_t)l * 1024 * NIN, NIN, (signed char*)(ws + WS_WINT) + (size_t)l * NP * 1024, wmaxw + (l * 3 + 0) * 3072, scr, r / 96, r % 96, lane);
        else if (r < I_IN + I_OUT) { r -= I_IN; quant_transpose_item(a.in[I_WOUT] + (size_t)l * 1024 * 1024, 1024, (signed char*)(ws + WS_WOUTT) + (size_t)l * 1024 * 1024, wmaxw + (l * 3 + 1) * 3072, scr, r / 32, r % 32, lane); }
        else { r -= I_IN + I_OUT; quant_transpose_item(a.in[I_WQ] + (size_t)l * 1024 * 2048, 2048, (signed char*)(ws + WS_WQT) + (size_t)l * 2048 * 1024, wmaxw + (l * 3 + 2) * 3072, scr, r / 64, r % 64, lane); } }
#undef a
}

template <bool SK>
__device__ __forceinline__ void phase_norm(int l, int which, LAS unsigned char* lds) {
    const KArgs ap = get_args();
#define a (*ap)

    const int tid = fresh_tid(), lane = tid & 63, wave = __builtin_amdgcn_readfirstlane(tid >> 6), G = fresh_g(), bx = fresh_bx();
    unsigned char* ws = a.ws;
    LAS float* wsk = (LAS float*)lds;
    if (SK) { const float* src = (const float*)(ws + WS_WSK) + (size_t)l * 16384; for (int i = tid; i < 16384 / 4; i += 512) ((LAS f32x4*)wsk)[i] = ((const f32x4*)src)[i]; __syncthreads(); }
    const int nrows = (which == 1 && l == DEPTH - 1) ? ML : M;
    const float* nw = a.in[which ? I_N2W : I_N1W] + l * 1024;
    const float* modl = (const float*)(ws + WS_MOD) + (size_t)l * 3 * 6144;
    const int shoff = which ? 3072 : 0, scoff = which ? 4096 : 1024;
    f32x4 nwv[4];
#pragma unroll
    for (int j = 0; j < 4; ++j) nwv[j] = *(const f32x4*)(nw + 4 * lane + 256 * j);
    for (int row = wave * G + bx; row < nrows; row += G * 8) {
        const float* src; int mrow;
        if (row < ML) { src = ((l == 0 && which == 0) ? a.in[I_X] : a.out) + (size_t)row * D; mrow = row >= T ? 1 : 0; }
        else { src = ((l == 0 && which == 0) ? a.in[I_CTX] : (const float*)(ws + WS_CTXX)) + (size_t)(row - ML) * D; mrow = 2; }
        const float* md = modl + mrow * 6144;
        f32x4 v[4]; float ss = 0.f;
#pragma unroll
        for (int j = 0; j < 4; ++j) { v[j] = *(const f32x4*)(src + 4 * lane + 256 * j); ss += (v[j][0] * v[j][0] + v[j][1] * v[j][1]) + (v[j][2] * v[j][2] + v[j][3] * v[j][3]); }
        const float rstd = rsqrtf(wave_sum(ss) * (1.f / D) + EPS);
        signed char* hrow = (signed char*)(ws + WS_H) + (size_t)row * D;
        float hmx = 0.f;
#pragma unroll
        for (int j = 0; j < 4; ++j) { const f32x4 sc = *(const f32x4*)(md + scoff + 4 * lane + 256 * j), sh = *(const f32x4*)(md + shoff + 4 * lane + 256 * j);
            v[j] = v[j] * rstd * nwv[j] * (sc + 1.f) + sh; hmx = fmaxf(hmx, fmaxf(fmaxf(fabsf(v[j][0]), fabsf(v[j][1])), fmaxf(fabsf(v[j][2]), fabsf(v[j][3])))); }
        hmx = fmaxf(wave_max(hmx), 1e-30f);
        { const float hinv = 127.f / hmx;
#pragma unroll
          for (int j = 0; j < 4; ++j) *(unsigned*)(hrow + 4 * lane + 256 * j) = ((unsigned)(int)rintf(v[j][0] * hinv) & 255u) | (((unsigned)(int)rintf(v[j][1] * hinv) & 255u) << 8) | (((unsigned)(int)rintf(v[j][2] * hinv) & 255u) << 16) | (((unsigned)(int)rintf(v[j][3] * hinv) & 255u) << 24);
          if (lane == 0) ((float*)(ws + WS_GB))[row] = hmx * (1.f / 127.f); }
        if (SK) {
            float p[16];
#pragma unroll
            for (int c = 0; c < 16; ++c) { float q = 0.f;
#pragma unroll
                for (int j = 0; j < 4; ++j) { const f32x4 w = *(const LAS f32x4*)(wsk + c * 1024 + 4 * lane + 256 * j); q += (v[j][0] * w[0] + v[j][1] * w[1]) + (v[j][2] * w[2] + v[j][3] * w[3]); }
                p[c] = q; }
            { const bool hb = (lane & 32) != 0;
#pragma unroll
              for (int c = 0; c < 8; ++c) { const float keep = hb ? p[c + 8] : p[c], send = hb ? p[c] : p[c + 8]; p[c] = keep + lane_xor<32>(send); } }
            { const bool hb = (lane & 16) != 0;
#pragma unroll
              for (int c = 0; c < 4; ++c) { const float keep = hb ? p[c + 4] : p[c], send = hb ? p[c] : p[c + 4]; p[c] = keep + lane_xor<16>(send); } }
            { const bool hb = (lane & 8) != 0;
#pragma unroll
              for (int c = 0; c < 2; ++c) { const float keep = hb ? p[c + 2] : p[c], send = hb ? p[c] : p[c + 2]; p[c] = keep + lane_xor<8>(send); } }
            { const bool hb = (lane & 4) != 0; const float keep = hb ? p[1] : p[0], send = hb ? p[0] : p[1]; p[0] = keep + lane_xor<4>(send); }
            p[0] += lane_xor<2>(p[0]); p[0] += lane_xor<1>(p[0]);
            if ((lane & 3) == 0) { const int c = ((lane >> 5) & 1) * 8 + ((lane >> 4) & 1) * 4 + ((lane >> 3) & 1) * 2 + ((lane >> 2) & 1); ((float*)(ws + WS_BA))[(size_t)row * 16 + c] = p[0]; }
        }
    }
    if (SK) __syncthreads();
}

__device__ __forceinline__ void phase_prep(int l, LAS unsigned char* lds) {
    const KArgs ap = get_args();
#define a (*ap)

    const int tid = fresh_tid(), lane = tid & 63, wave = __builtin_amdgcn_readfirstlane(tid >> 6), G = fresh_g(), bx = fresh_bx();
    unsigned char* ws = a.ws;
    const bf16_t* P = (const bf16_t*)(ws + WS_P);
    const float* ropec = (const float*)(ws + WS_ROPE); const float* ropes = ropec + 8192;
    const int sec = lane >> 5, fi = lane & 31;
    const float qw0 = a.in[I_QNW][l * 128 + sec * 64 + fi], qw1 = a.in[I_QNW][l * 128 + sec * 64 + 32 + fi];
    const float kw0 = a.in[I_KNW][l * 128 + sec * 64 + fi], kw1 = a.in[I_KNW][l * 128 + sec * 64 + 32 + fi];
    for (int row = wave * G + bx; row < M; row += G * 8) {
        const bool lat = row < ML;
        int b, tt, tlen; if (lat) { b = row >> 14; tt = row & (T - 1); tlen = T; } else { b = (row - ML) >> 8; tt = (row - ML) & (CT - 1); tlen = CT; }
        const bf16_t* prow = P + (size_t)row * NP;
        unsigned short xa[6][2];
#pragma unroll
        for (int hh = 0; hh < 6; ++hh) { const bf16_t* xp = prow + (hh < 4 ? hh * 128 : 512 + (hh - 4) * 128) + sec * 64 + fi; xa[hh][0] = xp[0]; xa[hh][1] = xp[32]; }
        const u32x2 vcp = *(const u32x2*)(prow + 768 + 4 * lane);
        float cs = 1.f, sn = 0.f;
        if (lat) { const int pos = sec ? (tt & 63) : (tt >> 6); cs = ropec[pos * 32 + fi]; sn = ropes[pos * 32 + fi]; }
        unsigned char* qo8 = ws + WS_QA + (size_t)row * 512;
        const size_t kvrow = (size_t)b * KVLEN + (lat ? tt : T + tt);
        unsigned char* ko8 = ws + WS_KA + kvrow * 256;
        float ssq[6];
#pragma unroll
        for (int hh = 0; hh < 6; ++hh) { const float x0 = bf2f(xa[hh][0]), x1 = bf2f(xa[hh][1]); ssq[hh] = x0 * x0 + x1 * x1; }
#pragma unroll
        for (int hh = 0; hh < 6; ++hh) ssq[hh] = wave_sum(ssq[hh]);
#pragma unroll
        for (int hh = 0; hh < 6; ++hh) {
            const float x0 = bf2f(xa[hh][0]), x1 = bf2f(xa[hh][1]);
            const float rs = rsqrtf(ssq[hh] * (1.f / 128.f) + EPS);
            const float y0 = x0 * rs * (hh < 4 ? qw0 : kw0), y1 = x1 * rs * (hh < 4 ? qw1 : kw1);
            const float qsc = hh < 4 ? 0.088388347648318440f * 1.4426950408889634f : 1.f;
            const float o0 = (y0 * cs - y1 * sn) * qsc, o1 = (y1 * cs + y0 * sn) * qsc;
            unsigned char* op8 = (hh < 4 ? qo8 + hh * 128 : ko8 + (hh - 4) * 128) + sec * 64 + fi;
            const float f8s = hh < 4 ? 8.f : 1.f;
            const int pk8 = __builtin_amdgcn_cvt_pk_fp8_f32(o0 * f8s, o1 * f8s, 0, false);
            op8[0] = (unsigned char)(pk8 & 255); op8[32] = (unsigned char)((pk8 >> 8) & 255);
        }
        { const int pos = lat ? tt : T + tt, tile = pos >> 6, k64 = pos & 63, k32 = k64 & 31;
          const int bytepos = 32 * ((k32 >> 2) & 1) + 16 * (k64 >> 5) + (k32 & 3) + 4 * (k32 >> 3);
          unsigned char* vt = ws + WS_VA + ((size_t)(b * 2) * (KVLEN / 64) + tile) * 8192 + bytepos;
          const unsigned short* vsrc = (const unsigned short*)&vcp;
          const int kvh_ = lane >> 5, d0 = (4 * lane) & 127;
          const int pk01 = __builtin_amdgcn_cvt_pk_fp8_f32(bf2f(vsrc[0]), bf2f(vsrc[1]), 0, false), pk23 = __builtin_amdgcn_cvt_pk_fp8_f32(bf2f(vsrc[2]), bf2f(vsrc[3]), 0, false);
          unsigned char* vt2 = vt + (size_t)kvh_ * (KVLEN / 64) * 8192 + (size_t)d0 * 64;
          vt2[0] = (unsigned char)(pk01 & 255); vt2[64] = (unsigned char)((pk01 >> 8) & 255); vt2[128] = (unsigned char)(pk23 & 255); vt2[192] = (unsigned char)((pk23 >> 8) & 255); }
    }
    __syncthreads();
}

constexpr int ATT_PARTS = 4;
__device__ __forceinline__ void phase_attn(int l, unsigned char* lds_raw, volatile LAS unsigned* MISC, int rep) {
    const KArgs ap = get_args();
#define a (*ap)
    unsigned char* ws = a.ws;
    const unsigned char* QA = ws + WS_QA; const unsigned char* KA = ws + WS_KA; const unsigned char* VT = ws + WS_VA;
    bf16_t* CAT = (bf16_t*)(ws + WS_CAT); float* LSE = (float*)(ws + WS_BA);
    unsigned* ctr = (unsigned*)(ws + WS_CTL) + 8192 + 64 * l + 1024 * rep;
    const int natt = 2048 + (l < DEPTH - 1 ? 8 : 0);
    constexpr int CONV_ROWS = 64, NCONV = 2 * NEXP / CONV_ROWS;
    const int nunits = natt + (l + 1 < DEPTH ? NCONV : 0);
    float braw;
    { const int ln = threadIdx.x & 63; float mq = fmaxf(fabsf(a.in[I_QNW][l * 128 + ln]), fabsf(a.in[I_QNW][l * 128 + 64 + ln])), mk = fmaxf(fabsf(a.in[I_KNW][l * 128 + ln]), fabsf(a.in[I_KNW][l * 128 + 64 + ln]));
      mq = wave_max(mq); mk = wave_max(mk);
      braw = __builtin_bit_cast(float, __builtin_amdgcn_readfirstlane(__builtin_bit_cast(int, 128.f * mq * mk))); }
    if (threadIdx.x == 0) MISC[12] = __hip_atomic_fetch_add(ctr, 1u, __ATOMIC_RELAXED, __HIP_MEMORY_SCOPE_AGENT);
    __syncthreads();
    int u = (int)MISC[12], par = 0;
    for (; u < nunits; ) {
        if (threadIdx.x == 0) MISC[13 - par] = __hip_atomic_fetch_add(ctr, 1u, __ATOMIC_RELAXED, __HIP_MEMORY_SCOPE_AGENT);
        if (u >= natt) {
            const int tq_ = fresh_tid();
            const int rwb = (u - natt) * CONV_ROWS + __builtin_amdgcn_readfirstlane(tq_ >> 6) * 8;
            convert_tables(a.in[I_U], a.in[I_V], ws, l + 1, rwb, 1, tq_ & 63, rwb + 8);
            __syncthreads();
            u = (int)MISC[13 - par]; par ^= 1;
            continue;
        }
        size_t r0, kv0; int h, kvh, seq, ldo; bf16_t* ob; float* lse;
        if (u < 2048) { const int qb = u & 63, g = (u >> 6) & 1, part = (u >> 7) & 3, b = u >> 10; kvh = (u >> 9) & 1; h = kvh * 2 + g;
            const int t0 = (part >> 1) * 130 + (part & 1) * 64;
            r0 = (size_t)b * T + (size_t)qb * 256; kv0 = (size_t)b * KVLEN + (size_t)t0 * 64; seq = ((part & 1) ? 66 : 64) * 64;
            ob = part ? (bf16_t*)(ws + (part == 1 ? WS_DQ : part == 2 ? WS_DK : WS_DV)) + r0 * 512 + h * 128 : CAT + r0 * 1024 + h * 128; ldo = part ? 512 : 1024; lse = LSE + ((size_t)part * ML + r0) * 4 + h; }
        else { const int b = (u - 2048) >> 2; h = (u - 2048) & 3; kvh = h >> 1; r0 = (size_t)ML + (size_t)b * CT; kv0 = (size_t)b * KVLEN + T; seq = CT;
            ob = CAT + r0 * 1024 + h * 128; ldo = 1024; lse = nullptr; }
        att::attn_dense_body(QA + r0 * 512 + h * 128, KA + kv0 * 256 + kvh * 128, VT + ((size_t)((kv0 / KVLEN) * 2 + kvh) * (KVLEN / 64) + (kv0 % KVLEN) / 64) * 8192, ob, ldo, seq, (char*)lds_raw, lse, braw);
        u = (int)MISC[13 - par]; par ^= 1;
    }
#undef a
}

__device__ __forceinline__ int tokperm(int q, int hh, int jj) { return 16 * q + 8 * (jj >> 2) + 4 * hh + (jj & 3); }
__device__ __forceinline__ int crow16(int r, int hi) { return (r & 3) + 8 * (r >> 2) + 4 * hi; }
__device__ __forceinline__ int kperm16(int s_, int g, int jj) { return 32 * s_ + 16 * (jj >> 2) + 4 * g + (jj & 3); }
__device__ __forceinline__ int frag_off(int i, int j) {
    return (((i >> 4) * 2 + (j >> 5)) * 64 + ((i & 15) + 16 * ((j >> 2) & 3))) * 16 + (4 * ((j >> 4) & 1) + (j & 3)) * 2;
}
template <int MODE>
__device__ __forceinline__ void phase_dn_chunkprep(int l, LAS unsigned char* lds) {
    const KArgs ap = get_args();
#define a (*ap)
    const int tid = fresh_tid(), lane = tid & 63, wave = __builtin_amdgcn_readfirstlane(tid >> 6), G = fresh_g(), bx = fresh_bx();
    unsigned char* ws = a.ws;
    constexpr int KT_OFF = 0, QT_OFF = 17408, VT_OFF = 34816, GS_OFF = 52224, RS_OFF = 68864, AM_OFF = 85504, SC_OFF = 120320, IMG_OFF = 0;
    const int r = lane & 31, hh = lane >> 5;
    const bf16_t* DQ = (const bf16_t*)(ws + WS_DQ); const bf16_t* DK = (const bf16_t*)(ws + WS_DK); const bf16_t* DV = (const bf16_t*)(ws + WS_DV);
    const float* BA = (const float*)(ws + WS_BA);
    constexpr int NTASK = MODE ? NB * 4 * 4 : NB * 4 * (NCH - 4);
#define CP_TASKID(t_) (MODE ? ((t_) >> 2) * NCH + ((t_) & 3) : ((t_) >> 8) * NCH + 4 + ((t_) & 255))
    LAS float* gsc = (LAS float*)(lds + SC_OFF);
    LAS float* bsc = gsc + 128;
    LAS float* gcs = gsc + 256;
    constexpr int CW_OFF = 121856, DI_OFF = CW_OFF + 5 * 1536 * 4;
    static_assert(DI_OFF + 8192 <= LDS_MISC, "chunkprep LDS");
    LAS float* cwl = (LAS float*)(lds + CW_OFF);
    for (int i = tid; i < 5 * 1536; i += 512) cwl[i] = a.in[I_CONVW][(size_t)l * 5 * 1536 + i];
    __syncthreads();
    const bf16_t* P = (const bf16_t*)(ws + WS_P);
    u32x4 xin[3][5][2];
#define CP_LOADX(task_) do { const int cidx_ = (task_) % NCH, bh_ = (task_) / NCH, b_ = bh_ >> 2, h_ = bh_ & 3; \
        const int row0_ = cidx_ < 4 ? ML + b_ * CT + cidx_ * 64 : b_ * T + (cidx_ - 4) * 64, tt_ = (cidx_ < 4 ? cidx_ * 64 : (cidx_ - 4) * 64) + (tid >> 3), tlen_ = cidx_ < 4 ? CT : T; \
        _Pragma("unroll") for (int j = 0; j < 5; ++j) { const int t2 = tt_ + j - 2; const bool ok = t2 >= 0 && t2 < tlen_; \
            const bf16_t* xr = P + (size_t)(row0_ + (tid >> 3) + (ok ? j - 2 : 0)) * NP + 1024 + h_ * 128 + (tid & 7) * 16; \
            _Pragma("unroll") for (int m = 0; m < 3; ++m) { const u32x4 w0 = *(const u32x4*)(xr + m * 512), w1 = *(const u32x4*)(xr + m * 512 + 8); \
                xin[m][j][0] = ok ? w0 : (u32x4){0u, 0u, 0u, 0u}; xin[m][j][1] = ok ? w1 : (u32x4){0u, 0u, 0u, 0u}; } } } while (0)
    if (bx < NTASK) CP_LOADX(CP_TASKID(bx));
    for (int tk = bx; tk < NTASK; tk += G) {
        const int task = CP_TASKID(tk);
        const int cidx = task % NCH, bh = task / NCH, b = bh >> 2, h = bh & 3;
        const int row0 = cidx < 4 ? ML + b * CT + cidx * 64 : b * T + (cidx - 4) * 64;
        unsigned char* rec = ws + WS_REC + (size_t)task * REC_BYTES;
        {
            const int rr = tid >> 3, seg = tid & 7;
            if (tid < 128) { const int d = tid >> 6, i = tid & 63, dh = d * 4 + h;
                const float xb = BA[(size_t)(row0 + i) * 16 + dh], z = BA[(size_t)(row0 + i) * 16 + 8 + dh] + a.in[I_DTB][l * 8 + dh];
                bsc[tid] = 1.f / (1.f + __expf(-xb)); gsc[tid] = -__expf(a.in[I_ALOG][l * 8 + dh]) * (fmaxf(z, 0.f) + log1pf(__expf(-fabsf(z)))); }
#pragma unroll
            for (int m = 0; m < 3; ++m) {
                float y[16];
#pragma unroll
                for (int c = 0; c < 16; ++c) y[c] = 0.f;
#pragma unroll
                for (int j = 0; j < 5; ++j) { const LAS float* wp = cwl + j * 1536 + m * 512 + h * 128 + seg * 16;
#pragma unroll
                    for (int q4 = 0; q4 < 4; ++q4) { const f32x4 wv = *(const LAS f32x4*)(wp + 4 * q4); const unsigned u0 = xin[m][j][q4 >> 1][2 * (q4 & 1)], u1 = xin[m][j][q4 >> 1][2 * (q4 & 1) + 1];
                        y[4 * q4 + 0] = fmaf(bflo(u0), wv[0], y[4 * q4 + 0]); y[4 * q4 + 1] = fmaf(bfhi(u0), wv[1], y[4 * q4 + 1]); y[4 * q4 + 2] = fmaf(bflo(u1), wv[2], y[4 * q4 + 2]); y[4 * q4 + 3] = fmaf(bfhi(u1), wv[3], y[4 * q4 + 3]); } }
                float ss = 0.f;
#pragma unroll
                for (int c = 0; c < 16; ++c) { y[c] = silu_f(y[c]); ss = fmaf(y[c], y[c], ss); }
                if (m < 2) { ss += lane_xor<1>(ss); ss += lane_xor<2>(ss); ss += lane_xor<4>(ss);
                    float sc = rsqrtf(ss + EPS); if (m == 0) sc *= 0.088388347648318440f;
#pragma unroll
                    for (int c = 0; c < 16; ++c) y[c] *= sc; }
                u32x4 o0, o1; o0.x = pkbf(y[0], y[1]); o0.y = pkbf(y[2], y[3]); o0.z = pkbf(y[4], y[5]); o0.w = pkbf(y[6], y[7]); o1.x = pkbf(y[8], y[9]); o1.y = pkbf(y[10], y[11]); o1.z = pkbf(y[12], y[13]); o1.w = pkbf(y[14], y[15]);
                LAS unsigned char* dst = lds + (m == 0 ? QT_OFF : m == 1 ? KT_OFF : VT_OFF) + rr * 272 + seg * 32;
                *(LAS u32x4*)dst = o0; *(LAS u32x4*)(dst + 16) = o1;
            }
        }
        __syncthreads();
        {
            const int mat = wave >> 2, ti = (wave >> 1) & 1, tj = wave & 1;
            f32x16 acc = {};
#pragma unroll
            for (int ks = 0; ks < 8; ++ks) {
                const bf16x8 av = *(const LAS bf16x8*)(lds + (mat ? QT_OFF : KT_OFF) + (32 * ti + r) * 272 + (16 * ks + 8 * hh) * 2);
                const bf16x8 bv = *(const LAS bf16x8*)(lds + KT_OFF + (32 * tj + r) * 272 + (16 * ks + 8 * hh) * 2);
                acc = __builtin_amdgcn_mfma_f32_32x32x16_bf16(av, bv, acc, 0, 0, 0);
            }
            LAS float* dst = (LAS float*)(lds + (mat ? RS_OFF : GS_OFF));
#pragma unroll
            for (int i = 0; i < 16; ++i) dst[(32 * ti + crow16(i, hh)) * 65 + 32 * tj + r] = acc[i];
        }
        { const int r16 = lane & 15, g4 = lane >> 4;
#pragma unroll
        for (int t = 0; t < 2; ++t) { const int f = wave * 2 + t, mt = f >> 2, sk = f & 3;
            { const u32x2 lo = *(const LAS u32x2*)(lds + KT_OFF + (16 * mt + r16) * 272 + (32 * sk + 4 * g4) * 2), hi2 = *(const LAS u32x2*)(lds + KT_OFF + (16 * mt + r16) * 272 + (32 * sk + 16 + 4 * g4) * 2);
              *(u32x4*)(rec + REC_K + f * 1024 + lane * 16) = (u32x4){lo.x, lo.y, hi2.x, hi2.y}; }
            { const u32x2 lo = *(const LAS u32x2*)(lds + QT_OFF + (16 * mt + r16) * 272 + (32 * sk + 4 * g4) * 2), hi2 = *(const LAS u32x2*)(lds + QT_OFF + (16 * mt + r16) * 272 + (32 * sk + 16 + 4 * g4) * 2);
              *(u32x4*)(rec + REC_Q + f * 1024 + lane * 16) = (u32x4){lo.x, lo.y, hi2.x, hi2.y}; } }
#pragma unroll
        for (int t = 0; t < 2; ++t) { const int f = wave * 2 + t, mt = f >> 1, sk = f & 1;
            unsigned e[8];
#pragma unroll
            for (int jj = 0; jj < 8; ++jj) e[jj] = *(const LAS unsigned short*)(lds + KT_OFF + kperm16(sk, g4, jj) * 272 + (16 * mt + r16) * 2);
            *(u32x4*)(rec + REC_KT + f * 1024 + lane * 16) = (u32x4){e[0] | (e[1] << 16), e[2] | (e[3] << 16), e[4] | (e[5] << 16), e[6] | (e[7] << 16)}; }
        { const int sl = wave;
            unsigned e[16];
#pragma unroll
            for (int i = 0; i < 16; ++i) e[i] = *(const LAS unsigned short*)(lds + VT_OFF + (16 * (i >> 2) + 4 * g4 + (i & 3)) * 272 + (16 * sl + r16) * 2);
            u32x4* vp = (u32x4*)(rec + REC_V + sl * 2048 + lane * 32);
            vp[0] = (u32x4){e[0] | (e[1] << 16), e[2] | (e[3] << 16), e[4] | (e[5] << 16), e[6] | (e[7] << 16)};
            vp[1] = (u32x4){e[8] | (e[9] << 16), e[10] | (e[11] << 16), e[12] | (e[13] << 16), e[14] | (e[15] << 16)}; }
        }
        if (tk + G < NTASK) CP_LOADX(CP_TASKID(tk + G));
        if (wave < 2) { const int d = wave; float gv = gsc[d * 64 + (d ? 63 - lane : lane)];
            gv += __builtin_bit_cast(float, __builtin_amdgcn_update_dpp(0, __builtin_bit_cast(int, gv), 0x111, 0xF, 0xF, true));
            gv += __builtin_bit_cast(float, __builtin_amdgcn_update_dpp(0, __builtin_bit_cast(int, gv), 0x112, 0xF, 0xF, true));
            gv += __builtin_bit_cast(float, __builtin_amdgcn_update_dpp(0, __builtin_bit_cast(int, gv), 0x114, 0xF, 0xF, true));
            gv += __builtin_bit_cast(float, __builtin_amdgcn_update_dpp(0, __builtin_bit_cast(int, gv), 0x118, 0xF, 0xF, true));
            { const float t0 = __builtin_bit_cast(float, __builtin_amdgcn_readlane(__builtin_bit_cast(int, gv), 15)), t1 = __builtin_bit_cast(float, __builtin_amdgcn_readlane(__builtin_bit_cast(int, gv), 31)), t2 = __builtin_bit_cast(float, __builtin_amdgcn_readlane(__builtin_bit_cast(int, gv), 47));
              const int rw_ = lane >> 4; gv += (rw_ >= 1 ? t0 : 0.f) + (rw_ >= 2 ? t1 : 0.f) + (rw_ >= 3 ? t2 : 0.f); }
            gcs[d * 64 + lane] = gv; }
        __syncthreads();
        const LAS float* Gs = (const LAS float*)(lds + GS_OFF); const LAS float* Rs = (const LAS float*)(lds + RS_OFF);
#pragma unroll 4
        for (int t = 0; t < 16; ++t) { const int e = tid + 512 * t, d = e >> 12, jp = (e >> 6) & 63, ip = e & 63;
            const int in_ = d ? 63 - ip : ip, jn = d ? 63 - jp : jp;
            const float dec = __expf(fminf(gcs[d * 64 + ip] - gcs[d * 64 + jp], 0.f));
            const float av = (jp < ip) ? bsc[d * 64 + in_] * Gs[in_ * 65 + jn] * dec : 0.f;
            ((LAS float*)(lds + AM_OFF))[d * 4352 + jp * 68 + ip] = av;
            const float qk = (jp <= ip) ? Rs[in_ * 65 + jn] * dec : 0.f;
            *(LAS unsigned short*)(lds + IMG_OFF + d * 16384 + 8192 + frag_off(in_, jn)) = (unsigned short)(pkbf(qk, 0.f) & 0xffffu); }
        __syncthreads();
        { int ln_ = lane; asm volatile("" : "+v"(ln_));
          const int d = wave >> 2, nt = wave & 3, n16 = ln_ & 15, g4 = ln_ >> 4;
          const LAS float* At = (const LAS float*)(lds + AM_OFF) + d * 4352;
          LAS float* Xd = (LAS float*)(lds + GS_OFF) + d * 4096;
          LAS float* Dinv = (LAS float*)(lds + DI_OFF) + d * 1024;
          { float x[16];
#pragma unroll
            for (int q = 0; q < 16; ++q) x[q] = (q == n16) ? 1.f : 0.f;
#pragma unroll
            for (int r2 = 0; r2 < 15; ++r2) { const LAS float* ar = At + (16 * nt + r2) * 68 + 16 * nt; const float xr = x[r2];
#pragma unroll
                for (int q4 = (r2 + 1) / 4; q4 < 4; ++q4) { const f32x4 a4 = *(const LAS f32x4*)(ar + 4 * q4);
#pragma unroll
                    for (int q = 0; q < 4; ++q) if (4 * q4 + q > r2) x[4 * q4 + q] = fmaf(-a4[q], xr, x[4 * q4 + q]); } }
            if (ln_ < 16) {
#pragma unroll
                for (int q = 0; q < 16; ++q) Dinv[nt * 256 + q * 16 + n16] = x[q]; } }
          if (wave == 2 || wave == 3) { const int d2 = wave - 2, ip = d2 ? 63 - lane : lane; const float gl = gcs[d2 * 64 + 63], gi = gcs[d2 * 64 + ip];
            float* sc = (float*)(rec + REC_DIR + d2 * REC_DIRSZ + 16384);
            sc[lane] = __expf(gi); sc[64 + lane] = __expf(gl - gi); if (lane == 0) sc[128] = __expf(gl); }
          __syncthreads();
          const int c = 16 * nt + n16, jn = d ? 63 - c : c; const float bj = bsc[d * 64 + jn];
          const int fj = (jn >> 5) * 1024 + ((jn >> 2) & 3) * 256 + ((jn >> 4) & 1) * 8 + (jn & 3) * 2;
#pragma unroll 1
          for (int B = 0; B < 4; ++B) {
            f32x4 y = {0.f, 0.f, 0.f, 0.f};
            if (nt <= B) {
                f32x4 acc;
#pragma unroll
                for (int r2 = 0; r2 < 4; ++r2) acc[r2] = (nt == B && 4 * g4 + r2 == n16) ? 1.f : 0.f;
#pragma unroll 2
                for (int j0 = 0; j0 < 16 * B; j0 += 4) { const float av = -At[(j0 + g4) * 68 + 16 * B + n16], bv = Xd[(j0 + g4) * 64 + c];
                    acc = __builtin_amdgcn_mfma_f32_16x16x4f32(av, bv, acc, 0, 0, 0); }
#pragma unroll
                for (int r2 = 0; r2 < 4; ++r2) Xd[(16 * B + 4 * g4 + r2) * 64 + c] = acc[r2];
#pragma unroll
                for (int s4 = 0; s4 < 4; ++s4) { const float av = Dinv[B * 256 + n16 * 16 + 4 * s4 + g4], bv = Xd[(16 * B + 4 * s4 + g4) * 64 + c];
                    y = __builtin_amdgcn_mfma_f32_16x16x4f32(av, bv, y, 0, 0, 0); }
            }
#pragma unroll
            for (int r2 = 0; r2 < 4; ++r2) { const int i = 16 * B + 4 * g4 + r2, in_ = d ? 63 - i : i; Xd[i * 64 + c] = y[r2];
                *(LAS unsigned short*)(lds + IMG_OFF + d * 16384 + (in_ >> 4) * 2048 + (in_ & 15) * 16 + fj) = (unsigned short)(pkbf_c(y[r2] * bj, 0.f) & 0xffffu); }
            __syncthreads();
          }
        }
#pragma unroll
        for (int t = 0; t < 4; ++t) { const int p = tid + 512 * t, d = p >> 10, off = (p & 1023) * 16;
            *(u32x4*)(rec + REC_DIR + d * REC_DIRSZ + off) = *(const LAS u32x4*)(lds + IMG_OFF + d * 16384 + off); }
        __syncthreads();
    }
#undef CP_LOADX
#undef CP_TASKID
#undef a
}

__device__ __forceinline__ bf16x8 pack44(const f32x4& lo, const f32x4& hi) {
    u32x4 p; p.x = pkbf_c(lo[0], lo[1]); p.y = pkbf_c(lo[2], lo[3]); p.z = pkbf_c(hi[0], hi[1]); p.w = pkbf_c(hi[2], hi[3]);
    return __builtin_bit_cast(bf16x8, p);
}
template <int VAR>
__device__ __forceinline__ void phase_dn_scan(int l, LAS unsigned char* lds) {
    const KArgs ap = get_args();
#define a (*ap)
    const int tid = fresh_tid(), lane = tid & 63, wave = __builtin_amdgcn_readfirstlane(tid >> 6), bx = fresh_bx();
    unsigned char* ws = a.ws;
    if (bx >= 32) return;
    const int chain = bx >> 1, half = bx & 1, b = chain >> 3, h = (chain >> 1) & 3, dir = chain & 1;
    const unsigned char* recb = ws + WS_REC + (size_t)((b * 4 + h) * NCH) * REC_BYTES;
    constexpr int BUFSZ = 74752;
#define CIDX(n) (dir ? ((n) < 4 ? 3 - (n) : 263 - (n)) : (n))
    if (wave >= 4) {
        const int sw = wave - 4;
#define DN_PIECE(i_) ((sw + 4 * (i_)) < 73 ? (sw + 4 * (i_)) : 72)
#define DN_SRC(rec_, p_) ((p_) < 48 ? (rec_) + (p_) * 1024 : (p_) < 65 ? (rec_) + REC_DIR + dir * REC_DIRSZ + ((p_) - 48) * 1024 : (rec_) + REC_V + half * 8192 + ((p_) - 65) * 1024)
#define DN_STAGE(n, bi) do { const unsigned char* rec_ = recb + (size_t)CIDX(n) * REC_BYTES; _Pragma("unroll") for (int i_ = 0; i_ < 19; ++i_) { const int p_ = DN_PIECE(i_); \
        __builtin_amdgcn_global_load_lds((const unsigned*)(DN_SRC(rec_, p_) + lane * 16), (LAS unsigned*)(lds + (bi) * BUFSZ + p_ * 1024), 16, 0, 0); } } while (0)
#define DN_SYNC() do { asm volatile("s_waitcnt vmcnt(0)" ::: "memory"); __builtin_amdgcn_s_barrier(); asm volatile("" ::: "memory"); } while (0)
        if (VAR != 3) DN_STAGE(0, 0);
        DN_SYNC();
        for (int n = 0; n < NCH; ++n) {
            if (VAR != 3 && n + 1 < NCH) DN_STAGE(n + 1, (n + 1) & 1);
            DN_SYNC();
        }
#undef DN_STAGE
#undef DN_PIECE
#undef DN_SRC
#undef DN_SYNC
    } else {
        const int sl = half * 4 + wave, c16 = lane & 15, g4 = lane >> 4;
        float* Og = (float*)(ws + (dir ? WS_OB : WS_OF)) + h * 128 + sl * 16 + c16;
        f32x4 S[8];
#pragma unroll
        for (int i = 0; i < 8; ++i) S[i] = (f32x4){0.f, 0.f, 0.f, 0.f};
        asm volatile("s_waitcnt lgkmcnt(0)" ::: "memory"); __builtin_amdgcn_s_barrier(); asm volatile("" ::: "memory");
        for (int n = 0; n < NCH; ++n) {
            if (VAR == 2) { asm volatile("s_waitcnt lgkmcnt(0)" ::: "memory"); __builtin_amdgcn_s_barrier(); asm volatile("" ::: "memory"); continue; }
            const LAS unsigned char* buf = lds + (n & 1) * BUFSZ;
            const int cidx = CIDX(n);
            const u32x4 vc0 = *(const LAS u32x4*)(buf + 66560 + wave * 2048 + lane * 32), vc1 = *(const LAS u32x4*)(buf + 66560 + wave * 2048 + lane * 32 + 16);
#define FR(off, f) (*(const LAS bf16x8*)(buf + (off) + (f) * 1024 + lane * 16))
#define MF(A, B, C) __builtin_amdgcn_mfma_f32_16x16x32_bf16((A), (B), (C), 0, 0, 0)
#define SB_() __builtin_amdgcn_sched_barrier(0)
            bf16x8 fa[8], fb[8];
            f32x4 eg[4], dl[4];
#pragma unroll
            for (int mt = 0; mt < 4; ++mt) { eg[mt] = *(const LAS f32x4*)(buf + 65536 + (16 * mt + 4 * g4) * 4); dl[mt] = *(const LAS f32x4*)(buf + 65536 + 256 + (16 * mt + 4 * g4) * 4); }
            const float egl = *(const LAS float*)(buf + 65536 + 512);
#define RD_KQ(dst, q) do { _Pragma("unroll") for (int mt = 0; mt < 4; ++mt) { dst[mt] = FR(0, mt * 4 + (q)); dst[4 + mt] = FR(32768, mt * 4 + (q)); } } while (0)
#define MM_KQ(src, q) do { _Pragma("unroll") for (int mt = 0; mt < 4; ++mt) { X[mt] = MF(src[mt], Sb[q], X[mt]); O[mt] = MF(src[4 + mt], Sb[q], O[mt]); } } while (0)
            f32x4 X[4], O[4], VN[4];
#pragma unroll
            for (int i = 0; i < 4; ++i) { X[i] = (f32x4){0.f, 0.f, 0.f, 0.f}; O[i] = (f32x4){0.f, 0.f, 0.f, 0.f}; VN[i] = (f32x4){0.f, 0.f, 0.f, 0.f}; }
            bf16x8 Sb[4];
#pragma unroll
            for (int q = 0; q < 4; ++q) Sb[q] = pack44(S[2 * q], S[2 * q + 1]);
            RD_KQ(fa, 0); SB_();
            RD_KQ(fb, 1); SB_(); MM_KQ(fa, 0); SB_();
            RD_KQ(fa, 2); SB_(); MM_KQ(fb, 1); SB_();
            RD_KQ(fb, 3); SB_(); MM_KQ(fa, 2); SB_();
#pragma unroll
            for (int i = 0; i < 8; ++i) fa[i] = FR(49152, i);
            SB_(); MM_KQ(fb, 3); SB_();
#pragma unroll
            for (int mt = 0; mt < 4; ++mt) { const unsigned w0 = (mt < 2 ? vc0 : vc1)[2 * (mt & 1)], w1 = (mt < 2 ? vc0 : vc1)[2 * (mt & 1) + 1];
                X[mt][0] = bflo(w0) - eg[mt][0] * X[mt][0]; X[mt][1] = bfhi(w0) - eg[mt][1] * X[mt][1]; X[mt][2] = bflo(w1) - eg[mt][2] * X[mt][2]; X[mt][3] = bfhi(w1) - eg[mt][3] * X[mt][3]; }
            const bf16x8 Yb0 = pack44(X[0], X[1]), Yb1 = pack44(X[2], X[3]);
            SB_();
#pragma unroll
            for (int i = 0; i < 8; ++i) fb[i] = FR(57344, i);
            SB_();
#pragma unroll
            for (int mt = 0; mt < 4; ++mt) { VN[mt] = MF(fa[mt * 2], Yb0, VN[mt]); VN[mt] = MF(fa[mt * 2 + 1], Yb1, VN[mt]); }
            SB_();
#pragma unroll
            for (int mt = 0; mt < 4; ++mt) O[mt] = O[mt] * eg[mt];
            const bf16x8 Vb0 = pack44(VN[0], VN[1]), Vb1 = pack44(VN[2], VN[3]);
            SB_();
#pragma unroll
            for (int i = 0; i < 8; ++i) fa[i] = FR(16384, i);
            SB_();
#pragma unroll
            for (int mt = 0; mt < 4; ++mt) { O[mt] = MF(fb[mt * 2], Vb0, O[mt]); O[mt] = MF(fb[mt * 2 + 1], Vb1, O[mt]); }
            SB_();
#pragma unroll
            for (int mt = 0; mt < 4; ++mt) VN[mt] = VN[mt] * dl[mt];
            const bf16x8 Vd0 = pack44(VN[0], VN[1]), Vd1 = pack44(VN[2], VN[3]);
#pragma unroll
            for (int i = 0; i < 8; ++i) S[i] = S[i] * egl;
            SB_();
#pragma unroll
            for (int i = 0; i < 8; ++i) fb[i] = FR(16384, 8 + i);
            SB_();
#pragma unroll
            for (int i = 0; i < 4; ++i) { S[i] = MF(fa[i * 2], Vd0, S[i]); S[i] = MF(fa[i * 2 + 1], Vd1, S[i]); }
            SB_();
#pragma unroll
            for (int i = 0; i < 4; ++i) { S[4 + i] = MF(fb[i * 2], Vd0, S[4 + i]); S[4 + i] = MF(fb[i * 2 + 1], Vd1, S[4 + i]); }
            SB_();
            {
                const int row0 = cidx < 4 ? ML + b * CT + cidx * 64 : b * T + (cidx - 4) * 64;
                float* op = Og + (size_t)(row0 + 4 * g4) * 512;
#pragma unroll
                for (int mt = 0; mt < 4; ++mt)
#pragma unroll
                    for (int t = 0; t < 4; ++t) { if (VAR != 1) op[(size_t)(16 * mt + t) * 512] = O[mt][t]; else asm volatile("" :: "v"(O[mt][t])); }
            }
#undef RD_KQ
#undef MM_KQ
#undef SB_
#undef FR
#undef MF
            asm volatile("s_waitcnt lgkmcnt(0)" ::: "memory"); __builtin_amdgcn_s_barrier(); asm volatile("" ::: "memory");
        }
    }
#undef CIDX
#undef a
}

__device__ __forceinline__ void phase_dn_out(int l) {
    const KArgs ap = get_args();
#define a (*ap)

    const int tid = fresh_tid(), lane = tid & 63, wave = __builtin_amdgcn_readfirstlane(tid >> 6), G = fresh_g(), bx = fresh_bx();
    unsigned char* ws = a.ws;
    const int nrows = (l == DEPTH - 1) ? ML : M;
    const float* OF = (const float*)(ws + WS_OF); const float* OB = (const float*)(ws + WS_OB);
    const bf16_t* P = (const bf16_t*)(ws + WS_P); bf16_t* CAT = (bf16_t*)(ws + WS_CAT);
    const f32x2 nw = *(const f32x2*)(a.in[I_DNW] + l * 128 + 2 * lane);
    const float* LSE = (const float*)(ws + WS_BA);
    for (int row = wave * G + bx; row < nrows; row += G * 8) {
        f32x2 of[4], ob[4]; unsigned gw[4];
#pragma unroll
        for (int hh = 0; hh < 4; ++hh) { of[hh] = *(const f32x2*)(OF + (size_t)row * 512 + hh * 128 + 2 * lane); ob[hh] = *(const f32x2*)(OB + (size_t)row * 512 + hh * 128 + 2 * lane);
            gw[hh] = *(const unsigned*)(P + (size_t)row * NP + 2560 + hh * 128 + 2 * lane); }
        u32x4 ap_[4]; float ls_[4];
#pragma unroll
        for (int p = 0; p < 4; ++p) { ap_[p] = (u32x4){0u, 0u, 0u, 0u}; ls_[p] = 0.f; }
        if (row < ML) {
            ap_[0] = *(const u32x4*)(CAT + (size_t)row * 1024 + 8 * lane); ap_[1] = *(const u32x4*)((const bf16_t*)(ws + WS_DQ) + (size_t)row * 512 + 8 * lane);
            ap_[2] = *(const u32x4*)((const bf16_t*)(ws + WS_DK) + (size_t)row * 512 + 8 * lane); ap_[3] = *(const u32x4*)((const bf16_t*)(ws + WS_DV) + (size_t)row * 512 + 8 * lane);
#pragma unroll
            for (int p = 0; p < 4; ++p) ls_[p] = LSE[((size_t)p * ML + row) * 4 + (lane >> 4)]; }
        float o0[4], o1[4], ssq[4];
#pragma unroll
        for (int hh = 0; hh < 4; ++hh) { o0[hh] = of[hh][0] + ob[hh][0]; o1[hh] = of[hh][1] + ob[hh][1]; ssq[hh] = o0[hh] * o0[hh] + o1[hh] * o1[hh]; }
#pragma unroll
        for (int hh = 0; hh < 4; ++hh) ssq[hh] = wave_sum(ssq[hh]);
        float mxv = 0.f;
#pragma unroll
        for (int hh = 0; hh < 4; ++hh) { const float rs = rsqrtf(ssq[hh] * (1.f / 128.f) + EPS); const float g0 = bflo(gw[hh]), g1 = bfhi(gw[hh]);
            o0[hh] = o0[hh] * rs * nw[0] * silu_f(g0); o1[hh] = o1[hh] * rs * nw[1] * silu_f(g1); mxv = fmaxf(mxv, fmaxf(fabsf(o0[hh]), fabsf(o1[hh]))); }
        float av[8];
        if (row < ML) { const float mx = fmaxf(fmaxf(ls_[0], ls_[1]), fmaxf(ls_[2], ls_[3]));
            float w_[4], wsum = 0.f;
#pragma unroll
            for (int p = 0; p < 4; ++p) { w_[p] = __expf(ls_[p] - mx); wsum += w_[p]; }
            const float inv = 1.f / wsum;
#pragma unroll
            for (int i = 0; i < 4; ++i) { float lo = 0.f, hi2 = 0.f;
#pragma unroll
                for (int p = 0; p < 4; ++p) { lo = fmaf(w_[p], bflo(ap_[p][i]), lo); hi2 = fmaf(w_[p], bfhi(ap_[p][i]), hi2); }
                av[2 * i] = lo * inv; av[2 * i + 1] = hi2 * inv; } }
        else { const u32x4 cw_ = *(const u32x4*)(CAT + (size_t)row * 1024 + 8 * lane);
#pragma unroll
            for (int i = 0; i < 4; ++i) { av[2 * i] = bflo(cw_[i]); av[2 * i + 1] = bfhi(cw_[i]); } }
#pragma unroll
        for (int i = 0; i < 8; ++i) mxv = fmaxf(mxv, fabsf(av[i]));
        mxv = fmaxf(wave_max(mxv), 1e-30f);
        const float cinv = 127.f / mxv;
        signed char* crow = (signed char*)(ws + WS_CATQ) + (size_t)row * 1024;
#define Q8_(x) ((unsigned)(int)rintf((x) * cinv) & 255u)
        { u32x2 o; o.x = Q8_(av[0]) | (Q8_(av[1]) << 8) | (Q8_(av[2]) << 16) | (Q8_(av[3]) << 24); o.y = Q8_(av[4]) | (Q8_(av[5]) << 8) | (Q8_(av[6]) << 16) | (Q8_(av[7]) << 24); *(u32x2*)(crow + 8 * lane) = o; }
#pragma unroll
        for (int hh = 0; hh < 4; ++hh) *(unsigned short*)(crow + 512 + hh * 128 + 2 * lane) = (unsigned short)(Q8_(o0[hh]) | (Q8_(o1[hh]) << 8));
#undef Q8_
        if (lane == 0) ((float*)(ws + WS_GB))[(1u << 18) + row] = mxv * (1.f / 127.f);
    }
#undef a
}

#define CE_DESC(a_, b_) do { const float hi_ = fmaxf(a_, b_), lo_ = fminf(a_, b_); a_ = hi_; b_ = lo_; } while (0)
__device__ __forceinline__ void bitonic_sort16_desc(float (&v)[16]) {
#pragma unroll
    for (int k = 2; k <= 16; k <<= 1)
#pragma unroll
        for (int j = k >> 1; j > 0; j >>= 1)
#pragma unroll
            for (int i = 0; i < 16; ++i) { const int p = i ^ j; if (p > i) { if ((i & k) == 0) CE_DESC(v[i], v[p]); else CE_DESC(v[p], v[i]); } }
}
__device__ __forceinline__ void merge_top16_desc(float (&lst)[16], const float (&nw)[16]) {
#pragma unroll
    for (int i = 0; i < 16; ++i) lst[i] = fmaxf(lst[i], nw[15 - i]);
#pragma unroll
    for (int j = 8; j > 0; j >>= 1)
#pragma unroll
        for (int i = 0; i < 16; ++i) { const int p = i ^ j; if (p > i) CE_DESC(lst[i], lst[p]); }
}
__device__ __forceinline__ void phase_peer_select(int l) {
    const KArgs ap = get_args();
#define a (*ap)
    const int tid = fresh_tid(), lane = tid & 63, wave = __builtin_amdgcn_readfirstlane(tid >> 6), G = fresh_g(), bx = fresh_bx();
    unsigned char* ws = a.ws;
    const int nrows = (l == DEPTH - 1) ? ML : M;
    const int ntask = (nrows / 32) * 4;
    const bf16_t* Q2 = (const bf16_t*)(ws + WS_P);
    const bf16_t* SKB = (const bf16_t*)(ws + WS_SKB) + (size_t)l * 8 * 2 * 128 * 128;
    int* PIDX = (int*)(ws + WS_PIDX); float* PGATE = (float*)(ws + WS_PGATE);
    const float NEG = -3.0e38f;
    const int r = lane & 31, hi = lane >> 5;
    for (int task = wave * G + bx; task < ntask; task += G * 8) {
        const int tg = task >> 2, hp = task & 3; const int row = tg * 32 + r;
        float mine0[16], mine1[16];
#pragma unroll
        for (int j = 0; j < 16; ++j) { mine0[j] = NEG; mine1[j] = NEG; }
        bf16x8 qA[8], kA[8];
        float lst[16];
#define SEL_QPTR(it_) (Q2 + (size_t)row * 2048 + (2 * hp + ((it_) >> 1)) * 256 + ((it_) & 1) * 128 + 8 * hi)
#define SEL_KPTR(it_, t_) (SKB + (size_t)(((2 * hp + ((it_) >> 1)) * 2 + ((it_) & 1)) * 128 + 32 * (t_) + r) * 128 + 8 * hi)
#define SEL_LDQ(dst, it_) do { const bf16_t* qp_ = SEL_QPTR(it_); _Pragma("unroll") for (int ks = 0; ks < 8; ++ks) dst[ks] = *(const bf16x8*)(qp_ + 16 * ks); } while (0)
#define SEL_LDK(dst, it_, t_) do { const bf16_t* kp_ = SEL_KPTR(it_, t_); _Pragma("unroll") for (int ks = 0; ks < 8; ++ks) dst[ks] = *(const bf16x8*)(kp_ + 16 * ks); } while (0)
#define SEL_RANK(qv, kv, t_) do { f32x16 acc = {}; _Pragma("unroll") for (int ks = 0; ks < 8; ++ks) acc = __builtin_amdgcn_mfma_f32_32x32x16_bf16(kv[ks], qv[ks], acc, 0, 0, 0); \
            const unsigned kb = (unsigned)(32 * (t_) + 4 * hi); float nw_[16]; \
            _Pragma("unroll") for (int i = 0; i < 16; ++i) nw_[i] = __uint_as_float((__float_as_uint(acc[i]) & 0xffffff80u) | (kb + (unsigned)((i & 3) + 8 * (i >> 2)))); \
            bitonic_sort16_desc(nw_); merge_top16_desc(lst, nw_); } while (0)
#define SB_() __builtin_amdgcn_sched_barrier(0)
#pragma unroll
        for (int j = 0; j < 16; ++j) lst[j] = NEG;
#pragma unroll 1
        for (int it = 0; it < 4; ++it) {
            SEL_LDQ(qA, it);
#pragma unroll 1
            for (int t = 0; t < 4; ++t) { SEL_LDK(kA, it, t); SEL_RANK(qA, kA, t); }
            float oth[16];
#pragma unroll
            for (int j = 0; j < 16; ++j) { auto rr = __builtin_amdgcn_permlane32_swap(__float_as_uint(lst[j]), __float_as_uint(lst[j]), false, false); oth[j] = __uint_as_float(hi ? rr[0] : rr[1]); }
            merge_top16_desc(lst, oth);
            const bool k0 = ((it >> 1) == hi) && ((it & 1) == 0), k1 = ((it >> 1) == hi) && ((it & 1) == 1);
#pragma unroll
            for (int j = 0; j < 16; ++j) { mine0[j] = k0 ? lst[j] : mine0[j]; mine1[j] = k1 ? lst[j] : mine1[j]; lst[j] = NEG; }
        }
#undef SB_
#undef SEL_QPTR
#undef SEL_KPTR
#undef SEL_LDQ
#undef SEL_LDK
#undef SEL_RANK
        const int h = 2 * hp + hi;
        float ts[16];
#pragma unroll
        for (int j = 0; j < 16; ++j) ts[j] = NEG;
#pragma unroll
        for (int i = 0; i < 16; ++i)
#pragma unroll
            for (int j = 0; j < 16; ++j) if ((i + 1) * (j + 1) <= 16) {
                const unsigned b0 = __float_as_uint(mine0[i]), b1 = __float_as_uint(mine1[j]);
                const float c = __uint_as_float(b0 & 0xffffff80u) + __uint_as_float(b1 & 0xffffff80u);
                float x = __uint_as_float((__float_as_uint(c) & 0xffffc000u) | ((b0 & 127u) << 7) | (b1 & 127u));
#pragma unroll
                for (int t = 0; t < 16; ++t) { const float hv = fmaxf(ts[t], x); x = fminf(ts[t], x); ts[t] = hv; }
            }
        int te[16]; float ex[16], sum = 0.f;
        const float tmax = __uint_as_float(__float_as_uint(ts[0]) & 0xffffc000u);
#pragma unroll
        for (int t = 0; t < 16; ++t) { const unsigned bt = __float_as_uint(ts[t]); te[t] = (int)(bt & 0x3fffu); ex[t] = __expf(__uint_as_float(bt & 0xffffc000u) - tmax); sum += ex[t]; }
        const float inv = 1.f / sum;
        int* ip = PIDX + (size_t)row * 128 + h * 16; float* gp = PGATE + (size_t)row * 128 + h * 16;
#pragma unroll
        for (int t = 0; t < 16; t += 4) { *(u32x4*)(ip + t) = (u32x4){(unsigned)te[t], (unsigned)te[t + 1], (unsigned)te[t + 2], (unsigned)te[t + 3]}; *(f32x4*)(gp + t) = (f32x4){ex[t] * inv, ex[t + 1] * inv, ex[t + 2] * inv, ex[t + 3] * inv}; }
    }
#undef a
}

template <bool WR, int GV = 0>
__device__ __forceinline__ void phase_peer_gather(int l, LAS unsigned char* lds) {
    const KArgs ap = get_args();
#define a (*ap)
    const int tid = fresh_tid(), lane = tid & 63, wave = __builtin_amdgcn_readfirstlane(tid >> 6), G = fresh_g(), bx = fresh_bx();
    unsigned char* ws = a.ws;
    const int nrows = (l == DEPTH - 1) ? ML : M;
    const unsigned char* UB = ws + WS_UB + (size_t)(l & 1) * TAB_SET; const unsigned char* VB = UB + 1024;
    const float* USC = (const float*)(ws + WS_USC) + (l & 1) * 2 * NEXP; const float* VSC = USC + NEXP;
    const int* PIDX = (const int*)(ws + WS_PIDX); const float* PGATE = (const float*)(ws + WS_PGATE);
    const float* modl = (const float*)(ws + WS_MOD) + (size_t)l * 3 * 6144 + 5120;
    const bool fuse = WR && (l + 1 < DEPTH);
    LAS float* wsk = (LAS float*)lds;
    if (fuse) { const float* src = (const float*)(ws + WS_WSK) + (size_t)(l + 1) * 16384; for (int i = tid; i < 16384 / 4; i += 512) ((LAS f32x4*)wsk)[i] = ((const f32x4*)src)[i]; __syncthreads(); }
    const float* nw1 = a.in[I_N1W] + (l + 1 < DEPTH ? l + 1 : l) * 1024 + 16 * lane;
    const float* modn = (const float*)(ws + WS_MOD) + (size_t)(l + 1 < DEPTH ? l + 1 : l) * 3 * 6144;
    for (int row = wave * G + bx; row < nrows; row += G * 8) {
        float hv[16], out[16];
        { const u32x4 hw = *(const u32x4*)((const signed char*)(ws + WS_H) + (size_t)row * D + 16 * lane); const float hsc = ((const float*)(ws + WS_GB))[row];
#pragma unroll
          for (int q = 0; q < 4; ++q) { const int w = (int)hw[q]; hv[4 * q + 0] = (float)((w << 24) >> 24) * hsc; hv[4 * q + 1] = (float)((w << 16) >> 24) * hsc; hv[4 * q + 2] = (float)((w << 8) >> 24) * hsc; hv[4 * q + 3] = (float)(w >> 24) * hsc; } }
        float hs = 0.f;
#pragma unroll
        for (int i = 0; i < 16; ++i) { out[i] = 0.f; hs += hv[i]; }
        const float hsum128 = 128.f * wave_sum(hs);
        float wacc = 0.f;
        const int id0 = PIDX[(size_t)row * 128 + lane], id1 = PIDX[(size_t)row * 128 + 64 + lane];
        const float gt0 = PGATE[(size_t)row * 128 + lane], gt1 = PGATE[(size_t)row * 128 + 64 + lane];
        const float us0 = USC[id0], us1 = USC[id1], vs0 = VSC[id0], vs1 = VSC[id1];
        for (int e0 = 0; e0 < 128; e0 += 8) {
            u32x4 uw[8], vw[8]; float gte[8], use[8], vse[8];
#pragma unroll
            for (int j = 0; j < 8; ++j) { const int e = e0 + j; const int id = __builtin_amdgcn_readlane(e0 < 64 ? id0 : id1, e & 63);
                gte[j] = __builtin_bit_cast(float, __builtin_amdgcn_readlane(__builtin_bit_cast(int, e0 < 64 ? gt0 : gt1), e & 63));
                use[j] = __builtin_bit_cast(float, __builtin_amdgcn_readlane(__builtin_bit_cast(int, e0 < 64 ? us0 : us1), e & 63));
                vse[j] = __builtin_bit_cast(float, __builtin_amdgcn_readlane(__builtin_bit_cast(int, e0 < 64 ? vs0 : vs1), e & 63));
                uw[j] = *(const u32x4*)(UB + (size_t)id * 2048 + 16 * lane); vw[j] = *(const u32x4*)(VB + (size_t)id * 2048 + 16 * lane); }
#pragma unroll
            for (int j = 0; j < 8; ++j) {
                float d0 = 0.f, d1 = 0.f;
#pragma unroll
                for (int q = 0; q < 4; ++q) { const unsigned w = uw[j][q];
                    d0 = fmaf((float)(w & 255u), hv[4 * q + 0], d0); d1 = fmaf((float)((w >> 8) & 255u), hv[4 * q + 1], d1);
                    d0 = fmaf((float)((w >> 16) & 255u), hv[4 * q + 2], d0); d1 = fmaf((float)(w >> 24), hv[4 * q + 3], d1); }
                const float dsum = (wave_sum(d0 + d1) - hsum128) * use[j];
                const float act = 0.5f * dsum * (1.f + erff(dsum * 0.70710678118654752f));
                const float wgt = gte[j] * act * vse[j];
                wacc += wgt;
                if (GV == 1) { asm volatile("" :: "v"(vw[j])); out[0] += wgt; } else
#pragma unroll
                for (int q = 0; q < 4; ++q) { const unsigned w = vw[j][q];
                    out[4 * q + 0] = fmaf(wgt, (float)(w & 255u), out[4 * q + 0]); out[4 * q + 1] = fmaf(wgt, (float)((w >> 8) & 255u), out[4 * q + 1]);
                    out[4 * q + 2] = fmaf(wgt, (float)((w >> 16) & 255u), out[4 * q + 2]); out[4 * q + 3] = fmaf(wgt, (float)(w >> 24), out[4 * q + 3]); }
            }
        }
        const float corr = 128.f * wacc;
        float* xr; int mrow;
        if (row < ML) { xr = a.out + (size_t)row * D; mrow = row >= T ? 1 : 0; } else { xr = (float*)(ws + WS_CTXX) + (size_t)(row - ML) * D; mrow = 2; }
        const float* g2 = modl + mrow * 6144 + 16 * lane;
        f32x4 xn[4];
#pragma unroll
        for (int i = 0; i < 4; ++i) { const f32x4 x = *(const f32x4*)(xr + 16 * lane + 4 * i), g = *(const f32x4*)(g2 + 4 * i);
            xn[i] = x + g * (f32x4){out[4 * i] - corr, out[4 * i + 1] - corr, out[4 * i + 2] - corr, out[4 * i + 3] - corr};
            if (WR) *(f32x4*)(xr + 16 * lane + 4 * i) = xn[i]; else asm volatile("" :: "v"(xn[i])); }
        if (fuse) {
            float ss = 0.f;
#pragma unroll
            for (int i = 0; i < 4; ++i) ss += (xn[i][0] * xn[i][0] + xn[i][1] * xn[i][1]) + (xn[i][2] * xn[i][2] + xn[i][3] * xn[i][3]);
            const float rstd = rsqrtf(wave_sum(ss) * (1.f / D) + EPS);
            const float* md = modn + mrow * 6144 + 16 * lane;
#pragma unroll
            for (int i = 0; i < 4; ++i) { const f32x4 nwv = *(const f32x4*)(nw1 + 4 * i), sc = *(const f32x4*)(md + 1024 + 4 * i), sh = *(const f32x4*)(md + 4 * i);
                xn[i] = xn[i] * rstd * nwv * (sc + 1.f) + sh; }
            { float hmx = 0.f;
#pragma unroll
              for (int i = 0; i < 4; ++i) hmx = fmaxf(hmx, fmaxf(fmaxf(fabsf(xn[i][0]), fabsf(xn[i][1])), fmaxf(fabsf(xn[i][2]), fabsf(xn[i][3]))));
              hmx = fmaxf(wave_max(hmx), 1e-30f); const float hinv = 127.f / hmx;
              u32x4 o;
#pragma unroll
              for (int i = 0; i < 4; ++i) o[i] = ((unsigned)(int)rintf(xn[i][0] * hinv) & 255u) | (((unsigned)(int)rintf(xn[i][1] * hinv) & 255u) << 8) | (((unsigned)(int)rintf(xn[i][2] * hinv) & 255u) << 16) | (((unsigned)(int)rintf(xn[i][3] * hinv) & 255u) << 24);
              *(u32x4*)((signed char*)(ws + WS_H) + (size_t)row * D + 16 * lane) = o;
              if (lane == 0) ((float*)(ws + WS_GB))[row] = hmx * (1.f / 127.f); }
            float p[16];
#pragma unroll
            for (int c = 0; c < 16; ++c) { float q = 0.f;
#pragma unroll
                for (int i = 0; i < 4; ++i) { const f32x4 w = *(const LAS f32x4*)(wsk + c * 1024 + 16 * lane + 4 * i); q += (xn[i][0] * w[0] + xn[i][1] * w[1]) + (xn[i][2] * w[2] + xn[i][3] * w[3]); }
                p[c] = q; }
            { const bool hb = (lane & 32) != 0;
#pragma unroll
              for (int c = 0; c < 8; ++c) { const float keep = hb ? p[c + 8] : p[c], send = hb ? p[c] : p[c + 8]; p[c] = keep + lane_xor<32>(send); } }
            { const bool hb = (lane & 16) != 0;
#pragma unroll
              for (int c = 0; c < 4; ++c) { const float keep = hb ? p[c + 4] : p[c], send = hb ? p[c] : p[c + 4]; p[c] = keep + lane_xor<16>(send); } }
            { const bool hb = (lane & 8) != 0;
#pragma unroll
              for (int c = 0; c < 2; ++c) { const float keep = hb ? p[c + 2] : p[c], send = hb ? p[c] : p[c + 2]; p[c] = keep + lane_xor<8>(send); } }
            { const bool hb = (lane & 4) != 0; const float keep = hb ? p[1] : p[0], send = hb ? p[0] : p[1]; p[0] = keep + lane_xor<4>(send); }
            p[0] += lane_xor<2>(p[0]); p[0] += lane_xor<1>(p[0]);
            if ((lane & 3) == 0) { const int c = ((lane >> 5) & 1) * 8 + ((lane >> 4) & 1) * 4 + ((lane >> 3) & 1) * 2 + ((lane >> 2) & 1); ((float*)(ws + WS_BA))[(size_t)row * 16 + c] = p[0]; }
        }
    }
    if (fuse) __syncthreads();
}
#undef a
constexpr size_t WS_PART = WS_P;
static_assert(WS_PART + 8 * (size_t)M * 1024 * 2 <= WS_GB, "partials region");
constexpr int GP_ITEM = 16;
struct GpMeta { int id0, id1; float gt0, gt1; u32x4 hw; float hsc; };
__device__ __forceinline__ void phase_peer_gpart(int l, LAS unsigned char* lds) {
    const KArgs ap = get_args();
#define a (*ap)
    const int tid = fresh_tid(), lane = tid & 63, wave = __builtin_amdgcn_readfirstlane(tid >> 6);
    unsigned char* ws = a.ws;
    const int nrows = (l == DEPTH - 1) ? ML : M;
    const int nitem = nrows / GP_ITEM;
    const unsigned char* UB = ws + WS_UB + (size_t)(l & 1) * TAB_SET; const unsigned char* VB = UB + 1024;
    const f32x2* SC2 = (const f32x2*)(ws + WS_USC) + (size_t)(l & 1) * NEXP;
    const int* PIDX = (const int*)(ws + WS_PIDX); const float* PGATE = (const float*)(ws + WS_PGATE);
    LAS u32x4* lst0 = (LAS u32x4*)lds + wave * 256;
    const int eidx = ((lane >> 5) & 1) * 4 + ((lane >> 4) & 1) * 2 + ((lane >> 3) & 1);
    const int x = (int)(xb_xcc_id() & 7u);
#define GP_LOAD_META(m_, row_) do { const int rw_ = (row_); (m_).id0 = PIDX[(size_t)rw_ * 128 + lane]; (m_).id1 = PIDX[(size_t)rw_ * 128 + 64 + lane]; (m_).gt0 = PGATE[(size_t)rw_ * 128 + lane]; (m_).gt1 = PGATE[(size_t)rw_ * 128 + 64 + lane]; \
        (m_).hw = *(const u32x4*)((const signed char*)(ws + WS_H) + (size_t)rw_ * D + 16 * lane); (m_).hsc = ((const float*)(ws + WS_GB))[rw_]; } while (0)
#define GP_LOAD_SC(sa_, sb_, m_) do { sa_ = (f32x2){0.f, 0.f}; sb_ = (f32x2){0.f, 0.f}; if (((m_).id0 >> 11) == p) sa_ = SC2[(m_).id0]; if (((m_).id1 >> 11) == p) sb_ = SC2[(m_).id1]; } while (0)
#define GP_BUILD(cnt_, m_, sa_, sb_, buf_) do { const bool s0_ = ((m_).id0 >> 11) == p, s1_ = ((m_).id1 >> 11) == p; const unsigned long long m0_ = __ballot(s0_), m1_ = __ballot(s1_); \
        const int c0_ = __builtin_popcountll(m0_); cnt_ = __builtin_amdgcn_readfirstlane(c0_ + __builtin_popcountll(m1_)); \
        const int r0_ = (int)__builtin_amdgcn_mbcnt_hi((unsigned)(m0_ >> 32), __builtin_amdgcn_mbcnt_lo((unsigned)m0_, 0u)); \
        const int r1_ = c0_ + (int)__builtin_amdgcn_mbcnt_hi((unsigned)(m1_ >> 32), __builtin_amdgcn_mbcnt_lo((unsigned)m1_, 0u)); \
        LAS u32x4* lb_ = lst0 + (buf_) * 128; \
        if (s0_) lb_[r0_] = (u32x4){(unsigned)(m_).id0, __float_as_uint((m_).gt0 * sa_[1]), __float_as_uint(sa_[0]), 0u}; \
        if (s1_) lb_[r1_] = (u32x4){(unsigned)(m_).id1, __float_as_uint((m_).gt1 * sb_[1]), __float_as_uint(sb_[0]), 0u}; } while (0)
#pragma unroll 1
    for (int pp = 0; pp < 8; ++pp) {
        const int p = (x + pp) & 7;
        unsigned* ctr = (unsigned*)(ws + WS_CTL) + 16384 + (l * 8 + p) * 64;
        unsigned* part = (unsigned*)(ws + WS_PART + (size_t)p * M * 2048);
        unsigned tk = 0; if (lane == 0) tk = __hip_atomic_fetch_add(ctr, 1u, __ATOMIC_RELAXED, __HIP_MEMORY_SCOPE_AGENT);
        int it = __builtin_amdgcn_readfirstlane((int)tk);
#pragma unroll 1
        while (it < nitem) {
            unsigned tn = 0; if (lane == 0) tn = __hip_atomic_fetch_add(ctr, 1u, __ATOMIC_RELAXED, __HIP_MEMORY_SCOPE_AGENT);
            const int row0 = it * GP_ITEM, rowl = row0 + GP_ITEM - 1;
            GpMeta m1, m2, m3; f32x2 sa1, sb1, sa2, sb2; int c_cur, c_nxt; u32x4 hw_cur; float hsc_cur;
            GP_LOAD_META(m1, row0); GP_LOAD_META(m2, min(row0 + 1, rowl)); GP_LOAD_META(m3, min(row0 + 2, rowl));
            GP_LOAD_SC(sa1, sb1, m1);
            GP_BUILD(c_cur, m1, sa1, sb1, 0); hw_cur = m1.hw; hsc_cur = m1.hsc;
            GP_LOAD_SC(sa1, sb1, m2);
            m1 = m2; m2 = m3;
            GP_LOAD_META(m3, min(row0 + 3, rowl));
#pragma unroll 1
            for (int i = 0; i < GP_ITEM; ++i) {
                const int row = row0 + i;
                GP_BUILD(c_nxt, m1, sa1, sb1, (i + 1) & 1);
                const u32x4 hw_nxt = m1.hw; const float hsc_nxt = m1.hsc;
                GP_LOAD_SC(sa2, sb2, m2);
                m1 = m2; sa1 = sa2; sb1 = sb2; m2 = m3;
                GP_LOAD_META(m3, min(row + 4, rowl));
                LAS u32x4* lst = lst0 + (i & 1) * 128;
                const int c = c_cur; const u32x4 hw = hw_cur; const float hsc = hsc_cur;
                f32x2 o2[8];
#pragma unroll
                for (int k = 0; k < 8; ++k) o2[k] = (f32x2){0.f, 0.f};
                float wacc = 0.f;
#pragma unroll 1
                for (int e = 0; e < c; e += 8) {
                    u32x4 uw[8], vw[8];
#pragma unroll
                    for (int j = 0; j < 8; ++j) { const int sl = min(e + j, c - 1);
                        const int id = __builtin_amdgcn_readfirstlane((int)lst[sl][0]);
                        uw[j] = *(const u32x4*)(UB + (size_t)id * 2048 + 16 * lane); vw[j] = *(const u32x4*)(VB + (size_t)id * 2048 + 16 * lane); }
                    const int ms = e + eidx; const u32x4 en = lst[min(ms, c - 1)];
                    float pd[8];
#pragma unroll
                    for (int j = 0; j < 8; ++j) { int d = 0;
#pragma unroll
                        for (int q = 0; q < 4; ++q) d = __builtin_amdgcn_sdot4((int)uw[j][q], (int)hw[q], d, false);
                        pd[j] = (float)d; }
                    { const bool hb = (lane & 32) != 0;
#pragma unroll
                      for (int j = 0; j < 4; ++j) { const float keep = hb ? pd[j + 4] : pd[j], send = hb ? pd[j] : pd[j + 4]; pd[j] = keep + lane_xor<32>(send); } }
                    { const bool hb = (lane & 16) != 0;
#pragma unroll
                      for (int j = 0; j < 2; ++j) { const float keep = hb ? pd[j + 2] : pd[j], send = hb ? pd[j] : pd[j + 2]; pd[j] = keep + lane_xor<16>(send); } }
                    { const bool hb = (lane & 8) != 0; const float keep = hb ? pd[1] : pd[0], send = hb ? pd[0] : pd[1]; pd[0] = keep + lane_xor<8>(send); }
                    pd[0] += lane_xor<4>(pd[0]); pd[0] += lane_xor<2>(pd[0]); pd[0] += lane_xor<1>(pd[0]);
                    const float dsum = pd[0] * (__uint_as_float(en[2]) * hsc);
                    const float act = 0.5f * dsum * (1.f + erff(dsum * 0.70710678118654752f));
                    const float wgt = ms < c ? __uint_as_float(en[1]) * act : 0.f;
                    wacc += wgt;
#pragma unroll
                    for (int j = 0; j < 8; ++j) {
                        const float wj = __builtin_bit_cast(float, __builtin_amdgcn_readlane(__builtin_bit_cast(int, wgt), 32 * ((j >> 2) & 1) + 16 * ((j >> 1) & 1) + 8 * (j & 1)));
                        const f32x2 ww = {wj, wj};
#pragma unroll
                        for (int q = 0; q < 4; ++q) { const unsigned w = vw[j][q];
                            const f32x2 v01 = {(float)(w & 255u), (float)((w >> 8) & 255u)}, v23 = {(float)((w >> 16) & 255u), (float)(w >> 24)};
                            o2[2 * q] = __builtin_elementwise_fma(ww, v01, o2[2 * q]); o2[2 * q + 1] = __builtin_elementwise_fma(ww, v23, o2[2 * q + 1]); }
                    }
                }
                const float corr = 16.f * wave_sum(wacc);
                u32x4 w0, w1;
#pragma unroll
                for (int k = 0; k < 4; ++k) { w0[k] = pkbf_c(o2[k][0] - corr, o2[k][1] - corr); w1[k] = pkbf_c(o2[4 + k][0] - corr, o2[4 + k][1] - corr); }
                unsigned* dst = part + (size_t)row * 512 + 8 * lane;
                __builtin_nontemporal_store(w0, (u32x4*)dst); __builtin_nontemporal_store(w1, (u32x4*)(dst + 4));
                c_cur = c_nxt; hw_cur = hw_nxt; hsc_cur = hsc_nxt;
            }
            it = __builtin_amdgcn_readfirstlane((int)tn);
        }
    }
#undef GP_LOAD_META
#undef GP_LOAD_SC
#undef GP_BUILD
#undef a
}

__device__ __forceinline__ void phase_peer_combine(int l, LAS unsigned char* lds) {
    const KArgs ap = get_args();
#define a (*ap)
    const int tid = fresh_tid(), lane = tid & 63, wave = __builtin_amdgcn_readfirstlane(tid >> 6), G = fresh_g(), bx = fresh_bx();
    unsigned char* ws = a.ws;
    const int nrows = (l == DEPTH - 1) ? ML : M;
    const float* modl = (const float*)(ws + WS_MOD) + (size_t)l * 3 * 6144 + 5120;
    const bool fuse = (l + 1 < DEPTH);
    LAS float* wsk = (LAS float*)lds;
    if (fuse) { const float* src = (const float*)(ws + WS_WSK) + (size_t)(l + 1) * 16384; for (int i = tid; i < 16384 / 4; i += 512) ((LAS f32x4*)wsk)[i] = ((const f32x4*)src)[i]; __syncthreads(); }
    const float* nw1 = a.in[I_N1W] + (l + 1 < DEPTH ? l + 1 : l) * 1024 + 16 * lane;
    const float* modn = (const float*)(ws + WS_MOD) + (size_t)(l + 1 < DEPTH ? l + 1 : l) * 3 * 6144;
    for (int row = wave * G + bx; row < nrows; row += G * 8) {
        float out[16];
#pragma unroll
        for (int i = 0; i < 16; ++i) out[i] = 0.f;
#pragma unroll
        for (int p = 0; p < 8; ++p) { const unsigned* src = (const unsigned*)(ws + WS_PART + (size_t)p * M * 2048) + (size_t)row * 512 + 8 * lane;
            const u32x4 w0 = __builtin_nontemporal_load((const u32x4*)src), w1 = __builtin_nontemporal_load((const u32x4*)(src + 4));
#pragma unroll
            for (int k = 0; k < 4; ++k) { out[2 * k] += bflo(w0[k]); out[2 * k + 1] += bfhi(w0[k]); out[8 + 2 * k] += bflo(w1[k]); out[8 + 2 * k + 1] += bfhi(w1[k]); } }
        float* xr; int mrow;
        if (row < ML) { xr = a.out + (size_t)row * D; mrow = row >= T ? 1 : 0; } else { xr = (float*)(ws + WS_CTXX) + (size_t)(row - ML) * D; mrow = 2; }
        const float* g2 = modl + mrow * 6144 + 16 * lane;
        f32x4 xn[4];
#pragma unroll
        for (int i = 0; i < 4; ++i) { const f32x4 x = *(const f32x4*)(xr + 16 * lane + 4 * i), g = *(const f32x4*)(g2 + 4 * i);
            xn[i] = x + g * (f32x4){out[4 * i], out[4 * i + 1], out[4 * i + 2], out[4 * i + 3]};
            *(f32x4*)(xr + 16 * lane + 4 * i) = xn[i]; }
        if (fuse) {
            float ss = 0.f;
#pragma unroll
            for (int i = 0; i < 4; ++i) ss += (xn[i][0] * xn[i][0] + xn[i][1] * xn[i][1]) + (xn[i][2] * xn[i][2] + xn[i][3] * xn[i][3]);
            const float rstd = rsqrtf(wave_sum(ss) * (1.f / D) + EPS);
            const float* md = modn + mrow * 6144 + 16 * lane;
#pragma unroll
            for (int i = 0; i < 4; ++i) { const f32x4 nwv = *(const f32x4*)(nw1 + 4 * i), sc = *(const f32x4*)(md + 1024 + 4 * i), sh = *(const f32x4*)(md + 4 * i);
                xn[i] = xn[i] * rstd * nwv * (sc + 1.f) + sh; }
            { float hmx = 0.f;
#pragma unroll
              for (int i = 0; i < 4; ++i) hmx = fmaxf(hmx, fmaxf(fmaxf(fabsf(xn[i][0]), fabsf(xn[i][1])), fmaxf(fabsf(xn[i][2]), fabsf(xn[i][3]))));
              hmx = fmaxf(wave_max(hmx), 1e-30f); const float hinv = 127.f / hmx;
              u32x4 o;
#pragma unroll
              for (int i = 0; i < 4; ++i) o[i] = ((unsigned)(int)rintf(xn[i][0] * hinv) & 255u) | (((unsigned)(int)rintf(xn[i][1] * hinv) & 255u) << 8) | (((unsigned)(int)rintf(xn[i][2] * hinv) & 255u) << 16) | (((unsigned)(int)rintf(xn[i][3] * hinv) & 255u) << 24);
              *(u32x4*)((signed char*)(ws + WS_H) + (size_t)row * D + 16 * lane) = o;
              if (lane == 0) ((float*)(ws + WS_GB))[row] = hmx * (1.f / 127.f); }
            float p[16];
#pragma unroll
            for (int c = 0; c < 16; ++c) { float q = 0.f;
#pragma unroll
                for (int i = 0; i < 4; ++i) { const f32x4 w = *(const LAS f32x4*)(wsk + c * 1024 + 16 * lane + 4 * i); q += (xn[i][0] * w[0] + xn[i][1] * w[1]) + (xn[i][2] * w[2] + xn[i][3] * w[3]); }
                p[c] = q; }
            { const bool hb = (lane & 32) != 0;
#pragma unroll
              for (int c = 0; c < 8; ++c) { const float keep = hb ? p[c + 8] : p[c], send = hb ? p[c] : p[c + 8]; p[c] = keep + lane_xor<32>(send); } }
            { const bool hb = (lane & 16) != 0;
#pragma unroll
              for (int c = 0; c < 4; ++c) { const float keep = hb ? p[c + 4] : p[c], send = hb ? p[c] : p[c + 4]; p[c] = keep + lane_xor<16>(send); } }
            { const bool hb = (lane & 8) != 0;
#pragma unroll
              for (int c = 0; c < 2; ++c) { const float keep = hb ? p[c + 2] : p[c], send = hb ? p[c] : p[c + 2]; p[c] = keep + lane_xor<8>(send); } }
            { const bool hb = (lane & 4) != 0; const float keep = hb ? p[1] : p[0], send = hb ? p[0] : p[1]; p[0] = keep + lane_xor<4>(send); }
            p[0] += lane_xor<2>(p[0]); p[0] += lane_xor<1>(p[0]);
            if ((lane & 3) == 0) { const int c = ((lane >> 5) & 1) * 8 + ((lane >> 4) & 1) * 4 + ((lane >> 3) & 1) * 2 + ((lane >> 2) & 1); ((float*)(ws + WS_BA))[(size_t)row * 16 + c] = p[0]; }
        }
    }
    if (fuse) __syncthreads();
#undef a
}
constexpr size_t WS_PD = WS_REC;
constexpr size_t WS_PW = WS_REC + 8 * (size_t)M * 128 * 4;
constexpr size_t WS_PC = WS_PW + (size_t)M * 128;
static_assert(WS_PC + (size_t)M * 8 * 4 <= WS_END, "sliced gather scratch");
constexpr int GS_ITEM = 8;
template <int PH>
__device__ __forceinline__ void phase_peer_slice(int l, int cslot) {
    const KArgs ap = get_args();
#define a (*ap)
    const int tid = fresh_tid(), lane = tid & 63;
    unsigned char* ws = a.ws;
    const int nrows = (l == DEPTH - 1) ? ML : M;
    const int nitem = nrows / GS_ITEM;
    const unsigned char* TAB = ws + WS_UB + (size_t)(l & 1) * TAB_SET + (PH ? (size_t)NEXP * 1024 : 0);
    const int* PIDX = (const int*)(ws + WS_PIDX);
    const unsigned char* PW = ws + WS_PW; const float* PC = (const float*)(ws + WS_PC);
    const float* modl = (const float*)(ws + WS_MOD) + (size_t)l * 3 * 6144 + 5120;
    const int g = lane >> 3, i8 = lane & 7;
    const int x = (int)(xb_xcc_id() & 7u);
#pragma unroll 1
    for (int pp = 0; pp < 8; ++pp) {
        const int p = (x + pp) & 7;
        unsigned* ctr = (unsigned*)(ws + WS_CTL) + 16384 + ((l * 2 + PH) * 8 + p) * 64 + cslot * 8192;
        const unsigned char* tb = TAB + (size_t)p * NEXP * 128 + 16 * i8;
        unsigned tk = 0; if (lane == 0) tk = __hip_atomic_fetch_add(ctr, 1u, __ATOMIC_RELAXED, __HIP_MEMORY_SCOPE_AGENT);
        int it = __builtin_amdgcn_readfirstlane((int)tk);
        if (it < nitem) {
            unsigned tn = 0; if (lane == 0) tn = __hip_atomic_fetch_add(ctr, 1u, __ATOMIC_RELAXED, __HIP_MEMORY_SCOPE_AGENT);
            const int row0 = it * GS_ITEM;
            u32x4 idc[4], idn[4], ra[8], rb[8]; u32x4 wc, wn; float sc_c, sc_n; u32x4 hc, hn;
#define GS_META(ids_, wts_, wsc_, h_, row_) do { const int rw_ = (row_); const u32x4* ip_ = (const u32x4*)(PIDX + (size_t)rw_ * 128 + 16 * g); _Pragma("unroll") for (int q_ = 0; q_ < 4; ++q_) ids_[q_] = ip_[q_]; \
                if (PH) { wts_ = *(const u32x4*)(PW + (size_t)rw_ * 128 + 16 * g); wsc_ = PC[(size_t)rw_ * 8 + g]; } \
                else h_ = *(const u32x4*)((const signed char*)(ws + WS_H) + (size_t)rw_ * D + 128 * p + 16 * i8); } while (0)
#define GS_ROWS(dst_, ids_, hf_) do { _Pragma("unroll") for (int k_ = 0; k_ < 8; ++k_) dst_[k_] = *(const u32x4*)(tb + (size_t)ids_[2 * (hf_) + (k_ >> 2)][k_ & 3] * 128); } while (0)
            GS_META(idc, wc, sc_c, hc, row0);
            GS_ROWS(ra, idc, 0);
            GS_META(idn, wn, sc_n, hn, row0 + 1);
            int i = 0, tnv = 0x7fffffff;
#pragma unroll 1
            for (;;) {
                if (i == GS_ITEM - 2) tnv = __builtin_amdgcn_readfirstlane((int)tn);
                const int row = it * GS_ITEM + i;
                const int r2 = (i + 2 < GS_ITEM) ? row + 2 : (tnv < nitem ? tnv * GS_ITEM + (i + 2 - GS_ITEM) : row);
                GS_ROWS(rb, idc, 1);
                if (PH == 0) {
                    int d[16];
#pragma unroll
                    for (int k = 0; k < 8; ++k) { int s_ = 0;
#pragma unroll
                        for (int q = 0; q < 4; ++q) s_ = __builtin_amdgcn_sdot4((int)ra[k][q], (int)hc[q], s_, false);
                        d[k] = s_; }
                    GS_ROWS(ra, idn, 0);
#pragma unroll
                    for (int k = 0; k < 8; ++k) { int s_ = 0;
#pragma unroll
                        for (int q = 0; q < 4; ++q) s_ = __builtin_amdgcn_sdot4((int)rb[k][q], (int)hc[q], s_, false);
                        d[8 + k] = s_; }
#define GS_IX(v_, K_) __builtin_bit_cast(int, lane_xor<K_>(__builtin_bit_cast(float, v_)))
                    { const bool hb = (lane & 4) != 0;
#pragma unroll
                      for (int j = 0; j < 8; ++j) { const int keep = hb ? d[j + 8] : d[j], send = hb ? d[j] : d[j + 8]; d[j] = keep + GS_IX(send, 4); } }
                    { const bool hb = (lane & 2) != 0;
#pragma unroll
                      for (int j = 0; j < 4; ++j) { const int keep = hb ? d[j + 4] : d[j], send = hb ? d[j] : d[j + 4]; d[j] = keep + GS_IX(send, 2); } }
                    { const bool hb = (lane & 1) != 0;
#pragma unroll
                      for (int j = 0; j < 2; ++j) { const int keep = hb ? d[j + 2] : d[j], send = hb ? d[j] : d[j + 2]; d[j] = keep + GS_IX(send, 1); } }
#undef GS_IX
                    u32x2 o = {(unsigned)d[0], (unsigned)d[1]};
                    __builtin_nontemporal_store(o, (u32x2*)((int*)(ws + WS_PD) + ((size_t)p * M + row) * 128 + 2 * lane));
                } else {
                    int oi[16];
#pragma unroll
                    for (int k = 0; k < 16; ++k) oi[k] = 0;
#define GS_QUAD(rr_, qd_, wd_) do { _Pragma("unroll") for (int q_ = 0; q_ < 4; ++q_) { \
                        const unsigned r0_ = rr_[4 * (qd_) + 0][q_], r1_ = rr_[4 * (qd_) + 1][q_], r2_ = rr_[4 * (qd_) + 2][q_], r3_ = rr_[4 * (qd_) + 3][q_]; \
                        const unsigned t0_ = __builtin_amdgcn_perm(r1_, r0_, 0x05010400u), t1_ = __builtin_amdgcn_perm(r1_, r0_, 0x07030602u), t2_ = __builtin_amdgcn_perm(r3_, r2_, 0x05010400u), t3_ = __builtin_amdgcn_perm(r3_, r2_, 0x07030602u); \
                        oi[4 * q_ + 0] = __builtin_amdgcn_sdot4((int)__builtin_amdgcn_perm(t2_, t0_, 0x05040100u), (int)(wd_), oi[4 * q_ + 0], false); \
                        oi[4 * q_ + 1] = __builtin_amdgcn_sdot4((int)__builtin_amdgcn_perm(t2_, t0_, 0x07060302u), (int)(wd_), oi[4 * q_ + 1], false); \
                        oi[4 * q_ + 2] = __builtin_amdgcn_sdot4((int)__builtin_amdgcn_perm(t3_, t1_, 0x05040100u), (int)(wd_), oi[4 * q_ + 2], false); \
                        oi[4 * q_ + 3] = __builtin_amdgcn_sdot4((int)__builtin_amdgcn_perm(t3_, t1_, 0x07060302u), (int)(wd_), oi[4 * q_ + 3], false); } } while (0)
                    GS_QUAD(ra, 0, wc[0]); GS_QUAD(ra, 1, wc[1]);
                    GS_ROWS(ra, idn, 0);
                    GS_QUAD(rb, 0, wc[2]); GS_QUAD(rb, 1, wc[3]);
#undef GS_QUAD
                    float o[16];
#pragma unroll
                    for (int k = 0; k < 16; ++k) o[k] = (float)oi[k] * sc_c;
                    { const bool hb = (lane & 32) != 0;
#pragma unroll
                      for (int j = 0; j < 8; ++j) { const float keep = hb ? o[j + 8] : o[j], send = hb ? o[j] : o[j + 8]; o[j] = keep + lane_xor<32>(send); } }
                    { const bool hb = (lane & 16) != 0;
#pragma unroll
                      for (int j = 0; j < 4; ++j) { const float keep = hb ? o[j + 4] : o[j], send = hb ? o[j] : o[j + 4]; o[j] = keep + lane_xor<16>(send); } }
                    { const bool hb = (lane & 8) != 0;
#pragma unroll
                      for (int j = 0; j < 2; ++j) { const float keep = hb ? o[j + 2] : o[j], send = hb ? o[j] : o[j + 2]; o[j] = keep + lane_xor<8>(send); } }
                    const float corr = 0.f;
                    float* xr; int mrow;
                    if (row < ML) { xr = a.out + (size_t)row * D; mrow = row >= T ? 1 : 0; } else { xr = (float*)(ws + WS_CTXX) + (size_t)(row - ML) * D; mrow = 2; }
                    const int col = 128 * p + 16 * i8 + 2 * g;
                    const f32x2 g2 = *(const f32x2*)(modl + mrow * 6144 + col), xo = *(const f32x2*)(xr + col);
                    *(f32x2*)(xr + col) = (f32x2){xo[0] + g2[0] * (o[0] - corr), xo[1] + g2[1] * (o[1] - corr)};
                }
#pragma unroll
                for (int q = 0; q < 4; ++q) idc[q] = idn[q];
                if (PH) { wc = wn; sc_c = sc_n; } else hc = hn;
                GS_META(idn, wn, sc_n, hn, r2);
                if (++i == GS_ITEM) {
                    if (tnv >= nitem) break;
                    it = tnv; i = 0; tnv = 0x7fffffff;
                    if (lane == 0) tn = __hip_atomic_fetch_add(ctr, 1u, __ATOMIC_RELAXED, __HIP_MEMORY_SCOPE_AGENT);
                }
            }
#undef GS_META
#undef GS_ROWS
        }
    }
#undef a
}
__device__ __forceinline__ void phase_peer_weights(int l) {
    const KArgs ap = get_args();
#define a (*ap)
    const int tid = fresh_tid(), lane = tid & 63, wave = __builtin_amdgcn_readfirstlane(tid >> 6), G = fresh_g(), bx = fresh_bx();
    unsigned char* ws = a.ws;
    const int nrows = (l == DEPTH - 1) ? ML : M;
    const f32x2* SC2 = (const f32x2*)(ws + WS_USC) + (size_t)(l & 1) * NEXP;
    const int* PIDX = (const int*)(ws + WS_PIDX); const float* PGATE = (const float*)(ws + WS_PGATE);
    for (int row = wave * G + bx; row < nrows; row += G * 8) {
        const u32x2 id = *(const u32x2*)(PIDX + (size_t)row * 128 + 2 * lane); const f32x2 gt = *(const f32x2*)(PGATE + (size_t)row * 128 + 2 * lane);
        const float hsc = ((const float*)(ws + WS_GB))[row];
        int d0 = 0, d1 = 0;
#pragma unroll
        for (int p = 0; p < 8; ++p) { const u32x2 v = __builtin_nontemporal_load((const u32x2*)((const int*)(ws + WS_PD) + ((size_t)p * M + row) * 128 + 2 * lane)); d0 += (int)v[0]; d1 += (int)v[1]; }
        const f32x2 s0 = SC2[id[0]], s1 = SC2[id[1]];
        const float x0 = (float)d0 * (s0[0] * hsc), x1 = (float)d1 * (s1[0] * hsc);
        const float w0 = gt[0] * s0[1] * (0.5f * x0 * (1.f + erff(x0 * 0.70710678118654752f))), w1 = gt[1] * s1[1] * (0.5f * x1 * (1.f + erff(x1 * 0.70710678118654752f)));
        float mx = fmaxf(fabsf(w0), fabsf(w1));
        mx = fmaxf(mx, lane_xor<1>(mx)); mx = fmaxf(mx, lane_xor<2>(mx)); mx = fmaxf(mx, lane_xor<4>(mx));
        mx = fmaxf(mx, 1e-30f); const float inv = 127.f / mx;
        *(unsigned short*)(ws + WS_PW + (size_t)row * 128 + 2 * lane) = (unsigned short)(((unsigned)(int)rintf(w0 * inv) & 255u) | (((unsigned)(int)rintf(w1 * inv) & 255u) << 8));
        if ((lane & 7) == 0) ((float*)(ws + WS_PC))[(size_t)row * 8 + (lane >> 3)] = mx * (1.f / 127.f);
    }
#undef a
}

__global__ void __launch_bounds__(512, 2) fwd(Args a) {
    extern __shared__ __attribute__((aligned(16))) unsigned char lds_raw[];
    LAS unsigned char* lds = (LAS unsigned char*)lds_raw;
    volatile LAS unsigned* MISC = (volatile LAS unsigned*)(lds + LDS_MISC);
    if (threadIdx.x < 16) MISC[threadIdx.x] = 0u;
    __syncthreads();
    XcdBarrier bar; bar.bar = (unsigned*)(a.ws + WS_CTL) + 4096; bar.x = 0; bar.st = MISC + 8;
    bar = xcd_barrier_post((unsigned*)(a.ws + WS_CTL) + 4096, MISC + 8);
#ifndef PHASE_MASK
#define PHASE_MASK 0x1FFF
#endif
#define EN(i) ((PHASE_MASK >> (i)) & 1)
#ifndef REP_MASK
#define REP_MASK 0
#endif
#define REPN(i) (1 + ((REP_MASK >> (i)) & 1))
#define IN(k) true
#define SEAM(k) do { XcdBarrier b_; b_.bar = (unsigned*)(get_args()->ws + WS_CTL) + 4096; b_.x = xb_xcc_id(); b_.st = (volatile LAS unsigned*)(lds + LDS_MISC) + 8; xcd_barrier(b_); } while (0)
    for (int rep_ = 0; rep_ < (REPN(0)); ++rep_) if (EN(0) && IN(0)) phase_prologue(lds);
    SEAM(0);
#pragma unroll 1
    for (int l_ = 0; l_ < DEPTH; ++l_) {
        int l = l_; asm volatile("" : "+s"(l));
        const int pb = 1 + l * NPH_L;
        const int mrows = (l == DEPTH - 1) ? ML : M;
        if (l == 0) { for (int rep_ = 0; rep_ < (REPN(1)); ++rep_) if (EN(1) && IN(pb + 0)) { phase_norm<true>(l, 0, lds); phase_quant_weights(lds); }
            SEAM(pb + 0); }
        for (int rep_ = 0; rep_ < (REPN(2)); ++rep_) if (EN(2) && IN(pb + 1)) { const KArgs ap = get_args(); unsigned char* ws = ap->ws; pg8::Gemm g{(const bf16_t*)(ws + WS_H), (const bf16_t*)((const signed char*)(ws + WS_WINT) + (size_t)l * NP * 1024), M, NP, 512}; pg8::StaticOrder S; S.init(M, NP, fresh_g(), fresh_bx());
            pg8::EpiBf16I8 E{(bf16_t*)(ws + WS_P), NP, (const float*)(ws + WS_GB), (const float*)(ws + WS_CTL) + CW_WMAX + (l * 3 + 0) * 3072}; pg8::gemm_phase(lds, g, S, E); }
        SEAM(pb + 1);
        for (int rep_ = 0; rep_ < (REPN(3)); ++rep_) if (EN(3) && IN(pb + 2)) { phase_dn_chunkprep<1>(l, lds); phase_prep(l, lds); }
        for (int rep_ = 0; rep_ < (REPN(4)); ++rep_) if (EN(4) && IN(pb + 3)) phase_dn_chunkprep<0>(l, lds);
        SEAM(pb + 3);
        for (int rep_ = 0; rep_ < (REPN(5)); ++rep_) if (EN(5) && IN(pb + 4)) { phase_dn_scan<0>(l, lds); __syncthreads(); phase_attn(l, lds_raw, MISC, rep_); }
        SEAM(pb + 4);
        for (int rep_ = 0; rep_ < (REPN(7)); ++rep_) if (EN(7) && IN(pb + 5)) phase_dn_out(l);
        SEAM(pb + 5);
        if (EN(8) && IN(pb + 6)) { const KArgs ap = get_args(); unsigned char* ws = ap->ws; pg8::Gemm g{(const bf16_t*)(ws + WS_CATQ), (const bf16_t*)((const signed char*)(ws + WS_WOUTT) + (size_t)l * 1024 * 1024), mrows, 1024, 512}; pg8::StaticOrder S; S.init(mrows, 1024, fresh_g(), fresh_bx());
            pg8::EpiResI8 E{l == 0 ? ap->in[I_X] : ap->out, l == 0 ? ap->in[I_CTX] : (const float*)(ws + WS_CTXX), ap->out, (float*)(ws + WS_CTXX), (const float*)(ws + WS_MOD) + (size_t)l * 3 * 6144 + 2048,
                              (const float*)(ws + WS_GB) + (1u << 18), (const float*)(ws + WS_CTL) + CW_WMAX + (l * 3 + 1) * 3072};
            pg8::gemm_phase(lds, g, S, E); }
        SEAM(pb + 6);
        for (int rep_ = 0; rep_ < (REPN(9)); ++rep_) if (EN(9) && IN(pb + 7)) phase_norm<false>(l, 1, lds);
        SEAM(pb + 7);
        for (int rep_ = 0; rep_ < (REPN(10)); ++rep_) if (EN(10) && IN(pb + 8)) { const KArgs ap = get_args(); unsigned char* ws = ap->ws; pg8::Gemm g{(const bf16_t*)(ws + WS_H), (const bf16_t*)((const signed char*)(ws + WS_WQT) + (size_t)l * 2048 * 1024), mrows, 2048, 512}; pg8::StaticOrder S; S.init(mrows, 2048, fresh_g(), fresh_bx());
            pg8::EpiBf16I8 E{(bf16_t*)(ws + WS_P), 2048, (const float*)(ws + WS_GB), (const float*)(ws + WS_CTL) + CW_WMAX + (l * 3 + 2) * 3072}; pg8::gemm_phase(lds, g, S, E); }
        SEAM(pb + 8);
        for (int rep_ = 0; rep_ < (REPN(11)); ++rep_) if (EN(11) && IN(pb + 9)) phase_peer_select(l);
        SEAM(pb + 9);
        #ifdef GATHER_VAR
        if (EN(12) && IN(pb + 10)) phase_peer_gather<false, GATHER_VAR>(l, lds);
#endif
#if GATHER_PART == 2
        if (EN(12) && IN(pb + 10)) phase_peer_slice<0>(l, 0);
        SEAM(pb + 10);
        if (EN(12) && IN(pb + 10)) phase_peer_weights(l);
        SEAM(pb + 10);
        if (EN(12) && IN(pb + 10)) phase_peer_slice<1>(l, 0);
        if (l + 1 < DEPTH) { SEAM(pb + 10); if (EN(12) && IN(pb + 10)) phase_norm<true>(l + 1, 0, lds); }
#elif GATHER_PART
        if (EN(12) && IN(pb + 10)) phase_peer_gpart(l, lds);
        SEAM(pb + 10);
        if (EN(12) && IN(pb + 10)) phase_peer_combine(l, lds);
#else
        if (REPN(12) > 1 && EN(12) && IN(pb + 10)) phase_peer_gather<false>(l, lds);
        if (EN(12) && IN(pb + 10)) phase_peer_gather<true>(l, lds);
#endif
        if (l + 1 < DEPTH) SEAM(pb + 10);
    }
#undef IN
#undef SEAM
}

#ifndef N_LAUNCH_MODE
#define N_LAUNCH_MODE 1
#endif
extern "C" void kernel_launch(void* const* d_in, const int* in_sizes, int n_in, void* d_out, int out_size, void* d_ws, size_t ws_size, hipStream_t stream) {
    static int grid = 0;
    if (grid == 0) {
        if (n_in != 20 || out_size != ML * D || ws_size < WS_END) { fprintf(stderr, "kernel_launch: unexpected shapes: n_in %d out %d ws %zu (need %zu)\n", n_in, out_size, ws_size, (size_t)WS_END); grid = -1; return; }
        int dev = 0, cus = 0, per_cu = 0;
        if (hipGetDevice(&dev) != hipSuccess || hipDeviceGetAttribute(&cus, hipDeviceAttributeMultiprocessorCount, dev) != hipSuccess) { grid = -1; return; }
        if (hipFuncSetAttribute((const void*)fwd, hipFuncAttributeMaxDynamicSharedMemorySize, LDS_BYTES) != hipSuccess) { fprintf(stderr, "kernel_launch: hipFuncSetAttribute failed\n"); grid = -1; return; }
        if (hipOccupancyMaxActiveBlocksPerMultiprocessor(&per_cu, (const void*)fwd, 512, LDS_BYTES) != hipSuccess || per_cu < 1) fprintf(stderr, "kernel_launch: occupancy query says %d\n", per_cu);
        (void)hipGetLastError();
        grid = cus;
    }
    if (grid < 0) return;
    (void)hipMemsetAsync((char*)d_ws + WS_CTL, 0, CTL_BYTES, stream);
    Args a{};
    for (int i = 0; i < 20; ++i) a.in[i] = (const float*)d_in[i];
    a.out = (float*)d_out; a.ws = (unsigned char*)d_ws;
    a.ph_lo = 0; a.ph_hi = NPHASE;
    hipLaunchKernelGGL(fwd, dim3(grid), dim3(512), LDS_BYTES, stream, a);
    const hipError_t le = hipPeekAtLastError();
    if (le != hipSuccess) fprintf(stderr, "kernel_launch: launch failed: %s\n", hipGetErrorName(le));
}
```

```cpp
#include <hip/hip_runtime.h>
#ifndef GATHER_PART
#define GATHER_PART 2
#endif
#include <cstdio>
#include <cstdint>

#define GAS __attribute__((address_space(1)))
#define LAS __attribute__((address_space(3)))
typedef unsigned short bf16_t;
typedef short bf16x8 __attribute__((ext_vector_type(8)));
typedef short s16x4 __attribute__((ext_vector_type(4)));
typedef float f32x4 __attribute__((ext_vector_type(4)));
typedef float f32x2 __attribute__((ext_vector_type(2)));
typedef float f32x16 __attribute__((ext_vector_type(16)));
typedef unsigned u32x4 __attribute__((ext_vector_type(4)));
typedef unsigned u32x2 __attribute__((ext_vector_type(2)));
typedef int i32x4 __attribute__((ext_vector_type(4)));

constexpr int D = 1024, NB = 2, T = 16384, DEPTH = 4, CT = 256;
constexpr int ML = NB * T, MC = NB * CT, M = ML + MC;
constexpr int NIN = 3088, NP = 3072;
constexpr int KVLEN = T + CT;
constexpr int NEXP = 16384;
constexpr float EPS = 1e-6f;
constexpr int NPH_L = 11;
constexpr int NPHASE = 1 + DEPTH * NPH_L;

constexpr size_t MiB = 1u << 20;
constexpr size_t WS_CTL = 0, CTL_BYTES = 1 * MiB;
constexpr size_t WS_MOD = 1 * MiB;
constexpr size_t WS_ROPE = 2 * MiB;
constexpr size_t WS_WSK = 3 * MiB;
constexpr size_t WS_CTXX = 4 * MiB;
constexpr size_t WS_WINT = 8 * MiB;
constexpr size_t WS_WOUTT = 32 * MiB;
constexpr size_t WS_WQT = 40 * MiB;
constexpr size_t WS_SKB = 56 * MiB;
constexpr size_t WS_USC = 58 * MiB;
constexpr size_t WS_UB = 64 * MiB;
constexpr size_t WS_VB = 80 * MiB;
constexpr size_t TAB_SET = 32 * MiB;
constexpr size_t WS_H = 128 * MiB;
static_assert(WS_H + 2 * (size_t)M * 1024 <= 193 * MiB, "H + concat int8");
constexpr size_t WS_CATQ = WS_H + (size_t)M * 1024;
constexpr size_t WS_P = 193 * MiB;
constexpr size_t WS_QA = 388 * MiB;
constexpr size_t WS_KA = 421 * MiB;
constexpr size_t WS_VA = 438 * MiB;
constexpr size_t WS_CAT = 455 * MiB;
constexpr size_t WS_DQ = 520 * MiB;
constexpr size_t WS_DK = 553 * MiB;
constexpr size_t WS_DV = 586 * MiB;
constexpr size_t WS_OF = 619 * MiB;
constexpr size_t WS_OB = 684 * MiB;
constexpr size_t WS_GB = 749 * MiB;
constexpr size_t WS_BA = 752 * MiB;
constexpr size_t WS_PIDX = 755 * MiB;
constexpr size_t WS_PGATE = 772 * MiB;
constexpr size_t WS_REC = 789 * MiB;
constexpr size_t WS_END = 990 * MiB;
constexpr int CW_WMAX = 65536;
constexpr int NCH = 260;
constexpr int REC_K = 0, REC_KT = 16384, REC_Q = 32768, REC_V = 49152, REC_DIR = 65536, REC_DIRSZ = 17408, REC_BYTES = REC_DIR + 2 * REC_DIRSZ;
static_assert((size_t)NB * 4 * NCH * REC_BYTES + WS_REC <= WS_END, "rec region");

constexpr int LDS_BYTES = 163840;
constexpr int LDS_MISC = 163840 - 256;

__device__ __forceinline__ float bf2f(unsigned b) { return __uint_as_float(b << 16); }
__device__ __forceinline__ float bflo(unsigned w) { return __uint_as_float(w << 16); }
__device__ __forceinline__ float bfhi(unsigned w) { return __uint_as_float(w & 0xffff0000u); }
typedef __bf16 bf2v __attribute__((ext_vector_type(2)));
__device__ __forceinline__ unsigned pkbf(float lo, float hi) { unsigned r; asm("v_cvt_pk_bf16_f32 %0, %1, %2" : "=v"(r) : "v"(lo), "v"(hi)); return r; }
__device__ __forceinline__ unsigned pkbf_c(float lo, float hi) { f32x2 v = {lo, hi}; bf2v r = __builtin_convertvector(v, bf2v); return __builtin_bit_cast(unsigned, r); }
template <int K> __device__ __forceinline__ float lane_xor(float v) {
    const int b = __builtin_bit_cast(int, v);
    if constexpr (K == 1) return __builtin_bit_cast(float, __builtin_amdgcn_update_dpp(0, b, 0xB1, 0xF, 0xF, true));
    else if constexpr (K == 2) return __builtin_bit_cast(float, __builtin_amdgcn_update_dpp(0, b, 0x4E, 0xF, 0xF, true));
    else if constexpr (K == 32) { auto rr = __builtin_amdgcn_permlane32_swap((unsigned)b, (unsigned)b, false, false); unsigned ln_ = __builtin_amdgcn_mbcnt_hi(~0u, __builtin_amdgcn_mbcnt_lo(~0u, 0u)); asm volatile("" : "+v"(ln_));
        return __uint_as_float((ln_ & 32u) ? rr[0] : rr[1]); }
    else return __builtin_bit_cast(float, __builtin_amdgcn_ds_swizzle(b, 0x1F | (K << 10)));
}
__device__ __forceinline__ float wave_sum(float v) {
    v += lane_xor<1>(v); v += lane_xor<2>(v);
    v += __builtin_bit_cast(float, __builtin_amdgcn_update_dpp(0, __builtin_bit_cast(int, v), 0x124, 0xF, 0xF, true));
    v += __builtin_bit_cast(float, __builtin_amdgcn_update_dpp(0, __builtin_bit_cast(int, v), 0x128, 0xF, 0xF, true));
    v += lane_xor<16>(v);
    { auto rr = __builtin_amdgcn_permlane32_swap(__float_as_uint(v), __float_as_uint(v), false, false); v = __uint_as_float(rr[0]) + __uint_as_float(rr[1]); }
    return v;
}
__device__ __forceinline__ float wave_max(float v) {
    v = fmaxf(v, lane_xor<1>(v)); v = fmaxf(v, lane_xor<2>(v));
    v = fmaxf(v, __builtin_bit_cast(float, __builtin_amdgcn_update_dpp(0, __builtin_bit_cast(int, v), 0x124, 0xF, 0xF, true)));
    v = fmaxf(v, __builtin_bit_cast(float, __builtin_amdgcn_update_dpp(0, __builtin_bit_cast(int, v), 0x128, 0xF, 0xF, true)));
    v = fmaxf(v, lane_xor<16>(v));
    { auto rr = __builtin_amdgcn_permlane32_swap(__float_as_uint(v), __float_as_uint(v), false, false); v = fmaxf(__uint_as_float(rr[0]), __uint_as_float(rr[1])); }
    return v;
}
__device__ __forceinline__ float silu_f(float x) { return x / (1.f + __expf(-x)); }
#define LDS_WAIT() asm volatile("s_waitcnt lgkmcnt(0)" ::: "memory")

#define XB_TMO      128
#define XB_XCNT(j)  (256  + 64 * (j))
#define XB_XSUB(j)  (1280 + 64 * (j))
#define XB_XGEN(j)  (2304 + 64 * (j))
#define XB_TOP      3328
#define XB_TOPGEN   3392
#define XCD_BAR_WORDS 3456
#define XB_SPIN_CAP (1u << 22)
__device__ __forceinline__ unsigned xb_ld(unsigned* p)              { return __hip_atomic_load(p, __ATOMIC_RELAXED, __HIP_MEMORY_SCOPE_AGENT); }
__device__ __forceinline__ unsigned xb_add(unsigned* p, unsigned v) { return __hip_atomic_fetch_add(p, v, __ATOMIC_RELAXED, __HIP_MEMORY_SCOPE_AGENT); }
__device__ __forceinline__ unsigned xb_xcc_id() { return (unsigned)__builtin_amdgcn_s_getreg((3 << 11) | 20) & 0xFu; }
#define XB_SPIN(cond, bar) do { unsigned _sp = 0; while (cond) { __builtin_amdgcn_s_sleep(1); \
    if ((++_sp & 255u) == 0u) { if (xb_ld(&(bar)[XB_TMO])) break; if (_sp > XB_SPIN_CAP) { atomicAdd(&(bar)[XB_TMO], 1u); break; } } } } while (0)
struct XcdBarrier { unsigned* bar; unsigned x; volatile LAS unsigned* st; };
__device__ __forceinline__ XcdBarrier xcd_barrier_post(unsigned* bar, volatile LAS unsigned* st) {
    XcdBarrier b; b.bar = bar; b.x = xb_xcc_id(); b.st = st;
    if (threadIdx.x == 0) (void)xb_add(&bar[XB_XCNT(b.x)], 1u);
    return b;
}
__device__ __forceinline__ void xcd_barrier_complete(unsigned* bar, unsigned x, unsigned& nloc, unsigned& nx) {
    const unsigned G = gridDim.x * gridDim.y * gridDim.z;
    unsigned sum, cnt, mine, sp = 0u;
    for (;;) {
        sum = 0u; cnt = 0u; mine = 0u;
#pragma unroll
        for (unsigned j = 0; j < 16; ++j) { const unsigned c = xb_ld(&bar[XB_XCNT(j)]); sum += c; cnt += (c > 0u) ? 1u : 0u; mine = (j == x) ? c : mine; }
        if (sum == G) break;
        __builtin_amdgcn_s_sleep(1);
        if ((++sp & 255u) == 0u) { if (xb_ld(&bar[XB_TMO])) break; if (sp > XB_SPIN_CAP) { atomicAdd(&bar[XB_TMO], 1u); break; } }
    }
    nloc = mine > 0u ? mine : 1u; nx = cnt > 0u ? cnt : 1u;
}
__device__ __forceinline__ void xcd_barrier(const XcdBarrier& b) {
    asm volatile("s_waitcnt vmcnt(0)" ::: "memory");
    __syncthreads();
    if (threadIdx.x == 0) {
        unsigned* bar = b.bar; unsigned bx_ = b.x;
        asm volatile("" : "+s"(bar), "+s"(bx_));
        __builtin_amdgcn_s_waitcnt(0);
        unsigned nloc = b.st[0], nx = b.st[1];
        if (nloc == 0u) { xcd_barrier_complete(bar, bx_, nloc, nx); b.st[0] = nloc; b.st[1] = nx; }
        const unsigned old = xb_add(&bar[XB_XSUB(bx_)], 1u);
        const unsigned gen = old / nloc;
        if (old + 1u == (gen + 1u) * nloc) {
            __builtin_amdgcn_fence(__ATOMIC_RELEASE, "agent");
            asm volatile("s_waitcnt vmcnt(0)" ::: "memory");
            const unsigned og = xb_add(&bar[XB_TOP], 1u);
            const unsigned tg = og / nx;
            if (og + 1u == (tg + 1u) * nx) xb_add(&bar[XB_TOPGEN], 1u);
            else XB_SPIN(xb_ld(&bar[XB_TOPGEN]) == tg, bar);
            __builtin_amdgcn_fence(__ATOMIC_ACQUIRE, "agent");
            xb_add(&bar[XB_XGEN(bx_)], 1u);
            asm volatile("s_waitcnt vmcnt(0)" ::: "memory");
        } else {
            XB_SPIN(xb_ld(&bar[XB_XGEN(bx_)]) == gen, bar);
            __builtin_amdgcn_fence(__ATOMIC_ACQUIRE, "agent");
            asm volatile("s_waitcnt vmcnt(0)" ::: "memory");
        }
    }
    __syncthreads();
}

namespace pg8 {
constexpr int BM = 256, BK = 64, HALF = 128, HTB = HALF * BK * 2, STAGE_BYTES = 8 * HTB, NXCD = 8, WGM = 8;
__host__ __device__ __forceinline__ int lds_byte(int r, int c) { const int st = (r >> 4) * 2 + (c >> 5), rr = r & 15, cc = c & 31, ob = rr * 64 + cc * 2; return st * 1024 + (ob ^ (((ob >> 9) & 1) << 5)); }
__host__ __device__ __forceinline__ void stage_rc(int b, int& R, int& C) { const int st = b / 1024, sb = b % 1024, swz = sb ^ (((sb >> 9) & 1) << 5); R = (st >> 1) * 16 + swz / 64; C = (st & 1) * 32 + (swz % 64) / 2; }
__host__ __device__ __forceinline__ int perm32(int rho) { const int n = rho >> 4, i = rho & 15; return 8 * (i >> 2) + 4 * n + (i & 3); }
struct Unit { int pm, pn; };
struct Gemm { const bf16_t* A; const bf16_t* Bt; int M, N, K; };
struct StaticOrder {
    int nM, nN, nwg, G, c;
    __host__ __device__ void init(int M_, int N_, int G_, int c_) { nM = M_ / BM; nN = N_ / BM; nwg = nM * nN; G = G_; c = c_; }
    __host__ __device__ bool next(int i, Unit& u) const {
        const long L = (long)i * G + c; if (L >= nwg) return false;
        int wgid = (int)L; { const int q = nwg / NXCD, r = nwg % NXCD, xcd = wgid % NXCD, off = wgid / NXCD; wgid = (xcd < r ? xcd * (q + 1) : r * (q + 1) + (xcd - r) * q) + off; }
        const int nig = WGM * nN, gid = wgid / nig, fm = gid * WGM, gsz = (nM - fm) < WGM ? (nM - fm) : WGM;
        u.pm = fm + ((wgid % nig) % gsz); u.pn = (wgid % nig) / gsz; return true;
    }
    __device__ __forceinline__ void a_ready(const Unit&) const {}
    __device__ __forceinline__ void done(const Unit&) const {}
};
struct EpiBf16 {
    static constexpr bool PERM = true, I8 = false; typedef f32x4 acc_t;
    bf16_t* O; int ldc;
    __device__ __forceinline__ void operator()(const f32x4 (&acc)[2][2][4][2], const Unit& u, int wr, int wc, int fr, int fq) const {
        const int row0 = u.pm * BM + wr * 64 + fr; const int col0 = u.pn * BM + wc * 32 + 8 * fq;
#pragma unroll
        for (int ai = 0; ai < 2; ++ai)
#pragma unroll
            for (int m = 0; m < 4; ++m) { bf16_t* rowp = O + (size_t)(row0 + ai * HALF + m * 16) * ldc + col0;
#pragma unroll
                for (int bj = 0; bj < 2; ++bj) { const f32x4 v0 = acc[ai][bj][m][0], v1 = acc[ai][bj][m][1];
                    u32x4 w; w.x = pkbf_c(v0[0], v0[1]); w.y = pkbf_c(v0[2], v0[3]); w.z = pkbf_c(v1[0], v1[1]); w.w = pkbf_c(v1[2], v1[3]);
                    *(u32x4*)(rowp + bj * HALF) = w; } }
    }
};
struct EpiBf16I8 {
    static constexpr bool PERM = true, I8 = true; typedef i32x4 acc_t;
    bf16_t* O; int ldc; const float* sa; const float* wmax;
    __device__ __forceinline__ void operator()(const i32x4 (&acc)[2][2][4][2], const Unit& u, int wr, int wc, int fr, int fq) const {
        const int row0 = u.pm * BM + wr * 64 + fr; const int col0 = u.pn * BM + wc * 32 + 8 * fq;
        f32x4 sw[2][2];
#pragma unroll
        for (int bj = 0; bj < 2; ++bj)
#pragma unroll
            for (int n = 0; n < 2; ++n) sw[bj][n] = *(const f32x4*)(wmax + col0 + bj * HALF + 4 * n) * (1.f / 127.f);
#pragma unroll
        for (int ai = 0; ai < 2; ++ai)
#pragma unroll
            for (int m = 0; m < 4; ++m) { const int row = row0 + ai * HALF + m * 16; const float sr = sa[row]; bf16_t* rowp = O + (size_t)row * ldc + col0;
#pragma unroll
                for (int bj = 0; bj < 2; ++bj) { const i32x4 a0 = acc[ai][bj][m][0], a1 = acc[ai][bj][m][1];
                    const f32x4 v0 = (f32x4){(float)a0[0], (float)a0[1], (float)a0[2], (float)a0[3]} * sw[bj][0] * sr, v1 = (f32x4){(float)a1[0], (float)a1[1], (float)a1[2], (float)a1[3]} * sw[bj][1] * sr;
                    u32x4 w; w.x = pkbf(v0[0], v0[1]); w.y = pkbf(v0[2], v0[3]); w.z = pkbf(v1[0], v1[1]); w.w = pkbf(v1[2], v1[3]);
                    *(u32x4*)(rowp + bj * HALF) = w; } }
    }
};
struct EpiRes {
    static constexpr bool PERM = false, I8 = false; typedef f32x4 acc_t;
    const float* src_lat; const float* src_ctx; float* dst_lat; float* dst_ctx; const float* gate;
    __device__ __forceinline__ void operator()(const f32x4 (&acc)[2][2][4][2], const Unit& u, int wr, int wc, int fr, int fq) const {
        const bool isctx = u.pm >= (ML / BM);
        const float* src = isctx ? src_ctx + (size_t)(u.pm - ML / BM) * BM * D : src_lat + (size_t)u.pm * BM * D;
        float* dst = isctx ? dst_ctx + (size_t)(u.pm - ML / BM) * BM * D : dst_lat + (size_t)u.pm * BM * D;
        const int mrow = isctx ? 2 : (u.pm >= (T / BM) ? 1 : 0);
        const int row0 = wr * 64 + fr, col0 = u.pn * BM + wc * 32 + 4 * fq;
        f32x4 gv[2][2];
#pragma unroll
        for (int bj = 0; bj < 2; ++bj)
#pragma unroll
            for (int n = 0; n < 2; ++n) gv[bj][n] = *(const f32x4*)(gate + mrow * 6144 + col0 + bj * HALF + n * 16);
#pragma unroll
        for (int ai = 0; ai < 2; ++ai)
#pragma unroll
            for (int m = 0; m < 4; ++m) { const size_t off = (size_t)(row0 + ai * HALF + m * 16) * D + col0;
#pragma unroll
                for (int bj = 0; bj < 2; ++bj)
#pragma unroll
                    for (int n = 0; n < 2; ++n) { const f32x4 s = *(const f32x4*)(src + off + bj * HALF + n * 16);
                        *(f32x4*)(dst + off + bj * HALF + n * 16) = s + gv[bj][n] * acc[ai][bj][m][n]; } }
    }
};

struct EpiResI8 {
    static constexpr bool PERM = false, I8 = true; typedef i32x4 acc_t;
    const float* src_lat; const float* src_ctx; float* dst_lat; float* dst_ctx; const float* gate; const float* sa; const float* wmax;
    __device__ __forceinline__ void operator()(const i32x4 (&acc)[2][2][4][2], const Unit& u, int wr, int wc, int fr, int fq) const {
        const bool isctx = u.pm >= (ML / BM);
        const float* src = isctx ? src_ctx + (size_t)(u.pm - ML / BM) * BM * D : src_lat + (size_t)u.pm * BM * D;
        float* dst = isctx ? dst_ctx + (size_t)(u.pm - ML / BM) * BM * D : dst_lat + (size_t)u.pm * BM * D;
        const int mrow = isctx ? 2 : (u.pm >= (T / BM) ? 1 : 0);
        const int row0 = wr * 64 + fr, col0 = u.pn * BM + wc * 32 + 4 * fq;
        f32x4 gv[2][2];
#pragma unroll
        for (int bj = 0; bj < 2; ++bj)
#pragma unroll
            for (int n = 0; n < 2; ++n) gv[bj][n] = *(const f32x4*)(gate + mrow * 6144 + col0 + bj * HALF + n * 16) * *(const f32x4*)(wmax + col0 + bj * HALF + n * 16) * (1.f / 127.f);
#pragma unroll
        for (int ai = 0; ai < 2; ++ai)
#pragma unroll
            for (int m = 0; m < 4; ++m) { const int rl = row0 + ai * HALF + m * 16; const float sr = sa[u.pm * BM + rl]; const size_t off = (size_t)rl * D + col0;
#pragma unroll
                for (int bj = 0; bj < 2; ++bj)
#pragma unroll
                    for (int n = 0; n < 2; ++n) { const f32x4 sv = *(const f32x4*)(src + off + bj * HALF + n * 16); const i32x4 ac = acc[ai][bj][m][n];
                        *(f32x4*)(dst + off + bj * HALF + n * 16) = sv + gv[bj][n] * ((f32x4){(float)ac[0], (float)ac[1], (float)ac[2], (float)ac[3]} * sr); } }
    }
};
template <class Epi, class Sched>
__device__ __forceinline__ void gemm_phase(LAS unsigned char* lds, const Gemm g, const Sched& S, const Epi& E) {
    constexpr bool I8 = Epi::I8;
    typedef typename Epi::acc_t acc_t;
    int tid = threadIdx.x; asm volatile("" : "+v"(tid)); const int wid = __builtin_amdgcn_readfirstlane(tid >> 6), lane = tid & 63, wr = wid >> 2, wc = wid & 3, fr = lane & 15, fq = lane >> 4;
    const int K = g.K, nt = K / BK;
    unsigned voffA[2], voffB[2];
#pragma unroll
    for (int i = 0; i < 2; ++i) { int R, C; stage_rc(tid * 16 + i * 8192, R, C); const int Rb = Epi::PERM ? ((R & ~31) + perm32(R & 31)) : R;
        voffA[i] = (unsigned)(R * K + C) * 2u; voffB[i] = (unsigned)(Rb * K + C) * 2u; }
    const size_t kstep = (size_t)(BK * 2);
    const size_t hstep = (size_t)HALF * K * 2;
    const size_t tstep = 2 * hstep;
    const unsigned ldsw = (unsigned)wid * 1024u;
    const int aoff = lds_byte(wr * 64 + fr, fq * 8), boff = lds_byte(wc * 32 + fr, fq * 8);
#define PG8_SA(b, h) (((b) * 2 + (h)) * HTB)
#define PG8_SB(b, h) ((4 + (b) * 2 + (h)) * HTB)
#define PG8_STAGE(bufoff, gbase, voff) do { _Pragma("unroll") for (int _i = 0; _i < 2; ++_i) \
        __builtin_amdgcn_global_load_lds((const unsigned*)((const char*)(gbase) + (voff)[_i]), (LAS unsigned*)(lds + (bufoff) + ldsw + _i * 8192), 16, 0, 0); } while (0)
#define PG8_LDA(dst, b, h) do { _Pragma("unroll") for (int m = 0; m < 4; ++m) _Pragma("unroll") for (int k = 0; k < 2; ++k) dst[m][k] = *(const LAS bf16x8*)(lds + PG8_SA(b, h) + aoff + m * 2048 + k * 1024); } while (0)
#define PG8_LDB(dst, b, h) do { _Pragma("unroll") for (int n = 0; n < 2; ++n) _Pragma("unroll") for (int k = 0; k < 2; ++k) dst[n][k] = *(const LAS bf16x8*)(lds + PG8_SB(b, h) + boff + n * 2048 + k * 1024); } while (0)
#define PG8_MMA(ai, bj, At, Bt) do { __builtin_amdgcn_s_setprio(1); _Pragma("unroll") for (int m = 0; m < 4; ++m) _Pragma("unroll") for (int n = 0; n < 2; ++n) _Pragma("unroll") for (int k = 0; k < 2; ++k) \
        { if constexpr (I8) acc[ai][bj][m][n] = __builtin_bit_cast(acc_t, __builtin_amdgcn_mfma_i32_16x16x64_i8(__builtin_bit_cast(i32x4, Bt[n][k]), __builtin_bit_cast(i32x4, At[m][k]), __builtin_bit_cast(i32x4, acc[ai][bj][m][n]), 0, 0, 0)); \
          else acc[ai][bj][m][n] = __builtin_bit_cast(acc_t, __builtin_amdgcn_mfma_f32_16x16x32_bf16(Bt[n][k], At[m][k], __builtin_bit_cast(f32x4, acc[ai][bj][m][n]), 0, 0, 0)); } __builtin_amdgcn_s_setprio(0); } while (0)
#define PG8_WAIT_V(n) asm volatile("s_waitcnt vmcnt(" #n ")" ::: "memory")
#define PG8_WAIT_L(n) asm volatile("s_waitcnt lgkmcnt(" #n ")" ::: "memory")
#define PG8_BAR __builtin_amdgcn_s_barrier()
#define PG8_SCHED __builtin_amdgcn_sched_barrier(0)
    Unit cur, nxt; int ui = 0;
    if (!S.next(0, cur)) return;
    acc_t acc[2][2][4][2];
#pragma unroll
    for (int a = 0; a < 2; ++a)
#pragma unroll
        for (int b = 0; b < 2; ++b)
#pragma unroll
            for (int m = 0; m < 4; ++m)
#pragma unroll
                for (int n = 0; n < 2; ++n) acc[a][b][m][n] = acc_t{};
    bf16x8 At[4][2], B0[2][2], B1[2][2];
    const char* cA = (const char*)g.A + (size_t)cur.pm * tstep; const char* cB = (const char*)g.Bt + (size_t)cur.pn * tstep;
    S.a_ready(cur);
    PG8_STAGE(PG8_SB(0, 0), cB, voffB); PG8_STAGE(PG8_SA(0, 0), cA, voffA); PG8_STAGE(PG8_SB(0, 1), cB + hstep, voffB); PG8_STAGE(PG8_SA(0, 1), cA + hstep, voffA);
    if (wr == 1) PG8_BAR;
    PG8_WAIT_V(4); PG8_BAR;
    PG8_STAGE(PG8_SB(1, 0), cB + kstep, voffB); PG8_STAGE(PG8_SA(1, 0), cA + kstep, voffA); PG8_STAGE(PG8_SB(1, 1), cB + hstep + kstep, voffB);
    PG8_WAIT_V(6); PG8_BAR;
    for (;;) {
        const bool has_next = S.next(ui + 1, nxt);
        const char* nA = has_next ? (const char*)g.A + (size_t)nxt.pm * tstep : cA; const char* nB = has_next ? (const char*)g.Bt + (size_t)nxt.pn * tstep : cB;
        for (int t = 0; t < nt; t += 2) {
            const bool last = (t == nt - 2);
            const char* a1 = cA + (size_t)(t + 1) * kstep;
            const char* a2 = last ? nA : cA + (size_t)(t + 2) * kstep; const char* b2 = last ? nB : cB + (size_t)(t + 2) * kstep;
            const char* a3 = a2 + kstep; const char* b3 = b2 + kstep;
            if (last && has_next) S.a_ready(nxt);
            PG8_LDB(B0, 0, 0); PG8_SCHED; PG8_LDA(At, 0, 0); PG8_STAGE(PG8_SA(1, 1), a1 + hstep, voffA);
            PG8_WAIT_L(8); PG8_BAR; PG8_WAIT_L(0); PG8_MMA(0, 0, At, B0); PG8_BAR; PG8_SCHED;
            PG8_LDB(B1, 0, 1); PG8_STAGE(PG8_SB(0, 0), b2, voffB);
            PG8_BAR; PG8_WAIT_L(0); PG8_MMA(0, 1, At, B1); PG8_BAR;
            PG8_LDA(At, 0, 1); PG8_STAGE(PG8_SA(0, 0), a2, voffA);
            PG8_BAR; PG8_WAIT_L(0); PG8_MMA(1, 0, At, B0); PG8_BAR; PG8_SCHED;
            PG8_STAGE(PG8_SB(0, 1), b2 + hstep, voffB);
            PG8_WAIT_V(6); PG8_BAR; PG8_MMA(1, 1, At, B1); PG8_BAR;
            PG8_LDB(B0, 1, 0); PG8_SCHED; PG8_LDA(At, 1, 0); PG8_STAGE(PG8_SA(0, 1), a2 + hstep, voffA);
            PG8_WAIT_L(8); PG8_BAR; PG8_WAIT_L(0); PG8_MMA(0, 0, At, B0); PG8_BAR; PG8_SCHED;
            PG8_LDB(B1, 1, 1); PG8_STAGE(PG8_SB(1, 0), b3, voffB);
            PG8_BAR; PG8_WAIT_L(0); PG8_MMA(0, 1, At, B1); PG8_BAR;
            PG8_LDA(At, 1, 1); PG8_STAGE(PG8_SA(1, 0), a3, voffA);
            PG8_BAR; PG8_WAIT_L(0); PG8_MMA(1, 0, At, B0); PG8_BAR; PG8_SCHED;
            PG8_STAGE(PG8_SB(1, 1), b3 + hstep, voffB);
            PG8_WAIT_V(6); PG8_BAR; PG8_MMA(1, 1, At, B1); PG8_BAR;
        }
        E(acc, cur, wr, wc, fr, fq); S.done(cur);
        if (!has_next) break;
#pragma unroll
        for (int a = 0; a < 2; ++a)
#pragma unroll
            for (int b = 0; b < 2; ++b)
#pragma unroll
                for (int m = 0; m < 4; ++m)
#pragma unroll
                    for (int n = 0; n < 2; ++n) acc[a][b][m][n] = acc_t{};
        cur = nxt; cA = nA; cB = nB; ++ui;
    }
    PG8_WAIT_V(0);
    if (wr == 0) PG8_BAR;
    PG8_BAR;
#undef PG8_SA
#undef PG8_SB
#undef PG8_STAGE
#undef PG8_LDA
#undef PG8_LDB
#undef PG8_MMA
#undef PG8_WAIT_V
#undef PG8_WAIT_L
#undef PG8_BAR
#undef PG8_SCHED
}
}

namespace att {
constexpr int HD = 128, NW = 8, QBLK = 32, KVBLK = 64;
constexpr float SCALE = 0.088388347648318440f;
constexpr float THR = 8.f;
constexpr int LDQ = 512, LDK = 256;
constexpr size_t SHM_V = KVBLK * HD * 2, SHM_K = KVBLK * HD * 2, SHM_ATTN = 2 * SHM_V + 2 * SHM_K + NW * 64 * 4;
#define KSWZ(row, colB) ((row) * 256 + ((colB) ^ (((row) & 7) << 4)))
#define SBAR() __builtin_amdgcn_sched_barrier(0)
__device__ __forceinline__ int crow(int r, int hi) { return (r & 3) + 8 * (r >> 2) + 4 * hi; }
__device__ __forceinline__ unsigned cvtpk(float lo, float hi) { unsigned r; asm volatile("v_cvt_pk_bf16_f32 %0, %1, %2" : "=v"(r) : "v"(lo), "v"(hi)); return r; }
__device__ __forceinline__ void partialSM(f32x16& p0, f32x16& p1) {
  for (int r = 0; r < 16; ++r) p0[r] = __builtin_amdgcn_exp2f(p0[r]);
}
typedef int i32x8 __attribute__((ext_vector_type(8)));
__device__ __forceinline__ void finishSM(f32x16& p0, f32x16& p1, i32x8& pa) {
  for (int r = 0; r < 16; ++r) p1[r] = __builtin_amdgcn_exp2f(p1[r]);
#pragma unroll
  for (int q = 0; q < 4; ++q) { int w = __builtin_amdgcn_cvt_pk_bf8_f32(p0[4 * q], p0[4 * q + 1], 0, false); w = __builtin_amdgcn_cvt_pk_bf8_f32(p0[4 * q + 2], p0[4 * q + 3], w, true); pa[q] = w;
    int w2 = __builtin_amdgcn_cvt_pk_bf8_f32(p1[4 * q], p1[4 * q + 1], 0, false); w2 = __builtin_amdgcn_cvt_pk_bf8_f32(p1[4 * q + 2], p1[4 * q + 3], w2, true); pa[4 + q] = w2; }
}
constexpr int K8_STRIDE = 144, K8_TILE = KVBLK * K8_STRIDE;
__device__ __forceinline__ void qkt(f32x16& p0, f32x16& p1, const unsigned char* Ks, const i32x8* qr, int r32, int hi, const f32x16& cinit) {
  p0 = cinit; p1 = cinit;
#pragma unroll
  for (int ks = 0; ks < 2; ++ks) {
    const u32x4* a0 = (const u32x4*)(Ks + r32 * K8_STRIDE + 64 * ks + 32 * hi); const u32x4* a1 = (const u32x4*)(Ks + (32 + r32) * K8_STRIDE + 64 * ks + 32 * hi);
    const u32x4 x0 = a0[0], x1 = a0[1], y0 = a1[0], y1 = a1[1];
    const i32x8 k0 = {(int)x0.x, (int)x0.y, (int)x0.z, (int)x0.w, (int)x1.x, (int)x1.y, (int)x1.z, (int)x1.w}, k1 = {(int)y0.x, (int)y0.y, (int)y0.z, (int)y0.w, (int)y1.x, (int)y1.y, (int)y1.z, (int)y1.w};
    p0 = __builtin_amdgcn_mfma_scale_f32_32x32x64_f8f6f4(k0, qr[ks], p0, 0, 0, 0, 0x7F7F7F7F, 0, 0x7C7C7C7C);
    p1 = __builtin_amdgcn_mfma_scale_f32_32x32x64_f8f6f4(k1, qr[ks], p1, 0, 0, 0, 0x7F7F7F7F, 0, 0x7C7C7C7C); }
}
constexpr int V8_STRIDE = 80, V8_TILE = HD * V8_STRIDE;
__device__ __forceinline__ void pv_d0(f32x16* o, f32x16& ol, const unsigned char* Vs, const i32x8& pa, int r32, int hi) {
  { const i32x8 ones = {0x38383838, 0x38383838, 0x38383838, 0x38383838, 0x38383838, 0x38383838, 0x38383838, 0x38383838};
    ol = __builtin_amdgcn_mfma_scale_f32_32x32x64_f8f6f4(pa, ones, ol, 1, 0, 0, 0x7F7F7F7F, 0, 0x7F7F7F7F); }
#pragma unroll
  for (int d0 = 0; d0 < 4; ++d0) { const u32x4* bp = (const u32x4*)(Vs + (32 * d0 + r32) * V8_STRIDE + 32 * hi); const u32x4 x0 = bp[0], x1 = bp[1];
    const i32x8 vb = {(int)x0.x, (int)x0.y, (int)x0.z, (int)x0.w, (int)x1.x, (int)x1.y, (int)x1.z, (int)x1.w};
    o[d0] = __builtin_amdgcn_mfma_scale_f32_32x32x64_f8f6f4(pa, vb, o[d0], 1  , 0  , 0, 0x7F7F7F7F, 0, 0x7F7F7F7F); }
}
__device__ __forceinline__ void attn_dense_body(const unsigned char* __restrict__ Qb, const unsigned char* __restrict__ Kh, const unsigned char* __restrict__ Vt,
                                                bf16_t* __restrict__ Ob, int LDO, int seq, char* lds, float* __restrict__ lse, float braw) {
  int tid = threadIdx.x; asm volatile("" : "+v"(tid)); const int wid = tid >> 6, lane = tid & 63, r32 = lane & 31, hi = lane >> 5;
  unsigned char* V_lds = (unsigned char*)lds; unsigned char* K_lds = (unsigned char*)(lds + 3 * V8_TILE);
  f32x16 o[4] = {}, ol = {}; i32x8 qr[2];
  const float mnC = __builtin_bit_cast(float, __builtin_amdgcn_readfirstlane(__builtin_bit_cast(int, -fmaxf(braw * (SCALE * 1.4426950408889634f) - 15.5f, 0.f))));
  f32x16 cinit;
#pragma unroll
  for (int r = 0; r < 16; ++r) cinit[r] = mnC;
  const unsigned char* Qw = Qb + (long)(wid * QBLK + r32) * LDQ + hi * 32;
#pragma unroll
  for (int ks = 0; ks < 2; ++ks) { const u32x4 x0 = *(const u32x4*)(Qw + 64 * ks), x1 = *(const u32x4*)(Qw + 64 * ks + 16);
    qr[ks] = (i32x8){(int)x0.x, (int)x0.y, (int)x0.z, (int)x0.w, (int)x1.x, (int)x1.y, (int)x1.z, (int)x1.w}; }
  const int krow = tid >> 3, kch = tid & 7;
  const int vrow = tid >> 2, vch = tid & 3;
  struct { u32x4 v8, k8; } sr_[2];
#define SLOAD(i, k0) do { sr_[i].v8 = *reinterpret_cast<const u32x4*>(Vt + (long)((k0) >> 6) * 8192 + tid * 16); \
    sr_[i].k8 = *reinterpret_cast<const u32x4*>(Kh + (long)((k0) + krow) * LDK + kch * 16); } while (0)
#define SWRITE(b, i) do { *(u32x4*)(V_lds + (b) * V8_TILE + vrow * V8_STRIDE + vch * 16) = sr_[i].v8; \
    *(u32x4*)(K_lds + (b) * K8_TILE + krow * K8_STRIDE + kch * 16) = sr_[i].k8; } while (0)
#define SWAIT() asm volatile("s_waitcnt vmcnt(2)" ::: "memory")
  f32x16 pA0, pA1, pB0, pB1; i32x8 pa; const int NT = seq / KVBLK;
  constexpr int SE = 0, SO = 1;
  SLOAD(SE, 0); asm volatile("s_waitcnt vmcnt(0)" ::: "memory"); SWRITE(0, SE);
  SLOAD(SO, KVBLK); SLOAD(SE, 2 * KVBLK);
  __syncthreads();
  qkt(pA0, pA1, K_lds, qr, r32, hi, cinit); partialSM(pA0, pA1);
  SWAIT(); SWRITE(1, SO); SLOAD(SO, 3 * KVBLK);
  __syncthreads();
  int s0 = 0, s1 = 1, s2 = 2;
  for (int j = 1; j + 1 < NT; j += 2) {
    SBAR(); qkt(pB0, pB1, K_lds + s1 * K8_TILE, qr, r32, hi, cinit);
    finishSM(pA0, pA1, pa); SBAR();
    pv_d0(o, ol, V_lds + s0 * V8_TILE, pa, r32, hi); partialSM(pB0, pB1);
    SBAR(); SWAIT(); SWRITE(s2, SE); SLOAD(SE, (j + 3 < NT ? j + 3 : NT - 1) * KVBLK);
    __syncthreads();
    SBAR(); qkt(pA0, pA1, K_lds + s2 * K8_TILE, qr, r32, hi, cinit);
    finishSM(pB0, pB1, pa); SBAR();
    pv_d0(o, ol, V_lds + s1 * V8_TILE, pa, r32, hi); partialSM(pA0, pA1);
    SBAR(); SWAIT(); SWRITE(s0, SO); SLOAD(SO, (j + 4 < NT ? j + 4 : NT - 1) * KVBLK);
    __syncthreads();
    { const int t_ = s0; s0 = s2; s2 = s1; s1 = t_; }
  }
  SBAR(); qkt(pB0, pB1, K_lds + s1 * K8_TILE, qr, r32, hi, cinit);
  finishSM(pA0, pA1, pa); SBAR();
  pv_d0(o, ol, V_lds + s0 * V8_TILE, pa, r32, hi); partialSM(pB0, pB1);
  finishSM(pB0, pB1, pa); SBAR();
  pv_d0(o, ol, V_lds + s1 * V8_TILE, pa, r32, hi);
  asm volatile("s_waitcnt vmcnt(0)" ::: "memory");
  if (lse && r32 == 0) {
#pragma unroll
    for (int r = 0; r < 16; ++r) lse[(wid * QBLK + crow(r, hi)) * 4] = __logf(ol[r]) - mnC * 0.69314718055994531f; }
  float rli[16];
#pragma unroll
  for (int r = 0; r < 16; ++r) rli[r] = __builtin_amdgcn_rcpf(ol[r]);
  bf16_t* Ow = Ob + (long)(wid * QBLK) * LDO;
#pragma unroll
  for (int r = 0; r < 16; ++r) { int orow = crow(r, hi);
    for (int d0 = 0; d0 < 4; ++d0) Ow[(long)orow * LDO + d0 * 32 + r32] = (bf16_t)(pkbf(o[d0][r] * rli[r], 0.f) & 0xffffu); }
  __syncthreads();
#undef SLOAD
#undef SWRITE
#undef SWAIT
}
}

struct Args { const float* in[20]; float* out; unsigned char* ws; int ph_lo, ph_hi; };
typedef const __attribute__((address_space(4))) Args* KArgs;
__device__ __forceinline__ KArgs get_args() { KArgs p = (KArgs)__builtin_amdgcn_kernarg_segment_ptr(); asm volatile("" : "+s"(p)); return p; }
__device__ __forceinline__ int fresh_tid() { int t = threadIdx.x; asm volatile("" : "+v"(t)); return t; }
__device__ __forceinline__ int fresh_bx() { int t = blockIdx.x; asm volatile("" : "+s"(t)); return t; }
__device__ __forceinline__ int fresh_g() { int t = gridDim.x; asm volatile("" : "+s"(t)); return t; }
enum { I_X = 0, I_C, I_CTX, I_CCTX, I_ADAW, I_ADAB, I_N1W, I_N2W, I_WIN, I_QNW, I_KNW, I_CONVW, I_ALOG, I_DTB, I_DNW, I_WOUT, I_WQ, I_SUBK, I_U, I_V };

__device__ __forceinline__ void convert_tables(const float* U, const float* V, unsigned char* ws, int l, int wvi, int nwv, int lane, int rw_end = 2 * NEXP) {
    const float* us = U + (size_t)l * NEXP * 1024; const float* vs = V + (size_t)l * NEXP * 1024;
    const int set = l & 1;
    float* scl = (float*)(ws + WS_USC) + set * 2 * NEXP;
    for (int rw = wvi; rw < rw_end; rw += nwv) {
        const bool isu = rw < NEXP; const int e = isu ? rw : rw - NEXP;
        const f32x4* sp = (const f32x4*)((isu ? us : vs) + (size_t)e * 1024 + 16 * lane);
        f32x4 x[4]; float mx = 0.f;
#pragma unroll
        for (int i = 0; i < 4; ++i) { x[i] = sp[i]; mx = fmaxf(mx, fmaxf(fmaxf(fabsf(x[i][0]), fabsf(x[i][1])), fmaxf(fabsf(x[i][2]), fabsf(x[i][3])))); }
        mx = wave_max(mx);
        const float sc = fmaxf(mx, 1e-30f) * (1.f / 127.f), inv = 1.f / sc;
        u32x4 o4;
        const float ofs = ((GATHER_PART && isu) || GATHER_PART == 2) ? 0.f : 128.f;
#pragma unroll
        for (int i = 0; i < 4; ++i) { const unsigned b0 = (unsigned)(int)(rintf(x[i][0] * inv) + ofs) & 255u, b1 = (unsigned)(int)(rintf(x[i][1] * inv) + ofs) & 255u, b2 = (unsigned)(int)(rintf(x[i][2] * inv) + ofs) & 255u, b3 = (unsigned)(int)(rintf(x[i][3] * inv) + ofs) & 255u;
            o4[i] = b0 | (b1 << 8) | (b2 << 16) | (b3 << 24); }
        if (GATHER_PART == 2) *(u32x4*)(ws + WS_UB + (size_t)set * TAB_SET + (isu ? 0 : (size_t)NEXP * 1024) + ((size_t)(lane >> 3) * NEXP + e) * 128 + 16 * (lane & 7)) = o4;
        else *(u32x4*)(ws + WS_UB + (size_t)set * TAB_SET + (size_t)e * 2048 + (isu ? 0 : 1024) + 16 * lane) = o4;
        if (lane == 0) { if (GATHER_PART) scl[2 * e + (isu ? 0 : 1)] = sc; else scl[rw] = sc; }
    }
}

__device__ __forceinline__ void transpose_item(const float* W, int ldw, int K, bf16_t* WT, LAS float* scr, int kb, int nb, int lane) {
    const int k0 = 64 * kb, n0 = 32 * nb;
#pragma unroll 8
    for (int i = 0; i < 32; ++i) { const int kk = 2 * i + (lane >> 5); scr[kk * 33 + (lane & 31)] = W[(size_t)(k0 + kk) * ldw + n0 + (lane & 31)]; }
    LDS_WAIT(); asm volatile("" ::: "memory");
    const int c = lane & 7;
#pragma unroll
    for (int j = 0; j < 4; ++j) { const int n = (lane >> 3) + 8 * j; const LAS float* s = scr + (8 * c) * 33 + n;
        u32x4 o; o.x = pkbf(s[0 * 33], s[1 * 33]); o.y = pkbf(s[2 * 33], s[3 * 33]); o.z = pkbf(s[4 * 33], s[5 * 33]); o.w = pkbf(s[6 * 33], s[7 * 33]);
        *(u32x4*)(WT + (size_t)(n0 + n) * K + k0 + 8 * c) = o; }
    LDS_WAIT(); asm volatile("" ::: "memory");
}
__device__ __forceinline__ void phase_prologue(LAS unsigned char* lds) {
    const KArgs ap = get_args();
#define a (*ap)

    const int tid = fresh_tid(), lane = tid & 63, wave = __builtin_amdgcn_readfirstlane(tid >> 6), G = fresh_g(), bx = fresh_bx();
    unsigned char* ws = a.ws;
    {
        LAS float* sc = (LAS float*)(lds + 70000);
        LAS float* part = (LAS float*)(lds + 70000 + 12288);
        for (int i = tid; i < 3 * 1024; i += 512) { const int r = i >> 10, k = i & 1023; const float v = r < 2 ? a.in[I_C][r * 1024 + k] : a.in[I_CCTX][k]; sc[i] = silu_f(v); }
        __syncthreads();
        float* mod = (float*)(ws + WS_MOD);
        for (int item = bx; item < DEPTH * 96; item += G) {
            const int l = item / 96, j0 = (item % 96) * 64;
            const float* wp = a.in[I_ADAW] + (size_t)l * 1024 * 6144 + (size_t)(wave * 128) * 6144 + j0 + lane;
            float a0 = 0.f, a1 = 0.f, a2 = 0.f;
#pragma unroll 8
            for (int kk = 0; kk < 128; ++kk) { const float w = wp[(size_t)kk * 6144]; const int k = wave * 128 + kk; a0 = fmaf(sc[k], w, a0); a1 = fmaf(sc[1024 + k], w, a1); a2 = fmaf(sc[2048 + k], w, a2); }
            part[(wave * 3 + 0) * 64 + lane] = a0; part[(wave * 3 + 1) * 64 + lane] = a1; part[(wave * 3 + 2) * 64 + lane] = a2;
            __syncthreads();
            if (tid < 192) { const int r = tid >> 6, jj = tid & 63; float s = a.in[I_ADAB][l * 6144 + j0 + jj];
#pragma unroll
                for (int w = 0; w < 8; ++w) s += part[(w * 3 + r) * 64 + jj];
                mod[(size_t)(l * 3 + r) * 6144 + j0 + jj] = s; }
            __syncthreads();
        }
    }
    {
        const int gw = bx * 8 + wave, NGW = G * 8;
        unsigned* wmaxw = (unsigned*)(ws + WS_CTL) + CW_WMAX;
        constexpr int NB_IN = NP / 64, NB_OUT = 1024 / 64, NB_Q = 2048 / 64, PER_L2 = (NB_IN + NB_OUT + NB_Q) * 8;
        for (int it = gw; it < DEPTH * PER_L2; it += NGW) { const int l = it / PER_L2; int r = it % PER_L2; const int kc = r & 7; r >>= 3;
            const int mi = r < NB_IN ? 0 : r < NB_IN + NB_OUT ? 1 : 2; const int nb = mi == 0 ? r : mi == 1 ? r - NB_IN : r - NB_IN - NB_OUT; const int ldw = mi == 0 ? NIN : mi == 1 ? 1024 : 2048;
            const float* wp = (mi == 0 ? a.in[I_WIN] + (size_t)l * 1024 * NIN : mi == 1 ? a.in[I_WOUT] + (size_t)l * 1024 * 1024 : a.in[I_WQ] + (size_t)l * 1024 * 2048) + (size_t)(kc * 128) * ldw + nb * 64 + lane;
            float mx = 0.f;
#pragma unroll 8
            for (int kk = 0; kk < 128; ++kk) mx = fmaxf(mx, fabsf(wp[(size_t)kk * ldw]));
            atomicMax(wmaxw + (l * 3 + mi) * 3072 + nb * 64 + lane, __float_as_uint(mx)); }
    }
    const size_t gt = (size_t)bx * 512 + tid, NT = (size_t)G * 512;
    for (size_t i = gt; i < (size_t)DEPTH * 16 * 1024; i += NT) { const int l = (int)(i >> 14), j = (int)((i >> 10) & 15), k = (int)(i & 1023);
        ((float*)(ws + WS_WSK))[i] = a.in[I_WIN][(size_t)l * 1024 * NIN + (size_t)k * NIN + NP + j]; }
    convert_tables(a.in[I_U], a.in[I_V], ws, 0, bx * 8 + wave, G * 8, lane);
    for (size_t i = gt; i < (size_t)DEPTH * 8 * 2 * 128 * 128 / 2; i += NT) { const f32x2 x = ((const f32x2*)a.in[I_SUBK])[i]; ((unsigned*)(ws + WS_SKB))[i] = pkbf(x[0], x[1]); }
    for (size_t i = gt; i < 8192; i += NT) { const int pos = (int)(i >> 5), fi = (int)(i & 31);
        const float inv = exp2f(-(float)fi * (13.287712379549449f / 32.f)); const float ang = (float)pos * inv;
        float rev = ang * 0.15915494309189535f; rev -= floorf(rev);
        ((float*)(ws + WS_ROPE))[i] = __builtin_amdgcn_cosf(rev); ((float*)(ws + WS_ROPE))[8192 + i] = __builtin_amdgcn_sinf(rev); }
}


__device__ __forceinline__ void quant_transpose_item(const float* W, int ldw, signed char* WT, const unsigned* wmaxw, LAS float* scr, int kb, int nb, int lane) {
    const int k0 = 64 * kb, n0 = 32 * nb;
#pragma unroll 8
    for (int i = 0; i < 32; ++i) { const int kk = 2 * i + (lane >> 5); scr[kk * 33 + (lane & 31)] = W[(size_t)(k0 + kk) * ldw + n0 + (lane & 31)]; }
    LDS_WAIT(); asm volatile("" ::: "memory");
    const int n = lane >> 1, hf = lane & 1;
    const float mx = __uint_as_float(wmaxw[n0 + n]), inv = mx > 0.f ? 127.f / mx : 0.f;
    u32x4 o[2];
#pragma unroll
    for (int q = 0; q < 8; ++q) { unsigned w = 0u;
#pragma unroll
        for (int b = 0; b < 4; ++b) { const int kk = 32 * hf + 4 * q + b; w |= ((unsigned)(int)rintf(scr[kk * 33 + n] * inv) & 255u) << (8 * b); }
        o[q >> 2][q & 3] = w; }
    u32x4* dst = (u32x4*)(WT + (size_t)(n0 + n) * 1024 + k0 + 32 * hf);
    dst[0] = o[0]; dst[1] = o[1];
    LDS_WAIT(); asm volatile("" ::: "memory");
}
__device__ __forceinline__ void phase_quant_weights(LAS unsigned char* lds) {
    const KArgs ap = get_args();
#define a (*ap)
    const int tid = fresh_tid(), lane = tid & 63, wave = __builtin_amdgcn_readfirstlane(tid >> 6), G = fresh_g(), bx = fresh_bx();
    unsigned char* ws = a.ws;
    LAS float* scr = (LAS float*)(lds + 65536 + wave * 8448);
    const unsigned* wmaxw = (const unsigned*)(ws + WS_CTL) + CW_WMAX;
    constexpr int I_IN = 16 * 96, I_OUT = 16 * 32, I_Q = 16 * 64, PER_L = I_IN + I_OUT + I_Q;
    for (int it = bx * 8 + wave; it < DEPTH * PER_L; it += G * 8) { const int l = it / PER_L; int r = it % PER_L;
        if (r < I_IN) quant_transpose_item(a.in[I_WIN] + (size_t)l * 1024 * NIN, NIN, (signed char*)(ws + WS_WINT) + (size_t)l * NP * 1024, wmaxw + (l * 3 + 0) * 3072, scr, r / 96, r % 96, lane);
        else if (r < I_IN + I_OUT) { r -= I_IN; quant_transpose_item(a.in[I_WOUT] + (size_t)l * 1024 * 1024, 1024, (signed char*)(ws + WS_WOUTT) + (size_t)l * 1024 * 1024, wmaxw + (l * 3 + 1) * 3072, scr, r / 32, r % 32, lane); }
        else { r -= I_IN + I_OUT; quant_transpose_item(a.in[I_WQ] + (size_t)l * 1024 * 2048, 2048, (signed char*)(ws + WS_WQT) + (size_t)l * 2048 * 1024, wmaxw + (l * 3 + 2) * 3072, scr, r / 64, r % 64, lane); } }
#undef a
}

template <bool SK>
__device__ __forceinline__ void phase_norm(int l, int which, LAS unsigned char* lds) {
    const KArgs ap = get_args();
#define a (*ap)

    const int tid = fresh_tid(), lane = tid & 63, wave = __builtin_amdgcn_readfirstlane(tid >> 6), G = fresh_g(), bx = fresh_bx();
    unsigned char* ws = a.ws;
    LAS float* wsk = (LAS float*)lds;
    if (SK) { const float* src = (const float*)(ws + WS_WSK) + (size_t)l * 16384; for (int i = tid; i < 16384 / 4; i += 512) ((LAS f32x4*)wsk)[i] = ((const f32x4*)src)[i]; __syncthreads(); }
    const int nrows = (which == 1 && l == DEPTH - 1) ? ML : M;
    const float* nw = a.in[which ? I_N2W : I_N1W] + l * 1024;
    const float* modl = (const float*)(ws + WS_MOD) + (size_t)l * 3 * 6144;
    const int shoff = which ? 3072 : 0, scoff = which ? 4096 : 1024;
    f32x4 nwv[4];
#pragma unroll
    for (int j = 0; j < 4; ++j) nwv[j] = *(const f32x4*)(nw + 4 * lane + 256 * j);
    for (int row = wave * G + bx; row < nrows; row += G * 8) {
        const float* src; int mrow;
        if (row < ML) { src = ((l == 0 && which == 0) ? a.in[I_X] : a.out) + (size_t)row * D; mrow = row >= T ? 1 : 0; }
        else { src = ((l == 0 && which == 0) ? a.in[I_CTX] : (const float*)(ws + WS_CTXX)) + (size_t)(row - ML) * D; mrow = 2; }
        const float* md = modl + mrow * 6144;
        f32x4 v[4]; float ss = 0.f;
#pragma unroll
        for (int j = 0; j < 4; ++j) { v[j] = *(const f32x4*)(src + 4 * lane + 256 * j); ss += (v[j][0] * v[j][0] + v[j][1] * v[j][1]) + (v[j][2] * v[j][2] + v[j][3] * v[j][3]); }
        const float rstd = rsqrtf(wave_sum(ss) * (1.f / D) + EPS);
        signed char* hrow = (signed char*)(ws + WS_H) + (size_t)row * D;
        float hmx = 0.f;
#pragma unroll
        for (int j = 0; j < 4; ++j) { const f32x4 sc = *(const f32x4*)(md + scoff + 4 * lane + 256 * j), sh = *(const f32x4*)(md + shoff + 4 * lane + 256 * j);
            v[j] = v[j] * rstd * nwv[j] * (sc + 1.f) + sh; hmx = fmaxf(hmx, fmaxf(fmaxf(fabsf(v[j][0]), fabsf(v[j][1])), fmaxf(fabsf(v[j][2]), fabsf(v[j][3])))); }
        hmx = fmaxf(wave_max(hmx), 1e-30f);
        { const float hinv = 127.f / hmx;
#pragma unroll
          for (int j = 0; j < 4; ++j) *(unsigned*)(hrow + 4 * lane + 256 * j) = ((unsigned)(int)rintf(v[j][0] * hinv) & 255u) | (((unsigned)(int)rintf(v[j][1] * hinv) & 255u) << 8) | (((unsigned)(int)rintf(v[j][2] * hinv) & 255u) << 16) | (((unsigned)(int)rintf(v[j][3] * hinv) & 255u) << 24);
          if (lane == 0) ((float*)(ws + WS_GB))[row] = hmx * (1.f / 127.f); }
        if (SK) {
            float p[16];
#pragma unroll
            for (int c = 0; c < 16; ++c) { float q = 0.f;
#pragma unroll
                for (int j = 0; j < 4; ++j) { const f32x4 w = *(const LAS f32x4*)(wsk + c * 1024 + 4 * lane + 256 * j); q += (v[j][0] * w[0] + v[j][1] * w[1]) + (v[j][2] * w[2] + v[j][3] * w[3]); }
                p[c] = q; }
            { const bool hb = (lane & 32) != 0;
#pragma unroll
              for (int c = 0; c < 8; ++c) { const float keep = hb ? p[c + 8] : p[c], send = hb ? p[c] : p[c + 8]; p[c] = keep + lane_xor<32>(send); } }
            { const bool hb = (lane & 16) != 0;
#pragma unroll
              for (int c = 0; c < 4; ++c) { const float keep = hb ? p[c + 4] : p[c], send = hb ? p[c] : p[c + 4]; p[c] = keep + lane_xor<16>(send); } }
            { const bool hb = (lane & 8) != 0;
#pragma unroll
              for (int c = 0; c < 2; ++c) { const float keep = hb ? p[c + 2] : p[c], send = hb ? p[c] : p[c + 2]; p[c] = keep + lane_xor<8>(send); } }
            { const bool hb = (lane & 4) != 0; const float keep = hb ? p[1] : p[0], send = hb ? p[0] : p[1]; p[0] = keep + lane_xor<4>(send); }
            p[0] += lane_xor<2>(p[0]); p[0] += lane_xor<1>(p[0]);
            if ((lane & 3) == 0) { const int c = ((lane >> 5) & 1) * 8 + ((lane >> 4) & 1) * 4 + ((lane >> 3) & 1) * 2 + ((lane >> 2) & 1); ((float*)(ws + WS_BA))[(size_t)row * 16 + c] = p[0]; }
        }
    }
    if (SK) __syncthreads();
}

__device__ __forceinline__ void phase_prep(int l, LAS unsigned char* lds) {
    const KArgs ap = get_args();
#define a (*ap)

    const int tid = fresh_tid(), lane = tid & 63, wave = __builtin_amdgcn_readfirstlane(tid >> 6), G = fresh_g(), bx = fresh_bx();
    unsigned char* ws = a.ws;
    const bf16_t* P = (const bf16_t*)(ws + WS_P);
    const float* ropec = (const float*)(ws + WS_ROPE); const float* ropes = ropec + 8192;
    const int sec = lane >> 5, fi = lane & 31;
    const float qw0 = a.in[I_QNW][l * 128 + sec * 64 + fi], qw1 = a.in[I_QNW][l * 128 + sec * 64 + 32 + fi];
    const float kw0 = a.in[I_KNW][l * 128 + sec * 64 + fi], kw1 = a.in[I_KNW][l * 128 + sec * 64 + 32 + fi];
    for (int row = wave * G + bx; row < M; row += G * 8) {
        const bool lat = row < ML;
        int b, tt, tlen; if (lat) { b = row >> 14; tt = row & (T - 1); tlen = T; } else { b = (row - ML) >> 8; tt = (row - ML) & (CT - 1); tlen = CT; }
        const bf16_t* prow = P + (size_t)row * NP;
        unsigned short xa[6][2];
#pragma unroll
        for (int hh = 0; hh < 6; ++hh) { const bf16_t* xp = prow + (hh < 4 ? hh * 128 : 512 + (hh - 4) * 128) + sec * 64 + fi; xa[hh][0] = xp[0]; xa[hh][1] = xp[32]; }
        const u32x2 vcp = *(const u32x2*)(prow + 768 + 4 * lane);
        float cs = 1.f, sn = 0.f;
        if (lat) { const int pos = sec ? (tt & 63) : (tt >> 6); cs = ropec[pos * 32 + fi]; sn = ropes[pos * 32 + fi]; }
        unsigned char* qo8 = ws + WS_QA + (size_t)row * 512;
        const size_t kvrow = (size_t)b * KVLEN + (lat ? tt : T + tt);
        unsigned char* ko8 = ws + WS_KA + kvrow * 256;
        float ssq[6];
#pragma unroll
        for (int hh = 0; hh < 6; ++hh) { const float x0 = bf2f(xa[hh][0]), x1 = bf2f(xa[hh][1]); ssq[hh] = x0 * x0 + x1 * x1; }
#pragma unroll
        for (int hh = 0; hh < 6; ++hh) ssq[hh] = wave_sum(ssq[hh]);
#pragma unroll
        for (int hh = 0; hh < 6; ++hh) {
            const float x0 = bf2f(xa[hh][0]), x1 = bf2f(xa[hh][1]);
            const float rs = rsqrtf(ssq[hh] * (1.f / 128.f) + EPS);
            const float y0 = x0 * rs * (hh < 4 ? qw0 : kw0), y1 = x1 * rs * (hh < 4 ? qw1 : kw1);
            const float qsc = hh < 4 ? 0.088388347648318440f * 1.4426950408889634f : 1.f;
            const float o0 = (y0 * cs - y1 * sn) * qsc, o1 = (y1 * cs + y0 * sn) * qsc;
            unsigned char* op8 = (hh < 4 ? qo8 + hh * 128 : ko8 + (hh - 4) * 128) + sec * 64 + fi;
            const float f8s = hh < 4 ? 8.f : 1.f;
            const int pk8 = __builtin_amdgcn_cvt_pk_fp8_f32(o0 * f8s, o1 * f8s, 0, false);
            op8[0] = (unsigned char)(pk8 & 255); op8[32] = (unsigned char)((pk8 >> 8) & 255);
        }
        { const int pos = lat ? tt : T + tt, tile = pos >> 6, k64 = pos & 63, k32 = k64 & 31;
          const int bytepos = 32 * ((k32 >> 2) & 1) + 16 * (k64 >> 5) + (k32 & 3) + 4 * (k32 >> 3);
          unsigned char* vt = ws + WS_VA + ((size_t)(b * 2) * (KVLEN / 64) + tile) * 8192 + bytepos;
          const unsigned short* vsrc = (const unsigned short*)&vcp;
          const int kvh_ = lane >> 5, d0 = (4 * lane) & 127;
          const int pk01 = __builtin_amdgcn_cvt_pk_fp8_f32(bf2f(vsrc[0]), bf2f(vsrc[1]), 0, false), pk23 = __builtin_amdgcn_cvt_pk_fp8_f32(bf2f(vsrc[2]), bf2f(vsrc[3]), 0, false);
          unsigned char* vt2 = vt + (size_t)kvh_ * (KVLEN / 64) * 8192 + (size_t)d0 * 64;
          vt2[0] = (unsigned char)(pk01 & 255); vt2[64] = (unsigned char)((pk01 >> 8) & 255); vt2[128] = (unsigned char)(pk23 & 255); vt2[192] = (unsigned char)((pk23 >> 8) & 255); }
    }
    __syncthreads();
}

constexpr int ATT_PARTS = 4;
__device__ __forceinline__ void phase_attn(int l, unsigned char* lds_raw, volatile LAS unsigned* MISC, int rep) {
    const KArgs ap = get_args();
#define a (*ap)
    unsigned char* ws = a.ws;
    const unsigned char* QA = ws + WS_QA; const unsigned char* KA = ws + WS_KA; const unsigned char* VT = ws + WS_VA;
    bf16_t* CAT = (bf16_t*)(ws + WS_CAT); float* LSE = (float*)(ws + WS_BA);
    unsigned* ctr = (unsigned*)(ws + WS_CTL) + 8192 + 64 * l + 1024 * rep;
    const int natt = 2048 + (l < DEPTH - 1 ? 8 : 0);
    constexpr int CONV_ROWS = 64, NCONV = 2 * NEXP / CONV_ROWS;
    const int nunits = natt + (l + 1 < DEPTH ? NCONV : 0);
    float braw;
    { const int ln = threadIdx.x & 63; float mq = fmaxf(fabsf(a.in[I_QNW][l * 128 + ln]), fabsf(a.in[I_QNW][l * 128 + 64 + ln])), mk = fmaxf(fabsf(a.in[I_KNW][l * 128 + ln]), fabsf(a.in[I_KNW][l * 128 + 64 + ln]));
      mq = wave_max(mq); mk = wave_max(mk);
      braw = __builtin_bit_cast(float, __builtin_amdgcn_readfirstlane(__builtin_bit_cast(int, 128.f * mq * mk))); }
    if (threadIdx.x == 0) MISC[12] = __hip_atomic_fetch_add(ctr, 1u, __ATOMIC_RELAXED, __HIP_MEMORY_SCOPE_AGENT);
    __syncthreads();
    int u = (int)MISC[12], par = 0;
    for (; u < nunits; ) {
        if (threadIdx.x == 0) MISC[13 - par] = __hip_atomic_fetch_add(ctr, 1u, __ATOMIC_RELAXED, __HIP_MEMORY_SCOPE_AGENT);
        if (u >= natt) {
            const int tq_ = fresh_tid();
            const int rwb = (u - natt) * CONV_ROWS + __builtin_amdgcn_readfirstlane(tq_ >> 6) * 8;
            convert_tables(a.in[I_U], a.in[I_V], ws, l + 1, rwb, 1, tq_ & 63, rwb + 8);
            __syncthreads();
            u = (int)MISC[13 - par]; par ^= 1;
            continue;
        }
        size_t r0, kv0; int h, kvh, seq, ldo; bf16_t* ob; float* lse;
        if (u < 2048) { const int qb = u & 63, g = (u >> 6) & 1, part = (u >> 7) & 3, b = u >> 10; kvh = (u >> 9) & 1; h = kvh * 2 + g;
            const int t0 = (part >> 1) * 130 + (part & 1) * 64;
            r0 = (size_t)b * T + (size_t)qb * 256; kv0 = (size_t)b * KVLEN + (size_t)t0 * 64; seq = ((part & 1) ? 66 : 64) * 64;
            ob = part ? (bf16_t*)(ws + (part == 1 ? WS_DQ : part == 2 ? WS_DK : WS_DV)) + r0 * 512 + h * 128 : CAT + r0 * 1024 + h * 128; ldo = part ? 512 : 1024; lse = LSE + ((size_t)part * ML + r0) * 4 + h; }
        else { const int b = (u - 2048) >> 2; h = (u - 2048) & 3; kvh = h >> 1; r0 = (size_t)ML + (size_t)b * CT; kv0 = (size_t)b * KVLEN + T; seq = CT;
            ob = CAT + r0 * 1024 + h * 128; ldo = 1024; lse = nullptr; }
        att::attn_dense_body(QA + r0 * 512 + h * 128, KA + kv0 * 256 + kvh * 128, VT + ((size_t)((kv0 / KVLEN) * 2 + kvh) * (KVLEN / 64) + (kv0 % KVLEN) / 64) * 8192, ob, ldo, seq, (char*)lds_raw, lse, braw);
        u = (int)MISC[13 - par]; par ^= 1;
    }
#undef a
}

__device__ __forceinline__ int tokperm(int q, int hh, int jj) { return 16 * q + 8 * (jj >> 2) + 4 * hh + (jj & 3); }
__device__ __forceinline__ int crow16(int r, int hi) { return (r & 3) + 8 * (r >> 2) + 4 * hi; }
__device__ __forceinline__ int kperm16(int s_, int g, int jj) { return 32 * s_ + 16 * (jj >> 2) + 4 * g + (jj & 3); }
__device__ __forceinline__ int frag_off(int i, int j) {
    return (((i >> 4) * 2 + (j >> 5)) * 64 + ((i & 15) + 16 * ((j >> 2) & 3))) * 16 + (4 * ((j >> 4) & 1) + (j & 3)) * 2;
}
template <int MODE>
__device__ __forceinline__ void phase_dn_chunkprep(int l, LAS unsigned char* lds) {
    const KArgs ap = get_args();
#define a (*ap)
    const int tid = fresh_tid(), lane = tid & 63, wave = __builtin_amdgcn_readfirstlane(tid >> 6), G = fresh_g(), bx = fresh_bx();
    unsigned char* ws = a.ws;
    constexpr int KT_OFF = 0, QT_OFF = 17408, VT_OFF = 34816, GS_OFF = 52224, RS_OFF = 68864, AM_OFF = 85504, SC_OFF = 120320, IMG_OFF = 0;
    const int r = lane & 31, hh = lane >> 5;
    const bf16_t* DQ = (const bf16_t*)(ws + WS_DQ); const bf16_t* DK = (const bf16_t*)(ws + WS_DK); const bf16_t* DV = (const bf16_t*)(ws + WS_DV);
    const float* BA = (const float*)(ws + WS_BA);
    constexpr int NTASK = MODE ? NB * 4 * 4 : NB * 4 * (NCH - 4);
#define CP_TASKID(t_) (MODE ? ((t_) >> 2) * NCH + ((t_) & 3) : ((t_) >> 8) * NCH + 4 + ((t_) & 255))
    LAS float* gsc = (LAS float*)(lds + SC_OFF);
    LAS float* bsc = gsc + 128;
    LAS float* gcs = gsc + 256;
    constexpr int CW_OFF = 121856, DI_OFF = CW_OFF + 5 * 1536 * 4;
    static_assert(DI_OFF + 8192 <= LDS_MISC, "chunkprep LDS");
    LAS float* cwl = (LAS float*)(lds + CW_OFF);
    for (int i = tid; i < 5 * 1536; i += 512) cwl[i] = a.in[I_CONVW][(size_t)l * 5 * 1536 + i];
    __syncthreads();
    const bf16_t* P = (const bf16_t*)(ws + WS_P);
    u32x4 xin[3][5][2];
#define CP_LOADX(task_) do { const int cidx_ = (task_) % NCH, bh_ = (task_) / NCH, b_ = bh_ >> 2, h_ = bh_ & 3; \
        const int row0_ = cidx_ < 4 ? ML + b_ * CT + cidx_ * 64 : b_ * T + (cidx_ - 4) * 64, tt_ = (cidx_ < 4 ? cidx_ * 64 : (cidx_ - 4) * 64) + (tid >> 3), tlen_ = cidx_ < 4 ? CT : T; \
        _Pragma("unroll") for (int j = 0; j < 5; ++j) { const int t2 = tt_ + j - 2; const bool ok = t2 >= 0 && t2 < tlen_; \
            const bf16_t* xr = P + (size_t)(row0_ + (tid >> 3) + (ok ? j - 2 : 0)) * NP + 1024 + h_ * 128 + (tid & 7) * 16; \
            _Pragma("unroll") for (int m = 0; m < 3; ++m) { const u32x4 w0 = *(const u32x4*)(xr + m * 512), w1 = *(const u32x4*)(xr + m * 512 + 8); \
                xin[m][j][0] = ok ? w0 : (u32x4){0u, 0u, 0u, 0u}; xin[m][j][1] = ok ? w1 : (u32x4){0u, 0u, 0u, 0u}; } } } while (0)
    if (bx < NTASK) CP_LOADX(CP_TASKID(bx));
    for (int tk = bx; tk < NTASK; tk += G) {
        const int task = CP_TASKID(tk);
        const int cidx = task % NCH, bh = task / NCH, b = bh >> 2, h = bh & 3;
        const int row0 = cidx < 4 ? ML + b * CT + cidx * 64 : b * T + (cidx - 4) * 64;
        unsigned char* rec = ws + WS_REC + (size_t)task * REC_BYTES;
        {
            const int rr = tid >> 3, seg = tid & 7;
            if (tid < 128) { const int d = tid >> 6, i = tid & 63, dh = d * 4 + h;
                const float xb = BA[(size_t)(row0 + i) * 16 + dh], z = BA[(size_t)(row0 + i) * 16 + 8 + dh] + a.in[I_DTB][l * 8 + dh];
                bsc[tid] = 1.f / (1.f + __expf(-xb)); gsc[tid] = -__expf(a.in[I_ALOG][l * 8 + dh]) * (fmaxf(z, 0.f) + log1pf(__expf(-fabsf(z)))); }
#pragma unroll
            for (int m = 0; m < 3; ++m) {
                float y[16];
#pragma unroll
                for (int c = 0; c < 16; ++c) y[c] = 0.f;
#pragma unroll
                for (int j = 0; j < 5; ++j) { const LAS float* wp = cwl + j * 1536 + m * 512 + h * 128 + seg * 16;
#pragma unroll
                    for (int q4 = 0; q4 < 4; ++q4) { const f32x4 wv = *(const LAS f32x4*)(wp + 4 * q4); const unsigned u0 = xin[m][j][q4 >> 1][2 * (q4 & 1)], u1 = xin[m][j][q4 >> 1][2 * (q4 & 1) + 1];
                        y[4 * q4 + 0] = fmaf(bflo(u0), wv[0], y[4 * q4 + 0]); y[4 * q4 + 1] = fmaf(bfhi(u0), wv[1], y[4 * q4 + 1]); y[4 * q4 + 2] = fmaf(bflo(u1), wv[2], y[4 * q4 + 2]); y[4 * q4 + 3] = fmaf(bfhi(u1), wv[3], y[4 * q4 + 3]); } }
                float ss = 0.f;
#pragma unroll
                for (int c = 0; c < 16; ++c) { y[c] = silu_f(y[c]); ss = fmaf(y[c], y[c], ss); }
                if (m < 2) { ss += lane_xor<1>(ss); ss += lane_xor<2>(ss); ss += lane_xor<4>(ss);
                    float sc = rsqrtf(ss + EPS); if (m == 0) sc *= 0.088388347648318440f;
#pragma unroll
                    for (int c = 0; c < 16; ++c) y[c] *= sc; }
                u32x4 o0, o1; o0.x = pkbf(y[0], y[1]); o0.y = pkbf(y[2], y[3]); o0.z = pkbf(y[4], y[5]); o0.w = pkbf(y[6], y[7]); o1.x = pkbf(y[8], y[9]); o1.y = pkbf(y[10], y[11]); o1.z = pkbf(y[12], y[13]); o1.w = pkbf(y[14], y[15]);
                LAS unsigned char* dst = lds + (m == 0 ? QT_OFF : m == 1 ? KT_OFF : VT_OFF) + rr * 272 + seg * 32;
                *(LAS u32x4*)dst = o0; *(LAS u32x4*)(dst + 16) = o1;
            }
        }
        __syncthreads();
        {
            const int mat = wave >> 2, ti = (wave >> 1) & 1, tj = wave & 1;
            f32x16 acc = {};
#pragma unroll
            for (int ks = 0; ks < 8; ++ks) {
                const bf16x8 av = *(const LAS bf16x8*)(lds + (mat ? QT_OFF : KT_OFF) + (32 * ti + r) * 272 + (16 * ks + 8 * hh) * 2);
                const bf16x8 bv = *(const LAS bf16x8*)(lds + KT_OFF + (32 * tj + r) * 272 + (16 * ks + 8 * hh) * 2);
                acc = __builtin_amdgcn_mfma_f32_32x32x16_bf16(av, bv, acc, 0, 0, 0);
            }
            LAS float* dst = (LAS float*)(lds + (mat ? RS_OFF : GS_OFF));
#pragma unroll
            for (int i = 0; i < 16; ++i) dst[(32 * ti + crow16(i, hh)) * 65 + 32 * tj + r] = acc[i];
        }
        { const int r16 = lane & 15, g4 = lane >> 4;
#pragma unroll
        for (int t = 0; t < 2; ++t) { const int f = wave * 2 + t, mt = f >> 2, sk = f & 3;
            { const u32x2 lo = *(const LAS u32x2*)(lds + KT_OFF + (16 * mt + r16) * 272 + (32 * sk + 4 * g4) * 2), hi2 = *(const LAS u32x2*)(lds + KT_OFF + (16 * mt + r16) * 272 + (32 * sk + 16 + 4 * g4) * 2);
              *(u32x4*)(rec + REC_K + f * 1024 + lane * 16) = (u32x4){lo.x, lo.y, hi2.x, hi2.y}; }
            { const u32x2 lo = *(const LAS u32x2*)(lds + QT_OFF + (16 * mt + r16) * 272 + (32 * sk + 4 * g4) * 2), hi2 = *(const LAS u32x2*)(lds + QT_OFF + (16 * mt + r16) * 272 + (32 * sk + 16 + 4 * g4) * 2);
              *(u32x4*)(rec + REC_Q + f * 1024 + lane * 16) = (u32x4){lo.x, lo.y, hi2.x, hi2.y}; } }
#pragma unroll
        for (int t = 0; t < 2; ++t) { const int f = wave * 2 + t, mt = f >> 1, sk = f & 1;
            unsigned e[8];
#pragma unroll
            for (int jj = 0; jj < 8; ++jj) e[jj] = *(const LAS unsigned short*)(lds + KT_OFF + kperm16(sk, g4, jj) * 272 + (16 * mt + r16) * 2);
            *(u32x4*)(rec + REC_KT + f * 1024 + lane * 16) = (u32x4){e[0] | (e[1] << 16), e[2] | (e[3] << 16), e[4] | (e[5] << 16), e[6] | (e[7] << 16)}; }
        { const int sl = wave;
            unsigned e[16];
#pragma unroll
            for (int i = 0; i < 16; ++i) e[i] = *(const LAS unsigned short*)(lds + VT_OFF + (16 * (i >> 2) + 4 * g4 + (i & 3)) * 272 + (16 * sl + r16) * 2);
            u32x4* vp = (u32x4*)(rec + REC_V + sl * 2048 + lane * 32);
            vp[0] = (u32x4){e[0] | (e[1] << 16), e[2] | (e[3] << 16), e[4] | (e[5] << 16), e[6] | (e[7] << 16)};
            vp[1] = (u32x4){e[8] | (e[9] << 16), e[10] | (e[11] << 16), e[12] | (e[13] << 16), e[14] | (e[15] << 16)}; }
        }
        if (tk + G < NTASK) CP_LOADX(CP_TASKID(tk + G));
        if (wave < 2) { const int d = wave; float gv = gsc[d * 64 + (d ? 63 - lane : lane)];
            gv += __builtin_bit_cast(float, __builtin_amdgcn_update_dpp(0, __builtin_bit_cast(int, gv), 0x111, 0xF, 0xF, true));
            gv += __builtin_bit_cast(float, __builtin_amdgcn_update_dpp(0, __builtin_bit_cast(int, gv), 0x112, 0xF, 0xF, true));
            gv += __builtin_bit_cast(float, __builtin_amdgcn_update_dpp(0, __builtin_bit_cast(int, gv), 0x114, 0xF, 0xF, true));
            gv += __builtin_bit_cast(float, __builtin_amdgcn_update_dpp(0, __builtin_bit_cast(int, gv), 0x118, 0xF, 0xF, true));
            { const float t0 = __builtin_bit_cast(float, __builtin_amdgcn_readlane(__builtin_bit_cast(int, gv), 15)), t1 = __builtin_bit_cast(float, __builtin_amdgcn_readlane(__builtin_bit_cast(int, gv), 31)), t2 = __builtin_bit_cast(float, __builtin_amdgcn_readlane(__builtin_bit_cast(int, gv), 47));
              const int rw_ = lane >> 4; gv += (rw_ >= 1 ? t0 : 0.f) + (rw_ >= 2 ? t1 : 0.f) + (rw_ >= 3 ? t2 : 0.f); }
            gcs[d * 64 + lane] = gv; }
        __syncthreads();
        const LAS float* Gs = (const LAS float*)(lds + GS_OFF); const LAS float* Rs = (const LAS float*)(lds + RS_OFF);
#pragma unroll 4
        for (int t = 0; t < 16; ++t) { const int e = tid + 512 * t, d = e >> 12, jp = (e >> 6) & 63, ip = e & 63;
            const int in_ = d ? 63 - ip : ip, jn = d ? 63 - jp : jp;
            const float dec = __expf(fminf(gcs[d * 64 + ip] - gcs[d * 64 + jp], 0.f));
            const float av = (jp < ip) ? bsc[d * 64 + in_] * Gs[in_ * 65 + jn] * dec : 0.f;
            ((LAS float*)(lds + AM_OFF))[d * 4352 + jp * 68 + ip] = av;
            const float qk = (jp <= ip) ? Rs[in_ * 65 + jn] * dec : 0.f;
            *(LAS unsigned short*)(lds + IMG_OFF + d * 16384 + 8192 + frag_off(in_, jn)) = (unsigned short)(pkbf(qk, 0.f) & 0xffffu); }
        __syncthreads();
        { int ln_ = lane; asm volatile("" : "+v"(ln_));
          const int d = wave >> 2, nt = wave & 3, n16 = ln_ & 15, g4 = ln_ >> 4;
          const LAS float* At = (const LAS float*)(lds + AM_OFF) + d * 4352;
          LAS float* Xd = (LAS float*)(lds + GS_OFF) + d * 4096;
          LAS float* Dinv = (LAS float*)(lds + DI_OFF) + d * 1024;
          { float x[16];
#pragma unroll
            for (int q = 0; q < 16; ++q) x[q] = (q == n16) ? 1.f : 0.f;
#pragma unroll
            for (int r2 = 0; r2 < 15; ++r2) { const LAS float* ar = At + (16 * nt + r2) * 68 + 16 * nt; const float xr = x[r2];
#pragma unroll
                for (int q4 = (r2 + 1) / 4; q4 < 4; ++q4) { const f32x4 a4 = *(const LAS f32x4*)(ar + 4 * q4);
#pragma unroll
                    for (int q = 0; q < 4; ++q) if (4 * q4 + q > r2) x[4 * q4 + q] = fmaf(-a4[q], xr, x[4 * q4 + q]); } }
            if (ln_ < 16) {
#pragma unroll
                for (int q = 0; q < 16; ++q) Dinv[nt * 256 + q * 16 + n16] = x[q]; } }
          if (wave == 2 || wave == 3) { const int d2 = wave - 2, ip = d2 ? 63 - lane : lane; const float gl = gcs[d2 * 64 + 63], gi = gcs[d2 * 64 + ip];
            float* sc = (float*)(rec + REC_DIR + d2 * REC_DIRSZ + 16384);
            sc[lane] = __expf(gi); sc[64 + lane] = __expf(gl - gi); if (lane == 0) sc[128] = __expf(gl); }
          __syncthreads();
          const int c = 16 * nt + n16, jn = d ? 63 - c : c; const float bj = bsc[d * 64 + jn];
          const int fj = (jn >> 5) * 1024 + ((jn >> 2) & 3) * 256 + ((jn >> 4) & 1) * 8 + (jn & 3) * 2;
#pragma unroll 1
          for (int B = 0; B < 4; ++B) {
            f32x4 y = {0.f, 0.f, 0.f, 0.f};
            if (nt <= B) {
                f32x4 acc;
#pragma unroll
                for (int r2 = 0; r2 < 4; ++r2) acc[r2] = (nt == B && 4 * g4 + r2 == n16) ? 1.f : 0.f;
#pragma unroll 2
                for (int j0 = 0; j0 < 16 * B; j0 += 4) { const float av = -At[(j0 + g4) * 68 + 16 * B + n16], bv = Xd[(j0 + g4) * 64 + c];
                    acc = __builtin_amdgcn_mfma_f32_16x16x4f32(av, bv, acc, 0, 0, 0); }
#pragma unroll
                for (int r2 = 0; r2 < 4; ++r2) Xd[(16 * B + 4 * g4 + r2) * 64 + c] = acc[r2];
#pragma unroll
                for (int s4 = 0; s4 < 4; ++s4) { const float av = Dinv[B * 256 + n16 * 16 + 4 * s4 + g4], bv = Xd[(16 * B + 4 * s4 + g4) * 64 + c];
                    y = __builtin_amdgcn_mfma_f32_16x16x4f32(av, bv, y, 0, 0, 0); }
            }
#pragma unroll
            for (int r2 = 0; r2 < 4; ++r2) { const int i = 16 * B + 4 * g4 + r2, in_ = d ? 63 - i : i; Xd[i * 64 + c] = y[r2];
                *(LAS unsigned short*)(lds + IMG_OFF + d * 16384 + (in_ >> 4) * 2048 + (in_ & 15) * 16 + fj) = (unsigned short)(pkbf_c(y[r2] * bj, 0.f) & 0xffffu); }
            __syncthreads();
          }
        }
#pragma unroll
        for (int t = 0; t < 4; ++t) { const int p = tid + 512 * t, d = p >> 10, off = (p & 1023) * 16;
            *(u32x4*)(rec + REC_DIR + d * REC_DIRSZ + off) = *(const LAS u32x4*)(lds + IMG_OFF + d * 16384 + off); }
        __syncthreads();
    }
#undef CP_LOADX
#undef CP_TASKID
#undef a
}

__device__ __forceinline__ bf16x8 pack44(const f32x4& lo, const f32x4& hi) {
    u32x4 p; p.x = pkbf_c(lo[0], lo[1]); p.y = pkbf_c(lo[2], lo[3]); p.z = pkbf_c(hi[0], hi[1]); p.w = pkbf_c(hi[2], hi[3]);
    return __builtin_bit_cast(bf16x8, p);
}
template <int VAR>
__device__ __forceinline__ void phase_dn_scan(int l, LAS unsigned char* lds) {
    const KArgs ap = get_args();
#define a (*ap)
    const int tid = fresh_tid(), lane = tid & 63, wave = __builtin_amdgcn_readfirstlane(tid >> 6), bx = fresh_bx();
    unsigned char* ws = a.ws;
    if (bx >= 32) return;
    const int chain = bx >> 1, half = bx & 1, b = chain >> 3, h = (chain >> 1) & 3, dir = chain & 1;
    const unsigned char* recb = ws + WS_REC + (size_t)((b * 4 + h) * NCH) * REC_BYTES;
    constexpr int BUFSZ = 74752;
#define CIDX(n) (dir ? ((n) < 4 ? 3 - (n) : 263 - (n)) : (n))
    if (wave >= 4) {
        const int sw = wave - 4;
#define DN_PIECE(i_) ((sw + 4 * (i_)) < 73 ? (sw + 4 * (i_)) : 72)
#define DN_SRC(rec_, p_) ((p_) < 48 ? (rec_) + (p_) * 1024 : (p_) < 65 ? (rec_) + REC_DIR + dir * REC_DIRSZ + ((p_) - 48) * 1024 : (rec_) + REC_V + half * 8192 + ((p_) - 65) * 1024)
#define DN_STAGE(n, bi) do { const unsigned char* rec_ = recb + (size_t)CIDX(n) * REC_BYTES; _Pragma("unroll") for (int i_ = 0; i_ < 19; ++i_) { const int p_ = DN_PIECE(i_); \
        __builtin_amdgcn_global_load_lds((const unsigned*)(DN_SRC(rec_, p_) + lane * 16), (LAS unsigned*)(lds + (bi) * BUFSZ + p_ * 1024), 16, 0, 0); } } while (0)
#define DN_SYNC() do { asm volatile("s_waitcnt vmcnt(0)" ::: "memory"); __builtin_amdgcn_s_barrier(); asm volatile("" ::: "memory"); } while (0)
        if (VAR != 3) DN_STAGE(0, 0);
        DN_SYNC();
        for (int n = 0; n < NCH; ++n) {
            if (VAR != 3 && n + 1 < NCH) DN_STAGE(n + 1, (n + 1) & 1);
            DN_SYNC();
        }
#undef DN_STAGE
#undef DN_PIECE
#undef DN_SRC
#undef DN_SYNC
    } else {
        const int sl = half * 4 + wave, c16 = lane & 15, g4 = lane >> 4;
        float* Og = (float*)(ws + (dir ? WS_OB : WS_OF)) + h * 128 + sl * 16 + c16;
        f32x4 S[8];
#pragma unroll
        for (int i = 0; i < 8; ++i) S[i] = (f32x4){0.f, 0.f, 0.f, 0.f};
        asm volatile("s_waitcnt lgkmcnt(0)" ::: "memory"); __builtin_amdgcn_s_barrier(); asm volatile("" ::: "memory");
        for (int n = 0; n < NCH; ++n) {
            if (VAR == 2) { asm volatile("s_waitcnt lgkmcnt(0)" ::: "memory"); __builtin_amdgcn_s_barrier(); asm volatile("" ::: "memory"); continue; }
            const LAS unsigned char* buf = lds + (n & 1) * BUFSZ;
            const int cidx = CIDX(n);
            const u32x4 vc0 = *(const LAS u32x4*)(buf + 66560 + wave * 2048 + lane * 32), vc1 = *(const LAS u32x4*)(buf + 66560 + wave * 2048 + lane * 32 + 16);
#define FR(off, f) (*(const LAS bf16x8*)(buf + (off) + (f) * 1024 + lane * 16))
#define MF(A, B, C) __builtin_amdgcn_mfma_f32_16x16x32_bf16((A), (B), (C), 0, 0, 0)
#define SB_() __builtin_amdgcn_sched_barrier(0)
            bf16x8 fa[8], fb[8];
            f32x4 eg[4], dl[4];
#pragma unroll
            for (int mt = 0; mt < 4; ++mt) { eg[mt] = *(const LAS f32x4*)(buf + 65536 + (16 * mt + 4 * g4) * 4); dl[mt] = *(const LAS f32x4*)(buf + 65536 + 256 + (16 * mt + 4 * g4) * 4); }
            const float egl = *(const LAS float*)(buf + 65536 + 512);
#define RD_KQ(dst, q) do { _Pragma("unroll") for (int mt = 0; mt < 4; ++mt) { dst[mt] = FR(0, mt * 4 + (q)); dst[4 + mt] = FR(32768, mt * 4 + (q)); } } while (0)
#define MM_KQ(src, q) do { _Pragma("unroll") for (int mt = 0; mt < 4; ++mt) { X[mt] = MF(src[mt], Sb[q], X[mt]); O[mt] = MF(src[4 + mt], Sb[q], O[mt]); } } while (0)
            f32x4 X[4], O[4], VN[4];
#pragma unroll
            for (int i = 0; i < 4; ++i) { X[i] = (f32x4){0.f, 0.f, 0.f, 0.f}; O[i] = (f32x4){0.f, 0.f, 0.f, 0.f}; VN[i] = (f32x4){0.f, 0.f, 0.f, 0.f}; }
            bf16x8 Sb[4];
#pragma unroll
            for (int q = 0; q < 4; ++q) Sb[q] = pack44(S[2 * q], S[2 * q + 1]);
            RD_KQ(fa, 0); SB_();
            RD_KQ(fb, 1); SB_(); MM_KQ(fa, 0); SB_();
            RD_KQ(fa, 2); SB_(); MM_KQ(fb, 1); SB_();
            RD_KQ(fb, 3); SB_(); MM_KQ(fa, 2); SB_();
#pragma unroll
            for (int i = 0; i < 8; ++i) fa[i] = FR(49152, i);
            SB_(); MM_KQ(fb, 3); SB_();
#pragma unroll
            for (int mt = 0; mt < 4; ++mt) { const unsigned w0 = (mt < 2 ? vc0 : vc1)[2 * (mt & 1)], w1 = (mt < 2 ? vc0 : vc1)[2 * (mt & 1) + 1];
                X[mt][0] = bflo(w0) - eg[mt][0] * X[mt][0]; X[mt][1] = bfhi(w0) - eg[mt][1] * X[mt][1]; X[mt][2] = bflo(w1) - eg[mt][2] * X[mt][2]; X[mt][3] = bfhi(w1) - eg[mt][3] * X[mt][3]; }
            const bf16x8 Yb0 = pack44(X[0], X[1]), Yb1 = pack44(X[2], X[3]);
            SB_();
#pragma unroll
            for (int i = 0; i < 8; ++i) fb[i] = FR(57344, i);
            SB_();
#pragma unroll
            for (int mt = 0; mt < 4; ++mt) { VN[mt] = MF(fa[mt * 2], Yb0, VN[mt]); VN[mt] = MF(fa[mt * 2 + 1], Yb1, VN[mt]); }
            SB_();
#pragma unroll
            for (int mt = 0; mt < 4; ++mt) O[mt] = O[mt] * eg[mt];
            const bf16x8 Vb0 = pack44(VN[0], VN[1]), Vb1 = pack44(VN[2], VN[3]);
            SB_();
#pragma unroll
            for (int i = 0; i < 8; ++i) fa[i] = FR(16384, i);
            SB_();
#pragma unroll
            for (int mt = 0; mt < 4; ++mt) { O[mt] = MF(fb[mt * 2], Vb0, O[mt]); O[mt] = MF(fb[mt * 2 + 1], Vb1, O[mt]); }
            SB_();
#pragma unroll
            for (int mt = 0; mt < 4; ++mt) VN[mt] = VN[mt] * dl[mt];
            const bf16x8 Vd0 = pack44(VN[0], VN[1]), Vd1 = pack44(VN[2], VN[3]);
#pragma unroll
            for (int i = 0; i < 8; ++i) S[i] = S[i] * egl;
            SB_();
#pragma unroll
            for (int i = 0; i < 8; ++i) fb[i] = FR(16384, 8 + i);
            SB_();
#pragma unroll
            for (int i = 0; i < 4; ++i) { S[i] = MF(fa[i * 2], Vd0, S[i]); S[i] = MF(fa[i * 2 + 1], Vd1, S[i]); }
            SB_();
#pragma unroll
            for (int i = 0; i < 4; ++i) { S[4 + i] = MF(fb[i * 2], Vd0, S[4 + i]); S[4 + i] = MF(fb[i * 2 + 1], Vd1, S[4 + i]); }
            SB_();
            {
                const int row0 = cidx < 4 ? ML + b * CT + cidx * 64 : b * T + (cidx - 4) * 64;
                float* op = Og + (size_t)(row0 + 4 * g4) * 512;
#pragma unroll
                for (int mt = 0; mt < 4; ++mt)
#pragma unroll
                    for (int t = 0; t < 4; ++t) { if (VAR != 1) op[(size_t)(16 * mt + t) * 512] = O[mt][t]; else asm volatile("" :: "v"(O[mt][t])); }
            }
#undef RD_KQ
#undef MM_KQ
#undef SB_
#undef FR
#undef MF
            asm volatile("s_waitcnt lgkmcnt(0)" ::: "memory"); __builtin_amdgcn_s_barrier(); asm volatile("" ::: "memory");
        }
    }
#undef CIDX
#undef a
}

__device__ __forceinline__ void phase_dn_out(int l) {
    const KArgs ap = get_args();
#define a (*ap)

    const int tid = fresh_tid(), lane = tid & 63, wave = __builtin_amdgcn_readfirstlane(tid >> 6), G = fresh_g(), bx = fresh_bx();
    unsigned char* ws = a.ws;
    const int nrows = (l == DEPTH - 1) ? ML : M;
    const float* OF = (const float*)(ws + WS_OF); const float* OB = (const float*)(ws + WS_OB);
    const bf16_t* P = (const bf16_t*)(ws + WS_P); bf16_t* CAT = (bf16_t*)(ws + WS_CAT);
    const f32x2 nw = *(const f32x2*)(a.in[I_DNW] + l * 128 + 2 * lane);
    const float* LSE = (const float*)(ws + WS_BA);
    for (int row = wave * G + bx; row < nrows; row += G * 8) {
        f32x2 of[4], ob[4]; unsigned gw[4];
#pragma unroll
        for (int hh = 0; hh < 4; ++hh) { of[hh] = *(const f32x2*)(OF + (size_t)row * 512 + hh * 128 + 2 * lane); ob[hh] = *(const f32x2*)(OB + (size_t)row * 512 + hh * 128 + 2 * lane);
            gw[hh] = *(const unsigned*)(P + (size_t)row * NP + 2560 + hh * 128 + 2 * lane); }
        u32x4 ap_[4]; float ls_[4];
#pragma unroll
        for (int p = 0; p < 4; ++p) { ap_[p] = (u32x4){0u, 0u, 0u, 0u}; ls_[p] = 0.f; }
        if (row < ML) {
            ap_[0] = *(const u32x4*)(CAT + (size_t)row * 1024 + 8 * lane); ap_[1] = *(const u32x4*)((const bf16_t*)(ws + WS_DQ) + (size_t)row * 512 + 8 * lane);
            ap_[2] = *(const u32x4*)((const bf16_t*)(ws + WS_DK) + (size_t)row * 512 + 8 * lane); ap_[3] = *(const u32x4*)((const bf16_t*)(ws + WS_DV) + (size_t)row * 512 + 8 * lane);
#pragma unroll
            for (int p = 0; p < 4; ++p) ls_[p] = LSE[((size_t)p * ML + row) * 4 + (lane >> 4)]; }
        float o0[4], o1[4], ssq[4];
#pragma unroll
        for (int hh = 0; hh < 4; ++hh) { o0[hh] = of[hh][0] + ob[hh][0]; o1[hh] = of[hh][1] + ob[hh][1]; ssq[hh] = o0[hh] * o0[hh] + o1[hh] * o1[hh]; }
#pragma unroll
        for (int hh = 0; hh < 4; ++hh) ssq[hh] = wave_sum(ssq[hh]);
        float mxv = 0.f;
#pragma unroll
        for (int hh = 0; hh < 4; ++hh) { const float rs = rsqrtf(ssq[hh] * (1.f / 128.f) + EPS); const float g0 = bflo(gw[hh]), g1 = bfhi(gw[hh]);
            o0[hh] = o0[hh] * rs * nw[0] * silu_f(g0); o1[hh] = o1[hh] * rs * nw[1] * silu_f(g1); mxv = fmaxf(mxv, fmaxf(fabsf(o0[hh]), fabsf(o1[hh]))); }
        float av[8];
        if (row < ML) { const float mx = fmaxf(fmaxf(ls_[0], ls_[1]), fmaxf(ls_[2], ls_[3]));
            float w_[4], wsum = 0.f;
#pragma unroll
            for (int p = 0; p < 4; ++p) { w_[p] = __expf(ls_[p] - mx); wsum += w_[p]; }
            const float inv = 1.f / wsum;
#pragma unroll
            for (int i = 0; i < 4; ++i) { float lo = 0.f, hi2 = 0.f;
#pragma unroll
                for (int p = 0; p < 4; ++p) { lo = fmaf(w_[p], bflo(ap_[p][i]), lo); hi2 = fmaf(w_[p], bfhi(ap_[p][i]), hi2); }
                av[2 * i] = lo * inv; av[2 * i + 1] = hi2 * inv; } }
        else { const u32x4 cw_ = *(const u32x4*)(CAT + (size_t)row * 1024 + 8 * lane);
#pragma unroll
            for (int i = 0; i < 4; ++i) { av[2 * i] = bflo(cw_[i]); av[2 * i + 1] = bfhi(cw_[i]); } }
#pragma unroll
        for (int i = 0; i < 8; ++i) mxv = fmaxf(mxv, fabsf(av[i]));
        mxv = fmaxf(wave_max(mxv), 1e-30f);
        const float cinv = 127.f / mxv;
        signed char* crow = (signed char*)(ws + WS_CATQ) + (size_t)row * 1024;
#define Q8_(x) ((unsigned)(int)rintf((x) * cinv) & 255u)
        { u32x2 o; o.x = Q8_(av[0]) | (Q8_(av[1]) << 8) | (Q8_(av[2]) << 16) | (Q8_(av[3]) << 24); o.y = Q8_(av[4]) | (Q8_(av[5]) << 8) | (Q8_(av[6]) << 16) | (Q8_(av[7]) << 24); *(u32x2*)(crow + 8 * lane) = o; }
#pragma unroll
        for (int hh = 0; hh < 4; ++hh) *(unsigned short*)(crow + 512 + hh * 128 + 2 * lane) = (unsigned short)(Q8_(o0[hh]) | (Q8_(o1[hh]) << 8));
#undef Q8_
        if (lane == 0) ((float*)(ws + WS_GB))[(1u << 18) + row] = mxv * (1.f / 127.f);
    }
#undef a
}

#define CE_DESC(a_, b_) do { const float hi_ = fmaxf(a_, b_), lo_ = fminf(a_, b_); a_ = hi_; b_ = lo_; } while (0)
__device__ __forceinline__ void bitonic_sort16_desc(float (&v)[16]) {
#pragma unroll
    for (int k = 2; k <= 16; k <<= 1)
#pragma unroll
        for (int j = k >> 1; j > 0; j >>= 1)
#pragma unroll
            for (int i = 0; i < 16; ++i) { const int p = i ^ j; if (p > i) { if ((i & k) == 0) CE_DESC(v[i], v[p]); else CE_DESC(v[p], v[i]); } }
}
__device__ __forceinline__ void merge_top16_desc(float (&lst)[16], const float (&nw)[16]) {
#pragma unroll
    for (int i = 0; i < 16; ++i) lst[i] = fmaxf(lst[i], nw[15 - i]);
#pragma unroll
    for (int j = 8; j > 0; j >>= 1)
#pragma unroll
        for (int i = 0; i < 16; ++i) { const int p = i ^ j; if (p > i) CE_DESC(lst[i], lst[p]); }
}
__device__ __forceinline__ void phase_peer_select(int l) {
    const KArgs ap = get_args();
#define a (*ap)
    const int tid = fresh_tid(), lane = tid & 63, wave = __builtin_amdgcn_readfirstlane(tid >> 6), G = fresh_g(), bx = fresh_bx();
    unsigned char* ws = a.ws;
    const int nrows = (l == DEPTH - 1) ? ML : M;
    const int ntask = (nrows / 32) * 4;
    const bf16_t* Q2 = (const bf16_t*)(ws + WS_P);
    const bf16_t* SKB = (const bf16_t*)(ws + WS_SKB) + (size_t)l * 8 * 2 * 128 * 128;
    int* PIDX = (int*)(ws + WS_PIDX); float* PGATE = (float*)(ws + WS_PGATE);
    const float NEG = -3.0e38f;
    const int r = lane & 31, hi = lane >> 5;
    for (int task = wave * G + bx; task < ntask; task += G * 8) {
        const int tg = task >> 2, hp = task & 3; const int row = tg * 32 + r;
        float mine0[16], mine1[16];
#pragma unroll
        for (int j = 0; j < 16; ++j) { mine0[j] = NEG; mine1[j] = NEG; }
        bf16x8 qA[8], kA[8];
        float lst[16];
#define SEL_QPTR(it_) (Q2 + (size_t)row * 2048 + (2 * hp + ((it_) >> 1)) * 256 + ((it_) & 1) * 128 + 8 * hi)
#define SEL_KPTR(it_, t_) (SKB + (size_t)(((2 * hp + ((it_) >> 1)) * 2 + ((it_) & 1)) * 128 + 32 * (t_) + r) * 128 + 8 * hi)
#define SEL_LDQ(dst, it_) do { const bf16_t* qp_ = SEL_QPTR(it_); _Pragma("unroll") for (int ks = 0; ks < 8; ++ks) dst[ks] = *(const bf16x8*)(qp_ + 16 * ks); } while (0)
#define SEL_LDK(dst, it_, t_) do { const bf16_t* kp_ = SEL_KPTR(it_, t_); _Pragma("unroll") for (int ks = 0; ks < 8; ++ks) dst[ks] = *(const bf16x8*)(kp_ + 16 * ks); } while (0)
#define SEL_RANK(qv, kv, t_) do { f32x16 acc = {}; _Pragma("unroll") for (int ks = 0; ks < 8; ++ks) acc = __builtin_amdgcn_mfma_f32_32x32x16_bf16(kv[ks], qv[ks], acc, 0, 0, 0); \
            const unsigned kb = (unsigned)(32 * (t_) + 4 * hi); float nw_[16]; \
            _Pragma("unroll") for (int i = 0; i < 16; ++i) nw_[i] = __uint_as_float((__float_as_uint(acc[i]) & 0xffffff80u) | (kb + (unsigned)((i & 3) + 8 * (i >> 2)))); \
            bitonic_sort16_desc(nw_); merge_top16_desc(lst, nw_); } while (0)
#define SB_() __builtin_amdgcn_sched_barrier(0)
#pragma unroll
        for (int j = 0; j < 16; ++j) lst[j] = NEG;
#pragma unroll 1
        for (int it = 0; it < 4; ++it) {
            SEL_LDQ(qA, it);
#pragma unroll 1
            for (int t = 0; t < 4; ++t) { SEL_LDK(kA, it, t); SEL_RANK(qA, kA, t); }
            float oth[16];
#pragma unroll
            for (int j = 0; j < 16; ++j) { auto rr = __builtin_amdgcn_permlane32_swap(__float_as_uint(lst[j]), __float_as_uint(lst[j]), false, false); oth[j] = __uint_as_float(hi ? rr[0] : rr[1]); }
            merge_top16_desc(lst, oth);
            const bool k0 = ((it >> 1) == hi) && ((it & 1) == 0), k1 = ((it >> 1) == hi) && ((it & 1) == 1);
#pragma unroll
            for (int j = 0; j < 16; ++j) { mine0[j] = k0 ? lst[j] : mine0[j]; mine1[j] = k1 ? lst[j] : mine1[j]; lst[j] = NEG; }
        }
#undef SB_
#undef SEL_QPTR
#undef SEL_KPTR
#undef SEL_LDQ
#undef SEL_LDK
#undef SEL_RANK
        const int h = 2 * hp + hi;
        float ts[16];
#pragma unroll
        for (int j = 0; j < 16; ++j) ts[j] = NEG;
#pragma unroll
        for (int i = 0; i < 16; ++i)
#pragma unroll
            for (int j = 0; j < 16; ++j) if ((i + 1) * (j + 1) <= 16) {
                const unsigned b0 = __float_as_uint(mine0[i]), b1 = __float_as_uint(mine1[j]);
                const float c = __uint_as_float(b0 & 0xffffff80u) + __uint_as_float(b1 & 0xffffff80u);
                float x = __uint_as_float((__float_as_uint(c) & 0xffffc000u) | ((b0 & 127u) << 7) | (b1 & 127u));
#pragma unroll
                for (int t = 0; t < 16; ++t) { const float hv = fmaxf(ts[t], x); x = fminf(ts[t], x); ts[t] = hv; }
            }
        int te[16]; float ex[16], sum = 0.f;
        const float tmax = __uint_as_float(__float_as_uint(ts[0]) & 0xffffc000u);
#pragma unroll
        for (int t = 0; t < 16; ++t) { const unsigned bt = __float_as_uint(ts[t]); te[t] = (int)(bt & 0x3fffu); ex[t] = __expf(__uint_as_float(bt & 0xffffc000u) - tmax); sum += ex[t]; }
        const float inv = 1.f / sum;
        unsigned short* ip = (unsigned short*)PIDX + (size_t)row * 128 + h * 16; float* gp = PGATE + (size_t)row * 128 + h * 16;
#pragma unroll
        for (int t = 0; t < 16; t += 8) *(u32x4*)(ip + t) = (u32x4){(unsigned)te[t] | ((unsigned)te[t + 1] << 16), (unsigned)te[t + 2] | ((unsigned)te[t + 3] << 16), (unsigned)te[t + 4] | ((unsigned)te[t + 5] << 16), (unsigned)te[t + 6] | ((unsigned)te[t + 7] << 16)};
#pragma unroll
        for (int t = 0; t < 16; t += 4) *(f32x4*)(gp + t) = (f32x4){ex[t] * inv, ex[t + 1] * inv, ex[t + 2] * inv, ex[t + 3] * inv};
    }
#undef a
}

template <bool WR, int GV = 0>
__device__ __forceinline__ void phase_peer_gather(int l, LAS unsigned char* lds) {
    const KArgs ap = get_args();
#define a (*ap)
    const int tid = fresh_tid(), lane = tid & 63, wave = __builtin_amdgcn_readfirstlane(tid >> 6), G = fresh_g(), bx = fresh_bx();
    unsigned char* ws = a.ws;
    const int nrows = (l == DEPTH - 1) ? ML : M;
    const unsigned char* UB = ws + WS_UB + (size_t)(l & 1) * TAB_SET; const unsigned char* VB = UB + 1024;
    const float* USC = (const float*)(ws + WS_USC) + (l & 1) * 2 * NEXP; const float* VSC = USC + NEXP;
    const int* PIDX = (const int*)(ws + WS_PIDX); const float* PGATE = (const float*)(ws + WS_PGATE);
    const float* modl = (const float*)(ws + WS_MOD) + (size_t)l * 3 * 6144 + 5120;
    const bool fuse = WR && (l + 1 < DEPTH);
    LAS float* wsk = (LAS float*)lds;
    if (fuse) { const float* src = (const float*)(ws + WS_WSK) + (size_t)(l + 1) * 16384; for (int i = tid; i < 16384 / 4; i += 512) ((LAS f32x4*)wsk)[i] = ((const f32x4*)src)[i]; __syncthreads(); }
    const float* nw1 = a.in[I_N1W] + (l + 1 < DEPTH ? l + 1 : l) * 1024 + 16 * lane;
    const float* modn = (const float*)(ws + WS_MOD) + (size_t)(l + 1 < DEPTH ? l + 1 : l) * 3 * 6144;
    for (int row = wave * G + bx; row < nrows; row += G * 8) {
        float hv[16], out[16];
        { const u32x4 hw = *(const u32x4*)((const signed char*)(ws + WS_H) + (size_t)row * D + 16 * lane); const float hsc = ((const float*)(ws + WS_GB))[row];
#pragma unroll
          for (int q = 0; q < 4; ++q) { const int w = (int)hw[q]; hv[4 * q + 0] = (float)((w << 24) >> 24) * hsc; hv[4 * q + 1] = (float)((w << 16) >> 24) * hsc; hv[4 * q + 2] = (float)((w << 8) >> 24) * hsc; hv[4 * q + 3] = (float)(w >> 24) * hsc; } }
        float hs = 0.f;
#pragma unroll
        for (int i = 0; i < 16; ++i) { out[i] = 0.f; hs += hv[i]; }
        const float hsum128 = 128.f * wave_sum(hs);
        float wacc = 0.f;
        const int id0 = PIDX[(size_t)row * 128 + lane], id1 = PIDX[(size_t)row * 128 + 64 + lane];
        const float gt0 = PGATE[(size_t)row * 128 + lane], gt1 = PGATE[(size_t)row * 128 + 64 + lane];
        const float us0 = USC[id0], us1 = USC[id1], vs0 = VSC[id0], vs1 = VSC[id1];
        for (int e0 = 0; e0 < 128; e0 += 8) {
            u32x4 uw[8], vw[8]; float gte[8], use[8], vse[8];
#pragma unroll
            for (int j = 0; j < 8; ++j) { const int e = e0 + j; const int id = __builtin_amdgcn_readlane(e0 < 64 ? id0 : id1, e & 63);
                gte[j] = __builtin_bit_cast(float, __builtin_amdgcn_readlane(__builtin_bit_cast(int, e0 < 64 ? gt0 : gt1), e & 63));
                use[j] = __builtin_bit_cast(float, __builtin_amdgcn_readlane(__builtin_bit_cast(int, e0 < 64 ? us0 : us1), e & 63));
                vse[j] = __builtin_bit_cast(float, __builtin_amdgcn_readlane(__builtin_bit_cast(int, e0 < 64 ? vs0 : vs1), e & 63));
                uw[j] = *(const u32x4*)(UB + (size_t)id * 2048 + 16 * lane); vw[j] = *(const u32x4*)(VB + (size_t)id * 2048 + 16 * lane); }
#pragma unroll
            for (int j = 0; j < 8; ++j) {
                float d0 = 0.f, d1 = 0.f;
#pragma unroll
                for (int q = 0; q < 4; ++q) { const unsigned w = uw[j][q];
                    d0 = fmaf((float)(w & 255u), hv[4 * q + 0], d0); d1 = fmaf((float)((w >> 8) & 255u), hv[4 * q + 1], d1);
                    d0 = fmaf((float)((w >> 16) & 255u), hv[4 * q + 2], d0); d1 = fmaf((float)(w >> 24), hv[4 * q + 3], d1); }
                const float dsum = (wave_sum(d0 + d1) - hsum128) * use[j];
                const float act = 0.5f * dsum * (1.f + erff(dsum * 0.70710678118654752f));
                const float wgt = gte[j] * act * vse[j];
                wacc += wgt;
                if (GV == 1) { asm volatile("" :: "v"(vw[j])); out[0] += wgt; } else
#pragma unroll
                for (int q = 0; q < 4; ++q) { const unsigned w = vw[j][q];
                    out[4 * q + 0] = fmaf(wgt, (float)(w & 255u), out[4 * q + 0]); out[4 * q + 1] = fmaf(wgt, (float)((w >> 8) & 255u), out[4 * q + 1]);
                    out[4 * q + 2] = fmaf(wgt, (float)((w >> 16) & 255u), out[4 * q + 2]); out[4 * q + 3] = fmaf(wgt, (float)(w >> 24), out[4 * q + 3]); }
            }
        }
        const float corr = 128.f * wacc;
        float* xr; int mrow;
        if (row < ML) { xr = a.out + (size_t)row * D; mrow = row >= T ? 1 : 0; } else { xr = (float*)(ws + WS_CTXX) + (size_t)(row - ML) * D; mrow = 2; }
        const float* g2 = modl + mrow * 6144 + 16 * lane;
        f32x4 xn[4];
#pragma unroll
        for (int i = 0; i < 4; ++i) { const f32x4 x = *(const f32x4*)(xr + 16 * lane + 4 * i), g = *(const f32x4*)(g2 + 4 * i);
            xn[i] = x + g * (f32x4){out[4 * i] - corr, out[4 * i + 1] - corr, out[4 * i + 2] - corr, out[4 * i + 3] - corr};
            if (WR) *(f32x4*)(xr + 16 * lane + 4 * i) = xn[i]; else asm volatile("" :: "v"(xn[i])); }
        if (fuse) {
            float ss = 0.f;
#pragma unroll
            for (int i = 0; i < 4; ++i) ss += (xn[i][0] * xn[i][0] + xn[i][1] * xn[i][1]) + (xn[i][2] * xn[i][2] + xn[i][3] * xn[i][3]);
            const float rstd = rsqrtf(wave_sum(ss) * (1.f / D) + EPS);
            const float* md = modn + mrow * 6144 + 16 * lane;
#pragma unroll
            for (int i = 0; i < 4; ++i) { const f32x4 nwv = *(const f32x4*)(nw1 + 4 * i), sc = *(const f32x4*)(md + 1024 + 4 * i), sh = *(const f32x4*)(md + 4 * i);
                xn[i] = xn[i] * rstd * nwv * (sc + 1.f) + sh; }
            { float hmx = 0.f;
#pragma unroll
              for (int i = 0; i < 4; ++i) hmx = fmaxf(hmx, fmaxf(fmaxf(fabsf(xn[i][0]), fabsf(xn[i][1])), fmaxf(fabsf(xn[i][2]), fabsf(xn[i][3]))));
              hmx = fmaxf(wave_max(hmx), 1e-30f); const float hinv = 127.f / hmx;
              u32x4 o;
#pragma unroll
              for (int i = 0; i < 4; ++i) o[i] = ((unsigned)(int)rintf(xn[i][0] * hinv) & 255u) | (((unsigned)(int)rintf(xn[i][1] * hinv) & 255u) << 8) | (((unsigned)(int)rintf(xn[i][2] * hinv) & 255u) << 16) | (((unsigned)(int)rintf(xn[i][3] * hinv) & 255u) << 24);
              *(u32x4*)((signed char*)(ws + WS_H) + (size_t)row * D + 16 * lane) = o;
              if (lane == 0) ((float*)(ws + WS_GB))[row] = hmx * (1.f / 127.f); }
            float p[16];
#pragma unroll
            for (int c = 0; c < 16; ++c) { float q = 0.f;
#pragma unroll
                for (int i = 0; i < 4; ++i) { const f32x4 w = *(const LAS f32x4*)(wsk + c * 1024 + 16 * lane + 4 * i); q += (xn[i][0] * w[0] + xn[i][1] * w[1]) + (xn[i][2] * w[2] + xn[i][3] * w[3]); }
                p[c] = q; }
            { const bool hb = (lane & 32) != 0;
#pragma unroll
              for (int c = 0; c < 8; ++c) { const float keep = hb ? p[c + 8] : p[c], send = hb ? p[c] : p[c + 8]; p[c] = keep + lane_xor<32>(send); } }
            { const bool hb = (lane & 16) != 0;
#pragma unroll
              for (int c = 0; c < 4; ++c) { const float keep = hb ? p[c + 4] : p[c], send = hb ? p[c] : p[c + 4]; p[c] = keep + lane_xor<16>(send); } }
            { const bool hb = (lane & 8) != 0;
#pragma unroll
              for (int c = 0; c < 2; ++c) { const float keep = hb ? p[c + 2] : p[c], send = hb ? p[c] : p[c + 2]; p[c] = keep + lane_xor<8>(send); } }
            { const bool hb = (lane & 4) != 0; const float keep = hb ? p[1] : p[0], send = hb ? p[0] : p[1]; p[0] = keep + lane_xor<4>(send); }
            p[0] += lane_xor<2>(p[0]); p[0] += lane_xor<1>(p[0]);
            if ((lane & 3) == 0) { const int c = ((lane >> 5) & 1) * 8 + ((lane >> 4) & 1) * 4 + ((lane >> 3) & 1) * 2 + ((lane >> 2) & 1); ((float*)(ws + WS_BA))[(size_t)row * 16 + c] = p[0]; }
        }
    }
    if (fuse) __syncthreads();
}
#undef a
constexpr size_t WS_PART = WS_P;
static_assert(WS_PART + 8 * (size_t)M * 1024 * 2 <= WS_GB, "partials region");
constexpr int GP_ITEM = 16;
struct GpMeta { int id0, id1; float gt0, gt1; u32x4 hw; float hsc; };
__device__ __forceinline__ void phase_peer_gpart(int l, LAS unsigned char* lds) {
    const KArgs ap = get_args();
#define a (*ap)
    const int tid = fresh_tid(), lane = tid & 63, wave = __builtin_amdgcn_readfirstlane(tid >> 6);
    unsigned char* ws = a.ws;
    const int nrows = (l == DEPTH - 1) ? ML : M;
    const int nitem = nrows / GP_ITEM;
    const unsigned char* UB = ws + WS_UB + (size_t)(l & 1) * TAB_SET; const unsigned char* VB = UB + 1024;
    const f32x2* SC2 = (const f32x2*)(ws + WS_USC) + (size_t)(l & 1) * NEXP;
    const int* PIDX = (const int*)(ws + WS_PIDX); const float* PGATE = (const float*)(ws + WS_PGATE);
    LAS u32x4* lst0 = (LAS u32x4*)lds + wave * 256;
    const int eidx = ((lane >> 5) & 1) * 4 + ((lane >> 4) & 1) * 2 + ((lane >> 3) & 1);
    const int x = (int)(xb_xcc_id() & 7u);
#define GP_LOAD_META(m_, row_) do { const int rw_ = (row_); (m_).id0 = PIDX[(size_t)rw_ * 128 + lane]; (m_).id1 = PIDX[(size_t)rw_ * 128 + 64 + lane]; (m_).gt0 = PGATE[(size_t)rw_ * 128 + lane]; (m_).gt1 = PGATE[(size_t)rw_ * 128 + 64 + lane]; \
        (m_).hw = *(const u32x4*)((const signed char*)(ws + WS_H) + (size_t)rw_ * D + 16 * lane); (m_).hsc = ((const float*)(ws + WS_GB))[rw_]; } while (0)
#define GP_LOAD_SC(sa_, sb_, m_) do { sa_ = (f32x2){0.f, 0.f}; sb_ = (f32x2){0.f, 0.f}; if (((m_).id0 >> 11) == p) sa_ = SC2[(m_).id0]; if (((m_).id1 >> 11) == p) sb_ = SC2[(m_).id1]; } while (0)
#define GP_BUILD(cnt_, m_, sa_, sb_, buf_) do { const bool s0_ = ((m_).id0 >> 11) == p, s1_ = ((m_).id1 >> 11) == p; const unsigned long long m0_ = __ballot(s0_), m1_ = __ballot(s1_); \
        const int c0_ = __builtin_popcountll(m0_); cnt_ = __builtin_amdgcn_readfirstlane(c0_ + __builtin_popcountll(m1_)); \
        const int r0_ = (int)__builtin_amdgcn_mbcnt_hi((unsigned)(m0_ >> 32), __builtin_amdgcn_mbcnt_lo((unsigned)m0_, 0u)); \
        const int r1_ = c0_ + (int)__builtin_amdgcn_mbcnt_hi((unsigned)(m1_ >> 32), __builtin_amdgcn_mbcnt_lo((unsigned)m1_, 0u)); \
        LAS u32x4* lb_ = lst0 + (buf_) * 128; \
        if (s0_) lb_[r0_] = (u32x4){(unsigned)(m_).id0, __float_as_uint((m_).gt0 * sa_[1]), __float_as_uint(sa_[0]), 0u}; \
        if (s1_) lb_[r1_] = (u32x4){(unsigned)(m_).id1, __float_as_uint((m_).gt1 * sb_[1]), __float_as_uint(sb_[0]), 0u}; } while (0)
#pragma unroll 1
    for (int pp = 0; pp < 8; ++pp) {
        const int p = (x + pp) & 7;
        unsigned* ctr = (unsigned*)(ws + WS_CTL) + 16384 + (l * 8 + p) * 64;
        unsigned* part = (unsigned*)(ws + WS_PART + (size_t)p * M * 2048);
        unsigned tk = 0; if (lane == 0) tk = __hip_atomic_fetch_add(ctr, 1u, __ATOMIC_RELAXED, __HIP_MEMORY_SCOPE_AGENT);
        int it = __builtin_amdgcn_readfirstlane((int)tk);
#pragma unroll 1
        while (it < nitem) {
            unsigned tn = 0; if (lane == 0) tn = __hip_atomic_fetch_add(ctr, 1u, __ATOMIC_RELAXED, __HIP_MEMORY_SCOPE_AGENT);
            const int row0 = it * GP_ITEM, rowl = row0 + GP_ITEM - 1;
            GpMeta m1, m2, m3; f32x2 sa1, sb1, sa2, sb2; int c_cur, c_nxt; u32x4 hw_cur; float hsc_cur;
            GP_LOAD_META(m1, row0); GP_LOAD_META(m2, min(row0 + 1, rowl)); GP_LOAD_META(m3, min(row0 + 2, rowl));
            GP_LOAD_SC(sa1, sb1, m1);
            GP_BUILD(c_cur, m1, sa1, sb1, 0); hw_cur = m1.hw; hsc_cur = m1.hsc;
            GP_LOAD_SC(sa1, sb1, m2);
            m1 = m2; m2 = m3;
            GP_LOAD_META(m3, min(row0 + 3, rowl));
#pragma unroll 1
            for (int i = 0; i < GP_ITEM; ++i) {
                const int row = row0 + i;
                GP_BUILD(c_nxt, m1, sa1, sb1, (i + 1) & 1);
                const u32x4 hw_nxt = m1.hw; const float hsc_nxt = m1.hsc;
                GP_LOAD_SC(sa2, sb2, m2);
                m1 = m2; sa1 = sa2; sb1 = sb2; m2 = m3;
                GP_LOAD_META(m3, min(row + 4, rowl));
                LAS u32x4* lst = lst0 + (i & 1) * 128;
                const int c = c_cur; const u32x4 hw = hw_cur; const float hsc = hsc_cur;
                f32x2 o2[8];
#pragma unroll
                for (int k = 0; k < 8; ++k) o2[k] = (f32x2){0.f, 0.f};
                float wacc = 0.f;
#pragma unroll 1
                for (int e = 0; e < c; e += 8) {
                    u32x4 uw[8], vw[8];
#pragma unroll
                    for (int j = 0; j < 8; ++j) { const int sl = min(e + j, c - 1);
                        const int id = __builtin_amdgcn_readfirstlane((int)lst[sl][0]);
                        uw[j] = *(const u32x4*)(UB + (size_t)id * 2048 + 16 * lane); vw[j] = *(const u32x4*)(VB + (size_t)id * 2048 + 16 * lane); }
                    const int ms = e + eidx; const u32x4 en = lst[min(ms, c - 1)];
                    float pd[8];
#pragma unroll
                    for (int j = 0; j < 8; ++j) { int d = 0;
#pragma unroll
                        for (int q = 0; q < 4; ++q) d = __builtin_amdgcn_sdot4((int)uw[j][q], (int)hw[q], d, false);
                        pd[j] = (float)d; }
                    { const bool hb = (lane & 32) != 0;
#pragma unroll
                      for (int j = 0; j < 4; ++j) { const float keep = hb ? pd[j + 4] : pd[j], send = hb ? pd[j] : pd[j + 4]; pd[j] = keep + lane_xor<32>(send); } }
                    { const bool hb = (lane & 16) != 0;
#pragma unroll
                      for (int j = 0; j < 2; ++j) { const float keep = hb ? pd[j + 2] : pd[j], send = hb ? pd[j] : pd[j + 2]; pd[j] = keep + lane_xor<16>(send); } }
                    { const bool hb = (lane & 8) != 0; const float keep = hb ? pd[1] : pd[0], send = hb ? pd[0] : pd[1]; pd[0] = keep + lane_xor<8>(send); }
                    pd[0] += lane_xor<4>(pd[0]); pd[0] += lane_xor<2>(pd[0]); pd[0] += lane_xor<1>(pd[0]);
                    const float dsum = pd[0] * (__uint_as_float(en[2]) * hsc);
                    const float act = 0.5f * dsum * (1.f + erff(dsum * 0.70710678118654752f));
                    const float wgt = ms < c ? __uint_as_float(en[1]) * act : 0.f;
                    wacc += wgt;
#pragma unroll
                    for (int j = 0; j < 8; ++j) {
                        const float wj = __builtin_bit_cast(float, __builtin_amdgcn_readlane(__builtin_bit_cast(int, wgt), 32 * ((j >> 2) & 1) + 16 * ((j >> 1) & 1) + 8 * (j & 1)));
                        const f32x2 ww = {wj, wj};
#pragma unroll
                        for (int q = 0; q < 4; ++q) { const unsigned w = vw[j][q];
                            const f32x2 v01 = {(float)(w & 255u), (float)((w >> 8) & 255u)}, v23 = {(float)((w >> 16) & 255u), (float)(w >> 24)};
                            o2[2 * q] = __builtin_elementwise_fma(ww, v01, o2[2 * q]); o2[2 * q + 1] = __builtin_elementwise_fma(ww, v23, o2[2 * q + 1]); }
                    }
                }
                const float corr = 16.f * wave_sum(wacc);
                u32x4 w0, w1;
#pragma unroll
                for (int k = 0; k < 4; ++k) { w0[k] = pkbf_c(o2[k][0] - corr, o2[k][1] - corr); w1[k] = pkbf_c(o2[4 + k][0] - corr, o2[4 + k][1] - corr); }
                unsigned* dst = part + (size_t)row * 512 + 8 * lane;
                __builtin_nontemporal_store(w0, (u32x4*)dst); __builtin_nontemporal_store(w1, (u32x4*)(dst + 4));
                c_cur = c_nxt; hw_cur = hw_nxt; hsc_cur = hsc_nxt;
            }
            it = __builtin_amdgcn_readfirstlane((int)tn);
        }
    }
#undef GP_LOAD_META
#undef GP_LOAD_SC
#undef GP_BUILD
#undef a
}

__device__ __forceinline__ void phase_peer_combine(int l, LAS unsigned char* lds) {
    const KArgs ap = get_args();
#define a (*ap)
    const int tid = fresh_tid(), lane = tid & 63, wave = __builtin_amdgcn_readfirstlane(tid >> 6), G = fresh_g(), bx = fresh_bx();
    unsigned char* ws = a.ws;
    const int nrows = (l == DEPTH - 1) ? ML : M;
    const float* modl = (const float*)(ws + WS_MOD) + (size_t)l * 3 * 6144 + 5120;
    const bool fuse = (l + 1 < DEPTH);
    LAS float* wsk = (LAS float*)lds;
    if (fuse) { const float* src = (const float*)(ws + WS_WSK) + (size_t)(l + 1) * 16384; for (int i = tid; i < 16384 / 4; i += 512) ((LAS f32x4*)wsk)[i] = ((const f32x4*)src)[i]; __syncthreads(); }
    const float* nw1 = a.in[I_N1W] + (l + 1 < DEPTH ? l + 1 : l) * 1024 + 16 * lane;
    const float* modn = (const float*)(ws + WS_MOD) + (size_t)(l + 1 < DEPTH ? l + 1 : l) * 3 * 6144;
    for (int row = wave * G + bx; row < nrows; row += G * 8) {
        float out[16];
#pragma unroll
        for (int i = 0; i < 16; ++i) out[i] = 0.f;
#pragma unroll
        for (int p = 0; p < 8; ++p) { const unsigned* src = (const unsigned*)(ws + WS_PART + (size_t)p * M * 2048) + (size_t)row * 512 + 8 * lane;
            const u32x4 w0 = __builtin_nontemporal_load((const u32x4*)src), w1 = __builtin_nontemporal_load((const u32x4*)(src + 4));
#pragma unroll
            for (int k = 0; k < 4; ++k) { out[2 * k] += bflo(w0[k]); out[2 * k + 1] += bfhi(w0[k]); out[8 + 2 * k] += bflo(w1[k]); out[8 + 2 * k + 1] += bfhi(w1[k]); } }
        float* xr; int mrow;
        if (row < ML) { xr = a.out + (size_t)row * D; mrow = row >= T ? 1 : 0; } else { xr = (float*)(ws + WS_CTXX) + (size_t)(row - ML) * D; mrow = 2; }
        const float* g2 = modl + mrow * 6144 + 16 * lane;
        f32x4 xn[4];
#pragma unroll
        for (int i = 0; i < 4; ++i) { const f32x4 x = *(const f32x4*)(xr + 16 * lane + 4 * i), g = *(const f32x4*)(g2 + 4 * i);
            xn[i] = x + g * (f32x4){out[4 * i], out[4 * i + 1], out[4 * i + 2], out[4 * i + 3]};
            *(f32x4*)(xr + 16 * lane + 4 * i) = xn[i]; }
        if (fuse) {
            float ss = 0.f;
#pragma unroll
            for (int i = 0; i < 4; ++i) ss += (xn[i][0] * xn[i][0] + xn[i][1] * xn[i][1]) + (xn[i][2] * xn[i][2] + xn[i][3] * xn[i][3]);
            const float rstd = rsqrtf(wave_sum(ss) * (1.f / D) + EPS);
            const float* md = modn + mrow * 6144 + 16 * lane;
#pragma unroll
            for (int i = 0; i < 4; ++i) { const f32x4 nwv = *(const f32x4*)(nw1 + 4 * i), sc = *(const f32x4*)(md + 1024 + 4 * i), sh = *(const f32x4*)(md + 4 * i);
                xn[i] = xn[i] * rstd * nwv * (sc + 1.f) + sh; }
            { float hmx = 0.f;
#pragma unroll
              for (int i = 0; i < 4; ++i) hmx = fmaxf(hmx, fmaxf(fmaxf(fabsf(xn[i][0]), fabsf(xn[i][1])), fmaxf(fabsf(xn[i][2]), fabsf(xn[i][3]))));
              hmx = fmaxf(wave_max(hmx), 1e-30f); const float hinv = 127.f / hmx;
              u32x4 o;
#pragma unroll
              for (int i = 0; i < 4; ++i) o[i] = ((unsigned)(int)rintf(xn[i][0] * hinv) & 255u) | (((unsigned)(int)rintf(xn[i][1] * hinv) & 255u) << 8) | (((unsigned)(int)rintf(xn[i][2] * hinv) & 255u) << 16) | (((unsigned)(int)rintf(xn[i][3] * hinv) & 255u) << 24);
              *(u32x4*)((signed char*)(ws + WS_H) + (size_t)row * D + 16 * lane) = o;
              if (lane == 0) ((float*)(ws + WS_GB))[row] = hmx * (1.f / 127.f); }
            float p[16];
#pragma unroll
            for (int c = 0; c < 16; ++c) { float q = 0.f;
#pragma unroll
                for (int i = 0; i < 4; ++i) { const f32x4 w = *(const LAS f32x4*)(wsk + c * 1024 + 16 * lane + 4 * i); q += (xn[i][0] * w[0] + xn[i][1] * w[1]) + (xn[i][2] * w[2] + xn[i][3] * w[3]); }
                p[c] = q; }
            { const bool hb = (lane & 32) != 0;
#pragma unroll
              for (int c = 0; c < 8; ++c) { const float keep = hb ? p[c + 8] : p[c], send = hb ? p[c] : p[c + 8]; p[c] = keep + lane_xor<32>(send); } }
            { const bool hb = (lane & 16) != 0;
#pragma unroll
              for (int c = 0; c < 4; ++c) { const float keep = hb ? p[c + 4] : p[c], send = hb ? p[c] : p[c + 4]; p[c] = keep + lane_xor<16>(send); } }
            { const bool hb = (lane & 8) != 0;
#pragma unroll
              for (int c = 0; c < 2; ++c) { const float keep = hb ? p[c + 2] : p[c], send = hb ? p[c] : p[c + 2]; p[c] = keep + lane_xor<8>(send); } }
            { const bool hb = (lane & 4) != 0; const float keep = hb ? p[1] : p[0], send = hb ? p[0] : p[1]; p[0] = keep + lane_xor<4>(send); }
            p[0] += lane_xor<2>(p[0]); p[0] += lane_xor<1>(p[0]);
            if ((lane & 3) == 0) { const int c = ((lane >> 5) & 1) * 8 + ((lane >> 4) & 1) * 4 + ((lane >> 3) & 1) * 2 + ((lane >> 2) & 1); ((float*)(ws + WS_BA))[(size_t)row * 16 + c] = p[0]; }
        }
    }
    if (fuse) __syncthreads();
#undef a
}
constexpr size_t WS_PD = WS_REC;
constexpr size_t WS_PW = WS_REC + 8 * (size_t)M * 128 * 4;
constexpr size_t WS_PC = WS_PW + (size_t)M * 128;
static_assert(WS_PC + (size_t)M * 8 * 4 <= WS_END, "sliced gather scratch");
constexpr int GS_ITEM = 8;
template <int PH>
__device__ __forceinline__ void phase_peer_slice(int l, int cslot) {
    const KArgs ap = get_args();
#define a (*ap)
    const int tid = fresh_tid(), lane = tid & 63;
    unsigned char* ws = a.ws;
    const int nrows = (l == DEPTH - 1) ? ML : M;
    const int nitem = nrows / GS_ITEM;
    const unsigned char* TAB = ws + WS_UB + (size_t)(l & 1) * TAB_SET + (PH ? (size_t)NEXP * 1024 : 0);
    const int* PIDX = (const int*)(ws + WS_PIDX);
    const unsigned char* PW = ws + WS_PW; const float* PC = (const float*)(ws + WS_PC);
    const float* modl = (const float*)(ws + WS_MOD) + (size_t)l * 3 * 6144 + 5120;
    const int g = lane >> 3, i8 = lane & 7;
    const int x = (int)(xb_xcc_id() & 7u);
#pragma unroll 1
    for (int pp = 0; pp < 8; ++pp) {
        const int p = (x + pp) & 7;
        unsigned* ctr = (unsigned*)(ws + WS_CTL) + 16384 + ((l * 2 + PH) * 8 + p) * 64 + cslot * 8192;
        const unsigned char* tb = TAB + (size_t)p * NEXP * 128 + 16 * i8;
        unsigned tk = 0; if (lane == 0) tk = __hip_atomic_fetch_add(ctr, 1u, __ATOMIC_RELAXED, __HIP_MEMORY_SCOPE_AGENT);
        int it = __builtin_amdgcn_readfirstlane((int)tk);
        if (it < nitem) {
            unsigned tn = 0; if (lane == 0) tn = __hip_atomic_fetch_add(ctr, 1u, __ATOMIC_RELAXED, __HIP_MEMORY_SCOPE_AGENT);
            const int row0 = it * GS_ITEM;
            u32x4 idc[2], idn[2], ra[8], rb[8]; u32x4 wc, wn; float sc_c, sc_n; u32x4 hc, hn;
#define GS_META(ids_, wts_, wsc_, h_, row_) do { const int rw_ = (row_); const u32x4* ip_ = (const u32x4*)((const unsigned short*)PIDX + (size_t)rw_ * 128 + 16 * g); ids_[0] = ip_[0]; ids_[1] = ip_[1]; \
                if (PH) { wts_ = *(const u32x4*)(PW + (size_t)rw_ * 128 + 16 * g); wsc_ = PC[(size_t)rw_ * 8 + g]; } \
                else h_ = *(const u32x4*)((const signed char*)(ws + WS_H) + (size_t)rw_ * D + 128 * p + 16 * i8); } while (0)
#define GS_ROWS(dst_, ids_, hf_) do { _Pragma("unroll") for (int k_ = 0; k_ < 8; ++k_) dst_[k_] = *(const u32x4*)(tb + (size_t)((ids_[hf_][k_ >> 1] >> (16 * (k_ & 1))) & 0xffffu) * 128); } while (0)
            GS_META(idc, wc, sc_c, hc, row0);
            GS_ROWS(ra, idc, 0);
            GS_META(idn, wn, sc_n, hn, row0 + 1);
            int i = 0, tnv = 0x7fffffff;
#pragma unroll 1
            for (;;) {
                if (i == GS_ITEM - 2) tnv = __builtin_amdgcn_readfirstlane((int)tn);
                const int row = it * GS_ITEM + i;
                const int r2 = (i + 2 < GS_ITEM) ? row + 2 : (tnv < nitem ? tnv * GS_ITEM + (i + 2 - GS_ITEM) : row);
                GS_ROWS(rb, idc, 1);
                if (PH == 0) {
                    int d[16];
#pragma unroll
                    for (int k = 0; k < 8; ++k) { int s_ = 0;
#pragma unroll
                        for (int q = 0; q < 4; ++q) s_ = __builtin_amdgcn_sdot4((int)ra[k][q], (int)hc[q], s_, false);
                        d[k] = s_; }
                    GS_ROWS(ra, idn, 0);
#pragma unroll
                    for (int k = 0; k < 8; ++k) { int s_ = 0;
#pragma unroll
                        for (int q = 0; q < 4; ++q) s_ = __builtin_amdgcn_sdot4((int)rb[k][q], (int)hc[q], s_, false);
                        d[8 + k] = s_; }
#define GS_IX(v_, K_) __builtin_bit_cast(int, lane_xor<K_>(__builtin_bit_cast(float, v_)))
                    { const bool hb = (lane & 4) != 0;
#pragma unroll
                      for (int j = 0; j < 8; ++j) { const int keep = hb ? d[j + 8] : d[j], send = hb ? d[j] : d[j + 8]; d[j] = keep + GS_IX(send, 4); } }
                    { const bool hb = (lane & 2) != 0;
#pragma unroll
                      for (int j = 0; j < 4; ++j) { const int keep = hb ? d[j + 4] : d[j], send = hb ? d[j] : d[j + 4]; d[j] = keep + GS_IX(send, 2); } }
                    { const bool hb = (lane & 1) != 0;
#pragma unroll
                      for (int j = 0; j < 2; ++j) { const int keep = hb ? d[j + 2] : d[j], send = hb ? d[j] : d[j + 2]; d[j] = keep + GS_IX(send, 1); } }
#undef GS_IX
                    u32x2 o = {(unsigned)d[0], (unsigned)d[1]};
                    __builtin_nontemporal_store(o, (u32x2*)((int*)(ws + WS_PD) + ((size_t)p * M + row) * 128 + 2 * lane));
                } else {
                    int oi[16];
#pragma unroll
                    for (int k = 0; k < 16; ++k) oi[k] = 0;
#define GS_QUAD(rr_, qd_, wd_) do { _Pragma("unroll") for (int q_ = 0; q_ < 4; ++q_) { \
                        const unsigned r0_ = rr_[4 * (qd_) + 0][q_], r1_ = rr_[4 * (qd_) + 1][q_], r2_ = rr_[4 * (qd_) + 2][q_], r3_ = rr_[4 * (qd_) + 3][q_]; \
                        const unsigned t0_ = __builtin_amdgcn_perm(r1_, r0_, 0x05010400u), t1_ = __builtin_amdgcn_perm(r1_, r0_, 0x07030602u), t2_ = __builtin_amdgcn_perm(r3_, r2_, 0x05010400u), t3_ = __builtin_amdgcn_perm(r3_, r2_, 0x07030602u); \
                        oi[4 * q_ + 0] = __builtin_amdgcn_sdot4((int)__builtin_amdgcn_perm(t2_, t0_, 0x05040100u), (int)(wd_), oi[4 * q_ + 0], false); \
                        oi[4 * q_ + 1] = __builtin_amdgcn_sdot4((int)__builtin_amdgcn_perm(t2_, t0_, 0x07060302u), (int)(wd_), oi[4 * q_ + 1], false); \
                        oi[4 * q_ + 2] = __builtin_amdgcn_sdot4((int)__builtin_amdgcn_perm(t3_, t1_, 0x05040100u), (int)(wd_), oi[4 * q_ + 2], false); \
                        oi[4 * q_ + 3] = __builtin_amdgcn_sdot4((int)__builtin_amdgcn_perm(t3_, t1_, 0x07060302u), (int)(wd_), oi[4 * q_ + 3], false); } } while (0)
                    GS_QUAD(ra, 0, wc[0]); GS_QUAD(ra, 1, wc[1]);
                    GS_ROWS(ra, idn, 0);
                    GS_QUAD(rb, 0, wc[2]); GS_QUAD(rb, 1, wc[3]);
#undef GS_QUAD
                    float o[16];
#pragma unroll
                    for (int k = 0; k < 16; ++k) o[k] = (float)oi[k] * sc_c;
                    { const bool hb = (lane & 32) != 0;
#pragma unroll
                      for (int j = 0; j < 8; ++j) { const float keep = hb ? o[j + 8] : o[j], send = hb ? o[j] : o[j + 8]; o[j] = keep + lane_xor<32>(send); } }
                    { const bool hb = (lane & 16) != 0;
#pragma unroll
                      for (int j = 0; j < 4; ++j) { const float keep = hb ? o[j + 4] : o[j], send = hb ? o[j] : o[j + 4]; o[j] = keep + lane_xor<16>(send); } }
                    { const bool hb = (lane & 8) != 0;
#pragma unroll
                      for (int j = 0; j < 2; ++j) { const float keep = hb ? o[j + 2] : o[j], send = hb ? o[j] : o[j + 2]; o[j] = keep + lane_xor<8>(send); } }
                    const float corr = 0.f;
                    float* xr; int mrow;
                    if (row < ML) { xr = a.out + (size_t)row * D; mrow = row >= T ? 1 : 0; } else { xr = (float*)(ws + WS_CTXX) + (size_t)(row - ML) * D; mrow = 2; }
                    const int col = 128 * p + 16 * i8 + 2 * g;
                    const f32x2 g2 = *(const f32x2*)(modl + mrow * 6144 + col), xo = *(const f32x2*)(xr + col);
                    *(f32x2*)(xr + col) = (f32x2){xo[0] + g2[0] * (o[0] - corr), xo[1] + g2[1] * (o[1] - corr)};
                }
#pragma unroll
                for (int q = 0; q < 2; ++q) idc[q] = idn[q];
                if (PH) { wc = wn; sc_c = sc_n; } else hc = hn;
                GS_META(idn, wn, sc_n, hn, r2);
                if (++i == GS_ITEM) {
                    if (tnv >= nitem) break;
                    it = tnv; i = 0; tnv = 0x7fffffff;
                    if (lane == 0) tn = __hip_atomic_fetch_add(ctr, 1u, __ATOMIC_RELAXED, __HIP_MEMORY_SCOPE_AGENT);
                }
            }
#undef GS_META
#undef GS_ROWS
        }
    }
#undef a
}
__device__ __forceinline__ void phase_peer_weights(int l) {
    const KArgs ap = get_args();
#define a (*ap)
    const int tid = fresh_tid(), lane = tid & 63, wave = __builtin_amdgcn_readfirstlane(tid >> 6), G = fresh_g(), bx = fresh_bx();
    unsigned char* ws = a.ws;
    const int nrows = (l == DEPTH - 1) ? ML : M;
    const f32x2* SC2 = (const f32x2*)(ws + WS_USC) + (size_t)(l & 1) * NEXP;
    const int* PIDX = (const int*)(ws + WS_PIDX); const float* PGATE = (const float*)(ws + WS_PGATE);
    for (int row = wave * G + bx; row < nrows; row += G * 8) {
        const unsigned idw = *((const unsigned*)PIDX + (size_t)row * 64 + lane); const u32x2 id = {idw & 0xffffu, idw >> 16}; const f32x2 gt = *(const f32x2*)(PGATE + (size_t)row * 128 + 2 * lane);
        const float hsc = ((const float*)(ws + WS_GB))[row];
        int d0 = 0, d1 = 0;
#pragma unroll
        for (int p = 0; p < 8; ++p) { const u32x2 v = __builtin_nontemporal_load((const u32x2*)((const int*)(ws + WS_PD) + ((size_t)p * M + row) * 128 + 2 * lane)); d0 += (int)v[0]; d1 += (int)v[1]; }
        const f32x2 s0 = SC2[id[0]], s1 = SC2[id[1]];
        const float x0 = (float)d0 * (s0[0] * hsc), x1 = (float)d1 * (s1[0] * hsc);
        const float w0 = gt[0] * s0[1] * (0.5f * x0 * (1.f + erff(x0 * 0.70710678118654752f))), w1 = gt[1] * s1[1] * (0.5f * x1 * (1.f + erff(x1 * 0.70710678118654752f)));
        float mx = fmaxf(fabsf(w0), fabsf(w1));
        mx = fmaxf(mx, lane_xor<1>(mx)); mx = fmaxf(mx, lane_xor<2>(mx)); mx = fmaxf(mx, lane_xor<4>(mx));
        mx = fmaxf(mx, 1e-30f); const float inv = 127.f / mx;
        *(unsigned short*)(ws + WS_PW + (size_t)row * 128 + 2 * lane) = (unsigned short)(((unsigned)(int)rintf(w0 * inv) & 255u) | (((unsigned)(int)rintf(w1 * inv) & 255u) << 8));
        if ((lane & 7) == 0) ((float*)(ws + WS_PC))[(size_t)row * 8 + (lane >> 3)] = mx * (1.f / 127.f);
    }
#undef a
}

__global__ void __launch_bounds__(512, 2) fwd(Args a) {
    extern __shared__ __attribute__((aligned(16))) unsigned char lds_raw[];
    LAS unsigned char* lds = (LAS unsigned char*)lds_raw;
    volatile LAS unsigned* MISC = (volatile LAS unsigned*)(lds + LDS_MISC);
    if (threadIdx.x < 16) MISC[threadIdx.x] = 0u;
    __syncthreads();
    XcdBarrier bar; bar.bar = (unsigned*)(a.ws + WS_CTL) + 4096; bar.x = 0; bar.st = MISC + 8;
    bar = xcd_barrier_post((unsigned*)(a.ws + WS_CTL) + 4096, MISC + 8);
#ifndef PHASE_MASK
#define PHASE_MASK 0x1FFF
#endif
#define EN(i) ((PHASE_MASK >> (i)) & 1)
#ifndef REP_MASK
#define REP_MASK 0
#endif
#define REPN(i) (1 + ((REP_MASK >> (i)) & 1))
#define IN(k) true
#define SEAM(k) do { XcdBarrier b_; b_.bar = (unsigned*)(get_args()->ws + WS_CTL) + 4096; b_.x = xb_xcc_id(); b_.st = (volatile LAS unsigned*)(lds + LDS_MISC) + 8; xcd_barrier(b_); } while (0)
    for (int rep_ = 0; rep_ < (REPN(0)); ++rep_) if (EN(0) && IN(0)) phase_prologue(lds);
    SEAM(0);
#pragma unroll 1
    for (int l_ = 0; l_ < DEPTH; ++l_) {
        int l = l_; asm volatile("" : "+s"(l));
        const int pb = 1 + l * NPH_L;
        const int mrows = (l == DEPTH - 1) ? ML : M;
        if (l == 0) { for (int rep_ = 0; rep_ < (REPN(1)); ++rep_) if (EN(1) && IN(pb + 0)) { phase_norm<true>(l, 0, lds); phase_quant_weights(lds); }
            SEAM(pb + 0); }
        for (int rep_ = 0; rep_ < (REPN(2)); ++rep_) if (EN(2) && IN(pb + 1)) { const KArgs ap = get_args(); unsigned char* ws = ap->ws; pg8::Gemm g{(const bf16_t*)(ws + WS_H), (const bf16_t*)((const signed char*)(ws + WS_WINT) + (size_t)l * NP * 1024), M, NP, 512}; pg8::StaticOrder S; S.init(M, NP, fresh_g(), fresh_bx());
            pg8::EpiBf16I8 E{(bf16_t*)(ws + WS_P), NP, (const float*)(ws + WS_GB), (const float*)(ws + WS_CTL) + CW_WMAX + (l * 3 + 0) * 3072}; pg8::gemm_phase(lds, g, S, E); }
        SEAM(pb + 1);
        for (int rep_ = 0; rep_ < (REPN(3)); ++rep_) if (EN(3) && IN(pb + 2)) { phase_dn_chunkprep<1>(l, lds); phase_prep(l, lds); }
        for (int rep_ = 0; rep_ < (REPN(4)); ++rep_) if (EN(4) && IN(pb + 3)) phase_dn_chunkprep<0>(l, lds);
        SEAM(pb + 3);
        for (int rep_ = 0; rep_ < (REPN(5)); ++rep_) if (EN(5) && IN(pb + 4)) { phase_dn_scan<0>(l, lds); __syncthreads(); phase_attn(l, lds_raw, MISC, rep_); }
        SEAM(pb + 4);
        for (int rep_ = 0; rep_ < (REPN(7)); ++rep_) if (EN(7) && IN(pb + 5)) phase_dn_out(l);
        SEAM(pb + 5);
        if (EN(8) && IN(pb + 6)) { const KArgs ap = get_args(); unsigned char* ws = ap->ws; pg8::Gemm g{(const bf16_t*)(ws + WS_CATQ), (const bf16_t*)((const signed char*)(ws + WS_WOUTT) + (size_t)l * 1024 * 1024), mrows, 1024, 512}; pg8::StaticOrder S; S.init(mrows, 1024, fresh_g(), fresh_bx());
            pg8::EpiResI8 E{l == 0 ? ap->in[I_X] : ap->out, l == 0 ? ap->in[I_CTX] : (const float*)(ws + WS_CTXX), ap->out, (float*)(ws + WS_CTXX), (const float*)(ws + WS_MOD) + (size_t)l * 3 * 6144 + 2048,
                              (const float*)(ws + WS_GB) + (1u << 18), (const float*)(ws + WS_CTL) + CW_WMAX + (l * 3 + 1) * 3072};
            pg8::gemm_phase(lds, g, S, E); }
        SEAM(pb + 6);
        for (int rep_ = 0; rep_ < (REPN(9)); ++rep_) if (EN(9) && IN(pb + 7)) phase_norm<false>(l, 1, lds);
        SEAM(pb + 7);
        for (int rep_ = 0; rep_ < (REPN(10)); ++rep_) if (EN(10) && IN(pb + 8)) { const KArgs ap = get_args(); unsigned char* ws = ap->ws; pg8::Gemm g{(const bf16_t*)(ws + WS_H), (const bf16_t*)((const signed char*)(ws + WS_WQT) + (size_t)l * 2048 * 1024), mrows, 2048, 512}; pg8::StaticOrder S; S.init(mrows, 2048, fresh_g(), fresh_bx());
            pg8::EpiBf16I8 E{(bf16_t*)(ws + WS_P), 2048, (const float*)(ws + WS_GB), (const float*)(ws + WS_CTL) + CW_WMAX + (l * 3 + 2) * 3072}; pg8::gemm_phase(lds, g, S, E); }
        SEAM(pb + 8);
        for (int rep_ = 0; rep_ < (REPN(11)); ++rep_) if (EN(11) && IN(pb + 9)) phase_peer_select(l);
        SEAM(pb + 9);
        #ifdef GATHER_VAR
        if (EN(12) && IN(pb + 10)) phase_peer_gather<false, GATHER_VAR>(l, lds);
#endif
#if GATHER_PART == 2
        if (EN(12) && IN(pb + 10)) phase_peer_slice<0>(l, 0);
        SEAM(pb + 10);
        if (EN(12) && IN(pb + 10)) phase_peer_weights(l);
        SEAM(pb + 10);
        if (EN(12) && IN(pb + 10)) phase_peer_slice<1>(l, 0);
        if (l + 1 < DEPTH) { SEAM(pb + 10); if (EN(12) && IN(pb + 10)) phase_norm<true>(l + 1, 0, lds); }
#elif GATHER_PART
        if (EN(12) && IN(pb + 10)) phase_peer_gpart(l, lds);
        SEAM(pb + 10);
        if (EN(12) && IN(pb + 10)) phase_peer_combine(l, lds);
#else
        if (REPN(12) > 1 && EN(12) && IN(pb + 10)) phase_peer_gather<false>(l, lds);
        if (EN(12) && IN(pb + 10)) phase_peer_gather<true>(l, lds);
#endif
        if (l + 1 < DEPTH) SEAM(pb + 10);
    }
#undef IN
#undef SEAM
}

#ifndef N_LAUNCH_MODE
#define N_LAUNCH_MODE 1
#endif
extern "C" void kernel_launch(void* const* d_in, const int* in_sizes, int n_in, void* d_out, int out_size, void* d_ws, size_t ws_size, hipStream_t stream) {
    static int grid = 0;
    if (grid == 0) {
        if (n_in != 20 || out_size != ML * D || ws_size < WS_END) { fprintf(stderr, "kernel_launch: unexpected shapes: n_in %d out %d ws %zu (need %zu)\n", n_in, out_size, ws_size, (size_t)WS_END); grid = -1; return; }
        int dev = 0, cus = 0, per_cu = 0;
        if (hipGetDevice(&dev) != hipSuccess || hipDeviceGetAttribute(&cus, hipDeviceAttributeMultiprocessorCount, dev) != hipSuccess) { grid = -1; return; }
        if (hipFuncSetAttribute((const void*)fwd, hipFuncAttributeMaxDynamicSharedMemorySize, LDS_BYTES) != hipSuccess) { fprintf(stderr, "kernel_launch: hipFuncSetAttribute failed\n"); grid = -1; return; }
        if (hipOccupancyMaxActiveBlocksPerMultiprocessor(&per_cu, (const void*)fwd, 512, LDS_BYTES) != hipSuccess || per_cu < 1) fprintf(stderr, "kernel_launch: occupancy query says %d\n", per_cu);
        (void)hipGetLastError();
        grid = cus;
    }
    if (grid < 0) return;
    (void)hipMemsetAsync((char*)d_ws + WS_CTL, 0, CTL_BYTES, stream);
    Args a{};
    for (int i = 0; i < 20; ++i) a.in[i] = (const float*)d_in[i];
    a.out = (float*)d_out; a.ws = (unsigned char*)d_ws;
    a.ph_lo = 0; a.ph_hi = NPHASE;
    hipLaunchKernelGGL(fwd, dim3(grid), dim3(512), LDS_BYTES, stream, a);
    const hipError_t le = hipPeekAtLastError();
    if (le != hipSuccess) fprintf(stderr, "kernel_launch: launch failed: %s\n", hipGetErrorName(le));
}
```

```cpp
#include <hip/hip_runtime.h>
#ifndef GATHER_PART
#define GATHER_PART 2
#endif
#include <cstdio>
#include <cstdint>

#define GAS __attribute__((address_space(1)))
#define LAS __attribute__((address_space(3)))
typedef unsigned short bf16_t;
typedef short bf16x8 __attribute__((ext_vector_type(8)));
typedef short s16x4 __attribute__((ext_vector_type(4)));
typedef float f32x4 __attribute__((ext_vector_type(4)));
typedef float f32x2 __attribute__((ext_vector_type(2)));
typedef float f32x16 __attribute__((ext_vector_type(16)));
typedef unsigned u32x4 __attribute__((ext_vector_type(4)));
typedef unsigned u32x2 __attribute__((ext_vector_type(2)));
typedef int i32x4 __attribute__((ext_vector_type(4)));

constexpr int D = 1024, NB = 2, T = 16384, DEPTH = 4, CT = 256;
constexpr int ML = NB * T, MC = NB * CT, M = ML + MC;
constexpr int NIN = 3088, NP = 3072;
constexpr int KVLEN = T + CT;
constexpr int NEXP = 16384;
constexpr float EPS = 1e-6f;
constexpr int NPH_L = 11;
constexpr int NPHASE = 1 + DEPTH * NPH_L;

constexpr size_t MiB = 1u << 20;
constexpr size_t WS_CTL = 0, CTL_BYTES = 1 * MiB;
constexpr size_t WS_MOD = 1 * MiB;
constexpr size_t WS_ROPE = 2 * MiB;
constexpr size_t WS_WSK = 3 * MiB;
constexpr size_t WS_CTXX = 4 * MiB;
constexpr size_t WS_WINT = 8 * MiB;
constexpr size_t WS_WOUTT = 32 * MiB;
constexpr size_t WS_WQT = 40 * MiB;
constexpr size_t WS_SKB = 56 * MiB;
constexpr size_t WS_USC = 58 * MiB;
constexpr size_t WS_UB = 64 * MiB;
constexpr size_t WS_VB = 80 * MiB;
constexpr size_t TAB_SET = 32 * MiB;
constexpr size_t WS_H = 128 * MiB;
static_assert(WS_H + 2 * (size_t)M * 1024 <= 193 * MiB, "H + concat int8");
constexpr size_t WS_CATQ = WS_H + (size_t)M * 1024;
constexpr size_t WS_P = 193 * MiB;
constexpr size_t WS_QA = 388 * MiB;
constexpr size_t WS_KA = 421 * MiB;
constexpr size_t WS_VA = 438 * MiB;
constexpr size_t WS_CAT = 455 * MiB;
constexpr size_t WS_DQ = 520 * MiB;
constexpr size_t WS_DK = 553 * MiB;
constexpr size_t WS_DV = 586 * MiB;
constexpr size_t WS_OF = 619 * MiB;
constexpr size_t WS_OB = WS_OF + (size_t)M * 1024;
constexpr size_t WS_XB = WS_OB + (size_t)M * 1024;
static_assert(WS_OB + (size_t)M * 1024 <= WS_XB && WS_XB + (size_t)M * 2048 <= 749 * MiB, "OF/OB/XB");
constexpr size_t WS_GB = 749 * MiB;
constexpr size_t WS_BA = 752 * MiB;
constexpr size_t WS_PIDX = 755 * MiB;
constexpr size_t WS_PGATE = 772 * MiB;
constexpr size_t WS_REC = 789 * MiB;
constexpr size_t WS_END = 990 * MiB;
constexpr int CW_WMAX = 65536;
constexpr int NCH = 260;
constexpr int REC_K = 0, REC_KT = 16384, REC_Q = 32768, REC_V = 49152, REC_DIR = 65536, REC_DIRSZ = 17408, REC_BYTES = REC_DIR + 2 * REC_DIRSZ;
static_assert((size_t)NB * 4 * NCH * REC_BYTES + WS_REC <= WS_END, "rec region");

constexpr int LDS_BYTES = 163840;
constexpr int LDS_MISC = 163840 - 256;

__device__ __forceinline__ float bf2f(unsigned b) { return __uint_as_float(b << 16); }
__device__ __forceinline__ float bflo(unsigned w) { return __uint_as_float(w << 16); }
__device__ __forceinline__ float bfhi(unsigned w) { return __uint_as_float(w & 0xffff0000u); }
typedef __bf16 bf2v __attribute__((ext_vector_type(2)));
__device__ __forceinline__ unsigned pkbf(float lo, float hi) { unsigned r; asm("v_cvt_pk_bf16_f32 %0, %1, %2" : "=v"(r) : "v"(lo), "v"(hi)); return r; }
__device__ __forceinline__ unsigned pkbf_c(float lo, float hi) { f32x2 v = {lo, hi}; bf2v r = __builtin_convertvector(v, bf2v); return __builtin_bit_cast(unsigned, r); }
template <int K> __device__ __forceinline__ float lane_xor(float v) {
    const int b = __builtin_bit_cast(int, v);
    if constexpr (K == 1) return __builtin_bit_cast(float, __builtin_amdgcn_update_dpp(0, b, 0xB1, 0xF, 0xF, true));
    else if constexpr (K == 2) return __builtin_bit_cast(float, __builtin_amdgcn_update_dpp(0, b, 0x4E, 0xF, 0xF, true));
    else if constexpr (K == 32) { auto rr = __builtin_amdgcn_permlane32_swap((unsigned)b, (unsigned)b, false, false); unsigned ln_ = __builtin_amdgcn_mbcnt_hi(~0u, __builtin_amdgcn_mbcnt_lo(~0u, 0u)); asm volatile("" : "+v"(ln_));
        return __uint_as_float((ln_ & 32u) ? rr[0] : rr[1]); }
    else return __builtin_bit_cast(float, __builtin_amdgcn_ds_swizzle(b, 0x1F | (K << 10)));
}
__device__ __forceinline__ float wave_sum(float v) {
    v += lane_xor<1>(v); v += lane_xor<2>(v);
    v += __builtin_bit_cast(float, __builtin_amdgcn_update_dpp(0, __builtin_bit_cast(int, v), 0x124, 0xF, 0xF, true));
    v += __builtin_bit_cast(float, __builtin_amdgcn_update_dpp(0, __builtin_bit_cast(int, v), 0x128, 0xF, 0xF, true));
    v += lane_xor<16>(v);
    { auto rr = __builtin_amdgcn_permlane32_swap(__float_as_uint(v), __float_as_uint(v), false, false); v = __uint_as_float(rr[0]) + __uint_as_float(rr[1]); }
    return v;
}
__device__ __forceinline__ float wave_max(float v) {
    v = fmaxf(v, lane_xor<1>(v)); v = fmaxf(v, lane_xor<2>(v));
    v = fmaxf(v, __builtin_bit_cast(float, __builtin_amdgcn_update_dpp(0, __builtin_bit_cast(int, v), 0x124, 0xF, 0xF, true)));
    v = fmaxf(v, __builtin_bit_cast(float, __builtin_amdgcn_update_dpp(0, __builtin_bit_cast(int, v), 0x128, 0xF, 0xF, true)));
    v = fmaxf(v, lane_xor<16>(v));
    { auto rr = __builtin_amdgcn_permlane32_swap(__float_as_uint(v), __float_as_uint(v), false, false); v = fmaxf(__uint_as_float(rr[0]), __uint_as_float(rr[1])); }
    return v;
}
__device__ __forceinline__ float silu_f(float x) { return x / (1.f + __expf(-x)); }
#define LDS_WAIT() asm volatile("s_waitcnt lgkmcnt(0)" ::: "memory")

#define XB_TMO      128
#define XB_XCNT(j)  (256  + 64 * (j))
#define XB_XSUB(j)  (1280 + 64 * (j))
#define XB_XGEN(j)  (2304 + 64 * (j))
#define XB_TOP      3328
#define XB_TOPGEN   3392
#define XCD_BAR_WORDS 3456
#define XB_SPIN_CAP (1u << 22)
__device__ __forceinline__ unsigned xb_ld(unsigned* p)              { return __hip_atomic_load(p, __ATOMIC_RELAXED, __HIP_MEMORY_SCOPE_AGENT); }
__device__ __forceinline__ unsigned xb_add(unsigned* p, unsigned v) { return __hip_atomic_fetch_add(p, v, __ATOMIC_RELAXED, __HIP_MEMORY_SCOPE_AGENT); }
__device__ __forceinline__ unsigned xb_xcc_id() { return (unsigned)__builtin_amdgcn_s_getreg((3 << 11) | 20) & 0xFu; }
#define XB_SPIN(cond, bar) do { unsigned _sp = 0; while (cond) { __builtin_amdgcn_s_sleep(1); \
    if ((++_sp & 255u) == 0u) { if (xb_ld(&(bar)[XB_TMO])) break; if (_sp > XB_SPIN_CAP) { atomicAdd(&(bar)[XB_TMO], 1u); break; } } } } while (0)
struct XcdBarrier { unsigned* bar; unsigned x; volatile LAS unsigned* st; };
__device__ __forceinline__ XcdBarrier xcd_barrier_post(unsigned* bar, volatile LAS unsigned* st) {
    XcdBarrier b; b.bar = bar; b.x = xb_xcc_id(); b.st = st;
    if (threadIdx.x == 0) (void)xb_add(&bar[XB_XCNT(b.x)], 1u);
    return b;
}
__device__ __forceinline__ void xcd_barrier_complete(unsigned* bar, unsigned x, unsigned& nloc, unsigned& nx) {
    const unsigned G = gridDim.x * gridDim.y * gridDim.z;
    unsigned sum, cnt, mine, sp = 0u;
    for (;;) {
        sum = 0u; cnt = 0u; mine = 0u;
#pragma unroll
        for (unsigned j = 0; j < 16; ++j) { const unsigned c = xb_ld(&bar[XB_XCNT(j)]); sum += c; cnt += (c > 0u) ? 1u : 0u; mine = (j == x) ? c : mine; }
        if (sum == G) break;
        __builtin_amdgcn_s_sleep(1);
        if ((++sp & 255u) == 0u) { if (xb_ld(&bar[XB_TMO])) break; if (sp > XB_SPIN_CAP) { atomicAdd(&bar[XB_TMO], 1u); break; } }
    }
    nloc = mine > 0u ? mine : 1u; nx = cnt > 0u ? cnt : 1u;
}
__device__ __forceinline__ void xcd_barrier(const XcdBarrier& b) {
    asm volatile("s_waitcnt vmcnt(0)" ::: "memory");
    __syncthreads();
    if (threadIdx.x == 0) {
        unsigned* bar = b.bar; unsigned bx_ = b.x;
        asm volatile("" : "+s"(bar), "+s"(bx_));
        __builtin_amdgcn_s_waitcnt(0);
        unsigned nloc = b.st[0], nx = b.st[1];
        if (nloc == 0u) { xcd_barrier_complete(bar, bx_, nloc, nx); b.st[0] = nloc; b.st[1] = nx; }
        const unsigned old = xb_add(&bar[XB_XSUB(bx_)], 1u);
        const unsigned gen = old / nloc;
        if (old + 1u == (gen + 1u) * nloc) {
            __builtin_amdgcn_fence(__ATOMIC_RELEASE, "agent");
            asm volatile("s_waitcnt vmcnt(0)" ::: "memory");
            const unsigned og = xb_add(&bar[XB_TOP], 1u);
            const unsigned tg = og / nx;
            if (og + 1u == (tg + 1u) * nx) xb_add(&bar[XB_TOPGEN], 1u);
            else XB_SPIN(xb_ld(&bar[XB_TOPGEN]) == tg, bar);
            __builtin_amdgcn_fence(__ATOMIC_ACQUIRE, "agent");
            xb_add(&bar[XB_XGEN(bx_)], 1u);
            asm volatile("s_waitcnt vmcnt(0)" ::: "memory");
        } else {
            XB_SPIN(xb_ld(&bar[XB_XGEN(bx_)]) == gen, bar);
            __builtin_amdgcn_fence(__ATOMIC_ACQUIRE, "agent");
            asm volatile("s_waitcnt vmcnt(0)" ::: "memory");
        }
    }
    __syncthreads();
}

namespace pg8 {
constexpr int BM = 256, BK = 64, HALF = 128, HTB = HALF * BK * 2, STAGE_BYTES = 8 * HTB, NXCD = 8, WGM = 8;
__host__ __device__ __forceinline__ int lds_byte(int r, int c) { const int st = (r >> 4) * 2 + (c >> 5), rr = r & 15, cc = c & 31, ob = rr * 64 + cc * 2; return st * 1024 + (ob ^ (((ob >> 9) & 1) << 5)); }
__host__ __device__ __forceinline__ void stage_rc(int b, int& R, int& C) { const int st = b / 1024, sb = b % 1024, swz = sb ^ (((sb >> 9) & 1) << 5); R = (st >> 1) * 16 + swz / 64; C = (st & 1) * 32 + (swz % 64) / 2; }
__host__ __device__ __forceinline__ int perm32(int rho) { const int n = rho >> 4, i = rho & 15; return 8 * (i >> 2) + 4 * n + (i & 3); }
struct Unit { int pm, pn; };
struct Gemm { const bf16_t* A; const bf16_t* Bt; int M, N, K; };
struct StaticOrder {
    int nM, nN, nwg, G, c;
    __host__ __device__ void init(int M_, int N_, int G_, int c_) { nM = M_ / BM; nN = N_ / BM; nwg = nM * nN; G = G_; c = c_; }
    __host__ __device__ bool next(int i, Unit& u) const {
        const long L = (long)i * G + c; if (L >= nwg) return false;
        int wgid = (int)L; { const int q = nwg / NXCD, r = nwg % NXCD, xcd = wgid % NXCD, off = wgid / NXCD; wgid = (xcd < r ? xcd * (q + 1) : r * (q + 1) + (xcd - r) * q) + off; }
        const int nig = WGM * nN, gid = wgid / nig, fm = gid * WGM, gsz = (nM - fm) < WGM ? (nM - fm) : WGM;
        u.pm = fm + ((wgid % nig) % gsz); u.pn = (wgid % nig) / gsz; return true;
    }
    __device__ __forceinline__ void a_ready(const Unit&) const {}
    __device__ __forceinline__ void done(const Unit&) const {}
};
struct EpiBf16 {
    static constexpr bool PERM = true, I8 = false; typedef f32x4 acc_t;
    bf16_t* O; int ldc;
    __device__ __forceinline__ void operator()(const f32x4 (&acc)[2][2][4][2], const Unit& u, int wr, int wc, int fr, int fq) const {
        const int row0 = u.pm * BM + wr * 64 + fr; const int col0 = u.pn * BM + wc * 32 + 8 * fq;
#pragma unroll
        for (int ai = 0; ai < 2; ++ai)
#pragma unroll
            for (int m = 0; m < 4; ++m) { bf16_t* rowp = O + (size_t)(row0 + ai * HALF + m * 16) * ldc + col0;
#pragma unroll
                for (int bj = 0; bj < 2; ++bj) { const f32x4 v0 = acc[ai][bj][m][0], v1 = acc[ai][bj][m][1];
                    u32x4 w; w.x = pkbf_c(v0[0], v0[1]); w.y = pkbf_c(v0[2], v0[3]); w.z = pkbf_c(v1[0], v1[1]); w.w = pkbf_c(v1[2], v1[3]);
                    *(u32x4*)(rowp + bj * HALF) = w; } }
    }
};
struct EpiBf16I8 {
    static constexpr bool PERM = true, I8 = true; typedef i32x4 acc_t;
    bf16_t* O; int ldc; const float* sa; const float* wmax;
    __device__ __forceinline__ void operator()(const i32x4 (&acc)[2][2][4][2], const Unit& u, int wr, int wc, int fr, int fq) const {
        const int row0 = u.pm * BM + wr * 64 + fr; const int col0 = u.pn * BM + wc * 32 + 8 * fq;
        f32x4 sw[2][2];
#pragma unroll
        for (int bj = 0; bj < 2; ++bj)
#pragma unroll
            for (int n = 0; n < 2; ++n) sw[bj][n] = *(const f32x4*)(wmax + col0 + bj * HALF + 4 * n) * (1.f / 127.f);
#pragma unroll
        for (int ai = 0; ai < 2; ++ai)
#pragma unroll
            for (int m = 0; m < 4; ++m) { const int row = row0 + ai * HALF + m * 16; const float sr = sa[row]; bf16_t* rowp = O + (size_t)row * ldc + col0;
#pragma unroll
                for (int bj = 0; bj < 2; ++bj) { const i32x4 a0 = acc[ai][bj][m][0], a1 = acc[ai][bj][m][1];
                    const f32x4 v0 = (f32x4){(float)a0[0], (float)a0[1], (float)a0[2], (float)a0[3]} * sw[bj][0] * sr, v1 = (f32x4){(float)a1[0], (float)a1[1], (float)a1[2], (float)a1[3]} * sw[bj][1] * sr;
                    u32x4 w; w.x = pkbf(v0[0], v0[1]); w.y = pkbf(v0[2], v0[3]); w.z = pkbf(v1[0], v1[1]); w.w = pkbf(v1[2], v1[3]);
                    *(u32x4*)(rowp + bj * HALF) = w; } }
    }
};
struct EpiRes {
    static constexpr bool PERM = false, I8 = false; typedef f32x4 acc_t;
    const float* src_lat; const float* src_ctx; float* dst_lat; float* dst_ctx; const float* gate;
    __device__ __forceinline__ void operator()(const f32x4 (&acc)[2][2][4][2], const Unit& u, int wr, int wc, int fr, int fq) const {
        const bool isctx = u.pm >= (ML / BM);
        const float* src = isctx ? src_ctx + (size_t)(u.pm - ML / BM) * BM * D : src_lat + (size_t)u.pm * BM * D;
        float* dst = isctx ? dst_ctx + (size_t)(u.pm - ML / BM) * BM * D : dst_lat + (size_t)u.pm * BM * D;
        const int mrow = isctx ? 2 : (u.pm >= (T / BM) ? 1 : 0);
        const int row0 = wr * 64 + fr, col0 = u.pn * BM + wc * 32 + 4 * fq;
        f32x4 gv[2][2];
#pragma unroll
        for (int bj = 0; bj < 2; ++bj)
#pragma unroll
            for (int n = 0; n < 2; ++n) gv[bj][n] = *(const f32x4*)(gate + mrow * 6144 + col0 + bj * HALF + n * 16);
#pragma unroll
        for (int ai = 0; ai < 2; ++ai)
#pragma unroll
            for (int m = 0; m < 4; ++m) { const size_t off = (size_t)(row0 + ai * HALF + m * 16) * D + col0;
#pragma unroll
                for (int bj = 0; bj < 2; ++bj)
#pragma unroll
                    for (int n = 0; n < 2; ++n) { const f32x4 s = *(const f32x4*)(src + off + bj * HALF + n * 16);
                        *(f32x4*)(dst + off + bj * HALF + n * 16) = s + gv[bj][n] * acc[ai][bj][m][n]; } }
    }
};

struct EpiResI8 {
    static constexpr bool PERM = false, I8 = true; typedef i32x4 acc_t;
    const float* src_lat; const float* src_ctx; bf16_t* xb; bool first; const float* gate; const float* sa; const float* wmax;
    __device__ __forceinline__ void operator()(const i32x4 (&acc)[2][2][4][2], const Unit& u, int wr, int wc, int fr, int fq) const {
        const bool isctx = u.pm >= (ML / BM);
        const float* src = isctx ? src_ctx + (size_t)(u.pm - ML / BM) * BM * D : src_lat + (size_t)u.pm * BM * D;
        bf16_t* dst = xb + (size_t)u.pm * BM * D;
        const int mrow = isctx ? 2 : (u.pm >= (T / BM) ? 1 : 0);
        const int row0 = wr * 64 + fr, col0 = u.pn * BM + wc * 32 + 4 * fq;
        f32x4 gv[2][2];
#pragma unroll
        for (int bj = 0; bj < 2; ++bj)
#pragma unroll
            for (int n = 0; n < 2; ++n) gv[bj][n] = *(const f32x4*)(gate + mrow * 6144 + col0 + bj * HALF + n * 16) * *(const f32x4*)(wmax + col0 + bj * HALF + n * 16) * (1.f / 127.f);
#pragma unroll
        for (int ai = 0; ai < 2; ++ai)
#pragma unroll
            for (int m = 0; m < 4; ++m) { const int rl = row0 + ai * HALF + m * 16; const float sr = sa[u.pm * BM + rl]; const size_t off = (size_t)rl * D + col0;
#pragma unroll
                for (int bj = 0; bj < 2; ++bj)
#pragma unroll
                    for (int n = 0; n < 2; ++n) { const i32x4 ac = acc[ai][bj][m][n]; f32x4 sv;
                        if (first) sv = *(const f32x4*)(src + off + bj * HALF + n * 16);
                        else { const u32x2 w_ = *(const u32x2*)(dst + off + bj * HALF + n * 16); sv = (f32x4){bflo(w_[0]), bfhi(w_[0]), bflo(w_[1]), bfhi(w_[1])}; }
                        const f32x4 r_ = sv + gv[bj][n] * ((f32x4){(float)ac[0], (float)ac[1], (float)ac[2], (float)ac[3]} * sr);
                        *(u32x2*)(dst + off + bj * HALF + n * 16) = (u32x2){pkbf(r_[0], r_[1]), pkbf(r_[2], r_[3])}; } }
    }
};
template <class Epi, class Sched>
__device__ __forceinline__ void gemm_phase(LAS unsigned char* lds, const Gemm g, const Sched& S, const Epi& E) {
    constexpr bool I8 = Epi::I8;
    typedef typename Epi::acc_t acc_t;
    int tid = threadIdx.x; asm volatile("" : "+v"(tid)); const int wid = __builtin_amdgcn_readfirstlane(tid >> 6), lane = tid & 63, wr = wid >> 2, wc = wid & 3, fr = lane & 15, fq = lane >> 4;
    const int K = g.K, nt = K / BK;
    unsigned voffA[2], voffB[2];
#pragma unroll
    for (int i = 0; i < 2; ++i) { int R, C; stage_rc(tid * 16 + i * 8192, R, C); const int Rb = Epi::PERM ? ((R & ~31) + perm32(R & 31)) : R;
        voffA[i] = (unsigned)(R * K + C) * 2u; voffB[i] = (unsigned)(Rb * K + C) * 2u; }
    const size_t kstep = (size_t)(BK * 2);
    const size_t hstep = (size_t)HALF * K * 2;
    const size_t tstep = 2 * hstep;
    const unsigned ldsw = (unsigned)wid * 1024u;
    const int aoff = lds_byte(wr * 64 + fr, fq * 8), boff = lds_byte(wc * 32 + fr, fq * 8);
#define PG8_SA(b, h) (((b) * 2 + (h)) * HTB)
#define PG8_SB(b, h) ((4 + (b) * 2 + (h)) * HTB)
#define PG8_STAGE(bufoff, gbase, voff) do { _Pragma("unroll") for (int _i = 0; _i < 2; ++_i) \
        __builtin_amdgcn_global_load_lds((const unsigned*)((const char*)(gbase) + (voff)[_i]), (LAS unsigned*)(lds + (bufoff) + ldsw + _i * 8192), 16, 0, 0); } while (0)
#define PG8_LDA(dst, b, h) do { _Pragma("unroll") for (int m = 0; m < 4; ++m) _Pragma("unroll") for (int k = 0; k < 2; ++k) dst[m][k] = *(const LAS bf16x8*)(lds + PG8_SA(b, h) + aoff + m * 2048 + k * 1024); } while (0)
#define PG8_LDB(dst, b, h) do { _Pragma("unroll") for (int n = 0; n < 2; ++n) _Pragma("unroll") for (int k = 0; k < 2; ++k) dst[n][k] = *(const LAS bf16x8*)(lds + PG8_SB(b, h) + boff + n * 2048 + k * 1024); } while (0)
#define PG8_MMA(ai, bj, At, Bt) do { __builtin_amdgcn_s_setprio(1); _Pragma("unroll") for (int m = 0; m < 4; ++m) _Pragma("unroll") for (int n = 0; n < 2; ++n) _Pragma("unroll") for (int k = 0; k < 2; ++k) \
        { if constexpr (I8) acc[ai][bj][m][n] = __builtin_bit_cast(acc_t, __builtin_amdgcn_mfma_i32_16x16x64_i8(__builtin_bit_cast(i32x4, Bt[n][k]), __builtin_bit_cast(i32x4, At[m][k]), __builtin_bit_cast(i32x4, acc[ai][bj][m][n]), 0, 0, 0)); \
          else acc[ai][bj][m][n] = __builtin_bit_cast(acc_t, __builtin_amdgcn_mfma_f32_16x16x32_bf16(Bt[n][k], At[m][k], __builtin_bit_cast(f32x4, acc[ai][bj][m][n]), 0, 0, 0)); } __builtin_amdgcn_s_setprio(0); } while (0)
#define PG8_WAIT_V(n) asm volatile("s_waitcnt vmcnt(" #n ")" ::: "memory")
#define PG8_WAIT_L(n) asm volatile("s_waitcnt lgkmcnt(" #n ")" ::: "memory")
#define PG8_BAR __builtin_amdgcn_s_barrier()
#define PG8_SCHED __builtin_amdgcn_sched_barrier(0)
    Unit cur, nxt; int ui = 0;
    if (!S.next(0, cur)) return;
    acc_t acc[2][2][4][2];
#pragma unroll
    for (int a = 0; a < 2; ++a)
#pragma unroll
        for (int b = 0; b < 2; ++b)
#pragma unroll
            for (int m = 0; m < 4; ++m)
#pragma unroll
                for (int n = 0; n < 2; ++n) acc[a][b][m][n] = acc_t{};
    bf16x8 At[4][2], B0[2][2], B1[2][2];
    const char* cA = (const char*)g.A + (size_t)cur.pm * tstep; const char* cB = (const char*)g.Bt + (size_t)cur.pn * tstep;
    S.a_ready(cur);
    PG8_STAGE(PG8_SB(0, 0), cB, voffB); PG8_STAGE(PG8_SA(0, 0), cA, voffA); PG8_STAGE(PG8_SB(0, 1), cB + hstep, voffB); PG8_STAGE(PG8_SA(0, 1), cA + hstep, voffA);
    if (wr == 1) PG8_BAR;
    PG8_WAIT_V(4); PG8_BAR;
    PG8_STAGE(PG8_SB(1, 0), cB + kstep, voffB); PG8_STAGE(PG8_SA(1, 0), cA + kstep, voffA); PG8_STAGE(PG8_SB(1, 1), cB + hstep + kstep, voffB);
    PG8_WAIT_V(6); PG8_BAR;
    for (;;) {
        const bool has_next = S.next(ui + 1, nxt);
        const char* nA = has_next ? (const char*)g.A + (size_t)nxt.pm * tstep : cA; const char* nB = has_next ? (const char*)g.Bt + (size_t)nxt.pn * tstep : cB;
        for (int t = 0; t < nt; t += 2) {
            const bool last = (t == nt - 2);
            const char* a1 = cA + (size_t)(t + 1) * kstep;
            const char* a2 = last ? nA : cA + (size_t)(t + 2) * kstep; const char* b2 = last ? nB : cB + (size_t)(t + 2) * kstep;
            const char* a3 = a2 + kstep; const char* b3 = b2 + kstep;
            if (last && has_next) S.a_ready(nxt);
            PG8_LDB(B0, 0, 0); PG8_SCHED; PG8_LDA(At, 0, 0); PG8_STAGE(PG8_SA(1, 1), a1 + hstep, voffA);
            PG8_WAIT_L(8); PG8_BAR; PG8_WAIT_L(0); PG8_MMA(0, 0, At, B0); PG8_BAR; PG8_SCHED;
            PG8_LDB(B1, 0, 1); PG8_STAGE(PG8_SB(0, 0), b2, voffB);
            PG8_BAR; PG8_WAIT_L(0); PG8_MMA(0, 1, At, B1); PG8_BAR;
            PG8_LDA(At, 0, 1); PG8_STAGE(PG8_SA(0, 0), a2, voffA);
            PG8_BAR; PG8_WAIT_L(0); PG8_MMA(1, 0, At, B0); PG8_BAR; PG8_SCHED;
            PG8_STAGE(PG8_SB(0, 1), b2 + hstep, voffB);
            PG8_WAIT_V(6); PG8_BAR; PG8_MMA(1, 1, At, B1); PG8_BAR;
            PG8_LDB(B0, 1, 0); PG8_SCHED; PG8_LDA(At, 1, 0); PG8_STAGE(PG8_SA(0, 1), a2 + hstep, voffA);
            PG8_WAIT_L(8); PG8_BAR; PG8_WAIT_L(0); PG8_MMA(0, 0, At, B0); PG8_BAR; PG8_SCHED;
            PG8_LDB(B1, 1, 1); PG8_STAGE(PG8_SB(1, 0), b3, voffB);
            PG8_BAR; PG8_WAIT_L(0); PG8_MMA(0, 1, At, B1); PG8_BAR;
            PG8_LDA(At, 1, 1); PG8_STAGE(PG8_SA(1, 0), a3, voffA);
            PG8_BAR; PG8_WAIT_L(0); PG8_MMA(1, 0, At, B0); PG8_BAR; PG8_SCHED;
            PG8_STAGE(PG8_SB(1, 1), b3 + hstep, voffB);
            PG8_WAIT_V(6); PG8_BAR; PG8_MMA(1, 1, At, B1); PG8_BAR;
        }
        E(acc, cur, wr, wc, fr, fq); S.done(cur);
        if (!has_next) break;
#pragma unroll
        for (int a = 0; a < 2; ++a)
#pragma unroll
            for (int b = 0; b < 2; ++b)
#pragma unroll
                for (int m = 0; m < 4; ++m)
#pragma unroll
                    for (int n = 0; n < 2; ++n) acc[a][b][m][n] = acc_t{};
        cur = nxt; cA = nA; cB = nB; ++ui;
    }
    PG8_WAIT_V(0);
    if (wr == 0) PG8_BAR;
    PG8_BAR;
#undef PG8_SA
#undef PG8_SB
#undef PG8_STAGE
#undef PG8_LDA
#undef PG8_LDB
#undef PG8_MMA
#undef PG8_WAIT_V
#undef PG8_WAIT_L
#undef PG8_BAR
#undef PG8_SCHED
}
}

namespace att {
constexpr int HD = 128, NW = 8, QBLK = 32, KVBLK = 64;
constexpr float SCALE = 0.088388347648318440f;
constexpr float THR = 8.f;
constexpr int LDQ = 512, LDK = 256;
constexpr size_t SHM_V = KVBLK * HD * 2, SHM_K = KVBLK * HD * 2, SHM_ATTN = 2 * SHM_V + 2 * SHM_K + NW * 64 * 4;
#define KSWZ(row, colB) ((row) * 256 + ((colB) ^ (((row) & 7) << 4)))
#define SBAR() __builtin_amdgcn_sched_barrier(0)
__device__ __forceinline__ int crow(int r, int hi) { return (r & 3) + 8 * (r >> 2) + 4 * hi; }
__device__ __forceinline__ unsigned cvtpk(float lo, float hi) { unsigned r; asm volatile("v_cvt_pk_bf16_f32 %0, %1, %2" : "=v"(r) : "v"(lo), "v"(hi)); return r; }
__device__ __forceinline__ void partialSM(f32x16& p0, f32x16& p1) {
  for (int r = 0; r < 16; ++r) p0[r] = __builtin_amdgcn_exp2f(p0[r]);
}
typedef int i32x8 __attribute__((ext_vector_type(8)));
__device__ __forceinline__ void finishSM(f32x16& p0, f32x16& p1, i32x8& pa) {
  for (int r = 0; r < 16; ++r) p1[r] = __builtin_amdgcn_exp2f(p1[r]);
#pragma unroll
  for (int q = 0; q < 4; ++q) { int w = __builtin_amdgcn_cvt_pk_bf8_f32(p0[4 * q], p0[4 * q + 1], 0, false); w = __builtin_amdgcn_cvt_pk_bf8_f32(p0[4 * q + 2], p0[4 * q + 3], w, true); pa[q] = w;
    int w2 = __builtin_amdgcn_cvt_pk_bf8_f32(p1[4 * q], p1[4 * q + 1], 0, false); w2 = __builtin_amdgcn_cvt_pk_bf8_f32(p1[4 * q + 2], p1[4 * q + 3], w2, true); pa[4 + q] = w2; }
}
constexpr int K8_STRIDE = 144, K8_TILE = KVBLK * K8_STRIDE;
__device__ __forceinline__ void qkt(f32x16& p0, f32x16& p1, const unsigned char* Ks, const i32x8* qr, int r32, int hi, const f32x16& cinit) {
  p0 = cinit; p1 = cinit;
#pragma unroll
  for (int ks = 0; ks < 2; ++ks) {
    const u32x4* a0 = (const u32x4*)(Ks + r32 * K8_STRIDE + 64 * ks + 32 * hi); const u32x4* a1 = (const u32x4*)(Ks + (32 + r32) * K8_STRIDE + 64 * ks + 32 * hi);
    const u32x4 x0 = a0[0], x1 = a0[1], y0 = a1[0], y1 = a1[1];
    const i32x8 k0 = {(int)x0.x, (int)x0.y, (int)x0.z, (int)x0.w, (int)x1.x, (int)x1.y, (int)x1.z, (int)x1.w}, k1 = {(int)y0.x, (int)y0.y, (int)y0.z, (int)y0.w, (int)y1.x, (int)y1.y, (int)y1.z, (int)y1.w};
    p0 = __builtin_amdgcn_mfma_scale_f32_32x32x64_f8f6f4(k0, qr[ks], p0, 0, 0, 0, 0x7F7F7F7F, 0, 0x7C7C7C7C);
    p1 = __builtin_amdgcn_mfma_scale_f32_32x32x64_f8f6f4(k1, qr[ks], p1, 0, 0, 0, 0x7F7F7F7F, 0, 0x7C7C7C7C); }
}
constexpr int V8_STRIDE = 80, V8_TILE = HD * V8_STRIDE;
__device__ __forceinline__ void pv_d0(f32x16* o, f32x16& ol, const unsigned char* Vs, const i32x8& pa, int r32, int hi) {
  { const i32x8 ones = {0x38383838, 0x38383838, 0x38383838, 0x38383838, 0x38383838, 0x38383838, 0x38383838, 0x38383838};
    ol = __builtin_amdgcn_mfma_scale_f32_32x32x64_f8f6f4(pa, ones, ol, 1, 0, 0, 0x7F7F7F7F, 0, 0x7F7F7F7F); }
#pragma unroll
  for (int d0 = 0; d0 < 4; ++d0) { const u32x4* bp = (const u32x4*)(Vs + (32 * d0 + r32) * V8_STRIDE + 32 * hi); const u32x4 x0 = bp[0], x1 = bp[1];
    const i32x8 vb = {(int)x0.x, (int)x0.y, (int)x0.z, (int)x0.w, (int)x1.x, (int)x1.y, (int)x1.z, (int)x1.w};
    o[d0] = __builtin_amdgcn_mfma_scale_f32_32x32x64_f8f6f4(pa, vb, o[d0], 1  , 0  , 0, 0x7F7F7F7F, 0, 0x7F7F7F7F); }
}
__device__ __forceinline__ void attn_dense_body(const unsigned char* __restrict__ Qb, const unsigned char* __restrict__ Kh, const unsigned char* __restrict__ Vt,
                                                bf16_t* __restrict__ Ob, int LDO, int seq, char* lds, float* __restrict__ lse, float braw) {
  int tid = threadIdx.x; asm volatile("" : "+v"(tid)); const int wid = tid >> 6, lane = tid & 63, r32 = lane & 31, hi = lane >> 5;
  unsigned char* V_lds = (unsigned char*)lds; unsigned char* K_lds = (unsigned char*)(lds + 3 * V8_TILE);
  f32x16 o[4] = {}, ol = {}; i32x8 qr[2];
  const float mnC = __builtin_bit_cast(float, __builtin_amdgcn_readfirstlane(__builtin_bit_cast(int, -fmaxf(braw * (SCALE * 1.4426950408889634f) - 15.5f, 0.f))));
  f32x16 cinit;
#pragma unroll
  for (int r = 0; r < 16; ++r) cinit[r] = mnC;
  const unsigned char* Qw = Qb + (long)(wid * QBLK + r32) * LDQ + hi * 32;
#pragma unroll
  for (int ks = 0; ks < 2; ++ks) { const u32x4 x0 = *(const u32x4*)(Qw + 64 * ks), x1 = *(const u32x4*)(Qw + 64 * ks + 16);
    qr[ks] = (i32x8){(int)x0.x, (int)x0.y, (int)x0.z, (int)x0.w, (int)x1.x, (int)x1.y, (int)x1.z, (int)x1.w}; }
  const int krow = tid >> 3, kch = tid & 7;
  const int vrow = tid >> 2, vch = tid & 3;
  struct { u32x4 v8, k8; } sr_[2];
#define SLOAD(i, k0) do { sr_[i].v8 = *reinterpret_cast<const u32x4*>(Vt + (long)((k0) >> 6) * 8192 + tid * 16); \
    sr_[i].k8 = *reinterpret_cast<const u32x4*>(Kh + (long)((k0) + krow) * LDK + kch * 16); } while (0)
#define SWRITE(b, i) do { *(u32x4*)(V_lds + (b) * V8_TILE + vrow * V8_STRIDE + vch * 16) = sr_[i].v8; \
    *(u32x4*)(K_lds + (b) * K8_TILE + krow * K8_STRIDE + kch * 16) = sr_[i].k8; } while (0)
#define SWAIT() asm volatile("s_waitcnt vmcnt(2)" ::: "memory")
  f32x16 pA0, pA1, pB0, pB1; i32x8 pa; const int NT = seq / KVBLK;
  constexpr int SE = 0, SO = 1;
  SLOAD(SE, 0); asm volatile("s_waitcnt vmcnt(0)" ::: "memory"); SWRITE(0, SE);
  SLOAD(SO, KVBLK); SLOAD(SE, 2 * KVBLK);
  __syncthreads();
  qkt(pA0, pA1, K_lds, qr, r32, hi, cinit); partialSM(pA0, pA1);
  SWAIT(); SWRITE(1, SO); SLOAD(SO, 3 * KVBLK);
  __syncthreads();
  int s0 = 0, s1 = 1, s2 = 2;
  for (int j = 1; j + 1 < NT; j += 2) {
    SBAR(); qkt(pB0, pB1, K_lds + s1 * K8_TILE, qr, r32, hi, cinit);
    finishSM(pA0, pA1, pa); SBAR();
    pv_d0(o, ol, V_lds + s0 * V8_TILE, pa, r32, hi); partialSM(pB0, pB1);
    SBAR(); SWAIT(); SWRITE(s2, SE); SLOAD(SE, (j + 3 < NT ? j + 3 : NT - 1) * KVBLK);
    __syncthreads();
    SBAR(); qkt(pA0, pA1, K_lds + s2 * K8_TILE, qr, r32, hi, cinit);
    finishSM(pB0, pB1, pa); SBAR();
    pv_d0(o, ol, V_lds + s1 * V8_TILE, pa, r32, hi); partialSM(pA0, pA1);
    SBAR(); SWAIT(); SWRITE(s0, SO); SLOAD(SO, (j + 4 < NT ? j + 4 : NT - 1) * KVBLK);
    __syncthreads();
    { const int t_ = s0; s0 = s2; s2 = s1; s1 = t_; }
  }
  SBAR(); qkt(pB0, pB1, K_lds + s1 * K8_TILE, qr, r32, hi, cinit);
  finishSM(pA0, pA1, pa); SBAR();
  pv_d0(o, ol, V_lds + s0 * V8_TILE, pa, r32, hi); partialSM(pB0, pB1);
  finishSM(pB0, pB1, pa); SBAR();
  pv_d0(o, ol, V_lds + s1 * V8_TILE, pa, r32, hi);
  asm volatile("s_waitcnt vmcnt(0)" ::: "memory");
  if (lse && r32 == 0) {
#pragma unroll
    for (int r = 0; r < 16; ++r) lse[(wid * QBLK + crow(r, hi)) * 4] = __logf(ol[r]) - mnC * 0.69314718055994531f; }
  float rli[16];
#pragma unroll
  for (int r = 0; r < 16; ++r) rli[r] = __builtin_amdgcn_rcpf(ol[r]);
  bf16_t* Ow = Ob + (long)(wid * QBLK) * LDO;
#pragma unroll
  for (int r = 0; r < 16; ++r) { int orow = crow(r, hi);
    for (int d0 = 0; d0 < 4; ++d0) Ow[(long)orow * LDO + d0 * 32 + r32] = (bf16_t)(pkbf(o[d0][r] * rli[r], 0.f) & 0xffffu); }
  __syncthreads();
#undef SLOAD
#undef SWRITE
#undef SWAIT
}
}

struct Args { const float* in[20]; float* out; unsigned char* ws; int ph_lo, ph_hi; };
typedef const __attribute__((address_space(4))) Args* KArgs;
__device__ __forceinline__ KArgs get_args() { KArgs p = (KArgs)__builtin_amdgcn_kernarg_segment_ptr(); asm volatile("" : "+s"(p)); return p; }
__device__ __forceinline__ int fresh_tid() { int t = threadIdx.x; asm volatile("" : "+v"(t)); return t; }
__device__ __forceinline__ int fresh_bx() { int t = blockIdx.x; asm volatile("" : "+s"(t)); return t; }
__device__ __forceinline__ int fresh_g() { int t = gridDim.x; asm volatile("" : "+s"(t)); return t; }
enum { I_X = 0, I_C, I_CTX, I_CCTX, I_ADAW, I_ADAB, I_N1W, I_N2W, I_WIN, I_QNW, I_KNW, I_CONVW, I_ALOG, I_DTB, I_DNW, I_WOUT, I_WQ, I_SUBK, I_U, I_V };

__device__ __forceinline__ void convert_tables(const float* U, const float* V, unsigned char* ws, int l, int wvi, int nwv, int lane, int rw_end = 2 * NEXP) {
    const float* us = U + (size_t)l * NEXP * 1024; const float* vs = V + (size_t)l * NEXP * 1024;
    const int set = l & 1;
    float* scl = (float*)(ws + WS_USC) + set * 2 * NEXP;
    for (int rw = wvi; rw < rw_end; rw += nwv) {
        const bool isu = rw < NEXP; const int e = isu ? rw : rw - NEXP;
        const f32x4* sp = (const f32x4*)((isu ? us : vs) + (size_t)e * 1024 + 16 * lane);
        f32x4 x[4]; float mx = 0.f;
#pragma unroll
        for (int i = 0; i < 4; ++i) { x[i] = sp[i]; mx = fmaxf(mx, fmaxf(fmaxf(fabsf(x[i][0]), fabsf(x[i][1])), fmaxf(fabsf(x[i][2]), fabsf(x[i][3])))); }
        mx = wave_max(mx);
        const float sc = fmaxf(mx, 1e-30f) * (1.f / 127.f), inv = 1.f / sc;
        u32x4 o4;
        const float ofs = ((GATHER_PART && isu) || GATHER_PART == 2) ? 0.f : 128.f;
#pragma unroll
        for (int i = 0; i < 4; ++i) { const unsigned b0 = (unsigned)(int)(rintf(x[i][0] * inv) + ofs) & 255u, b1 = (unsigned)(int)(rintf(x[i][1] * inv) + ofs) & 255u, b2 = (unsigned)(int)(rintf(x[i][2] * inv) + ofs) & 255u, b3 = (unsigned)(int)(rintf(x[i][3] * inv) + ofs) & 255u;
            o4[i] = b0 | (b1 << 8) | (b2 << 16) | (b3 << 24); }
        if (GATHER_PART == 2) *(u32x4*)(ws + WS_UB + (size_t)set * TAB_SET + (isu ? 0 : (size_t)NEXP * 1024) + ((size_t)(lane >> 3) * NEXP + e) * 128 + 16 * (lane & 7)) = o4;
        else *(u32x4*)(ws + WS_UB + (size_t)set * TAB_SET + (size_t)e * 2048 + (isu ? 0 : 1024) + 16 * lane) = o4;
        if (lane == 0) { if (GATHER_PART) scl[2 * e + (isu ? 0 : 1)] = sc; else scl[rw] = sc; }
    }
}

__device__ __forceinline__ void transpose_item(const float* W, int ldw, int K, bf16_t* WT, LAS float* scr, int kb, int nb, int lane) {
    const int k0 = 64 * kb, n0 = 32 * nb;
#pragma unroll 8
    for (int i = 0; i < 32; ++i) { const int kk = 2 * i + (lane >> 5); scr[kk * 33 + (lane & 31)] = W[(size_t)(k0 + kk) * ldw + n0 + (lane & 31)]; }
    LDS_WAIT(); asm volatile("" ::: "memory");
    const int c = lane & 7;
#pragma unroll
    for (int j = 0; j < 4; ++j) { const int n = (lane >> 3) + 8 * j; const LAS float* s = scr + (8 * c) * 33 + n;
        u32x4 o; o.x = pkbf(s[0 * 33], s[1 * 33]); o.y = pkbf(s[2 * 33], s[3 * 33]); o.z = pkbf(s[4 * 33], s[5 * 33]); o.w = pkbf(s[6 * 33], s[7 * 33]);
        *(u32x4*)(WT + (size_t)(n0 + n) * K + k0 + 8 * c) = o; }
    LDS_WAIT(); asm volatile("" ::: "memory");
}
__device__ __forceinline__ void phase_prologue(LAS unsigned char* lds) {
    const KArgs ap = get_args();
#define a (*ap)

    const int tid = fresh_tid(), lane = tid & 63, wave = __builtin_amdgcn_readfirstlane(tid >> 6), G = fresh_g(), bx = fresh_bx();
    unsigned char* ws = a.ws;
    {
        LAS float* sc = (LAS float*)(lds + 70000);
        LAS float* part = (LAS float*)(lds + 70000 + 12288);
        for (int i = tid; i < 3 * 1024; i += 512) { const int r = i >> 10, k = i & 1023; const float v = r < 2 ? a.in[I_C][r * 1024 + k] : a.in[I_CCTX][k]; sc[i] = silu_f(v); }
        __syncthreads();
        float* mod = (float*)(ws + WS_MOD);
        for (int item = bx; item < DEPTH * 96; item += G) {
            const int l = item / 96, j0 = (item % 96) * 64;
            const float* wp = a.in[I_ADAW] + (size_t)l * 1024 * 6144 + (size_t)(wave * 128) * 6144 + j0 + lane;
            float a0 = 0.f, a1 = 0.f, a2 = 0.f;
#pragma unroll 8
            for (int kk = 0; kk < 128; ++kk) { const float w = wp[(size_t)kk * 6144]; const int k = wave * 128 + kk; a0 = fmaf(sc[k], w, a0); a1 = fmaf(sc[1024 + k], w, a1); a2 = fmaf(sc[2048 + k], w, a2); }
            part[(wave * 3 + 0) * 64 + lane] = a0; part[(wave * 3 + 1) * 64 + lane] = a1; part[(wave * 3 + 2) * 64 + lane] = a2;
            __syncthreads();
            if (tid < 192) { const int r = tid >> 6, jj = tid & 63; float s = a.in[I_ADAB][l * 6144 + j0 + jj];
#pragma unroll
                for (int w = 0; w < 8; ++w) s += part[(w * 3 + r) * 64 + jj];
                mod[(size_t)(l * 3 + r) * 6144 + j0 + jj] = s; }
            __syncthreads();
        }
    }
    {
        const int gw = bx * 8 + wave, NGW = G * 8;
        unsigned* wmaxw = (unsigned*)(ws + WS_CTL) + CW_WMAX;
        constexpr int NB_IN = NP / 64, NB_OUT = 1024 / 64, NB_Q = 2048 / 64, PER_L2 = (NB_IN + NB_OUT + NB_Q) * 8;
        for (int it = gw; it < DEPTH * PER_L2; it += NGW) { const int l = it / PER_L2; int r = it % PER_L2; const int kc = r & 7; r >>= 3;
            const int mi = r < NB_IN ? 0 : r < NB_IN + NB_OUT ? 1 : 2; const int nb = mi == 0 ? r : mi == 1 ? r - NB_IN : r - NB_IN - NB_OUT; const int ldw = mi == 0 ? NIN : mi == 1 ? 1024 : 2048;
            const float* wp = (mi == 0 ? a.in[I_WIN] + (size_t)l * 1024 * NIN : mi == 1 ? a.in[I_WOUT] + (size_t)l * 1024 * 1024 : a.in[I_WQ] + (size_t)l * 1024 * 2048) + (size_t)(kc * 128) * ldw + nb * 64 + lane;
            float mx = 0.f;
#pragma unroll 8
            for (int kk = 0; kk < 128; ++kk) mx = fmaxf(mx, fabsf(wp[(size_t)kk * ldw]));
            atomicMax(wmaxw + (l * 3 + mi) * 3072 + nb * 64 + lane, __float_as_uint(mx)); }
    }
    const size_t gt = (size_t)bx * 512 + tid, NT = (size_t)G * 512;
    for (size_t i = gt; i < (size_t)DEPTH * 16 * 1024; i += NT) { const int l = (int)(i >> 14), j = (int)((i >> 10) & 15), k = (int)(i & 1023);
        ((float*)(ws + WS_WSK))[i] = a.in[I_WIN][(size_t)l * 1024 * NIN + (size_t)k * NIN + NP + j]; }
    convert_tables(a.in[I_U], a.in[I_V], ws, 0, bx * 8 + wave, G * 8, lane);
    for (size_t i = gt; i < (size_t)DEPTH * 8 * 2 * 128 * 128 / 2; i += NT) { const f32x2 x = ((const f32x2*)a.in[I_SUBK])[i]; ((unsigned*)(ws + WS_SKB))[i] = pkbf(x[0], x[1]); }
    for (size_t i = gt; i < 8192; i += NT) { const int pos = (int)(i >> 5), fi = (int)(i & 31);
        const float inv = exp2f(-(float)fi * (13.287712379549449f / 32.f)); const float ang = (float)pos * inv;
        float rev = ang * 0.15915494309189535f; rev -= floorf(rev);
        ((float*)(ws + WS_ROPE))[i] = __builtin_amdgcn_cosf(rev); ((float*)(ws + WS_ROPE))[8192 + i] = __builtin_amdgcn_sinf(rev); }
}


__device__ __forceinline__ void quant_transpose_item(const float* W, int ldw, signed char* WT, const unsigned* wmaxw, LAS float* scr, int kb, int nb, int lane) {
    const int k0 = 64 * kb, n0 = 32 * nb;
#pragma unroll 8
    for (int i = 0; i < 32; ++i) { const int kk = 2 * i + (lane >> 5); scr[kk * 33 + (lane & 31)] = W[(size_t)(k0 + kk) * ldw + n0 + (lane & 31)]; }
    LDS_WAIT(); asm volatile("" ::: "memory");
    const int n = lane >> 1, hf = lane & 1;
    const float mx = __uint_as_float(wmaxw[n0 + n]), inv = mx > 0.f ? 127.f / mx : 0.f;
    u32x4 o[2];
#pragma unroll
    for (int q = 0; q < 8; ++q) { unsigned w = 0u;
#pragma unroll
        for (int b = 0; b < 4; ++b) { const int kk = 32 * hf + 4 * q + b; w |= ((unsigned)(int)rintf(scr[kk * 33 + n] * inv) & 255u) << (8 * b); }
        o[q >> 2][q & 3] = w; }
    u32x4* dst = (u32x4*)(WT + (size_t)(n0 + n) * 1024 + k0 + 32 * hf);
    dst[0] = o[0]; dst[1] = o[1];
    LDS_WAIT(); asm volatile("" ::: "memory");
}
__device__ __forceinline__ void phase_quant_weights(LAS unsigned char* lds) {
    const KArgs ap = get_args();
#define a (*ap)
    const int tid = fresh_tid(), lane = tid & 63, wave = __builtin_amdgcn_readfirstlane(tid >> 6), G = fresh_g(), bx = fresh_bx();
    unsigned char* ws = a.ws;
    LAS float* scr = (LAS float*)(lds + 65536 + wave * 8448);
    const unsigned* wmaxw = (const unsigned*)(ws + WS_CTL) + CW_WMAX;
    constexpr int I_IN = 16 * 96, I_OUT = 16 * 32, I_Q = 16 * 64, PER_L = I_IN + I_OUT + I_Q;
    for (int it = bx * 8 + wave; it < DEPTH * PER_L; it += G * 8) { const int l = it / PER_L; int r = it % PER_L;
        if (r < I_IN) quant_transpose_item(a.in[I_WIN] + (size_t)l * 1024 * NIN, NIN, (signed char*)(ws + WS_WINT) + (size_t)l * NP * 1024, wmaxw + (l * 3 + 0) * 3072, scr, r / 96, r % 96, lane);
        else if (r < I_IN + I_OUT) { r -= I_IN; quant_transpose_item(a.in[I_WOUT] + (size_t)l * 1024 * 1024, 1024, (signed char*)(ws + WS_WOUTT) + (size_t)l * 1024 * 1024, wmaxw + (l * 3 + 1) * 3072, scr, r / 32, r % 32, lane); }
        else { r -= I_IN + I_OUT; quant_transpose_item(a.in[I_WQ] + (size_t)l * 1024 * 2048, 2048, (signed char*)(ws + WS_WQT) + (size_t)l * 2048 * 1024, wmaxw + (l * 3 + 2) * 3072, scr, r / 64, r % 64, lane); } }
#undef a
}

template <bool SK>
__device__ __forceinline__ void phase_norm(int l, int which, LAS unsigned char* lds) {
    const KArgs ap = get_args();
#define a (*ap)

    const int tid = fresh_tid(), lane = tid & 63, wave = __builtin_amdgcn_readfirstlane(tid >> 6), G = fresh_g(), bx = fresh_bx();
    unsigned char* ws = a.ws;
    LAS float* wsk = (LAS float*)lds;
    if (SK) { const float* src = (const float*)(ws + WS_WSK) + (size_t)l * 16384; for (int i = tid; i < 16384 / 4; i += 512) ((LAS f32x4*)wsk)[i] = ((const f32x4*)src)[i]; __syncthreads(); }
    const int nrows = (which == 1 && l == DEPTH - 1) ? ML : M;
    const float* nw = a.in[which ? I_N2W : I_N1W] + l * 1024;
    const float* modl = (const float*)(ws + WS_MOD) + (size_t)l * 3 * 6144;
    const int shoff = which ? 3072 : 0, scoff = which ? 4096 : 1024;
    f32x4 nwv[4];
#pragma unroll
    for (int j = 0; j < 4; ++j) nwv[j] = *(const f32x4*)(nw + 4 * lane + 256 * j);
    for (int row = wave * G + bx; row < nrows; row += G * 8) {
        const int mrow = row < ML ? (row >= T ? 1 : 0) : 2;
        const float* md = modl + mrow * 6144;
        f32x4 v[4]; float ss = 0.f;
        if (l == 0 && which == 0) { const float* src = row < ML ? a.in[I_X] + (size_t)row * D : a.in[I_CTX] + (size_t)(row - ML) * D;
#pragma unroll
            for (int j = 0; j < 4; ++j) v[j] = *(const f32x4*)(src + 4 * lane + 256 * j); }
        else { const bf16_t* src = (const bf16_t*)(ws + WS_XB) + (size_t)row * D;
#pragma unroll
            for (int j = 0; j < 4; ++j) { const u32x2 w_ = *(const u32x2*)(src + 4 * lane + 256 * j); v[j] = (f32x4){bflo(w_[0]), bfhi(w_[0]), bflo(w_[1]), bfhi(w_[1])}; } }
#pragma unroll
        for (int j = 0; j < 4; ++j) ss += (v[j][0] * v[j][0] + v[j][1] * v[j][1]) + (v[j][2] * v[j][2] + v[j][3] * v[j][3]);
        const float rstd = rsqrtf(wave_sum(ss) * (1.f / D) + EPS);
        signed char* hrow = (signed char*)(ws + WS_H) + (size_t)row * D;
        float hmx = 0.f;
#pragma unroll
        for (int j = 0; j < 4; ++j) { const f32x4 sc = *(const f32x4*)(md + scoff + 4 * lane + 256 * j), sh = *(const f32x4*)(md + shoff + 4 * lane + 256 * j);
            v[j] = v[j] * rstd * nwv[j] * (sc + 1.f) + sh; hmx = fmaxf(hmx, fmaxf(fmaxf(fabsf(v[j][0]), fabsf(v[j][1])), fmaxf(fabsf(v[j][2]), fabsf(v[j][3])))); }
        hmx = fmaxf(wave_max(hmx), 1e-30f);
        { const float hinv = 127.f / hmx;
#pragma unroll
          for (int j = 0; j < 4; ++j) *(unsigned*)(hrow + 4 * lane + 256 * j) = ((unsigned)(int)rintf(v[j][0] * hinv) & 255u) | (((unsigned)(int)rintf(v[j][1] * hinv) & 255u) << 8) | (((unsigned)(int)rintf(v[j][2] * hinv) & 255u) << 16) | (((unsigned)(int)rintf(v[j][3] * hinv) & 255u) << 24);
          if (lane == 0) ((float*)(ws + WS_GB))[row] = hmx * (1.f / 127.f); }
        if (SK) {
            float p[16];
#pragma unroll
            for (int c = 0; c < 16; ++c) { float q = 0.f;
#pragma unroll
                for (int j = 0; j < 4; ++j) { const f32x4 w = *(const LAS f32x4*)(wsk + c * 1024 + 4 * lane + 256 * j); q += (v[j][0] * w[0] + v[j][1] * w[1]) + (v[j][2] * w[2] + v[j][3] * w[3]); }
                p[c] = q; }
            { const bool hb = (lane & 32) != 0;
#pragma unroll
              for (int c = 0; c < 8; ++c) { const float keep = hb ? p[c + 8] : p[c], send = hb ? p[c] : p[c + 8]; p[c] = keep + lane_xor<32>(send); } }
            { const bool hb = (lane & 16) != 0;
#pragma unroll
              for (int c = 0; c < 4; ++c) { const float keep = hb ? p[c + 4] : p[c], send = hb ? p[c] : p[c + 4]; p[c] = keep + lane_xor<16>(send); } }
            { const bool hb = (lane & 8) != 0;
#pragma unroll
              for (int c = 0; c < 2; ++c) { const float keep = hb ? p[c + 2] : p[c], send = hb ? p[c] : p[c + 2]; p[c] = keep + lane_xor<8>(send); } }
            { const bool hb = (lane & 4) != 0; const float keep = hb ? p[1] : p[0], send = hb ? p[0] : p[1]; p[0] = keep + lane_xor<4>(send); }
            p[0] += lane_xor<2>(p[0]); p[0] += lane_xor<1>(p[0]);
            if ((lane & 3) == 0) { const int c = ((lane >> 5) & 1) * 8 + ((lane >> 4) & 1) * 4 + ((lane >> 3) & 1) * 2 + ((lane >> 2) & 1); ((float*)(ws + WS_BA))[(size_t)row * 16 + c] = p[0]; }
        }
    }
    if (SK) __syncthreads();
}

__device__ __forceinline__ void phase_prep(int l, LAS unsigned char* lds) {
    const KArgs ap = get_args();
#define a (*ap)

    const int tid = fresh_tid(), lane = tid & 63, wave = __builtin_amdgcn_readfirstlane(tid >> 6), G = fresh_g(), bx = fresh_bx();
    unsigned char* ws = a.ws;
    const bf16_t* P = (const bf16_t*)(ws + WS_P);
    const float* ropec = (const float*)(ws + WS_ROPE); const float* ropes = ropec + 8192;
    const int sec = lane >> 5, fi = lane & 31;
    const float qw0 = a.in[I_QNW][l * 128 + sec * 64 + fi], qw1 = a.in[I_QNW][l * 128 + sec * 64 + 32 + fi];
    const float kw0 = a.in[I_KNW][l * 128 + sec * 64 + fi], kw1 = a.in[I_KNW][l * 128 + sec * 64 + 32 + fi];
    for (int row = wave * G + bx; row < M; row += G * 8) {
        const bool lat = row < ML;
        int b, tt, tlen; if (lat) { b = row >> 14; tt = row & (T - 1); tlen = T; } else { b = (row - ML) >> 8; tt = (row - ML) & (CT - 1); tlen = CT; }
        const bf16_t* prow = P + (size_t)row * NP;
        unsigned short xa[6][2];
#pragma unroll
        for (int hh = 0; hh < 6; ++hh) { const bf16_t* xp = prow + (hh < 4 ? hh * 128 : 512 + (hh - 4) * 128) + sec * 64 + fi; xa[hh][0] = xp[0]; xa[hh][1] = xp[32]; }
        const u32x2 vcp = *(const u32x2*)(prow + 768 + 4 * lane);
        float cs = 1.f, sn = 0.f;
        if (lat) { const int pos = sec ? (tt & 63) : (tt >> 6); cs = ropec[pos * 32 + fi]; sn = ropes[pos * 32 + fi]; }
        unsigned char* qo8 = ws + WS_QA + (size_t)row * 512;
        const size_t kvrow = (size_t)b * KVLEN + (lat ? tt : T + tt);
        unsigned char* ko8 = ws + WS_KA + kvrow * 256;
        float ssq[6];
#pragma unroll
        for (int hh = 0; hh < 6; ++hh) { const float x0 = bf2f(xa[hh][0]), x1 = bf2f(xa[hh][1]); ssq[hh] = x0 * x0 + x1 * x1; }
#pragma unroll
        for (int hh = 0; hh < 6; ++hh) ssq[hh] = wave_sum(ssq[hh]);
#pragma unroll
        for (int hh = 0; hh < 6; ++hh) {
            const float x0 = bf2f(xa[hh][0]), x1 = bf2f(xa[hh][1]);
            const float rs = rsqrtf(ssq[hh] * (1.f / 128.f) + EPS);
            const float y0 = x0 * rs * (hh < 4 ? qw0 : kw0), y1 = x1 * rs * (hh < 4 ? qw1 : kw1);
            const float qsc = hh < 4 ? 0.088388347648318440f * 1.4426950408889634f : 1.f;
            const float o0 = (y0 * cs - y1 * sn) * qsc, o1 = (y1 * cs + y0 * sn) * qsc;
            unsigned char* op8 = (hh < 4 ? qo8 + hh * 128 : ko8 + (hh - 4) * 128) + sec * 64 + fi;
            const float f8s = hh < 4 ? 8.f : 1.f;
            const int pk8 = __builtin_amdgcn_cvt_pk_fp8_f32(o0 * f8s, o1 * f8s, 0, false);
            op8[0] = (unsigned char)(pk8 & 255); op8[32] = (unsigned char)((pk8 >> 8) & 255);
        }
        { const int pos = lat ? tt : T + tt, tile = pos >> 6, k64 = pos & 63, k32 = k64 & 31;
          const int bytepos = 32 * ((k32 >> 2) & 1) + 16 * (k64 >> 5) + (k32 & 3) + 4 * (k32 >> 3);
          unsigned char* vt = ws + WS_VA + ((size_t)(b * 2) * (KVLEN / 64) + tile) * 8192 + bytepos;
          const unsigned short* vsrc = (const unsigned short*)&vcp;
          const int kvh_ = lane >> 5, d0 = (4 * lane) & 127;
          const int pk01 = __builtin_amdgcn_cvt_pk_fp8_f32(bf2f(vsrc[0]), bf2f(vsrc[1]), 0, false), pk23 = __builtin_amdgcn_cvt_pk_fp8_f32(bf2f(vsrc[2]), bf2f(vsrc[3]), 0, false);
          unsigned char* vt2 = vt + (size_t)kvh_ * (KVLEN / 64) * 8192 + (size_t)d0 * 64;
          vt2[0] = (unsigned char)(pk01 & 255); vt2[64] = (unsigned char)((pk01 >> 8) & 255); vt2[128] = (unsigned char)(pk23 & 255); vt2[192] = (unsigned char)((pk23 >> 8) & 255); }
    }
    __syncthreads();
}

constexpr int ATT_PARTS = 4;
__device__ __forceinline__ void phase_attn(int l, unsigned char* lds_raw, volatile LAS unsigned* MISC, int rep) {
    const KArgs ap = get_args();
#define a (*ap)
    unsigned char* ws = a.ws;
    const unsigned char* QA = ws + WS_QA; const unsigned char* KA = ws + WS_KA; const unsigned char* VT = ws + WS_VA;
    bf16_t* CAT = (bf16_t*)(ws + WS_CAT); float* LSE = (float*)(ws + WS_BA);
    unsigned* ctr = (unsigned*)(ws + WS_CTL) + 8192 + 64 * l + 1024 * rep;
    const int natt = 2048 + (l < DEPTH - 1 ? 8 : 0);
    constexpr int CONV_ROWS = 64, NCONV = 2 * NEXP / CONV_ROWS;
    const int nunits = natt + (l + 1 < DEPTH ? NCONV : 0);
    float braw;
    { const int ln = threadIdx.x & 63; float mq = fmaxf(fabsf(a.in[I_QNW][l * 128 + ln]), fabsf(a.in[I_QNW][l * 128 + 64 + ln])), mk = fmaxf(fabsf(a.in[I_KNW][l * 128 + ln]), fabsf(a.in[I_KNW][l * 128 + 64 + ln]));
      mq = wave_max(mq); mk = wave_max(mk);
      braw = __builtin_bit_cast(float, __builtin_amdgcn_readfirstlane(__builtin_bit_cast(int, 128.f * mq * mk))); }
    if (threadIdx.x == 0) MISC[12] = __hip_atomic_fetch_add(ctr, 1u, __ATOMIC_RELAXED, __HIP_MEMORY_SCOPE_AGENT);
    __syncthreads();
    int u = (int)MISC[12], par = 0;
    for (; u < nunits; ) {
        if (threadIdx.x == 0) MISC[13 - par] = __hip_atomic_fetch_add(ctr, 1u, __ATOMIC_RELAXED, __HIP_MEMORY_SCOPE_AGENT);
        if (u >= natt) {
            const int tq_ = fresh_tid();
            const int rwb = (u - natt) * CONV_ROWS + __builtin_amdgcn_readfirstlane(tq_ >> 6) * 8;
            convert_tables(a.in[I_U], a.in[I_V], ws, l + 1, rwb, 1, tq_ & 63, rwb + 8);
            __syncthreads();
            u = (int)MISC[13 - par]; par ^= 1;
            continue;
        }
        size_t r0, kv0; int h, kvh, seq, ldo; bf16_t* ob; float* lse;
        if (u < 2048) { const int qb = u & 63, g = (u >> 6) & 1, part = (u >> 7) & 3, b = u >> 10; kvh = (u >> 9) & 1; h = kvh * 2 + g;
            const int t0 = (part >> 1) * 130 + (part & 1) * 64;
            r0 = (size_t)b * T + (size_t)qb * 256; kv0 = (size_t)b * KVLEN + (size_t)t0 * 64; seq = ((part & 1) ? 66 : 64) * 64;
            ob = part ? (bf16_t*)(ws + (part == 1 ? WS_DQ : part == 2 ? WS_DK : WS_DV)) + r0 * 512 + h * 128 : CAT + r0 * 1024 + h * 128; ldo = part ? 512 : 1024; lse = LSE + ((size_t)part * ML + r0) * 4 + h; }
        else { const int b = (u - 2048) >> 2; h = (u - 2048) & 3; kvh = h >> 1; r0 = (size_t)ML + (size_t)b * CT; kv0 = (size_t)b * KVLEN + T; seq = CT;
            ob = CAT + r0 * 1024 + h * 128; ldo = 1024; lse = nullptr; }
        att::attn_dense_body(QA + r0 * 512 + h * 128, KA + kv0 * 256 + kvh * 128, VT + ((size_t)((kv0 / KVLEN) * 2 + kvh) * (KVLEN / 64) + (kv0 % KVLEN) / 64) * 8192, ob, ldo, seq, (char*)lds_raw, lse, braw);
        u = (int)MISC[13 - par]; par ^= 1;
    }
#undef a
}

__device__ __forceinline__ int tokperm(int q, int hh, int jj) { return 16 * q + 8 * (jj >> 2) + 4 * hh + (jj & 3); }
__device__ __forceinline__ int crow16(int r, int hi) { return (r & 3) + 8 * (r >> 2) + 4 * hi; }
__device__ __forceinline__ int kperm16(int s_, int g, int jj) { return 32 * s_ + 16 * (jj >> 2) + 4 * g + (jj & 3); }
__device__ __forceinline__ int frag_off(int i, int j) {
    return (((i >> 4) * 2 + (j >> 5)) * 64 + ((i & 15) + 16 * ((j >> 2) & 3))) * 16 + (4 * ((j >> 4) & 1) + (j & 3)) * 2;
}
template <int MODE>
__device__ __forceinline__ void phase_dn_chunkprep(int l, LAS unsigned char* lds) {
    const KArgs ap = get_args();
#define a (*ap)
    const int tid = fresh_tid(), lane = tid & 63, wave = __builtin_amdgcn_readfirstlane(tid >> 6), G = fresh_g(), bx = fresh_bx();
    unsigned char* ws = a.ws;
    constexpr int KT_OFF = 0, QT_OFF = 17408, VT_OFF = 34816, GS_OFF = 52224, RS_OFF = 68864, AM_OFF = 85504, SC_OFF = 120320, IMG_OFF = 0;
    const int r = lane & 31, hh = lane >> 5;
    const bf16_t* DQ = (const bf16_t*)(ws + WS_DQ); const bf16_t* DK = (const bf16_t*)(ws + WS_DK); const bf16_t* DV = (const bf16_t*)(ws + WS_DV);
    const float* BA = (const float*)(ws + WS_BA);
    constexpr int NTASK = MODE ? NB * 4 * 4 : NB * 4 * (NCH - 4);
#define CP_TASKID(t_) (MODE ? ((t_) >> 2) * NCH + ((t_) & 3) : ((t_) >> 8) * NCH + 4 + ((t_) & 255))
    LAS float* gsc = (LAS float*)(lds + SC_OFF);
    LAS float* bsc = gsc + 128;
    LAS float* gcs = gsc + 256;
    constexpr int CW_OFF = 121856, DI_OFF = CW_OFF + 5 * 1536 * 4;
    static_assert(DI_OFF + 8192 <= LDS_MISC, "chunkprep LDS");
    LAS float* cwl = (LAS float*)(lds + CW_OFF);
    for (int i = tid; i < 5 * 1536; i += 512) cwl[i] = a.in[I_CONVW][(size_t)l * 5 * 1536 + i];
    __syncthreads();
    const bf16_t* P = (const bf16_t*)(ws + WS_P);
    u32x4 xin[3][5][2];
#define CP_LOADX(task_) do { const int cidx_ = (task_) % NCH, bh_ = (task_) / NCH, b_ = bh_ >> 2, h_ = bh_ & 3; \
        const int row0_ = cidx_ < 4 ? ML + b_ * CT + cidx_ * 64 : b_ * T + (cidx_ - 4) * 64, tt_ = (cidx_ < 4 ? cidx_ * 64 : (cidx_ - 4) * 64) + (tid >> 3), tlen_ = cidx_ < 4 ? CT : T; \
        _Pragma("unroll") for (int j = 0; j < 5; ++j) { const int t2 = tt_ + j - 2; const bool ok = t2 >= 0 && t2 < tlen_; \
            const bf16_t* xr = P + (size_t)(row0_ + (tid >> 3) + (ok ? j - 2 : 0)) * NP + 1024 + h_ * 128 + (tid & 7) * 16; \
            _Pragma("unroll") for (int m = 0; m < 3; ++m) { const u32x4 w0 = *(const u32x4*)(xr + m * 512), w1 = *(const u32x4*)(xr + m * 512 + 8); \
                xin[m][j][0] = ok ? w0 : (u32x4){0u, 0u, 0u, 0u}; xin[m][j][1] = ok ? w1 : (u32x4){0u, 0u, 0u, 0u}; } } } while (0)
    if (bx < NTASK) CP_LOADX(CP_TASKID(bx));
    for (int tk = bx; tk < NTASK; tk += G) {
        const int task = CP_TASKID(tk);
        const int cidx = task % NCH, bh = task / NCH, b = bh >> 2, h = bh & 3;
        const int row0 = cidx < 4 ? ML + b * CT + cidx * 64 : b * T + (cidx - 4) * 64;
        unsigned char* rec = ws + WS_REC + (size_t)task * REC_BYTES;
        {
            const int rr = tid >> 3, seg = tid & 7;
            if (tid < 128) { const int d = tid >> 6, i = tid & 63, dh = d * 4 + h;
                const float xb = BA[(size_t)(row0 + i) * 16 + dh], z = BA[(size_t)(row0 + i) * 16 + 8 + dh] + a.in[I_DTB][l * 8 + dh];
                bsc[tid] = 1.f / (1.f + __expf(-xb)); gsc[tid] = -__expf(a.in[I_ALOG][l * 8 + dh]) * (fmaxf(z, 0.f) + log1pf(__expf(-fabsf(z)))); }
#pragma unroll
            for (int m = 0; m < 3; ++m) {
                float y[16];
#pragma unroll
                for (int c = 0; c < 16; ++c) y[c] = 0.f;
#pragma unroll
                for (int j = 0; j < 5; ++j) { const LAS float* wp = cwl + j * 1536 + m * 512 + h * 128 + seg * 16;
#pragma unroll
                    for (int q4 = 0; q4 < 4; ++q4) { const f32x4 wv = *(const LAS f32x4*)(wp + 4 * q4); const unsigned u0 = xin[m][j][q4 >> 1][2 * (q4 & 1)], u1 = xin[m][j][q4 >> 1][2 * (q4 & 1) + 1];
                        y[4 * q4 + 0] = fmaf(bflo(u0), wv[0], y[4 * q4 + 0]); y[4 * q4 + 1] = fmaf(bfhi(u0), wv[1], y[4 * q4 + 1]); y[4 * q4 + 2] = fmaf(bflo(u1), wv[2], y[4 * q4 + 2]); y[4 * q4 + 3] = fmaf(bfhi(u1), wv[3], y[4 * q4 + 3]); } }
                float ss = 0.f;
#pragma unroll
                for (int c = 0; c < 16; ++c) { y[c] = silu_f(y[c]); ss = fmaf(y[c], y[c], ss); }
                if (m < 2) { ss += lane_xor<1>(ss); ss += lane_xor<2>(ss); ss += lane_xor<4>(ss);
                    float sc = rsqrtf(ss + EPS); if (m == 0) sc *= 0.088388347648318440f;
#pragma unroll
                    for (int c = 0; c < 16; ++c) y[c] *= sc; }
                u32x4 o0, o1; o0.x = pkbf(y[0], y[1]); o0.y = pkbf(y[2], y[3]); o0.z = pkbf(y[4], y[5]); o0.w = pkbf(y[6], y[7]); o1.x = pkbf(y[8], y[9]); o1.y = pkbf(y[10], y[11]); o1.z = pkbf(y[12], y[13]); o1.w = pkbf(y[14], y[15]);
                LAS unsigned char* dst = lds + (m == 0 ? QT_OFF : m == 1 ? KT_OFF : VT_OFF) + rr * 272 + seg * 32;
                *(LAS u32x4*)dst = o0; *(LAS u32x4*)(dst + 16) = o1;
            }
        }
        __syncthreads();
        {
            const int mat = wave >> 2, ti = (wave >> 1) & 1, tj = wave & 1;
            f32x16 acc = {};
#pragma unroll
            for (int ks = 0; ks < 8; ++ks) {
                const bf16x8 av = *(const LAS bf16x8*)(lds + (mat ? QT_OFF : KT_OFF) + (32 * ti + r) * 272 + (16 * ks + 8 * hh) * 2);
                const bf16x8 bv = *(const LAS bf16x8*)(lds + KT_OFF + (32 * tj + r) * 272 + (16 * ks + 8 * hh) * 2);
                acc = __builtin_amdgcn_mfma_f32_32x32x16_bf16(av, bv, acc, 0, 0, 0);
            }
            LAS float* dst = (LAS float*)(lds + (mat ? RS_OFF : GS_OFF));
#pragma unroll
            for (int i = 0; i < 16; ++i) dst[(32 * ti + crow16(i, hh)) * 65 + 32 * tj + r] = acc[i];
        }
        { const int r16 = lane & 15, g4 = lane >> 4;
#pragma unroll
        for (int t = 0; t < 2; ++t) { const int f = wave * 2 + t, mt = f >> 2, sk = f & 3;
            { const u32x2 lo = *(const LAS u32x2*)(lds + KT_OFF + (16 * mt + r16) * 272 + (32 * sk + 4 * g4) * 2), hi2 = *(const LAS u32x2*)(lds + KT_OFF + (16 * mt + r16) * 272 + (32 * sk + 16 + 4 * g4) * 2);
              *(u32x4*)(rec + REC_K + f * 1024 + lane * 16) = (u32x4){lo.x, lo.y, hi2.x, hi2.y}; }
            { const u32x2 lo = *(const LAS u32x2*)(lds + QT_OFF + (16 * mt + r16) * 272 + (32 * sk + 4 * g4) * 2), hi2 = *(const LAS u32x2*)(lds + QT_OFF + (16 * mt + r16) * 272 + (32 * sk + 16 + 4 * g4) * 2);
              *(u32x4*)(rec + REC_Q + f * 1024 + lane * 16) = (u32x4){lo.x, lo.y, hi2.x, hi2.y}; } }
#pragma unroll
        for (int t = 0; t < 2; ++t) { const int f = wave * 2 + t, mt = f >> 1, sk = f & 1;
            unsigned e[8];
#pragma unroll
            for (int jj = 0; jj < 8; ++jj) e[jj] = *(const LAS unsigned short*)(lds + KT_OFF + kperm16(sk, g4, jj) * 272 + (16 * mt + r16) * 2);
            *(u32x4*)(rec + REC_KT + f * 1024 + lane * 16) = (u32x4){e[0] | (e[1] << 16), e[2] | (e[3] << 16), e[4] | (e[5] << 16), e[6] | (e[7] << 16)}; }
        { const int sl = wave;
            unsigned e[16];
#pragma unroll
            for (int i = 0; i < 16; ++i) e[i] = *(const LAS unsigned short*)(lds + VT_OFF + (16 * (i >> 2) + 4 * g4 + (i & 3)) * 272 + (16 * sl + r16) * 2);
            u32x4* vp = (u32x4*)(rec + REC_V + sl * 2048 + lane * 32);
            vp[0] = (u32x4){e[0] | (e[1] << 16), e[2] | (e[3] << 16), e[4] | (e[5] << 16), e[6] | (e[7] << 16)};
            vp[1] = (u32x4){e[8] | (e[9] << 16), e[10] | (e[11] << 16), e[12] | (e[13] << 16), e[14] | (e[15] << 16)}; }
        }
        if (tk + G < NTASK) CP_LOADX(CP_TASKID(tk + G));
        if (wave < 2) { const int d = wave; float gv = gsc[d * 64 + (d ? 63 - lane : lane)];
            gv += __builtin_bit_cast(float, __builtin_amdgcn_update_dpp(0, __builtin_bit_cast(int, gv), 0x111, 0xF, 0xF, true));
            gv += __builtin_bit_cast(float, __builtin_amdgcn_update_dpp(0, __builtin_bit_cast(int, gv), 0x112, 0xF, 0xF, true));
            gv += __builtin_bit_cast(float, __builtin_amdgcn_update_dpp(0, __builtin_bit_cast(int, gv), 0x114, 0xF, 0xF, true));
            gv += __builtin_bit_cast(float, __builtin_amdgcn_update_dpp(0, __builtin_bit_cast(int, gv), 0x118, 0xF, 0xF, true));
            { const float t0 = __builtin_bit_cast(float, __builtin_amdgcn_readlane(__builtin_bit_cast(int, gv), 15)), t1 = __builtin_bit_cast(float, __builtin_amdgcn_readlane(__builtin_bit_cast(int, gv), 31)), t2 = __builtin_bit_cast(float, __builtin_amdgcn_readlane(__builtin_bit_cast(int, gv), 47));
              const int rw_ = lane >> 4; gv += (rw_ >= 1 ? t0 : 0.f) + (rw_ >= 2 ? t1 : 0.f) + (rw_ >= 3 ? t2 : 0.f); }
            gcs[d * 64 + lane] = gv; }
        __syncthreads();
        const LAS float* Gs = (const LAS float*)(lds + GS_OFF); const LAS float* Rs = (const LAS float*)(lds + RS_OFF);
#pragma unroll 4
        for (int t = 0; t < 16; ++t) { const int e = tid + 512 * t, d = e >> 12, jp = (e >> 6) & 63, ip = e & 63;
            const int in_ = d ? 63 - ip : ip, jn = d ? 63 - jp : jp;
            const float dec = __expf(fminf(gcs[d * 64 + ip] - gcs[d * 64 + jp], 0.f));
            const float av = (jp < ip) ? bsc[d * 64 + in_] * Gs[in_ * 65 + jn] * dec : 0.f;
            ((LAS float*)(lds + AM_OFF))[d * 4352 + jp * 68 + ip] = av;
            const float qk = (jp <= ip) ? Rs[in_ * 65 + jn] * dec : 0.f;
            *(LAS unsigned short*)(lds + IMG_OFF + d * 16384 + 8192 + frag_off(in_, jn)) = (unsigned short)(pkbf(qk, 0.f) & 0xffffu); }
        __syncthreads();
        { int ln_ = lane; asm volatile("" : "+v"(ln_));
          const int d = wave >> 2, nt = wave & 3, n16 = ln_ & 15, g4 = ln_ >> 4;
          const LAS float* At = (const LAS float*)(lds + AM_OFF) + d * 4352;
          LAS float* Xd = (LAS float*)(lds + GS_OFF) + d * 4096;
          LAS float* Dinv = (LAS float*)(lds + DI_OFF) + d * 1024;
          { float x[16];
#pragma unroll
            for (int q = 0; q < 16; ++q) x[q] = (q == n16) ? 1.f : 0.f;
#pragma unroll
            for (int r2 = 0; r2 < 15; ++r2) { const LAS float* ar = At + (16 * nt + r2) * 68 + 16 * nt; const float xr = x[r2];
#pragma unroll
                for (int q4 = (r2 + 1) / 4; q4 < 4; ++q4) { const f32x4 a4 = *(const LAS f32x4*)(ar + 4 * q4);
#pragma unroll
                    for (int q = 0; q < 4; ++q) if (4 * q4 + q > r2) x[4 * q4 + q] = fmaf(-a4[q], xr, x[4 * q4 + q]); } }
            if (ln_ < 16) {
#pragma unroll
                for (int q = 0; q < 16; ++q) Dinv[nt * 256 + q * 16 + n16] = x[q]; } }
          if (wave == 2 || wave == 3) { const int d2 = wave - 2, ip = d2 ? 63 - lane : lane; const float gl = gcs[d2 * 64 + 63], gi = gcs[d2 * 64 + ip];
            float* sc = (float*)(rec + REC_DIR + d2 * REC_DIRSZ + 16384);
            sc[lane] = __expf(gi); sc[64 + lane] = __expf(gl - gi); if (lane == 0) sc[128] = __expf(gl); }
          __syncthreads();
          const int c = 16 * nt + n16, jn = d ? 63 - c : c; const float bj = bsc[d * 64 + jn];
          const int fj = (jn >> 5) * 1024 + ((jn >> 2) & 3) * 256 + ((jn >> 4) & 1) * 8 + (jn & 3) * 2;
#pragma unroll 1
          for (int B = 0; B < 4; ++B) {
            f32x4 y = {0.f, 0.f, 0.f, 0.f};
            if (nt <= B) {
                f32x4 acc;
#pragma unroll
                for (int r2 = 0; r2 < 4; ++r2) acc[r2] = (nt == B && 4 * g4 + r2 == n16) ? 1.f : 0.f;
#pragma unroll 2
                for (int j0 = 0; j0 < 16 * B; j0 += 4) { const float av = -At[(j0 + g4) * 68 + 16 * B + n16], bv = Xd[(j0 + g4) * 64 + c];
                    acc = __builtin_amdgcn_mfma_f32_16x16x4f32(av, bv, acc, 0, 0, 0); }
#pragma unroll
                for (int r2 = 0; r2 < 4; ++r2) Xd[(16 * B + 4 * g4 + r2) * 64 + c] = acc[r2];
#pragma unroll
                for (int s4 = 0; s4 < 4; ++s4) { const float av = Dinv[B * 256 + n16 * 16 + 4 * s4 + g4], bv = Xd[(16 * B + 4 * s4 + g4) * 64 + c];
                    y = __builtin_amdgcn_mfma_f32_16x16x4f32(av, bv, y, 0, 0, 0); }
            }
#pragma unroll
            for (int r2 = 0; r2 < 4; ++r2) { const int i = 16 * B + 4 * g4 + r2, in_ = d ? 63 - i : i; Xd[i * 64 + c] = y[r2];
                *(LAS unsigned short*)(lds + IMG_OFF + d * 16384 + (in_ >> 4) * 2048 + (in_ & 15) * 16 + fj) = (unsigned short)(pkbf_c(y[r2] * bj, 0.f) & 0xffffu); }
            __syncthreads();
          }
        }
#pragma unroll
        for (int t = 0; t < 4; ++t) { const int p = tid + 512 * t, d = p >> 10, off = (p & 1023) * 16;
            *(u32x4*)(rec + REC_DIR + d * REC_DIRSZ + off) = *(const LAS u32x4*)(lds + IMG_OFF + d * 16384 + off); }
        __syncthreads();
    }
#undef CP_LOADX
#undef CP_TASKID
#undef a
}

__device__ __forceinline__ bf16x8 pack44(const f32x4& lo, const f32x4& hi) {
    u32x4 p; p.x = pkbf_c(lo[0], lo[1]); p.y = pkbf_c(lo[2], lo[3]); p.z = pkbf_c(hi[0], hi[1]); p.w = pkbf_c(hi[2], hi[3]);
    return __builtin_bit_cast(bf16x8, p);
}
template <int VAR>
__device__ __forceinline__ void phase_dn_scan(int l, LAS unsigned char* lds) {
    const KArgs ap = get_args();
#define a (*ap)
    const int tid = fresh_tid(), lane = tid & 63, wave = __builtin_amdgcn_readfirstlane(tid >> 6), bx = fresh_bx();
    unsigned char* ws = a.ws;
    if (bx >= 32) return;
    const int chain = bx >> 1, half = bx & 1, b = chain >> 3, h = (chain >> 1) & 3, dir = chain & 1;
    const unsigned char* recb = ws + WS_REC + (size_t)((b * 4 + h) * NCH) * REC_BYTES;
    constexpr int BUFSZ = 74752;
#define CIDX(n) (dir ? ((n) < 4 ? 3 - (n) : 263 - (n)) : (n))
    if (wave >= 4) {
        const int sw = wave - 4;
#define DN_PIECE(i_) ((sw + 4 * (i_)) < 73 ? (sw + 4 * (i_)) : 72)
#define DN_SRC(rec_, p_) ((p_) < 48 ? (rec_) + (p_) * 1024 : (p_) < 65 ? (rec_) + REC_DIR + dir * REC_DIRSZ + ((p_) - 48) * 1024 : (rec_) + REC_V + half * 8192 + ((p_) - 65) * 1024)
#define DN_STAGE(n, bi) do { const unsigned char* rec_ = recb + (size_t)CIDX(n) * REC_BYTES; _Pragma("unroll") for (int i_ = 0; i_ < 19; ++i_) { const int p_ = DN_PIECE(i_); \
        __builtin_amdgcn_global_load_lds((const unsigned*)(DN_SRC(rec_, p_) + lane * 16), (LAS unsigned*)(lds + (bi) * BUFSZ + p_ * 1024), 16, 0, 0); } } while (0)
#define DN_SYNC() do { asm volatile("s_waitcnt vmcnt(0)" ::: "memory"); __builtin_amdgcn_s_barrier(); asm volatile("" ::: "memory"); } while (0)
        if (VAR != 3) DN_STAGE(0, 0);
        DN_SYNC();
        for (int n = 0; n < NCH; ++n) {
            if (VAR != 3 && n + 1 < NCH) DN_STAGE(n + 1, (n + 1) & 1);
            DN_SYNC();
        }
#undef DN_STAGE
#undef DN_PIECE
#undef DN_SRC
#undef DN_SYNC
    } else {
        const int sl = half * 4 + wave, c16 = lane & 15, g4 = lane >> 4;
        bf16_t* Og = (bf16_t*)(ws + (dir ? WS_OB : WS_OF)) + h * 128 + sl * 16 + c16;
        f32x4 S[8];
#pragma unroll
        for (int i = 0; i < 8; ++i) S[i] = (f32x4){0.f, 0.f, 0.f, 0.f};
        asm volatile("s_waitcnt lgkmcnt(0)" ::: "memory"); __builtin_amdgcn_s_barrier(); asm volatile("" ::: "memory");
        for (int n = 0; n < NCH; ++n) {
            if (VAR == 2) { asm volatile("s_waitcnt lgkmcnt(0)" ::: "memory"); __builtin_amdgcn_s_barrier(); asm volatile("" ::: "memory"); continue; }
            const LAS unsigned char* buf = lds + (n & 1) * BUFSZ;
            const int cidx = CIDX(n);
            const u32x4 vc0 = *(const LAS u32x4*)(buf + 66560 + wave * 2048 + lane * 32), vc1 = *(const LAS u32x4*)(buf + 66560 + wave * 2048 + lane * 32 + 16);
#define FR(off, f) (*(const LAS bf16x8*)(buf + (off) + (f) * 1024 + lane * 16))
#define MF(A, B, C) __builtin_amdgcn_mfma_f32_16x16x32_bf16((A), (B), (C), 0, 0, 0)
#define SB_() __builtin_amdgcn_sched_barrier(0)
            bf16x8 fa[8], fb[8];
            f32x4 eg[4], dl[4];
#pragma unroll
            for (int mt = 0; mt < 4; ++mt) { eg[mt] = *(const LAS f32x4*)(buf + 65536 + (16 * mt + 4 * g4) * 4); dl[mt] = *(const LAS f32x4*)(buf + 65536 + 256 + (16 * mt + 4 * g4) * 4); }
            const float egl = *(const LAS float*)(buf + 65536 + 512);
#define RD_KQ(dst, q) do { _Pragma("unroll") for (int mt = 0; mt < 4; ++mt) { dst[mt] = FR(0, mt * 4 + (q)); dst[4 + mt] = FR(32768, mt * 4 + (q)); } } while (0)
#define MM_KQ(src, q) do { _Pragma("unroll") for (int mt = 0; mt < 4; ++mt) { X[mt] = MF(src[mt], Sb[q], X[mt]); O[mt] = MF(src[4 + mt], Sb[q], O[mt]); } } while (0)
            f32x4 X[4], O[4], VN[4];
#pragma unroll
            for (int i = 0; i < 4; ++i) { X[i] = (f32x4){0.f, 0.f, 0.f, 0.f}; O[i] = (f32x4){0.f, 0.f, 0.f, 0.f}; VN[i] = (f32x4){0.f, 0.f, 0.f, 0.f}; }
            bf16x8 Sb[4];
#pragma unroll
            for (int q = 0; q < 4; ++q) Sb[q] = pack44(S[2 * q], S[2 * q + 1]);
            RD_KQ(fa, 0); SB_();
            RD_KQ(fb, 1); SB_(); MM_KQ(fa, 0); SB_();
            RD_KQ(fa, 2); SB_(); MM_KQ(fb, 1); SB_();
            RD_KQ(fb, 3); SB_(); MM_KQ(fa, 2); SB_();
#pragma unroll
            for (int i = 0; i < 8; ++i) fa[i] = FR(49152, i);
            SB_(); MM_KQ(fb, 3); SB_();
#pragma unroll
            for (int mt = 0; mt < 4; ++mt) { const unsigned w0 = (mt < 2 ? vc0 : vc1)[2 * (mt & 1)], w1 = (mt < 2 ? vc0 : vc1)[2 * (mt & 1) + 1];
                X[mt][0] = bflo(w0) - eg[mt][0] * X[mt][0]; X[mt][1] = bfhi(w0) - eg[mt][1] * X[mt][1]; X[mt][2] = bflo(w1) - eg[mt][2] * X[mt][2]; X[mt][3] = bfhi(w1) - eg[mt][3] * X[mt][3]; }
            const bf16x8 Yb0 = pack44(X[0], X[1]), Yb1 = pack44(X[2], X[3]);
            SB_();
#pragma unroll
            for (int i = 0; i < 8; ++i) fb[i] = FR(57344, i);
            SB_();
#pragma unroll
            for (int mt = 0; mt < 4; ++mt) { VN[mt] = MF(fa[mt * 2], Yb0, VN[mt]); VN[mt] = MF(fa[mt * 2 + 1], Yb1, VN[mt]); }
            SB_();
#pragma unroll
            for (int mt = 0; mt < 4; ++mt) O[mt] = O[mt] * eg[mt];
            const bf16x8 Vb0 = pack44(VN[0], VN[1]), Vb1 = pack44(VN[2], VN[3]);
            SB_();
#pragma unroll
            for (int i = 0; i < 8; ++i) fa[i] = FR(16384, i);
            SB_();
#pragma unroll
            for (int mt = 0; mt < 4; ++mt) { O[mt] = MF(fb[mt * 2], Vb0, O[mt]); O[mt] = MF(fb[mt * 2 + 1], Vb1, O[mt]); }
            SB_();
#pragma unroll
            for (int mt = 0; mt < 4; ++mt) VN[mt] = VN[mt] * dl[mt];
            const bf16x8 Vd0 = pack44(VN[0], VN[1]), Vd1 = pack44(VN[2], VN[3]);
#pragma unroll
            for (int i = 0; i < 8; ++i) S[i] = S[i] * egl;
            SB_();
#pragma unroll
            for (int i = 0; i < 8; ++i) fb[i] = FR(16384, 8 + i);
            SB_();
#pragma unroll
            for (int i = 0; i < 4; ++i) { S[i] = MF(fa[i * 2], Vd0, S[i]); S[i] = MF(fa[i * 2 + 1], Vd1, S[i]); }
            SB_();
#pragma unroll
            for (int i = 0; i < 4; ++i) { S[4 + i] = MF(fb[i * 2], Vd0, S[4 + i]); S[4 + i] = MF(fb[i * 2 + 1], Vd1, S[4 + i]); }
            SB_();
            {
                const int row0 = cidx < 4 ? ML + b * CT + cidx * 64 : b * T + (cidx - 4) * 64;
                bf16_t* op = Og + (size_t)(row0 + 4 * g4) * 512;
#pragma unroll
                for (int mt = 0; mt < 4; ++mt)
#pragma unroll
                    for (int t = 0; t < 4; ++t) { if (VAR != 1) op[(size_t)(16 * mt + t) * 512] = (bf16_t)(pkbf_c(O[mt][t], 0.f) & 0xffffu); else asm volatile("" :: "v"(O[mt][t])); }
            }
#undef RD_KQ
#undef MM_KQ
#undef SB_
#undef FR
#undef MF
            asm volatile("s_waitcnt lgkmcnt(0)" ::: "memory"); __builtin_amdgcn_s_barrier(); asm volatile("" ::: "memory");
        }
    }
#undef CIDX
#undef a
}

__device__ __forceinline__ void phase_dn_out(int l) {
    const KArgs ap = get_args();
#define a (*ap)

    const int tid = fresh_tid(), lane = tid & 63, wave = __builtin_amdgcn_readfirstlane(tid >> 6), G = fresh_g(), bx = fresh_bx();
    unsigned char* ws = a.ws;
    const int nrows = (l == DEPTH - 1) ? ML : M;
    const bf16_t* OF = (const bf16_t*)(ws + WS_OF); const bf16_t* OB = (const bf16_t*)(ws + WS_OB);
    const bf16_t* P = (const bf16_t*)(ws + WS_P); bf16_t* CAT = (bf16_t*)(ws + WS_CAT);
    const f32x2 nw = *(const f32x2*)(a.in[I_DNW] + l * 128 + 2 * lane);
    const float* LSE = (const float*)(ws + WS_BA);
    for (int row = wave * G + bx; row < nrows; row += G * 8) {
        f32x2 of[4], ob[4]; unsigned gw[4];
#pragma unroll
        for (int hh = 0; hh < 4; ++hh) { const unsigned wf_ = *(const unsigned*)(OF + (size_t)row * 512 + hh * 128 + 2 * lane), wb_ = *(const unsigned*)(OB + (size_t)row * 512 + hh * 128 + 2 * lane); of[hh] = (f32x2){bflo(wf_), bfhi(wf_)}; ob[hh] = (f32x2){bflo(wb_), bfhi(wb_)};
            gw[hh] = *(const unsigned*)(P + (size_t)row * NP + 2560 + hh * 128 + 2 * lane); }
        u32x4 ap_[4]; float ls_[4];
#pragma unroll
        for (int p = 0; p < 4; ++p) { ap_[p] = (u32x4){0u, 0u, 0u, 0u}; ls_[p] = 0.f; }
        if (row < ML) {
            ap_[0] = *(const u32x4*)(CAT + (size_t)row * 1024 + 8 * lane); ap_[1] = *(const u32x4*)((const bf16_t*)(ws + WS_DQ) + (size_t)row * 512 + 8 * lane);
            ap_[2] = *(const u32x4*)((const bf16_t*)(ws + WS_DK) + (size_t)row * 512 + 8 * lane); ap_[3] = *(const u32x4*)((const bf16_t*)(ws + WS_DV) + (size_t)row * 512 + 8 * lane);
#pragma unroll
            for (int p = 0; p < 4; ++p) ls_[p] = LSE[((size_t)p * ML + row) * 4 + (lane >> 4)]; }
        float o0[4], o1[4], ssq[4];
#pragma unroll
        for (int hh = 0; hh < 4; ++hh) { o0[hh] = of[hh][0] + ob[hh][0]; o1[hh] = of[hh][1] + ob[hh][1]; ssq[hh] = o0[hh] * o0[hh] + o1[hh] * o1[hh]; }
#pragma unroll
        for (int hh = 0; hh < 4; ++hh) ssq[hh] = wave_sum(ssq[hh]);
        float mxv = 0.f;
#pragma unroll
        for (int hh = 0; hh < 4; ++hh) { const float rs = rsqrtf(ssq[hh] * (1.f / 128.f) + EPS); const float g0 = bflo(gw[hh]), g1 = bfhi(gw[hh]);
            o0[hh] = o0[hh] * rs * nw[0] * silu_f(g0); o1[hh] = o1[hh] * rs * nw[1] * silu_f(g1); mxv = fmaxf(mxv, fmaxf(fabsf(o0[hh]), fabsf(o1[hh]))); }
        float av[8];
        if (row < ML) { const float mx = fmaxf(fmaxf(ls_[0], ls_[1]), fmaxf(ls_[2], ls_[3]));
            float w_[4], wsum = 0.f;
#pragma unroll
            for (int p = 0; p < 4; ++p) { w_[p] = __expf(ls_[p] - mx); wsum += w_[p]; }
            const float inv = 1.f / wsum;
#pragma unroll
            for (int i = 0; i < 4; ++i) { float lo = 0.f, hi2 = 0.f;
#pragma unroll
                for (int p = 0; p < 4; ++p) { lo = fmaf(w_[p], bflo(ap_[p][i]), lo); hi2 = fmaf(w_[p], bfhi(ap_[p][i]), hi2); }
                av[2 * i] = lo * inv; av[2 * i + 1] = hi2 * inv; } }
        else { const u32x4 cw_ = *(const u32x4*)(CAT + (size_t)row * 1024 + 8 * lane);
#pragma unroll
            for (int i = 0; i < 4; ++i) { av[2 * i] = bflo(cw_[i]); av[2 * i + 1] = bfhi(cw_[i]); } }
#pragma unroll
        for (int i = 0; i < 8; ++i) mxv = fmaxf(mxv, fabsf(av[i]));
        mxv = fmaxf(wave_max(mxv), 1e-30f);
        const float cinv = 127.f / mxv;
        signed char* crow = (signed char*)(ws + WS_CATQ) + (size_t)row * 1024;
#define Q8_(x) ((unsigned)(int)rintf((x) * cinv) & 255u)
        { u32x2 o; o.x = Q8_(av[0]) | (Q8_(av[1]) << 8) | (Q8_(av[2]) << 16) | (Q8_(av[3]) << 24); o.y = Q8_(av[4]) | (Q8_(av[5]) << 8) | (Q8_(av[6]) << 16) | (Q8_(av[7]) << 24); *(u32x2*)(crow + 8 * lane) = o; }
#pragma unroll
        for (int hh = 0; hh < 4; ++hh) *(unsigned short*)(crow + 512 + hh * 128 + 2 * lane) = (unsigned short)(Q8_(o0[hh]) | (Q8_(o1[hh]) << 8));
#undef Q8_
        if (lane == 0) ((float*)(ws + WS_GB))[(1u << 18) + row] = mxv * (1.f / 127.f);
    }
#undef a
}

#define CE_DESC(a_, b_) do { const float hi_ = fmaxf(a_, b_), lo_ = fminf(a_, b_); a_ = hi_; b_ = lo_; } while (0)
__device__ __forceinline__ void bitonic_sort16_desc(float (&v)[16]) {
#pragma unroll
    for (int k = 2; k <= 16; k <<= 1)
#pragma unroll
        for (int j = k >> 1; j > 0; j >>= 1)
#pragma unroll
            for (int i = 0; i < 16; ++i) { const int p = i ^ j; if (p > i) { if ((i & k) == 0) CE_DESC(v[i], v[p]); else CE_DESC(v[p], v[i]); } }
}
__device__ __forceinline__ void merge_top16_desc(float (&lst)[16], const float (&nw)[16]) {
#pragma unroll
    for (int i = 0; i < 16; ++i) lst[i] = fmaxf(lst[i], nw[15 - i]);
#pragma unroll
    for (int j = 8; j > 0; j >>= 1)
#pragma unroll
        for (int i = 0; i < 16; ++i) { const int p = i ^ j; if (p > i) CE_DESC(lst[i], lst[p]); }
}
__device__ __forceinline__ void phase_peer_select(int l) {
    const KArgs ap = get_args();
#define a (*ap)
    const int tid = fresh_tid(), lane = tid & 63, wave = __builtin_amdgcn_readfirstlane(tid >> 6), G = fresh_g(), bx = fresh_bx();
    unsigned char* ws = a.ws;
    const int nrows = (l == DEPTH - 1) ? ML : M;
    const int ntask = (nrows / 32) * 4;
    const bf16_t* Q2 = (const bf16_t*)(ws + WS_P);
    const bf16_t* SKB = (const bf16_t*)(ws + WS_SKB) + (size_t)l * 8 * 2 * 128 * 128;
    int* PIDX = (int*)(ws + WS_PIDX); float* PGATE = (float*)(ws + WS_PGATE);
    const float NEG = -3.0e38f;
    const int r = lane & 31, hi = lane >> 5;
    for (int task = wave * G + bx; task < ntask; task += G * 8) {
        const int tg = task >> 2, hp = task & 3; const int row = tg * 32 + r;
        float mine0[16], mine1[16];
#pragma unroll
        for (int j = 0; j < 16; ++j) { mine0[j] = NEG; mine1[j] = NEG; }
        bf16x8 qA[8], kA[8];
        float lst[16];
#define SEL_QPTR(it_) (Q2 + (size_t)row * 2048 + (2 * hp + ((it_) >> 1)) * 256 + ((it_) & 1) * 128 + 8 * hi)
#define SEL_KPTR(it_, t_) (SKB + (size_t)(((2 * hp + ((it_) >> 1)) * 2 + ((it_) & 1)) * 128 + 32 * (t_) + r) * 128 + 8 * hi)
#define SEL_LDQ(dst, it_) do { const bf16_t* qp_ = SEL_QPTR(it_); _Pragma("unroll") for (int ks = 0; ks < 8; ++ks) dst[ks] = *(const bf16x8*)(qp_ + 16 * ks); } while (0)
#define SEL_LDK(dst, it_, t_) do { const bf16_t* kp_ = SEL_KPTR(it_, t_); _Pragma("unroll") for (int ks = 0; ks < 8; ++ks) dst[ks] = *(const bf16x8*)(kp_ + 16 * ks); } while (0)
#define SEL_RANK(qv, kv, t_) do { f32x16 acc = {}; _Pragma("unroll") for (int ks = 0; ks < 8; ++ks) acc = __builtin_amdgcn_mfma_f32_32x32x16_bf16(kv[ks], qv[ks], acc, 0, 0, 0); \
            const unsigned kb = (unsigned)(32 * (t_) + 4 * hi); float nw_[16]; \
            _Pragma("unroll") for (int i = 0; i < 16; ++i) nw_[i] = __uint_as_float((__float_as_uint(acc[i]) & 0xffffff80u) | (kb + (unsigned)((i & 3) + 8 * (i >> 2)))); \
            bitonic_sort16_desc(nw_); merge_top16_desc(lst, nw_); } while (0)
#define SB_() __builtin_amdgcn_sched_barrier(0)
#pragma unroll
        for (int j = 0; j < 16; ++j) lst[j] = NEG;
#pragma unroll 1
        for (int it = 0; it < 4; ++it) {
            SEL_LDQ(qA, it);
#pragma unroll 1
            for (int t = 0; t < 4; ++t) { SEL_LDK(kA, it, t); SEL_RANK(qA, kA, t); }
            float oth[16];
#pragma unroll
            for (int j = 0; j < 16; ++j) { auto rr = __builtin_amdgcn_permlane32_swap(__float_as_uint(lst[j]), __float_as_uint(lst[j]), false, false); oth[j] = __uint_as_float(hi ? rr[0] : rr[1]); }
            merge_top16_desc(lst, oth);
            const bool k0 = ((it >> 1) == hi) && ((it & 1) == 0), k1 = ((it >> 1) == hi) && ((it & 1) == 1);
#pragma unroll
            for (int j = 0; j < 16; ++j) { mine0[j] = k0 ? lst[j] : mine0[j]; mine1[j] = k1 ? lst[j] : mine1[j]; lst[j] = NEG; }
        }
#undef SB_
#undef SEL_QPTR
#undef SEL_KPTR
#undef SEL_LDQ
#undef SEL_LDK
#undef SEL_RANK
        const int h = 2 * hp + hi;
        float ts[16];
#pragma unroll
        for (int j = 0; j < 16; ++j) ts[j] = NEG;
#pragma unroll
        for (int i = 0; i < 16; ++i)
#pragma unroll
            for (int j = 0; j < 16; ++j) if ((i + 1) * (j + 1) <= 16) {
                const unsigned b0 = __float_as_uint(mine0[i]), b1 = __float_as_uint(mine1[j]);
                const float c = __uint_as_float(b0 & 0xffffff80u) + __uint_as_float(b1 & 0xffffff80u);
                float x = __uint_as_float((__float_as_uint(c) & 0xffffc000u) | ((b0 & 127u) << 7) | (b1 & 127u));
#pragma unroll
                for (int t = 0; t < 16; ++t) { const float hv = fmaxf(ts[t], x); x = fminf(ts[t], x); ts[t] = hv; }
            }
        int te[16]; float ex[16], sum = 0.f;
        const float tmax = __uint_as_float(__float_as_uint(ts[0]) & 0xffffc000u);
#pragma unroll
        for (int t = 0; t < 16; ++t) { const unsigned bt = __float_as_uint(ts[t]); te[t] = (int)(bt & 0x3fffu); ex[t] = __expf(__uint_as_float(bt & 0xffffc000u) - tmax); sum += ex[t]; }
        const float inv = 1.f / sum;
        unsigned short* ip = (unsigned short*)PIDX + (size_t)row * 128 + h * 16; float* gp = PGATE + (size_t)row * 128 + h * 16;
#pragma unroll
        for (int t = 0; t < 16; t += 8) *(u32x4*)(ip + t) = (u32x4){(unsigned)te[t] | ((unsigned)te[t + 1] << 16), (unsigned)te[t + 2] | ((unsigned)te[t + 3] << 16), (unsigned)te[t + 4] | ((unsigned)te[t + 5] << 16), (unsigned)te[t + 6] | ((unsigned)te[t + 7] << 16)};
#pragma unroll
        for (int t = 0; t < 16; t += 4) *(f32x4*)(gp + t) = (f32x4){ex[t] * inv, ex[t + 1] * inv, ex[t + 2] * inv, ex[t + 3] * inv};
    }
#undef a
}

template <bool WR, int GV = 0>
__device__ __forceinline__ void phase_peer_gather(int l, LAS unsigned char* lds) {
    const KArgs ap = get_args();
#define a (*ap)
    const int tid = fresh_tid(), lane = tid & 63, wave = __builtin_amdgcn_readfirstlane(tid >> 6), G = fresh_g(), bx = fresh_bx();
    unsigned char* ws = a.ws;
    const int nrows = (l == DEPTH - 1) ? ML : M;
    const unsigned char* UB = ws + WS_UB + (size_t)(l & 1) * TAB_SET; const unsigned char* VB = UB + 1024;
    const float* USC = (const float*)(ws + WS_USC) + (l & 1) * 2 * NEXP; const float* VSC = USC + NEXP;
    const int* PIDX = (const int*)(ws + WS_PIDX); const float* PGATE = (const float*)(ws + WS_PGATE);
    const float* modl = (const float*)(ws + WS_MOD) + (size_t)l * 3 * 6144 + 5120;
    const bool fuse = WR && (l + 1 < DEPTH);
    LAS float* wsk = (LAS float*)lds;
    if (fuse) { const float* src = (const float*)(ws + WS_WSK) + (size_t)(l + 1) * 16384; for (int i = tid; i < 16384 / 4; i += 512) ((LAS f32x4*)wsk)[i] = ((const f32x4*)src)[i]; __syncthreads(); }
    const float* nw1 = a.in[I_N1W] + (l + 1 < DEPTH ? l + 1 : l) * 1024 + 16 * lane;
    const float* modn = (const float*)(ws + WS_MOD) + (size_t)(l + 1 < DEPTH ? l + 1 : l) * 3 * 6144;
    for (int row = wave * G + bx; row < nrows; row += G * 8) {
        float hv[16], out[16];
        { const u32x4 hw = *(const u32x4*)((const signed char*)(ws + WS_H) + (size_t)row * D + 16 * lane); const float hsc = ((const float*)(ws + WS_GB))[row];
#pragma unroll
          for (int q = 0; q < 4; ++q) { const int w = (int)hw[q]; hv[4 * q + 0] = (float)((w << 24) >> 24) * hsc; hv[4 * q + 1] = (float)((w << 16) >> 24) * hsc; hv[4 * q + 2] = (float)((w << 8) >> 24) * hsc; hv[4 * q + 3] = (float)(w >> 24) * hsc; } }
        float hs = 0.f;
#pragma unroll
        for (int i = 0; i < 16; ++i) { out[i] = 0.f; hs += hv[i]; }
        const float hsum128 = 128.f * wave_sum(hs);
        float wacc = 0.f;
        const int id0 = PIDX[(size_t)row * 128 + lane], id1 = PIDX[(size_t)row * 128 + 64 + lane];
        const float gt0 = PGATE[(size_t)row * 128 + lane], gt1 = PGATE[(size_t)row * 128 + 64 + lane];
        const float us0 = USC[id0], us1 = USC[id1], vs0 = VSC[id0], vs1 = VSC[id1];
        for (int e0 = 0; e0 < 128; e0 += 8) {
            u32x4 uw[8], vw[8]; float gte[8], use[8], vse[8];
#pragma unroll
            for (int j = 0; j < 8; ++j) { const int e = e0 + j; const int id = __builtin_amdgcn_readlane(e0 < 64 ? id0 : id1, e & 63);
                gte[j] = __builtin_bit_cast(float, __builtin_amdgcn_readlane(__builtin_bit_cast(int, e0 < 64 ? gt0 : gt1), e & 63));
                use[j] = __builtin_bit_cast(float, __builtin_amdgcn_readlane(__builtin_bit_cast(int, e0 < 64 ? us0 : us1), e & 63));
                vse[j] = __builtin_bit_cast(float, __builtin_amdgcn_readlane(__builtin_bit_cast(int, e0 < 64 ? vs0 : vs1), e & 63));
                uw[j] = *(const u32x4*)(UB + (size_t)id * 2048 + 16 * lane); vw[j] = *(const u32x4*)(VB + (size_t)id * 2048 + 16 * lane); }
#pragma unroll
            for (int j = 0; j < 8; ++j) {
                float d0 = 0.f, d1 = 0.f;
#pragma unroll
                for (int q = 0; q < 4; ++q) { const unsigned w = uw[j][q];
                    d0 = fmaf((float)(w & 255u), hv[4 * q + 0], d0); d1 = fmaf((float)((w >> 8) & 255u), hv[4 * q + 1], d1);
                    d0 = fmaf((float)((w >> 16) & 255u), hv[4 * q + 2], d0); d1 = fmaf((float)(w >> 24), hv[4 * q + 3], d1); }
                const float dsum = (wave_sum(d0 + d1) - hsum128) * use[j];
                const float act = 0.5f * dsum * (1.f + erff(dsum * 0.70710678118654752f));
                const float wgt = gte[j] * act * vse[j];
                wacc += wgt;
                if (GV == 1) { asm volatile("" :: "v"(vw[j])); out[0] += wgt; } else
#pragma unroll
                for (int q = 0; q < 4; ++q) { const unsigned w = vw[j][q];
                    out[4 * q + 0] = fmaf(wgt, (float)(w & 255u), out[4 * q + 0]); out[4 * q + 1] = fmaf(wgt, (float)((w >> 8) & 255u), out[4 * q + 1]);
                    out[4 * q + 2] = fmaf(wgt, (float)((w >> 16) & 255u), out[4 * q + 2]); out[4 * q + 3] = fmaf(wgt, (float)(w >> 24), out[4 * q + 3]); }
            }
        }
        const float corr = 128.f * wacc;
        float* xr; int mrow;
        if (row < ML) { xr = a.out + (size_t)row * D; mrow = row >= T ? 1 : 0; } else { xr = (float*)(ws + WS_CTXX) + (size_t)(row - ML) * D; mrow = 2; }
        const float* g2 = modl + mrow * 6144 + 16 * lane;
        f32x4 xn[4];
#pragma unroll
        for (int i = 0; i < 4; ++i) { const f32x4 x = *(const f32x4*)(xr + 16 * lane + 4 * i), g = *(const f32x4*)(g2 + 4 * i);
            xn[i] = x + g * (f32x4){out[4 * i] - corr, out[4 * i + 1] - corr, out[4 * i + 2] - corr, out[4 * i + 3] - corr};
            if (WR) *(f32x4*)(xr + 16 * lane + 4 * i) = xn[i]; else asm volatile("" :: "v"(xn[i])); }
        if (fuse) {
            float ss = 0.f;
#pragma unroll
            for (int i = 0; i < 4; ++i) ss += (xn[i][0] * xn[i][0] + xn[i][1] * xn[i][1]) + (xn[i][2] * xn[i][2] + xn[i][3] * xn[i][3]);
            const float rstd = rsqrtf(wave_sum(ss) * (1.f / D) + EPS);
            const float* md = modn + mrow * 6144 + 16 * lane;
#pragma unroll
            for (int i = 0; i < 4; ++i) { const f32x4 nwv = *(const f32x4*)(nw1 + 4 * i), sc = *(const f32x4*)(md + 1024 + 4 * i), sh = *(const f32x4*)(md + 4 * i);
                xn[i] = xn[i] * rstd * nwv * (sc + 1.f) + sh; }
            { float hmx = 0.f;
#pragma unroll
              for (int i = 0; i < 4; ++i) hmx = fmaxf(hmx, fmaxf(fmaxf(fabsf(xn[i][0]), fabsf(xn[i][1])), fmaxf(fabsf(xn[i][2]), fabsf(xn[i][3]))));
              hmx = fmaxf(wave_max(hmx), 1e-30f); const float hinv = 127.f / hmx;
              u32x4 o;
#pragma unroll
              for (int i = 0; i < 4; ++i) o[i] = ((unsigned)(int)rintf(xn[i][0] * hinv) & 255u) | (((unsigned)(int)rintf(xn[i][1] * hinv) & 255u) << 8) | (((unsigned)(int)rintf(xn[i][2] * hinv) & 255u) << 16) | (((unsigned)(int)rintf(xn[i][3] * hinv) & 255u) << 24);
              *(u32x4*)((signed char*)(ws + WS_H) + (size_t)row * D + 16 * lane) = o;
              if (lane == 0) ((float*)(ws + WS_GB))[row] = hmx * (1.f / 127.f); }
            float p[16];
#pragma unroll
            for (int c = 0; c < 16; ++c) { float q = 0.f;
#pragma unroll
                for (int i = 0; i < 4; ++i) { const f32x4 w = *(const LAS f32x4*)(wsk + c * 1024 + 16 * lane + 4 * i); q += (xn[i][0] * w[0] + xn[i][1] * w[1]) + (xn[i][2] * w[2] + xn[i][3] * w[3]); }
                p[c] = q; }
            { const bool hb = (lane & 32) != 0;
#pragma unroll
              for (int c = 0; c < 8; ++c) { const float keep = hb ? p[c + 8] : p[c], send = hb ? p[c] : p[c + 8]; p[c] = keep + lane_xor<32>(send); } }
            { const bool hb = (lane & 16) != 0;
#pragma unroll
              for (int c = 0; c < 4; ++c) { const float keep = hb ? p[c + 4] : p[c], send = hb ? p[c] : p[c + 4]; p[c] = keep + lane_xor<16>(send); } }
            { const bool hb = (lane & 8) != 0;
#pragma unroll
              for (int c = 0; c < 2; ++c) { const float keep = hb ? p[c + 2] : p[c], send = hb ? p[c] : p[c + 2]; p[c] = keep + lane_xor<8>(send); } }
            { const bool hb = (lane & 4) != 0; const float keep = hb ? p[1] : p[0], send = hb ? p[0] : p[1]; p[0] = keep + lane_xor<4>(send); }
            p[0] += lane_xor<2>(p[0]); p[0] += lane_xor<1>(p[0]);
            if ((lane & 3) == 0) { const int c = ((lane >> 5) & 1) * 8 + ((lane >> 4) & 1) * 4 + ((lane >> 3) & 1) * 2 + ((lane >> 2) & 1); ((float*)(ws + WS_BA))[(size_t)row * 16 + c] = p[0]; }
        }
    }
    if (fuse) __syncthreads();
}
#undef a
constexpr size_t WS_PART = WS_P;
static_assert(WS_PART + 8 * (size_t)M * 1024 * 2 <= WS_GB, "partials region");
constexpr int GP_ITEM = 16;
struct GpMeta { int id0, id1; float gt0, gt1; u32x4 hw; float hsc; };
__device__ __forceinline__ void phase_peer_gpart(int l, LAS unsigned char* lds) {
    const KArgs ap = get_args();
#define a (*ap)
    const int tid = fresh_tid(), lane = tid & 63, wave = __builtin_amdgcn_readfirstlane(tid >> 6);
    unsigned char* ws = a.ws;
    const int nrows = (l == DEPTH - 1) ? ML : M;
    const int nitem = nrows / GP_ITEM;
    const unsigned char* UB = ws + WS_UB + (size_t)(l & 1) * TAB_SET; const unsigned char* VB = UB + 1024;
    const f32x2* SC2 = (const f32x2*)(ws + WS_USC) + (size_t)(l & 1) * NEXP;
    const int* PIDX = (const int*)(ws + WS_PIDX); const float* PGATE = (const float*)(ws + WS_PGATE);
    LAS u32x4* lst0 = (LAS u32x4*)lds + wave * 256;
    const int eidx = ((lane >> 5) & 1) * 4 + ((lane >> 4) & 1) * 2 + ((lane >> 3) & 1);
    const int x = (int)(xb_xcc_id() & 7u);
#define GP_LOAD_META(m_, row_) do { const int rw_ = (row_); (m_).id0 = PIDX[(size_t)rw_ * 128 + lane]; (m_).id1 = PIDX[(size_t)rw_ * 128 + 64 + lane]; (m_).gt0 = PGATE[(size_t)rw_ * 128 + lane]; (m_).gt1 = PGATE[(size_t)rw_ * 128 + 64 + lane]; \
        (m_).hw = *(const u32x4*)((const signed char*)(ws + WS_H) + (size_t)rw_ * D + 16 * lane); (m_).hsc = ((const float*)(ws + WS_GB))[rw_]; } while (0)
#define GP_LOAD_SC(sa_, sb_, m_) do { sa_ = (f32x2){0.f, 0.f}; sb_ = (f32x2){0.f, 0.f}; if (((m_).id0 >> 11) == p) sa_ = SC2[(m_).id0]; if (((m_).id1 >> 11) == p) sb_ = SC2[(m_).id1]; } while (0)
#define GP_BUILD(cnt_, m_, sa_, sb_, buf_) do { const bool s0_ = ((m_).id0 >> 11) == p, s1_ = ((m_).id1 >> 11) == p; const unsigned long long m0_ = __ballot(s0_), m1_ = __ballot(s1_); \
        const int c0_ = __builtin_popcountll(m0_); cnt_ = __builtin_amdgcn_readfirstlane(c0_ + __builtin_popcountll(m1_)); \
        const int r0_ = (int)__builtin_amdgcn_mbcnt_hi((unsigned)(m0_ >> 32), __builtin_amdgcn_mbcnt_lo((unsigned)m0_, 0u)); \
        const int r1_ = c0_ + (int)__builtin_amdgcn_mbcnt_hi((unsigned)(m1_ >> 32), __builtin_amdgcn_mbcnt_lo((unsigned)m1_, 0u)); \
        LAS u32x4* lb_ = lst0 + (buf_) * 128; \
        if (s0_) lb_[r0_] = (u32x4){(unsigned)(m_).id0, __float_as_uint((m_).gt0 * sa_[1]), __float_as_uint(sa_[0]), 0u}; \
        if (s1_) lb_[r1_] = (u32x4){(unsigned)(m_).id1, __float_as_uint((m_).gt1 * sb_[1]), __float_as_uint(sb_[0]), 0u}; } while (0)
#pragma unroll 1
    for (int pp = 0; pp < 8; ++pp) {
        const int p = (x + pp) & 7;
        unsigned* ctr = (unsigned*)(ws + WS_CTL) + 16384 + (l * 8 + p) * 64;
        unsigned* part = (unsigned*)(ws + WS_PART + (size_t)p * M * 2048);
        unsigned tk = 0; if (lane == 0) tk = __hip_atomic_fetch_add(ctr, 1u, __ATOMIC_RELAXED, __HIP_MEMORY_SCOPE_AGENT);
        int it = __builtin_amdgcn_readfirstlane((int)tk);
#pragma unroll 1
        while (it < nitem) {
            unsigned tn = 0; if (lane == 0) tn = __hip_atomic_fetch_add(ctr, 1u, __ATOMIC_RELAXED, __HIP_MEMORY_SCOPE_AGENT);
            const int row0 = it * GP_ITEM, rowl = row0 + GP_ITEM - 1;
            GpMeta m1, m2, m3; f32x2 sa1, sb1, sa2, sb2; int c_cur, c_nxt; u32x4 hw_cur; float hsc_cur;
            GP_LOAD_META(m1, row0); GP_LOAD_META(m2, min(row0 + 1, rowl)); GP_LOAD_META(m3, min(row0 + 2, rowl));
            GP_LOAD_SC(sa1, sb1, m1);
            GP_BUILD(c_cur, m1, sa1, sb1, 0); hw_cur = m1.hw; hsc_cur = m1.hsc;
            GP_LOAD_SC(sa1, sb1, m2);
            m1 = m2; m2 = m3;
            GP_LOAD_META(m3, min(row0 + 3, rowl));
#pragma unroll 1
            for (int i = 0; i < GP_ITEM; ++i) {
                const int row = row0 + i;
                GP_BUILD(c_nxt, m1, sa1, sb1, (i + 1) & 1);
                const u32x4 hw_nxt = m1.hw; const float hsc_nxt = m1.hsc;
                GP_LOAD_SC(sa2, sb2, m2);
                m1 = m2; sa1 = sa2; sb1 = sb2; m2 = m3;
                GP_LOAD_META(m3, min(row + 4, rowl));
                LAS u32x4* lst = lst0 + (i & 1) * 128;
                const int c = c_cur; const u32x4 hw = hw_cur; const float hsc = hsc_cur;
                f32x2 o2[8];
#pragma unroll
                for (int k = 0; k < 8; ++k) o2[k] = (f32x2){0.f, 0.f};
                float wacc = 0.f;
#pragma unroll 1
                for (int e = 0; e < c; e += 8) {
                    u32x4 uw[8], vw[8];
#pragma unroll
                    for (int j = 0; j < 8; ++j) { const int sl = min(e + j, c - 1);
                        const int id = __builtin_amdgcn_readfirstlane((int)lst[sl][0]);
                        uw[j] = *(const u32x4*)(UB + (size_t)id * 2048 + 16 * lane); vw[j] = *(const u32x4*)(VB + (size_t)id * 2048 + 16 * lane); }
                    const int ms = e + eidx; const u32x4 en = lst[min(ms, c - 1)];
                    float pd[8];
#pragma unroll
                    for (int j = 0; j < 8; ++j) { int d = 0;
#pragma unroll
                        for (int q = 0; q < 4; ++q) d = __builtin_amdgcn_sdot4((int)uw[j][q], (int)hw[q], d, false);
                        pd[j] = (float)d; }
                    { const bool hb = (lane & 32) != 0;
#pragma unroll
                      for (int j = 0; j < 4; ++j) { const float keep = hb ? pd[j + 4] : pd[j], send = hb ? pd[j] : pd[j + 4]; pd[j] = keep + lane_xor<32>(send); } }
                    { const bool hb = (lane & 16) != 0;
#pragma unroll
                      for (int j = 0; j < 2; ++j) { const float keep = hb ? pd[j + 2] : pd[j], send = hb ? pd[j] : pd[j + 2]; pd[j] = keep + lane_xor<16>(send); } }
                    { const bool hb = (lane & 8) != 0; const float keep = hb ? pd[1] : pd[0], send = hb ? pd[0] : pd[1]; pd[0] = keep + lane_xor<8>(send); }
                    pd[0] += lane_xor<4>(pd[0]); pd[0] += lane_xor<2>(pd[0]); pd[0] += lane_xor<1>(pd[0]);
                    const float dsum = pd[0] * (__uint_as_float(en[2]) * hsc);
                    const float act = 0.5f * dsum * (1.f + erff(dsum * 0.70710678118654752f));
                    const float wgt = ms < c ? __uint_as_float(en[1]) * act : 0.f;
                    wacc += wgt;
#pragma unroll
                    for (int j = 0; j < 8; ++j) {
                        const float wj = __builtin_bit_cast(float, __builtin_amdgcn_readlane(__builtin_bit_cast(int, wgt), 32 * ((j >> 2) & 1) + 16 * ((j >> 1) & 1) + 8 * (j & 1)));
                        const f32x2 ww = {wj, wj};
#pragma unroll
                        for (int q = 0; q < 4; ++q) { const unsigned w = vw[j][q];
                            const f32x2 v01 = {(float)(w & 255u), (float)((w >> 8) & 255u)}, v23 = {(float)((w >> 16) & 255u), (float)(w >> 24)};
                            o2[2 * q] = __builtin_elementwise_fma(ww, v01, o2[2 * q]); o2[2 * q + 1] = __builtin_elementwise_fma(ww, v23, o2[2 * q + 1]); }
                    }
                }
                const float corr = 16.f * wave_sum(wacc);
                u32x4 w0, w1;
#pragma unroll
                for (int k = 0; k < 4; ++k) { w0[k] = pkbf_c(o2[k][0] - corr, o2[k][1] - corr); w1[k] = pkbf_c(o2[4 + k][0] - corr, o2[4 + k][1] - corr); }
                unsigned* dst = part + (size_t)row * 512 + 8 * lane;
                __builtin_nontemporal_store(w0, (u32x4*)dst); __builtin_nontemporal_store(w1, (u32x4*)(dst + 4));
                c_cur = c_nxt; hw_cur = hw_nxt; hsc_cur = hsc_nxt;
            }
            it = __builtin_amdgcn_readfirstlane((int)tn);
        }
    }
#undef GP_LOAD_META
#undef GP_LOAD_SC
#undef GP_BUILD
#undef a
}

__device__ __forceinline__ void phase_peer_combine(int l, LAS unsigned char* lds) {
    const KArgs ap = get_args();
#define a (*ap)
    const int tid = fresh_tid(), lane = tid & 63, wave = __builtin_amdgcn_readfirstlane(tid >> 6), G = fresh_g(), bx = fresh_bx();
    unsigned char* ws = a.ws;
    const int nrows = (l == DEPTH - 1) ? ML : M;
    const float* modl = (const float*)(ws + WS_MOD) + (size_t)l * 3 * 6144 + 5120;
    const bool fuse = (l + 1 < DEPTH);
    LAS float* wsk = (LAS float*)lds;
    if (fuse) { const float* src = (const float*)(ws + WS_WSK) + (size_t)(l + 1) * 16384; for (int i = tid; i < 16384 / 4; i += 512) ((LAS f32x4*)wsk)[i] = ((const f32x4*)src)[i]; __syncthreads(); }
    const float* nw1 = a.in[I_N1W] + (l + 1 < DEPTH ? l + 1 : l) * 1024 + 16 * lane;
    const float* modn = (const float*)(ws + WS_MOD) + (size_t)(l + 1 < DEPTH ? l + 1 : l) * 3 * 6144;
    for (int row = wave * G + bx; row < nrows; row += G * 8) {
        float out[16];
#pragma unroll
        for (int i = 0; i < 16; ++i) out[i] = 0.f;
#pragma unroll
        for (int p = 0; p < 8; ++p) { const unsigned* src = (const unsigned*)(ws + WS_PART + (size_t)p * M * 2048) + (size_t)row * 512 + 8 * lane;
            const u32x4 w0 = __builtin_nontemporal_load((const u32x4*)src), w1 = __builtin_nontemporal_load((const u32x4*)(src + 4));
#pragma unroll
            for (int k = 0; k < 4; ++k) { out[2 * k] += bflo(w0[k]); out[2 * k + 1] += bfhi(w0[k]); out[8 + 2 * k] += bflo(w1[k]); out[8 + 2 * k + 1] += bfhi(w1[k]); } }
        float* xr; int mrow;
        if (row < ML) { xr = a.out + (size_t)row * D; mrow = row >= T ? 1 : 0; } else { xr = (float*)(ws + WS_CTXX) + (size_t)(row - ML) * D; mrow = 2; }
        const float* g2 = modl + mrow * 6144 + 16 * lane;
        f32x4 xn[4];
#pragma unroll
        for (int i = 0; i < 4; ++i) { const f32x4 x = *(const f32x4*)(xr + 16 * lane + 4 * i), g = *(const f32x4*)(g2 + 4 * i);
            xn[i] = x + g * (f32x4){out[4 * i], out[4 * i + 1], out[4 * i + 2], out[4 * i + 3]};
            *(f32x4*)(xr + 16 * lane + 4 * i) = xn[i]; }
        if (fuse) {
            float ss = 0.f;
#pragma unroll
            for (int i = 0; i < 4; ++i) ss += (xn[i][0] * xn[i][0] + xn[i][1] * xn[i][1]) + (xn[i][2] * xn[i][2] + xn[i][3] * xn[i][3]);
            const float rstd = rsqrtf(wave_sum(ss) * (1.f / D) + EPS);
            const float* md = modn + mrow * 6144 + 16 * lane;
#pragma unroll
            for (int i = 0; i < 4; ++i) { const f32x4 nwv = *(const f32x4*)(nw1 + 4 * i), sc = *(const f32x4*)(md + 1024 + 4 * i), sh = *(const f32x4*)(md + 4 * i);
                xn[i] = xn[i] * rstd * nwv * (sc + 1.f) + sh; }
            { float hmx = 0.f;
#pragma unroll
              for (int i = 0; i < 4; ++i) hmx = fmaxf(hmx, fmaxf(fmaxf(fabsf(xn[i][0]), fabsf(xn[i][1])), fmaxf(fabsf(xn[i][2]), fabsf(xn[i][3]))));
              hmx = fmaxf(wave_max(hmx), 1e-30f); const float hinv = 127.f / hmx;
              u32x4 o;
#pragma unroll
              for (int i = 0; i < 4; ++i) o[i] = ((unsigned)(int)rintf(xn[i][0] * hinv) & 255u) | (((unsigned)(int)rintf(xn[i][1] * hinv) & 255u) << 8) | (((unsigned)(int)rintf(xn[i][2] * hinv) & 255u) << 16) | (((unsigned)(int)rintf(xn[i][3] * hinv) & 255u) << 24);
              *(u32x4*)((signed char*)(ws + WS_H) + (size_t)row * D + 16 * lane) = o;
              if (lane == 0) ((float*)(ws + WS_GB))[row] = hmx * (1.f / 127.f); }
            float p[16];
#pragma unroll
            for (int c = 0; c < 16; ++c) { float q = 0.f;
#pragma unroll
                for (int i = 0; i < 4; ++i) { const f32x4 w = *(const LAS f32x4*)(wsk + c * 1024 + 16 * lane + 4 * i); q += (xn[i][0] * w[0] + xn[i][1] * w[1]) + (xn[i][2] * w[2] + xn[i][3] * w[3]); }
                p[c] = q; }
            { const bool hb = (lane & 32) != 0;
#pragma unroll
              for (int c = 0; c < 8; ++c) { const float keep = hb ? p[c + 8] : p[c], send = hb ? p[c] : p[c + 8]; p[c] = keep + lane_xor<32>(send); } }
            { const bool hb = (lane & 16) != 0;
#pragma unroll
              for (int c = 0; c < 4; ++c) { const float keep = hb ? p[c + 4] : p[c], send = hb ? p[c] : p[c + 4]; p[c] = keep + lane_xor<16>(send); } }
            { const bool hb = (lane & 8) != 0;
#pragma unroll
              for (int c = 0; c < 2; ++c) { const float keep = hb ? p[c + 2] : p[c], send = hb ? p[c] : p[c + 2]; p[c] = keep + lane_xor<8>(send); } }
            { const bool hb = (lane & 4) != 0; const float keep = hb ? p[1] : p[0], send = hb ? p[0] : p[1]; p[0] = keep + lane_xor<4>(send); }
            p[0] += lane_xor<2>(p[0]); p[0] += lane_xor<1>(p[0]);
            if ((lane & 3) == 0) { const int c = ((lane >> 5) & 1) * 8 + ((lane >> 4) & 1) * 4 + ((lane >> 3) & 1) * 2 + ((lane >> 2) & 1); ((float*)(ws + WS_BA))[(size_t)row * 16 + c] = p[0]; }
        }
    }
    if (fuse) __syncthreads();
#undef a
}
constexpr size_t WS_PD = WS_REC;
constexpr size_t WS_PW = WS_REC + 8 * (size_t)M * 128 * 4;
constexpr size_t WS_PC = WS_PW + (size_t)M * 128;
static_assert(WS_PC + (size_t)M * 8 * 4 <= WS_END, "sliced gather scratch");
constexpr int GS_ITEM = 8;
template <int PH>
__device__ __forceinline__ void phase_peer_slice(int l, int cslot) {
    const KArgs ap = get_args();
#define a (*ap)
    const int tid = fresh_tid(), lane = tid & 63;
    unsigned char* ws = a.ws;
    const int nrows = (l == DEPTH - 1) ? ML : M;
    const int nitem = nrows / GS_ITEM;
    const unsigned char* TAB = ws + WS_UB + (size_t)(l & 1) * TAB_SET + (PH ? (size_t)NEXP * 1024 : 0);
    const int* PIDX = (const int*)(ws + WS_PIDX);
    const unsigned char* PW = ws + WS_PW; const float* PC = (const float*)(ws + WS_PC);
    const float* modl = (const float*)(ws + WS_MOD) + (size_t)l * 3 * 6144 + 5120;
    const int g = lane >> 3, i8 = lane & 7;
    const int x = (int)(xb_xcc_id() & 7u);
#pragma unroll 1
    for (int pp = 0; pp < 8; ++pp) {
        const int p = (x + pp) & 7;
        unsigned* ctr = (unsigned*)(ws + WS_CTL) + 16384 + ((l * 2 + PH) * 8 + p) * 64 + cslot * 8192;
        const unsigned char* tb = TAB + (size_t)p * NEXP * 128 + 16 * i8;
        unsigned tk = 0; if (lane == 0) tk = __hip_atomic_fetch_add(ctr, 1u, __ATOMIC_RELAXED, __HIP_MEMORY_SCOPE_AGENT);
        int it = __builtin_amdgcn_readfirstlane((int)tk);
        if (it < nitem) {
            unsigned tn = 0; if (lane == 0) tn = __hip_atomic_fetch_add(ctr, 1u, __ATOMIC_RELAXED, __HIP_MEMORY_SCOPE_AGENT);
            const int row0 = it * GS_ITEM;
            u32x4 idc[2], idn[2], ra[8], rb[8]; u32x4 wc, wn; float sc_c, sc_n; u32x4 hc, hn;
#define GS_META(ids_, wts_, wsc_, h_, row_) do { const int rw_ = (row_); const u32x4* ip_ = (const u32x4*)((const unsigned short*)PIDX + (size_t)rw_ * 128 + 16 * g); ids_[0] = ip_[0]; ids_[1] = ip_[1]; \
                if (PH) { wts_ = *(const u32x4*)(PW + (size_t)rw_ * 128 + 16 * g); wsc_ = PC[(size_t)rw_ * 8 + g]; } \
                else h_ = *(const u32x4*)((const signed char*)(ws + WS_H) + (size_t)rw_ * D + 128 * p + 16 * i8); } while (0)
#define GS_ROWS(dst_, ids_, hf_) do { _Pragma("unroll") for (int k_ = 0; k_ < 8; ++k_) dst_[k_] = *(const u32x4*)(tb + (size_t)((ids_[hf_][k_ >> 1] >> (16 * (k_ & 1))) & 0xffffu) * 128); } while (0)
            GS_META(idc, wc, sc_c, hc, row0);
            GS_ROWS(ra, idc, 0);
            GS_META(idn, wn, sc_n, hn, row0 + 1);
            int i = 0, tnv = 0x7fffffff;
#pragma unroll 1
            for (;;) {
                if (i == GS_ITEM - 2) tnv = __builtin_amdgcn_readfirstlane((int)tn);
                const int row = it * GS_ITEM + i;
                const int r2 = (i + 2 < GS_ITEM) ? row + 2 : (tnv < nitem ? tnv * GS_ITEM + (i + 2 - GS_ITEM) : row);
                GS_ROWS(rb, idc, 1);
                if (PH == 0) {
                    int d[16];
#pragma unroll
                    for (int k = 0; k < 8; ++k) { int s_ = 0;
#pragma unroll
                        for (int q = 0; q < 4; ++q) s_ = __builtin_amdgcn_sdot4((int)ra[k][q], (int)hc[q], s_, false);
                        d[k] = s_; }
                    GS_ROWS(ra, idn, 0);
#pragma unroll
                    for (int k = 0; k < 8; ++k) { int s_ = 0;
#pragma unroll
                        for (int q = 0; q < 4; ++q) s_ = __builtin_amdgcn_sdot4((int)rb[k][q], (int)hc[q], s_, false);
                        d[8 + k] = s_; }
#define GS_IX(v_, K_) __builtin_bit_cast(int, lane_xor<K_>(__builtin_bit_cast(float, v_)))
                    { const bool hb = (lane & 4) != 0;
#pragma unroll
                      for (int j = 0; j < 8; ++j) { const int keep = hb ? d[j + 8] : d[j], send = hb ? d[j] : d[j + 8]; d[j] = keep + GS_IX(send, 4); } }
                    { const bool hb = (lane & 2) != 0;
#pragma unroll
                      for (int j = 0; j < 4; ++j) { const int keep = hb ? d[j + 4] : d[j], send = hb ? d[j] : d[j + 4]; d[j] = keep + GS_IX(send, 2); } }
                    { const bool hb = (lane & 1) != 0;
#pragma unroll
                      for (int j = 0; j < 2; ++j) { const int keep = hb ? d[j + 2] : d[j], send = hb ? d[j] : d[j + 2]; d[j] = keep + GS_IX(send, 1); } }
#undef GS_IX
                    u32x2 o = {(unsigned)d[0], (unsigned)d[1]};
                    __builtin_nontemporal_store(o, (u32x2*)((int*)(ws + WS_PD) + ((size_t)p * M + row) * 128 + 2 * lane));
                } else {
                    int oi[16];
#pragma unroll
                    for (int k = 0; k < 16; ++k) oi[k] = 0;
#define GS_QUAD(rr_, qd_, wd_) do { _Pragma("unroll") for (int q_ = 0; q_ < 4; ++q_) { \
                        const unsigned r0_ = rr_[4 * (qd_) + 0][q_], r1_ = rr_[4 * (qd_) + 1][q_], r2_ = rr_[4 * (qd_) + 2][q_], r3_ = rr_[4 * (qd_) + 3][q_]; \
                        const unsigned t0_ = __builtin_amdgcn_perm(r1_, r0_, 0x05010400u), t1_ = __builtin_amdgcn_perm(r1_, r0_, 0x07030602u), t2_ = __builtin_amdgcn_perm(r3_, r2_, 0x05010400u), t3_ = __builtin_amdgcn_perm(r3_, r2_, 0x07030602u); \
                        oi[4 * q_ + 0] = __builtin_amdgcn_sdot4((int)__builtin_amdgcn_perm(t2_, t0_, 0x05040100u), (int)(wd_), oi[4 * q_ + 0], false); \
                        oi[4 * q_ + 1] = __builtin_amdgcn_sdot4((int)__builtin_amdgcn_perm(t2_, t0_, 0x07060302u), (int)(wd_), oi[4 * q_ + 1], false); \
                        oi[4 * q_ + 2] = __builtin_amdgcn_sdot4((int)__builtin_amdgcn_perm(t3_, t1_, 0x05040100u), (int)(wd_), oi[4 * q_ + 2], false); \
                        oi[4 * q_ + 3] = __builtin_amdgcn_sdot4((int)__builtin_amdgcn_perm(t3_, t1_, 0x07060302u), (int)(wd_), oi[4 * q_ + 3], false); } } while (0)
                    GS_QUAD(ra, 0, wc[0]); GS_QUAD(ra, 1, wc[1]);
                    GS_ROWS(ra, idn, 0);
                    GS_QUAD(rb, 0, wc[2]); GS_QUAD(rb, 1, wc[3]);
#undef GS_QUAD
                    float o[16];
#pragma unroll
                    for (int k = 0; k < 16; ++k) o[k] = (float)oi[k] * sc_c;
                    { const bool hb = (lane & 32) != 0;
#pragma unroll
                      for (int j = 0; j < 8; ++j) { const float keep = hb ? o[j + 8] : o[j], send = hb ? o[j] : o[j + 8]; o[j] = keep + lane_xor<32>(send); } }
                    { const bool hb = (lane & 16) != 0;
#pragma unroll
                      for (int j = 0; j < 4; ++j) { const float keep = hb ? o[j + 4] : o[j], send = hb ? o[j] : o[j + 4]; o[j] = keep + lane_xor<16>(send); } }
                    { const bool hb = (lane & 8) != 0;
#pragma unroll
                      for (int j = 0; j < 2; ++j) { const float keep = hb ? o[j + 2] : o[j], send = hb ? o[j] : o[j + 2]; o[j] = keep + lane_xor<8>(send); } }
                    const float corr = 0.f;
                    const int mrow = row < ML ? (row >= T ? 1 : 0) : 2;
                    const int col = 128 * p + 16 * i8 + 2 * g;
                    unsigned* xp = (unsigned*)((bf16_t*)(ws + WS_XB) + (size_t)row * D + col);
                    const unsigned xw = *xp; const f32x2 g2 = *(const f32x2*)(modl + mrow * 6144 + col);
                    const float x0 = bflo(xw) + g2[0] * (o[0] - corr), x1 = bfhi(xw) + g2[1] * (o[1] - corr);
                    if (l == DEPTH - 1) *(f32x2*)(a.out + (size_t)row * D + col) = (f32x2){x0, x1};
                    else *xp = pkbf_c(x0, x1);
                }
#pragma unroll
                for (int q = 0; q < 2; ++q) idc[q] = idn[q];
                if (PH) { wc = wn; sc_c = sc_n; } else hc = hn;
                GS_META(idn, wn, sc_n, hn, r2);
                if (++i == GS_ITEM) {
                    if (tnv >= nitem) break;
                    it = tnv; i = 0; tnv = 0x7fffffff;
                    if (lane == 0) tn = __hip_atomic_fetch_add(ctr, 1u, __ATOMIC_RELAXED, __HIP_MEMORY_SCOPE_AGENT);
                }
            }
#undef GS_META
#undef GS_ROWS
        }
    }
#undef a
}
__device__ __forceinline__ void phase_peer_weights(int l) {
    const KArgs ap = get_args();
#define a (*ap)
    const int tid = fresh_tid(), lane = tid & 63, wave = __builtin_amdgcn_readfirstlane(tid >> 6), G = fresh_g(), bx = fresh_bx();
    unsigned char* ws = a.ws;
    const int nrows = (l == DEPTH - 1) ? ML : M;
    const f32x2* SC2 = (const f32x2*)(ws + WS_USC) + (size_t)(l & 1) * NEXP;
    const int* PIDX = (const int*)(ws + WS_PIDX); const float* PGATE = (const float*)(ws + WS_PGATE);
    for (int row = wave * G + bx; row < nrows; row += G * 8) {
        const unsigned idw = *((const unsigned*)PIDX + (size_t)row * 64 + lane); const u32x2 id = {idw & 0xffffu, idw >> 16}; const f32x2 gt = *(const f32x2*)(PGATE + (size_t)row * 128 + 2 * lane);
        const float hsc = ((const float*)(ws + WS_GB))[row];
        int d0 = 0, d1 = 0;
#pragma unroll
        for (int p = 0; p < 8; ++p) { const u32x2 v = __builtin_nontemporal_load((const u32x2*)((const int*)(ws + WS_PD) + ((size_t)p * M + row) * 128 + 2 * lane)); d0 += (int)v[0]; d1 += (int)v[1]; }
        const f32x2 s0 = SC2[id[0]], s1 = SC2[id[1]];
        const float x0 = (float)d0 * (s0[0] * hsc), x1 = (float)d1 * (s1[0] * hsc);
        const float w0 = gt[0] * s0[1] * (0.5f * x0 * (1.f + erff(x0 * 0.70710678118654752f))), w1 = gt[1] * s1[1] * (0.5f * x1 * (1.f + erff(x1 * 0.70710678118654752f)));
        float mx = fmaxf(fabsf(w0), fabsf(w1));
        mx = fmaxf(mx, lane_xor<1>(mx)); mx = fmaxf(mx, lane_xor<2>(mx)); mx = fmaxf(mx, lane_xor<4>(mx));
        mx = fmaxf(mx, 1e-30f); const float inv = 127.f / mx;
        *(unsigned short*)(ws + WS_PW + (size_t)row * 128 + 2 * lane) = (unsigned short)(((unsigned)(int)rintf(w0 * inv) & 255u) | (((unsigned)(int)rintf(w1 * inv) & 255u) << 8));
        if ((lane & 7) == 0) ((float*)(ws + WS_PC))[(size_t)row * 8 + (lane >> 3)] = mx * (1.f / 127.f);
    }
#undef a
}

__global__ void __launch_bounds__(512, 2) fwd(Args a) {
    extern __shared__ __attribute__((aligned(16))) unsigned char lds_raw[];
    LAS unsigned char* lds = (LAS unsigned char*)lds_raw;
    volatile LAS unsigned* MISC = (volatile LAS unsigned*)(lds + LDS_MISC);
    if (threadIdx.x < 16) MISC[threadIdx.x] = 0u;
    __syncthreads();
    XcdBarrier bar; bar.bar = (unsigned*)(a.ws + WS_CTL) + 4096; bar.x = 0; bar.st = MISC + 8;
    bar = xcd_barrier_post((unsigned*)(a.ws + WS_CTL) + 4096, MISC + 8);
#ifndef PHASE_MASK
#define PHASE_MASK 0x1FFF
#endif
#define EN(i) ((PHASE_MASK >> (i)) & 1)
#ifndef REP_MASK
#define REP_MASK 0
#endif
#define REPN(i) (1 + ((REP_MASK >> (i)) & 1))
#define IN(k) true
#define SEAM(k) do { XcdBarrier b_; b_.bar = (unsigned*)(get_args()->ws + WS_CTL) + 4096; b_.x = xb_xcc_id(); b_.st = (volatile LAS unsigned*)(lds + LDS_MISC) + 8; xcd_barrier(b_); } while (0)
    for (int rep_ = 0; rep_ < (REPN(0)); ++rep_) if (EN(0) && IN(0)) phase_prologue(lds);
    SEAM(0);
#pragma unroll 1
    for (int l_ = 0; l_ < DEPTH; ++l_) {
        int l = l_; asm volatile("" : "+s"(l));
        const int pb = 1 + l * NPH_L;
        const int mrows = (l == DEPTH - 1) ? ML : M;
        if (l == 0) { for (int rep_ = 0; rep_ < (REPN(1)); ++rep_) if (EN(1) && IN(pb + 0)) { phase_norm<true>(l, 0, lds); phase_quant_weights(lds); }
            SEAM(pb + 0); }
        for (int rep_ = 0; rep_ < (REPN(2)); ++rep_) if (EN(2) && IN(pb + 1)) { const KArgs ap = get_args(); unsigned char* ws = ap->ws; pg8::Gemm g{(const bf16_t*)(ws + WS_H), (const bf16_t*)((const signed char*)(ws + WS_WINT) + (size_t)l * NP * 1024), M, NP, 512}; pg8::StaticOrder S; S.init(M, NP, fresh_g(), fresh_bx());
            pg8::EpiBf16I8 E{(bf16_t*)(ws + WS_P), NP, (const float*)(ws + WS_GB), (const float*)(ws + WS_CTL) + CW_WMAX + (l * 3 + 0) * 3072}; pg8::gemm_phase(lds, g, S, E); }
        SEAM(pb + 1);
        for (int rep_ = 0; rep_ < (REPN(3)); ++rep_) if (EN(3) && IN(pb + 2)) { phase_dn_chunkprep<1>(l, lds); phase_prep(l, lds); }
        for (int rep_ = 0; rep_ < (REPN(4)); ++rep_) if (EN(4) && IN(pb + 3)) phase_dn_chunkprep<0>(l, lds);
        SEAM(pb + 3);
        for (int rep_ = 0; rep_ < (REPN(5)); ++rep_) if (EN(5) && IN(pb + 4)) { phase_dn_scan<0>(l, lds); __syncthreads(); phase_attn(l, lds_raw, MISC, rep_); }
        SEAM(pb + 4);
        for (int rep_ = 0; rep_ < (REPN(7)); ++rep_) if (EN(7) && IN(pb + 5)) phase_dn_out(l);
        SEAM(pb + 5);
        if (EN(8) && IN(pb + 6)) { const KArgs ap = get_args(); unsigned char* ws = ap->ws; pg8::Gemm g{(const bf16_t*)(ws + WS_CATQ), (const bf16_t*)((const signed char*)(ws + WS_WOUTT) + (size_t)l * 1024 * 1024), mrows, 1024, 512}; pg8::StaticOrder S; S.init(mrows, 1024, fresh_g(), fresh_bx());
            pg8::EpiResI8 E{ap->in[I_X], ap->in[I_CTX], (bf16_t*)(ws + WS_XB), l == 0, (const float*)(ws + WS_MOD) + (size_t)l * 3 * 6144 + 2048,
                              (const float*)(ws + WS_GB) + (1u << 18), (const float*)(ws + WS_CTL) + CW_WMAX + (l * 3 + 1) * 3072};
            pg8::gemm_phase(lds, g, S, E); }
        SEAM(pb + 6);
        for (int rep_ = 0; rep_ < (REPN(9)); ++rep_) if (EN(9) && IN(pb + 7)) phase_norm<false>(l, 1, lds);
        SEAM(pb + 7);
        for (int rep_ = 0; rep_ < (REPN(10)); ++rep_) if (EN(10) && IN(pb + 8)) { const KArgs ap = get_args(); unsigned char* ws = ap->ws; pg8::Gemm g{(const bf16_t*)(ws + WS_H), (const bf16_t*)((const signed char*)(ws + WS_WQT) + (size_t)l * 2048 * 1024), mrows, 2048, 512}; pg8::StaticOrder S; S.init(mrows, 2048, fresh_g(), fresh_bx());
            pg8::EpiBf16I8 E{(bf16_t*)(ws + WS_P), 2048, (const float*)(ws + WS_GB), (const float*)(ws + WS_CTL) + CW_WMAX + (l * 3 + 2) * 3072}; pg8::gemm_phase(lds, g, S, E); }
        SEAM(pb + 8);
        for (int rep_ = 0; rep_ < (REPN(11)); ++rep_) if (EN(11) && IN(pb + 9)) phase_peer_select(l);
        SEAM(pb + 9);
        #ifdef GATHER_VAR
        if (EN(12) && IN(pb + 10)) phase_peer_gather<false, GATHER_VAR>(l, lds);
#endif
#if GATHER_PART == 2
        if (EN(12) && IN(pb + 10)) phase_peer_slice<0>(l, 0);
        SEAM(pb + 10);
        if (EN(12) && IN(pb + 10)) phase_peer_weights(l);
        SEAM(pb + 10);
        if (EN(12) && IN(pb + 10)) phase_peer_slice<1>(l, 0);
        if (l + 1 < DEPTH) { SEAM(pb + 10); if (EN(12) && IN(pb + 10)) phase_norm<true>(l + 1, 0, lds); }
#elif GATHER_PART
        if (EN(12) && IN(pb + 10)) phase_peer_gpart(l, lds);
        SEAM(pb + 10);
        if (EN(12) && IN(pb + 10)) phase_peer_combine(l, lds);
#else
        if (REPN(12) > 1 && EN(12) && IN(pb + 10)) phase_peer_gather<false>(l, lds);
        if (EN(12) && IN(pb + 10)) phase_peer_gather<true>(l, lds);
#endif
        if (l + 1 < DEPTH) SEAM(pb + 10);
    }
#undef IN
#undef SEAM
}

#ifndef N_LAUNCH_MODE
#define N_LAUNCH_MODE 1
#endif
extern "C" void kernel_launch(void* const* d_in, const int* in_sizes, int n_in, void* d_out, int out_size, void* d_ws, size_t ws_size, hipStream_t stream) {
    static int grid = 0;
    if (grid == 0) {
        if (n_in != 20 || out_size != ML * D || ws_size < WS_END) { fprintf(stderr, "kernel_launch: unexpected shapes: n_in %d out %d ws %zu (need %zu)\n", n_in, out_size, ws_size, (size_t)WS_END); grid = -1; return; }
        int dev = 0, cus = 0, per_cu = 0;
        if (hipGetDevice(&dev) != hipSuccess || hipDeviceGetAttribute(&cus, hipDeviceAttributeMultiprocessorCount, dev) != hipSuccess) { grid = -1; return; }
        if (hipFuncSetAttribute((const void*)fwd, hipFuncAttributeMaxDynamicSharedMemorySize, LDS_BYTES) != hipSuccess) { fprintf(stderr, "kernel_launch: hipFuncSetAttribute failed\n"); grid = -1; return; }
        if (hipOccupancyMaxActiveBlocksPerMultiprocessor(&per_cu, (const void*)fwd, 512, LDS_BYTES) != hipSuccess || per_cu < 1) fprintf(stderr, "kernel_launch: occupancy query says %d\n", per_cu);
        (void)hipGetLastError();
        grid = cus;
    }
    if (grid < 0) return;
    (void)hipMemsetAsync((char*)d_ws + WS_CTL, 0, CTL_BYTES, stream);
    Args a{};
    for (int i = 0; i < 20; ++i) a.in[i] = (const float*)d_in[i];
    a.out = (float*)d_out; a.ws = (unsigned char*)d_ws;
    a.ph_lo = 0; a.ph_hi = NPHASE;
    hipLaunchKernelGGL(fwd, dim3(grid), dim3(512), LDS_BYTES, stream, a);
    const hipError_t le = hipPeekAtLastError();
    if (le != hipSuccess) fprintf(stderr, "kernel_launch: launch failed: %s\n", hipGetErrorName(le));
}
```

```cpp
#include <hip/hip_runtime.h>
#ifndef GATHER_PART
#define GATHER_PART 2
#endif
#include <cstdio>
#include <cstdint>

#define GAS __attribute__((address_space(1)))
#define LAS __attribute__((address_space(3)))
typedef unsigned short bf16_t;
typedef short bf16x8 __attribute__((ext_vector_type(8)));
typedef short s16x4 __attribute__((ext_vector_type(4)));
typedef float f32x4 __attribute__((ext_vector_type(4)));
typedef float f32x2 __attribute__((ext_vector_type(2)));
typedef float f32x16 __attribute__((ext_vector_type(16)));
typedef unsigned u32x4 __attribute__((ext_vector_type(4)));
typedef unsigned u32x2 __attribute__((ext_vector_type(2)));
typedef int i32x4 __attribute__((ext_vector_type(4)));

constexpr int D = 1024, NB = 2, T = 16384, DEPTH = 4, CT = 256;
constexpr int ML = NB * T, MC = NB * CT, M = ML + MC;
constexpr int NIN = 3088, NP = 3072;
constexpr int KVLEN = T + CT;
constexpr int NEXP = 16384;
constexpr float EPS = 1e-6f;
constexpr int NPH_L = 11;
constexpr int NPHASE = 1 + DEPTH * NPH_L;

constexpr size_t MiB = 1u << 20;
constexpr size_t WS_CTL = 0, CTL_BYTES = 1 * MiB;
constexpr size_t WS_MOD = 1 * MiB;
constexpr size_t WS_ROPE = 2 * MiB;
constexpr size_t WS_WSK = 3 * MiB;
constexpr size_t WS_CTXX = 4 * MiB;
constexpr size_t WS_WINT = 8 * MiB;
constexpr size_t WS_WOUTT = 32 * MiB;
constexpr size_t WS_WQT = 40 * MiB;
constexpr size_t WS_SKB = 56 * MiB;
constexpr size_t WS_USC = 58 * MiB;
constexpr size_t WS_UB = 64 * MiB;
constexpr size_t WS_VB = 80 * MiB;
constexpr size_t TAB_SET = 32 * MiB;
constexpr size_t WS_H = 128 * MiB;
static_assert(WS_H + 2 * (size_t)M * 1024 <= 193 * MiB, "H + concat int8");
constexpr size_t WS_CATQ = WS_H + (size_t)M * 1024;
constexpr size_t WS_P = 193 * MiB;
constexpr size_t WS_QA = 388 * MiB;
constexpr size_t WS_KA = 421 * MiB;
constexpr size_t WS_VA = 438 * MiB;
constexpr size_t WS_CAT = 455 * MiB;
constexpr size_t WS_DQ = 520 * MiB;
constexpr size_t WS_DK = 553 * MiB;
constexpr size_t WS_DV = 586 * MiB;
constexpr size_t WS_OF = 619 * MiB;
constexpr size_t WS_OB = WS_OF + (size_t)M * 1024;
constexpr size_t WS_XB = WS_OB + (size_t)M * 1024;
static_assert(WS_OB + (size_t)M * 1024 <= WS_XB && WS_XB + (size_t)M * 2048 <= 749 * MiB, "OF/OB/XB");
constexpr size_t WS_GB = 749 * MiB;
constexpr size_t WS_BA = 752 * MiB;
constexpr size_t WS_PIDX = 755 * MiB;
constexpr size_t WS_PGATE = 772 * MiB;
constexpr size_t WS_REC = 789 * MiB;
constexpr size_t WS_END = 990 * MiB;
constexpr int CW_WMAX = 65536;
constexpr int NCH = 260;
constexpr int REC_K = 0, REC_KT = 16384, REC_Q = 32768, REC_V = 49152, REC_DIR = 65536, REC_DIRSZ = 17408, REC_BYTES = REC_DIR + 2 * REC_DIRSZ;
static_assert((size_t)NB * 4 * NCH * REC_BYTES + WS_REC <= WS_END, "rec region");

constexpr int LDS_BYTES = 163840;
constexpr int LDS_MISC = 163840 - 256;

__device__ __forceinline__ float bf2f(unsigned b) { return __uint_as_float(b << 16); }
__device__ __forceinline__ float bflo(unsigned w) { return __uint_as_float(w << 16); }
__device__ __forceinline__ float bfhi(unsigned w) { return __uint_as_float(w & 0xffff0000u); }
typedef __bf16 bf2v __attribute__((ext_vector_type(2)));
__device__ __forceinline__ unsigned pkbf(float lo, float hi) { unsigned r; asm("v_cvt_pk_bf16_f32 %0, %1, %2" : "=v"(r) : "v"(lo), "v"(hi)); return r; }
__device__ __forceinline__ unsigned pkbf_c(float lo, float hi) { f32x2 v = {lo, hi}; bf2v r = __builtin_convertvector(v, bf2v); return __builtin_bit_cast(unsigned, r); }
template <int K> __device__ __forceinline__ float lane_xor(float v) {
    const int b = __builtin_bit_cast(int, v);
    if constexpr (K == 1) return __builtin_bit_cast(float, __builtin_amdgcn_update_dpp(0, b, 0xB1, 0xF, 0xF, true));
    else if constexpr (K == 2) return __builtin_bit_cast(float, __builtin_amdgcn_update_dpp(0, b, 0x4E, 0xF, 0xF, true));
    else if constexpr (K == 32) { auto rr = __builtin_amdgcn_permlane32_swap((unsigned)b, (unsigned)b, false, false); unsigned ln_ = __builtin_amdgcn_mbcnt_hi(~0u, __builtin_amdgcn_mbcnt_lo(~0u, 0u)); asm volatile("" : "+v"(ln_));
        return __uint_as_float((ln_ & 32u) ? rr[0] : rr[1]); }
    else return __builtin_bit_cast(float, __builtin_amdgcn_ds_swizzle(b, 0x1F | (K << 10)));
}
__device__ __forceinline__ float wave_sum(float v) {
    v += lane_xor<1>(v); v += lane_xor<2>(v);
    v += __builtin_bit_cast(float, __builtin_amdgcn_update_dpp(0, __builtin_bit_cast(int, v), 0x124, 0xF, 0xF, true));
    v += __builtin_bit_cast(float, __builtin_amdgcn_update_dpp(0, __builtin_bit_cast(int, v), 0x128, 0xF, 0xF, true));
    v += lane_xor<16>(v);
    { auto rr = __builtin_amdgcn_permlane32_swap(__float_as_uint(v), __float_as_uint(v), false, false); v = __uint_as_float(rr[0]) + __uint_as_float(rr[1]); }
    return v;
}
__device__ __forceinline__ float wave_max(float v) {
    v = fmaxf(v, lane_xor<1>(v)); v = fmaxf(v, lane_xor<2>(v));
    v = fmaxf(v, __builtin_bit_cast(float, __builtin_amdgcn_update_dpp(0, __builtin_bit_cast(int, v), 0x124, 0xF, 0xF, true)));
    v = fmaxf(v, __builtin_bit_cast(float, __builtin_amdgcn_update_dpp(0, __builtin_bit_cast(int, v), 0x128, 0xF, 0xF, true)));
    v = fmaxf(v, lane_xor<16>(v));
    { auto rr = __builtin_amdgcn_permlane32_swap(__float_as_uint(v), __float_as_uint(v), false, false); v = fmaxf(__uint_as_float(rr[0]), __uint_as_float(rr[1])); }
    return v;
}
__device__ __forceinline__ float silu_f(float x) { return x / (1.f + __expf(-x)); }
#define LDS_WAIT() asm volatile("s_waitcnt lgkmcnt(0)" ::: "memory")

#define XB_TMO      128
#define XB_XCNT(j)  (256  + 64 * (j))
#define XB_XSUB(j)  (1280 + 64 * (j))
#define XB_XGEN(j)  (2304 + 64 * (j))
#define XB_TOP      3328
#define XB_TOPGEN   3392
#define XCD_BAR_WORDS 3456
#define XB_SPIN_CAP (1u << 22)
__device__ __forceinline__ unsigned xb_ld(unsigned* p)              { return __hip_atomic_load(p, __ATOMIC_RELAXED, __HIP_MEMORY_SCOPE_AGENT); }
__device__ __forceinline__ unsigned xb_add(unsigned* p, unsigned v) { return __hip_atomic_fetch_add(p, v, __ATOMIC_RELAXED, __HIP_MEMORY_SCOPE_AGENT); }
__device__ __forceinline__ unsigned xb_xcc_id() { return (unsigned)__builtin_amdgcn_s_getreg((3 << 11) | 20) & 0xFu; }
#define XB_SPIN(cond, bar) do { unsigned _sp = 0; while (cond) { __builtin_amdgcn_s_sleep(1); \
    if ((++_sp & 255u) == 0u) { if (xb_ld(&(bar)[XB_TMO])) break; if (_sp > XB_SPIN_CAP) { atomicAdd(&(bar)[XB_TMO], 1u); break; } } } } while (0)
struct XcdBarrier { unsigned* bar; unsigned x; volatile LAS unsigned* st; };
__device__ __forceinline__ XcdBarrier xcd_barrier_post(unsigned* bar, volatile LAS unsigned* st) {
    XcdBarrier b; b.bar = bar; b.x = xb_xcc_id(); b.st = st;
    if (threadIdx.x == 0) (void)xb_add(&bar[XB_XCNT(b.x)], 1u);
    return b;
}
__device__ __forceinline__ void xcd_barrier_complete(unsigned* bar, unsigned x, unsigned& nloc, unsigned& nx) {
    const unsigned G = gridDim.x * gridDim.y * gridDim.z;
    unsigned sum, cnt, mine, sp = 0u;
    for (;;) {
        sum = 0u; cnt = 0u; mine = 0u;
#pragma unroll
        for (unsigned j = 0; j < 16; ++j) { const unsigned c = xb_ld(&bar[XB_XCNT(j)]); sum += c; cnt += (c > 0u) ? 1u : 0u; mine = (j == x) ? c : mine; }
        if (sum == G) break;
        __builtin_amdgcn_s_sleep(1);
        if ((++sp & 255u) == 0u) { if (xb_ld(&bar[XB_TMO])) break; if (sp > XB_SPIN_CAP) { atomicAdd(&bar[XB_TMO], 1u); break; } }
    }
    nloc = mine > 0u ? mine : 1u; nx = cnt > 0u ? cnt : 1u;
}
__device__ __forceinline__ void xcd_barrier(const XcdBarrier& b) {
    asm volatile("s_waitcnt vmcnt(0)" ::: "memory");
    __syncthreads();
    if (threadIdx.x == 0) {
        unsigned* bar = b.bar; unsigned bx_ = b.x;
        asm volatile("" : "+s"(bar), "+s"(bx_));
        __builtin_amdgcn_s_waitcnt(0);
        unsigned nloc = b.st[0], nx = b.st[1];
        if (nloc == 0u) { xcd_barrier_complete(bar, bx_, nloc, nx); b.st[0] = nloc; b.st[1] = nx; }
        const unsigned old = xb_add(&bar[XB_XSUB(bx_)], 1u);
        const unsigned gen = old / nloc;
        if (old + 1u == (gen + 1u) * nloc) {
            __builtin_amdgcn_fence(__ATOMIC_RELEASE, "agent");
            asm volatile("s_waitcnt vmcnt(0)" ::: "memory");
            const unsigned og = xb_add(&bar[XB_TOP], 1u);
            const unsigned tg = og / nx;
            if (og + 1u == (tg + 1u) * nx) xb_add(&bar[XB_TOPGEN], 1u);
            else XB_SPIN(xb_ld(&bar[XB_TOPGEN]) == tg, bar);
            __builtin_amdgcn_fence(__ATOMIC_ACQUIRE, "agent");
            xb_add(&bar[XB_XGEN(bx_)], 1u);
            asm volatile("s_waitcnt vmcnt(0)" ::: "memory");
        } else {
            XB_SPIN(xb_ld(&bar[XB_XGEN(bx_)]) == gen, bar);
            __builtin_amdgcn_fence(__ATOMIC_ACQUIRE, "agent");
            asm volatile("s_waitcnt vmcnt(0)" ::: "memory");
        }
    }
    __syncthreads();
}

namespace pg8 {
constexpr int BM = 256, BK = 64, HALF = 128, HTB = HALF * BK * 2, STAGE_BYTES = 8 * HTB, NXCD = 8, WGM = 8;
__host__ __device__ __forceinline__ int lds_byte(int r, int c) { const int st = (r >> 4) * 2 + (c >> 5), rr = r & 15, cc = c & 31, ob = rr * 64 + cc * 2; return st * 1024 + (ob ^ (((ob >> 9) & 1) << 5)); }
__host__ __device__ __forceinline__ void stage_rc(int b, int& R, int& C) { const int st = b / 1024, sb = b % 1024, swz = sb ^ (((sb >> 9) & 1) << 5); R = (st >> 1) * 16 + swz / 64; C = (st & 1) * 32 + (swz % 64) / 2; }
__host__ __device__ __forceinline__ int perm32(int rho) { const int n = rho >> 4, i = rho & 15; return 8 * (i >> 2) + 4 * n + (i & 3); }
struct Unit { int pm, pn; };
struct Gemm { const bf16_t* A; const bf16_t* Bt; int M, N, K; };
struct StaticOrder {
    int nM, nN, nwg, G, c;
    __host__ __device__ void init(int M_, int N_, int G_, int c_) { nM = M_ / BM; nN = N_ / BM; nwg = nM * nN; G = G_; c = c_; }
    __host__ __device__ bool next(int i, Unit& u) const {
        const long L = (long)i * G + c; if (L >= nwg) return false;
        int wgid = (int)L; { const int q = nwg / NXCD, r = nwg % NXCD, xcd = wgid % NXCD, off = wgid / NXCD; wgid = (xcd < r ? xcd * (q + 1) : r * (q + 1) + (xcd - r) * q) + off; }
        const int nig = WGM * nN, gid = wgid / nig, fm = gid * WGM, gsz = (nM - fm) < WGM ? (nM - fm) : WGM;
        u.pm = fm + ((wgid % nig) % gsz); u.pn = (wgid % nig) / gsz; return true;
    }
    __device__ __forceinline__ void a_ready(const Unit&) const {}
    __device__ __forceinline__ void done(const Unit&) const {}
};
struct EpiBf16 {
    static constexpr bool PERM = true, I8 = false; typedef f32x4 acc_t;
    bf16_t* O; int ldc;
    __device__ __forceinline__ void operator()(const f32x4 (&acc)[2][2][4][2], const Unit& u, int wr, int wc, int fr, int fq) const {
        const int row0 = u.pm * BM + wr * 64 + fr; const int col0 = u.pn * BM + wc * 32 + 8 * fq;
#pragma unroll
        for (int ai = 0; ai < 2; ++ai)
#pragma unroll
            for (int m = 0; m < 4; ++m) { bf16_t* rowp = O + (size_t)(row0 + ai * HALF + m * 16) * ldc + col0;
#pragma unroll
                for (int bj = 0; bj < 2; ++bj) { const f32x4 v0 = acc[ai][bj][m][0], v1 = acc[ai][bj][m][1];
                    u32x4 w; w.x = pkbf_c(v0[0], v0[1]); w.y = pkbf_c(v0[2], v0[3]); w.z = pkbf_c(v1[0], v1[1]); w.w = pkbf_c(v1[2], v1[3]);
                    *(u32x4*)(rowp + bj * HALF) = w; } }
    }
};
struct EpiBf16I8 {
    static constexpr bool PERM = true, I8 = true; typedef i32x4 acc_t;
    bf16_t* O; int ldc; const float* sa; const float* wmax;
    __device__ __forceinline__ void operator()(const i32x4 (&acc)[2][2][4][2], const Unit& u, int wr, int wc, int fr, int fq) const {
        const int row0 = u.pm * BM + wr * 64 + fr; const int col0 = u.pn * BM + wc * 32 + 8 * fq;
        f32x4 sw[2][2];
#pragma unroll
        for (int bj = 0; bj < 2; ++bj)
#pragma unroll
            for (int n = 0; n < 2; ++n) sw[bj][n] = *(const f32x4*)(wmax + col0 + bj * HALF + 4 * n) * (1.f / 127.f);
#pragma unroll
        for (int ai = 0; ai < 2; ++ai)
#pragma unroll
            for (int m = 0; m < 4; ++m) { const int row = row0 + ai * HALF + m * 16; const float sr = sa[row]; bf16_t* rowp = O + (size_t)row * ldc + col0;
#pragma unroll
                for (int bj = 0; bj < 2; ++bj) { const i32x4 a0 = acc[ai][bj][m][0], a1 = acc[ai][bj][m][1];
                    const f32x4 v0 = (f32x4){(float)a0[0], (float)a0[1], (float)a0[2], (float)a0[3]} * sw[bj][0] * sr, v1 = (f32x4){(float)a1[0], (float)a1[1], (float)a1[2], (float)a1[3]} * sw[bj][1] * sr;
                    u32x4 w; w.x = pkbf(v0[0], v0[1]); w.y = pkbf(v0[2], v0[3]); w.z = pkbf(v1[0], v1[1]); w.w = pkbf(v1[2], v1[3]);
                    *(u32x4*)(rowp + bj * HALF) = w; } }
    }
};
struct EpiRes {
    static constexpr bool PERM = false, I8 = false; typedef f32x4 acc_t;
    const float* src_lat; const float* src_ctx; float* dst_lat; float* dst_ctx; const float* gate;
    __device__ __forceinline__ void operator()(const f32x4 (&acc)[2][2][4][2], const Unit& u, int wr, int wc, int fr, int fq) const {
        const bool isctx = u.pm >= (ML / BM);
        const float* src = isctx ? src_ctx + (size_t)(u.pm - ML / BM) * BM * D : src_lat + (size_t)u.pm * BM * D;
        float* dst = isctx ? dst_ctx + (size_t)(u.pm - ML / BM) * BM * D : dst_lat + (size_t)u.pm * BM * D;
        const int mrow = isctx ? 2 : (u.pm >= (T / BM) ? 1 : 0);
        const int row0 = wr * 64 + fr, col0 = u.pn * BM + wc * 32 + 4 * fq;
        f32x4 gv[2][2];
#pragma unroll
        for (int bj = 0; bj < 2; ++bj)
#pragma unroll
            for (int n = 0; n < 2; ++n) gv[bj][n] = *(const f32x4*)(gate + mrow * 6144 + col0 + bj * HALF + n * 16);
#pragma unroll
        for (int ai = 0; ai < 2; ++ai)
#pragma unroll
            for (int m = 0; m < 4; ++m) { const size_t off = (size_t)(row0 + ai * HALF + m * 16) * D + col0;
#pragma unroll
                for (int bj = 0; bj < 2; ++bj)
#pragma unroll
                    for (int n = 0; n < 2; ++n) { const f32x4 s = *(const f32x4*)(src + off + bj * HALF + n * 16);
                        *(f32x4*)(dst + off + bj * HALF + n * 16) = s + gv[bj][n] * acc[ai][bj][m][n]; } }
    }
};

struct EpiResI8 {
    static constexpr bool PERM = false, I8 = true; typedef i32x4 acc_t;
    const float* src_lat; const float* src_ctx; bf16_t* xb; bool first; const float* gate; const float* sa; const float* wmax;
    __device__ __forceinline__ void operator()(const i32x4 (&acc)[2][2][4][2], const Unit& u, int wr, int wc, int fr, int fq) const {
        const bool isctx = u.pm >= (ML / BM);
        const float* src = isctx ? src_ctx + (size_t)(u.pm - ML / BM) * BM * D : src_lat + (size_t)u.pm * BM * D;
        bf16_t* dst = xb + (size_t)u.pm * BM * D;
        const int mrow = isctx ? 2 : (u.pm >= (T / BM) ? 1 : 0);
        const int row0 = wr * 64 + fr, col0 = u.pn * BM + wc * 32 + 4 * fq;
        f32x4 gv[2][2];
#pragma unroll
        for (int bj = 0; bj < 2; ++bj)
#pragma unroll
            for (int n = 0; n < 2; ++n) gv[bj][n] = *(const f32x4*)(gate + mrow * 6144 + col0 + bj * HALF + n * 16) * *(const f32x4*)(wmax + col0 + bj * HALF + n * 16) * (1.f / 127.f);
#pragma unroll
        for (int ai = 0; ai < 2; ++ai)
#pragma unroll
            for (int m = 0; m < 4; ++m) { const int rl = row0 + ai * HALF + m * 16; const float sr = sa[u.pm * BM + rl]; const size_t off = (size_t)rl * D + col0;
#pragma unroll
                for (int bj = 0; bj < 2; ++bj)
#pragma unroll
                    for (int n = 0; n < 2; ++n) { const i32x4 ac = acc[ai][bj][m][n]; f32x4 sv;
                        if (first) sv = *(const f32x4*)(src + off + bj * HALF + n * 16);
                        else { const u32x2 w_ = *(const u32x2*)(dst + off + bj * HALF + n * 16); sv = (f32x4){bflo(w_[0]), bfhi(w_[0]), bflo(w_[1]), bfhi(w_[1])}; }
                        const f32x4 r_ = sv + gv[bj][n] * ((f32x4){(float)ac[0], (float)ac[1], (float)ac[2], (float)ac[3]} * sr);
                        *(u32x2*)(dst + off + bj * HALF + n * 16) = (u32x2){pkbf(r_[0], r_[1]), pkbf(r_[2], r_[3])}; } }
    }
};
template <class Epi, class Sched>
__device__ __forceinline__ void gemm_phase(LAS unsigned char* lds, const Gemm g, const Sched& S, const Epi& E) {
    constexpr bool I8 = Epi::I8;
    typedef typename Epi::acc_t acc_t;
    int tid = threadIdx.x; asm volatile("" : "+v"(tid)); const int wid = __builtin_amdgcn_readfirstlane(tid >> 6), lane = tid & 63, wr = wid >> 2, wc = wid & 3, fr = lane & 15, fq = lane >> 4;
    const int K = g.K, nt = K / BK;
    unsigned voffA[2], voffB[2];
#pragma unroll
    for (int i = 0; i < 2; ++i) { int R, C; stage_rc(tid * 16 + i * 8192, R, C); const int Rb = Epi::PERM ? ((R & ~31) + perm32(R & 31)) : R;
        voffA[i] = (unsigned)(R * K + C) * 2u; voffB[i] = (unsigned)(Rb * K + C) * 2u; }
    const size_t kstep = (size_t)(BK * 2);
    const size_t hstep = (size_t)HALF * K * 2;
    const size_t tstep = 2 * hstep;
    const unsigned ldsw = (unsigned)wid * 1024u;
    const int aoff = lds_byte(wr * 64 + fr, fq * 8), boff = lds_byte(wc * 32 + fr, fq * 8);
#define PG8_SA(b, h) (((b) * 2 + (h)) * HTB)
#define PG8_SB(b, h) ((4 + (b) * 2 + (h)) * HTB)
#define PG8_STAGE(bufoff, gbase, voff) do { _Pragma("unroll") for (int _i = 0; _i < 2; ++_i) \
        __builtin_amdgcn_global_load_lds((const unsigned*)((const char*)(gbase) + (voff)[_i]), (LAS unsigned*)(lds + (bufoff) + ldsw + _i * 8192), 16, 0, 0); } while (0)
#define PG8_LDA(dst, b, h) do { _Pragma("unroll") for (int m = 0; m < 4; ++m) _Pragma("unroll") for (int k = 0; k < 2; ++k) dst[m][k] = *(const LAS bf16x8*)(lds + PG8_SA(b, h) + aoff + m * 2048 + k * 1024); } while (0)
#define PG8_LDB(dst, b, h) do { _Pragma("unroll") for (int n = 0; n < 2; ++n) _Pragma("unroll") for (int k = 0; k < 2; ++k) dst[n][k] = *(const LAS bf16x8*)(lds + PG8_SB(b, h) + boff + n * 2048 + k * 1024); } while (0)
#define PG8_MMA(ai, bj, At, Bt) do { __builtin_amdgcn_s_setprio(1); _Pragma("unroll") for (int m = 0; m < 4; ++m) _Pragma("unroll") for (int n = 0; n < 2; ++n) _Pragma("unroll") for (int k = 0; k < 2; ++k) \
        { if constexpr (I8) acc[ai][bj][m][n] = __builtin_bit_cast(acc_t, __builtin_amdgcn_mfma_i32_16x16x64_i8(__builtin_bit_cast(i32x4, Bt[n][k]), __builtin_bit_cast(i32x4, At[m][k]), __builtin_bit_cast(i32x4, acc[ai][bj][m][n]), 0, 0, 0)); \
          else acc[ai][bj][m][n] = __builtin_bit_cast(acc_t, __builtin_amdgcn_mfma_f32_16x16x32_bf16(Bt[n][k], At[m][k], __builtin_bit_cast(f32x4, acc[ai][bj][m][n]), 0, 0, 0)); } __builtin_amdgcn_s_setprio(0); } while (0)
#define PG8_WAIT_V(n) asm volatile("s_waitcnt vmcnt(" #n ")" ::: "memory")
#define PG8_WAIT_L(n) asm volatile("s_waitcnt lgkmcnt(" #n ")" ::: "memory")
#define PG8_BAR __builtin_amdgcn_s_barrier()
#define PG8_SCHED __builtin_amdgcn_sched_barrier(0)
    Unit cur, nxt; int ui = 0;
    if (!S.next(0, cur)) return;
    acc_t acc[2][2][4][2];
#pragma unroll
    for (int a = 0; a < 2; ++a)
#pragma unroll
        for (int b = 0; b < 2; ++b)
#pragma unroll
            for (int m = 0; m < 4; ++m)
#pragma unroll
                for (int n = 0; n < 2; ++n) acc[a][b][m][n] = acc_t{};
    bf16x8 At[4][2], B0[2][2], B1[2][2];
    const char* cA = (const char*)g.A + (size_t)cur.pm * tstep; const char* cB = (const char*)g.Bt + (size_t)cur.pn * tstep;
    S.a_ready(cur);
    PG8_STAGE(PG8_SB(0, 0), cB, voffB); PG8_STAGE(PG8_SA(0, 0), cA, voffA); PG8_STAGE(PG8_SB(0, 1), cB + hstep, voffB); PG8_STAGE(PG8_SA(0, 1), cA + hstep, voffA);
    if (wr == 1) PG8_BAR;
    PG8_WAIT_V(4); PG8_BAR;
    PG8_STAGE(PG8_SB(1, 0), cB + kstep, voffB); PG8_STAGE(PG8_SA(1, 0), cA + kstep, voffA); PG8_STAGE(PG8_SB(1, 1), cB + hstep + kstep, voffB);
    PG8_WAIT_V(6); PG8_BAR;
    for (;;) {
        const bool has_next = S.next(ui + 1, nxt);
        const char* nA = has_next ? (const char*)g.A + (size_t)nxt.pm * tstep : cA; const char* nB = has_next ? (const char*)g.Bt + (size_t)nxt.pn * tstep : cB;
        for (int t = 0; t < nt; t += 2) {
            const bool last = (t == nt - 2);
            const char* a1 = cA + (size_t)(t + 1) * kstep;
            const char* a2 = last ? nA : cA + (size_t)(t + 2) * kstep; const char* b2 = last ? nB : cB + (size_t)(t + 2) * kstep;
            const char* a3 = a2 + kstep; const char* b3 = b2 + kstep;
            if (last && has_next) S.a_ready(nxt);
            PG8_LDB(B0, 0, 0); PG8_SCHED; PG8_LDA(At, 0, 0); PG8_STAGE(PG8_SA(1, 1), a1 + hstep, voffA);
            PG8_WAIT_L(8); PG8_BAR; PG8_WAIT_L(0); PG8_MMA(0, 0, At, B0); PG8_BAR; PG8_SCHED;
            PG8_LDB(B1, 0, 1); PG8_STAGE(PG8_SB(0, 0), b2, voffB);
            PG8_BAR; PG8_WAIT_L(0); PG8_MMA(0, 1, At, B1); PG8_BAR;
            PG8_LDA(At, 0, 1); PG8_STAGE(PG8_SA(0, 0), a2, voffA);
            PG8_BAR; PG8_WAIT_L(0); PG8_MMA(1, 0, At, B0); PG8_BAR; PG8_SCHED;
            PG8_STAGE(PG8_SB(0, 1), b2 + hstep, voffB);
            PG8_WAIT_V(6); PG8_BAR; PG8_MMA(1, 1, At, B1); PG8_BAR;
            PG8_LDB(B0, 1, 0); PG8_SCHED; PG8_LDA(At, 1, 0); PG8_STAGE(PG8_SA(0, 1), a2 + hstep, voffA);
            PG8_WAIT_L(8); PG8_BAR; PG8_WAIT_L(0); PG8_MMA(0, 0, At, B0); PG8_BAR; PG8_SCHED;
            PG8_LDB(B1, 1, 1); PG8_STAGE(PG8_SB(1, 0), b3, voffB);
            PG8_BAR; PG8_WAIT_L(0); PG8_MMA(0, 1, At, B1); PG8_BAR;
            PG8_LDA(At, 1, 1); PG8_STAGE(PG8_SA(1, 0), a3, voffA);
            PG8_BAR; PG8_WAIT_L(0); PG8_MMA(1, 0, At, B0); PG8_BAR; PG8_SCHED;
            PG8_STAGE(PG8_SB(1, 1), b3 + hstep, voffB);
            PG8_WAIT_V(6); PG8_BAR; PG8_MMA(1, 1, At, B1); PG8_BAR;
        }
        E(acc, cur, wr, wc, fr, fq); S.done(cur);
        if (!has_next) break;
#pragma unroll
        for (int a = 0; a < 2; ++a)
#pragma unroll
            for (int b = 0; b < 2; ++b)
#pragma unroll
                for (int m = 0; m < 4; ++m)
#pragma unroll
                    for (int n = 0; n < 2; ++n) acc[a][b][m][n] = acc_t{};
        cur = nxt; cA = nA; cB = nB; ++ui;
    }
    PG8_WAIT_V(0);
    if (wr == 0) PG8_BAR;
    PG8_BAR;
#undef PG8_SA
#undef PG8_SB
#undef PG8_STAGE
#undef PG8_LDA
#undef PG8_LDB
#undef PG8_MMA
#undef PG8_WAIT_V
#undef PG8_WAIT_L
#undef PG8_BAR
#undef PG8_SCHED
}
}

namespace att {
constexpr int HD = 128, NW = 8, QBLK = 32, KVBLK = 64;
constexpr float SCALE = 0.088388347648318440f;
constexpr float THR = 8.f;
constexpr int LDQ = 512, LDK = 256;
constexpr size_t SHM_V = KVBLK * HD * 2, SHM_K = KVBLK * HD * 2, SHM_ATTN = 2 * SHM_V + 2 * SHM_K + NW * 64 * 4;
#define KSWZ(row, colB) ((row) * 256 + ((colB) ^ (((row) & 7) << 4)))
#define SBAR() __builtin_amdgcn_sched_barrier(0)
__device__ __forceinline__ int crow(int r, int hi) { return (r & 3) + 8 * (r >> 2) + 4 * hi; }
__device__ __forceinline__ unsigned cvtpk(float lo, float hi) { unsigned r; asm volatile("v_cvt_pk_bf16_f32 %0, %1, %2" : "=v"(r) : "v"(lo), "v"(hi)); return r; }
__device__ __forceinline__ void partialSM(f32x16& p0, f32x16& p1) {
  for (int r = 0; r < 16; ++r) p0[r] = __builtin_amdgcn_exp2f(p0[r]);
}
typedef int i32x8 __attribute__((ext_vector_type(8)));
__device__ __forceinline__ void finishSM(f32x16& p0, f32x16& p1, i32x8& pa) {
  for (int r = 0; r < 16; ++r) p1[r] = __builtin_amdgcn_exp2f(p1[r]);
#pragma unroll
  for (int q = 0; q < 4; ++q) { int w = __builtin_amdgcn_cvt_pk_bf8_f32(p0[4 * q], p0[4 * q + 1], 0, false); w = __builtin_amdgcn_cvt_pk_bf8_f32(p0[4 * q + 2], p0[4 * q + 3], w, true); pa[q] = w;
    int w2 = __builtin_amdgcn_cvt_pk_bf8_f32(p1[4 * q], p1[4 * q + 1], 0, false); w2 = __builtin_amdgcn_cvt_pk_bf8_f32(p1[4 * q + 2], p1[4 * q + 3], w2, true); pa[4 + q] = w2; }
}
constexpr int K8_STRIDE = 144, K8_TILE = KVBLK * K8_STRIDE;
__device__ __forceinline__ void qkt(f32x16& p0, f32x16& p1, const unsigned char* Ks, const i32x8* qr, int r32, int hi, const f32x16& cinit) {
  p0 = cinit; p1 = cinit;
#pragma unroll
  for (int ks = 0; ks < 2; ++ks) {
    const u32x4* a0 = (const u32x4*)(Ks + r32 * K8_STRIDE + 64 * ks + 32 * hi); const u32x4* a1 = (const u32x4*)(Ks + (32 + r32) * K8_STRIDE + 64 * ks + 32 * hi);
    const u32x4 x0 = a0[0], x1 = a0[1], y0 = a1[0], y1 = a1[1];
    const i32x8 k0 = {(int)x0.x, (int)x0.y, (int)x0.z, (int)x0.w, (int)x1.x, (int)x1.y, (int)x1.z, (int)x1.w}, k1 = {(int)y0.x, (int)y0.y, (int)y0.z, (int)y0.w, (int)y1.x, (int)y1.y, (int)y1.z, (int)y1.w};
    p0 = __builtin_amdgcn_mfma_scale_f32_32x32x64_f8f6f4(k0, qr[ks], p0, 0, 0, 0, 0x7F7F7F7F, 0, 0x7C7C7C7C);
    p1 = __builtin_amdgcn_mfma_scale_f32_32x32x64_f8f6f4(k1, qr[ks], p1, 0, 0, 0, 0x7F7F7F7F, 0, 0x7C7C7C7C); }
}
constexpr int V8_STRIDE = 80, V8_TILE = HD * V8_STRIDE;
__device__ __forceinline__ void pv_d0(f32x16* o, f32x16& ol, const unsigned char* Vs, const i32x8& pa, int r32, int hi) {
  { const i32x8 ones = {0x38383838, 0x38383838, 0x38383838, 0x38383838, 0x38383838, 0x38383838, 0x38383838, 0x38383838};
    ol = __builtin_amdgcn_mfma_scale_f32_32x32x64_f8f6f4(pa, ones, ol, 1, 0, 0, 0x7F7F7F7F, 0, 0x7F7F7F7F); }
#pragma unroll
  for (int d0 = 0; d0 < 4; ++d0) { const u32x4* bp = (const u32x4*)(Vs + (32 * d0 + r32) * V8_STRIDE + 32 * hi); const u32x4 x0 = bp[0], x1 = bp[1];
    const i32x8 vb = {(int)x0.x, (int)x0.y, (int)x0.z, (int)x0.w, (int)x1.x, (int)x1.y, (int)x1.z, (int)x1.w};
    o[d0] = __builtin_amdgcn_mfma_scale_f32_32x32x64_f8f6f4(pa, vb, o[d0], 1  , 0  , 0, 0x7F7F7F7F, 0, 0x7F7F7F7F); }
}
__device__ __forceinline__ void attn_dense_body(const unsigned char* __restrict__ Qb, const unsigned char* __restrict__ Kh, const unsigned char* __restrict__ Vt,
                                                bf16_t* __restrict__ Ob, int LDO, int seq, char* lds, float* __restrict__ lse, float braw) {
  int tid = threadIdx.x; asm volatile("" : "+v"(tid)); const int wid = tid >> 6, lane = tid & 63, r32 = lane & 31, hi = lane >> 5;
  unsigned char* V_lds = (unsigned char*)lds; unsigned char* K_lds = (unsigned char*)(lds + 3 * V8_TILE);
  f32x16 o[4] = {}, ol = {}; i32x8 qr[2];
  const float mnC = __builtin_bit_cast(float, __builtin_amdgcn_readfirstlane(__builtin_bit_cast(int, -fmaxf(braw * (SCALE * 1.4426950408889634f) - 15.5f, 0.f))));
  f32x16 cinit;
#pragma unroll
  for (int r = 0; r < 16; ++r) cinit[r] = mnC;
  const unsigned char* Qw = Qb + (long)(wid * QBLK + r32) * LDQ + hi * 32;
#pragma unroll
  for (int ks = 0; ks < 2; ++ks) { const u32x4 x0 = *(const u32x4*)(Qw + 64 * ks), x1 = *(const u32x4*)(Qw + 64 * ks + 16);
    qr[ks] = (i32x8){(int)x0.x, (int)x0.y, (int)x0.z, (int)x0.w, (int)x1.x, (int)x1.y, (int)x1.z, (int)x1.w}; }
  const int krow = tid >> 3, kch = tid & 7;
  const int vrow = tid >> 2, vch = tid & 3;
  struct { u32x4 v8, k8; } sr_[2];
#define SLOAD(i, k0) do { sr_[i].v8 = *reinterpret_cast<const u32x4*>(Vt + (long)((k0) >> 6) * 8192 + tid * 16); \
    sr_[i].k8 = *reinterpret_cast<const u32x4*>(Kh + (long)((k0) + krow) * LDK + kch * 16); } while (0)
#define SWRITE(b, i) do { *(u32x4*)(V_lds + (b) * V8_TILE + vrow * V8_STRIDE + vch * 16) = sr_[i].v8; \
    *(u32x4*)(K_lds + (b) * K8_TILE + krow * K8_STRIDE + kch * 16) = sr_[i].k8; } while (0)
#define SWAIT() asm volatile("s_waitcnt vmcnt(2)" ::: "memory")
  f32x16 pA0, pA1, pB0, pB1; i32x8 pa; const int NT = seq / KVBLK;
  constexpr int SE = 0, SO = 1;
  SLOAD(SE, 0); asm volatile("s_waitcnt vmcnt(0)" ::: "memory"); SWRITE(0, SE);
  SLOAD(SO, KVBLK); SLOAD(SE, 2 * KVBLK);
  __syncthreads();
  qkt(pA0, pA1, K_lds, qr, r32, hi, cinit); partialSM(pA0, pA1);
  SWAIT(); SWRITE(1, SO); SLOAD(SO, 3 * KVBLK);
  __syncthreads();
  int s0 = 0, s1 = 1, s2 = 2;
  for (int j = 1; j + 1 < NT; j += 2) {
    SBAR(); qkt(pB0, pB1, K_lds + s1 * K8_TILE, qr, r32, hi, cinit);
    finishSM(pA0, pA1, pa); SBAR();
    pv_d0(o, ol, V_lds + s0 * V8_TILE, pa, r32, hi); partialSM(pB0, pB1);
    SBAR(); SWAIT(); SWRITE(s2, SE); SLOAD(SE, (j + 3 < NT ? j + 3 : NT - 1) * KVBLK);
    __syncthreads();
    SBAR(); qkt(pA0, pA1, K_lds + s2 * K8_TILE, qr, r32, hi, cinit);
    finishSM(pB0, pB1, pa); SBAR();
    pv_d0(o, ol, V_lds + s1 * V8_TILE, pa, r32, hi); partialSM(pA0, pA1);
    SBAR(); SWAIT(); SWRITE(s0, SO); SLOAD(SO, (j + 4 < NT ? j + 4 : NT - 1) * KVBLK);
    __syncthreads();
    { const int t_ = s0; s0 = s2; s2 = s1; s1 = t_; }
  }
  SBAR(); qkt(pB0, pB1, K_lds + s1 * K8_TILE, qr, r32, hi, cinit);
  finishSM(pA0, pA1, pa); SBAR();
  pv_d0(o, ol, V_lds + s0 * V8_TILE, pa, r32, hi); partialSM(pB0, pB1);
  finishSM(pB0, pB1, pa); SBAR();
  pv_d0(o, ol, V_lds + s1 * V8_TILE, pa, r32, hi);
  asm volatile("s_waitcnt vmcnt(0)" ::: "memory");
  if (lse && r32 == 0) {
#pragma unroll
    for (int r = 0; r < 16; ++r) lse[(wid * QBLK + crow(r, hi)) * 4] = __logf(ol[r]) - mnC * 0.69314718055994531f; }
  float rli[16];
#pragma unroll
  for (int r = 0; r < 16; ++r) rli[r] = __builtin_amdgcn_rcpf(ol[r]);
  bf16_t* Ow = Ob + (long)(wid * QBLK) * LDO;
#pragma unroll
  for (int r = 0; r < 16; ++r) { int orow = crow(r, hi);
    for (int d0 = 0; d0 < 4; ++d0) Ow[(long)orow * LDO + d0 * 32 + r32] = (bf16_t)(pkbf(o[d0][r] * rli[r], 0.f) & 0xffffu); }
  __syncthreads();
#undef SLOAD
#undef SWRITE
#undef SWAIT
}
}

struct Args { const float* in[20]; float* out; unsigned char* ws; int ph_lo, ph_hi; };
typedef const __attribute__((address_space(4))) Args* KArgs;
__device__ __forceinline__ KArgs get_args() { KArgs p = (KArgs)__builtin_amdgcn_kernarg_segment_ptr(); asm volatile("" : "+s"(p)); return p; }
__device__ __forceinline__ int fresh_tid() { int t = threadIdx.x; asm volatile("" : "+v"(t)); return t; }
__device__ __forceinline__ int fresh_bx() { int t = blockIdx.x; asm volatile("" : "+s"(t)); return t; }
__device__ __forceinline__ int fresh_g() { int t = gridDim.x; asm volatile("" : "+s"(t)); return t; }
enum { I_X = 0, I_C, I_CTX, I_CCTX, I_ADAW, I_ADAB, I_N1W, I_N2W, I_WIN, I_QNW, I_KNW, I_CONVW, I_ALOG, I_DTB, I_DNW, I_WOUT, I_WQ, I_SUBK, I_U, I_V };

__device__ __forceinline__ void convert_tables(const float* U, const float* V, unsigned char* ws, int l, int wvi, int nwv, int lane, int rw_end = 2 * NEXP) {
    const float* us = U + (size_t)l * NEXP * 1024; const float* vs = V + (size_t)l * NEXP * 1024;
    const int set = l & 1;
    float* scl = (float*)(ws + WS_USC) + set * 2 * NEXP;
    for (int rw = wvi; rw < rw_end; rw += nwv) {
        const bool isu = rw < NEXP; const int e = isu ? rw : rw - NEXP;
        const f32x4* sp = (const f32x4*)((isu ? us : vs) + (size_t)e * 1024 + 16 * lane);
        f32x4 x[4]; float mx = 0.f;
#pragma unroll
        for (int i = 0; i < 4; ++i) { x[i] = sp[i]; mx = fmaxf(mx, fmaxf(fmaxf(fabsf(x[i][0]), fabsf(x[i][1])), fmaxf(fabsf(x[i][2]), fabsf(x[i][3])))); }
        mx = wave_max(mx);
        const float sc = fmaxf(mx, 1e-30f) * (1.f / 127.f), inv = 1.f / sc;
        u32x4 o4;
        const float ofs = ((GATHER_PART && isu) || GATHER_PART == 2) ? 0.f : 128.f;
#pragma unroll
        for (int i = 0; i < 4; ++i) { const unsigned b0 = (unsigned)(int)(rintf(x[i][0] * inv) + ofs) & 255u, b1 = (unsigned)(int)(rintf(x[i][1] * inv) + ofs) & 255u, b2 = (unsigned)(int)(rintf(x[i][2] * inv) + ofs) & 255u, b3 = (unsigned)(int)(rintf(x[i][3] * inv) + ofs) & 255u;
            o4[i] = b0 | (b1 << 8) | (b2 << 16) | (b3 << 24); }
        if (GATHER_PART == 2) *(u32x4*)(ws + WS_UB + (size_t)set * TAB_SET + (isu ? 0 : (size_t)NEXP * 1024) + ((size_t)(lane >> 3) * NEXP + e) * 128 + 16 * (lane & 7)) = o4;
        else *(u32x4*)(ws + WS_UB + (size_t)set * TAB_SET + (size_t)e * 2048 + (isu ? 0 : 1024) + 16 * lane) = o4;
        if (lane == 0) { if (GATHER_PART) scl[2 * e + (isu ? 0 : 1)] = sc; else scl[rw] = sc; }
    }
}

__device__ __forceinline__ void transpose_item(const float* W, int ldw, int K, bf16_t* WT, LAS float* scr, int kb, int nb, int lane) {
    const int k0 = 64 * kb, n0 = 32 * nb;
#pragma unroll 8
    for (int i = 0; i < 32; ++i) { const int kk = 2 * i + (lane >> 5); scr[kk * 33 + (lane & 31)] = W[(size_t)(k0 + kk) * ldw + n0 + (lane & 31)]; }
    LDS_WAIT(); asm volatile("" ::: "memory");
    const int c = lane & 7;
#pragma unroll
    for (int j = 0; j < 4; ++j) { const int n = (lane >> 3) + 8 * j; const LAS float* s = scr + (8 * c) * 33 + n;
        u32x4 o; o.x = pkbf(s[0 * 33], s[1 * 33]); o.y = pkbf(s[2 * 33], s[3 * 33]); o.z = pkbf(s[4 * 33], s[5 * 33]); o.w = pkbf(s[6 * 33], s[7 * 33]);
        *(u32x4*)(WT + (size_t)(n0 + n) * K + k0 + 8 * c) = o; }
    LDS_WAIT(); asm volatile("" ::: "memory");
}
__device__ __forceinline__ void phase_prologue(LAS unsigned char* lds) {
    const KArgs ap = get_args();
#define a (*ap)

    const int tid = fresh_tid(), lane = tid & 63, wave = __builtin_amdgcn_readfirstlane(tid >> 6), G = fresh_g(), bx = fresh_bx();
    unsigned char* ws = a.ws;
    {
        LAS float* sc = (LAS float*)(lds + 70000);
        LAS float* part = (LAS float*)(lds + 70000 + 12288);
        for (int i = tid; i < 3 * 1024; i += 512) { const int r = i >> 10, k = i & 1023; const float v = r < 2 ? a.in[I_C][r * 1024 + k] : a.in[I_CCTX][k]; sc[i] = silu_f(v); }
        __syncthreads();
        float* mod = (float*)(ws + WS_MOD);
        for (int item = bx; item < DEPTH * 96; item += G) {
            const int l = item / 96, j0 = (item % 96) * 64;
            const float* wp = a.in[I_ADAW] + (size_t)l * 1024 * 6144 + (size_t)(wave * 128) * 6144 + j0 + lane;
            float a0 = 0.f, a1 = 0.f, a2 = 0.f;
#pragma unroll 8
            for (int kk = 0; kk < 128; ++kk) { const float w = wp[(size_t)kk * 6144]; const int k = wave * 128 + kk; a0 = fmaf(sc[k], w, a0); a1 = fmaf(sc[1024 + k], w, a1); a2 = fmaf(sc[2048 + k], w, a2); }
            part[(wave * 3 + 0) * 64 + lane] = a0; part[(wave * 3 + 1) * 64 + lane] = a1; part[(wave * 3 + 2) * 64 + lane] = a2;
            __syncthreads();
            if (tid < 192) { const int r = tid >> 6, jj = tid & 63; float s = a.in[I_ADAB][l * 6144 + j0 + jj];
#pragma unroll
                for (int w = 0; w < 8; ++w) s += part[(w * 3 + r) * 64 + jj];
                mod[(size_t)(l * 3 + r) * 6144 + j0 + jj] = s; }
            __syncthreads();
        }
    }
    {
        const int gw = bx * 8 + wave, NGW = G * 8;
        unsigned* wmaxw = (unsigned*)(ws + WS_CTL) + CW_WMAX;
        constexpr int NB_IN = NP / 64, NB_OUT = 1024 / 64, NB_Q = 2048 / 64, PER_L2 = (NB_IN + NB_OUT + NB_Q) * 8;
        for (int it = gw; it < DEPTH * PER_L2; it += NGW) { const int l = it / PER_L2; int r = it % PER_L2; const int kc = r & 7; r >>= 3;
            const int mi = r < NB_IN ? 0 : r < NB_IN + NB_OUT ? 1 : 2; const int nb = mi == 0 ? r : mi == 1 ? r - NB_IN : r - NB_IN - NB_OUT; const int ldw = mi == 0 ? NIN : mi == 1 ? 1024 : 2048;
            const float* wp = (mi == 0 ? a.in[I_WIN] + (size_t)l * 1024 * NIN : mi == 1 ? a.in[I_WOUT] + (size_t)l * 1024 * 1024 : a.in[I_WQ] + (size_t)l * 1024 * 2048) + (size_t)(kc * 128) * ldw + nb * 64 + lane;
            float mx = 0.f;
#pragma unroll 8
            for (int kk = 0; kk < 128; ++kk) mx = fmaxf(mx, fabsf(wp[(size_t)kk * ldw]));
            atomicMax(wmaxw + (l * 3 + mi) * 3072 + nb * 64 + lane, __float_as_uint(mx)); }
    }
    const size_t gt = (size_t)bx * 512 + tid, NT = (size_t)G * 512;
    for (size_t i = gt; i < (size_t)DEPTH * 16 * 1024; i += NT) { const int l = (int)(i >> 14), j = (int)((i >> 10) & 15), k = (int)(i & 1023);
        ((float*)(ws + WS_WSK))[i] = a.in[I_WIN][(size_t)l * 1024 * NIN + (size_t)k * NIN + NP + j]; }
    for (size_t i = gt; i < (size_t)DEPTH * 8 * 2 * 128 * 128 / 2; i += NT) { const f32x2 x = ((const f32x2*)a.in[I_SUBK])[i]; ((unsigned*)(ws + WS_SKB))[i] = pkbf(x[0], x[1]); }
    for (size_t i = gt; i < 8192; i += NT) { const int pos = (int)(i >> 5), fi = (int)(i & 31);
        const float inv = exp2f(-(float)fi * (13.287712379549449f / 32.f)); const float ang = (float)pos * inv;
        float rev = ang * 0.15915494309189535f; rev -= floorf(rev);
        ((float*)(ws + WS_ROPE))[i] = __builtin_amdgcn_cosf(rev); ((float*)(ws + WS_ROPE))[8192 + i] = __builtin_amdgcn_sinf(rev); }
}


__device__ __forceinline__ void quant_transpose_item(const float* W, int ldw, signed char* WT, const unsigned* wmaxw, LAS float* scr, int kb, int nb, int lane) {
    const int k0 = 64 * kb, n0 = 32 * nb;
#pragma unroll 8
    for (int i = 0; i < 32; ++i) { const int kk = 2 * i + (lane >> 5); scr[kk * 33 + (lane & 31)] = W[(size_t)(k0 + kk) * ldw + n0 + (lane & 31)]; }
    LDS_WAIT(); asm volatile("" ::: "memory");
    const int n = lane >> 1, hf = lane & 1;
    const float mx = __uint_as_float(wmaxw[n0 + n]), inv = mx > 0.f ? 127.f / mx : 0.f;
    u32x4 o[2];
#pragma unroll
    for (int q = 0; q < 8; ++q) { unsigned w = 0u;
#pragma unroll
        for (int b = 0; b < 4; ++b) { const int kk = 32 * hf + 4 * q + b; w |= ((unsigned)(int)rintf(scr[kk * 33 + n] * inv) & 255u) << (8 * b); }
        o[q >> 2][q & 3] = w; }
    u32x4* dst = (u32x4*)(WT + (size_t)(n0 + n) * 1024 + k0 + 32 * hf);
    dst[0] = o[0]; dst[1] = o[1];
    LDS_WAIT(); asm volatile("" ::: "memory");
}
__device__ __forceinline__ void phase_quant_weights(LAS unsigned char* lds) {
    const KArgs ap = get_args();
#define a (*ap)
    const int tid = fresh_tid(), lane = tid & 63, wave = __builtin_amdgcn_readfirstlane(tid >> 6), G = fresh_g(), bx = fresh_bx();
    unsigned char* ws = a.ws;
    LAS float* scr = (LAS float*)(lds + 65536 + wave * 8448);
    const unsigned* wmaxw = (const unsigned*)(ws + WS_CTL) + CW_WMAX;
    constexpr int I_IN = 16 * 96, I_OUT = 16 * 32, I_Q = 16 * 64, PER_L = I_IN + I_OUT + I_Q;
    for (int it = bx * 8 + wave; it < DEPTH * PER_L; it += G * 8) { const int l = it / PER_L; int r = it % PER_L;
        if (r < I_IN) quant_transpose_item(a.in[I_WIN] + (size_t)l * 1024 * NIN, NIN, (signed char*)(ws + WS_WINT) + (size_t)l * NP * 1024, wmaxw + (l * 3 + 0) * 3072, scr, r / 96, r % 96, lane);
        else if (r < I_IN + I_OUT) { r -= I_IN; quant_transpose_item(a.in[I_WOUT] + (size_t)l * 1024 * 1024, 1024, (signed char*)(ws + WS_WOUTT) + (size_t)l * 1024 * 1024, wmaxw + (l * 3 + 1) * 3072, scr, r / 32, r % 32, lane); }
        else { r -= I_IN + I_OUT; quant_transpose_item(a.in[I_WQ] + (size_t)l * 1024 * 2048, 2048, (signed char*)(ws + WS_WQT) + (size_t)l * 2048 * 1024, wmaxw + (l * 3 + 2) * 3072, scr, r / 64, r % 64, lane); } }
#undef a
}

template <bool SK>
__device__ __forceinline__ void phase_norm(int l, int which, LAS unsigned char* lds) {
    const KArgs ap = get_args();
#define a (*ap)

    const int tid = fresh_tid(), lane = tid & 63, wave = __builtin_amdgcn_readfirstlane(tid >> 6), G = fresh_g(), bx = fresh_bx();
    unsigned char* ws = a.ws;
    LAS float* wsk = (LAS float*)lds;
    if (SK) { const float* src = (const float*)(ws + WS_WSK) + (size_t)l * 16384; for (int i = tid; i < 16384 / 4; i += 512) ((LAS f32x4*)wsk)[i] = ((const f32x4*)src)[i]; __syncthreads(); }
    const int nrows = (which == 1 && l == DEPTH - 1) ? ML : M;
    const float* nw = a.in[which ? I_N2W : I_N1W] + l * 1024;
    const float* modl = (const float*)(ws + WS_MOD) + (size_t)l * 3 * 6144;
    const int shoff = which ? 3072 : 0, scoff = which ? 4096 : 1024;
    f32x4 nwv[4];
#pragma unroll
    for (int j = 0; j < 4; ++j) nwv[j] = *(const f32x4*)(nw + 4 * lane + 256 * j);
    for (int row = wave * G + bx; row < nrows; row += G * 8) {
        const int mrow = row < ML ? (row >= T ? 1 : 0) : 2;
        const float* md = modl + mrow * 6144;
        f32x4 v[4]; float ss = 0.f;
        if (l == 0 && which == 0) { const float* src = row < ML ? a.in[I_X] + (size_t)row * D : a.in[I_CTX] + (size_t)(row - ML) * D;
#pragma unroll
            for (int j = 0; j < 4; ++j) v[j] = *(const f32x4*)(src + 4 * lane + 256 * j); }
        else { const bf16_t* src = (const bf16_t*)(ws + WS_XB) + (size_t)row * D;
#pragma unroll
            for (int j = 0; j < 4; ++j) { const u32x2 w_ = *(const u32x2*)(src + 4 * lane + 256 * j); v[j] = (f32x4){bflo(w_[0]), bfhi(w_[0]), bflo(w_[1]), bfhi(w_[1])}; } }
#pragma unroll
        for (int j = 0; j < 4; ++j) ss += (v[j][0] * v[j][0] + v[j][1] * v[j][1]) + (v[j][2] * v[j][2] + v[j][3] * v[j][3]);
        const float rstd = rsqrtf(wave_sum(ss) * (1.f / D) + EPS);
        signed char* hrow = (signed char*)(ws + WS_H) + (size_t)row * D;
        float hmx = 0.f;
#pragma unroll
        for (int j = 0; j < 4; ++j) { const f32x4 sc = *(const f32x4*)(md + scoff + 4 * lane + 256 * j), sh = *(const f32x4*)(md + shoff + 4 * lane + 256 * j);
            v[j] = v[j] * rstd * nwv[j] * (sc + 1.f) + sh; hmx = fmaxf(hmx, fmaxf(fmaxf(fabsf(v[j][0]), fabsf(v[j][1])), fmaxf(fabsf(v[j][2]), fabsf(v[j][3])))); }
        hmx = fmaxf(wave_max(hmx), 1e-30f);
        { const float hinv = 127.f / hmx;
#pragma unroll
          for (int j = 0; j < 4; ++j) *(unsigned*)(hrow + 4 * lane + 256 * j) = ((unsigned)(int)rintf(v[j][0] * hinv) & 255u) | (((unsigned)(int)rintf(v[j][1] * hinv) & 255u) << 8) | (((unsigned)(int)rintf(v[j][2] * hinv) & 255u) << 16) | (((unsigned)(int)rintf(v[j][3] * hinv) & 255u) << 24);
          if (lane == 0) ((float*)(ws + WS_GB))[row] = hmx * (1.f / 127.f); }
        if (SK) {
            float p[16];
#pragma unroll
            for (int c = 0; c < 16; ++c) { float q = 0.f;
#pragma unroll
                for (int j = 0; j < 4; ++j) { const f32x4 w = *(const LAS f32x4*)(wsk + c * 1024 + 4 * lane + 256 * j); q += (v[j][0] * w[0] + v[j][1] * w[1]) + (v[j][2] * w[2] + v[j][3] * w[3]); }
                p[c] = q; }
            { const bool hb = (lane & 32) != 0;
#pragma unroll
              for (int c = 0; c < 8; ++c) { const float keep = hb ? p[c + 8] : p[c], send = hb ? p[c] : p[c + 8]; p[c] = keep + lane_xor<32>(send); } }
            { const bool hb = (lane & 16) != 0;
#pragma unroll
              for (int c = 0; c < 4; ++c) { const float keep = hb ? p[c + 4] : p[c], send = hb ? p[c] : p[c + 4]; p[c] = keep + lane_xor<16>(send); } }
            { const bool hb = (lane & 8) != 0;
#pragma unroll
              for (int c = 0; c < 2; ++c) { const float keep = hb ? p[c + 2] : p[c], send = hb ? p[c] : p[c + 2]; p[c] = keep + lane_xor<8>(send); } }
            { const bool hb = (lane & 4) != 0; const float keep = hb ? p[1] : p[0], send = hb ? p[0] : p[1]; p[0] = keep + lane_xor<4>(send); }
            p[0] += lane_xor<2>(p[0]); p[0] += lane_xor<1>(p[0]);
            if ((lane & 3) == 0) { const int c = ((lane >> 5) & 1) * 8 + ((lane >> 4) & 1) * 4 + ((lane >> 3) & 1) * 2 + ((lane >> 2) & 1); ((float*)(ws + WS_BA))[(size_t)row * 16 + c] = p[0]; }
        }
    }
    if (SK) __syncthreads();
}

__device__ __forceinline__ void phase_prep(int l, LAS unsigned char* lds) {
    const KArgs ap = get_args();
#define a (*ap)

    const int tid = fresh_tid(), lane = tid & 63, wave = __builtin_amdgcn_readfirstlane(tid >> 6), G = fresh_g(), bx = fresh_bx();
    unsigned char* ws = a.ws;
    const bf16_t* P = (const bf16_t*)(ws + WS_P);
    const float* ropec = (const float*)(ws + WS_ROPE); const float* ropes = ropec + 8192;
    const int sec = lane >> 5, fi = lane & 31;
    const float qw0 = a.in[I_QNW][l * 128 + sec * 64 + fi], qw1 = a.in[I_QNW][l * 128 + sec * 64 + 32 + fi];
    const float kw0 = a.in[I_KNW][l * 128 + sec * 64 + fi], kw1 = a.in[I_KNW][l * 128 + sec * 64 + 32 + fi];
    for (int row = wave * G + bx; row < M; row += G * 8) {
        const bool lat = row < ML;
        int b, tt, tlen; if (lat) { b = row >> 14; tt = row & (T - 1); tlen = T; } else { b = (row - ML) >> 8; tt = (row - ML) & (CT - 1); tlen = CT; }
        const bf16_t* prow = P + (size_t)row * NP;
        unsigned short xa[6][2];
#pragma unroll
        for (int hh = 0; hh < 6; ++hh) { const bf16_t* xp = prow + (hh < 4 ? hh * 128 : 512 + (hh - 4) * 128) + sec * 64 + fi; xa[hh][0] = xp[0]; xa[hh][1] = xp[32]; }
        const u32x2 vcp = *(const u32x2*)(prow + 768 + 4 * lane);
        float cs = 1.f, sn = 0.f;
        if (lat) { const int pos = sec ? (tt & 63) : (tt >> 6); cs = ropec[pos * 32 + fi]; sn = ropes[pos * 32 + fi]; }
        unsigned char* qo8 = ws + WS_QA + (size_t)row * 512;
        const size_t kvrow = (size_t)b * KVLEN + (lat ? tt : T + tt);
        unsigned char* ko8 = ws + WS_KA + kvrow * 256;
        float ssq[6];
#pragma unroll
        for (int hh = 0; hh < 6; ++hh) { const float x0 = bf2f(xa[hh][0]), x1 = bf2f(xa[hh][1]); ssq[hh] = x0 * x0 + x1 * x1; }
#pragma unroll
        for (int hh = 0; hh < 6; ++hh) ssq[hh] = wave_sum(ssq[hh]);
#pragma unroll
        for (int hh = 0; hh < 6; ++hh) {
            const float x0 = bf2f(xa[hh][0]), x1 = bf2f(xa[hh][1]);
            const float rs = rsqrtf(ssq[hh] * (1.f / 128.f) + EPS);
            const float y0 = x0 * rs * (hh < 4 ? qw0 : kw0), y1 = x1 * rs * (hh < 4 ? qw1 : kw1);
            const float qsc = hh < 4 ? 0.088388347648318440f * 1.4426950408889634f : 1.f;
            const float o0 = (y0 * cs - y1 * sn) * qsc, o1 = (y1 * cs + y0 * sn) * qsc;
            unsigned char* op8 = (hh < 4 ? qo8 + hh * 128 : ko8 + (hh - 4) * 128) + sec * 64 + fi;
            const float f8s = hh < 4 ? 8.f : 1.f;
            const int pk8 = __builtin_amdgcn_cvt_pk_fp8_f32(o0 * f8s, o1 * f8s, 0, false);
            op8[0] = (unsigned char)(pk8 & 255); op8[32] = (unsigned char)((pk8 >> 8) & 255);
        }
        { const int pos = lat ? tt : T + tt, tile = pos >> 6, k64 = pos & 63, k32 = k64 & 31;
          const int bytepos = 32 * ((k32 >> 2) & 1) + 16 * (k64 >> 5) + (k32 & 3) + 4 * (k32 >> 3);
          unsigned char* vt = ws + WS_VA + ((size_t)(b * 2) * (KVLEN / 64) + tile) * 8192 + bytepos;
          const unsigned short* vsrc = (const unsigned short*)&vcp;
          const int kvh_ = lane >> 5, d0 = (4 * lane) & 127;
          const int pk01 = __builtin_amdgcn_cvt_pk_fp8_f32(bf2f(vsrc[0]), bf2f(vsrc[1]), 0, false), pk23 = __builtin_amdgcn_cvt_pk_fp8_f32(bf2f(vsrc[2]), bf2f(vsrc[3]), 0, false);
          unsigned char* vt2 = vt + (size_t)kvh_ * (KVLEN / 64) * 8192 + (size_t)d0 * 64;
          vt2[0] = (unsigned char)(pk01 & 255); vt2[64] = (unsigned char)((pk01 >> 8) & 255); vt2[128] = (unsigned char)(pk23 & 255); vt2[192] = (unsigned char)((pk23 >> 8) & 255); }
    }
    __syncthreads();
}

constexpr int ATT_PARTS = 4;
__device__ __forceinline__ void phase_attn(int l, unsigned char* lds_raw, volatile LAS unsigned* MISC, int rep) {
    const KArgs ap = get_args();
#define a (*ap)
    unsigned char* ws = a.ws;
    const unsigned char* QA = ws + WS_QA; const unsigned char* KA = ws + WS_KA; const unsigned char* VT = ws + WS_VA;
    bf16_t* CAT = (bf16_t*)(ws + WS_CAT); float* LSE = (float*)(ws + WS_BA);
    unsigned* ctr = (unsigned*)(ws + WS_CTL) + 8192 + 64 * l + 1024 * rep;
    const int natt = 2048 + (l < DEPTH - 1 ? 8 : 0);
    constexpr int CONV_ROWS = 64, NCONV = 2 * NEXP / CONV_ROWS;
    const int nunits = natt + (l + 1 < DEPTH ? NCONV : 0) + (l == 0 ? NCONV : 0);
    float braw;
    { const int ln = threadIdx.x & 63; float mq = fmaxf(fabsf(a.in[I_QNW][l * 128 + ln]), fabsf(a.in[I_QNW][l * 128 + 64 + ln])), mk = fmaxf(fabsf(a.in[I_KNW][l * 128 + ln]), fabsf(a.in[I_KNW][l * 128 + 64 + ln]));
      mq = wave_max(mq); mk = wave_max(mk);
      braw = __builtin_bit_cast(float, __builtin_amdgcn_readfirstlane(__builtin_bit_cast(int, 128.f * mq * mk))); }
    if (threadIdx.x == 0) MISC[12] = __hip_atomic_fetch_add(ctr, 1u, __ATOMIC_RELAXED, __HIP_MEMORY_SCOPE_AGENT);
    __syncthreads();
    int u = (int)MISC[12], par = 0;
    for (; u < nunits; ) {
        if (threadIdx.x == 0) MISC[13 - par] = __hip_atomic_fetch_add(ctr, 1u, __ATOMIC_RELAXED, __HIP_MEMORY_SCOPE_AGENT);
        if (u >= natt) {
            const int tq_ = fresh_tid();
            const int ci_ = u - natt, own_ = ci_ >= NCONV ? 1 : 0;
            const int rwb = (ci_ - own_ * NCONV) * CONV_ROWS + __builtin_amdgcn_readfirstlane(tq_ >> 6) * 8;
            convert_tables(a.in[I_U], a.in[I_V], ws, l + 1 - own_, rwb, 1, tq_ & 63, rwb + 8);
            __syncthreads();
            u = (int)MISC[13 - par]; par ^= 1;
            continue;
        }
        size_t r0, kv0; int h, kvh, seq, ldo; bf16_t* ob; float* lse;
        if (u < 2048) { const int qb = u & 63, g = (u >> 6) & 1, part = (u >> 7) & 3, b = u >> 10; kvh = (u >> 9) & 1; h = kvh * 2 + g;
            const int t0 = (part >> 1) * 130 + (part & 1) * 64;
            r0 = (size_t)b * T + (size_t)qb * 256; kv0 = (size_t)b * KVLEN + (size_t)t0 * 64; seq = ((part & 1) ? 66 : 64) * 64;
            ob = part ? (bf16_t*)(ws + (part == 1 ? WS_DQ : part == 2 ? WS_DK : WS_DV)) + r0 * 512 + h * 128 : CAT + r0 * 1024 + h * 128; ldo = part ? 512 : 1024; lse = LSE + ((size_t)part * ML + r0) * 4 + h; }
        else { const int b = (u - 2048) >> 2; h = (u - 2048) & 3; kvh = h >> 1; r0 = (size_t)ML + (size_t)b * CT; kv0 = (size_t)b * KVLEN + T; seq = CT;
            ob = CAT + r0 * 1024 + h * 128; ldo = 1024; lse = nullptr; }
        att::attn_dense_body(QA + r0 * 512 + h * 128, KA + kv0 * 256 + kvh * 128, VT + ((size_t)((kv0 / KVLEN) * 2 + kvh) * (KVLEN / 64) + (kv0 % KVLEN) / 64) * 8192, ob, ldo, seq, (char*)lds_raw, lse, braw);
        u = (int)MISC[13 - par]; par ^= 1;
    }
#undef a
}

__device__ __forceinline__ int tokperm(int q, int hh, int jj) { return 16 * q + 8 * (jj >> 2) + 4 * hh + (jj & 3); }
__device__ __forceinline__ int crow16(int r, int hi) { return (r & 3) + 8 * (r >> 2) + 4 * hi; }
__device__ __forceinline__ int kperm16(int s_, int g, int jj) { return 32 * s_ + 16 * (jj >> 2) + 4 * g + (jj & 3); }
__device__ __forceinline__ int frag_off(int i, int j) {
    return (((i >> 4) * 2 + (j >> 5)) * 64 + ((i & 15) + 16 * ((j >> 2) & 3))) * 16 + (4 * ((j >> 4) & 1) + (j & 3)) * 2;
}
template <int MODE>
__device__ __forceinline__ void phase_dn_chunkprep(int l, LAS unsigned char* lds) {
    const KArgs ap = get_args();
#define a (*ap)
    const int tid = fresh_tid(), lane = tid & 63, wave = __builtin_amdgcn_readfirstlane(tid >> 6), G = fresh_g(), bx = fresh_bx();
    unsigned char* ws = a.ws;
    constexpr int KT_OFF = 0, QT_OFF = 17408, VT_OFF = 34816, GS_OFF = 52224, RS_OFF = 68864, AM_OFF = 85504, SC_OFF = 120320, IMG_OFF = 0;
    const int r = lane & 31, hh = lane >> 5;
    const bf16_t* DQ = (const bf16_t*)(ws + WS_DQ); const bf16_t* DK = (const bf16_t*)(ws + WS_DK); const bf16_t* DV = (const bf16_t*)(ws + WS_DV);
    const float* BA = (const float*)(ws + WS_BA);
    constexpr int NTASK = MODE ? NB * 4 * 4 : NB * 4 * (NCH - 4);
#define CP_TASKID(t_) (MODE ? ((t_) >> 2) * NCH + ((t_) & 3) : ((t_) >> 8) * NCH + 4 + ((t_) & 255))
    LAS float* gsc = (LAS float*)(lds + SC_OFF);
    LAS float* bsc = gsc + 128;
    LAS float* gcs = gsc + 256;
    constexpr int CW_OFF = 121856, DI_OFF = CW_OFF + 5 * 1536 * 4;
    static_assert(DI_OFF + 8192 <= LDS_MISC, "chunkprep LDS");
    LAS float* cwl = (LAS float*)(lds + CW_OFF);
    for (int i = tid; i < 5 * 1536; i += 512) cwl[i] = a.in[I_CONVW][(size_t)l * 5 * 1536 + i];
    __syncthreads();
    const bf16_t* P = (const bf16_t*)(ws + WS_P);
    u32x4 xin[3][5][2];
#define CP_LOADX(task_) do { const int cidx_ = (task_) % NCH, bh_ = (task_) / NCH, b_ = bh_ >> 2, h_ = bh_ & 3; \
        const int row0_ = cidx_ < 4 ? ML + b_ * CT + cidx_ * 64 : b_ * T + (cidx_ - 4) * 64, tt_ = (cidx_ < 4 ? cidx_ * 64 : (cidx_ - 4) * 64) + (tid >> 3), tlen_ = cidx_ < 4 ? CT : T; \
        _Pragma("unroll") for (int j = 0; j < 5; ++j) { const int t2 = tt_ + j - 2; const bool ok = t2 >= 0 && t2 < tlen_; \
            const bf16_t* xr = P + (size_t)(row0_ + (tid >> 3) + (ok ? j - 2 : 0)) * NP + 1024 + h_ * 128 + (tid & 7) * 16; \
            _Pragma("unroll") for (int m = 0; m < 3; ++m) { const u32x4 w0 = *(const u32x4*)(xr + m * 512), w1 = *(const u32x4*)(xr + m * 512 + 8); \
                xin[m][j][0] = ok ? w0 : (u32x4){0u, 0u, 0u, 0u}; xin[m][j][1] = ok ? w1 : (u32x4){0u, 0u, 0u, 0u}; } } } while (0)
    if (bx < NTASK) CP_LOADX(CP_TASKID(bx));
    for (int tk = bx; tk < NTASK; tk += G) {
        const int task = CP_TASKID(tk);
        const int cidx = task % NCH, bh = task / NCH, b = bh >> 2, h = bh & 3;
        const int row0 = cidx < 4 ? ML + b * CT + cidx * 64 : b * T + (cidx - 4) * 64;
        unsigned char* rec = ws + WS_REC + (size_t)task * REC_BYTES;
        {
            const int rr = tid >> 3, seg = tid & 7;
            if (tid < 128) { const int d = tid >> 6, i = tid & 63, dh = d * 4 + h;
                const float xb = BA[(size_t)(row0 + i) * 16 + dh], z = BA[(size_t)(row0 + i) * 16 + 8 + dh] + a.in[I_DTB][l * 8 + dh];
                bsc[tid] = 1.f / (1.f + __expf(-xb)); gsc[tid] = -__expf(a.in[I_ALOG][l * 8 + dh]) * (fmaxf(z, 0.f) + log1pf(__expf(-fabsf(z)))); }
#pragma unroll
            for (int m = 0; m < 3; ++m) {
                float y[16];
#pragma unroll
                for (int c = 0; c < 16; ++c) y[c] = 0.f;
#pragma unroll
                for (int j = 0; j < 5; ++j) { const LAS float* wp = cwl + j * 1536 + m * 512 + h * 128 + seg * 16;
#pragma unroll
                    for (int q4 = 0; q4 < 4; ++q4) { const f32x4 wv = *(const LAS f32x4*)(wp + 4 * q4); const unsigned u0 = xin[m][j][q4 >> 1][2 * (q4 & 1)], u1 = xin[m][j][q4 >> 1][2 * (q4 & 1) + 1];
                        y[4 * q4 + 0] = fmaf(bflo(u0), wv[0], y[4 * q4 + 0]); y[4 * q4 + 1] = fmaf(bfhi(u0), wv[1], y[4 * q4 + 1]); y[4 * q4 + 2] = fmaf(bflo(u1), wv[2], y[4 * q4 + 2]); y[4 * q4 + 3] = fmaf(bfhi(u1), wv[3], y[4 * q4 + 3]); } }
                float ss = 0.f;
#pragma unroll
                for (int c = 0; c < 16; ++c) { y[c] = silu_f(y[c]); ss = fmaf(y[c], y[c], ss); }
                if (m < 2) { ss += lane_xor<1>(ss); ss += lane_xor<2>(ss); ss += lane_xor<4>(ss);
                    float sc = rsqrtf(ss + EPS); if (m == 0) sc *= 0.088388347648318440f;
#pragma unroll
                    for (int c = 0; c < 16; ++c) y[c] *= sc; }
                u32x4 o0, o1; o0.x = pkbf(y[0], y[1]); o0.y = pkbf(y[2], y[3]); o0.z = pkbf(y[4], y[5]); o0.w = pkbf(y[6], y[7]); o1.x = pkbf(y[8], y[9]); o1.y = pkbf(y[10], y[11]); o1.z = pkbf(y[12], y[13]); o1.w = pkbf(y[14], y[15]);
                LAS unsigned char* dst = lds + (m == 0 ? QT_OFF : m == 1 ? KT_OFF : VT_OFF) + rr * 272 + seg * 32;
                *(LAS u32x4*)dst = o0; *(LAS u32x4*)(dst + 16) = o1;
            }
        }
        __syncthreads();
        {
            const int mat = wave >> 2, ti = (wave >> 1) & 1, tj = wave & 1;
            f32x16 acc = {};
#pragma unroll
            for (int ks = 0; ks < 8; ++ks) {
                const bf16x8 av = *(const LAS bf16x8*)(lds + (mat ? QT_OFF : KT_OFF) + (32 * ti + r) * 272 + (16 * ks + 8 * hh) * 2);
                const bf16x8 bv = *(const LAS bf16x8*)(lds + KT_OFF + (32 * tj + r) * 272 + (16 * ks + 8 * hh) * 2);
                acc = __builtin_amdgcn_mfma_f32_32x32x16_bf16(av, bv, acc, 0, 0, 0);
            }
            LAS float* dst = (LAS float*)(lds + (mat ? RS_OFF : GS_OFF));
#pragma unroll
            for (int i = 0; i < 16; ++i) dst[(32 * ti + crow16(i, hh)) * 65 + 32 * tj + r] = acc[i];
        }
        { const int r16 = lane & 15, g4 = lane >> 4;
#pragma unroll
        for (int t = 0; t < 2; ++t) { const int f = wave * 2 + t, mt = f >> 2, sk = f & 3;
            { const u32x2 lo = *(const LAS u32x2*)(lds + KT_OFF + (16 * mt + r16) * 272 + (32 * sk + 4 * g4) * 2), hi2 = *(const LAS u32x2*)(lds + KT_OFF + (16 * mt + r16) * 272 + (32 * sk + 16 + 4 * g4) * 2);
              *(u32x4*)(rec + REC_K + f * 1024 + lane * 16) = (u32x4){lo.x, lo.y, hi2.x, hi2.y}; }
            { const u32x2 lo = *(const LAS u32x2*)(lds + QT_OFF + (16 * mt + r16) * 272 + (32 * sk + 4 * g4) * 2), hi2 = *(const LAS u32x2*)(lds + QT_OFF + (16 * mt + r16) * 272 + (32 * sk + 16 + 4 * g4) * 2);
              *(u32x4*)(rec + REC_Q + f * 1024 + lane * 16) = (u32x4){lo.x, lo.y, hi2.x, hi2.y}; } }
#pragma unroll
        for (int t = 0; t < 2; ++t) { const int f = wave * 2 + t, mt = f >> 1, sk = f & 1;
            unsigned e[8];
#pragma unroll
            for (int jj = 0; jj < 8; ++jj) e[jj] = *(const LAS unsigned short*)(lds + KT_OFF + kperm16(sk, g4, jj) * 272 + (16 * mt + r16) * 2);
            *(u32x4*)(rec + REC_KT + f * 1024 + lane * 16) = (u32x4){e[0] | (e[1] << 16), e[2] | (e[3] << 16), e[4] | (e[5] << 16), e[6] | (e[7] << 16)}; }
        { const int sl = wave;
            unsigned e[16];
#pragma unroll
            for (int i = 0; i < 16; ++i) e[i] = *(const LAS unsigned short*)(lds + VT_OFF + (16 * (i >> 2) + 4 * g4 + (i & 3)) * 272 + (16 * sl + r16) * 2);
            u32x4* vp = (u32x4*)(rec + REC_V + sl * 2048 + lane * 32);
            vp[0] = (u32x4){e[0] | (e[1] << 16), e[2] | (e[3] << 16), e[4] | (e[5] << 16), e[6] | (e[7] << 16)};
            vp[1] = (u32x4){e[8] | (e[9] << 16), e[10] | (e[11] << 16), e[12] | (e[13] << 16), e[14] | (e[15] << 16)}; }
        }
        if (tk + G < NTASK) CP_LOADX(CP_TASKID(tk + G));
        if (wave < 2) { const int d = wave; float gv = gsc[d * 64 + (d ? 63 - lane : lane)];
            gv += __builtin_bit_cast(float, __builtin_amdgcn_update_dpp(0, __builtin_bit_cast(int, gv), 0x111, 0xF, 0xF, true));
            gv += __builtin_bit_cast(float, __builtin_amdgcn_update_dpp(0, __builtin_bit_cast(int, gv), 0x112, 0xF, 0xF, true));
            gv += __builtin_bit_cast(float, __builtin_amdgcn_update_dpp(0, __builtin_bit_cast(int, gv), 0x114, 0xF, 0xF, true));
            gv += __builtin_bit_cast(float, __builtin_amdgcn_update_dpp(0, __builtin_bit_cast(int, gv), 0x118, 0xF, 0xF, true));
            { const float t0 = __builtin_bit_cast(float, __builtin_amdgcn_readlane(__builtin_bit_cast(int, gv), 15)), t1 = __builtin_bit_cast(float, __builtin_amdgcn_readlane(__builtin_bit_cast(int, gv), 31)), t2 = __builtin_bit_cast(float, __builtin_amdgcn_readlane(__builtin_bit_cast(int, gv), 47));
              const int rw_ = lane >> 4; gv += (rw_ >= 1 ? t0 : 0.f) + (rw_ >= 2 ? t1 : 0.f) + (rw_ >= 3 ? t2 : 0.f); }
            gcs[d * 64 + lane] = gv; }
        __syncthreads();
        const LAS float* Gs = (const LAS float*)(lds + GS_OFF); const LAS float* Rs = (const LAS float*)(lds + RS_OFF);
#pragma unroll 4
        for (int t = 0; t < 16; ++t) { const int e = tid + 512 * t, d = e >> 12, jp = (e >> 6) & 63, ip = e & 63;
            const int in_ = d ? 63 - ip : ip, jn = d ? 63 - jp : jp;
            const float dec = __expf(fminf(gcs[d * 64 + ip] - gcs[d * 64 + jp], 0.f));
            const float av = (jp < ip) ? bsc[d * 64 + in_] * Gs[in_ * 65 + jn] * dec : 0.f;
            ((LAS float*)(lds + AM_OFF))[d * 4352 + jp * 68 + ip] = av;
            const float qk = (jp <= ip) ? Rs[in_ * 65 + jn] * dec : 0.f;
            *(LAS unsigned short*)(lds + IMG_OFF + d * 16384 + 8192 + frag_off(in_, jn)) = (unsigned short)(pkbf(qk, 0.f) & 0xffffu); }
        __syncthreads();
        { int ln_ = lane; asm volatile("" : "+v"(ln_));
          const int d = wave >> 2, nt = wave & 3, n16 = ln_ & 15, g4 = ln_ >> 4;
          const LAS float* At = (const LAS float*)(lds + AM_OFF) + d * 4352;
          LAS float* Xd = (LAS float*)(lds + GS_OFF) + d * 4096;
          LAS float* Dinv = (LAS float*)(lds + DI_OFF) + d * 1024;
          { float x[16];
#pragma unroll
            for (int q = 0; q < 16; ++q) x[q] = (q == n16) ? 1.f : 0.f;
#pragma unroll
            for (int r2 = 0; r2 < 15; ++r2) { const LAS float* ar = At + (16 * nt + r2) * 68 + 16 * nt; const float xr = x[r2];
#pragma unroll
                for (int q4 = (r2 + 1) / 4; q4 < 4; ++q4) { const f32x4 a4 = *(const LAS f32x4*)(ar + 4 * q4);
#pragma unroll
                    for (int q = 0; q < 4; ++q) if (4 * q4 + q > r2) x[4 * q4 + q] = fmaf(-a4[q], xr, x[4 * q4 + q]); } }
            if (ln_ < 16) {
#pragma unroll
                for (int q = 0; q < 16; ++q) Dinv[nt * 256 + q * 16 + n16] = x[q]; } }
          if (wave == 2 || wave == 3) { const int d2 = wave - 2, ip = d2 ? 63 - lane : lane; const float gl = gcs[d2 * 64 + 63], gi = gcs[d2 * 64 + ip];
            float* sc = (float*)(rec + REC_DIR + d2 * REC_DIRSZ + 16384);
            sc[lane] = __expf(gi); sc[64 + lane] = __expf(gl - gi); if (lane == 0) sc[128] = __expf(gl); }
          __syncthreads();
          const int c = 16 * nt + n16, jn = d ? 63 - c : c; const float bj = bsc[d * 64 + jn];
          const int fj = (jn >> 5) * 1024 + ((jn >> 2) & 3) * 256 + ((jn >> 4) & 1) * 8 + (jn & 3) * 2;
#pragma unroll 1
          for (int B = 0; B < 4; ++B) {
            f32x4 y = {0.f, 0.f, 0.f, 0.f};
            if (nt <= B) {
                f32x4 acc;
#pragma unroll
                for (int r2 = 0; r2 < 4; ++r2) acc[r2] = (nt == B && 4 * g4 + r2 == n16) ? 1.f : 0.f;
#pragma unroll 2
                for (int j0 = 0; j0 < 16 * B; j0 += 4) { const float av = -At[(j0 + g4) * 68 + 16 * B + n16], bv = Xd[(j0 + g4) * 64 + c];
                    acc = __builtin_amdgcn_mfma_f32_16x16x4f32(av, bv, acc, 0, 0, 0); }
#pragma unroll
                for (int r2 = 0; r2 < 4; ++r2) Xd[(16 * B + 4 * g4 + r2) * 64 + c] = acc[r2];
#pragma unroll
                for (int s4 = 0; s4 < 4; ++s4) { const float av = Dinv[B * 256 + n16 * 16 + 4 * s4 + g4], bv = Xd[(16 * B + 4 * s4 + g4) * 64 + c];
                    y = __builtin_amdgcn_mfma_f32_16x16x4f32(av, bv, y, 0, 0, 0); }
            }
#pragma unroll
            for (int r2 = 0; r2 < 4; ++r2) { const int i = 16 * B + 4 * g4 + r2, in_ = d ? 63 - i : i; Xd[i * 64 + c] = y[r2];
                *(LAS unsigned short*)(lds + IMG_OFF + d * 16384 + (in_ >> 4) * 2048 + (in_ & 15) * 16 + fj) = (unsigned short)(pkbf_c(y[r2] * bj, 0.f) & 0xffffu); }
            __syncthreads();
          }
        }
#pragma unroll
        for (int t = 0; t < 4; ++t) { const int p = tid + 512 * t, d = p >> 10, off = (p & 1023) * 16;
            *(u32x4*)(rec + REC_DIR + d * REC_DIRSZ + off) = *(const LAS u32x4*)(lds + IMG_OFF + d * 16384 + off); }
        __syncthreads();
    }
#undef CP_LOADX
#undef CP_TASKID
#undef a
}

__device__ __forceinline__ bf16x8 pack44(const f32x4& lo, const f32x4& hi) {
    u32x4 p; p.x = pkbf_c(lo[0], lo[1]); p.y = pkbf_c(lo[2], lo[3]); p.z = pkbf_c(hi[0], hi[1]); p.w = pkbf_c(hi[2], hi[3]);
    return __builtin_bit_cast(bf16x8, p);
}
template <int VAR>
__device__ __forceinline__ void phase_dn_scan(int l, LAS unsigned char* lds) {
    const KArgs ap = get_args();
#define a (*ap)
    const int tid = fresh_tid(), lane = tid & 63, wave = __builtin_amdgcn_readfirstlane(tid >> 6), bx = fresh_bx();
    unsigned char* ws = a.ws;
    if (bx >= 32) return;
    const int chain = bx >> 1, half = bx & 1, b = chain >> 3, h = (chain >> 1) & 3, dir = chain & 1;
    const unsigned char* recb = ws + WS_REC + (size_t)((b * 4 + h) * NCH) * REC_BYTES;
    constexpr int BUFSZ = 74752;
#define CIDX(n) (dir ? ((n) < 4 ? 3 - (n) : 263 - (n)) : (n))
    if (wave >= 4) {
        const int sw = wave - 4;
#define DN_PIECE(i_) ((sw + 4 * (i_)) < 73 ? (sw + 4 * (i_)) : 72)
#define DN_SRC(rec_, p_) ((p_) < 48 ? (rec_) + (p_) * 1024 : (p_) < 65 ? (rec_) + REC_DIR + dir * REC_DIRSZ + ((p_) - 48) * 1024 : (rec_) + REC_V + half * 8192 + ((p_) - 65) * 1024)
#define DN_STAGE(n, bi) do { const unsigned char* rec_ = recb + (size_t)CIDX(n) * REC_BYTES; _Pragma("unroll") for (int i_ = 0; i_ < 19; ++i_) { const int p_ = DN_PIECE(i_); \
        __builtin_amdgcn_global_load_lds((const unsigned*)(DN_SRC(rec_, p_) + lane * 16), (LAS unsigned*)(lds + (bi) * BUFSZ + p_ * 1024), 16, 0, 0); } } while (0)
#define DN_SYNC() do { asm volatile("s_waitcnt vmcnt(0)" ::: "memory"); __builtin_amdgcn_s_barrier(); asm volatile("" ::: "memory"); } while (0)
        if (VAR != 3) DN_STAGE(0, 0);
        DN_SYNC();
        for (int n = 0; n < NCH; ++n) {
            if (VAR != 3 && n + 1 < NCH) DN_STAGE(n + 1, (n + 1) & 1);
            DN_SYNC();
        }
#undef DN_STAGE
#undef DN_PIECE
#undef DN_SRC
#undef DN_SYNC
    } else {
        const int sl = half * 4 + wave, c16 = lane & 15, g4 = lane >> 4;
        bf16_t* Og = (bf16_t*)(ws + (dir ? WS_OB : WS_OF)) + h * 128 + sl * 16 + c16;
        f32x4 S[8];
#pragma unroll
        for (int i = 0; i < 8; ++i) S[i] = (f32x4){0.f, 0.f, 0.f, 0.f};
        asm volatile("s_waitcnt lgkmcnt(0)" ::: "memory"); __builtin_amdgcn_s_barrier(); asm volatile("" ::: "memory");
        for (int n = 0; n < NCH; ++n) {
            if (VAR == 2) { asm volatile("s_waitcnt lgkmcnt(0)" ::: "memory"); __builtin_amdgcn_s_barrier(); asm volatile("" ::: "memory"); continue; }
            const LAS unsigned char* buf = lds + (n & 1) * BUFSZ;
            const int cidx = CIDX(n);
            const u32x4 vc0 = *(const LAS u32x4*)(buf + 66560 + wave * 2048 + lane * 32), vc1 = *(const LAS u32x4*)(buf + 66560 + wave * 2048 + lane * 32 + 16);
#define FR(off, f) (*(const LAS bf16x8*)(buf + (off) + (f) * 1024 + lane * 16))
#define MF(A, B, C) __builtin_amdgcn_mfma_f32_16x16x32_bf16((A), (B), (C), 0, 0, 0)
#define SB_() __builtin_amdgcn_sched_barrier(0)
            bf16x8 fa[8], fb[8];
            f32x4 eg[4], dl[4];
#pragma unroll
            for (int mt = 0; mt < 4; ++mt) { eg[mt] = *(const LAS f32x4*)(buf + 65536 + (16 * mt + 4 * g4) * 4); dl[mt] = *(const LAS f32x4*)(buf + 65536 + 256 + (16 * mt + 4 * g4) * 4); }
            const float egl = *(const LAS float*)(buf + 65536 + 512);
#define RD_KQ(dst, q) do { _Pragma("unroll") for (int mt = 0; mt < 4; ++mt) { dst[mt] = FR(0, mt * 4 + (q)); dst[4 + mt] = FR(32768, mt * 4 + (q)); } } while (0)
#define MM_KQ(src, q) do { _Pragma("unroll") for (int mt = 0; mt < 4; ++mt) { X[mt] = MF(src[mt], Sb[q], X[mt]); O[mt] = MF(src[4 + mt], Sb[q], O[mt]); } } while (0)
            f32x4 X[4], O[4], VN[4];
#pragma unroll
            for (int i = 0; i < 4; ++i) { X[i] = (f32x4){0.f, 0.f, 0.f, 0.f}; O[i] = (f32x4){0.f, 0.f, 0.f, 0.f}; VN[i] = (f32x4){0.f, 0.f, 0.f, 0.f}; }
            bf16x8 Sb[4];
#pragma unroll
            for (int q = 0; q < 4; ++q) Sb[q] = pack44(S[2 * q], S[2 * q + 1]);
            RD_KQ(fa, 0); SB_();
            RD_KQ(fb, 1); SB_(); MM_KQ(fa, 0); SB_();
            RD_KQ(fa, 2); SB_(); MM_KQ(fb, 1); SB_();
            RD_KQ(fb, 3); SB_(); MM_KQ(fa, 2); SB_();
#pragma unroll
            for (int i = 0; i < 8; ++i) fa[i] = FR(49152, i);
            SB_(); MM_KQ(fb, 3); SB_();
#pragma unroll
            for (int mt = 0; mt < 4; ++mt) { const unsigned w0 = (mt < 2 ? vc0 : vc1)[2 * (mt & 1)], w1 = (mt < 2 ? vc0 : vc1)[2 * (mt & 1) + 1];
                X[mt][0] = bflo(w0) - eg[mt][0] * X[mt][0]; X[mt][1] = bfhi(w0) - eg[mt][1] * X[mt][1]; X[mt][2] = bflo(w1) - eg[mt][2] * X[mt][2]; X[mt][3] = bfhi(w1) - eg[mt][3] * X[mt][3]; }
            const bf16x8 Yb0 = pack44(X[0], X[1]), Yb1 = pack44(X[2], X[3]);
            SB_();
#pragma unroll
            for (int i = 0; i < 8; ++i) fb[i] = FR(57344, i);
            SB_();
#pragma unroll
            for (int mt = 0; mt < 4; ++mt) { VN[mt] = MF(fa[mt * 2], Yb0, VN[mt]); VN[mt] = MF(fa[mt * 2 + 1], Yb1, VN[mt]); }
            SB_();
#pragma unroll
            for (int mt = 0; mt < 4; ++mt) O[mt] = O[mt] * eg[mt];
            const bf16x8 Vb0 = pack44(VN[0], VN[1]), Vb1 = pack44(VN[2], VN[3]);
            SB_();
#pragma unroll
            for (int i = 0; i < 8; ++i) fa[i] = FR(16384, i);
            SB_();
#pragma unroll
            for (int mt = 0; mt < 4; ++mt) { O[mt] = MF(fb[mt * 2], Vb0, O[mt]); O[mt] = MF(fb[mt * 2 + 1], Vb1, O[mt]); }
            SB_();
#pragma unroll
            for (int mt = 0; mt < 4; ++mt) VN[mt] = VN[mt] * dl[mt];
            const bf16x8 Vd0 = pack44(VN[0], VN[1]), Vd1 = pack44(VN[2], VN[3]);
#pragma unroll
            for (int i = 0; i < 8; ++i) S[i] = S[i] * egl;
            SB_();
#pragma unroll
            for (int i = 0; i < 8; ++i) fb[i] = FR(16384, 8 + i);
            SB_();
#pragma unroll
            for (int i = 0; i < 4; ++i) { S[i] = MF(fa[i * 2], Vd0, S[i]); S[i] = MF(fa[i * 2 + 1], Vd1, S[i]); }
            SB_();
#pragma unroll
            for (int i = 0; i < 4; ++i) { S[4 + i] = MF(fb[i * 2], Vd0, S[4 + i]); S[4 + i] = MF(fb[i * 2 + 1], Vd1, S[4 + i]); }
            SB_();
            {
                const int row0 = cidx < 4 ? ML + b * CT + cidx * 64 : b * T + (cidx - 4) * 64;
                bf16_t* op = Og + (size_t)(row0 + 4 * g4) * 512;
#pragma unroll
                for (int mt = 0; mt < 4; ++mt)
#pragma unroll
                    for (int t = 0; t < 4; ++t) { if (VAR != 1) op[(size_t)(16 * mt + t) * 512] = (bf16_t)(pkbf_c(O[mt][t], 0.f) & 0xffffu); else asm volatile("" :: "v"(O[mt][t])); }
            }
#undef RD_KQ
#undef MM_KQ
#undef SB_
#undef FR
#undef MF
            asm volatile("s_waitcnt lgkmcnt(0)" ::: "memory"); __builtin_amdgcn_s_barrier(); asm volatile("" ::: "memory");
        }
    }
#undef CIDX
#undef a
}

__device__ __forceinline__ void phase_dn_out(int l) {
    const KArgs ap = get_args();
#define a (*ap)

    const int tid = fresh_tid(), lane = tid & 63, wave = __builtin_amdgcn_readfirstlane(tid >> 6), G = fresh_g(), bx = fresh_bx();
    unsigned char* ws = a.ws;
    const int nrows = (l == DEPTH - 1) ? ML : M;
    const bf16_t* OF = (const bf16_t*)(ws + WS_OF); const bf16_t* OB = (const bf16_t*)(ws + WS_OB);
    const bf16_t* P = (const bf16_t*)(ws + WS_P); bf16_t* CAT = (bf16_t*)(ws + WS_CAT);
    const f32x2 nw = *(const f32x2*)(a.in[I_DNW] + l * 128 + 2 * lane);
    const float* LSE = (const float*)(ws + WS_BA);
    for (int row = wave * G + bx; row < nrows; row += G * 8) {
        f32x2 of[4], ob[4]; unsigned gw[4];
#pragma unroll
        for (int hh = 0; hh < 4; ++hh) { const unsigned wf_ = *(const unsigned*)(OF + (size_t)row * 512 + hh * 128 + 2 * lane), wb_ = *(const unsigned*)(OB + (size_t)row * 512 + hh * 128 + 2 * lane); of[hh] = (f32x2){bflo(wf_), bfhi(wf_)}; ob[hh] = (f32x2){bflo(wb_), bfhi(wb_)};
            gw[hh] = *(const unsigned*)(P + (size_t)row * NP + 2560 + hh * 128 + 2 * lane); }
        u32x4 ap_[4]; float ls_[4];
#pragma unroll
        for (int p = 0; p < 4; ++p) { ap_[p] = (u32x4){0u, 0u, 0u, 0u}; ls_[p] = 0.f; }
        if (row < ML) {
            ap_[0] = *(const u32x4*)(CAT + (size_t)row * 1024 + 8 * lane); ap_[1] = *(const u32x4*)((const bf16_t*)(ws + WS_DQ) + (size_t)row * 512 + 8 * lane);
            ap_[2] = *(const u32x4*)((const bf16_t*)(ws + WS_DK) + (size_t)row * 512 + 8 * lane); ap_[3] = *(const u32x4*)((const bf16_t*)(ws + WS_DV) + (size_t)row * 512 + 8 * lane);
#pragma unroll
            for (int p = 0; p < 4; ++p) ls_[p] = LSE[((size_t)p * ML + row) * 4 + (lane >> 4)]; }
        float o0[4], o1[4], ssq[4];
#pragma unroll
        for (int hh = 0; hh < 4; ++hh) { o0[hh] = of[hh][0] + ob[hh][0]; o1[hh] = of[hh][1] + ob[hh][1]; ssq[hh] = o0[hh] * o0[hh] + o1[hh] * o1[hh]; }
#pragma unroll
        for (int hh = 0; hh < 4; ++hh) ssq[hh] = wave_sum(ssq[hh]);
        float mxv = 0.f;
#pragma unroll
        for (int hh = 0; hh < 4; ++hh) { const float rs = rsqrtf(ssq[hh] * (1.f / 128.f) + EPS); const float g0 = bflo(gw[hh]), g1 = bfhi(gw[hh]);
            o0[hh] = o0[hh] * rs * nw[0] * silu_f(g0); o1[hh] = o1[hh] * rs * nw[1] * silu_f(g1); mxv = fmaxf(mxv, fmaxf(fabsf(o0[hh]), fabsf(o1[hh]))); }
        float av[8];
        if (row < ML) { const float mx = fmaxf(fmaxf(ls_[0], ls_[1]), fmaxf(ls_[2], ls_[3]));
            float w_[4], wsum = 0.f;
#pragma unroll
            for (int p = 0; p < 4; ++p) { w_[p] = __expf(ls_[p] - mx); wsum += w_[p]; }
            const float inv = 1.f / wsum;
#pragma unroll
            for (int i = 0; i < 4; ++i) { float lo = 0.f, hi2 = 0.f;
#pragma unroll
                for (int p = 0; p < 4; ++p) { lo = fmaf(w_[p], bflo(ap_[p][i]), lo); hi2 = fmaf(w_[p], bfhi(ap_[p][i]), hi2); }
                av[2 * i] = lo * inv; av[2 * i + 1] = hi2 * inv; } }
        else { const u32x4 cw_ = *(const u32x4*)(CAT + (size_t)row * 1024 + 8 * lane);
#pragma unroll
            for (int i = 0; i < 4; ++i) { av[2 * i] = bflo(cw_[i]); av[2 * i + 1] = bfhi(cw_[i]); } }
#pragma unroll
        for (int i = 0; i < 8; ++i) mxv = fmaxf(mxv, fabsf(av[i]));
        mxv = fmaxf(wave_max(mxv), 1e-30f);
        const float cinv = 127.f / mxv;
        signed char* crow = (signed char*)(ws + WS_CATQ) + (size_t)row * 1024;
#define Q8_(x) ((unsigned)(int)rintf((x) * cinv) & 255u)
        { u32x2 o; o.x = Q8_(av[0]) | (Q8_(av[1]) << 8) | (Q8_(av[2]) << 16) | (Q8_(av[3]) << 24); o.y = Q8_(av[4]) | (Q8_(av[5]) << 8) | (Q8_(av[6]) << 16) | (Q8_(av[7]) << 24); *(u32x2*)(crow + 8 * lane) = o; }
#pragma unroll
        for (int hh = 0; hh < 4; ++hh) *(unsigned short*)(crow + 512 + hh * 128 + 2 * lane) = (unsigned short)(Q8_(o0[hh]) | (Q8_(o1[hh]) << 8));
#undef Q8_
        if (lane == 0) ((float*)(ws + WS_GB))[(1u << 18) + row] = mxv * (1.f / 127.f);
    }
#undef a
}

#define CE_DESC(a_, b_) do { const float hi_ = fmaxf(a_, b_), lo_ = fminf(a_, b_); a_ = hi_; b_ = lo_; } while (0)
__device__ __forceinline__ void bitonic_sort16_desc(float (&v)[16]) {
#pragma unroll
    for (int k = 2; k <= 16; k <<= 1)
#pragma unroll
        for (int j = k >> 1; j > 0; j >>= 1)
#pragma unroll
            for (int i = 0; i < 16; ++i) { const int p = i ^ j; if (p > i) { if ((i & k) == 0) CE_DESC(v[i], v[p]); else CE_DESC(v[p], v[i]); } }
}
__device__ __forceinline__ void merge_top16_desc(float (&lst)[16], const float (&nw)[16]) {
#pragma unroll
    for (int i = 0; i < 16; ++i) lst[i] = fmaxf(lst[i], nw[15 - i]);
#pragma unroll
    for (int j = 8; j > 0; j >>= 1)
#pragma unroll
        for (int i = 0; i < 16; ++i) { const int p = i ^ j; if (p > i) CE_DESC(lst[i], lst[p]); }
}
__device__ __forceinline__ void phase_peer_select(int l) {
    const KArgs ap = get_args();
#define a (*ap)
    const int tid = fresh_tid(), lane = tid & 63, wave = __builtin_amdgcn_readfirstlane(tid >> 6), G = fresh_g(), bx = fresh_bx();
    unsigned char* ws = a.ws;
    const int nrows = (l == DEPTH - 1) ? ML : M;
    const int ntask = (nrows / 32) * 4;
    const bf16_t* Q2 = (const bf16_t*)(ws + WS_P);
    const bf16_t* SKB = (const bf16_t*)(ws + WS_SKB) + (size_t)l * 8 * 2 * 128 * 128;
    int* PIDX = (int*)(ws + WS_PIDX); float* PGATE = (float*)(ws + WS_PGATE);
    const float NEG = -3.0e38f;
    const int r = lane & 31, hi = lane >> 5;
    for (int task = wave * G + bx; task < ntask; task += G * 8) {
        const int tg = task >> 2, hp = task & 3; const int row = tg * 32 + r;
        float mine0[16], mine1[16];
#pragma unroll
        for (int j = 0; j < 16; ++j) { mine0[j] = NEG; mine1[j] = NEG; }
        bf16x8 qA[8], kA[8];
        float lst[16];
#define SEL_QPTR(it_) (Q2 + (size_t)row * 2048 + (2 * hp + ((it_) >> 1)) * 256 + ((it_) & 1) * 128 + 8 * hi)
#define SEL_KPTR(it_, t_) (SKB + (size_t)(((2 * hp + ((it_) >> 1)) * 2 + ((it_) & 1)) * 128 + 32 * (t_) + r) * 128 + 8 * hi)
#define SEL_LDQ(dst, it_) do { const bf16_t* qp_ = SEL_QPTR(it_); _Pragma("unroll") for (int ks = 0; ks < 8; ++ks) dst[ks] = *(const bf16x8*)(qp_ + 16 * ks); } while (0)
#define SEL_LDK(dst, it_, t_) do { const bf16_t* kp_ = SEL_KPTR(it_, t_); _Pragma("unroll") for (int ks = 0; ks < 8; ++ks) dst[ks] = *(const bf16x8*)(kp_ + 16 * ks); } while (0)
#define SEL_RANK(qv, kv, t_) do { f32x16 acc = {}; _Pragma("unroll") for (int ks = 0; ks < 8; ++ks) acc = __builtin_amdgcn_mfma_f32_32x32x16_bf16(kv[ks], qv[ks], acc, 0, 0, 0); \
            const unsigned kb = (unsigned)(32 * (t_) + 4 * hi); float nw_[16]; \
            _Pragma("unroll") for (int i = 0; i < 16; ++i) nw_[i] = __uint_as_float((__float_as_uint(acc[i]) & 0xffffff80u) | (kb + (unsigned)((i & 3) + 8 * (i >> 2)))); \
            bitonic_sort16_desc(nw_); merge_top16_desc(lst, nw_); } while (0)
#define SB_() __builtin_amdgcn_sched_barrier(0)
#pragma unroll
        for (int j = 0; j < 16; ++j) lst[j] = NEG;
#pragma unroll 1
        for (int it = 0; it < 4; ++it) {
            SEL_LDQ(qA, it);
#pragma unroll 1
            for (int t = 0; t < 4; ++t) { SEL_LDK(kA, it, t); SEL_RANK(qA, kA, t); }
            float oth[16];
#pragma unroll
            for (int j = 0; j < 16; ++j) { auto rr = __builtin_amdgcn_permlane32_swap(__float_as_uint(lst[j]), __float_as_uint(lst[j]), false, false); oth[j] = __uint_as_float(hi ? rr[0] : rr[1]); }
            merge_top16_desc(lst, oth);
            const bool k0 = ((it >> 1) == hi) && ((it & 1) == 0), k1 = ((it >> 1) == hi) && ((it & 1) == 1);
#pragma unroll
            for (int j = 0; j < 16; ++j) { mine0[j] = k0 ? lst[j] : mine0[j]; mine1[j] = k1 ? lst[j] : mine1[j]; lst[j] = NEG; }
        }
#undef SB_
#undef SEL_QPTR
#undef SEL_KPTR
#undef SEL_LDQ
#undef SEL_LDK
#undef SEL_RANK
        const int h = 2 * hp + hi;
        float ts[16];
#pragma unroll
        for (int j = 0; j < 16; ++j) ts[j] = NEG;
#pragma unroll
        for (int i = 0; i < 16; ++i)
#pragma unroll
            for (int j = 0; j < 16; ++j) if ((i + 1) * (j + 1) <= 16) {
                const unsigned b0 = __float_as_uint(mine0[i]), b1 = __float_as_uint(mine1[j]);
                const float c = __uint_as_float(b0 & 0xffffff80u) + __uint_as_float(b1 & 0xffffff80u);
                float x = __uint_as_float((__float_as_uint(c) & 0xffffc000u) | ((b0 & 127u) << 7) | (b1 & 127u));
#pragma unroll
                for (int t = 0; t < 16; ++t) { const float hv = fmaxf(ts[t], x); x = fminf(ts[t], x); ts[t] = hv; }
            }
        int te[16]; float ex[16], sum = 0.f;
        const float tmax = __uint_as_float(__float_as_uint(ts[0]) & 0xffffc000u);
#pragma unroll
        for (int t = 0; t < 16; ++t) { const unsigned bt = __float_as_uint(ts[t]); te[t] = (int)(bt & 0x3fffu); ex[t] = __expf(__uint_as_float(bt & 0xffffc000u) - tmax); sum += ex[t]; }
        const float inv = 1.f / sum;
        unsigned short* ip = (unsigned short*)PIDX + (size_t)row * 128 + h * 16; float* gp = PGATE + (size_t)row * 128 + h * 16;
#pragma unroll
        for (int t = 0; t < 16; t += 8) *(u32x4*)(ip + t) = (u32x4){(unsigned)te[t] | ((unsigned)te[t + 1] << 16), (unsigned)te[t + 2] | ((unsigned)te[t + 3] << 16), (unsigned)te[t + 4] | ((unsigned)te[t + 5] << 16), (unsigned)te[t + 6] | ((unsigned)te[t + 7] << 16)};
#pragma unroll
        for (int t = 0; t < 16; t += 4) *(f32x4*)(gp + t) = (f32x4){ex[t] * inv, ex[t + 1] * inv, ex[t + 2] * inv, ex[t + 3] * inv};
    }
#undef a
}

template <bool WR, int GV = 0>
__device__ __forceinline__ void phase_peer_gather(int l, LAS unsigned char* lds) {
    const KArgs ap = get_args();
#define a (*ap)
    const int tid = fresh_tid(), lane = tid & 63, wave = __builtin_amdgcn_readfirstlane(tid >> 6), G = fresh_g(), bx = fresh_bx();
    unsigned char* ws = a.ws;
    const int nrows = (l == DEPTH - 1) ? ML : M;
    const unsigned char* UB = ws + WS_UB + (size_t)(l & 1) * TAB_SET; const unsigned char* VB = UB + 1024;
    const float* USC = (const float*)(ws + WS_USC) + (l & 1) * 2 * NEXP; const float* VSC = USC + NEXP;
    const int* PIDX = (const int*)(ws + WS_PIDX); const float* PGATE = (const float*)(ws + WS_PGATE);
    const float* modl = (const float*)(ws + WS_MOD) + (size_t)l * 3 * 6144 + 5120;
    const bool fuse = WR && (l + 1 < DEPTH);
    LAS float* wsk = (LAS float*)lds;
    if (fuse) { const float* src = (const float*)(ws + WS_WSK) + (size_t)(l + 1) * 16384; for (int i = tid; i < 16384 / 4; i += 512) ((LAS f32x4*)wsk)[i] = ((const f32x4*)src)[i]; __syncthreads(); }
    const float* nw1 = a.in[I_N1W] + (l + 1 < DEPTH ? l + 1 : l) * 1024 + 16 * lane;
    const float* modn = (const float*)(ws + WS_MOD) + (size_t)(l + 1 < DEPTH ? l + 1 : l) * 3 * 6144;
    for (int row = wave * G + bx; row < nrows; row += G * 8) {
        float hv[16], out[16];
        { const u32x4 hw = *(const u32x4*)((const signed char*)(ws + WS_H) + (size_t)row * D + 16 * lane); const float hsc = ((const float*)(ws + WS_GB))[row];
#pragma unroll
          for (int q = 0; q < 4; ++q) { const int w = (int)hw[q]; hv[4 * q + 0] = (float)((w << 24) >> 24) * hsc; hv[4 * q + 1] = (float)((w << 16) >> 24) * hsc; hv[4 * q + 2] = (float)((w << 8) >> 24) * hsc; hv[4 * q + 3] = (float)(w >> 24) * hsc; } }
        float hs = 0.f;
#pragma unroll
        for (int i = 0; i < 16; ++i) { out[i] = 0.f; hs += hv[i]; }
        const float hsum128 = 128.f * wave_sum(hs);
        float wacc = 0.f;
        const int id0 = PIDX[(size_t)row * 128 + lane], id1 = PIDX[(size_t)row * 128 + 64 + lane];
        const float gt0 = PGATE[(size_t)row * 128 + lane], gt1 = PGATE[(size_t)row * 128 + 64 + lane];
        const float us0 = USC[id0], us1 = USC[id1], vs0 = VSC[id0], vs1 = VSC[id1];
        for (int e0 = 0; e0 < 128; e0 += 8) {
            u32x4 uw[8], vw[8]; float gte[8], use[8], vse[8];
#pragma unroll
            for (int j = 0; j < 8; ++j) { const int e = e0 + j; const int id = __builtin_amdgcn_readlane(e0 < 64 ? id0 : id1, e & 63);
                gte[j] = __builtin_bit_cast(float, __builtin_amdgcn_readlane(__builtin_bit_cast(int, e0 < 64 ? gt0 : gt1), e & 63));
                use[j] = __builtin_bit_cast(float, __builtin_amdgcn_readlane(__builtin_bit_cast(int, e0 < 64 ? us0 : us1), e & 63));
                vse[j] = __builtin_bit_cast(float, __builtin_amdgcn_readlane(__builtin_bit_cast(int, e0 < 64 ? vs0 : vs1), e & 63));
                uw[j] = *(const u32x4*)(UB + (size_t)id * 2048 + 16 * lane); vw[j] = *(const u32x4*)(VB + (size_t)id * 2048 + 16 * lane); }
#pragma unroll
            for (int j = 0; j < 8; ++j) {
                float d0 = 0.f, d1 = 0.f;
#pragma unroll
                for (int q = 0; q < 4; ++q) { const unsigned w = uw[j][q];
                    d0 = fmaf((float)(w & 255u), hv[4 * q + 0], d0); d1 = fmaf((float)((w >> 8) & 255u), hv[4 * q + 1], d1);
                    d0 = fmaf((float)((w >> 16) & 255u), hv[4 * q + 2], d0); d1 = fmaf((float)(w >> 24), hv[4 * q + 3], d1); }
                const float dsum = (wave_sum(d0 + d1) - hsum128) * use[j];
                const float act = 0.5f * dsum * (1.f + erff(dsum * 0.70710678118654752f));
                const float wgt = gte[j] * act * vse[j];
                wacc += wgt;
                if (GV == 1) { asm volatile("" :: "v"(vw[j])); out[0] += wgt; } else
#pragma unroll
                for (int q = 0; q < 4; ++q) { const unsigned w = vw[j][q];
                    out[4 * q + 0] = fmaf(wgt, (float)(w & 255u), out[4 * q + 0]); out[4 * q + 1] = fmaf(wgt, (float)((w >> 8) & 255u), out[4 * q + 1]);
                    out[4 * q + 2] = fmaf(wgt, (float)((w >> 16) & 255u), out[4 * q + 2]); out[4 * q + 3] = fmaf(wgt, (float)(w >> 24), out[4 * q + 3]); }
            }
        }
        const float corr = 128.f * wacc;
        float* xr; int mrow;
        if (row < ML) { xr = a.out + (size_t)row * D; mrow = row >= T ? 1 : 0; } else { xr = (float*)(ws + WS_CTXX) + (size_t)(row - ML) * D; mrow = 2; }
        const float* g2 = modl + mrow * 6144 + 16 * lane;
        f32x4 xn[4];
#pragma unroll
        for (int i = 0; i < 4; ++i) { const f32x4 x = *(const f32x4*)(xr + 16 * lane + 4 * i), g = *(const f32x4*)(g2 + 4 * i);
            xn[i] = x + g * (f32x4){out[4 * i] - corr, out[4 * i + 1] - corr, out[4 * i + 2] - corr, out[4 * i + 3] - corr};
            if (WR) *(f32x4*)(xr + 16 * lane + 4 * i) = xn[i]; else asm volatile("" :: "v"(xn[i])); }
        if (fuse) {
            float ss = 0.f;
#pragma unroll
            for (int i = 0; i < 4; ++i) ss += (xn[i][0] * xn[i][0] + xn[i][1] * xn[i][1]) + (xn[i][2] * xn[i][2] + xn[i][3] * xn[i][3]);
            const float rstd = rsqrtf(wave_sum(ss) * (1.f / D) + EPS);
            const float* md = modn + mrow * 6144 + 16 * lane;
#pragma unroll
            for (int i = 0; i < 4; ++i) { const f32x4 nwv = *(const f32x4*)(nw1 + 4 * i), sc = *(const f32x4*)(md + 1024 + 4 * i), sh = *(const f32x4*)(md + 4 * i);
                xn[i] = xn[i] * rstd * nwv * (sc + 1.f) + sh; }
            { float hmx = 0.f;
#pragma unroll
              for (int i = 0; i < 4; ++i) hmx = fmaxf(hmx, fmaxf(fmaxf(fabsf(xn[i][0]), fabsf(xn[i][1])), fmaxf(fabsf(xn[i][2]), fabsf(xn[i][3]))));
              hmx = fmaxf(wave_max(hmx), 1e-30f); const float hinv = 127.f / hmx;
              u32x4 o;
#pragma unroll
              for (int i = 0; i < 4; ++i) o[i] = ((unsigned)(int)rintf(xn[i][0] * hinv) & 255u) | (((unsigned)(int)rintf(xn[i][1] * hinv) & 255u) << 8) | (((unsigned)(int)rintf(xn[i][2] * hinv) & 255u) << 16) | (((unsigned)(int)rintf(xn[i][3] * hinv) & 255u) << 24);
              *(u32x4*)((signed char*)(ws + WS_H) + (size_t)row * D + 16 * lane) = o;
              if (lane == 0) ((float*)(ws + WS_GB))[row] = hmx * (1.f / 127.f); }
            float p[16];
#pragma unroll
            for (int c = 0; c < 16; ++c) { float q = 0.f;
#pragma unroll
                for (int i = 0; i < 4; ++i) { const f32x4 w = *(const LAS f32x4*)(wsk + c * 1024 + 16 * lane + 4 * i); q += (xn[i][0] * w[0] + xn[i][1] * w[1]) + (xn[i][2] * w[2] + xn[i][3] * w[3]); }
                p[c] = q; }
            { const bool hb = (lane & 32) != 0;
#pragma unroll
              for (int c = 0; c < 8; ++c) { const float keep = hb ? p[c + 8] : p[c], send = hb ? p[c] : p[c + 8]; p[c] = keep + lane_xor<32>(send); } }
            { const bool hb = (lane & 16) != 0;
#pragma unroll
              for (int c = 0; c < 4; ++c) { const float keep = hb ? p[c + 4] : p[c], send = hb ? p[c] : p[c + 4]; p[c] = keep + lane_xor<16>(send); } }
            { const bool hb = (lane & 8) != 0;
#pragma unroll
              for (int c = 0; c < 2; ++c) { const float keep = hb ? p[c + 2] : p[c], send = hb ? p[c] : p[c + 2]; p[c] = keep + lane_xor<8>(send); } }
            { const bool hb = (lane & 4) != 0; const float keep = hb ? p[1] : p[0], send = hb ? p[0] : p[1]; p[0] = keep + lane_xor<4>(send); }
            p[0] += lane_xor<2>(p[0]); p[0] += lane_xor<1>(p[0]);
            if ((lane & 3) == 0) { const int c = ((lane >> 5) & 1) * 8 + ((lane >> 4) & 1) * 4 + ((lane >> 3) & 1) * 2 + ((lane >> 2) & 1); ((float*)(ws + WS_BA))[(size_t)row * 16 + c] = p[0]; }
        }
    }
    if (fuse) __syncthreads();
}
#undef a
constexpr size_t WS_PART = WS_P;
static_assert(WS_PART + 8 * (size_t)M * 1024 * 2 <= WS_GB, "partials region");
constexpr int GP_ITEM = 16;
struct GpMeta { int id0, id1; float gt0, gt1; u32x4 hw; float hsc; };
__device__ __forceinline__ void phase_peer_gpart(int l, LAS unsigned char* lds) {
    const KArgs ap = get_args();
#define a (*ap)
    const int tid = fresh_tid(), lane = tid & 63, wave = __builtin_amdgcn_readfirstlane(tid >> 6);
    unsigned char* ws = a.ws;
    const int nrows = (l == DEPTH - 1) ? ML : M;
    const int nitem = nrows / GP_ITEM;
    const unsigned char* UB = ws + WS_UB + (size_t)(l & 1) * TAB_SET; const unsigned char* VB = UB + 1024;
    const f32x2* SC2 = (const f32x2*)(ws + WS_USC) + (size_t)(l & 1) * NEXP;
    const int* PIDX = (const int*)(ws + WS_PIDX); const float* PGATE = (const float*)(ws + WS_PGATE);
    LAS u32x4* lst0 = (LAS u32x4*)lds + wave * 256;
    const int eidx = ((lane >> 5) & 1) * 4 + ((lane >> 4) & 1) * 2 + ((lane >> 3) & 1);
    const int x = (int)(xb_xcc_id() & 7u);
#define GP_LOAD_META(m_, row_) do { const int rw_ = (row_); (m_).id0 = PIDX[(size_t)rw_ * 128 + lane]; (m_).id1 = PIDX[(size_t)rw_ * 128 + 64 + lane]; (m_).gt0 = PGATE[(size_t)rw_ * 128 + lane]; (m_).gt1 = PGATE[(size_t)rw_ * 128 + 64 + lane]; \
        (m_).hw = *(const u32x4*)((const signed char*)(ws + WS_H) + (size_t)rw_ * D + 16 * lane); (m_).hsc = ((const float*)(ws + WS_GB))[rw_]; } while (0)
#define GP_LOAD_SC(sa_, sb_, m_) do { sa_ = (f32x2){0.f, 0.f}; sb_ = (f32x2){0.f, 0.f}; if (((m_).id0 >> 11) == p) sa_ = SC2[(m_).id0]; if (((m_).id1 >> 11) == p) sb_ = SC2[(m_).id1]; } while (0)
#define GP_BUILD(cnt_, m_, sa_, sb_, buf_) do { const bool s0_ = ((m_).id0 >> 11) == p, s1_ = ((m_).id1 >> 11) == p; const unsigned long long m0_ = __ballot(s0_), m1_ = __ballot(s1_); \
        const int c0_ = __builtin_popcountll(m0_); cnt_ = __builtin_amdgcn_readfirstlane(c0_ + __builtin_popcountll(m1_)); \
        const int r0_ = (int)__builtin_amdgcn_mbcnt_hi((unsigned)(m0_ >> 32), __builtin_amdgcn_mbcnt_lo((unsigned)m0_, 0u)); \
        const int r1_ = c0_ + (int)__builtin_amdgcn_mbcnt_hi((unsigned)(m1_ >> 32), __builtin_amdgcn_mbcnt_lo((unsigned)m1_, 0u)); \
        LAS u32x4* lb_ = lst0 + (buf_) * 128; \
        if (s0_) lb_[r0_] = (u32x4){(unsigned)(m_).id0, __float_as_uint((m_).gt0 * sa_[1]), __float_as_uint(sa_[0]), 0u}; \
        if (s1_) lb_[r1_] = (u32x4){(unsigned)(m_).id1, __float_as_uint((m_).gt1 * sb_[1]), __float_as_uint(sb_[0]), 0u}; } while (0)
#pragma unroll 1
    for (int pp = 0; pp < 8; ++pp) {
        const int p = (x + pp) & 7;
        unsigned* ctr = (unsigned*)(ws + WS_CTL) + 16384 + (l * 8 + p) * 64;
        unsigned* part = (unsigned*)(ws + WS_PART + (size_t)p * M * 2048);
        unsigned tk = 0; if (lane == 0) tk = __hip_atomic_fetch_add(ctr, 1u, __ATOMIC_RELAXED, __HIP_MEMORY_SCOPE_AGENT);
        int it = __builtin_amdgcn_readfirstlane((int)tk);
#pragma unroll 1
        while (it < nitem) {
            unsigned tn = 0; if (lane == 0) tn = __hip_atomic_fetch_add(ctr, 1u, __ATOMIC_RELAXED, __HIP_MEMORY_SCOPE_AGENT);
            const int row0 = it * GP_ITEM, rowl = row0 + GP_ITEM - 1;
            GpMeta m1, m2, m3; f32x2 sa1, sb1, sa2, sb2; int c_cur, c_nxt; u32x4 hw_cur; float hsc_cur;
            GP_LOAD_META(m1, row0); GP_LOAD_META(m2, min(row0 + 1, rowl)); GP_LOAD_META(m3, min(row0 + 2, rowl));
            GP_LOAD_SC(sa1, sb1, m1);
            GP_BUILD(c_cur, m1, sa1, sb1, 0); hw_cur = m1.hw; hsc_cur = m1.hsc;
            GP_LOAD_SC(sa1, sb1, m2);
            m1 = m2; m2 = m3;
            GP_LOAD_META(m3, min(row0 + 3, rowl));
#pragma unroll 1
            for (int i = 0; i < GP_ITEM; ++i) {
                const int row = row0 + i;
                GP_BUILD(c_nxt, m1, sa1, sb1, (i + 1) & 1);
                const u32x4 hw_nxt = m1.hw; const float hsc_nxt = m1.hsc;
                GP_LOAD_SC(sa2, sb2, m2);
                m1 = m2; sa1 = sa2; sb1 = sb2; m2 = m3;
                GP_LOAD_META(m3, min(row + 4, rowl));
                LAS u32x4* lst = lst0 + (i & 1) * 128;
                const int c = c_cur; const u32x4 hw = hw_cur; const float hsc = hsc_cur;
                f32x2 o2[8];
#pragma unroll
                for (int k = 0; k < 8; ++k) o2[k] = (f32x2){0.f, 0.f};
                float wacc = 0.f;
#pragma unroll 1
                for (int e = 0; e < c; e += 8) {
                    u32x4 uw[8], vw[8];
#pragma unroll
                    for (int j = 0; j < 8; ++j) { const int sl = min(e + j, c - 1);
                        const int id = __builtin_amdgcn_readfirstlane((int)lst[sl][0]);
                        uw[j] = *(const u32x4*)(UB + (size_t)id * 2048 + 16 * lane); vw[j] = *(const u32x4*)(VB + (size_t)id * 2048 + 16 * lane); }
                    const int ms = e + eidx; const u32x4 en = lst[min(ms, c - 1)];
                    float pd[8];
#pragma unroll
                    for (int j = 0; j < 8; ++j) { int d = 0;
#pragma unroll
                        for (int q = 0; q < 4; ++q) d = __builtin_amdgcn_sdot4((int)uw[j][q], (int)hw[q], d, false);
                        pd[j] = (float)d; }
                    { const bool hb = (lane & 32) != 0;
#pragma unroll
                      for (int j = 0; j < 4; ++j) { const float keep = hb ? pd[j + 4] : pd[j], send = hb ? pd[j] : pd[j + 4]; pd[j] = keep + lane_xor<32>(send); } }
                    { const bool hb = (lane & 16) != 0;
#pragma unroll
                      for (int j = 0; j < 2; ++j) { const float keep = hb ? pd[j + 2] : pd[j], send = hb ? pd[j] : pd[j + 2]; pd[j] = keep + lane_xor<16>(send); } }
                    { const bool hb = (lane & 8) != 0; const float keep = hb ? pd[1] : pd[0], send = hb ? pd[0] : pd[1]; pd[0] = keep + lane_xor<8>(send); }
                    pd[0] += lane_xor<4>(pd[0]); pd[0] += lane_xor<2>(pd[0]); pd[0] += lane_xor<1>(pd[0]);
                    const float dsum = pd[0] * (__uint_as_float(en[2]) * hsc);
                    const float act = 0.5f * dsum * (1.f + erff(dsum * 0.70710678118654752f));
                    const float wgt = ms < c ? __uint_as_float(en[1]) * act : 0.f;
                    wacc += wgt;
#pragma unroll
                    for (int j = 0; j < 8; ++j) {
                        const float wj = __builtin_bit_cast(float, __builtin_amdgcn_readlane(__builtin_bit_cast(int, wgt), 32 * ((j >> 2) & 1) + 16 * ((j >> 1) & 1) + 8 * (j & 1)));
                        const f32x2 ww = {wj, wj};
#pragma unroll
                        for (int q = 0; q < 4; ++q) { const unsigned w = vw[j][q];
                            const f32x2 v01 = {(float)(w & 255u), (float)((w >> 8) & 255u)}, v23 = {(float)((w >> 16) & 255u), (float)(w >> 24)};
                            o2[2 * q] = __builtin_elementwise_fma(ww, v01, o2[2 * q]); o2[2 * q + 1] = __builtin_elementwise_fma(ww, v23, o2[2 * q + 1]); }
                    }
                }
                const float corr = 16.f * wave_sum(wacc);
                u32x4 w0, w1;
#pragma unroll
                for (int k = 0; k < 4; ++k) { w0[k] = pkbf_c(o2[k][0] - corr, o2[k][1] - corr); w1[k] = pkbf_c(o2[4 + k][0] - corr, o2[4 + k][1] - corr); }
                unsigned* dst = part + (size_t)row * 512 + 8 * lane;
                __builtin_nontemporal_store(w0, (u32x4*)dst); __builtin_nontemporal_store(w1, (u32x4*)(dst + 4));
                c_cur = c_nxt; hw_cur = hw_nxt; hsc_cur = hsc_nxt;
            }
            it = __builtin_amdgcn_readfirstlane((int)tn);
        }
    }
#undef GP_LOAD_META
#undef GP_LOAD_SC
#undef GP_BUILD
#undef a
}

__device__ __forceinline__ void phase_peer_combine(int l, LAS unsigned char* lds) {
    const KArgs ap = get_args();
#define a (*ap)
    const int tid = fresh_tid(), lane = tid & 63, wave = __builtin_amdgcn_readfirstlane(tid >> 6), G = fresh_g(), bx = fresh_bx();
    unsigned char* ws = a.ws;
    const int nrows = (l == DEPTH - 1) ? ML : M;
    const float* modl = (const float*)(ws + WS_MOD) + (size_t)l * 3 * 6144 + 5120;
    const bool fuse = (l + 1 < DEPTH);
    LAS float* wsk = (LAS float*)lds;
    if (fuse) { const float* src = (const float*)(ws + WS_WSK) + (size_t)(l + 1) * 16384; for (int i = tid; i < 16384 / 4; i += 512) ((LAS f32x4*)wsk)[i] = ((const f32x4*)src)[i]; __syncthreads(); }
    const float* nw1 = a.in[I_N1W] + (l + 1 < DEPTH ? l + 1 : l) * 1024 + 16 * lane;
    const float* modn = (const float*)(ws + WS_MOD) + (size_t)(l + 1 < DEPTH ? l + 1 : l) * 3 * 6144;
    for (int row = wave * G + bx; row < nrows; row += G * 8) {
        float out[16];
#pragma unroll
        for (int i = 0; i < 16; ++i) out[i] = 0.f;
#pragma unroll
        for (int p = 0; p < 8; ++p) { const unsigned* src = (const unsigned*)(ws + WS_PART + (size_t)p * M * 2048) + (size_t)row * 512 + 8 * lane;
            const u32x4 w0 = __builtin_nontemporal_load((const u32x4*)src), w1 = __builtin_nontemporal_load((const u32x4*)(src + 4));
#pragma unroll
            for (int k = 0; k < 4; ++k) { out[2 * k] += bflo(w0[k]); out[2 * k + 1] += bfhi(w0[k]); out[8 + 2 * k] += bflo(w1[k]); out[8 + 2 * k + 1] += bfhi(w1[k]); } }
        float* xr; int mrow;
        if (row < ML) { xr = a.out + (size_t)row * D; mrow = row >= T ? 1 : 0; } else { xr = (float*)(ws + WS_CTXX) + (size_t)(row - ML) * D; mrow = 2; }
        const float* g2 = modl + mrow * 6144 + 16 * lane;
        f32x4 xn[4];
#pragma unroll
        for (int i = 0; i < 4; ++i) { const f32x4 x = *(const f32x4*)(xr + 16 * lane + 4 * i), g = *(const f32x4*)(g2 + 4 * i);
            xn[i] = x + g * (f32x4){out[4 * i], out[4 * i + 1], out[4 * i + 2], out[4 * i + 3]};
            *(f32x4*)(xr + 16 * lane + 4 * i) = xn[i]; }
        if (fuse) {
            float ss = 0.f;
#pragma unroll
            for (int i = 0; i < 4; ++i) ss += (xn[i][0] * xn[i][0] + xn[i][1] * xn[i][1]) + (xn[i][2] * xn[i][2] + xn[i][3] * xn[i][3]);
            const float rstd = rsqrtf(wave_sum(ss) * (1.f / D) + EPS);
            const float* md = modn + mrow * 6144 + 16 * lane;
#pragma unroll
            for (int i = 0; i < 4; ++i) { const f32x4 nwv = *(const f32x4*)(nw1 + 4 * i), sc = *(const f32x4*)(md + 1024 + 4 * i), sh = *(const f32x4*)(md + 4 * i);
                xn[i] = xn[i] * rstd * nwv * (sc + 1.f) + sh; }
            { float hmx = 0.f;
#pragma unroll
              for (int i = 0; i < 4; ++i) hmx = fmaxf(hmx, fmaxf(fmaxf(fabsf(xn[i][0]), fabsf(xn[i][1])), fmaxf(fabsf(xn[i][2]), fabsf(xn[i][3]))));
              hmx = fmaxf(wave_max(hmx), 1e-30f); const float hinv = 127.f / hmx;
              u32x4 o;
#pragma unroll
              for (int i = 0; i < 4; ++i) o[i] = ((unsigned)(int)rintf(xn[i][0] * hinv) & 255u) | (((unsigned)(int)rintf(xn[i][1] * hinv) & 255u) << 8) | (((unsigned)(int)rintf(xn[i][2] * hinv) & 255u) << 16) | (((unsigned)(int)rintf(xn[i][3] * hinv) & 255u) << 24);
              *(u32x4*)((signed char*)(ws + WS_H) + (size_t)row * D + 16 * lane) = o;
              if (lane == 0) ((float*)(ws + WS_GB))[row] = hmx * (1.f / 127.f); }
            float p[16];
#pragma unroll
            for (int c = 0; c < 16; ++c) { float q = 0.f;
#pragma unroll
                for (int i = 0; i < 4; ++i) { const f32x4 w = *(const LAS f32x4*)(wsk + c * 1024 + 16 * lane + 4 * i); q += (xn[i][0] * w[0] + xn[i][1] * w[1]) + (xn[i][2] * w[2] + xn[i][3] * w[3]); }
                p[c] = q; }
            { const bool hb = (lane & 32) != 0;
#pragma unroll
              for (int c = 0; c < 8; ++c) { const float keep = hb ? p[c + 8] : p[c], send = hb ? p[c] : p[c + 8]; p[c] = keep + lane_xor<32>(send); } }
            { const bool hb = (lane & 16) != 0;
#pragma unroll
              for (int c = 0; c < 4; ++c) { const float keep = hb ? p[c + 4] : p[c], send = hb ? p[c] : p[c + 4]; p[c] = keep + lane_xor<16>(send); } }
            { const bool hb = (lane & 8) != 0;
#pragma unroll
              for (int c = 0; c < 2; ++c) { const float keep = hb ? p[c + 2] : p[c], send = hb ? p[c] : p[c + 2]; p[c] = keep + lane_xor<8>(send); } }
            { const bool hb = (lane & 4) != 0; const float keep = hb ? p[1] : p[0], send = hb ? p[0] : p[1]; p[0] = keep + lane_xor<4>(send); }
            p[0] += lane_xor<2>(p[0]); p[0] += lane_xor<1>(p[0]);
            if ((lane & 3) == 0) { const int c = ((lane >> 5) & 1) * 8 + ((lane >> 4) & 1) * 4 + ((lane >> 3) & 1) * 2 + ((lane >> 2) & 1); ((float*)(ws + WS_BA))[(size_t)row * 16 + c] = p[0]; }
        }
    }
    if (fuse) __syncthreads();
#undef a
}
constexpr size_t WS_PD = WS_REC;
constexpr size_t WS_PW = WS_REC + 8 * (size_t)M * 128 * 4;
constexpr size_t WS_PC = WS_PW + (size_t)M * 128;
static_assert(WS_PC + (size_t)M * 8 * 4 <= WS_END, "sliced gather scratch");
constexpr int GS_ITEM = 8;
template <int PH>
__device__ __forceinline__ void phase_peer_slice(int l, int cslot) {
    const KArgs ap = get_args();
#define a (*ap)
    const int tid = fresh_tid(), lane = tid & 63;
    unsigned char* ws = a.ws;
    const int nrows = (l == DEPTH - 1) ? ML : M;
    const int nitem = nrows / GS_ITEM;
    const unsigned char* TAB = ws + WS_UB + (size_t)(l & 1) * TAB_SET + (PH ? (size_t)NEXP * 1024 : 0);
    const int* PIDX = (const int*)(ws + WS_PIDX);
    const unsigned char* PW = ws + WS_PW; const float* PC = (const float*)(ws + WS_PC);
    const float* modl = (const float*)(ws + WS_MOD) + (size_t)l * 3 * 6144 + 5120;
    const int g = lane >> 3, i8 = lane & 7;
    const int x = (int)(xb_xcc_id() & 7u);
#pragma unroll 1
    for (int pp = 0; pp < 8; ++pp) {
        const int p = (x + pp) & 7;
        unsigned* ctr = (unsigned*)(ws + WS_CTL) + 16384 + ((l * 2 + PH) * 8 + p) * 64 + cslot * 8192;
        const unsigned char* tb = TAB + (size_t)p * NEXP * 128 + 16 * i8;
        unsigned tk = 0; if (lane == 0) tk = __hip_atomic_fetch_add(ctr, 1u, __ATOMIC_RELAXED, __HIP_MEMORY_SCOPE_AGENT);
        int it = __builtin_amdgcn_readfirstlane((int)tk);
        if (it < nitem) {
            unsigned tn = 0; if (lane == 0) tn = __hip_atomic_fetch_add(ctr, 1u, __ATOMIC_RELAXED, __HIP_MEMORY_SCOPE_AGENT);
            const int row0 = it * GS_ITEM;
            u32x4 idc[2], idn[2], ra[8], rb[8]; u32x4 wc, wn; float sc_c, sc_n; u32x4 hc, hn;
#define GS_META(ids_, wts_, wsc_, h_, row_) do { const int rw_ = (row_); const u32x4* ip_ = (const u32x4*)((const unsigned short*)PIDX + (size_t)rw_ * 128 + 16 * g); ids_[0] = ip_[0]; ids_[1] = ip_[1]; \
                if (PH) { wts_ = *(const u32x4*)(PW + (size_t)rw_ * 128 + 16 * g); wsc_ = PC[(size_t)rw_ * 8 + g]; } \
                else h_ = *(const u32x4*)((const signed char*)(ws + WS_H) + (size_t)rw_ * D + 128 * p + 16 * i8); } while (0)
#define GS_ROWS(dst_, ids_, hf_) do { _Pragma("unroll") for (int k_ = 0; k_ < 8; ++k_) dst_[k_] = *(const u32x4*)(tb + (size_t)((ids_[hf_][k_ >> 1] >> (16 * (k_ & 1))) & 0xffffu) * 128); } while (0)
            GS_META(idc, wc, sc_c, hc, row0);
            GS_ROWS(ra, idc, 0);
            GS_META(idn, wn, sc_n, hn, row0 + 1);
            int i = 0, tnv = 0x7fffffff;
#pragma unroll 1
            for (;;) {
                if (i == GS_ITEM - 2) tnv = __builtin_amdgcn_readfirstlane((int)tn);
                const int row = it * GS_ITEM + i;
                const int r2 = (i + 2 < GS_ITEM) ? row + 2 : (tnv < nitem ? tnv * GS_ITEM + (i + 2 - GS_ITEM) : row);
                GS_ROWS(rb, idc, 1);
                if (PH == 0) {
                    int d[16];
#pragma unroll
                    for (int k = 0; k < 8; ++k) { int s_ = 0;
#pragma unroll
                        for (int q = 0; q < 4; ++q) s_ = __builtin_amdgcn_sdot4((int)ra[k][q], (int)hc[q], s_, false);
                        d[k] = s_; }
                    GS_ROWS(ra, idn, 0);
#pragma unroll
                    for (int k = 0; k < 8; ++k) { int s_ = 0;
#pragma unroll
                        for (int q = 0; q < 4; ++q) s_ = __builtin_amdgcn_sdot4((int)rb[k][q], (int)hc[q], s_, false);
                        d[8 + k] = s_; }
#define GS_IX(v_, K_) __builtin_bit_cast(int, lane_xor<K_>(__builtin_bit_cast(float, v_)))
                    { const bool hb = (lane & 4) != 0;
#pragma unroll
                      for (int j = 0; j < 8; ++j) { const int keep = hb ? d[j + 8] : d[j], send = hb ? d[j] : d[j + 8]; d[j] = keep + GS_IX(send, 4); } }
                    { const bool hb = (lane & 2) != 0;
#pragma unroll
                      for (int j = 0; j < 4; ++j) { const int keep = hb ? d[j + 4] : d[j], send = hb ? d[j] : d[j + 4]; d[j] = keep + GS_IX(send, 2); } }
                    { const bool hb = (lane & 1) != 0;
#pragma unroll
                      for (int j = 0; j < 2; ++j) { const int keep = hb ? d[j + 2] : d[j], send = hb ? d[j] : d[j + 2]; d[j] = keep + GS_IX(send, 1); } }
#undef GS_IX
                    u32x2 o = {(unsigned)d[0], (unsigned)d[1]};
                    __builtin_nontemporal_store(o, (u32x2*)((int*)(ws + WS_PD) + ((size_t)p * M + row) * 128 + 2 * lane));
                } else {
                    int oi[16];
#pragma unroll
                    for (int k = 0; k < 16; ++k) oi[k] = 0;
#define GS_QUAD(rr_, qd_, wd_) do { _Pragma("unroll") for (int q_ = 0; q_ < 4; ++q_) { \
                        const unsigned r0_ = rr_[4 * (qd_) + 0][q_], r1_ = rr_[4 * (qd_) + 1][q_], r2_ = rr_[4 * (qd_) + 2][q_], r3_ = rr_[4 * (qd_) + 3][q_]; \
                        const unsigned t0_ = __builtin_amdgcn_perm(r1_, r0_, 0x05010400u), t1_ = __builtin_amdgcn_perm(r1_, r0_, 0x07030602u), t2_ = __builtin_amdgcn_perm(r3_, r2_, 0x05010400u), t3_ = __builtin_amdgcn_perm(r3_, r2_, 0x07030602u); \
                        oi[4 * q_ + 0] = __builtin_amdgcn_sdot4((int)__builtin_amdgcn_perm(t2_, t0_, 0x05040100u), (int)(wd_), oi[4 * q_ + 0], false); \
                        oi[4 * q_ + 1] = __builtin_amdgcn_sdot4((int)__builtin_amdgcn_perm(t2_, t0_, 0x07060302u), (int)(wd_), oi[4 * q_ + 1], false); \
                        oi[4 * q_ + 2] = __builtin_amdgcn_sdot4((int)__builtin_amdgcn_perm(t3_, t1_, 0x05040100u), (int)(wd_), oi[4 * q_ + 2], false); \
                        oi[4 * q_ + 3] = __builtin_amdgcn_sdot4((int)__builtin_amdgcn_perm(t3_, t1_, 0x07060302u), (int)(wd_), oi[4 * q_ + 3], false); } } while (0)
                    GS_QUAD(ra, 0, wc[0]); GS_QUAD(ra, 1, wc[1]);
                    GS_ROWS(ra, idn, 0);
                    GS_QUAD(rb, 0, wc[2]); GS_QUAD(rb, 1, wc[3]);
#undef GS_QUAD
                    float o[16];
#pragma unroll
                    for (int k = 0; k < 16; ++k) o[k] = (float)oi[k] * sc_c;
                    { const bool hb = (lane & 32) != 0;
#pragma unroll
                      for (int j = 0; j < 8; ++j) { const float keep = hb ? o[j + 8] : o[j], send = hb ? o[j] : o[j + 8]; o[j] = keep + lane_xor<32>(send); } }
                    { const bool hb = (lane & 16) != 0;
#pragma unroll
                      for (int j = 0; j < 4; ++j) { const float keep = hb ? o[j + 4] : o[j], send = hb ? o[j] : o[j + 4]; o[j] = keep + lane_xor<16>(send); } }
                    { const bool hb = (lane & 8) != 0;
#pragma unroll
                      for (int j = 0; j < 2; ++j) { const float keep = hb ? o[j + 2] : o[j], send = hb ? o[j] : o[j + 2]; o[j] = keep + lane_xor<8>(send); } }
                    const float corr = 0.f;
                    const int mrow = row < ML ? (row >= T ? 1 : 0) : 2;
                    const int col = 128 * p + 16 * i8 + 2 * g;
                    unsigned* xp = (unsigned*)((bf16_t*)(ws + WS_XB) + (size_t)row * D + col);
                    const unsigned xw = *xp; const f32x2 g2 = *(const f32x2*)(modl + mrow * 6144 + col);
                    const float x0 = bflo(xw) + g2[0] * (o[0] - corr), x1 = bfhi(xw) + g2[1] * (o[1] - corr);
                    if (l == DEPTH - 1) *(f32x2*)(a.out + (size_t)row * D + col) = (f32x2){x0, x1};
                    else *xp = pkbf_c(x0, x1);
                }
#pragma unroll
                for (int q = 0; q < 2; ++q) idc[q] = idn[q];
                if (PH) { wc = wn; sc_c = sc_n; } else hc = hn;
                GS_META(idn, wn, sc_n, hn, r2);
                if (++i == GS_ITEM) {
                    if (tnv >= nitem) break;
                    it = tnv; i = 0; tnv = 0x7fffffff;
                    if (lane == 0) tn = __hip_atomic_fetch_add(ctr, 1u, __ATOMIC_RELAXED, __HIP_MEMORY_SCOPE_AGENT);
                }
            }
#undef GS_META
#undef GS_ROWS
        }
    }
#undef a
}
__device__ __forceinline__ void phase_peer_weights(int l) {
    const KArgs ap = get_args();
#define a (*ap)
    const int tid = fresh_tid(), lane = tid & 63, wave = __builtin_amdgcn_readfirstlane(tid >> 6), G = fresh_g(), bx = fresh_bx();
    unsigned char* ws = a.ws;
    const int nrows = (l == DEPTH - 1) ? ML : M;
    const f32x2* SC2 = (const f32x2*)(ws + WS_USC) + (size_t)(l & 1) * NEXP;
    const int* PIDX = (const int*)(ws + WS_PIDX); const float* PGATE = (const float*)(ws + WS_PGATE);
    for (int row = wave * G + bx; row < nrows; row += G * 8) {
        const unsigned idw = *((const unsigned*)PIDX + (size_t)row * 64 + lane); const u32x2 id = {idw & 0xffffu, idw >> 16}; const f32x2 gt = *(const f32x2*)(PGATE + (size_t)row * 128 + 2 * lane);
        const float hsc = ((const float*)(ws + WS_GB))[row];
        int d0 = 0, d1 = 0;
#pragma unroll
        for (int p = 0; p < 8; ++p) { const u32x2 v = __builtin_nontemporal_load((const u32x2*)((const int*)(ws + WS_PD) + ((size_t)p * M + row) * 128 + 2 * lane)); d0 += (int)v[0]; d1 += (int)v[1]; }
        const f32x2 s0 = SC2[id[0]], s1 = SC2[id[1]];
        const float x0 = (float)d0 * (s0[0] * hsc), x1 = (float)d1 * (s1[0] * hsc);
        const float w0 = gt[0] * s0[1] * (0.5f * x0 * (1.f + erff(x0 * 0.70710678118654752f))), w1 = gt[1] * s1[1] * (0.5f * x1 * (1.f + erff(x1 * 0.70710678118654752f)));
        float mx = fmaxf(fabsf(w0), fabsf(w1));
        mx = fmaxf(mx, lane_xor<1>(mx)); mx = fmaxf(mx, lane_xor<2>(mx)); mx = fmaxf(mx, lane_xor<4>(mx));
        mx = fmaxf(mx, 1e-30f); const float inv = 127.f / mx;
        *(unsigned short*)(ws + WS_PW + (size_t)row * 128 + 2 * lane) = (unsigned short)(((unsigned)(int)rintf(w0 * inv) & 255u) | (((unsigned)(int)rintf(w1 * inv) & 255u) << 8));
        if ((lane & 7) == 0) ((float*)(ws + WS_PC))[(size_t)row * 8 + (lane >> 3)] = mx * (1.f / 127.f);
    }
#undef a
}

__global__ void __launch_bounds__(512, 2) fwd(Args a) {
    extern __shared__ __attribute__((aligned(16))) unsigned char lds_raw[];
    LAS unsigned char* lds = (LAS unsigned char*)lds_raw;
    volatile LAS unsigned* MISC = (volatile LAS unsigned*)(lds + LDS_MISC);
    if (threadIdx.x < 16) MISC[threadIdx.x] = 0u;
    __syncthreads();
    XcdBarrier bar; bar.bar = (unsigned*)(a.ws + WS_CTL) + 4096; bar.x = 0; bar.st = MISC + 8;
    bar = xcd_barrier_post((unsigned*)(a.ws + WS_CTL) + 4096, MISC + 8);
#ifndef PHASE_MASK
#define PHASE_MASK 0x1FFF
#endif
#define EN(i) ((PHASE_MASK >> (i)) & 1)
#ifndef REP_MASK
#define REP_MASK 0
#endif
#define REPN(i) (1 + ((REP_MASK >> (i)) & 1))
#define IN(k) true
#define SEAM(k) do { XcdBarrier b_; b_.bar = (unsigned*)(get_args()->ws + WS_CTL) + 4096; b_.x = xb_xcc_id(); b_.st = (volatile LAS unsigned*)(lds + LDS_MISC) + 8; xcd_barrier(b_); } while (0)
    for (int rep_ = 0; rep_ < (REPN(0)); ++rep_) if (EN(0) && IN(0)) phase_prologue(lds);
    SEAM(0);
#pragma unroll 1
    for (int l_ = 0; l_ < DEPTH; ++l_) {
        int l = l_; asm volatile("" : "+s"(l));
        const int pb = 1 + l * NPH_L;
        const int mrows = (l == DEPTH - 1) ? ML : M;
        if (l == 0) { for (int rep_ = 0; rep_ < (REPN(1)); ++rep_) if (EN(1) && IN(pb + 0)) { phase_norm<true>(l, 0, lds); phase_quant_weights(lds); }
            SEAM(pb + 0); }
        for (int rep_ = 0; rep_ < (REPN(2)); ++rep_) if (EN(2) && IN(pb + 1)) { const KArgs ap = get_args(); unsigned char* ws = ap->ws; pg8::Gemm g{(const bf16_t*)(ws + WS_H), (const bf16_t*)((const signed char*)(ws + WS_WINT) + (size_t)l * NP * 1024), M, NP, 512}; pg8::StaticOrder S; S.init(M, NP, fresh_g(), fresh_bx());
            pg8::EpiBf16I8 E{(bf16_t*)(ws + WS_P), NP, (const float*)(ws + WS_GB), (const float*)(ws + WS_CTL) + CW_WMAX + (l * 3 + 0) * 3072}; pg8::gemm_phase(lds, g, S, E); }
        SEAM(pb + 1);
        for (int rep_ = 0; rep_ < (REPN(3)); ++rep_) if (EN(3) && IN(pb + 2)) { phase_dn_chunkprep<1>(l, lds); phase_prep(l, lds); }
        for (int rep_ = 0; rep_ < (REPN(4)); ++rep_) if (EN(4) && IN(pb + 3)) phase_dn_chunkprep<0>(l, lds);
        SEAM(pb + 3);
        for (int rep_ = 0; rep_ < (REPN(5)); ++rep_) if (EN(5) && IN(pb + 4)) { phase_dn_scan<0>(l, lds); __syncthreads(); phase_attn(l, lds_raw, MISC, rep_); }
        SEAM(pb + 4);
        for (int rep_ = 0; rep_ < (REPN(7)); ++rep_) if (EN(7) && IN(pb + 5)) phase_dn_out(l);
        SEAM(pb + 5);
        if (EN(8) && IN(pb + 6)) { const KArgs ap = get_args(); unsigned char* ws = ap->ws; pg8::Gemm g{(const bf16_t*)(ws + WS_CATQ), (const bf16_t*)((const signed char*)(ws + WS_WOUTT) + (size_t)l * 1024 * 1024), mrows, 1024, 512}; pg8::StaticOrder S; S.init(mrows, 1024, fresh_g(), fresh_bx());
            pg8::EpiResI8 E{ap->in[I_X], ap->in[I_CTX], (bf16_t*)(ws + WS_XB), l == 0, (const float*)(ws + WS_MOD) + (size_t)l * 3 * 6144 + 2048,
                              (const float*)(ws + WS_GB) + (1u << 18), (const float*)(ws + WS_CTL) + CW_WMAX + (l * 3 + 1) * 3072};
            pg8::gemm_phase(lds, g, S, E); }
        SEAM(pb + 6);
        for (int rep_ = 0; rep_ < (REPN(9)); ++rep_) if (EN(9) && IN(pb + 7)) phase_norm<false>(l, 1, lds);
        SEAM(pb + 7);
        for (int rep_ = 0; rep_ < (REPN(10)); ++rep_) if (EN(10) && IN(pb + 8)) { const KArgs ap = get_args(); unsigned char* ws = ap->ws; pg8::Gemm g{(const bf16_t*)(ws + WS_H), (const bf16_t*)((const signed char*)(ws + WS_WQT) + (size_t)l * 2048 * 1024), mrows, 2048, 512}; pg8::StaticOrder S; S.init(mrows, 2048, fresh_g(), fresh_bx());
            pg8::EpiBf16I8 E{(bf16_t*)(ws + WS_P), 2048, (const float*)(ws + WS_GB), (const float*)(ws + WS_CTL) + CW_WMAX + (l * 3 + 2) * 3072}; pg8::gemm_phase(lds, g, S, E); }
        SEAM(pb + 8);
        for (int rep_ = 0; rep_ < (REPN(11)); ++rep_) if (EN(11) && IN(pb + 9)) phase_peer_select(l);
        SEAM(pb + 9);
        #ifdef GATHER_VAR
        if (EN(12) && IN(pb + 10)) phase_peer_gather<false, GATHER_VAR>(l, lds);
#endif
#if GATHER_PART == 2
        if (EN(12) && IN(pb + 10)) phase_peer_slice<0>(l, 0);
        SEAM(pb + 10);
        if (EN(12) && IN(pb + 10)) phase_peer_weights(l);
        SEAM(pb + 10);
        if (EN(12) && IN(pb + 10)) phase_peer_slice<1>(l, 0);
        if (l + 1 < DEPTH) { SEAM(pb + 10); if (EN(12) && IN(pb + 10)) phase_norm<true>(l + 1, 0, lds); }
#elif GATHER_PART
        if (EN(12) && IN(pb + 10)) phase_peer_gpart(l, lds);
        SEAM(pb + 10);
        if (EN(12) && IN(pb + 10)) phase_peer_combine(l, lds);
#else
        if (REPN(12) > 1 && EN(12) && IN(pb + 10)) phase_peer_gather<false>(l, lds);
        if (EN(12) && IN(pb + 10)) phase_peer_gather<true>(l, lds);
#endif
        if (l + 1 < DEPTH) SEAM(pb + 10);
    }
#undef IN
#undef SEAM
}

#ifndef N_LAUNCH_MODE
#define N_LAUNCH_MODE 1
#endif
extern "C" void kernel_launch(void* const* d_in, const int* in_sizes, int n_in, void* d_out, int out_size, void* d_ws, size_t ws_size, hipStream_t stream) {
    static int grid = 0;
    if (grid == 0) {
        if (n_in != 20 || out_size != ML * D || ws_size < WS_END) { fprintf(stderr, "kernel_launch: unexpected shapes: n_in %d out %d ws %zu (need %zu)\n", n_in, out_size, ws_size, (size_t)WS_END); grid = -1; return; }
        int dev = 0, cus = 0, per_cu = 0;
        if (hipGetDevice(&dev) != hipSuccess || hipDeviceGetAttribute(&cus, hipDeviceAttributeMultiprocessorCount, dev) != hipSuccess) { grid = -1; return; }
        if (hipFuncSetAttribute((const void*)fwd, hipFuncAttributeMaxDynamicSharedMemorySize, LDS_BYTES) != hipSuccess) { fprintf(stderr, "kernel_launch: hipFuncSetAttribute failed\n"); grid = -1; return; }
        if (hipOccupancyMaxActiveBlocksPerMultiprocessor(&per_cu, (const void*)fwd, 512, LDS_BYTES) != hipSuccess || per_cu < 1) fprintf(stderr, "kernel_launch: occupancy query says %d\n", per_cu);
        (void)hipGetLastError();
        grid = cus;
    }
    if (grid < 0) return;
    (void)hipMemsetAsync((char*)d_ws + WS_CTL, 0, CTL_BYTES, stream);
    Args a{};
    for (int i = 0; i < 20; ++i) a.in[i] = (const float*)d_in[i];
    a.out = (float*)d_out; a.ws = (unsigned char*)d_ws;
    a.ph_lo = 0; a.ph_hi = NPHASE;
    hipLaunchKernelGGL(fwd, dim3(grid), dim3(512), LDS_BYTES, stream, a);
    const hipError_t le = hipPeekAtLastError();
    if (le != hipSuccess) fprintf(stderr, "kernel_launch: launch failed: %s\n", hipGetErrorName(le));
}
```

```cpp
#include <hip/hip_runtime.h>
#ifndef GATHER_PART
#define GATHER_PART 2
#endif
#include <cstdio>
#include <cstdint>

#define GAS __attribute__((address_space(1)))
#define LAS __attribute__((address_space(3)))
typedef unsigned short bf16_t;
typedef short bf16x8 __attribute__((ext_vector_type(8)));
typedef short s16x4 __attribute__((ext_vector_type(4)));
typedef float f32x4 __attribute__((ext_vector_type(4)));
typedef float f32x2 __attribute__((ext_vector_type(2)));
typedef float f32x16 __attribute__((ext_vector_type(16)));
typedef unsigned u32x4 __attribute__((ext_vector_type(4)));
typedef unsigned u32x2 __attribute__((ext_vector_type(2)));
typedef int i32x4 __attribute__((ext_vector_type(4)));

constexpr int D = 1024, NB = 2, T = 16384, DEPTH = 4, CT = 256;
constexpr int ML = NB * T, MC = NB * CT, M = ML + MC;
constexpr int NIN = 3088, NP = 3072;
constexpr int KVLEN = T + CT;
constexpr int NEXP = 16384;
constexpr float EPS = 1e-6f;
constexpr int NPH_L = 11;
constexpr int NPHASE = 1 + DEPTH * NPH_L;

constexpr size_t MiB = 1u << 20;
constexpr size_t WS_CTL = 0, CTL_BYTES = 1 * MiB;
constexpr size_t WS_MOD = 1 * MiB;
constexpr size_t WS_ROPE = 2 * MiB;
constexpr size_t WS_WSK = 3 * MiB;
constexpr size_t WS_CTXX = 4 * MiB;
constexpr size_t WS_WINT = 8 * MiB;
constexpr size_t WS_WOUTT = 32 * MiB;
constexpr size_t WS_WQT = 40 * MiB;
constexpr size_t WS_SKB = 56 * MiB;
constexpr size_t WS_USC = 58 * MiB;
constexpr size_t WS_UB = 64 * MiB;
constexpr size_t WS_VB = 80 * MiB;
constexpr size_t TAB_SET = 32 * MiB;
constexpr size_t WS_H = 128 * MiB;
static_assert(WS_H + 2 * (size_t)M * 1024 <= 193 * MiB, "H + concat int8");
constexpr size_t WS_CATQ = WS_H + (size_t)M * 1024;
constexpr size_t WS_P = 193 * MiB;
constexpr size_t WS_QA = 388 * MiB;
constexpr size_t WS_KA = 421 * MiB;
constexpr size_t WS_VA = 438 * MiB;
constexpr size_t WS_CAT = 455 * MiB;
constexpr size_t WS_DQ = 520 * MiB;
constexpr size_t WS_DK = 553 * MiB;
constexpr size_t WS_DV = 586 * MiB;
constexpr size_t WS_OF = 619 * MiB;
constexpr size_t WS_OB = WS_OF + (size_t)M * 1024;
constexpr size_t WS_XB = WS_OB + (size_t)M * 1024;
static_assert(WS_OB + (size_t)M * 1024 <= WS_XB && WS_XB + (size_t)M * 2048 <= 749 * MiB, "OF/OB/XB");
constexpr size_t WS_GB = 749 * MiB;
constexpr size_t WS_BA = 752 * MiB;
constexpr size_t WS_PIDX = 755 * MiB;
constexpr size_t WS_PGATE = 772 * MiB;
constexpr size_t WS_REC = 789 * MiB;
constexpr size_t WS_END = 990 * MiB;
constexpr int CW_WMAX = 65536;
constexpr int NCH = 260;
constexpr int REC_K = 0, REC_KT = 16384, REC_Q = 32768, REC_V = 49152, REC_DIR = 65536, REC_DIRSZ = 17408, REC_BYTES = REC_DIR + 2 * REC_DIRSZ;
static_assert((size_t)NB * 4 * NCH * REC_BYTES + WS_REC <= WS_END, "rec region");

constexpr int LDS_BYTES = 163840;
constexpr int LDS_MISC = 163840 - 256;

__device__ __forceinline__ float bf2f(unsigned b) { return __uint_as_float(b << 16); }
__device__ __forceinline__ float bflo(unsigned w) { return __uint_as_float(w << 16); }
__device__ __forceinline__ float bfhi(unsigned w) { return __uint_as_float(w & 0xffff0000u); }
typedef __bf16 bf2v __attribute__((ext_vector_type(2)));
__device__ __forceinline__ unsigned pkbf(float lo, float hi) { unsigned r; asm("v_cvt_pk_bf16_f32 %0, %1, %2" : "=v"(r) : "v"(lo), "v"(hi)); return r; }
__device__ __forceinline__ unsigned pkbf_c(float lo, float hi) { f32x2 v = {lo, hi}; bf2v r = __builtin_convertvector(v, bf2v); return __builtin_bit_cast(unsigned, r); }
template <int K> __device__ __forceinline__ float lane_xor(float v) {
    const int b = __builtin_bit_cast(int, v);
    if constexpr (K == 1) return __builtin_bit_cast(float, __builtin_amdgcn_update_dpp(0, b, 0xB1, 0xF, 0xF, true));
    else if constexpr (K == 2) return __builtin_bit_cast(float, __builtin_amdgcn_update_dpp(0, b, 0x4E, 0xF, 0xF, true));
    else if constexpr (K == 32) { auto rr = __builtin_amdgcn_permlane32_swap((unsigned)b, (unsigned)b, false, false); unsigned ln_ = __builtin_amdgcn_mbcnt_hi(~0u, __builtin_amdgcn_mbcnt_lo(~0u, 0u)); asm volatile("" : "+v"(ln_));
        return __uint_as_float((ln_ & 32u) ? rr[0] : rr[1]); }
    else return __builtin_bit_cast(float, __builtin_amdgcn_ds_swizzle(b, 0x1F | (K << 10)));
}
__device__ __forceinline__ float wave_sum(float v) {
    v += lane_xor<1>(v); v += lane_xor<2>(v);
    v += __builtin_bit_cast(float, __builtin_amdgcn_update_dpp(0, __builtin_bit_cast(int, v), 0x124, 0xF, 0xF, true));
    v += __builtin_bit_cast(float, __builtin_amdgcn_update_dpp(0, __builtin_bit_cast(int, v), 0x128, 0xF, 0xF, true));
    v += lane_xor<16>(v);
    { auto rr = __builtin_amdgcn_permlane32_swap(__float_as_uint(v), __float_as_uint(v), false, false); v = __uint_as_float(rr[0]) + __uint_as_float(rr[1]); }
    return v;
}
__device__ __forceinline__ float wave_max(float v) {
    v = fmaxf(v, lane_xor<1>(v)); v = fmaxf(v, lane_xor<2>(v));
    v = fmaxf(v, __builtin_bit_cast(float, __builtin_amdgcn_update_dpp(0, __builtin_bit_cast(int, v), 0x124, 0xF, 0xF, true)));
    v = fmaxf(v, __builtin_bit_cast(float, __builtin_amdgcn_update_dpp(0, __builtin_bit_cast(int, v), 0x128, 0xF, 0xF, true)));
    v = fmaxf(v, lane_xor<16>(v));
    { auto rr = __builtin_amdgcn_permlane32_swap(__float_as_uint(v), __float_as_uint(v), false, false); v = fmaxf(__uint_as_float(rr[0]), __uint_as_float(rr[1])); }
    return v;
}
__device__ __forceinline__ float silu_f(float x) { return x / (1.f + __expf(-x)); }
#define LDS_WAIT() asm volatile("s_waitcnt lgkmcnt(0)" ::: "memory")

#define XB_TMO      128
#define XB_XCNT(j)  (256  + 64 * (j))
#define XB_XSUB(j)  (1280 + 64 * (j))
#define XB_XGEN(j)  (2304 + 64 * (j))
#define XB_TOP      3328
#define XB_TOPGEN   3392
#define XCD_BAR_WORDS 3456
#define XB_SPIN_CAP (1u << 22)
__device__ __forceinline__ unsigned xb_ld(unsigned* p)              { return __hip_atomic_load(p, __ATOMIC_RELAXED, __HIP_MEMORY_SCOPE_AGENT); }
__device__ __forceinline__ unsigned xb_add(unsigned* p, unsigned v) { return __hip_atomic_fetch_add(p, v, __ATOMIC_RELAXED, __HIP_MEMORY_SCOPE_AGENT); }
__device__ __forceinline__ unsigned xb_xcc_id() { return (unsigned)__builtin_amdgcn_s_getreg((3 << 11) | 20) & 0xFu; }
#define XB_SPIN(cond, bar) do { unsigned _sp = 0; while (cond) { __builtin_amdgcn_s_sleep(1); \
    if ((++_sp & 255u) == 0u) { if (xb_ld(&(bar)[XB_TMO])) break; if (_sp > XB_SPIN_CAP) { atomicAdd(&(bar)[XB_TMO], 1u); break; } } } } while (0)
struct XcdBarrier { unsigned* bar; unsigned x; volatile LAS unsigned* st; };
__device__ __forceinline__ XcdBarrier xcd_barrier_post(unsigned* bar, volatile LAS unsigned* st) {
    XcdBarrier b; b.bar = bar; b.x = xb_xcc_id(); b.st = st;
    if (threadIdx.x == 0) (void)xb_add(&bar[XB_XCNT(b.x)], 1u);
    return b;
}
__device__ __forceinline__ void xcd_barrier_complete(unsigned* bar, unsigned x, unsigned& nloc, unsigned& nx) {
    const unsigned G = gridDim.x * gridDim.y * gridDim.z;
    unsigned sum, cnt, mine, sp = 0u;
    for (;;) {
        sum = 0u; cnt = 0u; mine = 0u;
#pragma unroll
        for (unsigned j = 0; j < 16; ++j) { const unsigned c = xb_ld(&bar[XB_XCNT(j)]); sum += c; cnt += (c > 0u) ? 1u : 0u; mine = (j == x) ? c : mine; }
        if (sum == G) break;
        __builtin_amdgcn_s_sleep(1);
        if ((++sp & 255u) == 0u) { if (xb_ld(&bar[XB_TMO])) break; if (sp > XB_SPIN_CAP) { atomicAdd(&bar[XB_TMO], 1u); break; } }
    }
    nloc = mine > 0u ? mine : 1u; nx = cnt > 0u ? cnt : 1u;
}
__device__ __forceinline__ void xcd_barrier(const XcdBarrier& b) {
    asm volatile("s_waitcnt vmcnt(0)" ::: "memory");
    __syncthreads();
    if (threadIdx.x == 0) {
        unsigned* bar = b.bar; unsigned bx_ = b.x;
        asm volatile("" : "+s"(bar), "+s"(bx_));
        __builtin_amdgcn_s_waitcnt(0);
        unsigned nloc = b.st[0], nx = b.st[1];
        if (nloc == 0u) { xcd_barrier_complete(bar, bx_, nloc, nx); b.st[0] = nloc; b.st[1] = nx; }
        const unsigned old = xb_add(&bar[XB_XSUB(bx_)], 1u);
        const unsigned gen = old / nloc;
        if (old + 1u == (gen + 1u) * nloc) {
            __builtin_amdgcn_fence(__ATOMIC_RELEASE, "agent");
            asm volatile("s_waitcnt vmcnt(0)" ::: "memory");
            const unsigned og = xb_add(&bar[XB_TOP], 1u);
            const unsigned tg = og / nx;
            if (og + 1u == (tg + 1u) * nx) xb_add(&bar[XB_TOPGEN], 1u);
            else XB_SPIN(xb_ld(&bar[XB_TOPGEN]) == tg, bar);
            __builtin_amdgcn_fence(__ATOMIC_ACQUIRE, "agent");
            xb_add(&bar[XB_XGEN(bx_)], 1u);
            asm volatile("s_waitcnt vmcnt(0)" ::: "memory");
        } else {
            XB_SPIN(xb_ld(&bar[XB_XGEN(bx_)]) == gen, bar);
            __builtin_amdgcn_fence(__ATOMIC_ACQUIRE, "agent");
            asm volatile("s_waitcnt vmcnt(0)" ::: "memory");
        }
    }
    __syncthreads();
}

namespace pg8 {
constexpr int BM = 256, BK = 64, HALF = 128, HTB = HALF * BK * 2, STAGE_BYTES = 8 * HTB, NXCD = 8, WGM = 8;
__host__ __device__ __forceinline__ int lds_byte(int r, int c) { const int st = (r >> 4) * 2 + (c >> 5), rr = r & 15, cc = c & 31, ob = rr * 64 + cc * 2; return st * 1024 + (ob ^ (((ob >> 9) & 1) << 5)); }
__host__ __device__ __forceinline__ void stage_rc(int b, int& R, int& C) { const int st = b / 1024, sb = b % 1024, swz = sb ^ (((sb >> 9) & 1) << 5); R = (st >> 1) * 16 + swz / 64; C = (st & 1) * 32 + (swz % 64) / 2; }
__host__ __device__ __forceinline__ int perm32(int rho) { const int n = rho >> 4, i = rho & 15; return 8 * (i >> 2) + 4 * n + (i & 3); }
struct Unit { int pm, pn; };
struct Gemm { const bf16_t* A; const bf16_t* Bt; int M, N, K; };
struct StaticOrder {
    int nM, nN, nwg, G, c;
    __host__ __device__ void init(int M_, int N_, int G_, int c_) { nM = M_ / BM; nN = N_ / BM; nwg = nM * nN; G = G_; c = c_; }
    __host__ __device__ bool next(int i, Unit& u) const {
        const long L = (long)i * G + c; if (L >= nwg) return false;
        int wgid = (int)L; { const int q = nwg / NXCD, r = nwg % NXCD, xcd = wgid % NXCD, off = wgid / NXCD; wgid = (xcd < r ? xcd * (q + 1) : r * (q + 1) + (xcd - r) * q) + off; }
        const int nig = WGM * nN, gid = wgid / nig, fm = gid * WGM, gsz = (nM - fm) < WGM ? (nM - fm) : WGM;
        u.pm = fm + ((wgid % nig) % gsz); u.pn = (wgid % nig) / gsz; return true;
    }
    __device__ __forceinline__ void a_ready(const Unit&) const {}
    __device__ __forceinline__ void done(const Unit&) const {}
};
struct EpiBf16 {
    static constexpr bool PERM = true, I8 = false; typedef f32x4 acc_t;
    bf16_t* O; int ldc;
    __device__ __forceinline__ void operator()(const f32x4 (&acc)[2][2][4][2], const Unit& u, int wr, int wc, int fr, int fq) const {
        const int row0 = u.pm * BM + wr * 64 + fr; const int col0 = u.pn * BM + wc * 32 + 8 * fq;
#pragma unroll
        for (int ai = 0; ai < 2; ++ai)
#pragma unroll
            for (int m = 0; m < 4; ++m) { bf16_t* rowp = O + (size_t)(row0 + ai * HALF + m * 16) * ldc + col0;
#pragma unroll
                for (int bj = 0; bj < 2; ++bj) { const f32x4 v0 = acc[ai][bj][m][0], v1 = acc[ai][bj][m][1];
                    u32x4 w; w.x = pkbf_c(v0[0], v0[1]); w.y = pkbf_c(v0[2], v0[3]); w.z = pkbf_c(v1[0], v1[1]); w.w = pkbf_c(v1[2], v1[3]);
                    *(u32x4*)(rowp + bj * HALF) = w; } }
    }
};
struct EpiBf16I8 {
    static constexpr bool PERM = true, I8 = true; typedef i32x4 acc_t;
    bf16_t* O; int ldc; const float* sa; const float* wmax;
    __device__ __forceinline__ void operator()(const i32x4 (&acc)[2][2][4][2], const Unit& u, int wr, int wc, int fr, int fq) const {
        const int row0 = u.pm * BM + wr * 64 + fr; const int col0 = u.pn * BM + wc * 32 + 8 * fq;
        f32x4 sw[2][2];
#pragma unroll
        for (int bj = 0; bj < 2; ++bj)
#pragma unroll
            for (int n = 0; n < 2; ++n) sw[bj][n] = *(const f32x4*)(wmax + col0 + bj * HALF + 4 * n) * (1.f / 127.f);
#pragma unroll
        for (int ai = 0; ai < 2; ++ai)
#pragma unroll
            for (int m = 0; m < 4; ++m) { const int row = row0 + ai * HALF + m * 16; const float sr = sa[row]; bf16_t* rowp = O + (size_t)row * ldc + col0;
#pragma unroll
                for (int bj = 0; bj < 2; ++bj) { const i32x4 a0 = acc[ai][bj][m][0], a1 = acc[ai][bj][m][1];
                    const f32x4 v0 = (f32x4){(float)a0[0], (float)a0[1], (float)a0[2], (float)a0[3]} * sw[bj][0] * sr, v1 = (f32x4){(float)a1[0], (float)a1[1], (float)a1[2], (float)a1[3]} * sw[bj][1] * sr;
                    u32x4 w; w.x = pkbf(v0[0], v0[1]); w.y = pkbf(v0[2], v0[3]); w.z = pkbf(v1[0], v1[1]); w.w = pkbf(v1[2], v1[3]);
                    *(u32x4*)(rowp + bj * HALF) = w; } }
    }
};
struct EpiRes {
    static constexpr bool PERM = false, I8 = false; typedef f32x4 acc_t;
    const float* src_lat; const float* src_ctx; float* dst_lat; float* dst_ctx; const float* gate;
    __device__ __forceinline__ void operator()(const f32x4 (&acc)[2][2][4][2], const Unit& u, int wr, int wc, int fr, int fq) const {
        const bool isctx = u.pm >= (ML / BM);
        const float* src = isctx ? src_ctx + (size_t)(u.pm - ML / BM) * BM * D : src_lat + (size_t)u.pm * BM * D;
        float* dst = isctx ? dst_ctx + (size_t)(u.pm - ML / BM) * BM * D : dst_lat + (size_t)u.pm * BM * D;
        const int mrow = isctx ? 2 : (u.pm >= (T / BM) ? 1 : 0);
        const int row0 = wr * 64 + fr, col0 = u.pn * BM + wc * 32 + 4 * fq;
        f32x4 gv[2][2];
#pragma unroll
        for (int bj = 0; bj < 2; ++bj)
#pragma unroll
            for (int n = 0; n < 2; ++n) gv[bj][n] = *(const f32x4*)(gate + mrow * 6144 + col0 + bj * HALF + n * 16);
#pragma unroll
        for (int ai = 0; ai < 2; ++ai)
#pragma unroll
            for (int m = 0; m < 4; ++m) { const size_t off = (size_t)(row0 + ai * HALF + m * 16) * D + col0;
#pragma unroll
                for (int bj = 0; bj < 2; ++bj)
#pragma unroll
                    for (int n = 0; n < 2; ++n) { const f32x4 s = *(const f32x4*)(src + off + bj * HALF + n * 16);
                        *(f32x4*)(dst + off + bj * HALF + n * 16) = s + gv[bj][n] * acc[ai][bj][m][n]; } }
    }
};

struct EpiResI8 {
    static constexpr bool PERM = false, I8 = true; typedef i32x4 acc_t;
    const float* src_lat; const float* src_ctx; bf16_t* xb; bool first; const float* gate; const float* sa; const float* wmax;
    __device__ __forceinline__ void operator()(const i32x4 (&acc)[2][2][4][2], const Unit& u, int wr, int wc, int fr, int fq) const {
        const bool isctx = u.pm >= (ML / BM);
        const float* src = isctx ? src_ctx + (size_t)(u.pm - ML / BM) * BM * D : src_lat + (size_t)u.pm * BM * D;
        bf16_t* dst = xb + (size_t)u.pm * BM * D;
        const int mrow = isctx ? 2 : (u.pm >= (T / BM) ? 1 : 0);
        const int row0 = wr * 64 + fr, col0 = u.pn * BM + wc * 32 + 4 * fq;
        f32x4 gv[2][2];
#pragma unroll
        for (int bj = 0; bj < 2; ++bj)
#pragma unroll
            for (int n = 0; n < 2; ++n) gv[bj][n] = *(const f32x4*)(gate + mrow * 6144 + col0 + bj * HALF + n * 16) * *(const f32x4*)(wmax + col0 + bj * HALF + n * 16) * (1.f / 127.f);
#pragma unroll
        for (int ai = 0; ai < 2; ++ai)
#pragma unroll
            for (int m = 0; m < 4; ++m) { const int rl = row0 + ai * HALF + m * 16; const float sr = sa[u.pm * BM + rl]; const size_t off = (size_t)rl * D + col0;
#pragma unroll
                for (int bj = 0; bj < 2; ++bj)
#pragma unroll
                    for (int n = 0; n < 2; ++n) { const i32x4 ac = acc[ai][bj][m][n]; f32x4 sv;
                        if (first) sv = *(const f32x4*)(src + off + bj * HALF + n * 16);
                        else { const u32x2 w_ = *(const u32x2*)(dst + off + bj * HALF + n * 16); sv = (f32x4){bflo(w_[0]), bfhi(w_[0]), bflo(w_[1]), bfhi(w_[1])}; }
                        const f32x4 r_ = sv + gv[bj][n] * ((f32x4){(float)ac[0], (float)ac[1], (float)ac[2], (float)ac[3]} * sr);
                        *(u32x2*)(dst + off + bj * HALF + n * 16) = (u32x2){pkbf(r_[0], r_[1]), pkbf(r_[2], r_[3])}; } }
    }
};
template <class Epi, class Sched>
__device__ __forceinline__ void gemm_phase(LAS unsigned char* lds, const Gemm g, const Sched& S, const Epi& E) {
    constexpr bool I8 = Epi::I8;
    typedef typename Epi::acc_t acc_t;
    int tid = threadIdx.x; asm volatile("" : "+v"(tid)); const int wid = __builtin_amdgcn_readfirstlane(tid >> 6), lane = tid & 63, wr = wid >> 2, wc = wid & 3, fr = lane & 15, fq = lane >> 4;
    const int K = g.K, nt = K / BK;
    unsigned voffA[2], voffB[2];
#pragma unroll
    for (int i = 0; i < 2; ++i) { int R, C; stage_rc(tid * 16 + i * 8192, R, C); const int Rb = Epi::PERM ? ((R & ~31) + perm32(R & 31)) : R;
        voffA[i] = (unsigned)(R * K + C) * 2u; voffB[i] = (unsigned)(Rb * K + C) * 2u; }
    const size_t kstep = (size_t)(BK * 2);
    const size_t hstep = (size_t)HALF * K * 2;
    const size_t tstep = 2 * hstep;
    const unsigned ldsw = (unsigned)wid * 1024u;
    const int aoff = lds_byte(wr * 64 + fr, fq * 8), boff = lds_byte(wc * 32 + fr, fq * 8);
#define PG8_SA(b, h) (((b) * 2 + (h)) * HTB)
#define PG8_SB(b, h) ((4 + (b) * 2 + (h)) * HTB)
#define PG8_STAGE(bufoff, gbase, voff) do { _Pragma("unroll") for (int _i = 0; _i < 2; ++_i) \
        __builtin_amdgcn_global_load_lds((const unsigned*)((const char*)(gbase) + (voff)[_i]), (LAS unsigned*)(lds + (bufoff) + ldsw + _i * 8192), 16, 0, 0); } while (0)
#define PG8_LDA(dst, b, h) do { _Pragma("unroll") for (int m = 0; m < 4; ++m) _Pragma("unroll") for (int k = 0; k < 2; ++k) dst[m][k] = *(const LAS bf16x8*)(lds + PG8_SA(b, h) + aoff + m * 2048 + k * 1024); } while (0)
#define PG8_LDB(dst, b, h) do { _Pragma("unroll") for (int n = 0; n < 2; ++n) _Pragma("unroll") for (int k = 0; k < 2; ++k) dst[n][k] = *(const LAS bf16x8*)(lds + PG8_SB(b, h) + boff + n * 2048 + k * 1024); } while (0)
#define PG8_MMA(ai, bj, At, Bt) do { __builtin_amdgcn_s_setprio(1); _Pragma("unroll") for (int m = 0; m < 4; ++m) _Pragma("unroll") for (int n = 0; n < 2; ++n) _Pragma("unroll") for (int k = 0; k < 2; ++k) \
        { if constexpr (I8) acc[ai][bj][m][n] = __builtin_bit_cast(acc_t, __builtin_amdgcn_mfma_i32_16x16x64_i8(__builtin_bit_cast(i32x4, Bt[n][k]), __builtin_bit_cast(i32x4, At[m][k]), __builtin_bit_cast(i32x4, acc[ai][bj][m][n]), 0, 0, 0)); \
          else acc[ai][bj][m][n] = __builtin_bit_cast(acc_t, __builtin_amdgcn_mfma_f32_16x16x32_bf16(Bt[n][k], At[m][k], __builtin_bit_cast(f32x4, acc[ai][bj][m][n]), 0, 0, 0)); } __builtin_amdgcn_s_setprio(0); } while (0)
#define PG8_WAIT_V(n) asm volatile("s_waitcnt vmcnt(" #n ")" ::: "memory")
#define PG8_WAIT_L(n) asm volatile("s_waitcnt lgkmcnt(" #n ")" ::: "memory")
#define PG8_BAR __builtin_amdgcn_s_barrier()
#define PG8_SCHED __builtin_amdgcn_sched_barrier(0)
    Unit cur, nxt; int ui = 0;
    if (!S.next(0, cur)) return;
    acc_t acc[2][2][4][2];
#pragma unroll
    for (int a = 0; a < 2; ++a)
#pragma unroll
        for (int b = 0; b < 2; ++b)
#pragma unroll
            for (int m = 0; m < 4; ++m)
#pragma unroll
                for (int n = 0; n < 2; ++n) acc[a][b][m][n] = acc_t{};
    bf16x8 At[4][2], B0[2][2], B1[2][2];
    const char* cA = (const char*)g.A + (size_t)cur.pm * tstep; const char* cB = (const char*)g.Bt + (size_t)cur.pn * tstep;
    S.a_ready(cur);
    PG8_STAGE(PG8_SB(0, 0), cB, voffB); PG8_STAGE(PG8_SA(0, 0), cA, voffA); PG8_STAGE(PG8_SB(0, 1), cB + hstep, voffB); PG8_STAGE(PG8_SA(0, 1), cA + hstep, voffA);
    if (wr == 1) PG8_BAR;
    PG8_WAIT_V(4); PG8_BAR;
    PG8_STAGE(PG8_SB(1, 0), cB + kstep, voffB); PG8_STAGE(PG8_SA(1, 0), cA + kstep, voffA); PG8_STAGE(PG8_SB(1, 1), cB + hstep + kstep, voffB);
    PG8_WAIT_V(6); PG8_BAR;
    for (;;) {
        const bool has_next = S.next(ui + 1, nxt);
        const char* nA = has_next ? (const char*)g.A + (size_t)nxt.pm * tstep : cA; const char* nB = has_next ? (const char*)g.Bt + (size_t)nxt.pn * tstep : cB;
        for (int t = 0; t < nt; t += 2) {
            const bool last = (t == nt - 2);
            const char* a1 = cA + (size_t)(t + 1) * kstep;
            const char* a2 = last ? nA : cA + (size_t)(t + 2) * kstep; const char* b2 = last ? nB : cB + (size_t)(t + 2) * kstep;
            const char* a3 = a2 + kstep; const char* b3 = b2 + kstep;
            if (last && has_next) S.a_ready(nxt);
            PG8_LDB(B0, 0, 0); PG8_SCHED; PG8_LDA(At, 0, 0); PG8_STAGE(PG8_SA(1, 1), a1 + hstep, voffA);
            PG8_WAIT_L(8); PG8_BAR; PG8_WAIT_L(0); PG8_MMA(0, 0, At, B0); PG8_BAR; PG8_SCHED;
            PG8_LDB(B1, 0, 1); PG8_STAGE(PG8_SB(0, 0), b2, voffB);
            PG8_BAR; PG8_WAIT_L(0); PG8_MMA(0, 1, At, B1); PG8_BAR;
            PG8_LDA(At, 0, 1); PG8_STAGE(PG8_SA(0, 0), a2, voffA);
            PG8_BAR; PG8_WAIT_L(0); PG8_MMA(1, 0, At, B0); PG8_BAR; PG8_SCHED;
            PG8_STAGE(PG8_SB(0, 1), b2 + hstep, voffB);
            PG8_WAIT_V(6); PG8_BAR; PG8_MMA(1, 1, At, B1); PG8_BAR;
            PG8_LDB(B0, 1, 0); PG8_SCHED; PG8_LDA(At, 1, 0); PG8_STAGE(PG8_SA(0, 1), a2 + hstep, voffA);
            PG8_WAIT_L(8); PG8_BAR; PG8_WAIT_L(0); PG8_MMA(0, 0, At, B0); PG8_BAR; PG8_SCHED;
            PG8_LDB(B1, 1, 1); PG8_STAGE(PG8_SB(1, 0), b3, voffB);
            PG8_BAR; PG8_WAIT_L(0); PG8_MMA(0, 1, At, B1); PG8_BAR;
            PG8_LDA(At, 1, 1); PG8_STAGE(PG8_SA(1, 0), a3, voffA);
            PG8_BAR; PG8_WAIT_L(0); PG8_MMA(1, 0, At, B0); PG8_BAR; PG8_SCHED;
            PG8_STAGE(PG8_SB(1, 1), b3 + hstep, voffB);
            PG8_WAIT_V(6); PG8_BAR; PG8_MMA(1, 1, At, B1); PG8_BAR;
        }
        E(acc, cur, wr, wc, fr, fq); S.done(cur);
        if (!has_next) break;
#pragma unroll
        for (int a = 0; a < 2; ++a)
#pragma unroll
            for (int b = 0; b < 2; ++b)
#pragma unroll
                for (int m = 0; m < 4; ++m)
#pragma unroll
                    for (int n = 0; n < 2; ++n) acc[a][b][m][n] = acc_t{};
        cur = nxt; cA = nA; cB = nB; ++ui;
    }
    PG8_WAIT_V(0);
    if (wr == 0) PG8_BAR;
    PG8_BAR;
#undef PG8_SA
#undef PG8_SB
#undef PG8_STAGE
#undef PG8_LDA
#undef PG8_LDB
#undef PG8_MMA
#undef PG8_WAIT_V
#undef PG8_WAIT_L
#undef PG8_BAR
#undef PG8_SCHED
}
}

namespace att {
constexpr int HD = 128, NW = 8, QBLK = 32, KVBLK = 64;
constexpr float SCALE = 0.088388347648318440f;
constexpr float THR = 8.f;
constexpr int LDQ = 512, LDK = 256;
constexpr size_t SHM_V = KVBLK * HD * 2, SHM_K = KVBLK * HD * 2, SHM_ATTN = 2 * SHM_V + 2 * SHM_K + NW * 64 * 4;
#define KSWZ(row, colB) ((row) * 256 + ((colB) ^ (((row) & 7) << 4)))
#define SBAR() __builtin_amdgcn_sched_barrier(0)
__device__ __forceinline__ int crow(int r, int hi) { return (r & 3) + 8 * (r >> 2) + 4 * hi; }
__device__ __forceinline__ unsigned cvtpk(float lo, float hi) { unsigned r; asm volatile("v_cvt_pk_bf16_f32 %0, %1, %2" : "=v"(r) : "v"(lo), "v"(hi)); return r; }
__device__ __forceinline__ void partialSM(f32x16& p0, f32x16& p1) {
  for (int r = 0; r < 16; ++r) p0[r] = __builtin_amdgcn_exp2f(p0[r]);
}
typedef int i32x8 __attribute__((ext_vector_type(8)));
__device__ __forceinline__ void finishSM(f32x16& p0, f32x16& p1, i32x8& pa) {
  for (int r = 0; r < 16; ++r) p1[r] = __builtin_amdgcn_exp2f(p1[r]);
#pragma unroll
  for (int q = 0; q < 4; ++q) { int w = __builtin_amdgcn_cvt_pk_bf8_f32(p0[4 * q], p0[4 * q + 1], 0, false); w = __builtin_amdgcn_cvt_pk_bf8_f32(p0[4 * q + 2], p0[4 * q + 3], w, true); pa[q] = w;
    int w2 = __builtin_amdgcn_cvt_pk_bf8_f32(p1[4 * q], p1[4 * q + 1], 0, false); w2 = __builtin_amdgcn_cvt_pk_bf8_f32(p1[4 * q + 2], p1[4 * q + 3], w2, true); pa[4 + q] = w2; }
}
constexpr int K8_STRIDE = 144, K8_TILE = KVBLK * K8_STRIDE;
__device__ __forceinline__ void qkt(f32x16& p0, f32x16& p1, const unsigned char* Ks, const i32x8* qr, int r32, int hi, const f32x16& cinit) {
  p0 = cinit; p1 = cinit;
#pragma unroll
  for (int ks = 0; ks < 2; ++ks) {
    const u32x4* a0 = (const u32x4*)(Ks + r32 * K8_STRIDE + 64 * ks + 32 * hi); const u32x4* a1 = (const u32x4*)(Ks + (32 + r32) * K8_STRIDE + 64 * ks + 32 * hi);
    const u32x4 x0 = a0[0], x1 = a0[1], y0 = a1[0], y1 = a1[1];
    const i32x8 k0 = {(int)x0.x, (int)x0.y, (int)x0.z, (int)x0.w, (int)x1.x, (int)x1.y, (int)x1.z, (int)x1.w}, k1 = {(int)y0.x, (int)y0.y, (int)y0.z, (int)y0.w, (int)y1.x, (int)y1.y, (int)y1.z, (int)y1.w};
    p0 = __builtin_amdgcn_mfma_scale_f32_32x32x64_f8f6f4(k0, qr[ks], p0, 0, 0, 0, 0x7F7F7F7F, 0, 0x7C7C7C7C);
    p1 = __builtin_amdgcn_mfma_scale_f32_32x32x64_f8f6f4(k1, qr[ks], p1, 0, 0, 0, 0x7F7F7F7F, 0, 0x7C7C7C7C); }
}
constexpr int V8_STRIDE = 80, V8_TILE = HD * V8_STRIDE;
__device__ __forceinline__ void pv_d0(f32x16* o, f32x16& ol, const unsigned char* Vs, const i32x8& pa, int r32, int hi) {
  { const i32x8 ones = {0x38383838, 0x38383838, 0x38383838, 0x38383838, 0x38383838, 0x38383838, 0x38383838, 0x38383838};
    ol = __builtin_amdgcn_mfma_scale_f32_32x32x64_f8f6f4(pa, ones, ol, 1, 0, 0, 0x7F7F7F7F, 0, 0x7F7F7F7F); }
#pragma unroll
  for (int d0 = 0; d0 < 4; ++d0) { const u32x4* bp = (const u32x4*)(Vs + (32 * d0 + r32) * V8_STRIDE + 32 * hi); const u32x4 x0 = bp[0], x1 = bp[1];
    const i32x8 vb = {(int)x0.x, (int)x0.y, (int)x0.z, (int)x0.w, (int)x1.x, (int)x1.y, (int)x1.z, (int)x1.w};
    o[d0] = __builtin_amdgcn_mfma_scale_f32_32x32x64_f8f6f4(pa, vb, o[d0], 1  , 0  , 0, 0x7F7F7F7F, 0, 0x7F7F7F7F); }
}
__device__ __forceinline__ void attn_dense_body(const unsigned char* __restrict__ Qb, const unsigned char* __restrict__ Kh, const unsigned char* __restrict__ Vt,
                                                bf16_t* __restrict__ Ob, int LDO, int seq, char* lds, float* __restrict__ lse, float braw) {
  int tid = threadIdx.x; asm volatile("" : "+v"(tid)); const int wid = tid >> 6, lane = tid & 63, r32 = lane & 31, hi = lane >> 5;
  unsigned char* V_lds = (unsigned char*)lds; unsigned char* K_lds = (unsigned char*)(lds + 3 * V8_TILE);
  f32x16 o[4] = {}, ol = {}; i32x8 qr[2];
  const float mnC = __builtin_bit_cast(float, __builtin_amdgcn_readfirstlane(__builtin_bit_cast(int, -fmaxf(braw * (SCALE * 1.4426950408889634f) - 15.5f, 0.f))));
  f32x16 cinit;
#pragma unroll
  for (int r = 0; r < 16; ++r) cinit[r] = mnC;
  const unsigned char* Qw = Qb + (long)(wid * QBLK + r32) * LDQ + hi * 32;
#pragma unroll
  for (int ks = 0; ks < 2; ++ks) { const u32x4 x0 = *(const u32x4*)(Qw + 64 * ks), x1 = *(const u32x4*)(Qw + 64 * ks + 16);
    qr[ks] = (i32x8){(int)x0.x, (int)x0.y, (int)x0.z, (int)x0.w, (int)x1.x, (int)x1.y, (int)x1.z, (int)x1.w}; }
  const int krow = tid >> 3, kch = tid & 7;
  const int vrow = tid >> 2, vch = tid & 3;
  struct { u32x4 v8, k8; } sr_[2];
#define SLOAD(i, k0) do { sr_[i].v8 = *reinterpret_cast<const u32x4*>(Vt + (long)((k0) >> 6) * 8192 + tid * 16); \
    sr_[i].k8 = *reinterpret_cast<const u32x4*>(Kh + (long)((k0) + krow) * LDK + kch * 16); } while (0)
#define SWRITE(b, i) do { *(u32x4*)(V_lds + (b) * V8_TILE + vrow * V8_STRIDE + vch * 16) = sr_[i].v8; \
    *(u32x4*)(K_lds + (b) * K8_TILE + krow * K8_STRIDE + kch * 16) = sr_[i].k8; } while (0)
#define SWAIT() asm volatile("s_waitcnt vmcnt(2)" ::: "memory")
  f32x16 pA0, pA1, pB0, pB1; i32x8 pa; const int NT = seq / KVBLK;
  constexpr int SE = 0, SO = 1;
  SLOAD(SE, 0); asm volatile("s_waitcnt vmcnt(0)" ::: "memory"); SWRITE(0, SE);
  SLOAD(SO, KVBLK); SLOAD(SE, 2 * KVBLK);
  __syncthreads();
  qkt(pA0, pA1, K_lds, qr, r32, hi, cinit); partialSM(pA0, pA1);
  SWAIT(); SWRITE(1, SO); SLOAD(SO, 3 * KVBLK);
  __syncthreads();
  int s0 = 0, s1 = 1, s2 = 2;
  for (int j = 1; j + 1 < NT; j += 2) {
    SBAR(); qkt(pB0, pB1, K_lds + s1 * K8_TILE, qr, r32, hi, cinit);
    finishSM(pA0, pA1, pa); SBAR();
    pv_d0(o, ol, V_lds + s0 * V8_TILE, pa, r32, hi); partialSM(pB0, pB1);
    SBAR(); SWAIT(); SWRITE(s2, SE); SLOAD(SE, (j + 3 < NT ? j + 3 : NT - 1) * KVBLK);
    __syncthreads();
    SBAR(); qkt(pA0, pA1, K_lds + s2 * K8_TILE, qr, r32, hi, cinit);
    finishSM(pB0, pB1, pa); SBAR();
    pv_d0(o, ol, V_lds + s1 * V8_TILE, pa, r32, hi); partialSM(pA0, pA1);
    SBAR(); SWAIT(); SWRITE(s0, SO); SLOAD(SO, (j + 4 < NT ? j + 4 : NT - 1) * KVBLK);
    __syncthreads();
    { const int t_ = s0; s0 = s2; s2 = s1; s1 = t_; }
  }
  SBAR(); qkt(pB0, pB1, K_lds + s1 * K8_TILE, qr, r32, hi, cinit);
  finishSM(pA0, pA1, pa); SBAR();
  pv_d0(o, ol, V_lds + s0 * V8_TILE, pa, r32, hi); partialSM(pB0, pB1);
  finishSM(pB0, pB1, pa); SBAR();
  pv_d0(o, ol, V_lds + s1 * V8_TILE, pa, r32, hi);
  asm volatile("s_waitcnt vmcnt(0)" ::: "memory");
  if (lse && r32 == 0) {
#pragma unroll
    for (int r = 0; r < 16; ++r) lse[(wid * QBLK + crow(r, hi)) * 4] = __logf(ol[r]) - mnC * 0.69314718055994531f; }
  float rli[16];
#pragma unroll
  for (int r = 0; r < 16; ++r) rli[r] = __builtin_amdgcn_rcpf(ol[r]);
  bf16_t* Ow = Ob + (long)(wid * QBLK) * LDO;
#pragma unroll
  for (int r = 0; r < 16; ++r) { int orow = crow(r, hi);
    for (int d0 = 0; d0 < 4; ++d0) Ow[(long)orow * LDO + d0 * 32 + r32] = (bf16_t)(pkbf(o[d0][r] * rli[r], 0.f) & 0xffffu); }
  __syncthreads();
#undef SLOAD
#undef SWRITE
#undef SWAIT
}
}

struct Args { const float* in[20]; float* out; unsigned char* ws; int ph_lo, ph_hi; };
typedef const __attribute__((address_space(4))) Args* KArgs;
__device__ __forceinline__ KArgs get_args() { KArgs p = (KArgs)__builtin_amdgcn_kernarg_segment_ptr(); asm volatile("" : "+s"(p)); return p; }
__device__ __forceinline__ int fresh_tid() { int t = threadIdx.x; asm volatile("" : "+v"(t)); return t; }
__device__ __forceinline__ int fresh_bx() { int t = blockIdx.x; asm volatile("" : "+s"(t)); return t; }
__device__ __forceinline__ int fresh_g() { int t = gridDim.x; asm volatile("" : "+s"(t)); return t; }
enum { I_X = 0, I_C, I_CTX, I_CCTX, I_ADAW, I_ADAB, I_N1W, I_N2W, I_WIN, I_QNW, I_KNW, I_CONVW, I_ALOG, I_DTB, I_DNW, I_WOUT, I_WQ, I_SUBK, I_U, I_V };

__device__ __forceinline__ void convert_tables(const float* U, const float* V, unsigned char* ws, int l, int wvi, int nwv, int lane, int rw_end = 2 * NEXP) {
    const float* us = U + (size_t)l * NEXP * 1024; const float* vs = V + (size_t)l * NEXP * 1024;
    const int set = l & 1;
    float* scl = (float*)(ws + WS_USC) + set * 2 * NEXP;
    for (int rw = wvi; rw < rw_end; rw += nwv) {
        const bool isu = rw < NEXP; const int e = isu ? rw : rw - NEXP;
        const f32x4* sp = (const f32x4*)((isu ? us : vs) + (size_t)e * 1024 + 16 * lane);
        f32x4 x[4]; float mx = 0.f;
#pragma unroll
        for (int i = 0; i < 4; ++i) { x[i] = sp[i]; mx = fmaxf(mx, fmaxf(fmaxf(fabsf(x[i][0]), fabsf(x[i][1])), fmaxf(fabsf(x[i][2]), fabsf(x[i][3])))); }
        mx = wave_max(mx);
        const float sc = fmaxf(mx, 1e-30f) * (1.f / 127.f), inv = 1.f / sc;
        u32x4 o4;
        const float ofs = ((GATHER_PART && isu) || GATHER_PART == 2) ? 0.f : 128.f;
#pragma unroll
        for (int i = 0; i < 4; ++i) { const unsigned b0 = (unsigned)(int)(rintf(x[i][0] * inv) + ofs) & 255u, b1 = (unsigned)(int)(rintf(x[i][1] * inv) + ofs) & 255u, b2 = (unsigned)(int)(rintf(x[i][2] * inv) + ofs) & 255u, b3 = (unsigned)(int)(rintf(x[i][3] * inv) + ofs) & 255u;
            o4[i] = b0 | (b1 << 8) | (b2 << 16) | (b3 << 24); }
        if (GATHER_PART == 2) *(u32x4*)(ws + WS_UB + (size_t)set * TAB_SET + (isu ? 0 : (size_t)NEXP * 1024) + ((size_t)(lane >> 3) * NEXP + e) * 128 + 16 * (lane & 7)) = o4;
        else *(u32x4*)(ws + WS_UB + (size_t)set * TAB_SET + (size_t)e * 2048 + (isu ? 0 : 1024) + 16 * lane) = o4;
        if (lane == 0) { if (GATHER_PART) scl[2 * e + (isu ? 0 : 1)] = sc; else scl[rw] = sc; }
    }
}

__device__ __forceinline__ void transpose_item(const float* W, int ldw, int K, bf16_t* WT, LAS float* scr, int kb, int nb, int lane) {
    const int k0 = 64 * kb, n0 = 32 * nb;
#pragma unroll 8
    for (int i = 0; i < 32; ++i) { const int kk = 2 * i + (lane >> 5); scr[kk * 33 + (lane & 31)] = W[(size_t)(k0 + kk) * ldw + n0 + (lane & 31)]; }
    LDS_WAIT(); asm volatile("" ::: "memory");
    const int c = lane & 7;
#pragma unroll
    for (int j = 0; j < 4; ++j) { const int n = (lane >> 3) + 8 * j; const LAS float* s = scr + (8 * c) * 33 + n;
        u32x4 o; o.x = pkbf(s[0 * 33], s[1 * 33]); o.y = pkbf(s[2 * 33], s[3 * 33]); o.z = pkbf(s[4 * 33], s[5 * 33]); o.w = pkbf(s[6 * 33], s[7 * 33]);
        *(u32x4*)(WT + (size_t)(n0 + n) * K + k0 + 8 * c) = o; }
    LDS_WAIT(); asm volatile("" ::: "memory");
}
__device__ __forceinline__ void phase_prologue(LAS unsigned char* lds) {
    const KArgs ap = get_args();
#define a (*ap)

    const int tid = fresh_tid(), lane = tid & 63, wave = __builtin_amdgcn_readfirstlane(tid >> 6), G = fresh_g(), bx = fresh_bx();
    unsigned char* ws = a.ws;
    {
        LAS float* sc = (LAS float*)(lds + 70000);
        LAS float* part = (LAS float*)(lds + 70000 + 12288);
        for (int i = tid; i < 3 * 1024; i += 512) { const int r = i >> 10, k = i & 1023; const float v = r < 2 ? a.in[I_C][r * 1024 + k] : a.in[I_CCTX][k]; sc[i] = silu_f(v); }
        __syncthreads();
        float* mod = (float*)(ws + WS_MOD);
        for (int item = bx; item < DEPTH * 96; item += G) {
            const int l = item / 96, j0 = (item % 96) * 64;
            const float* wp = a.in[I_ADAW] + (size_t)l * 1024 * 6144 + (size_t)(wave * 128) * 6144 + j0 + lane;
            float a0 = 0.f, a1 = 0.f, a2 = 0.f;
#pragma unroll 8
            for (int kk = 0; kk < 128; ++kk) { const float w = wp[(size_t)kk * 6144]; const int k = wave * 128 + kk; a0 = fmaf(sc[k], w, a0); a1 = fmaf(sc[1024 + k], w, a1); a2 = fmaf(sc[2048 + k], w, a2); }
            part[(wave * 3 + 0) * 64 + lane] = a0; part[(wave * 3 + 1) * 64 + lane] = a1; part[(wave * 3 + 2) * 64 + lane] = a2;
            __syncthreads();
            if (tid < 192) { const int r = tid >> 6, jj = tid & 63; float s = a.in[I_ADAB][l * 6144 + j0 + jj];
#pragma unroll
                for (int w = 0; w < 8; ++w) s += part[(w * 3 + r) * 64 + jj];
                mod[(size_t)(l * 3 + r) * 6144 + j0 + jj] = s; }
            __syncthreads();
        }
    }
    {
        const int gw = bx * 8 + wave, NGW = G * 8;
        unsigned* wmaxw = (unsigned*)(ws + WS_CTL) + CW_WMAX;
        constexpr int NB_IN = NP / 64, NB_OUT = 1024 / 64, NB_Q = 2048 / 64, PER_L2 = (NB_IN + NB_OUT + NB_Q) * 8;
        for (int it = gw; it < DEPTH * PER_L2; it += NGW) { const int l = it / PER_L2; int r = it % PER_L2; const int kc = r & 7; r >>= 3;
            const int mi = r < NB_IN ? 0 : r < NB_IN + NB_OUT ? 1 : 2; const int nb = mi == 0 ? r : mi == 1 ? r - NB_IN : r - NB_IN - NB_OUT; const int ldw = mi == 0 ? NIN : mi == 1 ? 1024 : 2048;
            const float* wp = (mi == 0 ? a.in[I_WIN] + (size_t)l * 1024 * NIN : mi == 1 ? a.in[I_WOUT] + (size_t)l * 1024 * 1024 : a.in[I_WQ] + (size_t)l * 1024 * 2048) + (size_t)(kc * 128) * ldw + nb * 64 + lane;
            float mx = 0.f;
#pragma unroll 8
            for (int kk = 0; kk < 128; ++kk) mx = fmaxf(mx, fabsf(wp[(size_t)kk * ldw]));
            atomicMax(wmaxw + (l * 3 + mi) * 3072 + nb * 64 + lane, __float_as_uint(mx)); }
    }
    const size_t gt = (size_t)bx * 512 + tid, NT = (size_t)G * 512;
    for (size_t i = gt; i < (size_t)DEPTH * 16 * 1024; i += NT) { const int l = (int)(i >> 14), j = (int)((i >> 10) & 15), k = (int)(i & 1023);
        ((float*)(ws + WS_WSK))[i] = a.in[I_WIN][(size_t)l * 1024 * NIN + (size_t)k * NIN + NP + j]; }
    for (size_t i = gt; i < (size_t)DEPTH * 8 * 2 * 128 * 128 / 2; i += NT) { const f32x2 x = ((const f32x2*)a.in[I_SUBK])[i]; ((unsigned*)(ws + WS_SKB))[i] = pkbf(x[0], x[1]); }
    for (size_t i = gt; i < 8192; i += NT) { const int pos = (int)(i >> 5), fi = (int)(i & 31);
        const float inv = exp2f(-(float)fi * (13.287712379549449f / 32.f)); const float ang = (float)pos * inv;
        float rev = ang * 0.15915494309189535f; rev -= floorf(rev);
        ((float*)(ws + WS_ROPE))[i] = __builtin_amdgcn_cosf(rev); ((float*)(ws + WS_ROPE))[8192 + i] = __builtin_amdgcn_sinf(rev); }
}


__device__ __forceinline__ void quant_transpose_item(const float* W, int ldw, signed char* WT, const unsigned* wmaxw, LAS float* scr, int kb, int nb, int lane) {
    const int k0 = 64 * kb, n0 = 32 * nb;
#pragma unroll 8
    for (int i = 0; i < 32; ++i) { const int kk = 2 * i + (lane >> 5); scr[kk * 33 + (lane & 31)] = W[(size_t)(k0 + kk) * ldw + n0 + (lane & 31)]; }
    LDS_WAIT(); asm volatile("" ::: "memory");
    const int n = lane >> 1, hf = lane & 1;
    const float mx = __uint_as_float(wmaxw[n0 + n]), inv = mx > 0.f ? 127.f / mx : 0.f;
    u32x4 o[2];
#pragma unroll
    for (int q = 0; q < 8; ++q) { unsigned w = 0u;
#pragma unroll
        for (int b = 0; b < 4; ++b) { const int kk = 32 * hf + 4 * q + b; w |= ((unsigned)(int)rintf(scr[kk * 33 + n] * inv) & 255u) << (8 * b); }
        o[q >> 2][q & 3] = w; }
    u32x4* dst = (u32x4*)(WT + (size_t)(n0 + n) * 1024 + k0 + 32 * hf);
    dst[0] = o[0]; dst[1] = o[1];
    LDS_WAIT(); asm volatile("" ::: "memory");
}
__device__ __forceinline__ void phase_quant_weights(LAS unsigned char* lds) {
    const KArgs ap = get_args();
#define a (*ap)
    const int tid = fresh_tid(), lane = tid & 63, wave = __builtin_amdgcn_readfirstlane(tid >> 6), G = fresh_g(), bx = fresh_bx();
    unsigned char* ws = a.ws;
    LAS float* scr = (LAS float*)(lds + 65536 + wave * 8448);
    const unsigned* wmaxw = (const unsigned*)(ws + WS_CTL) + CW_WMAX;
    constexpr int I_IN = 16 * 96, I_OUT = 16 * 32, I_Q = 16 * 64, PER_L = I_IN + I_OUT + I_Q;
    for (int it = bx * 8 + wave; it < DEPTH * PER_L; it += G * 8) { const int l = it / PER_L; int r = it % PER_L;
        if (r < I_IN) quant_transpose_item(a.in[I_WIN] + (size_t)l * 1024 * NIN, NIN, (signed char*)(ws + WS_WINT) + (size_t)l * NP * 1024, wmaxw + (l * 3 + 0) * 3072, scr, r / 96, r % 96, lane);
        else if (r < I_IN + I_OUT) { r -= I_IN; quant_transpose_item(a.in[I_WOUT] + (size_t)l * 1024 * 1024, 1024, (signed char*)(ws + WS_WOUTT) + (size_t)l * 1024 * 1024, wmaxw + (l * 3 + 1) * 3072, scr, r / 32, r % 32, lane); }
        else { r -= I_IN + I_OUT; quant_transpose_item(a.in[I_WQ] + (size_t)l * 1024 * 2048, 2048, (signed char*)(ws + WS_WQT) + (size_t)l * 2048 * 1024, wmaxw + (l * 3 + 2) * 3072, scr, r / 64, r % 64, lane); } }
#undef a
}

template <bool SK>
__device__ __forceinline__ void phase_norm(int l, int which, LAS unsigned char* lds) {
    const KArgs ap = get_args();
#define a (*ap)

    const int tid = fresh_tid(), lane = tid & 63, wave = __builtin_amdgcn_readfirstlane(tid >> 6), G = fresh_g(), bx = fresh_bx();
    unsigned char* ws = a.ws;
    LAS float* wsk = (LAS float*)lds;
    if (SK) { const float* src = (const float*)(ws + WS_WSK) + (size_t)l * 16384; for (int i = tid; i < 16384 / 4; i += 512) ((LAS f32x4*)wsk)[i] = ((const f32x4*)src)[i]; __syncthreads(); }
    const int nrows = (which == 1 && l == DEPTH - 1) ? ML : M;
    const float* nw = a.in[which ? I_N2W : I_N1W] + l * 1024;
    const float* modl = (const float*)(ws + WS_MOD) + (size_t)l * 3 * 6144;
    const int shoff = which ? 3072 : 0, scoff = which ? 4096 : 1024;
    f32x4 nwv[4];
#pragma unroll
    for (int j = 0; j < 4; ++j) nwv[j] = *(const f32x4*)(nw + 4 * lane + 256 * j);
    for (int row = wave * G + bx; row < nrows; row += G * 8) {
        const int mrow = row < ML ? (row >= T ? 1 : 0) : 2;
        const float* md = modl + mrow * 6144;
        f32x4 v[4]; float ss = 0.f;
        if (l == 0 && which == 0) { const float* src = row < ML ? a.in[I_X] + (size_t)row * D : a.in[I_CTX] + (size_t)(row - ML) * D;
#pragma unroll
            for (int j = 0; j < 4; ++j) v[j] = *(const f32x4*)(src + 4 * lane + 256 * j); }
        else { const bf16_t* src = (const bf16_t*)(ws + WS_XB) + (size_t)row * D;
#pragma unroll
            for (int j = 0; j < 4; ++j) { const u32x2 w_ = *(const u32x2*)(src + 4 * lane + 256 * j); v[j] = (f32x4){bflo(w_[0]), bfhi(w_[0]), bflo(w_[1]), bfhi(w_[1])}; } }
#pragma unroll
        for (int j = 0; j < 4; ++j) ss += (v[j][0] * v[j][0] + v[j][1] * v[j][1]) + (v[j][2] * v[j][2] + v[j][3] * v[j][3]);
        const float rstd = rsqrtf(wave_sum(ss) * (1.f / D) + EPS);
        signed char* hrow = (signed char*)(ws + WS_H) + (size_t)row * D;
        float hmx = 0.f;
#pragma unroll
        for (int j = 0; j < 4; ++j) { const f32x4 sc = *(const f32x4*)(md + scoff + 4 * lane + 256 * j), sh = *(const f32x4*)(md + shoff + 4 * lane + 256 * j);
            v[j] = v[j] * rstd * nwv[j] * (sc + 1.f) + sh; hmx = fmaxf(hmx, fmaxf(fmaxf(fabsf(v[j][0]), fabsf(v[j][1])), fmaxf(fabsf(v[j][2]), fabsf(v[j][3])))); }
        hmx = fmaxf(wave_max(hmx), 1e-30f);
        { const float hinv = 127.f / hmx;
#pragma unroll
          for (int j = 0; j < 4; ++j) *(unsigned*)(hrow + 4 * lane + 256 * j) = ((unsigned)(int)rintf(v[j][0] * hinv) & 255u) | (((unsigned)(int)rintf(v[j][1] * hinv) & 255u) << 8) | (((unsigned)(int)rintf(v[j][2] * hinv) & 255u) << 16) | (((unsigned)(int)rintf(v[j][3] * hinv) & 255u) << 24);
          if (lane == 0) ((float*)(ws + WS_GB))[row] = hmx * (1.f / 127.f); }
        if (SK) {
            float p[16];
#pragma unroll
            for (int c = 0; c < 16; ++c) { float q = 0.f;
#pragma unroll
                for (int j = 0; j < 4; ++j) { const f32x4 w = *(const LAS f32x4*)(wsk + c * 1024 + 4 * lane + 256 * j); q += (v[j][0] * w[0] + v[j][1] * w[1]) + (v[j][2] * w[2] + v[j][3] * w[3]); }
                p[c] = q; }
            { const bool hb = (lane & 32) != 0;
#pragma unroll
              for (int c = 0; c < 8; ++c) { const float keep = hb ? p[c + 8] : p[c], send = hb ? p[c] : p[c + 8]; p[c] = keep + lane_xor<32>(send); } }
            { const bool hb = (lane & 16) != 0;
#pragma unroll
              for (int c = 0; c < 4; ++c) { const float keep = hb ? p[c + 4] : p[c], send = hb ? p[c] : p[c + 4]; p[c] = keep + lane_xor<16>(send); } }
            { const bool hb = (lane & 8) != 0;
#pragma unroll
              for (int c = 0; c < 2; ++c) { const float keep = hb ? p[c + 2] : p[c], send = hb ? p[c] : p[c + 2]; p[c] = keep + lane_xor<8>(send); } }
            { const bool hb = (lane & 4) != 0; const float keep = hb ? p[1] : p[0], send = hb ? p[0] : p[1]; p[0] = keep + lane_xor<4>(send); }
            p[0] += lane_xor<2>(p[0]); p[0] += lane_xor<1>(p[0]);
            if ((lane & 3) == 0) { const int c = ((lane >> 5) & 1) * 8 + ((lane >> 4) & 1) * 4 + ((lane >> 3) & 1) * 2 + ((lane >> 2) & 1); ((float*)(ws + WS_BA))[(size_t)row * 16 + c] = p[0]; }
        }
    }
    if (SK) __syncthreads();
}

__device__ __forceinline__ void phase_prep(int l, LAS unsigned char* lds) {
    const KArgs ap = get_args();
#define a (*ap)

    const int tid = fresh_tid(), lane = tid & 63, wave = __builtin_amdgcn_readfirstlane(tid >> 6), G = fresh_g(), bx = fresh_bx();
    unsigned char* ws = a.ws;
    const bf16_t* P = (const bf16_t*)(ws + WS_P);
    const float* ropec = (const float*)(ws + WS_ROPE); const float* ropes = ropec + 8192;
    const int sec = lane >> 5, fi = lane & 31;
    const float qw0 = a.in[I_QNW][l * 128 + sec * 64 + fi], qw1 = a.in[I_QNW][l * 128 + sec * 64 + 32 + fi];
    const float kw0 = a.in[I_KNW][l * 128 + sec * 64 + fi], kw1 = a.in[I_KNW][l * 128 + sec * 64 + 32 + fi];
    for (int row = wave * G + bx; row < M; row += G * 8) {
        const bool lat = row < ML;
        int b, tt, tlen; if (lat) { b = row >> 14; tt = row & (T - 1); tlen = T; } else { b = (row - ML) >> 8; tt = (row - ML) & (CT - 1); tlen = CT; }
        const bf16_t* prow = P + (size_t)row * NP;
        unsigned short xa[6][2];
#pragma unroll
        for (int hh = 0; hh < 6; ++hh) { const bf16_t* xp = prow + (hh < 4 ? hh * 128 : 512 + (hh - 4) * 128) + sec * 64 + fi; xa[hh][0] = xp[0]; xa[hh][1] = xp[32]; }
        const u32x2 vcp = *(const u32x2*)(prow + 768 + 4 * lane);
        float cs = 1.f, sn = 0.f;
        if (lat) { const int pos = sec ? (tt & 63) : (tt >> 6); cs = ropec[pos * 32 + fi]; sn = ropes[pos * 32 + fi]; }
        unsigned char* qo8 = ws + WS_QA + (size_t)row * 512;
        const size_t kvrow = (size_t)b * KVLEN + (lat ? tt : T + tt);
        unsigned char* ko8 = ws + WS_KA + kvrow * 256;
        float ssq[6];
#pragma unroll
        for (int hh = 0; hh < 6; ++hh) { const float x0 = bf2f(xa[hh][0]), x1 = bf2f(xa[hh][1]); ssq[hh] = x0 * x0 + x1 * x1; }
#pragma unroll
        for (int hh = 0; hh < 6; ++hh) ssq[hh] = wave_sum(ssq[hh]);
#pragma unroll
        for (int hh = 0; hh < 6; ++hh) {
            const float x0 = bf2f(xa[hh][0]), x1 = bf2f(xa[hh][1]);
            const float rs = rsqrtf(ssq[hh] * (1.f / 128.f) + EPS);
            const float y0 = x0 * rs * (hh < 4 ? qw0 : kw0), y1 = x1 * rs * (hh < 4 ? qw1 : kw1);
            const float qsc = hh < 4 ? 0.088388347648318440f * 1.4426950408889634f : 1.f;
            const float o0 = (y0 * cs - y1 * sn) * qsc, o1 = (y1 * cs + y0 * sn) * qsc;
            unsigned char* op8 = (hh < 4 ? qo8 + hh * 128 : ko8 + (hh - 4) * 128) + sec * 64 + fi;
            const float f8s = hh < 4 ? 8.f : 1.f;
            const int pk8 = __builtin_amdgcn_cvt_pk_fp8_f32(o0 * f8s, o1 * f8s, 0, false);
            op8[0] = (unsigned char)(pk8 & 255); op8[32] = (unsigned char)((pk8 >> 8) & 255);
        }
        { const int pos = lat ? tt : T + tt, tile = pos >> 6, k64 = pos & 63, k32 = k64 & 31;
          const int bytepos = 32 * ((k32 >> 2) & 1) + 16 * (k64 >> 5) + (k32 & 3) + 4 * (k32 >> 3);
          unsigned char* vt = ws + WS_VA + ((size_t)(b * 2) * (KVLEN / 64) + tile) * 8192 + bytepos;
          const unsigned short* vsrc = (const unsigned short*)&vcp;
          const int kvh_ = lane >> 5, d0 = (4 * lane) & 127;
          const int pk01 = __builtin_amdgcn_cvt_pk_fp8_f32(bf2f(vsrc[0]), bf2f(vsrc[1]), 0, false), pk23 = __builtin_amdgcn_cvt_pk_fp8_f32(bf2f(vsrc[2]), bf2f(vsrc[3]), 0, false);
          unsigned char* vt2 = vt + (size_t)kvh_ * (KVLEN / 64) * 8192 + (size_t)d0 * 64;
          vt2[0] = (unsigned char)(pk01 & 255); vt2[64] = (unsigned char)((pk01 >> 8) & 255); vt2[128] = (unsigned char)(pk23 & 255); vt2[192] = (unsigned char)((pk23 >> 8) & 255); }
    }
    __syncthreads();
}

constexpr int ATT_PARTS = 4;
__device__ __forceinline__ void phase_attn(int l, unsigned char* lds_raw, volatile LAS unsigned* MISC, int rep) {
    const KArgs ap = get_args();
#define a (*ap)
    unsigned char* ws = a.ws;
    const unsigned char* QA = ws + WS_QA; const unsigned char* KA = ws + WS_KA; const unsigned char* VT = ws + WS_VA;
    bf16_t* CAT = (bf16_t*)(ws + WS_CAT); float* LSE = (float*)(ws + WS_BA);
    unsigned* ctr = (unsigned*)(ws + WS_CTL) + 8192 + 64 * l + 1024 * rep;
    const int natt = 2048 + (l < DEPTH - 1 ? 8 : 0);
    constexpr int CONV_ROWS = 64, NCONV = 2 * NEXP / CONV_ROWS;
    const int nunits = natt + (l + 1 < DEPTH ? NCONV : 0) + (l == 0 ? NCONV : 0);
    float braw;
    { const int ln = threadIdx.x & 63; float mq = fmaxf(fabsf(a.in[I_QNW][l * 128 + ln]), fabsf(a.in[I_QNW][l * 128 + 64 + ln])), mk = fmaxf(fabsf(a.in[I_KNW][l * 128 + ln]), fabsf(a.in[I_KNW][l * 128 + 64 + ln]));
      mq = wave_max(mq); mk = wave_max(mk);
      braw = __builtin_bit_cast(float, __builtin_amdgcn_readfirstlane(__builtin_bit_cast(int, 128.f * mq * mk))); }
    if (threadIdx.x == 0) MISC[12] = __hip_atomic_fetch_add(ctr, 1u, __ATOMIC_RELAXED, __HIP_MEMORY_SCOPE_AGENT);
    __syncthreads();
    int u = (int)MISC[12], par = 0;
    for (; u < nunits; ) {
        if (threadIdx.x == 0) MISC[13 - par] = __hip_atomic_fetch_add(ctr, 1u, __ATOMIC_RELAXED, __HIP_MEMORY_SCOPE_AGENT);
        if (u >= natt) {
            const int tq_ = fresh_tid();
            const int ci_ = u - natt, own_ = ci_ >= NCONV ? 1 : 0;
            const int rwb = (ci_ - own_ * NCONV) * CONV_ROWS + __builtin_amdgcn_readfirstlane(tq_ >> 6) * 8;
            convert_tables(a.in[I_U], a.in[I_V], ws, l + 1 - own_, rwb, 1, tq_ & 63, rwb + 8);
            __syncthreads();
            u = (int)MISC[13 - par]; par ^= 1;
            continue;
        }
        size_t r0, kv0; int h, kvh, seq, ldo; bf16_t* ob; float* lse;
        if (u < 2048) { const int qb = u & 63, g = (u >> 6) & 1, part = (u >> 7) & 3, b = u >> 10; kvh = (u >> 9) & 1; h = kvh * 2 + g;
            const int t0 = (part >> 1) * 130 + (part & 1) * 64;
            r0 = (size_t)b * T + (size_t)qb * 256; kv0 = (size_t)b * KVLEN + (size_t)t0 * 64; seq = ((part & 1) ? 66 : 64) * 64;
            ob = part ? (bf16_t*)(ws + (part == 1 ? WS_DQ : part == 2 ? WS_DK : WS_DV)) + r0 * 512 + h * 128 : CAT + r0 * 1024 + h * 128; ldo = part ? 512 : 1024; lse = LSE + ((size_t)part * ML + r0) * 4 + h; }
        else { const int b = (u - 2048) >> 2; h = (u - 2048) & 3; kvh = h >> 1; r0 = (size_t)ML + (size_t)b * CT; kv0 = (size_t)b * KVLEN + T; seq = CT;
            ob = CAT + r0 * 1024 + h * 128; ldo = 1024; lse = nullptr; }
        att::attn_dense_body(QA + r0 * 512 + h * 128, KA + kv0 * 256 + kvh * 128, VT + ((size_t)((kv0 / KVLEN) * 2 + kvh) * (KVLEN / 64) + (kv0 % KVLEN) / 64) * 8192, ob, ldo, seq, (char*)lds_raw, lse, braw);
        u = (int)MISC[13 - par]; par ^= 1;
    }
#undef a
}

__device__ __forceinline__ int tokperm(int q, int hh, int jj) { return 16 * q + 8 * (jj >> 2) + 4 * hh + (jj & 3); }
__device__ __forceinline__ int crow16(int r, int hi) { return (r & 3) + 8 * (r >> 2) + 4 * hi; }
__device__ __forceinline__ int kperm16(int s_, int g, int jj) { return 32 * s_ + 16 * (jj >> 2) + 4 * g + (jj & 3); }
__device__ __forceinline__ int frag_off(int i, int j) {
    return (((i >> 4) * 2 + (j >> 5)) * 64 + ((i & 15) + 16 * ((j >> 2) & 3))) * 16 + (4 * ((j >> 4) & 1) + (j & 3)) * 2;
}
template <int MODE>
__device__ __forceinline__ void phase_dn_chunkprep(int l, LAS unsigned char* lds) {
    const KArgs ap = get_args();
#define a (*ap)
    const int tid = fresh_tid(), lane = tid & 63, wave = __builtin_amdgcn_readfirstlane(tid >> 6), G = fresh_g(), bx = fresh_bx();
    unsigned char* ws = a.ws;
    constexpr int KT_OFF = 0, QT_OFF = 17408, VT_OFF = 34816, GS_OFF = 52224, RS_OFF = 68864, AM_OFF = 85504, SC_OFF = 120320, IMG_OFF = 0;
    const int r = lane & 31, hh = lane >> 5;
    const bf16_t* DQ = (const bf16_t*)(ws + WS_DQ); const bf16_t* DK = (const bf16_t*)(ws + WS_DK); const bf16_t* DV = (const bf16_t*)(ws + WS_DV);
    const float* BA = (const float*)(ws + WS_BA);
    constexpr int NTASK = MODE ? NB * 4 * 4 : NB * 4 * (NCH - 4);
#define CP_TASKID(t_) (MODE ? ((t_) >> 2) * NCH + ((t_) & 3) : ((t_) >> 8) * NCH + 4 + ((t_) & 255))
    LAS float* gsc = (LAS float*)(lds + SC_OFF);
    LAS float* bsc = gsc + 128;
    LAS float* gcs = gsc + 256;
    constexpr int CW_OFF = 121856, DI_OFF = CW_OFF + 5 * 1536 * 4;
    static_assert(DI_OFF + 8192 <= LDS_MISC, "chunkprep LDS");
    LAS float* cwl = (LAS float*)(lds + CW_OFF);
    for (int i = tid; i < 5 * 1536; i += 512) cwl[i] = a.in[I_CONVW][(size_t)l * 5 * 1536 + i];
    __syncthreads();
    const bf16_t* P = (const bf16_t*)(ws + WS_P);
    u32x4 xin[3][5][2];
#define CP_LOADX(task_) do { const int cidx_ = (task_) % NCH, bh_ = (task_) / NCH, b_ = bh_ >> 2, h_ = bh_ & 3; \
        const int row0_ = cidx_ < 4 ? ML + b_ * CT + cidx_ * 64 : b_ * T + (cidx_ - 4) * 64, tt_ = (cidx_ < 4 ? cidx_ * 64 : (cidx_ - 4) * 64) + (tid >> 3), tlen_ = cidx_ < 4 ? CT : T; \
        _Pragma("unroll") for (int j = 0; j < 5; ++j) { const int t2 = tt_ + j - 2; const bool ok = t2 >= 0 && t2 < tlen_; \
            const bf16_t* xr = P + (size_t)(row0_ + (tid >> 3) + (ok ? j - 2 : 0)) * NP + 1024 + h_ * 128 + (tid & 7) * 16; \
            _Pragma("unroll") for (int m = 0; m < 3; ++m) { const u32x4 w0 = *(const u32x4*)(xr + m * 512), w1 = *(const u32x4*)(xr + m * 512 + 8); \
                xin[m][j][0] = ok ? w0 : (u32x4){0u, 0u, 0u, 0u}; xin[m][j][1] = ok ? w1 : (u32x4){0u, 0u, 0u, 0u}; } } } while (0)
    if (bx < NTASK) CP_LOADX(CP_TASKID(bx));
    for (int tk = bx; tk < NTASK; tk += G) {
        const int task = CP_TASKID(tk);
        const int cidx = task % NCH, bh = task / NCH, b = bh >> 2, h = bh & 3;
        const int row0 = cidx < 4 ? ML + b * CT + cidx * 64 : b * T + (cidx - 4) * 64;
        unsigned char* rec = ws + WS_REC + (size_t)task * REC_BYTES;
        {
            const int rr = tid >> 3, seg = tid & 7;
            if (tid < 128) { const int d = tid >> 6, i = tid & 63, dh = d * 4 + h;
                const float xb = BA[(size_t)(row0 + i) * 16 + dh], z = BA[(size_t)(row0 + i) * 16 + 8 + dh] + a.in[I_DTB][l * 8 + dh];
                bsc[tid] = 1.f / (1.f + __expf(-xb)); gsc[tid] = -__expf(a.in[I_ALOG][l * 8 + dh]) * (fmaxf(z, 0.f) + log1pf(__expf(-fabsf(z)))); }
#pragma unroll
            for (int m = 0; m < 3; ++m) {
                float y[16];
#pragma unroll
                for (int c = 0; c < 16; ++c) y[c] = 0.f;
#pragma unroll
                for (int j = 0; j < 5; ++j) { const LAS float* wp = cwl + j * 1536 + m * 512 + h * 128 + seg * 16;
#pragma unroll
                    for (int q4 = 0; q4 < 4; ++q4) { const f32x4 wv = *(const LAS f32x4*)(wp + 4 * q4); const unsigned u0 = xin[m][j][q4 >> 1][2 * (q4 & 1)], u1 = xin[m][j][q4 >> 1][2 * (q4 & 1) + 1];
                        y[4 * q4 + 0] = fmaf(bflo(u0), wv[0], y[4 * q4 + 0]); y[4 * q4 + 1] = fmaf(bfhi(u0), wv[1], y[4 * q4 + 1]); y[4 * q4 + 2] = fmaf(bflo(u1), wv[2], y[4 * q4 + 2]); y[4 * q4 + 3] = fmaf(bfhi(u1), wv[3], y[4 * q4 + 3]); } }
                float ss = 0.f;
#pragma unroll
                for (int c = 0; c < 16; ++c) { y[c] = silu_f(y[c]); ss = fmaf(y[c], y[c], ss); }
                if (m < 2) { ss += lane_xor<1>(ss); ss += lane_xor<2>(ss); ss += lane_xor<4>(ss);
                    float sc = rsqrtf(ss + EPS); if (m == 0) sc *= 0.088388347648318440f;
#pragma unroll
                    for (int c = 0; c < 16; ++c) y[c] *= sc; }
                u32x4 o0, o1; o0.x = pkbf(y[0], y[1]); o0.y = pkbf(y[2], y[3]); o0.z = pkbf(y[4], y[5]); o0.w = pkbf(y[6], y[7]); o1.x = pkbf(y[8], y[9]); o1.y = pkbf(y[10], y[11]); o1.z = pkbf(y[12], y[13]); o1.w = pkbf(y[14], y[15]);
                LAS unsigned char* dst = lds + (m == 0 ? QT_OFF : m == 1 ? KT_OFF : VT_OFF) + rr * 272 + seg * 32;
                *(LAS u32x4*)dst = o0; *(LAS u32x4*)(dst + 16) = o1;
            }
        }
        __syncthreads();
        {
            const int mat = wave >> 2, ti = (wave >> 1) & 1, tj = wave & 1;
            f32x16 acc = {};
#pragma unroll
            for (int ks = 0; ks < 8; ++ks) {
                const bf16x8 av = *(const LAS bf16x8*)(lds + (mat ? QT_OFF : KT_OFF) + (32 * ti + r) * 272 + (16 * ks + 8 * hh) * 2);
                const bf16x8 bv = *(const LAS bf16x8*)(lds + KT_OFF + (32 * tj + r) * 272 + (16 * ks + 8 * hh) * 2);
                acc = __builtin_amdgcn_mfma_f32_32x32x16_bf16(av, bv, acc, 0, 0, 0);
            }
            LAS float* dst = (LAS float*)(lds + (mat ? RS_OFF : GS_OFF));
#pragma unroll
            for (int i = 0; i < 16; ++i) dst[(32 * ti + crow16(i, hh)) * 65 + 32 * tj + r] = acc[i];
        }
        { const int r16 = lane & 15, g4 = lane >> 4;
#pragma unroll
        for (int t = 0; t < 2; ++t) { const int f = wave * 2 + t, mt = f >> 2, sk = f & 3;
            { const u32x2 lo = *(const LAS u32x2*)(lds + KT_OFF + (16 * mt + r16) * 272 + (32 * sk + 4 * g4) * 2), hi2 = *(const LAS u32x2*)(lds + KT_OFF + (16 * mt + r16) * 272 + (32 * sk + 16 + 4 * g4) * 2);
              *(u32x4*)(rec + REC_K + f * 1024 + lane * 16) = (u32x4){lo.x, lo.y, hi2.x, hi2.y}; }
            { const u32x2 lo = *(const LAS u32x2*)(lds + QT_OFF + (16 * mt + r16) * 272 + (32 * sk + 4 * g4) * 2), hi2 = *(const LAS u32x2*)(lds + QT_OFF + (16 * mt + r16) * 272 + (32 * sk + 16 + 4 * g4) * 2);
              *(u32x4*)(rec + REC_Q + f * 1024 + lane * 16) = (u32x4){lo.x, lo.y, hi2.x, hi2.y}; } }
#pragma unroll
        for (int t = 0; t < 2; ++t) { const int f = wave * 2 + t, mt = f >> 1, sk = f & 1;
            unsigned e[8];
#pragma unroll
            for (int jj = 0; jj < 8; ++jj) e[jj] = *(const LAS unsigned short*)(lds + KT_OFF + kperm16(sk, g4, jj) * 272 + (16 * mt + r16) * 2);
            *(u32x4*)(rec + REC_KT + f * 1024 + lane * 16) = (u32x4){e[0] | (e[1] << 16), e[2] | (e[3] << 16), e[4] | (e[5] << 16), e[6] | (e[7] << 16)}; }
        { const int sl = wave;
            unsigned e[16];
#pragma unroll
            for (int i = 0; i < 16; ++i) e[i] = *(const LAS unsigned short*)(lds + VT_OFF + (16 * (i >> 2) + 4 * g4 + (i & 3)) * 272 + (16 * sl + r16) * 2);
            u32x4* vp = (u32x4*)(rec + REC_V + sl * 2048 + lane * 32);
            vp[0] = (u32x4){e[0] | (e[1] << 16), e[2] | (e[3] << 16), e[4] | (e[5] << 16), e[6] | (e[7] << 16)};
            vp[1] = (u32x4){e[8] | (e[9] << 16), e[10] | (e[11] << 16), e[12] | (e[13] << 16), e[14] | (e[15] << 16)}; }
        }
        if (tk + G < NTASK) CP_LOADX(CP_TASKID(tk + G));
        if (wave < 2) { const int d = wave; float gv = gsc[d * 64 + (d ? 63 - lane : lane)];
            gv += __builtin_bit_cast(float, __builtin_amdgcn_update_dpp(0, __builtin_bit_cast(int, gv), 0x111, 0xF, 0xF, true));
            gv += __builtin_bit_cast(float, __builtin_amdgcn_update_dpp(0, __builtin_bit_cast(int, gv), 0x112, 0xF, 0xF, true));
            gv += __builtin_bit_cast(float, __builtin_amdgcn_update_dpp(0, __builtin_bit_cast(int, gv), 0x114, 0xF, 0xF, true));
            gv += __builtin_bit_cast(float, __builtin_amdgcn_update_dpp(0, __builtin_bit_cast(int, gv), 0x118, 0xF, 0xF, true));
            { const float t0 = __builtin_bit_cast(float, __builtin_amdgcn_readlane(__builtin_bit_cast(int, gv), 15)), t1 = __builtin_bit_cast(float, __builtin_amdgcn_readlane(__builtin_bit_cast(int, gv), 31)), t2 = __builtin_bit_cast(float, __builtin_amdgcn_readlane(__builtin_bit_cast(int, gv), 47));
              const int rw_ = lane >> 4; gv += (rw_ >= 1 ? t0 : 0.f) + (rw_ >= 2 ? t1 : 0.f) + (rw_ >= 3 ? t2 : 0.f); }
            gcs[d * 64 + lane] = gv; }
        __syncthreads();
        const LAS float* Gs = (const LAS float*)(lds + GS_OFF); const LAS float* Rs = (const LAS float*)(lds + RS_OFF);
#pragma unroll 4
        for (int t = 0; t < 16; ++t) { const int e = tid + 512 * t, d = e >> 12, jp = (e >> 6) & 63, ip = e & 63;
            const int in_ = d ? 63 - ip : ip, jn = d ? 63 - jp : jp;
            const float dec = __expf(fminf(gcs[d * 64 + ip] - gcs[d * 64 + jp], 0.f));
            const float av = (jp < ip) ? bsc[d * 64 + in_] * Gs[in_ * 65 + jn] * dec : 0.f;
            ((LAS float*)(lds + AM_OFF))[d * 4352 + jp * 68 + ip] = av;
            const float qk = (jp <= ip) ? Rs[in_ * 65 + jn] * dec : 0.f;
            *(LAS unsigned short*)(lds + IMG_OFF + d * 16384 + 8192 + frag_off(in_, jn)) = (unsigned short)(pkbf(qk, 0.f) & 0xffffu); }
        __syncthreads();
        { int ln_ = lane; asm volatile("" : "+v"(ln_));
          const int d = wave >> 2, nt = wave & 3, n16 = ln_ & 15, g4 = ln_ >> 4;
          const LAS float* At = (const LAS float*)(lds + AM_OFF) + d * 4352;
          LAS float* Xd = (LAS float*)(lds + GS_OFF) + d * 4096;
          LAS float* Dinv = (LAS float*)(lds + DI_OFF) + d * 1024;
          { float x[16];
#pragma unroll
            for (int q = 0; q < 16; ++q) x[q] = (q == n16) ? 1.f : 0.f;
#pragma unroll
            for (int r2 = 0; r2 < 15; ++r2) { const LAS float* ar = At + (16 * nt + r2) * 68 + 16 * nt; const float xr = x[r2];
#pragma unroll
                for (int q4 = (r2 + 1) / 4; q4 < 4; ++q4) { const f32x4 a4 = *(const LAS f32x4*)(ar + 4 * q4);
#pragma unroll
                    for (int q = 0; q < 4; ++q) if (4 * q4 + q > r2) x[4 * q4 + q] = fmaf(-a4[q], xr, x[4 * q4 + q]); } }
            if (ln_ < 16) {
#pragma unroll
                for (int q = 0; q < 16; ++q) Dinv[nt * 256 + q * 16 + n16] = x[q]; } }
          if (wave == 2 || wave == 3) { const int d2 = wave - 2, ip = d2 ? 63 - lane : lane; const float gl = gcs[d2 * 64 + 63], gi = gcs[d2 * 64 + ip];
            float* sc = (float*)(rec + REC_DIR + d2 * REC_DIRSZ + 16384);
            sc[lane] = __expf(gi); sc[64 + lane] = __expf(gl - gi); if (lane == 0) sc[128] = __expf(gl); }
          __syncthreads();
          const int c = 16 * nt + n16, jn = d ? 63 - c : c; const float bj = bsc[d * 64 + jn];
          const int fj = (jn >> 5) * 1024 + ((jn >> 2) & 3) * 256 + ((jn >> 4) & 1) * 8 + (jn & 3) * 2;
#pragma unroll 1
          for (int B = 0; B < 4; ++B) {
            f32x4 y = {0.f, 0.f, 0.f, 0.f};
            if (nt <= B) {
                f32x4 acc;
#pragma unroll
                for (int r2 = 0; r2 < 4; ++r2) acc[r2] = (nt == B && 4 * g4 + r2 == n16) ? 1.f : 0.f;
#pragma unroll 2
                for (int j0 = 0; j0 < 16 * B; j0 += 4) { const float av = -At[(j0 + g4) * 68 + 16 * B + n16], bv = Xd[(j0 + g4) * 64 + c];
                    acc = __builtin_amdgcn_mfma_f32_16x16x4f32(av, bv, acc, 0, 0, 0); }
#pragma unroll
                for (int r2 = 0; r2 < 4; ++r2) Xd[(16 * B + 4 * g4 + r2) * 64 + c] = acc[r2];
#pragma unroll
                for (int s4 = 0; s4 < 4; ++s4) { const float av = Dinv[B * 256 + n16 * 16 + 4 * s4 + g4], bv = Xd[(16 * B + 4 * s4 + g4) * 64 + c];
                    y = __builtin_amdgcn_mfma_f32_16x16x4f32(av, bv, y, 0, 0, 0); }
            }
#pragma unroll
            for (int r2 = 0; r2 < 4; ++r2) { const int i = 16 * B + 4 * g4 + r2, in_ = d ? 63 - i : i; Xd[i * 64 + c] = y[r2];
                *(LAS unsigned short*)(lds + IMG_OFF + d * 16384 + (in_ >> 4) * 2048 + (in_ & 15) * 16 + fj) = (unsigned short)(pkbf_c(y[r2] * bj, 0.f) & 0xffffu); }
            __syncthreads();
          }
        }
#pragma unroll
        for (int t = 0; t < 4; ++t) { const int p = tid + 512 * t, d = p >> 10, off = (p & 1023) * 16;
            *(u32x4*)(rec + REC_DIR + d * REC_DIRSZ + off) = *(const LAS u32x4*)(lds + IMG_OFF + d * 16384 + off); }
        __syncthreads();
    }
#undef CP_LOADX
#undef CP_TASKID
#undef a
}

__device__ __forceinline__ bf16x8 pack44(const f32x4& lo, const f32x4& hi) {
    u32x4 p; p.x = pkbf_c(lo[0], lo[1]); p.y = pkbf_c(lo[2], lo[3]); p.z = pkbf_c(hi[0], hi[1]); p.w = pkbf_c(hi[2], hi[3]);
    return __builtin_bit_cast(bf16x8, p);
}
template <int VAR>
__device__ __forceinline__ void phase_dn_scan(int l, LAS unsigned char* lds) {
    const KArgs ap = get_args();
#define a (*ap)
    const int tid = fresh_tid(), lane = tid & 63, wave = __builtin_amdgcn_readfirstlane(tid >> 6), bx = fresh_bx();
    unsigned char* ws = a.ws;
    if (bx >= 32) return;
    const int chain = bx >> 1, half = bx & 1, b = chain >> 3, h = (chain >> 1) & 3, dir = chain & 1;
    const unsigned char* recb = ws + WS_REC + (size_t)((b * 4 + h) * NCH) * REC_BYTES;
    constexpr int BUFSZ = 74752;
#define CIDX(n) (dir ? ((n) < 4 ? 3 - (n) : 263 - (n)) : (n))
    if (wave >= 4) {
        const int sw = wave - 4;
#define DN_PIECE(i_) ((sw + 4 * (i_)) < 73 ? (sw + 4 * (i_)) : 72)
#define DN_SRC(rec_, p_) ((p_) < 48 ? (rec_) + (p_) * 1024 : (p_) < 65 ? (rec_) + REC_DIR + dir * REC_DIRSZ + ((p_) - 48) * 1024 : (rec_) + REC_V + half * 8192 + ((p_) - 65) * 1024)
#define DN_STAGE(n, bi) do { const unsigned char* rec_ = recb + (size_t)CIDX(n) * REC_BYTES; _Pragma("unroll") for (int i_ = 0; i_ < 19; ++i_) { const int p_ = DN_PIECE(i_); \
        __builtin_amdgcn_global_load_lds((const unsigned*)(DN_SRC(rec_, p_) + lane * 16), (LAS unsigned*)(lds + (bi) * BUFSZ + p_ * 1024), 16, 0, 0); } } while (0)
#define DN_SYNC() do { asm volatile("s_waitcnt vmcnt(0)" ::: "memory"); __builtin_amdgcn_s_barrier(); asm volatile("" ::: "memory"); } while (0)
        if (VAR != 3) DN_STAGE(0, 0);
        DN_SYNC();
        for (int n = 0; n < NCH; ++n) {
            if (VAR != 3 && n + 1 < NCH) DN_STAGE(n + 1, (n + 1) & 1);
            DN_SYNC();
        }
#undef DN_STAGE
#undef DN_PIECE
#undef DN_SRC
#undef DN_SYNC
    } else {
        const int sl = half * 4 + wave, c16 = lane & 15, g4 = lane >> 4;
        bf16_t* Og = (bf16_t*)(ws + (dir ? WS_OB : WS_OF)) + h * 128 + sl * 16 + c16;
        f32x4 S[8];
#pragma unroll
        for (int i = 0; i < 8; ++i) S[i] = (f32x4){0.f, 0.f, 0.f, 0.f};
        asm volatile("s_waitcnt lgkmcnt(0)" ::: "memory"); __builtin_amdgcn_s_barrier(); asm volatile("" ::: "memory");
        for (int n = 0; n < NCH; ++n) {
            if (VAR == 2) { asm volatile("s_waitcnt lgkmcnt(0)" ::: "memory"); __builtin_amdgcn_s_barrier(); asm volatile("" ::: "memory"); continue; }
            const LAS unsigned char* buf = lds + (n & 1) * BUFSZ;
            const int cidx = CIDX(n);
            const u32x4 vc0 = *(const LAS u32x4*)(buf + 66560 + wave * 2048 + lane * 32), vc1 = *(const LAS u32x4*)(buf + 66560 + wave * 2048 + lane * 32 + 16);
#define FR(off, f) (*(const LAS bf16x8*)(buf + (off) + (f) * 1024 + lane * 16))
#define MF(A, B, C) __builtin_amdgcn_mfma_f32_16x16x32_bf16((A), (B), (C), 0, 0, 0)
#define SB_() __builtin_amdgcn_sched_barrier(0)
            bf16x8 fa[8], fb[8];
            f32x4 eg[4], dl[4];
#pragma unroll
            for (int mt = 0; mt < 4; ++mt) { eg[mt] = *(const LAS f32x4*)(buf + 65536 + (16 * mt + 4 * g4) * 4); dl[mt] = *(const LAS f32x4*)(buf + 65536 + 256 + (16 * mt + 4 * g4) * 4); }
            const float egl = *(const LAS float*)(buf + 65536 + 512);
#define RD_KQ(dst, q) do { _Pragma("unroll") for (int mt = 0; mt < 4; ++mt) { dst[mt] = FR(0, mt * 4 + (q)); dst[4 + mt] = FR(32768, mt * 4 + (q)); } } while (0)
#define MM_KQ(src, q) do { _Pragma("unroll") for (int mt = 0; mt < 4; ++mt) { X[mt] = MF(src[mt], Sb[q], X[mt]); O[mt] = MF(src[4 + mt], Sb[q], O[mt]); } } while (0)
            f32x4 X[4], O[4], VN[4];
#pragma unroll
            for (int i = 0; i < 4; ++i) { X[i] = (f32x4){0.f, 0.f, 0.f, 0.f}; O[i] = (f32x4){0.f, 0.f, 0.f, 0.f}; VN[i] = (f32x4){0.f, 0.f, 0.f, 0.f}; }
            bf16x8 Sb[4];
#pragma unroll
            for (int q = 0; q < 4; ++q) Sb[q] = pack44(S[2 * q], S[2 * q + 1]);
            RD_KQ(fa, 0); SB_();
            RD_KQ(fb, 1); SB_(); MM_KQ(fa, 0); SB_();
            RD_KQ(fa, 2); SB_(); MM_KQ(fb, 1); SB_();
            RD_KQ(fb, 3); SB_(); MM_KQ(fa, 2); SB_();
#pragma unroll
            for (int i = 0; i < 8; ++i) fa[i] = FR(49152, i);
            SB_(); MM_KQ(fb, 3); SB_();
#pragma unroll
            for (int mt = 0; mt < 4; ++mt) { const unsigned w0 = (mt < 2 ? vc0 : vc1)[2 * (mt & 1)], w1 = (mt < 2 ? vc0 : vc1)[2 * (mt & 1) + 1];
                X[mt][0] = bflo(w0) - eg[mt][0] * X[mt][0]; X[mt][1] = bfhi(w0) - eg[mt][1] * X[mt][1]; X[mt][2] = bflo(w1) - eg[mt][2] * X[mt][2]; X[mt][3] = bfhi(w1) - eg[mt][3] * X[mt][3]; }
            const bf16x8 Yb0 = pack44(X[0], X[1]), Yb1 = pack44(X[2], X[3]);
            SB_();
#pragma unroll
            for (int i = 0; i < 8; ++i) fb[i] = FR(57344, i);
            SB_();
#pragma unroll
            for (int mt = 0; mt < 4; ++mt) { VN[mt] = MF(fa[mt * 2], Yb0, VN[mt]); VN[mt] = MF(fa[mt * 2 + 1], Yb1, VN[mt]); }
            SB_();
#pragma unroll
            for (int mt = 0; mt < 4; ++mt) O[mt] = O[mt] * eg[mt];
            const bf16x8 Vb0 = pack44(VN[0], VN[1]), Vb1 = pack44(VN[2], VN[3]);
            SB_();
#pragma unroll
            for (int i = 0; i < 8; ++i) fa[i] = FR(16384, i);
            SB_();
#pragma unroll
            for (int mt = 0; mt < 4; ++mt) { O[mt] = MF(fb[mt * 2], Vb0, O[mt]); O[mt] = MF(fb[mt * 2 + 1], Vb1, O[mt]); }
            SB_();
#pragma unroll
            for (int mt = 0; mt < 4; ++mt) VN[mt] = VN[mt] * dl[mt];
            const bf16x8 Vd0 = pack44(VN[0], VN[1]), Vd1 = pack44(VN[2], VN[3]);
#pragma unroll
            for (int i = 0; i < 8; ++i) S[i] = S[i] * egl;
            SB_();
#pragma unroll
            for (int i = 0; i < 8; ++i) fb[i] = FR(16384, 8 + i);
            SB_();
#pragma unroll
            for (int i = 0; i < 4; ++i) { S[i] = MF(fa[i * 2], Vd0, S[i]); S[i] = MF(fa[i * 2 + 1], Vd1, S[i]); }
            SB_();
#pragma unroll
            for (int i = 0; i < 4; ++i) { S[4 + i] = MF(fb[i * 2], Vd0, S[4 + i]); S[4 + i] = MF(fb[i * 2 + 1], Vd1, S[4 + i]); }
            SB_();
            {
                const int row0 = cidx < 4 ? ML + b * CT + cidx * 64 : b * T + (cidx - 4) * 64;
                bf16_t* op = Og + (size_t)(row0 + 4 * g4) * 512;
#pragma unroll
                for (int mt = 0; mt < 4; ++mt)
#pragma unroll
                    for (int t = 0; t < 4; ++t) { if (VAR != 1) op[(size_t)(16 * mt + t) * 512] = (bf16_t)(pkbf_c(O[mt][t], 0.f) & 0xffffu); else asm volatile("" :: "v"(O[mt][t])); }
            }
#undef RD_KQ
#undef MM_KQ
#undef SB_
#undef FR
#undef MF
            asm volatile("s_waitcnt lgkmcnt(0)" ::: "memory"); __builtin_amdgcn_s_barrier(); asm volatile("" ::: "memory");
        }
    }
#undef CIDX
#undef a
}

__device__ __forceinline__ void phase_dn_out(int l) {
    const KArgs ap = get_args();
#define a (*ap)

    const int tid = fresh_tid(), lane = tid & 63, wave = __builtin_amdgcn_readfirstlane(tid >> 6), G = fresh_g(), bx = fresh_bx();
    unsigned char* ws = a.ws;
    const int nrows = (l == DEPTH - 1) ? ML : M;
    const bf16_t* OF = (const bf16_t*)(ws + WS_OF); const bf16_t* OB = (const bf16_t*)(ws + WS_OB);
    const bf16_t* P = (const bf16_t*)(ws + WS_P); bf16_t* CAT = (bf16_t*)(ws + WS_CAT);
    const f32x2 nw = *(const f32x2*)(a.in[I_DNW] + l * 128 + 2 * lane);
    const float* LSE = (const float*)(ws + WS_BA);
    for (int row = wave * G + bx; row < nrows; row += G * 8) {
        f32x2 of[4], ob[4]; unsigned gw[4];
#pragma unroll
        for (int hh = 0; hh < 4; ++hh) { const unsigned wf_ = *(const unsigned*)(OF + (size_t)row * 512 + hh * 128 + 2 * lane), wb_ = *(const unsigned*)(OB + (size_t)row * 512 + hh * 128 + 2 * lane); of[hh] = (f32x2){bflo(wf_), bfhi(wf_)}; ob[hh] = (f32x2){bflo(wb_), bfhi(wb_)};
            gw[hh] = *(const unsigned*)(P + (size_t)row * NP + 2560 + hh * 128 + 2 * lane); }
        u32x4 ap_[4]; float ls_[4];
#pragma unroll
        for (int p = 0; p < 4; ++p) { ap_[p] = (u32x4){0u, 0u, 0u, 0u}; ls_[p] = 0.f; }
        if (row < ML) {
            ap_[0] = *(const u32x4*)(CAT + (size_t)row * 1024 + 8 * lane); ap_[1] = *(const u32x4*)((const bf16_t*)(ws + WS_DQ) + (size_t)row * 512 + 8 * lane);
            ap_[2] = *(const u32x4*)((const bf16_t*)(ws + WS_DK) + (size_t)row * 512 + 8 * lane); ap_[3] = *(const u32x4*)((const bf16_t*)(ws + WS_DV) + (size_t)row * 512 + 8 * lane);
#pragma unroll
            for (int p = 0; p < 4; ++p) ls_[p] = LSE[((size_t)p * ML + row) * 4 + (lane >> 4)]; }
        float o0[4], o1[4], ssq[4];
#pragma unroll
        for (int hh = 0; hh < 4; ++hh) { o0[hh] = of[hh][0] + ob[hh][0]; o1[hh] = of[hh][1] + ob[hh][1]; ssq[hh] = o0[hh] * o0[hh] + o1[hh] * o1[hh]; }
#pragma unroll
        for (int hh = 0; hh < 4; ++hh) ssq[hh] = wave_sum(ssq[hh]);
        float mxv = 0.f;
#pragma unroll
        for (int hh = 0; hh < 4; ++hh) { const float rs = rsqrtf(ssq[hh] * (1.f / 128.f) + EPS); const float g0 = bflo(gw[hh]), g1 = bfhi(gw[hh]);
            o0[hh] = o0[hh] * rs * nw[0] * silu_f(g0); o1[hh] = o1[hh] * rs * nw[1] * silu_f(g1); mxv = fmaxf(mxv, fmaxf(fabsf(o0[hh]), fabsf(o1[hh]))); }
        float av[8];
        if (row < ML) { const float mx = fmaxf(fmaxf(ls_[0], ls_[1]), fmaxf(ls_[2], ls_[3]));
            float w_[4], wsum = 0.f;
#pragma unroll
            for (int p = 0; p < 4; ++p) { w_[p] = __expf(ls_[p] - mx); wsum += w_[p]; }
            const float inv = 1.f / wsum;
#pragma unroll
            for (int i = 0; i < 4; ++i) { float lo = 0.f, hi2 = 0.f;
#pragma unroll
                for (int p = 0; p < 4; ++p) { lo = fmaf(w_[p], bflo(ap_[p][i]), lo); hi2 = fmaf(w_[p], bfhi(ap_[p][i]), hi2); }
                av[2 * i] = lo * inv; av[2 * i + 1] = hi2 * inv; } }
        else { const u32x4 cw_ = *(const u32x4*)(CAT + (size_t)row * 1024 + 8 * lane);
#pragma unroll
            for (int i = 0; i < 4; ++i) { av[2 * i] = bflo(cw_[i]); av[2 * i + 1] = bfhi(cw_[i]); } }
#pragma unroll
        for (int i = 0; i < 8; ++i) mxv = fmaxf(mxv, fabsf(av[i]));
        mxv = fmaxf(wave_max(mxv), 1e-30f);
        const float cinv = 127.f / mxv;
        signed char* crow = (signed char*)(ws + WS_CATQ) + (size_t)row * 1024;
#define Q8_(x) ((unsigned)(int)rintf((x) * cinv) & 255u)
        { u32x2 o; o.x = Q8_(av[0]) | (Q8_(av[1]) << 8) | (Q8_(av[2]) << 16) | (Q8_(av[3]) << 24); o.y = Q8_(av[4]) | (Q8_(av[5]) << 8) | (Q8_(av[6]) << 16) | (Q8_(av[7]) << 24); *(u32x2*)(crow + 8 * lane) = o; }
#pragma unroll
        for (int hh = 0; hh < 4; ++hh) *(unsigned short*)(crow + 512 + hh * 128 + 2 * lane) = (unsigned short)(Q8_(o0[hh]) | (Q8_(o1[hh]) << 8));
#undef Q8_
        if (lane == 0) ((float*)(ws + WS_GB))[(1u << 18) + row] = mxv * (1.f / 127.f);
    }
#undef a
}

#define CE_DESC(a_, b_) do { const float hi_ = fmaxf(a_, b_), lo_ = fminf(a_, b_); a_ = hi_; b_ = lo_; } while (0)
__device__ __forceinline__ void bitonic_sort16_desc(float (&v)[16]) {
#pragma unroll
    for (int k = 2; k <= 16; k <<= 1)
#pragma unroll
        for (int j = k >> 1; j > 0; j >>= 1)
#pragma unroll
            for (int i = 0; i < 16; ++i) { const int p = i ^ j; if (p > i) { if ((i & k) == 0) CE_DESC(v[i], v[p]); else CE_DESC(v[p], v[i]); } }
}
__device__ __forceinline__ void merge_top16_desc(float (&lst)[16], const float (&nw)[16]) {
#pragma unroll
    for (int i = 0; i < 16; ++i) lst[i] = fmaxf(lst[i], nw[15 - i]);
#pragma unroll
    for (int j = 8; j > 0; j >>= 1)
#pragma unroll
        for (int i = 0; i < 16; ++i) { const int p = i ^ j; if (p > i) CE_DESC(lst[i], lst[p]); }
}
__device__ __forceinline__ void phase_peer_select(int l) {
    const KArgs ap = get_args();
#define a (*ap)
    const int tid = fresh_tid(), lane = tid & 63, wave = __builtin_amdgcn_readfirstlane(tid >> 6), G = fresh_g(), bx = fresh_bx();
    unsigned char* ws = a.ws;
    const int nrows = (l == DEPTH - 1) ? ML : M;
    const int ntask = (nrows / 32) * 4;
    const bf16_t* Q2 = (const bf16_t*)(ws + WS_P);
    const bf16_t* SKB = (const bf16_t*)(ws + WS_SKB) + (size_t)l * 8 * 2 * 128 * 128;
    int* PIDX = (int*)(ws + WS_PIDX); float* PGATE = (float*)(ws + WS_PGATE);
    const float NEG = -3.0e38f;
    const int r = lane & 31, hi = lane >> 5;
    for (int task = wave * G + bx; task < ntask; task += G * 8) {
        const int tg = task >> 2, hp = task & 3; const int row = tg * 32 + r;
        float mine0[16], mine1[16];
#pragma unroll
        for (int j = 0; j < 16; ++j) { mine0[j] = NEG; mine1[j] = NEG; }
        bf16x8 qA[8], kA[8];
        float lst[16];
#define SEL_QPTR(it_) (Q2 + (size_t)row * 2048 + (2 * hp + ((it_) >> 1)) * 256 + ((it_) & 1) * 128 + 8 * hi)
#define SEL_KPTR(it_, t_) (SKB + (size_t)(((2 * hp + ((it_) >> 1)) * 2 + ((it_) & 1)) * 128 + 32 * (t_) + r) * 128 + 8 * hi)
#define SEL_LDQ(dst, it_) do { const bf16_t* qp_ = SEL_QPTR(it_); _Pragma("unroll") for (int ks = 0; ks < 8; ++ks) dst[ks] = *(const bf16x8*)(qp_ + 16 * ks); } while (0)
#define SEL_LDK(dst, it_, t_) do { const bf16_t* kp_ = SEL_KPTR(it_, t_); _Pragma("unroll") for (int ks = 0; ks < 8; ++ks) dst[ks] = *(const bf16x8*)(kp_ + 16 * ks); } while (0)
#define SEL_RANK(qv, kv, t_) do { f32x16 acc = {}; _Pragma("unroll") for (int ks = 0; ks < 8; ++ks) acc = __builtin_amdgcn_mfma_f32_32x32x16_bf16(kv[ks], qv[ks], acc, 0, 0, 0); \
            const unsigned kb = (unsigned)(32 * (t_) + 4 * hi); float nw_[16]; \
            _Pragma("unroll") for (int i = 0; i < 16; ++i) nw_[i] = __uint_as_float((__float_as_uint(acc[i]) & 0xffffff80u) | (kb + (unsigned)((i & 3) + 8 * (i >> 2)))); \
            bitonic_sort16_desc(nw_); merge_top16_desc(lst, nw_); } while (0)
#define SB_() __builtin_amdgcn_sched_barrier(0)
#pragma unroll
        for (int j = 0; j < 16; ++j) lst[j] = NEG;
#pragma unroll 1
        for (int it = 0; it < 4; ++it) {
            SEL_LDQ(qA, it);
#pragma unroll 1
            for (int t = 0; t < 4; ++t) { SEL_LDK(kA, it, t); SEL_RANK(qA, kA, t); }
            float oth[16];
#pragma unroll
            for (int j = 0; j < 16; ++j) { auto rr = __builtin_amdgcn_permlane32_swap(__float_as_uint(lst[j]), __float_as_uint(lst[j]), false, false); oth[j] = __uint_as_float(hi ? rr[0] : rr[1]); }
            merge_top16_desc(lst, oth);
            const bool k0 = ((it >> 1) == hi) && ((it & 1) == 0), k1 = ((it >> 1) == hi) && ((it & 1) == 1);
#pragma unroll
            for (int j = 0; j < 16; ++j) { mine0[j] = k0 ? lst[j] : mine0[j]; mine1[j] = k1 ? lst[j] : mine1[j]; lst[j] = NEG; }
        }
#undef SB_
#undef SEL_QPTR
#undef SEL_KPTR
#undef SEL_LDQ
#undef SEL_LDK
#undef SEL_RANK
        const int h = 2 * hp + hi;
        float ts[16];
#pragma unroll
        for (int j = 0; j < 16; ++j) ts[j] = NEG;
#pragma unroll
        for (int i = 0; i < 16; ++i)
#pragma unroll
            for (int j = 0; j < 16; ++j) if ((i + 1) * (j + 1) <= 16) {
                const unsigned b0 = __float_as_uint(mine0[i]), b1 = __float_as_uint(mine1[j]);
                const float c = __uint_as_float(b0 & 0xffffff80u) + __uint_as_float(b1 & 0xffffff80u);
                float x = __uint_as_float((__float_as_uint(c) & 0xffffc000u) | ((b0 & 127u) << 7) | (b1 & 127u));
#pragma unroll
                for (int t = 0; t < 16; ++t) { const float hv = fmaxf(ts[t], x); x = fminf(ts[t], x); ts[t] = hv; }
            }
        int te[16]; float ex[16], sum = 0.f;
        const float tmax = __uint_as_float(__float_as_uint(ts[0]) & 0xffffc000u);
#pragma unroll
        for (int t = 0; t < 16; ++t) { const unsigned bt = __float_as_uint(ts[t]); te[t] = (int)(bt & 0x3fffu); ex[t] = __expf(__uint_as_float(bt & 0xffffc000u) - tmax); sum += ex[t]; }
        const float inv = 1.f / sum;
        unsigned short* ip = (unsigned short*)PIDX + (size_t)row * 128 + h * 16; float* gp = PGATE + (size_t)row * 128 + h * 16;
#pragma unroll
        for (int t = 0; t < 16; t += 8) *(u32x4*)(ip + t) = (u32x4){(unsigned)te[t] | ((unsigned)te[t + 1] << 16), (unsigned)te[t + 2] | ((unsigned)te[t + 3] << 16), (unsigned)te[t + 4] | ((unsigned)te[t + 5] << 16), (unsigned)te[t + 6] | ((unsigned)te[t + 7] << 16)};
#pragma unroll
        for (int t = 0; t < 16; t += 4) *(f32x4*)(gp + t) = (f32x4){ex[t] * inv, ex[t + 1] * inv, ex[t + 2] * inv, ex[t + 3] * inv};
    }
#undef a
}

template <bool WR, int GV = 0>
__device__ __forceinline__ void phase_peer_gather(int l, LAS unsigned char* lds) {
    const KArgs ap = get_args();
#define a (*ap)
    const int tid = fresh_tid(), lane = tid & 63, wave = __builtin_amdgcn_readfirstlane(tid >> 6), G = fresh_g(), bx = fresh_bx();
    unsigned char* ws = a.ws;
    const int nrows = (l == DEPTH - 1) ? ML : M;
    const unsigned char* UB = ws + WS_UB + (size_t)(l & 1) * TAB_SET; const unsigned char* VB = UB + 1024;
    const float* USC = (const float*)(ws + WS_USC) + (l & 1) * 2 * NEXP; const float* VSC = USC + NEXP;
    const int* PIDX = (const int*)(ws + WS_PIDX); const float* PGATE = (const float*)(ws + WS_PGATE);
    const float* modl = (const float*)(ws + WS_MOD) + (size_t)l * 3 * 6144 + 5120;
    const bool fuse = WR && (l + 1 < DEPTH);
    LAS float* wsk = (LAS float*)lds;
    if (fuse) { const float* src = (const float*)(ws + WS_WSK) + (size_t)(l + 1) * 16384; for (int i = tid; i < 16384 / 4; i += 512) ((LAS f32x4*)wsk)[i] = ((const f32x4*)src)[i]; __syncthreads(); }
    const float* nw1 = a.in[I_N1W] + (l + 1 < DEPTH ? l + 1 : l) * 1024 + 16 * lane;
    const float* modn = (const float*)(ws + WS_MOD) + (size_t)(l + 1 < DEPTH ? l + 1 : l) * 3 * 6144;
    for (int row = wave * G + bx; row < nrows; row += G * 8) {
        float hv[16], out[16];
        { const u32x4 hw = *(const u32x4*)((const signed char*)(ws + WS_H) + (size_t)row * D + 16 * lane); const float hsc = ((const float*)(ws + WS_GB))[row];
#pragma unroll
          for (int q = 0; q < 4; ++q) { const int w = (int)hw[q]; hv[4 * q + 0] = (float)((w << 24) >> 24) * hsc; hv[4 * q + 1] = (float)((w << 16) >> 24) * hsc; hv[4 * q + 2] = (float)((w << 8) >> 24) * hsc; hv[4 * q + 3] = (float)(w >> 24) * hsc; } }
        float hs = 0.f;
#pragma unroll
        for (int i = 0; i < 16; ++i) { out[i] = 0.f; hs += hv[i]; }
        const float hsum128 = 128.f * wave_sum(hs);
        float wacc = 0.f;
        const int id0 = PIDX[(size_t)row * 128 + lane], id1 = PIDX[(size_t)row * 128 + 64 + lane];
        const float gt0 = PGATE[(size_t)row * 128 + lane], gt1 = PGATE[(size_t)row * 128 + 64 + lane];
        const float us0 = USC[id0], us1 = USC[id1], vs0 = VSC[id0], vs1 = VSC[id1];
        for (int e0 = 0; e0 < 128; e0 += 8) {
            u32x4 uw[8], vw[8]; float gte[8], use[8], vse[8];
#pragma unroll
            for (int j = 0; j < 8; ++j) { const int e = e0 + j; const int id = __builtin_amdgcn_readlane(e0 < 64 ? id0 : id1, e & 63);
                gte[j] = __builtin_bit_cast(float, __builtin_amdgcn_readlane(__builtin_bit_cast(int, e0 < 64 ? gt0 : gt1), e & 63));
                use[j] = __builtin_bit_cast(float, __builtin_amdgcn_readlane(__builtin_bit_cast(int, e0 < 64 ? us0 : us1), e & 63));
                vse[j] = __builtin_bit_cast(float, __builtin_amdgcn_readlane(__builtin_bit_cast(int, e0 < 64 ? vs0 : vs1), e & 63));
                uw[j] = *(const u32x4*)(UB + (size_t)id * 2048 + 16 * lane); vw[j] = *(const u32x4*)(VB + (size_t)id * 2048 + 16 * lane); }
#pragma unroll
            for (int j = 0; j < 8; ++j) {
                float d0 = 0.f, d1 = 0.f;
#pragma unroll
                for (int q = 0; q < 4; ++q) { const unsigned w = uw[j][q];
                    d0 = fmaf((float)(w & 255u), hv[4 * q + 0], d0); d1 = fmaf((float)((w >> 8) & 255u), hv[4 * q + 1], d1);
                    d0 = fmaf((float)((w >> 16) & 255u), hv[4 * q + 2], d0); d1 = fmaf((float)(w >> 24), hv[4 * q + 3], d1); }
                const float dsum = (wave_sum(d0 + d1) - hsum128) * use[j];
                const float act = 0.5f * dsum * (1.f + erff(dsum * 0.70710678118654752f));
                const float wgt = gte[j] * act * vse[j];
                wacc += wgt;
                if (GV == 1) { asm volatile("" :: "v"(vw[j])); out[0] += wgt; } else
#pragma unroll
                for (int q = 0; q < 4; ++q) { const unsigned w = vw[j][q];
                    out[4 * q + 0] = fmaf(wgt, (float)(w & 255u), out[4 * q + 0]); out[4 * q + 1] = fmaf(wgt, (float)((w >> 8) & 255u), out[4 * q + 1]);
                    out[4 * q + 2] = fmaf(wgt, (float)((w >> 16) & 255u), out[4 * q + 2]); out[4 * q + 3] = fmaf(wgt, (float)(w >> 24), out[4 * q + 3]); }
            }
        }
        const float corr = 128.f * wacc;
        float* xr; int mrow;
        if (row < ML) { xr = a.out + (size_t)row * D; mrow = row >= T ? 1 : 0; } else { xr = (float*)(ws + WS_CTXX) + (size_t)(row - ML) * D; mrow = 2; }
        const float* g2 = modl + mrow * 6144 + 16 * lane;
        f32x4 xn[4];
#pragma unroll
        for (int i = 0; i < 4; ++i) { const f32x4 x = *(const f32x4*)(xr + 16 * lane + 4 * i), g = *(const f32x4*)(g2 + 4 * i);
            xn[i] = x + g * (f32x4){out[4 * i] - corr, out[4 * i + 1] - corr, out[4 * i + 2] - corr, out[4 * i + 3] - corr};
            if (WR) *(f32x4*)(xr + 16 * lane + 4 * i) = xn[i]; else asm volatile("" :: "v"(xn[i])); }
        if (fuse) {
            float ss = 0.f;
#pragma unroll
            for (int i = 0; i < 4; ++i) ss += (xn[i][0] * xn[i][0] + xn[i][1] * xn[i][1]) + (xn[i][2] * xn[i][2] + xn[i][3] * xn[i][3]);
            const float rstd = rsqrtf(wave_sum(ss) * (1.f / D) + EPS);
            const float* md = modn + mrow * 6144 + 16 * lane;
#pragma unroll
            for (int i = 0; i < 4; ++i) { const f32x4 nwv = *(const f32x4*)(nw1 + 4 * i), sc = *(const f32x4*)(md + 1024 + 4 * i), sh = *(const f32x4*)(md + 4 * i);
                xn[i] = xn[i] * rstd * nwv * (sc + 1.f) + sh; }
            { float hmx = 0.f;
#pragma unroll
              for (int i = 0; i < 4; ++i) hmx = fmaxf(hmx, fmaxf(fmaxf(fabsf(xn[i][0]), fabsf(xn[i][1])), fmaxf(fabsf(xn[i][2]), fabsf(xn[i][3]))));
              hmx = fmaxf(wave_max(hmx), 1e-30f); const float hinv = 127.f / hmx;
              u32x4 o;
#pragma unroll
              for (int i = 0; i < 4; ++i) o[i] = ((unsigned)(int)rintf(xn[i][0] * hinv) & 255u) | (((unsigned)(int)rintf(xn[i][1] * hinv) & 255u) << 8) | (((unsigned)(int)rintf(xn[i][2] * hinv) & 255u) << 16) | (((unsigned)(int)rintf(xn[i][3] * hinv) & 255u) << 24);
              *(u32x4*)((signed char*)(ws + WS_H) + (size_t)row * D + 16 * lane) = o;
              if (lane == 0) ((float*)(ws + WS_GB))[row] = hmx * (1.f / 127.f); }
            float p[16];
#pragma unroll
            for (int c = 0; c < 16; ++c) { float q = 0.f;
#pragma unroll
                for (int i = 0; i < 4; ++i) { const f32x4 w = *(const LAS f32x4*)(wsk + c * 1024 + 16 * lane + 4 * i); q += (xn[i][0] * w[0] + xn[i][1] * w[1]) + (xn[i][2] * w[2] + xn[i][3] * w[3]); }
                p[c] = q; }
            { const bool hb = (lane & 32) != 0;
#pragma unroll
              for (int c = 0; c < 8; ++c) { const float keep = hb ? p[c + 8] : p[c], send = hb ? p[c] : p[c + 8]; p[c] = keep + lane_xor<32>(send); } }
            { const bool hb = (lane & 16) != 0;
#pragma unroll
              for (int c = 0; c < 4; ++c) { const float keep = hb ? p[c + 4] : p[c], send = hb ? p[c] : p[c + 4]; p[c] = keep + lane_xor<16>(send); } }
            { const bool hb = (lane & 8) != 0;
#pragma unroll
              for (int c = 0; c < 2; ++c) { const float keep = hb ? p[c + 2] : p[c], send = hb ? p[c] : p[c + 2]; p[c] = keep + lane_xor<8>(send); } }
            { const bool hb = (lane & 4) != 0; const float keep = hb ? p[1] : p[0], send = hb ? p[0] : p[1]; p[0] = keep + lane_xor<4>(send); }
            p[0] += lane_xor<2>(p[0]); p[0] += lane_xor<1>(p[0]);
            if ((lane & 3) == 0) { const int c = ((lane >> 5) & 1) * 8 + ((lane >> 4) & 1) * 4 + ((lane >> 3) & 1) * 2 + ((lane >> 2) & 1); ((float*)(ws + WS_BA))[(size_t)row * 16 + c] = p[0]; }
        }
    }
    if (fuse) __syncthreads();
}
#undef a
constexpr size_t WS_PART = WS_P;
static_assert(WS_PART + 8 * (size_t)M * 1024 * 2 <= WS_GB, "partials region");
constexpr int GP_ITEM = 16;
struct GpMeta { int id0, id1; float gt0, gt1; u32x4 hw; float hsc; };
__device__ __forceinline__ void phase_peer_gpart(int l, LAS unsigned char* lds) {
    const KArgs ap = get_args();
#define a (*ap)
    const int tid = fresh_tid(), lane = tid & 63, wave = __builtin_amdgcn_readfirstlane(tid >> 6);
    unsigned char* ws = a.ws;
    const int nrows = (l == DEPTH - 1) ? ML : M;
    const int nitem = nrows / GP_ITEM;
    const unsigned char* UB = ws + WS_UB + (size_t)(l & 1) * TAB_SET; const unsigned char* VB = UB + 1024;
    const f32x2* SC2 = (const f32x2*)(ws + WS_USC) + (size_t)(l & 1) * NEXP;
    const int* PIDX = (const int*)(ws + WS_PIDX); const float* PGATE = (const float*)(ws + WS_PGATE);
    LAS u32x4* lst0 = (LAS u32x4*)lds + wave * 256;
    const int eidx = ((lane >> 5) & 1) * 4 + ((lane >> 4) & 1) * 2 + ((lane >> 3) & 1);
    const int x = (int)(xb_xcc_id() & 7u);
#define GP_LOAD_META(m_, row_) do { const int rw_ = (row_); (m_).id0 = PIDX[(size_t)rw_ * 128 + lane]; (m_).id1 = PIDX[(size_t)rw_ * 128 + 64 + lane]; (m_).gt0 = PGATE[(size_t)rw_ * 128 + lane]; (m_).gt1 = PGATE[(size_t)rw_ * 128 + 64 + lane]; \
        (m_).hw = *(const u32x4*)((const signed char*)(ws + WS_H) + (size_t)rw_ * D + 16 * lane); (m_).hsc = ((const float*)(ws + WS_GB))[rw_]; } while (0)
#define GP_LOAD_SC(sa_, sb_, m_) do { sa_ = (f32x2){0.f, 0.f}; sb_ = (f32x2){0.f, 0.f}; if (((m_).id0 >> 11) == p) sa_ = SC2[(m_).id0]; if (((m_).id1 >> 11) == p) sb_ = SC2[(m_).id1]; } while (0)
#define GP_BUILD(cnt_, m_, sa_, sb_, buf_) do { const bool s0_ = ((m_).id0 >> 11) == p, s1_ = ((m_).id1 >> 11) == p; const unsigned long long m0_ = __ballot(s0_), m1_ = __ballot(s1_); \
        const int c0_ = __builtin_popcountll(m0_); cnt_ = __builtin_amdgcn_readfirstlane(c0_ + __builtin_popcountll(m1_)); \
        const int r0_ = (int)__builtin_amdgcn_mbcnt_hi((unsigned)(m0_ >> 32), __builtin_amdgcn_mbcnt_lo((unsigned)m0_, 0u)); \
        const int r1_ = c0_ + (int)__builtin_amdgcn_mbcnt_hi((unsigned)(m1_ >> 32), __builtin_amdgcn_mbcnt_lo((unsigned)m1_, 0u)); \
        LAS u32x4* lb_ = lst0 + (buf_) * 128; \
        if (s0_) lb_[r0_] = (u32x4){(unsigned)(m_).id0, __float_as_uint((m_).gt0 * sa_[1]), __float_as_uint(sa_[0]), 0u}; \
        if (s1_) lb_[r1_] = (u32x4){(unsigned)(m_).id1, __float_as_uint((m_).gt1 * sb_[1]), __float_as_uint(sb_[0]), 0u}; } while (0)
#pragma unroll 1
    for (int pp = 0; pp < 8; ++pp) {
        const int p = (x + pp) & 7;
        unsigned* ctr = (unsigned*)(ws + WS_CTL) + 16384 + (l * 8 + p) * 64;
        unsigned* part = (unsigned*)(ws + WS_PART + (size_t)p * M * 2048);
        unsigned tk = 0; if (lane == 0) tk = __hip_atomic_fetch_add(ctr, 1u, __ATOMIC_RELAXED, __HIP_MEMORY_SCOPE_AGENT);
        int it = __builtin_amdgcn_readfirstlane((int)tk);
#pragma unroll 1
        while (it < nitem) {
            unsigned tn = 0; if (lane == 0) tn = __hip_atomic_fetch_add(ctr, 1u, __ATOMIC_RELAXED, __HIP_MEMORY_SCOPE_AGENT);
            const int row0 = it * GP_ITEM, rowl = row0 + GP_ITEM - 1;
            GpMeta m1, m2, m3; f32x2 sa1, sb1, sa2, sb2; int c_cur, c_nxt; u32x4 hw_cur; float hsc_cur;
            GP_LOAD_META(m1, row0); GP_LOAD_META(m2, min(row0 + 1, rowl)); GP_LOAD_META(m3, min(row0 + 2, rowl));
            GP_LOAD_SC(sa1, sb1, m1);
            GP_BUILD(c_cur, m1, sa1, sb1, 0); hw_cur = m1.hw; hsc_cur = m1.hsc;
            GP_LOAD_SC(sa1, sb1, m2);
            m1 = m2; m2 = m3;
            GP_LOAD_META(m3, min(row0 + 3, rowl));
#pragma unroll 1
            for (int i = 0; i < GP_ITEM; ++i) {
                const int row = row0 + i;
                GP_BUILD(c_nxt, m1, sa1, sb1, (i + 1) & 1);
                const u32x4 hw_nxt = m1.hw; const float hsc_nxt = m1.hsc;
                GP_LOAD_SC(sa2, sb2, m2);
                m1 = m2; sa1 = sa2; sb1 = sb2; m2 = m3;
                GP_LOAD_META(m3, min(row + 4, rowl));
                LAS u32x4* lst = lst0 + (i & 1) * 128;
                const int c = c_cur; const u32x4 hw = hw_cur; const float hsc = hsc_cur;
                f32x2 o2[8];
#pragma unroll
                for (int k = 0; k < 8; ++k) o2[k] = (f32x2){0.f, 0.f};
                float wacc = 0.f;
#pragma unroll 1
                for (int e = 0; e < c; e += 8) {
                    u32x4 uw[8], vw[8];
#pragma unroll
                    for (int j = 0; j < 8; ++j) { const int sl = min(e + j, c - 1);
                        const int id = __builtin_amdgcn_readfirstlane((int)lst[sl][0]);
                        uw[j] = *(const u32x4*)(UB + (size_t)id * 2048 + 16 * lane); vw[j] = *(const u32x4*)(VB + (size_t)id * 2048 + 16 * lane); }
                    const int ms = e + eidx; const u32x4 en = lst[min(ms, c - 1)];
                    float pd[8];
#pragma unroll
                    for (int j = 0; j < 8; ++j) { int d = 0;
#pragma unroll
                        for (int q = 0; q < 4; ++q) d = __builtin_amdgcn_sdot4((int)uw[j][q], (int)hw[q], d, false);
                        pd[j] = (float)d; }
                    { const bool hb = (lane & 32) != 0;
#pragma unroll
                      for (int j = 0; j < 4; ++j) { const float keep = hb ? pd[j + 4] : pd[j], send = hb ? pd[j] : pd[j + 4]; pd[j] = keep + lane_xor<32>(send); } }
                    { const bool hb = (lane & 16) != 0;
#pragma unroll
                      for (int j = 0; j < 2; ++j) { const float keep = hb ? pd[j + 2] : pd[j], send = hb ? pd[j] : pd[j + 2]; pd[j] = keep + lane_xor<16>(send); } }
                    { const bool hb = (lane & 8) != 0; const float keep = hb ? pd[1] : pd[0], send = hb ? pd[0] : pd[1]; pd[0] = keep + lane_xor<8>(send); }
                    pd[0] += lane_xor<4>(pd[0]); pd[0] += lane_xor<2>(pd[0]); pd[0] += lane_xor<1>(pd[0]);
                    const float dsum = pd[0] * (__uint_as_float(en[2]) * hsc);
                    const float act = 0.5f * dsum * (1.f + erff(dsum * 0.70710678118654752f));
                    const float wgt = ms < c ? __uint_as_float(en[1]) * act : 0.f;
                    wacc += wgt;
#pragma unroll
                    for (int j = 0; j < 8; ++j) {
                        const float wj = __builtin_bit_cast(float, __builtin_amdgcn_readlane(__builtin_bit_cast(int, wgt), 32 * ((j >> 2) & 1) + 16 * ((j >> 1) & 1) + 8 * (j & 1)));
                        const f32x2 ww = {wj, wj};
#pragma unroll
                        for (int q = 0; q < 4; ++q) { const unsigned w = vw[j][q];
                            const f32x2 v01 = {(float)(w & 255u), (float)((w >> 8) & 255u)}, v23 = {(float)((w >> 16) & 255u), (float)(w >> 24)};
                            o2[2 * q] = __builtin_elementwise_fma(ww, v01, o2[2 * q]); o2[2 * q + 1] = __builtin_elementwise_fma(ww, v23, o2[2 * q + 1]); }
                    }
                }
                const float corr = 16.f * wave_sum(wacc);
                u32x4 w0, w1;
#pragma unroll
                for (int k = 0; k < 4; ++k) { w0[k] = pkbf_c(o2[k][0] - corr, o2[k][1] - corr); w1[k] = pkbf_c(o2[4 + k][0] - corr, o2[4 + k][1] - corr); }
                unsigned* dst = part + (size_t)row * 512 + 8 * lane;
                __builtin_nontemporal_store(w0, (u32x4*)dst); __builtin_nontemporal_store(w1, (u32x4*)(dst + 4));
                c_cur = c_nxt; hw_cur = hw_nxt; hsc_cur = hsc_nxt;
            }
            it = __builtin_amdgcn_readfirstlane((int)tn);
        }
    }
#undef GP_LOAD_META
#undef GP_LOAD_SC
#undef GP_BUILD
#undef a
}

__device__ __forceinline__ void phase_peer_combine(int l, LAS unsigned char* lds) {
    const KArgs ap = get_args();
#define a (*ap)
    const int tid = fresh_tid(), lane = tid & 63, wave = __builtin_amdgcn_readfirstlane(tid >> 6), G = fresh_g(), bx = fresh_bx();
    unsigned char* ws = a.ws;
    const int nrows = (l == DEPTH - 1) ? ML : M;
    const float* modl = (const float*)(ws + WS_MOD) + (size_t)l * 3 * 6144 + 5120;
    const bool fuse = (l + 1 < DEPTH);
    LAS float* wsk = (LAS float*)lds;
    if (fuse) { const float* src = (const float*)(ws + WS_WSK) + (size_t)(l + 1) * 16384; for (int i = tid; i < 16384 / 4; i += 512) ((LAS f32x4*)wsk)[i] = ((const f32x4*)src)[i]; __syncthreads(); }
    const float* nw1 = a.in[I_N1W] + (l + 1 < DEPTH ? l + 1 : l) * 1024 + 16 * lane;
    const float* modn = (const float*)(ws + WS_MOD) + (size_t)(l + 1 < DEPTH ? l + 1 : l) * 3 * 6144;
    for (int row = wave * G + bx; row < nrows; row += G * 8) {
        float out[16];
#pragma unroll
        for (int i = 0; i < 16; ++i) out[i] = 0.f;
#pragma unroll
        for (int p = 0; p < 8; ++p) { const unsigned* src = (const unsigned*)(ws + WS_PART + (size_t)p * M * 2048) + (size_t)row * 512 + 8 * lane;
            const u32x4 w0 = __builtin_nontemporal_load((const u32x4*)src), w1 = __builtin_nontemporal_load((const u32x4*)(src + 4));
#pragma unroll
            for (int k = 0; k < 4; ++k) { out[2 * k] += bflo(w0[k]); out[2 * k + 1] += bfhi(w0[k]); out[8 + 2 * k] += bflo(w1[k]); out[8 + 2 * k + 1] += bfhi(w1[k]); } }
        float* xr; int mrow;
        if (row < ML) { xr = a.out + (size_t)row * D; mrow = row >= T ? 1 : 0; } else { xr = (float*)(ws + WS_CTXX) + (size_t)(row - ML) * D; mrow = 2; }
        const float* g2 = modl + mrow * 6144 + 16 * lane;
        f32x4 xn[4];
#pragma unroll
        for (int i = 0; i < 4; ++i) { const f32x4 x = *(const f32x4*)(xr + 16 * lane + 4 * i), g = *(const f32x4*)(g2 + 4 * i);
            xn[i] = x + g * (f32x4){out[4 * i], out[4 * i + 1], out[4 * i + 2], out[4 * i + 3]};
            *(f32x4*)(xr + 16 * lane + 4 * i) = xn[i]; }
        if (fuse) {
            float ss = 0.f;
#pragma unroll
            for (int i = 0; i < 4; ++i) ss += (xn[i][0] * xn[i][0] + xn[i][1] * xn[i][1]) + (xn[i][2] * xn[i][2] + xn[i][3] * xn[i][3]);
            const float rstd = rsqrtf(wave_sum(ss) * (1.f / D) + EPS);
            const float* md = modn + mrow * 6144 + 16 * lane;
#pragma unroll
            for (int i = 0; i < 4; ++i) { const f32x4 nwv = *(const f32x4*)(nw1 + 4 * i), sc = *(const f32x4*)(md + 1024 + 4 * i), sh = *(const f32x4*)(md + 4 * i);
                xn[i] = xn[i] * rstd * nwv * (sc + 1.f) + sh; }
            { float hmx = 0.f;
#pragma unroll
              for (int i = 0; i < 4; ++i) hmx = fmaxf(hmx, fmaxf(fmaxf(fabsf(xn[i][0]), fabsf(xn[i][1])), fmaxf(fabsf(xn[i][2]), fabsf(xn[i][3]))));
              hmx = fmaxf(wave_max(hmx), 1e-30f); const float hinv = 127.f / hmx;
              u32x4 o;
#pragma unroll
              for (int i = 0; i < 4; ++i) o[i] = ((unsigned)(int)rintf(xn[i][0] * hinv) & 255u) | (((unsigned)(int)rintf(xn[i][1] * hinv) & 255u) << 8) | (((unsigned)(int)rintf(xn[i][2] * hinv) & 255u) << 16) | (((unsigned)(int)rintf(xn[i][3] * hinv) & 255u) << 24);
              *(u32x4*)((signed char*)(ws + WS_H) + (size_t)row * D + 16 * lane) = o;
              if (lane == 0) ((float*)(ws + WS_GB))[row] = hmx * (1.f / 127.f); }
            float p[16];
#pragma unroll
            for (int c = 0; c < 16; ++c) { float q = 0.f;
#pragma unroll
                for (int i = 0; i < 4; ++i) { const f32x4 w = *(const LAS f32x4*)(wsk + c * 1024 + 16 * lane + 4 * i); q += (xn[i][0] * w[0] + xn[i][1] * w[1]) + (xn[i][2] * w[2] + xn[i][3] * w[3]); }
                p[c] = q; }
            { const bool hb = (lane & 32) != 0;
#pragma unroll
              for (int c = 0; c < 8; ++c) { const float keep = hb ? p[c + 8] : p[c], send = hb ? p[c] : p[c + 8]; p[c] = keep + lane_xor<32>(send); } }
            { const bool hb = (lane & 16) != 0;
#pragma unroll
              for (int c = 0; c < 4; ++c) { const float keep = hb ? p[c + 4] : p[c], send = hb ? p[c] : p[c + 4]; p[c] = keep + lane_xor<16>(send); } }
            { const bool hb = (lane & 8) != 0;
#pragma unroll
              for (int c = 0; c < 2; ++c) { const float keep = hb ? p[c + 2] : p[c], send = hb ? p[c] : p[c + 2]; p[c] = keep + lane_xor<8>(send); } }
            { const bool hb = (lane & 4) != 0; const float keep = hb ? p[1] : p[0], send = hb ? p[0] : p[1]; p[0] = keep + lane_xor<4>(send); }
            p[0] += lane_xor<2>(p[0]); p[0] += lane_xor<1>(p[0]);
            if ((lane & 3) == 0) { const int c = ((lane >> 5) & 1) * 8 + ((lane >> 4) & 1) * 4 + ((lane >> 3) & 1) * 2 + ((lane >> 2) & 1); ((float*)(ws + WS_BA))[(size_t)row * 16 + c] = p[0]; }
        }
    }
    if (fuse) __syncthreads();
#undef a
}
constexpr size_t WS_PD = WS_REC;
constexpr size_t WS_PW = WS_REC + 8 * (size_t)M * 128 * 4;
constexpr size_t WS_PC = WS_PW + (size_t)M * 128;
static_assert(WS_PC + (size_t)M * 8 * 4 <= WS_END, "sliced gather scratch");
constexpr int GS_ITEM = 8;
template <int PH>
__device__ __forceinline__ void phase_peer_slice(int l, int cslot) {
    const KArgs ap = get_args();
#define a (*ap)
    const int tid = fresh_tid(), lane = tid & 63;
    unsigned char* ws = a.ws;
    const int nrows = (l == DEPTH - 1) ? ML : M;
    const int nitem = nrows / GS_ITEM;
    const unsigned char* TAB = ws + WS_UB + (size_t)(l & 1) * TAB_SET + (PH ? (size_t)NEXP * 1024 : 0);
    const int* PIDX = (const int*)(ws + WS_PIDX);
    const unsigned char* PW = ws + WS_PW; const float* PC = (const float*)(ws + WS_PC);
    const float* modl = (const float*)(ws + WS_MOD) + (size_t)l * 3 * 6144 + 5120;
    const int g = lane >> 3, i8 = lane & 7;
    const int x = (int)(xb_xcc_id() & 7u);
#pragma unroll 1
    for (int pp = 0; pp < 8; ++pp) {
        const int p = (x + pp) & 7;
        unsigned* ctr = (unsigned*)(ws + WS_CTL) + 16384 + ((l * 2 + PH) * 8 + p) * 64 + cslot * 8192;
        const unsigned char* tb = TAB + (size_t)p * NEXP * 128 + 16 * i8;
        unsigned tk = 0; if (lane == 0) tk = __hip_atomic_fetch_add(ctr, 1u, __ATOMIC_RELAXED, __HIP_MEMORY_SCOPE_AGENT);
        int it = __builtin_amdgcn_readfirstlane((int)tk);
        if (it < nitem) {
            unsigned tn = 0; if (lane == 0) tn = __hip_atomic_fetch_add(ctr, 1u, __ATOMIC_RELAXED, __HIP_MEMORY_SCOPE_AGENT);
            const int row0 = it * GS_ITEM;
            u32x4 idc[2], idn[2], ra[8], rb[8]; u32x4 wc, wn; float sc_c, sc_n; u32x4 hc, hn;
#define GS_META(ids_, wts_, wsc_, h_, row_) do { const int rw_ = (row_); const u32x4* ip_ = (const u32x4*)((const unsigned short*)PIDX + (size_t)rw_ * 128 + 16 * g); ids_[0] = ip_[0]; ids_[1] = ip_[1]; \
                if (PH) { wts_ = *(const u32x4*)(PW + (size_t)rw_ * 128 + 16 * g); wsc_ = PC[rw_]; } \
                else h_ = *(const u32x4*)((const signed char*)(ws + WS_H) + (size_t)rw_ * D + 128 * p + 16 * i8); } while (0)
#define GS_ROWS(dst_, ids_, hf_) do { _Pragma("unroll") for (int k_ = 0; k_ < 8; ++k_) dst_[k_] = *(const u32x4*)(tb + (size_t)((ids_[hf_][k_ >> 1] >> (16 * (k_ & 1))) & 0xffffu) * 128); } while (0)
            GS_META(idc, wc, sc_c, hc, row0);
            GS_ROWS(ra, idc, 0);
            GS_META(idn, wn, sc_n, hn, row0 + 1);
            int i = 0, tnv = 0x7fffffff;
#pragma unroll 1
            for (;;) {
                if (i == GS_ITEM - 2) tnv = __builtin_amdgcn_readfirstlane((int)tn);
                const int row = it * GS_ITEM + i;
                const int r2 = (i + 2 < GS_ITEM) ? row + 2 : (tnv < nitem ? tnv * GS_ITEM + (i + 2 - GS_ITEM) : row);
                GS_ROWS(rb, idc, 1);
                if (PH == 0) {
                    int d[16];
#pragma unroll
                    for (int k = 0; k < 8; ++k) { int s_ = 0;
#pragma unroll
                        for (int q = 0; q < 4; ++q) s_ = __builtin_amdgcn_sdot4((int)ra[k][q], (int)hc[q], s_, false);
                        d[k] = s_; }
                    GS_ROWS(ra, idn, 0);
#pragma unroll
                    for (int k = 0; k < 8; ++k) { int s_ = 0;
#pragma unroll
                        for (int q = 0; q < 4; ++q) s_ = __builtin_amdgcn_sdot4((int)rb[k][q], (int)hc[q], s_, false);
                        d[8 + k] = s_; }
#define GS_IX(v_, K_) __builtin_bit_cast(int, lane_xor<K_>(__builtin_bit_cast(float, v_)))
                    { const bool hb = (lane & 4) != 0;
#pragma unroll
                      for (int j = 0; j < 8; ++j) { const int keep = hb ? d[j + 8] : d[j], send = hb ? d[j] : d[j + 8]; d[j] = keep + GS_IX(send, 4); } }
                    { const bool hb = (lane & 2) != 0;
#pragma unroll
                      for (int j = 0; j < 4; ++j) { const int keep = hb ? d[j + 4] : d[j], send = hb ? d[j] : d[j + 4]; d[j] = keep + GS_IX(send, 2); } }
                    { const bool hb = (lane & 1) != 0;
#pragma unroll
                      for (int j = 0; j < 2; ++j) { const int keep = hb ? d[j + 2] : d[j], send = hb ? d[j] : d[j + 2]; d[j] = keep + GS_IX(send, 1); } }
#undef GS_IX
                    u32x2 o = {(unsigned)d[0], (unsigned)d[1]};
                    __builtin_nontemporal_store(o, (u32x2*)((int*)(ws + WS_PD) + ((size_t)p * M + row) * 128 + 2 * lane));
                } else {
                    int oi[16];
#pragma unroll
                    for (int k = 0; k < 16; ++k) oi[k] = 0;
#define GS_QUAD(rr_, qd_, wd_) do { _Pragma("unroll") for (int q_ = 0; q_ < 4; ++q_) { \
                        const unsigned r0_ = rr_[4 * (qd_) + 0][q_], r1_ = rr_[4 * (qd_) + 1][q_], r2_ = rr_[4 * (qd_) + 2][q_], r3_ = rr_[4 * (qd_) + 3][q_]; \
                        const unsigned t0_ = __builtin_amdgcn_perm(r1_, r0_, 0x05010400u), t1_ = __builtin_amdgcn_perm(r1_, r0_, 0x07030602u), t2_ = __builtin_amdgcn_perm(r3_, r2_, 0x05010400u), t3_ = __builtin_amdgcn_perm(r3_, r2_, 0x07030602u); \
                        oi[4 * q_ + 0] = __builtin_amdgcn_sdot4((int)__builtin_amdgcn_perm(t2_, t0_, 0x05040100u), (int)(wd_), oi[4 * q_ + 0], false); \
                        oi[4 * q_ + 1] = __builtin_amdgcn_sdot4((int)__builtin_amdgcn_perm(t2_, t0_, 0x07060302u), (int)(wd_), oi[4 * q_ + 1], false); \
                        oi[4 * q_ + 2] = __builtin_amdgcn_sdot4((int)__builtin_amdgcn_perm(t3_, t1_, 0x05040100u), (int)(wd_), oi[4 * q_ + 2], false); \
                        oi[4 * q_ + 3] = __builtin_amdgcn_sdot4((int)__builtin_amdgcn_perm(t3_, t1_, 0x07060302u), (int)(wd_), oi[4 * q_ + 3], false); } } while (0)
                    GS_QUAD(ra, 0, wc[0]); GS_QUAD(ra, 1, wc[1]);
                    GS_ROWS(ra, idn, 0);
                    GS_QUAD(rb, 0, wc[2]); GS_QUAD(rb, 1, wc[3]);
#undef GS_QUAD
#pragma unroll
                    for (int j = 0; j < 8; ++j) { auto rr_ = __builtin_amdgcn_permlane32_swap((unsigned)oi[j], (unsigned)oi[j + 8], false, false); oi[j] = (int)(rr_[0] + rr_[1]); }
#pragma unroll
                    for (int j = 0; j < 4; ++j) { auto rr_ = __builtin_amdgcn_permlane16_swap((unsigned)oi[j], (unsigned)oi[j + 4], false, false); oi[j] = (int)(rr_[0] + rr_[1]); }
                    float o[2];
#pragma unroll
                    for (int j = 0; j < 2; ++j) { const int ta_ = oi[j] + __builtin_amdgcn_update_dpp(0, oi[j], 0x128, 0xF, 0xF, true), tb_ = oi[j + 2] + __builtin_amdgcn_update_dpp(0, oi[j + 2], 0x128, 0xF, 0xF, true);
                        o[j] = (float)((lane & 8) ? tb_ : ta_) * sc_c; }
                    const float corr = 0.f;
                    const int mrow = row < ML ? (row >= T ? 1 : 0) : 2;
                    const int col = 128 * p + 16 * i8 + 2 * g;
                    unsigned* xp = (unsigned*)((bf16_t*)(ws + WS_XB) + (size_t)row * D + col);
                    const unsigned xw = *xp; const f32x2 g2 = *(const f32x2*)(modl + mrow * 6144 + col);
                    const float x0 = bflo(xw) + g2[0] * (o[0] - corr), x1 = bfhi(xw) + g2[1] * (o[1] - corr);
                    if (l == DEPTH - 1) *(f32x2*)(a.out + (size_t)row * D + col) = (f32x2){x0, x1};
                    else *xp = pkbf_c(x0, x1);
                }
#pragma unroll
                for (int q = 0; q < 2; ++q) idc[q] = idn[q];
                if (PH) { wc = wn; sc_c = sc_n; } else hc = hn;
                GS_META(idn, wn, sc_n, hn, r2);
                if (++i == GS_ITEM) {
                    if (tnv >= nitem) break;
                    it = tnv; i = 0; tnv = 0x7fffffff;
                    if (lane == 0) tn = __hip_atomic_fetch_add(ctr, 1u, __ATOMIC_RELAXED, __HIP_MEMORY_SCOPE_AGENT);
                }
            }
#undef GS_META
#undef GS_ROWS
        }
    }
#undef a
}
__device__ __forceinline__ void phase_peer_weights(int l) {
    const KArgs ap = get_args();
#define a (*ap)
    const int tid = fresh_tid(), lane = tid & 63, wave = __builtin_amdgcn_readfirstlane(tid >> 6), G = fresh_g(), bx = fresh_bx();
    unsigned char* ws = a.ws;
    const int nrows = (l == DEPTH - 1) ? ML : M;
    const f32x2* SC2 = (const f32x2*)(ws + WS_USC) + (size_t)(l & 1) * NEXP;
    const int* PIDX = (const int*)(ws + WS_PIDX); const float* PGATE = (const float*)(ws + WS_PGATE);
    for (int row = wave * G + bx; row < nrows; row += G * 8) {
        const unsigned idw = *((const unsigned*)PIDX + (size_t)row * 64 + lane); const u32x2 id = {idw & 0xffffu, idw >> 16}; const f32x2 gt = *(const f32x2*)(PGATE + (size_t)row * 128 + 2 * lane);
        const float hsc = ((const float*)(ws + WS_GB))[row];
        int d0 = 0, d1 = 0;
#pragma unroll
        for (int p = 0; p < 8; ++p) { const u32x2 v = __builtin_nontemporal_load((const u32x2*)((const int*)(ws + WS_PD) + ((size_t)p * M + row) * 128 + 2 * lane)); d0 += (int)v[0]; d1 += (int)v[1]; }
        const f32x2 s0 = SC2[id[0]], s1 = SC2[id[1]];
        const float x0 = (float)d0 * (s0[0] * hsc), x1 = (float)d1 * (s1[0] * hsc);
        const float w0 = gt[0] * s0[1] * (0.5f * x0 * (1.f + erff(x0 * 0.70710678118654752f))), w1 = gt[1] * s1[1] * (0.5f * x1 * (1.f + erff(x1 * 0.70710678118654752f)));
        float mx = fmaxf(wave_max(fmaxf(fabsf(w0), fabsf(w1))), 1e-30f); const float inv = 127.f / mx;
        *(unsigned short*)(ws + WS_PW + (size_t)row * 128 + 2 * lane) = (unsigned short)(((unsigned)(int)rintf(w0 * inv) & 255u) | (((unsigned)(int)rintf(w1 * inv) & 255u) << 8));
        if (lane == 0) ((float*)(ws + WS_PC))[row] = mx * (1.f / 127.f);
    }
#undef a
}

__global__ void __launch_bounds__(512, 2) fwd(Args a) {
    extern __shared__ __attribute__((aligned(16))) unsigned char lds_raw[];
    LAS unsigned char* lds = (LAS unsigned char*)lds_raw;
    volatile LAS unsigned* MISC = (volatile LAS unsigned*)(lds + LDS_MISC);
    if (threadIdx.x < 16) MISC[threadIdx.x] = 0u;
    __syncthreads();
    XcdBarrier bar; bar.bar = (unsigned*)(a.ws + WS_CTL) + 4096; bar.x = 0; bar.st = MISC + 8;
    bar = xcd_barrier_post((unsigned*)(a.ws + WS_CTL) + 4096, MISC + 8);
#ifndef PHASE_MASK
#define PHASE_MASK 0x1FFF
#endif
#define EN(i) ((PHASE_MASK >> (i)) & 1)
#ifndef REP_MASK
#define REP_MASK 0
#endif
#define REPN(i) (1 + ((REP_MASK >> (i)) & 1))
#define IN(k) true
#define SEAM(k) do { XcdBarrier b_; b_.bar = (unsigned*)(get_args()->ws + WS_CTL) + 4096; b_.x = xb_xcc_id(); b_.st = (volatile LAS unsigned*)(lds + LDS_MISC) + 8; xcd_barrier(b_); } while (0)
    for (int rep_ = 0; rep_ < (REPN(0)); ++rep_) if (EN(0) && IN(0)) phase_prologue(lds);
    SEAM(0);
#pragma unroll 1
    for (int l_ = 0; l_ < DEPTH; ++l_) {
        int l = l_; asm volatile("" : "+s"(l));
        const int pb = 1 + l * NPH_L;
        const int mrows = (l == DEPTH - 1) ? ML : M;
        if (l == 0) { for (int rep_ = 0; rep_ < (REPN(1)); ++rep_) if (EN(1) && IN(pb + 0)) { phase_norm<true>(l, 0, lds); phase_quant_weights(lds); }
            SEAM(pb + 0); }
        for (int rep_ = 0; rep_ < (REPN(2)); ++rep_) if (EN(2) && IN(pb + 1)) { const KArgs ap = get_args(); unsigned char* ws = ap->ws; pg8::Gemm g{(const bf16_t*)(ws + WS_H), (const bf16_t*)((const signed char*)(ws + WS_WINT) + (size_t)l * NP * 1024), M, NP, 512}; pg8::StaticOrder S; S.init(M, NP, fresh_g(), fresh_bx());
            pg8::EpiBf16I8 E{(bf16_t*)(ws + WS_P), NP, (const float*)(ws + WS_GB), (const float*)(ws + WS_CTL) + CW_WMAX + (l * 3 + 0) * 3072}; pg8::gemm_phase(lds, g, S, E); }
        SEAM(pb + 1);
        for (int rep_ = 0; rep_ < (REPN(3)); ++rep_) if (EN(3) && IN(pb + 2)) { phase_dn_chunkprep<1>(l, lds); phase_prep(l, lds); }
        for (int rep_ = 0; rep_ < (REPN(4)); ++rep_) if (EN(4) && IN(pb + 3)) phase_dn_chunkprep<0>(l, lds);
        SEAM(pb + 3);
        for (int rep_ = 0; rep_ < (REPN(5)); ++rep_) if (EN(5) && IN(pb + 4)) { phase_dn_scan<0>(l, lds); __syncthreads(); phase_attn(l, lds_raw, MISC, rep_); }
        SEAM(pb + 4);
        for (int rep_ = 0; rep_ < (REPN(7)); ++rep_) if (EN(7) && IN(pb + 5)) phase_dn_out(l);
        SEAM(pb + 5);
        if (EN(8) && IN(pb + 6)) { const KArgs ap = get_args(); unsigned char* ws = ap->ws; pg8::Gemm g{(const bf16_t*)(ws + WS_CATQ), (const bf16_t*)((const signed char*)(ws + WS_WOUTT) + (size_t)l * 1024 * 1024), mrows, 1024, 512}; pg8::StaticOrder S; S.init(mrows, 1024, fresh_g(), fresh_bx());
            pg8::EpiResI8 E{ap->in[I_X], ap->in[I_CTX], (bf16_t*)(ws + WS_XB), l == 0, (const float*)(ws + WS_MOD) + (size_t)l * 3 * 6144 + 2048,
                              (const float*)(ws + WS_GB) + (1u << 18), (const float*)(ws + WS_CTL) + CW_WMAX + (l * 3 + 1) * 3072};
            pg8::gemm_phase(lds, g, S, E); }
        SEAM(pb + 6);
        for (int rep_ = 0; rep_ < (REPN(9)); ++rep_) if (EN(9) && IN(pb + 7)) phase_norm<false>(l, 1, lds);
        SEAM(pb + 7);
        for (int rep_ = 0; rep_ < (REPN(10)); ++rep_) if (EN(10) && IN(pb + 8)) { const KArgs ap = get_args(); unsigned char* ws = ap->ws; pg8::Gemm g{(const bf16_t*)(ws + WS_H), (const bf16_t*)((const signed char*)(ws + WS_WQT) + (size_t)l * 2048 * 1024), mrows, 2048, 512}; pg8::StaticOrder S; S.init(mrows, 2048, fresh_g(), fresh_bx());
            pg8::EpiBf16I8 E{(bf16_t*)(ws + WS_P), 2048, (const float*)(ws + WS_GB), (const float*)(ws + WS_CTL) + CW_WMAX + (l * 3 + 2) * 3072}; pg8::gemm_phase(lds, g, S, E); }
        SEAM(pb + 8);
        for (int rep_ = 0; rep_ < (REPN(11)); ++rep_) if (EN(11) && IN(pb + 9)) phase_peer_select(l);
        SEAM(pb + 9);
        #ifdef GATHER_VAR
        if (EN(12) && IN(pb + 10)) phase_peer_gather<false, GATHER_VAR>(l, lds);
#endif
#if GATHER_PART == 2
        if (EN(12) && IN(pb + 10)) phase_peer_slice<0>(l, 0);
        SEAM(pb + 10);
        if (EN(12) && IN(pb + 10)) phase_peer_weights(l);
        SEAM(pb + 10);
        if (EN(12) && IN(pb + 10)) phase_peer_slice<1>(l, 0);
        if (l + 1 < DEPTH) { SEAM(pb + 10); if (EN(12) && IN(pb + 10)) phase_norm<true>(l + 1, 0, lds); }
#elif GATHER_PART
        if (EN(12) && IN(pb + 10)) phase_peer_gpart(l, lds);
        SEAM(pb + 10);
        if (EN(12) && IN(pb + 10)) phase_peer_combine(l, lds);
#else
        if (REPN(12) > 1 && EN(12) && IN(pb + 10)) phase_peer_gather<false>(l, lds);
        if (EN(12) && IN(pb + 10)) phase_peer_gather<true>(l, lds);
#endif
        if (l + 1 < DEPTH) SEAM(pb + 10);
    }
#undef IN
#undef SEAM
}

#ifndef N_LAUNCH_MODE
#define N_LAUNCH_MODE 1
#endif
extern "C" void kernel_launch(void* const* d_in, const int* in_sizes, int n_in, void* d_out, int out_size, void* d_ws, size_t ws_size, hipStream_t stream) {
    static int grid = 0;
    if (grid == 0) {
        if (n_in != 20 || out_size != ML * D || ws_size < WS_END) { fprintf(stderr, "kernel_launch: unexpected shapes: n_in %d out %d ws %zu (need %zu)\n", n_in, out_size, ws_size, (size_t)WS_END); grid = -1; return; }
        int dev = 0, cus = 0, per_cu = 0;
        if (hipGetDevice(&dev) != hipSuccess || hipDeviceGetAttribute(&cus, hipDeviceAttributeMultiprocessorCount, dev) != hipSuccess) { grid = -1; return; }
        if (hipFuncSetAttribute((const void*)fwd, hipFuncAttributeMaxDynamicSharedMemorySize, LDS_BYTES) != hipSuccess) { fprintf(stderr, "kernel_launch: hipFuncSetAttribute failed\n"); grid = -1; return; }
        if (hipOccupancyMaxActiveBlocksPerMultiprocessor(&per_cu, (const void*)fwd, 512, LDS_BYTES) != hipSuccess || per_cu < 1) fprintf(stderr, "kernel_launch: occupancy query says %d\n", per_cu);
        (void)hipGetLastError();
        grid = cus;
    }
    if (grid < 0) return;
    (void)hipMemsetAsync((char*)d_ws + WS_CTL, 0, CTL_BYTES, stream);
    Args a{};
    for (int i = 0; i < 20; ++i) a.in[i] = (const float*)d_in[i];
    a.out = (float*)d_out; a.ws = (unsigned char*)d_ws;
    a.ph_lo = 0; a.ph_hi = NPHASE;
    hipLaunchKernelGGL(fwd, dim3(grid), dim3(512), LDS_BYTES, stream, a);
    const hipError_t le = hipPeekAtLastError();
    if (le != hipSuccess) fprintf(stderr, "kernel_launch: launch failed: %s\n", hipGetErrorName(le));
}
```

```cpp
#include <hip/hip_runtime.h>
#ifndef GATHER_PART
#define GATHER_PART 2
#endif
#include <cstdio>
#include <cstdint>

#define GAS __attribute__((address_space(1)))
#define LAS __attribute__((address_space(3)))
typedef unsigned short bf16_t;
typedef short bf16x8 __attribute__((ext_vector_type(8)));
typedef short s16x4 __attribute__((ext_vector_type(4)));
typedef float f32x4 __attribute__((ext_vector_type(4)));
typedef float f32x2 __attribute__((ext_vector_type(2)));
typedef float f32x16 __attribute__((ext_vector_type(16)));
typedef unsigned u32x4 __attribute__((ext_vector_type(4)));
typedef unsigned u32x2 __attribute__((ext_vector_type(2)));
typedef int i32x4 __attribute__((ext_vector_type(4)));

constexpr int D = 1024, NB = 2, T = 16384, DEPTH = 4, CT = 256;
constexpr int ML = NB * T, MC = NB * CT, M = ML + MC;
constexpr int NIN = 3088, NP = 3072;
constexpr int KVLEN = T + CT;
constexpr int NEXP = 16384;
constexpr float EPS = 1e-6f;
constexpr int NPH_L = 11;
constexpr int NPHASE = 1 + DEPTH * NPH_L;

constexpr size_t MiB = 1u << 20;
constexpr size_t WS_CTL = 0, CTL_BYTES = 1 * MiB;
constexpr size_t WS_MOD = 1 * MiB;
constexpr size_t WS_ROPE = 2 * MiB;
constexpr size_t WS_WSK = 3 * MiB;
constexpr size_t WS_CTXX = 4 * MiB;
constexpr size_t WS_WINT = 8 * MiB;
constexpr size_t WS_WOUTT = 32 * MiB;
constexpr size_t WS_WQT = 40 * MiB;
constexpr size_t WS_SKB = 56 * MiB;
constexpr size_t WS_USC = 58 * MiB;
constexpr size_t WS_UB = 64 * MiB;
constexpr size_t WS_VB = 80 * MiB;
constexpr size_t TAB_SET = 32 * MiB;
constexpr size_t WS_H = 128 * MiB;
static_assert(WS_H + 2 * (size_t)M * 1024 <= 193 * MiB, "H + concat int8");
constexpr size_t WS_CATQ = WS_H + (size_t)M * 1024;
constexpr size_t WS_P = 193 * MiB;
constexpr size_t WS_QA = 388 * MiB;
constexpr size_t WS_KA = 421 * MiB;
constexpr size_t WS_VA = 438 * MiB;
constexpr size_t WS_CAT = 455 * MiB;
constexpr size_t WS_DQ = 520 * MiB;
constexpr size_t WS_DK = 553 * MiB;
constexpr size_t WS_DV = 586 * MiB;
constexpr size_t WS_OF = 619 * MiB;
constexpr size_t WS_OB = WS_OF + (size_t)M * 1024;
constexpr size_t WS_XB = WS_OB + (size_t)M * 1024;
static_assert(WS_OB + (size_t)M * 1024 <= WS_XB && WS_XB + (size_t)M * 2048 <= 749 * MiB, "OF/OB/XB");
constexpr size_t WS_GB = 749 * MiB;
constexpr size_t WS_BA = 752 * MiB;
constexpr size_t WS_PIDX = 755 * MiB;
constexpr size_t WS_PGATE = 772 * MiB;
constexpr size_t WS_REC = 789 * MiB;
constexpr size_t WS_END = 990 * MiB;
constexpr int CW_WMAX = 65536;
constexpr int NCH = 260;
constexpr int REC_K = 0, REC_KT = 16384, REC_Q = 32768, REC_V = 49152, REC_DIR = 65536, REC_DIRSZ = 17408, REC_BYTES = REC_DIR + 2 * REC_DIRSZ;
static_assert((size_t)NB * 4 * NCH * REC_BYTES + WS_REC <= WS_END, "rec region");

constexpr int LDS_BYTES = 163840;
constexpr int LDS_MISC = 163840 - 256;

__device__ __forceinline__ float bf2f(unsigned b) { return __uint_as_float(b << 16); }
__device__ __forceinline__ float bflo(unsigned w) { return __uint_as_float(w << 16); }
__device__ __forceinline__ float bfhi(unsigned w) { return __uint_as_float(w & 0xffff0000u); }
typedef __bf16 bf2v __attribute__((ext_vector_type(2)));
__device__ __forceinline__ unsigned pkbf(float lo, float hi) { unsigned r; asm("v_cvt_pk_bf16_f32 %0, %1, %2" : "=v"(r) : "v"(lo), "v"(hi)); return r; }
__device__ __forceinline__ unsigned pkbf_c(float lo, float hi) { f32x2 v = {lo, hi}; bf2v r = __builtin_convertvector(v, bf2v); return __builtin_bit_cast(unsigned, r); }
template <int K> __device__ __forceinline__ float lane_xor(float v) {
    const int b = __builtin_bit_cast(int, v);
    if constexpr (K == 1) return __builtin_bit_cast(float, __builtin_amdgcn_update_dpp(0, b, 0xB1, 0xF, 0xF, true));
    else if constexpr (K == 2) return __builtin_bit_cast(float, __builtin_amdgcn_update_dpp(0, b, 0x4E, 0xF, 0xF, true));
    else if constexpr (K == 32) { auto rr = __builtin_amdgcn_permlane32_swap((unsigned)b, (unsigned)b, false, false); unsigned ln_ = __builtin_amdgcn_mbcnt_hi(~0u, __builtin_amdgcn_mbcnt_lo(~0u, 0u)); asm volatile("" : "+v"(ln_));
        return __uint_as_float((ln_ & 32u) ? rr[0] : rr[1]); }
    else return __builtin_bit_cast(float, __builtin_amdgcn_ds_swizzle(b, 0x1F | (K << 10)));
}
__device__ __forceinline__ float wave_sum(float v) {
    v += lane_xor<1>(v); v += lane_xor<2>(v);
    v += __builtin_bit_cast(float, __builtin_amdgcn_update_dpp(0, __builtin_bit_cast(int, v), 0x124, 0xF, 0xF, true));
    v += __builtin_bit_cast(float, __builtin_amdgcn_update_dpp(0, __builtin_bit_cast(int, v), 0x128, 0xF, 0xF, true));
    v += lane_xor<16>(v);
    { auto rr = __builtin_amdgcn_permlane32_swap(__float_as_uint(v), __float_as_uint(v), false, false); v = __uint_as_float(rr[0]) + __uint_as_float(rr[1]); }
    return v;
}
__device__ __forceinline__ float wave_max(float v) {
    v = fmaxf(v, lane_xor<1>(v)); v = fmaxf(v, lane_xor<2>(v));
    v = fmaxf(v, __builtin_bit_cast(float, __builtin_amdgcn_update_dpp(0, __builtin_bit_cast(int, v), 0x124, 0xF, 0xF, true)));
    v = fmaxf(v, __builtin_bit_cast(float, __builtin_amdgcn_update_dpp(0, __builtin_bit_cast(int, v), 0x128, 0xF, 0xF, true)));
    v = fmaxf(v, lane_xor<16>(v));
    { auto rr = __builtin_amdgcn_permlane32_swap(__float_as_uint(v), __float_as_uint(v), false, false); v = fmaxf(__uint_as_float(rr[0]), __uint_as_float(rr[1])); }
    return v;
}
__device__ __forceinline__ float silu_f(float x) { return x / (1.f + __expf(-x)); }
#define LDS_WAIT() asm volatile("s_waitcnt lgkmcnt(0)" ::: "memory")

#define XB_TMO      128
#define XB_XCNT(j)  (256  + 64 * (j))
#define XB_XSUB(j)  (1280 + 64 * (j))
#define XB_XGEN(j)  (2304 + 64 * (j))
#define XB_TOP      3328
#define XB_TOPGEN   3392
#define XCD_BAR_WORDS 3456
#define XB_SPIN_CAP (1u << 22)
__device__ __forceinline__ unsigned xb_ld(unsigned* p)              { return __hip_atomic_load(p, __ATOMIC_RELAXED, __HIP_MEMORY_SCOPE_AGENT); }
__device__ __forceinline__ unsigned xb_add(unsigned* p, unsigned v) { return __hip_atomic_fetch_add(p, v, __ATOMIC_RELAXED, __HIP_MEMORY_SCOPE_AGENT); }
__device__ __forceinline__ unsigned xb_xcc_id() { return (unsigned)__builtin_amdgcn_s_getreg((3 << 11) | 20) & 0xFu; }
#define XB_SPIN(cond, bar) do { unsigned _sp = 0; while (cond) { __builtin_amdgcn_s_sleep(1); \
    if ((++_sp & 255u) == 0u) { if (xb_ld(&(bar)[XB_TMO])) break; if (_sp > XB_SPIN_CAP) { atomicAdd(&(bar)[XB_TMO], 1u); break; } } } } while (0)
struct XcdBarrier { unsigned* bar; unsigned x; volatile LAS unsigned* st; };
__device__ __forceinline__ XcdBarrier xcd_barrier_post(unsigned* bar, volatile LAS unsigned* st) {
    XcdBarrier b; b.bar = bar; b.x = xb_xcc_id(); b.st = st;
    if (threadIdx.x == 0) (void)xb_add(&bar[XB_XCNT(b.x)], 1u);
    return b;
}
__device__ __forceinline__ void xcd_barrier_complete(unsigned* bar, unsigned x, unsigned& nloc, unsigned& nx) {
    const unsigned G = gridDim.x * gridDim.y * gridDim.z;
    unsigned sum, cnt, mine, sp = 0u;
    for (;;) {
        sum = 0u; cnt = 0u; mine = 0u;
#pragma unroll
        for (unsigned j = 0; j < 16; ++j) { const unsigned c = xb_ld(&bar[XB_XCNT(j)]); sum += c; cnt += (c > 0u) ? 1u : 0u; mine = (j == x) ? c : mine; }
        if (sum == G) break;
        __builtin_amdgcn_s_sleep(1);
        if ((++sp & 255u) == 0u) { if (xb_ld(&bar[XB_TMO])) break; if (sp > XB_SPIN_CAP) { atomicAdd(&bar[XB_TMO], 1u); break; } }
    }
    nloc = mine > 0u ? mine : 1u; nx = cnt > 0u ? cnt : 1u;
}
__device__ __forceinline__ void xcd_barrier(const XcdBarrier& b) {
    asm volatile("s_waitcnt vmcnt(0)" ::: "memory");
    __syncthreads();
    if (threadIdx.x == 0) {
        unsigned* bar = b.bar; unsigned bx_ = b.x;
        asm volatile("" : "+s"(bar), "+s"(bx_));
        __builtin_amdgcn_s_waitcnt(0);
        unsigned nloc = b.st[0], nx = b.st[1];
        if (nloc == 0u) { xcd_barrier_complete(bar, bx_, nloc, nx); b.st[0] = nloc; b.st[1] = nx; }
        const unsigned old = xb_add(&bar[XB_XSUB(bx_)], 1u);
        const unsigned gen = old / nloc;
        if (old + 1u == (gen + 1u) * nloc) {
            __builtin_amdgcn_fence(__ATOMIC_RELEASE, "agent");
            asm volatile("s_waitcnt vmcnt(0)" ::: "memory");
            const unsigned og = xb_add(&bar[XB_TOP], 1u);
            const unsigned tg = og / nx;
            if (og + 1u == (tg + 1u) * nx) xb_add(&bar[XB_TOPGEN], 1u);
            else XB_SPIN(xb_ld(&bar[XB_TOPGEN]) == tg, bar);
            __builtin_amdgcn_fence(__ATOMIC_ACQUIRE, "agent");
            xb_add(&bar[XB_XGEN(bx_)], 1u);
            asm volatile("s_waitcnt vmcnt(0)" ::: "memory");
        } else {
            XB_SPIN(xb_ld(&bar[XB_XGEN(bx_)]) == gen, bar);
            __builtin_amdgcn_fence(__ATOMIC_ACQUIRE, "agent");
            asm volatile("s_waitcnt vmcnt(0)" ::: "memory");
        }
    }
    __syncthreads();
}

namespace pg8 {
constexpr int BM = 256, BK = 64, HALF = 128, HTB = HALF * BK * 2, STAGE_BYTES = 8 * HTB, NXCD = 8, WGM = 8;
__host__ __device__ __forceinline__ int lds_byte(int r, int c) { const int st = (r >> 4) * 2 + (c >> 5), rr = r & 15, cc = c & 31, ob = rr * 64 + cc * 2; return st * 1024 + (ob ^ (((ob >> 9) & 1) << 5)); }
__host__ __device__ __forceinline__ void stage_rc(int b, int& R, int& C) { const int st = b / 1024, sb = b % 1024, swz = sb ^ (((sb >> 9) & 1) << 5); R = (st >> 1) * 16 + swz / 64; C = (st & 1) * 32 + (swz % 64) / 2; }
__host__ __device__ __forceinline__ int perm32(int rho) { const int n = rho >> 4, i = rho & 15; return 8 * (i >> 2) + 4 * n + (i & 3); }
struct Unit { int pm, pn; };
struct Gemm { const bf16_t* A; const bf16_t* Bt; int M, N, K; };
struct StaticOrder {
    int nM, nN, nwg, G, c;
    __host__ __device__ void init(int M_, int N_, int G_, int c_) { nM = M_ / BM; nN = N_ / BM; nwg = nM * nN; G = G_; c = c_; }
    __host__ __device__ bool next(int i, Unit& u) const {
        const long L = (long)i * G + c; if (L >= nwg) return false;
        int wgid = (int)L; { const int q = nwg / NXCD, r = nwg % NXCD, xcd = wgid % NXCD, off = wgid / NXCD; wgid = (xcd < r ? xcd * (q + 1) : r * (q + 1) + (xcd - r) * q) + off; }
        const int nig = WGM * nN, gid = wgid / nig, fm = gid * WGM, gsz = (nM - fm) < WGM ? (nM - fm) : WGM;
        u.pm = fm + ((wgid % nig) % gsz); u.pn = (wgid % nig) / gsz; return true;
    }
    __device__ __forceinline__ void a_ready(const Unit&) const {}
    __device__ __forceinline__ void done(const Unit&) const {}
};
struct EpiBf16 {
    static constexpr bool PERM = true, I8 = false; typedef f32x4 acc_t;
    bf16_t* O; int ldc;
    __device__ __forceinline__ void operator()(const f32x4 (&acc)[2][2][4][2], const Unit& u, int wr, int wc, int fr, int fq) const {
        const int row0 = u.pm * BM + wr * 64 + fr; const int col0 = u.pn * BM + wc * 32 + 8 * fq;
#pragma unroll
        for (int ai = 0; ai < 2; ++ai)
#pragma unroll
            for (int m = 0; m < 4; ++m) { bf16_t* rowp = O + (size_t)(row0 + ai * HALF + m * 16) * ldc + col0;
#pragma unroll
                for (int bj = 0; bj < 2; ++bj) { const f32x4 v0 = acc[ai][bj][m][0], v1 = acc[ai][bj][m][1];
                    u32x4 w; w.x = pkbf_c(v0[0], v0[1]); w.y = pkbf_c(v0[2], v0[3]); w.z = pkbf_c(v1[0], v1[1]); w.w = pkbf_c(v1[2], v1[3]);
                    *(u32x4*)(rowp + bj * HALF) = w; } }
    }
};
struct EpiBf16I8 {
    static constexpr bool PERM = true, I8 = true; typedef i32x4 acc_t;
    bf16_t* O; int ldc; const float* sa; const float* wmax;
    __device__ __forceinline__ void operator()(const i32x4 (&acc)[2][2][4][2], const Unit& u, int wr, int wc, int fr, int fq) const {
        const int row0 = u.pm * BM + wr * 64 + fr; const int col0 = u.pn * BM + wc * 32 + 8 * fq;
        f32x4 sw[2][2];
#pragma unroll
        for (int bj = 0; bj < 2; ++bj)
#pragma unroll
            for (int n = 0; n < 2; ++n) sw[bj][n] = *(const f32x4*)(wmax + col0 + bj * HALF + 4 * n) * (1.f / 127.f);
#pragma unroll
        for (int ai = 0; ai < 2; ++ai)
#pragma unroll
            for (int m = 0; m < 4; ++m) { const int row = row0 + ai * HALF + m * 16; const float sr = sa[row]; bf16_t* rowp = O + (size_t)row * ldc + col0;
#pragma unroll
                for (int bj = 0; bj < 2; ++bj) { const i32x4 a0 = acc[ai][bj][m][0], a1 = acc[ai][bj][m][1];
                    const f32x4 v0 = (f32x4){(float)a0[0], (float)a0[1], (float)a0[2], (float)a0[3]} * sw[bj][0] * sr, v1 = (f32x4){(float)a1[0], (float)a1[1], (float)a1[2], (float)a1[3]} * sw[bj][1] * sr;
                    u32x4 w; w.x = pkbf(v0[0], v0[1]); w.y = pkbf(v0[2], v0[3]); w.z = pkbf(v1[0], v1[1]); w.w = pkbf(v1[2], v1[3]);
                    *(u32x4*)(rowp + bj * HALF) = w; } }
    }
};
struct EpiRes {
    static constexpr bool PERM = false, I8 = false; typedef f32x4 acc_t;
    const float* src_lat; const float* src_ctx; float* dst_lat; float* dst_ctx; const float* gate;
    __device__ __forceinline__ void operator()(const f32x4 (&acc)[2][2][4][2], const Unit& u, int wr, int wc, int fr, int fq) const {
        const bool isctx = u.pm >= (ML / BM);
        const float* src = isctx ? src_ctx + (size_t)(u.pm - ML / BM) * BM * D : src_lat + (size_t)u.pm * BM * D;
        float* dst = isctx ? dst_ctx + (size_t)(u.pm - ML / BM) * BM * D : dst_lat + (size_t)u.pm * BM * D;
        const int mrow = isctx ? 2 : (u.pm >= (T / BM) ? 1 : 0);
        const int row0 = wr * 64 + fr, col0 = u.pn * BM + wc * 32 + 4 * fq;
        f32x4 gv[2][2];
#pragma unroll
        for (int bj = 0; bj < 2; ++bj)
#pragma unroll
            for (int n = 0; n < 2; ++n) gv[bj][n] = *(const f32x4*)(gate + mrow * 6144 + col0 + bj * HALF + n * 16);
#pragma unroll
        for (int ai = 0; ai < 2; ++ai)
#pragma unroll
            for (int m = 0; m < 4; ++m) { const size_t off = (size_t)(row0 + ai * HALF + m * 16) * D + col0;
#pragma unroll
                for (int bj = 0; bj < 2; ++bj)
#pragma unroll
                    for (int n = 0; n < 2; ++n) { const f32x4 s = *(const f32x4*)(src + off + bj * HALF + n * 16);
                        *(f32x4*)(dst + off + bj * HALF + n * 16) = s + gv[bj][n] * acc[ai][bj][m][n]; } }
    }
};

struct EpiResI8 {
    static constexpr bool PERM = false, I8 = true; typedef i32x4 acc_t;
    const float* src_lat; const float* src_ctx; bf16_t* xb; bool first; const float* gate; const float* sa; const float* wmax;
    __device__ __forceinline__ void operator()(const i32x4 (&acc)[2][2][4][2], const Unit& u, int wr, int wc, int fr, int fq) const {
        const bool isctx = u.pm >= (ML / BM);
        const float* src = isctx ? src_ctx + (size_t)(u.pm - ML / BM) * BM * D : src_lat + (size_t)u.pm * BM * D;
        bf16_t* dst = xb + (size_t)u.pm * BM * D;
        const int mrow = isctx ? 2 : (u.pm >= (T / BM) ? 1 : 0);
        const int row0 = wr * 64 + fr, col0 = u.pn * BM + wc * 32 + 4 * fq;
        f32x4 gv[2][2];
#pragma unroll
        for (int bj = 0; bj < 2; ++bj)
#pragma unroll
            for (int n = 0; n < 2; ++n) gv[bj][n] = *(const f32x4*)(gate + mrow * 6144 + col0 + bj * HALF + n * 16) * *(const f32x4*)(wmax + col0 + bj * HALF + n * 16) * (1.f / 127.f);
#pragma unroll
        for (int ai = 0; ai < 2; ++ai)
#pragma unroll
            for (int m = 0; m < 4; ++m) { const int rl = row0 + ai * HALF + m * 16; const float sr = sa[u.pm * BM + rl]; const size_t off = (size_t)rl * D + col0;
#pragma unroll
                for (int bj = 0; bj < 2; ++bj)
#pragma unroll
                    for (int n = 0; n < 2; ++n) { const i32x4 ac = acc[ai][bj][m][n]; f32x4 sv;
                        if (first) sv = *(const f32x4*)(src + off + bj * HALF + n * 16);
                        else { const u32x2 w_ = *(const u32x2*)(dst + off + bj * HALF + n * 16); sv = (f32x4){bflo(w_[0]), bfhi(w_[0]), bflo(w_[1]), bfhi(w_[1])}; }
                        const f32x4 r_ = sv + gv[bj][n] * ((f32x4){(float)ac[0], (float)ac[1], (float)ac[2], (float)ac[3]} * sr);
                        *(u32x2*)(dst + off + bj * HALF + n * 16) = (u32x2){pkbf(r_[0], r_[1]), pkbf(r_[2], r_[3])}; } }
    }
};
template <class Epi, class Sched>
__device__ __forceinline__ void gemm_phase(LAS unsigned char* lds, const Gemm g, const Sched& S, const Epi& E) {
    constexpr bool I8 = Epi::I8;
    typedef typename Epi::acc_t acc_t;
    int tid = threadIdx.x; asm volatile("" : "+v"(tid)); const int wid = __builtin_amdgcn_readfirstlane(tid >> 6), lane = tid & 63, wr = wid >> 2, wc = wid & 3, fr = lane & 15, fq = lane >> 4;
    const int K = g.K, nt = K / BK;
    unsigned voffA[2], voffB[2];
#pragma unroll
    for (int i = 0; i < 2; ++i) { int R, C; stage_rc(tid * 16 + i * 8192, R, C); const int Rb = Epi::PERM ? ((R & ~31) + perm32(R & 31)) : R;
        voffA[i] = (unsigned)(R * K + C) * 2u; voffB[i] = (unsigned)(Rb * K + C) * 2u; }
    const size_t kstep = (size_t)(BK * 2);
    const size_t hstep = (size_t)HALF * K * 2;
    const size_t tstep = 2 * hstep;
    const unsigned ldsw = (unsigned)wid * 1024u;
    const int aoff = lds_byte(wr * 64 + fr, fq * 8), boff = lds_byte(wc * 32 + fr, fq * 8);
#define PG8_SA(b, h) (((b) * 2 + (h)) * HTB)
#define PG8_SB(b, h) ((4 + (b) * 2 + (h)) * HTB)
#define PG8_STAGE(bufoff, gbase, voff) do { _Pragma("unroll") for (int _i = 0; _i < 2; ++_i) \
        __builtin_amdgcn_global_load_lds((const unsigned*)((const char*)(gbase) + (voff)[_i]), (LAS unsigned*)(lds + (bufoff) + ldsw + _i * 8192), 16, 0, 0); } while (0)
#define PG8_LDA(dst, b, h) do { _Pragma("unroll") for (int m = 0; m < 4; ++m) _Pragma("unroll") for (int k = 0; k < 2; ++k) dst[m][k] = *(const LAS bf16x8*)(lds + PG8_SA(b, h) + aoff + m * 2048 + k * 1024); } while (0)
#define PG8_LDB(dst, b, h) do { _Pragma("unroll") for (int n = 0; n < 2; ++n) _Pragma("unroll") for (int k = 0; k < 2; ++k) dst[n][k] = *(const LAS bf16x8*)(lds + PG8_SB(b, h) + boff + n * 2048 + k * 1024); } while (0)
#define PG8_MMA(ai, bj, At, Bt) do { __builtin_amdgcn_s_setprio(1); _Pragma("unroll") for (int m = 0; m < 4; ++m) _Pragma("unroll") for (int n = 0; n < 2; ++n) _Pragma("unroll") for (int k = 0; k < 2; ++k) \
        { if constexpr (I8) acc[ai][bj][m][n] = __builtin_bit_cast(acc_t, __builtin_amdgcn_mfma_i32_16x16x64_i8(__builtin_bit_cast(i32x4, Bt[n][k]), __builtin_bit_cast(i32x4, At[m][k]), __builtin_bit_cast(i32x4, acc[ai][bj][m][n]), 0, 0, 0)); \
          else acc[ai][bj][m][n] = __builtin_bit_cast(acc_t, __builtin_amdgcn_mfma_f32_16x16x32_bf16(Bt[n][k], At[m][k], __builtin_bit_cast(f32x4, acc[ai][bj][m][n]), 0, 0, 0)); } __builtin_amdgcn_s_setprio(0); } while (0)
#define PG8_WAIT_V(n) asm volatile("s_waitcnt vmcnt(" #n ")" ::: "memory")
#define PG8_WAIT_L(n) asm volatile("s_waitcnt lgkmcnt(" #n ")" ::: "memory")
#define PG8_BAR __builtin_amdgcn_s_barrier()
#define PG8_SCHED __builtin_amdgcn_sched_barrier(0)
    Unit cur, nxt; int ui = 0;
    if (!S.next(0, cur)) return;
    acc_t acc[2][2][4][2];
#pragma unroll
    for (int a = 0; a < 2; ++a)
#pragma unroll
        for (int b = 0; b < 2; ++b)
#pragma unroll
            for (int m = 0; m < 4; ++m)
#pragma unroll
                for (int n = 0; n < 2; ++n) acc[a][b][m][n] = acc_t{};
    bf16x8 At[4][2], B0[2][2], B1[2][2];
    const char* cA = (const char*)g.A + (size_t)cur.pm * tstep; const char* cB = (const char*)g.Bt + (size_t)cur.pn * tstep;
    S.a_ready(cur);
    PG8_STAGE(PG8_SB(0, 0), cB, voffB); PG8_STAGE(PG8_SA(0, 0), cA, voffA); PG8_STAGE(PG8_SB(0, 1), cB + hstep, voffB); PG8_STAGE(PG8_SA(0, 1), cA + hstep, voffA);
    if (wr == 1) PG8_BAR;
    PG8_WAIT_V(4); PG8_BAR;
    PG8_STAGE(PG8_SB(1, 0), cB + kstep, voffB); PG8_STAGE(PG8_SA(1, 0), cA + kstep, voffA); PG8_STAGE(PG8_SB(1, 1), cB + hstep + kstep, voffB);
    PG8_WAIT_V(6); PG8_BAR;
    for (;;) {
        const bool has_next = S.next(ui + 1, nxt);
        const char* nA = has_next ? (const char*)g.A + (size_t)nxt.pm * tstep : cA; const char* nB = has_next ? (const char*)g.Bt + (size_t)nxt.pn * tstep : cB;
        for (int t = 0; t < nt; t += 2) {
            const bool last = (t == nt - 2);
            const char* a1 = cA + (size_t)(t + 1) * kstep;
            const char* a2 = last ? nA : cA + (size_t)(t + 2) * kstep; const char* b2 = last ? nB : cB + (size_t)(t + 2) * kstep;
            const char* a3 = a2 + kstep; const char* b3 = b2 + kstep;
            if (last && has_next) S.a_ready(nxt);
            PG8_LDB(B0, 0, 0); PG8_SCHED; PG8_LDA(At, 0, 0); PG8_STAGE(PG8_SA(1, 1), a1 + hstep, voffA);
            PG8_WAIT_L(8); PG8_BAR; PG8_WAIT_L(0); PG8_MMA(0, 0, At, B0); PG8_BAR; PG8_SCHED;
            PG8_LDB(B1, 0, 1); PG8_STAGE(PG8_SB(0, 0), b2, voffB);
            PG8_BAR; PG8_WAIT_L(0); PG8_MMA(0, 1, At, B1); PG8_BAR;
            PG8_LDA(At, 0, 1); PG8_STAGE(PG8_SA(0, 0), a2, voffA);
            PG8_BAR; PG8_WAIT_L(0); PG8_MMA(1, 0, At, B0); PG8_BAR; PG8_SCHED;
            PG8_STAGE(PG8_SB(0, 1), b2 + hstep, voffB);
            PG8_WAIT_V(6); PG8_BAR; PG8_MMA(1, 1, At, B1); PG8_BAR;
            PG8_LDB(B0, 1, 0); PG8_SCHED; PG8_LDA(At, 1, 0); PG8_STAGE(PG8_SA(0, 1), a2 + hstep, voffA);
            PG8_WAIT_L(8); PG8_BAR; PG8_WAIT_L(0); PG8_MMA(0, 0, At, B0); PG8_BAR; PG8_SCHED;
            PG8_LDB(B1, 1, 1); PG8_STAGE(PG8_SB(1, 0), b3, voffB);
            PG8_BAR; PG8_WAIT_L(0); PG8_MMA(0, 1, At, B1); PG8_BAR;
            PG8_LDA(At, 1, 1); PG8_STAGE(PG8_SA(1, 0), a3, voffA);
            PG8_BAR; PG8_WAIT_L(0); PG8_MMA(1, 0, At, B0); PG8_BAR; PG8_SCHED;
            PG8_STAGE(PG8_SB(1, 1), b3 + hstep, voffB);
            PG8_WAIT_V(6); PG8_BAR; PG8_MMA(1, 1, At, B1); PG8_BAR;
        }
        E(acc, cur, wr, wc, fr, fq); S.done(cur);
        if (!has_next) break;
#pragma unroll
        for (int a = 0; a < 2; ++a)
#pragma unroll
            for (int b = 0; b < 2; ++b)
#pragma unroll
                for (int m = 0; m < 4; ++m)
#pragma unroll
                    for (int n = 0; n < 2; ++n) acc[a][b][m][n] = acc_t{};
        cur = nxt; cA = nA; cB = nB; ++ui;
    }
    PG8_WAIT_V(0);
    if (wr == 0) PG8_BAR;
    PG8_BAR;
#undef PG8_SA
#undef PG8_SB
#undef PG8_STAGE
#undef PG8_LDA
#undef PG8_LDB
#undef PG8_MMA
#undef PG8_WAIT_V
#undef PG8_WAIT_L
#undef PG8_BAR
#undef PG8_SCHED
}
}

namespace att {
constexpr int HD = 128, NW = 8, QBLK = 32, KVBLK = 64;
constexpr float SCALE = 0.088388347648318440f;
constexpr float THR = 8.f;
constexpr int LDQ = 512, LDK = 256;
constexpr size_t SHM_V = KVBLK * HD * 2, SHM_K = KVBLK * HD * 2, SHM_ATTN = 2 * SHM_V + 2 * SHM_K + NW * 64 * 4;
#define KSWZ(row, colB) ((row) * 256 + ((colB) ^ (((row) & 7) << 4)))
#define SBAR() __builtin_amdgcn_sched_barrier(0)
__device__ __forceinline__ int crow(int r, int hi) { return (r & 3) + 8 * (r >> 2) + 4 * hi; }
__device__ __forceinline__ unsigned cvtpk(float lo, float hi) { unsigned r; asm volatile("v_cvt_pk_bf16_f32 %0, %1, %2" : "=v"(r) : "v"(lo), "v"(hi)); return r; }
__device__ __forceinline__ void partialSM(f32x16& p0, f32x16& p1) {
  for (int r = 0; r < 16; ++r) p0[r] = __builtin_amdgcn_exp2f(p0[r]);
}
typedef int i32x8 __attribute__((ext_vector_type(8)));
__device__ __forceinline__ void finishSM(f32x16& p0, f32x16& p1, i32x8& pa) {
  for (int r = 0; r < 16; ++r) p1[r] = __builtin_amdgcn_exp2f(p1[r]);
#pragma unroll
  for (int q = 0; q < 4; ++q) { int w = __builtin_amdgcn_cvt_pk_bf8_f32(p0[4 * q], p0[4 * q + 1], 0, false); w = __builtin_amdgcn_cvt_pk_bf8_f32(p0[4 * q + 2], p0[4 * q + 3], w, true); pa[q] = w;
    int w2 = __builtin_amdgcn_cvt_pk_bf8_f32(p1[4 * q], p1[4 * q + 1], 0, false); w2 = __builtin_amdgcn_cvt_pk_bf8_f32(p1[4 * q + 2], p1[4 * q + 3], w2, true); pa[4 + q] = w2; }
}
constexpr int K8_STRIDE = 144, K8_TILE = KVBLK * K8_STRIDE;
__device__ __forceinline__ void qkt(f32x16& p0, f32x16& p1, const unsigned char* Ks, const i32x8* qr, int r32, int hi, const f32x16& cinit) {
  p0 = cinit; p1 = cinit;
#pragma unroll
  for (int ks = 0; ks < 2; ++ks) {
    const u32x4* a0 = (const u32x4*)(Ks + r32 * K8_STRIDE + 64 * ks + 32 * hi); const u32x4* a1 = (const u32x4*)(Ks + (32 + r32) * K8_STRIDE + 64 * ks + 32 * hi);
    const u32x4 x0 = a0[0], x1 = a0[1], y0 = a1[0], y1 = a1[1];
    const i32x8 k0 = {(int)x0.x, (int)x0.y, (int)x0.z, (int)x0.w, (int)x1.x, (int)x1.y, (int)x1.z, (int)x1.w}, k1 = {(int)y0.x, (int)y0.y, (int)y0.z, (int)y0.w, (int)y1.x, (int)y1.y, (int)y1.z, (int)y1.w};
    p0 = __builtin_amdgcn_mfma_scale_f32_32x32x64_f8f6f4(k0, qr[ks], p0, 0, 0, 0, 0x7F7F7F7F, 0, 0x7C7C7C7C);
    p1 = __builtin_amdgcn_mfma_scale_f32_32x32x64_f8f6f4(k1, qr[ks], p1, 0, 0, 0, 0x7F7F7F7F, 0, 0x7C7C7C7C); }
}
constexpr int V8_STRIDE = 80, V8_TILE = HD * V8_STRIDE;
__device__ __forceinline__ void pv_d0(f32x16* o, f32x16& ol, const unsigned char* Vs, const i32x8& pa, int r32, int hi) {
  { const i32x8 ones = {0x38383838, 0x38383838, 0x38383838, 0x38383838, 0x38383838, 0x38383838, 0x38383838, 0x38383838};
    ol = __builtin_amdgcn_mfma_scale_f32_32x32x64_f8f6f4(pa, ones, ol, 1, 0, 0, 0x7F7F7F7F, 0, 0x7F7F7F7F); }
#pragma unroll
  for (int d0 = 0; d0 < 4; ++d0) { const u32x4* bp = (const u32x4*)(Vs + (32 * d0 + r32) * V8_STRIDE + 32 * hi); const u32x4 x0 = bp[0], x1 = bp[1];
    const i32x8 vb = {(int)x0.x, (int)x0.y, (int)x0.z, (int)x0.w, (int)x1.x, (int)x1.y, (int)x1.z, (int)x1.w};
    o[d0] = __builtin_amdgcn_mfma_scale_f32_32x32x64_f8f6f4(pa, vb, o[d0], 1  , 0  , 0, 0x7F7F7F7F, 0, 0x7F7F7F7F); }
}
__device__ __forceinline__ void attn_dense_body(const unsigned char* __restrict__ Qb, const unsigned char* __restrict__ Kh, const unsigned char* __restrict__ Vt,
                                                bf16_t* __restrict__ Ob, int LDO, int seq, char* lds, float* __restrict__ lse, float braw) {
  int tid = threadIdx.x; asm volatile("" : "+v"(tid)); const int wid = tid >> 6, lane = tid & 63, r32 = lane & 31, hi = lane >> 5;
  unsigned char* V_lds = (unsigned char*)lds; unsigned char* K_lds = (unsigned char*)(lds + 3 * V8_TILE);
  f32x16 o[4] = {}, ol = {}; i32x8 qr[2];
  const float mnC = __builtin_bit_cast(float, __builtin_amdgcn_readfirstlane(__builtin_bit_cast(int, -fmaxf(braw * (SCALE * 1.4426950408889634f) - 15.5f, 0.f))));
  f32x16 cinit;
#pragma unroll
  for (int r = 0; r < 16; ++r) cinit[r] = mnC;
  const unsigned char* Qw = Qb + (long)(wid * QBLK + r32) * LDQ + hi * 32;
#pragma unroll
  for (int ks = 0; ks < 2; ++ks) { const u32x4 x0 = *(const u32x4*)(Qw + 64 * ks), x1 = *(const u32x4*)(Qw + 64 * ks + 16);
    qr[ks] = (i32x8){(int)x0.x, (int)x0.y, (int)x0.z, (int)x0.w, (int)x1.x, (int)x1.y, (int)x1.z, (int)x1.w}; }
  const int krow = tid >> 3, kch = tid & 7;
  const int vrow = tid >> 2, vch = tid & 3;
  struct { u32x4 v8, k8; } sr_[2];
#define SLOAD(i, k0) do { sr_[i].v8 = *reinterpret_cast<const u32x4*>(Vt + (long)((k0) >> 6) * 8192 + tid * 16); \
    sr_[i].k8 = *reinterpret_cast<const u32x4*>(Kh + (long)((k0) + krow) * LDK + kch * 16); } while (0)
#define SWRITE(b, i) do { *(u32x4*)(V_lds + (b) * V8_TILE + vrow * V8_STRIDE + vch * 16) = sr_[i].v8; \
    *(u32x4*)(K_lds + (b) * K8_TILE + krow * K8_STRIDE + kch * 16) = sr_[i].k8; } while (0)
#define SWAIT() asm volatile("s_waitcnt vmcnt(2)" ::: "memory")
  f32x16 pA0, pA1, pB0, pB1; i32x8 pa; const int NT = seq / KVBLK;
  constexpr int SE = 0, SO = 1;
  SLOAD(SE, 0); asm volatile("s_waitcnt vmcnt(0)" ::: "memory"); SWRITE(0, SE);
  SLOAD(SO, KVBLK); SLOAD(SE, 2 * KVBLK);
  __syncthreads();
  qkt(pA0, pA1, K_lds, qr, r32, hi, cinit); partialSM(pA0, pA1);
  SWAIT(); SWRITE(1, SO); SLOAD(SO, 3 * KVBLK);
  __syncthreads();
  int s0 = 0, s1 = 1, s2 = 2;
  for (int j = 1; j + 1 < NT; j += 2) {
    SBAR(); qkt(pB0, pB1, K_lds + s1 * K8_TILE, qr, r32, hi, cinit);
    finishSM(pA0, pA1, pa); SBAR();
    pv_d0(o, ol, V_lds + s0 * V8_TILE, pa, r32, hi); partialSM(pB0, pB1);
    SBAR(); SWAIT(); SWRITE(s2, SE); SLOAD(SE, (j + 3 < NT ? j + 3 : NT - 1) * KVBLK);
    __syncthreads();
    SBAR(); qkt(pA0, pA1, K_lds + s2 * K8_TILE, qr, r32, hi, cinit);
    finishSM(pB0, pB1, pa); SBAR();
    pv_d0(o, ol, V_lds + s1 * V8_TILE, pa, r32, hi); partialSM(pA0, pA1);
    SBAR(); SWAIT(); SWRITE(s0, SO); SLOAD(SO, (j + 4 < NT ? j + 4 : NT - 1) * KVBLK);
    __syncthreads();
    { const int t_ = s0; s0 = s2; s2 = s1; s1 = t_; }
  }
  SBAR(); qkt(pB0, pB1, K_lds + s1 * K8_TILE, qr, r32, hi, cinit);
  finishSM(pA0, pA1, pa); SBAR();
  pv_d0(o, ol, V_lds + s0 * V8_TILE, pa, r32, hi); partialSM(pB0, pB1);
  finishSM(pB0, pB1, pa); SBAR();
  pv_d0(o, ol, V_lds + s1 * V8_TILE, pa, r32, hi);
  asm volatile("s_waitcnt vmcnt(0)" ::: "memory");
  if (lse && r32 == 0) {
#pragma unroll
    for (int r = 0; r < 16; ++r) lse[(wid * QBLK + crow(r, hi)) * 4] = __logf(ol[r]) - mnC * 0.69314718055994531f; }
  float rli[16];
#pragma unroll
  for (int r = 0; r < 16; ++r) rli[r] = __builtin_amdgcn_rcpf(ol[r]);
  bf16_t* Ow = Ob + (long)(wid * QBLK) * LDO;
#pragma unroll
  for (int r = 0; r < 16; ++r) { int orow = crow(r, hi);
    for (int d0 = 0; d0 < 4; ++d0) Ow[(long)orow * LDO + d0 * 32 + r32] = (bf16_t)(pkbf(o[d0][r] * rli[r], 0.f) & 0xffffu); }
  __syncthreads();
#undef SLOAD
#undef SWRITE
#undef SWAIT
}
}

struct Args { const float* in[20]; float* out; unsigned char* ws; int ph_lo, ph_hi; };
typedef const __attribute__((address_space(4))) Args* KArgs;
__device__ __forceinline__ KArgs get_args() { KArgs p = (KArgs)__builtin_amdgcn_kernarg_segment_ptr(); asm volatile("" : "+s"(p)); return p; }
__device__ __forceinline__ int fresh_tid() { int t = threadIdx.x; asm volatile("" : "+v"(t)); return t; }
__device__ __forceinline__ int fresh_bx() { int t = blockIdx.x; asm volatile("" : "+s"(t)); return t; }
__device__ __forceinline__ int fresh_g() { int t = gridDim.x; asm volatile("" : "+s"(t)); return t; }
enum { I_X = 0, I_C, I_CTX, I_CCTX, I_ADAW, I_ADAB, I_N1W, I_N2W, I_WIN, I_QNW, I_KNW, I_CONVW, I_ALOG, I_DTB, I_DNW, I_WOUT, I_WQ, I_SUBK, I_U, I_V };

__device__ __forceinline__ void convert_tables(const float* U, const float* V, unsigned char* ws, int l, int wvi, int nwv, int lane, int rw_end = 2 * NEXP) {
    const float* us = U + (size_t)l * NEXP * 1024; const float* vs = V + (size_t)l * NEXP * 1024;
    const int set = l & 1;
    float* scl = (float*)(ws + WS_USC) + set * 2 * NEXP;
    for (int rw = wvi; rw < rw_end; rw += nwv) {
        const bool isu = rw < NEXP; const int e = isu ? rw : rw - NEXP;
        const f32x4* sp = (const f32x4*)((isu ? us : vs) + (size_t)e * 1024 + 16 * lane);
        f32x4 x[4]; float mx = 0.f;
#pragma unroll
        for (int i = 0; i < 4; ++i) { x[i] = sp[i]; mx = fmaxf(mx, fmaxf(fmaxf(fabsf(x[i][0]), fabsf(x[i][1])), fmaxf(fabsf(x[i][2]), fabsf(x[i][3])))); }
        mx = wave_max(mx);
        const float sc = fmaxf(mx, 1e-30f) * (1.f / 127.f), inv = 1.f / sc;
        u32x4 o4;
        const float ofs = ((GATHER_PART && isu) || GATHER_PART == 2) ? 0.f : 128.f;
#pragma unroll
        for (int i = 0; i < 4; ++i) { const unsigned b0 = (unsigned)(int)(rintf(x[i][0] * inv) + ofs) & 255u, b1 = (unsigned)(int)(rintf(x[i][1] * inv) + ofs) & 255u, b2 = (unsigned)(int)(rintf(x[i][2] * inv) + ofs) & 255u, b3 = (unsigned)(int)(rintf(x[i][3] * inv) + ofs) & 255u;
            o4[i] = b0 | (b1 << 8) | (b2 << 16) | (b3 << 24); }
        if (GATHER_PART == 2) *(u32x4*)(ws + WS_UB + (size_t)set * TAB_SET + (isu ? 0 : (size_t)NEXP * 1024) + ((size_t)(lane >> 3) * NEXP + e) * 128 + 16 * (lane & 7)) = o4;
        else *(u32x4*)(ws + WS_UB + (size_t)set * TAB_SET + (size_t)e * 2048 + (isu ? 0 : 1024) + 16 * lane) = o4;
        if (lane == 0) { if (GATHER_PART) scl[2 * e + (isu ? 0 : 1)] = sc; else scl[rw] = sc; }
    }
}

__device__ __forceinline__ void transpose_item(const float* W, int ldw, int K, bf16_t* WT, LAS float* scr, int kb, int nb, int lane) {
    const int k0 = 64 * kb, n0 = 32 * nb;
#pragma unroll 8
    for (int i = 0; i < 32; ++i) { const int kk = 2 * i + (lane >> 5); scr[kk * 33 + (lane & 31)] = W[(size_t)(k0 + kk) * ldw + n0 + (lane & 31)]; }
    LDS_WAIT(); asm volatile("" ::: "memory");
    const int c = lane & 7;
#pragma unroll
    for (int j = 0; j < 4; ++j) { const int n = (lane >> 3) + 8 * j; const LAS float* s = scr + (8 * c) * 33 + n;
        u32x4 o; o.x = pkbf(s[0 * 33], s[1 * 33]); o.y = pkbf(s[2 * 33], s[3 * 33]); o.z = pkbf(s[4 * 33], s[5 * 33]); o.w = pkbf(s[6 * 33], s[7 * 33]);
        *(u32x4*)(WT + (size_t)(n0 + n) * K + k0 + 8 * c) = o; }
    LDS_WAIT(); asm volatile("" ::: "memory");
}
__device__ __forceinline__ void phase_prologue(LAS unsigned char* lds) {
    const KArgs ap = get_args();
#define a (*ap)

    const int tid = fresh_tid(), lane = tid & 63, wave = __builtin_amdgcn_readfirstlane(tid >> 6), G = fresh_g(), bx = fresh_bx();
    unsigned char* ws = a.ws;
    {
        LAS float* sc = (LAS float*)(lds + 70000);
        LAS float* part = (LAS float*)(lds + 70000 + 12288);
        for (int i = tid; i < 3 * 1024; i += 512) { const int r = i >> 10, k = i & 1023; const float v = r < 2 ? a.in[I_C][r * 1024 + k] : a.in[I_CCTX][k]; sc[i] = silu_f(v); }
        __syncthreads();
        float* mod = (float*)(ws + WS_MOD);
        for (int item = bx; item < DEPTH * 96; item += G) {
            const int l = item / 96, j0 = (item % 96) * 64;
            const float* wp = a.in[I_ADAW] + (size_t)l * 1024 * 6144 + (size_t)(wave * 128) * 6144 + j0 + lane;
            float a0 = 0.f, a1 = 0.f, a2 = 0.f;
#pragma unroll 8
            for (int kk = 0; kk < 128; ++kk) { const float w = wp[(size_t)kk * 6144]; const int k = wave * 128 + kk; a0 = fmaf(sc[k], w, a0); a1 = fmaf(sc[1024 + k], w, a1); a2 = fmaf(sc[2048 + k], w, a2); }
            part[(wave * 3 + 0) * 64 + lane] = a0; part[(wave * 3 + 1) * 64 + lane] = a1; part[(wave * 3 + 2) * 64 + lane] = a2;
            __syncthreads();
            if (tid < 192) { const int r = tid >> 6, jj = tid & 63; float s = a.in[I_ADAB][l * 6144 + j0 + jj];
#pragma unroll
                for (int w = 0; w < 8; ++w) s += part[(w * 3 + r) * 64 + jj];
                mod[(size_t)(l * 3 + r) * 6144 + j0 + jj] = s; }
            __syncthreads();
        }
    }
    {
        const int gw = bx * 8 + wave, NGW = G * 8;
        unsigned* wmaxw = (unsigned*)(ws + WS_CTL) + CW_WMAX;
        constexpr int NB_IN = NP / 64, NB_OUT = 1024 / 64, NB_Q = 2048 / 64, PER_L2 = (NB_IN + NB_OUT + NB_Q) * 8;
        for (int it = gw; it < DEPTH * PER_L2; it += NGW) { const int l = it / PER_L2; int r = it % PER_L2; const int kc = r & 7; r >>= 3;
            const int mi = r < NB_IN ? 0 : r < NB_IN + NB_OUT ? 1 : 2; const int nb = mi == 0 ? r : mi == 1 ? r - NB_IN : r - NB_IN - NB_OUT; const int ldw = mi == 0 ? NIN : mi == 1 ? 1024 : 2048;
            const float* wp = (mi == 0 ? a.in[I_WIN] + (size_t)l * 1024 * NIN : mi == 1 ? a.in[I_WOUT] + (size_t)l * 1024 * 1024 : a.in[I_WQ] + (size_t)l * 1024 * 2048) + (size_t)(kc * 128) * ldw + nb * 64 + lane;
            float mx = 0.f;
#pragma unroll 8
            for (int kk = 0; kk < 128; ++kk) mx = fmaxf(mx, fabsf(wp[(size_t)kk * ldw]));
            atomicMax(wmaxw + (l * 3 + mi) * 3072 + nb * 64 + lane, __float_as_uint(mx)); }
    }
    const size_t gt = (size_t)bx * 512 + tid, NT = (size_t)G * 512;
    for (size_t i = gt; i < (size_t)DEPTH * 16 * 1024; i += NT) { const int l = (int)(i >> 14), j = (int)((i >> 10) & 15), k = (int)(i & 1023);
        ((float*)(ws + WS_WSK))[i] = a.in[I_WIN][(size_t)l * 1024 * NIN + (size_t)k * NIN + NP + j]; }
    for (size_t i = gt; i < (size_t)DEPTH * 8 * 2 * 128 * 128 / 2; i += NT) { const f32x2 x = ((const f32x2*)a.in[I_SUBK])[i]; ((unsigned*)(ws + WS_SKB))[i] = pkbf(x[0], x[1]); }
    for (size_t i = gt; i < 8192; i += NT) { const int pos = (int)(i >> 5), fi = (int)(i & 31);
        const float inv = exp2f(-(float)fi * (13.287712379549449f / 32.f)); const float ang = (float)pos * inv;
        float rev = ang * 0.15915494309189535f; rev -= floorf(rev);
        ((float*)(ws + WS_ROPE))[i] = __builtin_amdgcn_cosf(rev); ((float*)(ws + WS_ROPE))[8192 + i] = __builtin_amdgcn_sinf(rev); }
}


__device__ __forceinline__ void quant_transpose_item(const float* W, int ldw, signed char* WT, const unsigned* wmaxw, LAS float* scr, int kb, int nb, int lane) {
    const int k0 = 64 * kb, n0 = 32 * nb;
#pragma unroll 8
    for (int i = 0; i < 32; ++i) { const int kk = 2 * i + (lane >> 5); scr[kk * 33 + (lane & 31)] = W[(size_t)(k0 + kk) * ldw + n0 + (lane & 31)]; }
    LDS_WAIT(); asm volatile("" ::: "memory");
    const int n = lane >> 1, hf = lane & 1;
    const float mx = __uint_as_float(wmaxw[n0 + n]), inv = mx > 0.f ? 127.f / mx : 0.f;
    u32x4 o[2];
#pragma unroll
    for (int q = 0; q < 8; ++q) { unsigned w = 0u;
#pragma unroll
        for (int b = 0; b < 4; ++b) { const int kk = 32 * hf + 4 * q + b; w |= ((unsigned)(int)rintf(scr[kk * 33 + n] * inv) & 255u) << (8 * b); }
        o[q >> 2][q & 3] = w; }
    u32x4* dst = (u32x4*)(WT + (size_t)(n0 + n) * 1024 + k0 + 32 * hf);
    dst[0] = o[0]; dst[1] = o[1];
    LDS_WAIT(); asm volatile("" ::: "memory");
}
__device__ __forceinline__ void phase_quant_weights(LAS unsigned char* lds) {
    const KArgs ap = get_args();
#define a (*ap)
    const int tid = fresh_tid(), lane = tid & 63, wave = __builtin_amdgcn_readfirstlane(tid >> 6), G = fresh_g(), bx = fresh_bx();
    unsigned char* ws = a.ws;
    LAS float* scr = (LAS float*)(lds + 65536 + wave * 8448);
    const unsigned* wmaxw = (const unsigned*)(ws + WS_CTL) + CW_WMAX;
    constexpr int I_IN = 16 * 96, I_OUT = 16 * 32, I_Q = 16 * 64, PER_L = I_IN + I_OUT + I_Q;
    for (int it = bx * 8 + wave; it < DEPTH * PER_L; it += G * 8) { const int l = it / PER_L; int r = it % PER_L;
        if (r < I_IN) quant_transpose_item(a.in[I_WIN] + (size_t)l * 1024 * NIN, NIN, (signed char*)(ws + WS_WINT) + (size_t)l * NP * 1024, wmaxw + (l * 3 + 0) * 3072, scr, r / 96, r % 96, lane);
        else if (r < I_IN + I_OUT) { r -= I_IN; quant_transpose_item(a.in[I_WOUT] + (size_t)l * 1024 * 1024, 1024, (signed char*)(ws + WS_WOUTT) + (size_t)l * 1024 * 1024, wmaxw + (l * 3 + 1) * 3072, scr, r / 32, r % 32, lane); }
        else { r -= I_IN + I_OUT; quant_transpose_item(a.in[I_WQ] + (size_t)l * 1024 * 2048, 2048, (signed char*)(ws + WS_WQT) + (size_t)l * 2048 * 1024, wmaxw + (l * 3 + 2) * 3072, scr, r / 64, r % 64, lane); } }
#undef a
}

template <bool SK>
__device__ __forceinline__ void phase_norm(int l, int which, LAS unsigned char* lds) {
    const KArgs ap = get_args();
#define a (*ap)

    const int tid = fresh_tid(), lane = tid & 63, wave = __builtin_amdgcn_readfirstlane(tid >> 6), G = fresh_g(), bx = fresh_bx();
    unsigned char* ws = a.ws;
    LAS float* wsk = (LAS float*)lds;
    if (SK) { const float* src = (const float*)(ws + WS_WSK) + (size_t)l * 16384; for (int i = tid; i < 16384 / 4; i += 512) ((LAS f32x4*)wsk)[i] = ((const f32x4*)src)[i]; __syncthreads(); }
    const int nrows = (which == 1 && l == DEPTH - 1) ? ML : M;
    const float* nw = a.in[which ? I_N2W : I_N1W] + l * 1024;
    const float* modl = (const float*)(ws + WS_MOD) + (size_t)l * 3 * 6144;
    const int shoff = which ? 3072 : 0, scoff = which ? 4096 : 1024;
    f32x4 nwv[4];
#pragma unroll
    for (int j = 0; j < 4; ++j) nwv[j] = *(const f32x4*)(nw + 4 * lane + 256 * j);
    for (int row = wave * G + bx; row < nrows; row += G * 8) {
        const int mrow = row < ML ? (row >= T ? 1 : 0) : 2;
        const float* md = modl + mrow * 6144;
        f32x4 v[4]; float ss = 0.f;
        if (l == 0 && which == 0) { const float* src = row < ML ? a.in[I_X] + (size_t)row * D : a.in[I_CTX] + (size_t)(row - ML) * D;
#pragma unroll
            for (int j = 0; j < 4; ++j) v[j] = *(const f32x4*)(src + 4 * lane + 256 * j); }
        else { const bf16_t* src = (const bf16_t*)(ws + WS_XB) + (size_t)row * D;
#pragma unroll
            for (int j = 0; j < 4; ++j) { const u32x2 w_ = *(const u32x2*)(src + 4 * lane + 256 * j); v[j] = (f32x4){bflo(w_[0]), bfhi(w_[0]), bflo(w_[1]), bfhi(w_[1])}; } }
#pragma unroll
        for (int j = 0; j < 4; ++j) ss += (v[j][0] * v[j][0] + v[j][1] * v[j][1]) + (v[j][2] * v[j][2] + v[j][3] * v[j][3]);
        const float rstd = rsqrtf(wave_sum(ss) * (1.f / D) + EPS);
        signed char* hrow = (signed char*)(ws + WS_H) + (size_t)row * D;
        float hmx = 0.f;
#pragma unroll
        for (int j = 0; j < 4; ++j) { const f32x4 sc = *(const f32x4*)(md + scoff + 4 * lane + 256 * j), sh = *(const f32x4*)(md + shoff + 4 * lane + 256 * j);
            v[j] = v[j] * rstd * nwv[j] * (sc + 1.f) + sh; hmx = fmaxf(hmx, fmaxf(fmaxf(fabsf(v[j][0]), fabsf(v[j][1])), fmaxf(fabsf(v[j][2]), fabsf(v[j][3])))); }
        hmx = fmaxf(wave_max(hmx), 1e-30f);
        { const float hinv = 127.f / hmx;
#pragma unroll
          for (int j = 0; j < 4; ++j) *(unsigned*)(hrow + 4 * lane + 256 * j) = ((unsigned)(int)rintf(v[j][0] * hinv) & 255u) | (((unsigned)(int)rintf(v[j][1] * hinv) & 255u) << 8) | (((unsigned)(int)rintf(v[j][2] * hinv) & 255u) << 16) | (((unsigned)(int)rintf(v[j][3] * hinv) & 255u) << 24);
          if (lane == 0) ((float*)(ws + WS_GB))[row] = hmx * (1.f / 127.f); }
        if (SK) {
            float p[16];
#pragma unroll
            for (int c = 0; c < 16; ++c) { float q = 0.f;
#pragma unroll
                for (int j = 0; j < 4; ++j) { const f32x4 w = *(const LAS f32x4*)(wsk + c * 1024 + 4 * lane + 256 * j); q += (v[j][0] * w[0] + v[j][1] * w[1]) + (v[j][2] * w[2] + v[j][3] * w[3]); }
                p[c] = q; }
            { const bool hb = (lane & 32) != 0;
#pragma unroll
              for (int c = 0; c < 8; ++c) { const float keep = hb ? p[c + 8] : p[c], send = hb ? p[c] : p[c + 8]; p[c] = keep + lane_xor<32>(send); } }
            { const bool hb = (lane & 16) != 0;
#pragma unroll
              for (int c = 0; c < 4; ++c) { const float keep = hb ? p[c + 4] : p[c], send = hb ? p[c] : p[c + 4]; p[c] = keep + lane_xor<16>(send); } }
            { const bool hb = (lane & 8) != 0;
#pragma unroll
              for (int c = 0; c < 2; ++c) { const float keep = hb ? p[c + 2] : p[c], send = hb ? p[c] : p[c + 2]; p[c] = keep + lane_xor<8>(send); } }
            { const bool hb = (lane & 4) != 0; const float keep = hb ? p[1] : p[0], send = hb ? p[0] : p[1]; p[0] = keep + lane_xor<4>(send); }
            p[0] += lane_xor<2>(p[0]); p[0] += lane_xor<1>(p[0]);
            if ((lane & 3) == 0) { const int c = ((lane >> 5) & 1) * 8 + ((lane >> 4) & 1) * 4 + ((lane >> 3) & 1) * 2 + ((lane >> 2) & 1); ((float*)(ws + WS_BA))[(size_t)row * 16 + c] = p[0]; }
        }
    }
    if (SK) __syncthreads();
}

__device__ __forceinline__ void phase_prep(int l, LAS unsigned char* lds) {
    const KArgs ap = get_args();
#define a (*ap)

    const int tid = fresh_tid(), lane = tid & 63, wave = __builtin_amdgcn_readfirstlane(tid >> 6), G = fresh_g(), bx = fresh_bx();
    unsigned char* ws = a.ws;
    const bf16_t* P = (const bf16_t*)(ws + WS_P);
    const float* ropec = (const float*)(ws + WS_ROPE); const float* ropes = ropec + 8192;
    const int sec = lane >> 5, fi = lane & 31;
    const float qw0 = a.in[I_QNW][l * 128 + sec * 64 + fi], qw1 = a.in[I_QNW][l * 128 + sec * 64 + 32 + fi];
    const float kw0 = a.in[I_KNW][l * 128 + sec * 64 + fi], kw1 = a.in[I_KNW][l * 128 + sec * 64 + 32 + fi];
    for (int row = wave * G + bx; row < M; row += G * 8) {
        const bool lat = row < ML;
        int b, tt, tlen; if (lat) { b = row >> 14; tt = row & (T - 1); tlen = T; } else { b = (row - ML) >> 8; tt = (row - ML) & (CT - 1); tlen = CT; }
        const bf16_t* prow = P + (size_t)row * NP;
        unsigned short xa[6][2];
#pragma unroll
        for (int hh = 0; hh < 6; ++hh) { const bf16_t* xp = prow + (hh < 4 ? hh * 128 : 512 + (hh - 4) * 128) + sec * 64 + fi; xa[hh][0] = xp[0]; xa[hh][1] = xp[32]; }
        const u32x2 vcp = *(const u32x2*)(prow + 768 + 4 * lane);
        float cs = 1.f, sn = 0.f;
        if (lat) { const int pos = sec ? (tt & 63) : (tt >> 6); cs = ropec[pos * 32 + fi]; sn = ropes[pos * 32 + fi]; }
        unsigned char* qo8 = ws + WS_QA + (size_t)row * 512;
        const size_t kvrow = (size_t)b * KVLEN + (lat ? tt : T + tt);
        unsigned char* ko8 = ws + WS_KA + kvrow * 256;
        float ssq[6];
#pragma unroll
        for (int hh = 0; hh < 6; ++hh) { const float x0 = bf2f(xa[hh][0]), x1 = bf2f(xa[hh][1]); ssq[hh] = x0 * x0 + x1 * x1; }
#pragma unroll
        for (int hh = 0; hh < 6; ++hh) ssq[hh] = wave_sum(ssq[hh]);
#pragma unroll
        for (int hh = 0; hh < 6; ++hh) {
            const float x0 = bf2f(xa[hh][0]), x1 = bf2f(xa[hh][1]);
            const float rs = rsqrtf(ssq[hh] * (1.f / 128.f) + EPS);
            const float y0 = x0 * rs * (hh < 4 ? qw0 : kw0), y1 = x1 * rs * (hh < 4 ? qw1 : kw1);
            const float qsc = hh < 4 ? 0.088388347648318440f * 1.4426950408889634f : 1.f;
            const float o0 = (y0 * cs - y1 * sn) * qsc, o1 = (y1 * cs + y0 * sn) * qsc;
            unsigned char* op8 = (hh < 4 ? qo8 + hh * 128 : ko8 + (hh - 4) * 128) + sec * 64 + fi;
            const float f8s = hh < 4 ? 8.f : 1.f;
            const int pk8 = __builtin_amdgcn_cvt_pk_fp8_f32(o0 * f8s, o1 * f8s, 0, false);
            op8[0] = (unsigned char)(pk8 & 255); op8[32] = (unsigned char)((pk8 >> 8) & 255);
        }
        { const int pos = lat ? tt : T + tt, tile = pos >> 6, k64 = pos & 63, k32 = k64 & 31;
          const int bytepos = 32 * ((k32 >> 2) & 1) + 16 * (k64 >> 5) + (k32 & 3) + 4 * (k32 >> 3);
          unsigned char* vt = ws + WS_VA + ((size_t)(b * 2) * (KVLEN / 64) + tile) * 8192 + bytepos;
          const unsigned short* vsrc = (const unsigned short*)&vcp;
          const int kvh_ = lane >> 5, d0 = (4 * lane) & 127;
          const int pk01 = __builtin_amdgcn_cvt_pk_fp8_f32(bf2f(vsrc[0]), bf2f(vsrc[1]), 0, false), pk23 = __builtin_amdgcn_cvt_pk_fp8_f32(bf2f(vsrc[2]), bf2f(vsrc[3]), 0, false);
          unsigned char* vt2 = vt + (size_t)kvh_ * (KVLEN / 64) * 8192 + (size_t)d0 * 64;
          vt2[0] = (unsigned char)(pk01 & 255); vt2[64] = (unsigned char)((pk01 >> 8) & 255); vt2[128] = (unsigned char)(pk23 & 255); vt2[192] = (unsigned char)((pk23 >> 8) & 255); }
    }
    __syncthreads();
}

constexpr int ATT_PARTS = 4;
__device__ __forceinline__ void phase_attn(int l, unsigned char* lds_raw, volatile LAS unsigned* MISC, int rep) {
    const KArgs ap = get_args();
#define a (*ap)
    unsigned char* ws = a.ws;
    const unsigned char* QA = ws + WS_QA; const unsigned char* KA = ws + WS_KA; const unsigned char* VT = ws + WS_VA;
    bf16_t* CAT = (bf16_t*)(ws + WS_CAT); float* LSE = (float*)(ws + WS_BA);
    unsigned* ctr = (unsigned*)(ws + WS_CTL) + 8192 + 64 * l + 1024 * rep;
    const int natt = 2048 + (l < DEPTH - 1 ? 8 : 0);
    constexpr int CONV_ROWS = 64, NCONV = 2 * NEXP / CONV_ROWS;
    const int nunits = natt + (l + 1 < DEPTH ? NCONV : 0) + (l == 0 ? NCONV : 0);
    float braw;
    { const int ln = threadIdx.x & 63; float mq = fmaxf(fabsf(a.in[I_QNW][l * 128 + ln]), fabsf(a.in[I_QNW][l * 128 + 64 + ln])), mk = fmaxf(fabsf(a.in[I_KNW][l * 128 + ln]), fabsf(a.in[I_KNW][l * 128 + 64 + ln]));
      mq = wave_max(mq); mk = wave_max(mk);
      braw = __builtin_bit_cast(float, __builtin_amdgcn_readfirstlane(__builtin_bit_cast(int, 128.f * mq * mk))); }
    if (threadIdx.x == 0) MISC[12] = __hip_atomic_fetch_add(ctr, 1u, __ATOMIC_RELAXED, __HIP_MEMORY_SCOPE_AGENT);
    __syncthreads();
    int u = (int)MISC[12], par = 0;
    for (; u < nunits; ) {
        if (threadIdx.x == 0) MISC[13 - par] = __hip_atomic_fetch_add(ctr, 1u, __ATOMIC_RELAXED, __HIP_MEMORY_SCOPE_AGENT);
        if (u >= natt) {
            const int tq_ = fresh_tid();
            const int ci_ = u - natt, own_ = ci_ >= NCONV ? 1 : 0;
            const int rwb = (ci_ - own_ * NCONV) * CONV_ROWS + __builtin_amdgcn_readfirstlane(tq_ >> 6) * 8;
            convert_tables(a.in[I_U], a.in[I_V], ws, l + 1 - own_, rwb, 1, tq_ & 63, rwb + 8);
            __syncthreads();
            u = (int)MISC[13 - par]; par ^= 1;
            continue;
        }
        size_t r0, kv0; int h, kvh, seq, ldo; bf16_t* ob; float* lse;
        if (u < 2048) { const int qb = u & 63, g = (u >> 6) & 1, part = (u >> 7) & 3, b = u >> 10; kvh = (u >> 9) & 1; h = kvh * 2 + g;
            const int t0 = (part >> 1) * 130 + (part & 1) * 64;
            r0 = (size_t)b * T + (size_t)qb * 256; kv0 = (size_t)b * KVLEN + (size_t)t0 * 64; seq = ((part & 1) ? 66 : 64) * 64;
            ob = part ? (bf16_t*)(ws + (part == 1 ? WS_DQ : part == 2 ? WS_DK : WS_DV)) + r0 * 512 + h * 128 : CAT + r0 * 1024 + h * 128; ldo = part ? 512 : 1024; lse = LSE + ((size_t)part * ML + r0) * 4 + h; }
        else { const int b = (u - 2048) >> 2; h = (u - 2048) & 3; kvh = h >> 1; r0 = (size_t)ML + (size_t)b * CT; kv0 = (size_t)b * KVLEN + T; seq = CT;
            ob = CAT + r0 * 1024 + h * 128; ldo = 1024; lse = nullptr; }
        att::attn_dense_body(QA + r0 * 512 + h * 128, KA + kv0 * 256 + kvh * 128, VT + ((size_t)((kv0 / KVLEN) * 2 + kvh) * (KVLEN / 64) + (kv0 % KVLEN) / 64) * 8192, ob, ldo, seq, (char*)lds_raw, lse, braw);
        u = (int)MISC[13 - par]; par ^= 1;
    }
#undef a
}

__device__ __forceinline__ int tokperm(int q, int hh, int jj) { return 16 * q + 8 * (jj >> 2) + 4 * hh + (jj & 3); }
__device__ __forceinline__ int crow16(int r, int hi) { return (r & 3) + 8 * (r >> 2) + 4 * hi; }
__device__ __forceinline__ int kperm16(int s_, int g, int jj) { return 32 * s_ + 16 * (jj >> 2) + 4 * g + (jj & 3); }
__device__ __forceinline__ int frag_off(int i, int j) {
    return (((i >> 4) * 2 + (j >> 5)) * 64 + ((i & 15) + 16 * ((j >> 2) & 3))) * 16 + (4 * ((j >> 4) & 1) + (j & 3)) * 2;
}
template <int MODE>
__device__ __forceinline__ void phase_dn_chunkprep(int l, LAS unsigned char* lds) {
    const KArgs ap = get_args();
#define a (*ap)
    const int tid = fresh_tid(), lane = tid & 63, wave = __builtin_amdgcn_readfirstlane(tid >> 6), G = fresh_g(), bx = fresh_bx();
    unsigned char* ws = a.ws;
    constexpr int KT_OFF = 0, QT_OFF = 17408, VT_OFF = 34816, GS_OFF = 52224, RS_OFF = 68864, AM_OFF = 85504, SC_OFF = 120320, IMG_OFF = 0;
    const int r = lane & 31, hh = lane >> 5;
    const bf16_t* DQ = (const bf16_t*)(ws + WS_DQ); const bf16_t* DK = (const bf16_t*)(ws + WS_DK); const bf16_t* DV = (const bf16_t*)(ws + WS_DV);
    const float* BA = (const float*)(ws + WS_BA);
    constexpr int NTASK = MODE ? NB * 4 * 4 : NB * 4 * (NCH - 4);
#define CP_TASKID(t_) (MODE ? ((t_) >> 2) * NCH + ((t_) & 3) : ((t_) >> 8) * NCH + 4 + ((t_) & 255))
    LAS float* gsc = (LAS float*)(lds + SC_OFF);
    LAS float* bsc = gsc + 128;
    LAS float* gcs = gsc + 256;
    constexpr int CW_OFF = 121856, DI_OFF = CW_OFF + 5 * 1536 * 4;
    static_assert(DI_OFF + 8192 <= LDS_MISC, "chunkprep LDS");
    LAS float* cwl = (LAS float*)(lds + CW_OFF);
    for (int i = tid; i < 5 * 1536; i += 512) cwl[i] = a.in[I_CONVW][(size_t)l * 5 * 1536 + i];
    __syncthreads();
    const bf16_t* P = (const bf16_t*)(ws + WS_P);
    u32x4 xin[3][5][2];
#define CP_LOADX(task_) do { const int cidx_ = (task_) % NCH, bh_ = (task_) / NCH, b_ = bh_ >> 2, h_ = bh_ & 3; \
        const int row0_ = cidx_ < 4 ? ML + b_ * CT + cidx_ * 64 : b_ * T + (cidx_ - 4) * 64, tt_ = (cidx_ < 4 ? cidx_ * 64 : (cidx_ - 4) * 64) + (tid >> 3), tlen_ = cidx_ < 4 ? CT : T; \
        _Pragma("unroll") for (int j = 0; j < 5; ++j) { const int t2 = tt_ + j - 2; const bool ok = t2 >= 0 && t2 < tlen_; \
            const bf16_t* xr = P + (size_t)(row0_ + (tid >> 3) + (ok ? j - 2 : 0)) * NP + 1024 + h_ * 128 + (tid & 7) * 16; \
            _Pragma("unroll") for (int m = 0; m < 3; ++m) { const u32x4 w0 = *(const u32x4*)(xr + m * 512), w1 = *(const u32x4*)(xr + m * 512 + 8); \
                xin[m][j][0] = ok ? w0 : (u32x4){0u, 0u, 0u, 0u}; xin[m][j][1] = ok ? w1 : (u32x4){0u, 0u, 0u, 0u}; } } } while (0)
    if (bx < NTASK) CP_LOADX(CP_TASKID(bx));
    for (int tk = bx; tk < NTASK; tk += G) {
        const int task = CP_TASKID(tk);
        const int cidx = task % NCH, bh = task / NCH, b = bh >> 2, h = bh & 3;
        const int row0 = cidx < 4 ? ML + b * CT + cidx * 64 : b * T + (cidx - 4) * 64;
        unsigned char* rec = ws + WS_REC + (size_t)task * REC_BYTES;
        {
            const int rr = tid >> 3, seg = tid & 7;
            if (tid < 128) { const int d = tid >> 6, i = tid & 63, dh = d * 4 + h;
                const float xb = BA[(size_t)(row0 + i) * 16 + dh], z = BA[(size_t)(row0 + i) * 16 + 8 + dh] + a.in[I_DTB][l * 8 + dh];
                bsc[tid] = 1.f / (1.f + __expf(-xb)); gsc[tid] = -__expf(a.in[I_ALOG][l * 8 + dh]) * (fmaxf(z, 0.f) + log1pf(__expf(-fabsf(z)))); }
#pragma unroll
            for (int m = 0; m < 3; ++m) {
                float y[16];
#pragma unroll
                for (int c = 0; c < 16; ++c) y[c] = 0.f;
#pragma unroll
                for (int j = 0; j < 5; ++j) { const LAS float* wp = cwl + j * 1536 + m * 512 + h * 128 + seg * 16;
#pragma unroll
                    for (int q4 = 0; q4 < 4; ++q4) { const f32x4 wv = *(const LAS f32x4*)(wp + 4 * q4); const unsigned u0 = xin[m][j][q4 >> 1][2 * (q4 & 1)], u1 = xin[m][j][q4 >> 1][2 * (q4 & 1) + 1];
                        y[4 * q4 + 0] = fmaf(bflo(u0), wv[0], y[4 * q4 + 0]); y[4 * q4 + 1] = fmaf(bfhi(u0), wv[1], y[4 * q4 + 1]); y[4 * q4 + 2] = fmaf(bflo(u1), wv[2], y[4 * q4 + 2]); y[4 * q4 + 3] = fmaf(bfhi(u1), wv[3], y[4 * q4 + 3]); } }
                float ss = 0.f;
#pragma unroll
                for (int c = 0; c < 16; ++c) { y[c] = silu_f(y[c]); ss = fmaf(y[c], y[c], ss); }
                if (m < 2) { ss += lane_xor<1>(ss); ss += lane_xor<2>(ss); ss += lane_xor<4>(ss);
                    float sc = rsqrtf(ss + EPS); if (m == 0) sc *= 0.088388347648318440f;
#pragma unroll
                    for (int c = 0; c < 16; ++c) y[c] *= sc; }
                u32x4 o0, o1; o0.x = pkbf(y[0], y[1]); o0.y = pkbf(y[2], y[3]); o0.z = pkbf(y[4], y[5]); o0.w = pkbf(y[6], y[7]); o1.x = pkbf(y[8], y[9]); o1.y = pkbf(y[10], y[11]); o1.z = pkbf(y[12], y[13]); o1.w = pkbf(y[14], y[15]);
                LAS unsigned char* dst = lds + (m == 0 ? QT_OFF : m == 1 ? KT_OFF : VT_OFF) + rr * 272 + seg * 32;
                *(LAS u32x4*)dst = o0; *(LAS u32x4*)(dst + 16) = o1;
            }
        }
        __syncthreads();
        {
            const int mat = wave >> 2, ti = (wave >> 1) & 1, tj = wave & 1;
            f32x16 acc = {};
#pragma unroll
            for (int ks = 0; ks < 8; ++ks) {
                const bf16x8 av = *(const LAS bf16x8*)(lds + (mat ? QT_OFF : KT_OFF) + (32 * ti + r) * 272 + (16 * ks + 8 * hh) * 2);
                const bf16x8 bv = *(const LAS bf16x8*)(lds + KT_OFF + (32 * tj + r) * 272 + (16 * ks + 8 * hh) * 2);
                acc = __builtin_amdgcn_mfma_f32_32x32x16_bf16(av, bv, acc, 0, 0, 0);
            }
            LAS float* dst = (LAS float*)(lds + (mat ? RS_OFF : GS_OFF));
#pragma unroll
            for (int i = 0; i < 16; ++i) dst[(32 * ti + crow16(i, hh)) * 65 + 32 * tj + r] = acc[i];
        }
        { const int r16 = lane & 15, g4 = lane >> 4;
#pragma unroll
        for (int t = 0; t < 2; ++t) { const int f = wave * 2 + t, mt = f >> 2, sk = f & 3;
            { const u32x2 lo = *(const LAS u32x2*)(lds + KT_OFF + (16 * mt + r16) * 272 + (32 * sk + 4 * g4) * 2), hi2 = *(const LAS u32x2*)(lds + KT_OFF + (16 * mt + r16) * 272 + (32 * sk + 16 + 4 * g4) * 2);
              *(u32x4*)(rec + REC_K + f * 1024 + lane * 16) = (u32x4){lo.x, lo.y, hi2.x, hi2.y}; }
            { const u32x2 lo = *(const LAS u32x2*)(lds + QT_OFF + (16 * mt + r16) * 272 + (32 * sk + 4 * g4) * 2), hi2 = *(const LAS u32x2*)(lds + QT_OFF + (16 * mt + r16) * 272 + (32 * sk + 16 + 4 * g4) * 2);
              *(u32x4*)(rec + REC_Q + f * 1024 + lane * 16) = (u32x4){lo.x, lo.y, hi2.x, hi2.y}; } }
#pragma unroll
        for (int t = 0; t < 2; ++t) { const int f = wave * 2 + t, mt = f >> 1, sk = f & 1;
            unsigned e[8];
#pragma unroll
            for (int jj = 0; jj < 8; ++jj) e[jj] = *(const LAS unsigned short*)(lds + KT_OFF + kperm16(sk, g4, jj) * 272 + (16 * mt + r16) * 2);
            *(u32x4*)(rec + REC_KT + f * 1024 + lane * 16) = (u32x4){e[0] | (e[1] << 16), e[2] | (e[3] << 16), e[4] | (e[5] << 16), e[6] | (e[7] << 16)}; }
        { const int sl = wave;
            unsigned e[16];
#pragma unroll
            for (int i = 0; i < 16; ++i) e[i] = *(const LAS unsigned short*)(lds + VT_OFF + (16 * (i >> 2) + 4 * g4 + (i & 3)) * 272 + (16 * sl + r16) * 2);
            u32x4* vp = (u32x4*)(rec + REC_V + sl * 2048 + lane * 32);
            vp[0] = (u32x4){e[0] | (e[1] << 16), e[2] | (e[3] << 16), e[4] | (e[5] << 16), e[6] | (e[7] << 16)};
            vp[1] = (u32x4){e[8] | (e[9] << 16), e[10] | (e[11] << 16), e[12] | (e[13] << 16), e[14] | (e[15] << 16)}; }
        }
        if (tk + G < NTASK) CP_LOADX(CP_TASKID(tk + G));
        if (wave < 2) { const int d = wave; float gv = gsc[d * 64 + (d ? 63 - lane : lane)];
            gv += __builtin_bit_cast(float, __builtin_amdgcn_update_dpp(0, __builtin_bit_cast(int, gv), 0x111, 0xF, 0xF, true));
            gv += __builtin_bit_cast(float, __builtin_amdgcn_update_dpp(0, __builtin_bit_cast(int, gv), 0x112, 0xF, 0xF, true));
            gv += __builtin_bit_cast(float, __builtin_amdgcn_update_dpp(0, __builtin_bit_cast(int, gv), 0x114, 0xF, 0xF, true));
            gv += __builtin_bit_cast(float, __builtin_amdgcn_update_dpp(0, __builtin_bit_cast(int, gv), 0x118, 0xF, 0xF, true));
            { const float t0 = __builtin_bit_cast(float, __builtin_amdgcn_readlane(__builtin_bit_cast(int, gv), 15)), t1 = __builtin_bit_cast(float, __builtin_amdgcn_readlane(__builtin_bit_cast(int, gv), 31)), t2 = __builtin_bit_cast(float, __builtin_amdgcn_readlane(__builtin_bit_cast(int, gv), 47));
              const int rw_ = lane >> 4; gv += (rw_ >= 1 ? t0 : 0.f) + (rw_ >= 2 ? t1 : 0.f) + (rw_ >= 3 ? t2 : 0.f); }
            gcs[d * 64 + lane] = gv; }
        __syncthreads();
        const LAS float* Gs = (const LAS float*)(lds + GS_OFF); const LAS float* Rs = (const LAS float*)(lds + RS_OFF);
#pragma unroll 4
        for (int t = 0; t < 16; ++t) { const int e = tid + 512 * t, d = e >> 12, jp = (e >> 6) & 63, ip = e & 63;
            const int in_ = d ? 63 - ip : ip, jn = d ? 63 - jp : jp;
            const float dec = __expf(fminf(gcs[d * 64 + ip] - gcs[d * 64 + jp], 0.f));
            const float av = (jp < ip) ? bsc[d * 64 + in_] * Gs[in_ * 65 + jn] * dec : 0.f;
            ((LAS float*)(lds + AM_OFF))[d * 4352 + jp * 68 + ip] = av;
            const float qk = (jp <= ip) ? Rs[in_ * 65 + jn] * dec : 0.f;
            *(LAS unsigned short*)(lds + IMG_OFF + d * 16384 + 8192 + frag_off(in_, jn)) = (unsigned short)(pkbf(qk, 0.f) & 0xffffu); }
        __syncthreads();
        { int ln_ = lane; asm volatile("" : "+v"(ln_));
          const int d = wave >> 2, nt = wave & 3, n16 = ln_ & 15, g4 = ln_ >> 4;
          const LAS float* At = (const LAS float*)(lds + AM_OFF) + d * 4352;
          LAS float* Xd = (LAS float*)(lds + GS_OFF) + d * 4096;
          LAS float* Dinv = (LAS float*)(lds + DI_OFF) + d * 1024;
          { float x[16];
#pragma unroll
            for (int q = 0; q < 16; ++q) x[q] = (q == n16) ? 1.f : 0.f;
#pragma unroll
            for (int r2 = 0; r2 < 15; ++r2) { const LAS float* ar = At + (16 * nt + r2) * 68 + 16 * nt; const float xr = x[r2];
#pragma unroll
                for (int q4 = (r2 + 1) / 4; q4 < 4; ++q4) { const f32x4 a4 = *(const LAS f32x4*)(ar + 4 * q4);
#pragma unroll
                    for (int q = 0; q < 4; ++q) if (4 * q4 + q > r2) x[4 * q4 + q] = fmaf(-a4[q], xr, x[4 * q4 + q]); } }
            if (ln_ < 16) {
#pragma unroll
                for (int q = 0; q < 16; ++q) Dinv[nt * 256 + q * 16 + n16] = x[q]; } }
          if (wave == 2 || wave == 3) { const int d2 = wave - 2, ip = d2 ? 63 - lane : lane; const float gl = gcs[d2 * 64 + 63], gi = gcs[d2 * 64 + ip];
            float* sc = (float*)(rec + REC_DIR + d2 * REC_DIRSZ + 16384);
            sc[lane] = __expf(gi); sc[64 + lane] = __expf(gl - gi); if (lane == 0) sc[128] = __expf(gl); }
          __syncthreads();
          const int c = 16 * nt + n16, jn = d ? 63 - c : c; const float bj = bsc[d * 64 + jn];
          const int fj = (jn >> 5) * 1024 + ((jn >> 2) & 3) * 256 + ((jn >> 4) & 1) * 8 + (jn & 3) * 2;
#pragma unroll 1
          for (int B = 0; B < 4; ++B) {
            f32x4 y = {0.f, 0.f, 0.f, 0.f};
            if (nt <= B) {
                f32x4 acc;
#pragma unroll
                for (int r2 = 0; r2 < 4; ++r2) acc[r2] = (nt == B && 4 * g4 + r2 == n16) ? 1.f : 0.f;
#pragma unroll 2
                for (int j0 = 0; j0 < 16 * B; j0 += 4) { const float av = -At[(j0 + g4) * 68 + 16 * B + n16], bv = Xd[(j0 + g4) * 64 + c];
                    acc = __builtin_amdgcn_mfma_f32_16x16x4f32(av, bv, acc, 0, 0, 0); }
#pragma unroll
                for (int r2 = 0; r2 < 4; ++r2) Xd[(16 * B + 4 * g4 + r2) * 64 + c] = acc[r2];
#pragma unroll
                for (int s4 = 0; s4 < 4; ++s4) { const float av = Dinv[B * 256 + n16 * 16 + 4 * s4 + g4], bv = Xd[(16 * B + 4 * s4 + g4) * 64 + c];
                    y = __builtin_amdgcn_mfma_f32_16x16x4f32(av, bv, y, 0, 0, 0); }
            }
#pragma unroll
            for (int r2 = 0; r2 < 4; ++r2) { const int i = 16 * B + 4 * g4 + r2, in_ = d ? 63 - i : i; Xd[i * 64 + c] = y[r2];
                *(LAS unsigned short*)(lds + IMG_OFF + d * 16384 + (in_ >> 4) * 2048 + (in_ & 15) * 16 + fj) = (unsigned short)(pkbf_c(y[r2] * bj, 0.f) & 0xffffu); }
            __syncthreads();
          }
        }
#pragma unroll
        for (int t = 0; t < 4; ++t) { const int p = tid + 512 * t, d = p >> 10, off = (p & 1023) * 16;
            *(u32x4*)(rec + REC_DIR + d * REC_DIRSZ + off) = *(const LAS u32x4*)(lds + IMG_OFF + d * 16384 + off); }
        __syncthreads();
    }
#undef CP_LOADX
#undef CP_TASKID
#undef a
}

__device__ __forceinline__ bf16x8 pack44(const f32x4& lo, const f32x4& hi) {
    u32x4 p; p.x = pkbf_c(lo[0], lo[1]); p.y = pkbf_c(lo[2], lo[3]); p.z = pkbf_c(hi[0], hi[1]); p.w = pkbf_c(hi[2], hi[3]);
    return __builtin_bit_cast(bf16x8, p);
}
template <int VAR>
__device__ __forceinline__ void phase_dn_scan(int l, LAS unsigned char* lds) {
    const KArgs ap = get_args();
#define a (*ap)
    const int tid = fresh_tid(), lane = tid & 63, wave = __builtin_amdgcn_readfirstlane(tid >> 6), bx = fresh_bx();
    unsigned char* ws = a.ws;
    if (bx >= 32) return;
    const int chain = bx >> 1, half = bx & 1, b = chain >> 3, h = (chain >> 1) & 3, dir = chain & 1;
    const unsigned char* recb = ws + WS_REC + (size_t)((b * 4 + h) * NCH) * REC_BYTES;
    constexpr int BUFSZ = 74752;
#define CIDX(n) (dir ? ((n) < 4 ? 3 - (n) : 263 - (n)) : (n))
    if (wave >= 4) {
        const int sw = wave - 4;
#define DN_PIECE(i_) ((sw + 4 * (i_)) < 73 ? (sw + 4 * (i_)) : 72)
#define DN_SRC(rec_, p_) ((p_) < 48 ? (rec_) + (p_) * 1024 : (p_) < 65 ? (rec_) + REC_DIR + dir * REC_DIRSZ + ((p_) - 48) * 1024 : (rec_) + REC_V + half * 8192 + ((p_) - 65) * 1024)
#define DN_STAGE(n, bi) do { const unsigned char* rec_ = recb + (size_t)CIDX(n) * REC_BYTES; _Pragma("unroll") for (int i_ = 0; i_ < 19; ++i_) { const int p_ = DN_PIECE(i_); \
        __builtin_amdgcn_global_load_lds((const unsigned*)(DN_SRC(rec_, p_) + lane * 16), (LAS unsigned*)(lds + (bi) * BUFSZ + p_ * 1024), 16, 0, 0); } } while (0)
#define DN_SYNC() do { asm volatile("s_waitcnt vmcnt(0)" ::: "memory"); __builtin_amdgcn_s_barrier(); asm volatile("" ::: "memory"); } while (0)
        if (VAR != 3) DN_STAGE(0, 0);
        DN_SYNC();
        for (int n = 0; n < NCH; ++n) {
            if (VAR != 3 && n + 1 < NCH) DN_STAGE(n + 1, (n + 1) & 1);
            DN_SYNC();
        }
#undef DN_STAGE
#undef DN_PIECE
#undef DN_SRC
#undef DN_SYNC
    } else {
        const int sl = half * 4 + wave, c16 = lane & 15, g4 = lane >> 4;
        bf16_t* Og = (bf16_t*)(ws + (dir ? WS_OB : WS_OF)) + h * 128 + sl * 16 + c16;
        f32x4 S[8];
#pragma unroll
        for (int i = 0; i < 8; ++i) S[i] = (f32x4){0.f, 0.f, 0.f, 0.f};
        asm volatile("s_waitcnt lgkmcnt(0)" ::: "memory"); __builtin_amdgcn_s_barrier(); asm volatile("" ::: "memory");
        for (int n = 0; n < NCH; ++n) {
            if (VAR == 2) { asm volatile("s_waitcnt lgkmcnt(0)" ::: "memory"); __builtin_amdgcn_s_barrier(); asm volatile("" ::: "memory"); continue; }
            const LAS unsigned char* buf = lds + (n & 1) * BUFSZ;
            const int cidx = CIDX(n);
            const u32x4 vc0 = *(const LAS u32x4*)(buf + 66560 + wave * 2048 + lane * 32), vc1 = *(const LAS u32x4*)(buf + 66560 + wave * 2048 + lane * 32 + 16);
#define FR(off, f) (*(const LAS bf16x8*)(buf + (off) + (f) * 1024 + lane * 16))
#define MF(A, B, C) __builtin_amdgcn_mfma_f32_16x16x32_bf16((A), (B), (C), 0, 0, 0)
#define SB_() __builtin_amdgcn_sched_barrier(0)
            bf16x8 fa[8], fb[8];
            f32x4 eg[4], dl[4];
#pragma unroll
            for (int mt = 0; mt < 4; ++mt) { eg[mt] = *(const LAS f32x4*)(buf + 65536 + (16 * mt + 4 * g4) * 4); dl[mt] = *(const LAS f32x4*)(buf + 65536 + 256 + (16 * mt + 4 * g4) * 4); }
            const float egl = *(const LAS float*)(buf + 65536 + 512);
#define RD_KQ(dst, q) do { _Pragma("unroll") for (int mt = 0; mt < 4; ++mt) { dst[mt] = FR(0, mt * 4 + (q)); dst[4 + mt] = FR(32768, mt * 4 + (q)); } } while (0)
#define MM_KQ(src, q) do { _Pragma("unroll") for (int mt = 0; mt < 4; ++mt) { X[mt] = MF(src[mt], Sb[q], X[mt]); O[mt] = MF(src[4 + mt], Sb[q], O[mt]); } } while (0)
            f32x4 X[4], O[4], VN[4];
#pragma unroll
            for (int i = 0; i < 4; ++i) { X[i] = (f32x4){0.f, 0.f, 0.f, 0.f}; O[i] = (f32x4){0.f, 0.f, 0.f, 0.f}; VN[i] = (f32x4){0.f, 0.f, 0.f, 0.f}; }
            bf16x8 Sb[4];
#pragma unroll
            for (int q = 0; q < 4; ++q) Sb[q] = pack44(S[2 * q], S[2 * q + 1]);
            RD_KQ(fa, 0); SB_();
            RD_KQ(fb, 1); SB_(); MM_KQ(fa, 0); SB_();
            RD_KQ(fa, 2); SB_(); MM_KQ(fb, 1); SB_();
            RD_KQ(fb, 3); SB_(); MM_KQ(fa, 2); SB_();
#pragma unroll
            for (int i = 0; i < 8; ++i) fa[i] = FR(49152, i);
            SB_(); MM_KQ(fb, 3); SB_();
#pragma unroll
            for (int mt = 0; mt < 4; ++mt) { const unsigned w0 = (mt < 2 ? vc0 : vc1)[2 * (mt & 1)], w1 = (mt < 2 ? vc0 : vc1)[2 * (mt & 1) + 1];
                X[mt][0] = bflo(w0) - eg[mt][0] * X[mt][0]; X[mt][1] = bfhi(w0) - eg[mt][1] * X[mt][1]; X[mt][2] = bflo(w1) - eg[mt][2] * X[mt][2]; X[mt][3] = bfhi(w1) - eg[mt][3] * X[mt][3]; }
            const bf16x8 Yb0 = pack44(X[0], X[1]), Yb1 = pack44(X[2], X[3]);
            SB_();
#pragma unroll
            for (int i = 0; i < 8; ++i) fb[i] = FR(57344, i);
            SB_();
#pragma unroll
            for (int mt = 0; mt < 4; ++mt) { VN[mt] = MF(fa[mt * 2], Yb0, VN[mt]); VN[mt] = MF(fa[mt * 2 + 1], Yb1, VN[mt]); }
            SB_();
#pragma unroll
            for (int mt = 0; mt < 4; ++mt) O[mt] = O[mt] * eg[mt];
            const bf16x8 Vb0 = pack44(VN[0], VN[1]), Vb1 = pack44(VN[2], VN[3]);
            SB_();
#pragma unroll
            for (int i = 0; i < 8; ++i) fa[i] = FR(16384, i);
            SB_();
#pragma unroll
            for (int mt = 0; mt < 4; ++mt) { O[mt] = MF(fb[mt * 2], Vb0, O[mt]); O[mt] = MF(fb[mt * 2 + 1], Vb1, O[mt]); }
            SB_();
#pragma unroll
            for (int mt = 0; mt < 4; ++mt) VN[mt] = VN[mt] * dl[mt];
            const bf16x8 Vd0 = pack44(VN[0], VN[1]), Vd1 = pack44(VN[2], VN[3]);
#pragma unroll
            for (int i = 0; i < 8; ++i) S[i] = S[i] * egl;
            SB_();
#pragma unroll
            for (int i = 0; i < 8; ++i) fb[i] = FR(16384, 8 + i);
            SB_();
#pragma unroll
            for (int i = 0; i < 4; ++i) { S[i] = MF(fa[i * 2], Vd0, S[i]); S[i] = MF(fa[i * 2 + 1], Vd1, S[i]); }
            SB_();
#pragma unroll
            for (int i = 0; i < 4; ++i) { S[4 + i] = MF(fb[i * 2], Vd0, S[4 + i]); S[4 + i] = MF(fb[i * 2 + 1], Vd1, S[4 + i]); }
            SB_();
            {
                const int row0 = cidx < 4 ? ML + b * CT + cidx * 64 : b * T + (cidx - 4) * 64;
                bf16_t* op = Og + (size_t)(row0 + 4 * g4) * 512;
#pragma unroll
                for (int mt = 0; mt < 4; ++mt)
#pragma unroll
                    for (int t = 0; t < 4; ++t) { if (VAR != 1) op[(size_t)(16 * mt + t) * 512] = (bf16_t)(pkbf_c(O[mt][t], 0.f) & 0xffffu); else asm volatile("" :: "v"(O[mt][t])); }
            }
#undef RD_KQ
#undef MM_KQ
#undef SB_
#undef FR
#undef MF
            asm volatile("s_waitcnt lgkmcnt(0)" ::: "memory"); __builtin_amdgcn_s_barrier(); asm volatile("" ::: "memory");
        }
    }
#undef CIDX
#undef a
}

__device__ __forceinline__ void phase_dn_out(int l) {
    const KArgs ap = get_args();
#define a (*ap)

    const int tid = fresh_tid(), lane = tid & 63, wave = __builtin_amdgcn_readfirstlane(tid >> 6), G = fresh_g(), bx = fresh_bx();
    unsigned char* ws = a.ws;
    const int nrows = (l == DEPTH - 1) ? ML : M;
    const bf16_t* OF = (const bf16_t*)(ws + WS_OF); const bf16_t* OB = (const bf16_t*)(ws + WS_OB);
    const bf16_t* P = (const bf16_t*)(ws + WS_P); bf16_t* CAT = (bf16_t*)(ws + WS_CAT);
    const f32x2 nw = *(const f32x2*)(a.in[I_DNW] + l * 128 + 2 * lane);
    const float* LSE = (const float*)(ws + WS_BA);
    for (int row = wave * G + bx; row < nrows; row += G * 8) {
        f32x2 of[4], ob[4]; unsigned gw[4];
#pragma unroll
        for (int hh = 0; hh < 4; ++hh) { const unsigned wf_ = *(const unsigned*)(OF + (size_t)row * 512 + hh * 128 + 2 * lane), wb_ = *(const unsigned*)(OB + (size_t)row * 512 + hh * 128 + 2 * lane); of[hh] = (f32x2){bflo(wf_), bfhi(wf_)}; ob[hh] = (f32x2){bflo(wb_), bfhi(wb_)};
            gw[hh] = *(const unsigned*)(P + (size_t)row * NP + 2560 + hh * 128 + 2 * lane); }
        u32x4 ap_[4]; float ls_[4];
#pragma unroll
        for (int p = 0; p < 4; ++p) { ap_[p] = (u32x4){0u, 0u, 0u, 0u}; ls_[p] = 0.f; }
        if (row < ML) {
            ap_[0] = *(const u32x4*)(CAT + (size_t)row * 1024 + 8 * lane); ap_[1] = *(const u32x4*)((const bf16_t*)(ws + WS_DQ) + (size_t)row * 512 + 8 * lane);
            ap_[2] = *(const u32x4*)((const bf16_t*)(ws + WS_DK) + (size_t)row * 512 + 8 * lane); ap_[3] = *(const u32x4*)((const bf16_t*)(ws + WS_DV) + (size_t)row * 512 + 8 * lane);
#pragma unroll
            for (int p = 0; p < 4; ++p) ls_[p] = LSE[((size_t)p * ML + row) * 4 + (lane >> 4)]; }
        float o0[4], o1[4], ssq[4];
#pragma unroll
        for (int hh = 0; hh < 4; ++hh) { o0[hh] = of[hh][0] + ob[hh][0]; o1[hh] = of[hh][1] + ob[hh][1]; ssq[hh] = o0[hh] * o0[hh] + o1[hh] * o1[hh]; }
#pragma unroll
        for (int hh = 0; hh < 4; ++hh) ssq[hh] = wave_sum(ssq[hh]);
        float mxv = 0.f;
#pragma unroll
        for (int hh = 0; hh < 4; ++hh) { const float rs = rsqrtf(ssq[hh] * (1.f / 128.f) + EPS); const float g0 = bflo(gw[hh]), g1 = bfhi(gw[hh]);
            o0[hh] = o0[hh] * rs * nw[0] * silu_f(g0); o1[hh] = o1[hh] * rs * nw[1] * silu_f(g1); mxv = fmaxf(mxv, fmaxf(fabsf(o0[hh]), fabsf(o1[hh]))); }
        float av[8];
        if (row < ML) { const float mx = fmaxf(fmaxf(ls_[0], ls_[1]), fmaxf(ls_[2], ls_[3]));
            float w_[4], wsum = 0.f;
#pragma unroll
            for (int p = 0; p < 4; ++p) { w_[p] = __expf(ls_[p] - mx); wsum += w_[p]; }
            const float inv = 1.f / wsum;
#pragma unroll
            for (int i = 0; i < 4; ++i) { float lo = 0.f, hi2 = 0.f;
#pragma unroll
                for (int p = 0; p < 4; ++p) { lo = fmaf(w_[p], bflo(ap_[p][i]), lo); hi2 = fmaf(w_[p], bfhi(ap_[p][i]), hi2); }
                av[2 * i] = lo * inv; av[2 * i + 1] = hi2 * inv; } }
        else { const u32x4 cw_ = *(const u32x4*)(CAT + (size_t)row * 1024 + 8 * lane);
#pragma unroll
            for (int i = 0; i < 4; ++i) { av[2 * i] = bflo(cw_[i]); av[2 * i + 1] = bfhi(cw_[i]); } }
#pragma unroll
        for (int i = 0; i < 8; ++i) mxv = fmaxf(mxv, fabsf(av[i]));
        mxv = fmaxf(wave_max(mxv), 1e-30f);
        const float cinv = 127.f / mxv;
        signed char* crow = (signed char*)(ws + WS_CATQ) + (size_t)row * 1024;
#define Q8_(x) ((unsigned)(int)rintf((x) * cinv) & 255u)
        { u32x2 o; o.x = Q8_(av[0]) | (Q8_(av[1]) << 8) | (Q8_(av[2]) << 16) | (Q8_(av[3]) << 24); o.y = Q8_(av[4]) | (Q8_(av[5]) << 8) | (Q8_(av[6]) << 16) | (Q8_(av[7]) << 24); *(u32x2*)(crow + 8 * lane) = o; }
#pragma unroll
        for (int hh = 0; hh < 4; ++hh) *(unsigned short*)(crow + 512 + hh * 128 + 2 * lane) = (unsigned short)(Q8_(o0[hh]) | (Q8_(o1[hh]) << 8));
#undef Q8_
        if (lane == 0) ((float*)(ws + WS_GB))[(1u << 18) + row] = mxv * (1.f / 127.f);
    }
#undef a
}

#define CE_DESC(a_, b_) do { const float hi_ = fmaxf(a_, b_), lo_ = fminf(a_, b_); a_ = hi_; b_ = lo_; } while (0)
__device__ __forceinline__ void bitonic_sort16_desc(float (&v)[16]) {
#define S2_(i_, j_) CE_DESC(v[i_], v[j_]);
    S2_(0,13) S2_(1,12) S2_(2,15) S2_(3,14) S2_(4,8) S2_(5,6) S2_(7,11) S2_(9,10)
    S2_(0,5) S2_(1,7) S2_(2,9) S2_(3,4) S2_(6,13) S2_(8,14) S2_(10,15) S2_(11,12)
    S2_(0,1) S2_(2,3) S2_(4,5) S2_(6,8) S2_(7,9) S2_(10,11) S2_(12,13) S2_(14,15)
    S2_(0,2) S2_(1,3) S2_(4,10) S2_(5,11) S2_(6,7) S2_(8,9) S2_(12,14) S2_(13,15)
    S2_(1,2) S2_(3,12) S2_(4,6) S2_(5,7) S2_(8,10) S2_(9,11) S2_(13,14)
    S2_(1,4) S2_(2,6) S2_(5,8) S2_(7,10) S2_(9,13) S2_(11,14)
    S2_(2,4) S2_(3,6) S2_(9,12) S2_(11,13)
    S2_(3,5) S2_(6,8) S2_(7,9) S2_(10,12)
    S2_(3,4) S2_(5,6) S2_(7,8) S2_(9,10) S2_(11,12)
    S2_(6,7) S2_(8,9)
#undef S2_
}
__device__ __forceinline__ void merge_top16_desc(float (&lst)[16], const float (&nw)[16]) {
#pragma unroll
    for (int i = 0; i < 16; ++i) lst[i] = fmaxf(lst[i], nw[15 - i]);
#pragma unroll
    for (int j = 8; j > 0; j >>= 1)
#pragma unroll
        for (int i = 0; i < 16; ++i) { const int p = i ^ j; if (p > i) CE_DESC(lst[i], lst[p]); }
}
__device__ __forceinline__ void phase_peer_select(int l) {
    const KArgs ap = get_args();
#define a (*ap)
    const int tid = fresh_tid(), lane = tid & 63, wave = __builtin_amdgcn_readfirstlane(tid >> 6), G = fresh_g(), bx = fresh_bx();
    unsigned char* ws = a.ws;
    const int nrows = (l == DEPTH - 1) ? ML : M;
    const int ntask = (nrows / 32) * 4;
    const bf16_t* Q2 = (const bf16_t*)(ws + WS_P);
    const bf16_t* SKB = (const bf16_t*)(ws + WS_SKB) + (size_t)l * 8 * 2 * 128 * 128;
    int* PIDX = (int*)(ws + WS_PIDX); float* PGATE = (float*)(ws + WS_PGATE);
    const float NEG = -3.0e38f;
    const int r = lane & 31, hi = lane >> 5;
    for (int task = wave * G + bx; task < ntask; task += G * 8) {
        const int tg = task >> 2, hp = task & 3; const int row = tg * 32 + r;
        float mine0[16], mine1[16];
#pragma unroll
        for (int j = 0; j < 16; ++j) { mine0[j] = NEG; mine1[j] = NEG; }
        bf16x8 qA[8], kA[8];
        float lst[16];
#define SEL_QPTR(it_) (Q2 + (size_t)row * 2048 + (2 * hp + ((it_) >> 1)) * 256 + ((it_) & 1) * 128 + 8 * hi)
#define SEL_KPTR(it_, t_) (SKB + (size_t)(((2 * hp + ((it_) >> 1)) * 2 + ((it_) & 1)) * 128 + 32 * (t_) + r) * 128 + 8 * hi)
#define SEL_LDQ(dst, it_) do { const bf16_t* qp_ = SEL_QPTR(it_); _Pragma("unroll") for (int ks = 0; ks < 8; ++ks) dst[ks] = *(const bf16x8*)(qp_ + 16 * ks); } while (0)
#define SEL_LDK(dst, it_, t_) do { const bf16_t* kp_ = SEL_KPTR(it_, t_); _Pragma("unroll") for (int ks = 0; ks < 8; ++ks) dst[ks] = *(const bf16x8*)(kp_ + 16 * ks); } while (0)
#define SEL_RANK(qv, kv, t_) do { f32x16 acc = {}; _Pragma("unroll") for (int ks = 0; ks < 8; ++ks) acc = __builtin_amdgcn_mfma_f32_32x32x16_bf16(kv[ks], qv[ks], acc, 0, 0, 0); \
            const unsigned kb = (unsigned)(32 * (t_) + 4 * hi); float nw_[16]; \
            _Pragma("unroll") for (int i = 0; i < 16; ++i) nw_[i] = __uint_as_float((__float_as_uint(acc[i]) & 0xffffff80u) | (kb + (unsigned)((i & 3) + 8 * (i >> 2)))); \
            bitonic_sort16_desc(nw_); merge_top16_desc(lst, nw_); } while (0)
#define SB_() __builtin_amdgcn_sched_barrier(0)
#pragma unroll
        for (int j = 0; j < 16; ++j) lst[j] = NEG;
#pragma unroll 1
        for (int it = 0; it < 4; ++it) {
            SEL_LDQ(qA, it);
#pragma unroll 1
            for (int t = 0; t < 4; ++t) { SEL_LDK(kA, it, t); SEL_RANK(qA, kA, t); }
            float oth[16];
#pragma unroll
            for (int j = 0; j < 16; ++j) { auto rr = __builtin_amdgcn_permlane32_swap(__float_as_uint(lst[j]), __float_as_uint(lst[j]), false, false); oth[j] = __uint_as_float(hi ? rr[0] : rr[1]); }
            merge_top16_desc(lst, oth);
            const bool k0 = ((it >> 1) == hi) && ((it & 1) == 0), k1 = ((it >> 1) == hi) && ((it & 1) == 1);
#pragma unroll
            for (int j = 0; j < 16; ++j) { mine0[j] = k0 ? lst[j] : mine0[j]; mine1[j] = k1 ? lst[j] : mine1[j]; lst[j] = NEG; }
        }
#undef SB_
#undef SEL_QPTR
#undef SEL_KPTR
#undef SEL_LDQ
#undef SEL_LDK
#undef SEL_RANK
        const int h = 2 * hp + hi;
        float ts[16];
#pragma unroll
        for (int j = 0; j < 16; ++j) ts[j] = NEG;
#pragma unroll
        for (int i = 0; i < 16; ++i)
#pragma unroll
            for (int j = 0; j < 16; ++j) if ((i + 1) * (j + 1) <= 16) {
                const unsigned b0 = __float_as_uint(mine0[i]), b1 = __float_as_uint(mine1[j]);
                const float c = __uint_as_float(b0 & 0xffffff80u) + __uint_as_float(b1 & 0xffffff80u);
                float x = __uint_as_float((__float_as_uint(c) & 0xffffc000u) | ((b0 & 127u) << 7) | (b1 & 127u));
#pragma unroll
                for (int t = 0; t < 16; ++t) { const float hv = fmaxf(ts[t], x); x = fminf(ts[t], x); ts[t] = hv; }
            }
        int te[16]; float ex[16], sum = 0.f;
        const float tmax = __uint_as_float(__float_as_uint(ts[0]) & 0xffffc000u);
#pragma unroll
        for (int t = 0; t < 16; ++t) { const unsigned bt = __float_as_uint(ts[t]); te[t] = (int)(bt & 0x3fffu); ex[t] = __expf(__uint_as_float(bt & 0xffffc000u) - tmax); sum += ex[t]; }
        const float inv = 1.f / sum;
        unsigned short* ip = (unsigned short*)PIDX + (size_t)row * 128 + h * 16; float* gp = PGATE + (size_t)row * 128 + h * 16;
#pragma unroll
        for (int t = 0; t < 16; t += 8) *(u32x4*)(ip + t) = (u32x4){(unsigned)te[t] | ((unsigned)te[t + 1] << 16), (unsigned)te[t + 2] | ((unsigned)te[t + 3] << 16), (unsigned)te[t + 4] | ((unsigned)te[t + 5] << 16), (unsigned)te[t + 6] | ((unsigned)te[t + 7] << 16)};
#pragma unroll
        for (int t = 0; t < 16; t += 4) *(f32x4*)(gp + t) = (f32x4){ex[t] * inv, ex[t + 1] * inv, ex[t + 2] * inv, ex[t + 3] * inv};
    }
#undef a
}

template <bool WR, int GV = 0>
__device__ __forceinline__ void phase_peer_gather(int l, LAS unsigned char* lds) {
    const KArgs ap = get_args();
#define a (*ap)
    const int tid = fresh_tid(), lane = tid & 63, wave = __builtin_amdgcn_readfirstlane(tid >> 6), G = fresh_g(), bx = fresh_bx();
    unsigned char* ws = a.ws;
    const int nrows = (l == DEPTH - 1) ? ML : M;
    const unsigned char* UB = ws + WS_UB + (size_t)(l & 1) * TAB_SET; const unsigned char* VB = UB + 1024;
    const float* USC = (const float*)(ws + WS_USC) + (l & 1) * 2 * NEXP; const float* VSC = USC + NEXP;
    const int* PIDX = (const int*)(ws + WS_PIDX); const float* PGATE = (const float*)(ws + WS_PGATE);
    const float* modl = (const float*)(ws + WS_MOD) + (size_t)l * 3 * 6144 + 5120;
    const bool fuse = WR && (l + 1 < DEPTH);
    LAS float* wsk = (LAS float*)lds;
    if (fuse) { const float* src = (const float*)(ws + WS_WSK) + (size_t)(l + 1) * 16384; for (int i = tid; i < 16384 / 4; i += 512) ((LAS f32x4*)wsk)[i] = ((const f32x4*)src)[i]; __syncthreads(); }
    const float* nw1 = a.in[I_N1W] + (l + 1 < DEPTH ? l + 1 : l) * 1024 + 16 * lane;
    const float* modn = (const float*)(ws + WS_MOD) + (size_t)(l + 1 < DEPTH ? l + 1 : l) * 3 * 6144;
    for (int row = wave * G + bx; row < nrows; row += G * 8) {
        float hv[16], out[16];
        { const u32x4 hw = *(const u32x4*)((const signed char*)(ws + WS_H) + (size_t)row * D + 16 * lane); const float hsc = ((const float*)(ws + WS_GB))[row];
#pragma unroll
          for (int q = 0; q < 4; ++q) { const int w = (int)hw[q]; hv[4 * q + 0] = (float)((w << 24) >> 24) * hsc; hv[4 * q + 1] = (float)((w << 16) >> 24) * hsc; hv[4 * q + 2] = (float)((w << 8) >> 24) * hsc; hv[4 * q + 3] = (float)(w >> 24) * hsc; } }
        float hs = 0.f;
#pragma unroll
        for (int i = 0; i < 16; ++i) { out[i] = 0.f; hs += hv[i]; }
        const float hsum128 = 128.f * wave_sum(hs);
        float wacc = 0.f;
        const int id0 = PIDX[(size_t)row * 128 + lane], id1 = PIDX[(size_t)row * 128 + 64 + lane];
        const float gt0 = PGATE[(size_t)row * 128 + lane], gt1 = PGATE[(size_t)row * 128 + 64 + lane];
        const float us0 = USC[id0], us1 = USC[id1], vs0 = VSC[id0], vs1 = VSC[id1];
        for (int e0 = 0; e0 < 128; e0 += 8) {
            u32x4 uw[8], vw[8]; float gte[8], use[8], vse[8];
#pragma unroll
            for (int j = 0; j < 8; ++j) { const int e = e0 + j; const int id = __builtin_amdgcn_readlane(e0 < 64 ? id0 : id1, e & 63);
                gte[j] = __builtin_bit_cast(float, __builtin_amdgcn_readlane(__builtin_bit_cast(int, e0 < 64 ? gt0 : gt1), e & 63));
                use[j] = __builtin_bit_cast(float, __builtin_amdgcn_readlane(__builtin_bit_cast(int, e0 < 64 ? us0 : us1), e & 63));
                vse[j] = __builtin_bit_cast(float, __builtin_amdgcn_readlane(__builtin_bit_cast(int, e0 < 64 ? vs0 : vs1), e & 63));
                uw[j] = *(const u32x4*)(UB + (size_t)id * 2048 + 16 * lane); vw[j] = *(const u32x4*)(VB + (size_t)id * 2048 + 16 * lane); }
#pragma unroll
            for (int j = 0; j < 8; ++j) {
                float d0 = 0.f, d1 = 0.f;
#pragma unroll
                for (int q = 0; q < 4; ++q) { const unsigned w = uw[j][q];
                    d0 = fmaf((float)(w & 255u), hv[4 * q + 0], d0); d1 = fmaf((float)((w >> 8) & 255u), hv[4 * q + 1], d1);
                    d0 = fmaf((float)((w >> 16) & 255u), hv[4 * q + 2], d0); d1 = fmaf((float)(w >> 24), hv[4 * q + 3], d1); }
                const float dsum = (wave_sum(d0 + d1) - hsum128) * use[j];
                const float act = 0.5f * dsum * (1.f + erff(dsum * 0.70710678118654752f));
                const float wgt = gte[j] * act * vse[j];
                wacc += wgt;
                if (GV == 1) { asm volatile("" :: "v"(vw[j])); out[0] += wgt; } else
#pragma unroll
                for (int q = 0; q < 4; ++q) { const unsigned w = vw[j][q];
                    out[4 * q + 0] = fmaf(wgt, (float)(w & 255u), out[4 * q + 0]); out[4 * q + 1] = fmaf(wgt, (float)((w >> 8) & 255u), out[4 * q + 1]);
                    out[4 * q + 2] = fmaf(wgt, (float)((w >> 16) & 255u), out[4 * q + 2]); out[4 * q + 3] = fmaf(wgt, (float)(w >> 24), out[4 * q + 3]); }
            }
        }
        const float corr = 128.f * wacc;
        float* xr; int mrow;
        if (row < ML) { xr = a.out + (size_t)row * D; mrow = row >= T ? 1 : 0; } else { xr = (float*)(ws + WS_CTXX) + (size_t)(row - ML) * D; mrow = 2; }
        const float* g2 = modl + mrow * 6144 + 16 * lane;
        f32x4 xn[4];
#pragma unroll
        for (int i = 0; i < 4; ++i) { const f32x4 x = *(const f32x4*)(xr + 16 * lane + 4 * i), g = *(const f32x4*)(g2 + 4 * i);
            xn[i] = x + g * (f32x4){out[4 * i] - corr, out[4 * i + 1] - corr, out[4 * i + 2] - corr, out[4 * i + 3] - corr};
            if (WR) *(f32x4*)(xr + 16 * lane + 4 * i) = xn[i]; else asm volatile("" :: "v"(xn[i])); }
        if (fuse) {
            float ss = 0.f;
#pragma unroll
            for (int i = 0; i < 4; ++i) ss += (xn[i][0] * xn[i][0] + xn[i][1] * xn[i][1]) + (xn[i][2] * xn[i][2] + xn[i][3] * xn[i][3]);
            const float rstd = rsqrtf(wave_sum(ss) * (1.f / D) + EPS);
            const float* md = modn + mrow * 6144 + 16 * lane;
#pragma unroll
            for (int i = 0; i < 4; ++i) { const f32x4 nwv = *(const f32x4*)(nw1 + 4 * i), sc = *(const f32x4*)(md + 1024 + 4 * i), sh = *(const f32x4*)(md + 4 * i);
                xn[i] = xn[i] * rstd * nwv * (sc + 1.f) + sh; }
            { float hmx = 0.f;
#pragma unroll
              for (int i = 0; i < 4; ++i) hmx = fmaxf(hmx, fmaxf(fmaxf(fabsf(xn[i][0]), fabsf(xn[i][1])), fmaxf(fabsf(xn[i][2]), fabsf(xn[i][3]))));
              hmx = fmaxf(wave_max(hmx), 1e-30f); const float hinv = 127.f / hmx;
              u32x4 o;
#pragma unroll
              for (int i = 0; i < 4; ++i) o[i] = ((unsigned)(int)rintf(xn[i][0] * hinv) & 255u) | (((unsigned)(int)rintf(xn[i][1] * hinv) & 255u) << 8) | (((unsigned)(int)rintf(xn[i][2] * hinv) & 255u) << 16) | (((unsigned)(int)rintf(xn[i][3] * hinv) & 255u) << 24);
              *(u32x4*)((signed char*)(ws + WS_H) + (size_t)row * D + 16 * lane) = o;
              if (lane == 0) ((float*)(ws + WS_GB))[row] = hmx * (1.f / 127.f); }
            float p[16];
#pragma unroll
            for (int c = 0; c < 16; ++c) { float q = 0.f;
#pragma unroll
                for (int i = 0; i < 4; ++i) { const f32x4 w = *(const LAS f32x4*)(wsk + c * 1024 + 16 * lane + 4 * i); q += (xn[i][0] * w[0] + xn[i][1] * w[1]) + (xn[i][2] * w[2] + xn[i][3] * w[3]); }
                p[c] = q; }
            { const bool hb = (lane & 32) != 0;
#pragma unroll
              for (int c = 0; c < 8; ++c) { const float keep = hb ? p[c + 8] : p[c], send = hb ? p[c] : p[c + 8]; p[c] = keep + lane_xor<32>(send); } }
            { const bool hb = (lane & 16) != 0;
#pragma unroll
              for (int c = 0; c < 4; ++c) { const float keep = hb ? p[c + 4] : p[c], send = hb ? p[c] : p[c + 4]; p[c] = keep + lane_xor<16>(send); } }
            { const bool hb = (lane & 8) != 0;
#pragma unroll
              for (int c = 0; c < 2; ++c) { const float keep = hb ? p[c + 2] : p[c], send = hb ? p[c] : p[c + 2]; p[c] = keep + lane_xor<8>(send); } }
            { const bool hb = (lane & 4) != 0; const float keep = hb ? p[1] : p[0], send = hb ? p[0] : p[1]; p[0] = keep + lane_xor<4>(send); }
            p[0] += lane_xor<2>(p[0]); p[0] += lane_xor<1>(p[0]);
            if ((lane & 3) == 0) { const int c = ((lane >> 5) & 1) * 8 + ((lane >> 4) & 1) * 4 + ((lane >> 3) & 1) * 2 + ((lane >> 2) & 1); ((float*)(ws + WS_BA))[(size_t)row * 16 + c] = p[0]; }
        }
    }
    if (fuse) __syncthreads();
}
#undef a
constexpr size_t WS_PART = WS_P;
static_assert(WS_PART + 8 * (size_t)M * 1024 * 2 <= WS_GB, "partials region");
constexpr int GP_ITEM = 16;
struct GpMeta { int id0, id1; float gt0, gt1; u32x4 hw; float hsc; };
__device__ __forceinline__ void phase_peer_gpart(int l, LAS unsigned char* lds) {
    const KArgs ap = get_args();
#define a (*ap)
    const int tid = fresh_tid(), lane = tid & 63, wave = __builtin_amdgcn_readfirstlane(tid >> 6);
    unsigned char* ws = a.ws;
    const int nrows = (l == DEPTH - 1) ? ML : M;
    const int nitem = nrows / GP_ITEM;
    const unsigned char* UB = ws + WS_UB + (size_t)(l & 1) * TAB_SET; const unsigned char* VB = UB + 1024;
    const f32x2* SC2 = (const f32x2*)(ws + WS_USC) + (size_t)(l & 1) * NEXP;
    const int* PIDX = (const int*)(ws + WS_PIDX); const float* PGATE = (const float*)(ws + WS_PGATE);
    LAS u32x4* lst0 = (LAS u32x4*)lds + wave * 256;
    const int eidx = ((lane >> 5) & 1) * 4 + ((lane >> 4) & 1) * 2 + ((lane >> 3) & 1);
    const int x = (int)(xb_xcc_id() & 7u);
#define GP_LOAD_META(m_, row_) do { const int rw_ = (row_); (m_).id0 = PIDX[(size_t)rw_ * 128 + lane]; (m_).id1 = PIDX[(size_t)rw_ * 128 + 64 + lane]; (m_).gt0 = PGATE[(size_t)rw_ * 128 + lane]; (m_).gt1 = PGATE[(size_t)rw_ * 128 + 64 + lane]; \
        (m_).hw = *(const u32x4*)((const signed char*)(ws + WS_H) + (size_t)rw_ * D + 16 * lane); (m_).hsc = ((const float*)(ws + WS_GB))[rw_]; } while (0)
#define GP_LOAD_SC(sa_, sb_, m_) do { sa_ = (f32x2){0.f, 0.f}; sb_ = (f32x2){0.f, 0.f}; if (((m_).id0 >> 11) == p) sa_ = SC2[(m_).id0]; if (((m_).id1 >> 11) == p) sb_ = SC2[(m_).id1]; } while (0)
#define GP_BUILD(cnt_, m_, sa_, sb_, buf_) do { const bool s0_ = ((m_).id0 >> 11) == p, s1_ = ((m_).id1 >> 11) == p; const unsigned long long m0_ = __ballot(s0_), m1_ = __ballot(s1_); \
        const int c0_ = __builtin_popcountll(m0_); cnt_ = __builtin_amdgcn_readfirstlane(c0_ + __builtin_popcountll(m1_)); \
        const int r0_ = (int)__builtin_amdgcn_mbcnt_hi((unsigned)(m0_ >> 32), __builtin_amdgcn_mbcnt_lo((unsigned)m0_, 0u)); \
        const int r1_ = c0_ + (int)__builtin_amdgcn_mbcnt_hi((unsigned)(m1_ >> 32), __builtin_amdgcn_mbcnt_lo((unsigned)m1_, 0u)); \
        LAS u32x4* lb_ = lst0 + (buf_) * 128; \
        if (s0_) lb_[r0_] = (u32x4){(unsigned)(m_).id0, __float_as_uint((m_).gt0 * sa_[1]), __float_as_uint(sa_[0]), 0u}; \
        if (s1_) lb_[r1_] = (u32x4){(unsigned)(m_).id1, __float_as_uint((m_).gt1 * sb_[1]), __float_as_uint(sb_[0]), 0u}; } while (0)
#pragma unroll 1
    for (int pp = 0; pp < 8; ++pp) {
        const int p = (x + pp) & 7;
        unsigned* ctr = (unsigned*)(ws + WS_CTL) + 16384 + (l * 8 + p) * 64;
        unsigned* part = (unsigned*)(ws + WS_PART + (size_t)p * M * 2048);
        unsigned tk = 0; if (lane == 0) tk = __hip_atomic_fetch_add(ctr, 1u, __ATOMIC_RELAXED, __HIP_MEMORY_SCOPE_AGENT);
        int it = __builtin_amdgcn_readfirstlane((int)tk);
#pragma unroll 1
        while (it < nitem) {
            unsigned tn = 0; if (lane == 0) tn = __hip_atomic_fetch_add(ctr, 1u, __ATOMIC_RELAXED, __HIP_MEMORY_SCOPE_AGENT);
            const int row0 = it * GP_ITEM, rowl = row0 + GP_ITEM - 1;
            GpMeta m1, m2, m3; f32x2 sa1, sb1, sa2, sb2; int c_cur, c_nxt; u32x4 hw_cur; float hsc_cur;
            GP_LOAD_META(m1, row0); GP_LOAD_META(m2, min(row0 + 1, rowl)); GP_LOAD_META(m3, min(row0 + 2, rowl));
            GP_LOAD_SC(sa1, sb1, m1);
            GP_BUILD(c_cur, m1, sa1, sb1, 0); hw_cur = m1.hw; hsc_cur = m1.hsc;
            GP_LOAD_SC(sa1, sb1, m2);
            m1 = m2; m2 = m3;
            GP_LOAD_META(m3, min(row0 + 3, rowl));
#pragma unroll 1
            for (int i = 0; i < GP_ITEM; ++i) {
                const int row = row0 + i;
                GP_BUILD(c_nxt, m1, sa1, sb1, (i + 1) & 1);
                const u32x4 hw_nxt = m1.hw; const float hsc_nxt = m1.hsc;
                GP_LOAD_SC(sa2, sb2, m2);
                m1 = m2; sa1 = sa2; sb1 = sb2; m2 = m3;
                GP_LOAD_META(m3, min(row + 4, rowl));
                LAS u32x4* lst = lst0 + (i & 1) * 128;
                const int c = c_cur; const u32x4 hw = hw_cur; const float hsc = hsc_cur;
                f32x2 o2[8];
#pragma unroll
                for (int k = 0; k < 8; ++k) o2[k] = (f32x2){0.f, 0.f};
                float wacc = 0.f;
#pragma unroll 1
                for (int e = 0; e < c; e += 8) {
                    u32x4 uw[8], vw[8];
#pragma unroll
                    for (int j = 0; j < 8; ++j) { const int sl = min(e + j, c - 1);
                        const int id = __builtin_amdgcn_readfirstlane((int)lst[sl][0]);
                        uw[j] = *(const u32x4*)(UB + (size_t)id * 2048 + 16 * lane); vw[j] = *(const u32x4*)(VB + (size_t)id * 2048 + 16 * lane); }
                    const int ms = e + eidx; const u32x4 en = lst[min(ms, c - 1)];
                    float pd[8];
#pragma unroll
                    for (int j = 0; j < 8; ++j) { int d = 0;
#pragma unroll
                        for (int q = 0; q < 4; ++q) d = __builtin_amdgcn_sdot4((int)uw[j][q], (int)hw[q], d, false);
                        pd[j] = (float)d; }
                    { const bool hb = (lane & 32) != 0;
#pragma unroll
                      for (int j = 0; j < 4; ++j) { const float keep = hb ? pd[j + 4] : pd[j], send = hb ? pd[j] : pd[j + 4]; pd[j] = keep + lane_xor<32>(send); } }
                    { const bool hb = (lane & 16) != 0;
#pragma unroll
                      for (int j = 0; j < 2; ++j) { const float keep = hb ? pd[j + 2] : pd[j], send = hb ? pd[j] : pd[j + 2]; pd[j] = keep + lane_xor<16>(send); } }
                    { const bool hb = (lane & 8) != 0; const float keep = hb ? pd[1] : pd[0], send = hb ? pd[0] : pd[1]; pd[0] = keep + lane_xor<8>(send); }
                    pd[0] += lane_xor<4>(pd[0]); pd[0] += lane_xor<2>(pd[0]); pd[0] += lane_xor<1>(pd[0]);
                    const float dsum = pd[0] * (__uint_as_float(en[2]) * hsc);
                    const float act = 0.5f * dsum * (1.f + erff(dsum * 0.70710678118654752f));
                    const float wgt = ms < c ? __uint_as_float(en[1]) * act : 0.f;
                    wacc += wgt;
#pragma unroll
                    for (int j = 0; j < 8; ++j) {
                        const float wj = __builtin_bit_cast(float, __builtin_amdgcn_readlane(__builtin_bit_cast(int, wgt), 32 * ((j >> 2) & 1) + 16 * ((j >> 1) & 1) + 8 * (j & 1)));
                        const f32x2 ww = {wj, wj};
#pragma unroll
                        for (int q = 0; q < 4; ++q) { const unsigned w = vw[j][q];
                            const f32x2 v01 = {(float)(w & 255u), (float)((w >> 8) & 255u)}, v23 = {(float)((w >> 16) & 255u), (float)(w >> 24)};
                            o2[2 * q] = __builtin_elementwise_fma(ww, v01, o2[2 * q]); o2[2 * q + 1] = __builtin_elementwise_fma(ww, v23, o2[2 * q + 1]); }
                    }
                }
                const float corr = 16.f * wave_sum(wacc);
                u32x4 w0, w1;
#pragma unroll
                for (int k = 0; k < 4; ++k) { w0[k] = pkbf_c(o2[k][0] - corr, o2[k][1] - corr); w1[k] = pkbf_c(o2[4 + k][0] - corr, o2[4 + k][1] - corr); }
                unsigned* dst = part + (size_t)row * 512 + 8 * lane;
                __builtin_nontemporal_store(w0, (u32x4*)dst); __builtin_nontemporal_store(w1, (u32x4*)(dst + 4));
                c_cur = c_nxt; hw_cur = hw_nxt; hsc_cur = hsc_nxt;
            }
            it = __builtin_amdgcn_readfirstlane((int)tn);
        }
    }
#undef GP_LOAD_META
#undef GP_LOAD_SC
#undef GP_BUILD
#undef a
}

__device__ __forceinline__ void phase_peer_combine(int l, LAS unsigned char* lds) {
    const KArgs ap = get_args();
#define a (*ap)
    const int tid = fresh_tid(), lane = tid & 63, wave = __builtin_amdgcn_readfirstlane(tid >> 6), G = fresh_g(), bx = fresh_bx();
    unsigned char* ws = a.ws;
    const int nrows = (l == DEPTH - 1) ? ML : M;
    const float* modl = (const float*)(ws + WS_MOD) + (size_t)l * 3 * 6144 + 5120;
    const bool fuse = (l + 1 < DEPTH);
    LAS float* wsk = (LAS float*)lds;
    if (fuse) { const float* src = (const float*)(ws + WS_WSK) + (size_t)(l + 1) * 16384; for (int i = tid; i < 16384 / 4; i += 512) ((LAS f32x4*)wsk)[i] = ((const f32x4*)src)[i]; __syncthreads(); }
    const float* nw1 = a.in[I_N1W] + (l + 1 < DEPTH ? l + 1 : l) * 1024 + 16 * lane;
    const float* modn = (const float*)(ws + WS_MOD) + (size_t)(l + 1 < DEPTH ? l + 1 : l) * 3 * 6144;
    for (int row = wave * G + bx; row < nrows; row += G * 8) {
        float out[16];
#pragma unroll
        for (int i = 0; i < 16; ++i) out[i] = 0.f;
#pragma unroll
        for (int p = 0; p < 8; ++p) { const unsigned* src = (const unsigned*)(ws + WS_PART + (size_t)p * M * 2048) + (size_t)row * 512 + 8 * lane;
            const u32x4 w0 = __builtin_nontemporal_load((const u32x4*)src), w1 = __builtin_nontemporal_load((const u32x4*)(src + 4));
#pragma unroll
            for (int k = 0; k < 4; ++k) { out[2 * k] += bflo(w0[k]); out[2 * k + 1] += bfhi(w0[k]); out[8 + 2 * k] += bflo(w1[k]); out[8 + 2 * k + 1] += bfhi(w1[k]); } }
        float* xr; int mrow;
        if (row < ML) { xr = a.out + (size_t)row * D; mrow = row >= T ? 1 : 0; } else { xr = (float*)(ws + WS_CTXX) + (size_t)(row - ML) * D; mrow = 2; }
        const float* g2 = modl + mrow * 6144 + 16 * lane;
        f32x4 xn[4];
#pragma unroll
        for (int i = 0; i < 4; ++i) { const f32x4 x = *(const f32x4*)(xr + 16 * lane + 4 * i), g = *(const f32x4*)(g2 + 4 * i);
            xn[i] = x + g * (f32x4){out[4 * i], out[4 * i + 1], out[4 * i + 2], out[4 * i + 3]};
            *(f32x4*)(xr + 16 * lane + 4 * i) = xn[i]; }
        if (fuse) {
            float ss = 0.f;
#pragma unroll
            for (int i = 0; i < 4; ++i) ss += (xn[i][0] * xn[i][0] + xn[i][1] * xn[i][1]) + (xn[i][2] * xn[i][2] + xn[i][3] * xn[i][3]);
            const float rstd = rsqrtf(wave_sum(ss) * (1.f / D) + EPS);
            const float* md = modn + mrow * 6144 + 16 * lane;
#pragma unroll
            for (int i = 0; i < 4; ++i) { const f32x4 nwv = *(const f32x4*)(nw1 + 4 * i), sc = *(const f32x4*)(md + 1024 + 4 * i), sh = *(const f32x4*)(md + 4 * i);
                xn[i] = xn[i] * rstd * nwv * (sc + 1.f) + sh; }
            { float hmx = 0.f;
#pragma unroll
              for (int i = 0; i < 4; ++i) hmx = fmaxf(hmx, fmaxf(fmaxf(fabsf(xn[i][0]), fabsf(xn[i][1])), fmaxf(fabsf(xn[i][2]), fabsf(xn[i][3]))));
              hmx = fmaxf(wave_max(hmx), 1e-30f); const float hinv = 127.f / hmx;
              u32x4 o;
#pragma unroll
              for (int i = 0; i < 4; ++i) o[i] = ((unsigned)(int)rintf(xn[i][0] * hinv) & 255u) | (((unsigned)(int)rintf(xn[i][1] * hinv) & 255u) << 8) | (((unsigned)(int)rintf(xn[i][2] * hinv) & 255u) << 16) | (((unsigned)(int)rintf(xn[i][3] * hinv) & 255u) << 24);
              *(u32x4*)((signed char*)(ws + WS_H) + (size_t)row * D + 16 * lane) = o;
              if (lane == 0) ((float*)(ws + WS_GB))[row] = hmx * (1.f / 127.f); }
            float p[16];
#pragma unroll
            for (int c = 0; c < 16; ++c) { float q = 0.f;
#pragma unroll
                for (int i = 0; i < 4; ++i) { const f32x4 w = *(const LAS f32x4*)(wsk + c * 1024 + 16 * lane + 4 * i); q += (xn[i][0] * w[0] + xn[i][1] * w[1]) + (xn[i][2] * w[2] + xn[i][3] * w[3]); }
                p[c] = q; }
            { const bool hb = (lane & 32) != 0;
#pragma unroll
              for (int c = 0; c < 8; ++c) { const float keep = hb ? p[c + 8] : p[c], send = hb ? p[c] : p[c + 8]; p[c] = keep + lane_xor<32>(send); } }
            { const bool hb = (lane & 16) != 0;
#pragma unroll
              for (int c = 0; c < 4; ++c) { const float keep = hb ? p[c + 4] : p[c], send = hb ? p[c] : p[c + 4]; p[c] = keep + lane_xor<16>(send); } }
            { const bool hb = (lane & 8) != 0;
#pragma unroll
              for (int c = 0; c < 2; ++c) { const float keep = hb ? p[c + 2] : p[c], send = hb ? p[c] : p[c + 2]; p[c] = keep + lane_xor<8>(send); } }
            { const bool hb = (lane & 4) != 0; const float keep = hb ? p[1] : p[0], send = hb ? p[0] : p[1]; p[0] = keep + lane_xor<4>(send); }
            p[0] += lane_xor<2>(p[0]); p[0] += lane_xor<1>(p[0]);
            if ((lane & 3) == 0) { const int c = ((lane >> 5) & 1) * 8 + ((lane >> 4) & 1) * 4 + ((lane >> 3) & 1) * 2 + ((lane >> 2) & 1); ((float*)(ws + WS_BA))[(size_t)row * 16 + c] = p[0]; }
        }
    }
    if (fuse) __syncthreads();
#undef a
}
constexpr size_t WS_PD = WS_REC;
constexpr size_t WS_PW = WS_REC + 8 * (size_t)M * 128 * 4;
constexpr size_t WS_PC = WS_PW + (size_t)M * 128;
static_assert(WS_PC + (size_t)M * 8 * 4 <= WS_END, "sliced gather scratch");
constexpr int GS_ITEM = 8;
template <int PH>
__device__ __forceinline__ void phase_peer_slice(int l, int cslot) {
    const KArgs ap = get_args();
#define a (*ap)
    const int tid = fresh_tid(), lane = tid & 63;
    unsigned char* ws = a.ws;
    const int nrows = (l == DEPTH - 1) ? ML : M;
    const int nitem = nrows / GS_ITEM;
    const unsigned char* TAB = ws + WS_UB + (size_t)(l & 1) * TAB_SET + (PH ? (size_t)NEXP * 1024 : 0);
    const int* PIDX = (const int*)(ws + WS_PIDX);
    const unsigned char* PW = ws + WS_PW; const float* PC = (const float*)(ws + WS_PC);
    const float* modl = (const float*)(ws + WS_MOD) + (size_t)l * 3 * 6144 + 5120;
    const int g = lane >> 3, i8 = lane & 7;
    const int x = (int)(xb_xcc_id() & 7u);
#pragma unroll 1
    for (int pp = 0; pp < 8; ++pp) {
        const int p = (x + pp) & 7;
        unsigned* ctr = (unsigned*)(ws + WS_CTL) + 16384 + ((l * 2 + PH) * 8 + p) * 64 + cslot * 8192;
        const unsigned char* tb = TAB + (size_t)p * NEXP * 128 + 16 * i8;
        unsigned tk = 0; if (lane == 0) tk = __hip_atomic_fetch_add(ctr, 1u, __ATOMIC_RELAXED, __HIP_MEMORY_SCOPE_AGENT);
        int it = __builtin_amdgcn_readfirstlane((int)tk);
        if (it < nitem) {
            unsigned tn = 0; if (lane == 0) tn = __hip_atomic_fetch_add(ctr, 1u, __ATOMIC_RELAXED, __HIP_MEMORY_SCOPE_AGENT);
            const int row0 = it * GS_ITEM;
            u32x4 idc[2], idn[2], ra[8], rb[8]; u32x4 wc, wn; float sc_c, sc_n; u32x4 hc, hn;
#define GS_META(ids_, wts_, wsc_, h_, row_) do { const int rw_ = (row_); const u32x4* ip_ = (const u32x4*)((const unsigned short*)PIDX + (size_t)rw_ * 128 + 16 * g); ids_[0] = ip_[0]; ids_[1] = ip_[1]; \
                if (PH) { wts_ = *(const u32x4*)(PW + (size_t)rw_ * 128 + 16 * g); wsc_ = PC[rw_]; } \
                else h_ = *(const u32x4*)((const signed char*)(ws + WS_H) + (size_t)rw_ * D + 128 * p + 16 * i8); } while (0)
#define GS_ROWS(dst_, ids_, hf_) do { _Pragma("unroll") for (int k_ = 0; k_ < 8; ++k_) dst_[k_] = *(const u32x4*)(tb + (size_t)((ids_[hf_][k_ >> 1] >> (16 * (k_ & 1))) & 0xffffu) * 128); } while (0)
            GS_META(idc, wc, sc_c, hc, row0);
            GS_ROWS(ra, idc, 0);
            GS_META(idn, wn, sc_n, hn, row0 + 1);
            int i = 0, tnv = 0x7fffffff;
#pragma unroll 1
            for (;;) {
                if (i == GS_ITEM - 2) tnv = __builtin_amdgcn_readfirstlane((int)tn);
                const int row = it * GS_ITEM + i;
                const int r2 = (i + 2 < GS_ITEM) ? row + 2 : (tnv < nitem ? tnv * GS_ITEM + (i + 2 - GS_ITEM) : row);
                GS_ROWS(rb, idc, 1);
                if (PH == 0) {
                    int d[16];
#pragma unroll
                    for (int k = 0; k < 8; ++k) { int s_ = 0;
#pragma unroll
                        for (int q = 0; q < 4; ++q) s_ = __builtin_amdgcn_sdot4((int)ra[k][q], (int)hc[q], s_, false);
                        d[k] = s_; }
                    GS_ROWS(ra, idn, 0);
#pragma unroll
                    for (int k = 0; k < 8; ++k) { int s_ = 0;
#pragma unroll
                        for (int q = 0; q < 4; ++q) s_ = __builtin_amdgcn_sdot4((int)rb[k][q], (int)hc[q], s_, false);
                        d[8 + k] = s_; }
#define GS_IX(v_, K_) __builtin_bit_cast(int, lane_xor<K_>(__builtin_bit_cast(float, v_)))
                    { const bool hb = (lane & 4) != 0;
#pragma unroll
                      for (int j = 0; j < 8; ++j) { const int keep = hb ? d[j + 8] : d[j], send = hb ? d[j] : d[j + 8]; d[j] = keep + GS_IX(send, 4); } }
                    { const bool hb = (lane & 2) != 0;
#pragma unroll
                      for (int j = 0; j < 4; ++j) { const int keep = hb ? d[j + 4] : d[j], send = hb ? d[j] : d[j + 4]; d[j] = keep + GS_IX(send, 2); } }
                    { const bool hb = (lane & 1) != 0;
#pragma unroll
                      for (int j = 0; j < 2; ++j) { const int keep = hb ? d[j + 2] : d[j], send = hb ? d[j] : d[j + 2]; d[j] = keep + GS_IX(send, 1); } }
#undef GS_IX
                    u32x2 o = {(unsigned)d[0], (unsigned)d[1]};
                    __builtin_nontemporal_store(o, (u32x2*)((int*)(ws + WS_PD) + ((size_t)p * M + row) * 128 + 2 * lane));
                } else {
                    int oi[16];
#pragma unroll
                    for (int k = 0; k < 16; ++k) oi[k] = 0;
#define GS_QUAD(rr_, qd_, wd_) do { _Pragma("unroll") for (int q_ = 0; q_ < 4; ++q_) { \
                        const unsigned r0_ = rr_[4 * (qd_) + 0][q_], r1_ = rr_[4 * (qd_) + 1][q_], r2_ = rr_[4 * (qd_) + 2][q_], r3_ = rr_[4 * (qd_) + 3][q_]; \
                        const unsigned t0_ = __builtin_amdgcn_perm(r1_, r0_, 0x05010400u), t1_ = __builtin_amdgcn_perm(r1_, r0_, 0x07030602u), t2_ = __builtin_amdgcn_perm(r3_, r2_, 0x05010400u), t3_ = __builtin_amdgcn_perm(r3_, r2_, 0x07030602u); \
                        oi[4 * q_ + 0] = __builtin_amdgcn_sdot4((int)__builtin_amdgcn_perm(t2_, t0_, 0x05040100u), (int)(wd_), oi[4 * q_ + 0], false); \
                        oi[4 * q_ + 1] = __builtin_amdgcn_sdot4((int)__builtin_amdgcn_perm(t2_, t0_, 0x07060302u), (int)(wd_), oi[4 * q_ + 1], false); \
                        oi[4 * q_ + 2] = __builtin_amdgcn_sdot4((int)__builtin_amdgcn_perm(t3_, t1_, 0x05040100u), (int)(wd_), oi[4 * q_ + 2], false); \
                        oi[4 * q_ + 3] = __builtin_amdgcn_sdot4((int)__builtin_amdgcn_perm(t3_, t1_, 0x07060302u), (int)(wd_), oi[4 * q_ + 3], false); } } while (0)
                    GS_QUAD(ra, 0, wc[0]); GS_QUAD(ra, 1, wc[1]);
                    GS_ROWS(ra, idn, 0);
                    GS_QUAD(rb, 0, wc[2]); GS_QUAD(rb, 1, wc[3]);
#undef GS_QUAD
#pragma unroll
                    for (int j = 0; j < 8; ++j) { auto rr_ = __builtin_amdgcn_permlane32_swap((unsigned)oi[j], (unsigned)oi[j + 8], false, false); oi[j] = (int)(rr_[0] + rr_[1]); }
#pragma unroll
                    for (int j = 0; j < 4; ++j) { auto rr_ = __builtin_amdgcn_permlane16_swap((unsigned)oi[j], (unsigned)oi[j + 4], false, false); oi[j] = (int)(rr_[0] + rr_[1]); }
                    float o[2];
#pragma unroll
                    for (int j = 0; j < 2; ++j) { const int ta_ = oi[j] + __builtin_amdgcn_update_dpp(0, oi[j], 0x128, 0xF, 0xF, true), tb_ = oi[j + 2] + __builtin_amdgcn_update_dpp(0, oi[j + 2], 0x128, 0xF, 0xF, true);
                        o[j] = (float)((lane & 8) ? tb_ : ta_) * sc_c; }
                    const float corr = 0.f;
                    const int mrow = row < ML ? (row >= T ? 1 : 0) : 2;
                    const int col = 128 * p + 16 * i8 + 2 * g;
                    unsigned* xp = (unsigned*)((bf16_t*)(ws + WS_XB) + (size_t)row * D + col);
                    const unsigned xw = *xp; const f32x2 g2 = *(const f32x2*)(modl + mrow * 6144 + col);
                    const float x0 = bflo(xw) + g2[0] * (o[0] - corr), x1 = bfhi(xw) + g2[1] * (o[1] - corr);
                    if (l == DEPTH - 1) *(f32x2*)(a.out + (size_t)row * D + col) = (f32x2){x0, x1};
                    else *xp = pkbf_c(x0, x1);
                }
#pragma unroll
                for (int q = 0; q < 2; ++q) idc[q] = idn[q];
                if (PH) { wc = wn; sc_c = sc_n; } else hc = hn;
                GS_META(idn, wn, sc_n, hn, r2);
                if (++i == GS_ITEM) {
                    if (tnv >= nitem) break;
                    it = tnv; i = 0; tnv = 0x7fffffff;
                    if (lane == 0) tn = __hip_atomic_fetch_add(ctr, 1u, __ATOMIC_RELAXED, __HIP_MEMORY_SCOPE_AGENT);
                }
            }
#undef GS_META
#undef GS_ROWS
        }
    }
#undef a
}
__device__ __forceinline__ void phase_peer_weights(int l) {
    const KArgs ap = get_args();
#define a (*ap)
    const int tid = fresh_tid(), lane = tid & 63, wave = __builtin_amdgcn_readfirstlane(tid >> 6), G = fresh_g(), bx = fresh_bx();
    unsigned char* ws = a.ws;
    const int nrows = (l == DEPTH - 1) ? ML : M;
    const f32x2* SC2 = (const f32x2*)(ws + WS_USC) + (size_t)(l & 1) * NEXP;
    const int* PIDX = (const int*)(ws + WS_PIDX); const float* PGATE = (const float*)(ws + WS_PGATE);
    for (int row = wave * G + bx; row < nrows; row += G * 8) {
        const unsigned idw = *((const unsigned*)PIDX + (size_t)row * 64 + lane); const u32x2 id = {idw & 0xffffu, idw >> 16}; const f32x2 gt = *(const f32x2*)(PGATE + (size_t)row * 128 + 2 * lane);
        const float hsc = ((const float*)(ws + WS_GB))[row];
        int d0 = 0, d1 = 0;
#pragma unroll
        for (int p = 0; p < 8; ++p) { const u32x2 v = __builtin_nontemporal_load((const u32x2*)((const int*)(ws + WS_PD) + ((size_t)p * M + row) * 128 + 2 * lane)); d0 += (int)v[0]; d1 += (int)v[1]; }
        const f32x2 s0 = SC2[id[0]], s1 = SC2[id[1]];
        const float x0 = (float)d0 * (s0[0] * hsc), x1 = (float)d1 * (s1[0] * hsc);
        const float w0 = gt[0] * s0[1] * (0.5f * x0 * (1.f + erff(x0 * 0.70710678118654752f))), w1 = gt[1] * s1[1] * (0.5f * x1 * (1.f + erff(x1 * 0.70710678118654752f)));
        float mx = fmaxf(wave_max(fmaxf(fabsf(w0), fabsf(w1))), 1e-30f); const float inv = 127.f / mx;
        *(unsigned short*)(ws + WS_PW + (size_t)row * 128 + 2 * lane) = (unsigned short)(((unsigned)(int)rintf(w0 * inv) & 255u) | (((unsigned)(int)rintf(w1 * inv) & 255u) << 8));
        if (lane == 0) ((float*)(ws + WS_PC))[row] = mx * (1.f / 127.f);
    }
#undef a
}

__global__ void __launch_bounds__(512, 2) fwd(Args a) {
    extern __shared__ __attribute__((aligned(16))) unsigned char lds_raw[];
    LAS unsigned char* lds = (LAS unsigned char*)lds_raw;
    volatile LAS unsigned* MISC = (volatile LAS unsigned*)(lds + LDS_MISC);
    if (threadIdx.x < 16) MISC[threadIdx.x] = 0u;
    __syncthreads();
    XcdBarrier bar; bar.bar = (unsigned*)(a.ws + WS_CTL) + 4096; bar.x = 0; bar.st = MISC + 8;
    bar = xcd_barrier_post((unsigned*)(a.ws + WS_CTL) + 4096, MISC + 8);
#ifndef PHASE_MASK
#define PHASE_MASK 0x1FFF
#endif
#define EN(i) ((PHASE_MASK >> (i)) & 1)
#ifndef REP_MASK
#define REP_MASK 0
#endif
#define REPN(i) (1 + ((REP_MASK >> (i)) & 1))
#define IN(k) true
#define SEAM(k) do { XcdBarrier b_; b_.bar = (unsigned*)(get_args()->ws + WS_CTL) + 4096; b_.x = xb_xcc_id(); b_.st = (volatile LAS unsigned*)(lds + LDS_MISC) + 8; xcd_barrier(b_); } while (0)
    for (int rep_ = 0; rep_ < (REPN(0)); ++rep_) if (EN(0) && IN(0)) phase_prologue(lds);
    SEAM(0);
#pragma unroll 1
    for (int l_ = 0; l_ < DEPTH; ++l_) {
        int l = l_; asm volatile("" : "+s"(l));
        const int pb = 1 + l * NPH_L;
        const int mrows = (l == DEPTH - 1) ? ML : M;
        if (l == 0) { for (int rep_ = 0; rep_ < (REPN(1)); ++rep_) if (EN(1) && IN(pb + 0)) { phase_norm<true>(l, 0, lds); phase_quant_weights(lds); }
            SEAM(pb + 0); }
        for (int rep_ = 0; rep_ < (REPN(2)); ++rep_) if (EN(2) && IN(pb + 1)) { const KArgs ap = get_args(); unsigned char* ws = ap->ws; pg8::Gemm g{(const bf16_t*)(ws + WS_H), (const bf16_t*)((const signed char*)(ws + WS_WINT) + (size_t)l * NP * 1024), M, NP, 512}; pg8::StaticOrder S; S.init(M, NP, fresh_g(), fresh_bx());
            pg8::EpiBf16I8 E{(bf16_t*)(ws + WS_P), NP, (const float*)(ws + WS_GB), (const float*)(ws + WS_CTL) + CW_WMAX + (l * 3 + 0) * 3072}; pg8::gemm_phase(lds, g, S, E); }
        SEAM(pb + 1);
        for (int rep_ = 0; rep_ < (REPN(3)); ++rep_) if (EN(3) && IN(pb + 2)) { phase_dn_chunkprep<1>(l, lds); phase_prep(l, lds); }
        for (int rep_ = 0; rep_ < (REPN(4)); ++rep_) if (EN(4) && IN(pb + 3)) phase_dn_chunkprep<0>(l, lds);
        SEAM(pb + 3);
        for (int rep_ = 0; rep_ < (REPN(5)); ++rep_) if (EN(5) && IN(pb + 4)) { phase_dn_scan<0>(l, lds); __syncthreads(); phase_attn(l, lds_raw, MISC, rep_); }
        SEAM(pb + 4);
        for (int rep_ = 0; rep_ < (REPN(7)); ++rep_) if (EN(7) && IN(pb + 5)) phase_dn_out(l);
        SEAM(pb + 5);
        if (EN(8) && IN(pb + 6)) { const KArgs ap = get_args(); unsigned char* ws = ap->ws; pg8::Gemm g{(const bf16_t*)(ws + WS_CATQ), (const bf16_t*)((const signed char*)(ws + WS_WOUTT) + (size_t)l * 1024 * 1024), mrows, 1024, 512}; pg8::StaticOrder S; S.init(mrows, 1024, fresh_g(), fresh_bx());
            pg8::EpiResI8 E{ap->in[I_X], ap->in[I_CTX], (bf16_t*)(ws + WS_XB), l == 0, (const float*)(ws + WS_MOD) + (size_t)l * 3 * 6144 + 2048,
                              (const float*)(ws + WS_GB) + (1u << 18), (const float*)(ws + WS_CTL) + CW_WMAX + (l * 3 + 1) * 3072};
            pg8::gemm_phase(lds, g, S, E); }
        SEAM(pb + 6);
        for (int rep_ = 0; rep_ < (REPN(9)); ++rep_) if (EN(9) && IN(pb + 7)) phase_norm<false>(l, 1, lds);
        SEAM(pb + 7);
        for (int rep_ = 0; rep_ < (REPN(10)); ++rep_) if (EN(10) && IN(pb + 8)) { const KArgs ap = get_args(); unsigned char* ws = ap->ws; pg8::Gemm g{(const bf16_t*)(ws + WS_H), (const bf16_t*)((const signed char*)(ws + WS_WQT) + (size_t)l * 2048 * 1024), mrows, 2048, 512}; pg8::StaticOrder S; S.init(mrows, 2048, fresh_g(), fresh_bx());
            pg8::EpiBf16I8 E{(bf16_t*)(ws + WS_P), 2048, (const float*)(ws + WS_GB), (const float*)(ws + WS_CTL) + CW_WMAX + (l * 3 + 2) * 3072}; pg8::gemm_phase(lds, g, S, E); }
        SEAM(pb + 8);
        for (int rep_ = 0; rep_ < (REPN(11)); ++rep_) if (EN(11) && IN(pb + 9)) phase_peer_select(l);
        SEAM(pb + 9);
        #ifdef GATHER_VAR
        if (EN(12) && IN(pb + 10)) phase_peer_gather<false, GATHER_VAR>(l, lds);
#endif
#if GATHER_PART == 2
        if (EN(12) && IN(pb + 10)) phase_peer_slice<0>(l, 0);
        SEAM(pb + 10);
        if (EN(12) && IN(pb + 10)) phase_peer_weights(l);
        SEAM(pb + 10);
        if (EN(12) && IN(pb + 10)) phase_peer_slice<1>(l, 0);
        if (l + 1 < DEPTH) { SEAM(pb + 10); if (EN(12) && IN(pb + 10)) phase_norm<true>(l + 1, 0, lds); }
#elif GATHER_PART
        if (EN(12) && IN(pb + 10)) phase_peer_gpart(l, lds);
        SEAM(pb + 10);
        if (EN(12) && IN(pb + 10)) phase_peer_combine(l, lds);
#else
        if (REPN(12) > 1 && EN(12) && IN(pb + 10)) phase_peer_gather<false>(l, lds);
        if (EN(12) && IN(pb + 10)) phase_peer_gather<true>(l, lds);
#endif
        if (l + 1 < DEPTH) SEAM(pb + 10);
    }
#undef IN
#undef SEAM
}

#ifndef N_LAUNCH_MODE
#define N_LAUNCH_MODE 1
#endif
extern "C" void kernel_launch(void* const* d_in, const int* in_sizes, int n_in, void* d_out, int out_size, void* d_ws, size_t ws_size, hipStream_t stream) {
    static int grid = 0;
    if (grid == 0) {
        if (n_in != 20 || out_size != ML * D || ws_size < WS_END) { fprintf(stderr, "kernel_launch: unexpected shapes: n_in %d out %d ws %zu (need %zu)\n", n_in, out_size, ws_size, (size_t)WS_END); grid = -1; return; }
        int dev = 0, cus = 0, per_cu = 0;
        if (hipGetDevice(&dev) != hipSuccess || hipDeviceGetAttribute(&cus, hipDeviceAttributeMultiprocessorCount, dev) != hipSuccess) { grid = -1; return; }
        if (hipFuncSetAttribute((const void*)fwd, hipFuncAttributeMaxDynamicSharedMemorySize, LDS_BYTES) != hipSuccess) { fprintf(stderr, "kernel_launch: hipFuncSetAttribute failed\n"); grid = -1; return; }
        if (hipOccupancyMaxActiveBlocksPerMultiprocessor(&per_cu, (const void*)fwd, 512, LDS_BYTES) != hipSuccess || per_cu < 1) fprintf(stderr, "kernel_launch: occupancy query says %d\n", per_cu);
        (void)hipGetLastError();
        grid = cus;
    }
    if (grid < 0) return;
    (void)hipMemsetAsync((char*)d_ws + WS_CTL, 0, CTL_BYTES, stream);
    Args a{};
    for (int i = 0; i < 20; ++i) a.in[i] = (const float*)d_in[i];
    a.out = (float*)d_out; a.ws = (unsigned char*)d_ws;
    a.ph_lo = 0; a.ph_hi = NPHASE;
    hipLaunchKernelGGL(fwd, dim3(grid), dim3(512), LDS_BYTES, stream, a);
    const hipError_t le = hipPeekAtLastError();
    if (le != hipSuccess) fprintf(stderr, "kernel_launch: launch failed: %s\n", hipGetErrorName(le));
}
```

```cpp
#include <hip/hip_runtime.h>
#ifndef GATHER_PART
#define GATHER_PART 2
#endif
#include <cstdio>
#include <cstdint>

#define GAS __attribute__((address_space(1)))
#define LAS __attribute__((address_space(3)))
typedef unsigned short bf16_t;
typedef short bf16x8 __attribute__((ext_vector_type(8)));
typedef short s16x4 __attribute__((ext_vector_type(4)));
typedef float f32x4 __attribute__((ext_vector_type(4)));
typedef float f32x2 __attribute__((ext_vector_type(2)));
typedef float f32x16 __attribute__((ext_vector_type(16)));
typedef unsigned u32x4 __attribute__((ext_vector_type(4)));
typedef unsigned u32x2 __attribute__((ext_vector_type(2)));
typedef int i32x4 __attribute__((ext_vector_type(4)));

constexpr int D = 1024, NB = 2, T = 16384, DEPTH = 4, CT = 256;
constexpr int ML = NB * T, MC = NB * CT, M = ML + MC;
constexpr int NIN = 3088, NP = 3072;
constexpr int KVLEN = T + CT;
constexpr int NEXP = 16384;
constexpr float EPS = 1e-6f;
constexpr int NPH_L = 11;
constexpr int NPHASE = 1 + DEPTH * NPH_L;

constexpr size_t MiB = 1u << 20;
constexpr size_t WS_CTL = 0, CTL_BYTES = 1 * MiB;
constexpr size_t WS_MOD = 1 * MiB;
constexpr size_t WS_ROPE = 2 * MiB;
constexpr size_t WS_WSK = 3 * MiB;
constexpr size_t WS_CTXX = 4 * MiB;
constexpr size_t WS_WINT = 8 * MiB;
constexpr size_t WS_WOUTT = 32 * MiB;
constexpr size_t WS_WQT = 40 * MiB;
constexpr size_t WS_SKB = 56 * MiB;
constexpr size_t WS_USC = 58 * MiB;
constexpr size_t WS_UB = 64 * MiB;
constexpr size_t WS_VB = 80 * MiB;
constexpr size_t TAB_SET = 32 * MiB;
constexpr size_t WS_H = 128 * MiB;
static_assert(WS_H + 2 * (size_t)M * 1024 <= 193 * MiB, "H + concat int8");
constexpr size_t WS_CATQ = WS_H + (size_t)M * 1024;
constexpr size_t WS_P = 193 * MiB;
constexpr size_t WS_QA = 388 * MiB;
constexpr size_t WS_KA = 421 * MiB;
constexpr size_t WS_VA = 438 * MiB;
constexpr size_t WS_CAT = 455 * MiB;
constexpr size_t WS_DQ = 520 * MiB;
constexpr size_t WS_DK = 553 * MiB;
constexpr size_t WS_DV = 586 * MiB;
constexpr size_t WS_OF = 619 * MiB;
constexpr size_t WS_OB = WS_OF + (size_t)M * 1024;
constexpr size_t WS_XB = WS_OB + (size_t)M * 1024;
static_assert(WS_OB + (size_t)M * 1024 <= WS_XB && WS_XB + (size_t)M * 2048 <= 749 * MiB, "OF/OB/XB");
constexpr size_t WS_GB = 749 * MiB;
constexpr size_t WS_BA = 752 * MiB;
constexpr size_t WS_PIDX = 755 * MiB;
constexpr size_t WS_PGATE = 772 * MiB;
constexpr size_t WS_REC = 789 * MiB;
constexpr size_t WS_END = 990 * MiB;
constexpr int CW_WMAX = 65536;
constexpr int NCH = 260;
constexpr int REC_K = 0, REC_KT = 16384, REC_Q = 32768, REC_V = 49152, REC_DIR = 65536, REC_DIRSZ = 17408, REC_BYTES = REC_DIR + 2 * REC_DIRSZ;
static_assert((size_t)NB * 4 * NCH * REC_BYTES + WS_REC <= WS_END, "rec region");

constexpr int LDS_BYTES = 163840;
constexpr int LDS_MISC = 163840 - 256;

__device__ __forceinline__ float bf2f(unsigned b) { return __uint_as_float(b << 16); }
__device__ __forceinline__ float bflo(unsigned w) { return __uint_as_float(w << 16); }
__device__ __forceinline__ float bfhi(unsigned w) { return __uint_as_float(w & 0xffff0000u); }
typedef __bf16 bf2v __attribute__((ext_vector_type(2)));
__device__ __forceinline__ unsigned pkbf(float lo, float hi) { unsigned r; asm("v_cvt_pk_bf16_f32 %0, %1, %2" : "=v"(r) : "v"(lo), "v"(hi)); return r; }
__device__ __forceinline__ unsigned pkbf_c(float lo, float hi) { f32x2 v = {lo, hi}; bf2v r = __builtin_convertvector(v, bf2v); return __builtin_bit_cast(unsigned, r); }
template <int K> __device__ __forceinline__ float lane_xor(float v) {
    const int b = __builtin_bit_cast(int, v);
    if constexpr (K == 1) return __builtin_bit_cast(float, __builtin_amdgcn_update_dpp(0, b, 0xB1, 0xF, 0xF, true));
    else if constexpr (K == 2) return __builtin_bit_cast(float, __builtin_amdgcn_update_dpp(0, b, 0x4E, 0xF, 0xF, true));
    else if constexpr (K == 32) { auto rr = __builtin_amdgcn_permlane32_swap((unsigned)b, (unsigned)b, false, false); unsigned ln_ = __builtin_amdgcn_mbcnt_hi(~0u, __builtin_amdgcn_mbcnt_lo(~0u, 0u)); asm volatile("" : "+v"(ln_));
        return __uint_as_float((ln_ & 32u) ? rr[0] : rr[1]); }
    else return __builtin_bit_cast(float, __builtin_amdgcn_ds_swizzle(b, 0x1F | (K << 10)));
}
__device__ __forceinline__ float wave_sum(float v) {
    v += lane_xor<1>(v); v += lane_xor<2>(v);
    v += __builtin_bit_cast(float, __builtin_amdgcn_update_dpp(0, __builtin_bit_cast(int, v), 0x124, 0xF, 0xF, true));
    v += __builtin_bit_cast(float, __builtin_amdgcn_update_dpp(0, __builtin_bit_cast(int, v), 0x128, 0xF, 0xF, true));
    v += lane_xor<16>(v);
    { auto rr = __builtin_amdgcn_permlane32_swap(__float_as_uint(v), __float_as_uint(v), false, false); v = __uint_as_float(rr[0]) + __uint_as_float(rr[1]); }
    return v;
}
__device__ __forceinline__ float wave_max(float v) {
    v = fmaxf(v, lane_xor<1>(v)); v = fmaxf(v, lane_xor<2>(v));
    v = fmaxf(v, __builtin_bit_cast(float, __builtin_amdgcn_update_dpp(0, __builtin_bit_cast(int, v), 0x124, 0xF, 0xF, true)));
    v = fmaxf(v, __builtin_bit_cast(float, __builtin_amdgcn_update_dpp(0, __builtin_bit_cast(int, v), 0x128, 0xF, 0xF, true)));
    v = fmaxf(v, lane_xor<16>(v));
    { auto rr = __builtin_amdgcn_permlane32_swap(__float_as_uint(v), __float_as_uint(v), false, false); v = fmaxf(__uint_as_float(rr[0]), __uint_as_float(rr[1])); }
    return v;
}
__device__ __forceinline__ float silu_f(float x) { return x * __builtin_amdgcn_rcpf(1.f + __expf(-x)); }
#define LDS_WAIT() asm volatile("s_waitcnt lgkmcnt(0)" ::: "memory")

#define XB_TMO      128
#define XB_XCNT(j)  (256  + 64 * (j))
#define XB_XSUB(j)  (1280 + 64 * (j))
#define XB_XGEN(j)  (2304 + 64 * (j))
#define XB_TOP      3328
#define XB_TOPGEN   3392
#define XCD_BAR_WORDS 3456
#define XB_SPIN_CAP (1u << 22)
__device__ __forceinline__ unsigned xb_ld(unsigned* p)              { return __hip_atomic_load(p, __ATOMIC_RELAXED, __HIP_MEMORY_SCOPE_AGENT); }
__device__ __forceinline__ unsigned xb_add(unsigned* p, unsigned v) { return __hip_atomic_fetch_add(p, v, __ATOMIC_RELAXED, __HIP_MEMORY_SCOPE_AGENT); }
__device__ __forceinline__ unsigned xb_xcc_id() { return (unsigned)__builtin_amdgcn_s_getreg((3 << 11) | 20) & 0xFu; }
#define XB_SPIN(cond, bar) do { unsigned _sp = 0; while (cond) { __builtin_amdgcn_s_sleep(1); \
    if ((++_sp & 255u) == 0u) { if (xb_ld(&(bar)[XB_TMO])) break; if (_sp > XB_SPIN_CAP) { atomicAdd(&(bar)[XB_TMO], 1u); break; } } } } while (0)
struct XcdBarrier { unsigned* bar; unsigned x; volatile LAS unsigned* st; };
__device__ __forceinline__ XcdBarrier xcd_barrier_post(unsigned* bar, volatile LAS unsigned* st) {
    XcdBarrier b; b.bar = bar; b.x = xb_xcc_id(); b.st = st;
    if (threadIdx.x == 0) (void)xb_add(&bar[XB_XCNT(b.x)], 1u);
    return b;
}
__device__ __forceinline__ void xcd_barrier_complete(unsigned* bar, unsigned x, unsigned& nloc, unsigned& nx) {
    const unsigned G = gridDim.x * gridDim.y * gridDim.z;
    unsigned sum, cnt, mine, sp = 0u;
    for (;;) {
        sum = 0u; cnt = 0u; mine = 0u;
#pragma unroll
        for (unsigned j = 0; j < 16; ++j) { const unsigned c = xb_ld(&bar[XB_XCNT(j)]); sum += c; cnt += (c > 0u) ? 1u : 0u; mine = (j == x) ? c : mine; }
        if (sum == G) break;
        __builtin_amdgcn_s_sleep(1);
        if ((++sp & 255u) == 0u) { if (xb_ld(&bar[XB_TMO])) break; if (sp > XB_SPIN_CAP) { atomicAdd(&bar[XB_TMO], 1u); break; } }
    }
    nloc = mine > 0u ? mine : 1u; nx = cnt > 0u ? cnt : 1u;
}
__device__ __forceinline__ void xcd_barrier(const XcdBarrier& b) {
    asm volatile("s_waitcnt vmcnt(0)" ::: "memory");
    __syncthreads();
    if (threadIdx.x == 0) {
        unsigned* bar = b.bar; unsigned bx_ = b.x;
        asm volatile("" : "+s"(bar), "+s"(bx_));
        __builtin_amdgcn_s_waitcnt(0);
        unsigned nloc = b.st[0], nx = b.st[1];
        if (nloc == 0u) { xcd_barrier_complete(bar, bx_, nloc, nx); b.st[0] = nloc; b.st[1] = nx; }
        const unsigned old = xb_add(&bar[XB_XSUB(bx_)], 1u);
        const unsigned gen = old / nloc;
        if (old + 1u == (gen + 1u) * nloc) {
            __builtin_amdgcn_fence(__ATOMIC_RELEASE, "agent");
            asm volatile("s_waitcnt vmcnt(0)" ::: "memory");
            const unsigned og = xb_add(&bar[XB_TOP], 1u);
            const unsigned tg = og / nx;
            if (og + 1u == (tg + 1u) * nx) xb_add(&bar[XB_TOPGEN], 1u);
            else XB_SPIN(xb_ld(&bar[XB_TOPGEN]) == tg, bar);
            __builtin_amdgcn_fence(__ATOMIC_ACQUIRE, "agent");
            xb_add(&bar[XB_XGEN(bx_)], 1u);
            asm volatile("s_waitcnt vmcnt(0)" ::: "memory");
        } else {
            XB_SPIN(xb_ld(&bar[XB_XGEN(bx_)]) == gen, bar);
            __builtin_amdgcn_fence(__ATOMIC_ACQUIRE, "agent");
            asm volatile("s_waitcnt vmcnt(0)" ::: "memory");
        }
    }
    __syncthreads();
}

namespace pg8 {
constexpr int BM = 256, BK = 64, HALF = 128, HTB = HALF * BK * 2, STAGE_BYTES = 8 * HTB, NXCD = 8, WGM = 8;
__host__ __device__ __forceinline__ int lds_byte(int r, int c) { const int st = (r >> 4) * 2 + (c >> 5), rr = r & 15, cc = c & 31, ob = rr * 64 + cc * 2; return st * 1024 + (ob ^ (((ob >> 9) & 1) << 5)); }
__host__ __device__ __forceinline__ void stage_rc(int b, int& R, int& C) { const int st = b / 1024, sb = b % 1024, swz = sb ^ (((sb >> 9) & 1) << 5); R = (st >> 1) * 16 + swz / 64; C = (st & 1) * 32 + (swz % 64) / 2; }
__host__ __device__ __forceinline__ int perm32(int rho) { const int n = rho >> 4, i = rho & 15; return 8 * (i >> 2) + 4 * n + (i & 3); }
struct Unit { int pm, pn; };
struct Gemm { const bf16_t* A; const bf16_t* Bt; int M, N, K; };
struct StaticOrder {
    int nM, nN, nwg, G, c;
    __host__ __device__ void init(int M_, int N_, int G_, int c_) { nM = M_ / BM; nN = N_ / BM; nwg = nM * nN; G = G_; c = c_; }
    __host__ __device__ bool next(int i, Unit& u) const {
        const long L = (long)i * G + c; if (L >= nwg) return false;
        int wgid = (int)L; { const int q = nwg / NXCD, r = nwg % NXCD, xcd = wgid % NXCD, off = wgid / NXCD; wgid = (xcd < r ? xcd * (q + 1) : r * (q + 1) + (xcd - r) * q) + off; }
        const int nig = WGM * nN, gid = wgid / nig, fm = gid * WGM, gsz = (nM - fm) < WGM ? (nM - fm) : WGM;
        u.pm = fm + ((wgid % nig) % gsz); u.pn = (wgid % nig) / gsz; return true;
    }
    __device__ __forceinline__ void a_ready(const Unit&) const {}
    __device__ __forceinline__ void done(const Unit&) const {}
};
struct EpiBf16 {
    static constexpr bool PERM = true, I8 = false; typedef f32x4 acc_t;
    bf16_t* O; int ldc;
    __device__ __forceinline__ void operator()(const f32x4 (&acc)[2][2][4][2], const Unit& u, int wr, int wc, int fr, int fq) const {
        const int row0 = u.pm * BM + wr * 64 + fr; const int col0 = u.pn * BM + wc * 32 + 8 * fq;
#pragma unroll
        for (int ai = 0; ai < 2; ++ai)
#pragma unroll
            for (int m = 0; m < 4; ++m) { bf16_t* rowp = O + (size_t)(row0 + ai * HALF + m * 16) * ldc + col0;
#pragma unroll
                for (int bj = 0; bj < 2; ++bj) { const f32x4 v0 = acc[ai][bj][m][0], v1 = acc[ai][bj][m][1];
                    u32x4 w; w.x = pkbf_c(v0[0], v0[1]); w.y = pkbf_c(v0[2], v0[3]); w.z = pkbf_c(v1[0], v1[1]); w.w = pkbf_c(v1[2], v1[3]);
                    *(u32x4*)(rowp + bj * HALF) = w; } }
    }
};
struct EpiBf16I8 {
    static constexpr bool PERM = true, I8 = true; typedef i32x4 acc_t;
    bf16_t* O; int ldc; const float* sa; const float* wmax;
    __device__ __forceinline__ void operator()(const i32x4 (&acc)[2][2][4][2], const Unit& u, int wr, int wc, int fr, int fq) const {
        const int row0 = u.pm * BM + wr * 64 + fr; const int col0 = u.pn * BM + wc * 32 + 8 * fq;
        f32x4 sw[2][2];
#pragma unroll
        for (int bj = 0; bj < 2; ++bj)
#pragma unroll
            for (int n = 0; n < 2; ++n) sw[bj][n] = *(const f32x4*)(wmax + col0 + bj * HALF + 4 * n) * (1.f / 127.f);
#pragma unroll
        for (int ai = 0; ai < 2; ++ai)
#pragma unroll
            for (int m = 0; m < 4; ++m) { const int row = row0 + ai * HALF + m * 16; const float sr = sa[row]; bf16_t* rowp = O + (size_t)row * ldc + col0;
#pragma unroll
                for (int bj = 0; bj < 2; ++bj) { const i32x4 a0 = acc[ai][bj][m][0], a1 = acc[ai][bj][m][1];
                    const f32x4 v0 = (f32x4){(float)a0[0], (float)a0[1], (float)a0[2], (float)a0[3]} * sw[bj][0] * sr, v1 = (f32x4){(float)a1[0], (float)a1[1], (float)a1[2], (float)a1[3]} * sw[bj][1] * sr;
                    u32x4 w; w.x = pkbf(v0[0], v0[1]); w.y = pkbf(v0[2], v0[3]); w.z = pkbf(v1[0], v1[1]); w.w = pkbf(v1[2], v1[3]);
                    *(u32x4*)(rowp + bj * HALF) = w; } }
    }
};
struct EpiRes {
    static constexpr bool PERM = false, I8 = false; typedef f32x4 acc_t;
    const float* src_lat; const float* src_ctx; float* dst_lat; float* dst_ctx; const float* gate;
    __device__ __forceinline__ void operator()(const f32x4 (&acc)[2][2][4][2], const Unit& u, int wr, int wc, int fr, int fq) const {
        const bool isctx = u.pm >= (ML / BM);
        const float* src = isctx ? src_ctx + (size_t)(u.pm - ML / BM) * BM * D : src_lat + (size_t)u.pm * BM * D;
        float* dst = isctx ? dst_ctx + (size_t)(u.pm - ML / BM) * BM * D : dst_lat + (size_t)u.pm * BM * D;
        const int mrow = isctx ? 2 : (u.pm >= (T / BM) ? 1 : 0);
        const int row0 = wr * 64 + fr, col0 = u.pn * BM + wc * 32 + 4 * fq;
        f32x4 gv[2][2];
#pragma unroll
        for (int bj = 0; bj < 2; ++bj)
#pragma unroll
            for (int n = 0; n < 2; ++n) gv[bj][n] = *(const f32x4*)(gate + mrow * 6144 + col0 + bj * HALF + n * 16);
#pragma unroll
        for (int ai = 0; ai < 2; ++ai)
#pragma unroll
            for (int m = 0; m < 4; ++m) { const size_t off = (size_t)(row0 + ai * HALF + m * 16) * D + col0;
#pragma unroll
                for (int bj = 0; bj < 2; ++bj)
#pragma unroll
                    for (int n = 0; n < 2; ++n) { const f32x4 s = *(const f32x4*)(src + off + bj * HALF + n * 16);
                        *(f32x4*)(dst + off + bj * HALF + n * 16) = s + gv[bj][n] * acc[ai][bj][m][n]; } }
    }
};

struct EpiResI8 {
    static constexpr bool PERM = false, I8 = true; typedef i32x4 acc_t;
    const float* src_lat; const float* src_ctx; bf16_t* xb; bool first; const float* gate; const float* sa; const float* wmax;
    __device__ __forceinline__ void operator()(const i32x4 (&acc)[2][2][4][2], const Unit& u, int wr, int wc, int fr, int fq) const {
        const bool isctx = u.pm >= (ML / BM);
        const float* src = isctx ? src_ctx + (size_t)(u.pm - ML / BM) * BM * D : src_lat + (size_t)u.pm * BM * D;
        bf16_t* dst = xb + (size_t)u.pm * BM * D;
        const int mrow = isctx ? 2 : (u.pm >= (T / BM) ? 1 : 0);
        const int row0 = wr * 64 + fr, col0 = u.pn * BM + wc * 32 + 4 * fq;
        f32x4 gv[2][2];
#pragma unroll
        for (int bj = 0; bj < 2; ++bj)
#pragma unroll
            for (int n = 0; n < 2; ++n) gv[bj][n] = *(const f32x4*)(gate + mrow * 6144 + col0 + bj * HALF + n * 16) * *(const f32x4*)(wmax + col0 + bj * HALF + n * 16) * (1.f / 127.f);
#pragma unroll
        for (int ai = 0; ai < 2; ++ai)
#pragma unroll
            for (int m = 0; m < 4; ++m) { const int rl = row0 + ai * HALF + m * 16; const float sr = sa[u.pm * BM + rl]; const size_t off = (size_t)rl * D + col0;
#pragma unroll
                for (int bj = 0; bj < 2; ++bj)
#pragma unroll
                    for (int n = 0; n < 2; ++n) { const i32x4 ac = acc[ai][bj][m][n]; f32x4 sv;
                        if (first) sv = *(const f32x4*)(src + off + bj * HALF + n * 16);
                        else { const u32x2 w_ = *(const u32x2*)(dst + off + bj * HALF + n * 16); sv = (f32x4){bflo(w_[0]), bfhi(w_[0]), bflo(w_[1]), bfhi(w_[1])}; }
                        const f32x4 r_ = sv + gv[bj][n] * ((f32x4){(float)ac[0], (float)ac[1], (float)ac[2], (float)ac[3]} * sr);
                        *(u32x2*)(dst + off + bj * HALF + n * 16) = (u32x2){pkbf(r_[0], r_[1]), pkbf(r_[2], r_[3])}; } }
    }
};
template <class Epi, class Sched>
__device__ __forceinline__ void gemm_phase(LAS unsigned char* lds, const Gemm g, const Sched& S, const Epi& E) {
    constexpr bool I8 = Epi::I8;
    typedef typename Epi::acc_t acc_t;
    int tid = threadIdx.x; asm volatile("" : "+v"(tid)); const int wid = __builtin_amdgcn_readfirstlane(tid >> 6), lane = tid & 63, wr = wid >> 2, wc = wid & 3, fr = lane & 15, fq = lane >> 4;
    const int K = g.K, nt = K / BK;
    unsigned voffA[2], voffB[2];
#pragma unroll
    for (int i = 0; i < 2; ++i) { int R, C; stage_rc(tid * 16 + i * 8192, R, C); const int Rb = Epi::PERM ? ((R & ~31) + perm32(R & 31)) : R;
        voffA[i] = (unsigned)(R * K + C) * 2u; voffB[i] = (unsigned)(Rb * K + C) * 2u; }
    const size_t kstep = (size_t)(BK * 2);
    const size_t hstep = (size_t)HALF * K * 2;
    const size_t tstep = 2 * hstep;
    const unsigned ldsw = (unsigned)wid * 1024u;
    const int aoff = lds_byte(wr * 64 + fr, fq * 8), boff = lds_byte(wc * 32 + fr, fq * 8);
#define PG8_SA(b, h) (((b) * 2 + (h)) * HTB)
#define PG8_SB(b, h) ((4 + (b) * 2 + (h)) * HTB)
#define PG8_STAGE(bufoff, gbase, voff) do { _Pragma("unroll") for (int _i = 0; _i < 2; ++_i) \
        __builtin_amdgcn_global_load_lds((const unsigned*)((const char*)(gbase) + (voff)[_i]), (LAS unsigned*)(lds + (bufoff) + ldsw + _i * 8192), 16, 0, 0); } while (0)
#define PG8_LDA(dst, b, h) do { _Pragma("unroll") for (int m = 0; m < 4; ++m) _Pragma("unroll") for (int k = 0; k < 2; ++k) dst[m][k] = *(const LAS bf16x8*)(lds + PG8_SA(b, h) + aoff + m * 2048 + k * 1024); } while (0)
#define PG8_LDB(dst, b, h) do { _Pragma("unroll") for (int n = 0; n < 2; ++n) _Pragma("unroll") for (int k = 0; k < 2; ++k) dst[n][k] = *(const LAS bf16x8*)(lds + PG8_SB(b, h) + boff + n * 2048 + k * 1024); } while (0)
#define PG8_MMA(ai, bj, At, Bt) do { __builtin_amdgcn_s_setprio(1); _Pragma("unroll") for (int m = 0; m < 4; ++m) _Pragma("unroll") for (int n = 0; n < 2; ++n) _Pragma("unroll") for (int k = 0; k < 2; ++k) \
        { if constexpr (I8) acc[ai][bj][m][n] = __builtin_bit_cast(acc_t, __builtin_amdgcn_mfma_i32_16x16x64_i8(__builtin_bit_cast(i32x4, Bt[n][k]), __builtin_bit_cast(i32x4, At[m][k]), __builtin_bit_cast(i32x4, acc[ai][bj][m][n]), 0, 0, 0)); \
          else acc[ai][bj][m][n] = __builtin_bit_cast(acc_t, __builtin_amdgcn_mfma_f32_16x16x32_bf16(Bt[n][k], At[m][k], __builtin_bit_cast(f32x4, acc[ai][bj][m][n]), 0, 0, 0)); } __builtin_amdgcn_s_setprio(0); } while (0)
#define PG8_WAIT_V(n) asm volatile("s_waitcnt vmcnt(" #n ")" ::: "memory")
#define PG8_WAIT_L(n) asm volatile("s_waitcnt lgkmcnt(" #n ")" ::: "memory")
#define PG8_BAR __builtin_amdgcn_s_barrier()
#define PG8_SCHED __builtin_amdgcn_sched_barrier(0)
    Unit cur, nxt; int ui = 0;
    if (!S.next(0, cur)) return;
    acc_t acc[2][2][4][2];
#pragma unroll
    for (int a = 0; a < 2; ++a)
#pragma unroll
        for (int b = 0; b < 2; ++b)
#pragma unroll
            for (int m = 0; m < 4; ++m)
#pragma unroll
                for (int n = 0; n < 2; ++n) acc[a][b][m][n] = acc_t{};
    bf16x8 At[4][2], B0[2][2], B1[2][2];
    const char* cA = (const char*)g.A + (size_t)cur.pm * tstep; const char* cB = (const char*)g.Bt + (size_t)cur.pn * tstep;
    S.a_ready(cur);
    PG8_STAGE(PG8_SB(0, 0), cB, voffB); PG8_STAGE(PG8_SA(0, 0), cA, voffA); PG8_STAGE(PG8_SB(0, 1), cB + hstep, voffB); PG8_STAGE(PG8_SA(0, 1), cA + hstep, voffA);
    if (wr == 1) PG8_BAR;
    PG8_WAIT_V(4); PG8_BAR;
    PG8_STAGE(PG8_SB(1, 0), cB + kstep, voffB); PG8_STAGE(PG8_SA(1, 0), cA + kstep, voffA); PG8_STAGE(PG8_SB(1, 1), cB + hstep + kstep, voffB);
    PG8_WAIT_V(6); PG8_BAR;
    for (;;) {
        const bool has_next = S.next(ui + 1, nxt);
        const char* nA = has_next ? (const char*)g.A + (size_t)nxt.pm * tstep : cA; const char* nB = has_next ? (const char*)g.Bt + (size_t)nxt.pn * tstep : cB;
        for (int t = 0; t < nt; t += 2) {
            const bool last = (t == nt - 2);
            const char* a1 = cA + (size_t)(t + 1) * kstep;
            const char* a2 = last ? nA : cA + (size_t)(t + 2) * kstep; const char* b2 = last ? nB : cB + (size_t)(t + 2) * kstep;
            const char* a3 = a2 + kstep; const char* b3 = b2 + kstep;
            if (last && has_next) S.a_ready(nxt);
            PG8_LDB(B0, 0, 0); PG8_SCHED; PG8_LDA(At, 0, 0); PG8_STAGE(PG8_SA(1, 1), a1 + hstep, voffA);
            PG8_WAIT_L(8); PG8_BAR; PG8_WAIT_L(0); PG8_MMA(0, 0, At, B0); PG8_BAR; PG8_SCHED;
            PG8_LDB(B1, 0, 1); PG8_STAGE(PG8_SB(0, 0), b2, voffB);
            PG8_BAR; PG8_WAIT_L(0); PG8_MMA(0, 1, At, B1); PG8_BAR;
            PG8_LDA(At, 0, 1); PG8_STAGE(PG8_SA(0, 0), a2, voffA);
            PG8_BAR; PG8_WAIT_L(0); PG8_MMA(1, 0, At, B0); PG8_BAR; PG8_SCHED;
            PG8_STAGE(PG8_SB(0, 1), b2 + hstep, voffB);
            PG8_WAIT_V(6); PG8_BAR; PG8_MMA(1, 1, At, B1); PG8_BAR;
            PG8_LDB(B0, 1, 0); PG8_SCHED; PG8_LDA(At, 1, 0); PG8_STAGE(PG8_SA(0, 1), a2 + hstep, voffA);
            PG8_WAIT_L(8); PG8_BAR; PG8_WAIT_L(0); PG8_MMA(0, 0, At, B0); PG8_BAR; PG8_SCHED;
            PG8_LDB(B1, 1, 1); PG8_STAGE(PG8_SB(1, 0), b3, voffB);
            PG8_BAR; PG8_WAIT_L(0); PG8_MMA(0, 1, At, B1); PG8_BAR;
            PG8_LDA(At, 1, 1); PG8_STAGE(PG8_SA(1, 0), a3, voffA);
            PG8_BAR; PG8_WAIT_L(0); PG8_MMA(1, 0, At, B0); PG8_BAR; PG8_SCHED;
            PG8_STAGE(PG8_SB(1, 1), b3 + hstep, voffB);
            PG8_WAIT_V(6); PG8_BAR; PG8_MMA(1, 1, At, B1); PG8_BAR;
        }
        E(acc, cur, wr, wc, fr, fq); S.done(cur);
        if (!has_next) break;
#pragma unroll
        for (int a = 0; a < 2; ++a)
#pragma unroll
            for (int b = 0; b < 2; ++b)
#pragma unroll
                for (int m = 0; m < 4; ++m)
#pragma unroll
                    for (int n = 0; n < 2; ++n) acc[a][b][m][n] = acc_t{};
        cur = nxt; cA = nA; cB = nB; ++ui;
    }
    PG8_WAIT_V(0);
    if (wr == 0) PG8_BAR;
    PG8_BAR;
#undef PG8_SA
#undef PG8_SB
#undef PG8_STAGE
#undef PG8_LDA
#undef PG8_LDB
#undef PG8_MMA
#undef PG8_WAIT_V
#undef PG8_WAIT_L
#undef PG8_BAR
#undef PG8_SCHED
}
}

namespace att {
constexpr int HD = 128, NW = 8, QBLK = 32, KVBLK = 64;
constexpr float SCALE = 0.088388347648318440f;
constexpr float THR = 8.f;
constexpr int LDQ = 512, LDK = 256;
constexpr size_t SHM_V = KVBLK * HD * 2, SHM_K = KVBLK * HD * 2, SHM_ATTN = 2 * SHM_V + 2 * SHM_K + NW * 64 * 4;
#define KSWZ(row, colB) ((row) * 256 + ((colB) ^ (((row) & 7) << 4)))
#define SBAR() __builtin_amdgcn_sched_barrier(0)
__device__ __forceinline__ int crow(int r, int hi) { return (r & 3) + 8 * (r >> 2) + 4 * hi; }
__device__ __forceinline__ unsigned cvtpk(float lo, float hi) { unsigned r; asm volatile("v_cvt_pk_bf16_f32 %0, %1, %2" : "=v"(r) : "v"(lo), "v"(hi)); return r; }
__device__ __forceinline__ void partialSM(f32x16& p0, f32x16& p1) {
  for (int r = 0; r < 16; ++r) p0[r] = __builtin_amdgcn_exp2f(p0[r]);
}
typedef int i32x8 __attribute__((ext_vector_type(8)));
__device__ __forceinline__ void finishSM(f32x16& p0, f32x16& p1, i32x8& pa) {
  for (int r = 0; r < 16; ++r) p1[r] = __builtin_amdgcn_exp2f(p1[r]);
#pragma unroll
  for (int q = 0; q < 4; ++q) { int w = __builtin_amdgcn_cvt_pk_bf8_f32(p0[4 * q], p0[4 * q + 1], 0, false); w = __builtin_amdgcn_cvt_pk_bf8_f32(p0[4 * q + 2], p0[4 * q + 3], w, true); pa[q] = w;
    int w2 = __builtin_amdgcn_cvt_pk_bf8_f32(p1[4 * q], p1[4 * q + 1], 0, false); w2 = __builtin_amdgcn_cvt_pk_bf8_f32(p1[4 * q + 2], p1[4 * q + 3], w2, true); pa[4 + q] = w2; }
}
constexpr int K8_STRIDE = 144, K8_TILE = KVBLK * K8_STRIDE;
__device__ __forceinline__ void qkt(f32x16& p0, f32x16& p1, const unsigned char* Ks, const i32x8* qr, int r32, int hi, const f32x16& cinit) {
  p0 = cinit; p1 = cinit;
#pragma unroll
  for (int ks = 0; ks < 2; ++ks) {
    const u32x4* a0 = (const u32x4*)(Ks + r32 * K8_STRIDE + 64 * ks + 32 * hi); const u32x4* a1 = (const u32x4*)(Ks + (32 + r32) * K8_STRIDE + 64 * ks + 32 * hi);
    const u32x4 x0 = a0[0], x1 = a0[1], y0 = a1[0], y1 = a1[1];
    const i32x8 k0 = {(int)x0.x, (int)x0.y, (int)x0.z, (int)x0.w, (int)x1.x, (int)x1.y, (int)x1.z, (int)x1.w}, k1 = {(int)y0.x, (int)y0.y, (int)y0.z, (int)y0.w, (int)y1.x, (int)y1.y, (int)y1.z, (int)y1.w};
    p0 = __builtin_amdgcn_mfma_scale_f32_32x32x64_f8f6f4(k0, qr[ks], p0, 0, 0, 0, 0x7F7F7F7F, 0, 0x7C7C7C7C);
    p1 = __builtin_amdgcn_mfma_scale_f32_32x32x64_f8f6f4(k1, qr[ks], p1, 0, 0, 0, 0x7F7F7F7F, 0, 0x7C7C7C7C); }
}
constexpr int V8_STRIDE = 80, V8_TILE = HD * V8_STRIDE;
__device__ __forceinline__ void pv_d0(f32x16* o, f32x16& ol, const unsigned char* Vs, const i32x8& pa, int r32, int hi) {
  { const i32x8 ones = {0x38383838, 0x38383838, 0x38383838, 0x38383838, 0x38383838, 0x38383838, 0x38383838, 0x38383838};
    ol = __builtin_amdgcn_mfma_scale_f32_32x32x64_f8f6f4(pa, ones, ol, 1, 0, 0, 0x7F7F7F7F, 0, 0x7F7F7F7F); }
#pragma unroll
  for (int d0 = 0; d0 < 4; ++d0) { const u32x4* bp = (const u32x4*)(Vs + (32 * d0 + r32) * V8_STRIDE + 32 * hi); const u32x4 x0 = bp[0], x1 = bp[1];
    const i32x8 vb = {(int)x0.x, (int)x0.y, (int)x0.z, (int)x0.w, (int)x1.x, (int)x1.y, (int)x1.z, (int)x1.w};
    o[d0] = __builtin_amdgcn_mfma_scale_f32_32x32x64_f8f6f4(pa, vb, o[d0], 1  , 0  , 0, 0x7F7F7F7F, 0, 0x7F7F7F7F); }
}
__device__ __forceinline__ void attn_dense_body(const unsigned char* __restrict__ Qb, const unsigned char* __restrict__ Kh, const unsigned char* __restrict__ Vt,
                                                bf16_t* __restrict__ Ob, int LDO, int seq, char* lds, float* __restrict__ lse, float braw) {
  int tid = threadIdx.x; asm volatile("" : "+v"(tid)); const int wid = tid >> 6, lane = tid & 63, r32 = lane & 31, hi = lane >> 5;
  unsigned char* V_lds = (unsigned char*)lds; unsigned char* K_lds = (unsigned char*)(lds + 3 * V8_TILE);
  f32x16 o[4] = {}, ol = {}; i32x8 qr[2];
  const float mnC = __builtin_bit_cast(float, __builtin_amdgcn_readfirstlane(__builtin_bit_cast(int, -fmaxf(braw * (SCALE * 1.4426950408889634f) - 15.5f, 0.f))));
  f32x16 cinit;
#pragma unroll
  for (int r = 0; r < 16; ++r) cinit[r] = mnC;
  const unsigned char* Qw = Qb + (long)(wid * QBLK + r32) * LDQ + hi * 32;
#pragma unroll
  for (int ks = 0; ks < 2; ++ks) { const u32x4 x0 = *(const u32x4*)(Qw + 64 * ks), x1 = *(const u32x4*)(Qw + 64 * ks + 16);
    qr[ks] = (i32x8){(int)x0.x, (int)x0.y, (int)x0.z, (int)x0.w, (int)x1.x, (int)x1.y, (int)x1.z, (int)x1.w}; }
  const int krow = tid >> 3, kch = tid & 7;
  const int vrow = tid >> 2, vch = tid & 3;
  struct { u32x4 v8, k8; } sr_[2];
#define SLOAD(i, k0) do { sr_[i].v8 = *reinterpret_cast<const u32x4*>(Vt + (long)((k0) >> 6) * 8192 + tid * 16); \
    sr_[i].k8 = *reinterpret_cast<const u32x4*>(Kh + (long)((k0) + krow) * LDK + kch * 16); } while (0)
#define SWRITE(b, i) do { *(u32x4*)(V_lds + (b) * V8_TILE + vrow * V8_STRIDE + vch * 16) = sr_[i].v8; \
    *(u32x4*)(K_lds + (b) * K8_TILE + krow * K8_STRIDE + kch * 16) = sr_[i].k8; } while (0)
#define SWAIT() asm volatile("s_waitcnt vmcnt(2)" ::: "memory")
  f32x16 pA0, pA1, pB0, pB1; i32x8 pa; const int NT = seq / KVBLK;
  constexpr int SE = 0, SO = 1;
  SLOAD(SE, 0); asm volatile("s_waitcnt vmcnt(0)" ::: "memory"); SWRITE(0, SE);
  SLOAD(SO, KVBLK); SLOAD(SE, 2 * KVBLK);
  __syncthreads();
  qkt(pA0, pA1, K_lds, qr, r32, hi, cinit); partialSM(pA0, pA1);
  SWAIT(); SWRITE(1, SO); SLOAD(SO, 3 * KVBLK);
  __syncthreads();
  int s0 = 0, s1 = 1, s2 = 2;
  for (int j = 1; j + 1 < NT; j += 2) {
    SBAR(); qkt(pB0, pB1, K_lds + s1 * K8_TILE, qr, r32, hi, cinit);
    finishSM(pA0, pA1, pa); SBAR();
    pv_d0(o, ol, V_lds + s0 * V8_TILE, pa, r32, hi); partialSM(pB0, pB1);
    SBAR(); SWAIT(); SWRITE(s2, SE); SLOAD(SE, (j + 3 < NT ? j + 3 : NT - 1) * KVBLK);
    __syncthreads();
    SBAR(); qkt(pA0, pA1, K_lds + s2 * K8_TILE, qr, r32, hi, cinit);
    finishSM(pB0, pB1, pa); SBAR();
    pv_d0(o, ol, V_lds + s1 * V8_TILE, pa, r32, hi); partialSM(pA0, pA1);
    SBAR(); SWAIT(); SWRITE(s0, SO); SLOAD(SO, (j + 4 < NT ? j + 4 : NT - 1) * KVBLK);
    __syncthreads();
    { const int t_ = s0; s0 = s2; s2 = s1; s1 = t_; }
  }
  SBAR(); qkt(pB0, pB1, K_lds + s1 * K8_TILE, qr, r32, hi, cinit);
  finishSM(pA0, pA1, pa); SBAR();
  pv_d0(o, ol, V_lds + s0 * V8_TILE, pa, r32, hi); partialSM(pB0, pB1);
  finishSM(pB0, pB1, pa); SBAR();
  pv_d0(o, ol, V_lds + s1 * V8_TILE, pa, r32, hi);
  asm volatile("s_waitcnt vmcnt(0)" ::: "memory");
  if (lse && r32 == 0) {
#pragma unroll
    for (int r = 0; r < 16; ++r) lse[(wid * QBLK + crow(r, hi)) * 4] = __logf(ol[r]) - mnC * 0.69314718055994531f; }
  float rli[16];
#pragma unroll
  for (int r = 0; r < 16; ++r) rli[r] = __builtin_amdgcn_rcpf(ol[r]);
  bf16_t* Ow = Ob + (long)(wid * QBLK) * LDO;
#pragma unroll
  for (int r = 0; r < 16; ++r) { int orow = crow(r, hi);
    for (int d0 = 0; d0 < 4; ++d0) Ow[(long)orow * LDO + d0 * 32 + r32] = (bf16_t)(pkbf(o[d0][r] * rli[r], 0.f) & 0xffffu); }
  __syncthreads();
#undef SLOAD
#undef SWRITE
#undef SWAIT
}
}

struct Args { const float* in[20]; float* out; unsigned char* ws; int ph_lo, ph_hi; };
typedef const __attribute__((address_space(4))) Args* KArgs;
__device__ __forceinline__ KArgs get_args() { KArgs p = (KArgs)__builtin_amdgcn_kernarg_segment_ptr(); asm volatile("" : "+s"(p)); return p; }
__device__ __forceinline__ int fresh_tid() { int t = threadIdx.x; asm volatile("" : "+v"(t)); return t; }
__device__ __forceinline__ int fresh_bx() { int t = blockIdx.x; asm volatile("" : "+s"(t)); return t; }
__device__ __forceinline__ int fresh_g() { int t = gridDim.x; asm volatile("" : "+s"(t)); return t; }
enum { I_X = 0, I_C, I_CTX, I_CCTX, I_ADAW, I_ADAB, I_N1W, I_N2W, I_WIN, I_QNW, I_KNW, I_CONVW, I_ALOG, I_DTB, I_DNW, I_WOUT, I_WQ, I_SUBK, I_U, I_V };

__device__ __forceinline__ void convert_tables(const float* U, const float* V, unsigned char* ws, int l, int wvi, int nwv, int lane, int rw_end = 2 * NEXP) {
    const float* us = U + (size_t)l * NEXP * 1024; const float* vs = V + (size_t)l * NEXP * 1024;
    const int set = l & 1;
    float* scl = (float*)(ws + WS_USC) + set * 2 * NEXP;
    for (int rw = wvi; rw < rw_end; rw += nwv) {
        const bool isu = rw < NEXP; const int e = isu ? rw : rw - NEXP;
        const f32x4* sp = (const f32x4*)((isu ? us : vs) + (size_t)e * 1024 + 16 * lane);
        f32x4 x[4]; float mx = 0.f;
#pragma unroll
        for (int i = 0; i < 4; ++i) { x[i] = sp[i]; mx = fmaxf(mx, fmaxf(fmaxf(fabsf(x[i][0]), fabsf(x[i][1])), fmaxf(fabsf(x[i][2]), fabsf(x[i][3])))); }
        mx = wave_max(mx);
        const float sc = fmaxf(mx, 1e-30f) * (1.f / 127.f), inv = 1.f / sc;
        u32x4 o4;
        const float ofs = ((GATHER_PART && isu) || GATHER_PART == 2) ? 0.f : 128.f;
#pragma unroll
        for (int i = 0; i < 4; ++i) { const unsigned b0 = (unsigned)(int)(rintf(x[i][0] * inv) + ofs) & 255u, b1 = (unsigned)(int)(rintf(x[i][1] * inv) + ofs) & 255u, b2 = (unsigned)(int)(rintf(x[i][2] * inv) + ofs) & 255u, b3 = (unsigned)(int)(rintf(x[i][3] * inv) + ofs) & 255u;
            o4[i] = b0 | (b1 << 8) | (b2 << 16) | (b3 << 24); }
        if (GATHER_PART == 2) *(u32x4*)(ws + WS_UB + (size_t)set * TAB_SET + (isu ? 0 : (size_t)NEXP * 1024) + ((size_t)(lane >> 3) * NEXP + e) * 128 + 16 * (lane & 7)) = o4;
        else *(u32x4*)(ws + WS_UB + (size_t)set * TAB_SET + (size_t)e * 2048 + (isu ? 0 : 1024) + 16 * lane) = o4;
        if (lane == 0) { if (GATHER_PART) scl[2 * e + (isu ? 0 : 1)] = sc; else scl[rw] = sc; }
    }
}

__device__ __forceinline__ void transpose_item(const float* W, int ldw, int K, bf16_t* WT, LAS float* scr, int kb, int nb, int lane) {
    const int k0 = 64 * kb, n0 = 32 * nb;
#pragma unroll 8
    for (int i = 0; i < 32; ++i) { const int kk = 2 * i + (lane >> 5); scr[kk * 33 + (lane & 31)] = W[(size_t)(k0 + kk) * ldw + n0 + (lane & 31)]; }
    LDS_WAIT(); asm volatile("" ::: "memory");
    const int c = lane & 7;
#pragma unroll
    for (int j = 0; j < 4; ++j) { const int n = (lane >> 3) + 8 * j; const LAS float* s = scr + (8 * c) * 33 + n;
        u32x4 o; o.x = pkbf(s[0 * 33], s[1 * 33]); o.y = pkbf(s[2 * 33], s[3 * 33]); o.z = pkbf(s[4 * 33], s[5 * 33]); o.w = pkbf(s[6 * 33], s[7 * 33]);
        *(u32x4*)(WT + (size_t)(n0 + n) * K + k0 + 8 * c) = o; }
    LDS_WAIT(); asm volatile("" ::: "memory");
}
__device__ __forceinline__ void phase_prologue(LAS unsigned char* lds) {
    const KArgs ap = get_args();
#define a (*ap)

    const int tid = fresh_tid(), lane = tid & 63, wave = __builtin_amdgcn_readfirstlane(tid >> 6), G = fresh_g(), bx = fresh_bx();
    unsigned char* ws = a.ws;
    {
        LAS float* sc = (LAS float*)(lds + 70000);
        LAS float* part = (LAS float*)(lds + 70000 + 12288);
        for (int i = tid; i < 3 * 1024; i += 512) { const int r = i >> 10, k = i & 1023; const float v = r < 2 ? a.in[I_C][r * 1024 + k] : a.in[I_CCTX][k]; sc[i] = silu_f(v); }
        __syncthreads();
        float* mod = (float*)(ws + WS_MOD);
        for (int item = bx; item < DEPTH * 96; item += G) {
            const int l = item / 96, j0 = (item % 96) * 64;
            const float* wp = a.in[I_ADAW] + (size_t)l * 1024 * 6144 + (size_t)(wave * 128) * 6144 + j0 + lane;
            float a0 = 0.f, a1 = 0.f, a2 = 0.f;
#pragma unroll 8
            for (int kk = 0; kk < 128; ++kk) { const float w = wp[(size_t)kk * 6144]; const int k = wave * 128 + kk; a0 = fmaf(sc[k], w, a0); a1 = fmaf(sc[1024 + k], w, a1); a2 = fmaf(sc[2048 + k], w, a2); }
            part[(wave * 3 + 0) * 64 + lane] = a0; part[(wave * 3 + 1) * 64 + lane] = a1; part[(wave * 3 + 2) * 64 + lane] = a2;
            __syncthreads();
            if (tid < 192) { const int r = tid >> 6, jj = tid & 63; float s = a.in[I_ADAB][l * 6144 + j0 + jj];
#pragma unroll
                for (int w = 0; w < 8; ++w) s += part[(w * 3 + r) * 64 + jj];
                mod[(size_t)(l * 3 + r) * 6144 + j0 + jj] = s; }
            __syncthreads();
        }
    }
    {
        const int gw = bx * 8 + wave, NGW = G * 8;
        unsigned* wmaxw = (unsigned*)(ws + WS_CTL) + CW_WMAX;
        constexpr int NB_IN = NP / 64, NB_OUT = 1024 / 64, NB_Q = 2048 / 64, PER_L2 = (NB_IN + NB_OUT + NB_Q) * 8;
        for (int it = gw; it < DEPTH * PER_L2; it += NGW) { const int l = it / PER_L2; int r = it % PER_L2; const int kc = r & 7; r >>= 3;
            const int mi = r < NB_IN ? 0 : r < NB_IN + NB_OUT ? 1 : 2; const int nb = mi == 0 ? r : mi == 1 ? r - NB_IN : r - NB_IN - NB_OUT; const int ldw = mi == 0 ? NIN : mi == 1 ? 1024 : 2048;
            const float* wp = (mi == 0 ? a.in[I_WIN] + (size_t)l * 1024 * NIN : mi == 1 ? a.in[I_WOUT] + (size_t)l * 1024 * 1024 : a.in[I_WQ] + (size_t)l * 1024 * 2048) + (size_t)(kc * 128) * ldw + nb * 64 + lane;
            float mx = 0.f;
#pragma unroll 8
            for (int kk = 0; kk < 128; ++kk) mx = fmaxf(mx, fabsf(wp[(size_t)kk * ldw]));
            atomicMax(wmaxw + (l * 3 + mi) * 3072 + nb * 64 + lane, __float_as_uint(mx)); }
    }
    const size_t gt = (size_t)bx * 512 + tid, NT = (size_t)G * 512;
    for (size_t i = gt; i < (size_t)DEPTH * 16 * 1024; i += NT) { const int l = (int)(i >> 14), j = (int)((i >> 10) & 15), k = (int)(i & 1023);
        ((float*)(ws + WS_WSK))[i] = a.in[I_WIN][(size_t)l * 1024 * NIN + (size_t)k * NIN + NP + j]; }
    for (size_t i = gt; i < (size_t)DEPTH * 8 * 2 * 128 * 128 / 2; i += NT) { const f32x2 x = ((const f32x2*)a.in[I_SUBK])[i]; ((unsigned*)(ws + WS_SKB))[i] = pkbf(x[0], x[1]); }
    for (size_t i = gt; i < 8192; i += NT) { const int pos = (int)(i >> 5), fi = (int)(i & 31);
        const float inv = exp2f(-(float)fi * (13.287712379549449f / 32.f)); const float ang = (float)pos * inv;
        float rev = ang * 0.15915494309189535f; rev -= floorf(rev);
        ((float*)(ws + WS_ROPE))[i] = __builtin_amdgcn_cosf(rev); ((float*)(ws + WS_ROPE))[8192 + i] = __builtin_amdgcn_sinf(rev); }
}


__device__ __forceinline__ void quant_transpose_item(const float* W, int ldw, signed char* WT, const unsigned* wmaxw, LAS float* scr, int kb, int nb, int lane) {
    const int k0 = 64 * kb, n0 = 32 * nb;
#pragma unroll 8
    for (int i = 0; i < 32; ++i) { const int kk = 2 * i + (lane >> 5); scr[kk * 33 + (lane & 31)] = W[(size_t)(k0 + kk) * ldw + n0 + (lane & 31)]; }
    LDS_WAIT(); asm volatile("" ::: "memory");
    const int n = lane >> 1, hf = lane & 1;
    const float mx = __uint_as_float(wmaxw[n0 + n]), inv = mx > 0.f ? 127.f / mx : 0.f;
    u32x4 o[2];
#pragma unroll
    for (int q = 0; q < 8; ++q) { unsigned w = 0u;
#pragma unroll
        for (int b = 0; b < 4; ++b) { const int kk = 32 * hf + 4 * q + b; w |= ((unsigned)(int)rintf(scr[kk * 33 + n] * inv) & 255u) << (8 * b); }
        o[q >> 2][q & 3] = w; }
    u32x4* dst = (u32x4*)(WT + (size_t)(n0 + n) * 1024 + k0 + 32 * hf);
    dst[0] = o[0]; dst[1] = o[1];
    LDS_WAIT(); asm volatile("" ::: "memory");
}
__device__ __forceinline__ void phase_quant_weights(LAS unsigned char* lds) {
    const KArgs ap = get_args();
#define a (*ap)
    const int tid = fresh_tid(), lane = tid & 63, wave = __builtin_amdgcn_readfirstlane(tid >> 6), G = fresh_g(), bx = fresh_bx();
    unsigned char* ws = a.ws;
    LAS float* scr = (LAS float*)(lds + 65536 + wave * 8448);
    const unsigned* wmaxw = (const unsigned*)(ws + WS_CTL) + CW_WMAX;
    constexpr int I_IN = 16 * 96, I_OUT = 16 * 32, I_Q = 16 * 64, PER_L = I_IN + I_OUT + I_Q;
    for (int it = bx * 8 + wave; it < DEPTH * PER_L; it += G * 8) { const int l = it / PER_L; int r = it % PER_L;
        if (r < I_IN) quant_transpose_item(a.in[I_WIN] + (size_t)l * 1024 * NIN, NIN, (signed char*)(ws + WS_WINT) + (size_t)l * NP * 1024, wmaxw + (l * 3 + 0) * 3072, scr, r / 96, r % 96, lane);
        else if (r < I_IN + I_OUT) { r -= I_IN; quant_transpose_item(a.in[I_WOUT] + (size_t)l * 1024 * 1024, 1024, (signed char*)(ws + WS_WOUTT) + (size_t)l * 1024 * 1024, wmaxw + (l * 3 + 1) * 3072, scr, r / 32, r % 32, lane); }
        else { r -= I_IN + I_OUT; quant_transpose_item(a.in[I_WQ] + (size_t)l * 1024 * 2048, 2048, (signed char*)(ws + WS_WQT) + (size_t)l * 2048 * 1024, wmaxw + (l * 3 + 2) * 3072, scr, r / 64, r % 64, lane); } }
#undef a
}

template <bool SK>
__device__ __forceinline__ void phase_norm(int l, int which, LAS unsigned char* lds) {
    const KArgs ap = get_args();
#define a (*ap)

    const int tid = fresh_tid(), lane = tid & 63, wave = __builtin_amdgcn_readfirstlane(tid >> 6), G = fresh_g(), bx = fresh_bx();
    unsigned char* ws = a.ws;
    LAS float* wsk = (LAS float*)lds;
    if (SK) { const float* src = (const float*)(ws + WS_WSK) + (size_t)l * 16384; for (int i = tid; i < 16384 / 4; i += 512) ((LAS f32x4*)wsk)[i] = ((const f32x4*)src)[i]; __syncthreads(); }
    const int nrows = (which == 1 && l == DEPTH - 1) ? ML : M;
    const float* nw = a.in[which ? I_N2W : I_N1W] + l * 1024;
    const float* modl = (const float*)(ws + WS_MOD) + (size_t)l * 3 * 6144;
    const int shoff = which ? 3072 : 0, scoff = which ? 4096 : 1024;
    f32x4 nwv[4];
#pragma unroll
    for (int j = 0; j < 4; ++j) nwv[j] = *(const f32x4*)(nw + 4 * lane + 256 * j);
    for (int row = wave * G + bx; row < nrows; row += G * 8) {
        const int mrow = row < ML ? (row >= T ? 1 : 0) : 2;
        const float* md = modl + mrow * 6144;
        f32x4 v[4]; float ss = 0.f;
        if (l == 0 && which == 0) { const float* src = row < ML ? a.in[I_X] + (size_t)row * D : a.in[I_CTX] + (size_t)(row - ML) * D;
#pragma unroll
            for (int j = 0; j < 4; ++j) v[j] = *(const f32x4*)(src + 4 * lane + 256 * j); }
        else { const bf16_t* src = (const bf16_t*)(ws + WS_XB) + (size_t)row * D;
#pragma unroll
            for (int j = 0; j < 4; ++j) { const u32x2 w_ = *(const u32x2*)(src + 4 * lane + 256 * j); v[j] = (f32x4){bflo(w_[0]), bfhi(w_[0]), bflo(w_[1]), bfhi(w_[1])}; } }
#pragma unroll
        for (int j = 0; j < 4; ++j) ss += (v[j][0] * v[j][0] + v[j][1] * v[j][1]) + (v[j][2] * v[j][2] + v[j][3] * v[j][3]);
        const float rstd = rsqrtf(wave_sum(ss) * (1.f / D) + EPS);
        signed char* hrow = (signed char*)(ws + WS_H) + (size_t)row * D;
        float hmx = 0.f;
#pragma unroll
        for (int j = 0; j < 4; ++j) { const f32x4 sc = *(const f32x4*)(md + scoff + 4 * lane + 256 * j), sh = *(const f32x4*)(md + shoff + 4 * lane + 256 * j);
            v[j] = v[j] * rstd * nwv[j] * (sc + 1.f) + sh; hmx = fmaxf(hmx, fmaxf(fmaxf(fabsf(v[j][0]), fabsf(v[j][1])), fmaxf(fabsf(v[j][2]), fabsf(v[j][3])))); }
        hmx = fmaxf(wave_max(hmx), 1e-30f);
        { const float hinv = 127.f / hmx;
#pragma unroll
          for (int j = 0; j < 4; ++j) *(unsigned*)(hrow + 4 * lane + 256 * j) = ((unsigned)(int)rintf(v[j][0] * hinv) & 255u) | (((unsigned)(int)rintf(v[j][1] * hinv) & 255u) << 8) | (((unsigned)(int)rintf(v[j][2] * hinv) & 255u) << 16) | (((unsigned)(int)rintf(v[j][3] * hinv) & 255u) << 24);
          if (lane == 0) ((float*)(ws + WS_GB))[row] = hmx * (1.f / 127.f); }
        if (SK) {
            float p[16];
#pragma unroll
            for (int c = 0; c < 16; ++c) { float q = 0.f;
#pragma unroll
                for (int j = 0; j < 4; ++j) { const f32x4 w = *(const LAS f32x4*)(wsk + c * 1024 + 4 * lane + 256 * j); q += (v[j][0] * w[0] + v[j][1] * w[1]) + (v[j][2] * w[2] + v[j][3] * w[3]); }
                p[c] = q; }
            { const bool hb = (lane & 32) != 0;
#pragma unroll
              for (int c = 0; c < 8; ++c) { const float keep = hb ? p[c + 8] : p[c], send = hb ? p[c] : p[c + 8]; p[c] = keep + lane_xor<32>(send); } }
            { const bool hb = (lane & 16) != 0;
#pragma unroll
              for (int c = 0; c < 4; ++c) { const float keep = hb ? p[c + 4] : p[c], send = hb ? p[c] : p[c + 4]; p[c] = keep + lane_xor<16>(send); } }
            { const bool hb = (lane & 8) != 0;
#pragma unroll
              for (int c = 0; c < 2; ++c) { const float keep = hb ? p[c + 2] : p[c], send = hb ? p[c] : p[c + 2]; p[c] = keep + lane_xor<8>(send); } }
            { const bool hb = (lane & 4) != 0; const float keep = hb ? p[1] : p[0], send = hb ? p[0] : p[1]; p[0] = keep + lane_xor<4>(send); }
            p[0] += lane_xor<2>(p[0]); p[0] += lane_xor<1>(p[0]);
            if ((lane & 3) == 0) { const int c = ((lane >> 5) & 1) * 8 + ((lane >> 4) & 1) * 4 + ((lane >> 3) & 1) * 2 + ((lane >> 2) & 1); ((float*)(ws + WS_BA))[(size_t)row * 16 + c] = p[0]; }
        }
    }
    if (SK) __syncthreads();
}

__device__ __forceinline__ void phase_prep(int l, LAS unsigned char* lds) {
    const KArgs ap = get_args();
#define a (*ap)

    const int tid = fresh_tid(), lane = tid & 63, wave = __builtin_amdgcn_readfirstlane(tid >> 6), G = fresh_g(), bx = fresh_bx();
    unsigned char* ws = a.ws;
    const bf16_t* P = (const bf16_t*)(ws + WS_P);
    const float* ropec = (const float*)(ws + WS_ROPE); const float* ropes = ropec + 8192;
    const int sec = lane >> 5, fi = lane & 31;
    const float qw0 = a.in[I_QNW][l * 128 + sec * 64 + fi], qw1 = a.in[I_QNW][l * 128 + sec * 64 + 32 + fi];
    const float kw0 = a.in[I_KNW][l * 128 + sec * 64 + fi], kw1 = a.in[I_KNW][l * 128 + sec * 64 + 32 + fi];
    for (int row = wave * G + bx; row < M; row += G * 8) {
        const bool lat = row < ML;
        int b, tt, tlen; if (lat) { b = row >> 14; tt = row & (T - 1); tlen = T; } else { b = (row - ML) >> 8; tt = (row - ML) & (CT - 1); tlen = CT; }
        const bf16_t* prow = P + (size_t)row * NP;
        unsigned short xa[6][2];
#pragma unroll
        for (int hh = 0; hh < 6; ++hh) { const bf16_t* xp = prow + (hh < 4 ? hh * 128 : 512 + (hh - 4) * 128) + sec * 64 + fi; xa[hh][0] = xp[0]; xa[hh][1] = xp[32]; }
        const u32x2 vcp = *(const u32x2*)(prow + 768 + 4 * lane);
        float cs = 1.f, sn = 0.f;
        if (lat) { const int pos = sec ? (tt & 63) : (tt >> 6); cs = ropec[pos * 32 + fi]; sn = ropes[pos * 32 + fi]; }
        unsigned char* qo8 = ws + WS_QA + (size_t)row * 512;
        const size_t kvrow = (size_t)b * KVLEN + (lat ? tt : T + tt);
        unsigned char* ko8 = ws + WS_KA + kvrow * 256;
        float ssq[6];
#pragma unroll
        for (int hh = 0; hh < 6; ++hh) { const float x0 = bf2f(xa[hh][0]), x1 = bf2f(xa[hh][1]); ssq[hh] = x0 * x0 + x1 * x1; }
#pragma unroll
        for (int hh = 0; hh < 6; ++hh) ssq[hh] = wave_sum(ssq[hh]);
#pragma unroll
        for (int hh = 0; hh < 6; ++hh) {
            const float x0 = bf2f(xa[hh][0]), x1 = bf2f(xa[hh][1]);
            const float rs = rsqrtf(ssq[hh] * (1.f / 128.f) + EPS);
            const float y0 = x0 * rs * (hh < 4 ? qw0 : kw0), y1 = x1 * rs * (hh < 4 ? qw1 : kw1);
            const float qsc = hh < 4 ? 0.088388347648318440f * 1.4426950408889634f : 1.f;
            const float o0 = (y0 * cs - y1 * sn) * qsc, o1 = (y1 * cs + y0 * sn) * qsc;
            unsigned char* op8 = (hh < 4 ? qo8 + hh * 128 : ko8 + (hh - 4) * 128) + sec * 64 + fi;
            const float f8s = hh < 4 ? 8.f : 1.f;
            const int pk8 = __builtin_amdgcn_cvt_pk_fp8_f32(o0 * f8s, o1 * f8s, 0, false);
            op8[0] = (unsigned char)(pk8 & 255); op8[32] = (unsigned char)((pk8 >> 8) & 255);
        }
        { const int pos = lat ? tt : T + tt, tile = pos >> 6, k64 = pos & 63, k32 = k64 & 31;
          const int bytepos = 32 * ((k32 >> 2) & 1) + 16 * (k64 >> 5) + (k32 & 3) + 4 * (k32 >> 3);
          unsigned char* vt = ws + WS_VA + ((size_t)(b * 2) * (KVLEN / 64) + tile) * 8192 + bytepos;
          const unsigned short* vsrc = (const unsigned short*)&vcp;
          const int kvh_ = lane >> 5, d0 = (4 * lane) & 127;
          const int pk01 = __builtin_amdgcn_cvt_pk_fp8_f32(bf2f(vsrc[0]), bf2f(vsrc[1]), 0, false), pk23 = __builtin_amdgcn_cvt_pk_fp8_f32(bf2f(vsrc[2]), bf2f(vsrc[3]), 0, false);
          unsigned char* vt2 = vt + (size_t)kvh_ * (KVLEN / 64) * 8192 + (size_t)d0 * 64;
          vt2[0] = (unsigned char)(pk01 & 255); vt2[64] = (unsigned char)((pk01 >> 8) & 255); vt2[128] = (unsigned char)(pk23 & 255); vt2[192] = (unsigned char)((pk23 >> 8) & 255); }
    }
    __syncthreads();
}

constexpr int ATT_PARTS = 4;
__device__ __forceinline__ void phase_attn(int l, unsigned char* lds_raw, volatile LAS unsigned* MISC, int rep) {
    const KArgs ap = get_args();
#define a (*ap)
    unsigned char* ws = a.ws;
    const unsigned char* QA = ws + WS_QA; const unsigned char* KA = ws + WS_KA; const unsigned char* VT = ws + WS_VA;
    bf16_t* CAT = (bf16_t*)(ws + WS_CAT); float* LSE = (float*)(ws + WS_BA);
    unsigned* ctr = (unsigned*)(ws + WS_CTL) + 8192 + 64 * l + 1024 * rep;
    const int natt = 2048 + (l < DEPTH - 1 ? 8 : 0);
    constexpr int CONV_ROWS = 64, NCONV = 2 * NEXP / CONV_ROWS;
    const int nunits = natt + (l + 1 < DEPTH ? NCONV : 0) + (l == 0 ? NCONV : 0);
    float braw;
    { const int ln = threadIdx.x & 63; float mq = fmaxf(fabsf(a.in[I_QNW][l * 128 + ln]), fabsf(a.in[I_QNW][l * 128 + 64 + ln])), mk = fmaxf(fabsf(a.in[I_KNW][l * 128 + ln]), fabsf(a.in[I_KNW][l * 128 + 64 + ln]));
      mq = wave_max(mq); mk = wave_max(mk);
      braw = __builtin_bit_cast(float, __builtin_amdgcn_readfirstlane(__builtin_bit_cast(int, 128.f * mq * mk))); }
    if (threadIdx.x == 0) MISC[12] = __hip_atomic_fetch_add(ctr, 1u, __ATOMIC_RELAXED, __HIP_MEMORY_SCOPE_AGENT);
    __syncthreads();
    int u = (int)MISC[12], par = 0;
    for (; u < nunits; ) {
        if (threadIdx.x == 0) MISC[13 - par] = __hip_atomic_fetch_add(ctr, 1u, __ATOMIC_RELAXED, __HIP_MEMORY_SCOPE_AGENT);
        if (u >= natt) {
            const int tq_ = fresh_tid();
            const int ci_ = u - natt, own_ = ci_ >= NCONV ? 1 : 0;
            const int rwb = (ci_ - own_ * NCONV) * CONV_ROWS + __builtin_amdgcn_readfirstlane(tq_ >> 6) * 8;
            convert_tables(a.in[I_U], a.in[I_V], ws, l + 1 - own_, rwb, 1, tq_ & 63, rwb + 8);
            __syncthreads();
            u = (int)MISC[13 - par]; par ^= 1;
            continue;
        }
        size_t r0, kv0; int h, kvh, seq, ldo; bf16_t* ob; float* lse;
        if (u < 2048) { const int qb = u & 63, g = (u >> 6) & 1, part = (u >> 7) & 3, b = u >> 10; kvh = (u >> 9) & 1; h = kvh * 2 + g;
            const int t0 = (part >> 1) * 130 + (part & 1) * 64;
            r0 = (size_t)b * T + (size_t)qb * 256; kv0 = (size_t)b * KVLEN + (size_t)t0 * 64; seq = ((part & 1) ? 66 : 64) * 64;
            ob = part ? (bf16_t*)(ws + (part == 1 ? WS_DQ : part == 2 ? WS_DK : WS_DV)) + r0 * 512 + h * 128 : CAT + r0 * 1024 + h * 128; ldo = part ? 512 : 1024; lse = LSE + ((size_t)part * ML + r0) * 4 + h; }
        else { const int b = (u - 2048) >> 2; h = (u - 2048) & 3; kvh = h >> 1; r0 = (size_t)ML + (size_t)b * CT; kv0 = (size_t)b * KVLEN + T; seq = CT;
            ob = CAT + r0 * 1024 + h * 128; ldo = 1024; lse = nullptr; }
        att::attn_dense_body(QA + r0 * 512 + h * 128, KA + kv0 * 256 + kvh * 128, VT + ((size_t)((kv0 / KVLEN) * 2 + kvh) * (KVLEN / 64) + (kv0 % KVLEN) / 64) * 8192, ob, ldo, seq, (char*)lds_raw, lse, braw);
        u = (int)MISC[13 - par]; par ^= 1;
    }
#undef a
}

__device__ __forceinline__ int tokperm(int q, int hh, int jj) { return 16 * q + 8 * (jj >> 2) + 4 * hh + (jj & 3); }
__device__ __forceinline__ int crow16(int r, int hi) { return (r & 3) + 8 * (r >> 2) + 4 * hi; }
__device__ __forceinline__ int kperm16(int s_, int g, int jj) { return 32 * s_ + 16 * (jj >> 2) + 4 * g + (jj & 3); }
__device__ __forceinline__ int frag_off(int i, int j) {
    return (((i >> 4) * 2 + (j >> 5)) * 64 + ((i & 15) + 16 * ((j >> 2) & 3))) * 16 + (4 * ((j >> 4) & 1) + (j & 3)) * 2;
}
template <int MODE>
__device__ __forceinline__ void phase_dn_chunkprep(int l, LAS unsigned char* lds) {
    const KArgs ap = get_args();
#define a (*ap)
    const int tid = fresh_tid(), lane = tid & 63, wave = __builtin_amdgcn_readfirstlane(tid >> 6), G = fresh_g(), bx = fresh_bx();
    unsigned char* ws = a.ws;
    constexpr int KT_OFF = 0, QT_OFF = 17408, VT_OFF = 34816, GS_OFF = 52224, RS_OFF = 68864, AM_OFF = 85504, SC_OFF = 120320, IMG_OFF = 0;
    const int r = lane & 31, hh = lane >> 5;
    const bf16_t* DQ = (const bf16_t*)(ws + WS_DQ); const bf16_t* DK = (const bf16_t*)(ws + WS_DK); const bf16_t* DV = (const bf16_t*)(ws + WS_DV);
    const float* BA = (const float*)(ws + WS_BA);
    constexpr int NTASK = MODE ? NB * 4 * 4 : NB * 4 * (NCH - 4);
#define CP_TASKID(t_) (MODE ? ((t_) >> 2) * NCH + ((t_) & 3) : ((t_) >> 8) * NCH + 4 + ((t_) & 255))
    LAS float* gsc = (LAS float*)(lds + SC_OFF);
    LAS float* bsc = gsc + 128;
    LAS float* gcs = gsc + 256;
    constexpr int CW_OFF = 121856, DI_OFF = CW_OFF + 5 * 1536 * 4;
    static_assert(DI_OFF + 8192 <= LDS_MISC, "chunkprep LDS");
    LAS float* cwl = (LAS float*)(lds + CW_OFF);
    for (int i = tid; i < 5 * 1536; i += 512) cwl[i] = a.in[I_CONVW][(size_t)l * 5 * 1536 + i];
    __syncthreads();
    const bf16_t* P = (const bf16_t*)(ws + WS_P);
    u32x4 xin[3][5][2];
#define CP_LOADX(task_) do { const int cidx_ = (task_) % NCH, bh_ = (task_) / NCH, b_ = bh_ >> 2, h_ = bh_ & 3; \
        const int row0_ = cidx_ < 4 ? ML + b_ * CT + cidx_ * 64 : b_ * T + (cidx_ - 4) * 64, tt_ = (cidx_ < 4 ? cidx_ * 64 : (cidx_ - 4) * 64) + (tid >> 3), tlen_ = cidx_ < 4 ? CT : T; \
        _Pragma("unroll") for (int j = 0; j < 5; ++j) { const int t2 = tt_ + j - 2; const bool ok = t2 >= 0 && t2 < tlen_; \
            const bf16_t* xr = P + (size_t)(row0_ + (tid >> 3) + (ok ? j - 2 : 0)) * NP + 1024 + h_ * 128 + (tid & 7) * 16; \
            _Pragma("unroll") for (int m = 0; m < 3; ++m) { const u32x4 w0 = *(const u32x4*)(xr + m * 512), w1 = *(const u32x4*)(xr + m * 512 + 8); \
                xin[m][j][0] = ok ? w0 : (u32x4){0u, 0u, 0u, 0u}; xin[m][j][1] = ok ? w1 : (u32x4){0u, 0u, 0u, 0u}; } } } while (0)
    if (bx < NTASK) CP_LOADX(CP_TASKID(bx));
    for (int tk = bx; tk < NTASK; tk += G) {
        const int task = CP_TASKID(tk);
        const int cidx = task % NCH, bh = task / NCH, b = bh >> 2, h = bh & 3;
        const int row0 = cidx < 4 ? ML + b * CT + cidx * 64 : b * T + (cidx - 4) * 64;
        unsigned char* rec = ws + WS_REC + (size_t)task * REC_BYTES;
        {
            const int rr = tid >> 3, seg = tid & 7;
            if (tid < 128) { const int d = tid >> 6, i = tid & 63, dh = d * 4 + h;
                const float xb = BA[(size_t)(row0 + i) * 16 + dh], z = BA[(size_t)(row0 + i) * 16 + 8 + dh] + a.in[I_DTB][l * 8 + dh];
                bsc[tid] = 1.f / (1.f + __expf(-xb)); gsc[tid] = -__expf(a.in[I_ALOG][l * 8 + dh]) * (fmaxf(z, 0.f) + log1pf(__expf(-fabsf(z)))); }
#pragma unroll
            for (int m = 0; m < 3; ++m) {
                float y[16];
#pragma unroll
                for (int c = 0; c < 16; ++c) y[c] = 0.f;
#pragma unroll
                for (int j = 0; j < 5; ++j) { const LAS float* wp = cwl + j * 1536 + m * 512 + h * 128 + seg * 16;
#pragma unroll
                    for (int q4 = 0; q4 < 4; ++q4) { const f32x4 wv = *(const LAS f32x4*)(wp + 4 * q4); const unsigned u0 = xin[m][j][q4 >> 1][2 * (q4 & 1)], u1 = xin[m][j][q4 >> 1][2 * (q4 & 1) + 1];
                        y[4 * q4 + 0] = fmaf(bflo(u0), wv[0], y[4 * q4 + 0]); y[4 * q4 + 1] = fmaf(bfhi(u0), wv[1], y[4 * q4 + 1]); y[4 * q4 + 2] = fmaf(bflo(u1), wv[2], y[4 * q4 + 2]); y[4 * q4 + 3] = fmaf(bfhi(u1), wv[3], y[4 * q4 + 3]); } }
                float ss = 0.f;
#pragma unroll
                for (int c = 0; c < 16; ++c) { y[c] = silu_f(y[c]); ss = fmaf(y[c], y[c], ss); }
                if (m < 2) { ss += lane_xor<1>(ss); ss += lane_xor<2>(ss); ss += lane_xor<4>(ss);
                    float sc = rsqrtf(ss + EPS); if (m == 0) sc *= 0.088388347648318440f;
#pragma unroll
                    for (int c = 0; c < 16; ++c) y[c] *= sc; }
                u32x4 o0, o1; o0.x = pkbf(y[0], y[1]); o0.y = pkbf(y[2], y[3]); o0.z = pkbf(y[4], y[5]); o0.w = pkbf(y[6], y[7]); o1.x = pkbf(y[8], y[9]); o1.y = pkbf(y[10], y[11]); o1.z = pkbf(y[12], y[13]); o1.w = pkbf(y[14], y[15]);
                LAS unsigned char* dst = lds + (m == 0 ? QT_OFF : m == 1 ? KT_OFF : VT_OFF) + rr * 272 + seg * 32;
                *(LAS u32x4*)dst = o0; *(LAS u32x4*)(dst + 16) = o1;
            }
        }
        __syncthreads();
        {
            const int mat = wave >> 2, ti = (wave >> 1) & 1, tj = wave & 1;
            f32x16 acc = {};
#pragma unroll
            for (int ks = 0; ks < 8; ++ks) {
                const bf16x8 av = *(const LAS bf16x8*)(lds + (mat ? QT_OFF : KT_OFF) + (32 * ti + r) * 272 + (16 * ks + 8 * hh) * 2);
                const bf16x8 bv = *(const LAS bf16x8*)(lds + KT_OFF + (32 * tj + r) * 272 + (16 * ks + 8 * hh) * 2);
                acc = __builtin_amdgcn_mfma_f32_32x32x16_bf16(av, bv, acc, 0, 0, 0);
            }
            LAS float* dst = (LAS float*)(lds + (mat ? RS_OFF : GS_OFF));
#pragma unroll
            for (int i = 0; i < 16; ++i) dst[(32 * ti + crow16(i, hh)) * 65 + 32 * tj + r] = acc[i];
        }
        { const int r16 = lane & 15, g4 = lane >> 4;
#pragma unroll
        for (int t = 0; t < 2; ++t) { const int f = wave * 2 + t, mt = f >> 2, sk = f & 3;
            { const u32x2 lo = *(const LAS u32x2*)(lds + KT_OFF + (16 * mt + r16) * 272 + (32 * sk + 4 * g4) * 2), hi2 = *(const LAS u32x2*)(lds + KT_OFF + (16 * mt + r16) * 272 + (32 * sk + 16 + 4 * g4) * 2);
              *(u32x4*)(rec + REC_K + f * 1024 + lane * 16) = (u32x4){lo.x, lo.y, hi2.x, hi2.y}; }
            { const u32x2 lo = *(const LAS u32x2*)(lds + QT_OFF + (16 * mt + r16) * 272 + (32 * sk + 4 * g4) * 2), hi2 = *(const LAS u32x2*)(lds + QT_OFF + (16 * mt + r16) * 272 + (32 * sk + 16 + 4 * g4) * 2);
              *(u32x4*)(rec + REC_Q + f * 1024 + lane * 16) = (u32x4){lo.x, lo.y, hi2.x, hi2.y}; } }
#pragma unroll
        for (int t = 0; t < 2; ++t) { const int f = wave * 2 + t, mt = f >> 1, sk = f & 1;
            unsigned e[8];
#pragma unroll
            for (int jj = 0; jj < 8; ++jj) e[jj] = *(const LAS unsigned short*)(lds + KT_OFF + kperm16(sk, g4, jj) * 272 + (16 * mt + r16) * 2);
            *(u32x4*)(rec + REC_KT + f * 1024 + lane * 16) = (u32x4){e[0] | (e[1] << 16), e[2] | (e[3] << 16), e[4] | (e[5] << 16), e[6] | (e[7] << 16)}; }
        { const int sl = wave;
            unsigned e[16];
#pragma unroll
            for (int i = 0; i < 16; ++i) e[i] = *(const LAS unsigned short*)(lds + VT_OFF + (16 * (i >> 2) + 4 * g4 + (i & 3)) * 272 + (16 * sl + r16) * 2);
            u32x4* vp = (u32x4*)(rec + REC_V + sl * 2048 + lane * 32);
            vp[0] = (u32x4){e[0] | (e[1] << 16), e[2] | (e[3] << 16), e[4] | (e[5] << 16), e[6] | (e[7] << 16)};
            vp[1] = (u32x4){e[8] | (e[9] << 16), e[10] | (e[11] << 16), e[12] | (e[13] << 16), e[14] | (e[15] << 16)}; }
        }
        if (tk + G < NTASK) CP_LOADX(CP_TASKID(tk + G));
        if (wave < 2) { const int d = wave; float gv = gsc[d * 64 + (d ? 63 - lane : lane)];
            gv += __builtin_bit_cast(float, __builtin_amdgcn_update_dpp(0, __builtin_bit_cast(int, gv), 0x111, 0xF, 0xF, true));
            gv += __builtin_bit_cast(float, __builtin_amdgcn_update_dpp(0, __builtin_bit_cast(int, gv), 0x112, 0xF, 0xF, true));
            gv += __builtin_bit_cast(float, __builtin_amdgcn_update_dpp(0, __builtin_bit_cast(int, gv), 0x114, 0xF, 0xF, true));
            gv += __builtin_bit_cast(float, __builtin_amdgcn_update_dpp(0, __builtin_bit_cast(int, gv), 0x118, 0xF, 0xF, true));
            { const float t0 = __builtin_bit_cast(float, __builtin_amdgcn_readlane(__builtin_bit_cast(int, gv), 15)), t1 = __builtin_bit_cast(float, __builtin_amdgcn_readlane(__builtin_bit_cast(int, gv), 31)), t2 = __builtin_bit_cast(float, __builtin_amdgcn_readlane(__builtin_bit_cast(int, gv), 47));
              const int rw_ = lane >> 4; gv += (rw_ >= 1 ? t0 : 0.f) + (rw_ >= 2 ? t1 : 0.f) + (rw_ >= 3 ? t2 : 0.f); }
            gcs[d * 64 + lane] = gv; }
        __syncthreads();
        const LAS float* Gs = (const LAS float*)(lds + GS_OFF); const LAS float* Rs = (const LAS float*)(lds + RS_OFF);
#pragma unroll 4
        for (int t = 0; t < 16; ++t) { const int e = tid + 512 * t, d = e >> 12, jp = (e >> 6) & 63, ip = e & 63;
            const int in_ = d ? 63 - ip : ip, jn = d ? 63 - jp : jp;
            const float dec = __expf(fminf(gcs[d * 64 + ip] - gcs[d * 64 + jp], 0.f));
            const float av = (jp < ip) ? bsc[d * 64 + in_] * Gs[in_ * 65 + jn] * dec : 0.f;
            ((LAS float*)(lds + AM_OFF))[d * 4352 + jp * 68 + ip] = av;
            const float qk = (jp <= ip) ? Rs[in_ * 65 + jn] * dec : 0.f;
            *(LAS unsigned short*)(lds + IMG_OFF + d * 16384 + 8192 + frag_off(in_, jn)) = (unsigned short)(pkbf(qk, 0.f) & 0xffffu); }
        __syncthreads();
        { int ln_ = lane; asm volatile("" : "+v"(ln_));
          const int d = wave >> 2, nt = wave & 3, n16 = ln_ & 15, g4 = ln_ >> 4;
          const LAS float* At = (const LAS float*)(lds + AM_OFF) + d * 4352;
          LAS float* Xd = (LAS float*)(lds + GS_OFF) + d * 4096;
          LAS float* Dinv = (LAS float*)(lds + DI_OFF) + d * 1024;
          { float x[16];
#pragma unroll
            for (int q = 0; q < 16; ++q) x[q] = (q == n16) ? 1.f : 0.f;
#pragma unroll
            for (int r2 = 0; r2 < 15; ++r2) { const LAS float* ar = At + (16 * nt + r2) * 68 + 16 * nt; const float xr = x[r2];
#pragma unroll
                for (int q4 = (r2 + 1) / 4; q4 < 4; ++q4) { const f32x4 a4 = *(const LAS f32x4*)(ar + 4 * q4);
#pragma unroll
                    for (int q = 0; q < 4; ++q) if (4 * q4 + q > r2) x[4 * q4 + q] = fmaf(-a4[q], xr, x[4 * q4 + q]); } }
            if (ln_ < 16) {
#pragma unroll
                for (int q = 0; q < 16; ++q) Dinv[nt * 256 + q * 16 + n16] = x[q]; } }
          if (wave == 2 || wave == 3) { const int d2 = wave - 2, ip = d2 ? 63 - lane : lane; const float gl = gcs[d2 * 64 + 63], gi = gcs[d2 * 64 + ip];
            float* sc = (float*)(rec + REC_DIR + d2 * REC_DIRSZ + 16384);
            sc[lane] = __expf(gi); sc[64 + lane] = __expf(gl - gi); if (lane == 0) sc[128] = __expf(gl); }
          __syncthreads();
          const int c = 16 * nt + n16, jn = d ? 63 - c : c; const float bj = bsc[d * 64 + jn];
          const int fj = (jn >> 5) * 1024 + ((jn >> 2) & 3) * 256 + ((jn >> 4) & 1) * 8 + (jn & 3) * 2;
#pragma unroll 1
          for (int B = 0; B < 4; ++B) {
            f32x4 y = {0.f, 0.f, 0.f, 0.f};
            if (nt <= B) {
                f32x4 acc;
#pragma unroll
                for (int r2 = 0; r2 < 4; ++r2) acc[r2] = (nt == B && 4 * g4 + r2 == n16) ? 1.f : 0.f;
#pragma unroll 2
                for (int j0 = 0; j0 < 16 * B; j0 += 4) { const float av = -At[(j0 + g4) * 68 + 16 * B + n16], bv = Xd[(j0 + g4) * 64 + c];
                    acc = __builtin_amdgcn_mfma_f32_16x16x4f32(av, bv, acc, 0, 0, 0); }
#pragma unroll
                for (int r2 = 0; r2 < 4; ++r2) Xd[(16 * B + 4 * g4 + r2) * 64 + c] = acc[r2];
#pragma unroll
                for (int s4 = 0; s4 < 4; ++s4) { const float av = Dinv[B * 256 + n16 * 16 + 4 * s4 + g4], bv = Xd[(16 * B + 4 * s4 + g4) * 64 + c];
                    y = __builtin_amdgcn_mfma_f32_16x16x4f32(av, bv, y, 0, 0, 0); }
            }
#pragma unroll
            for (int r2 = 0; r2 < 4; ++r2) { const int i = 16 * B + 4 * g4 + r2, in_ = d ? 63 - i : i; Xd[i * 64 + c] = y[r2];
                *(LAS unsigned short*)(lds + IMG_OFF + d * 16384 + (in_ >> 4) * 2048 + (in_ & 15) * 16 + fj) = (unsigned short)(pkbf_c(y[r2] * bj, 0.f) & 0xffffu); }
            __syncthreads();
          }
        }
#pragma unroll
        for (int t = 0; t < 4; ++t) { const int p = tid + 512 * t, d = p >> 10, off = (p & 1023) * 16;
            *(u32x4*)(rec + REC_DIR + d * REC_DIRSZ + off) = *(const LAS u32x4*)(lds + IMG_OFF + d * 16384 + off); }
        __syncthreads();
    }
#undef CP_LOADX
#undef CP_TASKID
#undef a
}

__device__ __forceinline__ bf16x8 pack44(const f32x4& lo, const f32x4& hi) {
    u32x4 p; p.x = pkbf_c(lo[0], lo[1]); p.y = pkbf_c(lo[2], lo[3]); p.z = pkbf_c(hi[0], hi[1]); p.w = pkbf_c(hi[2], hi[3]);
    return __builtin_bit_cast(bf16x8, p);
}
template <int VAR>
__device__ __forceinline__ void phase_dn_scan(int l, LAS unsigned char* lds) {
    const KArgs ap = get_args();
#define a (*ap)
    const int tid = fresh_tid(), lane = tid & 63, wave = __builtin_amdgcn_readfirstlane(tid >> 6), bx = fresh_bx();
    unsigned char* ws = a.ws;
    if (bx >= 32) return;
    const int chain = bx >> 1, half = bx & 1, b = chain >> 3, h = (chain >> 1) & 3, dir = chain & 1;
    const unsigned char* recb = ws + WS_REC + (size_t)((b * 4 + h) * NCH) * REC_BYTES;
    constexpr int BUFSZ = 74752;
#define CIDX(n) (dir ? ((n) < 4 ? 3 - (n) : 263 - (n)) : (n))
    if (wave >= 4) {
        const int sw = wave - 4;
#define DN_PIECE(i_) ((sw + 4 * (i_)) < 73 ? (sw + 4 * (i_)) : 72)
#define DN_SRC(rec_, p_) ((p_) < 48 ? (rec_) + (p_) * 1024 : (p_) < 65 ? (rec_) + REC_DIR + dir * REC_DIRSZ + ((p_) - 48) * 1024 : (rec_) + REC_V + half * 8192 + ((p_) - 65) * 1024)
#define DN_STAGE(n, bi) do { const unsigned char* rec_ = recb + (size_t)CIDX(n) * REC_BYTES; _Pragma("unroll") for (int i_ = 0; i_ < 19; ++i_) { const int p_ = DN_PIECE(i_); \
        __builtin_amdgcn_global_load_lds((const unsigned*)(DN_SRC(rec_, p_) + lane * 16), (LAS unsigned*)(lds + (bi) * BUFSZ + p_ * 1024), 16, 0, 0); } } while (0)
#define DN_SYNC() do { asm volatile("s_waitcnt vmcnt(0)" ::: "memory"); __builtin_amdgcn_s_barrier(); asm volatile("" ::: "memory"); } while (0)
        if (VAR != 3) DN_STAGE(0, 0);
        DN_SYNC();
        for (int n = 0; n < NCH; ++n) {
            if (VAR != 3 && n + 1 < NCH) DN_STAGE(n + 1, (n + 1) & 1);
            DN_SYNC();
        }
#undef DN_STAGE
#undef DN_PIECE
#undef DN_SRC
#undef DN_SYNC
    } else {
        const int sl = half * 4 + wave, c16 = lane & 15, g4 = lane >> 4;
        bf16_t* Og = (bf16_t*)(ws + (dir ? WS_OB : WS_OF)) + h * 128 + sl * 16 + c16;
        f32x4 S[8];
#pragma unroll
        for (int i = 0; i < 8; ++i) S[i] = (f32x4){0.f, 0.f, 0.f, 0.f};
        asm volatile("s_waitcnt lgkmcnt(0)" ::: "memory"); __builtin_amdgcn_s_barrier(); asm volatile("" ::: "memory");
        for (int n = 0; n < NCH; ++n) {
            if (VAR == 2) { asm volatile("s_waitcnt lgkmcnt(0)" ::: "memory"); __builtin_amdgcn_s_barrier(); asm volatile("" ::: "memory"); continue; }
            const LAS unsigned char* buf = lds + (n & 1) * BUFSZ;
            const int cidx = CIDX(n);
            const u32x4 vc0 = *(const LAS u32x4*)(buf + 66560 + wave * 2048 + lane * 32), vc1 = *(const LAS u32x4*)(buf + 66560 + wave * 2048 + lane * 32 + 16);
#define FR(off, f) (*(const LAS bf16x8*)(buf + (off) + (f) * 1024 + lane * 16))
#define MF(A, B, C) __builtin_amdgcn_mfma_f32_16x16x32_bf16((A), (B), (C), 0, 0, 0)
#define SB_() __builtin_amdgcn_sched_barrier(0)
            bf16x8 fa[8], fb[8];
            f32x4 eg[4], dl[4];
#pragma unroll
            for (int mt = 0; mt < 4; ++mt) { eg[mt] = *(const LAS f32x4*)(buf + 65536 + (16 * mt + 4 * g4) * 4); dl[mt] = *(const LAS f32x4*)(buf + 65536 + 256 + (16 * mt + 4 * g4) * 4); }
            const float egl = *(const LAS float*)(buf + 65536 + 512);
#define RD_KQ(dst, q) do { _Pragma("unroll") for (int mt = 0; mt < 4; ++mt) { dst[mt] = FR(0, mt * 4 + (q)); dst[4 + mt] = FR(32768, mt * 4 + (q)); } } while (0)
#define MM_KQ(src, q) do { _Pragma("unroll") for (int mt = 0; mt < 4; ++mt) { X[mt] = MF(src[mt], Sb[q], X[mt]); O[mt] = MF(src[4 + mt], Sb[q], O[mt]); } } while (0)
            f32x4 X[4], O[4], VN[4];
#pragma unroll
            for (int i = 0; i < 4; ++i) { X[i] = (f32x4){0.f, 0.f, 0.f, 0.f}; O[i] = (f32x4){0.f, 0.f, 0.f, 0.f}; VN[i] = (f32x4){0.f, 0.f, 0.f, 0.f}; }
            bf16x8 Sb[4];
#pragma unroll
            for (int q = 0; q < 4; ++q) Sb[q] = pack44(S[2 * q], S[2 * q + 1]);
            RD_KQ(fa, 0); SB_();
            RD_KQ(fb, 1); SB_(); MM_KQ(fa, 0); SB_();
            RD_KQ(fa, 2); SB_(); MM_KQ(fb, 1); SB_();
            RD_KQ(fb, 3); SB_(); MM_KQ(fa, 2); SB_();
#pragma unroll
            for (int i = 0; i < 8; ++i) fa[i] = FR(49152, i);
            SB_(); MM_KQ(fb, 3); SB_();
#pragma unroll
            for (int mt = 0; mt < 4; ++mt) { const unsigned w0 = (mt < 2 ? vc0 : vc1)[2 * (mt & 1)], w1 = (mt < 2 ? vc0 : vc1)[2 * (mt & 1) + 1];
                X[mt][0] = bflo(w0) - eg[mt][0] * X[mt][0]; X[mt][1] = bfhi(w0) - eg[mt][1] * X[mt][1]; X[mt][2] = bflo(w1) - eg[mt][2] * X[mt][2]; X[mt][3] = bfhi(w1) - eg[mt][3] * X[mt][3]; }
            const bf16x8 Yb0 = pack44(X[0], X[1]), Yb1 = pack44(X[2], X[3]);
            SB_();
#pragma unroll
            for (int i = 0; i < 8; ++i) fb[i] = FR(57344, i);
            SB_();
#pragma unroll
            for (int mt = 0; mt < 4; ++mt) { VN[mt] = MF(fa[mt * 2], Yb0, VN[mt]); VN[mt] = MF(fa[mt * 2 + 1], Yb1, VN[mt]); }
            SB_();
#pragma unroll
            for (int mt = 0; mt < 4; ++mt) O[mt] = O[mt] * eg[mt];
            const bf16x8 Vb0 = pack44(VN[0], VN[1]), Vb1 = pack44(VN[2], VN[3]);
            SB_();
#pragma unroll
            for (int i = 0; i < 8; ++i) fa[i] = FR(16384, i);
            SB_();
#pragma unroll
            for (int mt = 0; mt < 4; ++mt) { O[mt] = MF(fb[mt * 2], Vb0, O[mt]); O[mt] = MF(fb[mt * 2 + 1], Vb1, O[mt]); }
            SB_();
#pragma unroll
            for (int mt = 0; mt < 4; ++mt) VN[mt] = VN[mt] * dl[mt];
            const bf16x8 Vd0 = pack44(VN[0], VN[1]), Vd1 = pack44(VN[2], VN[3]);
#pragma unroll
            for (int i = 0; i < 8; ++i) S[i] = S[i] * egl;
            SB_();
#pragma unroll
            for (int i = 0; i < 8; ++i) fb[i] = FR(16384, 8 + i);
            SB_();
#pragma unroll
            for (int i = 0; i < 4; ++i) { S[i] = MF(fa[i * 2], Vd0, S[i]); S[i] = MF(fa[i * 2 + 1], Vd1, S[i]); }
            SB_();
#pragma unroll
            for (int i = 0; i < 4; ++i) { S[4 + i] = MF(fb[i * 2], Vd0, S[4 + i]); S[4 + i] = MF(fb[i * 2 + 1], Vd1, S[4 + i]); }
            SB_();
            {
                const int row0 = cidx < 4 ? ML + b * CT + cidx * 64 : b * T + (cidx - 4) * 64;
                bf16_t* op = Og + (size_t)(row0 + 4 * g4) * 512;
#pragma unroll
                for (int mt = 0; mt < 4; ++mt)
#pragma unroll
                    for (int t = 0; t < 4; ++t) { if (VAR != 1) op[(size_t)(16 * mt + t) * 512] = (bf16_t)(pkbf_c(O[mt][t], 0.f) & 0xffffu); else asm volatile("" :: "v"(O[mt][t])); }
            }
#undef RD_KQ
#undef MM_KQ
#undef SB_
#undef FR
#undef MF
            asm volatile("s_waitcnt lgkmcnt(0)" ::: "memory"); __builtin_amdgcn_s_barrier(); asm volatile("" ::: "memory");
        }
    }
#undef CIDX
#undef a
}

__device__ __forceinline__ void phase_dn_out(int l) {
    const KArgs ap = get_args();
#define a (*ap)

    const int tid = fresh_tid(), lane = tid & 63, wave = __builtin_amdgcn_readfirstlane(tid >> 6), G = fresh_g(), bx = fresh_bx();
    unsigned char* ws = a.ws;
    const int nrows = (l == DEPTH - 1) ? ML : M;
    const bf16_t* OF = (const bf16_t*)(ws + WS_OF); const bf16_t* OB = (const bf16_t*)(ws + WS_OB);
    const bf16_t* P = (const bf16_t*)(ws + WS_P); bf16_t* CAT = (bf16_t*)(ws + WS_CAT);
    const f32x2 nw = *(const f32x2*)(a.in[I_DNW] + l * 128 + 2 * lane);
    const float* LSE = (const float*)(ws + WS_BA);
    for (int row = wave * G + bx; row < nrows; row += G * 8) {
        f32x2 of[4], ob[4]; unsigned gw[4];
#pragma unroll
        for (int hh = 0; hh < 4; ++hh) { const unsigned wf_ = *(const unsigned*)(OF + (size_t)row * 512 + hh * 128 + 2 * lane), wb_ = *(const unsigned*)(OB + (size_t)row * 512 + hh * 128 + 2 * lane); of[hh] = (f32x2){bflo(wf_), bfhi(wf_)}; ob[hh] = (f32x2){bflo(wb_), bfhi(wb_)};
            gw[hh] = *(const unsigned*)(P + (size_t)row * NP + 2560 + hh * 128 + 2 * lane); }
        u32x4 ap_[4]; float ls_[4];
#pragma unroll
        for (int p = 0; p < 4; ++p) { ap_[p] = (u32x4){0u, 0u, 0u, 0u}; ls_[p] = 0.f; }
        if (row < ML) {
            ap_[0] = *(const u32x4*)(CAT + (size_t)row * 1024 + 8 * lane); ap_[1] = *(const u32x4*)((const bf16_t*)(ws + WS_DQ) + (size_t)row * 512 + 8 * lane);
            ap_[2] = *(const u32x4*)((const bf16_t*)(ws + WS_DK) + (size_t)row * 512 + 8 * lane); ap_[3] = *(const u32x4*)((const bf16_t*)(ws + WS_DV) + (size_t)row * 512 + 8 * lane);
#pragma unroll
            for (int p = 0; p < 4; ++p) ls_[p] = LSE[((size_t)p * ML + row) * 4 + (lane >> 4)]; }
        float o0[4], o1[4], ssq[4];
#pragma unroll
        for (int hh = 0; hh < 4; ++hh) { o0[hh] = of[hh][0] + ob[hh][0]; o1[hh] = of[hh][1] + ob[hh][1]; ssq[hh] = o0[hh] * o0[hh] + o1[hh] * o1[hh]; }
#pragma unroll
        for (int hh = 0; hh < 4; ++hh) ssq[hh] = wave_sum(ssq[hh]);
        float mxv = 0.f;
#pragma unroll
        for (int hh = 0; hh < 4; ++hh) { const float rs = rsqrtf(ssq[hh] * (1.f / 128.f) + EPS); const float g0 = bflo(gw[hh]), g1 = bfhi(gw[hh]);
            o0[hh] = o0[hh] * rs * nw[0] * silu_f(g0); o1[hh] = o1[hh] * rs * nw[1] * silu_f(g1); mxv = fmaxf(mxv, fmaxf(fabsf(o0[hh]), fabsf(o1[hh]))); }
        float av[8];
        if (row < ML) { const float mx = fmaxf(fmaxf(ls_[0], ls_[1]), fmaxf(ls_[2], ls_[3]));
            float w_[4], wsum = 0.f;
#pragma unroll
            for (int p = 0; p < 4; ++p) { w_[p] = __expf(ls_[p] - mx); wsum += w_[p]; }
            const float inv = 1.f / wsum;
#pragma unroll
            for (int i = 0; i < 4; ++i) { float lo = 0.f, hi2 = 0.f;
#pragma unroll
                for (int p = 0; p < 4; ++p) { lo = fmaf(w_[p], bflo(ap_[p][i]), lo); hi2 = fmaf(w_[p], bfhi(ap_[p][i]), hi2); }
                av[2 * i] = lo * inv; av[2 * i + 1] = hi2 * inv; } }
        else { const u32x4 cw_ = *(const u32x4*)(CAT + (size_t)row * 1024 + 8 * lane);
#pragma unroll
            for (int i = 0; i < 4; ++i) { av[2 * i] = bflo(cw_[i]); av[2 * i + 1] = bfhi(cw_[i]); } }
#pragma unroll
        for (int i = 0; i < 8; ++i) mxv = fmaxf(mxv, fabsf(av[i]));
        mxv = fmaxf(wave_max(mxv), 1e-30f);
        const float cinv = 127.f / mxv;
        signed char* crow = (signed char*)(ws + WS_CATQ) + (size_t)row * 1024;
#define Q8_(x) ((unsigned)(int)rintf((x) * cinv) & 255u)
        { u32x2 o; o.x = Q8_(av[0]) | (Q8_(av[1]) << 8) | (Q8_(av[2]) << 16) | (Q8_(av[3]) << 24); o.y = Q8_(av[4]) | (Q8_(av[5]) << 8) | (Q8_(av[6]) << 16) | (Q8_(av[7]) << 24); *(u32x2*)(crow + 8 * lane) = o; }
#pragma unroll
        for (int hh = 0; hh < 4; ++hh) *(unsigned short*)(crow + 512 + hh * 128 + 2 * lane) = (unsigned short)(Q8_(o0[hh]) | (Q8_(o1[hh]) << 8));
#undef Q8_
        if (lane == 0) ((float*)(ws + WS_GB))[(1u << 18) + row] = mxv * (1.f / 127.f);
    }
#undef a
}

#define CE_DESC(a_, b_) do { const float hi_ = fmaxf(a_, b_), lo_ = fminf(a_, b_); a_ = hi_; b_ = lo_; } while (0)
__device__ __forceinline__ void bitonic_sort16_desc(float (&v)[16]) {
#define S2_(i_, j_) CE_DESC(v[i_], v[j_]);
    S2_(0,13) S2_(1,12) S2_(2,15) S2_(3,14) S2_(4,8) S2_(5,6) S2_(7,11) S2_(9,10)
    S2_(0,5) S2_(1,7) S2_(2,9) S2_(3,4) S2_(6,13) S2_(8,14) S2_(10,15) S2_(11,12)
    S2_(0,1) S2_(2,3) S2_(4,5) S2_(6,8) S2_(7,9) S2_(10,11) S2_(12,13) S2_(14,15)
    S2_(0,2) S2_(1,3) S2_(4,10) S2_(5,11) S2_(6,7) S2_(8,9) S2_(12,14) S2_(13,15)
    S2_(1,2) S2_(3,12) S2_(4,6) S2_(5,7) S2_(8,10) S2_(9,11) S2_(13,14)
    S2_(1,4) S2_(2,6) S2_(5,8) S2_(7,10) S2_(9,13) S2_(11,14)
    S2_(2,4) S2_(3,6) S2_(9,12) S2_(11,13)
    S2_(3,5) S2_(6,8) S2_(7,9) S2_(10,12)
    S2_(3,4) S2_(5,6) S2_(7,8) S2_(9,10) S2_(11,12)
    S2_(6,7) S2_(8,9)
#undef S2_
}
__device__ __forceinline__ void merge_top16_desc(float (&lst)[16], const float (&nw)[16]) {
#pragma unroll
    for (int i = 0; i < 16; ++i) lst[i] = fmaxf(lst[i], nw[15 - i]);
#pragma unroll
    for (int j = 8; j > 0; j >>= 1)
#pragma unroll
        for (int i = 0; i < 16; ++i) { const int p = i ^ j; if (p > i) CE_DESC(lst[i], lst[p]); }
}
__device__ __forceinline__ void phase_peer_select(int l) {
    const KArgs ap = get_args();
#define a (*ap)
    const int tid = fresh_tid(), lane = tid & 63, wave = __builtin_amdgcn_readfirstlane(tid >> 6), G = fresh_g(), bx = fresh_bx();
    unsigned char* ws = a.ws;
    const int nrows = (l == DEPTH - 1) ? ML : M;
    const int ntask = (nrows / 32) * 4;
    const bf16_t* Q2 = (const bf16_t*)(ws + WS_P);
    const bf16_t* SKB = (const bf16_t*)(ws + WS_SKB) + (size_t)l * 8 * 2 * 128 * 128;
    int* PIDX = (int*)(ws + WS_PIDX); float* PGATE = (float*)(ws + WS_PGATE);
    const float NEG = -3.0e38f;
    const int r = lane & 31, hi = lane >> 5;
    for (int task = wave * G + bx; task < ntask; task += G * 8) {
        const int tg = task >> 2, hp = task & 3; const int row = tg * 32 + r;
        float mine0[16], mine1[16];
#pragma unroll
        for (int j = 0; j < 16; ++j) { mine0[j] = NEG; mine1[j] = NEG; }
        bf16x8 qA[8], kA[8];
        float lst[16];
#define SEL_QPTR(it_) (Q2 + (size_t)row * 2048 + (2 * hp + ((it_) >> 1)) * 256 + ((it_) & 1) * 128 + 8 * hi)
#define SEL_KPTR(it_, t_) (SKB + (size_t)(((2 * hp + ((it_) >> 1)) * 2 + ((it_) & 1)) * 128 + 32 * (t_) + r) * 128 + 8 * hi)
#define SEL_LDQ(dst, it_) do { const bf16_t* qp_ = SEL_QPTR(it_); _Pragma("unroll") for (int ks = 0; ks < 8; ++ks) dst[ks] = *(const bf16x8*)(qp_ + 16 * ks); } while (0)
#define SEL_LDK(dst, it_, t_) do { const bf16_t* kp_ = SEL_KPTR(it_, t_); _Pragma("unroll") for (int ks = 0; ks < 8; ++ks) dst[ks] = *(const bf16x8*)(kp_ + 16 * ks); } while (0)
#define SEL_RANK(qv, kv, t_) do { f32x16 acc = {}; _Pragma("unroll") for (int ks = 0; ks < 8; ++ks) acc = __builtin_amdgcn_mfma_f32_32x32x16_bf16(kv[ks], qv[ks], acc, 0, 0, 0); \
            const unsigned kb = (unsigned)(32 * (t_) + 4 * hi); float nw_[16]; \
            _Pragma("unroll") for (int i = 0; i < 16; ++i) nw_[i] = __uint_as_float((__float_as_uint(acc[i]) & 0xffffff80u) | (kb + (unsigned)((i & 3) + 8 * (i >> 2)))); \
            bitonic_sort16_desc(nw_); merge_top16_desc(lst, nw_); } while (0)
#define SB_() __builtin_amdgcn_sched_barrier(0)
#pragma unroll
        for (int j = 0; j < 16; ++j) lst[j] = NEG;
#pragma unroll 1
        for (int it = 0; it < 4; ++it) {
            SEL_LDQ(qA, it);
#pragma unroll 1
            for (int t = 0; t < 4; ++t) { SEL_LDK(kA, it, t); SEL_RANK(qA, kA, t); }
            float oth[16];
#pragma unroll
            for (int j = 0; j < 16; ++j) { auto rr = __builtin_amdgcn_permlane32_swap(__float_as_uint(lst[j]), __float_as_uint(lst[j]), false, false); oth[j] = __uint_as_float(hi ? rr[0] : rr[1]); }
            merge_top16_desc(lst, oth);
            const bool k0 = ((it >> 1) == hi) && ((it & 1) == 0), k1 = ((it >> 1) == hi) && ((it & 1) == 1);
#pragma unroll
            for (int j = 0; j < 16; ++j) { mine0[j] = k0 ? lst[j] : mine0[j]; mine1[j] = k1 ? lst[j] : mine1[j]; lst[j] = NEG; }
        }
#undef SB_
#undef SEL_QPTR
#undef SEL_KPTR
#undef SEL_LDQ
#undef SEL_LDK
#undef SEL_RANK
        const int h = 2 * hp + hi;
        float ts[16];
#pragma unroll
        for (int j = 0; j < 16; ++j) ts[j] = NEG;
#pragma unroll
        for (int i = 0; i < 16; ++i)
#pragma unroll
            for (int j = 0; j < 16; ++j) if ((i + 1) * (j + 1) <= 16) {
                const unsigned b0 = __float_as_uint(mine0[i]), b1 = __float_as_uint(mine1[j]);
                const float c = __uint_as_float(b0 & 0xffffff80u) + __uint_as_float(b1 & 0xffffff80u);
                float x = __uint_as_float((__float_as_uint(c) & 0xffffc000u) | ((b0 & 127u) << 7) | (b1 & 127u));
#pragma unroll
                for (int t = 0; t < 16; ++t) { const float hv = fmaxf(ts[t], x); x = fminf(ts[t], x); ts[t] = hv; }
            }
        int te[16]; float ex[16], sum = 0.f;
        const float tmax = __uint_as_float(__float_as_uint(ts[0]) & 0xffffc000u);
#pragma unroll
        for (int t = 0; t < 16; ++t) { const unsigned bt = __float_as_uint(ts[t]); te[t] = (int)(bt & 0x3fffu); ex[t] = __expf(__uint_as_float(bt & 0xffffc000u) - tmax); sum += ex[t]; }
        const float inv = 1.f / sum;
        unsigned short* ip = (unsigned short*)PIDX + (size_t)row * 128 + h * 16; float* gp = PGATE + (size_t)row * 128 + h * 16;
#pragma unroll
        for (int t = 0; t < 16; t += 8) *(u32x4*)(ip + t) = (u32x4){(unsigned)te[t] | ((unsigned)te[t + 1] << 16), (unsigned)te[t + 2] | ((unsigned)te[t + 3] << 16), (unsigned)te[t + 4] | ((unsigned)te[t + 5] << 16), (unsigned)te[t + 6] | ((unsigned)te[t + 7] << 16)};
#pragma unroll
        for (int t = 0; t < 16; t += 4) *(f32x4*)(gp + t) = (f32x4){ex[t] * inv, ex[t + 1] * inv, ex[t + 2] * inv, ex[t + 3] * inv};
    }
#undef a
}

template <bool WR, int GV = 0>
__device__ __forceinline__ void phase_peer_gather(int l, LAS unsigned char* lds) {
    const KArgs ap = get_args();
#define a (*ap)
    const int tid = fresh_tid(), lane = tid & 63, wave = __builtin_amdgcn_readfirstlane(tid >> 6), G = fresh_g(), bx = fresh_bx();
    unsigned char* ws = a.ws;
    const int nrows = (l == DEPTH - 1) ? ML : M;
    const unsigned char* UB = ws + WS_UB + (size_t)(l & 1) * TAB_SET; const unsigned char* VB = UB + 1024;
    const float* USC = (const float*)(ws + WS_USC) + (l & 1) * 2 * NEXP; const float* VSC = USC + NEXP;
    const int* PIDX = (const int*)(ws + WS_PIDX); const float* PGATE = (const float*)(ws + WS_PGATE);
    const float* modl = (const float*)(ws + WS_MOD) + (size_t)l * 3 * 6144 + 5120;
    const bool fuse = WR && (l + 1 < DEPTH);
    LAS float* wsk = (LAS float*)lds;
    if (fuse) { const float* src = (const float*)(ws + WS_WSK) + (size_t)(l + 1) * 16384; for (int i = tid; i < 16384 / 4; i += 512) ((LAS f32x4*)wsk)[i] = ((const f32x4*)src)[i]; __syncthreads(); }
    const float* nw1 = a.in[I_N1W] + (l + 1 < DEPTH ? l + 1 : l) * 1024 + 16 * lane;
    const float* modn = (const float*)(ws + WS_MOD) + (size_t)(l + 1 < DEPTH ? l + 1 : l) * 3 * 6144;
    for (int row = wave * G + bx; row < nrows; row += G * 8) {
        float hv[16], out[16];
        { const u32x4 hw = *(const u32x4*)((const signed char*)(ws + WS_H) + (size_t)row * D + 16 * lane); const float hsc = ((const float*)(ws + WS_GB))[row];
#pragma unroll
          for (int q = 0; q < 4; ++q) { const int w = (int)hw[q]; hv[4 * q + 0] = (float)((w << 24) >> 24) * hsc; hv[4 * q + 1] = (float)((w << 16) >> 24) * hsc; hv[4 * q + 2] = (float)((w << 8) >> 24) * hsc; hv[4 * q + 3] = (float)(w >> 24) * hsc; } }
        float hs = 0.f;
#pragma unroll
        for (int i = 0; i < 16; ++i) { out[i] = 0.f; hs += hv[i]; }
        const float hsum128 = 128.f * wave_sum(hs);
        float wacc = 0.f;
        const int id0 = PIDX[(size_t)row * 128 + lane], id1 = PIDX[(size_t)row * 128 + 64 + lane];
        const float gt0 = PGATE[(size_t)row * 128 + lane], gt1 = PGATE[(size_t)row * 128 + 64 + lane];
        const float us0 = USC[id0], us1 = USC[id1], vs0 = VSC[id0], vs1 = VSC[id1];
        for (int e0 = 0; e0 < 128; e0 += 8) {
            u32x4 uw[8], vw[8]; float gte[8], use[8], vse[8];
#pragma unroll
            for (int j = 0; j < 8; ++j) { const int e = e0 + j; const int id = __builtin_amdgcn_readlane(e0 < 64 ? id0 : id1, e & 63);
                gte[j] = __builtin_bit_cast(float, __builtin_amdgcn_readlane(__builtin_bit_cast(int, e0 < 64 ? gt0 : gt1), e & 63));
                use[j] = __builtin_bit_cast(float, __builtin_amdgcn_readlane(__builtin_bit_cast(int, e0 < 64 ? us0 : us1), e & 63));
                vse[j] = __builtin_bit_cast(float, __builtin_amdgcn_readlane(__builtin_bit_cast(int, e0 < 64 ? vs0 : vs1), e & 63));
                uw[j] = *(const u32x4*)(UB + (size_t)id * 2048 + 16 * lane); vw[j] = *(const u32x4*)(VB + (size_t)id * 2048 + 16 * lane); }
#pragma unroll
            for (int j = 0; j < 8; ++j) {
                float d0 = 0.f, d1 = 0.f;
#pragma unroll
                for (int q = 0; q < 4; ++q) { const unsigned w = uw[j][q];
                    d0 = fmaf((float)(w & 255u), hv[4 * q + 0], d0); d1 = fmaf((float)((w >> 8) & 255u), hv[4 * q + 1], d1);
                    d0 = fmaf((float)((w >> 16) & 255u), hv[4 * q + 2], d0); d1 = fmaf((float)(w >> 24), hv[4 * q + 3], d1); }
                const float dsum = (wave_sum(d0 + d1) - hsum128) * use[j];
                const float act = 0.5f * dsum * (1.f + erff(dsum * 0.70710678118654752f));
                const float wgt = gte[j] * act * vse[j];
                wacc += wgt;
                if (GV == 1) { asm volatile("" :: "v"(vw[j])); out[0] += wgt; } else
#pragma unroll
                for (int q = 0; q < 4; ++q) { const unsigned w = vw[j][q];
                    out[4 * q + 0] = fmaf(wgt, (float)(w & 255u), out[4 * q + 0]); out[4 * q + 1] = fmaf(wgt, (float)((w >> 8) & 255u), out[4 * q + 1]);
                    out[4 * q + 2] = fmaf(wgt, (float)((w >> 16) & 255u), out[4 * q + 2]); out[4 * q + 3] = fmaf(wgt, (float)(w >> 24), out[4 * q + 3]); }
            }
        }
        const float corr = 128.f * wacc;
        float* xr; int mrow;
        if (row < ML) { xr = a.out + (size_t)row * D; mrow = row >= T ? 1 : 0; } else { xr = (float*)(ws + WS_CTXX) + (size_t)(row - ML) * D; mrow = 2; }
        const float* g2 = modl + mrow * 6144 + 16 * lane;
        f32x4 xn[4];
#pragma unroll
        for (int i = 0; i < 4; ++i) { const f32x4 x = *(const f32x4*)(xr + 16 * lane + 4 * i), g = *(const f32x4*)(g2 + 4 * i);
            xn[i] = x + g * (f32x4){out[4 * i] - corr, out[4 * i + 1] - corr, out[4 * i + 2] - corr, out[4 * i + 3] - corr};
            if (WR) *(f32x4*)(xr + 16 * lane + 4 * i) = xn[i]; else asm volatile("" :: "v"(xn[i])); }
        if (fuse) {
            float ss = 0.f;
#pragma unroll
            for (int i = 0; i < 4; ++i) ss += (xn[i][0] * xn[i][0] + xn[i][1] * xn[i][1]) + (xn[i][2] * xn[i][2] + xn[i][3] * xn[i][3]);
            const float rstd = rsqrtf(wave_sum(ss) * (1.f / D) + EPS);
            const float* md = modn + mrow * 6144 + 16 * lane;
#pragma unroll
            for (int i = 0; i < 4; ++i) { const f32x4 nwv = *(const f32x4*)(nw1 + 4 * i), sc = *(const f32x4*)(md + 1024 + 4 * i), sh = *(const f32x4*)(md + 4 * i);
                xn[i] = xn[i] * rstd * nwv * (sc + 1.f) + sh; }
            { float hmx = 0.f;
#pragma unroll
              for (int i = 0; i < 4; ++i) hmx = fmaxf(hmx, fmaxf(fmaxf(fabsf(xn[i][0]), fabsf(xn[i][1])), fmaxf(fabsf(xn[i][2]), fabsf(xn[i][3]))));
              hmx = fmaxf(wave_max(hmx), 1e-30f); const float hinv = 127.f / hmx;
              u32x4 o;
#pragma unroll
              for (int i = 0; i < 4; ++i) o[i] = ((unsigned)(int)rintf(xn[i][0] * hinv) & 255u) | (((unsigned)(int)rintf(xn[i][1] * hinv) & 255u) << 8) | (((unsigned)(int)rintf(xn[i][2] * hinv) & 255u) << 16) | (((unsigned)(int)rintf(xn[i][3] * hinv) & 255u) << 24);
              *(u32x4*)((signed char*)(ws + WS_H) + (size_t)row * D + 16 * lane) = o;
              if (lane == 0) ((float*)(ws + WS_GB))[row] = hmx * (1.f / 127.f); }
            float p[16];
#pragma unroll
            for (int c = 0; c < 16; ++c) { float q = 0.f;
#pragma unroll
                for (int i = 0; i < 4; ++i) { const f32x4 w = *(const LAS f32x4*)(wsk + c * 1024 + 16 * lane + 4 * i); q += (xn[i][0] * w[0] + xn[i][1] * w[1]) + (xn[i][2] * w[2] + xn[i][3] * w[3]); }
                p[c] = q; }
            { const bool hb = (lane & 32) != 0;
#pragma unroll
              for (int c = 0; c < 8; ++c) { const float keep = hb ? p[c + 8] : p[c], send = hb ? p[c] : p[c + 8]; p[c] = keep + lane_xor<32>(send); } }
            { const bool hb = (lane & 16) != 0;
#pragma unroll
              for (int c = 0; c < 4; ++c) { const float keep = hb ? p[c + 4] : p[c], send = hb ? p[c] : p[c + 4]; p[c] = keep + lane_xor<16>(send); } }
            { const bool hb = (lane & 8) != 0;
#pragma unroll
              for (int c = 0; c < 2; ++c) { const float keep = hb ? p[c + 2] : p[c], send = hb ? p[c] : p[c + 2]; p[c] = keep + lane_xor<8>(send); } }
            { const bool hb = (lane & 4) != 0; const float keep = hb ? p[1] : p[0], send = hb ? p[0] : p[1]; p[0] = keep + lane_xor<4>(send); }
            p[0] += lane_xor<2>(p[0]); p[0] += lane_xor<1>(p[0]);
            if ((lane & 3) == 0) { const int c = ((lane >> 5) & 1) * 8 + ((lane >> 4) & 1) * 4 + ((lane >> 3) & 1) * 2 + ((lane >> 2) & 1); ((float*)(ws + WS_BA))[(size_t)row * 16 + c] = p[0]; }
        }
    }
    if (fuse) __syncthreads();
}
#undef a
constexpr size_t WS_PART = WS_P;
static_assert(WS_PART + 8 * (size_t)M * 1024 * 2 <= WS_GB, "partials region");
constexpr int GP_ITEM = 16;
struct GpMeta { int id0, id1; float gt0, gt1; u32x4 hw; float hsc; };
__device__ __forceinline__ void phase_peer_gpart(int l, LAS unsigned char* lds) {
    const KArgs ap = get_args();
#define a (*ap)
    const int tid = fresh_tid(), lane = tid & 63, wave = __builtin_amdgcn_readfirstlane(tid >> 6);
    unsigned char* ws = a.ws;
    const int nrows = (l == DEPTH - 1) ? ML : M;
    const int nitem = nrows / GP_ITEM;
    const unsigned char* UB = ws + WS_UB + (size_t)(l & 1) * TAB_SET; const unsigned char* VB = UB + 1024;
    const f32x2* SC2 = (const f32x2*)(ws + WS_USC) + (size_t)(l & 1) * NEXP;
    const int* PIDX = (const int*)(ws + WS_PIDX); const float* PGATE = (const float*)(ws + WS_PGATE);
    LAS u32x4* lst0 = (LAS u32x4*)lds + wave * 256;
    const int eidx = ((lane >> 5) & 1) * 4 + ((lane >> 4) & 1) * 2 + ((lane >> 3) & 1);
    const int x = (int)(xb_xcc_id() & 7u);
#define GP_LOAD_META(m_, row_) do { const int rw_ = (row_); (m_).id0 = PIDX[(size_t)rw_ * 128 + lane]; (m_).id1 = PIDX[(size_t)rw_ * 128 + 64 + lane]; (m_).gt0 = PGATE[(size_t)rw_ * 128 + lane]; (m_).gt1 = PGATE[(size_t)rw_ * 128 + 64 + lane]; \
        (m_).hw = *(const u32x4*)((const signed char*)(ws + WS_H) + (size_t)rw_ * D + 16 * lane); (m_).hsc = ((const float*)(ws + WS_GB))[rw_]; } while (0)
#define GP_LOAD_SC(sa_, sb_, m_) do { sa_ = (f32x2){0.f, 0.f}; sb_ = (f32x2){0.f, 0.f}; if (((m_).id0 >> 11) == p) sa_ = SC2[(m_).id0]; if (((m_).id1 >> 11) == p) sb_ = SC2[(m_).id1]; } while (0)
#define GP_BUILD(cnt_, m_, sa_, sb_, buf_) do { const bool s0_ = ((m_).id0 >> 11) == p, s1_ = ((m_).id1 >> 11) == p; const unsigned long long m0_ = __ballot(s0_), m1_ = __ballot(s1_); \
        const int c0_ = __builtin_popcountll(m0_); cnt_ = __builtin_amdgcn_readfirstlane(c0_ + __builtin_popcountll(m1_)); \
        const int r0_ = (int)__builtin_amdgcn_mbcnt_hi((unsigned)(m0_ >> 32), __builtin_amdgcn_mbcnt_lo((unsigned)m0_, 0u)); \
        const int r1_ = c0_ + (int)__builtin_amdgcn_mbcnt_hi((unsigned)(m1_ >> 32), __builtin_amdgcn_mbcnt_lo((unsigned)m1_, 0u)); \
        LAS u32x4* lb_ = lst0 + (buf_) * 128; \
        if (s0_) lb_[r0_] = (u32x4){(unsigned)(m_).id0, __float_as_uint((m_).gt0 * sa_[1]), __float_as_uint(sa_[0]), 0u}; \
        if (s1_) lb_[r1_] = (u32x4){(unsigned)(m_).id1, __float_as_uint((m_).gt1 * sb_[1]), __float_as_uint(sb_[0]), 0u}; } while (0)
#pragma unroll 1
    for (int pp = 0; pp < 8; ++pp) {
        const int p = (x + pp) & 7;
        unsigned* ctr = (unsigned*)(ws + WS_CTL) + 16384 + (l * 8 + p) * 64;
        unsigned* part = (unsigned*)(ws + WS_PART + (size_t)p * M * 2048);
        unsigned tk = 0; if (lane == 0) tk = __hip_atomic_fetch_add(ctr, 1u, __ATOMIC_RELAXED, __HIP_MEMORY_SCOPE_AGENT);
        int it = __builtin_amdgcn_readfirstlane((int)tk);
#pragma unroll 1
        while (it < nitem) {
            unsigned tn = 0; if (lane == 0) tn = __hip_atomic_fetch_add(ctr, 1u, __ATOMIC_RELAXED, __HIP_MEMORY_SCOPE_AGENT);
            const int row0 = it * GP_ITEM, rowl = row0 + GP_ITEM - 1;
            GpMeta m1, m2, m3; f32x2 sa1, sb1, sa2, sb2; int c_cur, c_nxt; u32x4 hw_cur; float hsc_cur;
            GP_LOAD_META(m1, row0); GP_LOAD_META(m2, min(row0 + 1, rowl)); GP_LOAD_META(m3, min(row0 + 2, rowl));
            GP_LOAD_SC(sa1, sb1, m1);
            GP_BUILD(c_cur, m1, sa1, sb1, 0); hw_cur = m1.hw; hsc_cur = m1.hsc;
            GP_LOAD_SC(sa1, sb1, m2);
            m1 = m2; m2 = m3;
            GP_LOAD_META(m3, min(row0 + 3, rowl));
#pragma unroll 1
            for (int i = 0; i < GP_ITEM; ++i) {
                const int row = row0 + i;
                GP_BUILD(c_nxt, m1, sa1, sb1, (i + 1) & 1);
                const u32x4 hw_nxt = m1.hw; const float hsc_nxt = m1.hsc;
                GP_LOAD_SC(sa2, sb2, m2);
                m1 = m2; sa1 = sa2; sb1 = sb2; m2 = m3;
                GP_LOAD_META(m3, min(row + 4, rowl));
                LAS u32x4* lst = lst0 + (i & 1) * 128;
                const int c = c_cur; const u32x4 hw = hw_cur; const float hsc = hsc_cur;
                f32x2 o2[8];
#pragma unroll
                for (int k = 0; k < 8; ++k) o2[k] = (f32x2){0.f, 0.f};
                float wacc = 0.f;
#pragma unroll 1
                for (int e = 0; e < c; e += 8) {
                    u32x4 uw[8], vw[8];
#pragma unroll
                    for (int j = 0; j < 8; ++j) { const int sl = min(e + j, c - 1);
                        const int id = __builtin_amdgcn_readfirstlane((int)lst[sl][0]);
                        uw[j] = *(const u32x4*)(UB + (size_t)id * 2048 + 16 * lane); vw[j] = *(const u32x4*)(VB + (size_t)id * 2048 + 16 * lane); }
                    const int ms = e + eidx; const u32x4 en = lst[min(ms, c - 1)];
                    float pd[8];
#pragma unroll
                    for (int j = 0; j < 8; ++j) { int d = 0;
#pragma unroll
                        for (int q = 0; q < 4; ++q) d = __builtin_amdgcn_sdot4((int)uw[j][q], (int)hw[q], d, false);
                        pd[j] = (float)d; }
                    { const bool hb = (lane & 32) != 0;
#pragma unroll
                      for (int j = 0; j < 4; ++j) { const float keep = hb ? pd[j + 4] : pd[j], send = hb ? pd[j] : pd[j + 4]; pd[j] = keep + lane_xor<32>(send); } }
                    { const bool hb = (lane & 16) != 0;
#pragma unroll
                      for (int j = 0; j < 2; ++j) { const float keep = hb ? pd[j + 2] : pd[j], send = hb ? pd[j] : pd[j + 2]; pd[j] = keep + lane_xor<16>(send); } }
                    { const bool hb = (lane & 8) != 0; const float keep = hb ? pd[1] : pd[0], send = hb ? pd[0] : pd[1]; pd[0] = keep + lane_xor<8>(send); }
                    pd[0] += lane_xor<4>(pd[0]); pd[0] += lane_xor<2>(pd[0]); pd[0] += lane_xor<1>(pd[0]);
                    const float dsum = pd[0] * (__uint_as_float(en[2]) * hsc);
                    const float act = 0.5f * dsum * (1.f + erff(dsum * 0.70710678118654752f));
                    const float wgt = ms < c ? __uint_as_float(en[1]) * act : 0.f;
                    wacc += wgt;
#pragma unroll
                    for (int j = 0; j < 8; ++j) {
                        const float wj = __builtin_bit_cast(float, __builtin_amdgcn_readlane(__builtin_bit_cast(int, wgt), 32 * ((j >> 2) & 1) + 16 * ((j >> 1) & 1) + 8 * (j & 1)));
                        const f32x2 ww = {wj, wj};
#pragma unroll
                        for (int q = 0; q < 4; ++q) { const unsigned w = vw[j][q];
                            const f32x2 v01 = {(float)(w & 255u), (float)((w >> 8) & 255u)}, v23 = {(float)((w >> 16) & 255u), (float)(w >> 24)};
                            o2[2 * q] = __builtin_elementwise_fma(ww, v01, o2[2 * q]); o2[2 * q + 1] = __builtin_elementwise_fma(ww, v23, o2[2 * q + 1]); }
                    }
                }
                const float corr = 16.f * wave_sum(wacc);
                u32x4 w0, w1;
#pragma unroll
                for (int k = 0; k < 4; ++k) { w0[k] = pkbf_c(o2[k][0] - corr, o2[k][1] - corr); w1[k] = pkbf_c(o2[4 + k][0] - corr, o2[4 + k][1] - corr); }
                unsigned* dst = part + (size_t)row * 512 + 8 * lane;
                __builtin_nontemporal_store(w0, (u32x4*)dst); __builtin_nontemporal_store(w1, (u32x4*)(dst + 4));
                c_cur = c_nxt; hw_cur = hw_nxt; hsc_cur = hsc_nxt;
            }
            it = __builtin_amdgcn_readfirstlane((int)tn);
        }
    }
#undef GP_LOAD_META
#undef GP_LOAD_SC
#undef GP_BUILD
#undef a
}

__device__ __forceinline__ void phase_peer_combine(int l, LAS unsigned char* lds) {
    const KArgs ap = get_args();
#define a (*ap)
    const int tid = fresh_tid(), lane = tid & 63, wave = __builtin_amdgcn_readfirstlane(tid >> 6), G = fresh_g(), bx = fresh_bx();
    unsigned char* ws = a.ws;
    const int nrows = (l == DEPTH - 1) ? ML : M;
    const float* modl = (const float*)(ws + WS_MOD) + (size_t)l * 3 * 6144 + 5120;
    const bool fuse = (l + 1 < DEPTH);
    LAS float* wsk = (LAS float*)lds;
    if (fuse) { const float* src = (const float*)(ws + WS_WSK) + (size_t)(l + 1) * 16384; for (int i = tid; i < 16384 / 4; i += 512) ((LAS f32x4*)wsk)[i] = ((const f32x4*)src)[i]; __syncthreads(); }
    const float* nw1 = a.in[I_N1W] + (l + 1 < DEPTH ? l + 1 : l) * 1024 + 16 * lane;
    const float* modn = (const float*)(ws + WS_MOD) + (size_t)(l + 1 < DEPTH ? l + 1 : l) * 3 * 6144;
    for (int row = wave * G + bx; row < nrows; row += G * 8) {
        float out[16];
#pragma unroll
        for (int i = 0; i < 16; ++i) out[i] = 0.f;
#pragma unroll
        for (int p = 0; p < 8; ++p) { const unsigned* src = (const unsigned*)(ws + WS_PART + (size_t)p * M * 2048) + (size_t)row * 512 + 8 * lane;
            const u32x4 w0 = __builtin_nontemporal_load((const u32x4*)src), w1 = __builtin_nontemporal_load((const u32x4*)(src + 4));
#pragma unroll
            for (int k = 0; k < 4; ++k) { out[2 * k] += bflo(w0[k]); out[2 * k + 1] += bfhi(w0[k]); out[8 + 2 * k] += bflo(w1[k]); out[8 + 2 * k + 1] += bfhi(w1[k]); } }
        float* xr; int mrow;
        if (row < ML) { xr = a.out + (size_t)row * D; mrow = row >= T ? 1 : 0; } else { xr = (float*)(ws + WS_CTXX) + (size_t)(row - ML) * D; mrow = 2; }
        const float* g2 = modl + mrow * 6144 + 16 * lane;
        f32x4 xn[4];
#pragma unroll
        for (int i = 0; i < 4; ++i) { const f32x4 x = *(const f32x4*)(xr + 16 * lane + 4 * i), g = *(const f32x4*)(g2 + 4 * i);
            xn[i] = x + g * (f32x4){out[4 * i], out[4 * i + 1], out[4 * i + 2], out[4 * i + 3]};
            *(f32x4*)(xr + 16 * lane + 4 * i) = xn[i]; }
        if (fuse) {
            float ss = 0.f;
#pragma unroll
            for (int i = 0; i < 4; ++i) ss += (xn[i][0] * xn[i][0] + xn[i][1] * xn[i][1]) + (xn[i][2] * xn[i][2] + xn[i][3] * xn[i][3]);
            const float rstd = rsqrtf(wave_sum(ss) * (1.f / D) + EPS);
            const float* md = modn + mrow * 6144 + 16 * lane;
#pragma unroll
            for (int i = 0; i < 4; ++i) { const f32x4 nwv = *(const f32x4*)(nw1 + 4 * i), sc = *(const f32x4*)(md + 1024 + 4 * i), sh = *(const f32x4*)(md + 4 * i);
                xn[i] = xn[i] * rstd * nwv * (sc + 1.f) + sh; }
            { float hmx = 0.f;
#pragma unroll
              for (int i = 0; i < 4; ++i) hmx = fmaxf(hmx, fmaxf(fmaxf(fabsf(xn[i][0]), fabsf(xn[i][1])), fmaxf(fabsf(xn[i][2]), fabsf(xn[i][3]))));
              hmx = fmaxf(wave_max(hmx), 1e-30f); const float hinv = 127.f / hmx;
              u32x4 o;
#pragma unroll
              for (int i = 0; i < 4; ++i) o[i] = ((unsigned)(int)rintf(xn[i][0] * hinv) & 255u) | (((unsigned)(int)rintf(xn[i][1] * hinv) & 255u) << 8) | (((unsigned)(int)rintf(xn[i][2] * hinv) & 255u) << 16) | (((unsigned)(int)rintf(xn[i][3] * hinv) & 255u) << 24);
              *(u32x4*)((signed char*)(ws + WS_H) + (size_t)row * D + 16 * lane) = o;
              if (lane == 0) ((float*)(ws + WS_GB))[row] = hmx * (1.f / 127.f); }
            float p[16];
#pragma unroll
            for (int c = 0; c < 16; ++c) { float q = 0.f;
#pragma unroll
                for (int i = 0; i < 4; ++i) { const f32x4 w = *(const LAS f32x4*)(wsk + c * 1024 + 16 * lane + 4 * i); q += (xn[i][0] * w[0] + xn[i][1] * w[1]) + (xn[i][2] * w[2] + xn[i][3] * w[3]); }
                p[c] = q; }
            { const bool hb = (lane & 32) != 0;
#pragma unroll
              for (int c = 0; c < 8; ++c) { const float keep = hb ? p[c + 8] : p[c], send = hb ? p[c] : p[c + 8]; p[c] = keep + lane_xor<32>(send); } }
            { const bool hb = (lane & 16) != 0;
#pragma unroll
              for (int c = 0; c < 4; ++c) { const float keep = hb ? p[c + 4] : p[c], send = hb ? p[c] : p[c + 4]; p[c] = keep + lane_xor<16>(send); } }
            { const bool hb = (lane & 8) != 0;
#pragma unroll
              for (int c = 0; c < 2; ++c) { const float keep = hb ? p[c + 2] : p[c], send = hb ? p[c] : p[c + 2]; p[c] = keep + lane_xor<8>(send); } }
            { const bool hb = (lane & 4) != 0; const float keep = hb ? p[1] : p[0], send = hb ? p[0] : p[1]; p[0] = keep + lane_xor<4>(send); }
            p[0] += lane_xor<2>(p[0]); p[0] += lane_xor<1>(p[0]);
            if ((lane & 3) == 0) { const int c = ((lane >> 5) & 1) * 8 + ((lane >> 4) & 1) * 4 + ((lane >> 3) & 1) * 2 + ((lane >> 2) & 1); ((float*)(ws + WS_BA))[(size_t)row * 16 + c] = p[0]; }
        }
    }
    if (fuse) __syncthreads();
#undef a
}
constexpr size_t WS_PD = WS_REC;
constexpr size_t WS_PW = WS_REC + 8 * (size_t)M * 128 * 4;
constexpr size_t WS_PC = WS_PW + (size_t)M * 128;
static_assert(WS_PC + (size_t)M * 8 * 4 <= WS_END, "sliced gather scratch");
constexpr int GS_ITEM = 8;
template <int PH>
__device__ __forceinline__ void phase_peer_slice(int l, int cslot) {
    const KArgs ap = get_args();
#define a (*ap)
    const int tid = fresh_tid(), lane = tid & 63;
    unsigned char* ws = a.ws;
    const int nrows = (l == DEPTH - 1) ? ML : M;
    const int nitem = nrows / GS_ITEM;
    const unsigned char* TAB = ws + WS_UB + (size_t)(l & 1) * TAB_SET + (PH ? (size_t)NEXP * 1024 : 0);
    const int* PIDX = (const int*)(ws + WS_PIDX);
    const unsigned char* PW = ws + WS_PW; const float* PC = (const float*)(ws + WS_PC);
    const float* modl = (const float*)(ws + WS_MOD) + (size_t)l * 3 * 6144 + 5120;
    const int g = lane >> 3, i8 = lane & 7;
    const int x = (int)(xb_xcc_id() & 7u);
#pragma unroll 1
    for (int pp = 0; pp < 8; ++pp) {
        const int p = (x + pp) & 7;
        unsigned* ctr = (unsigned*)(ws + WS_CTL) + 16384 + ((l * 2 + PH) * 8 + p) * 64 + cslot * 8192;
        const unsigned char* tb = TAB + (size_t)p * NEXP * 128 + 16 * i8;
        unsigned tk = 0; if (lane == 0) tk = __hip_atomic_fetch_add(ctr, 1u, __ATOMIC_RELAXED, __HIP_MEMORY_SCOPE_AGENT);
        int it = __builtin_amdgcn_readfirstlane((int)tk);
        if (it < nitem) {
            unsigned tn = 0; if (lane == 0) tn = __hip_atomic_fetch_add(ctr, 1u, __ATOMIC_RELAXED, __HIP_MEMORY_SCOPE_AGENT);
            const int row0 = it * GS_ITEM;
            u32x4 idc[2], idn[2], ra[8], rb[8]; u32x4 wc, wn; float sc_c, sc_n; u32x4 hc, hn;
#define GS_META(ids_, wts_, wsc_, h_, row_) do { const int rw_ = (row_); const u32x4* ip_ = (const u32x4*)((const unsigned short*)PIDX + (size_t)rw_ * 128 + 16 * g); ids_[0] = ip_[0]; ids_[1] = ip_[1]; \
                if (PH) { wts_ = *(const u32x4*)(PW + (size_t)rw_ * 128 + 16 * g); wsc_ = PC[rw_]; } \
                else h_ = *(const u32x4*)((const signed char*)(ws + WS_H) + (size_t)rw_ * D + 128 * p + 16 * i8); } while (0)
#define GS_ROWS(dst_, ids_, hf_) do { _Pragma("unroll") for (int k_ = 0; k_ < 8; ++k_) dst_[k_] = *(const u32x4*)(tb + (size_t)((ids_[hf_][k_ >> 1] >> (16 * (k_ & 1))) & 0xffffu) * 128); } while (0)
            GS_META(idc, wc, sc_c, hc, row0);
            GS_ROWS(ra, idc, 0);
            GS_META(idn, wn, sc_n, hn, row0 + 1);
            int i = 0, tnv = 0x7fffffff;
#pragma unroll 1
            for (;;) {
                if (i == GS_ITEM - 2) tnv = __builtin_amdgcn_readfirstlane((int)tn);
                const int row = it * GS_ITEM + i;
                const int r2 = (i + 2 < GS_ITEM) ? row + 2 : (tnv < nitem ? tnv * GS_ITEM + (i + 2 - GS_ITEM) : row);
                GS_ROWS(rb, idc, 1);
                if (PH == 0) {
                    int d[16];
#pragma unroll
                    for (int k = 0; k < 8; ++k) { int s_ = 0;
#pragma unroll
                        for (int q = 0; q < 4; ++q) s_ = __builtin_amdgcn_sdot4((int)ra[k][q], (int)hc[q], s_, false);
                        d[k] = s_; }
                    GS_ROWS(ra, idn, 0);
#pragma unroll
                    for (int k = 0; k < 8; ++k) { int s_ = 0;
#pragma unroll
                        for (int q = 0; q < 4; ++q) s_ = __builtin_amdgcn_sdot4((int)rb[k][q], (int)hc[q], s_, false);
                        d[8 + k] = s_; }
#define GS_IX(v_, K_) __builtin_bit_cast(int, lane_xor<K_>(__builtin_bit_cast(float, v_)))
                    { const bool hb = (lane & 4) != 0;
#pragma unroll
                      for (int j = 0; j < 8; ++j) { const int keep = hb ? d[j + 8] : d[j], send = hb ? d[j] : d[j + 8]; d[j] = keep + GS_IX(send, 4); } }
                    { const bool hb = (lane & 2) != 0;
#pragma unroll
                      for (int j = 0; j < 4; ++j) { const int keep = hb ? d[j + 4] : d[j], send = hb ? d[j] : d[j + 4]; d[j] = keep + GS_IX(send, 2); } }
                    { const bool hb = (lane & 1) != 0;
#pragma unroll
                      for (int j = 0; j < 2; ++j) { const int keep = hb ? d[j + 2] : d[j], send = hb ? d[j] : d[j + 2]; d[j] = keep + GS_IX(send, 1); } }
#undef GS_IX
                    u32x2 o = {(unsigned)d[0], (unsigned)d[1]};
                    __builtin_nontemporal_store(o, (u32x2*)((int*)(ws + WS_PD) + ((size_t)p * M + row) * 128 + 2 * lane));
                } else {
                    int oi[16];
#pragma unroll
                    for (int k = 0; k < 16; ++k) oi[k] = 0;
#define GS_QUAD(rr_, qd_, wd_) do { _Pragma("unroll") for (int q_ = 0; q_ < 4; ++q_) { \
                        const unsigned r0_ = rr_[4 * (qd_) + 0][q_], r1_ = rr_[4 * (qd_) + 1][q_], r2_ = rr_[4 * (qd_) + 2][q_], r3_ = rr_[4 * (qd_) + 3][q_]; \
                        const unsigned t0_ = __builtin_amdgcn_perm(r1_, r0_, 0x05010400u), t1_ = __builtin_amdgcn_perm(r1_, r0_, 0x07030602u), t2_ = __builtin_amdgcn_perm(r3_, r2_, 0x05010400u), t3_ = __builtin_amdgcn_perm(r3_, r2_, 0x07030602u); \
                        oi[4 * q_ + 0] = __builtin_amdgcn_sdot4((int)__builtin_amdgcn_perm(t2_, t0_, 0x05040100u), (int)(wd_), oi[4 * q_ + 0], false); \
                        oi[4 * q_ + 1] = __builtin_amdgcn_sdot4((int)__builtin_amdgcn_perm(t2_, t0_, 0x07060302u), (int)(wd_), oi[4 * q_ + 1], false); \
                        oi[4 * q_ + 2] = __builtin_amdgcn_sdot4((int)__builtin_amdgcn_perm(t3_, t1_, 0x05040100u), (int)(wd_), oi[4 * q_ + 2], false); \
                        oi[4 * q_ + 3] = __builtin_amdgcn_sdot4((int)__builtin_amdgcn_perm(t3_, t1_, 0x07060302u), (int)(wd_), oi[4 * q_ + 3], false); } } while (0)
                    GS_QUAD(ra, 0, wc[0]); GS_QUAD(ra, 1, wc[1]);
                    GS_ROWS(ra, idn, 0);
                    GS_QUAD(rb, 0, wc[2]); GS_QUAD(rb, 1, wc[3]);
#undef GS_QUAD
#pragma unroll
                    for (int j = 0; j < 8; ++j) { auto rr_ = __builtin_amdgcn_permlane32_swap((unsigned)oi[j], (unsigned)oi[j + 8], false, false); oi[j] = (int)(rr_[0] + rr_[1]); }
#pragma unroll
                    for (int j = 0; j < 4; ++j) { auto rr_ = __builtin_amdgcn_permlane16_swap((unsigned)oi[j], (unsigned)oi[j + 4], false, false); oi[j] = (int)(rr_[0] + rr_[1]); }
                    float o[2];
#pragma unroll
                    for (int j = 0; j < 2; ++j) { const int ta_ = oi[j] + __builtin_amdgcn_update_dpp(0, oi[j], 0x128, 0xF, 0xF, true), tb_ = oi[j + 2] + __builtin_amdgcn_update_dpp(0, oi[j + 2], 0x128, 0xF, 0xF, true);
                        o[j] = (float)((lane & 8) ? tb_ : ta_) * sc_c; }
                    const float corr = 0.f;
                    const int mrow = row < ML ? (row >= T ? 1 : 0) : 2;
                    const int col = 128 * p + 16 * i8 + 2 * g;
                    unsigned* xp = (unsigned*)((bf16_t*)(ws + WS_XB) + (size_t)row * D + col);
                    const unsigned xw = *xp; const f32x2 g2 = *(const f32x2*)(modl + mrow * 6144 + col);
                    const float x0 = bflo(xw) + g2[0] * (o[0] - corr), x1 = bfhi(xw) + g2[1] * (o[1] - corr);
                    if (l == DEPTH - 1) *(f32x2*)(a.out + (size_t)row * D + col) = (f32x2){x0, x1};
                    else *xp = pkbf_c(x0, x1);
                }
#pragma unroll
                for (int q = 0; q < 2; ++q) idc[q] = idn[q];
                if (PH) { wc = wn; sc_c = sc_n; } else hc = hn;
                GS_META(idn, wn, sc_n, hn, r2);
                if (++i == GS_ITEM) {
                    if (tnv >= nitem) break;
                    it = tnv; i = 0; tnv = 0x7fffffff;
                    if (lane == 0) tn = __hip_atomic_fetch_add(ctr, 1u, __ATOMIC_RELAXED, __HIP_MEMORY_SCOPE_AGENT);
                }
            }
#undef GS_META
#undef GS_ROWS
        }
    }
#undef a
}
__device__ __forceinline__ void phase_peer_weights(int l) {
    const KArgs ap = get_args();
#define a (*ap)
    const int tid = fresh_tid(), lane = tid & 63, wave = __builtin_amdgcn_readfirstlane(tid >> 6), G = fresh_g(), bx = fresh_bx();
    unsigned char* ws = a.ws;
    const int nrows = (l == DEPTH - 1) ? ML : M;
    const f32x2* SC2 = (const f32x2*)(ws + WS_USC) + (size_t)(l & 1) * NEXP;
    const int* PIDX = (const int*)(ws + WS_PIDX); const float* PGATE = (const float*)(ws + WS_PGATE);
    for (int row = wave * G + bx; row < nrows; row += G * 8) {
        const unsigned idw = *((const unsigned*)PIDX + (size_t)row * 64 + lane); const u32x2 id = {idw & 0xffffu, idw >> 16}; const f32x2 gt = *(const f32x2*)(PGATE + (size_t)row * 128 + 2 * lane);
        const float hsc = ((const float*)(ws + WS_GB))[row];
        int d0 = 0, d1 = 0;
#pragma unroll
        for (int p = 0; p < 8; ++p) { const u32x2 v = __builtin_nontemporal_load((const u32x2*)((const int*)(ws + WS_PD) + ((size_t)p * M + row) * 128 + 2 * lane)); d0 += (int)v[0]; d1 += (int)v[1]; }
        const f32x2 s0 = SC2[id[0]], s1 = SC2[id[1]];
        const float x0 = (float)d0 * (s0[0] * hsc), x1 = (float)d1 * (s1[0] * hsc);
        const float w0 = gt[0] * s0[1] * (0.5f * x0 * (1.f + erff(x0 * 0.70710678118654752f))), w1 = gt[1] * s1[1] * (0.5f * x1 * (1.f + erff(x1 * 0.70710678118654752f)));
        float mx = fmaxf(wave_max(fmaxf(fabsf(w0), fabsf(w1))), 1e-30f); const float inv = 127.f / mx;
        *(unsigned short*)(ws + WS_PW + (size_t)row * 128 + 2 * lane) = (unsigned short)(((unsigned)(int)rintf(w0 * inv) & 255u) | (((unsigned)(int)rintf(w1 * inv) & 255u) << 8));
        if (lane == 0) ((float*)(ws + WS_PC))[row] = mx * (1.f / 127.f);
    }
#undef a
}

__global__ void __launch_bounds__(512, 2) fwd(Args a) {
    extern __shared__ __attribute__((aligned(16))) unsigned char lds_raw[];
    LAS unsigned char* lds = (LAS unsigned char*)lds_raw;
    volatile LAS unsigned* MISC = (volatile LAS unsigned*)(lds + LDS_MISC);
    if (threadIdx.x < 16) MISC[threadIdx.x] = 0u;
    __syncthreads();
    XcdBarrier bar; bar.bar = (unsigned*)(a.ws + WS_CTL) + 4096; bar.x = 0; bar.st = MISC + 8;
    bar = xcd_barrier_post((unsigned*)(a.ws + WS_CTL) + 4096, MISC + 8);
#ifndef PHASE_MASK
#define PHASE_MASK 0x1FFF
#endif
#define EN(i) ((PHASE_MASK >> (i)) & 1)
#ifndef REP_MASK
#define REP_MASK 0
#endif
#define REPN(i) (1 + ((REP_MASK >> (i)) & 1))
#define IN(k) true
#define SEAM(k) do { XcdBarrier b_; b_.bar = (unsigned*)(get_args()->ws + WS_CTL) + 4096; b_.x = xb_xcc_id(); b_.st = (volatile LAS unsigned*)(lds + LDS_MISC) + 8; xcd_barrier(b_); } while (0)
    for (int rep_ = 0; rep_ < (REPN(0)); ++rep_) if (EN(0) && IN(0)) phase_prologue(lds);
    SEAM(0);
#pragma unroll 1
    for (int l_ = 0; l_ < DEPTH; ++l_) {
        int l = l_; asm volatile("" : "+s"(l));
        const int pb = 1 + l * NPH_L;
        const int mrows = (l == DEPTH - 1) ? ML : M;
        if (l == 0) { for (int rep_ = 0; rep_ < (REPN(1)); ++rep_) if (EN(1) && IN(pb + 0)) { phase_norm<true>(l, 0, lds); phase_quant_weights(lds); }
            SEAM(pb + 0); }
        for (int rep_ = 0; rep_ < (REPN(2)); ++rep_) if (EN(2) && IN(pb + 1)) { const KArgs ap = get_args(); unsigned char* ws = ap->ws; pg8::Gemm g{(const bf16_t*)(ws + WS_H), (const bf16_t*)((const signed char*)(ws + WS_WINT) + (size_t)l * NP * 1024), M, NP, 512}; pg8::StaticOrder S; S.init(M, NP, fresh_g(), fresh_bx());
            pg8::EpiBf16I8 E{(bf16_t*)(ws + WS_P), NP, (const float*)(ws + WS_GB), (const float*)(ws + WS_CTL) + CW_WMAX + (l * 3 + 0) * 3072}; pg8::gemm_phase(lds, g, S, E); }
        SEAM(pb + 1);
        for (int rep_ = 0; rep_ < (REPN(3)); ++rep_) if (EN(3) && IN(pb + 2)) { phase_dn_chunkprep<1>(l, lds); phase_prep(l, lds); }
        for (int rep_ = 0; rep_ < (REPN(4)); ++rep_) if (EN(4) && IN(pb + 3)) phase_dn_chunkprep<0>(l, lds);
        SEAM(pb + 3);
        for (int rep_ = 0; rep_ < (REPN(5)); ++rep_) if (EN(5) && IN(pb + 4)) { phase_dn_scan<0>(l, lds); __syncthreads(); phase_attn(l, lds_raw, MISC, rep_); }
        SEAM(pb + 4);
        for (int rep_ = 0; rep_ < (REPN(7)); ++rep_) if (EN(7) && IN(pb + 5)) phase_dn_out(l);
        SEAM(pb + 5);
        if (EN(8) && IN(pb + 6)) { const KArgs ap = get_args(); unsigned char* ws = ap->ws; pg8::Gemm g{(const bf16_t*)(ws + WS_CATQ), (const bf16_t*)((const signed char*)(ws + WS_WOUTT) + (size_t)l * 1024 * 1024), mrows, 1024, 512}; pg8::StaticOrder S; S.init(mrows, 1024, fresh_g(), fresh_bx());
            pg8::EpiResI8 E{ap->in[I_X], ap->in[I_CTX], (bf16_t*)(ws + WS_XB), l == 0, (const float*)(ws + WS_MOD) + (size_t)l * 3 * 6144 + 2048,
                              (const float*)(ws + WS_GB) + (1u << 18), (const float*)(ws + WS_CTL) + CW_WMAX + (l * 3 + 1) * 3072};
            pg8::gemm_phase(lds, g, S, E); }
        SEAM(pb + 6);
        for (int rep_ = 0; rep_ < (REPN(9)); ++rep_) if (EN(9) && IN(pb + 7)) phase_norm<false>(l, 1, lds);
        SEAM(pb + 7);
        for (int rep_ = 0; rep_ < (REPN(10)); ++rep_) if (EN(10) && IN(pb + 8)) { const KArgs ap = get_args(); unsigned char* ws = ap->ws; pg8::Gemm g{(const bf16_t*)(ws + WS_H), (const bf16_t*)((const signed char*)(ws + WS_WQT) + (size_t)l * 2048 * 1024), mrows, 2048, 512}; pg8::StaticOrder S; S.init(mrows, 2048, fresh_g(), fresh_bx());
            pg8::EpiBf16I8 E{(bf16_t*)(ws + WS_P), 2048, (const float*)(ws + WS_GB), (const float*)(ws + WS_CTL) + CW_WMAX + (l * 3 + 2) * 3072}; pg8::gemm_phase(lds, g, S, E); }
        SEAM(pb + 8);
        for (int rep_ = 0; rep_ < (REPN(11)); ++rep_) if (EN(11) && IN(pb + 9)) phase_peer_select(l);
        SEAM(pb + 9);
        #ifdef GATHER_VAR
        if (EN(12) && IN(pb + 10)) phase_peer_gather<false, GATHER_VAR>(l, lds);
#endif
#if GATHER_PART == 2
        if (EN(12) && IN(pb + 10)) phase_peer_slice<0>(l, 0);
        SEAM(pb + 10);
        if (EN(12) && IN(pb + 10)) phase_peer_weights(l);
        SEAM(pb + 10);
        if (EN(12) && IN(pb + 10)) phase_peer_slice<1>(l, 0);
        if (l + 1 < DEPTH) { SEAM(pb + 10); if (EN(12) && IN(pb + 10)) phase_norm<true>(l + 1, 0, lds); }
#elif GATHER_PART
        if (EN(12) && IN(pb + 10)) phase_peer_gpart(l, lds);
        SEAM(pb + 10);
        if (EN(12) && IN(pb + 10)) phase_peer_combine(l, lds);
#else
        if (REPN(12) > 1 && EN(12) && IN(pb + 10)) phase_peer_gather<false>(l, lds);
        if (EN(12) && IN(pb + 10)) phase_peer_gather<true>(l, lds);
#endif
        if (l + 1 < DEPTH) SEAM(pb + 10);
    }
#undef IN
#undef SEAM
}

#ifndef N_LAUNCH_MODE
#define N_LAUNCH_MODE 1
#endif
extern "C" void kernel_launch(void* const* d_in, const int* in_sizes, int n_in, void* d_out, int out_size, void* d_ws, size_t ws_size, hipStream_t stream) {
    static int grid = 0;
    if (grid == 0) {
        if (n_in != 20 || out_size != ML * D || ws_size < WS_END) { fprintf(stderr, "kernel_launch: unexpected shapes: n_in %d out %d ws %zu (need %zu)\n", n_in, out_size, ws_size, (size_t)WS_END); grid = -1; return; }
        int dev = 0, cus = 0, per_cu = 0;
        if (hipGetDevice(&dev) != hipSuccess || hipDeviceGetAttribute(&cus, hipDeviceAttributeMultiprocessorCount, dev) != hipSuccess) { grid = -1; return; }
        if (hipFuncSetAttribute((const void*)fwd, hipFuncAttributeMaxDynamicSharedMemorySize, LDS_BYTES) != hipSuccess) { fprintf(stderr, "kernel_launch: hipFuncSetAttribute failed\n"); grid = -1; return; }
        if (hipOccupancyMaxActiveBlocksPerMultiprocessor(&per_cu, (const void*)fwd, 512, LDS_BYTES) != hipSuccess || per_cu < 1) fprintf(stderr, "kernel_launch: occupancy query says %d\n", per_cu);
        (void)hipGetLastError();
        grid = cus;
    }
    if (grid < 0) return;
    (void)hipMemsetAsync((char*)d_ws + WS_CTL, 0, CTL_BYTES, stream);
    Args a{};
    for (int i = 0; i < 20; ++i) a.in[i] = (const float*)d_in[i];
    a.out = (float*)d_out; a.ws = (unsigned char*)d_ws;
    a.ph_lo = 0; a.ph_hi = NPHASE;
    hipLaunchKernelGGL(fwd, dim3(grid), dim3(512), LDS_BYTES, stream, a);
    const hipError_t le = hipPeekAtLastError();
    if (le != hipSuccess) fprintf(stderr, "kernel_launch: launch failed: %s\n", hipGetErrorName(le));
}
```
